# Optimizing an MI355X kernel written in HIP

```python
import jax, jax.numpy as jnp
from jax import lax
import numpy as np

D_MODEL = 1024
BATCH = 4
SEQ = 8192
DEPTH = 1

CHUNK = 64
N_LEFT_CHUNKS = 8
BAND = (N_LEFT_CHUNKS + 1) * CHUNK
ATT_HEADS = 8
HEAD_DIM = 64
ATT_WIDTH = ATT_HEADS * HEAD_DIM
MAX_REL = 128
SGU_BLOCK = 128
SGU_GROUPS = 8
SGU_WIDTH = 512
SGU_GROUP_DIM = SGU_WIDTH // SGU_GROUPS
IN_WIDTH = 3 * ATT_WIDTH + 2 * SGU_WIDTH
N_BRANCHES = 2
N_EXPERTS = 32
TOP_K = 4
D_EXPERT = D_MODEL
SWIGLU_LIMIT = 7.0
SWIGLU_ALPHA = 1.702
EXPERT_BLOCK = 256
N_MOD = 6
EPS = 1e-6

kernel_name = "hybrid_chunk_attn_gmlp_moe_block"


def rmsnorm(x, g):
    xf = x.astype(jnp.float32)
    y = xf * lax.rsqrt(jnp.mean(xf * xf, axis=-1, keepdims=True) + EPS)
    return (y * g.astype(jnp.float32)).astype(x.dtype)


def layernorm(x, g, b):
    xf = x.astype(jnp.float32)
    mu = jnp.mean(xf, axis=-1, keepdims=True)
    var = jnp.mean(jnp.square(xf - mu), axis=-1, keepdims=True)
    y = (xf - mu) * lax.rsqrt(var + EPS)
    return (y * g.astype(jnp.float32) + b.astype(jnp.float32)).astype(x.dtype)


def chunk_attention(q, k, v, rel_bias):
    B, S, _ = q.shape
    n_chunks = S // CHUNK
    q = q.reshape(B, n_chunks, CHUNK, ATT_HEADS, HEAD_DIM)
    k = k.reshape(B, n_chunks, CHUNK, ATT_HEADS, HEAD_DIM)
    v = v.reshape(B, n_chunks, CHUNK, ATT_HEADS, HEAD_DIM)
    pad = ((0, 0), (N_LEFT_CHUNKS, 0), (0, 0), (0, 0), (0, 0))
    kp = jnp.pad(k, pad)
    vp = jnp.pad(v, pad)
    kb = jnp.concatenate([kp[:, j:j + n_chunks] for j in range(N_LEFT_CHUNKS + 1)], axis=2)
    vb = jnp.concatenate([vp[:, j:j + n_chunks] for j in range(N_LEFT_CHUNKS + 1)], axis=2)
    scores = jnp.einsum('bcqhd,bckhd->bchqk', q, kb).astype(jnp.float32) * (HEAD_DIM ** -0.5)
    rel = (N_LEFT_CHUNKS * CHUNK + jnp.arange(CHUNK, dtype=jnp.int32)[:, None]) \
        - jnp.arange(BAND, dtype=jnp.int32)[None, :]
    idx = jnp.clip(rel, -MAX_REL, MAX_REL) + MAX_REL
    bias = rel_bias[:, idx].astype(jnp.float32)
    scores = scores + bias[None, None]
    kpos = jnp.arange(n_chunks, dtype=jnp.int32)[:, None] * CHUNK - N_LEFT_CHUNKS * CHUNK \
        + jnp.arange(BAND, dtype=jnp.int32)[None, :]
    valid = (kpos >= 0)[None, :, None, None, :]
    scores = jnp.where(valid, scores, -1e30)
    p = jax.nn.softmax(scores, axis=-1).astype(v.dtype)
    o = jnp.einsum('bchqk,bckhd->bcqhd', p, vb)
    return o.reshape(B, S, ATT_WIDTH)


def spatial_gating(z, ln_g, ln_b, w_s, b_s):
    B, S, _ = z.shape
    z = jax.nn.gelu(z, approximate=False)
    u, vv = jnp.split(z, 2, axis=-1)
    vv = layernorm(vv, ln_g, ln_b)
    n_blocks = S // SGU_BLOCK
    vv = vv.reshape(B, n_blocks, SGU_BLOCK, SGU_GROUPS, SGU_GROUP_DIM)
    causal = jnp.tril(jnp.ones((SGU_BLOCK, SGU_BLOCK), dtype=w_s.dtype))
    wm = w_s * causal[None]
    s = jnp.einsum('gts,bnsgd->bntgd', wm, vv) + b_s.T[None, None, :, :, None]
    return u * s.reshape(B, S, SGU_WIDTH)


def moe_ffn(h, w_router, b_router, w_gate_up, b_gate_up, w_down, b_down):
    B, S, D = h.shape
    xt = h.reshape(-1, D)
    N = xt.shape[0]
    logits = (xt @ w_router + b_router).astype(jnp.float32)
    top_v, top_i = lax.top_k(logits, TOP_K)
    gates = jax.nn.softmax(top_v, axis=-1).astype(h.dtype)
    n_assign = N * TOP_K
    flat_e = top_i.reshape(-1).astype(jnp.int32)
    flat_tok = jnp.arange(n_assign, dtype=jnp.int32) // TOP_K
    flat_g = gates.reshape(-1)
    order = jnp.argsort(flat_e)
    sorted_e = flat_e[order]
    sorted_tok = flat_tok[order]
    sorted_g = flat_g[order]
    counts = jnp.zeros((N_EXPERTS,), jnp.int32).at[flat_e].add(1)
    padded = (counts + EXPERT_BLOCK - 1) // EXPERT_BLOCK * EXPERT_BLOCK
    pad_end = jnp.cumsum(padded)
    pad_start = pad_end - padded
    start = jnp.cumsum(counts) - counts
    rank = jnp.arange(n_assign, dtype=jnp.int32) - start[sorted_e]
    dest = pad_start[sorted_e] + rank
    n_blocks = -(-n_assign // EXPERT_BLOCK) + N_EXPERTS
    P = n_blocks * EXPERT_BLOCK
    buf_tok = jnp.zeros((P,), jnp.int32).at[dest].set(sorted_tok)
    buf_g = jnp.zeros((P,), h.dtype).at[dest].set(sorted_g)
    block_start = jnp.arange(n_blocks, dtype=jnp.int32) * EXPERT_BLOCK
    block_e = jnp.minimum(jnp.searchsorted(pad_end, block_start, side='right'), N_EXPERTS - 1)
    xb = xt[buf_tok].reshape(n_blocks, EXPERT_BLOCK, D)

    def expert_block(args):
        xblk, e = args
        gu = xblk @ w_gate_up[e] + b_gate_up[e]
        x_glu = jnp.minimum(gu[:, :D_EXPERT], SWIGLU_LIMIT)
        x_lin = jnp.clip(gu[:, D_EXPERT:], -SWIGLU_LIMIT, SWIGLU_LIMIT)
        act = x_glu * jax.nn.sigmoid(SWIGLU_ALPHA * x_glu) * (x_lin + 1)
        return act @ w_down[e] + b_down[e]

    yb = lax.map(expert_block, (xb, block_e)).reshape(P, D)
    out = jnp.zeros_like(xt).at[buf_tok].add(yb * buf_g[:, None])
    return out.reshape(B, S, D)


def setup_inputs(seed: int = 0) -> dict:
    key = jax.random.key(seed)
    ks = jax.random.split(key, 26)
    L, D = DEPTH, D_MODEL

    def nrm(k, shape, scale):
        return jax.random.normal(k, shape, jnp.float32) * scale

    return {
        "x": nrm(ks[0], (BATCH, SEQ, D), 1.0),
        "c": nrm(ks[1], (BATCH, D), 1.0),
        "w_ada": nrm(ks[2], (L, D, N_MOD * D), D ** -0.5),
        "b_ada": nrm(ks[3], (L, N_MOD * D), 0.02),
        "g_pre_mix": 1.0 + nrm(ks[4], (L, D), 0.05),
        "g_post_mix": 1.0 + nrm(ks[5], (L, D), 0.05),
        "w_in": nrm(ks[6], (L, D, IN_WIDTH), D ** -0.5),
        "rel_bias": nrm(ks[7], (L, ATT_HEADS, 2 * MAX_REL + 1), 0.5),
        "sgu_ln_g": 1.0 + nrm(ks[8], (L, SGU_WIDTH), 0.05),
        "sgu_ln_b": nrm(ks[9], (L, SGU_WIDTH), 0.02),
        "w_spatial": nrm(ks[10], (L, SGU_GROUPS, SGU_BLOCK, SGU_BLOCK), 0.5 * SGU_BLOCK ** -0.5),
        "b_spatial": 1.0 + nrm(ks[11], (L, SGU_GROUPS, SGU_BLOCK), 0.1),
        "w_branch_a": nrm(ks[12], (L, ATT_WIDTH, D), ATT_WIDTH ** -0.5),
        "w_branch_b": nrm(ks[13], (L, SGU_WIDTH, D), SGU_WIDTH ** -0.5),
        "w_gate": nrm(ks[14], (L, D, N_BRANCHES * D), D ** -0.5),
        "b_gate": nrm(ks[15], (L, N_BRANCHES * D), 0.02),
        "w_out": nrm(ks[16], (L, D, D), D ** -0.5),
        "g_pre_ffn": 1.0 + nrm(ks[17], (L, D), 0.05),
        "g_post_ffn": 1.0 + nrm(ks[18], (L, D), 0.05),
        "w_router": nrm(ks[19], (L, D, N_EXPERTS), D ** -0.5),
        "b_router": nrm(ks[20], (L, N_EXPERTS), 0.01),
        "w_gate_up": nrm(ks[21], (L, N_EXPERTS, D, 2 * D_EXPERT), D ** -0.5),
        "b_gate_up": nrm(ks[22], (L, N_EXPERTS, 2 * D_EXPERT), 0.02),
        "w_down": nrm(ks[23], (L, N_EXPERTS, D_EXPERT, D), D_EXPERT ** -0.5),
        "b_down": nrm(ks[24], (L, N_EXPERTS, D), 0.02),
    }


def reference(x, c, w_ada, b_ada, g_pre_mix, g_post_mix, w_in, rel_bias, sgu_ln_g, sgu_ln_b,
              w_spatial, b_spatial, w_branch_a, w_branch_b, w_gate, b_gate, w_out,
              g_pre_ffn, g_post_ffn, w_router, b_router, w_gate_up, b_gate_up, w_down, b_down):
    c_act = jax.nn.silu(c)
    for l in range(DEPTH):
        mod = (c_act @ w_ada[l] + b_ada[l])[:, None, :]
        sh1, sc1, gt1, sh2, sc2, gt2 = jnp.split(mod, N_MOD, axis=-1)

        h = rmsnorm(x, g_pre_mix[l]) * (1 + sc1) + sh1
        proj = h @ w_in[l]
        q = proj[..., :ATT_WIDTH]
        k = proj[..., ATT_WIDTH:2 * ATT_WIDTH]
        v = proj[..., 2 * ATT_WIDTH:3 * ATT_WIDTH]
        z = proj[..., 3 * ATT_WIDTH:]
        y_a = chunk_attention(q, k, v, rel_bias[l])
        y_b = spatial_gating(z, sgu_ln_g[l], sgu_ln_b[l], w_spatial[l], b_spatial[l])
        gates = jax.nn.sigmoid(h @ w_gate[l] + b_gate[l])
        g_a, g_b = jnp.split(gates, N_BRANCHES, axis=-1)
        merged = g_a * (y_a @ w_branch_a[l]) + g_b * (y_b @ w_branch_b[l])
        y = rmsnorm(merged @ w_out[l], g_post_mix[l])
        x = x + gt1 * y

        h = rmsnorm(x, g_pre_ffn[l]) * (1 + sc2) + sh2
        y = moe_ffn(h, w_router[l], b_router[l], w_gate_up[l], b_gate_up[l], w_down[l], b_down[l])
        y = rmsnorm(y, g_post_ffn[l])
        x = x + gt2 * y
    return x
```

```cpp
#include <hip/hip_runtime.h>
#include <cstdio>
#include <cstdint>

constexpr int NB = 4, SEQ = 8192, D = 1024, NTOK = NB * SEQ;
constexpr int AW = 512, NHEAD = 8, HD = 64, CHUNK = 64, NLEFT = 8, BAND = 576, MAXREL = 128, NREL = 257;
constexpr int SW = 512, SGB = 128, SGG = 8, SGD = 64;
constexpr int INW = 2560, NEXP = 32, TOPK = 4, DE = 1024, NMOD = 6;
constexpr float EPS = 1e-6f, SWL = 7.0f, SWA = 1.702f;
constexpr float LOG2E = 1.4426950408889634f;
constexpr float QSCALE = 0.125f * LOG2E;
constexpr int SH1 = 0, SC1 = 1024, GT1 = 2048, SH2 = 3072, SC2 = 4096, GT2 = 5120;

typedef unsigned short bf16;
__device__ __forceinline__ float bf2f(bf16 v) { return __uint_as_float(((unsigned)v) << 16); }
__device__ __forceinline__ bf16 f2bf(float f) { unsigned u = __float_as_uint(f); return (bf16)((u + 0x7fffu + ((u >> 16) & 1u)) >> 16); }
__device__ __forceinline__ float wave_sum(float v) {
#pragma unroll
    for (int o = 1; o < 64; o <<= 1) v += __shfl_xor(v, o);
    return v;
}
__device__ __forceinline__ float gelu_erf(float x) { return 0.5f * x * (1.0f + erff(x * 0.70710678118654752f)); }
__device__ __forceinline__ float sigmoidf_(float x) { return 1.0f / (1.0f + __expf(-x)); }

constexpr size_t MiB = 1u << 20;
constexpr size_t WS_CTL = 0, CTL_ZERO_BYTES = 1 * MiB;
constexpr size_t WS_MOD = 1 * MiB;
constexpr size_t WS_W1T = 2 * MiB, WS_WBRT = 12 * MiB, WS_WOUTT = 14 * MiB, WS_WRT = 16 * MiB;
constexpr size_t WS_TOPE = 17 * MiB, WS_TOPG = 18 * MiB, WS_LIST = 19 * MiB;
constexpr size_t WS_WGUT = 32 * MiB, WS_WDNT = 160 * MiB;
constexpr size_t WS_XN = 224 * MiB;
constexpr size_t WS_Q = 288 * MiB, WS_K = 320 * MiB, WS_V = 352 * MiB, WS_U = 384 * MiB, WS_VG = 416 * MiB;
constexpr size_t WS_GT = 448 * MiB;
constexpr size_t WS_YAB = 576 * MiB, WS_MRG = 640 * MiB, WS_Y1 = 704 * MiB;
constexpr size_t WS_ACT = 288 * MiB;
constexpr size_t WS_Y2 = 576 * MiB;
constexpr size_t WS_VN = 768 * MiB;
constexpr size_t WS_TMP = 832 * MiB;
constexpr size_t WS_END = 960 * MiB;
constexpr int CW_CNT = 1024;

__global__ __launch_bounds__(256) void nv_mod(const float* __restrict__ c, const float* __restrict__ w_ada, const float* __restrict__ b_ada, float* __restrict__ mod) {
    __shared__ float sc[NB * D];
    for (int i = threadIdx.x; i < NB * D; i += 256) { const float v = c[i]; sc[i] = v / (1.0f + __expf(-v)); }
    __syncthreads();
    const int j = blockIdx.x * 256 + threadIdx.x;
    float a0 = 0.f, a1 = 0.f, a2 = 0.f, a3 = 0.f;
    for (int k = 0; k < D; ++k) { const float w = w_ada[(size_t)k * (NMOD * D) + j]; a0 += sc[k] * w; a1 += sc[D + k] * w; a2 += sc[2 * D + k] * w; a3 += sc[3 * D + k] * w; }
    const float bb = b_ada[j];
    mod[j] = a0 + bb; mod[6144 + j] = a1 + bb; mod[2 * 6144 + j] = a2 + bb; mod[3 * 6144 + j] = a3 + bb;
}

__global__ __launch_bounds__(256) void nv_xn1(const float* __restrict__ x, const float* __restrict__ g, const float* __restrict__ mod, bf16* __restrict__ xn) {
    const int row = blockIdx.x * 4 + (threadIdx.x >> 6), lane = threadIdx.x & 63, b = row / SEQ;
    const float4* xr = (const float4*)(x + (size_t)row * D);
    float4 v[4]; float ss = 0.f;
#pragma unroll
    for (int j = 0; j < 4; ++j) { v[j] = xr[lane + 64 * j]; ss += v[j].x * v[j].x + v[j].y * v[j].y + v[j].z * v[j].z + v[j].w * v[j].w; }
    const float rstd = rsqrtf(wave_sum(ss) * (1.0f / D) + EPS);
    const float* mb = mod + b * 6144;
#pragma unroll
    for (int j = 0; j < 4; ++j) {
        const int c0 = (lane + 64 * j) * 4; const float vv[4] = {v[j].x, v[j].y, v[j].z, v[j].w}; bf16 o[4];
#pragma unroll
        for (int i = 0; i < 4; ++i) o[i] = f2bf(vv[i] * rstd * g[c0 + i] * (1.0f + mb[SC1 + c0 + i]) + mb[SH1 + c0 + i]);
        *(uint2*)(xn + (size_t)row * D + c0) = make_uint2((unsigned)o[0] | ((unsigned)o[1] << 16), (unsigned)o[2] | ((unsigned)o[3] << 16));
    }
}

template <class G, bool DUAL>
__global__ __launch_bounds__(256) void nv_gemm(G g, int ldw, int K) {
    __shared__ float As[16][68];
    __shared__ float Ws[16][64];
    __shared__ float Ws2[DUAL ? 16 : 1][64];
    const int z = blockIdx.z; int nrows; const float* W; const float* W2;
    if (!g.setup(z, nrows, W, W2)) return;
    const int r0 = blockIdx.y * 64, n0 = blockIdx.x * 64;
    if (r0 >= nrows) return;
    const int tid = threadIdx.x, tx = tid & 15, ty = tid >> 4;
    const int lr = tid >> 2, lk = (tid & 3) * 4;
    int ar = r0 + lr; if (ar >= nrows) ar = nrows - 1;
    const bf16* ap = g.arow(z, ar) + lk;
    const int wk = tid >> 4, wn = (tid & 15) * 4;
    float acc[4][4], acc2[4][4];
#pragma unroll
    for (int i = 0; i < 4; ++i)
#pragma unroll
        for (int j = 0; j < 4; ++j) { acc[i][j] = 0.f; acc2[i][j] = 0.f; }
    for (int k0 = 0; k0 < K; k0 += 16) {
        const uint2 av = *(const uint2*)(ap + k0);
        As[lk + 0][lr] = bf2f((bf16)(av.x & 0xffff)); As[lk + 1][lr] = bf2f((bf16)(av.x >> 16));
        As[lk + 2][lr] = bf2f((bf16)(av.y & 0xffff)); As[lk + 3][lr] = bf2f((bf16)(av.y >> 16));
        *(float4*)&Ws[wk][wn] = *(const float4*)(W + (size_t)(k0 + wk) * ldw + n0 + wn);
        if (DUAL) *(float4*)&Ws2[wk][wn] = *(const float4*)(W2 + (size_t)(k0 + wk) * ldw + n0 + wn);
        __syncthreads();
#pragma unroll
        for (int kk = 0; kk < 16; ++kk) {
            const float4 a = *(const float4*)&As[kk][ty * 4]; const float4 b = *(const float4*)&Ws[kk][tx * 4];
            const float aa[4] = {a.x, a.y, a.z, a.w}, bb[4] = {b.x, b.y, b.z, b.w};
#pragma unroll
            for (int i = 0; i < 4; ++i)
#pragma unroll
                for (int j = 0; j < 4; ++j) acc[i][j] += aa[i] * bb[j];
            if (DUAL) { const float4 b2 = *(const float4*)&Ws2[kk][tx * 4]; const float cc[4] = {b2.x, b2.y, b2.z, b2.w};
#pragma unroll
                for (int i = 0; i < 4; ++i)
#pragma unroll
                    for (int j = 0; j < 4; ++j) acc2[i][j] += aa[i] * cc[j]; }
        }
        __syncthreads();
    }
#pragma unroll
    for (int i = 0; i < 4; ++i) { const int r = r0 + ty * 4 + i; if (r < nrows) {
#pragma unroll
        for (int j = 0; j < 4; ++j) g.store(z, r, n0 + tx * 4 + j, acc[i][j], acc2[i][j]); } }
}

struct G_In {
    const bf16* A; const float* W; bf16 *Q, *Kb, *V, *U, *VG;
    __device__ bool setup(int, int& nrows, const float*& w, const float*& w2) const { nrows = NTOK; w = W; w2 = W; return true; }
    __device__ const bf16* arow(int, int r) const { return A + (size_t)r * D; }
    __device__ void store(int, int r, int n, float acc, float) const {
        if (n < 512) Q[(size_t)r * 512 + n] = f2bf(acc * QSCALE);
        else if (n < 1024) Kb[(size_t)r * 512 + n - 512] = f2bf(acc);
        else if (n < 1536) V[(size_t)r * 512 + n - 1024] = f2bf(acc);
        else if (n < 2048) U[(size_t)r * 512 + n - 1536] = f2bf(gelu_erf(acc));
        else VG[(size_t)r * 512 + n - 2048] = f2bf(gelu_erf(acc));
    }
};
struct G_Gate {
    const bf16* A; const float* W; const float* bias; bf16* GT;
    __device__ bool setup(int, int& nrows, const float*& w, const float*& w2) const { nrows = NTOK; w = W; w2 = W; return true; }
    __device__ const bf16* arow(int, int r) const { return A + (size_t)r * D; }
    __device__ void store(int, int r, int n, float acc, float) const { GT[(size_t)r * 2048 + n] = f2bf(sigmoidf_(acc + bias[n])); }
};
struct G_BrA {
    const bf16* YAB; const float* W; const bf16* GT; float* TMP;
    __device__ bool setup(int, int& nrows, const float*& w, const float*& w2) const { nrows = NTOK; w = W; w2 = W; return true; }
    __device__ const bf16* arow(int, int r) const { return YAB + (size_t)r * 1024; }
    __device__ void store(int, int r, int n, float acc, float) const { TMP[(size_t)r * 1024 + n] = bf2f(GT[(size_t)r * 2048 + n]) * acc; }
};
struct G_BrB {
    const bf16* YAB; const float* W; const bf16* GT; const float* TMP; bf16* MRG;
    __device__ bool setup(int, int& nrows, const float*& w, const float*& w2) const { nrows = NTOK; w = W; w2 = W; return true; }
    __device__ const bf16* arow(int, int r) const { return YAB + (size_t)r * 1024 + 512; }
    __device__ void store(int, int r, int n, float acc, float) const { MRG[(size_t)r * 1024 + n] = f2bf(TMP[(size_t)r * 1024 + n] + bf2f(GT[(size_t)r * 2048 + 1024 + n]) * acc); }
};
struct G_Out {
    const bf16* MRG; const float* W; bf16* Y1;
    __device__ bool setup(int, int& nrows, const float*& w, const float*& w2) const { nrows = NTOK; w = W; w2 = W; return true; }
    __device__ const bf16* arow(int, int r) const { return MRG + (size_t)r * 1024; }
    __device__ void store(int, int r, int n, float acc, float) const { Y1[(size_t)r * 1024 + n] = f2bf(acc); }
};
__device__ __forceinline__ int moe_rowbase(const unsigned* cnt, int e) { int s = 0; for (int i = 0; i < e; ++i) s += (int)((cnt[i] + 255u) / 256u) * 256; return s; }
struct G_MoeGU {
    const bf16* XN2; const float* Wgu; const float* bgu; const unsigned* cnt; const int* list; bf16* ACT;
    __device__ bool setup(int z, int& nrows, const float*& w, const float*& w2) const { nrows = (int)cnt[z]; w = Wgu + (size_t)z * D * 2048; w2 = w + 1024; return nrows > 0; }
    __device__ const bf16* arow(int z, int r) const { const int slot = list[(size_t)z * NTOK + r]; return XN2 + (size_t)(slot >> 2) * D; }
    __device__ void store(int z, int r, int n, float acc, float acc2) const {
        const float xg = fminf(acc + bgu[z * 2048 + n], SWL); const float xl = fminf(fmaxf(acc2 + bgu[z * 2048 + 1024 + n], -SWL), SWL);
        ACT[(size_t)(moe_rowbase(cnt, z) + r) * 1024 + n] = f2bf(xg * sigmoidf_(SWA * xg) * (xl + 1.0f));
    }
};
struct G_MoeDn {
    const bf16* ACT; const float* Wdn; const float* bdn; const unsigned* cnt; const int* list; const float* topg; bf16* Y2;
    __device__ bool setup(int z, int& nrows, const float*& w, const float*& w2) const { nrows = (int)cnt[z]; w = Wdn + (size_t)z * D * D; w2 = w; return nrows > 0; }
    __device__ const bf16* arow(int z, int r) const { return ACT + (size_t)(moe_rowbase(cnt, z) + r) * 1024; }
    __device__ void store(int z, int r, int n, float acc, float) const { const int slot = list[(size_t)z * NTOK + r]; Y2[(size_t)slot * 1024 + n] = f2bf((acc + bdn[z * 1024 + n]) * topg[slot]); }
};

__global__ __launch_bounds__(256) void nv_attn(const bf16* __restrict__ Q, const bf16* __restrict__ Kb, const bf16* __restrict__ V, const float* __restrict__ rel_bias, bf16* __restrict__ YAB) {
    const int gid = blockIdx.x * 256 + threadIdx.x, h = gid & 7, tok = gid >> 3, b = tok / SEQ, t = tok % SEQ, c = t / CHUNK, qi = t % CHUNK;
    float q[64], o[64];
    const uint4* qp = (const uint4*)(Q + (size_t)tok * 512 + h * 64);
#pragma unroll
    for (int i = 0; i < 8; ++i) { const uint4 w = qp[i]; const unsigned ww[4] = {w.x, w.y, w.z, w.w};
#pragma unroll
        for (int j = 0; j < 4; ++j) { q[i * 8 + 2 * j] = bf2f((bf16)(ww[j] & 0xffff)); q[i * 8 + 2 * j + 1] = bf2f((bf16)(ww[j] >> 16)); } }
#pragma unroll
    for (int d = 0; d < 64; ++d) o[d] = 0.f;
    float m = -1e30f, l = 0.f;
    for (int kj = 0; kj < BAND; ++kj) {
        const int kpos = (c - NLEFT) * CHUNK + kj; if (kpos < 0) continue;
        const size_t kr = ((size_t)(b * SEQ + kpos)) * 512 + h * 64;
        const uint4* kp = (const uint4*)(Kb + kr); float s = 0.f;
#pragma unroll
        for (int i = 0; i < 8; ++i) { const uint4 w = kp[i]; const unsigned ww[4] = {w.x, w.y, w.z, w.w};
#pragma unroll
            for (int j = 0; j < 4; ++j) { s += q[i * 8 + 2 * j] * bf2f((bf16)(ww[j] & 0xffff)); s += q[i * 8 + 2 * j + 1] * bf2f((bf16)(ww[j] >> 16)); } }
        int rel = NLEFT * CHUNK + qi - kj; rel = rel < -MAXREL ? -MAXREL : (rel > MAXREL ? MAXREL : rel);
        s += rel_bias[h * NREL + rel + MAXREL] * LOG2E;
        const float mn = fmaxf(m, s), alpha = exp2f(m - mn), p = exp2f(s - mn);
        l = l * alpha + p; m = mn;
        const uint4* vp = (const uint4*)(V + kr);
#pragma unroll
        for (int i = 0; i < 8; ++i) { const uint4 w = vp[i]; const unsigned ww[4] = {w.x, w.y, w.z, w.w};
#pragma unroll
            for (int j = 0; j < 4; ++j) { o[i * 8 + 2 * j] = o[i * 8 + 2 * j] * alpha + p * bf2f((bf16)(ww[j] & 0xffff)); o[i * 8 + 2 * j + 1] = o[i * 8 + 2 * j + 1] * alpha + p * bf2f((bf16)(ww[j] >> 16)); } }
    }
    const float inv = 1.0f / l;
    bf16* op = YAB + (size_t)tok * 1024 + h * 64;
#pragma unroll
    for (int d = 0; d < 64; d += 2) *(unsigned*)(op + d) = (unsigned)f2bf(o[d] * inv) | ((unsigned)f2bf(o[d + 1] * inv) << 16);
}

__global__ __launch_bounds__(256) void nv_sgu_ln(const bf16* __restrict__ VG, const float* __restrict__ ln_g, const float* __restrict__ ln_b, float* __restrict__ VN) {
    const int row = blockIdx.x * 4 + (threadIdx.x >> 6), lane = threadIdx.x & 63;
    const uint4 w = *(const uint4*)(VG + (size_t)row * 512 + lane * 8); const unsigned ww[4] = {w.x, w.y, w.z, w.w};
    float v[8]; float s = 0.f;
#pragma unroll
    for (int j = 0; j < 4; ++j) { v[2 * j] = bf2f((bf16)(ww[j] & 0xffff)); v[2 * j + 1] = bf2f((bf16)(ww[j] >> 16)); s += v[2 * j] + v[2 * j + 1]; }
    const float mu = wave_sum(s) * (1.0f / 512.0f); float q = 0.f;
#pragma unroll
    for (int j = 0; j < 8; ++j) { v[j] -= mu; q += v[j] * v[j]; }
    const float rstd = rsqrtf(wave_sum(q) * (1.0f / 512.0f) + EPS);
#pragma unroll
    for (int j = 0; j < 8; ++j) VN[(size_t)row * 512 + lane * 8 + j] = v[j] * rstd * ln_g[lane * 8 + j] + ln_b[lane * 8 + j];
}
__global__ __launch_bounds__(256) void nv_sgu(const float* __restrict__ VN, const bf16* __restrict__ U, const float* __restrict__ w_s, const float* __restrict__ b_s, bf16* __restrict__ YAB) {
    const int gid = blockIdx.x * 256 + threadIdx.x, c = gid & 511, tok = gid >> 9, tl = tok & 127, tb = tok - tl, g = c >> 6;
    float acc = b_s[g * 128 + tl];
    const float* wr = w_s + ((size_t)g * 128 + tl) * 128;
    for (int s = 0; s <= tl; ++s) acc += wr[s] * VN[(size_t)(tb + s) * 512 + c];
    YAB[(size_t)tok * 1024 + 512 + c] = f2bf(bf2f(U[(size_t)tok * 512 + c]) * acc);
}

__global__ __launch_bounds__(256) void nv_rowpass1(const float* __restrict__ x, const bf16* __restrict__ Y1, const float* __restrict__ mod, const float* __restrict__ g_post_mix,
                                                   const float* __restrict__ g_pre_ffn, const float* __restrict__ w_router, const float* __restrict__ b_router,
                                                   float* __restrict__ X1, bf16* __restrict__ XN2, int* __restrict__ tope, float* __restrict__ topg, unsigned* cnt, int* __restrict__ list) {
    const int row = blockIdx.x * 4 + (threadIdx.x >> 6), lane = threadIdx.x & 63, b = row / SEQ;
    const float* mb = mod + b * 6144;
    float xv[16], yv[16]; float ss = 0.f;
#pragma unroll
    for (int j = 0; j < 4; ++j) {
        const int c0 = (lane + 64 * j) * 4;
        const float4 xx = *(const float4*)(x + (size_t)row * D + c0); xv[4 * j] = xx.x; xv[4 * j + 1] = xx.y; xv[4 * j + 2] = xx.z; xv[4 * j + 3] = xx.w;
        const uint2 yy = *(const uint2*)(Y1 + (size_t)row * D + c0);
        yv[4 * j] = bf2f((bf16)(yy.x & 0xffff)); yv[4 * j + 1] = bf2f((bf16)(yy.x >> 16)); yv[4 * j + 2] = bf2f((bf16)(yy.y & 0xffff)); yv[4 * j + 3] = bf2f((bf16)(yy.y >> 16));
#pragma unroll
        for (int i = 0; i < 4; ++i) ss += yv[4 * j + i] * yv[4 * j + i];
    }
    const float rstd = rsqrtf(wave_sum(ss) * (1.0f / D) + EPS); float s2 = 0.f;
#pragma unroll
    for (int j = 0; j < 4; ++j) { const int c0 = (lane + 64 * j) * 4;
#pragma unroll
        for (int i = 0; i < 4; ++i) { const float x1 = xv[4 * j + i] + mb[GT1 + c0 + i] * (yv[4 * j + i] * rstd * g_post_mix[c0 + i]); xv[4 * j + i] = x1; s2 += x1 * x1; }
        *(float4*)(X1 + (size_t)row * D + c0) = make_float4(xv[4 * j], xv[4 * j + 1], xv[4 * j + 2], xv[4 * j + 3]); }
    const float rstd2 = rsqrtf(wave_sum(s2) * (1.0f / D) + EPS);
#pragma unroll
    for (int j = 0; j < 4; ++j) { const int c0 = (lane + 64 * j) * 4;
#pragma unroll
        for (int i = 0; i < 4; ++i) xv[4 * j + i] = xv[4 * j + i] * rstd2 * g_pre_ffn[c0 + i] * (1.0f + mb[SC2 + c0 + i]) + mb[SH2 + c0 + i];
        *(uint2*)(XN2 + (size_t)row * D + c0) = make_uint2((unsigned)f2bf(xv[4 * j]) | ((unsigned)f2bf(xv[4 * j + 1]) << 16), (unsigned)f2bf(xv[4 * j + 2]) | ((unsigned)f2bf(xv[4 * j + 3]) << 16)); }
    float mylogit = -1e30f;
    for (int e = 0; e < NEXP; ++e) {
        float p = 0.f;
#pragma unroll
        for (int j = 0; j < 4; ++j) { const int c0 = (lane + 64 * j) * 4;
#pragma unroll
            for (int i = 0; i < 4; ++i) p += xv[4 * j + i] * w_router[(size_t)(c0 + i) * NEXP + e]; }
        p = wave_sum(p) + b_router[e];
        if (lane == e) mylogit = p;
    }
    float tv[4]; int ti[4];
#pragma unroll
    for (int k = 0; k < 4; ++k) {
        float bv = mylogit; int bi = lane;
#pragma unroll
        for (int o = 1; o < 64; o <<= 1) { const float ov = __shfl_xor(bv, o); const int oi = __shfl_xor(bi, o); if (ov > bv || (ov == bv && oi < bi)) { bv = ov; bi = oi; } }
        tv[k] = bv; ti[k] = bi; if (lane == bi) mylogit = -3e38f;
    }
    if (lane == 0) {
        const float e0 = 1.0f, e1 = __expf(tv[1] - tv[0]), e2 = __expf(tv[2] - tv[0]), e3 = __expf(tv[3] - tv[0]); const float inv = 1.0f / (e0 + e1 + e2 + e3);
        const float gg[4] = {e0 * inv, e1 * inv, e2 * inv, e3 * inv};
#pragma unroll
        for (int k = 0; k < 4; ++k) { const int slot = row * 4 + k; tope[slot] = ti[k]; topg[slot] = gg[k]; const unsigned pos = atomicAdd(&cnt[ti[k]], 1u); list[(size_t)ti[k] * NTOK + pos] = slot; }
    }
}

__global__ __launch_bounds__(256) void nv_final(const bf16* __restrict__ Y2, const float* __restrict__ mod, const float* __restrict__ g_post_ffn, float* __restrict__ out) {
    const int row = blockIdx.x * 4 + (threadIdx.x >> 6), lane = threadIdx.x & 63, b = row / SEQ;
    const float* mb = mod + b * 6144;
    float yv[16]; float ss = 0.f;
#pragma unroll
    for (int j = 0; j < 4; ++j) { const int c0 = (lane + 64 * j) * 4; float a[4] = {0.f, 0.f, 0.f, 0.f};
#pragma unroll
        for (int k = 0; k < 4; ++k) { const uint2 yy = *(const uint2*)(Y2 + ((size_t)row * 4 + k) * D + c0);
            a[0] += bf2f((bf16)(yy.x & 0xffff)); a[1] += bf2f((bf16)(yy.x >> 16)); a[2] += bf2f((bf16)(yy.y & 0xffff)); a[3] += bf2f((bf16)(yy.y >> 16)); }
#pragma unroll
        for (int i = 0; i < 4; ++i) { yv[4 * j + i] = a[i]; ss += a[i] * a[i]; } }
    const float rstd = rsqrtf(wave_sum(ss) * (1.0f / D) + EPS);
#pragma unroll
    for (int j = 0; j < 4; ++j) { const int c0 = (lane + 64 * j) * 4; float4 xx = *(const float4*)(out + (size_t)row * D + c0);
        xx.x += mb[GT2 + c0] * (yv[4 * j] * rstd * g_post_ffn[c0]); xx.y += mb[GT2 + c0 + 1] * (yv[4 * j + 1] * rstd * g_post_ffn[c0 + 1]);
        xx.z += mb[GT2 + c0 + 2] * (yv[4 * j + 2] * rstd * g_post_ffn[c0 + 2]); xx.w += mb[GT2 + c0 + 3] * (yv[4 * j + 3] * rstd * g_post_ffn[c0 + 3]);
        *(float4*)(out + (size_t)row * D + c0) = xx; }
}

extern "C" void kernel_launch(void* const* d_in, const int* in_sizes, int n_in, void* d_out, int out_size, void* d_ws, size_t ws_size, hipStream_t stream) {
    if (n_in != 25 || in_sizes[0] != NTOK * D || out_size != NTOK * D || ws_size < WS_END) { fprintf(stderr, "kernel_launch: unexpected shapes (n_in %d in0 %d out %d ws %zu)\n", n_in, n_in > 0 ? in_sizes[0] : -1, out_size, ws_size); return; }
    const float* x = (const float*)d_in[0]; const float* c = (const float*)d_in[1]; const float* w_ada = (const float*)d_in[2]; const float* b_ada = (const float*)d_in[3];
    const float* g_pre_mix = (const float*)d_in[4]; const float* g_post_mix = (const float*)d_in[5]; const float* w_in = (const float*)d_in[6]; const float* rel_bias = (const float*)d_in[7];
    const float* sgu_ln_g = (const float*)d_in[8]; const float* sgu_ln_b = (const float*)d_in[9]; const float* w_spatial = (const float*)d_in[10]; const float* b_spatial = (const float*)d_in[11];
    const float* w_branch_a = (const float*)d_in[12]; const float* w_branch_b = (const float*)d_in[13]; const float* w_gate = (const float*)d_in[14]; const float* b_gate = (const float*)d_in[15];
    const float* w_out = (const float*)d_in[16]; const float* g_pre_ffn = (const float*)d_in[17]; const float* g_post_ffn = (const float*)d_in[18]; const float* w_router = (const float*)d_in[19];
    const float* b_router = (const float*)d_in[20]; const float* w_gate_up = (const float*)d_in[21]; const float* b_gate_up = (const float*)d_in[22]; const float* w_down = (const float*)d_in[23];
    const float* b_down = (const float*)d_in[24];
    unsigned char* ws = (unsigned char*)d_ws; float* out = (float*)d_out;
    unsigned* ctl = (unsigned*)(ws + WS_CTL); float* mod = (float*)(ws + WS_MOD);
    bf16 *XN = (bf16*)(ws + WS_XN), *Qb = (bf16*)(ws + WS_Q), *Kb = (bf16*)(ws + WS_K), *Vb = (bf16*)(ws + WS_V), *Ub = (bf16*)(ws + WS_U), *VG = (bf16*)(ws + WS_VG);
    bf16 *GT = (bf16*)(ws + WS_GT), *YAB = (bf16*)(ws + WS_YAB), *MRG = (bf16*)(ws + WS_MRG), *Y1 = (bf16*)(ws + WS_Y1), *ACT = (bf16*)(ws + WS_ACT), *Y2 = (bf16*)(ws + WS_Y2);
    float *VN = (float*)(ws + WS_VN), *TMP = (float*)(ws + WS_TMP);
    int* tope = (int*)(ws + WS_TOPE); float* topg = (float*)(ws + WS_TOPG); int* list = (int*)(ws + WS_LIST); unsigned* cnt = ctl + CW_CNT;

    hipMemsetAsync(ws + WS_CTL, 0, CTL_ZERO_BYTES, stream);
    nv_mod<<<NMOD * D / 256, 256, 0, stream>>>(c, w_ada, b_ada, mod);
    nv_xn1<<<NTOK / 4, 256, 0, stream>>>(x, g_pre_mix, mod, XN);
    { G_In g{XN, w_in, Qb, Kb, Vb, Ub, VG}; nv_gemm<G_In, false><<<dim3(INW / 64, NTOK / 64, 1), 256, 0, stream>>>(g, INW, D); }
    { G_Gate g{XN, w_gate, b_gate, GT}; nv_gemm<G_Gate, false><<<dim3(2048 / 64, NTOK / 64, 1), 256, 0, stream>>>(g, 2048, D); }
    nv_attn<<<NTOK * NHEAD / 256, 256, 0, stream>>>(Qb, Kb, Vb, rel_bias, YAB);
    nv_sgu_ln<<<NTOK / 4, 256, 0, stream>>>(VG, sgu_ln_g, sgu_ln_b, VN);
    nv_sgu<<<NTOK * SW / 256, 256, 0, stream>>>(VN, Ub, w_spatial, b_spatial, YAB);
    { G_BrA g{YAB, w_branch_a, GT, TMP}; nv_gemm<G_BrA, false><<<dim3(D / 64, NTOK / 64, 1), 256, 0, stream>>>(g, D, AW); }
    { G_BrB g{YAB, w_branch_b, GT, TMP, MRG}; nv_gemm<G_BrB, false><<<dim3(D / 64, NTOK / 64, 1), 256, 0, stream>>>(g, D, SW); }
    { G_Out g{MRG, w_out, Y1}; nv_gemm<G_Out, false><<<dim3(D / 64, NTOK / 64, 1), 256, 0, stream>>>(g, D, D); }
    nv_rowpass1<<<NTOK / 4, 256, 0, stream>>>(x, Y1, mod, g_post_mix, g_pre_ffn, w_router, b_router, out, XN, tope, topg, cnt, list);
    { G_MoeGU g{XN, w_gate_up, b_gate_up, cnt, list, ACT}; nv_gemm<G_MoeGU, true><<<dim3(DE / 64, NTOK / 64, NEXP), 256, 0, stream>>>(g, 2048, D); }
    { G_MoeDn g{ACT, w_down, b_down, cnt, list, topg, Y2}; nv_gemm<G_MoeDn, false><<<dim3(D / 64, NTOK / 64, NEXP), 256, 0, stream>>>(g, D, DE); }
    nv_final<<<NTOK / 4, 256, 0, stream>>>(Y2, mod, g_post_ffn, out);
}
```

```cpp
#include <hip/hip_runtime.h>
#include <cstdio>
#include <cstdint>

constexpr int NB = 4, SEQ = 8192, D = 1024, NTOK = NB * SEQ;
constexpr int AW = 512, NHEAD = 8, HD = 64, CHUNK = 64, NLEFT = 8, BAND = 576, MAXREL = 128, NREL = 257;
constexpr int SW = 512, SGB = 128, SGG = 8, SGD = 64;
constexpr int INW = 2560, NEXP = 32, TOPK = 4, DE = 1024, NMOD = 6;
constexpr float EPS = 1e-6f, SWL = 7.0f, SWA = 1.702f;
constexpr float LOG2E = 1.4426950408889634f;
constexpr float QSCALE = 0.125f * LOG2E;
constexpr int SH1 = 0, SC1 = 1024, GT1 = 2048, SH2 = 3072, SC2 = 4096, GT2 = 5120;

typedef unsigned short bf16;
__device__ __forceinline__ float bf2f(bf16 v) { return __uint_as_float(((unsigned)v) << 16); }
__device__ __forceinline__ bf16 f2bf(float f) { unsigned u = __float_as_uint(f); return (bf16)((u + 0x7fffu + ((u >> 16) & 1u)) >> 16); }
__device__ __forceinline__ float wave_sum(float v) {
#pragma unroll
    for (int o = 1; o < 64; o <<= 1) v += __shfl_xor(v, o);
    return v;
}
__device__ __forceinline__ float gelu_erf(float x) { return 0.5f * x * (1.0f + erff(x * 0.70710678118654752f)); }
__device__ __forceinline__ float sigmoidf_(float x) { return 1.0f / (1.0f + __expf(-x)); }

constexpr size_t MiB = 1u << 20;
constexpr size_t WS_CTL = 0, CTL_ZERO_BYTES = 1 * MiB;
constexpr size_t WS_MOD = 1 * MiB;
constexpr size_t WS_W1T = 2 * MiB, WS_WBRT = 12 * MiB, WS_WOUTT = 14 * MiB, WS_WRT = 16 * MiB;
constexpr size_t WS_TOPE = 17 * MiB, WS_TOPG = 18 * MiB, WS_LIST = 19 * MiB;
constexpr size_t WS_WGUT = 32 * MiB, WS_WDNT = 160 * MiB;
constexpr size_t WS_XN = 224 * MiB;
constexpr size_t WS_Q = 288 * MiB, WS_K = 320 * MiB, WS_V = 352 * MiB, WS_U = 384 * MiB, WS_VG = 416 * MiB;
constexpr size_t WS_GT = 448 * MiB;
constexpr size_t WS_YAB = 576 * MiB, WS_MRG = 640 * MiB, WS_Y1 = 704 * MiB;
constexpr size_t WS_ACT = 288 * MiB;
constexpr size_t WS_Y2 = 576 * MiB;
constexpr size_t WS_VN = 768 * MiB;
constexpr size_t WS_TMP = 832 * MiB;
constexpr size_t WS_END = 960 * MiB;
constexpr int CW_CNT = 1024;

__global__ __launch_bounds__(256) void nv_mod(const float* __restrict__ c, const float* __restrict__ w_ada, const float* __restrict__ b_ada, float* __restrict__ mod) {
    __shared__ float sc[NB * D];
    for (int i = threadIdx.x; i < NB * D; i += 256) { const float v = c[i]; sc[i] = v / (1.0f + __expf(-v)); }
    __syncthreads();
    const int j = blockIdx.x * 256 + threadIdx.x;
    float a0 = 0.f, a1 = 0.f, a2 = 0.f, a3 = 0.f;
    for (int k = 0; k < D; ++k) { const float w = w_ada[(size_t)k * (NMOD * D) + j]; a0 += sc[k] * w; a1 += sc[D + k] * w; a2 += sc[2 * D + k] * w; a3 += sc[3 * D + k] * w; }
    const float bb = b_ada[j];
    mod[j] = a0 + bb; mod[6144 + j] = a1 + bb; mod[2 * 6144 + j] = a2 + bb; mod[3 * 6144 + j] = a3 + bb;
}

__global__ __launch_bounds__(256) void nv_xn1(const float* __restrict__ x, const float* __restrict__ g, const float* __restrict__ mod, bf16* __restrict__ xn) {
    const int row = blockIdx.x * 4 + (threadIdx.x >> 6), lane = threadIdx.x & 63, b = row / SEQ;
    const float4* xr = (const float4*)(x + (size_t)row * D);
    float4 v[4]; float ss = 0.f;
#pragma unroll
    for (int j = 0; j < 4; ++j) { v[j] = xr[lane + 64 * j]; ss += v[j].x * v[j].x + v[j].y * v[j].y + v[j].z * v[j].z + v[j].w * v[j].w; }
    const float rstd = rsqrtf(wave_sum(ss) * (1.0f / D) + EPS);
    const float* mb = mod + b * 6144;
#pragma unroll
    for (int j = 0; j < 4; ++j) {
        const int c0 = (lane + 64 * j) * 4; const float vv[4] = {v[j].x, v[j].y, v[j].z, v[j].w}; bf16 o[4];
#pragma unroll
        for (int i = 0; i < 4; ++i) o[i] = f2bf(vv[i] * rstd * g[c0 + i] * (1.0f + mb[SC1 + c0 + i]) + mb[SH1 + c0 + i]);
        *(uint2*)(xn + (size_t)row * D + c0) = make_uint2((unsigned)o[0] | ((unsigned)o[1] << 16), (unsigned)o[2] | ((unsigned)o[3] << 16));
    }
}

template <class G, bool DUAL>
__global__ __launch_bounds__(256) void nv_gemm(G g, int ldw, int K) {
    __shared__ float As[16][68];
    __shared__ float Ws[16][64];
    __shared__ float Ws2[DUAL ? 16 : 1][64];
    const int z = blockIdx.z; int nrows; const float* W; const float* W2;
    if (!g.setup(z, nrows, W, W2)) return;
    const int r0 = blockIdx.y * 64, n0 = blockIdx.x * 64;
    if (r0 >= nrows) return;
    const int tid = threadIdx.x, tx = tid & 15, ty = tid >> 4;
    const int lr = tid >> 2, lk = (tid & 3) * 4;
    int ar = r0 + lr; if (ar >= nrows) ar = nrows - 1;
    const bf16* ap = g.arow(z, ar) + lk;
    const int wk = tid >> 4, wn = (tid & 15) * 4;
    float acc[4][4], acc2[4][4];
#pragma unroll
    for (int i = 0; i < 4; ++i)
#pragma unroll
        for (int j = 0; j < 4; ++j) { acc[i][j] = 0.f; acc2[i][j] = 0.f; }
    for (int k0 = 0; k0 < K; k0 += 16) {
        const uint2 av = *(const uint2*)(ap + k0);
        As[lk + 0][lr] = bf2f((bf16)(av.x & 0xffff)); As[lk + 1][lr] = bf2f((bf16)(av.x >> 16));
        As[lk + 2][lr] = bf2f((bf16)(av.y & 0xffff)); As[lk + 3][lr] = bf2f((bf16)(av.y >> 16));
        *(float4*)&Ws[wk][wn] = *(const float4*)(W + (size_t)(k0 + wk) * ldw + n0 + wn);
        if (DUAL) *(float4*)&Ws2[wk][wn] = *(const float4*)(W2 + (size_t)(k0 + wk) * ldw + n0 + wn);
        __syncthreads();
#pragma unroll
        for (int kk = 0; kk < 16; ++kk) {
            const float4 a = *(const float4*)&As[kk][ty * 4]; const float4 b = *(const float4*)&Ws[kk][tx * 4];
            const float aa[4] = {a.x, a.y, a.z, a.w}, bb[4] = {b.x, b.y, b.z, b.w};
#pragma unroll
            for (int i = 0; i < 4; ++i)
#pragma unroll
                for (int j = 0; j < 4; ++j) acc[i][j] += aa[i] * bb[j];
            if (DUAL) { const float4 b2 = *(const float4*)&Ws2[kk][tx * 4]; const float cc[4] = {b2.x, b2.y, b2.z, b2.w};
#pragma unroll
                for (int i = 0; i < 4; ++i)
#pragma unroll
                    for (int j = 0; j < 4; ++j) acc2[i][j] += aa[i] * cc[j]; }
        }
        __syncthreads();
    }
#pragma unroll
    for (int i = 0; i < 4; ++i) { const int r = r0 + ty * 4 + i; if (r < nrows) {
#pragma unroll
        for (int j = 0; j < 4; ++j) g.store(z, r, n0 + tx * 4 + j, acc[i][j], acc2[i][j]); } }
}

struct G_In {
    const bf16* A; const float* W; bf16 *Q, *Kb, *V, *U, *VG;
    __device__ bool setup(int, int& nrows, const float*& w, const float*& w2) const { nrows = NTOK; w = W; w2 = W; return true; }
    __device__ const bf16* arow(int, int r) const { return A + (size_t)r * D; }
    __device__ void store(int, int r, int n, float acc, float) const {
        if (n < 512) Q[(size_t)r * 512 + n] = f2bf(acc * QSCALE);
        else if (n < 1024) Kb[(size_t)r * 512 + n - 512] = f2bf(acc);
        else if (n < 1536) V[(size_t)r * 512 + n - 1024] = f2bf(acc);
        else if (n < 2048) U[(size_t)r * 512 + n - 1536] = f2bf(gelu_erf(acc));
        else VG[(size_t)r * 512 + n - 2048] = f2bf(gelu_erf(acc));
    }
};
struct G_Gate {
    const bf16* A; const float* W; const float* bias; bf16* GT;
    __device__ bool setup(int, int& nrows, const float*& w, const float*& w2) const { nrows = NTOK; w = W; w2 = W; return true; }
    __device__ const bf16* arow(int, int r) const { return A + (size_t)r * D; }
    __device__ void store(int, int r, int n, float acc, float) const { GT[(size_t)r * 2048 + n] = f2bf(sigmoidf_(acc + bias[n])); }
};
struct G_BrA {
    const bf16* YAB; const float* W; const bf16* GT; float* TMP;
    __device__ bool setup(int, int& nrows, const float*& w, const float*& w2) const { nrows = NTOK; w = W; w2 = W; return true; }
    __device__ const bf16* arow(int, int r) const { return YAB + (size_t)r * 1024; }
    __device__ void store(int, int r, int n, float acc, float) const { TMP[(size_t)r * 1024 + n] = bf2f(GT[(size_t)r * 2048 + n]) * acc; }
};
struct G_BrB {
    const bf16* YAB; const float* W; const bf16* GT; const float* TMP; bf16* MRG;
    __device__ bool setup(int, int& nrows, const float*& w, const float*& w2) const { nrows = NTOK; w = W; w2 = W; return true; }
    __device__ const bf16* arow(int, int r) const { return YAB + (size_t)r * 1024 + 512; }
    __device__ void store(int, int r, int n, float acc, float) const { MRG[(size_t)r * 1024 + n] = f2bf(TMP[(size_t)r * 1024 + n] + bf2f(GT[(size_t)r * 2048 + 1024 + n]) * acc); }
};
struct G_Out {
    const bf16* MRG; const float* W; bf16* Y1;
    __device__ bool setup(int, int& nrows, const float*& w, const float*& w2) const { nrows = NTOK; w = W; w2 = W; return true; }
    __device__ const bf16* arow(int, int r) const { return MRG + (size_t)r * 1024; }
    __device__ void store(int, int r, int n, float acc, float) const { Y1[(size_t)r * 1024 + n] = f2bf(acc); }
};
__device__ __forceinline__ int moe_rowbase(const unsigned* cnt, int e) { int s = 0; for (int i = 0; i < e; ++i) s += (int)((cnt[i] + 255u) / 256u) * 256; return s; }
struct G_MoeGU {
    const bf16* XN2; const float* Wgu; const float* bgu; const unsigned* cnt; const int* list; bf16* ACT;
    __device__ bool setup(int z, int& nrows, const float*& w, const float*& w2) const { nrows = (int)cnt[z]; w = Wgu + (size_t)z * D * 2048; w2 = w + 1024; return nrows > 0; }
    __device__ const bf16* arow(int z, int r) const { const int slot = list[(size_t)z * NTOK + r]; return XN2 + (size_t)(slot >> 2) * D; }
    __device__ void store(int z, int r, int n, float acc, float acc2) const {
        const float xg = fminf(acc + bgu[z * 2048 + n], SWL); const float xl = fminf(fmaxf(acc2 + bgu[z * 2048 + 1024 + n], -SWL), SWL);
        ACT[(size_t)(moe_rowbase(cnt, z) + r) * 1024 + n] = f2bf(xg * sigmoidf_(SWA * xg) * (xl + 1.0f));
    }
};
struct G_MoeDn {
    const bf16* ACT; const float* Wdn; const float* bdn; const unsigned* cnt; const int* list; const float* topg; bf16* Y2;
    __device__ bool setup(int z, int& nrows, const float*& w, const float*& w2) const { nrows = (int)cnt[z]; w = Wdn + (size_t)z * D * D; w2 = w; return nrows > 0; }
    __device__ const bf16* arow(int z, int r) const { return ACT + (size_t)(moe_rowbase(cnt, z) + r) * 1024; }
    __device__ void store(int z, int r, int n, float acc, float) const { const int slot = list[(size_t)z * NTOK + r]; Y2[(size_t)slot * 1024 + n] = f2bf((acc + bdn[z * 1024 + n]) * topg[slot]); }
};

__global__ __launch_bounds__(256) void nv_attn(const bf16* __restrict__ Q, const bf16* __restrict__ Kb, const bf16* __restrict__ V, const float* __restrict__ rel_bias, bf16* __restrict__ YAB) {
    const int gid = blockIdx.x * 256 + threadIdx.x, h = gid & 7, tok = gid >> 3, b = tok / SEQ, t = tok % SEQ, c = t / CHUNK, qi = t % CHUNK;
    float q[64], o[64];
    const uint4* qp = (const uint4*)(Q + (size_t)tok * 512 + h * 64);
#pragma unroll
    for (int i = 0; i < 8; ++i) { const uint4 w = qp[i]; const unsigned ww[4] = {w.x, w.y, w.z, w.w};
#pragma unroll
        for (int j = 0; j < 4; ++j) { q[i * 8 + 2 * j] = bf2f((bf16)(ww[j] & 0xffff)); q[i * 8 + 2 * j + 1] = bf2f((bf16)(ww[j] >> 16)); } }
#pragma unroll
    for (int d = 0; d < 64; ++d) o[d] = 0.f;
    float m = -1e30f, l = 0.f;
    for (int kj = 0; kj < BAND; ++kj) {
        const int kpos = (c - NLEFT) * CHUNK + kj; if (kpos < 0) continue;
        const size_t kr = ((size_t)(b * SEQ + kpos)) * 512 + h * 64;
        const uint4* kp = (const uint4*)(Kb + kr); float s = 0.f;
#pragma unroll
        for (int i = 0; i < 8; ++i) { const uint4 w = kp[i]; const unsigned ww[4] = {w.x, w.y, w.z, w.w};
#pragma unroll
            for (int j = 0; j < 4; ++j) { s += q[i * 8 + 2 * j] * bf2f((bf16)(ww[j] & 0xffff)); s += q[i * 8 + 2 * j + 1] * bf2f((bf16)(ww[j] >> 16)); } }
        int rel = NLEFT * CHUNK + qi - kj; rel = rel < -MAXREL ? -MAXREL : (rel > MAXREL ? MAXREL : rel);
        s += rel_bias[h * NREL + rel + MAXREL] * LOG2E;
        const float mn = fmaxf(m, s), alpha = exp2f(m - mn), p = exp2f(s - mn);
        l = l * alpha + p; m = mn;
        const uint4* vp = (const uint4*)(V + kr);
#pragma unroll
        for (int i = 0; i < 8; ++i) { const uint4 w = vp[i]; const unsigned ww[4] = {w.x, w.y, w.z, w.w};
#pragma unroll
            for (int j = 0; j < 4; ++j) { o[i * 8 + 2 * j] = o[i * 8 + 2 * j] * alpha + p * bf2f((bf16)(ww[j] & 0xffff)); o[i * 8 + 2 * j + 1] = o[i * 8 + 2 * j + 1] * alpha + p * bf2f((bf16)(ww[j] >> 16)); } }
    }
    const float inv = 1.0f / l;
    bf16* op = YAB + (size_t)tok * 1024 + h * 64;
#pragma unroll
    for (int d = 0; d < 64; d += 2) *(unsigned*)(op + d) = (unsigned)f2bf(o[d] * inv) | ((unsigned)f2bf(o[d + 1] * inv) << 16);
}

__global__ __launch_bounds__(256) void nv_sgu_ln(const bf16* __restrict__ VG, const float* __restrict__ ln_g, const float* __restrict__ ln_b, float* __restrict__ VN) {
    const int row = blockIdx.x * 4 + (threadIdx.x >> 6), lane = threadIdx.x & 63;
    const uint4 w = *(const uint4*)(VG + (size_t)row * 512 + lane * 8); const unsigned ww[4] = {w.x, w.y, w.z, w.w};
    float v[8]; float s = 0.f;
#pragma unroll
    for (int j = 0; j < 4; ++j) { v[2 * j] = bf2f((bf16)(ww[j] & 0xffff)); v[2 * j + 1] = bf2f((bf16)(ww[j] >> 16)); s += v[2 * j] + v[2 * j + 1]; }
    const float mu = wave_sum(s) * (1.0f / 512.0f); float q = 0.f;
#pragma unroll
    for (int j = 0; j < 8; ++j) { v[j] -= mu; q += v[j] * v[j]; }
    const float rstd = rsqrtf(wave_sum(q) * (1.0f / 512.0f) + EPS);
#pragma unroll
    for (int j = 0; j < 8; ++j) VN[(size_t)row * 512 + lane * 8 + j] = v[j] * rstd * ln_g[lane * 8 + j] + ln_b[lane * 8 + j];
}
__global__ __launch_bounds__(256) void nv_sgu(const float* __restrict__ VN, const bf16* __restrict__ U, const float* __restrict__ w_s, const float* __restrict__ b_s, bf16* __restrict__ YAB) {
    const int gid = blockIdx.x * 256 + threadIdx.x, c = gid & 511, tok = gid >> 9, tl = tok & 127, tb = tok - tl, g = c >> 6;
    float acc = b_s[g * 128 + tl];
    const float* wr = w_s + ((size_t)g * 128 + tl) * 128;
    for (int s = 0; s <= tl; ++s) acc += wr[s] * VN[(size_t)(tb + s) * 512 + c];
    YAB[(size_t)tok * 1024 + 512 + c] = f2bf(bf2f(U[(size_t)tok * 512 + c]) * acc);
}

__global__ __launch_bounds__(256) void nv_rowpass1(const float* __restrict__ x, const bf16* __restrict__ Y1, const float* __restrict__ mod, const float* __restrict__ g_post_mix,
                                                   const float* __restrict__ g_pre_ffn, const float* __restrict__ w_router, const float* __restrict__ b_router,
                                                   float* __restrict__ X1, bf16* __restrict__ XN2, int* __restrict__ tope, float* __restrict__ topg, unsigned* cnt, int* __restrict__ list) {
    const int row = blockIdx.x * 4 + (threadIdx.x >> 6), lane = threadIdx.x & 63, b = row / SEQ;
    const float* mb = mod + b * 6144;
    float xv[16], yv[16]; float ss = 0.f;
#pragma unroll
    for (int j = 0; j < 4; ++j) {
        const int c0 = (lane + 64 * j) * 4;
        const float4 xx = *(const float4*)(x + (size_t)row * D + c0); xv[4 * j] = xx.x; xv[4 * j + 1] = xx.y; xv[4 * j + 2] = xx.z; xv[4 * j + 3] = xx.w;
        const uint2 yy = *(const uint2*)(Y1 + (size_t)row * D + c0);
        yv[4 * j] = bf2f((bf16)(yy.x & 0xffff)); yv[4 * j + 1] = bf2f((bf16)(yy.x >> 16)); yv[4 * j + 2] = bf2f((bf16)(yy.y & 0xffff)); yv[4 * j + 3] = bf2f((bf16)(yy.y >> 16));
#pragma unroll
        for (int i = 0; i < 4; ++i) ss += yv[4 * j + i] * yv[4 * j + i];
    }
    const float rstd = rsqrtf(wave_sum(ss) * (1.0f / D) + EPS); float s2 = 0.f;
#pragma unroll
    for (int j = 0; j < 4; ++j) { const int c0 = (lane + 64 * j) * 4;
#pragma unroll
        for (int i = 0; i < 4; ++i) { const float x1 = xv[4 * j + i] + mb[GT1 + c0 + i] * (yv[4 * j + i] * rstd * g_post_mix[c0 + i]); xv[4 * j + i] = x1; s2 += x1 * x1; }
        *(float4*)(X1 + (size_t)row * D + c0) = make_float4(xv[4 * j], xv[4 * j + 1], xv[4 * j + 2], xv[4 * j + 3]); }
    const float rstd2 = rsqrtf(wave_sum(s2) * (1.0f / D) + EPS);
#pragma unroll
    for (int j = 0; j < 4; ++j) { const int c0 = (lane + 64 * j) * 4;
#pragma unroll
        for (int i = 0; i < 4; ++i) xv[4 * j + i] = xv[4 * j + i] * rstd2 * g_pre_ffn[c0 + i] * (1.0f + mb[SC2 + c0 + i]) + mb[SH2 + c0 + i];
        *(uint2*)(XN2 + (size_t)row * D + c0) = make_uint2((unsigned)f2bf(xv[4 * j]) | ((unsigned)f2bf(xv[4 * j + 1]) << 16), (unsigned)f2bf(xv[4 * j + 2]) | ((unsigned)f2bf(xv[4 * j + 3]) << 16)); }
    float mylogit = -1e30f;
    for (int e = 0; e < NEXP; ++e) {
        float p = 0.f;
#pragma unroll
        for (int j = 0; j < 4; ++j) { const int c0 = (lane + 64 * j) * 4;
#pragma unroll
            for (int i = 0; i < 4; ++i) p += xv[4 * j + i] * w_router[(size_t)(c0 + i) * NEXP + e]; }
        p = wave_sum(p) + b_router[e];
        if (lane == e) mylogit = p;
    }
    float tv[4]; int ti[4];
#pragma unroll
    for (int k = 0; k < 4; ++k) {
        float bv = mylogit; int bi = lane;
#pragma unroll
        for (int o = 1; o < 64; o <<= 1) { const float ov = __shfl_xor(bv, o); const int oi = __shfl_xor(bi, o); if (ov > bv || (ov == bv && oi < bi)) { bv = ov; bi = oi; } }
        tv[k] = bv; ti[k] = bi; if (lane == bi) mylogit = -3e38f;
    }
    if (lane == 0) {
        const float e0 = 1.0f, e1 = __expf(tv[1] - tv[0]), e2 = __expf(tv[2] - tv[0]), e3 = __expf(tv[3] - tv[0]); const float inv = 1.0f / (e0 + e1 + e2 + e3);
        const float gg[4] = {e0 * inv, e1 * inv, e2 * inv, e3 * inv};
#pragma unroll
        for (int k = 0; k < 4; ++k) { const int slot = row * 4 + k; tope[slot] = ti[k]; topg[slot] = gg[k]; const unsigned pos = atomicAdd(&cnt[ti[k]], 1u); list[(size_t)ti[k] * NTOK + pos] = slot; }
    }
}

__global__ __launch_bounds__(256) void nv_final(const bf16* __restrict__ Y2, const float* __restrict__ mod, const float* __restrict__ g_post_ffn, float* __restrict__ out) {
    const int row = blockIdx.x * 4 + (threadIdx.x >> 6), lane = threadIdx.x & 63, b = row / SEQ;
    const float* mb = mod + b * 6144;
    float yv[16]; float ss = 0.f;
#pragma unroll
    for (int j = 0; j < 4; ++j) { const int c0 = (lane + 64 * j) * 4; float a[4] = {0.f, 0.f, 0.f, 0.f};
#pragma unroll
        for (int k = 0; k < 4; ++k) { const uint2 yy = *(const uint2*)(Y2 + ((size_t)row * 4 + k) * D + c0);
            a[0] += bf2f((bf16)(yy.x & 0xffff)); a[1] += bf2f((bf16)(yy.x >> 16)); a[2] += bf2f((bf16)(yy.y & 0xffff)); a[3] += bf2f((bf16)(yy.y >> 16)); }
#pragma unroll
        for (int i = 0; i < 4; ++i) { yv[4 * j + i] = a[i]; ss += a[i] * a[i]; } }
    const float rstd = rsqrtf(wave_sum(ss) * (1.0f / D) + EPS);
#pragma unroll
    for (int j = 0; j < 4; ++j) { const int c0 = (lane + 64 * j) * 4; float4 xx = *(const float4*)(out + (size_t)row * D + c0);
        xx.x += mb[GT2 + c0] * (yv[4 * j] * rstd * g_post_ffn[c0]); xx.y += mb[GT2 + c0 + 1] * (yv[4 * j + 1] * rstd * g_post_ffn[c0 + 1]);
        xx.z += mb[GT2 + c0 + 2] * (yv[4 * j + 2] * rstd * g_post_ffn[c0 + 2]); xx.w += mb[GT2 + c0 + 3] * (yv[4 * j + 3] * rstd * g_post_ffn[c0 + 3]);
        *(float4*)(out + (size_t)row * D + c0) = xx; }
}

#define LAS __attribute__((address_space(3)))
#define GAS __attribute__((address_space(1)))
typedef short bf16x8 __attribute__((ext_vector_type(8)));
typedef short s16x4 __attribute__((ext_vector_type(4)));
typedef float f32x4 __attribute__((ext_vector_type(4)));
typedef float f32x2 __attribute__((ext_vector_type(2)));
typedef float f32x16 __attribute__((ext_vector_type(16)));
typedef unsigned u32x4 __attribute__((ext_vector_type(4)));
typedef unsigned u32x2 __attribute__((ext_vector_type(2)));
typedef __bf16 bf16x2_t __attribute__((ext_vector_type(2)));
constexpr int NWAVES = 8;
constexpr int TRASH_SLOT = NTOK * 4;

__device__ __forceinline__ unsigned cvtpk(float lo, float hi) { f32x2 v = {lo, hi}; bf16x2_t b = __builtin_convertvector(v, bf16x2_t); return __builtin_bit_cast(unsigned, b); }
__device__ __forceinline__ float bflo(unsigned w) { return __uint_as_float(w << 16); }
__device__ __forceinline__ float bfhi(unsigned w) { return __uint_as_float(w & 0xffff0000u); }
__device__ __forceinline__ float fast_sigmoid(float x) { return __builtin_amdgcn_rcpf(1.0f + __builtin_amdgcn_exp2f(-LOG2E * x)); }
__device__ __forceinline__ f32x2 gelu_pk(f32x2 v) {
    const f32x2 av = __builtin_elementwise_abs(v), d = av * 0.2316418882f + 1.0f;
    f32x2 t; t.x = __builtin_amdgcn_rcpf(d.x); t.y = __builtin_amdgcn_rcpf(d.y);
    f32x2 q = t * 0.5307027145f + (-0.7265760135f); q = q * t + 0.7107068705f; q = q * t + (-0.142248368f); q = q * t + 0.127414796f; q = q * t;
    const f32x2 s = (v * v) * (-0.72134752044f);
    f32x2 e; e.x = __builtin_amdgcn_exp2f(s.x); e.y = __builtin_amdgcn_exp2f(s.y);
    const f32x2 m = v * (q * e), r = v - m;
    f32x2 o; o.x = v.x < 0.f ? m.x : r.x; o.y = v.y < 0.f ? m.y : r.y; return o;
}

constexpr int RING_OFF = 0, RING_BYTES = 131072;
constexpr int GTAB_OFF = RING_BYTES, GTAB_UNITS = 20, GTAB_BYTES = GTAB_UNITS * 256 * 4;
constexpr int MISC_OFF = GTAB_OFF + GTAB_BYTES;
constexpr int LDS_BYTES = MISC_OFF + 512;
static_assert(LDS_BYTES <= 160 * 1024, "LDS map");

#define XB_TMO      128
#define XB_XCNT(j)  (256  + 64 * (j))
#define XB_XSUB(j)  (1280 + 64 * (j))
#define XB_XGEN(j)  (2304 + 64 * (j))
#define XB_TOP      3328
#define XB_TOPGEN   3392
#define XCD_BAR_WORDS 3456
#define XB_SPIN_CAP (1u << 18)
__device__ __forceinline__ unsigned xb_ld(unsigned* p)              { return __hip_atomic_load(p, __ATOMIC_RELAXED, __HIP_MEMORY_SCOPE_AGENT); }
__device__ __forceinline__ unsigned xb_add(unsigned* p, unsigned v) { return __hip_atomic_fetch_add(p, v, __ATOMIC_RELAXED, __HIP_MEMORY_SCOPE_AGENT); }
__device__ __forceinline__ unsigned xb_xcc_id() { return (unsigned)__builtin_amdgcn_s_getreg((3 << 11) | 20) & 0xFu; }
#define XB_SPIN(cond, bar) do { unsigned _sp = 0; while (cond) { __builtin_amdgcn_s_sleep(1); \
    if ((++_sp & 255u) == 0u) { if (xb_ld(&(bar)[XB_TMO])) break; if (_sp > XB_SPIN_CAP) { atomicAdd(&(bar)[XB_TMO], 1u); break; } } } } while (0)
struct XcdBarrier { unsigned* bar; unsigned x; volatile LAS unsigned* st; };
__device__ __forceinline__ XcdBarrier xcd_barrier_post(unsigned* bar, volatile LAS unsigned* st) {
    XcdBarrier b; b.bar = bar; b.x = xb_xcc_id(); b.st = st;
    if (threadIdx.x == 0) (void)xb_add(&bar[XB_XCNT(b.x)], 1u);
    return b;
}
__device__ __forceinline__ void xcd_barrier_complete(unsigned* bar, unsigned x, unsigned& nloc, unsigned& nx) {
    const unsigned G = gridDim.x * gridDim.y * gridDim.z;
    unsigned sum, cnt, mine, sp = 0u;
    for (;;) {
        sum = 0u; cnt = 0u; mine = 0u;
#pragma unroll
        for (unsigned j = 0; j < 16; ++j) { const unsigned c = xb_ld(&bar[XB_XCNT(j)]); sum += c; cnt += (c > 0u) ? 1u : 0u; mine = (j == x) ? c : mine; }
        if (sum == G) break;
        __builtin_amdgcn_s_sleep(1);
        if ((++sp & 255u) == 0u) { if (xb_ld(&bar[XB_TMO])) break; if (sp > XB_SPIN_CAP) { atomicAdd(&bar[XB_TMO], 1u); break; } }
    }
    nloc = mine > 0u ? mine : 1u; nx = cnt > 0u ? cnt : 1u;
}
__device__ __forceinline__ void xcd_barrier(const XcdBarrier& b) {
    asm volatile("s_waitcnt vmcnt(0)" ::: "memory");
    __syncthreads();
    if (threadIdx.x == 0) {
        unsigned* bar = b.bar;
        __builtin_amdgcn_s_waitcnt(0);
        unsigned nloc = b.st[0], nx = b.st[1];
        if (nloc == 0u) { xcd_barrier_complete(bar, b.x, nloc, nx); b.st[0] = nloc; b.st[1] = nx; }
        const unsigned old = xb_add(&bar[XB_XSUB(b.x)], 1u);
        const unsigned gen = old / nloc;
        if (old + 1u == (gen + 1u) * nloc) {
            __builtin_amdgcn_fence(__ATOMIC_RELEASE, "agent");
            asm volatile("s_waitcnt vmcnt(0)" ::: "memory");
            const unsigned og = xb_add(&bar[XB_TOP], 1u);
            const unsigned tg = og / nx;
            if (og + 1u == (tg + 1u) * nx) xb_add(&bar[XB_TOPGEN], 1u);
            else XB_SPIN(xb_ld(&bar[XB_TOPGEN]) == tg, bar);
            __builtin_amdgcn_fence(__ATOMIC_ACQUIRE, "agent");
            xb_add(&bar[XB_XGEN(b.x)], 1u);
            asm volatile("s_waitcnt vmcnt(0)" ::: "memory");
        } else {
            XB_SPIN(xb_ld(&bar[XB_XGEN(b.x)]) == gen, bar);
            __builtin_amdgcn_fence(__ATOMIC_ACQUIRE, "agent");
            asm volatile("s_waitcnt vmcnt(0)" ::: "memory");
        }
    }
    __syncthreads();
}
constexpr int CW_BAR = 4096;

namespace pg8 {
constexpr int BM = 256, BK = 64, HALF = 128, HTB = HALF * BK * 2, STAGE_BYTES = 8 * HTB, NXCD = 8, WGM = 8;
__host__ __device__ __forceinline__ int lds_byte(int r, int c) { const int st = (r >> 4) * 2 + (c >> 5), rr = r & 15, cc = c & 31, ob = rr * 64 + cc * 2; return st * 1024 + (ob ^ (((ob >> 9) & 1) << 5)); }
__host__ __device__ __forceinline__ void stage_rc(int b, int& R, int& C) { const int st = b / 1024, sb = b % 1024, swz = sb ^ (((sb >> 9) & 1) << 5); R = (st >> 1) * 16 + swz / 64; C = (st & 1) * 32 + (swz % 64) / 2; }
__host__ __device__ __forceinline__ int perm32(int rho) { const int n = rho >> 4, i = rho & 15; return 8 * (i >> 2) + 4 * n + (i & 3); }
struct Unit { int pm, pn, aux; };

__device__ __forceinline__ bool static_unit(int i, int G, int c, int nM, int nN, int& pm, int& pn) {
    const int nwg = nM * nN; const long L = (long)i * G + c; if (L >= nwg) return false;
    int wgid = (int)L; { const int q = nwg / NXCD, r = nwg % NXCD, xcd = wgid % NXCD, off = wgid / NXCD; wgid = (xcd < r ? xcd * (q + 1) : r * (q + 1) + (xcd - r) * q) + off; }
    const int nig = WGM * nN, gid = wgid / nig, fm = gid * WGM, gsz = (nM - fm) < WGM ? (nM - fm) : WGM;
    pm = fm + ((wgid % nig) % gsz); pn = (wgid % nig) / gsz; return true;
}

template <class Epi, class Sched>
__device__ __forceinline__ void gemm_phase(LAS unsigned char* lds, const Sched& S, const Epi& E, const int lda, const int ldb, const int nt) {
    const int tid = threadIdx.x, wid = __builtin_amdgcn_readfirstlane(tid >> 6), lane = tid & 63, wr = wid >> 2, wc = wid & 3, fr = lane & 15, fq = lane >> 4;
    int Rr[2], Cc[2]; unsigned voffB[2];
#pragma unroll
    for (int i = 0; i < 2; ++i) { stage_rc(tid * 16 + i * 8192, Rr[i], Cc[i]); const int Rb = (Rr[i] & ~31) + perm32(Rr[i] & 31); voffB[i] = (unsigned)(Rb * ldb + Cc[i]) * 2u; }
    const size_t kstep = (size_t)(BK * 2);
    const size_t hstepB = (size_t)HALF * ldb * 2;
    const unsigned ldsw = (unsigned)wid * 1024u;
    const int aoff = lds_byte(wr * 64 + fr, fq * 8), boff = lds_byte(wc * 32 + fr, fq * 8);
#define PG8_SA(b, h) (((b) * 2 + (h)) * HTB)
#define PG8_SB(b, h) ((4 + (b) * 2 + (h)) * HTB)
#define PG8_STAGE(bufoff, gbase, voff) do { _Pragma("unroll") for (int _i = 0; _i < 2; ++_i) \
        __builtin_amdgcn_global_load_lds((const unsigned*)((const char*)(gbase) + (voff)[_i]), (LAS unsigned*)(lds + (bufoff) + ldsw + _i * 8192), 16, 0, 0); } while (0)
#define PG8_LDA(dst, b, h) do { _Pragma("unroll") for (int m = 0; m < 4; ++m) _Pragma("unroll") for (int k = 0; k < 2; ++k) dst[m][k] = *(const LAS bf16x8*)(lds + PG8_SA(b, h) + aoff + m * 2048 + k * 1024); } while (0)
#define PG8_LDB(dst, b, h) do { _Pragma("unroll") for (int n = 0; n < 2; ++n) _Pragma("unroll") for (int k = 0; k < 2; ++k) dst[n][k] = *(const LAS bf16x8*)(lds + PG8_SB(b, h) + boff + n * 2048 + k * 1024); } while (0)
#define PG8_MMA(ai, bj, At, Bt) do { __builtin_amdgcn_s_setprio(1); _Pragma("unroll") for (int m = 0; m < 4; ++m) _Pragma("unroll") for (int n = 0; n < 2; ++n) _Pragma("unroll") for (int k = 0; k < 2; ++k) \
        acc[ai][bj][m][n] = __builtin_amdgcn_mfma_f32_16x16x32_bf16(Bt[n][k], At[m][k], acc[ai][bj][m][n], 0, 0, 0); __builtin_amdgcn_s_setprio(0); } while (0)
#define PG8_WAIT_V(n) asm volatile("s_waitcnt vmcnt(" #n ")" ::: "memory")
#define PG8_WAIT_L(n) asm volatile("s_waitcnt lgkmcnt(" #n ")" ::: "memory")
#define PG8_BAR __builtin_amdgcn_s_barrier()
#define PG8_SCHED __builtin_amdgcn_sched_barrier(0)
    Unit cur, nxt; int ui = 0;
    if (!S.next(0, cur)) return;
    f32x4 acc[2][2][4][2];
#pragma unroll
    for (int a = 0; a < 2; ++a)
#pragma unroll
        for (int b = 0; b < 2; ++b)
#pragma unroll
            for (int m = 0; m < 4; ++m)
#pragma unroll
                for (int n = 0; n < 2; ++n) acc[a][b][m][n] = (f32x4){0.f, 0.f, 0.f, 0.f};
    bf16x8 At[4][2], B0[2][2], B1[2][2];
    unsigned oA[2][2];
#pragma unroll
    for (int h = 0; h < 2; ++h)
#pragma unroll
        for (int i = 0; i < 2; ++i) oA[h][i] = Sched::GATHER ? (S.goff(0, h * HALF + Rr[i]) + (unsigned)Cc[i] * 2u) : (unsigned)((h * HALF + Rr[i]) * lda + Cc[i]) * 2u;
    const char* cA = S.aptr(cur); const char* cB = S.bptr(cur);
    PG8_STAGE(PG8_SB(0, 0), cB, voffB); PG8_STAGE(PG8_SB(0, 1), cB + hstepB, voffB); PG8_STAGE(PG8_SA(0, 0), cA, oA[0]); PG8_STAGE(PG8_SA(0, 1), cA, oA[1]);
    if (wr == 1) PG8_BAR;
    PG8_WAIT_V(2); PG8_BAR;
    PG8_STAGE(PG8_SB(1, 0), cB + kstep, voffB); PG8_STAGE(PG8_SA(1, 0), cA + kstep, oA[0]); PG8_STAGE(PG8_SB(1, 1), cB + hstepB + kstep, voffB);
    PG8_WAIT_V(6); PG8_BAR;
    for (;;) {
        const bool has_next = S.next(ui + 1, nxt);
        const char* nA = has_next ? S.aptr(nxt) : cA; const char* nB = has_next ? S.bptr(nxt) : cB;
        for (int t = 0; t < nt; t += 2) {
            const bool last = (t == nt - 2);
            const char* a1 = cA + (size_t)(t + 1) * kstep;
            const char* a2 = last ? nA : cA + (size_t)(t + 2) * kstep; const char* b2 = last ? nB : cB + (size_t)(t + 2) * kstep;
            const char* a3 = a2 + kstep; const char* b3 = b2 + kstep;
            PG8_LDB(B0, 0, 0); PG8_LDB(B1, 0, 1); PG8_SCHED; PG8_LDA(At, 0, 0); PG8_STAGE(PG8_SA(1, 1), a1, oA[1]);
            if constexpr (Sched::GATHER) { if (last && has_next) {
#pragma unroll
                for (int h = 0; h < 2; ++h)
#pragma unroll
                    for (int i = 0; i < 2; ++i) oA[h][i] = S.goff(ui + 1, h * HALF + Rr[i]) + (unsigned)Cc[i] * 2u; } }
            PG8_WAIT_V(8); PG8_WAIT_L(0); PG8_BAR; PG8_MMA(0, 0, At, B0); PG8_MMA(0, 1, At, B1); PG8_BAR; PG8_SCHED;
            PG8_LDA(At, 0, 1); PG8_STAGE(PG8_SB(0, 0), b2, voffB); PG8_STAGE(PG8_SB(0, 1), b2 + hstepB, voffB); PG8_STAGE(PG8_SA(0, 0), a2, oA[0]);
            PG8_WAIT_V(8); PG8_WAIT_L(0); PG8_BAR; PG8_MMA(1, 0, At, B0); PG8_MMA(1, 1, At, B1); PG8_BAR; PG8_SCHED;
            PG8_LDB(B0, 1, 0); PG8_LDB(B1, 1, 1); PG8_SCHED; PG8_LDA(At, 1, 0); PG8_STAGE(PG8_SA(0, 1), a2, oA[1]);
            PG8_WAIT_V(8); PG8_WAIT_L(0); PG8_BAR; PG8_MMA(0, 0, At, B0); PG8_MMA(0, 1, At, B1); PG8_BAR; PG8_SCHED;
            PG8_LDA(At, 1, 1); PG8_STAGE(PG8_SB(1, 0), b3, voffB); PG8_STAGE(PG8_SB(1, 1), b3 + hstepB, voffB); PG8_STAGE(PG8_SA(1, 0), a3, oA[0]);
            PG8_WAIT_V(8); PG8_WAIT_L(0); PG8_BAR; PG8_MMA(1, 0, At, B0); PG8_MMA(1, 1, At, B1); PG8_BAR; PG8_SCHED;
        }
        if (wr == 0) PG8_BAR;
        bool keep = false;
        if constexpr (Sched::HAS_MID) { if (S.is_mid(cur)) { E.mid(acc, cur, wr, wc, fr, fq); keep = true; } }
        if (!keep) E(acc, cur, wr, wc, fr, fq);
        if (!has_next) break;
        if (!keep) {
#pragma unroll
            for (int a = 0; a < 2; ++a)
#pragma unroll
                for (int b = 0; b < 2; ++b)
#pragma unroll
                    for (int m = 0; m < 4; ++m)
#pragma unroll
                        for (int n = 0; n < 2; ++n) acc[a][b][m][n] = (f32x4){0.f, 0.f, 0.f, 0.f};
        }
        cur = nxt; cA = nA; cB = nB; ++ui;
        if (wr == 1) PG8_BAR;
    }
    PG8_WAIT_V(0);
    PG8_BAR;
#undef PG8_SA
#undef PG8_SB
#undef PG8_STAGE
#undef PG8_LDA
#undef PG8_LDB
#undef PG8_MMA
#undef PG8_WAIT_V
#undef PG8_WAIT_L
#undef PG8_BAR
#undef PG8_SCHED
}
}
using pg8::Unit;

struct Args { const float* in[25]; float* out; unsigned char* ws; int ph_lo, ph_hi; };
static_assert(sizeof(Args) == 27 * 8 + 8, "Args has no padding");
struct Frame {
    LAS unsigned char* lds; volatile LAS unsigned* MISC; unsigned* ctl;
    int tid, lane, wave, vcu, G;
};
#define LDS_WAIT() asm volatile("s_waitcnt lgkmcnt(0)" ::: "memory")
#define VM_WAIT() asm volatile("s_waitcnt vmcnt(0)" ::: "memory")

struct SchedStatic {
    static constexpr bool GATHER = false, HAS_MID = false;
    const char* A; const char* B; int nM, nN, G, c; size_t astep, bstep;
    __device__ __forceinline__ bool next(int i, Unit& u) const { u.aux = 0; return pg8::static_unit(i, G, c, nM, nN, u.pm, u.pn); }
    __device__ __forceinline__ const char* aptr(const Unit& u) const { return A + (size_t)u.pm * astep; }
    __device__ __forceinline__ const char* bptr(const Unit& u) const { return B + (size_t)u.pn * bstep; }
    __device__ __forceinline__ bool is_mid(const Unit&) const { return false; }
    __device__ __forceinline__ unsigned goff(int, int) const { return 0u; }
};
struct SchedSplit2 {
    static constexpr bool GATHER = false, HAS_MID = true;
    const char* A; const char* B; int nM, nN, G, c; size_t astep, bstep, khalf;
    __device__ __forceinline__ bool next(int i, Unit& u) const { u.aux = i & 1; return pg8::static_unit(i >> 1, G, c, nM, nN, u.pm, u.pn); }
    __device__ __forceinline__ const char* aptr(const Unit& u) const { return A + (size_t)u.pm * astep + (size_t)u.aux * khalf; }
    __device__ __forceinline__ const char* bptr(const Unit& u) const { return B + (size_t)u.pn * bstep + (size_t)u.aux * khalf; }
    __device__ __forceinline__ bool is_mid(const Unit& u) const { return u.aux == 0; }
    __device__ __forceinline__ unsigned goff(int, int) const { return 0u; }
};
__device__ __forceinline__ int moe_find_e(volatile LAS unsigned* MISC, int rb) { int e = 0;
#pragma unroll 1
    for (int i = 1; i < NEXP; ++i) e += ((int)MISC[i] <= rb) ? 1 : 0;
    return e; }
template <int NPN, bool GATH>
struct SchedMoe {
    static constexpr bool GATHER = GATH, HAS_MID = false;
    static constexpr int RPX = 32 / NPN;
    const char* A; const char* B; volatile LAS unsigned* MISC; const LAS unsigned* gtab; int c, G, nrb; size_t bstep_e, bstep_n;
    __device__ __forceinline__ bool next(int i, Unit& u) const {
        int rb, pn;
        if (G == 256) { const int x = c & 7, j = c >> 3; rb = (8 * i + x) * RPX + j / NPN; pn = j % NPN; }
        else { const long L = (long)i * G + c; rb = (int)(L / NPN); pn = (int)(L % NPN); }
        if (rb >= nrb) return false;
        u.pm = rb; u.pn = pn; u.aux = moe_find_e(MISC, rb); return true;
    }
    __device__ __forceinline__ const char* aptr(const Unit& u) const { return GATH ? A : A + (size_t)u.pm * (256 * 1024 * 2); }
    __device__ __forceinline__ const char* bptr(const Unit& u) const { return B + (size_t)u.aux * bstep_e + (size_t)u.pn * bstep_n; }
    __device__ __forceinline__ bool is_mid(const Unit&) const { return false; }
    __device__ __forceinline__ unsigned goff(int ui, int row) const { return gtab[ui * 256 + row]; }
};

#define EPI_ARGS f32x4 (&acc)[2][2][4][2], const Unit& u, int wr, int wc, int fr, int fq
struct EpiG1 {
    bf16 *Q, *K, *V, *U, *VG, *GT; const float* bgate;
    __device__ __forceinline__ void mid(EPI_ARGS) const {}
    __device__ __forceinline__ void operator()(EPI_ARGS) const {
        const int pn = u.pn; const int row0 = u.pm * 256 + wr * 64 + fr;
        if (pn < 6) {
            const int t = pn >> 1; bf16* base = Q + (size_t)t * ((WS_K - WS_Q) / 2); const float sc = (t == 0) ? QSCALE : 1.0f;    const int col0 = (pn & 1) * 256 + wc * 32 + 8 * fq;
#pragma unroll
            for (int ai = 0; ai < 2; ++ai)
#pragma unroll
                for (int m = 0; m < 4; ++m) { bf16* rowp = base + (size_t)(row0 + ai * 128 + m * 16) * 512 + col0;
#pragma unroll
                    for (int bj = 0; bj < 2; ++bj) { const f32x4 v0 = acc[ai][bj][m][0] * sc, v1 = acc[ai][bj][m][1] * sc;
                        u32x4 w; w.x = cvtpk(v0[0], v0[1]); w.y = cvtpk(v0[2], v0[3]); w.z = cvtpk(v1[0], v1[1]); w.w = cvtpk(v1[2], v1[3]); *(u32x4*)(rowp + bj * 128) = w; } }
        } else if (pn < 10) {
            bf16* base = Q + (size_t)(pn >> 1) * ((WS_K - WS_Q) / 2); const int col0 = (pn & 1) * 256 + wc * 32 + 8 * fq;
#pragma unroll
            for (int ai = 0; ai < 2; ++ai)
#pragma unroll
                for (int m = 0; m < 4; ++m) { bf16* rowp = base + (size_t)(row0 + ai * 128 + m * 16) * 512 + col0;
#pragma unroll
                    for (int bj = 0; bj < 2; ++bj) { const f32x4 v0 = acc[ai][bj][m][0], v1 = acc[ai][bj][m][1];
                        const f32x2 a = gelu_pk((f32x2){v0[0], v0[1]}), b = gelu_pk((f32x2){v0[2], v0[3]}), c = gelu_pk((f32x2){v1[0], v1[1]}), d = gelu_pk((f32x2){v1[2], v1[3]});
                        u32x4 w; w.x = cvtpk(a.x, a.y); w.y = cvtpk(b.x, b.y); w.z = cvtpk(c.x, c.y); w.w = cvtpk(d.x, d.y); *(u32x4*)(rowp + bj * 128) = w; } }
        } else {
            const int col0 = (pn - 10) * 256 + wc * 32 + 8 * fq;
            f32x4 bv[2][2];
#pragma unroll
            for (int bj = 0; bj < 2; ++bj)
#pragma unroll
                for (int n = 0; n < 2; ++n) bv[bj][n] = *(const f32x4*)(bgate + col0 + bj * 128 + 4 * n);
#pragma unroll
            for (int ai = 0; ai < 2; ++ai)
#pragma unroll
                for (int m = 0; m < 4; ++m) { bf16* rowp = GT + (size_t)(row0 + ai * 128 + m * 16) * 2048 + col0;
#pragma unroll
                    for (int bj = 0; bj < 2; ++bj) { const f32x4 v0 = acc[ai][bj][m][0] + bv[bj][0], v1 = acc[ai][bj][m][1] + bv[bj][1];
                        u32x4 w; w.x = cvtpk(fast_sigmoid(v0[0]), fast_sigmoid(v0[1])); w.y = cvtpk(fast_sigmoid(v0[2]), fast_sigmoid(v0[3]));
                        w.z = cvtpk(fast_sigmoid(v1[0]), fast_sigmoid(v1[1])); w.w = cvtpk(fast_sigmoid(v1[2]), fast_sigmoid(v1[3])); *(u32x4*)(rowp + bj * 128) = w; } }
        }
    }
};
struct EpiG2 {
    const bf16* GT; bf16* MRG;
    __device__ __forceinline__ void mid(EPI_ARGS) const {
        const int row0 = u.pm * 256 + wr * 64 + fr, col0 = u.pn * 256 + wc * 32 + 8 * fq;
#pragma unroll
        for (int ai = 0; ai < 2; ++ai)
#pragma unroll
            for (int m = 0; m < 4; ++m) { const bf16* gp = GT + (size_t)(row0 + ai * 128 + m * 16) * 2048 + col0;
#pragma unroll
                for (int bj = 0; bj < 2; ++bj) { const u32x4 ga = *(const u32x4*)(gp + bj * 128), gb = *(const u32x4*)(gp + 1024 + bj * 128);
                    f32x4 r0, r1;
                    r0[0] = bflo(ga.x) * __builtin_amdgcn_rcpf(fmaxf(bflo(gb.x), 1e-30f)); r0[1] = bfhi(ga.x) * __builtin_amdgcn_rcpf(fmaxf(bfhi(gb.x), 1e-30f));
                    r0[2] = bflo(ga.y) * __builtin_amdgcn_rcpf(fmaxf(bflo(gb.y), 1e-30f)); r0[3] = bfhi(ga.y) * __builtin_amdgcn_rcpf(fmaxf(bfhi(gb.y), 1e-30f));
                    r1[0] = bflo(ga.z) * __builtin_amdgcn_rcpf(fmaxf(bflo(gb.z), 1e-30f)); r1[1] = bfhi(ga.z) * __builtin_amdgcn_rcpf(fmaxf(bfhi(gb.z), 1e-30f));
                    r1[2] = bflo(ga.w) * __builtin_amdgcn_rcpf(fmaxf(bflo(gb.w), 1e-30f)); r1[3] = bfhi(ga.w) * __builtin_amdgcn_rcpf(fmaxf(bfhi(gb.w), 1e-30f));
                    acc[ai][bj][m][0] *= r0; acc[ai][bj][m][1] *= r1; } }
    }
    __device__ __forceinline__ void operator()(EPI_ARGS) const {
        const int row0 = u.pm * 256 + wr * 64 + fr, col0 = u.pn * 256 + wc * 32 + 8 * fq;
#pragma unroll
        for (int ai = 0; ai < 2; ++ai)
#pragma unroll
            for (int m = 0; m < 4; ++m) { const size_t r = (size_t)(row0 + ai * 128 + m * 16); const bf16* gp = GT + r * 2048 + 1024 + col0; bf16* op = MRG + r * 1024 + col0;
#pragma unroll
                for (int bj = 0; bj < 2; ++bj) { const u32x4 gb = *(const u32x4*)(gp + bj * 128); const f32x4 v0 = acc[ai][bj][m][0], v1 = acc[ai][bj][m][1];
                    u32x4 w; w.x = cvtpk(v0[0] * bflo(gb.x), v0[1] * bfhi(gb.x)); w.y = cvtpk(v0[2] * bflo(gb.y), v0[3] * bfhi(gb.y));
                    w.z = cvtpk(v1[0] * bflo(gb.z), v1[1] * bfhi(gb.z)); w.w = cvtpk(v1[2] * bflo(gb.w), v1[3] * bfhi(gb.w)); *(u32x4*)(op + bj * 128) = w; } }
    }
};
struct EpiPlain {
    bf16* O;
    __device__ __forceinline__ void mid(EPI_ARGS) const {}
    __device__ __forceinline__ void operator()(EPI_ARGS) const {
        const int row0 = u.pm * 256 + wr * 64 + fr, col0 = u.pn * 256 + wc * 32 + 8 * fq;
#pragma unroll
        for (int ai = 0; ai < 2; ++ai)
#pragma unroll
            for (int m = 0; m < 4; ++m) { bf16* op = O + (size_t)(row0 + ai * 128 + m * 16) * 1024 + col0;
#pragma unroll
                for (int bj = 0; bj < 2; ++bj) { const f32x4 v0 = acc[ai][bj][m][0], v1 = acc[ai][bj][m][1];
                    u32x4 w; w.x = cvtpk(v0[0], v0[1]); w.y = cvtpk(v0[2], v0[3]); w.z = cvtpk(v1[0], v1[1]); w.w = cvtpk(v1[2], v1[3]); *(u32x4*)(op + bj * 128) = w; } }
    }
};
struct EpiAct {
    const float* bgu; bf16* ACT;
    __device__ __forceinline__ void mid(EPI_ARGS) const {}
    __device__ __forceinline__ void operator()(EPI_ARGS) const {
        const int e = u.aux; const int row0 = u.pm * 256 + wr * 64 + fr, col0 = u.pn * 128 + wc * 32 + 8 * fq;
        const float* bp = bgu + (size_t)e * 2048 + col0;
        const f32x4 bg0 = *(const f32x4*)(bp), bg1 = *(const f32x4*)(bp + 4), bl0 = *(const f32x4*)(bp + 1024), bl1 = *(const f32x4*)(bp + 1028);
#pragma unroll
        for (int ai = 0; ai < 2; ++ai)
#pragma unroll
            for (int m = 0; m < 4; ++m) {
                f32x4 o[2];
#pragma unroll
                for (int n = 0; n < 2; ++n) { const f32x4 g = acc[ai][0][m][n] + (n ? bg1 : bg0), l = acc[ai][1][m][n] + (n ? bl1 : bl0);
#pragma unroll
                    for (int i = 0; i < 4; ++i) { const float xg = fminf(g[i], SWL), xl = fminf(fmaxf(l[i], -SWL), SWL); o[n][i] = xg * fast_sigmoid(SWA * xg) * (xl + 1.0f); } }
                u32x4 w; w.x = cvtpk(o[0][0], o[0][1]); w.y = cvtpk(o[0][2], o[0][3]); w.z = cvtpk(o[1][0], o[1][1]); w.w = cvtpk(o[1][2], o[1][3]);
                *(u32x4*)(ACT + (size_t)(row0 + ai * 128 + m * 16) * 1024 + col0) = w; }
    }
};
struct EpiDown {
    const float* bdn; const int* list; const float* topg; volatile LAS unsigned* MISC; bf16* Y2;
    __device__ __forceinline__ void mid(EPI_ARGS) const {}
    __device__ __forceinline__ void operator()(EPI_ARGS) const {
        const int e = u.aux; const int j256 = (u.pm - (int)MISC[e]) * 256; const int ecnt = (int)MISC[40 + e];
        const int col0 = u.pn * 256 + wc * 32 + 8 * fq;
        f32x4 bv[2][2];
#pragma unroll
        for (int bj = 0; bj < 2; ++bj)
#pragma unroll
            for (int n = 0; n < 2; ++n) bv[bj][n] = *(const f32x4*)(bdn + (size_t)e * 1024 + col0 + bj * 128 + 4 * n);
#pragma unroll
        for (int ai = 0; ai < 2; ++ai)
#pragma unroll
            for (int m = 0; m < 4; ++m) { const int pos = j256 + ai * 128 + wr * 64 + m * 16 + fr;
                int slot = TRASH_SLOT; if (pos < ecnt) slot = list[(size_t)e * NTOK + pos];
                const float g = topg[slot]; bf16* op = Y2 + (size_t)slot * 1024 + col0;
#pragma unroll
                for (int bj = 0; bj < 2; ++bj) { const f32x4 v0 = (acc[ai][bj][m][0] + bv[bj][0]) * g, v1 = (acc[ai][bj][m][1] + bv[bj][1]) * g;
                    u32x4 w; w.x = cvtpk(v0[0], v0[1]); w.y = cvtpk(v0[2], v0[3]); w.z = cvtpk(v1[0], v1[1]); w.w = cvtpk(v1[2], v1[3]); *(u32x4*)(op + bj * 128) = w; } }
    }
};

__device__ __forceinline__ void tr_item(const float* W, int N, bf16* WT, int ldt, int k0, int n0, int drow0, int dk0, LAS float* scr, int lane) {
#pragma unroll 8
    for (int i = 0; i < 32; ++i) { const int kk = 2 * i + (lane >> 5); scr[kk * 33 + (lane & 31)] = W[(size_t)(k0 + kk) * N + n0 + (lane & 31)]; }
    LDS_WAIT(); asm volatile("" ::: "memory");
    const int c = lane & 7;
#pragma unroll
    for (int j = 0; j < 4; ++j) { const int n = (lane >> 3) + 8 * j; const LAS float* s = scr + (8 * c) * 33 + n;
        u32x4 o; o.x = cvtpk(s[0 * 33], s[1 * 33]); o.y = cvtpk(s[2 * 33], s[3 * 33]); o.z = cvtpk(s[4 * 33], s[5 * 33]); o.w = cvtpk(s[6 * 33], s[7 * 33]);
        *(u32x4*)(WT + (size_t)(drow0 + n) * ldt + dk0 + k0 + 8 * c) = o; }
    LDS_WAIT(); asm volatile("" ::: "memory");
}
__device__ __forceinline__ void phaseA(const Frame& F, const Args& a) {
    unsigned char* ws = a.ws;
    if (F.vcu < 192) {
        const float* c = a.in[1]; const float* w_ada = a.in[2]; const float* b_ada = a.in[3]; float* mod = (float*)(ws + WS_MOD);
        LAS float* red = (LAS float*)(F.lds);
        const int col = F.vcu * 32 + (F.tid & 31), ks = F.tid >> 5;
        float a0 = 0.f, a1 = 0.f, a2 = 0.f, a3 = 0.f;
        for (int k = ks * 64; k < ks * 64 + 64; ++k) { const float w = w_ada[(size_t)k * 6144 + col];
            const float c0 = c[k], c1 = c[D + k], c2 = c[2 * D + k], c3 = c[3 * D + k];
            a0 += c0 * __builtin_amdgcn_rcpf(1.0f + __expf(-c0)) * w; a1 += c1 * __builtin_amdgcn_rcpf(1.0f + __expf(-c1)) * w;
            a2 += c2 * __builtin_amdgcn_rcpf(1.0f + __expf(-c2)) * w; a3 += c3 * __builtin_amdgcn_rcpf(1.0f + __expf(-c3)) * w; }
        red[(ks * 4 + 0) * 32 + (F.tid & 31)] = a0; red[(ks * 4 + 1) * 32 + (F.tid & 31)] = a1; red[(ks * 4 + 2) * 32 + (F.tid & 31)] = a2; red[(ks * 4 + 3) * 32 + (F.tid & 31)] = a3;
        __syncthreads();
        if (F.tid < 128) { const int b = F.tid >> 5, cc = F.tid & 31; float s = 0.f;
#pragma unroll
            for (int k = 0; k < 16; ++k) s += red[(k * 4 + b) * 32 + cc];
            mod[b * 6144 + F.vcu * 32 + cc] = s + b_ada[F.vcu * 32 + cc]; }
        __syncthreads();
    }
    LAS float* scr = (LAS float*)(F.lds + F.wave * 16384);
    const int gw = F.vcu * NWAVES + F.wave, NGW = F.G * NWAVES;
    bf16* W1T = (bf16*)(ws + WS_W1T); bf16* WBRT = (bf16*)(ws + WS_WBRT); bf16* WOUTT = (bf16*)(ws + WS_WOUTT); bf16* WGUT = (bf16*)(ws + WS_WGUT); bf16* WDNT = (bf16*)(ws + WS_WDNT);
    constexpr int I_IN = 16 * 80, I_GATE = 16 * 64, I_BR = 8 * 32, I_OUT = 16 * 32, I_GU = 16 * 64, I_DN = 16 * 32;
    constexpr int NITEMS = I_IN + I_GATE + 2 * I_BR + I_OUT + NEXP * (I_GU + I_DN);
    for (int it = gw; it < NITEMS; it += NGW) {
        int r = it;
        if (r < I_IN) { const int n0 = 32 * (r % 80); tr_item(a.in[6], INW, W1T, 1024, 64 * (r / 80), n0, n0, 0, scr, F.lane); continue; } r -= I_IN;
        if (r < I_GATE) { const int n0 = 32 * (r % 64); tr_item(a.in[14], 2048, W1T, 1024, 64 * (r / 64), n0, INW + n0, 0, scr, F.lane); continue; } r -= I_GATE;
        if (r < I_BR) { const int n0 = 32 * (r % 32); tr_item(a.in[12], 1024, WBRT, 1024, 64 * (r / 32), n0, n0, 0, scr, F.lane); continue; } r -= I_BR;
        if (r < I_BR) { const int n0 = 32 * (r % 32); tr_item(a.in[13], 1024, WBRT, 1024, 64 * (r / 32), n0, n0, 512, scr, F.lane); continue; } r -= I_BR;
        if (r < I_OUT) { const int n0 = 32 * (r % 32); tr_item(a.in[16], 1024, WOUTT, 1024, 64 * (r / 32), n0, n0, 0, scr, F.lane); continue; } r -= I_OUT;
        if (r < NEXP * I_GU) { const int e = r / I_GU, q = r % I_GU, kb = q / 64, nb = q % 64, n0 = 32 * nb;
            const int m0 = n0 & 1023, drow = 256 * (m0 >> 7) + (m0 & 127) + (n0 >= 1024 ? 128 : 0);
            tr_item(a.in[21] + (size_t)e * D * 2048, 2048, WGUT + (size_t)e * 2048 * 1024, 1024, 64 * kb, n0, drow, 0, scr, F.lane); continue; } r -= NEXP * I_GU;
        { const int e = r / I_DN, q = r % I_DN, n0 = 32 * (q % 32); tr_item(a.in[23] + (size_t)e * D * D, 1024, WDNT + (size_t)e * 1024 * 1024, 1024, 64 * (q / 32), n0, n0, 0, scr, F.lane); }
    }
}
__device__ __forceinline__ void phaseB(const Frame& F, const Args& a) {
    const float* x = a.in[0]; const float* g = a.in[4]; const float* mod = (const float*)(a.ws + WS_MOD); bf16* xn = (bf16*)(a.ws + WS_XN);
    const int gw = F.vcu * NWAVES + F.wave, NGW = F.G * NWAVES;
    for (int row = gw; row < NTOK; row += NGW) {
        const int b = row / SEQ; const float* mb = mod + b * 6144;
        const f32x4* xr = (const f32x4*)(x + (size_t)row * D) + F.lane;
        f32x4 v[4]; float ss = 0.f;
#pragma unroll
        for (int j = 0; j < 4; ++j) { v[j] = xr[64 * j]; ss += (v[j].x * v[j].x + v[j].y * v[j].y) + (v[j].z * v[j].z + v[j].w * v[j].w); }
        const float rstd = rsqrtf(wave_sum(ss) * (1.0f / D) + EPS);
        u32x2* o8 = (u32x2*)(xn + (size_t)row * D) + F.lane;
#pragma unroll
        for (int j = 0; j < 4; ++j) { const int c0 = (F.lane + 64 * j) * 4;
            const f32x4 gg = *(const f32x4*)(g + c0), sc = *(const f32x4*)(mb + SC1 + c0), sh = *(const f32x4*)(mb + SH1 + c0);
            const f32x4 h = v[j] * rstd * gg * (sc + 1.0f) + sh;
            u32x2 w; w.x = cvtpk(h[0], h[1]); w.y = cvtpk(h[2], h[3]); o8[64 * j] = w; }
    }
}

constexpr int SGU_STRIDE = 1088;
__device__ __forceinline__ s16x4 vtr(const LAS unsigned char* p) { typedef short v4i16_t __attribute__((ext_vector_type(4))); return __builtin_bit_cast(s16x4, __builtin_amdgcn_ds_read_tr16_b64_v4i16((LAS v4i16_t*)p)); }
__device__ __forceinline__ void sgu_unit(const Frame& F, const Args& a, int b, int blk) {
    const bf16* VG = (const bf16*)(a.ws + WS_VG); const bf16* U = (const bf16*)(a.ws + WS_U); bf16* YAB = (bf16*)(a.ws + WS_YAB);
    const float* ln_g = a.in[8]; const float* ln_b = a.in[9]; const float* w_s = a.in[10]; const float* b_s = a.in[11];
    const int tok0 = b * SEQ + blk * SGB, lane = F.lane;
    {
        f32x4 g0 = *(const f32x4*)(ln_g + lane * 8), g1 = *(const f32x4*)(ln_g + lane * 8 + 4), b0 = *(const f32x4*)(ln_b + lane * 8), b1 = *(const f32x4*)(ln_b + lane * 8 + 4);
#pragma unroll 4
        for (int rr = 0; rr < 16; ++rr) { const int row = F.wave * 16 + rr;
            const u32x4 w = *(const u32x4*)(VG + (size_t)(tok0 + row) * 512 + lane * 8);
            f32x4 v0 = {bflo(w.x), bfhi(w.x), bflo(w.y), bfhi(w.y)}, v1 = {bflo(w.z), bfhi(w.z), bflo(w.w), bfhi(w.w)};
            const float mu = wave_sum((v0[0] + v0[1]) + (v0[2] + v0[3]) + (v1[0] + v1[1]) + (v1[2] + v1[3])) * (1.0f / 512.0f);
            v0 -= mu; v1 -= mu;
            const float var = wave_sum((v0[0] * v0[0] + v0[1] * v0[1]) + (v0[2] * v0[2] + v0[3] * v0[3]) + (v1[0] * v1[0] + v1[1] * v1[1]) + (v1[2] * v1[2] + v1[3] * v1[3])) * (1.0f / 512.0f);
            const float rstd = rsqrtf(var + EPS);
            v0 = v0 * rstd * g0 + b0; v1 = v1 * rstd * g1 + b1;
            u32x4 o; o.x = cvtpk(v0[0], v0[1]); o.y = cvtpk(v0[2], v0[3]); o.z = cvtpk(v1[0], v1[1]); o.w = cvtpk(v1[2], v1[3]);
            *(LAS u32x4*)(F.lds + row * SGU_STRIDE + lane * 16) = o; }
    }
    __syncthreads();
    {
        const int g = F.wave, r32 = lane & 31, hi = lane >> 5, i16 = lane & 15, g16 = (lane >> 4) & 1;
        const LAS unsigned char* vb = F.lds + (8 * hi + (i16 >> 2)) * SGU_STRIDE + (g * 64 + 16 * g16 + 4 * (i16 & 3)) * 2;
#pragma unroll 1
        for (int tb = 0; tb < 4; ++tb) {
            const int t = 32 * tb + r32; const float* wrow = w_s + ((size_t)g * 128 + t) * 128;
            f32x16 a0, a1;
#pragma unroll
            for (int r = 0; r < 16; ++r) { a0[r] = 0.f; a1[r] = 0.f; }
#pragma unroll 1
            for (int ks = 0; ks < 2 * tb + 2; ++ks) {
                const int s0 = 16 * ks + 8 * hi;
                const f32x4 w0 = *(const f32x4*)(wrow + s0), w1 = *(const f32x4*)(wrow + s0 + 4);
                float wv[8] = {w0[0], w0[1], w0[2], w0[3], w1[0], w1[1], w1[2], w1[3]};
#pragma unroll
                for (int j = 0; j < 8; ++j) wv[j] = (s0 + j <= t) ? wv[j] : 0.f;
                u32x4 bw; bw.x = cvtpk(wv[0], wv[1]); bw.y = cvtpk(wv[2], wv[3]); bw.z = cvtpk(wv[4], wv[5]); bw.w = cvtpk(wv[6], wv[7]);
                const bf16x8 bfrag = __builtin_bit_cast(bf16x8, bw);
                const LAS unsigned char* p = vb + ks * 16 * SGU_STRIDE;
                const s16x4 l0 = vtr(p), h0 = vtr(p + 4 * SGU_STRIDE), l1 = vtr(p + 64), h1 = vtr(p + 4 * SGU_STRIDE + 64);
                const bf16x8 A0 = {l0[0], l0[1], l0[2], l0[3], h0[0], h0[1], h0[2], h0[3]}, A1 = {l1[0], l1[1], l1[2], l1[3], h1[0], h1[1], h1[2], h1[3]};
                a0 = __builtin_amdgcn_mfma_f32_32x32x16_bf16(A0, bfrag, a0, 0, 0, 0);
                a1 = __builtin_amdgcn_mfma_f32_32x32x16_bf16(A1, bfrag, a1, 0, 0, 0);
            }
            const float bs = b_s[g * 128 + t];
            const bf16* up = U + (size_t)(tok0 + t) * 512 + g * 64 + 4 * hi; bf16* op = YAB + (size_t)(tok0 + t) * 1024 + 512 + g * 64 + 4 * hi;
#pragma unroll
            for (int gg = 0; gg < 4; ++gg) {
                const u32x2 u0 = *(const u32x2*)(up + 8 * gg), u1 = *(const u32x2*)(up + 32 + 8 * gg);
                u32x2 o0, o1;
                o0.x = cvtpk(bflo(u0.x) * (a0[4 * gg] + bs), bfhi(u0.x) * (a0[4 * gg + 1] + bs)); o0.y = cvtpk(bflo(u0.y) * (a0[4 * gg + 2] + bs), bfhi(u0.y) * (a0[4 * gg + 3] + bs));
                o1.x = cvtpk(bflo(u1.x) * (a1[4 * gg] + bs), bfhi(u1.x) * (a1[4 * gg + 1] + bs)); o1.y = cvtpk(bflo(u1.y) * (a1[4 * gg + 2] + bs), bfhi(u1.y) * (a1[4 * gg + 3] + bs));
                *(u32x2*)(op + 8 * gg) = o0; *(u32x2*)(op + 32 + 8 * gg) = o1; }
        }
    }
    __syncthreads();
}

__device__ __forceinline__ void attn_task(const bf16* __restrict__ Q, const bf16* __restrict__ Kb, const bf16* __restrict__ Vb, bf16* YAB, LAS unsigned char* vt, const LAS float* bt,
                                          int b, int c, int h, int half, int lane) {
    const int r32 = lane & 31, hi = lane >> 5, i16 = lane & 15, g16 = (lane >> 4) & 1;
    const int tok0 = b * SEQ + c * CHUNK, qi = half * 32 + r32, qtok = tok0 + qi;
    bf16x8 qf[4];
#pragma unroll
    for (int s = 0; s < 4; ++s) qf[s] = *(const bf16x8*)(Q + (size_t)qtok * 512 + h * 64 + 16 * s + 8 * hi);
    f32x16 o0, o1;
#pragma unroll
    for (int r = 0; r < 16; ++r) { o0[r] = 0.f; o1[r] = 0.f; }
    float m = -1e30f, l = 0.f;
    const int j0 = (c < NLEFT) ? (NLEFT - c) : 0;
    const int fb = (i16 >> 3) & 1;
    LAS unsigned char* vw = vt + (lane >> 3) * 128 + (((lane & 7) ^ (((lane >> 4) & 1) * 4)) * 16);
    const LAS unsigned char* vr0 = vt + (4 * hi + (i16 >> 2)) * 128 + ((4 * (0 ^ fb) + 2 * g16 + ((i16 & 3) >> 1)) * 16) + (i16 & 1) * 8;
    const LAS unsigned char* vr1 = vt + (4 * hi + (i16 >> 2)) * 128 + ((4 * (1 ^ fb) + 2 * g16 + ((i16 & 3) >> 1)) * 16) + (i16 & 1) * 8;
    const size_t hoff = (size_t)h * 64;
    bf16x8 kf[2][4]; u32x4 vn[8];
    {
        const bf16* kp = Kb + (size_t)(tok0 + (j0 - NLEFT) * CHUNK) * 512 + hoff; const bf16* vp = Vb + (size_t)(tok0 + (j0 - NLEFT) * CHUNK) * 512 + hoff;
#pragma unroll
        for (int blk = 0; blk < 2; ++blk)
#pragma unroll
            for (int s = 0; s < 4; ++s) kf[blk][s] = *(const bf16x8*)(kp + (size_t)(32 * blk + r32) * 512 + 16 * s + 8 * hi);
#pragma unroll
        for (int p = 0; p < 8; ++p) vn[p] = *(const u32x4*)(vp + (size_t)(8 * p + (lane >> 3)) * 512 + (lane & 7) * 8);
#pragma unroll
        for (int p = 0; p < 8; ++p) *(LAS u32x4*)(vw + p * 1024) = vn[p];
    }
#pragma unroll 1
    for (int j = j0; j < 9; ++j) {
        const bool more = (j + 1 < 9);
        const bf16* kp = Kb + (size_t)(tok0 + (j + 1 - NLEFT) * CHUNK) * 512 + hoff; const bf16* vp = Vb + (size_t)(tok0 + (j + 1 - NLEFT) * CHUNK) * 512 + hoff;
        if (more) {
#pragma unroll
            for (int p = 0; p < 8; ++p) vn[p] = *(const u32x4*)(vp + (size_t)(8 * p + (lane >> 3)) * 512 + (lane & 7) * 8);
        }
        f32x16 p0, p1;
#pragma unroll
        for (int r = 0; r < 16; ++r) { p0[r] = 0.f; p1[r] = 0.f; }
#pragma unroll
        for (int s = 0; s < 4; ++s) { p0 = __builtin_amdgcn_mfma_f32_32x32x16_bf16(kf[0][s], qf[s], p0, 0, 0, 0); p1 = __builtin_amdgcn_mfma_f32_32x32x16_bf16(kf[1][s], qf[s], p1, 0, 0, 0); }
        if (more) {
#pragma unroll
            for (int blk = 0; blk < 2; ++blk)
#pragma unroll
                for (int s = 0; s < 4; ++s) kf[blk][s] = *(const bf16x8*)(kp + (size_t)(32 * blk + r32) * 512 + 16 * s + 8 * hi);
        }
        if (j >= 6) {
            const int base = 640 + qi - 64 * j - 4 * hi;
#pragma unroll
            for (int r = 0; r < 16; ++r) { const int kk = (r & 3) + 8 * (r >> 2); int i0 = base - kk, i1 = base - 32 - kk; i0 = i0 > 256 ? 256 : i0; i1 = i1 > 256 ? 256 : i1; p0[r] += bt[i0]; p1[r] += bt[i1]; }
        }
        float tm = fmaxf(p0[0], p1[0]);
#pragma unroll
        for (int r = 1; r < 16; ++r) tm = fmaxf(tm, fmaxf(p0[r], p1[r]));
        tm = fmaxf(tm, __shfl_xor(tm, 32));
        const float mn = fmaxf(m, tm), alpha = __builtin_amdgcn_exp2f(m - mn); m = mn;
        float ps = 0.f;
#pragma unroll
        for (int r = 0; r < 16; ++r) { p0[r] = __builtin_amdgcn_exp2f(p0[r] - mn); p1[r] = __builtin_amdgcn_exp2f(p1[r] - mn); ps += p0[r] + p1[r]; }
        l = l * alpha + ps;
#pragma unroll
        for (int r = 0; r < 16; ++r) { o0[r] *= alpha; o1[r] *= alpha; }
        bf16x8 pb[2][2];
#pragma unroll
        for (int s = 0; s < 2; ++s) {
            u32x4 w0; w0.x = cvtpk(p0[8 * s], p0[8 * s + 1]); w0.y = cvtpk(p0[8 * s + 2], p0[8 * s + 3]); w0.z = cvtpk(p0[8 * s + 4], p0[8 * s + 5]); w0.w = cvtpk(p0[8 * s + 6], p0[8 * s + 7]);
            u32x4 w1; w1.x = cvtpk(p1[8 * s], p1[8 * s + 1]); w1.y = cvtpk(p1[8 * s + 2], p1[8 * s + 3]); w1.z = cvtpk(p1[8 * s + 4], p1[8 * s + 5]); w1.w = cvtpk(p1[8 * s + 6], p1[8 * s + 7]);
            pb[0][s] = __builtin_bit_cast(bf16x8, w0); pb[1][s] = __builtin_bit_cast(bf16x8, w1); }
#pragma unroll
        for (int blk = 0; blk < 2; ++blk)
#pragma unroll
            for (int s = 0; s < 2; ++s) {
                const int ko = (32 * blk + 16 * s) * 128;
                const s16x4 l0 = vtr(vr0 + ko), h0 = vtr(vr0 + ko + 1024), l1 = vtr(vr1 + ko), h1 = vtr(vr1 + ko + 1024);
                const bf16x8 A0 = {l0[0], l0[1], l0[2], l0[3], h0[0], h0[1], h0[2], h0[3]}, A1 = {l1[0], l1[1], l1[2], l1[3], h1[0], h1[1], h1[2], h1[3]};
                o0 = __builtin_amdgcn_mfma_f32_32x32x16_bf16(A0, pb[blk][s], o0, 0, 0, 0);
                o1 = __builtin_amdgcn_mfma_f32_32x32x16_bf16(A1, pb[blk][s], o1, 0, 0, 0);
            }
        if (more) {
#pragma unroll
            for (int p = 0; p < 8; ++p) *(LAS u32x4*)(vw + p * 1024) = vn[p];
        }
    }
    l += __shfl_xor(l, 32);
    const float inv = __builtin_amdgcn_rcpf(l);
    bf16* op = YAB + (size_t)qtok * 1024 + hoff + 4 * hi;
#pragma unroll
    for (int gg = 0; gg < 4; ++gg) {
        u32x2 w0, w1;
        w0.x = cvtpk(o0[4 * gg] * inv, o0[4 * gg + 1] * inv); w0.y = cvtpk(o0[4 * gg + 2] * inv, o0[4 * gg + 3] * inv);
        w1.x = cvtpk(o1[4 * gg] * inv, o1[4 * gg + 1] * inv); w1.y = cvtpk(o1[4 * gg + 2] * inv, o1[4 * gg + 3] * inv);
        *(u32x2*)(op + 8 * gg) = w0; *(u32x2*)(op + 32 + 8 * gg) = w1; }
}
__device__ __forceinline__ void phaseD(const Frame& F, const Args& a) {
    for (int unit = F.vcu; unit < NB * (SEQ / SGB); unit += F.G) sgu_unit(F, a, unit / (SEQ / SGB), unit % (SEQ / SGB));
    const bf16* Q = (const bf16*)(a.ws + WS_Q); const bf16* Kb = (const bf16*)(a.ws + WS_K); const bf16* Vb = (const bf16*)(a.ws + WS_V); bf16* YAB = (bf16*)(a.ws + WS_YAB);
    LAS unsigned char* vt = F.lds + F.wave * 8192; LAS float* bt = (LAS float*)(F.lds + 65536 + F.wave * 1088);
    const float* rb = a.in[7] + F.wave * NREL; const float b256 = rb[256];
    for (int i = F.lane; i < NREL; i += 64) bt[i] = (rb[i] - b256) * LOG2E;
    LDS_WAIT();
    const int NCH = NB * (SEQ / CHUNK);
    for (int v = F.vcu; v < NCH / 2; v += F.G) {
#pragma unroll 1
        for (int k = 0; k < 4; ++k) { const int gc = (k < 2) ? v : (NCH - 1 - v); attn_task(Q, Kb, Vb, YAB, vt, bt, gc / (SEQ / CHUNK), gc % (SEQ / CHUNK), F.wave, k & 1, F.lane); }
    }
}

__device__ __forceinline__ void phaseG(const Frame& F, const Args& a) {
    const float* x = a.in[0]; const bf16* Y1 = (const bf16*)(a.ws + WS_Y1); const float* mod = (const float*)(a.ws + WS_MOD); const float* g_post_mix = a.in[5]; const float* g_pre_ffn = a.in[17];
    const float* w_router = a.in[19]; const float* b_router = a.in[20]; float* X1 = a.out; bf16* XN2 = (bf16*)(a.ws + WS_XN);
    int* tope = (int*)(a.ws + WS_TOPE); float* topg = (float*)(a.ws + WS_TOPG); int* list = (int*)(a.ws + WS_LIST); unsigned* cnt = F.ctl + CW_CNT;
    LAS float* wrt = (LAS float*)F.lds;
    for (int i = F.tid; i < D * NEXP; i += NWAVES * 64) { const int c = i >> 5, e = i & 31; wrt[e * D + c] = w_router[i]; }
    __syncthreads();
    const int lane = F.lane, gw = F.vcu * NWAVES + F.wave, NGW = F.G * NWAVES;
    const float mybias = b_router[(lane >> 1) & 31];
    for (int row = gw; row < NTOK; row += NGW) {
        const int b = row / SEQ; const float* mb = mod + b * 6144;
        f32x4 xv[4], yv[4]; float ss = 0.f;
#pragma unroll
        for (int j = 0; j < 4; ++j) { const int c0 = (lane + 64 * j) * 4; xv[j] = *(const f32x4*)(x + (size_t)row * D + c0);
            const u32x2 yy = *(const u32x2*)(Y1 + (size_t)row * D + c0); yv[j] = (f32x4){bflo(yy.x), bfhi(yy.x), bflo(yy.y), bfhi(yy.y)};
            ss += (yv[j][0] * yv[j][0] + yv[j][1] * yv[j][1]) + (yv[j][2] * yv[j][2] + yv[j][3] * yv[j][3]); }
        const float rstd = rsqrtf(wave_sum(ss) * (1.0f / D) + EPS); float s2 = 0.f;
#pragma unroll
        for (int j = 0; j < 4; ++j) { const int c0 = (lane + 64 * j) * 4;
            const f32x4 gp = *(const f32x4*)(g_post_mix + c0), gt = *(const f32x4*)(mb + GT1 + c0);
            xv[j] = xv[j] + gt * (yv[j] * rstd * gp);
            *(f32x4*)(X1 + (size_t)row * D + c0) = xv[j];
            s2 += (xv[j][0] * xv[j][0] + xv[j][1] * xv[j][1]) + (xv[j][2] * xv[j][2] + xv[j][3] * xv[j][3]); }
        const float rstd2 = rsqrtf(wave_sum(s2) * (1.0f / D) + EPS);
#pragma unroll
        for (int j = 0; j < 4; ++j) { const int c0 = (lane + 64 * j) * 4;
            const f32x4 gf = *(const f32x4*)(g_pre_ffn + c0), sc = *(const f32x4*)(mb + SC2 + c0), sh = *(const f32x4*)(mb + SH2 + c0);
            xv[j] = xv[j] * rstd2 * gf * (sc + 1.0f) + sh;
            u32x2 w; w.x = cvtpk(xv[j][0], xv[j][1]); w.y = cvtpk(xv[j][2], xv[j][3]); *(u32x2*)(XN2 + (size_t)row * D + c0) = w; }
        float v[32];
#pragma unroll
        for (int eg = 0; eg < 8; ++eg) {
#pragma unroll
            for (int ee = 0; ee < 4; ++ee) { const int e = eg * 4 + ee; float p = 0.f;
#pragma unroll
                for (int j = 0; j < 4; ++j) { const f32x4 w = *(const LAS f32x4*)(wrt + e * D + (lane + 64 * j) * 4); p += (xv[j][0] * w[0] + xv[j][1] * w[1]) + (xv[j][2] * w[2] + xv[j][3] * w[3]); }
                v[e] = p; }
            asm volatile("" ::: "memory");
        }
#pragma unroll
        for (int k = 0; k < 16; ++k) { const bool up = (lane & 32) != 0; const float send = up ? v[k] : v[16 + k], keep = up ? v[16 + k] : v[k]; v[k] = keep + __shfl_xor(send, 32); }
#pragma unroll
        for (int k = 0; k < 8; ++k) { const bool up = (lane & 16) != 0; const float send = up ? v[k] : v[8 + k], keep = up ? v[8 + k] : v[k]; v[k] = keep + __shfl_xor(send, 16); }
#pragma unroll
        for (int k = 0; k < 4; ++k) { const bool up = (lane & 8) != 0; const float send = up ? v[k] : v[4 + k], keep = up ? v[4 + k] : v[k]; v[k] = keep + __shfl_xor(send, 8); }
#pragma unroll
        for (int k = 0; k < 2; ++k) { const bool up = (lane & 4) != 0; const float send = up ? v[k] : v[2 + k], keep = up ? v[2 + k] : v[k]; v[k] = keep + __shfl_xor(send, 4); }
        { const bool up = (lane & 2) != 0; const float send = up ? v[0] : v[1], keep = up ? v[1] : v[0]; v[0] = keep + __shfl_xor(send, 2); }
        float mylogit = v[0] + __shfl_xor(v[0], 1) + mybias;
        if (lane & 1) mylogit = -3e38f;
        float tv[4]; int ti[4];
#pragma unroll
        for (int k = 0; k < 4; ++k) {
            float bv = mylogit; int bi = lane >> 1;
#pragma unroll
            for (int o = 1; o < 64; o <<= 1) { const float ov = __shfl_xor(bv, o); const int oi = __shfl_xor(bi, o); if (ov > bv || (ov == bv && oi < bi)) { bv = ov; bi = oi; } }
            tv[k] = bv; ti[k] = bi; if ((lane >> 1) == bi) mylogit = -3e38f;
        }
        if (lane == 0) {
            const float e1 = __expf(tv[1] - tv[0]), e2 = __expf(tv[2] - tv[0]), e3 = __expf(tv[3] - tv[0]); const float inv = 1.0f / (1.0f + e1 + e2 + e3);
            const float gg[4] = {inv, e1 * inv, e2 * inv, e3 * inv};
#pragma unroll
            for (int k = 0; k < 4; ++k) { const int slot = row * 4 + k; tope[slot] = ti[k]; topg[slot] = gg[k]; const unsigned pos = atomicAdd(&cnt[ti[k]], 1u); list[(size_t)ti[k] * NTOK + pos] = slot; }
        }
    }
}
__device__ __forceinline__ int moe_tables(const Frame& F) {
    __syncthreads();
    if (F.tid < NEXP) F.MISC[40 + F.tid] = __hip_atomic_load(F.ctl + CW_CNT + F.tid, __ATOMIC_RELAXED, __HIP_MEMORY_SCOPE_AGENT);
    __syncthreads();
    if (F.tid == 0) { unsigned s = 0; for (int e = 0; e < NEXP; ++e) { F.MISC[e] = s; s += (F.MISC[40 + e] + 255u) >> 8; } F.MISC[32] = s; }
    __syncthreads();
    return (int)F.MISC[32];
}
__device__ __forceinline__ void phaseJ(const Frame& F, const Args& a) {
    const bf16* Y2 = (const bf16*)(a.ws + WS_Y2); const float* mod = (const float*)(a.ws + WS_MOD); const float* gpf = a.in[18]; float* out = a.out;
    const int lane = F.lane, gw = F.vcu * NWAVES + F.wave, NGW = F.G * NWAVES;
    for (int row = gw; row < NTOK; row += NGW) {
        const int b = row / SEQ; const float* mb = mod + b * 6144;
        f32x4 yv[4]; float ss = 0.f;
#pragma unroll
        for (int j = 0; j < 4; ++j) { const int c0 = (lane + 64 * j) * 4; f32x4 s = {0.f, 0.f, 0.f, 0.f};
#pragma unroll
            for (int k = 0; k < 4; ++k) { const u32x2 yy = *(const u32x2*)(Y2 + ((size_t)row * 4 + k) * D + c0); s += (f32x4){bflo(yy.x), bfhi(yy.x), bflo(yy.y), bfhi(yy.y)}; }
            yv[j] = s; ss += (s[0] * s[0] + s[1] * s[1]) + (s[2] * s[2] + s[3] * s[3]); }
        const float rstd = rsqrtf(wave_sum(ss) * (1.0f / D) + EPS);
#pragma unroll
        for (int j = 0; j < 4; ++j) { const int c0 = (lane + 64 * j) * 4;
            const f32x4 g = *(const f32x4*)(gpf + c0), gt = *(const f32x4*)(mb + GT2 + c0); f32x4 xx = *(const f32x4*)(out + (size_t)row * D + c0);
            xx = xx + gt * (yv[j] * rstd * g); *(f32x4*)(out + (size_t)row * D + c0) = xx; }
    }
}

constexpr int N_PHASES = 10;
__global__ void __launch_bounds__(NWAVES * 64, 2) mega_fwd(Args args) {
    extern __shared__ __attribute__((aligned(16))) unsigned char lds_raw[];
    Frame F;
    F.lds = (LAS unsigned char*)lds_raw; F.MISC = (volatile LAS unsigned*)(F.lds + MISC_OFF);
    F.tid = threadIdx.x; F.lane = F.tid & 63; F.wave = __builtin_amdgcn_readfirstlane(F.tid >> 6);
    F.G = gridDim.x; { const int bx = blockIdx.x; F.vcu = (F.G % 8 == 0) ? (bx % 8) * (F.G / 8) + bx / 8 : bx; }
    F.ctl = (unsigned*)(args.ws + WS_CTL);
    for (int u = F.tid; u < 128; u += NWAVES * 64) F.MISC[u] = 0u;
    __syncthreads();
    const int lo = args.ph_lo, hi = args.ph_hi;
    XcdBarrier bar; bar.bar = F.ctl + CW_BAR; bar.x = 0; bar.st = F.MISC + 80;
    if (hi - lo > 1) bar = xcd_barrier_post(F.ctl + CW_BAR, F.MISC + 80);
#ifndef PH_COMPILE_MASK
#define PH_COMPILE_MASK 0x3ff
#endif
#define IN(k) (((PH_COMPILE_MASK >> (k)) & 1) && lo <= (k) && (k) < hi)
#define SEAM(k) do { if (IN(k) && IN((k) + 1)) xcd_barrier(bar); } while (0)
    unsigned char* ws = args.ws;
    bf16 *XN = (bf16*)(ws + WS_XN), *Qb = (bf16*)(ws + WS_Q), *Kb = (bf16*)(ws + WS_K), *Vb = (bf16*)(ws + WS_V), *Ub = (bf16*)(ws + WS_U), *VG = (bf16*)(ws + WS_VG);
    bf16 *GT = (bf16*)(ws + WS_GT), *YAB = (bf16*)(ws + WS_YAB), *MRG = (bf16*)(ws + WS_MRG), *Y1 = (bf16*)(ws + WS_Y1), *ACT = (bf16*)(ws + WS_ACT), *Y2 = (bf16*)(ws + WS_Y2);

    if (IN(0)) { phaseA(F, args); } SEAM(0);
    if (IN(1)) { phaseB(F, args); } SEAM(1);
    if (IN(2)) {
        SchedStatic S{(const char*)XN, (const char*)(ws + WS_W1T), NTOK / 256, 4608 / 256, F.G, (int)blockIdx.x, (size_t)256 * 1024 * 2, (size_t)256 * 1024 * 2};
        EpiG1 E{Qb, Kb, Vb, Ub, VG, GT, args.in[15]};
        pg8::gemm_phase<EpiG1, SchedStatic>(F.lds + RING_OFF, S, E, 1024, 1024, 16);
    } SEAM(2);
    if (IN(3)) { phaseD(F, args); } SEAM(3);
    if (IN(4)) {
        SchedSplit2 S{(const char*)YAB, (const char*)(ws + WS_WBRT), NTOK / 256, 4, F.G, (int)blockIdx.x, (size_t)256 * 1024 * 2, (size_t)256 * 1024 * 2, (size_t)512 * 2};
        EpiG2 E{GT, MRG};
        pg8::gemm_phase<EpiG2, SchedSplit2>(F.lds + RING_OFF, S, E, 1024, 1024, 8);
    } SEAM(4);
    if (IN(5)) {
        SchedStatic S{(const char*)MRG, (const char*)(ws + WS_WOUTT), NTOK / 256, 4, F.G, (int)blockIdx.x, (size_t)256 * 1024 * 2, (size_t)256 * 1024 * 2};
        EpiPlain E{Y1};
        pg8::gemm_phase<EpiPlain, SchedStatic>(F.lds + RING_OFF, S, E, 1024, 1024, 16);
    } SEAM(5);
    if (IN(6)) { phaseG(F, args); } SEAM(6);
    if (IN(7)) {
        const int nrb = moe_tables(F);
        const int* list = (const int*)(ws + WS_LIST);
        typedef SchedMoe<8, true> SM;
        SM S{(const char*)XN, (const char*)(ws + WS_WGUT), F.MISC, (const LAS unsigned*)(F.lds + GTAB_OFF), (int)blockIdx.x, F.G, nrb, (size_t)2048 * 1024 * 2, (size_t)256 * 1024 * 2};
        { Unit u; LAS unsigned* gt = (LAS unsigned*)(F.lds + GTAB_OFF);
          for (int k = 0; k < GTAB_UNITS && S.next(k, u); ++k) { const int e = u.aux, j256 = (u.pm - (int)F.MISC[e]) * 256, ecnt = (int)F.MISC[40 + e];
              for (int r = F.tid; r < 256; r += NWAVES * 64) { const int pos = j256 + r; int tok = 0; if (pos < ecnt) tok = list[(size_t)e * NTOK + pos] >> 2; gt[k * 256 + r] = (unsigned)tok * 2048u; } } }
        __syncthreads();
        EpiAct E{args.in[22], ACT};
        pg8::gemm_phase<EpiAct, SM>(F.lds + RING_OFF, S, E, 1024, 1024, 16);
    } SEAM(7);
    if (IN(8)) {
        const int nrb = moe_tables(F);
        typedef SchedMoe<4, false> SM;
        SM S{(const char*)ACT, (const char*)(ws + WS_WDNT), F.MISC, (const LAS unsigned*)(F.lds + GTAB_OFF), (int)blockIdx.x, F.G, nrb, (size_t)1024 * 1024 * 2, (size_t)256 * 1024 * 2};
        EpiDown E{args.in[24], (const int*)(ws + WS_LIST), (const float*)(ws + WS_TOPG), F.MISC, Y2};
        pg8::gemm_phase<EpiDown, SM>(F.lds + RING_OFF, S, E, 1024, 1024, 16);
    } SEAM(8);
    if (IN(9)) { phaseJ(F, args); }
#undef IN
#undef SEAM
}
#ifndef MEGA_MASK
#define MEGA_MASK 0x3ff
#endif
#ifndef ONE_LAUNCH
#define ONE_LAUNCH 1
#endif
extern "C" void kernel_launch(void* const* d_in, const int* in_sizes, int n_in, void* d_out, int out_size, void* d_ws, size_t ws_size, hipStream_t stream) {
    if (n_in != 25 || in_sizes[0] != NTOK * D || out_size != NTOK * D || ws_size < WS_END) { fprintf(stderr, "kernel_launch: unexpected shapes (n_in %d in0 %d out %d ws %zu)\n", n_in, n_in > 0 ? in_sizes[0] : -1, out_size, ws_size); return; }
    static int grid = 0;
    if (grid == 0) {
        int dev = 0, cus = 0, per_cu = 0;
        if (hipGetDevice(&dev) != hipSuccess || hipDeviceGetAttribute(&cus, hipDeviceAttributeMultiprocessorCount, dev) != hipSuccess) { fprintf(stderr, "kernel_launch: device query failed\n"); grid = -1; return; }
        if (hipFuncSetAttribute((const void*)mega_fwd, hipFuncAttributeMaxDynamicSharedMemorySize, LDS_BYTES) != hipSuccess) { fprintf(stderr, "kernel_launch: hipFuncSetAttribute failed\n"); grid = -1; return; }
        if (hipOccupancyMaxActiveBlocksPerMultiprocessor(&per_cu, (const void*)mega_fwd, NWAVES * 64, LDS_BYTES) != hipSuccess || per_cu < 1) { fprintf(stderr, "kernel_launch: occupancy query says %d\n", per_cu); }
        (void)hipGetLastError();
        grid = cus;
    }
    if (grid < 0) return;
    const float* x = (const float*)d_in[0]; const float* c = (const float*)d_in[1]; const float* w_ada = (const float*)d_in[2]; const float* b_ada = (const float*)d_in[3];
    const float* g_pre_mix = (const float*)d_in[4]; const float* g_post_mix = (const float*)d_in[5]; const float* w_in = (const float*)d_in[6]; const float* rel_bias = (const float*)d_in[7];
    const float* sgu_ln_g = (const float*)d_in[8]; const float* sgu_ln_b = (const float*)d_in[9]; const float* w_spatial = (const float*)d_in[10]; const float* b_spatial = (const float*)d_in[11];
    const float* w_branch_a = (const float*)d_in[12]; const float* w_branch_b = (const float*)d_in[13]; const float* w_gate = (const float*)d_in[14]; const float* b_gate = (const float*)d_in[15];
    const float* w_out = (const float*)d_in[16]; const float* g_pre_ffn = (const float*)d_in[17]; const float* g_post_ffn = (const float*)d_in[18]; const float* w_router = (const float*)d_in[19];
    const float* b_router = (const float*)d_in[20]; const float* w_gate_up = (const float*)d_in[21]; const float* b_gate_up = (const float*)d_in[22]; const float* w_down = (const float*)d_in[23];
    const float* b_down = (const float*)d_in[24];
    unsigned char* ws = (unsigned char*)d_ws; float* out = (float*)d_out;
    unsigned* ctl = (unsigned*)(ws + WS_CTL); float* mod = (float*)(ws + WS_MOD);
    bf16 *XN = (bf16*)(ws + WS_XN), *Qb = (bf16*)(ws + WS_Q), *Kb = (bf16*)(ws + WS_K), *Vb = (bf16*)(ws + WS_V), *Ub = (bf16*)(ws + WS_U), *VG = (bf16*)(ws + WS_VG);
    bf16 *GT = (bf16*)(ws + WS_GT), *YAB = (bf16*)(ws + WS_YAB), *MRG = (bf16*)(ws + WS_MRG), *Y1 = (bf16*)(ws + WS_Y1), *ACT = (bf16*)(ws + WS_ACT), *Y2 = (bf16*)(ws + WS_Y2);
    float *VN = (float*)(ws + WS_VN), *TMP = (float*)(ws + WS_TMP);
    int* tope = (int*)(ws + WS_TOPE); float* topg = (float*)(ws + WS_TOPG); int* list = (int*)(ws + WS_LIST); unsigned* cnt = ctl + CW_CNT;
    (void)x; (void)c; (void)w_ada; (void)b_ada; (void)g_pre_mix; (void)rel_bias; (void)sgu_ln_g; (void)sgu_ln_b; (void)w_spatial; (void)b_spatial; (void)tope;

    if (hipMemsetAsync(ws + WS_CTL, 0, CTL_ZERO_BYTES, stream) != hipSuccess) { fprintf(stderr, "kernel_launch: memset failed\n"); return; }
    Args a{};
    for (int i = 0; i < 25; ++i) a.in[i] = (const float*)d_in[i];
    a.out = out; a.ws = ws;
#if ONE_LAUNCH
    a.ph_lo = 0; a.ph_hi = N_PHASES;
    hipLaunchKernelGGL(mega_fwd, dim3(grid), dim3(NWAVES * 64), LDS_BYTES, stream, a);
    if (hipPeekAtLastError() != hipSuccess) fprintf(stderr, "kernel_launch: launch failed\n");
#else
    for (int ph = 0; ph < N_PHASES; ++ph) {
        if (((MEGA_MASK >> ph) & 1) || ph == 0) { a.ph_lo = ph; a.ph_hi = ph + 1; hipLaunchKernelGGL(mega_fwd, dim3(grid), dim3(NWAVES * 64), LDS_BYTES, stream, a); if (((MEGA_MASK >> ph) & 1)) continue; }
        switch (ph) {
        case 0: nv_mod<<<NMOD * D / 256, 256, 0, stream>>>(c, w_ada, b_ada, mod); break;
        case 1: nv_xn1<<<NTOK / 4, 256, 0, stream>>>(x, g_pre_mix, mod, XN); break;
        case 2: { G_In g{XN, w_in, Qb, Kb, Vb, Ub, VG}; nv_gemm<G_In, false><<<dim3(INW / 64, NTOK / 64, 1), 256, 0, stream>>>(g, INW, D); }
                { G_Gate g{XN, w_gate, b_gate, GT}; nv_gemm<G_Gate, false><<<dim3(2048 / 64, NTOK / 64, 1), 256, 0, stream>>>(g, 2048, D); } break;
        case 3: nv_attn<<<NTOK * NHEAD / 256, 256, 0, stream>>>(Qb, Kb, Vb, rel_bias, YAB);
                nv_sgu_ln<<<NTOK / 4, 256, 0, stream>>>(VG, sgu_ln_g, sgu_ln_b, VN);
                nv_sgu<<<NTOK * SW / 256, 256, 0, stream>>>(VN, Ub, w_spatial, b_spatial, YAB); break;
        case 4: { G_BrA g{YAB, w_branch_a, GT, TMP}; nv_gemm<G_BrA, false><<<dim3(D / 64, NTOK / 64, 1), 256, 0, stream>>>(g, D, AW); }
                { G_BrB g{YAB, w_branch_b, GT, TMP, MRG}; nv_gemm<G_BrB, false><<<dim3(D / 64, NTOK / 64, 1), 256, 0, stream>>>(g, D, SW); } break;
        case 5: { G_Out g{MRG, w_out, Y1}; nv_gemm<G_Out, false><<<dim3(D / 64, NTOK / 64, 1), 256, 0, stream>>>(g, D, D); } break;
        case 6: nv_rowpass1<<<NTOK / 4, 256, 0, stream>>>(x, Y1, mod, g_post_mix, g_pre_ffn, w_router, b_router, out, XN, tope, topg, cnt, list); break;
        case 7: { G_MoeGU g{XN, w_gate_up, b_gate_up, cnt, list, ACT}; nv_gemm<G_MoeGU, true><<<dim3(DE / 64, NTOK / 64, NEXP), 256, 0, stream>>>(g, 2048, D); } break;
        case 8: { G_MoeDn g{ACT, w_down, b_down, cnt, list, topg, Y2}; nv_gemm<G_MoeDn, false><<<dim3(D / 64, NTOK / 64, NEXP), 256, 0, stream>>>(g, D, DE); } break;
        case 9: nv_final<<<NTOK / 4, 256, 0, stream>>>(Y2, mod, g_post_ffn, out); break;
        }
    }
#endif
}
```

```cpp
#include <hip/hip_runtime.h>
#include <cstdio>
#include <cstdint>

constexpr int NB = 4, SEQ = 8192, D = 1024, NTOK = NB * SEQ;
constexpr int AW = 512, NHEAD = 8, HD = 64, CHUNK = 64, NLEFT = 8, BAND = 576, MAXREL = 128, NREL = 257;
constexpr int SW = 512, SGB = 128, SGG = 8, SGD = 64;
constexpr int INW = 2560, NEXP = 32, TOPK = 4, DE = 1024, NMOD = 6;
constexpr float EPS = 1e-6f, SWL = 7.0f, SWA = 1.702f;
constexpr float LOG2E = 1.4426950408889634f;
constexpr float QSCALE = 0.125f * LOG2E;
constexpr int SH1 = 0, SC1 = 1024, GT1 = 2048, SH2 = 3072, SC2 = 4096, GT2 = 5120;

typedef unsigned short bf16;
__device__ __forceinline__ float bf2f(bf16 v) { return __uint_as_float(((unsigned)v) << 16); }
__device__ __forceinline__ bf16 f2bf(float f) { unsigned u = __float_as_uint(f); return (bf16)((u + 0x7fffu + ((u >> 16) & 1u)) >> 16); }
__device__ __forceinline__ float wave_sum(float v) {
#pragma unroll
    for (int o = 1; o < 64; o <<= 1) v += __shfl_xor(v, o);
    return v;
}
__device__ __forceinline__ float gelu_erf(float x) { return 0.5f * x * (1.0f + erff(x * 0.70710678118654752f)); }
__device__ __forceinline__ float sigmoidf_(float x) { return 1.0f / (1.0f + __expf(-x)); }

constexpr size_t MiB = 1u << 20;
constexpr size_t WS_CTL = 0, CTL_ZERO_BYTES = 1 * MiB;
constexpr size_t WS_MOD = 1 * MiB;
constexpr size_t WS_W1T = 2 * MiB, WS_WBRT = 12 * MiB, WS_WOUTT = 14 * MiB, WS_WRT = 16 * MiB;
constexpr size_t WS_TOPE = 17 * MiB, WS_TOPG = 18 * MiB, WS_LIST = 19 * MiB;
constexpr size_t WS_WGUT = 32 * MiB, WS_WDNT = 160 * MiB;
constexpr size_t WS_XN = 224 * MiB;
constexpr size_t WS_Q = 288 * MiB, WS_K = 320 * MiB, WS_V = 352 * MiB, WS_U = 384 * MiB, WS_VG = 416 * MiB;
constexpr size_t WS_GT = 448 * MiB;
constexpr size_t WS_YAB = 576 * MiB, WS_MRG = 640 * MiB, WS_Y1 = 704 * MiB;
constexpr size_t WS_ACT = 288 * MiB;
constexpr size_t WS_Y2 = 576 * MiB;
constexpr size_t WS_VN = 768 * MiB;
constexpr size_t WS_TMP = 832 * MiB;
constexpr size_t WS_END = 960 * MiB;
constexpr int CW_CNT = 1024;

__global__ __launch_bounds__(256) void nv_mod(const float* __restrict__ c, const float* __restrict__ w_ada, const float* __restrict__ b_ada, float* __restrict__ mod) {
    __shared__ float sc[NB * D];
    for (int i = threadIdx.x; i < NB * D; i += 256) { const float v = c[i]; sc[i] = v / (1.0f + __expf(-v)); }
    __syncthreads();
    const int j = blockIdx.x * 256 + threadIdx.x;
    float a0 = 0.f, a1 = 0.f, a2 = 0.f, a3 = 0.f;
    for (int k = 0; k < D; ++k) { const float w = w_ada[(size_t)k * (NMOD * D) + j]; a0 += sc[k] * w; a1 += sc[D + k] * w; a2 += sc[2 * D + k] * w; a3 += sc[3 * D + k] * w; }
    const float bb = b_ada[j];
    mod[j] = a0 + bb; mod[6144 + j] = a1 + bb; mod[2 * 6144 + j] = a2 + bb; mod[3 * 6144 + j] = a3 + bb;
}

__global__ __launch_bounds__(256) void nv_xn1(const float* __restrict__ x, const float* __restrict__ g, const float* __restrict__ mod, bf16* __restrict__ xn) {
    const int row = blockIdx.x * 4 + (threadIdx.x >> 6), lane = threadIdx.x & 63, b = row / SEQ;
    const float4* xr = (const float4*)(x + (size_t)row * D);
    float4 v[4]; float ss = 0.f;
#pragma unroll
    for (int j = 0; j < 4; ++j) { v[j] = xr[lane + 64 * j]; ss += v[j].x * v[j].x + v[j].y * v[j].y + v[j].z * v[j].z + v[j].w * v[j].w; }
    const float rstd = rsqrtf(wave_sum(ss) * (1.0f / D) + EPS);
    const float* mb = mod + b * 6144;
#pragma unroll
    for (int j = 0; j < 4; ++j) {
        const int c0 = (lane + 64 * j) * 4; const float vv[4] = {v[j].x, v[j].y, v[j].z, v[j].w}; bf16 o[4];
#pragma unroll
        for (int i = 0; i < 4; ++i) o[i] = f2bf(vv[i] * rstd * g[c0 + i] * (1.0f + mb[SC1 + c0 + i]) + mb[SH1 + c0 + i]);
        *(uint2*)(xn + (size_t)row * D + c0) = make_uint2((unsigned)o[0] | ((unsigned)o[1] << 16), (unsigned)o[2] | ((unsigned)o[3] << 16));
    }
}

template <class G, bool DUAL>
__global__ __launch_bounds__(256) void nv_gemm(G g, int ldw, int K) {
    __shared__ float As[16][68];
    __shared__ float Ws[16][64];
    __shared__ float Ws2[DUAL ? 16 : 1][64];
    const int z = blockIdx.z; int nrows; const float* W; const float* W2;
    if (!g.setup(z, nrows, W, W2)) return;
    const int r0 = blockIdx.y * 64, n0 = blockIdx.x * 64;
    if (r0 >= nrows) return;
    const int tid = threadIdx.x, tx = tid & 15, ty = tid >> 4;
    const int lr = tid >> 2, lk = (tid & 3) * 4;
    int ar = r0 + lr; if (ar >= nrows) ar = nrows - 1;
    const bf16* ap = g.arow(z, ar) + lk;
    const int wk = tid >> 4, wn = (tid & 15) * 4;
    float acc[4][4], acc2[4][4];
#pragma unroll
    for (int i = 0; i < 4; ++i)
#pragma unroll
        for (int j = 0; j < 4; ++j) { acc[i][j] = 0.f; acc2[i][j] = 0.f; }
    for (int k0 = 0; k0 < K; k0 += 16) {
        const uint2 av = *(const uint2*)(ap + k0);
        As[lk + 0][lr] = bf2f((bf16)(av.x & 0xffff)); As[lk + 1][lr] = bf2f((bf16)(av.x >> 16));
        As[lk + 2][lr] = bf2f((bf16)(av.y & 0xffff)); As[lk + 3][lr] = bf2f((bf16)(av.y >> 16));
        *(float4*)&Ws[wk][wn] = *(const float4*)(W + (size_t)(k0 + wk) * ldw + n0 + wn);
        if (DUAL) *(float4*)&Ws2[wk][wn] = *(const float4*)(W2 + (size_t)(k0 + wk) * ldw + n0 + wn);
        __syncthreads();
#pragma unroll
        for (int kk = 0; kk < 16; ++kk) {
            const float4 a = *(const float4*)&As[kk][ty * 4]; const float4 b = *(const float4*)&Ws[kk][tx * 4];
            const float aa[4] = {a.x, a.y, a.z, a.w}, bb[4] = {b.x, b.y, b.z, b.w};
#pragma unroll
            for (int i = 0; i < 4; ++i)
#pragma unroll
                for (int j = 0; j < 4; ++j) acc[i][j] += aa[i] * bb[j];
            if (DUAL) { const float4 b2 = *(const float4*)&Ws2[kk][tx * 4]; const float cc[4] = {b2.x, b2.y, b2.z, b2.w};
#pragma unroll
                for (int i = 0; i < 4; ++i)
#pragma unroll
                    for (int j = 0; j < 4; ++j) acc2[i][j] += aa[i] * cc[j]; }
        }
        __syncthreads();
    }
#pragma unroll
    for (int i = 0; i < 4; ++i) { const int r = r0 + ty * 4 + i; if (r < nrows) {
#pragma unroll
        for (int j = 0; j < 4; ++j) g.store(z, r, n0 + tx * 4 + j, acc[i][j], acc2[i][j]); } }
}

struct G_In {
    const bf16* A; const float* W; bf16 *Q, *Kb, *V, *U, *VG;
    __device__ bool setup(int, int& nrows, const float*& w, const float*& w2) const { nrows = NTOK; w = W; w2 = W; return true; }
    __device__ const bf16* arow(int, int r) const { return A + (size_t)r * D; }
    __device__ void store(int, int r, int n, float acc, float) const {
        if (n < 512) Q[(size_t)r * 512 + n] = f2bf(acc * QSCALE);
        else if (n < 1024) Kb[(size_t)r * 512 + n - 512] = f2bf(acc);
        else if (n < 1536) V[(size_t)r * 512 + n - 1024] = f2bf(acc);
        else if (n < 2048) U[(size_t)r * 512 + n - 1536] = f2bf(gelu_erf(acc));
        else VG[(size_t)r * 512 + n - 2048] = f2bf(gelu_erf(acc));
    }
};
struct G_Gate {
    const bf16* A; const float* W; const float* bias; bf16* GT;
    __device__ bool setup(int, int& nrows, const float*& w, const float*& w2) const { nrows = NTOK; w = W; w2 = W; return true; }
    __device__ const bf16* arow(int, int r) const { return A + (size_t)r * D; }
    __device__ void store(int, int r, int n, float acc, float) const { GT[(size_t)r * 2048 + n] = f2bf(sigmoidf_(acc + bias[n])); }
};
struct G_BrA {
    const bf16* YAB; const float* W; const bf16* GT; float* TMP;
    __device__ bool setup(int, int& nrows, const float*& w, const float*& w2) const { nrows = NTOK; w = W; w2 = W; return true; }
    __device__ const bf16* arow(int, int r) const { return YAB + (size_t)r * 1024; }
    __device__ void store(int, int r, int n, float acc, float) const { TMP[(size_t)r * 1024 + n] = bf2f(GT[(size_t)r * 2048 + n]) * acc; }
};
struct G_BrB {
    const bf16* YAB; const float* W; const bf16* GT; const float* TMP; bf16* MRG;
    __device__ bool setup(int, int& nrows, const float*& w, const float*& w2) const { nrows = NTOK; w = W; w2 = W; return true; }
    __device__ const bf16* arow(int, int r) const { return YAB + (size_t)r * 1024 + 512; }
    __device__ void store(int, int r, int n, float acc, float) const { MRG[(size_t)r * 1024 + n] = f2bf(TMP[(size_t)r * 1024 + n] + bf2f(GT[(size_t)r * 2048 + 1024 + n]) * acc); }
};
struct G_Out {
    const bf16* MRG; const float* W; bf16* Y1;
    __device__ bool setup(int, int& nrows, const float*& w, const float*& w2) const { nrows = NTOK; w = W; w2 = W; return true; }
    __device__ const bf16* arow(int, int r) const { return MRG + (size_t)r * 1024; }
    __device__ void store(int, int r, int n, float acc, float) const { Y1[(size_t)r * 1024 + n] = f2bf(acc); }
};
__device__ __forceinline__ int moe_rowbase(const unsigned* cnt, int e) { int s = 0; for (int i = 0; i < e; ++i) s += (int)((cnt[i] + 255u) / 256u) * 256; return s; }
struct G_MoeGU {
    const bf16* XN2; const float* Wgu; const float* bgu; const unsigned* cnt; const int* list; bf16* ACT;
    __device__ bool setup(int z, int& nrows, const float*& w, const float*& w2) const { nrows = (int)cnt[z]; w = Wgu + (size_t)z * D * 2048; w2 = w + 1024; return nrows > 0; }
    __device__ const bf16* arow(int z, int r) const { const int slot = list[(size_t)z * NTOK + r]; return XN2 + (size_t)(slot >> 2) * D; }
    __device__ void store(int z, int r, int n, float acc, float acc2) const {
        const float xg = fminf(acc + bgu[z * 2048 + n], SWL); const float xl = fminf(fmaxf(acc2 + bgu[z * 2048 + 1024 + n], -SWL), SWL);
        ACT[(size_t)(moe_rowbase(cnt, z) + r) * 1024 + n] = f2bf(xg * sigmoidf_(SWA * xg) * (xl + 1.0f));
    }
};
struct G_MoeDn {
    const bf16* ACT; const float* Wdn; const float* bdn; const unsigned* cnt; const int* list; const float* topg; bf16* Y2;
    __device__ bool setup(int z, int& nrows, const float*& w, const float*& w2) const { nrows = (int)cnt[z]; w = Wdn + (size_t)z * D * D; w2 = w; return nrows > 0; }
    __device__ const bf16* arow(int z, int r) const { return ACT + (size_t)(moe_rowbase(cnt, z) + r) * 1024; }
    __device__ void store(int z, int r, int n, float acc, float) const { const int slot = list[(size_t)z * NTOK + r]; Y2[(size_t)slot * 1024 + n] = f2bf((acc + bdn[z * 1024 + n]) * topg[slot]); }
};

__global__ __launch_bounds__(256) void nv_attn(const bf16* __restrict__ Q, const bf16* __restrict__ Kb, const bf16* __restrict__ V, const float* __restrict__ rel_bias, bf16* __restrict__ YAB) {
    const int gid = blockIdx.x * 256 + threadIdx.x, h = gid & 7, tok = gid >> 3, b = tok / SEQ, t = tok % SEQ, c = t / CHUNK, qi = t % CHUNK;
    float q[64], o[64];
    const uint4* qp = (const uint4*)(Q + (size_t)tok * 512 + h * 64);
#pragma unroll
    for (int i = 0; i < 8; ++i) { const uint4 w = qp[i]; const unsigned ww[4] = {w.x, w.y, w.z, w.w};
#pragma unroll
        for (int j = 0; j < 4; ++j) { q[i * 8 + 2 * j] = bf2f((bf16)(ww[j] & 0xffff)); q[i * 8 + 2 * j + 1] = bf2f((bf16)(ww[j] >> 16)); } }
#pragma unroll
    for (int d = 0; d < 64; ++d) o[d] = 0.f;
    float m = -1e30f, l = 0.f;
    for (int kj = 0; kj < BAND; ++kj) {
        const int kpos = (c - NLEFT) * CHUNK + kj; if (kpos < 0) continue;
        const size_t kr = ((size_t)(b * SEQ + kpos)) * 512 + h * 64;
        const uint4* kp = (const uint4*)(Kb + kr); float s = 0.f;
#pragma unroll
        for (int i = 0; i < 8; ++i) { const uint4 w = kp[i]; const unsigned ww[4] = {w.x, w.y, w.z, w.w};
#pragma unroll
            for (int j = 0; j < 4; ++j) { s += q[i * 8 + 2 * j] * bf2f((bf16)(ww[j] & 0xffff)); s += q[i * 8 + 2 * j + 1] * bf2f((bf16)(ww[j] >> 16)); } }
        int rel = NLEFT * CHUNK + qi - kj; rel = rel < -MAXREL ? -MAXREL : (rel > MAXREL ? MAXREL : rel);
        s += rel_bias[h * NREL + rel + MAXREL] * LOG2E;
        const float mn = fmaxf(m, s), alpha = exp2f(m - mn), p = exp2f(s - mn);
        l = l * alpha + p; m = mn;
        const uint4* vp = (const uint4*)(V + kr);
#pragma unroll
        for (int i = 0; i < 8; ++i) { const uint4 w = vp[i]; const unsigned ww[4] = {w.x, w.y, w.z, w.w};
#pragma unroll
            for (int j = 0; j < 4; ++j) { o[i * 8 + 2 * j] = o[i * 8 + 2 * j] * alpha + p * bf2f((bf16)(ww[j] & 0xffff)); o[i * 8 + 2 * j + 1] = o[i * 8 + 2 * j + 1] * alpha + p * bf2f((bf16)(ww[j] >> 16)); } }
    }
    const float inv = 1.0f / l;
    bf16* op = YAB + (size_t)tok * 1024 + h * 64;
#pragma unroll
    for (int d = 0; d < 64; d += 2) *(unsigned*)(op + d) = (unsigned)f2bf(o[d] * inv) | ((unsigned)f2bf(o[d + 1] * inv) << 16);
}

__global__ __launch_bounds__(256) void nv_sgu_ln(const bf16* __restrict__ VG, const float* __restrict__ ln_g, const float* __restrict__ ln_b, float* __restrict__ VN) {
    const int row = blockIdx.x * 4 + (threadIdx.x >> 6), lane = threadIdx.x & 63;
    const uint4 w = *(const uint4*)(VG + (size_t)row * 512 + lane * 8); const unsigned ww[4] = {w.x, w.y, w.z, w.w};
    float v[8]; float s = 0.f;
#pragma unroll
    for (int j = 0; j < 4; ++j) { v[2 * j] = bf2f((bf16)(ww[j] & 0xffff)); v[2 * j + 1] = bf2f((bf16)(ww[j] >> 16)); s += v[2 * j] + v[2 * j + 1]; }
    const float mu = wave_sum(s) * (1.0f / 512.0f); float q = 0.f;
#pragma unroll
    for (int j = 0; j < 8; ++j) { v[j] -= mu; q += v[j] * v[j]; }
    const float rstd = rsqrtf(wave_sum(q) * (1.0f / 512.0f) + EPS);
#pragma unroll
    for (int j = 0; j < 8; ++j) VN[(size_t)row * 512 + lane * 8 + j] = v[j] * rstd * ln_g[lane * 8 + j] + ln_b[lane * 8 + j];
}
__global__ __launch_bounds__(256) void nv_sgu(const float* __restrict__ VN, const bf16* __restrict__ U, const float* __restrict__ w_s, const float* __restrict__ b_s, bf16* __restrict__ YAB) {
    const int gid = blockIdx.x * 256 + threadIdx.x, c = gid & 511, tok = gid >> 9, tl = tok & 127, tb = tok - tl, g = c >> 6;
    float acc = b_s[g * 128 + tl];
    const float* wr = w_s + ((size_t)g * 128 + tl) * 128;
    for (int s = 0; s <= tl; ++s) acc += wr[s] * VN[(size_t)(tb + s) * 512 + c];
    YAB[(size_t)tok * 1024 + 512 + c] = f2bf(bf2f(U[(size_t)tok * 512 + c]) * acc);
}

__global__ __launch_bounds__(256) void nv_rowpass1(const float* __restrict__ x, const bf16* __restrict__ Y1, const float* __restrict__ mod, const float* __restrict__ g_post_mix,
                                                   const float* __restrict__ g_pre_ffn, const float* __restrict__ w_router, const float* __restrict__ b_router,
                                                   float* __restrict__ X1, bf16* __restrict__ XN2, int* __restrict__ tope, float* __restrict__ topg, unsigned* cnt, int* __restrict__ list) {
    const int row = blockIdx.x * 4 + (threadIdx.x >> 6), lane = threadIdx.x & 63, b = row / SEQ;
    const float* mb = mod + b * 6144;
    float xv[16], yv[16]; float ss = 0.f;
#pragma unroll
    for (int j = 0; j < 4; ++j) {
        const int c0 = (lane + 64 * j) * 4;
        const float4 xx = *(const float4*)(x + (size_t)row * D + c0); xv[4 * j] = xx.x; xv[4 * j + 1] = xx.y; xv[4 * j + 2] = xx.z; xv[4 * j + 3] = xx.w;
        const uint2 yy = *(const uint2*)(Y1 + (size_t)row * D + c0);
        yv[4 * j] = bf2f((bf16)(yy.x & 0xffff)); yv[4 * j + 1] = bf2f((bf16)(yy.x >> 16)); yv[4 * j + 2] = bf2f((bf16)(yy.y & 0xffff)); yv[4 * j + 3] = bf2f((bf16)(yy.y >> 16));
#pragma unroll
        for (int i = 0; i < 4; ++i) ss += yv[4 * j + i] * yv[4 * j + i];
    }
    const float rstd = rsqrtf(wave_sum(ss) * (1.0f / D) + EPS); float s2 = 0.f;
#pragma unroll
    for (int j = 0; j < 4; ++j) { const int c0 = (lane + 64 * j) * 4;
#pragma unroll
        for (int i = 0; i < 4; ++i) { const float x1 = xv[4 * j + i] + mb[GT1 + c0 + i] * (yv[4 * j + i] * rstd * g_post_mix[c0 + i]); xv[4 * j + i] = x1; s2 += x1 * x1; }
        *(float4*)(X1 + (size_t)row * D + c0) = make_float4(xv[4 * j], xv[4 * j + 1], xv[4 * j + 2], xv[4 * j + 3]); }
    const float rstd2 = rsqrtf(wave_sum(s2) * (1.0f / D) + EPS);
#pragma unroll
    for (int j = 0; j < 4; ++j) { const int c0 = (lane + 64 * j) * 4;
#pragma unroll
        for (int i = 0; i < 4; ++i) xv[4 * j + i] = xv[4 * j + i] * rstd2 * g_pre_ffn[c0 + i] * (1.0f + mb[SC2 + c0 + i]) + mb[SH2 + c0 + i];
        *(uint2*)(XN2 + (size_t)row * D + c0) = make_uint2((unsigned)f2bf(xv[4 * j]) | ((unsigned)f2bf(xv[4 * j + 1]) << 16), (unsigned)f2bf(xv[4 * j + 2]) | ((unsigned)f2bf(xv[4 * j + 3]) << 16)); }
    float mylogit = -1e30f;
    for (int e = 0; e < NEXP; ++e) {
        float p = 0.f;
#pragma unroll
        for (int j = 0; j < 4; ++j) { const int c0 = (lane + 64 * j) * 4;
#pragma unroll
            for (int i = 0; i < 4; ++i) p += xv[4 * j + i] * w_router[(size_t)(c0 + i) * NEXP + e]; }
        p = wave_sum(p) + b_router[e];
        if (lane == e) mylogit = p;
    }
    float tv[4]; int ti[4];
#pragma unroll
    for (int k = 0; k < 4; ++k) {
        float bv = mylogit; int bi = lane;
#pragma unroll
        for (int o = 1; o < 64; o <<= 1) { const float ov = __shfl_xor(bv, o); const int oi = __shfl_xor(bi, o); if (ov > bv || (ov == bv && oi < bi)) { bv = ov; bi = oi; } }
        tv[k] = bv; ti[k] = bi; if (lane == bi) mylogit = -3e38f;
    }
    if (lane == 0) {
        const float e0 = 1.0f, e1 = __expf(tv[1] - tv[0]), e2 = __expf(tv[2] - tv[0]), e3 = __expf(tv[3] - tv[0]); const float inv = 1.0f / (e0 + e1 + e2 + e3);
        const float gg[4] = {e0 * inv, e1 * inv, e2 * inv, e3 * inv};
#pragma unroll
        for (int k = 0; k < 4; ++k) { const int slot = row * 4 + k; tope[slot] = ti[k]; topg[slot] = gg[k]; const unsigned pos = atomicAdd(&cnt[ti[k]], 1u); list[(size_t)ti[k] * NTOK + pos] = slot; }
    }
}

__global__ __launch_bounds__(256) void nv_final(const bf16* __restrict__ Y2, const float* __restrict__ mod, const float* __restrict__ g_post_ffn, float* __restrict__ out) {
    const int row = blockIdx.x * 4 + (threadIdx.x >> 6), lane = threadIdx.x & 63, b = row / SEQ;
    const float* mb = mod + b * 6144;
    float yv[16]; float ss = 0.f;
#pragma unroll
    for (int j = 0; j < 4; ++j) { const int c0 = (lane + 64 * j) * 4; float a[4] = {0.f, 0.f, 0.f, 0.f};
#pragma unroll
        for (int k = 0; k < 4; ++k) { const uint2 yy = *(const uint2*)(Y2 + ((size_t)row * 4 + k) * D + c0);
            a[0] += bf2f((bf16)(yy.x & 0xffff)); a[1] += bf2f((bf16)(yy.x >> 16)); a[2] += bf2f((bf16)(yy.y & 0xffff)); a[3] += bf2f((bf16)(yy.y >> 16)); }
#pragma unroll
        for (int i = 0; i < 4; ++i) { yv[4 * j + i] = a[i]; ss += a[i] * a[i]; } }
    const float rstd = rsqrtf(wave_sum(ss) * (1.0f / D) + EPS);
#pragma unroll
    for (int j = 0; j < 4; ++j) { const int c0 = (lane + 64 * j) * 4; float4 xx = *(const float4*)(out + (size_t)row * D + c0);
        xx.x += mb[GT2 + c0] * (yv[4 * j] * rstd * g_post_ffn[c0]); xx.y += mb[GT2 + c0 + 1] * (yv[4 * j + 1] * rstd * g_post_ffn[c0 + 1]);
        xx.z += mb[GT2 + c0 + 2] * (yv[4 * j + 2] * rstd * g_post_ffn[c0 + 2]); xx.w += mb[GT2 + c0 + 3] * (yv[4 * j + 3] * rstd * g_post_ffn[c0 + 3]);
        *(float4*)(out + (size_t)row * D + c0) = xx; }
}

#define LAS __attribute__((address_space(3)))
#define GAS __attribute__((address_space(1)))
typedef short bf16x8 __attribute__((ext_vector_type(8)));
typedef short s16x4 __attribute__((ext_vector_type(4)));
typedef float f32x4 __attribute__((ext_vector_type(4)));
typedef float f32x2 __attribute__((ext_vector_type(2)));
typedef float f32x16 __attribute__((ext_vector_type(16)));
typedef unsigned u32x4 __attribute__((ext_vector_type(4)));
typedef unsigned u32x2 __attribute__((ext_vector_type(2)));
typedef __bf16 bf16x2_t __attribute__((ext_vector_type(2)));
constexpr int NWAVES = 8;
constexpr int TRASH_SLOT = NTOK * 4;

__device__ __forceinline__ unsigned cvtpk(float lo, float hi) { f32x2 v = {lo, hi}; bf16x2_t b = __builtin_convertvector(v, bf16x2_t); return __builtin_bit_cast(unsigned, b); }
__device__ __forceinline__ float bflo(unsigned w) { return __uint_as_float(w << 16); }
__device__ __forceinline__ float bfhi(unsigned w) { return __uint_as_float(w & 0xffff0000u); }
__device__ __forceinline__ float fast_sigmoid(float x) { return __builtin_amdgcn_rcpf(1.0f + __builtin_amdgcn_exp2f(-LOG2E * x)); }
__device__ __forceinline__ f32x2 gelu_pk(f32x2 v) {
    const f32x2 av = __builtin_elementwise_abs(v), d = av * 0.2316418882f + 1.0f;
    f32x2 t; t.x = __builtin_amdgcn_rcpf(d.x); t.y = __builtin_amdgcn_rcpf(d.y);
    f32x2 q = t * 0.5307027145f + (-0.7265760135f); q = q * t + 0.7107068705f; q = q * t + (-0.142248368f); q = q * t + 0.127414796f; q = q * t;
    const f32x2 s = (v * v) * (-0.72134752044f);
    f32x2 e; e.x = __builtin_amdgcn_exp2f(s.x); e.y = __builtin_amdgcn_exp2f(s.y);
    const f32x2 m = v * (q * e), r = v - m;
    f32x2 o; o.x = v.x < 0.f ? m.x : r.x; o.y = v.y < 0.f ? m.y : r.y; return o;
}

constexpr int RING_OFF = 0, RING_BYTES = 131072;
constexpr int GTAB_OFF = RING_BYTES, GTAB_UNITS = 20, GTAB_BYTES = GTAB_UNITS * 256 * 4;
constexpr int MISC_OFF = GTAB_OFF + GTAB_BYTES;
constexpr int LDS_BYTES = MISC_OFF + 512;
static_assert(LDS_BYTES <= 160 * 1024, "LDS map");

#define XB_TMO      128
#define XB_XCNT(j)  (256  + 64 * (j))
#define XB_XSUB(j)  (1280 + 64 * (j))
#define XB_XGEN(j)  (2304 + 64 * (j))
#define XB_TOP      3328
#define XB_TOPGEN   3392
#define XCD_BAR_WORDS 3456
#define XB_SPIN_CAP (1u << 18)
__device__ __forceinline__ unsigned xb_ld(unsigned* p)              { return __hip_atomic_load(p, __ATOMIC_RELAXED, __HIP_MEMORY_SCOPE_AGENT); }
__device__ __forceinline__ unsigned xb_add(unsigned* p, unsigned v) { return __hip_atomic_fetch_add(p, v, __ATOMIC_RELAXED, __HIP_MEMORY_SCOPE_AGENT); }
__device__ __forceinline__ unsigned xb_xcc_id() { return (unsigned)__builtin_amdgcn_s_getreg((3 << 11) | 20) & 0xFu; }
#define XB_SPIN(cond, bar) do { unsigned _sp = 0; while (cond) { __builtin_amdgcn_s_sleep(1); \
    if ((++_sp & 255u) == 0u) { if (xb_ld(&(bar)[XB_TMO])) break; if (_sp > XB_SPIN_CAP) { atomicAdd(&(bar)[XB_TMO], 1u); break; } } } } while (0)
struct XcdBarrier { unsigned* bar; unsigned x; volatile LAS unsigned* st; };
__device__ __forceinline__ XcdBarrier xcd_barrier_post(unsigned* bar, volatile LAS unsigned* st) {
    XcdBarrier b; b.bar = bar; b.x = xb_xcc_id(); b.st = st;
    if (threadIdx.x == 0) (void)xb_add(&bar[XB_XCNT(b.x)], 1u);
    return b;
}
__device__ __forceinline__ void xcd_barrier_complete(unsigned* bar, unsigned x, unsigned& nloc, unsigned& nx) {
    const unsigned G = gridDim.x * gridDim.y * gridDim.z;
    unsigned sum, cnt, mine, sp = 0u;
    for (;;) {
        sum = 0u; cnt = 0u; mine = 0u;
#pragma unroll
        for (unsigned j = 0; j < 16; ++j) { const unsigned c = xb_ld(&bar[XB_XCNT(j)]); sum += c; cnt += (c > 0u) ? 1u : 0u; mine = (j == x) ? c : mine; }
        if (sum == G) break;
        __builtin_amdgcn_s_sleep(1);
        if ((++sp & 255u) == 0u) { if (xb_ld(&bar[XB_TMO])) break; if (sp > XB_SPIN_CAP) { atomicAdd(&bar[XB_TMO], 1u); break; } }
    }
    nloc = mine > 0u ? mine : 1u; nx = cnt > 0u ? cnt : 1u;
}
__device__ __forceinline__ void xcd_barrier(const XcdBarrier& b) {
    asm volatile("s_waitcnt vmcnt(0)" ::: "memory");
    __syncthreads();
    if (threadIdx.x == 0) {
        unsigned* bar = b.bar;
        __builtin_amdgcn_s_waitcnt(0);
        unsigned nloc = b.st[0], nx = b.st[1];
        if (nloc == 0u) { xcd_barrier_complete(bar, b.x, nloc, nx); b.st[0] = nloc; b.st[1] = nx; }
        const unsigned old = xb_add(&bar[XB_XSUB(b.x)], 1u);
        const unsigned gen = old / nloc;
        if (old + 1u == (gen + 1u) * nloc) {
            __builtin_amdgcn_fence(__ATOMIC_RELEASE, "agent");
            asm volatile("s_waitcnt vmcnt(0)" ::: "memory");
            const unsigned og = xb_add(&bar[XB_TOP], 1u);
            const unsigned tg = og / nx;
            if (og + 1u == (tg + 1u) * nx) xb_add(&bar[XB_TOPGEN], 1u);
            else XB_SPIN(xb_ld(&bar[XB_TOPGEN]) == tg, bar);
            __builtin_amdgcn_fence(__ATOMIC_ACQUIRE, "agent");
            xb_add(&bar[XB_XGEN(b.x)], 1u);
            asm volatile("s_waitcnt vmcnt(0)" ::: "memory");
        } else {
            XB_SPIN(xb_ld(&bar[XB_XGEN(b.x)]) == gen, bar);
            __builtin_amdgcn_fence(__ATOMIC_ACQUIRE, "agent");
            asm volatile("s_waitcnt vmcnt(0)" ::: "memory");
        }
    }
    __syncthreads();
}
constexpr int CW_BAR = 4096;

namespace pg8 {
constexpr int BM = 256, BK = 64, HALF = 128, HTB = HALF * BK * 2, STAGE_BYTES = 8 * HTB, NXCD = 8, WGM = 8;
__host__ __device__ __forceinline__ int lds_byte(int r, int c) { const int st = (r >> 4) * 2 + (c >> 5), rr = r & 15, cc = c & 31, ob = rr * 64 + cc * 2; return st * 1024 + (ob ^ (((ob >> 9) & 1) << 5)); }
__host__ __device__ __forceinline__ void stage_rc(int b, int& R, int& C) { const int st = b / 1024, sb = b % 1024, swz = sb ^ (((sb >> 9) & 1) << 5); R = (st >> 1) * 16 + swz / 64; C = (st & 1) * 32 + (swz % 64) / 2; }
__host__ __device__ __forceinline__ int perm32(int rho) { const int n = rho >> 4, i = rho & 15; return 8 * (i >> 2) + 4 * n + (i & 3); }
struct Unit { int pm, pn, aux; };

__device__ __forceinline__ bool static_unit(int i, int G, int c, int nM, int nN, int& pm, int& pn) {
    const int nwg = nM * nN; const long L = (long)i * G + c; if (L >= nwg) return false;
    int wgid = (int)L; { const int q = nwg / NXCD, r = nwg % NXCD, xcd = wgid % NXCD, off = wgid / NXCD; wgid = (xcd < r ? xcd * (q + 1) : r * (q + 1) + (xcd - r) * q) + off; }
    const int nig = WGM * nN, gid = wgid / nig, fm = gid * WGM, gsz = (nM - fm) < WGM ? (nM - fm) : WGM;
    pm = fm + ((wgid % nig) % gsz); pn = (wgid % nig) / gsz; return true;
}

template <class Epi, class Sched>
__device__ __forceinline__ void gemm_phase(LAS unsigned char* lds, const Sched& S, const Epi& E, const int lda, const int ldb, const int nt) {
    const int tid = threadIdx.x, wid = __builtin_amdgcn_readfirstlane(tid >> 6), lane = tid & 63, wr = wid >> 2, wc = wid & 3, fr = lane & 15, fq = lane >> 4;
    int Rr[2], Cc[2]; unsigned voffB[2];
#pragma unroll
    for (int i = 0; i < 2; ++i) { stage_rc(tid * 16 + i * 8192, Rr[i], Cc[i]); const int Rb = (Rr[i] & ~31) + perm32(Rr[i] & 31); voffB[i] = (unsigned)(Rb * ldb + Cc[i]) * 2u; }
    const size_t kstep = (size_t)(BK * 2);
    const size_t hstepB = (size_t)HALF * ldb * 2;
    const unsigned ldsw = (unsigned)wid * 1024u;
    const int aoff = lds_byte(wr * 64 + fr, fq * 8), boff = lds_byte(wc * 32 + fr, fq * 8);
#define PG8_SA(b, h) (((b) * 2 + (h)) * HTB)
#define PG8_SB(b, h) ((4 + (b) * 2 + (h)) * HTB)
#define PG8_STAGE(bufoff, gbase, voff) do { _Pragma("unroll") for (int _i = 0; _i < 2; ++_i) \
        __builtin_amdgcn_global_load_lds((const unsigned*)((const char*)(gbase) + (voff)[_i]), (LAS unsigned*)(lds + (bufoff) + ldsw + _i * 8192), 16, 0, 0); } while (0)
#define PG8_LDA(dst, b, h) do { _Pragma("unroll") for (int m = 0; m < 4; ++m) _Pragma("unroll") for (int k = 0; k < 2; ++k) dst[m][k] = *(const LAS bf16x8*)(lds + PG8_SA(b, h) + aoff + m * 2048 + k * 1024); } while (0)
#define PG8_LDB(dst, b, h) do { _Pragma("unroll") for (int n = 0; n < 2; ++n) _Pragma("unroll") for (int k = 0; k < 2; ++k) dst[n][k] = *(const LAS bf16x8*)(lds + PG8_SB(b, h) + boff + n * 2048 + k * 1024); } while (0)
#define PG8_MMA(ai, bj, At, Bt) do { __builtin_amdgcn_s_setprio(1); _Pragma("unroll") for (int m = 0; m < 4; ++m) _Pragma("unroll") for (int n = 0; n < 2; ++n) _Pragma("unroll") for (int k = 0; k < 2; ++k) \
        acc[ai][bj][m][n] = __builtin_amdgcn_mfma_f32_16x16x32_bf16(Bt[n][k], At[m][k], acc[ai][bj][m][n], 0, 0, 0); __builtin_amdgcn_s_setprio(0); } while (0)
#define PG8_WAIT_V(n) asm volatile("s_waitcnt vmcnt(" #n ")" ::: "memory")
#define PG8_WAIT_L(n) asm volatile("s_waitcnt lgkmcnt(" #n ")" ::: "memory")
#define PG8_BAR __builtin_amdgcn_s_barrier()
#define PG8_SCHED __builtin_amdgcn_sched_barrier(0)
    Unit cur, nxt; int ui = 0;
    if (!S.next(0, cur)) return;
    f32x4 acc[2][2][4][2];
#pragma unroll
    for (int a = 0; a < 2; ++a)
#pragma unroll
        for (int b = 0; b < 2; ++b)
#pragma unroll
            for (int m = 0; m < 4; ++m)
#pragma unroll
                for (int n = 0; n < 2; ++n) acc[a][b][m][n] = (f32x4){0.f, 0.f, 0.f, 0.f};
    bf16x8 At[4][2], B0[2][2], B1[2][2];
    unsigned oA[2][2];
#pragma unroll
    for (int h = 0; h < 2; ++h)
#pragma unroll
        for (int i = 0; i < 2; ++i) oA[h][i] = Sched::GATHER ? (S.goff(0, h * HALF + Rr[i]) + (unsigned)Cc[i] * 2u) : (unsigned)((h * HALF + Rr[i]) * lda + Cc[i]) * 2u;
    const char* cA = S.aptr(cur); const char* cB = S.bptr(cur);
    PG8_STAGE(PG8_SB(0, 0), cB, voffB); PG8_STAGE(PG8_SB(0, 1), cB + hstepB, voffB); PG8_STAGE(PG8_SA(0, 0), cA, oA[0]); PG8_STAGE(PG8_SA(0, 1), cA, oA[1]);
    if (wr == 1) PG8_BAR;
    PG8_WAIT_V(2); PG8_BAR;
    PG8_STAGE(PG8_SB(1, 0), cB + kstep, voffB); PG8_STAGE(PG8_SA(1, 0), cA + kstep, oA[0]); PG8_STAGE(PG8_SB(1, 1), cB + hstepB + kstep, voffB);
    PG8_WAIT_V(6); PG8_BAR;
    for (;;) {
        const bool has_next = S.next(ui + 1, nxt);
        const char* nA = has_next ? S.aptr(nxt) : cA; const char* nB = has_next ? S.bptr(nxt) : cB;
        for (int t = 0; t < nt; t += 2) {
            const bool last = (t == nt - 2);
            const char* a1 = cA + (size_t)(t + 1) * kstep;
            const char* a2 = last ? nA : cA + (size_t)(t + 2) * kstep; const char* b2 = last ? nB : cB + (size_t)(t + 2) * kstep;
            const char* a3 = a2 + kstep; const char* b3 = b2 + kstep;
            PG8_LDB(B0, 0, 0); PG8_LDB(B1, 0, 1); PG8_SCHED; PG8_LDA(At, 0, 0); PG8_STAGE(PG8_SA(1, 1), a1, oA[1]);
            if constexpr (Sched::GATHER) { if (last && has_next) {
#pragma unroll
                for (int h = 0; h < 2; ++h)
#pragma unroll
                    for (int i = 0; i < 2; ++i) oA[h][i] = S.goff(ui + 1, h * HALF + Rr[i]) + (unsigned)Cc[i] * 2u; } }
            PG8_WAIT_V(8); PG8_WAIT_L(0); PG8_BAR; PG8_MMA(0, 0, At, B0); PG8_MMA(0, 1, At, B1); PG8_BAR; PG8_SCHED;
            PG8_LDA(At, 0, 1); PG8_STAGE(PG8_SB(0, 0), b2, voffB); PG8_STAGE(PG8_SB(0, 1), b2 + hstepB, voffB); PG8_STAGE(PG8_SA(0, 0), a2, oA[0]);
            PG8_WAIT_V(8); PG8_WAIT_L(0); PG8_BAR; PG8_MMA(1, 0, At, B0); PG8_MMA(1, 1, At, B1); PG8_BAR; PG8_SCHED;
            PG8_LDB(B0, 1, 0); PG8_LDB(B1, 1, 1); PG8_SCHED; PG8_LDA(At, 1, 0); PG8_STAGE(PG8_SA(0, 1), a2, oA[1]);
            PG8_WAIT_V(8); PG8_WAIT_L(0); PG8_BAR; PG8_MMA(0, 0, At, B0); PG8_MMA(0, 1, At, B1); PG8_BAR; PG8_SCHED;
            PG8_LDA(At, 1, 1); PG8_STAGE(PG8_SB(1, 0), b3, voffB); PG8_STAGE(PG8_SB(1, 1), b3 + hstepB, voffB); PG8_STAGE(PG8_SA(1, 0), a3, oA[0]);
            PG8_WAIT_V(8); PG8_WAIT_L(0); PG8_BAR; PG8_MMA(1, 0, At, B0); PG8_MMA(1, 1, At, B1); PG8_BAR; PG8_SCHED;
        }
        if (wr == 0) PG8_BAR;
        bool keep = false;
        if constexpr (Sched::HAS_MID) { if (S.is_mid(cur)) { E.mid(acc, cur, wr, wc, fr, fq); keep = true; } }
        if (!keep) E(acc, cur, wr, wc, fr, fq);
        if (!has_next) break;
        if (!keep) {
#pragma unroll
            for (int a = 0; a < 2; ++a)
#pragma unroll
                for (int b = 0; b < 2; ++b)
#pragma unroll
                    for (int m = 0; m < 4; ++m)
#pragma unroll
                        for (int n = 0; n < 2; ++n) acc[a][b][m][n] = (f32x4){0.f, 0.f, 0.f, 0.f};
        }
        cur = nxt; cA = nA; cB = nB; ++ui;
        if (wr == 1) PG8_BAR;
    }
    PG8_WAIT_V(0);
    PG8_BAR;
#undef PG8_SA
#undef PG8_SB
#undef PG8_STAGE
#undef PG8_LDA
#undef PG8_LDB
#undef PG8_MMA
#undef PG8_WAIT_V
#undef PG8_WAIT_L
#undef PG8_BAR
#undef PG8_SCHED
}
}
using pg8::Unit;

struct Args { const float* in[25]; float* out; unsigned char* ws; int ph_lo, ph_hi, rep_mask, pad; };
static_assert(sizeof(Args) == 27 * 8 + 16, "Args has no padding");
struct Frame {
    LAS unsigned char* lds; volatile LAS unsigned* MISC; unsigned* ctl;
    int tid, lane, wave, vcu, G;
};
#define LDS_WAIT() asm volatile("s_waitcnt lgkmcnt(0)" ::: "memory")
#define VM_WAIT() asm volatile("s_waitcnt vmcnt(0)" ::: "memory")

struct SchedStatic {
    static constexpr bool GATHER = false, HAS_MID = false;
    const char* A; const char* B; int nM, nN, G, c; size_t astep, bstep;
    __device__ __forceinline__ bool next(int i, Unit& u) const { u.aux = 0; return pg8::static_unit(i, G, c, nM, nN, u.pm, u.pn); }
    __device__ __forceinline__ const char* aptr(const Unit& u) const { return A + (size_t)u.pm * astep; }
    __device__ __forceinline__ const char* bptr(const Unit& u) const { return B + (size_t)u.pn * bstep; }
    __device__ __forceinline__ bool is_mid(const Unit&) const { return false; }
    __device__ __forceinline__ unsigned goff(int, int) const { return 0u; }
};
struct SchedSplit2 {
    static constexpr bool GATHER = false, HAS_MID = true;
    const char* A; const char* B; int nM, nN, G, c; size_t astep, bstep, khalf;
    __device__ __forceinline__ bool next(int i, Unit& u) const { u.aux = i & 1; return pg8::static_unit(i >> 1, G, c, nM, nN, u.pm, u.pn); }
    __device__ __forceinline__ const char* aptr(const Unit& u) const { return A + (size_t)u.pm * astep + (size_t)u.aux * khalf; }
    __device__ __forceinline__ const char* bptr(const Unit& u) const { return B + (size_t)u.pn * bstep + (size_t)u.aux * khalf; }
    __device__ __forceinline__ bool is_mid(const Unit& u) const { return u.aux == 0; }
    __device__ __forceinline__ unsigned goff(int, int) const { return 0u; }
};
__device__ __forceinline__ int moe_find_e(volatile LAS unsigned* MISC, int rb) { int e = 0;
#pragma unroll 1
    for (int i = 1; i < NEXP; ++i) e += ((int)MISC[i] <= rb) ? 1 : 0;
    return e; }
template <int NPN, bool GATH>
struct SchedMoe {
    static constexpr bool GATHER = GATH, HAS_MID = false;
    static constexpr int RPX = 32 / NPN;
    const char* A; const char* B; volatile LAS unsigned* MISC; const LAS unsigned* gtab; int c, G, nrb; size_t bstep_e, bstep_n;
    __device__ __forceinline__ bool next(int i, Unit& u) const {
        int rb, pn;
        if (G == 256) { const int x = c & 7, j = c >> 3; rb = (8 * i + x) * RPX + j / NPN; pn = j % NPN; }
        else { const long L = (long)i * G + c; rb = (int)(L / NPN); pn = (int)(L % NPN); }
        if (rb >= nrb) return false;
        u.pm = rb; u.pn = pn; u.aux = moe_find_e(MISC, rb); return true;
    }
    __device__ __forceinline__ const char* aptr(const Unit& u) const { return GATH ? A : A + (size_t)u.pm * (256 * 1024 * 2); }
    __device__ __forceinline__ const char* bptr(const Unit& u) const { return B + (size_t)u.aux * bstep_e + (size_t)u.pn * bstep_n; }
    __device__ __forceinline__ bool is_mid(const Unit&) const { return false; }
    __device__ __forceinline__ unsigned goff(int ui, int row) const { return gtab[ui * 256 + row]; }
};

#define EPI_ARGS f32x4 (&acc)[2][2][4][2], const Unit& u, int wr, int wc, int fr, int fq
struct EpiG1 {
    bf16 *Q, *K, *V, *U, *VG, *GT; const float* bgate;
    __device__ __forceinline__ void mid(EPI_ARGS) const {}
    __device__ __forceinline__ void operator()(EPI_ARGS) const {
        const int pn = u.pn; const int row0 = u.pm * 256 + wr * 64 + fr;
        if (pn < 6) {
            const int t = pn >> 1; bf16* base = Q + (size_t)t * ((WS_K - WS_Q) / 2); const float sc = (t == 0) ? QSCALE : 1.0f;    const int col0 = (pn & 1) * 256 + wc * 32 + 8 * fq;
#pragma unroll
            for (int ai = 0; ai < 2; ++ai)
#pragma unroll
                for (int m = 0; m < 4; ++m) { bf16* rowp = base + (size_t)(row0 + ai * 128 + m * 16) * 512 + col0;
#pragma unroll
                    for (int bj = 0; bj < 2; ++bj) { const f32x4 v0 = acc[ai][bj][m][0] * sc, v1 = acc[ai][bj][m][1] * sc;
                        u32x4 w; w.x = cvtpk(v0[0], v0[1]); w.y = cvtpk(v0[2], v0[3]); w.z = cvtpk(v1[0], v1[1]); w.w = cvtpk(v1[2], v1[3]); *(u32x4*)(rowp + bj * 128) = w; } }
        } else if (pn < 10) {
            bf16* base = Q + (size_t)(pn >> 1) * ((WS_K - WS_Q) / 2); const int col0 = (pn & 1) * 256 + wc * 32 + 8 * fq;
#pragma unroll
            for (int ai = 0; ai < 2; ++ai)
#pragma unroll
                for (int m = 0; m < 4; ++m) { bf16* rowp = base + (size_t)(row0 + ai * 128 + m * 16) * 512 + col0;
#pragma unroll
                    for (int bj = 0; bj < 2; ++bj) { const f32x4 v0 = acc[ai][bj][m][0], v1 = acc[ai][bj][m][1];
                        const f32x2 a = gelu_pk((f32x2){v0[0], v0[1]}), b = gelu_pk((f32x2){v0[2], v0[3]}), c = gelu_pk((f32x2){v1[0], v1[1]}), d = gelu_pk((f32x2){v1[2], v1[3]});
                        u32x4 w; w.x = cvtpk(a.x, a.y); w.y = cvtpk(b.x, b.y); w.z = cvtpk(c.x, c.y); w.w = cvtpk(d.x, d.y); *(u32x4*)(rowp + bj * 128) = w; } }
        } else {
            const int col0 = (pn - 10) * 256 + wc * 32 + 8 * fq;
            f32x4 bv[2][2];
#pragma unroll
            for (int bj = 0; bj < 2; ++bj)
#pragma unroll
                for (int n = 0; n < 2; ++n) bv[bj][n] = *(const f32x4*)(bgate + col0 + bj * 128 + 4 * n);
#pragma unroll
            for (int ai = 0; ai < 2; ++ai)
#pragma unroll
                for (int m = 0; m < 4; ++m) { bf16* rowp = GT + (size_t)(row0 + ai * 128 + m * 16) * 2048 + col0;
#pragma unroll
                    for (int bj = 0; bj < 2; ++bj) { const f32x4 v0 = acc[ai][bj][m][0] + bv[bj][0], v1 = acc[ai][bj][m][1] + bv[bj][1];
                        u32x4 w; w.x = cvtpk(fast_sigmoid(v0[0]), fast_sigmoid(v0[1])); w.y = cvtpk(fast_sigmoid(v0[2]), fast_sigmoid(v0[3]));
                        w.z = cvtpk(fast_sigmoid(v1[0]), fast_sigmoid(v1[1])); w.w = cvtpk(fast_sigmoid(v1[2]), fast_sigmoid(v1[3])); *(u32x4*)(rowp + bj * 128) = w; } }
        }
    }
};
struct EpiG2 {
    const bf16* GT; bf16* MRG;
    __device__ __forceinline__ void mid(EPI_ARGS) const {
        const int row0 = u.pm * 256 + wr * 64 + fr, col0 = u.pn * 256 + wc * 32 + 8 * fq;
#pragma unroll
        for (int ai = 0; ai < 2; ++ai)
#pragma unroll
            for (int m = 0; m < 4; ++m) { const bf16* gp = GT + (size_t)(row0 + ai * 128 + m * 16) * 2048 + col0;
#pragma unroll
                for (int bj = 0; bj < 2; ++bj) { const u32x4 ga = *(const u32x4*)(gp + bj * 128), gb = *(const u32x4*)(gp + 1024 + bj * 128);
                    f32x4 r0, r1;
                    r0[0] = bflo(ga.x) * __builtin_amdgcn_rcpf(fmaxf(bflo(gb.x), 1e-30f)); r0[1] = bfhi(ga.x) * __builtin_amdgcn_rcpf(fmaxf(bfhi(gb.x), 1e-30f));
                    r0[2] = bflo(ga.y) * __builtin_amdgcn_rcpf(fmaxf(bflo(gb.y), 1e-30f)); r0[3] = bfhi(ga.y) * __builtin_amdgcn_rcpf(fmaxf(bfhi(gb.y), 1e-30f));
                    r1[0] = bflo(ga.z) * __builtin_amdgcn_rcpf(fmaxf(bflo(gb.z), 1e-30f)); r1[1] = bfhi(ga.z) * __builtin_amdgcn_rcpf(fmaxf(bfhi(gb.z), 1e-30f));
                    r1[2] = bflo(ga.w) * __builtin_amdgcn_rcpf(fmaxf(bflo(gb.w), 1e-30f)); r1[3] = bfhi(ga.w) * __builtin_amdgcn_rcpf(fmaxf(bfhi(gb.w), 1e-30f));
                    acc[ai][bj][m][0] *= r0; acc[ai][bj][m][1] *= r1; } }
    }
    __device__ __forceinline__ void operator()(EPI_ARGS) const {
        const int row0 = u.pm * 256 + wr * 64 + fr, col0 = u.pn * 256 + wc * 32 + 8 * fq;
#pragma unroll
        for (int ai = 0; ai < 2; ++ai)
#pragma unroll
            for (int m = 0; m < 4; ++m) { const size_t r = (size_t)(row0 + ai * 128 + m * 16); const bf16* gp = GT + r * 2048 + 1024 + col0; bf16* op = MRG + r * 1024 + col0;
#pragma unroll
                for (int bj = 0; bj < 2; ++bj) { const u32x4 gb = *(const u32x4*)(gp + bj * 128); const f32x4 v0 = acc[ai][bj][m][0], v1 = acc[ai][bj][m][1];
                    u32x4 w; w.x = cvtpk(v0[0] * bflo(gb.x), v0[1] * bfhi(gb.x)); w.y = cvtpk(v0[2] * bflo(gb.y), v0[3] * bfhi(gb.y));
                    w.z = cvtpk(v1[0] * bflo(gb.z), v1[1] * bfhi(gb.z)); w.w = cvtpk(v1[2] * bflo(gb.w), v1[3] * bfhi(gb.w)); *(u32x4*)(op + bj * 128) = w; } }
    }
};
struct EpiPlain {
    bf16* O;
    __device__ __forceinline__ void mid(EPI_ARGS) const {}
    __device__ __forceinline__ void operator()(EPI_ARGS) const {
        const int row0 = u.pm * 256 + wr * 64 + fr, col0 = u.pn * 256 + wc * 32 + 8 * fq;
#pragma unroll
        for (int ai = 0; ai < 2; ++ai)
#pragma unroll
            for (int m = 0; m < 4; ++m) { bf16* op = O + (size_t)(row0 + ai * 128 + m * 16) * 1024 + col0;
#pragma unroll
                for (int bj = 0; bj < 2; ++bj) { const f32x4 v0 = acc[ai][bj][m][0], v1 = acc[ai][bj][m][1];
                    u32x4 w; w.x = cvtpk(v0[0], v0[1]); w.y = cvtpk(v0[2], v0[3]); w.z = cvtpk(v1[0], v1[1]); w.w = cvtpk(v1[2], v1[3]); *(u32x4*)(op + bj * 128) = w; } }
    }
};
struct EpiAct {
    const float* bgu; bf16* ACT;
    __device__ __forceinline__ void mid(EPI_ARGS) const {}
    __device__ __forceinline__ void operator()(EPI_ARGS) const {
        const int e = u.aux; const int row0 = u.pm * 256 + wr * 64 + fr, col0 = u.pn * 128 + wc * 32 + 8 * fq;
        const float* bp = bgu + (size_t)e * 2048 + col0;
        const f32x4 bg0 = *(const f32x4*)(bp), bg1 = *(const f32x4*)(bp + 4), bl0 = *(const f32x4*)(bp + 1024), bl1 = *(const f32x4*)(bp + 1028);
#pragma unroll
        for (int ai = 0; ai < 2; ++ai)
#pragma unroll
            for (int m = 0; m < 4; ++m) {
                f32x4 o[2];
#pragma unroll
                for (int n = 0; n < 2; ++n) { const f32x4 g = acc[ai][0][m][n] + (n ? bg1 : bg0), l = acc[ai][1][m][n] + (n ? bl1 : bl0);
#pragma unroll
                    for (int i = 0; i < 4; ++i) { const float xg = fminf(g[i], SWL), xl = fminf(fmaxf(l[i], -SWL), SWL); o[n][i] = xg * fast_sigmoid(SWA * xg) * (xl + 1.0f); } }
                u32x4 w; w.x = cvtpk(o[0][0], o[0][1]); w.y = cvtpk(o[0][2], o[0][3]); w.z = cvtpk(o[1][0], o[1][1]); w.w = cvtpk(o[1][2], o[1][3]);
                *(u32x4*)(ACT + (size_t)(row0 + ai * 128 + m * 16) * 1024 + col0) = w; }
    }
};
struct EpiDown {
    const float* bdn; const int* list; const float* topg; volatile LAS unsigned* MISC; bf16* Y2;
    __device__ __forceinline__ void mid(EPI_ARGS) const {}
    __device__ __forceinline__ void operator()(EPI_ARGS) const {
        const int e = u.aux; const int j256 = (u.pm - (int)MISC[e]) * 256; const int ecnt = (int)MISC[40 + e];
        const int col0 = u.pn * 256 + wc * 32 + 8 * fq;
        f32x4 bv[2][2];
#pragma unroll
        for (int bj = 0; bj < 2; ++bj)
#pragma unroll
            for (int n = 0; n < 2; ++n) bv[bj][n] = *(const f32x4*)(bdn + (size_t)e * 1024 + col0 + bj * 128 + 4 * n);
#pragma unroll
        for (int ai = 0; ai < 2; ++ai)
#pragma unroll
            for (int m = 0; m < 4; ++m) { const int pos = j256 + ai * 128 + wr * 64 + m * 16 + fr;
                int slot = TRASH_SLOT; if (pos < ecnt) slot = list[(size_t)e * NTOK + pos];
                const float g = topg[slot]; bf16* op = Y2 + (size_t)slot * 1024 + col0;
#pragma unroll
                for (int bj = 0; bj < 2; ++bj) { const f32x4 v0 = (acc[ai][bj][m][0] + bv[bj][0]) * g, v1 = (acc[ai][bj][m][1] + bv[bj][1]) * g;
                    u32x4 w; w.x = cvtpk(v0[0], v0[1]); w.y = cvtpk(v0[2], v0[3]); w.z = cvtpk(v1[0], v1[1]); w.w = cvtpk(v1[2], v1[3]); *(u32x4*)(op + bj * 128) = w; } }
    }
};

__device__ __forceinline__ void tr_item(const float* W, int N, bf16* WT, int ldt, int k0, int n0, int drow0, int dk0, LAS float* scr, int lane) {
#pragma unroll 8
    for (int i = 0; i < 32; ++i) { const int kk = 2 * i + (lane >> 5); scr[kk * 33 + (lane & 31)] = W[(size_t)(k0 + kk) * N + n0 + (lane & 31)]; }
    LDS_WAIT(); asm volatile("" ::: "memory");
    const int c = lane & 7;
#pragma unroll
    for (int j = 0; j < 4; ++j) { const int n = (lane >> 3) + 8 * j; const LAS float* s = scr + (8 * c) * 33 + n;
        u32x4 o; o.x = cvtpk(s[0 * 33], s[1 * 33]); o.y = cvtpk(s[2 * 33], s[3 * 33]); o.z = cvtpk(s[4 * 33], s[5 * 33]); o.w = cvtpk(s[6 * 33], s[7 * 33]);
        *(u32x4*)(WT + (size_t)(drow0 + n) * ldt + dk0 + k0 + 8 * c) = o; }
    LDS_WAIT(); asm volatile("" ::: "memory");
}
__device__ __forceinline__ void phaseA(const Frame& F, const Args& a) {
    unsigned char* ws = a.ws;
    if (F.vcu < 192) {
        const float* c = a.in[1]; const float* w_ada = a.in[2]; const float* b_ada = a.in[3]; float* mod = (float*)(ws + WS_MOD);
        LAS float* red = (LAS float*)(F.lds);
        const int col = F.vcu * 32 + (F.tid & 31), ks = F.tid >> 5;
        float a0 = 0.f, a1 = 0.f, a2 = 0.f, a3 = 0.f;
        for (int k = ks * 64; k < ks * 64 + 64; ++k) { const float w = w_ada[(size_t)k * 6144 + col];
            const float c0 = c[k], c1 = c[D + k], c2 = c[2 * D + k], c3 = c[3 * D + k];
            a0 += c0 * __builtin_amdgcn_rcpf(1.0f + __expf(-c0)) * w; a1 += c1 * __builtin_amdgcn_rcpf(1.0f + __expf(-c1)) * w;
            a2 += c2 * __builtin_amdgcn_rcpf(1.0f + __expf(-c2)) * w; a3 += c3 * __builtin_amdgcn_rcpf(1.0f + __expf(-c3)) * w; }
        red[(ks * 4 + 0) * 32 + (F.tid & 31)] = a0; red[(ks * 4 + 1) * 32 + (F.tid & 31)] = a1; red[(ks * 4 + 2) * 32 + (F.tid & 31)] = a2; red[(ks * 4 + 3) * 32 + (F.tid & 31)] = a3;
        __syncthreads();
        if (F.tid < 128) { const int b = F.tid >> 5, cc = F.tid & 31; float s = 0.f;
#pragma unroll
            for (int k = 0; k < 16; ++k) s += red[(k * 4 + b) * 32 + cc];
            mod[b * 6144 + F.vcu * 32 + cc] = s + b_ada[F.vcu * 32 + cc]; }
        __syncthreads();
    }
    LAS float* scr = (LAS float*)(F.lds + F.wave * 16384);
    const int gw = F.vcu * NWAVES + F.wave, NGW = F.G * NWAVES;
    bf16* W1T = (bf16*)(ws + WS_W1T); bf16* WBRT = (bf16*)(ws + WS_WBRT); bf16* WOUTT = (bf16*)(ws + WS_WOUTT); bf16* WGUT = (bf16*)(ws + WS_WGUT); bf16* WDNT = (bf16*)(ws + WS_WDNT);
    constexpr int I_IN = 16 * 80, I_GATE = 16 * 64, I_BR = 8 * 32, I_OUT = 16 * 32, I_GU = 16 * 64, I_DN = 16 * 32;
    constexpr int NITEMS = I_IN + I_GATE + 2 * I_BR + I_OUT + NEXP * (I_GU + I_DN);
    for (int it = gw; it < NITEMS; it += NGW) {
        int r = it;
        if (r < I_IN) { const int n0 = 32 * (r % 80); tr_item(a.in[6], INW, W1T, 1024, 64 * (r / 80), n0, n0, 0, scr, F.lane); continue; } r -= I_IN;
        if (r < I_GATE) { const int n0 = 32 * (r % 64); tr_item(a.in[14], 2048, W1T, 1024, 64 * (r / 64), n0, INW + n0, 0, scr, F.lane); continue; } r -= I_GATE;
        if (r < I_BR) { const int n0 = 32 * (r % 32); tr_item(a.in[12], 1024, WBRT, 1024, 64 * (r / 32), n0, n0, 0, scr, F.lane); continue; } r -= I_BR;
        if (r < I_BR) { const int n0 = 32 * (r % 32); tr_item(a.in[13], 1024, WBRT, 1024, 64 * (r / 32), n0, n0, 512, scr, F.lane); continue; } r -= I_BR;
        if (r < I_OUT) { const int n0 = 32 * (r % 32); tr_item(a.in[16], 1024, WOUTT, 1024, 64 * (r / 32), n0, n0, 0, scr, F.lane); continue; } r -= I_OUT;
        if (r < NEXP * I_GU) { const int e = r / I_GU, q = r % I_GU, kb = q / 64, nb = q % 64, n0 = 32 * nb;
            const int m0 = n0 & 1023, drow = 256 * (m0 >> 7) + (m0 & 127) + (n0 >= 1024 ? 128 : 0);
            tr_item(a.in[21] + (size_t)e * D * 2048, 2048, WGUT + (size_t)e * 2048 * 1024, 1024, 64 * kb, n0, drow, 0, scr, F.lane); continue; } r -= NEXP * I_GU;
        { const int e = r / I_DN, q = r % I_DN, n0 = 32 * (q % 32); tr_item(a.in[23] + (size_t)e * D * D, 1024, WDNT + (size_t)e * 1024 * 1024, 1024, 64 * (q / 32), n0, n0, 0, scr, F.lane); }
    }
}
__device__ __forceinline__ void phaseB(const Frame& F, const Args& a) {
    const float* x = a.in[0]; const float* g = a.in[4]; const float* mod = (const float*)(a.ws + WS_MOD); bf16* xn = (bf16*)(a.ws + WS_XN);
    const int gw = F.vcu * NWAVES + F.wave, NGW = F.G * NWAVES;
    for (int row0 = gw * 4; row0 < NTOK; row0 += NGW * 4) {
        f32x4 v[4][4];
#pragma unroll
        for (int rr = 0; rr < 4; ++rr)
#pragma unroll
            for (int j = 0; j < 4; ++j) v[rr][j] = *((const f32x4*)(x + (size_t)(row0 + rr) * D) + F.lane + 64 * j);
        const int b = row0 / SEQ; const float* mb = mod + b * 6144;
#pragma unroll
        for (int rr = 0; rr < 4; ++rr) {
            float ss = 0.f;
#pragma unroll
            for (int j = 0; j < 4; ++j) ss += (v[rr][j].x * v[rr][j].x + v[rr][j].y * v[rr][j].y) + (v[rr][j].z * v[rr][j].z + v[rr][j].w * v[rr][j].w);
            const float rstd = rsqrtf(wave_sum(ss) * (1.0f / D) + EPS);
            u32x2* o8 = (u32x2*)(xn + (size_t)(row0 + rr) * D) + F.lane;
#pragma unroll
            for (int j = 0; j < 4; ++j) { const int c0 = (F.lane + 64 * j) * 4;
                const f32x4 gg = *(const f32x4*)(g + c0), sc = *(const f32x4*)(mb + SC1 + c0), sh = *(const f32x4*)(mb + SH1 + c0);
                const f32x4 h = v[rr][j] * rstd * gg * (sc + 1.0f) + sh;
                u32x2 w; w.x = cvtpk(h[0], h[1]); w.y = cvtpk(h[2], h[3]); o8[64 * j] = w; }
        }
    }
}

constexpr int SGU_STRIDE = 1088;
__device__ __forceinline__ s16x4 vtr(const LAS unsigned char* p) { typedef short v4i16_t __attribute__((ext_vector_type(4))); return __builtin_bit_cast(s16x4, __builtin_amdgcn_ds_read_tr16_b64_v4i16((LAS v4i16_t*)p)); }
__device__ __forceinline__ void sgu_unit(const Frame& F, const Args& a, int b, int blk) {
    const bf16* VG = (const bf16*)(a.ws + WS_VG); const bf16* U = (const bf16*)(a.ws + WS_U); bf16* YAB = (bf16*)(a.ws + WS_YAB);
    const float* ln_g = a.in[8]; const float* ln_b = a.in[9]; const float* w_s = a.in[10]; const float* b_s = a.in[11];
    const int tok0 = b * SEQ + blk * SGB, lane = F.lane;
    {
        f32x4 g0 = *(const f32x4*)(ln_g + lane * 8), g1 = *(const f32x4*)(ln_g + lane * 8 + 4), b0 = *(const f32x4*)(ln_b + lane * 8), b1 = *(const f32x4*)(ln_b + lane * 8 + 4);
#pragma unroll 4
        for (int rr = 0; rr < 16; ++rr) { const int row = F.wave * 16 + rr;
            const u32x4 w = *(const u32x4*)(VG + (size_t)(tok0 + row) * 512 + lane * 8);
            f32x4 v0 = {bflo(w.x), bfhi(w.x), bflo(w.y), bfhi(w.y)}, v1 = {bflo(w.z), bfhi(w.z), bflo(w.w), bfhi(w.w)};
            const float mu = wave_sum((v0[0] + v0[1]) + (v0[2] + v0[3]) + (v1[0] + v1[1]) + (v1[2] + v1[3])) * (1.0f / 512.0f);
            v0 -= mu; v1 -= mu;
            const float var = wave_sum((v0[0] * v0[0] + v0[1] * v0[1]) + (v0[2] * v0[2] + v0[3] * v0[3]) + (v1[0] * v1[0] + v1[1] * v1[1]) + (v1[2] * v1[2] + v1[3] * v1[3])) * (1.0f / 512.0f);
            const float rstd = rsqrtf(var + EPS);
            v0 = v0 * rstd * g0 + b0; v1 = v1 * rstd * g1 + b1;
            u32x4 o; o.x = cvtpk(v0[0], v0[1]); o.y = cvtpk(v0[2], v0[3]); o.z = cvtpk(v1[0], v1[1]); o.w = cvtpk(v1[2], v1[3]);
            *(LAS u32x4*)(F.lds + row * SGU_STRIDE + lane * 16) = o; }
    }
    __syncthreads();
    {
        const int g = F.wave, r32 = lane & 31, hi = lane >> 5, i16 = lane & 15, g16 = (lane >> 4) & 1;
        const LAS unsigned char* vb = F.lds + (8 * hi + (i16 >> 2)) * SGU_STRIDE + (g * 64 + 16 * g16 + 4 * (i16 & 3)) * 2;
#pragma unroll 1
        for (int tb = 0; tb < 4; ++tb) {
            const int t = 32 * tb + r32; const float* wrow = w_s + ((size_t)g * 128 + t) * 128;
            f32x16 a0, a1;
#pragma unroll
            for (int r = 0; r < 16; ++r) { a0[r] = 0.f; a1[r] = 0.f; }
#pragma unroll 1
            for (int ks = 0; ks < 2 * tb + 2; ++ks) {
                const int s0 = 16 * ks + 8 * hi;
                const f32x4 w0 = *(const f32x4*)(wrow + s0), w1 = *(const f32x4*)(wrow + s0 + 4);
                float wv[8] = {w0[0], w0[1], w0[2], w0[3], w1[0], w1[1], w1[2], w1[3]};
#pragma unroll
                for (int j = 0; j < 8; ++j) wv[j] = (s0 + j <= t) ? wv[j] : 0.f;
                u32x4 bw; bw.x = cvtpk(wv[0], wv[1]); bw.y = cvtpk(wv[2], wv[3]); bw.z = cvtpk(wv[4], wv[5]); bw.w = cvtpk(wv[6], wv[7]);
                const bf16x8 bfrag = __builtin_bit_cast(bf16x8, bw);
                const LAS unsigned char* p = vb + ks * 16 * SGU_STRIDE;
                const s16x4 l0 = vtr(p), h0 = vtr(p + 4 * SGU_STRIDE), l1 = vtr(p + 64), h1 = vtr(p + 4 * SGU_STRIDE + 64);
                const bf16x8 A0 = {l0[0], l0[1], l0[2], l0[3], h0[0], h0[1], h0[2], h0[3]}, A1 = {l1[0], l1[1], l1[2], l1[3], h1[0], h1[1], h1[2], h1[3]};
                a0 = __builtin_amdgcn_mfma_f32_32x32x16_bf16(A0, bfrag, a0, 0, 0, 0);
                a1 = __builtin_amdgcn_mfma_f32_32x32x16_bf16(A1, bfrag, a1, 0, 0, 0);
            }
            const float bs = b_s[g * 128 + t];
            const bf16* up = U + (size_t)(tok0 + t) * 512 + g * 64 + 4 * hi; bf16* op = YAB + (size_t)(tok0 + t) * 1024 + 512 + g * 64 + 4 * hi;
#pragma unroll
            for (int gg = 0; gg < 4; ++gg) {
                const u32x2 u0 = *(const u32x2*)(up + 8 * gg), u1 = *(const u32x2*)(up + 32 + 8 * gg);
                u32x2 o0, o1;
                o0.x = cvtpk(bflo(u0.x) * (a0[4 * gg] + bs), bfhi(u0.x) * (a0[4 * gg + 1] + bs)); o0.y = cvtpk(bflo(u0.y) * (a0[4 * gg + 2] + bs), bfhi(u0.y) * (a0[4 * gg + 3] + bs));
                o1.x = cvtpk(bflo(u1.x) * (a1[4 * gg] + bs), bfhi(u1.x) * (a1[4 * gg + 1] + bs)); o1.y = cvtpk(bflo(u1.y) * (a1[4 * gg + 2] + bs), bfhi(u1.y) * (a1[4 * gg + 3] + bs));
                *(u32x2*)(op + 8 * gg) = o0; *(u32x2*)(op + 32 + 8 * gg) = o1; }
        }
    }
    __syncthreads();
}

__device__ __forceinline__ void attn_task(const bf16* __restrict__ Q, const bf16* __restrict__ Kb, const bf16* __restrict__ Vb, bf16* YAB, LAS unsigned char* vt, const LAS float* bt,
                                          int b, int c, int h, int half, int lane) {
    const int r32 = lane & 31, hi = lane >> 5, i16 = lane & 15, g16 = (lane >> 4) & 1;
    const int tok0 = b * SEQ + c * CHUNK, qi = half * 32 + r32, qtok = tok0 + qi;
    bf16x8 qf[4];
#pragma unroll
    for (int s = 0; s < 4; ++s) qf[s] = *(const bf16x8*)(Q + (size_t)qtok * 512 + h * 64 + 16 * s + 8 * hi);
    f32x16 o0, o1;
#pragma unroll
    for (int r = 0; r < 16; ++r) { o0[r] = 0.f; o1[r] = 0.f; }
    float m = -1e30f, l = 0.f;
    const int j0 = (c < NLEFT) ? (NLEFT - c) : 0;
    const int fb = (i16 >> 3) & 1;
    LAS unsigned char* vw = vt + (lane >> 3) * 128 + (((lane & 7) ^ (((lane >> 4) & 1) * 4)) * 16);
    const LAS unsigned char* vr0 = vt + (4 * hi + (i16 >> 2)) * 128 + ((4 * (0 ^ fb) + 2 * g16 + ((i16 & 3) >> 1)) * 16) + (i16 & 1) * 8;
    const LAS unsigned char* vr1 = vt + (4 * hi + (i16 >> 2)) * 128 + ((4 * (1 ^ fb) + 2 * g16 + ((i16 & 3) >> 1)) * 16) + (i16 & 1) * 8;
    const size_t hoff = (size_t)h * 64;
    bf16x8 kf[2][4]; u32x4 vn[8];
    {
        const bf16* kp = Kb + (size_t)(tok0 + (j0 - NLEFT) * CHUNK) * 512 + hoff; const bf16* vp = Vb + (size_t)(tok0 + (j0 - NLEFT) * CHUNK) * 512 + hoff;
#pragma unroll
        for (int blk = 0; blk < 2; ++blk)
#pragma unroll
            for (int s = 0; s < 4; ++s) kf[blk][s] = *(const bf16x8*)(kp + (size_t)(32 * blk + r32) * 512 + 16 * s + 8 * hi);
#pragma unroll
        for (int p = 0; p < 8; ++p) vn[p] = *(const u32x4*)(vp + (size_t)(8 * p + (lane >> 3)) * 512 + (lane & 7) * 8);
#pragma unroll
        for (int p = 0; p < 8; ++p) *(LAS u32x4*)(vw + p * 1024) = vn[p];
    }
#pragma unroll 1
    for (int j = j0; j < 9; ++j) {
        const bool more = (j + 1 < 9);
        const bf16* kp = Kb + (size_t)(tok0 + (j + 1 - NLEFT) * CHUNK) * 512 + hoff; const bf16* vp = Vb + (size_t)(tok0 + (j + 1 - NLEFT) * CHUNK) * 512 + hoff;
        if (more) {
#pragma unroll
            for (int p = 0; p < 8; ++p) vn[p] = *(const u32x4*)(vp + (size_t)(8 * p + (lane >> 3)) * 512 + (lane & 7) * 8);
        }
        f32x16 p0, p1;
#pragma unroll
        for (int r = 0; r < 16; ++r) { p0[r] = 0.f; p1[r] = 0.f; }
#pragma unroll
        for (int s = 0; s < 4; ++s) { p0 = __builtin_amdgcn_mfma_f32_32x32x16_bf16(kf[0][s], qf[s], p0, 0, 0, 0); p1 = __builtin_amdgcn_mfma_f32_32x32x16_bf16(kf[1][s], qf[s], p1, 0, 0, 0); }
        if (more) {
#pragma unroll
            for (int blk = 0; blk < 2; ++blk)
#pragma unroll
                for (int s = 0; s < 4; ++s) kf[blk][s] = *(const bf16x8*)(kp + (size_t)(32 * blk + r32) * 512 + 16 * s + 8 * hi);
        }
        if (j >= 6) {
            const int base = 640 + qi - 64 * j - 4 * hi;
#pragma unroll
            for (int r = 0; r < 16; ++r) { const int kk = (r & 3) + 8 * (r >> 2); int i0 = base - kk, i1 = base - 32 - kk; i0 = i0 > 256 ? 256 : i0; i1 = i1 > 256 ? 256 : i1; p0[r] += bt[i0]; p1[r] += bt[i1]; }
        }
        float tm = fmaxf(p0[0], p1[0]);
#pragma unroll
        for (int r = 1; r < 16; ++r) tm = fmaxf(tm, fmaxf(p0[r], p1[r]));
        tm = fmaxf(tm, __shfl_xor(tm, 32));
        const float mn = fmaxf(m, tm), alpha = __builtin_amdgcn_exp2f(m - mn); m = mn;
        float ps = 0.f;
#pragma unroll
        for (int r = 0; r < 16; ++r) { p0[r] = __builtin_amdgcn_exp2f(p0[r] - mn); p1[r] = __builtin_amdgcn_exp2f(p1[r] - mn); ps += p0[r] + p1[r]; }
        l = l * alpha + ps;
#pragma unroll
        for (int r = 0; r < 16; ++r) { o0[r] *= alpha; o1[r] *= alpha; }
        bf16x8 pb[2][2];
#pragma unroll
        for (int s = 0; s < 2; ++s) {
            u32x4 w0; w0.x = cvtpk(p0[8 * s], p0[8 * s + 1]); w0.y = cvtpk(p0[8 * s + 2], p0[8 * s + 3]); w0.z = cvtpk(p0[8 * s + 4], p0[8 * s + 5]); w0.w = cvtpk(p0[8 * s + 6], p0[8 * s + 7]);
            u32x4 w1; w1.x = cvtpk(p1[8 * s], p1[8 * s + 1]); w1.y = cvtpk(p1[8 * s + 2], p1[8 * s + 3]); w1.z = cvtpk(p1[8 * s + 4], p1[8 * s + 5]); w1.w = cvtpk(p1[8 * s + 6], p1[8 * s + 7]);
            pb[0][s] = __builtin_bit_cast(bf16x8, w0); pb[1][s] = __builtin_bit_cast(bf16x8, w1); }
#pragma unroll
        for (int blk = 0; blk < 2; ++blk)
#pragma unroll
            for (int s = 0; s < 2; ++s) {
                const int ko = (32 * blk + 16 * s) * 128;
                const s16x4 l0 = vtr(vr0 + ko), h0 = vtr(vr0 + ko + 1024), l1 = vtr(vr1 + ko), h1 = vtr(vr1 + ko + 1024);
                const bf16x8 A0 = {l0[0], l0[1], l0[2], l0[3], h0[0], h0[1], h0[2], h0[3]}, A1 = {l1[0], l1[1], l1[2], l1[3], h1[0], h1[1], h1[2], h1[3]};
                o0 = __builtin_amdgcn_mfma_f32_32x32x16_bf16(A0, pb[blk][s], o0, 0, 0, 0);
                o1 = __builtin_amdgcn_mfma_f32_32x32x16_bf16(A1, pb[blk][s], o1, 0, 0, 0);
            }
        if (more) {
#pragma unroll
            for (int p = 0; p < 8; ++p) *(LAS u32x4*)(vw + p * 1024) = vn[p];
        }
    }
    l += __shfl_xor(l, 32);
    const float inv = __builtin_amdgcn_rcpf(l);
    bf16* op = YAB + (size_t)qtok * 1024 + hoff + 4 * hi;
#pragma unroll
    for (int gg = 0; gg < 4; ++gg) {
        u32x2 w0, w1;
        w0.x = cvtpk(o0[4 * gg] * inv, o0[4 * gg + 1] * inv); w0.y = cvtpk(o0[4 * gg + 2] * inv, o0[4 * gg + 3] * inv);
        w1.x = cvtpk(o1[4 * gg] * inv, o1[4 * gg + 1] * inv); w1.y = cvtpk(o1[4 * gg + 2] * inv, o1[4 * gg + 3] * inv);
        *(u32x2*)(op + 8 * gg) = w0; *(u32x2*)(op + 32 + 8 * gg) = w1; }
}
__device__ __forceinline__ void phaseD(const Frame& F, const Args& a) {
    for (int unit = F.vcu; unit < NB * (SEQ / SGB); unit += F.G) sgu_unit(F, a, unit / (SEQ / SGB), unit % (SEQ / SGB));
    const bf16* Q = (const bf16*)(a.ws + WS_Q); const bf16* Kb = (const bf16*)(a.ws + WS_K); const bf16* Vb = (const bf16*)(a.ws + WS_V); bf16* YAB = (bf16*)(a.ws + WS_YAB);
    LAS unsigned char* vt = F.lds + F.wave * 8192; LAS float* bt = (LAS float*)(F.lds + 65536 + F.wave * 1088);
    const float* rb = a.in[7] + F.wave * NREL; const float b256 = rb[256];
    for (int i = F.lane; i < NREL; i += 64) bt[i] = (rb[i] - b256) * LOG2E;
    LDS_WAIT();
    const int NCH = NB * (SEQ / CHUNK);
    for (int v = F.vcu; v < NCH / 2; v += F.G) {
#pragma unroll 1
        for (int k = 0; k < 4; ++k) { const int gc = (k < 2) ? v : (NCH - 1 - v); attn_task(Q, Kb, Vb, YAB, vt, bt, gc / (SEQ / CHUNK), gc % (SEQ / CHUNK), F.wave, k & 1, F.lane); }
    }
}

constexpr int G_HT_STRIDE = 2064;
__device__ __forceinline__ void phaseG(const Frame& F, const Args& a) {
    const float* x = a.in[0]; const bf16* Y1 = (const bf16*)(a.ws + WS_Y1); const float* mod = (const float*)(a.ws + WS_MOD); const float* g_post_mix = a.in[5]; const float* g_pre_ffn = a.in[17];
    const float* w_router = a.in[19]; const float* b_router = a.in[20]; float* X1 = a.out; bf16* XN2 = (bf16*)(a.ws + WS_XN);
    int* tope = (int*)(a.ws + WS_TOPE); float* topg = (float*)(a.ws + WS_TOPG); int* list = (int*)(a.ws + WS_LIST); unsigned* cnt = F.ctl + CW_CNT;
    LAS unsigned char* HT = F.lds;
    LAS float* PL = (LAS float*)(F.lds + 33792);
    LAS float* LG = PL + 8 * 32 * 16;
    LAS float* TV = LG + 512;
    LAS unsigned* LC = (LAS unsigned*)(TV + 64);
    LAS unsigned* AS = LC + 64;
    const int tid = F.tid, lane = F.lane, wave = F.wave, kq = lane >> 4, i16 = lane & 15;
    if (tid < 64) LC[tid] = 0u;
    bf16x8 whi[2][4], wlo[2][4];
#pragma unroll
    for (int et = 0; et < 2; ++et)
#pragma unroll
        for (int ks = 0; ks < 4; ++ks) { unsigned h[4], l[4];
#pragma unroll
            for (int jj = 0; jj < 4; ++jj) { const int k = 128 * wave + 32 * ks + 8 * kq + 2 * jj;
                const float w0 = w_router[(size_t)k * NEXP + et * 16 + i16], w1 = w_router[(size_t)(k + 1) * NEXP + et * 16 + i16];
                const unsigned hh = cvtpk(w0, w1); h[jj] = hh; l[jj] = cvtpk(w0 - bflo(hh), w1 - bfhi(hh)); }
            u32x4 hv = {h[0], h[1], h[2], h[3]}, lv = {l[0], l[1], l[2], l[3]};
            whi[et][ks] = __builtin_bit_cast(bf16x8, hv); wlo[et][ks] = __builtin_bit_cast(bf16x8, lv); }
    __syncthreads();
    int tl = 0;
    for (int T = F.vcu; T < NTOK / 16; T += F.G, ++tl) {
        const int b = (16 * T) / SEQ; const float* mb = mod + b * 6144; const int rbase = 16 * T + 2 * wave;
        f32x4 xv[2][4]; u32x2 yr[2][4];
#pragma unroll
        for (int rr = 0; rr < 2; ++rr)
#pragma unroll
            for (int j = 0; j < 4; ++j) { const int c0 = (lane + 64 * j) * 4; xv[rr][j] = *(const f32x4*)(x + (size_t)(rbase + rr) * D + c0); yr[rr][j] = *(const u32x2*)(Y1 + (size_t)(rbase + rr) * D + c0); }
#pragma unroll
        for (int rr = 0; rr < 2; ++rr) {
            const int row = rbase + rr; f32x4 yv[4]; float ss = 0.f;
#pragma unroll
            for (int j = 0; j < 4; ++j) { yv[j] = (f32x4){bflo(yr[rr][j].x), bfhi(yr[rr][j].x), bflo(yr[rr][j].y), bfhi(yr[rr][j].y)}; ss += (yv[j][0] * yv[j][0] + yv[j][1] * yv[j][1]) + (yv[j][2] * yv[j][2] + yv[j][3] * yv[j][3]); }
            const float rstd = rsqrtf(wave_sum(ss) * (1.0f / D) + EPS); float s2 = 0.f;
#pragma unroll
            for (int j = 0; j < 4; ++j) { const int c0 = (lane + 64 * j) * 4;
                const f32x4 gp = *(const f32x4*)(g_post_mix + c0), gt = *(const f32x4*)(mb + GT1 + c0);
                xv[rr][j] = xv[rr][j] + gt * (yv[j] * rstd * gp);
                *(f32x4*)(X1 + (size_t)row * D + c0) = xv[rr][j];
                s2 += (xv[rr][j][0] * xv[rr][j][0] + xv[rr][j][1] * xv[rr][j][1]) + (xv[rr][j][2] * xv[rr][j][2] + xv[rr][j][3] * xv[rr][j][3]); }
            const float rstd2 = rsqrtf(wave_sum(s2) * (1.0f / D) + EPS);
#pragma unroll
            for (int j = 0; j < 4; ++j) { const int c0 = (lane + 64 * j) * 4;
                const f32x4 gf = *(const f32x4*)(g_pre_ffn + c0), sc = *(const f32x4*)(mb + SC2 + c0), sh = *(const f32x4*)(mb + SH2 + c0);
                const f32x4 h = xv[rr][j] * rstd2 * gf * (sc + 1.0f) + sh;
                u32x2 w; w.x = cvtpk(h[0], h[1]); w.y = cvtpk(h[2], h[3]); *(u32x2*)(XN2 + (size_t)row * D + c0) = w;
                *(LAS u32x2*)(HT + (2 * wave + rr) * G_HT_STRIDE + c0 * 2) = w; }
        }
        __syncthreads();
        {
            f32x4 acc0 = {0.f, 0.f, 0.f, 0.f}, acc1 = {0.f, 0.f, 0.f, 0.f};
#pragma unroll
            for (int ks = 0; ks < 4; ++ks) { const bf16x8 hb = *(const LAS bf16x8*)(HT + i16 * G_HT_STRIDE + (128 * wave + 32 * ks + 8 * kq) * 2);
                acc0 = __builtin_amdgcn_mfma_f32_16x16x32_bf16(whi[0][ks], hb, acc0, 0, 0, 0); acc0 = __builtin_amdgcn_mfma_f32_16x16x32_bf16(wlo[0][ks], hb, acc0, 0, 0, 0);
                acc1 = __builtin_amdgcn_mfma_f32_16x16x32_bf16(whi[1][ks], hb, acc1, 0, 0, 0); acc1 = __builtin_amdgcn_mfma_f32_16x16x32_bf16(wlo[1][ks], hb, acc1, 0, 0, 0); }
#pragma unroll
            for (int r = 0; r < 4; ++r) { PL[(wave * 32 + 4 * kq + r) * 16 + i16] = acc0[r]; PL[(wave * 32 + 16 + 4 * kq + r) * 16 + i16] = acc1[r]; }
        }
        __syncthreads();
        const int row = tid & 15, e = tid >> 4;
        float lg = b_router[e];
#pragma unroll
        for (int w = 0; w < 8; ++w) lg += PL[(w * 32 + e) * 16 + row];
        LG[e * 16 + row] = lg;
        __syncthreads();
        int rank = 0;
#pragma unroll
        for (int e2 = 0; e2 < 32; ++e2) { const float o = LG[e2 * 16 + row]; rank += (o > lg || (o == lg && e2 < e)) ? 1 : 0; }
        if (rank < 4) TV[row * 4 + rank] = lg;
        __syncthreads();
        if (rank < 4) {
            const float m = TV[row * 4], den = 1.0f + __expf(TV[row * 4 + 1] - m) + __expf(TV[row * 4 + 2] - m) + __expf(TV[row * 4 + 3] - m);
            const int slot = (16 * T + row) * 4 + rank; tope[slot] = e; topg[slot] = __expf(lg - m) / den;
            const unsigned lp = __hip_atomic_fetch_add(LC + e, 1u, __ATOMIC_RELAXED, __HIP_MEMORY_SCOPE_WORKGROUP);
            if (tl < 16) AS[tl * 64 + row * 4 + rank] = (unsigned)e | (lp << 8);
        }
    }
    __syncthreads();
    if (tid < NEXP) LC[32 + tid] = atomicAdd(&cnt[tid], LC[tid]);
    __syncthreads();
    for (int i = tid; i < tl * 64; i += NWAVES * 64) { const unsigned as = AS[i]; const int e = as & 255, lp = as >> 8; const int T = F.vcu + (i >> 6) * F.G;
        list[(size_t)e * NTOK + LC[32 + e] + lp] = (16 * T + ((i & 63) >> 2)) * 4 + (i & 3); }
}
__device__ __forceinline__ int moe_tables(const Frame& F) {
    __syncthreads();
    if (F.tid < NEXP) F.MISC[40 + F.tid] = __hip_atomic_load(F.ctl + CW_CNT + F.tid, __ATOMIC_RELAXED, __HIP_MEMORY_SCOPE_AGENT);
    __syncthreads();
    if (F.tid == 0) { unsigned s = 0; for (int e = 0; e < NEXP; ++e) { F.MISC[e] = s; s += (F.MISC[40 + e] + 255u) >> 8; } F.MISC[32] = s; }
    __syncthreads();
    return (int)F.MISC[32];
}
__device__ __forceinline__ void phaseJ(const Frame& F, const Args& a) {
    const bf16* Y2 = (const bf16*)(a.ws + WS_Y2); const float* mod = (const float*)(a.ws + WS_MOD); const float* gpf = a.in[18]; float* out = a.out;
    const int lane = F.lane, gw = F.vcu * NWAVES + F.wave, NGW = F.G * NWAVES;
    for (int row0 = gw * 2; row0 < NTOK; row0 += NGW * 2) {
        const int b = row0 / SEQ; const float* mb = mod + b * 6144;
        u32x2 yy[2][4][4]; f32x4 xx[2][4];
#pragma unroll
        for (int rr = 0; rr < 2; ++rr)
#pragma unroll
            for (int j = 0; j < 4; ++j) { const int c0 = (lane + 64 * j) * 4;
#pragma unroll
                for (int k = 0; k < 4; ++k) yy[rr][j][k] = *(const u32x2*)(Y2 + ((size_t)(row0 + rr) * 4 + k) * D + c0);
                xx[rr][j] = *(const f32x4*)(out + (size_t)(row0 + rr) * D + c0); }
#pragma unroll
        for (int rr = 0; rr < 2; ++rr) {
            f32x4 yv[4]; float ss = 0.f;
#pragma unroll
            for (int j = 0; j < 4; ++j) { f32x4 s = {0.f, 0.f, 0.f, 0.f};
#pragma unroll
                for (int k = 0; k < 4; ++k) s += (f32x4){bflo(yy[rr][j][k].x), bfhi(yy[rr][j][k].x), bflo(yy[rr][j][k].y), bfhi(yy[rr][j][k].y)};
                yv[j] = s; ss += (s[0] * s[0] + s[1] * s[1]) + (s[2] * s[2] + s[3] * s[3]); }
            const float rstd = rsqrtf(wave_sum(ss) * (1.0f / D) + EPS);
#pragma unroll
            for (int j = 0; j < 4; ++j) { const int c0 = (lane + 64 * j) * 4;
                const f32x4 g = *(const f32x4*)(gpf + c0), gt = *(const f32x4*)(mb + GT2 + c0);
                *(f32x4*)(out + (size_t)(row0 + rr) * D + c0) = xx[rr][j] + gt * (yv[j] * rstd * g); }
        }
    }
}

constexpr int N_PHASES = 10;
__global__ void __launch_bounds__(NWAVES * 64, 2) mega_fwd(Args args) {
    extern __shared__ __attribute__((aligned(16))) unsigned char lds_raw[];
    Frame F;
    F.lds = (LAS unsigned char*)lds_raw; F.MISC = (volatile LAS unsigned*)(F.lds + MISC_OFF);
    F.tid = threadIdx.x; F.lane = F.tid & 63; F.wave = __builtin_amdgcn_readfirstlane(F.tid >> 6);
    F.G = gridDim.x; { const int bx = blockIdx.x; F.vcu = (F.G % 8 == 0) ? (bx % 8) * (F.G / 8) + bx / 8 : bx; }
    F.ctl = (unsigned*)(args.ws + WS_CTL);
    for (int u = F.tid; u < 128; u += NWAVES * 64) F.MISC[u] = 0u;
    __syncthreads();
    const int lo = args.ph_lo, hi = args.ph_hi;
    XcdBarrier bar; bar.bar = F.ctl + CW_BAR; bar.x = 0; bar.st = F.MISC + 80;
    if (hi - lo > 1) bar = xcd_barrier_post(F.ctl + CW_BAR, F.MISC + 80);
#ifndef PH_COMPILE_MASK
#define PH_COMPILE_MASK 0x3ff
#endif
#define IN(k) (((PH_COMPILE_MASK >> (k)) & 1) && lo <= (k) && (k) < hi)
#define SEAM(k) do { if (IN(k) && IN((k) + 1)) xcd_barrier(bar); } while (0)
    unsigned char* ws = args.ws;
    bf16 *XN = (bf16*)(ws + WS_XN), *Qb = (bf16*)(ws + WS_Q), *Kb = (bf16*)(ws + WS_K), *Vb = (bf16*)(ws + WS_V), *Ub = (bf16*)(ws + WS_U), *VG = (bf16*)(ws + WS_VG);
    bf16 *GT = (bf16*)(ws + WS_GT), *YAB = (bf16*)(ws + WS_YAB), *MRG = (bf16*)(ws + WS_MRG), *Y1 = (bf16*)(ws + WS_Y1), *ACT = (bf16*)(ws + WS_ACT), *Y2 = (bf16*)(ws + WS_Y2);

    if (IN(0)) { phaseA(F, args); } SEAM(0);
    if (IN(1)) { phaseB(F, args); } SEAM(1);
    if (IN(2)) {
        SchedStatic S{(const char*)XN, (const char*)(ws + WS_W1T), NTOK / 256, 4608 / 256, F.G, (int)blockIdx.x, (size_t)256 * 1024 * 2, (size_t)256 * 1024 * 2};
        EpiG1 E{Qb, Kb, Vb, Ub, VG, GT, args.in[15]};
        pg8::gemm_phase<EpiG1, SchedStatic>(F.lds + RING_OFF, S, E, 1024, 1024, 16);
    } SEAM(2);
    if (IN(3)) { phaseD(F, args); } SEAM(3);
    if (IN(4)) {
        SchedSplit2 S{(const char*)YAB, (const char*)(ws + WS_WBRT), NTOK / 256, 4, F.G, (int)blockIdx.x, (size_t)256 * 1024 * 2, (size_t)256 * 1024 * 2, (size_t)512 * 2};
        EpiG2 E{GT, MRG};
        pg8::gemm_phase<EpiG2, SchedSplit2>(F.lds + RING_OFF, S, E, 1024, 1024, 8);
    } SEAM(4);
    if (IN(5)) {
        SchedStatic S{(const char*)MRG, (const char*)(ws + WS_WOUTT), NTOK / 256, 4, F.G, (int)blockIdx.x, (size_t)256 * 1024 * 2, (size_t)256 * 1024 * 2};
        EpiPlain E{Y1};
        pg8::gemm_phase<EpiPlain, SchedStatic>(F.lds + RING_OFF, S, E, 1024, 1024, 16);
    } SEAM(5);
    if (IN(6)) { phaseG(F, args); } SEAM(6);
    if (IN(7)) {
        const int nrb = moe_tables(F);
        const int* list = (const int*)(ws + WS_LIST);
        typedef SchedMoe<8, true> SM;
        SM S{(const char*)XN, (const char*)(ws + WS_WGUT), F.MISC, (const LAS unsigned*)(F.lds + GTAB_OFF), (int)blockIdx.x, F.G, nrb, (size_t)2048 * 1024 * 2, (size_t)256 * 1024 * 2};
        { Unit u; LAS unsigned* gt = (LAS unsigned*)(F.lds + GTAB_OFF);
          for (int k = 0; k < GTAB_UNITS && S.next(k, u); ++k) { const int e = u.aux, j256 = (u.pm - (int)F.MISC[e]) * 256, ecnt = (int)F.MISC[40 + e];
              for (int r = F.tid; r < 256; r += NWAVES * 64) { const int pos = j256 + r; int tok = 0; if (pos < ecnt) tok = list[(size_t)e * NTOK + pos] >> 2; gt[k * 256 + r] = (unsigned)tok * 2048u; } } }
        __syncthreads();
        EpiAct E{args.in[22], ACT};
        pg8::gemm_phase<EpiAct, SM>(F.lds + RING_OFF, S, E, 1024, 1024, 16);
    } SEAM(7);
    if (IN(8)) {
        const int nrb = moe_tables(F);
        typedef SchedMoe<4, false> SM;
        SM S{(const char*)ACT, (const char*)(ws + WS_WDNT), F.MISC, (const LAS unsigned*)(F.lds + GTAB_OFF), (int)blockIdx.x, F.G, nrb, (size_t)1024 * 1024 * 2, (size_t)256 * 1024 * 2};
        EpiDown E{args.in[24], (const int*)(ws + WS_LIST), (const float*)(ws + WS_TOPG), F.MISC, Y2};
        pg8::gemm_phase<EpiDown, SM>(F.lds + RING_OFF, S, E, 1024, 1024, 16);
    } SEAM(8);
    if (IN(9)) { phaseJ(F, args); }
#undef IN
#undef SEAM
}
#ifndef MEGA_MASK
#define MEGA_MASK 0x3ff
#endif
#ifndef REP_MASK
#define REP_MASK 0
#endif
#ifndef ONE_LAUNCH
#define ONE_LAUNCH 1
#endif
extern "C" void kernel_launch(void* const* d_in, const int* in_sizes, int n_in, void* d_out, int out_size, void* d_ws, size_t ws_size, hipStream_t stream) {
    if (n_in != 25 || in_sizes[0] != NTOK * D || out_size != NTOK * D || ws_size < WS_END) { fprintf(stderr, "kernel_launch: unexpected shapes (n_in %d in0 %d out %d ws %zu)\n", n_in, n_in > 0 ? in_sizes[0] : -1, out_size, ws_size); return; }
    static int grid = 0;
    if (grid == 0) {
        int dev = 0, cus = 0, per_cu = 0;
        if (hipGetDevice(&dev) != hipSuccess || hipDeviceGetAttribute(&cus, hipDeviceAttributeMultiprocessorCount, dev) != hipSuccess) { fprintf(stderr, "kernel_launch: device query failed\n"); grid = -1; return; }
        if (hipFuncSetAttribute((const void*)mega_fwd, hipFuncAttributeMaxDynamicSharedMemorySize, LDS_BYTES) != hipSuccess) { fprintf(stderr, "kernel_launch: hipFuncSetAttribute failed\n"); grid = -1; return; }
        if (hipOccupancyMaxActiveBlocksPerMultiprocessor(&per_cu, (const void*)mega_fwd, NWAVES * 64, LDS_BYTES) != hipSuccess || per_cu < 1) { fprintf(stderr, "kernel_launch: occupancy query says %d\n", per_cu); }
        (void)hipGetLastError();
        grid = cus;
    }
    if (grid < 0) return;
    const float* x = (const float*)d_in[0]; const float* c = (const float*)d_in[1]; const float* w_ada = (const float*)d_in[2]; const float* b_ada = (const float*)d_in[3];
    const float* g_pre_mix = (const float*)d_in[4]; const float* g_post_mix = (const float*)d_in[5]; const float* w_in = (const float*)d_in[6]; const float* rel_bias = (const float*)d_in[7];
    const float* sgu_ln_g = (const float*)d_in[8]; const float* sgu_ln_b = (const float*)d_in[9]; const float* w_spatial = (const float*)d_in[10]; const float* b_spatial = (const float*)d_in[11];
    const float* w_branch_a = (const float*)d_in[12]; const float* w_branch_b = (const float*)d_in[13]; const float* w_gate = (const float*)d_in[14]; const float* b_gate = (const float*)d_in[15];
    const float* w_out = (const float*)d_in[16]; const float* g_pre_ffn = (const float*)d_in[17]; const float* g_post_ffn = (const float*)d_in[18]; const float* w_router = (const float*)d_in[19];
    const float* b_router = (const float*)d_in[20]; const float* w_gate_up = (const float*)d_in[21]; const float* b_gate_up = (const float*)d_in[22]; const float* w_down = (const float*)d_in[23];
    const float* b_down = (const float*)d_in[24];
    unsigned char* ws = (unsigned char*)d_ws; float* out = (float*)d_out;
    unsigned* ctl = (unsigned*)(ws + WS_CTL); float* mod = (float*)(ws + WS_MOD);
    bf16 *XN = (bf16*)(ws + WS_XN), *Qb = (bf16*)(ws + WS_Q), *Kb = (bf16*)(ws + WS_K), *Vb = (bf16*)(ws + WS_V), *Ub = (bf16*)(ws + WS_U), *VG = (bf16*)(ws + WS_VG);
    bf16 *GT = (bf16*)(ws + WS_GT), *YAB = (bf16*)(ws + WS_YAB), *MRG = (bf16*)(ws + WS_MRG), *Y1 = (bf16*)(ws + WS_Y1), *ACT = (bf16*)(ws + WS_ACT), *Y2 = (bf16*)(ws + WS_Y2);
    float *VN = (float*)(ws + WS_VN), *TMP = (float*)(ws + WS_TMP);
    int* tope = (int*)(ws + WS_TOPE); float* topg = (float*)(ws + WS_TOPG); int* list = (int*)(ws + WS_LIST); unsigned* cnt = ctl + CW_CNT;
    (void)x; (void)c; (void)w_ada; (void)b_ada; (void)g_pre_mix; (void)rel_bias; (void)sgu_ln_g; (void)sgu_ln_b; (void)w_spatial; (void)b_spatial; (void)tope;

    if (hipMemsetAsync(ws + WS_CTL, 0, CTL_ZERO_BYTES, stream) != hipSuccess) { fprintf(stderr, "kernel_launch: memset failed\n"); return; }
    Args a{};
    for (int i = 0; i < 25; ++i) a.in[i] = (const float*)d_in[i];
    a.out = out; a.ws = ws;
#if ONE_LAUNCH
    a.ph_lo = 0; a.ph_hi = N_PHASES;
    hipLaunchKernelGGL(mega_fwd, dim3(grid), dim3(NWAVES * 64), LDS_BYTES, stream, a);
    if (hipPeekAtLastError() != hipSuccess) fprintf(stderr, "kernel_launch: launch failed\n");
    for (int ph = 0; ph < N_PHASES; ++ph) if ((REP_MASK >> ph) & 1) {
        a.ph_lo = ph; a.ph_hi = ph + 1; hipLaunchKernelGGL(mega_fwd, dim3(grid), dim3(NWAVES * 64), LDS_BYTES, stream, a); }
#else
    for (int ph = 0; ph < N_PHASES; ++ph) {
        if (((MEGA_MASK >> ph) & 1) || ph == 0) { a.ph_lo = ph; a.ph_hi = ph + 1; hipLaunchKernelGGL(mega_fwd, dim3(grid), dim3(NWAVES * 64), LDS_BYTES, stream, a); if (((MEGA_MASK >> ph) & 1)) continue; }
        switch (ph) {
        case 0: nv_mod<<<NMOD * D / 256, 256, 0, stream>>>(c, w_ada, b_ada, mod); break;
        case 1: nv_xn1<<<NTOK / 4, 256, 0, stream>>>(x, g_pre_mix, mod, XN); break;
        case 2: { G_In g{XN, w_in, Qb, Kb, Vb, Ub, VG}; nv_gemm<G_In, false><<<dim3(INW / 64, NTOK / 64, 1), 256, 0, stream>>>(g, INW, D); }
                { G_Gate g{XN, w_gate, b_gate, GT}; nv_gemm<G_Gate, false><<<dim3(2048 / 64, NTOK / 64, 1), 256, 0, stream>>>(g, 2048, D); } break;
        case 3: nv_attn<<<NTOK * NHEAD / 256, 256, 0, stream>>>(Qb, Kb, Vb, rel_bias, YAB);
                nv_sgu_ln<<<NTOK / 4, 256, 0, stream>>>(VG, sgu_ln_g, sgu_ln_b, VN);
                nv_sgu<<<NTOK * SW / 256, 256, 0, stream>>>(VN, Ub, w_spatial, b_spatial, YAB); break;
        case 4: { G_BrA g{YAB, w_branch_a, GT, TMP}; nv_gemm<G_BrA, false><<<dim3(D / 64, NTOK / 64, 1), 256, 0, stream>>>(g, D, AW); }
                { G_BrB g{YAB, w_branch_b, GT, TMP, MRG}; nv_gemm<G_BrB, false><<<dim3(D / 64, NTOK / 64, 1), 256, 0, stream>>>(g, D, SW); } break;
        case 5: { G_Out g{MRG, w_out, Y1}; nv_gemm<G_Out, false><<<dim3(D / 64, NTOK / 64, 1), 256, 0, stream>>>(g, D, D); } break;
        case 6: nv_rowpass1<<<NTOK / 4, 256, 0, stream>>>(x, Y1, mod, g_post_mix, g_pre_ffn, w_router, b_router, out, XN, tope, topg, cnt, list); break;
        case 7: { G_MoeGU g{XN, w_gate_up, b_gate_up, cnt, list, ACT}; nv_gemm<G_MoeGU, true><<<dim3(DE / 64, NTOK / 64, NEXP), 256, 0, stream>>>(g, 2048, D); } break;
        case 8: { G_MoeDn g{ACT, w_down, b_down, cnt, list, topg, Y2}; nv_gemm<G_MoeDn, false><<<dim3(D / 64, NTOK / 64, NEXP), 256, 0, stream>>>(g, D, DE); } break;
        case 9: nv_final<<<NTOK / 4, 256, 0, stream>>>(Y2, mod, g_post_ffn, out); break;
        }
    }
#endif
}
```

```cpp
#include <hip/hip_runtime.h>
#include <cstdio>
#include <cstdint>

constexpr int NB = 4, SEQ = 8192, D = 1024, NTOK = NB * SEQ;
constexpr int AW = 512, NHEAD = 8, HD = 64, CHUNK = 64, NLEFT = 8, BAND = 576, MAXREL = 128, NREL = 257;
constexpr int SW = 512, SGB = 128, SGG = 8, SGD = 64;
constexpr int INW = 2560, NEXP = 32, TOPK = 4, DE = 1024, NMOD = 6;
constexpr float EPS = 1e-6f, SWL = 7.0f, SWA = 1.702f;
constexpr float LOG2E = 1.4426950408889634f;
constexpr float QSCALE = 0.125f * LOG2E;
constexpr int SH1 = 0, SC1 = 1024, GT1 = 2048, SH2 = 3072, SC2 = 4096, GT2 = 5120;

typedef unsigned short bf16;
__device__ __forceinline__ float bf2f(bf16 v) { return __uint_as_float(((unsigned)v) << 16); }
__device__ __forceinline__ bf16 f2bf(float f) { unsigned u = __float_as_uint(f); return (bf16)((u + 0x7fffu + ((u >> 16) & 1u)) >> 16); }
__device__ __forceinline__ float wave_sum(float v) {
#pragma unroll
    for (int o = 1; o < 64; o <<= 1) v += __shfl_xor(v, o);
    return v;
}
__device__ __forceinline__ float gelu_erf(float x) { return 0.5f * x * (1.0f + erff(x * 0.70710678118654752f)); }
__device__ __forceinline__ float sigmoidf_(float x) { return 1.0f / (1.0f + __expf(-x)); }

constexpr size_t MiB = 1u << 20;
constexpr size_t WS_CTL = 0, CTL_ZERO_BYTES = 1 * MiB;
constexpr size_t WS_MOD = 1 * MiB;
constexpr size_t WS_W1T = 2 * MiB, WS_WBRT = 12 * MiB, WS_WOUTT = 14 * MiB, WS_WRT = 16 * MiB;
constexpr size_t WS_TOPE = 17 * MiB, WS_TOPG = 18 * MiB, WS_LIST = 19 * MiB;
constexpr size_t WS_WGUT = 32 * MiB, WS_WDNT = 160 * MiB;
constexpr size_t WS_XN = 224 * MiB;
constexpr size_t WS_Q = 288 * MiB, WS_K = 320 * MiB, WS_V = 352 * MiB, WS_U = 384 * MiB, WS_VG = 416 * MiB;
constexpr size_t WS_GT = 448 * MiB;
constexpr size_t WS_YAB = 576 * MiB, WS_MRG = 640 * MiB, WS_Y1 = 704 * MiB;
constexpr size_t WS_ACT = 288 * MiB;
constexpr size_t WS_Y2 = 576 * MiB;
constexpr size_t WS_VN = 768 * MiB;
constexpr size_t WS_TMP = 832 * MiB;
constexpr size_t WS_END = 960 * MiB;
constexpr int CW_CNT = 1024;

__global__ __launch_bounds__(256) void nv_mod(const float* __restrict__ c, const float* __restrict__ w_ada, const float* __restrict__ b_ada, float* __restrict__ mod) {
    __shared__ float sc[NB * D];
    for (int i = threadIdx.x; i < NB * D; i += 256) { const float v = c[i]; sc[i] = v / (1.0f + __expf(-v)); }
    __syncthreads();
    const int j = blockIdx.x * 256 + threadIdx.x;
    float a0 = 0.f, a1 = 0.f, a2 = 0.f, a3 = 0.f;
    for (int k = 0; k < D; ++k) { const float w = w_ada[(size_t)k * (NMOD * D) + j]; a0 += sc[k] * w; a1 += sc[D + k] * w; a2 += sc[2 * D + k] * w; a3 += sc[3 * D + k] * w; }
    const float bb = b_ada[j];
    mod[j] = a0 + bb; mod[6144 + j] = a1 + bb; mod[2 * 6144 + j] = a2 + bb; mod[3 * 6144 + j] = a3 + bb;
}

__global__ __launch_bounds__(256) void nv_xn1(const float* __restrict__ x, const float* __restrict__ g, const float* __restrict__ mod, bf16* __restrict__ xn) {
    const int row = blockIdx.x * 4 + (threadIdx.x >> 6), lane = threadIdx.x & 63, b = row / SEQ;
    const float4* xr = (const float4*)(x + (size_t)row * D);
    float4 v[4]; float ss = 0.f;
#pragma unroll
    for (int j = 0; j < 4; ++j) { v[j] = xr[lane + 64 * j]; ss += v[j].x * v[j].x + v[j].y * v[j].y + v[j].z * v[j].z + v[j].w * v[j].w; }
    const float rstd = rsqrtf(wave_sum(ss) * (1.0f / D) + EPS);
    const float* mb = mod + b * 6144;
#pragma unroll
    for (int j = 0; j < 4; ++j) {
        const int c0 = (lane + 64 * j) * 4; const float vv[4] = {v[j].x, v[j].y, v[j].z, v[j].w}; bf16 o[4];
#pragma unroll
        for (int i = 0; i < 4; ++i) o[i] = f2bf(vv[i] * rstd * g[c0 + i] * (1.0f + mb[SC1 + c0 + i]) + mb[SH1 + c0 + i]);
        *(uint2*)(xn + (size_t)row * D + c0) = make_uint2((unsigned)o[0] | ((unsigned)o[1] << 16), (unsigned)o[2] | ((unsigned)o[3] << 16));
    }
}

template <class G, bool DUAL>
__global__ __launch_bounds__(256) void nv_gemm(G g, int ldw, int K) {
    __shared__ float As[16][68];
    __shared__ float Ws[16][64];
    __shared__ float Ws2[DUAL ? 16 : 1][64];
    const int z = blockIdx.z; int nrows; const float* W; const float* W2;
    if (!g.setup(z, nrows, W, W2)) return;
    const int r0 = blockIdx.y * 64, n0 = blockIdx.x * 64;
    if (r0 >= nrows) return;
    const int tid = threadIdx.x, tx = tid & 15, ty = tid >> 4;
    const int lr = tid >> 2, lk = (tid & 3) * 4;
    int ar = r0 + lr; if (ar >= nrows) ar = nrows - 1;
    const bf16* ap = g.arow(z, ar) + lk;
    const int wk = tid >> 4, wn = (tid & 15) * 4;
    float acc[4][4], acc2[4][4];
#pragma unroll
    for (int i = 0; i < 4; ++i)
#pragma unroll
        for (int j = 0; j < 4; ++j) { acc[i][j] = 0.f; acc2[i][j] = 0.f; }
    for (int k0 = 0; k0 < K; k0 += 16) {
        const uint2 av = *(const uint2*)(ap + k0);
        As[lk + 0][lr] = bf2f((bf16)(av.x & 0xffff)); As[lk + 1][lr] = bf2f((bf16)(av.x >> 16));
        As[lk + 2][lr] = bf2f((bf16)(av.y & 0xffff)); As[lk + 3][lr] = bf2f((bf16)(av.y >> 16));
        *(float4*)&Ws[wk][wn] = *(const float4*)(W + (size_t)(k0 + wk) * ldw + n0 + wn);
        if (DUAL) *(float4*)&Ws2[wk][wn] = *(const float4*)(W2 + (size_t)(k0 + wk) * ldw + n0 + wn);
        __syncthreads();
#pragma unroll
        for (int kk = 0; kk < 16; ++kk) {
            const float4 a = *(const float4*)&As[kk][ty * 4]; const float4 b = *(const float4*)&Ws[kk][tx * 4];
            const float aa[4] = {a.x, a.y, a.z, a.w}, bb[4] = {b.x, b.y, b.z, b.w};
#pragma unroll
            for (int i = 0; i < 4; ++i)
#pragma unroll
                for (int j = 0; j < 4; ++j) acc[i][j] += aa[i] * bb[j];
            if (DUAL) { const float4 b2 = *(const float4*)&Ws2[kk][tx * 4]; const float cc[4] = {b2.x, b2.y, b2.z, b2.w};
#pragma unroll
                for (int i = 0; i < 4; ++i)
#pragma unroll
                    for (int j = 0; j < 4; ++j) acc2[i][j] += aa[i] * cc[j]; }
        }
        __syncthreads();
    }
#pragma unroll
    for (int i = 0; i < 4; ++i) { const int r = r0 + ty * 4 + i; if (r < nrows) {
#pragma unroll
        for (int j = 0; j < 4; ++j) g.store(z, r, n0 + tx * 4 + j, acc[i][j], acc2[i][j]); } }
}

struct G_In {
    const bf16* A; const float* W; bf16 *Q, *Kb, *V, *U, *VG;
    __device__ bool setup(int, int& nrows, const float*& w, const float*& w2) const { nrows = NTOK; w = W; w2 = W; return true; }
    __device__ const bf16* arow(int, int r) const { return A + (size_t)r * D; }
    __device__ void store(int, int r, int n, float acc, float) const {
        if (n < 512) Q[(size_t)r * 512 + n] = f2bf(acc * QSCALE);
        else if (n < 1024) Kb[(size_t)r * 512 + n - 512] = f2bf(acc);
        else if (n < 1536) V[(size_t)r * 512 + n - 1024] = f2bf(acc);
        else if (n < 2048) U[(size_t)r * 512 + n - 1536] = f2bf(gelu_erf(acc));
        else VG[(size_t)r * 512 + n - 2048] = f2bf(gelu_erf(acc));
    }
};
struct G_Gate {
    const bf16* A; const float* W; const float* bias; bf16* GT;
    __device__ bool setup(int, int& nrows, const float*& w, const float*& w2) const { nrows = NTOK; w = W; w2 = W; return true; }
    __device__ const bf16* arow(int, int r) const { return A + (size_t)r * D; }
    __device__ void store(int, int r, int n, float acc, float) const { GT[(size_t)r * 2048 + n] = f2bf(sigmoidf_(acc + bias[n])); }
};
struct G_BrA {
    const bf16* YAB; const float* W; const bf16* GT; float* TMP;
    __device__ bool setup(int, int& nrows, const float*& w, const float*& w2) const { nrows = NTOK; w = W; w2 = W; return true; }
    __device__ const bf16* arow(int, int r) const { return YAB + (size_t)r * 1024; }
    __device__ void store(int, int r, int n, float acc, float) const { TMP[(size_t)r * 1024 + n] = bf2f(GT[(size_t)r * 2048 + n]) * acc; }
};
struct G_BrB {
    const bf16* YAB; const float* W; const bf16* GT; const float* TMP; bf16* MRG;
    __device__ bool setup(int, int& nrows, const float*& w, const float*& w2) const { nrows = NTOK; w = W; w2 = W; return true; }
    __device__ const bf16* arow(int, int r) const { return YAB + (size_t)r * 1024 + 512; }
    __device__ void store(int, int r, int n, float acc, float) const { MRG[(size_t)r * 1024 + n] = f2bf(TMP[(size_t)r * 1024 + n] + bf2f(GT[(size_t)r * 2048 + 1024 + n]) * acc); }
};
struct G_Out {
    const bf16* MRG; const float* W; bf16* Y1;
    __device__ bool setup(int, int& nrows, const float*& w, const float*& w2) const { nrows = NTOK; w = W; w2 = W; return true; }
    __device__ const bf16* arow(int, int r) const { return MRG + (size_t)r * 1024; }
    __device__ void store(int, int r, int n, float acc, float) const { Y1[(size_t)r * 1024 + n] = f2bf(acc); }
};
__device__ __forceinline__ int moe_rowbase(const unsigned* cnt, int e) { int s = 0; for (int i = 0; i < e; ++i) s += (int)((cnt[i] + 255u) / 256u) * 256; return s; }
struct G_MoeGU {
    const bf16* XN2; const float* Wgu; const float* bgu; const unsigned* cnt; const int* list; bf16* ACT;
    __device__ bool setup(int z, int& nrows, const float*& w, const float*& w2) const { nrows = (int)cnt[z]; w = Wgu + (size_t)z * D * 2048; w2 = w + 1024; return nrows > 0; }
    __device__ const bf16* arow(int z, int r) const { const int slot = list[(size_t)z * NTOK + r]; return XN2 + (size_t)(slot >> 2) * D; }
    __device__ void store(int z, int r, int n, float acc, float acc2) const {
        const float xg = fminf(acc + bgu[z * 2048 + n], SWL); const float xl = fminf(fmaxf(acc2 + bgu[z * 2048 + 1024 + n], -SWL), SWL);
        ACT[(size_t)(moe_rowbase(cnt, z) + r) * 1024 + n] = f2bf(xg * sigmoidf_(SWA * xg) * (xl + 1.0f));
    }
};
struct G_MoeDn {
    const bf16* ACT; const float* Wdn; const float* bdn; const unsigned* cnt; const int* list; const float* topg; bf16* Y2;
    __device__ bool setup(int z, int& nrows, const float*& w, const float*& w2) const { nrows = (int)cnt[z]; w = Wdn + (size_t)z * D * D; w2 = w; return nrows > 0; }
    __device__ const bf16* arow(int z, int r) const { return ACT + (size_t)(moe_rowbase(cnt, z) + r) * 1024; }
    __device__ void store(int z, int r, int n, float acc, float) const { const int slot = list[(size_t)z * NTOK + r]; Y2[(size_t)slot * 1024 + n] = f2bf((acc + bdn[z * 1024 + n]) * topg[slot]); }
};

__global__ __launch_bounds__(256) void nv_attn(const bf16* __restrict__ Q, const bf16* __restrict__ Kb, const bf16* __restrict__ V, const float* __restrict__ rel_bias, bf16* __restrict__ YAB) {
    const int gid = blockIdx.x * 256 + threadIdx.x, h = gid & 7, tok = gid >> 3, b = tok / SEQ, t = tok % SEQ, c = t / CHUNK, qi = t % CHUNK;
    float q[64], o[64];
    const uint4* qp = (const uint4*)(Q + (size_t)tok * 512 + h * 64);
#pragma unroll
    for (int i = 0; i < 8; ++i) { const uint4 w = qp[i]; const unsigned ww[4] = {w.x, w.y, w.z, w.w};
#pragma unroll
        for (int j = 0; j < 4; ++j) { q[i * 8 + 2 * j] = bf2f((bf16)(ww[j] & 0xffff)); q[i * 8 + 2 * j + 1] = bf2f((bf16)(ww[j] >> 16)); } }
#pragma unroll
    for (int d = 0; d < 64; ++d) o[d] = 0.f;
    float m = -1e30f, l = 0.f;
    for (int kj = 0; kj < BAND; ++kj) {
        const int kpos = (c - NLEFT) * CHUNK + kj; if (kpos < 0) continue;
        const size_t kr = ((size_t)(b * SEQ + kpos)) * 512 + h * 64;
        const uint4* kp = (const uint4*)(Kb + kr); float s = 0.f;
#pragma unroll
        for (int i = 0; i < 8; ++i) { const uint4 w = kp[i]; const unsigned ww[4] = {w.x, w.y, w.z, w.w};
#pragma unroll
            for (int j = 0; j < 4; ++j) { s += q[i * 8 + 2 * j] * bf2f((bf16)(ww[j] & 0xffff)); s += q[i * 8 + 2 * j + 1] * bf2f((bf16)(ww[j] >> 16)); } }
        int rel = NLEFT * CHUNK + qi - kj; rel = rel < -MAXREL ? -MAXREL : (rel > MAXREL ? MAXREL : rel);
        s += rel_bias[h * NREL + rel + MAXREL] * LOG2E;
        const float mn = fmaxf(m, s), alpha = exp2f(m - mn), p = exp2f(s - mn);
        l = l * alpha + p; m = mn;
        const uint4* vp = (const uint4*)(V + kr);
#pragma unroll
        for (int i = 0; i < 8; ++i) { const uint4 w = vp[i]; const unsigned ww[4] = {w.x, w.y, w.z, w.w};
#pragma unroll
            for (int j = 0; j < 4; ++j) { o[i * 8 + 2 * j] = o[i * 8 + 2 * j] * alpha + p * bf2f((bf16)(ww[j] & 0xffff)); o[i * 8 + 2 * j + 1] = o[i * 8 + 2 * j + 1] * alpha + p * bf2f((bf16)(ww[j] >> 16)); } }
    }
    const float inv = 1.0f / l;
    bf16* op = YAB + (size_t)tok * 1024 + h * 64;
#pragma unroll
    for (int d = 0; d < 64; d += 2) *(unsigned*)(op + d) = (unsigned)f2bf(o[d] * inv) | ((unsigned)f2bf(o[d + 1] * inv) << 16);
}

__global__ __launch_bounds__(256) void nv_sgu_ln(const bf16* __restrict__ VG, const float* __restrict__ ln_g, const float* __restrict__ ln_b, float* __restrict__ VN) {
    const int row = blockIdx.x * 4 + (threadIdx.x >> 6), lane = threadIdx.x & 63;
    const uint4 w = *(const uint4*)(VG + (size_t)row * 512 + lane * 8); const unsigned ww[4] = {w.x, w.y, w.z, w.w};
    float v[8]; float s = 0.f;
#pragma unroll
    for (int j = 0; j < 4; ++j) { v[2 * j] = bf2f((bf16)(ww[j] & 0xffff)); v[2 * j + 1] = bf2f((bf16)(ww[j] >> 16)); s += v[2 * j] + v[2 * j + 1]; }
    const float mu = wave_sum(s) * (1.0f / 512.0f); float q = 0.f;
#pragma unroll
    for (int j = 0; j < 8; ++j) { v[j] -= mu; q += v[j] * v[j]; }
    const float rstd = rsqrtf(wave_sum(q) * (1.0f / 512.0f) + EPS);
#pragma unroll
    for (int j = 0; j < 8; ++j) VN[(size_t)row * 512 + lane * 8 + j] = v[j] * rstd * ln_g[lane * 8 + j] + ln_b[lane * 8 + j];
}
__global__ __launch_bounds__(256) void nv_sgu(const float* __restrict__ VN, const bf16* __restrict__ U, const float* __restrict__ w_s, const float* __restrict__ b_s, bf16* __restrict__ YAB) {
    const int gid = blockIdx.x * 256 + threadIdx.x, c = gid & 511, tok = gid >> 9, tl = tok & 127, tb = tok - tl, g = c >> 6;
    float acc = b_s[g * 128 + tl];
    const float* wr = w_s + ((size_t)g * 128 + tl) * 128;
    for (int s = 0; s <= tl; ++s) acc += wr[s] * VN[(size_t)(tb + s) * 512 + c];
    YAB[(size_t)tok * 1024 + 512 + c] = f2bf(bf2f(U[(size_t)tok * 512 + c]) * acc);
}

__global__ __launch_bounds__(256) void nv_rowpass1(const float* __restrict__ x, const bf16* __restrict__ Y1, const float* __restrict__ mod, const float* __restrict__ g_post_mix,
                                                   const float* __restrict__ g_pre_ffn, const float* __restrict__ w_router, const float* __restrict__ b_router,
                                                   float* __restrict__ X1, bf16* __restrict__ XN2, int* __restrict__ tope, float* __restrict__ topg, unsigned* cnt, int* __restrict__ list) {
    const int row = blockIdx.x * 4 + (threadIdx.x >> 6), lane = threadIdx.x & 63, b = row / SEQ;
    const float* mb = mod + b * 6144;
    float xv[16], yv[16]; float ss = 0.f;
#pragma unroll
    for (int j = 0; j < 4; ++j) {
        const int c0 = (lane + 64 * j) * 4;
        const float4 xx = *(const float4*)(x + (size_t)row * D + c0); xv[4 * j] = xx.x; xv[4 * j + 1] = xx.y; xv[4 * j + 2] = xx.z; xv[4 * j + 3] = xx.w;
        const uint2 yy = *(const uint2*)(Y1 + (size_t)row * D + c0);
        yv[4 * j] = bf2f((bf16)(yy.x & 0xffff)); yv[4 * j + 1] = bf2f((bf16)(yy.x >> 16)); yv[4 * j + 2] = bf2f((bf16)(yy.y & 0xffff)); yv[4 * j + 3] = bf2f((bf16)(yy.y >> 16));
#pragma unroll
        for (int i = 0; i < 4; ++i) ss += yv[4 * j + i] * yv[4 * j + i];
    }
    const float rstd = rsqrtf(wave_sum(ss) * (1.0f / D) + EPS); float s2 = 0.f;
#pragma unroll
    for (int j = 0; j < 4; ++j) { const int c0 = (lane + 64 * j) * 4;
#pragma unroll
        for (int i = 0; i < 4; ++i) { const float x1 = xv[4 * j + i] + mb[GT1 + c0 + i] * (yv[4 * j + i] * rstd * g_post_mix[c0 + i]); xv[4 * j + i] = x1; s2 += x1 * x1; }
        *(float4*)(X1 + (size_t)row * D + c0) = make_float4(xv[4 * j], xv[4 * j + 1], xv[4 * j + 2], xv[4 * j + 3]); }
    const float rstd2 = rsqrtf(wave_sum(s2) * (1.0f / D) + EPS);
#pragma unroll
    for (int j = 0; j < 4; ++j) { const int c0 = (lane + 64 * j) * 4;
#pragma unroll
        for (int i = 0; i < 4; ++i) xv[4 * j + i] = xv[4 * j + i] * rstd2 * g_pre_ffn[c0 + i] * (1.0f + mb[SC2 + c0 + i]) + mb[SH2 + c0 + i];
        *(uint2*)(XN2 + (size_t)row * D + c0) = make_uint2((unsigned)f2bf(xv[4 * j]) | ((unsigned)f2bf(xv[4 * j + 1]) << 16), (unsigned)f2bf(xv[4 * j + 2]) | ((unsigned)f2bf(xv[4 * j + 3]) << 16)); }
    float mylogit = -1e30f;
    for (int e = 0; e < NEXP; ++e) {
        float p = 0.f;
#pragma unroll
        for (int j = 0; j < 4; ++j) { const int c0 = (lane + 64 * j) * 4;
#pragma unroll
            for (int i = 0; i < 4; ++i) p += xv[4 * j + i] * w_router[(size_t)(c0 + i) * NEXP + e]; }
        p = wave_sum(p) + b_router[e];
        if (lane == e) mylogit = p;
    }
    float tv[4]; int ti[4];
#pragma unroll
    for (int k = 0; k < 4; ++k) {
        float bv = mylogit; int bi = lane;
#pragma unroll
        for (int o = 1; o < 64; o <<= 1) { const float ov = __shfl_xor(bv, o); const int oi = __shfl_xor(bi, o); if (ov > bv || (ov == bv && oi < bi)) { bv = ov; bi = oi; } }
        tv[k] = bv; ti[k] = bi; if (lane == bi) mylogit = -3e38f;
    }
    if (lane == 0) {
        const float e0 = 1.0f, e1 = __expf(tv[1] - tv[0]), e2 = __expf(tv[2] - tv[0]), e3 = __expf(tv[3] - tv[0]); const float inv = 1.0f / (e0 + e1 + e2 + e3);
        const float gg[4] = {e0 * inv, e1 * inv, e2 * inv, e3 * inv};
#pragma unroll
        for (int k = 0; k < 4; ++k) { const int slot = row * 4 + k; tope[slot] = ti[k]; topg[slot] = gg[k]; const unsigned pos = atomicAdd(&cnt[ti[k]], 1u); list[(size_t)ti[k] * NTOK + pos] = slot; }
    }
}

__global__ __launch_bounds__(256) void nv_final(const bf16* __restrict__ Y2, const float* __restrict__ mod, const float* __restrict__ g_post_ffn, float* __restrict__ out) {
    const int row = blockIdx.x * 4 + (threadIdx.x >> 6), lane = threadIdx.x & 63, b = row / SEQ;
    const float* mb = mod + b * 6144;
    float yv[16]; float ss = 0.f;
#pragma unroll
    for (int j = 0; j < 4; ++j) { const int c0 = (lane + 64 * j) * 4; float a[4] = {0.f, 0.f, 0.f, 0.f};
#pragma unroll
        for (int k = 0; k < 4; ++k) { const uint2 yy = *(const uint2*)(Y2 + ((size_t)row * 4 + k) * D + c0);
            a[0] += bf2f((bf16)(yy.x & 0xffff)); a[1] += bf2f((bf16)(yy.x >> 16)); a[2] += bf2f((bf16)(yy.y & 0xffff)); a[3] += bf2f((bf16)(yy.y >> 16)); }
#pragma unroll
        for (int i = 0; i < 4; ++i) { yv[4 * j + i] = a[i]; ss += a[i] * a[i]; } }
    const float rstd = rsqrtf(wave_sum(ss) * (1.0f / D) + EPS);
#pragma unroll
    for (int j = 0; j < 4; ++j) { const int c0 = (lane + 64 * j) * 4; float4 xx = *(const float4*)(out + (size_t)row * D + c0);
        xx.x += mb[GT2 + c0] * (yv[4 * j] * rstd * g_post_ffn[c0]); xx.y += mb[GT2 + c0 + 1] * (yv[4 * j + 1] * rstd * g_post_ffn[c0 + 1]);
        xx.z += mb[GT2 + c0 + 2] * (yv[4 * j + 2] * rstd * g_post_ffn[c0 + 2]); xx.w += mb[GT2 + c0 + 3] * (yv[4 * j + 3] * rstd * g_post_ffn[c0 + 3]);
        *(float4*)(out + (size_t)row * D + c0) = xx; }
}

#define LAS __attribute__((address_space(3)))
#define GAS __attribute__((address_space(1)))
typedef short bf16x8 __attribute__((ext_vector_type(8)));
typedef short s16x4 __attribute__((ext_vector_type(4)));
typedef float f32x4 __attribute__((ext_vector_type(4)));
typedef float f32x2 __attribute__((ext_vector_type(2)));
typedef float f32x16 __attribute__((ext_vector_type(16)));
typedef unsigned u32x4 __attribute__((ext_vector_type(4)));
typedef unsigned u32x2 __attribute__((ext_vector_type(2)));
typedef __bf16 bf16x2_t __attribute__((ext_vector_type(2)));
constexpr int NWAVES = 8;
constexpr int TRASH_SLOT = NTOK * 4;

__device__ __forceinline__ unsigned cvtpk(float lo, float hi) { f32x2 v = {lo, hi}; bf16x2_t b = __builtin_convertvector(v, bf16x2_t); return __builtin_bit_cast(unsigned, b); }
__device__ __forceinline__ float clamp8(float v) { return fminf(fmaxf(v, -448.0f), 448.0f); }
__device__ __forceinline__ unsigned pk_fp8x4(float a, float b, float c, float d) {
    int w = 0; w = __builtin_amdgcn_cvt_pk_fp8_f32(clamp8(a), clamp8(b), w, false); w = __builtin_amdgcn_cvt_pk_fp8_f32(clamp8(c), clamp8(d), w, true); return (unsigned)w; }
constexpr float F8_WSCALE = 64.0f, F8_ASCALE = 4.0f, F8_DESCALE = 1.0f / (64.0f * 4.0f);
__device__ __forceinline__ float bflo(unsigned w) { return __uint_as_float(w << 16); }
__device__ __forceinline__ float bfhi(unsigned w) { return __uint_as_float(w & 0xffff0000u); }
__device__ __forceinline__ float fast_sigmoid(float x) { return __builtin_amdgcn_rcpf(1.0f + __builtin_amdgcn_exp2f(-LOG2E * x)); }
__device__ __forceinline__ f32x2 gelu_pk(f32x2 v) {
    const f32x2 av = __builtin_elementwise_abs(v), d = av * 0.2316418882f + 1.0f;
    f32x2 t; t.x = __builtin_amdgcn_rcpf(d.x); t.y = __builtin_amdgcn_rcpf(d.y);
    f32x2 q = t * 0.5307027145f + (-0.7265760135f); q = q * t + 0.7107068705f; q = q * t + (-0.142248368f); q = q * t + 0.127414796f; q = q * t;
    const f32x2 s = (v * v) * (-0.72134752044f);
    f32x2 e; e.x = __builtin_amdgcn_exp2f(s.x); e.y = __builtin_amdgcn_exp2f(s.y);
    const f32x2 m = v * (q * e), r = v - m;
    f32x2 o; o.x = v.x < 0.f ? m.x : r.x; o.y = v.y < 0.f ? m.y : r.y; return o;
}

constexpr int RING_OFF = 0, RING_BYTES = 131072;
constexpr int GTAB_OFF = RING_BYTES, GTAB_UNITS = 20, GTAB_BYTES = GTAB_UNITS * 256 * 4;
constexpr int MISC_OFF = GTAB_OFF + GTAB_BYTES;
constexpr int LDS_BYTES = MISC_OFF + 512;
static_assert(LDS_BYTES <= 160 * 1024, "LDS map");

#define XB_TMO      128
#define XB_XCNT(j)  (256  + 64 * (j))
#define XB_XSUB(j)  (1280 + 64 * (j))
#define XB_XGEN(j)  (2304 + 64 * (j))
#define XB_TOP      3328
#define XB_TOPGEN   3392
#define XCD_BAR_WORDS 3456
#define XB_SPIN_CAP (1u << 18)
__device__ __forceinline__ unsigned xb_ld(unsigned* p)              { return __hip_atomic_load(p, __ATOMIC_RELAXED, __HIP_MEMORY_SCOPE_AGENT); }
__device__ __forceinline__ unsigned xb_add(unsigned* p, unsigned v) { return __hip_atomic_fetch_add(p, v, __ATOMIC_RELAXED, __HIP_MEMORY_SCOPE_AGENT); }
__device__ __forceinline__ unsigned xb_xcc_id() { return (unsigned)__builtin_amdgcn_s_getreg((3 << 11) | 20) & 0xFu; }
#define XB_SPIN(cond, bar) do { unsigned _sp = 0; while (cond) { __builtin_amdgcn_s_sleep(1); \
    if ((++_sp & 255u) == 0u) { if (xb_ld(&(bar)[XB_TMO])) break; if (_sp > XB_SPIN_CAP) { atomicAdd(&(bar)[XB_TMO], 1u); break; } } } } while (0)
struct XcdBarrier { unsigned* bar; unsigned x; volatile LAS unsigned* st; };
__device__ __forceinline__ XcdBarrier xcd_barrier_post(unsigned* bar, volatile LAS unsigned* st) {
    XcdBarrier b; b.bar = bar; b.x = xb_xcc_id(); b.st = st;
    if (threadIdx.x == 0) (void)xb_add(&bar[XB_XCNT(b.x)], 1u);
    return b;
}
__device__ __forceinline__ void xcd_barrier_complete(unsigned* bar, unsigned x, unsigned& nloc, unsigned& nx) {
    const unsigned G = gridDim.x * gridDim.y * gridDim.z;
    unsigned sum, cnt, mine, sp = 0u;
    for (;;) {
        sum = 0u; cnt = 0u; mine = 0u;
#pragma unroll
        for (unsigned j = 0; j < 16; ++j) { const unsigned c = xb_ld(&bar[XB_XCNT(j)]); sum += c; cnt += (c > 0u) ? 1u : 0u; mine = (j == x) ? c : mine; }
        if (sum == G) break;
        __builtin_amdgcn_s_sleep(1);
        if ((++sp & 255u) == 0u) { if (xb_ld(&bar[XB_TMO])) break; if (sp > XB_SPIN_CAP) { atomicAdd(&bar[XB_TMO], 1u); break; } }
    }
    nloc = mine > 0u ? mine : 1u; nx = cnt > 0u ? cnt : 1u;
}
__device__ __forceinline__ void xcd_barrier(const XcdBarrier& b) {
    asm volatile("s_waitcnt vmcnt(0)" ::: "memory");
    __syncthreads();
    if (threadIdx.x == 0) {
        unsigned* bar = b.bar;
        __builtin_amdgcn_s_waitcnt(0);
        unsigned nloc = b.st[0], nx = b.st[1];
        if (nloc == 0u) { xcd_barrier_complete(bar, b.x, nloc, nx); b.st[0] = nloc; b.st[1] = nx; }
        const unsigned old = xb_add(&bar[XB_XSUB(b.x)], 1u);
        const unsigned gen = old / nloc;
        if (old + 1u == (gen + 1u) * nloc) {
            __builtin_amdgcn_fence(__ATOMIC_RELEASE, "agent");
            asm volatile("s_waitcnt vmcnt(0)" ::: "memory");
            const unsigned og = xb_add(&bar[XB_TOP], 1u);
            const unsigned tg = og / nx;
            if (og + 1u == (tg + 1u) * nx) xb_add(&bar[XB_TOPGEN], 1u);
            else XB_SPIN(xb_ld(&bar[XB_TOPGEN]) == tg, bar);
            __builtin_amdgcn_fence(__ATOMIC_ACQUIRE, "agent");
            xb_add(&bar[XB_XGEN(b.x)], 1u);
            asm volatile("s_waitcnt vmcnt(0)" ::: "memory");
        } else {
            XB_SPIN(xb_ld(&bar[XB_XGEN(b.x)]) == gen, bar);
            __builtin_amdgcn_fence(__ATOMIC_ACQUIRE, "agent");
            asm volatile("s_waitcnt vmcnt(0)" ::: "memory");
        }
    }
    __syncthreads();
}
constexpr int CW_BAR = 4096;

namespace pg8 {
constexpr int BM = 256, BK = 64, HALF = 128, HTB = HALF * BK * 2, STAGE_BYTES = 8 * HTB, NXCD = 8, WGM = 8;
__host__ __device__ __forceinline__ int lds_byte(int r, int c) { const int st = (r >> 4) * 2 + (c >> 5), rr = r & 15, cc = c & 31, ob = rr * 64 + cc * 2; return st * 1024 + (ob ^ (((ob >> 9) & 1) << 5)); }
__host__ __device__ __forceinline__ void stage_rc(int b, int& R, int& C) { const int st = b / 1024, sb = b % 1024, swz = sb ^ (((sb >> 9) & 1) << 5); R = (st >> 1) * 16 + swz / 64; C = (st & 1) * 32 + (swz % 64) / 2; }
__host__ __device__ __forceinline__ int perm32(int rho) { const int n = rho >> 4, i = rho & 15; return 8 * (i >> 2) + 4 * n + (i & 3); }
struct Unit { int pm, pn, aux; };
typedef int v4i_t __attribute__((ext_vector_type(4)));
typedef int v8i_t __attribute__((ext_vector_type(8)));

__device__ __forceinline__ bool static_unit(int i, int G, int c, int nM, int nN, int& pm, int& pn) {
    const int nwg = nM * nN; const long L = (long)i * G + c; if (L >= nwg) return false;
    int wgid = (int)L; { const int q = nwg / NXCD, r = nwg % NXCD, xcd = wgid % NXCD, off = wgid / NXCD; wgid = (xcd < r ? xcd * (q + 1) : r * (q + 1) + (xcd - r) * q) + off; }
    const int nig = WGM * nN, gid = wgid / nig, fm = gid * WGM, gsz = (nM - fm) < WGM ? (nM - fm) : WGM;
    pm = fm + ((wgid % nig) % gsz); pn = (wgid % nig) / gsz; return true;
}

template <class Epi, class Sched, bool FP8>
__device__ __forceinline__ void gemm_phase(LAS unsigned char* lds, const Sched& S, const Epi& E, const int lda, const int ldb, const int nt) {
    const int tid = threadIdx.x, wid = __builtin_amdgcn_readfirstlane(tid >> 6), lane = tid & 63, wr = wid >> 2, wc = wid & 3, fr = lane & 15, fq = lane >> 4;
    int Rr[2], Cc[2]; unsigned voffB[2];
#pragma unroll
    for (int i = 0; i < 2; ++i) { stage_rc(tid * 16 + i * 8192, Rr[i], Cc[i]); const int Rb = (Rr[i] & ~31) + perm32(Rr[i] & 31); voffB[i] = (unsigned)(Rb * ldb + Cc[i] * 2); }
    const size_t kstep = (size_t)(BK * 2);
    const size_t hstepB = (size_t)HALF * ldb;
    const size_t hstepA = Sched::GATHER ? (size_t)0 : (size_t)HALF * lda;
    const unsigned ldsw = (unsigned)wid * 1024u;
    const int aoff = lds_byte(wr * 64 + fr, fq * 8), boff = lds_byte(wc * 32 + fr, fq * 8);
#define PG8_SA(b, h) (((b) * 2 + (h)) * HTB)
#define PG8_SB(b, h) ((4 + (b) * 2 + (h)) * HTB)
#define PG8_STAGE(bufoff, gbase, voff) do { _Pragma("unroll") for (int _i = 0; _i < 2; ++_i) \
        __builtin_amdgcn_global_load_lds((const unsigned*)((const char*)(gbase) + (voff)[_i]), (LAS unsigned*)(lds + (bufoff) + ldsw + _i * 8192), 16, 0, 0); } while (0)
#define PG8_LDA(dst, b, h) do { _Pragma("unroll") for (int m = 0; m < 4; ++m) _Pragma("unroll") for (int k = 0; k < 2; ++k) dst[m][k] = *(const LAS bf16x8*)(lds + PG8_SA(b, h) + aoff + m * 2048 + k * 1024); } while (0)
#define PG8_LDB(dst, b, h) do { _Pragma("unroll") for (int n = 0; n < 2; ++n) _Pragma("unroll") for (int k = 0; k < 2; ++k) dst[n][k] = *(const LAS bf16x8*)(lds + PG8_SB(b, h) + boff + n * 2048 + k * 1024); } while (0)
#define PG8_CAT(x) __builtin_shufflevector(__builtin_bit_cast(v4i_t, (x)[0]), __builtin_bit_cast(v4i_t, (x)[1]), 0, 1, 2, 3, 4, 5, 6, 7)
#define PG8_MMA(ai, bj, At, Bt) do { __builtin_amdgcn_s_setprio(1); if constexpr (FP8) { _Pragma("unroll") for (int m = 0; m < 4; ++m) _Pragma("unroll") for (int n = 0; n < 2; ++n) \
        acc[ai][bj][m][n] = __builtin_amdgcn_mfma_scale_f32_16x16x128_f8f6f4(PG8_CAT(Bt[n]), PG8_CAT(At[m]), acc[ai][bj][m][n], 0, 0, 0, 0x7F7F7F7F, 0, 0x7F7F7F7F); } \
    else { _Pragma("unroll") for (int m = 0; m < 4; ++m) _Pragma("unroll") for (int n = 0; n < 2; ++n) _Pragma("unroll") for (int k = 0; k < 2; ++k) \
        acc[ai][bj][m][n] = __builtin_amdgcn_mfma_f32_16x16x32_bf16(Bt[n][k], At[m][k], acc[ai][bj][m][n], 0, 0, 0); } __builtin_amdgcn_s_setprio(0); } while (0)
#define PG8_WAIT_V(n) asm volatile("s_waitcnt vmcnt(" #n ")" ::: "memory")
#define PG8_WAIT_L(n) asm volatile("s_waitcnt lgkmcnt(" #n ")" ::: "memory")
#define PG8_BAR __builtin_amdgcn_s_barrier()
#define PG8_SCHED __builtin_amdgcn_sched_barrier(0)
    Unit cur, nxt; int ui = 0;
    if (!S.next(0, cur)) return;
    f32x4 acc[2][2][4][2];
#pragma unroll
    for (int a = 0; a < 2; ++a)
#pragma unroll
        for (int b = 0; b < 2; ++b)
#pragma unroll
            for (int m = 0; m < 4; ++m)
#pragma unroll
                for (int n = 0; n < 2; ++n) acc[a][b][m][n] = (f32x4){0.f, 0.f, 0.f, 0.f};
    bf16x8 At[4][2], B0[2][2], B1[2][2];
    unsigned oA[2][2];
#pragma unroll
    for (int h = 0; h < 2; ++h)
#pragma unroll
        for (int i = 0; i < 2; ++i) oA[h][i] = Sched::GATHER ? (S.goff(0, h * HALF + Rr[i]) + (unsigned)Cc[i] * 2u) : (unsigned)(Rr[i] * lda + Cc[i] * 2);
    const char* cA = S.aptr(cur); const char* cB = S.bptr(cur);
    PG8_STAGE(PG8_SB(0, 0), cB, voffB); PG8_STAGE(PG8_SB(0, 1), cB + hstepB, voffB); PG8_STAGE(PG8_SA(0, 0), cA, oA[0]); PG8_STAGE(PG8_SA(0, 1), cA + hstepA, oA[1]);
    if (wr == 1) PG8_BAR;
    PG8_WAIT_V(2); PG8_BAR;
    PG8_STAGE(PG8_SB(1, 0), cB + kstep, voffB); PG8_STAGE(PG8_SA(1, 0), cA + kstep, oA[0]); PG8_STAGE(PG8_SB(1, 1), cB + hstepB + kstep, voffB);
    PG8_WAIT_V(6); PG8_BAR;
    for (;;) {
        const bool has_next = S.next(ui + 1, nxt);
        const char* nA = has_next ? S.aptr(nxt) : cA; const char* nB = has_next ? S.bptr(nxt) : cB;
#pragma clang loop unroll(disable)
        for (int t = 0; t < nt; t += 2) {
            const bool last = (t == nt - 2);
            const char* a1 = cA + (size_t)(t + 1) * kstep;
            const char* a2 = last ? nA : cA + (size_t)(t + 2) * kstep; const char* b2 = last ? nB : cB + (size_t)(t + 2) * kstep;
            const char* a3 = a2 + kstep; const char* b3 = b2 + kstep;
            PG8_LDB(B0, 0, 0); PG8_LDB(B1, 0, 1); PG8_SCHED; PG8_LDA(At, 0, 0); PG8_STAGE(PG8_SA(1, 1), a1 + hstepA, oA[1]);
            if constexpr (Sched::GATHER) { if (last && has_next) {
#pragma unroll
                for (int h = 0; h < 2; ++h)
#pragma unroll
                    for (int i = 0; i < 2; ++i) oA[h][i] = S.goff(ui + 1, h * HALF + Rr[i]) + (unsigned)Cc[i] * 2u; } }
            PG8_WAIT_V(8); PG8_WAIT_L(0); PG8_BAR; PG8_MMA(0, 0, At, B0); PG8_MMA(0, 1, At, B1); PG8_BAR; PG8_SCHED;
            PG8_LDA(At, 0, 1); PG8_STAGE(PG8_SB(0, 0), b2, voffB); PG8_STAGE(PG8_SB(0, 1), b2 + hstepB, voffB); PG8_STAGE(PG8_SA(0, 0), a2, oA[0]);
            PG8_WAIT_V(8); PG8_WAIT_L(0); PG8_BAR; PG8_MMA(1, 0, At, B0); PG8_MMA(1, 1, At, B1); PG8_BAR; PG8_SCHED;
            PG8_LDB(B0, 1, 0); PG8_LDB(B1, 1, 1); PG8_SCHED; PG8_LDA(At, 1, 0); PG8_STAGE(PG8_SA(0, 1), a2 + hstepA, oA[1]);
            PG8_WAIT_V(8); PG8_WAIT_L(0); PG8_BAR; PG8_MMA(0, 0, At, B0); PG8_MMA(0, 1, At, B1); PG8_BAR; PG8_SCHED;
            PG8_LDA(At, 1, 1); PG8_STAGE(PG8_SB(1, 0), b3, voffB); PG8_STAGE(PG8_SB(1, 1), b3 + hstepB, voffB); PG8_STAGE(PG8_SA(1, 0), a3, oA[0]);
            PG8_WAIT_V(8); PG8_WAIT_L(0); PG8_BAR; PG8_MMA(1, 0, At, B0); PG8_MMA(1, 1, At, B1); PG8_BAR; PG8_SCHED;
        }
        if (wr == 0) PG8_BAR;
        bool keep = false;
        {
            int tz = threadIdx.x; asm volatile("" : "+v"(tz)); const int ewid = tz >> 6, el = tz & 63, ewr = ewid >> 2, ewc = ewid & 3, efr = el & 15, efq = el >> 4;
            if constexpr (Sched::HAS_MID) { if (S.is_mid(cur)) { E.mid(acc, cur, ewr, ewc, efr, efq); keep = true; } }
            if (!keep) E(acc, cur, ewr, ewc, efr, efq);
        }
        if (!has_next) break;
        if (!keep) {
#pragma unroll
            for (int a = 0; a < 2; ++a)
#pragma unroll
                for (int b = 0; b < 2; ++b)
#pragma unroll
                    for (int m = 0; m < 4; ++m)
#pragma unroll
                        for (int n = 0; n < 2; ++n) acc[a][b][m][n] = (f32x4){0.f, 0.f, 0.f, 0.f};
        }
        cur = nxt; cA = nA; cB = nB; ++ui;
        if (wr == 1) PG8_BAR;
    }
    PG8_WAIT_V(0);
    PG8_BAR;
#undef PG8_SA
#undef PG8_SB
#undef PG8_STAGE
#undef PG8_LDA
#undef PG8_LDB
#undef PG8_MMA
#undef PG8_CAT
#undef PG8_WAIT_V
#undef PG8_WAIT_L
#undef PG8_BAR
#undef PG8_SCHED
}
}
using pg8::Unit;

struct Args { const float* in[25]; float* out; unsigned char* ws; int ph_lo, ph_hi, rep_mask, pad; };
static_assert(sizeof(Args) == 27 * 8 + 16, "Args has no padding");
struct Frame {
    LAS unsigned char* lds; volatile LAS unsigned* MISC; unsigned* ctl;
    int tid, lane, wave, vcu, G;
};
#define LDS_WAIT() asm volatile("s_waitcnt lgkmcnt(0)" ::: "memory")
#define VM_WAIT() asm volatile("s_waitcnt vmcnt(0)" ::: "memory")

struct SchedStatic {
    static constexpr bool GATHER = false, HAS_MID = false;
    const char* A; const char* B; int nM, nN, G, c; size_t astep, bstep;
    __device__ __forceinline__ bool next(int i, Unit& u) const { u.aux = 0; return pg8::static_unit(i, G, c, nM, nN, u.pm, u.pn); }
    __device__ __forceinline__ const char* aptr(const Unit& u) const { return A + (size_t)u.pm * astep; }
    __device__ __forceinline__ const char* bptr(const Unit& u) const { return B + (size_t)u.pn * bstep; }
    __device__ __forceinline__ bool is_mid(const Unit&) const { return false; }
    __device__ __forceinline__ unsigned goff(int, int) const { return 0u; }
};
struct SchedSplit2 {
    static constexpr bool GATHER = false, HAS_MID = true;
    const char* A; const char* B; int nM, nN, G, c; size_t astep, bstep, khalf;
    __device__ __forceinline__ bool next(int i, Unit& u) const { u.aux = i & 1; return pg8::static_unit(i >> 1, G, c, nM, nN, u.pm, u.pn); }
    __device__ __forceinline__ const char* aptr(const Unit& u) const { return A + (size_t)u.pm * astep + (size_t)u.aux * khalf; }
    __device__ __forceinline__ const char* bptr(const Unit& u) const { return B + (size_t)u.pn * bstep + (size_t)u.aux * khalf; }
    __device__ __forceinline__ bool is_mid(const Unit& u) const { return u.aux == 0; }
    __device__ __forceinline__ unsigned goff(int, int) const { return 0u; }
};
__device__ __forceinline__ int moe_find_e(volatile LAS unsigned* MISC, int rb) { int e = 0;
#pragma unroll 1
    for (int i = 1; i < NEXP; ++i) e += ((int)MISC[i] <= rb) ? 1 : 0;
    return e; }
template <int NPN, bool GATH>
struct SchedMoe {
    static constexpr bool GATHER = GATH, HAS_MID = false;
    static constexpr int RPX = 32 / NPN;
    const char* A; const char* B; volatile LAS unsigned* MISC; const LAS unsigned* gtab; int c, G, nrb; size_t bstep_e, bstep_n;
    __device__ __forceinline__ bool next(int i, Unit& u) const {
        int rb, pn;
        if (G == 256) { const int x = c & 7, j = c >> 3; rb = (8 * i + x) * RPX + j / NPN; pn = j % NPN; }
        else { const long L = (long)i * G + c; rb = (int)(L / NPN); pn = (int)(L % NPN); }
        if (rb >= nrb) return false;
        u.pm = rb; u.pn = pn; u.aux = moe_find_e(MISC, rb); return true;
    }
    __device__ __forceinline__ const char* aptr(const Unit& u) const { return GATH ? A : A + (size_t)u.pm * (256 * 1024); }
    __device__ __forceinline__ const char* bptr(const Unit& u) const { return B + (size_t)u.aux * bstep_e + (size_t)u.pn * bstep_n; }
    __device__ __forceinline__ bool is_mid(const Unit&) const { return false; }
    __device__ __forceinline__ unsigned goff(int ui, int row) const { return gtab[ui * 256 + row]; }
};

#define EPI_ARGS f32x4 (&acc)[2][2][4][2], const Unit& u, int wr, int wc, int fr, int fq
struct EpiG1 {
    bf16 *Q, *K, *V, *U, *VG, *GT; const float* bgate;
    __device__ __forceinline__ void mid(EPI_ARGS) const {}
    __device__ __forceinline__ void operator()(EPI_ARGS) const {
        const int pn = u.pn; const int row0 = u.pm * 256 + wr * 64 + fr;
        if (pn < 6) {
            const int t = pn >> 1; bf16* base = Q + (size_t)t * ((WS_K - WS_Q) / 2); const float sc = (t == 0) ? QSCALE : 1.0f;    const int col0 = (pn & 1) * 256 + wc * 32 + 8 * fq;
#pragma unroll
            for (int ai = 0; ai < 2; ++ai)
#pragma unroll
                for (int m = 0; m < 4; ++m) { bf16* rowp = base + (size_t)(row0 + ai * 128 + m * 16) * 512 + col0;
#pragma unroll
                    for (int bj = 0; bj < 2; ++bj) { const f32x4 v0 = acc[ai][bj][m][0] * sc, v1 = acc[ai][bj][m][1] * sc;
                        u32x4 w; w.x = cvtpk(v0[0], v0[1]); w.y = cvtpk(v0[2], v0[3]); w.z = cvtpk(v1[0], v1[1]); w.w = cvtpk(v1[2], v1[3]); *(u32x4*)(rowp + bj * 128) = w; } }
        } else if (pn < 10) {
            bf16* base = Q + (size_t)(pn >> 1) * ((WS_K - WS_Q) / 2); const int col0 = (pn & 1) * 256 + wc * 32 + 8 * fq;
#pragma unroll
            for (int ai = 0; ai < 2; ++ai)
#pragma unroll
                for (int m = 0; m < 4; ++m) { bf16* rowp = base + (size_t)(row0 + ai * 128 + m * 16) * 512 + col0;
#pragma unroll
                    for (int bj = 0; bj < 2; ++bj) { const f32x4 v0 = acc[ai][bj][m][0], v1 = acc[ai][bj][m][1];
                        const f32x2 a = gelu_pk((f32x2){v0[0], v0[1]}), b = gelu_pk((f32x2){v0[2], v0[3]}), c = gelu_pk((f32x2){v1[0], v1[1]}), d = gelu_pk((f32x2){v1[2], v1[3]});
                        u32x4 w; w.x = cvtpk(a.x, a.y); w.y = cvtpk(b.x, b.y); w.z = cvtpk(c.x, c.y); w.w = cvtpk(d.x, d.y); *(u32x4*)(rowp + bj * 128) = w; } }
        } else {
            const int col0 = (pn - 10) * 256 + wc * 32 + 8 * fq;
            f32x4 bv[2][2];
#pragma unroll
            for (int bj = 0; bj < 2; ++bj)
#pragma unroll
                for (int n = 0; n < 2; ++n) bv[bj][n] = *(const f32x4*)(bgate + col0 + bj * 128 + 4 * n);
#pragma unroll
            for (int ai = 0; ai < 2; ++ai)
#pragma unroll
                for (int m = 0; m < 4; ++m) { bf16* rowp = GT + (size_t)(row0 + ai * 128 + m * 16) * 2048 + col0;
#pragma unroll
                    for (int bj = 0; bj < 2; ++bj) { const f32x4 v0 = acc[ai][bj][m][0] + bv[bj][0], v1 = acc[ai][bj][m][1] + bv[bj][1];
                        u32x4 w; w.x = cvtpk(fast_sigmoid(v0[0]), fast_sigmoid(v0[1])); w.y = cvtpk(fast_sigmoid(v0[2]), fast_sigmoid(v0[3]));
                        w.z = cvtpk(fast_sigmoid(v1[0]), fast_sigmoid(v1[1])); w.w = cvtpk(fast_sigmoid(v1[2]), fast_sigmoid(v1[3])); *(u32x4*)(rowp + bj * 128) = w; } }
        }
    }
};
struct EpiG2 {
    const bf16* GT; bf16* MRG;
    __device__ __forceinline__ void mid(EPI_ARGS) const {
        const int row0 = u.pm * 256 + wr * 64 + fr, col0 = u.pn * 256 + wc * 32 + 8 * fq;
#pragma unroll
        for (int ai = 0; ai < 2; ++ai)
#pragma unroll
            for (int m = 0; m < 4; ++m) { const bf16* gp = GT + (size_t)(row0 + ai * 128 + m * 16) * 2048 + col0;
#pragma unroll
                for (int bj = 0; bj < 2; ++bj) { const u32x4 ga = *(const u32x4*)(gp + bj * 128), gb = *(const u32x4*)(gp + 1024 + bj * 128);
                    f32x4 r0, r1;
                    r0[0] = bflo(ga.x) * __builtin_amdgcn_rcpf(fmaxf(bflo(gb.x), 1e-30f)); r0[1] = bfhi(ga.x) * __builtin_amdgcn_rcpf(fmaxf(bfhi(gb.x), 1e-30f));
                    r0[2] = bflo(ga.y) * __builtin_amdgcn_rcpf(fmaxf(bflo(gb.y), 1e-30f)); r0[3] = bfhi(ga.y) * __builtin_amdgcn_rcpf(fmaxf(bfhi(gb.y), 1e-30f));
                    r1[0] = bflo(ga.z) * __builtin_amdgcn_rcpf(fmaxf(bflo(gb.z), 1e-30f)); r1[1] = bfhi(ga.z) * __builtin_amdgcn_rcpf(fmaxf(bfhi(gb.z), 1e-30f));
                    r1[2] = bflo(ga.w) * __builtin_amdgcn_rcpf(fmaxf(bflo(gb.w), 1e-30f)); r1[3] = bfhi(ga.w) * __builtin_amdgcn_rcpf(fmaxf(bfhi(gb.w), 1e-30f));
                    acc[ai][bj][m][0] *= r0; acc[ai][bj][m][1] *= r1; } }
    }
    __device__ __forceinline__ void operator()(EPI_ARGS) const {
        const int row0 = u.pm * 256 + wr * 64 + fr, col0 = u.pn * 256 + wc * 32 + 8 * fq;
#pragma unroll
        for (int ai = 0; ai < 2; ++ai)
#pragma unroll
            for (int m = 0; m < 4; ++m) { const size_t r = (size_t)(row0 + ai * 128 + m * 16); const bf16* gp = GT + r * 2048 + 1024 + col0; bf16* op = MRG + r * 1024 + col0;
#pragma unroll
                for (int bj = 0; bj < 2; ++bj) { const u32x4 gb = *(const u32x4*)(gp + bj * 128); const f32x4 v0 = acc[ai][bj][m][0], v1 = acc[ai][bj][m][1];
                    u32x4 w; w.x = cvtpk(v0[0] * bflo(gb.x), v0[1] * bfhi(gb.x)); w.y = cvtpk(v0[2] * bflo(gb.y), v0[3] * bfhi(gb.y));
                    w.z = cvtpk(v1[0] * bflo(gb.z), v1[1] * bfhi(gb.z)); w.w = cvtpk(v1[2] * bflo(gb.w), v1[3] * bfhi(gb.w)); *(u32x4*)(op + bj * 128) = w; } }
    }
};
struct EpiPlain {
    bf16* O;
    __device__ __forceinline__ void mid(EPI_ARGS) const {}
    __device__ __forceinline__ void operator()(EPI_ARGS) const {
        const int row0 = u.pm * 256 + wr * 64 + fr, col0 = u.pn * 256 + wc * 32 + 8 * fq;
#pragma unroll
        for (int ai = 0; ai < 2; ++ai)
#pragma unroll
            for (int m = 0; m < 4; ++m) { bf16* op = O + (size_t)(row0 + ai * 128 + m * 16) * 1024 + col0;
#pragma unroll
                for (int bj = 0; bj < 2; ++bj) { const f32x4 v0 = acc[ai][bj][m][0], v1 = acc[ai][bj][m][1];
                    u32x4 w; w.x = cvtpk(v0[0], v0[1]); w.y = cvtpk(v0[2], v0[3]); w.z = cvtpk(v1[0], v1[1]); w.w = cvtpk(v1[2], v1[3]); *(u32x4*)(op + bj * 128) = w; } }
    }
};
struct EpiAct {
    const float* bgu; unsigned char* ACT8;
    __device__ __forceinline__ void mid(EPI_ARGS) const {}
    __device__ __forceinline__ void operator()(EPI_ARGS) const {
        const int e = u.aux; const int row0 = u.pm * 256 + wr * 64 + fr, col0 = u.pn * 128 + wc * 32 + 8 * fq;
        const float* bp = bgu + (size_t)e * 2048 + col0;
        const f32x4 bg0 = *(const f32x4*)(bp), bg1 = *(const f32x4*)(bp + 4), bl0 = *(const f32x4*)(bp + 1024), bl1 = *(const f32x4*)(bp + 1028);
#pragma unroll
        for (int ai = 0; ai < 2; ++ai)
#pragma unroll
            for (int m = 0; m < 4; ++m) {
                f32x4 o[2];
#pragma unroll
                for (int n = 0; n < 2; ++n) { const f32x4 g = acc[ai][0][m][n] * F8_DESCALE + (n ? bg1 : bg0), l = acc[ai][1][m][n] * F8_DESCALE + (n ? bl1 : bl0);
#pragma unroll
                    for (int i = 0; i < 4; ++i) { const float xg = fminf(g[i], SWL), xl = fminf(fmaxf(l[i], -SWL), SWL); o[n][i] = xg * fast_sigmoid(SWA * xg) * (xl + 1.0f) * F8_ASCALE; } }
                u32x2 w; w.x = pk_fp8x4(o[0][0], o[0][1], o[0][2], o[0][3]); w.y = pk_fp8x4(o[1][0], o[1][1], o[1][2], o[1][3]);
                *(u32x2*)(ACT8 + (size_t)(row0 + ai * 128 + m * 16) * 1024 + col0) = w; }
    }
};
struct EpiDown {
    const float* bdn; const int* list; const float* topg; volatile LAS unsigned* MISC; bf16* Y2;
    __device__ __forceinline__ void mid(EPI_ARGS) const {}
    __device__ __forceinline__ void operator()(EPI_ARGS) const {
        const int e = u.aux; const int j256 = (u.pm - (int)MISC[e]) * 256; const int ecnt = (int)MISC[40 + e];
        const int col0 = u.pn * 256 + wc * 32 + 8 * fq;
        f32x4 bv[2][2];
#pragma unroll
        for (int bj = 0; bj < 2; ++bj)
#pragma unroll
            for (int n = 0; n < 2; ++n) bv[bj][n] = *(const f32x4*)(bdn + (size_t)e * 1024 + col0 + bj * 128 + 4 * n);
#pragma unroll
        for (int ai = 0; ai < 2; ++ai)
#pragma unroll
            for (int m = 0; m < 4; ++m) { const int pos = j256 + ai * 128 + wr * 64 + m * 16 + fr;
                int slot = TRASH_SLOT; if (pos < ecnt) slot = list[(size_t)e * NTOK + pos];
                const float g = topg[slot]; bf16* op = Y2 + (size_t)slot * 1024 + col0;
#pragma unroll
                for (int bj = 0; bj < 2; ++bj) { const f32x4 v0 = (acc[ai][bj][m][0] * F8_DESCALE + bv[bj][0]) * g, v1 = (acc[ai][bj][m][1] * F8_DESCALE + bv[bj][1]) * g;
                    u32x4 w; w.x = cvtpk(v0[0], v0[1]); w.y = cvtpk(v0[2], v0[3]); w.z = cvtpk(v1[0], v1[1]); w.w = cvtpk(v1[2], v1[3]); *(u32x4*)(op + bj * 128) = w; }
                if (m & 1) asm volatile("" ::: "memory"); }
    }
};

__device__ __forceinline__ void tr_item(const float* W, int N, bf16* WT, int ldt, int k0, int n0, int drow0, int dk0, LAS float* scr, int lane) {
#pragma unroll 8
    for (int i = 0; i < 32; ++i) { const int kk = 2 * i + (lane >> 5); scr[kk * 33 + (lane & 31)] = W[(size_t)(k0 + kk) * N + n0 + (lane & 31)]; }
    LDS_WAIT(); asm volatile("" ::: "memory");
    const int c = lane & 7;
#pragma unroll
    for (int j = 0; j < 4; ++j) { const int n = (lane >> 3) + 8 * j; const LAS float* s = scr + (8 * c) * 33 + n;
        u32x4 o; o.x = cvtpk(s[0 * 33], s[1 * 33]); o.y = cvtpk(s[2 * 33], s[3 * 33]); o.z = cvtpk(s[4 * 33], s[5 * 33]); o.w = cvtpk(s[6 * 33], s[7 * 33]);
        *(u32x4*)(WT + (size_t)(drow0 + n) * ldt + dk0 + k0 + 8 * c) = o; }
    LDS_WAIT(); asm volatile("" ::: "memory");
}
__device__ __forceinline__ void tr_item8(const float* W, int N, unsigned char* WT, int ldt, int k0, int n0, int drow0, float scale, LAS float* scr, int lane) {
#pragma unroll 8
    for (int i = 0; i < 64; ++i) { const int kk = 2 * i + (lane >> 5); scr[kk * 33 + (lane & 31)] = W[(size_t)(k0 + kk) * N + n0 + (lane & 31)]; }
    LDS_WAIT(); asm volatile("" ::: "memory");
    const int c = lane & 7;
#pragma unroll
    for (int j = 0; j < 4; ++j) { const int n = (lane >> 3) + 8 * j; const LAS float* s = scr + (16 * c) * 33 + n;
        u32x4 o;
        o.x = pk_fp8x4(s[0 * 33] * scale, s[1 * 33] * scale, s[2 * 33] * scale, s[3 * 33] * scale); o.y = pk_fp8x4(s[4 * 33] * scale, s[5 * 33] * scale, s[6 * 33] * scale, s[7 * 33] * scale);
        o.z = pk_fp8x4(s[8 * 33] * scale, s[9 * 33] * scale, s[10 * 33] * scale, s[11 * 33] * scale); o.w = pk_fp8x4(s[12 * 33] * scale, s[13 * 33] * scale, s[14 * 33] * scale, s[15 * 33] * scale);
        *(u32x4*)(WT + (size_t)(drow0 + n) * ldt + k0 + 16 * c) = o; }
    LDS_WAIT(); asm volatile("" ::: "memory");
}
__device__ __forceinline__ void phaseA(const Frame& F, const Args& a) {
    unsigned char* ws = a.ws;
    if (F.vcu < 192) {
        const float* c = a.in[1]; const float* w_ada = a.in[2]; const float* b_ada = a.in[3]; float* mod = (float*)(ws + WS_MOD);
        LAS float* red = (LAS float*)(F.lds);
        const int col = F.vcu * 32 + (F.tid & 31), ks = F.tid >> 5;
        float a0 = 0.f, a1 = 0.f, a2 = 0.f, a3 = 0.f;
        for (int k = ks * 64; k < ks * 64 + 64; ++k) { const float w = w_ada[(size_t)k * 6144 + col];
            const float c0 = c[k], c1 = c[D + k], c2 = c[2 * D + k], c3 = c[3 * D + k];
            a0 += c0 * __builtin_amdgcn_rcpf(1.0f + __expf(-c0)) * w; a1 += c1 * __builtin_amdgcn_rcpf(1.0f + __expf(-c1)) * w;
            a2 += c2 * __builtin_amdgcn_rcpf(1.0f + __expf(-c2)) * w; a3 += c3 * __builtin_amdgcn_rcpf(1.0f + __expf(-c3)) * w; }
        red[(ks * 4 + 0) * 32 + (F.tid & 31)] = a0; red[(ks * 4 + 1) * 32 + (F.tid & 31)] = a1; red[(ks * 4 + 2) * 32 + (F.tid & 31)] = a2; red[(ks * 4 + 3) * 32 + (F.tid & 31)] = a3;
        __syncthreads();
        if (F.tid < 128) { const int b = F.tid >> 5, cc = F.tid & 31; float s = 0.f;
#pragma unroll
            for (int k = 0; k < 16; ++k) s += red[(k * 4 + b) * 32 + cc];
            mod[b * 6144 + F.vcu * 32 + cc] = s + b_ada[F.vcu * 32 + cc]; }
        __syncthreads();
    }
    LAS float* scr = (LAS float*)(F.lds + F.wave * 17408);
    const int gw = F.vcu * NWAVES + F.wave, NGW = F.G * NWAVES;
    bf16* W1T = (bf16*)(ws + WS_W1T); bf16* WBRT = (bf16*)(ws + WS_WBRT); bf16* WOUTT = (bf16*)(ws + WS_WOUTT); unsigned char* WGUT = ws + WS_WGUT; unsigned char* WDNT = ws + WS_WDNT;
    constexpr int I_IN = 16 * 80, I_GATE = 16 * 64, I_BR = 8 * 32, I_OUT = 16 * 32, I_GU = 8 * 64, I_DN = 8 * 32;
    constexpr int NITEMS = I_IN + I_GATE + 2 * I_BR + I_OUT + NEXP * (I_GU + I_DN);
    for (int it = gw; it < NITEMS; it += NGW) {
        int r = it;
        if (r < I_IN) { const int n0 = 32 * (r % 80); tr_item(a.in[6], INW, W1T, 1024, 64 * (r / 80), n0, n0, 0, scr, F.lane); continue; } r -= I_IN;
        if (r < I_GATE) { const int n0 = 32 * (r % 64); tr_item(a.in[14], 2048, W1T, 1024, 64 * (r / 64), n0, INW + n0, 0, scr, F.lane); continue; } r -= I_GATE;
        if (r < I_BR) { const int n0 = 32 * (r % 32); tr_item(a.in[12], 1024, WBRT, 1024, 64 * (r / 32), n0, n0, 0, scr, F.lane); continue; } r -= I_BR;
        if (r < I_BR) { const int n0 = 32 * (r % 32); tr_item(a.in[13], 1024, WBRT, 1024, 64 * (r / 32), n0, n0, 512, scr, F.lane); continue; } r -= I_BR;
        if (r < I_OUT) { const int n0 = 32 * (r % 32); tr_item(a.in[16], 1024, WOUTT, 1024, 64 * (r / 32), n0, n0, 0, scr, F.lane); continue; } r -= I_OUT;
        if (r < NEXP * I_GU) { const int e = r / I_GU, q = r % I_GU, kb = q / 64, nb = q % 64, n0 = 32 * nb;
            const int m0 = n0 & 1023, drow = 256 * (m0 >> 7) + (m0 & 127) + (n0 >= 1024 ? 128 : 0);
            tr_item8(a.in[21] + (size_t)e * D * 2048, 2048, WGUT + (size_t)e * 2048 * 1024, 1024, 128 * kb, n0, drow, F8_WSCALE, scr, F.lane); continue; } r -= NEXP * I_GU;
        { const int e = r / I_DN, q = r % I_DN, n0 = 32 * (q % 32); tr_item8(a.in[23] + (size_t)e * D * D, 1024, WDNT + (size_t)e * 1024 * 1024, 1024, 128 * (q / 32), n0, n0, F8_WSCALE, scr, F.lane); }
    }
}
__device__ __forceinline__ void phaseB(const Frame& F, const Args& a) {
    const float* x = a.in[0]; const float* g = a.in[4]; const float* mod = (const float*)(a.ws + WS_MOD); bf16* xn = (bf16*)(a.ws + WS_XN);
    const int gw = F.vcu * NWAVES + F.wave, NGW = F.G * NWAVES;
    for (int row0 = gw * 4; row0 < NTOK; row0 += NGW * 4) {
        f32x4 v[4][4];
#pragma unroll
        for (int rr = 0; rr < 4; ++rr)
#pragma unroll
            for (int j = 0; j < 4; ++j) v[rr][j] = *((const f32x4*)(x + (size_t)(row0 + rr) * D) + F.lane + 64 * j);
        const int b = row0 / SEQ; const float* mb = mod + b * 6144;
#pragma unroll
        for (int rr = 0; rr < 4; ++rr) {
            float ss = 0.f;
#pragma unroll
            for (int j = 0; j < 4; ++j) ss += (v[rr][j].x * v[rr][j].x + v[rr][j].y * v[rr][j].y) + (v[rr][j].z * v[rr][j].z + v[rr][j].w * v[rr][j].w);
            const float rstd = rsqrtf(wave_sum(ss) * (1.0f / D) + EPS);
            u32x2* o8 = (u32x2*)(xn + (size_t)(row0 + rr) * D) + F.lane;
#pragma unroll
            for (int j = 0; j < 4; ++j) { const int c0 = (F.lane + 64 * j) * 4;
                const f32x4 gg = *(const f32x4*)(g + c0), sc = *(const f32x4*)(mb + SC1 + c0), sh = *(const f32x4*)(mb + SH1 + c0);
                const f32x4 h = v[rr][j] * rstd * gg * (sc + 1.0f) + sh;
                u32x2 w; w.x = cvtpk(h[0], h[1]); w.y = cvtpk(h[2], h[3]); o8[64 * j] = w; }
        }
    }
}

constexpr int SGU_STRIDE = 1088;
__device__ __forceinline__ s16x4 vtr(const LAS unsigned char* p) { typedef short v4i16_t __attribute__((ext_vector_type(4))); return __builtin_bit_cast(s16x4, __builtin_amdgcn_ds_read_tr16_b64_v4i16((LAS v4i16_t*)p)); }
__device__ __forceinline__ void sgu_unit(const Frame& F, const Args& a, int b, int blk) {
    const bf16* VG = (const bf16*)(a.ws + WS_VG); const bf16* U = (const bf16*)(a.ws + WS_U); bf16* YAB = (bf16*)(a.ws + WS_YAB);
    const float* ln_g = a.in[8]; const float* ln_b = a.in[9]; const float* w_s = a.in[10]; const float* b_s = a.in[11];
    const int tok0 = b * SEQ + blk * SGB, lane = F.lane;
    {
        f32x4 g0 = *(const f32x4*)(ln_g + lane * 8), g1 = *(const f32x4*)(ln_g + lane * 8 + 4), b0 = *(const f32x4*)(ln_b + lane * 8), b1 = *(const f32x4*)(ln_b + lane * 8 + 4);
#pragma unroll 4
        for (int rr = 0; rr < 16; ++rr) { const int row = F.wave * 16 + rr;
            const u32x4 w = *(const u32x4*)(VG + (size_t)(tok0 + row) * 512 + lane * 8);
            f32x4 v0 = {bflo(w.x), bfhi(w.x), bflo(w.y), bfhi(w.y)}, v1 = {bflo(w.z), bfhi(w.z), bflo(w.w), bfhi(w.w)};
            const float mu = wave_sum((v0[0] + v0[1]) + (v0[2] + v0[3]) + (v1[0] + v1[1]) + (v1[2] + v1[3])) * (1.0f / 512.0f);
            v0 -= mu; v1 -= mu;
            const float var = wave_sum((v0[0] * v0[0] + v0[1] * v0[1]) + (v0[2] * v0[2] + v0[3] * v0[3]) + (v1[0] * v1[0] + v1[1] * v1[1]) + (v1[2] * v1[2] + v1[3] * v1[3])) * (1.0f / 512.0f);
            const float rstd = rsqrtf(var + EPS);
            v0 = v0 * rstd * g0 + b0; v1 = v1 * rstd * g1 + b1;
            u32x4 o; o.x = cvtpk(v0[0], v0[1]); o.y = cvtpk(v0[2], v0[3]); o.z = cvtpk(v1[0], v1[1]); o.w = cvtpk(v1[2], v1[3]);
            *(LAS u32x4*)(F.lds + row * SGU_STRIDE + lane * 16) = o; }
    }
    __syncthreads();
    {
        const int g = F.wave, r32 = lane & 31, hi = lane >> 5, i16 = lane & 15, g16 = (lane >> 4) & 1;
        const LAS unsigned char* vb = F.lds + (8 * hi + (i16 >> 2)) * SGU_STRIDE + (g * 64 + 16 * g16 + 4 * (i16 & 3)) * 2;
#pragma unroll 1
        for (int tb = 0; tb < 4; ++tb) {
            const int t = 32 * tb + r32; const float* wrow = w_s + ((size_t)g * 128 + t) * 128;
            f32x16 a0, a1;
#pragma unroll
            for (int r = 0; r < 16; ++r) { a0[r] = 0.f; a1[r] = 0.f; }
#pragma unroll 1
            for (int ks = 0; ks < 2 * tb + 2; ++ks) {
                const int s0 = 16 * ks + 8 * hi;
                const f32x4 w0 = *(const f32x4*)(wrow + s0), w1 = *(const f32x4*)(wrow + s0 + 4);
                float wv[8] = {w0[0], w0[1], w0[2], w0[3], w1[0], w1[1], w1[2], w1[3]};
#pragma unroll
                for (int j = 0; j < 8; ++j) wv[j] = (s0 + j <= t) ? wv[j] : 0.f;
                u32x4 bw; bw.x = cvtpk(wv[0], wv[1]); bw.y = cvtpk(wv[2], wv[3]); bw.z = cvtpk(wv[4], wv[5]); bw.w = cvtpk(wv[6], wv[7]);
                const bf16x8 bfrag = __builtin_bit_cast(bf16x8, bw);
                const LAS unsigned char* p = vb + ks * 16 * SGU_STRIDE;
                const s16x4 l0 = vtr(p), h0 = vtr(p + 4 * SGU_STRIDE), l1 = vtr(p + 64), h1 = vtr(p + 4 * SGU_STRIDE + 64);
                const bf16x8 A0 = {l0[0], l0[1], l0[2], l0[3], h0[0], h0[1], h0[2], h0[3]}, A1 = {l1[0], l1[1], l1[2], l1[3], h1[0], h1[1], h1[2], h1[3]};
                a0 = __builtin_amdgcn_mfma_f32_32x32x16_bf16(A0, bfrag, a0, 0, 0, 0);
                a1 = __builtin_amdgcn_mfma_f32_32x32x16_bf16(A1, bfrag, a1, 0, 0, 0);
            }
            const float bs = b_s[g * 128 + t];
            const bf16* up = U + (size_t)(tok0 + t) * 512 + g * 64 + 4 * hi; bf16* op = YAB + (size_t)(tok0 + t) * 1024 + 512 + g * 64 + 4 * hi;
#pragma unroll
            for (int gg = 0; gg < 4; ++gg) {
                const u32x2 u0 = *(const u32x2*)(up + 8 * gg), u1 = *(const u32x2*)(up + 32 + 8 * gg);
                u32x2 o0, o1;
                o0.x = cvtpk(bflo(u0.x) * (a0[4 * gg] + bs), bfhi(u0.x) * (a0[4 * gg + 1] + bs)); o0.y = cvtpk(bflo(u0.y) * (a0[4 * gg + 2] + bs), bfhi(u0.y) * (a0[4 * gg + 3] + bs));
                o1.x = cvtpk(bflo(u1.x) * (a1[4 * gg] + bs), bfhi(u1.x) * (a1[4 * gg + 1] + bs)); o1.y = cvtpk(bflo(u1.y) * (a1[4 * gg + 2] + bs), bfhi(u1.y) * (a1[4 * gg + 3] + bs));
                *(u32x2*)(op + 8 * gg) = o0; *(u32x2*)(op + 32 + 8 * gg) = o1; }
        }
    }
    __syncthreads();
}

__device__ __forceinline__ void attn_task(const bf16* __restrict__ Q, const bf16* __restrict__ Kb, const bf16* __restrict__ Vb, bf16* YAB, LAS unsigned char* vt, const LAS float* bt,
                                          int b, int c, int h, int half, int lane) {
    const int r32 = lane & 31, hi = lane >> 5, i16 = lane & 15, g16 = (lane >> 4) & 1;
    const int tok0 = b * SEQ + c * CHUNK, qi = half * 32 + r32, qtok = tok0 + qi;
    bf16x8 qf[4];
#pragma unroll
    for (int s = 0; s < 4; ++s) qf[s] = *(const bf16x8*)(Q + (size_t)qtok * 512 + h * 64 + 16 * s + 8 * hi);
    f32x16 o0, o1;
#pragma unroll
    for (int r = 0; r < 16; ++r) { o0[r] = 0.f; o1[r] = 0.f; }
    float m = -1e30f, l = 0.f;
    const int j0 = (c < NLEFT) ? (NLEFT - c) : 0;
    const int fb = (i16 >> 3) & 1;
    LAS unsigned char* vw = vt + (lane >> 3) * 128 + (((lane & 7) ^ (((lane >> 4) & 1) * 4)) * 16);
    const LAS unsigned char* vr0 = vt + (4 * hi + (i16 >> 2)) * 128 + ((4 * (0 ^ fb) + 2 * g16 + ((i16 & 3) >> 1)) * 16) + (i16 & 1) * 8;
    const LAS unsigned char* vr1 = vt + (4 * hi + (i16 >> 2)) * 128 + ((4 * (1 ^ fb) + 2 * g16 + ((i16 & 3) >> 1)) * 16) + (i16 & 1) * 8;
    const size_t hoff = (size_t)h * 64;
    bf16x8 kf[2][4]; u32x4 vn[8];
    {
        const bf16* kp = Kb + (size_t)(tok0 + (j0 - NLEFT) * CHUNK) * 512 + hoff; const bf16* vp = Vb + (size_t)(tok0 + (j0 - NLEFT) * CHUNK) * 512 + hoff;
#pragma unroll
        for (int blk = 0; blk < 2; ++blk)
#pragma unroll
            for (int s = 0; s < 4; ++s) kf[blk][s] = *(const bf16x8*)(kp + (size_t)(32 * blk + r32) * 512 + 16 * s + 8 * hi);
#pragma unroll
        for (int p = 0; p < 8; ++p) vn[p] = *(const u32x4*)(vp + (size_t)(8 * p + (lane >> 3)) * 512 + (lane & 7) * 8);
#pragma unroll
        for (int p = 0; p < 8; ++p) *(LAS u32x4*)(vw + p * 1024) = vn[p];
    }
#pragma unroll 1
    for (int j = j0; j < 9; ++j) {
        const bool more = (j + 1 < 9);
        const bf16* kp = Kb + (size_t)(tok0 + (j + 1 - NLEFT) * CHUNK) * 512 + hoff; const bf16* vp = Vb + (size_t)(tok0 + (j + 1 - NLEFT) * CHUNK) * 512 + hoff;
        if (more) {
#pragma unroll
            for (int p = 0; p < 8; ++p) vn[p] = *(const u32x4*)(vp + (size_t)(8 * p + (lane >> 3)) * 512 + (lane & 7) * 8);
        }
        f32x16 p0, p1;
#pragma unroll
        for (int r = 0; r < 16; ++r) { p0[r] = 0.f; p1[r] = 0.f; }
#pragma unroll
        for (int s = 0; s < 4; ++s) { p0 = __builtin_amdgcn_mfma_f32_32x32x16_bf16(kf[0][s], qf[s], p0, 0, 0, 0); p1 = __builtin_amdgcn_mfma_f32_32x32x16_bf16(kf[1][s], qf[s], p1, 0, 0, 0); }
        if (more) {
#pragma unroll
            for (int blk = 0; blk < 2; ++blk)
#pragma unroll
                for (int s = 0; s < 4; ++s) kf[blk][s] = *(const bf16x8*)(kp + (size_t)(32 * blk + r32) * 512 + 16 * s + 8 * hi);
        }
        if (j >= 6) {
            const int base = 640 + qi - 64 * j - 4 * hi;
#pragma unroll
            for (int r = 0; r < 16; ++r) { const int kk = (r & 3) + 8 * (r >> 2); int i0 = base - kk, i1 = base - 32 - kk; i0 = i0 > 256 ? 256 : i0; i1 = i1 > 256 ? 256 : i1; p0[r] += bt[i0]; p1[r] += bt[i1]; }
        }
        float tm = fmaxf(p0[0], p1[0]);
#pragma unroll
        for (int r = 1; r < 16; ++r) tm = fmaxf(tm, fmaxf(p0[r], p1[r]));
        tm = fmaxf(tm, __shfl_xor(tm, 32));
        const float mn = fmaxf(m, tm), alpha = __builtin_amdgcn_exp2f(m - mn); m = mn;
        float ps = 0.f;
#pragma unroll
        for (int r = 0; r < 16; ++r) { p0[r] = __builtin_amdgcn_exp2f(p0[r] - mn); p1[r] = __builtin_amdgcn_exp2f(p1[r] - mn); ps += p0[r] + p1[r]; }
        l = l * alpha + ps;
#pragma unroll
        for (int r = 0; r < 16; ++r) { o0[r] *= alpha; o1[r] *= alpha; }
        bf16x8 pb[2][2];
#pragma unroll
        for (int s = 0; s < 2; ++s) {
            u32x4 w0; w0.x = cvtpk(p0[8 * s], p0[8 * s + 1]); w0.y = cvtpk(p0[8 * s + 2], p0[8 * s + 3]); w0.z = cvtpk(p0[8 * s + 4], p0[8 * s + 5]); w0.w = cvtpk(p0[8 * s + 6], p0[8 * s + 7]);
            u32x4 w1; w1.x = cvtpk(p1[8 * s], p1[8 * s + 1]); w1.y = cvtpk(p1[8 * s + 2], p1[8 * s + 3]); w1.z = cvtpk(p1[8 * s + 4], p1[8 * s + 5]); w1.w = cvtpk(p1[8 * s + 6], p1[8 * s + 7]);
            pb[0][s] = __builtin_bit_cast(bf16x8, w0); pb[1][s] = __builtin_bit_cast(bf16x8, w1); }
#pragma unroll
        for (int blk = 0; blk < 2; ++blk)
#pragma unroll
            for (int s = 0; s < 2; ++s) {
                const int ko = (32 * blk + 16 * s) * 128;
                const s16x4 l0 = vtr(vr0 + ko), h0 = vtr(vr0 + ko + 1024), l1 = vtr(vr1 + ko), h1 = vtr(vr1 + ko + 1024);
                const bf16x8 A0 = {l0[0], l0[1], l0[2], l0[3], h0[0], h0[1], h0[2], h0[3]}, A1 = {l1[0], l1[1], l1[2], l1[3], h1[0], h1[1], h1[2], h1[3]};
                o0 = __builtin_amdgcn_mfma_f32_32x32x16_bf16(A0, pb[blk][s], o0, 0, 0, 0);
                o1 = __builtin_amdgcn_mfma_f32_32x32x16_bf16(A1, pb[blk][s], o1, 0, 0, 0);
            }
        if (more) {
#pragma unroll
            for (int p = 0; p < 8; ++p) *(LAS u32x4*)(vw + p * 1024) = vn[p];
        }
    }
    l += __shfl_xor(l, 32);
    const float inv = __builtin_amdgcn_rcpf(l);
    bf16* op = YAB + (size_t)qtok * 1024 + hoff + 4 * hi;
#pragma unroll
    for (int gg = 0; gg < 4; ++gg) {
        u32x2 w0, w1;
        w0.x = cvtpk(o0[4 * gg] * inv, o0[4 * gg + 1] * inv); w0.y = cvtpk(o0[4 * gg + 2] * inv, o0[4 * gg + 3] * inv);
        w1.x = cvtpk(o1[4 * gg] * inv, o1[4 * gg + 1] * inv); w1.y = cvtpk(o1[4 * gg + 2] * inv, o1[4 * gg + 3] * inv);
        *(u32x2*)(op + 8 * gg) = w0; *(u32x2*)(op + 32 + 8 * gg) = w1; }
}
__device__ __forceinline__ void phaseD(const Frame& F, const Args& a) {
    for (int unit = F.vcu; unit < NB * (SEQ / SGB); unit += F.G) sgu_unit(F, a, unit / (SEQ / SGB), unit % (SEQ / SGB));
    const bf16* Q = (const bf16*)(a.ws + WS_Q); const bf16* Kb = (const bf16*)(a.ws + WS_K); const bf16* Vb = (const bf16*)(a.ws + WS_V); bf16* YAB = (bf16*)(a.ws + WS_YAB);
    LAS unsigned char* vt = F.lds + F.wave * 8192; LAS float* bt = (LAS float*)(F.lds + 65536 + F.wave * 1088);
    const float* rb = a.in[7] + F.wave * NREL; const float b256 = rb[256];
    for (int i = F.lane; i < NREL; i += 64) bt[i] = (rb[i] - b256) * LOG2E;
    LDS_WAIT();
    const int NCH = NB * (SEQ / CHUNK);
    for (int v = F.vcu; v < NCH / 2; v += F.G) {
#pragma unroll 1
        for (int k = 0; k < 4; ++k) { const int gc = (k < 2) ? v : (NCH - 1 - v); attn_task(Q, Kb, Vb, YAB, vt, bt, gc / (SEQ / CHUNK), gc % (SEQ / CHUNK), F.wave, k & 1, F.lane); }
    }
}

constexpr int G_HT_STRIDE = 2064;
__device__ __forceinline__ void phaseG(const Frame& F, const Args& a) {
    const float* x = a.in[0]; const bf16* Y1 = (const bf16*)(a.ws + WS_Y1); const float* mod = (const float*)(a.ws + WS_MOD); const float* g_post_mix = a.in[5]; const float* g_pre_ffn = a.in[17];
    const float* w_router = a.in[19]; const float* b_router = a.in[20]; float* X1 = a.out; unsigned char* XN8 = a.ws + WS_XN;
    int* tope = (int*)(a.ws + WS_TOPE); float* topg = (float*)(a.ws + WS_TOPG); int* list = (int*)(a.ws + WS_LIST); unsigned* cnt = F.ctl + CW_CNT;
    LAS unsigned char* HT = F.lds;
    LAS float* PL = (LAS float*)(F.lds + 33792);
    LAS float* LG = PL + 8 * 32 * 16;
    LAS float* TV = LG + 512;
    LAS unsigned* LC = (LAS unsigned*)(TV + 64);
    LAS unsigned* AS = LC + 64;
    const int tid = F.tid, lane = F.lane, wave = F.wave, kq = lane >> 4, i16 = lane & 15;
    if (tid < 64) LC[tid] = 0u;
    bf16x8 whi[2][4], wlo[2][4];
#pragma unroll
    for (int et = 0; et < 2; ++et)
#pragma unroll
        for (int ks = 0; ks < 4; ++ks) { unsigned h[4], l[4];
#pragma unroll
            for (int jj = 0; jj < 4; ++jj) { const int k = 128 * wave + 32 * ks + 8 * kq + 2 * jj;
                const float w0 = w_router[(size_t)k * NEXP + et * 16 + i16], w1 = w_router[(size_t)(k + 1) * NEXP + et * 16 + i16];
                const unsigned hh = cvtpk(w0, w1); h[jj] = hh; l[jj] = cvtpk(w0 - bflo(hh), w1 - bfhi(hh)); }
            u32x4 hv = {h[0], h[1], h[2], h[3]}, lv = {l[0], l[1], l[2], l[3]};
            whi[et][ks] = __builtin_bit_cast(bf16x8, hv); wlo[et][ks] = __builtin_bit_cast(bf16x8, lv); }
    __syncthreads();
    int tl = 0;
    for (int T = F.vcu; T < NTOK / 16; T += F.G, ++tl) {
        const int b = (16 * T) / SEQ; const float* mb = mod + b * 6144; const int rbase = 16 * T + 2 * wave;
        f32x4 xv[2][4]; u32x2 yr[2][4];
#pragma unroll
        for (int rr = 0; rr < 2; ++rr)
#pragma unroll
            for (int j = 0; j < 4; ++j) { const int c0 = (lane + 64 * j) * 4; xv[rr][j] = *(const f32x4*)(x + (size_t)(rbase + rr) * D + c0); yr[rr][j] = *(const u32x2*)(Y1 + (size_t)(rbase + rr) * D + c0); }
#pragma unroll
        for (int rr = 0; rr < 2; ++rr) {
            const int row = rbase + rr; f32x4 yv[4]; float ss = 0.f;
#pragma unroll
            for (int j = 0; j < 4; ++j) { yv[j] = (f32x4){bflo(yr[rr][j].x), bfhi(yr[rr][j].x), bflo(yr[rr][j].y), bfhi(yr[rr][j].y)}; ss += (yv[j][0] * yv[j][0] + yv[j][1] * yv[j][1]) + (yv[j][2] * yv[j][2] + yv[j][3] * yv[j][3]); }
            const float rstd = rsqrtf(wave_sum(ss) * (1.0f / D) + EPS); float s2 = 0.f;
#pragma unroll
            for (int j = 0; j < 4; ++j) { const int c0 = (lane + 64 * j) * 4;
                const f32x4 gp = *(const f32x4*)(g_post_mix + c0), gt = *(const f32x4*)(mb + GT1 + c0);
                xv[rr][j] = xv[rr][j] + gt * (yv[j] * rstd * gp);
                *(f32x4*)(X1 + (size_t)row * D + c0) = xv[rr][j];
                s2 += (xv[rr][j][0] * xv[rr][j][0] + xv[rr][j][1] * xv[rr][j][1]) + (xv[rr][j][2] * xv[rr][j][2] + xv[rr][j][3] * xv[rr][j][3]); }
            const float rstd2 = rsqrtf(wave_sum(s2) * (1.0f / D) + EPS);
#pragma unroll
            for (int j = 0; j < 4; ++j) { const int c0 = (lane + 64 * j) * 4;
                const f32x4 gf = *(const f32x4*)(g_pre_ffn + c0), sc = *(const f32x4*)(mb + SC2 + c0), sh = *(const f32x4*)(mb + SH2 + c0);
                const f32x4 h = xv[rr][j] * rstd2 * gf * (sc + 1.0f) + sh;
                u32x2 w; w.x = cvtpk(h[0], h[1]); w.y = cvtpk(h[2], h[3]); *(unsigned*)(XN8 + (size_t)row * D + c0) = pk_fp8x4(h[0] * F8_ASCALE, h[1] * F8_ASCALE, h[2] * F8_ASCALE, h[3] * F8_ASCALE);
                *(LAS u32x2*)(HT + (2 * wave + rr) * G_HT_STRIDE + c0 * 2) = w; }
        }
        __syncthreads();
        {
            f32x4 acc0 = {0.f, 0.f, 0.f, 0.f}, acc1 = {0.f, 0.f, 0.f, 0.f};
#pragma unroll
            for (int ks = 0; ks < 4; ++ks) { const bf16x8 hb = *(const LAS bf16x8*)(HT + i16 * G_HT_STRIDE + (128 * wave + 32 * ks + 8 * kq) * 2);
                acc0 = __builtin_amdgcn_mfma_f32_16x16x32_bf16(whi[0][ks], hb, acc0, 0, 0, 0); acc0 = __builtin_amdgcn_mfma_f32_16x16x32_bf16(wlo[0][ks], hb, acc0, 0, 0, 0);
                acc1 = __builtin_amdgcn_mfma_f32_16x16x32_bf16(whi[1][ks], hb, acc1, 0, 0, 0); acc1 = __builtin_amdgcn_mfma_f32_16x16x32_bf16(wlo[1][ks], hb, acc1, 0, 0, 0); }
#pragma unroll
            for (int r = 0; r < 4; ++r) { PL[(wave * 32 + 4 * kq + r) * 16 + i16] = acc0[r]; PL[(wave * 32 + 16 + 4 * kq + r) * 16 + i16] = acc1[r]; }
        }
        __syncthreads();
        const int row = tid & 15, e = tid >> 4;
        float lg = b_router[e];
#pragma unroll
        for (int w = 0; w < 8; ++w) lg += PL[(w * 32 + e) * 16 + row];
        LG[e * 16 + row] = lg;
        __syncthreads();
        int rank = 0;
#pragma unroll
        for (int e2 = 0; e2 < 32; ++e2) { const float o = LG[e2 * 16 + row]; rank += (o > lg || (o == lg && e2 < e)) ? 1 : 0; }
        if (rank < 4) TV[row * 4 + rank] = lg;
        __syncthreads();
        if (rank < 4) {
            const float m = TV[row * 4], den = 1.0f + __expf(TV[row * 4 + 1] - m) + __expf(TV[row * 4 + 2] - m) + __expf(TV[row * 4 + 3] - m);
            const int slot = (16 * T + row) * 4 + rank; tope[slot] = e; topg[slot] = __expf(lg - m) / den;
            const unsigned lp = __hip_atomic_fetch_add(LC + e, 1u, __ATOMIC_RELAXED, __HIP_MEMORY_SCOPE_WORKGROUP);
            if (tl < 16) AS[tl * 64 + row * 4 + rank] = (unsigned)e | (lp << 8);
        }
    }
    __syncthreads();
    if (tid < NEXP) LC[32 + tid] = atomicAdd(&cnt[tid], LC[tid]);
    __syncthreads();
    for (int i = tid; i < tl * 64; i += NWAVES * 64) { const unsigned as = AS[i]; const int e = as & 255, lp = as >> 8; const int T = F.vcu + (i >> 6) * F.G;
        list[(size_t)e * NTOK + LC[32 + e] + lp] = (16 * T + ((i & 63) >> 2)) * 4 + (i & 3); }
}
__device__ __forceinline__ int moe_tables(const Frame& F) {
    __syncthreads();
    if (F.tid < NEXP) F.MISC[40 + F.tid] = __hip_atomic_load(F.ctl + CW_CNT + F.tid, __ATOMIC_RELAXED, __HIP_MEMORY_SCOPE_AGENT);
    __syncthreads();
    if (F.tid == 0) { unsigned s = 0; for (int e = 0; e < NEXP; ++e) { F.MISC[e] = s; s += (F.MISC[40 + e] + 255u) >> 8; } F.MISC[32] = s; }
    __syncthreads();
    return (int)F.MISC[32];
}
__device__ __forceinline__ void phaseJ(const Frame& F, const Args& a) {
    const bf16* Y2 = (const bf16*)(a.ws + WS_Y2); const float* mod = (const float*)(a.ws + WS_MOD); const float* gpf = a.in[18]; float* out = a.out;
    const int lane = F.lane, gw = F.vcu * NWAVES + F.wave, NGW = F.G * NWAVES;
    for (int row0 = gw * 2; row0 < NTOK; row0 += NGW * 2) {
        const int b = row0 / SEQ; const float* mb = mod + b * 6144;
        u32x2 yy[2][4][4]; f32x4 xx[2][4];
#pragma unroll
        for (int rr = 0; rr < 2; ++rr)
#pragma unroll
            for (int j = 0; j < 4; ++j) { const int c0 = (lane + 64 * j) * 4;
#pragma unroll
                for (int k = 0; k < 4; ++k) yy[rr][j][k] = *(const u32x2*)(Y2 + ((size_t)(row0 + rr) * 4 + k) * D + c0);
                xx[rr][j] = *(const f32x4*)(out + (size_t)(row0 + rr) * D + c0); }
#pragma unroll
        for (int rr = 0; rr < 2; ++rr) {
            f32x4 yv[4]; float ss = 0.f;
#pragma unroll
            for (int j = 0; j < 4; ++j) { f32x4 s = {0.f, 0.f, 0.f, 0.f};
#pragma unroll
                for (int k = 0; k < 4; ++k) s += (f32x4){bflo(yy[rr][j][k].x), bfhi(yy[rr][j][k].x), bflo(yy[rr][j][k].y), bfhi(yy[rr][j][k].y)};
                yv[j] = s; ss += (s[0] * s[0] + s[1] * s[1]) + (s[2] * s[2] + s[3] * s[3]); }
            const float rstd = rsqrtf(wave_sum(ss) * (1.0f / D) + EPS);
#pragma unroll
            for (int j = 0; j < 4; ++j) { const int c0 = (lane + 64 * j) * 4;
                const f32x4 g = *(const f32x4*)(gpf + c0), gt = *(const f32x4*)(mb + GT2 + c0);
                *(f32x4*)(out + (size_t)(row0 + rr) * D + c0) = xx[rr][j] + gt * (yv[j] * rstd * g); }
        }
    }
}

constexpr int N_PHASES = 10;
__global__ void __launch_bounds__(NWAVES * 64, 2) mega_fwd(Args args) {
    extern __shared__ __attribute__((aligned(16))) unsigned char lds_raw[];
    Frame F;
    F.lds = (LAS unsigned char*)lds_raw; F.MISC = (volatile LAS unsigned*)(F.lds + MISC_OFF);
    F.tid = threadIdx.x; F.lane = F.tid & 63; F.wave = __builtin_amdgcn_readfirstlane(F.tid >> 6);
    F.G = gridDim.x; { const int bx = blockIdx.x; F.vcu = (F.G % 8 == 0) ? (bx % 8) * (F.G / 8) + bx / 8 : bx; }
    F.ctl = (unsigned*)(args.ws + WS_CTL);
    for (int u = F.tid; u < 128; u += NWAVES * 64) F.MISC[u] = 0u;
    __syncthreads();
    const int lo = args.ph_lo, hi = args.ph_hi;
    XcdBarrier bar; bar.bar = F.ctl + CW_BAR; bar.x = 0; bar.st = F.MISC + 80;
    if (hi - lo > 1) bar = xcd_barrier_post(F.ctl + CW_BAR, F.MISC + 80);
#ifndef PH_COMPILE_MASK
#define PH_COMPILE_MASK 0x3ff
#endif
#define IN(k) (((PH_COMPILE_MASK >> (k)) & 1) && lo <= (k) && (k) < hi)
#define SEAM(k) do { if (IN(k) && IN((k) + 1)) xcd_barrier(bar); } while (0)
    unsigned char* ws = args.ws;
    bf16 *XN = (bf16*)(ws + WS_XN), *Qb = (bf16*)(ws + WS_Q), *Kb = (bf16*)(ws + WS_K), *Vb = (bf16*)(ws + WS_V), *Ub = (bf16*)(ws + WS_U), *VG = (bf16*)(ws + WS_VG);
    bf16 *GT = (bf16*)(ws + WS_GT), *YAB = (bf16*)(ws + WS_YAB), *MRG = (bf16*)(ws + WS_MRG), *Y1 = (bf16*)(ws + WS_Y1), *ACT = (bf16*)(ws + WS_ACT), *Y2 = (bf16*)(ws + WS_Y2);

    if (IN(0)) { phaseA(F, args); } SEAM(0);
    if (IN(1)) { phaseB(F, args); } SEAM(1);
    if (IN(2)) {
        SchedStatic S{(const char*)XN, (const char*)(ws + WS_W1T), NTOK / 256, 4608 / 256, F.G, (int)blockIdx.x, (size_t)256 * 1024 * 2, (size_t)256 * 1024 * 2};
        EpiG1 E{Qb, Kb, Vb, Ub, VG, GT, args.in[15]};
        pg8::gemm_phase<EpiG1, SchedStatic, false>(F.lds + RING_OFF, S, E, 2048, 2048, 16);
    } SEAM(2);
    if (IN(3)) { phaseD(F, args); } SEAM(3);
    if (IN(4)) {
        SchedSplit2 S{(const char*)YAB, (const char*)(ws + WS_WBRT), NTOK / 256, 4, F.G, (int)blockIdx.x, (size_t)256 * 1024 * 2, (size_t)256 * 1024 * 2, (size_t)512 * 2};
        EpiG2 E{GT, MRG};
        pg8::gemm_phase<EpiG2, SchedSplit2, false>(F.lds + RING_OFF, S, E, 2048, 2048, 8);
    } SEAM(4);
    if (IN(5)) {
        SchedStatic S{(const char*)MRG, (const char*)(ws + WS_WOUTT), NTOK / 256, 4, F.G, (int)blockIdx.x, (size_t)256 * 1024 * 2, (size_t)256 * 1024 * 2};
        EpiPlain E{Y1};
        pg8::gemm_phase<EpiPlain, SchedStatic, false>(F.lds + RING_OFF, S, E, 2048, 2048, 16);
    } SEAM(5);
    if (IN(6)) { phaseG(F, args); } SEAM(6);
    if (IN(7)) {
        const int nrb = moe_tables(F);
        const int* list = (const int*)(ws + WS_LIST);
        typedef SchedMoe<8, true> SM;
        SM S{(const char*)XN, (const char*)(ws + WS_WGUT), F.MISC, (const LAS unsigned*)(F.lds + GTAB_OFF), (int)blockIdx.x, F.G, nrb, (size_t)2048 * 1024, (size_t)256 * 1024};
        { Unit u; LAS unsigned* gt = (LAS unsigned*)(F.lds + GTAB_OFF);
          for (int k = 0; k < GTAB_UNITS && S.next(k, u); ++k) { const int e = u.aux, j256 = (u.pm - (int)F.MISC[e]) * 256, ecnt = (int)F.MISC[40 + e];
              for (int r = F.tid; r < 256; r += NWAVES * 64) { const int pos = j256 + r; int tok = 0; if (pos < ecnt) tok = list[(size_t)e * NTOK + pos] >> 2; gt[k * 256 + r] = (unsigned)tok * 1024u; } } }
        __syncthreads();
        EpiAct E{args.in[22], (unsigned char*)ACT};
        pg8::gemm_phase<EpiAct, SM, true>(F.lds + RING_OFF, S, E, 1024, 1024, 8);
    } SEAM(7);
    if (IN(8)) {
        const int nrb = moe_tables(F);
        typedef SchedMoe<4, true> SM;
        SM S{(const char*)ACT, (const char*)(ws + WS_WDNT), F.MISC, (const LAS unsigned*)(F.lds + GTAB_OFF), (int)blockIdx.x, F.G, nrb, (size_t)1024 * 1024, (size_t)256 * 1024};
        { Unit u; LAS unsigned* gt = (LAS unsigned*)(F.lds + GTAB_OFF);
          for (int k = 0; k < GTAB_UNITS && S.next(k, u); ++k) for (int r = F.tid; r < 256; r += NWAVES * 64) gt[k * 256 + r] = (unsigned)(u.pm * 256 + r) * 1024u; }
        __syncthreads();
        EpiDown E{args.in[24], (const int*)(ws + WS_LIST), (const float*)(ws + WS_TOPG), F.MISC, Y2};
        pg8::gemm_phase<EpiDown, SM, true>(F.lds + RING_OFF, S, E, 1024, 1024, 8);
    } SEAM(8);
    if (IN(9)) { phaseJ(F, args); }
#undef IN
#undef SEAM
}
#ifndef MEGA_MASK
#define MEGA_MASK 0x3ff
#endif
#ifndef REP_MASK
#define REP_MASK 0
#endif
#ifndef ONE_LAUNCH
#define ONE_LAUNCH 1
#endif
extern "C" void kernel_launch(void* const* d_in, const int* in_sizes, int n_in, void* d_out, int out_size, void* d_ws, size_t ws_size, hipStream_t stream) {
    if (n_in != 25 || in_sizes[0] != NTOK * D || out_size != NTOK * D || ws_size < WS_END) { fprintf(stderr, "kernel_launch: unexpected shapes (n_in %d in0 %d out %d ws %zu)\n", n_in, n_in > 0 ? in_sizes[0] : -1, out_size, ws_size); return; }
    static int grid = 0;
    if (grid == 0) {
        int dev = 0, cus = 0, per_cu = 0;
        if (hipGetDevice(&dev) != hipSuccess || hipDeviceGetAttribute(&cus, hipDeviceAttributeMultiprocessorCount, dev) != hipSuccess) { fprintf(stderr, "kernel_launch: device query failed\n"); grid = -1; return; }
        if (hipFuncSetAttribute((const void*)mega_fwd, hipFuncAttributeMaxDynamicSharedMemorySize, LDS_BYTES) != hipSuccess) { fprintf(stderr, "kernel_launch: hipFuncSetAttribute failed\n"); grid = -1; return; }
        if (hipOccupancyMaxActiveBlocksPerMultiprocessor(&per_cu, (const void*)mega_fwd, NWAVES * 64, LDS_BYTES) != hipSuccess || per_cu < 1) { fprintf(stderr, "kernel_launch: occupancy query says %d\n", per_cu); }
        (void)hipGetLastError();
        grid = cus;
    }
    if (grid < 0) return;
    const float* x = (const float*)d_in[0]; const float* c = (const float*)d_in[1]; const float* w_ada = (const float*)d_in[2]; const float* b_ada = (const float*)d_in[3];
    const float* g_pre_mix = (const float*)d_in[4]; const float* g_post_mix = (const float*)d_in[5]; const float* w_in = (const float*)d_in[6]; const float* rel_bias = (const float*)d_in[7];
    const float* sgu_ln_g = (const float*)d_in[8]; const float* sgu_ln_b = (const float*)d_in[9]; const float* w_spatial = (const float*)d_in[10]; const float* b_spatial = (const float*)d_in[11];
    const float* w_branch_a = (const float*)d_in[12]; const float* w_branch_b = (const float*)d_in[13]; const float* w_gate = (const float*)d_in[14]; const float* b_gate = (const float*)d_in[15];
    const float* w_out = (const float*)d_in[16]; const float* g_pre_ffn = (const float*)d_in[17]; const float* g_post_ffn = (const float*)d_in[18]; const float* w_router = (const float*)d_in[19];
    const float* b_router = (const float*)d_in[20]; const float* w_gate_up = (const float*)d_in[21]; const float* b_gate_up = (const float*)d_in[22]; const float* w_down = (const float*)d_in[23];
    const float* b_down = (const float*)d_in[24];
    unsigned char* ws = (unsigned char*)d_ws; float* out = (float*)d_out;
    unsigned* ctl = (unsigned*)(ws + WS_CTL); float* mod = (float*)(ws + WS_MOD);
    bf16 *XN = (bf16*)(ws + WS_XN), *Qb = (bf16*)(ws + WS_Q), *Kb = (bf16*)(ws + WS_K), *Vb = (bf16*)(ws + WS_V), *Ub = (bf16*)(ws + WS_U), *VG = (bf16*)(ws + WS_VG);
    bf16 *GT = (bf16*)(ws + WS_GT), *YAB = (bf16*)(ws + WS_YAB), *MRG = (bf16*)(ws + WS_MRG), *Y1 = (bf16*)(ws + WS_Y1), *ACT = (bf16*)(ws + WS_ACT), *Y2 = (bf16*)(ws + WS_Y2);
    float *VN = (float*)(ws + WS_VN), *TMP = (float*)(ws + WS_TMP);
    int* tope = (int*)(ws + WS_TOPE); float* topg = (float*)(ws + WS_TOPG); int* list = (int*)(ws + WS_LIST); unsigned* cnt = ctl + CW_CNT;
    (void)x; (void)c; (void)w_ada; (void)b_ada; (void)g_pre_mix; (void)rel_bias; (void)sgu_ln_g; (void)sgu_ln_b; (void)w_spatial; (void)b_spatial; (void)tope;

    if (hipMemsetAsync(ws + WS_CTL, 0, CTL_ZERO_BYTES, stream) != hipSuccess) { fprintf(stderr, "kernel_launch: memset failed\n"); return; }
    Args a{};
    for (int i = 0; i < 25; ++i) a.in[i] = (const float*)d_in[i];
    a.out = out; a.ws = ws;
#if ONE_LAUNCH
    a.ph_lo = 0; a.ph_hi = N_PHASES;
    hipLaunchKernelGGL(mega_fwd, dim3(grid), dim3(NWAVES * 64), LDS_BYTES, stream, a);
    if (hipPeekAtLastError() != hipSuccess) fprintf(stderr, "kernel_launch: launch failed\n");
    for (int ph = 0; ph < N_PHASES; ++ph) if ((REP_MASK >> ph) & 1) {
        a.ph_lo = ph; a.ph_hi = ph + 1; hipLaunchKernelGGL(mega_fwd, dim3(grid), dim3(NWAVES * 64), LDS_BYTES, stream, a); }
#else
    for (int ph = 0; ph < N_PHASES; ++ph) {
        if (((MEGA_MASK >> ph) & 1) || ph == 0) { a.ph_lo = ph; a.ph_hi = ph + 1; hipLaunchKernelGGL(mega_fwd, dim3(grid), dim3(NWAVES * 64), LDS_BYTES, stream, a); if (((MEGA_MASK >> ph) & 1)) continue; }
        switch (ph) {
        case 0: nv_mod<<<NMOD * D / 256, 256, 0, stream>>>(c, w_ada, b_ada, mod); break;
        case 1: nv_xn1<<<NTOK / 4, 256, 0, stream>>>(x, g_pre_mix, mod, XN); break;
        case 2: { G_In g{XN, w_in, Qb, Kb, Vb, Ub, VG}; nv_gemm<G_In, false><<<dim3(INW / 64, NTOK / 64, 1), 256, 0, stream>>>(g, INW, D); }
                { G_Gate g{XN, w_gate, b_gate, GT}; nv_gemm<G_Gate, false><<<dim3(2048 / 64, NTOK / 64, 1), 256, 0, stream>>>(g, 2048, D); } break;
        case 3: nv_attn<<<NTOK * NHEAD / 256, 256, 0, stream>>>(Qb, Kb, Vb, rel_bias, YAB);
                nv_sgu_ln<<<NTOK / 4, 256, 0, stream>>>(VG, sgu_ln_g, sgu_ln_b, VN);
                nv_sgu<<<NTOK * SW / 256, 256, 0, stream>>>(VN, Ub, w_spatial, b_spatial, YAB); break;
        case 4: { G_BrA g{YAB, w_branch_a, GT, TMP}; nv_gemm<G_BrA, false><<<dim3(D / 64, NTOK / 64, 1), 256, 0, stream>>>(g, D, AW); }
                { G_BrB g{YAB, w_branch_b, GT, TMP, MRG}; nv_gemm<G_BrB, false><<<dim3(D / 64, NTOK / 64, 1), 256, 0, stream>>>(g, D, SW); } break;
        case 5: { G_Out g{MRG, w_out, Y1}; nv_gemm<G_Out, false><<<dim3(D / 64, NTOK / 64, 1), 256, 0, stream>>>(g, D, D); } break;
        case 6: nv_rowpass1<<<NTOK / 4, 256, 0, stream>>>(x, Y1, mod, g_post_mix, g_pre_ffn, w_router, b_router, out, XN, tope, topg, cnt, list); break;
        case 7: { G_MoeGU g{XN, w_gate_up, b_gate_up, cnt, list, ACT}; nv_gemm<G_MoeGU, true><<<dim3(DE / 64, NTOK / 64, NEXP), 256, 0, stream>>>(g, 2048, D); } break;
        case 8: { G_MoeDn g{ACT, w_down, b_down, cnt, list, topg, Y2}; nv_gemm<G_MoeDn, false><<<dim3(D / 64, NTOK / 64, NEXP), 256, 0, stream>>>(g, D, DE); } break;
        case 9: nv_final<<<NTOK / 4, 256, 0, stream>>>(Y2, mod, g_post_ffn, out); break;
        }
    }
#endif
}
```

```cpp
#include <hip/hip_runtime.h>
#include <cstdio>
#include <cstdint>

constexpr int NB = 4, SEQ = 8192, D = 1024, NTOK = NB * SEQ;
constexpr int AW = 512, NHEAD = 8, HD = 64, CHUNK = 64, NLEFT = 8, BAND = 576, MAXREL = 128, NREL = 257;
constexpr int SW = 512, SGB = 128, SGG = 8, SGD = 64;
constexpr int INW = 2560, NEXP = 32, TOPK = 4, DE = 1024, NMOD = 6;
constexpr float EPS = 1e-6f, SWL = 7.0f, SWA = 1.702f;
constexpr float LOG2E = 1.4426950408889634f;
constexpr float QSCALE = 0.125f * LOG2E;
constexpr int SH1 = 0, SC1 = 1024, GT1 = 2048, SH2 = 3072, SC2 = 4096, GT2 = 5120;

typedef unsigned short bf16;
__device__ __forceinline__ float bf2f(bf16 v) { return __uint_as_float(((unsigned)v) << 16); }
__device__ __forceinline__ bf16 f2bf(float f) { unsigned u = __float_as_uint(f); return (bf16)((u + 0x7fffu + ((u >> 16) & 1u)) >> 16); }
__device__ __forceinline__ float wave_sum(float v) {
#pragma unroll
    for (int o = 1; o < 64; o <<= 1) v += __shfl_xor(v, o);
    return v;
}
__device__ __forceinline__ float gelu_erf(float x) { return 0.5f * x * (1.0f + erff(x * 0.70710678118654752f)); }
__device__ __forceinline__ float sigmoidf_(float x) { return 1.0f / (1.0f + __expf(-x)); }

constexpr size_t MiB = 1u << 20;
constexpr size_t WS_CTL = 0, CTL_ZERO_BYTES = 1 * MiB;
constexpr size_t WS_MOD = 1 * MiB;
constexpr size_t WS_W1T = 2 * MiB, WS_WBRT = 12 * MiB, WS_WOUTT = 14 * MiB, WS_WRT = 16 * MiB;
constexpr size_t WS_TOPE = 17 * MiB, WS_TOPG = 18 * MiB, WS_LIST = 19 * MiB;
constexpr size_t WS_WGUT = 32 * MiB, WS_WDNT = 160 * MiB;
constexpr size_t WS_XN = 224 * MiB;
constexpr size_t WS_Q = 288 * MiB, WS_K = 320 * MiB, WS_V = 352 * MiB, WS_U = 384 * MiB, WS_VG = 416 * MiB;
constexpr size_t WS_GT = 448 * MiB;
constexpr size_t WS_YAB = 576 * MiB, WS_MRG = 640 * MiB, WS_Y1 = 704 * MiB;
constexpr size_t WS_ACT = 288 * MiB;
constexpr size_t WS_Y2 = 576 * MiB;
constexpr size_t WS_VN = 768 * MiB;
constexpr size_t WS_TMP = 832 * MiB;
constexpr size_t WS_END = 960 * MiB;
constexpr int CW_CNT = 1024;

__global__ __launch_bounds__(256) void nv_mod(const float* __restrict__ c, const float* __restrict__ w_ada, const float* __restrict__ b_ada, float* __restrict__ mod) {
    __shared__ float sc[NB * D];
    for (int i = threadIdx.x; i < NB * D; i += 256) { const float v = c[i]; sc[i] = v / (1.0f + __expf(-v)); }
    __syncthreads();
    const int j = blockIdx.x * 256 + threadIdx.x;
    float a0 = 0.f, a1 = 0.f, a2 = 0.f, a3 = 0.f;
    for (int k = 0; k < D; ++k) { const float w = w_ada[(size_t)k * (NMOD * D) + j]; a0 += sc[k] * w; a1 += sc[D + k] * w; a2 += sc[2 * D + k] * w; a3 += sc[3 * D + k] * w; }
    const float bb = b_ada[j];
    mod[j] = a0 + bb; mod[6144 + j] = a1 + bb; mod[2 * 6144 + j] = a2 + bb; mod[3 * 6144 + j] = a3 + bb;
}

__global__ __launch_bounds__(256) void nv_xn1(const float* __restrict__ x, const float* __restrict__ g, const float* __restrict__ mod, bf16* __restrict__ xn) {
    const int row = blockIdx.x * 4 + (threadIdx.x >> 6), lane = threadIdx.x & 63, b = row / SEQ;
    const float4* xr = (const float4*)(x + (size_t)row * D);
    float4 v[4]; float ss = 0.f;
#pragma unroll
    for (int j = 0; j < 4; ++j) { v[j] = xr[lane + 64 * j]; ss += v[j].x * v[j].x + v[j].y * v[j].y + v[j].z * v[j].z + v[j].w * v[j].w; }
    const float rstd = rsqrtf(wave_sum(ss) * (1.0f / D) + EPS);
    const float* mb = mod + b * 6144;
#pragma unroll
    for (int j = 0; j < 4; ++j) {
        const int c0 = (lane + 64 * j) * 4; const float vv[4] = {v[j].x, v[j].y, v[j].z, v[j].w}; bf16 o[4];
#pragma unroll
        for (int i = 0; i < 4; ++i) o[i] = f2bf(vv[i] * rstd * g[c0 + i] * (1.0f + mb[SC1 + c0 + i]) + mb[SH1 + c0 + i]);
        *(uint2*)(xn + (size_t)row * D + c0) = make_uint2((unsigned)o[0] | ((unsigned)o[1] << 16), (unsigned)o[2] | ((unsigned)o[3] << 16));
    }
}

template <class G, bool DUAL>
__global__ __launch_bounds__(256) void nv_gemm(G g, int ldw, int K) {
    __shared__ float As[16][68];
    __shared__ float Ws[16][64];
    __shared__ float Ws2[DUAL ? 16 : 1][64];
    const int z = blockIdx.z; int nrows; const float* W; const float* W2;
    if (!g.setup(z, nrows, W, W2)) return;
    const int r0 = blockIdx.y * 64, n0 = blockIdx.x * 64;
    if (r0 >= nrows) return;
    const int tid = threadIdx.x, tx = tid & 15, ty = tid >> 4;
    const int lr = tid >> 2, lk = (tid & 3) * 4;
    int ar = r0 + lr; if (ar >= nrows) ar = nrows - 1;
    const bf16* ap = g.arow(z, ar) + lk;
    const int wk = tid >> 4, wn = (tid & 15) * 4;
    float acc[4][4], acc2[4][4];
#pragma unroll
    for (int i = 0; i < 4; ++i)
#pragma unroll
        for (int j = 0; j < 4; ++j) { acc[i][j] = 0.f; acc2[i][j] = 0.f; }
    for (int k0 = 0; k0 < K; k0 += 16) {
        const uint2 av = *(const uint2*)(ap + k0);
        As[lk + 0][lr] = bf2f((bf16)(av.x & 0xffff)); As[lk + 1][lr] = bf2f((bf16)(av.x >> 16));
        As[lk + 2][lr] = bf2f((bf16)(av.y & 0xffff)); As[lk + 3][lr] = bf2f((bf16)(av.y >> 16));
        *(float4*)&Ws[wk][wn] = *(const float4*)(W + (size_t)(k0 + wk) * ldw + n0 + wn);
        if (DUAL) *(float4*)&Ws2[wk][wn] = *(const float4*)(W2 + (size_t)(k0 + wk) * ldw + n0 + wn);
        __syncthreads();
#pragma unroll
        for (int kk = 0; kk < 16; ++kk) {
            const float4 a = *(const float4*)&As[kk][ty * 4]; const float4 b = *(const float4*)&Ws[kk][tx * 4];
            const float aa[4] = {a.x, a.y, a.z, a.w}, bb[4] = {b.x, b.y, b.z, b.w};
#pragma unroll
            for (int i = 0; i < 4; ++i)
#pragma unroll
                for (int j = 0; j < 4; ++j) acc[i][j] += aa[i] * bb[j];
            if (DUAL) { const float4 b2 = *(const float4*)&Ws2[kk][tx * 4]; const float cc[4] = {b2.x, b2.y, b2.z, b2.w};
#pragma unroll
                for (int i = 0; i < 4; ++i)
#pragma unroll
                    for (int j = 0; j < 4; ++j) acc2[i][j] += aa[i] * cc[j]; }
        }
        __syncthreads();
    }
#pragma unroll
    for (int i = 0; i < 4; ++i) { const int r = r0 + ty * 4 + i; if (r < nrows) {
#pragma unroll
        for (int j = 0; j < 4; ++j) g.store(z, r, n0 + tx * 4 + j, acc[i][j], acc2[i][j]); } }
}

struct G_In {
    const bf16* A; const float* W; bf16 *Q, *Kb, *V, *U, *VG;
    __device__ bool setup(int, int& nrows, const float*& w, const float*& w2) const { nrows = NTOK; w = W; w2 = W; return true; }
    __device__ const bf16* arow(int, int r) const { return A + (size_t)r * D; }
    __device__ void store(int, int r, int n, float acc, float) const {
        if (n < 512) Q[(size_t)r * 512 + n] = f2bf(acc * QSCALE);
        else if (n < 1024) Kb[(size_t)r * 512 + n - 512] = f2bf(acc);
        else if (n < 1536) V[(size_t)r * 512 + n - 1024] = f2bf(acc);
        else if (n < 2048) U[(size_t)r * 512 + n - 1536] = f2bf(gelu_erf(acc));
        else VG[(size_t)r * 512 + n - 2048] = f2bf(gelu_erf(acc));
    }
};
struct G_Gate {
    const bf16* A; const float* W; const float* bias; bf16* GT;
    __device__ bool setup(int, int& nrows, const float*& w, const float*& w2) const { nrows = NTOK; w = W; w2 = W; return true; }
    __device__ const bf16* arow(int, int r) const { return A + (size_t)r * D; }
    __device__ void store(int, int r, int n, float acc, float) const { GT[(size_t)r * 2048 + n] = f2bf(sigmoidf_(acc + bias[n])); }
};
struct G_BrA {
    const bf16* YAB; const float* W; const bf16* GT; float* TMP;
    __device__ bool setup(int, int& nrows, const float*& w, const float*& w2) const { nrows = NTOK; w = W; w2 = W; return true; }
    __device__ const bf16* arow(int, int r) const { return YAB + (size_t)r * 1024; }
    __device__ void store(int, int r, int n, float acc, float) const { TMP[(size_t)r * 1024 + n] = bf2f(GT[(size_t)r * 2048 + n]) * acc; }
};
struct G_BrB {
    const bf16* YAB; const float* W; const bf16* GT; const float* TMP; bf16* MRG;
    __device__ bool setup(int, int& nrows, const float*& w, const float*& w2) const { nrows = NTOK; w = W; w2 = W; return true; }
    __device__ const bf16* arow(int, int r) const { return YAB + (size_t)r * 1024 + 512; }
    __device__ void store(int, int r, int n, float acc, float) const { MRG[(size_t)r * 1024 + n] = f2bf(TMP[(size_t)r * 1024 + n] + bf2f(GT[(size_t)r * 2048 + 1024 + n]) * acc); }
};
struct G_Out {
    const bf16* MRG; const float* W; bf16* Y1;
    __device__ bool setup(int, int& nrows, const float*& w, const float*& w2) const { nrows = NTOK; w = W; w2 = W; return true; }
    __device__ const bf16* arow(int, int r) const { return MRG + (size_t)r * 1024; }
    __device__ void store(int, int r, int n, float acc, float) const { Y1[(size_t)r * 1024 + n] = f2bf(acc); }
};
__device__ __forceinline__ int moe_rowbase(const unsigned* cnt, int e) { int s = 0; for (int i = 0; i < e; ++i) s += (int)((cnt[i] + 255u) / 256u) * 256; return s; }
struct G_MoeGU {
    const bf16* XN2; const float* Wgu; const float* bgu; const unsigned* cnt; const int* list; bf16* ACT;
    __device__ bool setup(int z, int& nrows, const float*& w, const float*& w2) const { nrows = (int)cnt[z]; w = Wgu + (size_t)z * D * 2048; w2 = w + 1024; return nrows > 0; }
    __device__ const bf16* arow(int z, int r) const { const int slot = list[(size_t)z * NTOK + r]; return XN2 + (size_t)(slot >> 2) * D; }
    __device__ void store(int z, int r, int n, float acc, float acc2) const {
        const float xg = fminf(acc + bgu[z * 2048 + n], SWL); const float xl = fminf(fmaxf(acc2 + bgu[z * 2048 + 1024 + n], -SWL), SWL);
        ACT[(size_t)(moe_rowbase(cnt, z) + r) * 1024 + n] = f2bf(xg * sigmoidf_(SWA * xg) * (xl + 1.0f));
    }
};
struct G_MoeDn {
    const bf16* ACT; const float* Wdn; const float* bdn; const unsigned* cnt; const int* list; const float* topg; bf16* Y2;
    __device__ bool setup(int z, int& nrows, const float*& w, const float*& w2) const { nrows = (int)cnt[z]; w = Wdn + (size_t)z * D * D; w2 = w; return nrows > 0; }
    __device__ const bf16* arow(int z, int r) const { return ACT + (size_t)(moe_rowbase(cnt, z) + r) * 1024; }
    __device__ void store(int z, int r, int n, float acc, float) const { const int slot = list[(size_t)z * NTOK + r]; Y2[(size_t)slot * 1024 + n] = f2bf((acc + bdn[z * 1024 + n]) * topg[slot]); }
};

__global__ __launch_bounds__(256) void nv_attn(const bf16* __restrict__ Q, const bf16* __restrict__ Kb, const bf16* __restrict__ V, const float* __restrict__ rel_bias, bf16* __restrict__ YAB) {
    const int gid = blockIdx.x * 256 + threadIdx.x, h = gid & 7, tok = gid >> 3, b = tok / SEQ, t = tok % SEQ, c = t / CHUNK, qi = t % CHUNK;
    float q[64], o[64];
    const uint4* qp = (const uint4*)(Q + (size_t)tok * 512 + h * 64);
#pragma unroll
    for (int i = 0; i < 8; ++i) { const uint4 w = qp[i]; const unsigned ww[4] = {w.x, w.y, w.z, w.w};
#pragma unroll
        for (int j = 0; j < 4; ++j) { q[i * 8 + 2 * j] = bf2f((bf16)(ww[j] & 0xffff)); q[i * 8 + 2 * j + 1] = bf2f((bf16)(ww[j] >> 16)); } }
#pragma unroll
    for (int d = 0; d < 64; ++d) o[d] = 0.f;
    float m = -1e30f, l = 0.f;
    for (int kj = 0; kj < BAND; ++kj) {
        const int kpos = (c - NLEFT) * CHUNK + kj; if (kpos < 0) continue;
        const size_t kr = ((size_t)(b * SEQ + kpos)) * 512 + h * 64;
        const uint4* kp = (const uint4*)(Kb + kr); float s = 0.f;
#pragma unroll
        for (int i = 0; i < 8; ++i) { const uint4 w = kp[i]; const unsigned ww[4] = {w.x, w.y, w.z, w.w};
#pragma unroll
            for (int j = 0; j < 4; ++j) { s += q[i * 8 + 2 * j] * bf2f((bf16)(ww[j] & 0xffff)); s += q[i * 8 + 2 * j + 1] * bf2f((bf16)(ww[j] >> 16)); } }
        int rel = NLEFT * CHUNK + qi - kj; rel = rel < -MAXREL ? -MAXREL : (rel > MAXREL ? MAXREL : rel);
        s += rel_bias[h * NREL + rel + MAXREL] * LOG2E;
        const float mn = fmaxf(m, s), alpha = exp2f(m - mn), p = exp2f(s - mn);
        l = l * alpha + p; m = mn;
        const uint4* vp = (const uint4*)(V + kr);
#pragma unroll
        for (int i = 0; i < 8; ++i) { const uint4 w = vp[i]; const unsigned ww[4] = {w.x, w.y, w.z, w.w};
#pragma unroll
            for (int j = 0; j < 4; ++j) { o[i * 8 + 2 * j] = o[i * 8 + 2 * j] * alpha + p * bf2f((bf16)(ww[j] & 0xffff)); o[i * 8 + 2 * j + 1] = o[i * 8 + 2 * j + 1] * alpha + p * bf2f((bf16)(ww[j] >> 16)); } }
    }
    const float inv = 1.0f / l;
    bf16* op = YAB + (size_t)tok * 1024 + h * 64;
#pragma unroll
    for (int d = 0; d < 64; d += 2) *(unsigned*)(op + d) = (unsigned)f2bf(o[d] * inv) | ((unsigned)f2bf(o[d + 1] * inv) << 16);
}

__global__ __launch_bounds__(256) void nv_sgu_ln(const bf16* __restrict__ VG, const float* __restrict__ ln_g, const float* __restrict__ ln_b, float* __restrict__ VN) {
    const int row = blockIdx.x * 4 + (threadIdx.x >> 6), lane = threadIdx.x & 63;
    const uint4 w = *(const uint4*)(VG + (size_t)row * 512 + lane * 8); const unsigned ww[4] = {w.x, w.y, w.z, w.w};
    float v[8]; float s = 0.f;
#pragma unroll
    for (int j = 0; j < 4; ++j) { v[2 * j] = bf2f((bf16)(ww[j] & 0xffff)); v[2 * j + 1] = bf2f((bf16)(ww[j] >> 16)); s += v[2 * j] + v[2 * j + 1]; }
    const float mu = wave_sum(s) * (1.0f / 512.0f); float q = 0.f;
#pragma unroll
    for (int j = 0; j < 8; ++j) { v[j] -= mu; q += v[j] * v[j]; }
    const float rstd = rsqrtf(wave_sum(q) * (1.0f / 512.0f) + EPS);
#pragma unroll
    for (int j = 0; j < 8; ++j) VN[(size_t)row * 512 + lane * 8 + j] = v[j] * rstd * ln_g[lane * 8 + j] + ln_b[lane * 8 + j];
}
__global__ __launch_bounds__(256) void nv_sgu(const float* __restrict__ VN, const bf16* __restrict__ U, const float* __restrict__ w_s, const float* __restrict__ b_s, bf16* __restrict__ YAB) {
    const int gid = blockIdx.x * 256 + threadIdx.x, c = gid & 511, tok = gid >> 9, tl = tok & 127, tb = tok - tl, g = c >> 6;
    float acc = b_s[g * 128 + tl];
    const float* wr = w_s + ((size_t)g * 128 + tl) * 128;
    for (int s = 0; s <= tl; ++s) acc += wr[s] * VN[(size_t)(tb + s) * 512 + c];
    YAB[(size_t)tok * 1024 + 512 + c] = f2bf(bf2f(U[(size_t)tok * 512 + c]) * acc);
}

__global__ __launch_bounds__(256) void nv_rowpass1(const float* __restrict__ x, const bf16* __restrict__ Y1, const float* __restrict__ mod, const float* __restrict__ g_post_mix,
                                                   const float* __restrict__ g_pre_ffn, const float* __restrict__ w_router, const float* __restrict__ b_router,
                                                   float* __restrict__ X1, bf16* __restrict__ XN2, int* __restrict__ tope, float* __restrict__ topg, unsigned* cnt, int* __restrict__ list) {
    const int row = blockIdx.x * 4 + (threadIdx.x >> 6), lane = threadIdx.x & 63, b = row / SEQ;
    const float* mb = mod + b * 6144;
    float xv[16], yv[16]; float ss = 0.f;
#pragma unroll
    for (int j = 0; j < 4; ++j) {
        const int c0 = (lane + 64 * j) * 4;
        const float4 xx = *(const float4*)(x + (size_t)row * D + c0); xv[4 * j] = xx.x; xv[4 * j + 1] = xx.y; xv[4 * j + 2] = xx.z; xv[4 * j + 3] = xx.w;
        const uint2 yy = *(const uint2*)(Y1 + (size_t)row * D + c0);
        yv[4 * j] = bf2f((bf16)(yy.x & 0xffff)); yv[4 * j + 1] = bf2f((bf16)(yy.x >> 16)); yv[4 * j + 2] = bf2f((bf16)(yy.y & 0xffff)); yv[4 * j + 3] = bf2f((bf16)(yy.y >> 16));
#pragma unroll
        for (int i = 0; i < 4; ++i) ss += yv[4 * j + i] * yv[4 * j + i];
    }
    const float rstd = rsqrtf(wave_sum(ss) * (1.0f / D) + EPS); float s2 = 0.f;
#pragma unroll
    for (int j = 0; j < 4; ++j) { const int c0 = (lane + 64 * j) * 4;
#pragma unroll
        for (int i = 0; i < 4; ++i) { const float x1 = xv[4 * j + i] + mb[GT1 + c0 + i] * (yv[4 * j + i] * rstd * g_post_mix[c0 + i]); xv[4 * j + i] = x1; s2 += x1 * x1; }
        *(float4*)(X1 + (size_t)row * D + c0) = make_float4(xv[4 * j], xv[4 * j + 1], xv[4 * j + 2], xv[4 * j + 3]); }
    const float rstd2 = rsqrtf(wave_sum(s2) * (1.0f / D) + EPS);
#pragma unroll
    for (int j = 0; j < 4; ++j) { const int c0 = (lane + 64 * j) * 4;
#pragma unroll
        for (int i = 0; i < 4; ++i) xv[4 * j + i] = xv[4 * j + i] * rstd2 * g_pre_ffn[c0 + i] * (1.0f + mb[SC2 + c0 + i]) + mb[SH2 + c0 + i];
        *(uint2*)(XN2 + (size_t)row * D + c0) = make_uint2((unsigned)f2bf(xv[4 * j]) | ((unsigned)f2bf(xv[4 * j + 1]) << 16), (unsigned)f2bf(xv[4 * j + 2]) | ((unsigned)f2bf(xv[4 * j + 3]) << 16)); }
    float mylogit = -1e30f;
    for (int e = 0; e < NEXP; ++e) {
        float p = 0.f;
#pragma unroll
        for (int j = 0; j < 4; ++j) { const int c0 = (lane + 64 * j) * 4;
#pragma unroll
            for (int i = 0; i < 4; ++i) p += xv[4 * j + i] * w_router[(size_t)(c0 + i) * NEXP + e]; }
        p = wave_sum(p) + b_router[e];
        if (lane == e) mylogit = p;
    }
    float tv[4]; int ti[4];
#pragma unroll
    for (int k = 0; k < 4; ++k) {
        float bv = mylogit; int bi = lane;
#pragma unroll
        for (int o = 1; o < 64; o <<= 1) { const float ov = __shfl_xor(bv, o); const int oi = __shfl_xor(bi, o); if (ov > bv || (ov == bv && oi < bi)) { bv = ov; bi = oi; } }
        tv[k] = bv; ti[k] = bi; if (lane == bi) mylogit = -3e38f;
    }
    if (lane == 0) {
        const float e0 = 1.0f, e1 = __expf(tv[1] - tv[0]), e2 = __expf(tv[2] - tv[0]), e3 = __expf(tv[3] - tv[0]); const float inv = 1.0f / (e0 + e1 + e2 + e3);
        const float gg[4] = {e0 * inv, e1 * inv, e2 * inv, e3 * inv};
#pragma unroll
        for (int k = 0; k < 4; ++k) { const int slot = row * 4 + k; tope[slot] = ti[k]; topg[slot] = gg[k]; const unsigned pos = atomicAdd(&cnt[ti[k]], 1u); list[(size_t)ti[k] * NTOK + pos] = slot; }
    }
}

__global__ __launch_bounds__(256) void nv_final(const bf16* __restrict__ Y2, const float* __restrict__ mod, const float* __restrict__ g_post_ffn, float* __restrict__ out) {
    const int row = blockIdx.x * 4 + (threadIdx.x >> 6), lane = threadIdx.x & 63, b = row / SEQ;
    const float* mb = mod + b * 6144;
    float yv[16]; float ss = 0.f;
#pragma unroll
    for (int j = 0; j < 4; ++j) { const int c0 = (lane + 64 * j) * 4; float a[4] = {0.f, 0.f, 0.f, 0.f};
#pragma unroll
        for (int k = 0; k < 4; ++k) { const uint2 yy = *(const uint2*)(Y2 + ((size_t)row * 4 + k) * D + c0);
            a[0] += bf2f((bf16)(yy.x & 0xffff)); a[1] += bf2f((bf16)(yy.x >> 16)); a[2] += bf2f((bf16)(yy.y & 0xffff)); a[3] += bf2f((bf16)(yy.y >> 16)); }
#pragma unroll
        for (int i = 0; i < 4; ++i) { yv[4 * j + i] = a[i]; ss += a[i] * a[i]; } }
    const float rstd = rsqrtf(wave_sum(ss) * (1.0f / D) + EPS);
#pragma unroll
    for (int j = 0; j < 4; ++j) { const int c0 = (lane + 64 * j) * 4; float4 xx = *(const float4*)(out + (size_t)row * D + c0);
        xx.x += mb[GT2 + c0] * (yv[4 * j] * rstd * g_post_ffn[c0]); xx.y += mb[GT2 + c0 + 1] * (yv[4 * j + 1] * rstd * g_post_ffn[c0 + 1]);
        xx.z += mb[GT2 + c0 + 2] * (yv[4 * j + 2] * rstd * g_post_ffn[c0 + 2]); xx.w += mb[GT2 + c0 + 3] * (yv[4 * j + 3] * rstd * g_post_ffn[c0 + 3]);
        *(float4*)(out + (size_t)row * D + c0) = xx; }
}

#define LAS __attribute__((address_space(3)))
#define GAS __attribute__((address_space(1)))
typedef short bf16x8 __attribute__((ext_vector_type(8)));
typedef short s16x4 __attribute__((ext_vector_type(4)));
typedef float f32x4 __attribute__((ext_vector_type(4)));
typedef float f32x2 __attribute__((ext_vector_type(2)));
typedef float f32x16 __attribute__((ext_vector_type(16)));
typedef unsigned u32x4 __attribute__((ext_vector_type(4)));
typedef unsigned u32x2 __attribute__((ext_vector_type(2)));
typedef __bf16 bf16x2_t __attribute__((ext_vector_type(2)));
constexpr int NWAVES = 8;
constexpr int TRASH_SLOT = NTOK * 4;

__device__ __forceinline__ unsigned cvtpk(float lo, float hi) { f32x2 v = {lo, hi}; bf16x2_t b = __builtin_convertvector(v, bf16x2_t); return __builtin_bit_cast(unsigned, b); }
__device__ __forceinline__ float clamp8(float v) { return fminf(fmaxf(v, -448.0f), 448.0f); }
__device__ __forceinline__ unsigned pk_fp8x4(float a, float b, float c, float d) {
    int w = 0; w = __builtin_amdgcn_cvt_pk_fp8_f32(clamp8(a), clamp8(b), w, false); w = __builtin_amdgcn_cvt_pk_fp8_f32(clamp8(c), clamp8(d), w, true); return (unsigned)w; }
constexpr float F8_WSCALE = 64.0f, F8_ASCALE = 4.0f, F8_DESCALE = 1.0f / (64.0f * 4.0f);
__device__ __forceinline__ float bflo(unsigned w) { return __uint_as_float(w << 16); }
__device__ __forceinline__ float bfhi(unsigned w) { return __uint_as_float(w & 0xffff0000u); }
__device__ __forceinline__ float fast_sigmoid(float x) { return __builtin_amdgcn_rcpf(1.0f + __builtin_amdgcn_exp2f(-LOG2E * x)); }
__device__ __forceinline__ f32x2 gelu_pk(f32x2 v) {
    const f32x2 av = __builtin_elementwise_abs(v), d = av * 0.2316418882f + 1.0f;
    f32x2 t; t.x = __builtin_amdgcn_rcpf(d.x); t.y = __builtin_amdgcn_rcpf(d.y);
    f32x2 q = t * 0.5307027145f + (-0.7265760135f); q = q * t + 0.7107068705f; q = q * t + (-0.142248368f); q = q * t + 0.127414796f; q = q * t;
    const f32x2 s = (v * v) * (-0.72134752044f);
    f32x2 e; e.x = __builtin_amdgcn_exp2f(s.x); e.y = __builtin_amdgcn_exp2f(s.y);
    const f32x2 m = v * (q * e), r = v - m;
    f32x2 o; o.x = v.x < 0.f ? m.x : r.x; o.y = v.y < 0.f ? m.y : r.y; return o;
}

constexpr int RING_OFF = 0, RING_BYTES = 131072;
constexpr int GTAB_OFF = RING_BYTES, GTAB_UNITS = 20, GTAB_BYTES = GTAB_UNITS * 256 * 4;
constexpr int MISC_OFF = GTAB_OFF + GTAB_BYTES;
constexpr int LDS_BYTES = MISC_OFF + 512;
static_assert(LDS_BYTES <= 160 * 1024, "LDS map");

#define XB_TMO      128
#define XB_XCNT(j)  (256  + 64 * (j))
#define XB_XSUB(j)  (1280 + 64 * (j))
#define XB_XGEN(j)  (2304 + 64 * (j))
#define XB_TOP      3328
#define XB_TOPGEN   3392
#define XCD_BAR_WORDS 3456
#define XB_SPIN_CAP (1u << 18)
__device__ __forceinline__ unsigned xb_ld(unsigned* p)              { return __hip_atomic_load(p, __ATOMIC_RELAXED, __HIP_MEMORY_SCOPE_AGENT); }
__device__ __forceinline__ unsigned xb_add(unsigned* p, unsigned v) { return __hip_atomic_fetch_add(p, v, __ATOMIC_RELAXED, __HIP_MEMORY_SCOPE_AGENT); }
__device__ __forceinline__ unsigned xb_xcc_id() { return (unsigned)__builtin_amdgcn_s_getreg((3 << 11) | 20) & 0xFu; }
#define XB_SPIN(cond, bar) do { unsigned _sp = 0; while (cond) { __builtin_amdgcn_s_sleep(1); \
    if ((++_sp & 255u) == 0u) { if (xb_ld(&(bar)[XB_TMO])) break; if (_sp > XB_SPIN_CAP) { atomicAdd(&(bar)[XB_TMO], 1u); break; } } } } while (0)
struct XcdBarrier { unsigned* bar; unsigned x; volatile LAS unsigned* st; };
__device__ __forceinline__ XcdBarrier xcd_barrier_post(unsigned* bar, volatile LAS unsigned* st) {
    XcdBarrier b; b.bar = bar; b.x = xb_xcc_id(); b.st = st;
    if (threadIdx.x == 0) (void)xb_add(&bar[XB_XCNT(b.x)], 1u);
    return b;
}
__device__ __forceinline__ void xcd_barrier_complete(unsigned* bar, unsigned x, unsigned& nloc, unsigned& nx) {
    const unsigned G = gridDim.x * gridDim.y * gridDim.z;
    unsigned sum, cnt, mine, sp = 0u;
    for (;;) {
        sum = 0u; cnt = 0u; mine = 0u;
#pragma unroll
        for (unsigned j = 0; j < 16; ++j) { const unsigned c = xb_ld(&bar[XB_XCNT(j)]); sum += c; cnt += (c > 0u) ? 1u : 0u; mine = (j == x) ? c : mine; }
        if (sum == G) break;
        __builtin_amdgcn_s_sleep(1);
        if ((++sp & 255u) == 0u) { if (xb_ld(&bar[XB_TMO])) break; if (sp > XB_SPIN_CAP) { atomicAdd(&bar[XB_TMO], 1u); break; } }
    }
    nloc = mine > 0u ? mine : 1u; nx = cnt > 0u ? cnt : 1u;
}
__device__ __forceinline__ void xcd_barrier(const XcdBarrier& b) {
    asm volatile("s_waitcnt vmcnt(0)" ::: "memory");
    __syncthreads();
    if (threadIdx.x == 0) {
        unsigned* bar = b.bar;
        __builtin_amdgcn_s_waitcnt(0);
        unsigned nloc = b.st[0], nx = b.st[1];
        if (nloc == 0u) { xcd_barrier_complete(bar, b.x, nloc, nx); b.st[0] = nloc; b.st[1] = nx; }
        const unsigned old = xb_add(&bar[XB_XSUB(b.x)], 1u);
        const unsigned gen = old / nloc;
        if (old + 1u == (gen + 1u) * nloc) {
            __builtin_amdgcn_fence(__ATOMIC_RELEASE, "agent");
            asm volatile("s_waitcnt vmcnt(0)" ::: "memory");
            const unsigned og = xb_add(&bar[XB_TOP], 1u);
            const unsigned tg = og / nx;
            if (og + 1u == (tg + 1u) * nx) xb_add(&bar[XB_TOPGEN], 1u);
            else XB_SPIN(xb_ld(&bar[XB_TOPGEN]) == tg, bar);
            __builtin_amdgcn_fence(__ATOMIC_ACQUIRE, "agent");
            xb_add(&bar[XB_XGEN(b.x)], 1u);
            asm volatile("s_waitcnt vmcnt(0)" ::: "memory");
        } else {
            XB_SPIN(xb_ld(&bar[XB_XGEN(b.x)]) == gen, bar);
            __builtin_amdgcn_fence(__ATOMIC_ACQUIRE, "agent");
            asm volatile("s_waitcnt vmcnt(0)" ::: "memory");
        }
    }
    __syncthreads();
}
constexpr int CW_BAR = 4096;

namespace pg8 {
constexpr int BM = 256, BK = 64, HALF = 128, HTB = HALF * BK * 2, STAGE_BYTES = 8 * HTB, NXCD = 8, WGM = 8;
__host__ __device__ __forceinline__ int lds_byte(int r, int c) { return r * 128 + ((((c >> 3) ^ (r >> 1)) & 7) << 4); }
__host__ __device__ __forceinline__ void stage_rc(int b, int& R, int& C) { R = b >> 7; C = ((((b >> 4) ^ (R >> 1)) & 7) << 3); }
__host__ __device__ __forceinline__ int perm32(int rho) { const int n = rho >> 4, i = rho & 15; return 8 * (i >> 2) + 4 * n + (i & 3); }
struct Unit { int pm, pn, aux; };
typedef int v4i_t __attribute__((ext_vector_type(4)));
typedef int v8i_t __attribute__((ext_vector_type(8)));

__device__ __forceinline__ bool static_unit(int i, int G, int c, int nM, int nN, int& pm, int& pn) {
    const int nwg = nM * nN; const long L = (long)i * G + c; if (L >= nwg) return false;
    int wgid = (int)L; { const int q = nwg / NXCD, r = nwg % NXCD, xcd = wgid % NXCD, off = wgid / NXCD; wgid = (xcd < r ? xcd * (q + 1) : r * (q + 1) + (xcd - r) * q) + off; }
    const int nig = WGM * nN, gid = wgid / nig, fm = gid * WGM, gsz = (nM - fm) < WGM ? (nM - fm) : WGM;
    pm = fm + ((wgid % nig) % gsz); pn = (wgid % nig) / gsz; return true;
}

template <class Epi, class Sched, bool FP8>
__device__ __forceinline__ void gemm_phase(LAS unsigned char* lds, const Sched& S, const Epi& E, const int lda, const int ldb, const int nt, const int dbg_flags = 0) {
    const int tid = threadIdx.x, wid = __builtin_amdgcn_readfirstlane(tid >> 6), lane = tid & 63, wr = wid >> 2, wc = wid & 3, fr = lane & 15, fq = lane >> 4;
    int Rr[2], Cc[2]; unsigned voffB[2];
#pragma unroll
    for (int i = 0; i < 2; ++i) { stage_rc(tid * 16 + i * 8192, Rr[i], Cc[i]); const int Rb = (Rr[i] & ~31) + perm32(Rr[i] & 31); voffB[i] = (unsigned)(Rb * ldb + Cc[i] * 2); }
    const size_t kstep = (size_t)(BK * 2);
    const size_t hstepB = (size_t)HALF * ldb;
    const size_t hstepA = Sched::GATHER ? (size_t)0 : (size_t)HALF * lda;
    const unsigned ldsw = (unsigned)wid * 1024u;
    const int aoff = lds_byte(wr * 64 + fr, fq * 8), boff = lds_byte(wc * 32 + fr, fq * 8);
#define PG8_SA(b, h) (((b) * 2 + (h)) * HTB)
#define PG8_SB(b, h) ((4 + (b) * 2 + (h)) * HTB)
#define PG8_STAGE(bufoff, gbase, voff) do { _Pragma("unroll") for (int _i = 0; _i < 2; ++_i) \
        __builtin_amdgcn_global_load_lds((const unsigned*)((const char*)(gbase) + (voff)[_i]), (LAS unsigned*)(lds + (bufoff) + ldsw + _i * 8192), 16, 0, 0); } while (0)
#define PG8_LDA(dst, b, h) do { _Pragma("unroll") for (int m = 0; m < 4; ++m) _Pragma("unroll") for (int k = 0; k < 2; ++k) dst[m][k] = *(const LAS bf16x8*)(lds + PG8_SA(b, h) + (aoff ^ (k * 64)) + m * 2048); } while (0)
#define PG8_LDB(dst, b, h) do { _Pragma("unroll") for (int n = 0; n < 2; ++n) _Pragma("unroll") for (int k = 0; k < 2; ++k) dst[n][k] = *(const LAS bf16x8*)(lds + PG8_SB(b, h) + (boff ^ (k * 64)) + n * 2048); } while (0)
#define PG8_CAT(x) __builtin_shufflevector(__builtin_bit_cast(v4i_t, (x)[0]), __builtin_bit_cast(v4i_t, (x)[1]), 0, 1, 2, 3, 4, 5, 6, 7)
#define PG8_MMA(ai, bj, At, Bt) do { __builtin_amdgcn_s_setprio(1); if constexpr (FP8) { _Pragma("unroll") for (int m = 0; m < 4; ++m) _Pragma("unroll") for (int n = 0; n < 2; ++n) \
        acc[ai][bj][m][n] = __builtin_amdgcn_mfma_scale_f32_16x16x128_f8f6f4(PG8_CAT(Bt[n]), PG8_CAT(At[m]), acc[ai][bj][m][n], 0, 0, 0, 0x7F7F7F7F, 0, 0x7F7F7F7F); } \
    else { _Pragma("unroll") for (int m = 0; m < 4; ++m) _Pragma("unroll") for (int n = 0; n < 2; ++n) _Pragma("unroll") for (int k = 0; k < 2; ++k) \
        acc[ai][bj][m][n] = __builtin_amdgcn_mfma_f32_16x16x32_bf16(Bt[n][k], At[m][k], acc[ai][bj][m][n], 0, 0, 0); } __builtin_amdgcn_s_setprio(0); } while (0)
#define PG8_WAIT_V(n) asm volatile("s_waitcnt vmcnt(" #n ")" ::: "memory")
#define PG8_WAIT_L(n) asm volatile("s_waitcnt lgkmcnt(" #n ")" ::: "memory")
#define PG8_BAR __builtin_amdgcn_s_barrier()
#define PG8_SCHED __builtin_amdgcn_sched_barrier(0)
    Unit cur, nxt; int ui = 0;
    if (!S.next(0, cur)) return;
    f32x4 acc[2][2][4][2];
#pragma unroll
    for (int a = 0; a < 2; ++a)
#pragma unroll
        for (int b = 0; b < 2; ++b)
#pragma unroll
            for (int m = 0; m < 4; ++m)
#pragma unroll
                for (int n = 0; n < 2; ++n) acc[a][b][m][n] = (f32x4){0.f, 0.f, 0.f, 0.f};
    bf16x8 At[4][2], B0[2][2], B1[2][2];
    unsigned oA[2][2];
#pragma unroll
    for (int h = 0; h < 2; ++h)
#pragma unroll
        for (int i = 0; i < 2; ++i) oA[h][i] = Sched::GATHER ? (S.goff(0, h * HALF + Rr[i]) + (unsigned)Cc[i] * 2u) : (unsigned)(Rr[i] * lda + Cc[i] * 2);
    const char* cA = S.aptr(cur); const char* cB = S.bptr(cur);
    PG8_STAGE(PG8_SB(0, 0), cB, voffB); PG8_STAGE(PG8_SB(0, 1), cB + hstepB, voffB); PG8_STAGE(PG8_SA(0, 0), cA, oA[0]); PG8_STAGE(PG8_SA(0, 1), cA + hstepA, oA[1]);
    if (wr == 1) PG8_BAR;
    PG8_WAIT_V(2); PG8_BAR;
    PG8_STAGE(PG8_SB(1, 0), cB + kstep, voffB); PG8_STAGE(PG8_SA(1, 0), cA + kstep, oA[0]); PG8_STAGE(PG8_SB(1, 1), cB + hstepB + kstep, voffB);
    PG8_WAIT_V(6); PG8_BAR;
    for (;;) {
        const bool has_next = S.next(ui + 1, nxt);
        const char* nA = has_next ? S.aptr(nxt) : cA; const char* nB = has_next ? S.bptr(nxt) : cB;
#pragma clang loop unroll(disable)
        for (int t = 0; t < nt; t += 2) {
            const bool last = (t == nt - 2);
            const char* a1 = cA + (size_t)(t + 1) * kstep;
            const char* a2 = last ? nA : cA + (size_t)(t + 2) * kstep; const char* b2 = last ? nB : cB + (size_t)(t + 2) * kstep;
            const char* a3 = a2 + kstep; const char* b3 = b2 + kstep;
            PG8_LDB(B0, 0, 0); PG8_LDB(B1, 0, 1); PG8_SCHED; PG8_LDA(At, 0, 0); PG8_STAGE(PG8_SA(1, 1), a1 + hstepA, oA[1]);
            if constexpr (Sched::GATHER) { if (last && has_next) {
#pragma unroll
                for (int h = 0; h < 2; ++h)
#pragma unroll
                    for (int i = 0; i < 2; ++i) oA[h][i] = S.goff(ui + 1, h * HALF + Rr[i]) + (unsigned)Cc[i] * 2u; } }
            PG8_WAIT_V(8); PG8_WAIT_L(0); PG8_BAR; PG8_MMA(0, 0, At, B0); PG8_MMA(0, 1, At, B1); PG8_BAR; PG8_SCHED;
            PG8_LDA(At, 0, 1); PG8_STAGE(PG8_SB(0, 0), b2, voffB); PG8_STAGE(PG8_SB(0, 1), b2 + hstepB, voffB); PG8_STAGE(PG8_SA(0, 0), a2, oA[0]);
            PG8_WAIT_V(8); PG8_WAIT_L(0); PG8_BAR; PG8_MMA(1, 0, At, B0); PG8_MMA(1, 1, At, B1); PG8_BAR; PG8_SCHED;
            PG8_LDB(B0, 1, 0); PG8_LDB(B1, 1, 1); PG8_SCHED; PG8_LDA(At, 1, 0); PG8_STAGE(PG8_SA(0, 1), a2 + hstepA, oA[1]);
            PG8_WAIT_V(8); PG8_WAIT_L(0); PG8_BAR; PG8_MMA(0, 0, At, B0); PG8_MMA(0, 1, At, B1); PG8_BAR; PG8_SCHED;
            PG8_LDA(At, 1, 1); PG8_STAGE(PG8_SB(1, 0), b3, voffB); PG8_STAGE(PG8_SB(1, 1), b3 + hstepB, voffB); PG8_STAGE(PG8_SA(1, 0), a3, oA[0]);
            PG8_WAIT_V(8); PG8_WAIT_L(0); PG8_BAR; PG8_MMA(1, 0, At, B0); PG8_MMA(1, 1, At, B1); PG8_BAR; PG8_SCHED;
        }
        if (wr == 0) PG8_BAR;
        bool keep = false;
        {
            int tz = threadIdx.x; asm volatile("" : "+v"(tz)); const int ewid = tz >> 6, el = tz & 63, ewr = ewid >> 2, ewc = ewid & 3, efr = el & 15, efq = el >> 4;
            if constexpr (Sched::HAS_MID) { if (S.is_mid(cur)) { E.mid(acc, cur, ewr, ewc, efr, efq); keep = true; } }
            if (!keep && !(dbg_flags & 1)) E(acc, cur, ewr, ewc, efr, efq);
        }
        if (!has_next) break;
        if (!keep) {
#pragma unroll
            for (int a = 0; a < 2; ++a)
#pragma unroll
                for (int b = 0; b < 2; ++b)
#pragma unroll
                    for (int m = 0; m < 4; ++m)
#pragma unroll
                        for (int n = 0; n < 2; ++n) acc[a][b][m][n] = (f32x4){0.f, 0.f, 0.f, 0.f};
        }
        cur = nxt; cA = nA; cB = nB; ++ui;
        if (wr == 1) PG8_BAR;
    }
    PG8_WAIT_V(0);
    PG8_BAR;
#undef PG8_SA
#undef PG8_SB
#undef PG8_STAGE
#undef PG8_LDA
#undef PG8_LDB
#undef PG8_MMA
#undef PG8_CAT
#undef PG8_WAIT_V
#undef PG8_WAIT_L
#undef PG8_BAR
#undef PG8_SCHED
}
}
using pg8::Unit;

struct Args { const float* in[25]; float* out; unsigned char* ws; int ph_lo, ph_hi, rep_mask, pad; };
static_assert(sizeof(Args) == 27 * 8 + 16, "Args has no padding");
struct Frame {
    LAS unsigned char* lds; volatile LAS unsigned* MISC; unsigned* ctl;
    int tid, lane, wave, vcu, G;
};
#define LDS_WAIT() asm volatile("s_waitcnt lgkmcnt(0)" ::: "memory")
#define VM_WAIT() asm volatile("s_waitcnt vmcnt(0)" ::: "memory")

struct SchedStatic {
    static constexpr bool GATHER = false, HAS_MID = false;
    const char* A; const char* B; int nM, nN, G, c; size_t astep, bstep;
    __device__ __forceinline__ bool next(int i, Unit& u) const { u.aux = 0; return pg8::static_unit(i, G, c, nM, nN, u.pm, u.pn); }
    __device__ __forceinline__ const char* aptr(const Unit& u) const { return A + (size_t)u.pm * astep; }
    __device__ __forceinline__ const char* bptr(const Unit& u) const { return B + (size_t)u.pn * bstep; }
    __device__ __forceinline__ bool is_mid(const Unit&) const { return false; }
    __device__ __forceinline__ unsigned goff(int, int) const { return 0u; }
};
struct SchedSplit2 {
    static constexpr bool GATHER = false, HAS_MID = true;
    const char* A; const char* B; int nM, nN, G, c; size_t astep, bstep, khalf;
    __device__ __forceinline__ bool next(int i, Unit& u) const { u.aux = i & 1; return pg8::static_unit(i >> 1, G, c, nM, nN, u.pm, u.pn); }
    __device__ __forceinline__ const char* aptr(const Unit& u) const { return A + (size_t)u.pm * astep + (size_t)u.aux * khalf; }
    __device__ __forceinline__ const char* bptr(const Unit& u) const { return B + (size_t)u.pn * bstep + (size_t)u.aux * khalf; }
    __device__ __forceinline__ bool is_mid(const Unit& u) const { return u.aux == 0; }
    __device__ __forceinline__ unsigned goff(int, int) const { return 0u; }
};
__device__ __forceinline__ int moe_find_e(volatile LAS unsigned* MISC, int rb) { int e = 0;
#pragma unroll 1
    for (int i = 1; i < NEXP; ++i) e += ((int)MISC[i] <= rb) ? 1 : 0;
    return e; }
template <int NPN, bool GATH>
struct SchedMoe {
    static constexpr bool GATHER = GATH, HAS_MID = false;
    static constexpr int RPX = 32 / NPN;
    static constexpr int UT0 = 96, UTN = 24;
    const char* A; const char* B; volatile LAS unsigned* MISC; const LAS unsigned* gtab; int c, G, nrb; size_t bstep_e, bstep_n;
    __device__ __forceinline__ bool slow_next(int i, Unit& u) const {
        int rb, pn;
        if (G == 256) { const int x = c & 7, j = c >> 3; rb = (8 * i + x) * RPX + j / NPN; pn = j % NPN; }
        else { const long L = (long)i * G + c; rb = (int)(L / NPN); pn = (int)(L % NPN); }
        if (rb >= nrb) return false;
        u.pm = rb; u.pn = pn; u.aux = moe_find_e(MISC, rb); return true;
    }
    __device__ __forceinline__ void build(int tid) const {
        if (tid < UTN) { Unit u; const bool ok = slow_next(tid, u); MISC[UT0 + tid] = ok ? (0x80000000u | ((unsigned)u.aux << 16) | ((unsigned)u.pn << 12) | (unsigned)u.pm) : 0u; }
        __syncthreads();
    }
    __device__ __forceinline__ bool next(int i, Unit& u) const {
        if (i >= UTN) return false;
        const unsigned w = MISC[UT0 + i]; if (!(w >> 31)) return false;
        u.pm = (int)(w & 0xfffu); u.pn = (int)((w >> 12) & 0xfu); u.aux = (int)((w >> 16) & 0xffu); return true;
    }
    __device__ __forceinline__ const char* aptr(const Unit& u) const { return GATH ? A : A + (size_t)u.pm * (256 * 1024); }
    __device__ __forceinline__ const char* bptr(const Unit& u) const { return B + (size_t)u.aux * bstep_e + (size_t)u.pn * bstep_n; }
    __device__ __forceinline__ bool is_mid(const Unit&) const { return false; }
    __device__ __forceinline__ unsigned goff(int ui, int row) const { return gtab[ui * 256 + row]; }
};

#define EPI_ARGS f32x4 (&acc)[2][2][4][2], const Unit& u, int wr, int wc, int fr, int fq
struct EpiG1 {
    bf16 *Q, *K, *V, *U, *VG, *GT; const float* bgate;
    __device__ __forceinline__ void mid(EPI_ARGS) const {}
    __device__ __forceinline__ void operator()(EPI_ARGS) const {
        const int pn = u.pn; const int row0 = u.pm * 256 + wr * 64 + fr;
        if (pn < 6) {
            const int t = pn >> 1; bf16* base = Q + (size_t)t * ((WS_K - WS_Q) / 2); const float sc = (t == 0) ? QSCALE : 1.0f;    const int col0 = (pn & 1) * 256 + wc * 32 + 8 * fq;
#pragma unroll
            for (int ai = 0; ai < 2; ++ai)
#pragma unroll
                for (int m = 0; m < 4; ++m) { bf16* rowp = base + (size_t)(row0 + ai * 128 + m * 16) * 512 + col0;
#pragma unroll
                    for (int bj = 0; bj < 2; ++bj) { const f32x4 v0 = acc[ai][bj][m][0] * sc, v1 = acc[ai][bj][m][1] * sc;
                        u32x4 w; w.x = cvtpk(v0[0], v0[1]); w.y = cvtpk(v0[2], v0[3]); w.z = cvtpk(v1[0], v1[1]); w.w = cvtpk(v1[2], v1[3]); *(u32x4*)(rowp + bj * 128) = w; } }
        } else if (pn < 10) {
            bf16* base = Q + (size_t)(pn >> 1) * ((WS_K - WS_Q) / 2); const int col0 = (pn & 1) * 256 + wc * 32 + 8 * fq;
#pragma unroll
            for (int ai = 0; ai < 2; ++ai)
#pragma unroll
                for (int m = 0; m < 4; ++m) { bf16* rowp = base + (size_t)(row0 + ai * 128 + m * 16) * 512 + col0;
#pragma unroll
                    for (int bj = 0; bj < 2; ++bj) { const f32x4 v0 = acc[ai][bj][m][0], v1 = acc[ai][bj][m][1];
                        const f32x2 a = gelu_pk((f32x2){v0[0], v0[1]}), b = gelu_pk((f32x2){v0[2], v0[3]}), c = gelu_pk((f32x2){v1[0], v1[1]}), d = gelu_pk((f32x2){v1[2], v1[3]});
                        u32x4 w; w.x = cvtpk(a.x, a.y); w.y = cvtpk(b.x, b.y); w.z = cvtpk(c.x, c.y); w.w = cvtpk(d.x, d.y); *(u32x4*)(rowp + bj * 128) = w; } }
        } else {
            const int col0 = (pn - 10) * 256 + wc * 32 + 8 * fq;
            f32x4 bv[2][2];
#pragma unroll
            for (int bj = 0; bj < 2; ++bj)
#pragma unroll
                for (int n = 0; n < 2; ++n) bv[bj][n] = *(const f32x4*)(bgate + col0 + bj * 128 + 4 * n);
#pragma unroll
            for (int ai = 0; ai < 2; ++ai)
#pragma unroll
                for (int m = 0; m < 4; ++m) { bf16* rowp = GT + (size_t)(row0 + ai * 128 + m * 16) * 2048 + col0;
#pragma unroll
                    for (int bj = 0; bj < 2; ++bj) { const f32x4 v0 = acc[ai][bj][m][0] + bv[bj][0], v1 = acc[ai][bj][m][1] + bv[bj][1];
                        u32x4 w; w.x = cvtpk(fast_sigmoid(v0[0]), fast_sigmoid(v0[1])); w.y = cvtpk(fast_sigmoid(v0[2]), fast_sigmoid(v0[3]));
                        w.z = cvtpk(fast_sigmoid(v1[0]), fast_sigmoid(v1[1])); w.w = cvtpk(fast_sigmoid(v1[2]), fast_sigmoid(v1[3])); *(u32x4*)(rowp + bj * 128) = w; } }
        }
    }
};
struct EpiG2 {
    const bf16* GT; bf16* MRG;
    __device__ __forceinline__ void mid(EPI_ARGS) const {
        const int row0 = u.pm * 256 + wr * 64 + fr, col0 = u.pn * 256 + wc * 32 + 8 * fq;
#pragma unroll
        for (int ai = 0; ai < 2; ++ai)
#pragma unroll
            for (int m = 0; m < 4; ++m) { const bf16* gp = GT + (size_t)(row0 + ai * 128 + m * 16) * 2048 + col0;
#pragma unroll
                for (int bj = 0; bj < 2; ++bj) { const u32x4 ga = *(const u32x4*)(gp + bj * 128), gb = *(const u32x4*)(gp + 1024 + bj * 128);
                    f32x4 r0, r1;
                    r0[0] = bflo(ga.x) * __builtin_amdgcn_rcpf(fmaxf(bflo(gb.x), 1e-30f)); r0[1] = bfhi(ga.x) * __builtin_amdgcn_rcpf(fmaxf(bfhi(gb.x), 1e-30f));
                    r0[2] = bflo(ga.y) * __builtin_amdgcn_rcpf(fmaxf(bflo(gb.y), 1e-30f)); r0[3] = bfhi(ga.y) * __builtin_amdgcn_rcpf(fmaxf(bfhi(gb.y), 1e-30f));
                    r1[0] = bflo(ga.z) * __builtin_amdgcn_rcpf(fmaxf(bflo(gb.z), 1e-30f)); r1[1] = bfhi(ga.z) * __builtin_amdgcn_rcpf(fmaxf(bfhi(gb.z), 1e-30f));
                    r1[2] = bflo(ga.w) * __builtin_amdgcn_rcpf(fmaxf(bflo(gb.w), 1e-30f)); r1[3] = bfhi(ga.w) * __builtin_amdgcn_rcpf(fmaxf(bfhi(gb.w), 1e-30f));
                    acc[ai][bj][m][0] *= r0; acc[ai][bj][m][1] *= r1; } }
    }
    __device__ __forceinline__ void operator()(EPI_ARGS) const {
        const int row0 = u.pm * 256 + wr * 64 + fr, col0 = u.pn * 256 + wc * 32 + 8 * fq;
#pragma unroll
        for (int ai = 0; ai < 2; ++ai)
#pragma unroll
            for (int m = 0; m < 4; ++m) { const size_t r = (size_t)(row0 + ai * 128 + m * 16); const bf16* gp = GT + r * 2048 + 1024 + col0; bf16* op = MRG + r * 1024 + col0;
#pragma unroll
                for (int bj = 0; bj < 2; ++bj) { const u32x4 gb = *(const u32x4*)(gp + bj * 128); const f32x4 v0 = acc[ai][bj][m][0], v1 = acc[ai][bj][m][1];
                    u32x4 w; w.x = cvtpk(v0[0] * bflo(gb.x), v0[1] * bfhi(gb.x)); w.y = cvtpk(v0[2] * bflo(gb.y), v0[3] * bfhi(gb.y));
                    w.z = cvtpk(v1[0] * bflo(gb.z), v1[1] * bfhi(gb.z)); w.w = cvtpk(v1[2] * bflo(gb.w), v1[3] * bfhi(gb.w)); *(u32x4*)(op + bj * 128) = w; } }
    }
};
struct EpiPlain {
    bf16* O;
    __device__ __forceinline__ void mid(EPI_ARGS) const {}
    __device__ __forceinline__ void operator()(EPI_ARGS) const {
        const int row0 = u.pm * 256 + wr * 64 + fr, col0 = u.pn * 256 + wc * 32 + 8 * fq;
#pragma unroll
        for (int ai = 0; ai < 2; ++ai)
#pragma unroll
            for (int m = 0; m < 4; ++m) { bf16* op = O + (size_t)(row0 + ai * 128 + m * 16) * 1024 + col0;
#pragma unroll
                for (int bj = 0; bj < 2; ++bj) { const f32x4 v0 = acc[ai][bj][m][0], v1 = acc[ai][bj][m][1];
                    u32x4 w; w.x = cvtpk(v0[0], v0[1]); w.y = cvtpk(v0[2], v0[3]); w.z = cvtpk(v1[0], v1[1]); w.w = cvtpk(v1[2], v1[3]); *(u32x4*)(op + bj * 128) = w; } }
    }
};
struct EpiAct {
    const float* bgu; unsigned char* ACT8;
    __device__ __forceinline__ void mid(EPI_ARGS) const {}
    __device__ __forceinline__ f32x2 act2(f32x2 g, f32x2 l) const {
        f32x2 xg, xl; xg.x = fminf(g.x, SWL); xg.y = fminf(g.y, SWL); xl.x = fminf(fmaxf(l.x, -SWL), SWL); xl.y = fminf(fmaxf(l.y, -SWL), SWL);
        const f32x2 t = xg * (-SWA * LOG2E); f32x2 e; e.x = __builtin_amdgcn_exp2f(t.x); e.y = __builtin_amdgcn_exp2f(t.y);
        const f32x2 d = e + 1.0f; f32x2 r; r.x = __builtin_amdgcn_rcpf(d.x); r.y = __builtin_amdgcn_rcpf(d.y);
        return (xg * r) * (xl * F8_ASCALE + F8_ASCALE);
    }
    __device__ __forceinline__ void operator()(EPI_ARGS) const {
        const int e = u.aux; const int row0 = u.pm * 256 + wr * 64 + fr, col0 = u.pn * 128 + wc * 32 + 8 * fq;
        const float* bp = bgu + (size_t)e * 2048 + col0;
        const f32x4 bg0 = *(const f32x4*)(bp), bg1 = *(const f32x4*)(bp + 4), bl0 = *(const f32x4*)(bp + 1024), bl1 = *(const f32x4*)(bp + 1028);
#pragma unroll
        for (int ai = 0; ai < 2; ++ai)
#pragma unroll
            for (int m = 0; m < 4; ++m) {
                const f32x4 g0 = acc[ai][0][m][0] * F8_DESCALE + bg0, g1 = acc[ai][0][m][1] * F8_DESCALE + bg1, l0 = acc[ai][1][m][0] * F8_DESCALE + bl0, l1 = acc[ai][1][m][1] * F8_DESCALE + bl1;
                const f32x2 o0 = act2((f32x2){g0[0], g0[1]}, (f32x2){l0[0], l0[1]}), o1 = act2((f32x2){g0[2], g0[3]}, (f32x2){l0[2], l0[3]});
                const f32x2 o2 = act2((f32x2){g1[0], g1[1]}, (f32x2){l1[0], l1[1]}), o3 = act2((f32x2){g1[2], g1[3]}, (f32x2){l1[2], l1[3]});
                u32x2 w; w.x = pk_fp8x4(o0.x, o0.y, o1.x, o1.y); w.y = pk_fp8x4(o2.x, o2.y, o3.x, o3.y);
                *(u32x2*)(ACT8 + (size_t)(row0 + ai * 128 + m * 16) * 1024 + col0) = w; }
    }
};
struct EpiDown {
    const float* bdn; bf16* Y2s;
    __device__ __forceinline__ void mid(EPI_ARGS) const {}
    __device__ __forceinline__ void operator()(EPI_ARGS) const {
        const int e = u.aux; const int row0 = u.pm * 256 + wr * 64 + fr, col0 = u.pn * 256 + wc * 32 + 8 * fq;
        f32x4 bv[2][2];
#pragma unroll
        for (int bj = 0; bj < 2; ++bj)
#pragma unroll
            for (int n = 0; n < 2; ++n) bv[bj][n] = *(const f32x4*)(bdn + (size_t)e * 1024 + col0 + bj * 128 + 4 * n);
#pragma unroll
        for (int ai = 0; ai < 2; ++ai)
#pragma unroll
            for (int m = 0; m < 4; ++m) { bf16* op = Y2s + (size_t)(row0 + ai * 128 + m * 16) * 1024 + col0;
#pragma unroll
                for (int bj = 0; bj < 2; ++bj) { const f32x4 v0 = acc[ai][bj][m][0] * F8_DESCALE + bv[bj][0], v1 = acc[ai][bj][m][1] * F8_DESCALE + bv[bj][1];
                    u32x4 w; w.x = cvtpk(v0[0], v0[1]); w.y = cvtpk(v0[2], v0[3]); w.z = cvtpk(v1[0], v1[1]); w.w = cvtpk(v1[2], v1[3]); *(u32x4*)(op + bj * 128) = w; } }
    }
};

__device__ __forceinline__ void tr_item(const float* W, int N, bf16* WT, int ldt, int k0, int n0, int drow0, int dk0, LAS float* scr, int lane) {
#pragma unroll 8
    for (int i = 0; i < 32; ++i) { const int kk = 2 * i + (lane >> 5); scr[kk * 33 + (lane & 31)] = W[(size_t)(k0 + kk) * N + n0 + (lane & 31)]; }
    LDS_WAIT(); asm volatile("" ::: "memory");
    const int c = lane & 7;
#pragma unroll
    for (int j = 0; j < 4; ++j) { const int n = (lane >> 3) + 8 * j; const LAS float* s = scr + (8 * c) * 33 + n;
        u32x4 o; o.x = cvtpk(s[0 * 33], s[1 * 33]); o.y = cvtpk(s[2 * 33], s[3 * 33]); o.z = cvtpk(s[4 * 33], s[5 * 33]); o.w = cvtpk(s[6 * 33], s[7 * 33]);
        *(u32x4*)(WT + (size_t)(drow0 + n) * ldt + dk0 + k0 + 8 * c) = o; }
    LDS_WAIT(); asm volatile("" ::: "memory");
}
__device__ __forceinline__ void tr_item8(const float* W, int N, unsigned char* WT, int ldt, int k0, int n0, int drow0, float scale, LAS float* scr, int lane) {
#pragma unroll 8
    for (int i = 0; i < 64; ++i) { const int kk = 2 * i + (lane >> 5); scr[kk * 33 + (lane & 31)] = W[(size_t)(k0 + kk) * N + n0 + (lane & 31)]; }
    LDS_WAIT(); asm volatile("" ::: "memory");
    const int c = lane & 7;
#pragma unroll
    for (int j = 0; j < 4; ++j) { const int n = (lane >> 3) + 8 * j; const LAS float* s = scr + (16 * c) * 33 + n;
        u32x4 o;
        o.x = pk_fp8x4(s[0 * 33] * scale, s[1 * 33] * scale, s[2 * 33] * scale, s[3 * 33] * scale); o.y = pk_fp8x4(s[4 * 33] * scale, s[5 * 33] * scale, s[6 * 33] * scale, s[7 * 33] * scale);
        o.z = pk_fp8x4(s[8 * 33] * scale, s[9 * 33] * scale, s[10 * 33] * scale, s[11 * 33] * scale); o.w = pk_fp8x4(s[12 * 33] * scale, s[13 * 33] * scale, s[14 * 33] * scale, s[15 * 33] * scale);
        *(u32x4*)(WT + (size_t)(drow0 + n) * ldt + k0 + 16 * c) = o; }
    LDS_WAIT(); asm volatile("" ::: "memory");
}
__device__ __forceinline__ void phaseA(const Frame& F, const Args& a) {
    unsigned char* ws = a.ws;
    if (F.vcu < 192) {
        const float* c = a.in[1]; const float* w_ada = a.in[2]; const float* b_ada = a.in[3]; float* mod = (float*)(ws + WS_MOD);
        LAS float* red = (LAS float*)(F.lds);
        const int col = F.vcu * 32 + (F.tid & 31), ks = F.tid >> 5;
        float a0 = 0.f, a1 = 0.f, a2 = 0.f, a3 = 0.f;
        for (int k = ks * 64; k < ks * 64 + 64; ++k) { const float w = w_ada[(size_t)k * 6144 + col];
            const float c0 = c[k], c1 = c[D + k], c2 = c[2 * D + k], c3 = c[3 * D + k];
            a0 += c0 * __builtin_amdgcn_rcpf(1.0f + __expf(-c0)) * w; a1 += c1 * __builtin_amdgcn_rcpf(1.0f + __expf(-c1)) * w;
            a2 += c2 * __builtin_amdgcn_rcpf(1.0f + __expf(-c2)) * w; a3 += c3 * __builtin_amdgcn_rcpf(1.0f + __expf(-c3)) * w; }
        red[(ks * 4 + 0) * 32 + (F.tid & 31)] = a0; red[(ks * 4 + 1) * 32 + (F.tid & 31)] = a1; red[(ks * 4 + 2) * 32 + (F.tid & 31)] = a2; red[(ks * 4 + 3) * 32 + (F.tid & 31)] = a3;
        __syncthreads();
        if (F.tid < 128) { const int b = F.tid >> 5, cc = F.tid & 31; float s = 0.f;
#pragma unroll
            for (int k = 0; k < 16; ++k) s += red[(k * 4 + b) * 32 + cc];
            mod[b * 6144 + F.vcu * 32 + cc] = s + b_ada[F.vcu * 32 + cc]; }
        __syncthreads();
    }
    LAS float* scr = (LAS float*)(F.lds + F.wave * 17408);
    const int gw = F.vcu * NWAVES + F.wave, NGW = F.G * NWAVES;
    bf16* W1T = (bf16*)(ws + WS_W1T); bf16* WBRT = (bf16*)(ws + WS_WBRT); bf16* WOUTT = (bf16*)(ws + WS_WOUTT); unsigned char* WGUT = ws + WS_WGUT; unsigned char* WDNT = ws + WS_WDNT;
    constexpr int I_IN = 16 * 80, I_GATE = 16 * 64, I_BR = 8 * 32, I_OUT = 16 * 32, I_GU = 8 * 64, I_DN = 8 * 32;
    constexpr int NITEMS = I_IN + I_GATE + 2 * I_BR + I_OUT + NEXP * (I_GU + I_DN);
    for (int it = gw; it < NITEMS; it += NGW) {
        int r = it;
        if (r < I_IN) { const int n0 = 32 * (r % 80); tr_item(a.in[6], INW, W1T, 1024, 64 * (r / 80), n0, n0, 0, scr, F.lane); continue; } r -= I_IN;
        if (r < I_GATE) { const int n0 = 32 * (r % 64); tr_item(a.in[14], 2048, W1T, 1024, 64 * (r / 64), n0, INW + n0, 0, scr, F.lane); continue; } r -= I_GATE;
        if (r < I_BR) { const int n0 = 32 * (r % 32); tr_item(a.in[12], 1024, WBRT, 1024, 64 * (r / 32), n0, n0, 0, scr, F.lane); continue; } r -= I_BR;
        if (r < I_BR) { const int n0 = 32 * (r % 32); tr_item(a.in[13], 1024, WBRT, 1024, 64 * (r / 32), n0, n0, 512, scr, F.lane); continue; } r -= I_BR;
        if (r < I_OUT) { const int n0 = 32 * (r % 32); tr_item(a.in[16], 1024, WOUTT, 1024, 64 * (r / 32), n0, n0, 0, scr, F.lane); continue; } r -= I_OUT;
        if (r < NEXP * I_GU) { const int e = r / I_GU, q = r % I_GU, kb = q / 64, nb = q % 64, n0 = 32 * nb;
            const int m0 = n0 & 1023, drow = 256 * (m0 >> 7) + (m0 & 127) + (n0 >= 1024 ? 128 : 0);
            tr_item8(a.in[21] + (size_t)e * D * 2048, 2048, WGUT + (size_t)e * 2048 * 1024, 1024, 128 * kb, n0, drow, F8_WSCALE, scr, F.lane); continue; } r -= NEXP * I_GU;
        { const int e = r / I_DN, q = r % I_DN, n0 = 32 * (q % 32); tr_item8(a.in[23] + (size_t)e * D * D, 1024, WDNT + (size_t)e * 1024 * 1024, 1024, 128 * (q / 32), n0, n0, F8_WSCALE, scr, F.lane); }
    }
}
__device__ __forceinline__ void phaseB(const Frame& F, const Args& a) {
    const float* x = a.in[0]; const float* g = a.in[4]; const float* mod = (const float*)(a.ws + WS_MOD); bf16* xn = (bf16*)(a.ws + WS_XN);
    const int gw = F.vcu * NWAVES + F.wave, NGW = F.G * NWAVES;
    for (int row0 = gw * 4; row0 < NTOK; row0 += NGW * 4) {
        f32x4 v[4][4];
#pragma unroll
        for (int rr = 0; rr < 4; ++rr)
#pragma unroll
            for (int j = 0; j < 4; ++j) v[rr][j] = *((const f32x4*)(x + (size_t)(row0 + rr) * D) + F.lane + 64 * j);
        const int b = row0 / SEQ; const float* mb = mod + b * 6144;
#pragma unroll
        for (int rr = 0; rr < 4; ++rr) {
            float ss = 0.f;
#pragma unroll
            for (int j = 0; j < 4; ++j) ss += (v[rr][j].x * v[rr][j].x + v[rr][j].y * v[rr][j].y) + (v[rr][j].z * v[rr][j].z + v[rr][j].w * v[rr][j].w);
            const float rstd = rsqrtf(wave_sum(ss) * (1.0f / D) + EPS);
            u32x2* o8 = (u32x2*)(xn + (size_t)(row0 + rr) * D) + F.lane;
#pragma unroll
            for (int j = 0; j < 4; ++j) { const int c0 = (F.lane + 64 * j) * 4;
                const f32x4 gg = *(const f32x4*)(g + c0), sc = *(const f32x4*)(mb + SC1 + c0), sh = *(const f32x4*)(mb + SH1 + c0);
                const f32x4 h = v[rr][j] * rstd * gg * (sc + 1.0f) + sh;
                u32x2 w; w.x = cvtpk(h[0], h[1]); w.y = cvtpk(h[2], h[3]); o8[64 * j] = w; }
        }
    }
}

constexpr int SGU_STRIDE = 1088;
__device__ __forceinline__ s16x4 vtr(const LAS unsigned char* p) { typedef short v4i16_t __attribute__((ext_vector_type(4))); return __builtin_bit_cast(s16x4, __builtin_amdgcn_ds_read_tr16_b64_v4i16((LAS v4i16_t*)p)); }
__device__ __forceinline__ void sgu_unit(const Frame& F, const Args& a, int b, int blk) {
    const bf16* VG = (const bf16*)(a.ws + WS_VG); const bf16* U = (const bf16*)(a.ws + WS_U); bf16* YAB = (bf16*)(a.ws + WS_YAB);
    const float* ln_g = a.in[8]; const float* ln_b = a.in[9]; const float* w_s = a.in[10]; const float* b_s = a.in[11];
    const int tok0 = b * SEQ + blk * SGB, lane = F.lane;
    {
        f32x4 g0 = *(const f32x4*)(ln_g + lane * 8), g1 = *(const f32x4*)(ln_g + lane * 8 + 4), b0 = *(const f32x4*)(ln_b + lane * 8), b1 = *(const f32x4*)(ln_b + lane * 8 + 4);
#pragma unroll 4
        for (int rr = 0; rr < 16; ++rr) { const int row = F.wave * 16 + rr;
            const u32x4 w = *(const u32x4*)(VG + (size_t)(tok0 + row) * 512 + lane * 8);
            f32x4 v0 = {bflo(w.x), bfhi(w.x), bflo(w.y), bfhi(w.y)}, v1 = {bflo(w.z), bfhi(w.z), bflo(w.w), bfhi(w.w)};
            const float mu = wave_sum((v0[0] + v0[1]) + (v0[2] + v0[3]) + (v1[0] + v1[1]) + (v1[2] + v1[3])) * (1.0f / 512.0f);
            v0 -= mu; v1 -= mu;
            const float var = wave_sum((v0[0] * v0[0] + v0[1] * v0[1]) + (v0[2] * v0[2] + v0[3] * v0[3]) + (v1[0] * v1[0] + v1[1] * v1[1]) + (v1[2] * v1[2] + v1[3] * v1[3])) * (1.0f / 512.0f);
            const float rstd = rsqrtf(var + EPS);
            v0 = v0 * rstd * g0 + b0; v1 = v1 * rstd * g1 + b1;
            u32x4 o; o.x = cvtpk(v0[0], v0[1]); o.y = cvtpk(v0[2], v0[3]); o.z = cvtpk(v1[0], v1[1]); o.w = cvtpk(v1[2], v1[3]);
            *(LAS u32x4*)(F.lds + row * SGU_STRIDE + lane * 16) = o; }
    }
    __syncthreads();
    {
        const int g = F.wave, r32 = lane & 31, hi = lane >> 5, i16 = lane & 15, g16 = (lane >> 4) & 1;
        const LAS unsigned char* vb = F.lds + (8 * hi + (i16 >> 2)) * SGU_STRIDE + (g * 64 + 16 * g16 + 4 * (i16 & 3)) * 2;
#pragma unroll 1
        for (int tb = 0; tb < 4; ++tb) {
            const int t = 32 * tb + r32; const float* wrow = w_s + ((size_t)g * 128 + t) * 128;
            f32x16 a0, a1;
#pragma unroll
            for (int r = 0; r < 16; ++r) { a0[r] = 0.f; a1[r] = 0.f; }
#pragma unroll 1
            for (int ks = 0; ks < 2 * tb + 2; ++ks) {
                const int s0 = 16 * ks + 8 * hi;
                const f32x4 w0 = *(const f32x4*)(wrow + s0), w1 = *(const f32x4*)(wrow + s0 + 4);
                float wv[8] = {w0[0], w0[1], w0[2], w0[3], w1[0], w1[1], w1[2], w1[3]};
#pragma unroll
                for (int j = 0; j < 8; ++j) wv[j] = (s0 + j <= t) ? wv[j] : 0.f;
                u32x4 bw; bw.x = cvtpk(wv[0], wv[1]); bw.y = cvtpk(wv[2], wv[3]); bw.z = cvtpk(wv[4], wv[5]); bw.w = cvtpk(wv[6], wv[7]);
                const bf16x8 bfrag = __builtin_bit_cast(bf16x8, bw);
                const LAS unsigned char* p = vb + ks * 16 * SGU_STRIDE;
                const s16x4 l0 = vtr(p), h0 = vtr(p + 4 * SGU_STRIDE), l1 = vtr(p + 64), h1 = vtr(p + 4 * SGU_STRIDE + 64);
                const bf16x8 A0 = {l0[0], l0[1], l0[2], l0[3], h0[0], h0[1], h0[2], h0[3]}, A1 = {l1[0], l1[1], l1[2], l1[3], h1[0], h1[1], h1[2], h1[3]};
                a0 = __builtin_amdgcn_mfma_f32_32x32x16_bf16(A0, bfrag, a0, 0, 0, 0);
                a1 = __builtin_amdgcn_mfma_f32_32x32x16_bf16(A1, bfrag, a1, 0, 0, 0);
            }
            const float bs = b_s[g * 128 + t];
            const bf16* up = U + (size_t)(tok0 + t) * 512 + g * 64 + 4 * hi; bf16* op = YAB + (size_t)(tok0 + t) * 1024 + 512 + g * 64 + 4 * hi;
#pragma unroll
            for (int gg = 0; gg < 4; ++gg) {
                const u32x2 u0 = *(const u32x2*)(up + 8 * gg), u1 = *(const u32x2*)(up + 32 + 8 * gg);
                u32x2 o0, o1;
                o0.x = cvtpk(bflo(u0.x) * (a0[4 * gg] + bs), bfhi(u0.x) * (a0[4 * gg + 1] + bs)); o0.y = cvtpk(bflo(u0.y) * (a0[4 * gg + 2] + bs), bfhi(u0.y) * (a0[4 * gg + 3] + bs));
                o1.x = cvtpk(bflo(u1.x) * (a1[4 * gg] + bs), bfhi(u1.x) * (a1[4 * gg + 1] + bs)); o1.y = cvtpk(bflo(u1.y) * (a1[4 * gg + 2] + bs), bfhi(u1.y) * (a1[4 * gg + 3] + bs));
                *(u32x2*)(op + 8 * gg) = o0; *(u32x2*)(op + 32 + 8 * gg) = o1; }
        }
    }
    __syncthreads();
}

__device__ __forceinline__ void attn_task(const bf16* __restrict__ Q, const bf16* __restrict__ Kb, const bf16* __restrict__ Vb, bf16* YAB, LAS unsigned char* vt, const LAS float* bt,
                                          int b, int c, int h, int half, int lane) {
    const int r32 = lane & 31, hi = lane >> 5, i16 = lane & 15, g16 = (lane >> 4) & 1;
    const int tok0 = b * SEQ + c * CHUNK, qi = half * 32 + r32, qtok = tok0 + qi;
    bf16x8 qf[4];
#pragma unroll
    for (int s = 0; s < 4; ++s) qf[s] = *(const bf16x8*)(Q + (size_t)qtok * 512 + h * 64 + 16 * s + 8 * hi);
    f32x16 o0, o1;
#pragma unroll
    for (int r = 0; r < 16; ++r) { o0[r] = 0.f; o1[r] = 0.f; }
    float m = -1e30f, l = 0.f;
    const int j0 = (c < NLEFT) ? (NLEFT - c) : 0;
    const int fb = (i16 >> 3) & 1;
    LAS unsigned char* vw = vt + (lane >> 3) * 128 + (((lane & 7) ^ (((lane >> 4) & 1) * 4)) * 16);
    const LAS unsigned char* vr0 = vt + (4 * hi + (i16 >> 2)) * 128 + ((4 * (0 ^ fb) + 2 * g16 + ((i16 & 3) >> 1)) * 16) + (i16 & 1) * 8;
    const LAS unsigned char* vr1 = vt + (4 * hi + (i16 >> 2)) * 128 + ((4 * (1 ^ fb) + 2 * g16 + ((i16 & 3) >> 1)) * 16) + (i16 & 1) * 8;
    const size_t hoff = (size_t)h * 64;
    bf16x8 kf[2][4]; u32x4 vn[8];
    {
        const bf16* kp = Kb + (size_t)(tok0 + (j0 - NLEFT) * CHUNK) * 512 + hoff; const bf16* vp = Vb + (size_t)(tok0 + (j0 - NLEFT) * CHUNK) * 512 + hoff;
#pragma unroll
        for (int blk = 0; blk < 2; ++blk)
#pragma unroll
            for (int s = 0; s < 4; ++s) kf[blk][s] = *(const bf16x8*)(kp + (size_t)(32 * blk + r32) * 512 + 16 * s + 8 * hi);
#pragma unroll
        for (int p = 0; p < 8; ++p) vn[p] = *(const u32x4*)(vp + (size_t)(8 * p + (lane >> 3)) * 512 + (lane & 7) * 8);
#pragma unroll
        for (int p = 0; p < 8; ++p) *(LAS u32x4*)(vw + p * 1024) = vn[p];
    }
#pragma unroll 1
    for (int j = j0; j < 9; ++j) {
        const bool more = (j + 1 < 9);
        const bf16* kp = Kb + (size_t)(tok0 + (j + 1 - NLEFT) * CHUNK) * 512 + hoff; const bf16* vp = Vb + (size_t)(tok0 + (j + 1 - NLEFT) * CHUNK) * 512 + hoff;
        if (more) {
#pragma unroll
            for (int p = 0; p < 8; ++p) vn[p] = *(const u32x4*)(vp + (size_t)(8 * p + (lane >> 3)) * 512 + (lane & 7) * 8);
        }
        f32x16 p0, p1;
#pragma unroll
        for (int r = 0; r < 16; ++r) { p0[r] = 0.f; p1[r] = 0.f; }
#pragma unroll
        for (int s = 0; s < 4; ++s) { p0 = __builtin_amdgcn_mfma_f32_32x32x16_bf16(kf[0][s], qf[s], p0, 0, 0, 0); p1 = __builtin_amdgcn_mfma_f32_32x32x16_bf16(kf[1][s], qf[s], p1, 0, 0, 0); }
        if (more) {
#pragma unroll
            for (int blk = 0; blk < 2; ++blk)
#pragma unroll
                for (int s = 0; s < 4; ++s) kf[blk][s] = *(const bf16x8*)(kp + (size_t)(32 * blk + r32) * 512 + 16 * s + 8 * hi);
        }
        if (j >= 6) {
            const int base = 640 + qi - 64 * j - 4 * hi;
#pragma unroll
            for (int r = 0; r < 16; ++r) { const int kk = (r & 3) + 8 * (r >> 2); int i0 = base - kk, i1 = base - 32 - kk; i0 = i0 > 256 ? 256 : i0; i1 = i1 > 256 ? 256 : i1; p0[r] += bt[i0]; p1[r] += bt[i1]; }
        }
        float tm = fmaxf(p0[0], p1[0]);
#pragma unroll
        for (int r = 1; r < 16; ++r) tm = fmaxf(tm, fmaxf(p0[r], p1[r]));
        tm = fmaxf(tm, __shfl_xor(tm, 32));
        const float mn = fmaxf(m, tm), alpha = __builtin_amdgcn_exp2f(m - mn); m = mn;
        float ps = 0.f;
#pragma unroll
        for (int r = 0; r < 16; ++r) { p0[r] = __builtin_amdgcn_exp2f(p0[r] - mn); p1[r] = __builtin_amdgcn_exp2f(p1[r] - mn); ps += p0[r] + p1[r]; }
        l = l * alpha + ps;
#pragma unroll
        for (int r = 0; r < 16; ++r) { o0[r] *= alpha; o1[r] *= alpha; }
        bf16x8 pb[2][2];
#pragma unroll
        for (int s = 0; s < 2; ++s) {
            u32x4 w0; w0.x = cvtpk(p0[8 * s], p0[8 * s + 1]); w0.y = cvtpk(p0[8 * s + 2], p0[8 * s + 3]); w0.z = cvtpk(p0[8 * s + 4], p0[8 * s + 5]); w0.w = cvtpk(p0[8 * s + 6], p0[8 * s + 7]);
            u32x4 w1; w1.x = cvtpk(p1[8 * s], p1[8 * s + 1]); w1.y = cvtpk(p1[8 * s + 2], p1[8 * s + 3]); w1.z = cvtpk(p1[8 * s + 4], p1[8 * s + 5]); w1.w = cvtpk(p1[8 * s + 6], p1[8 * s + 7]);
            pb[0][s] = __builtin_bit_cast(bf16x8, w0); pb[1][s] = __builtin_bit_cast(bf16x8, w1); }
#pragma unroll
        for (int blk = 0; blk < 2; ++blk)
#pragma unroll
            for (int s = 0; s < 2; ++s) {
                const int ko = (32 * blk + 16 * s) * 128;
                const s16x4 l0 = vtr(vr0 + ko), h0 = vtr(vr0 + ko + 1024), l1 = vtr(vr1 + ko), h1 = vtr(vr1 + ko + 1024);
                const bf16x8 A0 = {l0[0], l0[1], l0[2], l0[3], h0[0], h0[1], h0[2], h0[3]}, A1 = {l1[0], l1[1], l1[2], l1[3], h1[0], h1[1], h1[2], h1[3]};
                o0 = __builtin_amdgcn_mfma_f32_32x32x16_bf16(A0, pb[blk][s], o0, 0, 0, 0);
                o1 = __builtin_amdgcn_mfma_f32_32x32x16_bf16(A1, pb[blk][s], o1, 0, 0, 0);
            }
        if (more) {
#pragma unroll
            for (int p = 0; p < 8; ++p) *(LAS u32x4*)(vw + p * 1024) = vn[p];
        }
    }
    l += __shfl_xor(l, 32);
    const float inv = __builtin_amdgcn_rcpf(l);
    bf16* op = YAB + (size_t)qtok * 1024 + hoff + 4 * hi;
#pragma unroll
    for (int gg = 0; gg < 4; ++gg) {
        u32x2 w0, w1;
        w0.x = cvtpk(o0[4 * gg] * inv, o0[4 * gg + 1] * inv); w0.y = cvtpk(o0[4 * gg + 2] * inv, o0[4 * gg + 3] * inv);
        w1.x = cvtpk(o1[4 * gg] * inv, o1[4 * gg + 1] * inv); w1.y = cvtpk(o1[4 * gg + 2] * inv, o1[4 * gg + 3] * inv);
        *(u32x2*)(op + 8 * gg) = w0; *(u32x2*)(op + 32 + 8 * gg) = w1; }
}
__device__ __forceinline__ void phaseD(const Frame& F, const Args& a) {
    for (int unit = F.vcu; unit < NB * (SEQ / SGB); unit += F.G) sgu_unit(F, a, unit / (SEQ / SGB), unit % (SEQ / SGB));
    const bf16* Q = (const bf16*)(a.ws + WS_Q); const bf16* Kb = (const bf16*)(a.ws + WS_K); const bf16* Vb = (const bf16*)(a.ws + WS_V); bf16* YAB = (bf16*)(a.ws + WS_YAB);
    LAS unsigned char* vt = F.lds + F.wave * 8192; LAS float* bt = (LAS float*)(F.lds + 65536 + F.wave * 1088);
    const float* rb = a.in[7] + F.wave * NREL; const float b256 = rb[256];
    for (int i = F.lane; i < NREL; i += 64) bt[i] = (rb[i] - b256) * LOG2E;
    LDS_WAIT();
    const int NCH = NB * (SEQ / CHUNK);
    for (int v = F.vcu; v < NCH / 2; v += F.G) {
#pragma unroll 1
        for (int k = 0; k < 4; ++k) { const int gc = (k < 2) ? v : (NCH - 1 - v); attn_task(Q, Kb, Vb, YAB, vt, bt, gc / (SEQ / CHUNK), gc % (SEQ / CHUNK), F.wave, k & 1, F.lane); }
    }
}

constexpr int G_HT_STRIDE = 2064;
__device__ __forceinline__ void phaseG(const Frame& F, const Args& a) {
    const float* x = a.in[0]; const bf16* Y1 = (const bf16*)(a.ws + WS_Y1); const float* mod = (const float*)(a.ws + WS_MOD); const float* g_post_mix = a.in[5]; const float* g_pre_ffn = a.in[17];
    const float* w_router = a.in[19]; const float* b_router = a.in[20]; float* X1 = a.out; unsigned char* XN8 = a.ws + WS_XN;
    float* topg = (float*)(a.ws + WS_TOPG); int* list = (int*)(a.ws + WS_LIST); unsigned* cnt = F.ctl + CW_CNT;
    LAS unsigned char* HT = F.lds;
    LAS float* PL = (LAS float*)(F.lds + 33792);
    LAS float* LG = PL + 8 * 32 * 16;
    LAS float* TV = LG + 512;
    LAS unsigned* LC = (LAS unsigned*)(TV + 64);
    LAS unsigned* AS = LC + 64;
    const int tid = F.tid, lane = F.lane, wave = F.wave, kq = lane >> 4, i16 = lane & 15;
    if (tid < 64) LC[tid] = 0u;
    bf16x8 whi[2][4], wlo[2][4];
#pragma unroll
    for (int et = 0; et < 2; ++et)
#pragma unroll
        for (int ks = 0; ks < 4; ++ks) { unsigned h[4], l[4];
#pragma unroll
            for (int jj = 0; jj < 4; ++jj) { const int k = 128 * wave + 32 * ks + 8 * kq + 2 * jj;
                const float w0 = w_router[(size_t)k * NEXP + et * 16 + i16], w1 = w_router[(size_t)(k + 1) * NEXP + et * 16 + i16];
                const unsigned hh = cvtpk(w0, w1); h[jj] = hh; l[jj] = cvtpk(w0 - bflo(hh), w1 - bfhi(hh)); }
            u32x4 hv = {h[0], h[1], h[2], h[3]}, lv = {l[0], l[1], l[2], l[3]};
            whi[et][ks] = __builtin_bit_cast(bf16x8, hv); wlo[et][ks] = __builtin_bit_cast(bf16x8, lv); }
    __syncthreads();
    int tl = 0;
    for (int T = F.vcu; T < NTOK / 16; T += F.G, ++tl) {
        const int b = (16 * T) / SEQ; const float* mb = mod + b * 6144; const int rbase = 16 * T + 2 * wave;
        f32x4 xv[2][4]; u32x2 yr[2][4];
#pragma unroll
        for (int rr = 0; rr < 2; ++rr)
#pragma unroll
            for (int j = 0; j < 4; ++j) { const int c0 = (lane + 64 * j) * 4; xv[rr][j] = *(const f32x4*)(x + (size_t)(rbase + rr) * D + c0); yr[rr][j] = *(const u32x2*)(Y1 + (size_t)(rbase + rr) * D + c0); }
#pragma unroll
        for (int rr = 0; rr < 2; ++rr) {
            const int row = rbase + rr; f32x4 yv[4]; float ss = 0.f;
#pragma unroll
            for (int j = 0; j < 4; ++j) { yv[j] = (f32x4){bflo(yr[rr][j].x), bfhi(yr[rr][j].x), bflo(yr[rr][j].y), bfhi(yr[rr][j].y)}; ss += (yv[j][0] * yv[j][0] + yv[j][1] * yv[j][1]) + (yv[j][2] * yv[j][2] + yv[j][3] * yv[j][3]); }
            const float rstd = rsqrtf(wave_sum(ss) * (1.0f / D) + EPS); float s2 = 0.f;
#pragma unroll
            for (int j = 0; j < 4; ++j) { const int c0 = (lane + 64 * j) * 4;
                const f32x4 gp = *(const f32x4*)(g_post_mix + c0), gt = *(const f32x4*)(mb + GT1 + c0);
                xv[rr][j] = xv[rr][j] + gt * (yv[j] * rstd * gp);
                *(f32x4*)(X1 + (size_t)row * D + c0) = xv[rr][j];
                s2 += (xv[rr][j][0] * xv[rr][j][0] + xv[rr][j][1] * xv[rr][j][1]) + (xv[rr][j][2] * xv[rr][j][2] + xv[rr][j][3] * xv[rr][j][3]); }
            const float rstd2 = rsqrtf(wave_sum(s2) * (1.0f / D) + EPS);
#pragma unroll
            for (int j = 0; j < 4; ++j) { const int c0 = (lane + 64 * j) * 4;
                const f32x4 gf = *(const f32x4*)(g_pre_ffn + c0), sc = *(const f32x4*)(mb + SC2 + c0), sh = *(const f32x4*)(mb + SH2 + c0);
                const f32x4 h = xv[rr][j] * rstd2 * gf * (sc + 1.0f) + sh;
                u32x2 w; w.x = cvtpk(h[0], h[1]); w.y = cvtpk(h[2], h[3]); *(unsigned*)(XN8 + (size_t)row * D + c0) = pk_fp8x4(h[0] * F8_ASCALE, h[1] * F8_ASCALE, h[2] * F8_ASCALE, h[3] * F8_ASCALE);
                *(LAS u32x2*)(HT + (2 * wave + rr) * G_HT_STRIDE + c0 * 2) = w; }
        }
        __syncthreads();
        {
            f32x4 acc0 = {0.f, 0.f, 0.f, 0.f}, acc1 = {0.f, 0.f, 0.f, 0.f};
#pragma unroll
            for (int ks = 0; ks < 4; ++ks) { const bf16x8 hb = *(const LAS bf16x8*)(HT + i16 * G_HT_STRIDE + (128 * wave + 32 * ks + 8 * kq) * 2);
                acc0 = __builtin_amdgcn_mfma_f32_16x16x32_bf16(whi[0][ks], hb, acc0, 0, 0, 0); acc0 = __builtin_amdgcn_mfma_f32_16x16x32_bf16(wlo[0][ks], hb, acc0, 0, 0, 0);
                acc1 = __builtin_amdgcn_mfma_f32_16x16x32_bf16(whi[1][ks], hb, acc1, 0, 0, 0); acc1 = __builtin_amdgcn_mfma_f32_16x16x32_bf16(wlo[1][ks], hb, acc1, 0, 0, 0); }
#pragma unroll
            for (int r = 0; r < 4; ++r) { PL[(wave * 32 + 4 * kq + r) * 16 + i16] = acc0[r]; PL[(wave * 32 + 16 + 4 * kq + r) * 16 + i16] = acc1[r]; }
        }
        __syncthreads();
        const int row = tid & 15, e = tid >> 4;
        float lg = b_router[e];
#pragma unroll
        for (int w = 0; w < 8; ++w) lg += PL[(w * 32 + e) * 16 + row];
        LG[e * 16 + row] = lg;
        __syncthreads();
        int rank = 0;
#pragma unroll
        for (int e2 = 0; e2 < 32; ++e2) { const float o = LG[e2 * 16 + row]; rank += (o > lg || (o == lg && e2 < e)) ? 1 : 0; }
        if (rank < 4) TV[row * 4 + rank] = lg;
        __syncthreads();
        if (rank < 4) {
            const float m = TV[row * 4], den = 1.0f + __expf(TV[row * 4 + 1] - m) + __expf(TV[row * 4 + 2] - m) + __expf(TV[row * 4 + 3] - m);
            const int slot = (16 * T + row) * 4 + rank; topg[slot] = __expf(lg - m) / den;
            const unsigned lp = __hip_atomic_fetch_add(LC + e, 1u, __ATOMIC_RELAXED, __HIP_MEMORY_SCOPE_WORKGROUP);
            if (tl < 16) AS[tl * 64 + row * 4 + rank] = (unsigned)e | (lp << 8);
        }
    }
    __syncthreads();
    if (tid < NEXP) LC[32 + tid] = atomicAdd(&cnt[tid], LC[tid]);
    __syncthreads();
    for (int i = tid; i < tl * 64; i += NWAVES * 64) { const unsigned as = AS[i]; const int e = as & 255, lp = as >> 8; const int T = F.vcu + (i >> 6) * F.G;
        list[(size_t)e * NTOK + LC[32 + e] + lp] = (16 * T + ((i & 63) >> 2)) * 4 + (i & 3); }
}
__device__ __forceinline__ int moe_tables(const Frame& F) {
    __syncthreads();
    if (F.tid < NEXP) F.MISC[40 + F.tid] = __hip_atomic_load(F.ctl + CW_CNT + F.tid, __ATOMIC_RELAXED, __HIP_MEMORY_SCOPE_AGENT);
    __syncthreads();
    if (F.tid == 0) { unsigned s = 0; for (int e = 0; e < NEXP; ++e) { F.MISC[e] = s; s += (F.MISC[40 + e] + 255u) >> 8; } F.MISC[32] = s; }
    __syncthreads();
    return (int)F.MISC[32];
}
__device__ __forceinline__ void phaseJ(const Frame& F, const Args& a) {
    const bf16* Y2s = (const bf16*)(a.ws + WS_Y2); const float* mod = (const float*)(a.ws + WS_MOD); const float* gpf = a.in[18]; float* out = a.out;
    const int* inv = (const int*)(a.ws + WS_TOPE); const float* topg = (const float*)(a.ws + WS_TOPG);
    const int lane = F.lane, gw = F.vcu * NWAVES + F.wave, NGW = F.G * NWAVES;
    for (int row0 = gw * 2; row0 < NTOK; row0 += NGW * 2) {
        const int b = row0 / SEQ; const float* mb = mod + b * 6144;
        int pp[2][4]; float gg[2][4];
#pragma unroll
        for (int rr = 0; rr < 2; ++rr)
#pragma unroll
            for (int k = 0; k < 4; ++k) { pp[rr][k] = __builtin_amdgcn_readfirstlane(inv[(row0 + rr) * 4 + k]); gg[rr][k] = topg[(row0 + rr) * 4 + k]; }
        u32x2 yy[2][4][4]; f32x4 xx[2][4];
#pragma unroll
        for (int rr = 0; rr < 2; ++rr)
#pragma unroll
            for (int j = 0; j < 4; ++j) { const int c0 = (lane + 64 * j) * 4;
#pragma unroll
                for (int k = 0; k < 4; ++k) yy[rr][j][k] = *(const u32x2*)(Y2s + (size_t)pp[rr][k] * D + c0);
                xx[rr][j] = *(const f32x4*)(out + (size_t)(row0 + rr) * D + c0); }
#pragma unroll
        for (int rr = 0; rr < 2; ++rr) {
            f32x4 yv[4]; float ss = 0.f;
#pragma unroll
            for (int j = 0; j < 4; ++j) { f32x4 s = {0.f, 0.f, 0.f, 0.f};
#pragma unroll
                for (int k = 0; k < 4; ++k) s += (f32x4){bflo(yy[rr][j][k].x), bfhi(yy[rr][j][k].x), bflo(yy[rr][j][k].y), bfhi(yy[rr][j][k].y)} * gg[rr][k];
                yv[j] = s; ss += (s[0] * s[0] + s[1] * s[1]) + (s[2] * s[2] + s[3] * s[3]); }
            const float rstd = rsqrtf(wave_sum(ss) * (1.0f / D) + EPS);
#pragma unroll
            for (int j = 0; j < 4; ++j) { const int c0 = (lane + 64 * j) * 4;
                const f32x4 g = *(const f32x4*)(gpf + c0), gt = *(const f32x4*)(mb + GT2 + c0);
                *(f32x4*)(out + (size_t)(row0 + rr) * D + c0) = xx[rr][j] + gt * (yv[j] * rstd * g); }
        }
    }
}

constexpr int N_PHASES = 10;
__global__ void __launch_bounds__(NWAVES * 64, 2) mega_fwd(Args args) {
    extern __shared__ __attribute__((aligned(16))) unsigned char lds_raw[];
    Frame F;
    F.lds = (LAS unsigned char*)lds_raw; F.MISC = (volatile LAS unsigned*)(F.lds + MISC_OFF);
    F.tid = threadIdx.x; F.lane = F.tid & 63; F.wave = __builtin_amdgcn_readfirstlane(F.tid >> 6);
    F.G = gridDim.x; { const int bx = blockIdx.x; F.vcu = (F.G % 8 == 0) ? (bx % 8) * (F.G / 8) + bx / 8 : bx; }
    F.ctl = (unsigned*)(args.ws + WS_CTL);
    for (int u = F.tid; u < 128; u += NWAVES * 64) F.MISC[u] = 0u;
    __syncthreads();
    const int lo = args.ph_lo, hi = args.ph_hi;
    XcdBarrier bar; bar.bar = F.ctl + CW_BAR; bar.x = 0; bar.st = F.MISC + 80;
    if (hi - lo > 1) bar = xcd_barrier_post(F.ctl + CW_BAR, F.MISC + 80);
#ifndef PH_COMPILE_MASK
#define PH_COMPILE_MASK 0x3ff
#endif
#define IN(k) (((PH_COMPILE_MASK >> (k)) & 1) && lo <= (k) && (k) < hi)
#define SEAM(k) do { if (IN(k) && IN((k) + 1)) xcd_barrier(bar); } while (0)
    unsigned char* ws = args.ws;
    bf16 *XN = (bf16*)(ws + WS_XN), *Qb = (bf16*)(ws + WS_Q), *Kb = (bf16*)(ws + WS_K), *Vb = (bf16*)(ws + WS_V), *Ub = (bf16*)(ws + WS_U), *VG = (bf16*)(ws + WS_VG);
    bf16 *GT = (bf16*)(ws + WS_GT), *YAB = (bf16*)(ws + WS_YAB), *MRG = (bf16*)(ws + WS_MRG), *Y1 = (bf16*)(ws + WS_Y1), *ACT = (bf16*)(ws + WS_ACT), *Y2 = (bf16*)(ws + WS_Y2);

    if (IN(0)) { phaseA(F, args); } SEAM(0);
    if (IN(1)) { phaseB(F, args); } SEAM(1);
    if (IN(2)) {
        SchedStatic S{(const char*)XN, (const char*)(ws + WS_W1T), NTOK / 256, 4608 / 256, F.G, (int)blockIdx.x, (size_t)256 * 1024 * 2, (size_t)256 * 1024 * 2};
        EpiG1 E{Qb, Kb, Vb, Ub, VG, GT, args.in[15]};
        pg8::gemm_phase<EpiG1, SchedStatic, false>(F.lds + RING_OFF, S, E, 2048, 2048, 16, args.pad);
    } SEAM(2);
    if (IN(3)) { phaseD(F, args); } SEAM(3);
    if (IN(4)) {
        SchedSplit2 S{(const char*)YAB, (const char*)(ws + WS_WBRT), NTOK / 256, 4, F.G, (int)blockIdx.x, (size_t)256 * 1024 * 2, (size_t)256 * 1024 * 2, (size_t)512 * 2};
        EpiG2 E{GT, MRG};
        pg8::gemm_phase<EpiG2, SchedSplit2, false>(F.lds + RING_OFF, S, E, 2048, 2048, 8);
    } SEAM(4);
    if (IN(5)) {
        SchedStatic S{(const char*)MRG, (const char*)(ws + WS_WOUTT), NTOK / 256, 4, F.G, (int)blockIdx.x, (size_t)256 * 1024 * 2, (size_t)256 * 1024 * 2};
        EpiPlain E{Y1};
        pg8::gemm_phase<EpiPlain, SchedStatic, false>(F.lds + RING_OFF, S, E, 2048, 2048, 16);
    } SEAM(5);
    if (IN(6)) { phaseG(F, args); } SEAM(6);
    if (IN(7)) {
        const int nrb = moe_tables(F);
        const int* list = (const int*)(ws + WS_LIST);
        {
            int* inv = (int*)(ws + WS_TOPE);
            for (int g = (int)blockIdx.x * (NWAVES * 64) + F.tid; g < NTOK * TOPK; g += F.G * NWAVES * 64) {
                int e = 0, base = 0;
#pragma unroll 1
                for (int i = 0; i < NEXP; ++i) { const int c = (int)F.MISC[40 + i]; if (g >= base + c) { base += c; e = i + 1; } else break; }
                const int pos = g - base; if (e < NEXP) inv[list[(size_t)e * NTOK + pos]] = (int)F.MISC[e] * 256 + pos; }
        }
        typedef SchedMoe<8, true> SM;
        SM S{(const char*)XN, (const char*)(ws + WS_WGUT), F.MISC, (const LAS unsigned*)(F.lds + GTAB_OFF), (int)blockIdx.x, F.G, nrb, (size_t)2048 * 1024, (size_t)256 * 1024};
        S.build(F.tid);
        { Unit u; LAS unsigned* gt = (LAS unsigned*)(F.lds + GTAB_OFF);
          for (int k = 0; k < GTAB_UNITS && S.next(k, u); ++k) { const int e = u.aux, j256 = (u.pm - (int)F.MISC[e]) * 256, ecnt = (int)F.MISC[40 + e];
              for (int r = F.tid; r < 256; r += NWAVES * 64) { const int pos = j256 + r; int tok = 0; if (pos < ecnt) tok = list[(size_t)e * NTOK + pos] >> 2; gt[k * 256 + r] = (unsigned)tok * 1024u; } } }
        __syncthreads();
        EpiAct E{args.in[22], (unsigned char*)ACT};
        pg8::gemm_phase<EpiAct, SM, true>(F.lds + RING_OFF, S, E, 1024, 1024, 8, args.pad);
    } SEAM(7);
    if (IN(8)) {
        const int nrb = moe_tables(F);
        typedef SchedMoe<4, true> SM;
        SM S{(const char*)ACT, (const char*)(ws + WS_WDNT), F.MISC, (const LAS unsigned*)(F.lds + GTAB_OFF), (int)blockIdx.x, F.G, nrb, (size_t)1024 * 1024, (size_t)256 * 1024};
        S.build(F.tid);
        { Unit u; LAS unsigned* gt = (LAS unsigned*)(F.lds + GTAB_OFF);
          for (int k = 0; k < GTAB_UNITS && S.next(k, u); ++k) for (int r = F.tid; r < 256; r += NWAVES * 64) gt[k * 256 + r] = (unsigned)(u.pm * 256 + r) * 1024u; }
        __syncthreads();
        EpiDown E{args.in[24], Y2};
        pg8::gemm_phase<EpiDown, SM, true>(F.lds + RING_OFF, S, E, 1024, 1024, 8, args.pad);
    } SEAM(8);
    if (IN(9)) { phaseJ(F, args); }
#undef IN
#undef SEAM
}
#ifndef MEGA_MASK
#define MEGA_MASK 0x3ff
#endif
#ifndef REP_MASK
#define REP_MASK 0
#endif
#ifndef REP_FLAGS
#define REP_FLAGS 0
#endif
#ifndef ONE_LAUNCH
#define ONE_LAUNCH 1
#endif
extern "C" void kernel_launch(void* const* d_in, const int* in_sizes, int n_in, void* d_out, int out_size, void* d_ws, size_t ws_size, hipStream_t stream) {
    if (n_in != 25 || in_sizes[0] != NTOK * D || out_size != NTOK * D || ws_size < WS_END) { fprintf(stderr, "kernel_launch: unexpected shapes (n_in %d in0 %d out %d ws %zu)\n", n_in, n_in > 0 ? in_sizes[0] : -1, out_size, ws_size); return; }
    static int grid = 0;
    if (grid == 0) {
        int dev = 0, cus = 0, per_cu = 0;
        if (hipGetDevice(&dev) != hipSuccess || hipDeviceGetAttribute(&cus, hipDeviceAttributeMultiprocessorCount, dev) != hipSuccess) { fprintf(stderr, "kernel_launch: device query failed\n"); grid = -1; return; }
        if (hipFuncSetAttribute((const void*)mega_fwd, hipFuncAttributeMaxDynamicSharedMemorySize, LDS_BYTES) != hipSuccess) { fprintf(stderr, "kernel_launch: hipFuncSetAttribute failed\n"); grid = -1; return; }
        if (hipOccupancyMaxActiveBlocksPerMultiprocessor(&per_cu, (const void*)mega_fwd, NWAVES * 64, LDS_BYTES) != hipSuccess || per_cu < 1) { fprintf(stderr, "kernel_launch: occupancy query says %d\n", per_cu); }
        (void)hipGetLastError();
        grid = cus;
    }
    if (grid < 0) return;
    const float* x = (const float*)d_in[0]; const float* c = (const float*)d_in[1]; const float* w_ada = (const float*)d_in[2]; const float* b_ada = (const float*)d_in[3];
    const float* g_pre_mix = (const float*)d_in[4]; const float* g_post_mix = (const float*)d_in[5]; const float* w_in = (const float*)d_in[6]; const float* rel_bias = (const float*)d_in[7];
    const float* sgu_ln_g = (const float*)d_in[8]; const float* sgu_ln_b = (const float*)d_in[9]; const float* w_spatial = (const float*)d_in[10]; const float* b_spatial = (const float*)d_in[11];
    const float* w_branch_a = (const float*)d_in[12]; const float* w_branch_b = (const float*)d_in[13]; const float* w_gate = (const float*)d_in[14]; const float* b_gate = (const float*)d_in[15];
    const float* w_out = (const float*)d_in[16]; const float* g_pre_ffn = (const float*)d_in[17]; const float* g_post_ffn = (const float*)d_in[18]; const float* w_router = (const float*)d_in[19];
    const float* b_router = (const float*)d_in[20]; const float* w_gate_up = (const float*)d_in[21]; const float* b_gate_up = (const float*)d_in[22]; const float* w_down = (const float*)d_in[23];
    const float* b_down = (const float*)d_in[24];
    unsigned char* ws = (unsigned char*)d_ws; float* out = (float*)d_out;
    unsigned* ctl = (unsigned*)(ws + WS_CTL); float* mod = (float*)(ws + WS_MOD);
    bf16 *XN = (bf16*)(ws + WS_XN), *Qb = (bf16*)(ws + WS_Q), *Kb = (bf16*)(ws + WS_K), *Vb = (bf16*)(ws + WS_V), *Ub = (bf16*)(ws + WS_U), *VG = (bf16*)(ws + WS_VG);
    bf16 *GT = (bf16*)(ws + WS_GT), *YAB = (bf16*)(ws + WS_YAB), *MRG = (bf16*)(ws + WS_MRG), *Y1 = (bf16*)(ws + WS_Y1), *ACT = (bf16*)(ws + WS_ACT), *Y2 = (bf16*)(ws + WS_Y2);
    float *VN = (float*)(ws + WS_VN), *TMP = (float*)(ws + WS_TMP);
    int* tope = (int*)(ws + WS_TOPE); float* topg = (float*)(ws + WS_TOPG); int* list = (int*)(ws + WS_LIST); unsigned* cnt = ctl + CW_CNT;
    (void)x; (void)c; (void)w_ada; (void)b_ada; (void)g_pre_mix; (void)rel_bias; (void)sgu_ln_g; (void)sgu_ln_b; (void)w_spatial; (void)b_spatial; (void)tope;

    if (hipMemsetAsync(ws + WS_CTL, 0, CTL_ZERO_BYTES, stream) != hipSuccess) { fprintf(stderr, "kernel_launch: memset failed\n"); return; }
    Args a{};
    for (int i = 0; i < 25; ++i) a.in[i] = (const float*)d_in[i];
    a.out = out; a.ws = ws;
#if ONE_LAUNCH
    a.ph_lo = 0; a.ph_hi = N_PHASES;
    hipLaunchKernelGGL(mega_fwd, dim3(grid), dim3(NWAVES * 64), LDS_BYTES, stream, a);
    if (hipPeekAtLastError() != hipSuccess) fprintf(stderr, "kernel_launch: launch failed\n");
    for (int ph = 0; ph < N_PHASES; ++ph) if ((REP_MASK >> ph) & 1) {
        a.ph_lo = ph; a.ph_hi = ph + 1; a.pad = REP_FLAGS; hipLaunchKernelGGL(mega_fwd, dim3(grid), dim3(NWAVES * 64), LDS_BYTES, stream, a); }
#else
    for (int ph = 0; ph < N_PHASES; ++ph) {
        if (((MEGA_MASK >> ph) & 1) || ph == 0) { a.ph_lo = ph; a.ph_hi = ph + 1; hipLaunchKernelGGL(mega_fwd, dim3(grid), dim3(NWAVES * 64), LDS_BYTES, stream, a); if (((MEGA_MASK >> ph) & 1)) continue; }
        switch (ph) {
        case 0: nv_mod<<<NMOD * D / 256, 256, 0, stream>>>(c, w_ada, b_ada, mod); break;
        case 1: nv_xn1<<<NTOK / 4, 256, 0, stream>>>(x, g_pre_mix, mod, XN); break;
        case 2: { G_In g{XN, w_in, Qb, Kb, Vb, Ub, VG}; nv_gemm<G_In, false><<<dim3(INW / 64, NTOK / 64, 1), 256, 0, stream>>>(g, INW, D); }
                { G_Gate g{XN, w_gate, b_gate, GT}; nv_gemm<G_Gate, false><<<dim3(2048 / 64, NTOK / 64, 1), 256, 0, stream>>>(g, 2048, D); } break;
        case 3: nv_attn<<<NTOK * NHEAD / 256, 256, 0, stream>>>(Qb, Kb, Vb, rel_bias, YAB);
                nv_sgu_ln<<<NTOK / 4, 256, 0, stream>>>(VG, sgu_ln_g, sgu_ln_b, VN);
                nv_sgu<<<NTOK * SW / 256, 256, 0, stream>>>(VN, Ub, w_spatial, b_spatial, YAB); break;
        case 4: { G_BrA g{YAB, w_branch_a, GT, TMP}; nv_gemm<G_BrA, false><<<dim3(D / 64, NTOK / 64, 1), 256, 0, stream>>>(g, D, AW); }
                { G_BrB g{YAB, w_branch_b, GT, TMP, MRG}; nv_gemm<G_BrB, false><<<dim3(D / 64, NTOK / 64, 1), 256, 0, stream>>>(g, D, SW); } break;
        case 5: { G_Out g{MRG, w_out, Y1}; nv_gemm<G_Out, false><<<dim3(D / 64, NTOK / 64, 1), 256, 0, stream>>>(g, D, D); } break;
        case 6: nv_rowpass1<<<NTOK / 4, 256, 0, stream>>>(x, Y1, mod, g_post_mix, g_pre_ffn, w_router, b_router, out, XN, tope, topg, cnt, list); break;
        case 7: { G_MoeGU g{XN, w_gate_up, b_gate_up, cnt, list, ACT}; nv_gemm<G_MoeGU, true><<<dim3(DE / 64, NTOK / 64, NEXP), 256, 0, stream>>>(g, 2048, D); } break;
        case 8: { G_MoeDn g{ACT, w_down, b_down, cnt, list, topg, Y2}; nv_gemm<G_MoeDn, false><<<dim3(D / 64, NTOK / 64, NEXP), 256, 0, stream>>>(g, D, DE); } break;
        case 9: nv_final<<<NTOK / 4, 256, 0, stream>>>(Y2, mod, g_post_ffn, out); break;
        }
    }
#endif
}
```

```cpp
#include <hip/hip_runtime.h>
#include <cstdio>
#include <cstdint>

constexpr int NB = 4, SEQ = 8192, D = 1024, NTOK = NB * SEQ;
constexpr int AW = 512, NHEAD = 8, HD = 64, CHUNK = 64, NLEFT = 8, BAND = 576, MAXREL = 128, NREL = 257;
constexpr int SW = 512, SGB = 128, SGG = 8, SGD = 64;
constexpr int INW = 2560, NEXP = 32, TOPK = 4, DE = 1024, NMOD = 6;
constexpr float EPS = 1e-6f, SWL = 7.0f, SWA = 1.702f;
constexpr float LOG2E = 1.4426950408889634f;
constexpr float QSCALE = 0.125f * LOG2E;
constexpr int SH1 = 0, SC1 = 1024, GT1 = 2048, SH2 = 3072, SC2 = 4096, GT2 = 5120;

typedef unsigned short bf16;
__device__ __forceinline__ float bf2f(bf16 v) { return __uint_as_float(((unsigned)v) << 16); }
__device__ __forceinline__ bf16 f2bf(float f) { unsigned u = __float_as_uint(f); return (bf16)((u + 0x7fffu + ((u >> 16) & 1u)) >> 16); }
__device__ __forceinline__ float wave_sum(float v) {
#pragma unroll
    for (int o = 1; o < 64; o <<= 1) v += __shfl_xor(v, o);
    return v;
}
__device__ __forceinline__ float gelu_erf(float x) { return 0.5f * x * (1.0f + erff(x * 0.70710678118654752f)); }
__device__ __forceinline__ float sigmoidf_(float x) { return 1.0f / (1.0f + __expf(-x)); }

constexpr size_t MiB = 1u << 20;
constexpr size_t WS_CTL = 0, CTL_ZERO_BYTES = 1 * MiB;
constexpr size_t WS_MOD = 1 * MiB;
constexpr size_t WS_W1T = 2 * MiB, WS_WBRT = 12 * MiB, WS_WOUTT = 14 * MiB, WS_WRT = 16 * MiB;
constexpr size_t WS_TOPE = 17 * MiB, WS_TOPG = 18 * MiB, WS_LIST = 19 * MiB;
constexpr size_t WS_WGUT = 32 * MiB, WS_WDNT = 160 * MiB;
constexpr size_t WS_XN = 224 * MiB;
constexpr size_t WS_Q = 288 * MiB, WS_K = 320 * MiB, WS_V = 352 * MiB, WS_U = 384 * MiB, WS_VG = 416 * MiB;
constexpr size_t WS_GT = 448 * MiB;
constexpr size_t WS_YAB = 576 * MiB, WS_MRG = 640 * MiB, WS_Y1 = 704 * MiB;
constexpr size_t WS_ACT = 288 * MiB;
constexpr size_t WS_Y2 = 576 * MiB;
constexpr size_t WS_VN = 768 * MiB;
constexpr size_t WS_TMP = 832 * MiB;
constexpr size_t WS_END = 960 * MiB;
constexpr int CW_CNT = 1024;

__global__ __launch_bounds__(256) void nv_mod(const float* __restrict__ c, const float* __restrict__ w_ada, const float* __restrict__ b_ada, float* __restrict__ mod) {
    __shared__ float sc[NB * D];
    for (int i = threadIdx.x; i < NB * D; i += 256) { const float v = c[i]; sc[i] = v / (1.0f + __expf(-v)); }
    __syncthreads();
    const int j = blockIdx.x * 256 + threadIdx.x;
    float a0 = 0.f, a1 = 0.f, a2 = 0.f, a3 = 0.f;
    for (int k = 0; k < D; ++k) { const float w = w_ada[(size_t)k * (NMOD * D) + j]; a0 += sc[k] * w; a1 += sc[D + k] * w; a2 += sc[2 * D + k] * w; a3 += sc[3 * D + k] * w; }
    const float bb = b_ada[j];
    mod[j] = a0 + bb; mod[6144 + j] = a1 + bb; mod[2 * 6144 + j] = a2 + bb; mod[3 * 6144 + j] = a3 + bb;
}

__global__ __launch_bounds__(256) void nv_xn1(const float* __restrict__ x, const float* __restrict__ g, const float* __restrict__ mod, bf16* __restrict__ xn) {
    const int row = blockIdx.x * 4 + (threadIdx.x >> 6), lane = threadIdx.x & 63, b = row / SEQ;
    const float4* xr = (const float4*)(x + (size_t)row * D);
    float4 v[4]; float ss = 0.f;
#pragma unroll
    for (int j = 0; j < 4; ++j) { v[j] = xr[lane + 64 * j]; ss += v[j].x * v[j].x + v[j].y * v[j].y + v[j].z * v[j].z + v[j].w * v[j].w; }
    const float rstd = rsqrtf(wave_sum(ss) * (1.0f / D) + EPS);
    const float* mb = mod + b * 6144;
#pragma unroll
    for (int j = 0; j < 4; ++j) {
        const int c0 = (lane + 64 * j) * 4; const float vv[4] = {v[j].x, v[j].y, v[j].z, v[j].w}; bf16 o[4];
#pragma unroll
        for (int i = 0; i < 4; ++i) o[i] = f2bf(vv[i] * rstd * g[c0 + i] * (1.0f + mb[SC1 + c0 + i]) + mb[SH1 + c0 + i]);
        *(uint2*)(xn + (size_t)row * D + c0) = make_uint2((unsigned)o[0] | ((unsigned)o[1] << 16), (unsigned)o[2] | ((unsigned)o[3] << 16));
    }
}

template <class G, bool DUAL>
__global__ __launch_bounds__(256) void nv_gemm(G g, int ldw, int K) {
    __shared__ float As[16][68];
    __shared__ float Ws[16][64];
    __shared__ float Ws2[DUAL ? 16 : 1][64];
    const int z = blockIdx.z; int nrows; const float* W; const float* W2;
    if (!g.setup(z, nrows, W, W2)) return;
    const int r0 = blockIdx.y * 64, n0 = blockIdx.x * 64;
    if (r0 >= nrows) return;
    const int tid = threadIdx.x, tx = tid & 15, ty = tid >> 4;
    const int lr = tid >> 2, lk = (tid & 3) * 4;
    int ar = r0 + lr; if (ar >= nrows) ar = nrows - 1;
    const bf16* ap = g.arow(z, ar) + lk;
    const int wk = tid >> 4, wn = (tid & 15) * 4;
    float acc[4][4], acc2[4][4];
#pragma unroll
    for (int i = 0; i < 4; ++i)
#pragma unroll
        for (int j = 0; j < 4; ++j) { acc[i][j] = 0.f; acc2[i][j] = 0.f; }
    for (int k0 = 0; k0 < K; k0 += 16) {
        const uint2 av = *(const uint2*)(ap + k0);
        As[lk + 0][lr] = bf2f((bf16)(av.x & 0xffff)); As[lk + 1][lr] = bf2f((bf16)(av.x >> 16));
        As[lk + 2][lr] = bf2f((bf16)(av.y & 0xffff)); As[lk + 3][lr] = bf2f((bf16)(av.y >> 16));
        *(float4*)&Ws[wk][wn] = *(const float4*)(W + (size_t)(k0 + wk) * ldw + n0 + wn);
        if (DUAL) *(float4*)&Ws2[wk][wn] = *(const float4*)(W2 + (size_t)(k0 + wk) * ldw + n0 + wn);
        __syncthreads();
#pragma unroll
        for (int kk = 0; kk < 16; ++kk) {
            const float4 a = *(const float4*)&As[kk][ty * 4]; const float4 b = *(const float4*)&Ws[kk][tx * 4];
            const float aa[4] = {a.x, a.y, a.z, a.w}, bb[4] = {b.x, b.y, b.z, b.w};
#pragma unroll
            for (int i = 0; i < 4; ++i)
#pragma unroll
                for (int j = 0; j < 4; ++j) acc[i][j] += aa[i] * bb[j];
            if (DUAL) { const float4 b2 = *(const float4*)&Ws2[kk][tx * 4]; const float cc[4] = {b2.x, b2.y, b2.z, b2.w};
#pragma unroll
                for (int i = 0; i < 4; ++i)
#pragma unroll
                    for (int j = 0; j < 4; ++j) acc2[i][j] += aa[i] * cc[j]; }
        }
        __syncthreads();
    }
#pragma unroll
    for (int i = 0; i < 4; ++i) { const int r = r0 + ty * 4 + i; if (r < nrows) {
#pragma unroll
        for (int j = 0; j < 4; ++j) g.store(z, r, n0 + tx * 4 + j, acc[i][j], acc2[i][j]); } }
}

struct G_In {
    const bf16* A; const float* W; bf16 *Q, *Kb, *V, *U, *VG;
    __device__ bool setup(int, int& nrows, const float*& w, const float*& w2) const { nrows = NTOK; w = W; w2 = W; return true; }
    __device__ const bf16* arow(int, int r) const { return A + (size_t)r * D; }
    __device__ void store(int, int r, int n, float acc, float) const {
        if (n < 512) Q[(size_t)r * 512 + n] = f2bf(acc * QSCALE);
        else if (n < 1024) Kb[(size_t)r * 512 + n - 512] = f2bf(acc);
        else if (n < 1536) V[(size_t)r * 512 + n - 1024] = f2bf(acc);
        else if (n < 2048) U[(size_t)r * 512 + n - 1536] = f2bf(gelu_erf(acc));
        else VG[(size_t)r * 512 + n - 2048] = f2bf(gelu_erf(acc));
    }
};
struct G_Gate {
    const bf16* A; const float* W; const float* bias; bf16* GT;
    __device__ bool setup(int, int& nrows, const float*& w, const float*& w2) const { nrows = NTOK; w = W; w2 = W; return true; }
    __device__ const bf16* arow(int, int r) const { return A + (size_t)r * D; }
    __device__ void store(int, int r, int n, float acc, float) const { GT[(size_t)r * 2048 + n] = f2bf(sigmoidf_(acc + bias[n])); }
};
struct G_BrA {
    const bf16* YAB; const float* W; const bf16* GT; float* TMP;
    __device__ bool setup(int, int& nrows, const float*& w, const float*& w2) const { nrows = NTOK; w = W; w2 = W; return true; }
    __device__ const bf16* arow(int, int r) const { return YAB + (size_t)r * 1024; }
    __device__ void store(int, int r, int n, float acc, float) const { TMP[(size_t)r * 1024 + n] = bf2f(GT[(size_t)r * 2048 + n]) * acc; }
};
struct G_BrB {
    const bf16* YAB; const float* W; const bf16* GT; const float* TMP; bf16* MRG;
    __device__ bool setup(int, int& nrows, const float*& w, const float*& w2) const { nrows = NTOK; w = W; w2 = W; return true; }
    __device__ const bf16* arow(int, int r) const { return YAB + (size_t)r * 1024 + 512; }
    __device__ void store(int, int r, int n, float acc, float) const { MRG[(size_t)r * 1024 + n] = f2bf(TMP[(size_t)r * 1024 + n] + bf2f(GT[(size_t)r * 2048 + 1024 + n]) * acc); }
};
struct G_Out {
    const bf16* MRG; const float* W; bf16* Y1;
    __device__ bool setup(int, int& nrows, const float*& w, const float*& w2) const { nrows = NTOK; w = W; w2 = W; return true; }
    __device__ const bf16* arow(int, int r) const { return MRG + (size_t)r * 1024; }
    __device__ void store(int, int r, int n, float acc, float) const { Y1[(size_t)r * 1024 + n] = f2bf(acc); }
};
__device__ __forceinline__ int moe_rowbase(const unsigned* cnt, int e) { int s = 0; for (int i = 0; i < e; ++i) s += (int)((cnt[i] + 255u) / 256u) * 256; return s; }
struct G_MoeGU {
    const bf16* XN2; const float* Wgu; const float* bgu; const unsigned* cnt; const int* list; bf16* ACT;
    __device__ bool setup(int z, int& nrows, const float*& w, const float*& w2) const { nrows = (int)cnt[z]; w = Wgu + (size_t)z * D * 2048; w2 = w + 1024; return nrows > 0; }
    __device__ const bf16* arow(int z, int r) const { const int slot = list[(size_t)z * NTOK + r]; return XN2 + (size_t)(slot >> 2) * D; }
    __device__ void store(int z, int r, int n, float acc, float acc2) const {
        const float xg = fminf(acc + bgu[z * 2048 + n], SWL); const float xl = fminf(fmaxf(acc2 + bgu[z * 2048 + 1024 + n], -SWL), SWL);
        ACT[(size_t)(moe_rowbase(cnt, z) + r) * 1024 + n] = f2bf(xg * sigmoidf_(SWA * xg) * (xl + 1.0f));
    }
};
struct G_MoeDn {
    const bf16* ACT; const float* Wdn; const float* bdn; const unsigned* cnt; const int* list; const float* topg; bf16* Y2;
    __device__ bool setup(int z, int& nrows, const float*& w, const float*& w2) const { nrows = (int)cnt[z]; w = Wdn + (size_t)z * D * D; w2 = w; return nrows > 0; }
    __device__ const bf16* arow(int z, int r) const { return ACT + (size_t)(moe_rowbase(cnt, z) + r) * 1024; }
    __device__ void store(int z, int r, int n, float acc, float) const { const int slot = list[(size_t)z * NTOK + r]; Y2[(size_t)slot * 1024 + n] = f2bf((acc + bdn[z * 1024 + n]) * topg[slot]); }
};

__global__ __launch_bounds__(256) void nv_attn(const bf16* __restrict__ Q, const bf16* __restrict__ Kb, const bf16* __restrict__ V, const float* __restrict__ rel_bias, bf16* __restrict__ YAB) {
    const int gid = blockIdx.x * 256 + threadIdx.x, h = gid & 7, tok = gid >> 3, b = tok / SEQ, t = tok % SEQ, c = t / CHUNK, qi = t % CHUNK;
    float q[64], o[64];
    const uint4* qp = (const uint4*)(Q + (size_t)tok * 512 + h * 64);
#pragma unroll
    for (int i = 0; i < 8; ++i) { const uint4 w = qp[i]; const unsigned ww[4] = {w.x, w.y, w.z, w.w};
#pragma unroll
        for (int j = 0; j < 4; ++j) { q[i * 8 + 2 * j] = bf2f((bf16)(ww[j] & 0xffff)); q[i * 8 + 2 * j + 1] = bf2f((bf16)(ww[j] >> 16)); } }
#pragma unroll
    for (int d = 0; d < 64; ++d) o[d] = 0.f;
    float m = -1e30f, l = 0.f;
    for (int kj = 0; kj < BAND; ++kj) {
        const int kpos = (c - NLEFT) * CHUNK + kj; if (kpos < 0) continue;
        const size_t kr = ((size_t)(b * SEQ + kpos)) * 512 + h * 64;
        const uint4* kp = (const uint4*)(Kb + kr); float s = 0.f;
#pragma unroll
        for (int i = 0; i < 8; ++i) { const uint4 w = kp[i]; const unsigned ww[4] = {w.x, w.y, w.z, w.w};
#pragma unroll
            for (int j = 0; j < 4; ++j) { s += q[i * 8 + 2 * j] * bf2f((bf16)(ww[j] & 0xffff)); s += q[i * 8 + 2 * j + 1] * bf2f((bf16)(ww[j] >> 16)); } }
        int rel = NLEFT * CHUNK + qi - kj; rel = rel < -MAXREL ? -MAXREL : (rel > MAXREL ? MAXREL : rel);
        s += rel_bias[h * NREL + rel + MAXREL] * LOG2E;
        const float mn = fmaxf(m, s), alpha = exp2f(m - mn), p = exp2f(s - mn);
        l = l * alpha + p; m = mn;
        const uint4* vp = (const uint4*)(V + kr);
#pragma unroll
        for (int i = 0; i < 8; ++i) { const uint4 w = vp[i]; const unsigned ww[4] = {w.x, w.y, w.z, w.w};
#pragma unroll
            for (int j = 0; j < 4; ++j) { o[i * 8 + 2 * j] = o[i * 8 + 2 * j] * alpha + p * bf2f((bf16)(ww[j] & 0xffff)); o[i * 8 + 2 * j + 1] = o[i * 8 + 2 * j + 1] * alpha + p * bf2f((bf16)(ww[j] >> 16)); } }
    }
    const float inv = 1.0f / l;
    bf16* op = YAB + (size_t)tok * 1024 + h * 64;
#pragma unroll
    for (int d = 0; d < 64; d += 2) *(unsigned*)(op + d) = (unsigned)f2bf(o[d] * inv) | ((unsigned)f2bf(o[d + 1] * inv) << 16);
}

__global__ __launch_bounds__(256) void nv_sgu_ln(const bf16* __restrict__ VG, const float* __restrict__ ln_g, const float* __restrict__ ln_b, float* __restrict__ VN) {
    const int row = blockIdx.x * 4 + (threadIdx.x >> 6), lane = threadIdx.x & 63;
    const uint4 w = *(const uint4*)(VG + (size_t)row * 512 + lane * 8); const unsigned ww[4] = {w.x, w.y, w.z, w.w};
    float v[8]; float s = 0.f;
#pragma unroll
    for (int j = 0; j < 4; ++j) { v[2 * j] = bf2f((bf16)(ww[j] & 0xffff)); v[2 * j + 1] = bf2f((bf16)(ww[j] >> 16)); s += v[2 * j] + v[2 * j + 1]; }
    const float mu = wave_sum(s) * (1.0f / 512.0f); float q = 0.f;
#pragma unroll
    for (int j = 0; j < 8; ++j) { v[j] -= mu; q += v[j] * v[j]; }
    const float rstd = rsqrtf(wave_sum(q) * (1.0f / 512.0f) + EPS);
#pragma unroll
    for (int j = 0; j < 8; ++j) VN[(size_t)row * 512 + lane * 8 + j] = v[j] * rstd * ln_g[lane * 8 + j] + ln_b[lane * 8 + j];
}
__global__ __launch_bounds__(256) void nv_sgu(const float* __restrict__ VN, const bf16* __restrict__ U, const float* __restrict__ w_s, const float* __restrict__ b_s, bf16* __restrict__ YAB) {
    const int gid = blockIdx.x * 256 + threadIdx.x, c = gid & 511, tok = gid >> 9, tl = tok & 127, tb = tok - tl, g = c >> 6;
    float acc = b_s[g * 128 + tl];
    const float* wr = w_s + ((size_t)g * 128 + tl) * 128;
    for (int s = 0; s <= tl; ++s) acc += wr[s] * VN[(size_t)(tb + s) * 512 + c];
    YAB[(size_t)tok * 1024 + 512 + c] = f2bf(bf2f(U[(size_t)tok * 512 + c]) * acc);
}

__global__ __launch_bounds__(256) void nv_rowpass1(const float* __restrict__ x, const bf16* __restrict__ Y1, const float* __restrict__ mod, const float* __restrict__ g_post_mix,
                                                   const float* __restrict__ g_pre_ffn, const float* __restrict__ w_router, const float* __restrict__ b_router,
                                                   float* __restrict__ X1, bf16* __restrict__ XN2, int* __restrict__ tope, float* __restrict__ topg, unsigned* cnt, int* __restrict__ list) {
    const int row = blockIdx.x * 4 + (threadIdx.x >> 6), lane = threadIdx.x & 63, b = row / SEQ;
    const float* mb = mod + b * 6144;
    float xv[16], yv[16]; float ss = 0.f;
#pragma unroll
    for (int j = 0; j < 4; ++j) {
        const int c0 = (lane + 64 * j) * 4;
        const float4 xx = *(const float4*)(x + (size_t)row * D + c0); xv[4 * j] = xx.x; xv[4 * j + 1] = xx.y; xv[4 * j + 2] = xx.z; xv[4 * j + 3] = xx.w;
        const uint2 yy = *(const uint2*)(Y1 + (size_t)row * D + c0);
        yv[4 * j] = bf2f((bf16)(yy.x & 0xffff)); yv[4 * j + 1] = bf2f((bf16)(yy.x >> 16)); yv[4 * j + 2] = bf2f((bf16)(yy.y & 0xffff)); yv[4 * j + 3] = bf2f((bf16)(yy.y >> 16));
#pragma unroll
        for (int i = 0; i < 4; ++i) ss += yv[4 * j + i] * yv[4 * j + i];
    }
    const float rstd = rsqrtf(wave_sum(ss) * (1.0f / D) + EPS); float s2 = 0.f;
#pragma unroll
    for (int j = 0; j < 4; ++j) { const int c0 = (lane + 64 * j) * 4;
#pragma unroll
        for (int i = 0; i < 4; ++i) { const float x1 = xv[4 * j + i] + mb[GT1 + c0 + i] * (yv[4 * j + i] * rstd * g_post_mix[c0 + i]); xv[4 * j + i] = x1; s2 += x1 * x1; }
        *(float4*)(X1 + (size_t)row * D + c0) = make_float4(xv[4 * j], xv[4 * j + 1], xv[4 * j + 2], xv[4 * j + 3]); }
    const float rstd2 = rsqrtf(wave_sum(s2) * (1.0f / D) + EPS);
#pragma unroll
    for (int j = 0; j < 4; ++j) { const int c0 = (lane + 64 * j) * 4;
#pragma unroll
        for (int i = 0; i < 4; ++i) xv[4 * j + i] = xv[4 * j + i] * rstd2 * g_pre_ffn[c0 + i] * (1.0f + mb[SC2 + c0 + i]) + mb[SH2 + c0 + i];
        *(uint2*)(XN2 + (size_t)row * D + c0) = make_uint2((unsigned)f2bf(xv[4 * j]) | ((unsigned)f2bf(xv[4 * j + 1]) << 16), (unsigned)f2bf(xv[4 * j + 2]) | ((unsigned)f2bf(xv[4 * j + 3]) << 16)); }
    float mylogit = -1e30f;
    for (int e = 0; e < NEXP; ++e) {
        float p = 0.f;
#pragma unroll
        for (int j = 0; j < 4; ++j) { const int c0 = (lane + 64 * j) * 4;
#pragma unroll
            for (int i = 0; i < 4; ++i) p += xv[4 * j + i] * w_router[(size_t)(c0 + i) * NEXP + e]; }
        p = wave_sum(p) + b_router[e];
        if (lane == e) mylogit = p;
    }
    float tv[4]; int ti[4];
#pragma unroll
    for (int k = 0; k < 4; ++k) {
        float bv = mylogit; int bi = lane;
#pragma unroll
        for (int o = 1; o < 64; o <<= 1) { const float ov = __shfl_xor(bv, o); const int oi = __shfl_xor(bi, o); if (ov > bv || (ov == bv && oi < bi)) { bv = ov; bi = oi; } }
        tv[k] = bv; ti[k] = bi; if (lane == bi) mylogit = -3e38f;
    }
    if (lane == 0) {
        const float e0 = 1.0f, e1 = __expf(tv[1] - tv[0]), e2 = __expf(tv[2] - tv[0]), e3 = __expf(tv[3] - tv[0]); const float inv = 1.0f / (e0 + e1 + e2 + e3);
        const float gg[4] = {e0 * inv, e1 * inv, e2 * inv, e3 * inv};
#pragma unroll
        for (int k = 0; k < 4; ++k) { const int slot = row * 4 + k; tope[slot] = ti[k]; topg[slot] = gg[k]; const unsigned pos = atomicAdd(&cnt[ti[k]], 1u); list[(size_t)ti[k] * NTOK + pos] = slot; }
    }
}

__global__ __launch_bounds__(256) void nv_final(const bf16* __restrict__ Y2, const float* __restrict__ mod, const float* __restrict__ g_post_ffn, float* __restrict__ out) {
    const int row = blockIdx.x * 4 + (threadIdx.x >> 6), lane = threadIdx.x & 63, b = row / SEQ;
    const float* mb = mod + b * 6144;
    float yv[16]; float ss = 0.f;
#pragma unroll
    for (int j = 0; j < 4; ++j) { const int c0 = (lane + 64 * j) * 4; float a[4] = {0.f, 0.f, 0.f, 0.f};
#pragma unroll
        for (int k = 0; k < 4; ++k) { const uint2 yy = *(const uint2*)(Y2 + ((size_t)row * 4 + k) * D + c0);
            a[0] += bf2f((bf16)(yy.x & 0xffff)); a[1] += bf2f((bf16)(yy.x >> 16)); a[2] += bf2f((bf16)(yy.y & 0xffff)); a[3] += bf2f((bf16)(yy.y >> 16)); }
#pragma unroll
        for (int i = 0; i < 4; ++i) { yv[4 * j + i] = a[i]; ss += a[i] * a[i]; } }
    const float rstd = rsqrtf(wave_sum(ss) * (1.0f / D) + EPS);
#pragma unroll
    for (int j = 0; j < 4; ++j) { const int c0 = (lane + 64 * j) * 4; float4 xx = *(const float4*)(out + (size_t)row * D + c0);
        xx.x += mb[GT2 + c0] * (yv[4 * j] * rstd * g_post_ffn[c0]); xx.y += mb[GT2 + c0 + 1] * (yv[4 * j + 1] * rstd * g_post_ffn[c0 + 1]);
        xx.z += mb[GT2 + c0 + 2] * (yv[4 * j + 2] * rstd * g_post_ffn[c0 + 2]); xx.w += mb[GT2 + c0 + 3] * (yv[4 * j + 3] * rstd * g_post_ffn[c0 + 3]);
        *(float4*)(out + (size_t)row * D + c0) = xx; }
}

#define LAS __attribute__((address_space(3)))
#define GAS __attribute__((address_space(1)))
typedef short bf16x8 __attribute__((ext_vector_type(8)));
typedef short s16x4 __attribute__((ext_vector_type(4)));
typedef float f32x4 __attribute__((ext_vector_type(4)));
typedef float f32x2 __attribute__((ext_vector_type(2)));
typedef float f32x16 __attribute__((ext_vector_type(16)));
typedef unsigned u32x4 __attribute__((ext_vector_type(4)));
typedef unsigned u32x2 __attribute__((ext_vector_type(2)));
typedef __bf16 bf16x2_t __attribute__((ext_vector_type(2)));
constexpr int NWAVES = 8;
constexpr int TRASH_SLOT = NTOK * 4;

__device__ __forceinline__ unsigned cvtpk(float lo, float hi) { f32x2 v = {lo, hi}; bf16x2_t b = __builtin_convertvector(v, bf16x2_t); return __builtin_bit_cast(unsigned, b); }
__device__ __forceinline__ float wsum(float v) {
    v += __builtin_bit_cast(float, __builtin_amdgcn_update_dpp(0, __builtin_bit_cast(int, v), 0xB1, 0xF, 0xF, true));
    v += __builtin_bit_cast(float, __builtin_amdgcn_update_dpp(0, __builtin_bit_cast(int, v), 0x4E, 0xF, 0xF, true));
    v += __builtin_bit_cast(float, __builtin_amdgcn_update_dpp(0, __builtin_bit_cast(int, v), 0x124, 0xF, 0xF, true));
    v += __builtin_bit_cast(float, __builtin_amdgcn_update_dpp(0, __builtin_bit_cast(int, v), 0x128, 0xF, 0xF, true));
    const int iv = __builtin_bit_cast(int, v);
    const float s0 = __builtin_bit_cast(float, __builtin_amdgcn_readlane(iv, 0)), s1 = __builtin_bit_cast(float, __builtin_amdgcn_readlane(iv, 16));
    const float s2 = __builtin_bit_cast(float, __builtin_amdgcn_readlane(iv, 32)), s3 = __builtin_bit_cast(float, __builtin_amdgcn_readlane(iv, 48));
    return (s0 + s1) + (s2 + s3);
}
__device__ __forceinline__ float clamp8(float v) { return fminf(fmaxf(v, -448.0f), 448.0f); }
__device__ __forceinline__ unsigned pk_fp8x4(float a, float b, float c, float d) {
    int w = 0; w = __builtin_amdgcn_cvt_pk_fp8_f32(clamp8(a), clamp8(b), w, false); w = __builtin_amdgcn_cvt_pk_fp8_f32(clamp8(c), clamp8(d), w, true); return (unsigned)w; }
constexpr float F8_YSCALE = 16.0f;
constexpr size_t WS_X1B = 768 * MiB;
constexpr float F8_WSCALE = 64.0f, F8_ASCALE = 4.0f, F8_DESCALE = 1.0f / (64.0f * 4.0f);
__device__ __forceinline__ float bflo(unsigned w) { return __uint_as_float(w << 16); }
__device__ __forceinline__ float bfhi(unsigned w) { return __uint_as_float(w & 0xffff0000u); }
__device__ __forceinline__ float fast_sigmoid(float x) { return __builtin_amdgcn_rcpf(1.0f + __builtin_amdgcn_exp2f(-LOG2E * x)); }
__device__ __forceinline__ f32x2 sigmoid_pk(f32x2 v) { const f32x2 t = v * (-LOG2E); f32x2 e; e.x = __builtin_amdgcn_exp2f(t.x); e.y = __builtin_amdgcn_exp2f(t.y); const f32x2 d = e + 1.0f; f32x2 r; r.x = __builtin_amdgcn_rcpf(d.x); r.y = __builtin_amdgcn_rcpf(d.y); return r; }
__device__ __forceinline__ f32x2 gelu_pk(f32x2 v) {
    const f32x2 av = __builtin_elementwise_abs(v), d = av * 0.2316418882f + 1.0f;
    f32x2 t; t.x = __builtin_amdgcn_rcpf(d.x); t.y = __builtin_amdgcn_rcpf(d.y);
    f32x2 q = t * 0.5307027145f + (-0.7265760135f); q = q * t + 0.7107068705f; q = q * t + (-0.142248368f); q = q * t + 0.127414796f; q = q * t;
    const f32x2 s = (v * v) * (-0.72134752044f);
    f32x2 e; e.x = __builtin_amdgcn_exp2f(s.x); e.y = __builtin_amdgcn_exp2f(s.y);
    const f32x2 m = v * (q * e), r = v - m;
    f32x2 o; o.x = v.x < 0.f ? m.x : r.x; o.y = v.y < 0.f ? m.y : r.y; return o;
}

constexpr int RING_OFF = 0, RING_BYTES = 131072;
constexpr int GTAB_OFF = RING_BYTES, GTAB_UNITS = 20, GTAB_BYTES = GTAB_UNITS * 256 * 4;
constexpr int MISC_OFF = GTAB_OFF + GTAB_BYTES;
constexpr int LDS_BYTES = MISC_OFF + 512;
static_assert(LDS_BYTES <= 160 * 1024, "LDS map");

#define XB_TMO      128
#define XB_XCNT(j)  (256  + 64 * (j))
#define XB_XSUB(j)  (1280 + 64 * (j))
#define XB_XGEN(j)  (2304 + 64 * (j))
#define XB_TOP      3328
#define XB_TOPGEN   3392
#define XCD_BAR_WORDS 3456
#define XB_SPIN_CAP (1u << 18)
__device__ __forceinline__ unsigned xb_ld(unsigned* p)              { return __hip_atomic_load(p, __ATOMIC_RELAXED, __HIP_MEMORY_SCOPE_AGENT); }
__device__ __forceinline__ unsigned xb_add(unsigned* p, unsigned v) { return __hip_atomic_fetch_add(p, v, __ATOMIC_RELAXED, __HIP_MEMORY_SCOPE_AGENT); }
__device__ __forceinline__ unsigned xb_xcc_id() { return (unsigned)__builtin_amdgcn_s_getreg((3 << 11) | 20) & 0xFu; }
#define XB_SPIN(cond, bar) do { unsigned _sp = 0; while (cond) { __builtin_amdgcn_s_sleep(1); \
    if ((++_sp & 255u) == 0u) { if (xb_ld(&(bar)[XB_TMO])) break; if (_sp > XB_SPIN_CAP) { atomicAdd(&(bar)[XB_TMO], 1u); break; } } } } while (0)
struct XcdBarrier { unsigned* bar; unsigned x; volatile LAS unsigned* st; };
__device__ __forceinline__ XcdBarrier xcd_barrier_post(unsigned* bar, volatile LAS unsigned* st) {
    XcdBarrier b; b.bar = bar; b.x = xb_xcc_id(); b.st = st;
    if (threadIdx.x == 0) (void)xb_add(&bar[XB_XCNT(b.x)], 1u);
    return b;
}
__device__ __forceinline__ void xcd_barrier_complete(unsigned* bar, unsigned x, unsigned& nloc, unsigned& nx) {
    const unsigned G = gridDim.x * gridDim.y * gridDim.z;
    unsigned sum, cnt, mine, sp = 0u;
    for (;;) {
        sum = 0u; cnt = 0u; mine = 0u;
#pragma unroll
        for (unsigned j = 0; j < 16; ++j) { const unsigned c = xb_ld(&bar[XB_XCNT(j)]); sum += c; cnt += (c > 0u) ? 1u : 0u; mine = (j == x) ? c : mine; }
        if (sum == G) break;
        __builtin_amdgcn_s_sleep(1);
        if ((++sp & 255u) == 0u) { if (xb_ld(&bar[XB_TMO])) break; if (sp > XB_SPIN_CAP) { atomicAdd(&bar[XB_TMO], 1u); break; } }
    }
    nloc = mine > 0u ? mine : 1u; nx = cnt > 0u ? cnt : 1u;
}
__device__ __forceinline__ void xcd_barrier(const XcdBarrier& b) {
    asm volatile("s_waitcnt vmcnt(0)" ::: "memory");
    __syncthreads();
    if (threadIdx.x == 0) {
        unsigned* bar = b.bar;
        __builtin_amdgcn_s_waitcnt(0);
        unsigned nloc = b.st[0], nx = b.st[1];
        if (nloc == 0u) { xcd_barrier_complete(bar, b.x, nloc, nx); b.st[0] = nloc; b.st[1] = nx; }
        const unsigned old = xb_add(&bar[XB_XSUB(b.x)], 1u);
        const unsigned gen = old / nloc;
        if (old + 1u == (gen + 1u) * nloc) {
            __builtin_amdgcn_fence(__ATOMIC_RELEASE, "agent");
            asm volatile("s_waitcnt vmcnt(0)" ::: "memory");
            const unsigned og = xb_add(&bar[XB_TOP], 1u);
            const unsigned tg = og / nx;
            if (og + 1u == (tg + 1u) * nx) xb_add(&bar[XB_TOPGEN], 1u);
            else XB_SPIN(xb_ld(&bar[XB_TOPGEN]) == tg, bar);
            __builtin_amdgcn_fence(__ATOMIC_ACQUIRE, "agent");
            xb_add(&bar[XB_XGEN(b.x)], 1u);
            asm volatile("s_waitcnt vmcnt(0)" ::: "memory");
        } else {
            XB_SPIN(xb_ld(&bar[XB_XGEN(b.x)]) == gen, bar);
            __builtin_amdgcn_fence(__ATOMIC_ACQUIRE, "agent");
            asm volatile("s_waitcnt vmcnt(0)" ::: "memory");
        }
    }
    __syncthreads();
}
constexpr int CW_BAR = 4096;

namespace pg8 {
constexpr int BM = 256, BK = 64, HALF = 128, HTB = HALF * BK * 2, STAGE_BYTES = 8 * HTB, NXCD = 8, WGM = 8;
__host__ __device__ __forceinline__ int lds_byte(int r, int c) { return r * 128 + ((((c >> 3) ^ (r >> 1)) & 7) << 4); }
__host__ __device__ __forceinline__ void stage_rc(int b, int& R, int& C) { R = b >> 7; C = ((((b >> 4) ^ (R >> 1)) & 7) << 3); }
__host__ __device__ __forceinline__ int perm32(int rho) { const int n = rho >> 4, i = rho & 15; return 8 * (i >> 2) + 4 * n + (i & 3); }
struct Unit { int pm, pn, aux; };
typedef int v4i_t __attribute__((ext_vector_type(4)));
typedef int v8i_t __attribute__((ext_vector_type(8)));

__device__ __forceinline__ bool static_unit(int i, int G, int c, int nM, int nN, int& pm, int& pn) {
    const int nwg = nM * nN; const long L = (long)i * G + c; if (L >= nwg) return false;
    int wgid = (int)L; { const int q = nwg / NXCD, r = nwg % NXCD, xcd = wgid % NXCD, off = wgid / NXCD; wgid = (xcd < r ? xcd * (q + 1) : r * (q + 1) + (xcd - r) * q) + off; }
    const int nig = WGM * nN, gid = wgid / nig, fm = gid * WGM, gsz = (nM - fm) < WGM ? (nM - fm) : WGM;
    pm = fm + ((wgid % nig) % gsz); pn = (wgid % nig) / gsz; return true;
}

template <class Epi, class Sched, bool FP8>
__device__ __forceinline__ void gemm_phase(LAS unsigned char* lds, const Sched& S, const Epi& E, const int lda, const int ldb, const int nt, const int dbg_flags = 0) {
    const int tid = threadIdx.x, wid = __builtin_amdgcn_readfirstlane(tid >> 6), lane = tid & 63, wr = wid >> 2, wc = wid & 3, fr = lane & 15, fq = lane >> 4;
    int Rr[2], Cc[2]; unsigned voffB[2];
#pragma unroll
    for (int i = 0; i < 2; ++i) { stage_rc(tid * 16 + i * 8192, Rr[i], Cc[i]); const int Rb = (Rr[i] & ~31) + perm32(Rr[i] & 31); voffB[i] = (unsigned)(Rb * ldb + Cc[i] * 2); }
    const size_t kstep = (size_t)(BK * 2);
    const size_t hstepB = (size_t)HALF * ldb;
    const size_t hstepA = Sched::GATHER ? (size_t)0 : (size_t)HALF * lda;
    const unsigned ldsw = (unsigned)wid * 1024u;
    const int aoff = lds_byte(wr * 64 + fr, fq * 8), boff = lds_byte(wc * 32 + fr, fq * 8);
#define PG8_SA(b, h) (((b) * 2 + (h)) * HTB)
#define PG8_SB(b, h) ((4 + (b) * 2 + (h)) * HTB)
#define PG8_STAGE(bufoff, gbase, voff) do { _Pragma("unroll") for (int _i = 0; _i < 2; ++_i) \
        __builtin_amdgcn_global_load_lds((const unsigned*)((const char*)(gbase) + (voff)[_i]), (LAS unsigned*)(lds + (bufoff) + ldsw + _i * 8192), 16, 0, 0); } while (0)
#define PG8_LDA(dst, b, h) do { _Pragma("unroll") for (int m = 0; m < 4; ++m) _Pragma("unroll") for (int k = 0; k < 2; ++k) dst[m][k] = *(const LAS bf16x8*)(lds + PG8_SA(b, h) + (aoff ^ (k * 64)) + m * 2048); } while (0)
#define PG8_LDB(dst, b, h) do { _Pragma("unroll") for (int n = 0; n < 2; ++n) _Pragma("unroll") for (int k = 0; k < 2; ++k) dst[n][k] = *(const LAS bf16x8*)(lds + PG8_SB(b, h) + (boff ^ (k * 64)) + n * 2048); } while (0)
#define PG8_CAT(x) __builtin_shufflevector(__builtin_bit_cast(v4i_t, (x)[0]), __builtin_bit_cast(v4i_t, (x)[1]), 0, 1, 2, 3, 4, 5, 6, 7)
#define PG8_MMA(ai, bj, At, Bt) do { __builtin_amdgcn_s_setprio(1); if constexpr (FP8) { _Pragma("unroll") for (int m = 0; m < 4; ++m) _Pragma("unroll") for (int n = 0; n < 2; ++n) \
        acc[ai][bj][m][n] = __builtin_amdgcn_mfma_scale_f32_16x16x128_f8f6f4(PG8_CAT(Bt[n]), PG8_CAT(At[m]), acc[ai][bj][m][n], 0, 0, 0, 0x7F7F7F7F, 0, 0x7F7F7F7F); } \
    else { _Pragma("unroll") for (int m = 0; m < 4; ++m) _Pragma("unroll") for (int n = 0; n < 2; ++n) _Pragma("unroll") for (int k = 0; k < 2; ++k) \
        acc[ai][bj][m][n] = __builtin_amdgcn_mfma_f32_16x16x32_bf16(Bt[n][k], At[m][k], acc[ai][bj][m][n], 0, 0, 0); } __builtin_amdgcn_s_setprio(0); } while (0)
#define PG8_WAIT_V(n) asm volatile("s_waitcnt vmcnt(" #n ")" ::: "memory")
#define PG8_WAIT_L(n) asm volatile("s_waitcnt lgkmcnt(" #n ")" ::: "memory")
#define PG8_BAR __builtin_amdgcn_s_barrier()
#define PG8_SCHED __builtin_amdgcn_sched_barrier(0)
    Unit cur, nxt; int ui = 0;
    if (!S.next(0, cur)) return;
    f32x4 acc[2][2][4][2];
#pragma unroll
    for (int a = 0; a < 2; ++a)
#pragma unroll
        for (int b = 0; b < 2; ++b)
#pragma unroll
            for (int m = 0; m < 4; ++m)
#pragma unroll
                for (int n = 0; n < 2; ++n) acc[a][b][m][n] = (f32x4){0.f, 0.f, 0.f, 0.f};
    bf16x8 At[4][2], B0[2][2], B1[2][2];
    unsigned oA[2][2];
#pragma unroll
    for (int h = 0; h < 2; ++h)
#pragma unroll
        for (int i = 0; i < 2; ++i) oA[h][i] = Sched::GATHER ? (S.goff(0, h * HALF + Rr[i]) + (unsigned)Cc[i] * 2u) : (unsigned)(Rr[i] * lda + Cc[i] * 2);
    const char* cA = S.aptr(cur); const char* cB = S.bptr(cur);
    PG8_STAGE(PG8_SB(0, 0), cB, voffB); PG8_STAGE(PG8_SB(0, 1), cB + hstepB, voffB); PG8_STAGE(PG8_SA(0, 0), cA, oA[0]); PG8_STAGE(PG8_SA(0, 1), cA + hstepA, oA[1]);
    if (wr == 1) PG8_BAR;
    PG8_WAIT_V(2); PG8_BAR;
    PG8_STAGE(PG8_SB(1, 0), cB + kstep, voffB); PG8_STAGE(PG8_SA(1, 0), cA + kstep, oA[0]); PG8_STAGE(PG8_SB(1, 1), cB + hstepB + kstep, voffB);
    PG8_WAIT_V(6); PG8_BAR;
    for (;;) {
        const bool has_next = S.next(ui + 1, nxt);
        const char* nA = has_next ? S.aptr(nxt) : cA; const char* nB = has_next ? S.bptr(nxt) : cB;
#pragma clang loop unroll(disable)
        for (int t = 0; t < nt; t += 2) {
            const bool last = (t == nt - 2);
            const char* a1 = cA + (size_t)(t + 1) * kstep;
            const char* a2 = last ? nA : cA + (size_t)(t + 2) * kstep; const char* b2 = last ? nB : cB + (size_t)(t + 2) * kstep;
            const char* a3 = a2 + kstep; const char* b3 = b2 + kstep;
            PG8_LDB(B0, 0, 0); PG8_LDB(B1, 0, 1); PG8_SCHED; PG8_LDA(At, 0, 0); PG8_STAGE(PG8_SA(1, 1), a1 + hstepA, oA[1]);
            if constexpr (Sched::GATHER) { if (last && has_next) {
#pragma unroll
                for (int h = 0; h < 2; ++h)
#pragma unroll
                    for (int i = 0; i < 2; ++i) oA[h][i] = S.goff(ui + 1, h * HALF + Rr[i]) + (unsigned)Cc[i] * 2u; } }
            PG8_WAIT_V(8); PG8_WAIT_L(0); PG8_BAR; PG8_MMA(0, 0, At, B0); PG8_MMA(0, 1, At, B1); PG8_BAR; PG8_SCHED;
            PG8_LDA(At, 0, 1); PG8_STAGE(PG8_SB(0, 0), b2, voffB); PG8_STAGE(PG8_SB(0, 1), b2 + hstepB, voffB); PG8_STAGE(PG8_SA(0, 0), a2, oA[0]);
            PG8_WAIT_V(8); PG8_WAIT_L(0); PG8_BAR; PG8_MMA(1, 0, At, B0); PG8_MMA(1, 1, At, B1); PG8_BAR; PG8_SCHED;
            PG8_LDB(B0, 1, 0); PG8_LDB(B1, 1, 1); PG8_SCHED; PG8_LDA(At, 1, 0); PG8_STAGE(PG8_SA(0, 1), a2 + hstepA, oA[1]);
            PG8_WAIT_V(8); PG8_WAIT_L(0); PG8_BAR; PG8_MMA(0, 0, At, B0); PG8_MMA(0, 1, At, B1); PG8_BAR; PG8_SCHED;
            PG8_LDA(At, 1, 1); PG8_STAGE(PG8_SB(1, 0), b3, voffB); PG8_STAGE(PG8_SB(1, 1), b3 + hstepB, voffB); PG8_STAGE(PG8_SA(1, 0), a3, oA[0]);
            PG8_WAIT_V(8); PG8_WAIT_L(0); PG8_BAR; PG8_MMA(1, 0, At, B0); PG8_MMA(1, 1, At, B1); PG8_BAR; PG8_SCHED;
        }
        if (wr == 0) PG8_BAR;
        bool keep = false;
        {
            int tz = threadIdx.x; asm volatile("" : "+v"(tz)); const int ewid = tz >> 6, el = tz & 63, ewr = ewid >> 2, ewc = ewid & 3, efr = el & 15, efq = el >> 4;
            if constexpr (Sched::HAS_MID) { if (S.is_mid(cur)) { E.mid(acc, cur, ewr, ewc, efr, efq); keep = true; } }
            if (!keep && !(dbg_flags & 1)) E(acc, cur, ewr, ewc, efr, efq);
        }
        if (!has_next) break;
        if (!keep) {
#pragma unroll
            for (int a = 0; a < 2; ++a)
#pragma unroll
                for (int b = 0; b < 2; ++b)
#pragma unroll
                    for (int m = 0; m < 4; ++m)
#pragma unroll
                        for (int n = 0; n < 2; ++n) acc[a][b][m][n] = (f32x4){0.f, 0.f, 0.f, 0.f};
        }
        cur = nxt; cA = nA; cB = nB; ++ui;
        if (wr == 1) PG8_BAR;
    }
    PG8_WAIT_V(0);
    PG8_BAR;
#undef PG8_SA
#undef PG8_SB
#undef PG8_STAGE
#undef PG8_LDA
#undef PG8_LDB
#undef PG8_MMA
#undef PG8_CAT
#undef PG8_WAIT_V
#undef PG8_WAIT_L
#undef PG8_BAR
#undef PG8_SCHED
}
}
using pg8::Unit;

struct Args { const float* in[25]; float* out; unsigned char* ws; int ph_lo, ph_hi, rep_mask, pad; };
static_assert(sizeof(Args) == 27 * 8 + 16, "Args has no padding");
struct Frame {
    LAS unsigned char* lds; volatile LAS unsigned* MISC; unsigned* ctl;
    int tid, lane, wave, vcu, G;
};
#define LDS_WAIT() asm volatile("s_waitcnt lgkmcnt(0)" ::: "memory")
#define VM_WAIT() asm volatile("s_waitcnt vmcnt(0)" ::: "memory")

struct SchedStatic {
    static constexpr bool GATHER = false, HAS_MID = false;
    const char* A; const char* B; int nM, nN, G, c; size_t astep, bstep;
    __device__ __forceinline__ bool next(int i, Unit& u) const { u.aux = 0; return pg8::static_unit(i, G, c, nM, nN, u.pm, u.pn); }
    __device__ __forceinline__ const char* aptr(const Unit& u) const { return A + (size_t)u.pm * astep; }
    __device__ __forceinline__ const char* bptr(const Unit& u) const { return B + (size_t)u.pn * bstep; }
    __device__ __forceinline__ bool is_mid(const Unit&) const { return false; }
    __device__ __forceinline__ unsigned goff(int, int) const { return 0u; }
};
struct SchedSplit2 {
    static constexpr bool GATHER = false, HAS_MID = true;
    const char* A; const char* B; int nM, nN, G, c; size_t astep, bstep, khalf;
    __device__ __forceinline__ bool next(int i, Unit& u) const { u.aux = i & 1; return pg8::static_unit(i >> 1, G, c, nM, nN, u.pm, u.pn); }
    __device__ __forceinline__ const char* aptr(const Unit& u) const { return A + (size_t)u.pm * astep + (size_t)u.aux * khalf; }
    __device__ __forceinline__ const char* bptr(const Unit& u) const { return B + (size_t)u.pn * bstep + (size_t)u.aux * khalf; }
    __device__ __forceinline__ bool is_mid(const Unit& u) const { return u.aux == 0; }
    __device__ __forceinline__ unsigned goff(int, int) const { return 0u; }
};
__device__ __forceinline__ int moe_find_e(volatile LAS unsigned* MISC, int rb) { int e = 0;
#pragma unroll 1
    for (int i = 1; i < NEXP; ++i) e += ((int)MISC[i] <= rb) ? 1 : 0;
    return e; }
template <int NPN, bool GATH>
struct SchedMoe {
    static constexpr bool GATHER = GATH, HAS_MID = false;
    static constexpr int RPX = 32 / NPN;
    static constexpr int UT0 = 96, UTN = 24;
    const char* A; const char* B; volatile LAS unsigned* MISC; const LAS unsigned* gtab; int c, G, nrb; size_t bstep_e, bstep_n;
    __device__ __forceinline__ bool slow_next(int i, Unit& u) const {
        int rb, pn;
        if (G == 256) { const int x = c & 7, j = c >> 3; rb = (8 * i + x) * RPX + j / NPN; pn = j % NPN; }
        else { const long L = (long)i * G + c; rb = (int)(L / NPN); pn = (int)(L % NPN); }
        if (rb >= nrb) return false;
        u.pm = rb; u.pn = pn; u.aux = moe_find_e(MISC, rb); return true;
    }
    __device__ __forceinline__ void build(int tid) const {
        if (tid < UTN) { Unit u; const bool ok = slow_next(tid, u); MISC[UT0 + tid] = ok ? (0x80000000u | ((unsigned)u.aux << 16) | ((unsigned)u.pn << 12) | (unsigned)u.pm) : 0u; }
        __syncthreads();
    }
    __device__ __forceinline__ bool next(int i, Unit& u) const {
        if (i >= UTN) return false;
        const unsigned w = MISC[UT0 + i]; if (!(w >> 31)) return false;
        u.pm = (int)(w & 0xfffu); u.pn = (int)((w >> 12) & 0xfu); u.aux = (int)((w >> 16) & 0xffu); return true;
    }
    __device__ __forceinline__ const char* aptr(const Unit& u) const { return GATH ? A : A + (size_t)u.pm * (256 * 1024); }
    __device__ __forceinline__ const char* bptr(const Unit& u) const { return B + (size_t)u.aux * bstep_e + (size_t)u.pn * bstep_n; }
    __device__ __forceinline__ bool is_mid(const Unit&) const { return false; }
    __device__ __forceinline__ unsigned goff(int ui, int row) const { return gtab[ui * 256 + row]; }
};

#define EPI_ARGS f32x4 (&acc)[2][2][4][2], const Unit& u, int wr, int wc, int fr, int fq
struct EpiG1 {
    bf16 *Q, *K, *V, *U, *VG, *GT; const float* bgate;
    __device__ __forceinline__ void mid(EPI_ARGS) const {}
    __device__ __forceinline__ void operator()(EPI_ARGS) const {
        const int pn = u.pn; const int row0 = u.pm * 256 + wr * 64 + fr;
        if (pn < 6) {
            const int t = pn >> 1; bf16* base = Q + (size_t)t * ((WS_K - WS_Q) / 2); const float sc = (t == 0) ? QSCALE : 1.0f;    const int col0 = (pn & 1) * 256 + wc * 32 + 8 * fq;
#pragma unroll
            for (int ai = 0; ai < 2; ++ai)
#pragma unroll
                for (int m = 0; m < 4; ++m) { bf16* rowp = base + (size_t)(row0 + ai * 128 + m * 16) * 512 + col0;
#pragma unroll
                    for (int bj = 0; bj < 2; ++bj) { const f32x4 v0 = acc[ai][bj][m][0] * sc, v1 = acc[ai][bj][m][1] * sc;
                        u32x4 w; w.x = cvtpk(v0[0], v0[1]); w.y = cvtpk(v0[2], v0[3]); w.z = cvtpk(v1[0], v1[1]); w.w = cvtpk(v1[2], v1[3]); *(u32x4*)(rowp + bj * 128) = w; } }
        } else if (pn < 10) {
            bf16* base = Q + (size_t)(pn >> 1) * ((WS_K - WS_Q) / 2); const int col0 = (pn & 1) * 256 + wc * 32 + 8 * fq;
#pragma unroll
            for (int ai = 0; ai < 2; ++ai)
#pragma unroll
                for (int m = 0; m < 4; ++m) { bf16* rowp = base + (size_t)(row0 + ai * 128 + m * 16) * 512 + col0;
#pragma unroll
                    for (int bj = 0; bj < 2; ++bj) { const f32x4 v0 = acc[ai][bj][m][0], v1 = acc[ai][bj][m][1];
                        const f32x2 a = gelu_pk((f32x2){v0[0], v0[1]}), b = gelu_pk((f32x2){v0[2], v0[3]}), c = gelu_pk((f32x2){v1[0], v1[1]}), d = gelu_pk((f32x2){v1[2], v1[3]});
                        u32x4 w; w.x = cvtpk(a.x, a.y); w.y = cvtpk(b.x, b.y); w.z = cvtpk(c.x, c.y); w.w = cvtpk(d.x, d.y); *(u32x4*)(rowp + bj * 128) = w; } }
        } else {
            const int col0 = (pn - 10) * 256 + wc * 32 + 8 * fq;
            f32x4 bv[2][2];
#pragma unroll
            for (int bj = 0; bj < 2; ++bj)
#pragma unroll
                for (int n = 0; n < 2; ++n) bv[bj][n] = *(const f32x4*)(bgate + col0 + bj * 128 + 4 * n);
#pragma unroll
            for (int ai = 0; ai < 2; ++ai)
#pragma unroll
                for (int m = 0; m < 4; ++m) { bf16* rowp = GT + (size_t)(row0 + ai * 128 + m * 16) * 2048 + col0;
#pragma unroll
                    for (int bj = 0; bj < 2; ++bj) { const f32x4 v0 = acc[ai][bj][m][0] + bv[bj][0], v1 = acc[ai][bj][m][1] + bv[bj][1];
                        const f32x2 a = sigmoid_pk((f32x2){v0[0], v0[1]}), b = sigmoid_pk((f32x2){v0[2], v0[3]}), c = sigmoid_pk((f32x2){v1[0], v1[1]}), d = sigmoid_pk((f32x2){v1[2], v1[3]});
                        u32x4 w; w.x = cvtpk(a.x, a.y); w.y = cvtpk(b.x, b.y); w.z = cvtpk(c.x, c.y); w.w = cvtpk(d.x, d.y); *(u32x4*)(rowp + bj * 128) = w; } }
        }
    }
};
struct EpiG2 {
    const bf16* GT; bf16* MRG;
    __device__ __forceinline__ void mid(EPI_ARGS) const {
        const int row0 = u.pm * 256 + wr * 64 + fr, col0 = u.pn * 256 + wc * 32 + 8 * fq;
#pragma unroll
        for (int ai = 0; ai < 2; ++ai)
#pragma unroll
            for (int m = 0; m < 4; ++m) { const bf16* gp = GT + (size_t)(row0 + ai * 128 + m * 16) * 2048 + col0;
#pragma unroll
                for (int bj = 0; bj < 2; ++bj) { const u32x4 ga = *(const u32x4*)(gp + bj * 128), gb = *(const u32x4*)(gp + 1024 + bj * 128);
                    f32x4 r0, r1;
                    r0[0] = bflo(ga.x) * __builtin_amdgcn_rcpf(fmaxf(bflo(gb.x), 1e-30f)); r0[1] = bfhi(ga.x) * __builtin_amdgcn_rcpf(fmaxf(bfhi(gb.x), 1e-30f));
                    r0[2] = bflo(ga.y) * __builtin_amdgcn_rcpf(fmaxf(bflo(gb.y), 1e-30f)); r0[3] = bfhi(ga.y) * __builtin_amdgcn_rcpf(fmaxf(bfhi(gb.y), 1e-30f));
                    r1[0] = bflo(ga.z) * __builtin_amdgcn_rcpf(fmaxf(bflo(gb.z), 1e-30f)); r1[1] = bfhi(ga.z) * __builtin_amdgcn_rcpf(fmaxf(bfhi(gb.z), 1e-30f));
                    r1[2] = bflo(ga.w) * __builtin_amdgcn_rcpf(fmaxf(bflo(gb.w), 1e-30f)); r1[3] = bfhi(ga.w) * __builtin_amdgcn_rcpf(fmaxf(bfhi(gb.w), 1e-30f));
                    acc[ai][bj][m][0] *= r0; acc[ai][bj][m][1] *= r1; } }
    }
    __device__ __forceinline__ void operator()(EPI_ARGS) const {
        const int row0 = u.pm * 256 + wr * 64 + fr, col0 = u.pn * 256 + wc * 32 + 8 * fq;
#pragma unroll
        for (int ai = 0; ai < 2; ++ai)
#pragma unroll
            for (int m = 0; m < 4; ++m) { const size_t r = (size_t)(row0 + ai * 128 + m * 16); const bf16* gp = GT + r * 2048 + 1024 + col0; bf16* op = MRG + r * 1024 + col0;
#pragma unroll
                for (int bj = 0; bj < 2; ++bj) { const u32x4 gb = *(const u32x4*)(gp + bj * 128); const f32x4 v0 = acc[ai][bj][m][0], v1 = acc[ai][bj][m][1];
                    u32x4 w; w.x = cvtpk(v0[0] * bflo(gb.x), v0[1] * bfhi(gb.x)); w.y = cvtpk(v0[2] * bflo(gb.y), v0[3] * bfhi(gb.y));
                    w.z = cvtpk(v1[0] * bflo(gb.z), v1[1] * bfhi(gb.z)); w.w = cvtpk(v1[2] * bflo(gb.w), v1[3] * bfhi(gb.w)); *(u32x4*)(op + bj * 128) = w; } }
    }
};
struct EpiPlain {
    bf16* O;
    __device__ __forceinline__ void mid(EPI_ARGS) const {}
    __device__ __forceinline__ void operator()(EPI_ARGS) const {
        const int row0 = u.pm * 256 + wr * 64 + fr, col0 = u.pn * 256 + wc * 32 + 8 * fq;
#pragma unroll
        for (int ai = 0; ai < 2; ++ai)
#pragma unroll
            for (int m = 0; m < 4; ++m) { bf16* op = O + (size_t)(row0 + ai * 128 + m * 16) * 1024 + col0;
#pragma unroll
                for (int bj = 0; bj < 2; ++bj) { const f32x4 v0 = acc[ai][bj][m][0], v1 = acc[ai][bj][m][1];
                    u32x4 w; w.x = cvtpk(v0[0], v0[1]); w.y = cvtpk(v0[2], v0[3]); w.z = cvtpk(v1[0], v1[1]); w.w = cvtpk(v1[2], v1[3]); *(u32x4*)(op + bj * 128) = w; } }
    }
};
struct EpiAct {
    const float* bgu; unsigned char* ACT8;
    __device__ __forceinline__ void mid(EPI_ARGS) const {}
    __device__ __forceinline__ f32x2 act2(f32x2 g, f32x2 l) const {
        f32x2 xg, xl; xg.x = fminf(g.x, SWL); xg.y = fminf(g.y, SWL); xl.x = fminf(fmaxf(l.x, -SWL), SWL); xl.y = fminf(fmaxf(l.y, -SWL), SWL);
        const f32x2 t = xg * (-SWA * LOG2E); f32x2 e; e.x = __builtin_amdgcn_exp2f(t.x); e.y = __builtin_amdgcn_exp2f(t.y);
        const f32x2 d = e + 1.0f; f32x2 r; r.x = __builtin_amdgcn_rcpf(d.x); r.y = __builtin_amdgcn_rcpf(d.y);
        return (xg * r) * (xl * F8_ASCALE + F8_ASCALE);
    }
    __device__ __forceinline__ void operator()(EPI_ARGS) const {
        const int e = u.aux; const int row0 = u.pm * 256 + wr * 64 + fr, col0 = u.pn * 128 + wc * 32 + 8 * fq;
        const float* bp = bgu + (size_t)e * 2048 + col0;
        const f32x4 bg0 = *(const f32x4*)(bp), bg1 = *(const f32x4*)(bp + 4), bl0 = *(const f32x4*)(bp + 1024), bl1 = *(const f32x4*)(bp + 1028);
#pragma unroll
        for (int ai = 0; ai < 2; ++ai)
#pragma unroll
            for (int m = 0; m < 4; ++m) {
                const f32x4 g0 = acc[ai][0][m][0] * F8_DESCALE + bg0, g1 = acc[ai][0][m][1] * F8_DESCALE + bg1, l0 = acc[ai][1][m][0] * F8_DESCALE + bl0, l1 = acc[ai][1][m][1] * F8_DESCALE + bl1;
                const f32x2 o0 = act2((f32x2){g0[0], g0[1]}, (f32x2){l0[0], l0[1]}), o1 = act2((f32x2){g0[2], g0[3]}, (f32x2){l0[2], l0[3]});
                const f32x2 o2 = act2((f32x2){g1[0], g1[1]}, (f32x2){l1[0], l1[1]}), o3 = act2((f32x2){g1[2], g1[3]}, (f32x2){l1[2], l1[3]});
                u32x2 w; w.x = pk_fp8x4(o0.x, o0.y, o1.x, o1.y); w.y = pk_fp8x4(o2.x, o2.y, o3.x, o3.y);
                *(u32x2*)(ACT8 + (size_t)(row0 + ai * 128 + m * 16) * 1024 + col0) = w; }
    }
};
struct EpiDown {
    const float* bdn; unsigned char* Y2s;
    __device__ __forceinline__ void mid(EPI_ARGS) const {}
    __device__ __forceinline__ void operator()(EPI_ARGS) const {
        const int e = u.aux; const int row0 = u.pm * 256 + wr * 64 + fr, col0 = u.pn * 256 + wc * 32 + 8 * fq;
        f32x4 bv[2][2];
#pragma unroll
        for (int bj = 0; bj < 2; ++bj)
#pragma unroll
            for (int n = 0; n < 2; ++n) bv[bj][n] = *(const f32x4*)(bdn + (size_t)e * 1024 + col0 + bj * 128 + 4 * n) * F8_YSCALE;
#pragma unroll
        for (int ai = 0; ai < 2; ++ai)
#pragma unroll
            for (int m = 0; m < 4; ++m) { unsigned char* op = Y2s + (size_t)(row0 + ai * 128 + m * 16) * 1024 + col0;
#pragma unroll
                for (int bj = 0; bj < 2; ++bj) { const f32x4 v0 = acc[ai][bj][m][0] * (F8_DESCALE * F8_YSCALE) + bv[bj][0], v1 = acc[ai][bj][m][1] * (F8_DESCALE * F8_YSCALE) + bv[bj][1];
                    u32x2 w; w.x = pk_fp8x4(v0[0], v0[1], v0[2], v0[3]); w.y = pk_fp8x4(v1[0], v1[1], v1[2], v1[3]); *(u32x2*)(op + bj * 128) = w; } }
    }
};

struct WItem { const float* W; unsigned char* dst; int N, k0, n0, ldt, drow, dk0, fp8; };
__device__ __forceinline__ WItem witem_decode(const Args& a, int r) {
    unsigned char* ws = a.ws; WItem it;
    constexpr int I_IN = 8 * 80, I_GATE = 8 * 64, I_BR = 4 * 32, I_OUT = 8 * 32, I_GU = 8 * 64, I_DN = 8 * 32;
    it.fp8 = 0; it.dk0 = 0; it.ldt = 2048;
    if (r < I_IN) { it.W = a.in[6]; it.N = INW; it.k0 = 128 * (r / 80); it.n0 = 32 * (r % 80); it.dst = ws + WS_W1T; it.drow = it.n0; return it; } r -= I_IN;
    if (r < I_GATE) { it.W = a.in[14]; it.N = 2048; it.k0 = 128 * (r / 64); it.n0 = 32 * (r % 64); it.dst = ws + WS_W1T; it.drow = INW + it.n0; return it; } r -= I_GATE;
    if (r < I_BR) { it.W = a.in[12]; it.N = 1024; it.k0 = 128 * (r / 32); it.n0 = 32 * (r % 32); it.dst = ws + WS_WBRT; it.drow = it.n0; return it; } r -= I_BR;
    if (r < I_BR) { it.W = a.in[13]; it.N = 1024; it.k0 = 128 * (r / 32); it.n0 = 32 * (r % 32); it.dst = ws + WS_WBRT; it.drow = it.n0; it.dk0 = 512; return it; } r -= I_BR;
    if (r < I_OUT) { it.W = a.in[16]; it.N = 1024; it.k0 = 128 * (r / 32); it.n0 = 32 * (r % 32); it.dst = ws + WS_WOUTT; it.drow = it.n0; return it; } r -= I_OUT;
    it.fp8 = 1; it.ldt = 1024;
    if (r < NEXP * I_GU) { const int e = r / I_GU, q = r % I_GU; it.W = a.in[21] + (size_t)e * D * 2048; it.N = 2048; it.k0 = 128 * (q / 64); it.n0 = 32 * (q % 64); it.dst = ws + WS_WGUT + (size_t)e * 2048 * 1024;
        const int m0 = it.n0 & 1023; it.drow = 256 * (m0 >> 7) + (m0 & 127) + (it.n0 >= 1024 ? 128 : 0); return it; }
    r -= NEXP * I_GU;
    { const int e = r / I_DN, q = r % I_DN; it.W = a.in[23] + (size_t)e * D * D; it.N = 1024; it.k0 = 128 * (q / 32); it.n0 = 32 * (q % 32); it.dst = ws + WS_WDNT + (size_t)e * 1024 * 1024; it.drow = it.n0; }
    return it;
}
constexpr int W_NITEMS = 8 * 80 + 8 * 64 + 2 * 4 * 32 + 8 * 32 + NEXP * (8 * 64 + 8 * 32);
__device__ __forceinline__ void witem_load(const WItem& it, float (&v)[64], int lane) {
    const float* p = it.W + (size_t)(it.k0 + (lane >> 5)) * it.N + it.n0 + (lane & 31);
#pragma unroll
    for (int i = 0; i < 64; ++i) v[i] = p[(size_t)(2 * i) * it.N];
}
__device__ __forceinline__ void witem_store(const WItem& it, const float (&v)[64], LAS float* scr, int lane) {
#pragma unroll
    for (int i = 0; i < 64; ++i) scr[(2 * i + (lane >> 5)) * 33 + (lane & 31)] = v[i];
    LDS_WAIT(); asm volatile("" ::: "memory");
    const int c = lane & 7;
#pragma unroll
    for (int j = 0; j < 4; ++j) { const int n = (lane >> 3) + 8 * j; const LAS float* s = scr + (16 * c) * 33 + n;
        float x[16];
#pragma unroll
        for (int q = 0; q < 16; ++q) x[q] = s[q * 33];
        unsigned char* d = it.dst + (size_t)(it.drow + n) * it.ldt;
        if (it.fp8) { u32x4 o;
            o.x = pk_fp8x4(x[0] * F8_WSCALE, x[1] * F8_WSCALE, x[2] * F8_WSCALE, x[3] * F8_WSCALE); o.y = pk_fp8x4(x[4] * F8_WSCALE, x[5] * F8_WSCALE, x[6] * F8_WSCALE, x[7] * F8_WSCALE);
            o.z = pk_fp8x4(x[8] * F8_WSCALE, x[9] * F8_WSCALE, x[10] * F8_WSCALE, x[11] * F8_WSCALE); o.w = pk_fp8x4(x[12] * F8_WSCALE, x[13] * F8_WSCALE, x[14] * F8_WSCALE, x[15] * F8_WSCALE);
            *(u32x4*)(d + it.dk0 + it.k0 + 16 * c) = o; }
        else { u32x4 o0, o1;
            o0.x = cvtpk(x[0], x[1]); o0.y = cvtpk(x[2], x[3]); o0.z = cvtpk(x[4], x[5]); o0.w = cvtpk(x[6], x[7]); o1.x = cvtpk(x[8], x[9]); o1.y = cvtpk(x[10], x[11]); o1.z = cvtpk(x[12], x[13]); o1.w = cvtpk(x[14], x[15]);
            *(u32x4*)(d + (size_t)(it.dk0 + it.k0 + 16 * c) * 2) = o0; *(u32x4*)(d + (size_t)(it.dk0 + it.k0 + 16 * c) * 2 + 16) = o1; } }
    LDS_WAIT(); asm volatile("" ::: "memory");
}
__device__ __forceinline__ void phaseA(const Frame& F, const Args& a) {
    unsigned char* ws = a.ws;
    if (F.vcu < 192) {
        const float* c = a.in[1]; const float* w_ada = a.in[2]; const float* b_ada = a.in[3]; float* mod = (float*)(ws + WS_MOD);
        LAS float* red = (LAS float*)(F.lds);
        const int col = F.vcu * 32 + (F.tid & 31), ks = F.tid >> 5;
        float a0 = 0.f, a1 = 0.f, a2 = 0.f, a3 = 0.f;
        for (int k = ks * 64; k < ks * 64 + 64; ++k) { const float w = w_ada[(size_t)k * 6144 + col];
            const float c0 = c[k], c1 = c[D + k], c2 = c[2 * D + k], c3 = c[3 * D + k];
            a0 += c0 * __builtin_amdgcn_rcpf(1.0f + __expf(-c0)) * w; a1 += c1 * __builtin_amdgcn_rcpf(1.0f + __expf(-c1)) * w;
            a2 += c2 * __builtin_amdgcn_rcpf(1.0f + __expf(-c2)) * w; a3 += c3 * __builtin_amdgcn_rcpf(1.0f + __expf(-c3)) * w; }
        red[(ks * 4 + 0) * 32 + (F.tid & 31)] = a0; red[(ks * 4 + 1) * 32 + (F.tid & 31)] = a1; red[(ks * 4 + 2) * 32 + (F.tid & 31)] = a2; red[(ks * 4 + 3) * 32 + (F.tid & 31)] = a3;
        __syncthreads();
        if (F.tid < 128) { const int b = F.tid >> 5, cc = F.tid & 31; float s = 0.f;
#pragma unroll
            for (int k = 0; k < 16; ++k) s += red[(k * 4 + b) * 32 + cc];
            mod[b * 6144 + F.vcu * 32 + cc] = s + b_ada[F.vcu * 32 + cc]; }
        __syncthreads();
    }
    if (F.vcu == 192 % F.G) {
        const float* w_router = a.in[19]; bf16* wrt = (bf16*)(ws + WS_WRT);
        for (int i = F.tid; i < D * NEXP; i += NWAVES * 64) { const int k = i >> 5, e = i & 31; const float w = w_router[i]; const unsigned hh = cvtpk(w, 0.f) & 0xffffu;
            wrt[(size_t)e * D + k] = (bf16)hh; wrt[(size_t)(NEXP + e) * D + k] = (bf16)(cvtpk(w - bflo(hh), 0.f) & 0xffffu); }
    }
    LAS float* scr = (LAS float*)(F.lds + F.wave * 17408);
    const int gw = F.vcu * NWAVES + F.wave, NGW = F.G * NWAVES;
    if (gw < W_NITEMS) {
        float va[64], vb[64];
        WItem ia = witem_decode(a, gw), ib = ia;
        witem_load(ia, va, F.lane);
        for (int it = gw; it < W_NITEMS; it += 2 * NGW) {
            const bool hb = (it + NGW < W_NITEMS);
            ib = witem_decode(a, hb ? it + NGW : it); witem_load(ib, vb, F.lane);
            witem_store(ia, va, scr, F.lane);
            if (!hb) break;
            const bool ha = (it + 2 * NGW < W_NITEMS);
            ia = witem_decode(a, ha ? it + 2 * NGW : it); witem_load(ia, va, F.lane);
            witem_store(ib, vb, scr, F.lane);
            if (!ha) break;
        }
    }
}
__device__ __forceinline__ void phaseB(const Frame& F, const Args& a) {
    const float* x = a.in[0]; const float* g = a.in[4]; const float* mod = (const float*)(a.ws + WS_MOD); bf16* xn = (bf16*)(a.ws + WS_XN);
    const int gw = F.vcu * NWAVES + F.wave, NGW = F.G * NWAVES;
    f32x4 cg[4], csh[4]; int cb = -1;
    for (int row0 = gw * 4; row0 < NTOK; row0 += NGW * 4) {
        f32x4 v[4][4];
#pragma unroll
        for (int rr = 0; rr < 4; ++rr)
#pragma unroll
            for (int j = 0; j < 4; ++j) v[rr][j] = *((const f32x4*)(x + (size_t)(row0 + rr) * D) + F.lane + 64 * j);
        const int b = row0 / SEQ; const float* mb = mod + b * 6144;
        if (b != cb) { cb = b;
#pragma unroll
            for (int j = 0; j < 4; ++j) { const int c0 = (F.lane + 64 * j) * 4; cg[j] = *(const f32x4*)(g + c0) * (*(const f32x4*)(mb + SC1 + c0) + 1.0f); csh[j] = *(const f32x4*)(mb + SH1 + c0); } }
#pragma unroll
        for (int rr = 0; rr < 4; ++rr) {
            float ss = 0.f;
#pragma unroll
            for (int j = 0; j < 4; ++j) ss += (v[rr][j].x * v[rr][j].x + v[rr][j].y * v[rr][j].y) + (v[rr][j].z * v[rr][j].z + v[rr][j].w * v[rr][j].w);
            const float rstd = rsqrtf(wsum(ss) * (1.0f / D) + EPS);
            u32x2* o8 = (u32x2*)(xn + (size_t)(row0 + rr) * D) + F.lane;
#pragma unroll
            for (int j = 0; j < 4; ++j) {
                const f32x4 h = v[rr][j] * rstd * cg[j] + csh[j];
                u32x2 w; w.x = cvtpk(h[0], h[1]); w.y = cvtpk(h[2], h[3]); o8[64 * j] = w; }
        }
    }
}

constexpr int SGU_STRIDE = 1088;
__device__ __forceinline__ s16x4 vtr(const LAS unsigned char* p) { typedef short v4i16_t __attribute__((ext_vector_type(4))); return __builtin_bit_cast(s16x4, __builtin_amdgcn_ds_read_tr16_b64_v4i16((LAS v4i16_t*)p)); }
__device__ __forceinline__ void sgu_unit(const Frame& F, const Args& a, int b, int blk) {
    const bf16* VG = (const bf16*)(a.ws + WS_VG); const bf16* U = (const bf16*)(a.ws + WS_U); bf16* YAB = (bf16*)(a.ws + WS_YAB);
    const float* ln_g = a.in[8]; const float* ln_b = a.in[9]; const float* w_s = a.in[10]; const float* b_s = a.in[11];
    const int tok0 = b * SEQ + blk * SGB, lane = F.lane;
    {
        const f32x4 g0 = *(const f32x4*)(ln_g + lane * 8), g1 = *(const f32x4*)(ln_g + lane * 8 + 4), b0 = *(const f32x4*)(ln_b + lane * 8), b1 = *(const f32x4*)(ln_b + lane * 8 + 4);
#pragma unroll 1
        for (int r4 = 0; r4 < 16; r4 += 4) {
            u32x4 w[4];
#pragma unroll
            for (int rr = 0; rr < 4; ++rr) w[rr] = *(const u32x4*)(VG + (size_t)(tok0 + F.wave * 16 + r4 + rr) * 512 + lane * 8);
#pragma unroll
            for (int rr = 0; rr < 4; ++rr) { const int row = F.wave * 16 + r4 + rr;
                f32x4 v0 = {bflo(w[rr].x), bfhi(w[rr].x), bflo(w[rr].y), bfhi(w[rr].y)}, v1 = {bflo(w[rr].z), bfhi(w[rr].z), bflo(w[rr].w), bfhi(w[rr].w)};
                const float mu = wsum((v0[0] + v0[1]) + (v0[2] + v0[3]) + (v1[0] + v1[1]) + (v1[2] + v1[3])) * (1.0f / 512.0f);
                v0 -= mu; v1 -= mu;
                const float var = wsum((v0[0] * v0[0] + v0[1] * v0[1]) + (v0[2] * v0[2] + v0[3] * v0[3]) + (v1[0] * v1[0] + v1[1] * v1[1]) + (v1[2] * v1[2] + v1[3] * v1[3])) * (1.0f / 512.0f);
                const float rstd = rsqrtf(var + EPS);
                v0 = v0 * rstd * g0 + b0; v1 = v1 * rstd * g1 + b1;
                u32x4 o; o.x = cvtpk(v0[0], v0[1]); o.y = cvtpk(v0[2], v0[3]); o.z = cvtpk(v1[0], v1[1]); o.w = cvtpk(v1[2], v1[3]);
                *(LAS u32x4*)(F.lds + row * SGU_STRIDE + lane * 16) = o; }
        }
    }
    __syncthreads();
    {
        const int g = F.wave, r32 = lane & 31, hi = lane >> 5, i16 = lane & 15, g16 = (lane >> 4) & 1;
        const LAS unsigned char* vb = F.lds + (8 * hi + (i16 >> 2)) * SGU_STRIDE + (g * 64 + 16 * g16 + 4 * (i16 & 3)) * 2;
#pragma unroll
        for (int tb = 0; tb < 4; ++tb) {
            const int t = 32 * tb + r32; const float* wrow = w_s + ((size_t)g * 128 + t) * 128;
            f32x4 wr0[8], wr1[8];
#pragma unroll
            for (int ks = 0; ks < 2 * tb + 2; ++ks) { wr0[ks] = *(const f32x4*)(wrow + 16 * ks + 8 * hi); wr1[ks] = *(const f32x4*)(wrow + 16 * ks + 8 * hi + 4); }
            const float bs = b_s[g * 128 + t];
            const bf16* up = U + (size_t)(tok0 + t) * 512 + g * 64 + 4 * hi;
            u32x2 uu0[4], uu1[4];
#pragma unroll
            for (int gg = 0; gg < 4; ++gg) { uu0[gg] = *(const u32x2*)(up + 8 * gg); uu1[gg] = *(const u32x2*)(up + 32 + 8 * gg); }
            f32x16 a0, a1;
#pragma unroll
            for (int r = 0; r < 16; ++r) { a0[r] = 0.f; a1[r] = 0.f; }
#pragma unroll
            for (int ks = 0; ks < 2 * tb + 2; ++ks) {
                const int s0 = 16 * ks + 8 * hi;
                float wv[8] = {wr0[ks][0], wr0[ks][1], wr0[ks][2], wr0[ks][3], wr1[ks][0], wr1[ks][1], wr1[ks][2], wr1[ks][3]};
                if (ks >= 2 * tb) {
#pragma unroll
                    for (int j = 0; j < 8; ++j) wv[j] = (s0 + j <= t) ? wv[j] : 0.f; }
                u32x4 bw; bw.x = cvtpk(wv[0], wv[1]); bw.y = cvtpk(wv[2], wv[3]); bw.z = cvtpk(wv[4], wv[5]); bw.w = cvtpk(wv[6], wv[7]);
                const bf16x8 bfrag = __builtin_bit_cast(bf16x8, bw);
                const LAS unsigned char* p = vb + ks * 16 * SGU_STRIDE;
                const s16x4 l0 = vtr(p), h0 = vtr(p + 4 * SGU_STRIDE), l1 = vtr(p + 64), h1 = vtr(p + 4 * SGU_STRIDE + 64);
                const bf16x8 A0 = {l0[0], l0[1], l0[2], l0[3], h0[0], h0[1], h0[2], h0[3]}, A1 = {l1[0], l1[1], l1[2], l1[3], h1[0], h1[1], h1[2], h1[3]};
                a0 = __builtin_amdgcn_mfma_f32_32x32x16_bf16(A0, bfrag, a0, 0, 0, 0);
                a1 = __builtin_amdgcn_mfma_f32_32x32x16_bf16(A1, bfrag, a1, 0, 0, 0);
            }
            bf16* op = YAB + (size_t)(tok0 + t) * 1024 + 512 + g * 64 + 4 * hi;
#pragma unroll
            for (int gg = 0; gg < 4; ++gg) {
                u32x2 o0, o1;
                o0.x = cvtpk(bflo(uu0[gg].x) * (a0[4 * gg] + bs), bfhi(uu0[gg].x) * (a0[4 * gg + 1] + bs)); o0.y = cvtpk(bflo(uu0[gg].y) * (a0[4 * gg + 2] + bs), bfhi(uu0[gg].y) * (a0[4 * gg + 3] + bs));
                o1.x = cvtpk(bflo(uu1[gg].x) * (a1[4 * gg] + bs), bfhi(uu1[gg].x) * (a1[4 * gg + 1] + bs)); o1.y = cvtpk(bflo(uu1[gg].y) * (a1[4 * gg + 2] + bs), bfhi(uu1[gg].y) * (a1[4 * gg + 3] + bs));
                *(u32x2*)(op + 8 * gg) = o0; *(u32x2*)(op + 32 + 8 * gg) = o1; }
        }
    }
    __syncthreads();
}

constexpr int AT_BUF = 65536, AT_V = 32768, AT_BT = GTAB_OFF;
static_assert(8 * 1088 <= GTAB_BYTES, "bias tables fit above the ring");
__device__ __forceinline__ void attn_chunks(const Frame& F, const Args& a, int gc0, int gc1) {
    const bf16* __restrict__ Q = (const bf16*)(a.ws + WS_Q); const bf16* __restrict__ Kb = (const bf16*)(a.ws + WS_K); const bf16* __restrict__ Vb = (const bf16*)(a.ws + WS_V); bf16* YAB = (bf16*)(a.ws + WS_YAB);
    const int tid = F.tid, lane = F.lane, wave = F.wave, pr = wave >> 1, half = wave & 1;
    const int r32 = lane & 31, hi = lane >> 5, i16 = lane & 15, g16 = (lane >> 4) & 1;
    const int gcs[2] = {gc0, gc1};
    int j0s[2], nts[2], tok0s[2];
#pragma unroll
    for (int i = 0; i < 2; ++i) { const int c = gcs[i] % (SEQ / CHUNK); j0s[i] = (c < NLEFT) ? (NLEFT - c) : 0; nts[i] = 9 - j0s[i]; tok0s[i] = (gcs[i] / (SEQ / CHUNK)) * SEQ + c * CHUNK; }
    const int total = 2 * nts[0] + 2 * nts[1];
    const int lrow = tid >> 5, c16 = tid & 31, lhh = c16 >> 3, lch = c16 & 7;
    const int kwoff = lhh * 8192 + lrow * 128 + ((lch ^ ((lrow >> 1) & 7)) << 4);
    const int vwoff = AT_V + lhh * 8192 + lrow * 128 + ((lch ^ (((lrow >> 1) & 1) << 2)) << 4);
    int ko[4];
#pragma unroll
    for (int sI = 0; sI < 4; ++sI) ko[sI] = pr * 8192 + r32 * 128 + ((((2 * sI + hi) ^ ((r32 >> 1) & 7))) << 4);
    const int fb = (i16 >> 3) & 1;
    const int vr0 = AT_V + pr * 8192 + (4 * hi + (i16 >> 2)) * 128 + ((4 * (0 ^ fb) + 2 * g16 + ((i16 & 3) >> 1)) * 16) + (i16 & 1) * 8;
    const int vr1 = AT_V + pr * 8192 + (4 * hi + (i16 >> 2)) * 128 + ((4 * (1 ^ fb) + 2 * g16 + ((i16 & 3) >> 1)) * 16) + (i16 & 1) * 8;
#define AT_DECODE(t, ci, hp, j) do { ci = ((t) >= 2 * nts[0]) ? 1 : 0; const int tt_ = (t) - ci * 2 * nts[0]; hp = (tt_ >= nts[ci]) ? 1 : 0; j = j0s[ci] + tt_ - hp * nts[ci]; } while (0)
    u32x4 kn[4], vn[4];
    {
        int ci, hp, j; AT_DECODE(0, ci, hp, j);
        const size_t g = (size_t)(tok0s[ci] + (j - NLEFT) * CHUNK + lrow) * 512 + hp * 256 + c16 * 8;
#pragma unroll
        for (int i = 0; i < 4; ++i) { kn[i] = *(const u32x4*)(Kb + g + (size_t)i * 16 * 512); vn[i] = *(const u32x4*)(Vb + g + (size_t)i * 16 * 512); }
#pragma unroll
        for (int i = 0; i < 4; ++i) { *(LAS u32x4*)(F.lds + kwoff + i * 2048) = kn[i]; *(LAS u32x4*)(F.lds + vwoff + i * 2048) = vn[i]; }
    }
    __syncthreads();
    bf16x8 qf[4]; f32x16 o0, o1; float m = -1e30f, l = 0.f;
#pragma unroll
    for (int r = 0; r < 16; ++r) { o0[r] = 0.f; o1[r] = 0.f; }
#pragma unroll
    for (int sI = 0; sI < 4; ++sI) qf[sI] = (bf16x8){0, 0, 0, 0, 0, 0, 0, 0};
#pragma unroll 1
    for (int t = 0; t < total; ++t) {
        int ci, hp, j; AT_DECODE(t, ci, hp, j);
        const int tn = (t + 1 < total) ? t + 1 : t; int cin, hpn, jn; AT_DECODE(tn, cin, hpn, jn);
        const int h = 4 * hp + pr, qi = half * 32 + r32, qtok = tok0s[ci] + qi;
        if (j == j0s[ci]) {
#pragma unroll
            for (int sI = 0; sI < 4; ++sI) qf[sI] = *(const bf16x8*)(Q + (size_t)qtok * 512 + h * 64 + 16 * sI + 8 * hi);
#pragma unroll
            for (int r = 0; r < 16; ++r) { o0[r] = 0.f; o1[r] = 0.f; }
            m = -1e30f; l = 0.f;
        }
        asm volatile("" ::: "memory");
        {
            const size_t g = (size_t)(tok0s[cin] + (jn - NLEFT) * CHUNK + lrow) * 512 + hpn * 256 + c16 * 8;
#pragma unroll
            for (int i = 0; i < 4; ++i) { kn[i] = *(const u32x4*)(Kb + g + (size_t)i * 16 * 512); vn[i] = *(const u32x4*)(Vb + g + (size_t)i * 16 * 512); }
        }
        asm volatile("" ::: "memory");
        const LAS unsigned char* buf = F.lds + (t & 1) * AT_BUF;
        f32x16 p0, p1;
#pragma unroll
        for (int r = 0; r < 16; ++r) { p0[r] = 0.f; p1[r] = 0.f; }
#pragma unroll
        for (int sI = 0; sI < 4; ++sI) { const bf16x8 k0 = *(const LAS bf16x8*)(buf + ko[sI]), k1 = *(const LAS bf16x8*)(buf + ko[sI] + 4096);
            p0 = __builtin_amdgcn_mfma_f32_32x32x16_bf16(k0, qf[sI], p0, 0, 0, 0); p1 = __builtin_amdgcn_mfma_f32_32x32x16_bf16(k1, qf[sI], p1, 0, 0, 0); }
        if (j >= 6) {
            const LAS float* bt = (const LAS float*)(F.lds + AT_BT + h * 1088);
            const int base = 640 + qi - 64 * j - 4 * hi;
#pragma unroll
            for (int r = 0; r < 16; ++r) { const int kk = (r & 3) + 8 * (r >> 2); int i0 = base - kk, i1 = base - 32 - kk; i0 = i0 > 256 ? 256 : i0; i1 = i1 > 256 ? 256 : i1; p0[r] += bt[i0]; p1[r] += bt[i1]; }
        }
        float tm = fmaxf(p0[0], p1[0]);
#pragma unroll
        for (int r = 1; r < 16; ++r) tm = fmaxf(tm, fmaxf(p0[r], p1[r]));
        { const auto rr = __builtin_amdgcn_permlane32_swap(__float_as_uint(tm), __float_as_uint(tm), false, false); tm = fmaxf(__uint_as_float(rr[0]), __uint_as_float(rr[1])); }
        const float mn = fmaxf(m, tm), alpha = __builtin_amdgcn_exp2f(m - mn); m = mn;
        float ps = 0.f;
#pragma unroll
        for (int r = 0; r < 16; ++r) { p0[r] = __builtin_amdgcn_exp2f(p0[r] - mn); p1[r] = __builtin_amdgcn_exp2f(p1[r] - mn); ps += p0[r] + p1[r]; }
        l = l * alpha + ps;
#pragma unroll
        for (int r = 0; r < 16; ++r) { o0[r] *= alpha; o1[r] *= alpha; }
        bf16x8 pb[2][2];
#pragma unroll
        for (int sI = 0; sI < 2; ++sI) {
            u32x4 w0; w0.x = cvtpk(p0[8 * sI], p0[8 * sI + 1]); w0.y = cvtpk(p0[8 * sI + 2], p0[8 * sI + 3]); w0.z = cvtpk(p0[8 * sI + 4], p0[8 * sI + 5]); w0.w = cvtpk(p0[8 * sI + 6], p0[8 * sI + 7]);
            u32x4 w1; w1.x = cvtpk(p1[8 * sI], p1[8 * sI + 1]); w1.y = cvtpk(p1[8 * sI + 2], p1[8 * sI + 3]); w1.z = cvtpk(p1[8 * sI + 4], p1[8 * sI + 5]); w1.w = cvtpk(p1[8 * sI + 6], p1[8 * sI + 7]);
            pb[0][sI] = __builtin_bit_cast(bf16x8, w0); pb[1][sI] = __builtin_bit_cast(bf16x8, w1); }
#pragma unroll
        for (int blk = 0; blk < 2; ++blk)
#pragma unroll
            for (int sI = 0; sI < 2; ++sI) {
                const int kof = (32 * blk + 16 * sI) * 128;
                const s16x4 l0 = vtr(buf + vr0 + kof), h0 = vtr(buf + vr0 + kof + 1024), l1 = vtr(buf + vr1 + kof), h1 = vtr(buf + vr1 + kof + 1024);
                const bf16x8 A0 = {l0[0], l0[1], l0[2], l0[3], h0[0], h0[1], h0[2], h0[3]}, A1 = {l1[0], l1[1], l1[2], l1[3], h1[0], h1[1], h1[2], h1[3]};
                o0 = __builtin_amdgcn_mfma_f32_32x32x16_bf16(A0, pb[blk][sI], o0, 0, 0, 0);
                o1 = __builtin_amdgcn_mfma_f32_32x32x16_bf16(A1, pb[blk][sI], o1, 0, 0, 0);
            }
        if (j == 8) {
            float lt = l; { const auto rr = __builtin_amdgcn_permlane32_swap(__float_as_uint(lt), __float_as_uint(lt), false, false); lt = __uint_as_float(rr[0]) + __uint_as_float(rr[1]); }
            const float inv = __builtin_amdgcn_rcpf(lt);
            bf16* op = YAB + (size_t)qtok * 1024 + h * 64 + 4 * hi;
#pragma unroll
            for (int gg = 0; gg < 4; ++gg) {
                u32x2 w0, w1;
                w0.x = cvtpk(o0[4 * gg] * inv, o0[4 * gg + 1] * inv); w0.y = cvtpk(o0[4 * gg + 2] * inv, o0[4 * gg + 3] * inv);
                w1.x = cvtpk(o1[4 * gg] * inv, o1[4 * gg + 1] * inv); w1.y = cvtpk(o1[4 * gg + 2] * inv, o1[4 * gg + 3] * inv);
                *(u32x2*)(op + 8 * gg) = w0; *(u32x2*)(op + 32 + 8 * gg) = w1; }
        }
        {
            LAS unsigned char* nb = F.lds + ((t + 1) & 1) * AT_BUF;
#pragma unroll
            for (int i = 0; i < 4; ++i) { *(LAS u32x4*)(nb + kwoff + i * 2048) = kn[i]; *(LAS u32x4*)(nb + vwoff + i * 2048) = vn[i]; }
        }
        __syncthreads();
    }
#undef AT_DECODE
}
__device__ __forceinline__ void phaseD(const Frame& F, const Args& a) {
    if (!(a.pad & 8)) for (int unit = F.vcu; unit < NB * (SEQ / SGB); unit += F.G) sgu_unit(F, a, unit / (SEQ / SGB), unit % (SEQ / SGB));
    if (a.pad & 16) return;
    for (int i = F.tid; i < NHEAD * NREL; i += NWAVES * 64) { const int h = i / NREL, k = i % NREL; ((LAS float*)(F.lds + AT_BT + h * 1088))[k] = (a.in[7][i] - a.in[7][h * NREL + 256]) * LOG2E; }
    __syncthreads();
    const int NCH = NB * (SEQ / CHUNK);
    for (int v = F.vcu; v < NCH / 2; v += F.G) attn_chunks(F, a, v, NCH - 1 - v);
}

constexpr int G_HT_STRIDE = 2064;
__device__ __forceinline__ void phaseG(const Frame& F, const Args& a) {
    const float* x = a.in[0]; const bf16* Y1 = (const bf16*)(a.ws + WS_Y1); const float* mod = (const float*)(a.ws + WS_MOD); const float* g_post_mix = a.in[5]; const float* g_pre_ffn = a.in[17];
    const float* b_router = a.in[20]; bf16* X1b = (bf16*)(a.ws + WS_X1B); unsigned char* XN8 = a.ws + WS_XN;
    const bf16* wrt = (const bf16*)(a.ws + WS_WRT);
    float* topg = (float*)(a.ws + WS_TOPG); int* list = (int*)(a.ws + WS_LIST); unsigned* cnt = F.ctl + CW_CNT;
    LAS unsigned char* HT = F.lds;
    LAS float* PL = (LAS float*)(F.lds + 33792);
    LAS float* LG = PL + 8 * 16 * 32;
    LAS float* TV = LG + 512;
    LAS unsigned* LC = (LAS unsigned*)(TV + 64);
    LAS unsigned* AS = LC + 64;
    const int tid = F.tid, lane = F.lane, wave = F.wave, kq = lane >> 4, i16 = lane & 15;
    if (tid < 64) LC[tid] = 0u;
    bf16x8 whi[2][4], wlo[2][4];
#pragma unroll
    for (int et = 0; et < 2; ++et)
#pragma unroll
        for (int ks = 0; ks < 4; ++ks) { const size_t o = (size_t)(et * 16 + i16) * D + 128 * wave + 32 * ks + 8 * kq; whi[et][ks] = *(const bf16x8*)(wrt + o); wlo[et][ks] = *(const bf16x8*)(wrt + (size_t)NEXP * D + o); }
    const int myrow = tid >> 5, mye = lane & 31;
    const float mybias = b_router[mye];
    __syncthreads();
    const int NT = NTOK / 16;
    f32x4 xv[2][4]; u32x2 yr[2][4];
    {   const int rbase = 16 * F.vcu + 2 * wave;
#pragma unroll
        for (int rr = 0; rr < 2; ++rr)
#pragma unroll
            for (int j = 0; j < 4; ++j) { const int c0 = (lane + 64 * j) * 4; xv[rr][j] = *(const f32x4*)(x + (size_t)(rbase + rr) * D + c0); yr[rr][j] = *(const u32x2*)(Y1 + (size_t)(rbase + rr) * D + c0); } }
    int tl = 0;
    f32x4 cgp[4], cgf[4], cgt[4], csc[4], csh[4]; int cb = -1;
#pragma unroll
    for (int j = 0; j < 4; ++j) { const int c0 = (lane + 64 * j) * 4; cgp[j] = *(const f32x4*)(g_post_mix + c0); cgf[j] = *(const f32x4*)(g_pre_ffn + c0); }
#pragma unroll 1
    for (int T = F.vcu; T < NT; T += F.G, ++tl) {
        const int b = (16 * T) / SEQ; const float* mb = mod + b * 6144; const int rbase = 16 * T + 2 * wave;
        if (b != cb) { cb = b;
#pragma unroll
            for (int j = 0; j < 4; ++j) { const int c0 = (lane + 64 * j) * 4; cgt[j] = *(const f32x4*)(mb + GT1 + c0); csc[j] = *(const f32x4*)(mb + SC2 + c0) + 1.0f; csh[j] = *(const f32x4*)(mb + SH2 + c0); } }
#pragma unroll
        for (int rr = 0; rr < 2; ++rr) {
            const int row = rbase + rr; f32x4 yv[4]; float ss = 0.f;
#pragma unroll
            for (int j = 0; j < 4; ++j) { yv[j] = (f32x4){bflo(yr[rr][j].x), bfhi(yr[rr][j].x), bflo(yr[rr][j].y), bfhi(yr[rr][j].y)}; ss += (yv[j][0] * yv[j][0] + yv[j][1] * yv[j][1]) + (yv[j][2] * yv[j][2] + yv[j][3] * yv[j][3]); }
            const float rstd = rsqrtf(wsum(ss) * (1.0f / D) + EPS); float s2 = 0.f;
#pragma unroll
            for (int j = 0; j < 4; ++j) { const int c0 = (lane + 64 * j) * 4;
                xv[rr][j] = xv[rr][j] + cgt[j] * (yv[j] * rstd * cgp[j]);
                { u32x2 w1; w1.x = cvtpk(xv[rr][j][0], xv[rr][j][1]); w1.y = cvtpk(xv[rr][j][2], xv[rr][j][3]); *(u32x2*)(X1b + (size_t)row * D + c0) = w1; }
                s2 += (xv[rr][j][0] * xv[rr][j][0] + xv[rr][j][1] * xv[rr][j][1]) + (xv[rr][j][2] * xv[rr][j][2] + xv[rr][j][3] * xv[rr][j][3]); }
            const float rstd2 = rsqrtf(wsum(s2) * (1.0f / D) + EPS);
#pragma unroll
            for (int j = 0; j < 4; ++j) { const int c0 = (lane + 64 * j) * 4;
                const f32x4 h = xv[rr][j] * rstd2 * cgf[j] * csc[j] + csh[j];
                u32x2 w; w.x = cvtpk(h[0], h[1]); w.y = cvtpk(h[2], h[3]); *(unsigned*)(XN8 + (size_t)row * D + c0) = pk_fp8x4(h[0] * F8_ASCALE, h[1] * F8_ASCALE, h[2] * F8_ASCALE, h[3] * F8_ASCALE);
                *(LAS u32x2*)(HT + (2 * wave + rr) * G_HT_STRIDE + c0 * 2) = w; }
        }
        {
            const int Tn = (T + F.G < NT) ? T + F.G : T; const int rb2 = 16 * Tn + 2 * wave;
#pragma unroll
            for (int rr = 0; rr < 2; ++rr)
#pragma unroll
                for (int j = 0; j < 4; ++j) { const int c0 = (lane + 64 * j) * 4; xv[rr][j] = *(const f32x4*)(x + (size_t)(rb2 + rr) * D + c0); yr[rr][j] = *(const u32x2*)(Y1 + (size_t)(rb2 + rr) * D + c0); }
        }
        LDS_WAIT(); __builtin_amdgcn_s_barrier(); asm volatile("" ::: "memory");
        {
            f32x4 acc0 = {0.f, 0.f, 0.f, 0.f}, acc1 = {0.f, 0.f, 0.f, 0.f};
#pragma unroll
            for (int ks = 0; ks < 4; ++ks) { const bf16x8 hb = *(const LAS bf16x8*)(HT + i16 * G_HT_STRIDE + (128 * wave + 32 * ks + 8 * kq) * 2);
                acc0 = __builtin_amdgcn_mfma_f32_16x16x32_bf16(whi[0][ks], hb, acc0, 0, 0, 0); acc0 = __builtin_amdgcn_mfma_f32_16x16x32_bf16(wlo[0][ks], hb, acc0, 0, 0, 0);
                acc1 = __builtin_amdgcn_mfma_f32_16x16x32_bf16(whi[1][ks], hb, acc1, 0, 0, 0); acc1 = __builtin_amdgcn_mfma_f32_16x16x32_bf16(wlo[1][ks], hb, acc1, 0, 0, 0); }
            *(LAS f32x4*)(PL + (wave * 16 + i16) * 32 + 4 * kq) = acc0; *(LAS f32x4*)(PL + (wave * 16 + i16) * 32 + 16 + 4 * kq) = acc1;
        }
        LDS_WAIT(); __builtin_amdgcn_s_barrier(); asm volatile("" ::: "memory");
        float lg = mybias;
#pragma unroll
        for (int w = 0; w < 8; ++w) lg += PL[(w * 16 + myrow) * 32 + mye];
        LG[myrow * 32 + mye] = lg;
        LDS_WAIT(); asm volatile("" ::: "memory");
        int rank = 0;
#pragma unroll
        for (int q = 0; q < 8; ++q) { const f32x4 o = *(const LAS f32x4*)(LG + myrow * 32 + 4 * q);
#pragma unroll
            for (int i = 0; i < 4; ++i) { const int e2 = 4 * q + i; rank += (o[i] > lg || (o[i] == lg && e2 < mye)) ? 1 : 0; } }
        if (rank < 4) TV[myrow * 4 + rank] = lg;
        LDS_WAIT(); asm volatile("" ::: "memory");
        const f32x4 tv = *(const LAS f32x4*)(TV + myrow * 4);
        if (rank < 4) {
            const float den = 1.0f + __expf(tv[1] - tv[0]) + __expf(tv[2] - tv[0]) + __expf(tv[3] - tv[0]);
            const int slot = (16 * T + myrow) * 4 + rank; topg[slot] = __expf(lg - tv[0]) / den;
            const unsigned lp = __hip_atomic_fetch_add(LC + mye, 1u, __ATOMIC_RELAXED, __HIP_MEMORY_SCOPE_WORKGROUP);
            if (tl < 16) AS[tl * 64 + myrow * 4 + rank] = (unsigned)mye | (lp << 8);
        }
    }
    __syncthreads();
    if (tid < NEXP) LC[32 + tid] = atomicAdd(&cnt[tid], LC[tid]);
    __syncthreads();
    for (int i = tid; i < tl * 64; i += NWAVES * 64) { const unsigned as = AS[i]; const int e = as & 255, lp = as >> 8; const int T = F.vcu + (i >> 6) * F.G;
        list[(size_t)e * NTOK + LC[32 + e] + lp] = (16 * T + ((i & 63) >> 2)) * 4 + (i & 3); }
}
__device__ __forceinline__ int moe_tables(const Frame& F) {
    __syncthreads();
    if (F.tid < NEXP) F.MISC[40 + F.tid] = __hip_atomic_load(F.ctl + CW_CNT + F.tid, __ATOMIC_RELAXED, __HIP_MEMORY_SCOPE_AGENT);
    __syncthreads();
    if (F.tid == 0) { unsigned s = 0; for (int e = 0; e < NEXP; ++e) { F.MISC[e] = s; s += (F.MISC[40 + e] + 255u) >> 8; } F.MISC[32] = s; }
    __syncthreads();
    return (int)F.MISC[32];
}
__device__ __forceinline__ void phaseJ(const Frame& F, const Args& a) {
    const unsigned char* Y2s = a.ws + WS_Y2; const bf16* X1b = (const bf16*)(a.ws + WS_X1B); const float* mod = (const float*)(a.ws + WS_MOD); const float* gpf = a.in[18]; float* out = a.out;
    const int* inv = (const int*)(a.ws + WS_TOPE); const float* topg = (const float*)(a.ws + WS_TOPG);
    const int lane = F.lane, gw = F.vcu * NWAVES + F.wave, NGW = F.G * NWAVES;
    f32x4 cgg[4]; int cb = -1;
    for (int row0 = gw * 4; row0 < NTOK; row0 += NGW * 4) {
        const int b = row0 / SEQ; const float* mb = mod + b * 6144;
        if (b != cb) { cb = b;
#pragma unroll
            for (int j = 0; j < 4; ++j) { const int c0 = (lane + 64 * j) * 4; cgg[j] = *(const f32x4*)(gpf + c0) * *(const f32x4*)(mb + GT2 + c0); } }
        int pp[4][4]; float gg[4][4];
#pragma unroll
        for (int rr = 0; rr < 4; ++rr)
#pragma unroll
            for (int k = 0; k < 4; ++k) { pp[rr][k] = __builtin_amdgcn_readfirstlane(inv[(row0 + rr) * 4 + k]); gg[rr][k] = topg[(row0 + rr) * 4 + k] * (1.0f / F8_YSCALE); }
        unsigned yy[4][4][4]; u32x2 xx[4][4];
#pragma unroll
        for (int rr = 0; rr < 4; ++rr)
#pragma unroll
            for (int j = 0; j < 4; ++j) { const int c0 = (lane + 64 * j) * 4;
#pragma unroll
                for (int k = 0; k < 4; ++k) yy[rr][j][k] = *(const unsigned*)(Y2s + (size_t)pp[rr][k] * D + c0);
                xx[rr][j] = *(const u32x2*)(X1b + (size_t)(row0 + rr) * D + c0); }
#pragma unroll
        for (int rr = 0; rr < 4; ++rr) {
            f32x4 yv[4]; float ss = 0.f;
#pragma unroll
            for (int j = 0; j < 4; ++j) { f32x4 s = {0.f, 0.f, 0.f, 0.f};
#pragma unroll
                for (int k = 0; k < 4; ++k) { const f32x2 lo = __builtin_amdgcn_cvt_pk_f32_fp8((int)yy[rr][j][k], false), hi = __builtin_amdgcn_cvt_pk_f32_fp8((int)yy[rr][j][k], true);
                    s += (f32x4){lo.x, lo.y, hi.x, hi.y} * gg[rr][k]; }
                yv[j] = s; ss += (s[0] * s[0] + s[1] * s[1]) + (s[2] * s[2] + s[3] * s[3]); }
            const float rstd = rsqrtf(wsum(ss) * (1.0f / D) + EPS);
#pragma unroll
            for (int j = 0; j < 4; ++j) { const int c0 = (lane + 64 * j) * 4;
                const f32x4 x1 = {bflo(xx[rr][j].x), bfhi(xx[rr][j].x), bflo(xx[rr][j].y), bfhi(xx[rr][j].y)};
                *(f32x4*)(out + (size_t)(row0 + rr) * D + c0) = x1 + cgg[j] * (yv[j] * rstd); }
        }
    }
}

constexpr int N_PHASES = 10;
__global__ void __launch_bounds__(NWAVES * 64, 2) mega_fwd(Args args) {
    extern __shared__ __attribute__((aligned(16))) unsigned char lds_raw[];
    Frame F;
    F.lds = (LAS unsigned char*)lds_raw; F.MISC = (volatile LAS unsigned*)(F.lds + MISC_OFF);
    F.tid = threadIdx.x; F.lane = F.tid & 63; F.wave = __builtin_amdgcn_readfirstlane(F.tid >> 6);
    F.G = gridDim.x; { const int bx = blockIdx.x; F.vcu = (F.G % 8 == 0) ? (bx % 8) * (F.G / 8) + bx / 8 : bx; }
    F.ctl = (unsigned*)(args.ws + WS_CTL);
    for (int u = F.tid; u < 128; u += NWAVES * 64) F.MISC[u] = 0u;
    __syncthreads();
    const int lo = args.ph_lo, hi = args.ph_hi;
    XcdBarrier bar; bar.bar = F.ctl + CW_BAR; bar.x = 0; bar.st = F.MISC + 80;
    if (hi - lo > 1) bar = xcd_barrier_post(F.ctl + CW_BAR, F.MISC + 80);
#ifndef PH_COMPILE_MASK
#define PH_COMPILE_MASK 0x3ff
#endif
#define IN(k) (((PH_COMPILE_MASK >> (k)) & 1) && lo <= (k) && (k) < hi)
#define SEAM(k) do { if (IN(k) && IN((k) + 1)) xcd_barrier(bar); } while (0)
    unsigned char* ws = args.ws;
    bf16 *XN = (bf16*)(ws + WS_XN), *Qb = (bf16*)(ws + WS_Q), *Kb = (bf16*)(ws + WS_K), *Vb = (bf16*)(ws + WS_V), *Ub = (bf16*)(ws + WS_U), *VG = (bf16*)(ws + WS_VG);
    bf16 *GT = (bf16*)(ws + WS_GT), *YAB = (bf16*)(ws + WS_YAB), *MRG = (bf16*)(ws + WS_MRG), *Y1 = (bf16*)(ws + WS_Y1), *ACT = (bf16*)(ws + WS_ACT), *Y2 = (bf16*)(ws + WS_Y2);

    if (IN(0)) { phaseA(F, args); } SEAM(0);
    if (IN(1)) { phaseB(F, args); } SEAM(1);
    if (IN(2)) {
        SchedStatic S{(const char*)XN, (const char*)(ws + WS_W1T), NTOK / 256, 4608 / 256, F.G, (int)blockIdx.x, (size_t)256 * 1024 * 2, (size_t)256 * 1024 * 2};
        EpiG1 E{Qb, Kb, Vb, Ub, VG, GT, args.in[15]};
        pg8::gemm_phase<EpiG1, SchedStatic, false>(F.lds + RING_OFF, S, E, 2048, 2048, 16, args.pad);
    } SEAM(2);
    if (IN(3)) { phaseD(F, args); } SEAM(3);
    if (IN(4)) {
        SchedSplit2 S{(const char*)YAB, (const char*)(ws + WS_WBRT), NTOK / 256, 4, F.G, (int)blockIdx.x, (size_t)256 * 1024 * 2, (size_t)256 * 1024 * 2, (size_t)512 * 2};
        EpiG2 E{GT, MRG};
        pg8::gemm_phase<EpiG2, SchedSplit2, false>(F.lds + RING_OFF, S, E, 2048, 2048, 8);
    } SEAM(4);
    if (IN(5)) {
        SchedStatic S{(const char*)MRG, (const char*)(ws + WS_WOUTT), NTOK / 256, 4, F.G, (int)blockIdx.x, (size_t)256 * 1024 * 2, (size_t)256 * 1024 * 2};
        EpiPlain E{Y1};
        pg8::gemm_phase<EpiPlain, SchedStatic, false>(F.lds + RING_OFF, S, E, 2048, 2048, 16);
    } SEAM(5);
    if (IN(6)) { phaseG(F, args); } SEAM(6);
    if (IN(7)) {
        const int nrb = moe_tables(F);
        const int* list = (const int*)(ws + WS_LIST);
        {
            int* inv = (int*)(ws + WS_TOPE);
            for (int g = (int)blockIdx.x * (NWAVES * 64) + F.tid; g < NTOK * TOPK; g += F.G * NWAVES * 64) {
                int e = 0, base = 0;
#pragma unroll 1
                for (int i = 0; i < NEXP; ++i) { const int c = (int)F.MISC[40 + i]; if (g >= base + c) { base += c; e = i + 1; } else break; }
                const int pos = g - base; if (e < NEXP) inv[list[(size_t)e * NTOK + pos]] = (int)F.MISC[e] * 256 + pos; }
        }
        typedef SchedMoe<8, true> SM;
        SM S{(const char*)XN, (const char*)(ws + WS_WGUT), F.MISC, (const LAS unsigned*)(F.lds + GTAB_OFF), (int)blockIdx.x, F.G, nrb, (size_t)2048 * 1024, (size_t)256 * 1024};
        S.build(F.tid);
        { Unit u; LAS unsigned* gt = (LAS unsigned*)(F.lds + GTAB_OFF);
          for (int k = 0; k < GTAB_UNITS && S.next(k, u); ++k) { const int e = u.aux, j256 = (u.pm - (int)F.MISC[e]) * 256, ecnt = (int)F.MISC[40 + e];
              for (int r = F.tid; r < 256; r += NWAVES * 64) { const int pos = j256 + r; int tok = 0; if (pos < ecnt) tok = list[(size_t)e * NTOK + pos] >> 2; gt[k * 256 + r] = (unsigned)tok * 1024u; } } }
        __syncthreads();
        EpiAct E{args.in[22], (unsigned char*)ACT};
        pg8::gemm_phase<EpiAct, SM, true>(F.lds + RING_OFF, S, E, 1024, 1024, 8, args.pad);
    } SEAM(7);
    if (IN(8)) {
        const int nrb = moe_tables(F);
        typedef SchedMoe<4, true> SM;
        SM S{(const char*)ACT, (const char*)(ws + WS_WDNT), F.MISC, (const LAS unsigned*)(F.lds + GTAB_OFF), (int)blockIdx.x, F.G, nrb, (size_t)1024 * 1024, (size_t)256 * 1024};
        S.build(F.tid);
        { Unit u; LAS unsigned* gt = (LAS unsigned*)(F.lds + GTAB_OFF);
          for (int k = 0; k < GTAB_UNITS && S.next(k, u); ++k) for (int r = F.tid; r < 256; r += NWAVES * 64) gt[k * 256 + r] = (unsigned)(u.pm * 256 + r) * 1024u; }
        __syncthreads();
        EpiDown E{args.in[24], (unsigned char*)Y2};
        pg8::gemm_phase<EpiDown, SM, true>(F.lds + RING_OFF, S, E, 1024, 1024, 8, args.pad);
    } SEAM(8);
    if (IN(9)) { phaseJ(F, args); }
#undef IN
#undef SEAM
}
#ifndef MEGA_MASK
#define MEGA_MASK 0x3ff
#endif
#ifndef REP_MASK
#define REP_MASK 0
#endif
#ifndef REP_FLAGS
#define REP_FLAGS 0
#endif
#ifndef ONE_LAUNCH
#define ONE_LAUNCH 1
#endif
extern "C" void kernel_launch(void* const* d_in, const int* in_sizes, int n_in, void* d_out, int out_size, void* d_ws, size_t ws_size, hipStream_t stream) {
    if (n_in != 25 || in_sizes[0] != NTOK * D || out_size != NTOK * D || ws_size < WS_END) { fprintf(stderr, "kernel_launch: unexpected shapes (n_in %d in0 %d out %d ws %zu)\n", n_in, n_in > 0 ? in_sizes[0] : -1, out_size, ws_size); return; }
    static int grid = 0;
    if (grid == 0) {
        int dev = 0, cus = 0, per_cu = 0;
        if (hipGetDevice(&dev) != hipSuccess || hipDeviceGetAttribute(&cus, hipDeviceAttributeMultiprocessorCount, dev) != hipSuccess) { fprintf(stderr, "kernel_launch: device query failed\n"); grid = -1; return; }
        if (hipFuncSetAttribute((const void*)mega_fwd, hipFuncAttributeMaxDynamicSharedMemorySize, LDS_BYTES) != hipSuccess) { fprintf(stderr, "kernel_launch: hipFuncSetAttribute failed\n"); grid = -1; return; }
        if (hipOccupancyMaxActiveBlocksPerMultiprocessor(&per_cu, (const void*)mega_fwd, NWAVES * 64, LDS_BYTES) != hipSuccess || per_cu < 1) { fprintf(stderr, "kernel_launch: occupancy query says %d\n", per_cu); }
        (void)hipGetLastError();
        grid = cus;
    }
    if (grid < 0) return;
    const float* x = (const float*)d_in[0]; const float* c = (const float*)d_in[1]; const float* w_ada = (const float*)d_in[2]; const float* b_ada = (const float*)d_in[3];
    const float* g_pre_mix = (const float*)d_in[4]; const float* g_post_mix = (const float*)d_in[5]; const float* w_in = (const float*)d_in[6]; const float* rel_bias = (const float*)d_in[7];
    const float* sgu_ln_g = (const float*)d_in[8]; const float* sgu_ln_b = (const float*)d_in[9]; const float* w_spatial = (const float*)d_in[10]; const float* b_spatial = (const float*)d_in[11];
    const float* w_branch_a = (const float*)d_in[12]; const float* w_branch_b = (const float*)d_in[13]; const float* w_gate = (const float*)d_in[14]; const float* b_gate = (const float*)d_in[15];
    const float* w_out = (const float*)d_in[16]; const float* g_pre_ffn = (const float*)d_in[17]; const float* g_post_ffn = (const float*)d_in[18]; const float* w_router = (const float*)d_in[19];
    const float* b_router = (const float*)d_in[20]; const float* w_gate_up = (const float*)d_in[21]; const float* b_gate_up = (const float*)d_in[22]; const float* w_down = (const float*)d_in[23];
    const float* b_down = (const float*)d_in[24];
    unsigned char* ws = (unsigned char*)d_ws; float* out = (float*)d_out;
    unsigned* ctl = (unsigned*)(ws + WS_CTL); float* mod = (float*)(ws + WS_MOD);
    bf16 *XN = (bf16*)(ws + WS_XN), *Qb = (bf16*)(ws + WS_Q), *Kb = (bf16*)(ws + WS_K), *Vb = (bf16*)(ws + WS_V), *Ub = (bf16*)(ws + WS_U), *VG = (bf16*)(ws + WS_VG);
    bf16 *GT = (bf16*)(ws + WS_GT), *YAB = (bf16*)(ws + WS_YAB), *MRG = (bf16*)(ws + WS_MRG), *Y1 = (bf16*)(ws + WS_Y1), *ACT = (bf16*)(ws + WS_ACT), *Y2 = (bf16*)(ws + WS_Y2);
    float *VN = (float*)(ws + WS_VN), *TMP = (float*)(ws + WS_TMP);
    int* tope = (int*)(ws + WS_TOPE); float* topg = (float*)(ws + WS_TOPG); int* list = (int*)(ws + WS_LIST); unsigned* cnt = ctl + CW_CNT;
    (void)x; (void)c; (void)w_ada; (void)b_ada; (void)g_pre_mix; (void)rel_bias; (void)sgu_ln_g; (void)sgu_ln_b; (void)w_spatial; (void)b_spatial; (void)tope;

    if (hipMemsetAsync(ws + WS_CTL, 0, CTL_ZERO_BYTES, stream) != hipSuccess) { fprintf(stderr, "kernel_launch: memset failed\n"); return; }
    Args a{};
    for (int i = 0; i < 25; ++i) a.in[i] = (const float*)d_in[i];
    a.out = out; a.ws = ws;
#if ONE_LAUNCH
    a.ph_lo = 0; a.ph_hi = N_PHASES;
    hipLaunchKernelGGL(mega_fwd, dim3(grid), dim3(NWAVES * 64), LDS_BYTES, stream, a);
    if (hipPeekAtLastError() != hipSuccess) fprintf(stderr, "kernel_launch: launch failed\n");
    for (int ph = 0; ph < N_PHASES; ++ph) if ((REP_MASK >> ph) & 1) {
        a.ph_lo = ph; a.ph_hi = ph + 1; a.pad = REP_FLAGS; hipLaunchKernelGGL(mega_fwd, dim3(grid), dim3(NWAVES * 64), LDS_BYTES, stream, a); }
#else
    for (int ph = 0; ph < N_PHASES; ++ph) {
        if (((MEGA_MASK >> ph) & 1) || ph == 0) { a.ph_lo = ph; a.ph_hi = ph + 1; hipLaunchKernelGGL(mega_fwd, dim3(grid), dim3(NWAVES * 64), LDS_BYTES, stream, a); if (((MEGA_MASK >> ph) & 1)) continue; }
        switch (ph) {
        case 0: nv_mod<<<NMOD * D / 256, 256, 0, stream>>>(c, w_ada, b_ada, mod); break;
        case 1: nv_xn1<<<NTOK / 4, 256, 0, stream>>>(x, g_pre_mix, mod, XN); break;
        case 2: { G_In g{XN, w_in, Qb, Kb, Vb, Ub, VG}; nv_gemm<G_In, false><<<dim3(INW / 64, NTOK / 64, 1), 256, 0, stream>>>(g, INW, D); }
                { G_Gate g{XN, w_gate, b_gate, GT}; nv_gemm<G_Gate, false><<<dim3(2048 / 64, NTOK / 64, 1), 256, 0, stream>>>(g, 2048, D); } break;
        case 3: nv_attn<<<NTOK * NHEAD / 256, 256, 0, stream>>>(Qb, Kb, Vb, rel_bias, YAB);
                nv_sgu_ln<<<NTOK / 4, 256, 0, stream>>>(VG, sgu_ln_g, sgu_ln_b, VN);
                nv_sgu<<<NTOK * SW / 256, 256, 0, stream>>>(VN, Ub, w_spatial, b_spatial, YAB); break;
        case 4: { G_BrA g{YAB, w_branch_a, GT, TMP}; nv_gemm<G_BrA, false><<<dim3(D / 64, NTOK / 64, 1), 256, 0, stream>>>(g, D, AW); }
                { G_BrB g{YAB, w_branch_b, GT, TMP, MRG}; nv_gemm<G_BrB, false><<<dim3(D / 64, NTOK / 64, 1), 256, 0, stream>>>(g, D, SW); } break;
        case 5: { G_Out g{MRG, w_out, Y1}; nv_gemm<G_Out, false><<<dim3(D / 64, NTOK / 64, 1), 256, 0, stream>>>(g, D, D); } break;
        case 6: nv_rowpass1<<<NTOK / 4, 256, 0, stream>>>(x, Y1, mod, g_post_mix, g_pre_ffn, w_router, b_router, out, XN, tope, topg, cnt, list); break;
        case 7: { G_MoeGU g{XN, w_gate_up, b_gate_up, cnt, list, ACT}; nv_gemm<G_MoeGU, true><<<dim3(DE / 64, NTOK / 64, NEXP), 256, 0, stream>>>(g, 2048, D); } break;
        case 8: { G_MoeDn g{ACT, w_down, b_down, cnt, list, topg, Y2}; nv_gemm<G_MoeDn, false><<<dim3(D / 64, NTOK / 64, NEXP), 256, 0, stream>>>(g, D, DE); } break;
        case 9: nv_final<<<NTOK / 4, 256, 0, stream>>>(Y2, mod, g_post_ffn, out); break;
        }
    }
#endif
}
```

```cpp
#include <hip/hip_runtime.h>
#include <cstdio>
#include <cstdint>

constexpr int NB = 4, SEQ = 8192, D = 1024, NTOK = NB * SEQ;
constexpr int AW = 512, NHEAD = 8, HD = 64, CHUNK = 64, NLEFT = 8, BAND = 576, MAXREL = 128, NREL = 257;
constexpr int SW = 512, SGB = 128, SGG = 8, SGD = 64;
constexpr int INW = 2560, NEXP = 32, TOPK = 4, DE = 1024, NMOD = 6;
constexpr float EPS = 1e-6f, SWL = 7.0f, SWA = 1.702f;
constexpr float LOG2E = 1.4426950408889634f;
constexpr float QSCALE = 0.125f * LOG2E;
constexpr int SH1 = 0, SC1 = 1024, GT1 = 2048, SH2 = 3072, SC2 = 4096, GT2 = 5120;

typedef unsigned short bf16;
__device__ __forceinline__ float bf2f(bf16 v) { return __uint_as_float(((unsigned)v) << 16); }
__device__ __forceinline__ bf16 f2bf(float f) { unsigned u = __float_as_uint(f); return (bf16)((u + 0x7fffu + ((u >> 16) & 1u)) >> 16); }
__device__ __forceinline__ float wave_sum(float v) {
#pragma unroll
    for (int o = 1; o < 64; o <<= 1) v += __shfl_xor(v, o);
    return v;
}
__device__ __forceinline__ float gelu_erf(float x) { return 0.5f * x * (1.0f + erff(x * 0.70710678118654752f)); }
__device__ __forceinline__ float sigmoidf_(float x) { return 1.0f / (1.0f + __expf(-x)); }

constexpr size_t MiB = 1u << 20;
constexpr size_t WS_CTL = 0, CTL_ZERO_BYTES = 1 * MiB;
constexpr size_t WS_MOD = 1 * MiB;
constexpr size_t WS_W1T = 2 * MiB, WS_WBRT = 12 * MiB, WS_WOUTT = 14 * MiB, WS_WRT = 16 * MiB;
constexpr size_t WS_TOPE = 17 * MiB, WS_TOPG = 18 * MiB, WS_LIST = 19 * MiB;
constexpr size_t WS_WGUT = 32 * MiB, WS_WDNT = 160 * MiB;
constexpr size_t WS_XN = 224 * MiB;
constexpr size_t WS_Q = 288 * MiB, WS_K = 320 * MiB, WS_V = 352 * MiB, WS_U = 384 * MiB, WS_VG = 416 * MiB;
constexpr size_t WS_GT = 448 * MiB;
constexpr size_t WS_YAB = 576 * MiB, WS_MRG = 640 * MiB, WS_Y1 = 704 * MiB;
constexpr size_t WS_ACT = 288 * MiB;
constexpr size_t WS_Y2 = 576 * MiB;
constexpr size_t WS_VN = 768 * MiB;
constexpr size_t WS_TMP = 832 * MiB;
constexpr size_t WS_END = 960 * MiB;
constexpr int CW_CNT = 1024;

__global__ __launch_bounds__(256) void nv_mod(const float* __restrict__ c, const float* __restrict__ w_ada, const float* __restrict__ b_ada, float* __restrict__ mod) {
    __shared__ float sc[NB * D];
    for (int i = threadIdx.x; i < NB * D; i += 256) { const float v = c[i]; sc[i] = v / (1.0f + __expf(-v)); }
    __syncthreads();
    const int j = blockIdx.x * 256 + threadIdx.x;
    float a0 = 0.f, a1 = 0.f, a2 = 0.f, a3 = 0.f;
    for (int k = 0; k < D; ++k) { const float w = w_ada[(size_t)k * (NMOD * D) + j]; a0 += sc[k] * w; a1 += sc[D + k] * w; a2 += sc[2 * D + k] * w; a3 += sc[3 * D + k] * w; }
    const float bb = b_ada[j];
    mod[j] = a0 + bb; mod[6144 + j] = a1 + bb; mod[2 * 6144 + j] = a2 + bb; mod[3 * 6144 + j] = a3 + bb;
}

__global__ __launch_bounds__(256) void nv_xn1(const float* __restrict__ x, const float* __restrict__ g, const float* __restrict__ mod, bf16* __restrict__ xn) {
    const int row = blockIdx.x * 4 + (threadIdx.x >> 6), lane = threadIdx.x & 63, b = row / SEQ;
    const float4* xr = (const float4*)(x + (size_t)row * D);
    float4 v[4]; float ss = 0.f;
#pragma unroll
    for (int j = 0; j < 4; ++j) { v[j] = xr[lane + 64 * j]; ss += v[j].x * v[j].x + v[j].y * v[j].y + v[j].z * v[j].z + v[j].w * v[j].w; }
    const float rstd = rsqrtf(wave_sum(ss) * (1.0f / D) + EPS);
    const float* mb = mod + b * 6144;
#pragma unroll
    for (int j = 0; j < 4; ++j) {
        const int c0 = (lane + 64 * j) * 4; const float vv[4] = {v[j].x, v[j].y, v[j].z, v[j].w}; bf16 o[4];
#pragma unroll
        for (int i = 0; i < 4; ++i) o[i] = f2bf(vv[i] * rstd * g[c0 + i] * (1.0f + mb[SC1 + c0 + i]) + mb[SH1 + c0 + i]);
        *(uint2*)(xn + (size_t)row * D + c0) = make_uint2((unsigned)o[0] | ((unsigned)o[1] << 16), (unsigned)o[2] | ((unsigned)o[3] << 16));
    }
}

template <class G, bool DUAL>
__global__ __launch_bounds__(256) void nv_gemm(G g, int ldw, int K) {
    __shared__ float As[16][68];
    __shared__ float Ws[16][64];
    __shared__ float Ws2[DUAL ? 16 : 1][64];
    const int z = blockIdx.z; int nrows; const float* W; const float* W2;
    if (!g.setup(z, nrows, W, W2)) return;
    const int r0 = blockIdx.y * 64, n0 = blockIdx.x * 64;
    if (r0 >= nrows) return;
    const int tid = threadIdx.x, tx = tid & 15, ty = tid >> 4;
    const int lr = tid >> 2, lk = (tid & 3) * 4;
    int ar = r0 + lr; if (ar >= nrows) ar = nrows - 1;
    const bf16* ap = g.arow(z, ar) + lk;
    const int wk = tid >> 4, wn = (tid & 15) * 4;
    float acc[4][4], acc2[4][4];
#pragma unroll
    for (int i = 0; i < 4; ++i)
#pragma unroll
        for (int j = 0; j < 4; ++j) { acc[i][j] = 0.f; acc2[i][j] = 0.f; }
    for (int k0 = 0; k0 < K; k0 += 16) {
        const uint2 av = *(const uint2*)(ap + k0);
        As[lk + 0][lr] = bf2f((bf16)(av.x & 0xffff)); As[lk + 1][lr] = bf2f((bf16)(av.x >> 16));
        As[lk + 2][lr] = bf2f((bf16)(av.y & 0xffff)); As[lk + 3][lr] = bf2f((bf16)(av.y >> 16));
        *(float4*)&Ws[wk][wn] = *(const float4*)(W + (size_t)(k0 + wk) * ldw + n0 + wn);
        if (DUAL) *(float4*)&Ws2[wk][wn] = *(const float4*)(W2 + (size_t)(k0 + wk) * ldw + n0 + wn);
        __syncthreads();
#pragma unroll
        for (int kk = 0; kk < 16; ++kk) {
            const float4 a = *(const float4*)&As[kk][ty * 4]; const float4 b = *(const float4*)&Ws[kk][tx * 4];
            const float aa[4] = {a.x, a.y, a.z, a.w}, bb[4] = {b.x, b.y, b.z, b.w};
#pragma unroll
            for (int i = 0; i < 4; ++i)
#pragma unroll
                for (int j = 0; j < 4; ++j) acc[i][j] += aa[i] * bb[j];
            if (DUAL) { const float4 b2 = *(const float4*)&Ws2[kk][tx * 4]; const float cc[4] = {b2.x, b2.y, b2.z, b2.w};
#pragma unroll
                for (int i = 0; i < 4; ++i)
#pragma unroll
                    for (int j = 0; j < 4; ++j) acc2[i][j] += aa[i] * cc[j]; }
        }
        __syncthreads();
    }
#pragma unroll
    for (int i = 0; i < 4; ++i) { const int r = r0 + ty * 4 + i; if (r < nrows) {
#pragma unroll
        for (int j = 0; j < 4; ++j) g.store(z, r, n0 + tx * 4 + j, acc[i][j], acc2[i][j]); } }
}

struct G_In {
    const bf16* A; const float* W; bf16 *Q, *Kb, *V, *U, *VG;
    __device__ bool setup(int, int& nrows, const float*& w, const float*& w2) const { nrows = NTOK; w = W; w2 = W; return true; }
    __device__ const bf16* arow(int, int r) const { return A + (size_t)r * D; }
    __device__ void store(int, int r, int n, float acc, float) const {
        if (n < 512) Q[(size_t)r * 512 + n] = f2bf(acc * QSCALE);
        else if (n < 1024) Kb[(size_t)r * 512 + n - 512] = f2bf(acc);
        else if (n < 1536) V[(size_t)r * 512 + n - 1024] = f2bf(acc);
        else if (n < 2048) U[(size_t)r * 512 + n - 1536] = f2bf(gelu_erf(acc));
        else VG[(size_t)r * 512 + n - 2048] = f2bf(gelu_erf(acc));
    }
};
struct G_Gate {
    const bf16* A; const float* W; const float* bias; bf16* GT;
    __device__ bool setup(int, int& nrows, const float*& w, const float*& w2) const { nrows = NTOK; w = W; w2 = W; return true; }
    __device__ const bf16* arow(int, int r) const { return A + (size_t)r * D; }
    __device__ void store(int, int r, int n, float acc, float) const { GT[(size_t)r * 2048 + n] = f2bf(sigmoidf_(acc + bias[n])); }
};
struct G_BrA {
    const bf16* YAB; const float* W; const bf16* GT; float* TMP;
    __device__ bool setup(int, int& nrows, const float*& w, const float*& w2) const { nrows = NTOK; w = W; w2 = W; return true; }
    __device__ const bf16* arow(int, int r) const { return YAB + (size_t)r * 1024; }
    __device__ void store(int, int r, int n, float acc, float) const { TMP[(size_t)r * 1024 + n] = bf2f(GT[(size_t)r * 2048 + n]) * acc; }
};
struct G_BrB {
    const bf16* YAB; const float* W; const bf16* GT; const float* TMP; bf16* MRG;
    __device__ bool setup(int, int& nrows, const float*& w, const float*& w2) const { nrows = NTOK; w = W; w2 = W; return true; }
    __device__ const bf16* arow(int, int r) const { return YAB + (size_t)r * 1024 + 512; }
    __device__ void store(int, int r, int n, float acc, float) const { MRG[(size_t)r * 1024 + n] = f2bf(TMP[(size_t)r * 1024 + n] + bf2f(GT[(size_t)r * 2048 + 1024 + n]) * acc); }
};
struct G_Out {
    const bf16* MRG; const float* W; bf16* Y1;
    __device__ bool setup(int, int& nrows, const float*& w, const float*& w2) const { nrows = NTOK; w = W; w2 = W; return true; }
    __device__ const bf16* arow(int, int r) const { return MRG + (size_t)r * 1024; }
    __device__ void store(int, int r, int n, float acc, float) const { Y1[(size_t)r * 1024 + n] = f2bf(acc); }
};
__device__ __forceinline__ int moe_rowbase(const unsigned* cnt, int e) { int s = 0; for (int i = 0; i < e; ++i) s += (int)((cnt[i] + 255u) / 256u) * 256; return s; }
struct G_MoeGU {
    const bf16* XN2; const float* Wgu; const float* bgu; const unsigned* cnt; const int* list; bf16* ACT;
    __device__ bool setup(int z, int& nrows, const float*& w, const float*& w2) const { nrows = (int)cnt[z]; w = Wgu + (size_t)z * D * 2048; w2 = w + 1024; return nrows > 0; }
    __device__ const bf16* arow(int z, int r) const { const int slot = list[(size_t)z * NTOK + r]; return XN2 + (size_t)(slot >> 2) * D; }
    __device__ void store(int z, int r, int n, float acc, float acc2) const {
        const float xg = fminf(acc + bgu[z * 2048 + n], SWL); const float xl = fminf(fmaxf(acc2 + bgu[z * 2048 + 1024 + n], -SWL), SWL);
        ACT[(size_t)(moe_rowbase(cnt, z) + r) * 1024 + n] = f2bf(xg * sigmoidf_(SWA * xg) * (xl + 1.0f));
    }
};
struct G_MoeDn {
    const bf16* ACT; const float* Wdn; const float* bdn; const unsigned* cnt; const int* list; const float* topg; bf16* Y2;
    __device__ bool setup(int z, int& nrows, const float*& w, const float*& w2) const { nrows = (int)cnt[z]; w = Wdn + (size_t)z * D * D; w2 = w; return nrows > 0; }
    __device__ const bf16* arow(int z, int r) const { return ACT + (size_t)(moe_rowbase(cnt, z) + r) * 1024; }
    __device__ void store(int z, int r, int n, float acc, float) const { const int slot = list[(size_t)z * NTOK + r]; Y2[(size_t)slot * 1024 + n] = f2bf((acc + bdn[z * 1024 + n]) * topg[slot]); }
};

__global__ __launch_bounds__(256) void nv_attn(const bf16* __restrict__ Q, const bf16* __restrict__ Kb, const bf16* __restrict__ V, const float* __restrict__ rel_bias, bf16* __restrict__ YAB) {
    const int gid = blockIdx.x * 256 + threadIdx.x, h = gid & 7, tok = gid >> 3, b = tok / SEQ, t = tok % SEQ, c = t / CHUNK, qi = t % CHUNK;
    float q[64], o[64];
    const uint4* qp = (const uint4*)(Q + (size_t)tok * 512 + h * 64);
#pragma unroll
    for (int i = 0; i < 8; ++i) { const uint4 w = qp[i]; const unsigned ww[4] = {w.x, w.y, w.z, w.w};
#pragma unroll
        for (int j = 0; j < 4; ++j) { q[i * 8 + 2 * j] = bf2f((bf16)(ww[j] & 0xffff)); q[i * 8 + 2 * j + 1] = bf2f((bf16)(ww[j] >> 16)); } }
#pragma unroll
    for (int d = 0; d < 64; ++d) o[d] = 0.f;
    float m = -1e30f, l = 0.f;
    for (int kj = 0; kj < BAND; ++kj) {
        const int kpos = (c - NLEFT) * CHUNK + kj; if (kpos < 0) continue;
        const size_t kr = ((size_t)(b * SEQ + kpos)) * 512 + h * 64;
        const uint4* kp = (const uint4*)(Kb + kr); float s = 0.f;
#pragma unroll
        for (int i = 0; i < 8; ++i) { const uint4 w = kp[i]; const unsigned ww[4] = {w.x, w.y, w.z, w.w};
#pragma unroll
            for (int j = 0; j < 4; ++j) { s += q[i * 8 + 2 * j] * bf2f((bf16)(ww[j] & 0xffff)); s += q[i * 8 + 2 * j + 1] * bf2f((bf16)(ww[j] >> 16)); } }
        int rel = NLEFT * CHUNK + qi - kj; rel = rel < -MAXREL ? -MAXREL : (rel > MAXREL ? MAXREL : rel);
        s += rel_bias[h * NREL + rel + MAXREL] * LOG2E;
        const float mn = fmaxf(m, s), alpha = exp2f(m - mn), p = exp2f(s - mn);
        l = l * alpha + p; m = mn;
        const uint4* vp = (const uint4*)(V + kr);
#pragma unroll
        for (int i = 0; i < 8; ++i) { const uint4 w = vp[i]; const unsigned ww[4] = {w.x, w.y, w.z, w.w};
#pragma unroll
            for (int j = 0; j < 4; ++j) { o[i * 8 + 2 * j] = o[i * 8 + 2 * j] * alpha + p * bf2f((bf16)(ww[j] & 0xffff)); o[i * 8 + 2 * j + 1] = o[i * 8 + 2 * j + 1] * alpha + p * bf2f((bf16)(ww[j] >> 16)); } }
    }
    const float inv = 1.0f / l;
    bf16* op = YAB + (size_t)tok * 1024 + h * 64;
#pragma unroll
    for (int d = 0; d < 64; d += 2) *(unsigned*)(op + d) = (unsigned)f2bf(o[d] * inv) | ((unsigned)f2bf(o[d + 1] * inv) << 16);
}

__global__ __launch_bounds__(256) void nv_sgu_ln(const bf16* __restrict__ VG, const float* __restrict__ ln_g, const float* __restrict__ ln_b, float* __restrict__ VN) {
    const int row = blockIdx.x * 4 + (threadIdx.x >> 6), lane = threadIdx.x & 63;
    const uint4 w = *(const uint4*)(VG + (size_t)row * 512 + lane * 8); const unsigned ww[4] = {w.x, w.y, w.z, w.w};
    float v[8]; float s = 0.f;
#pragma unroll
    for (int j = 0; j < 4; ++j) { v[2 * j] = bf2f((bf16)(ww[j] & 0xffff)); v[2 * j + 1] = bf2f((bf16)(ww[j] >> 16)); s += v[2 * j] + v[2 * j + 1]; }
    const float mu = wave_sum(s) * (1.0f / 512.0f); float q = 0.f;
#pragma unroll
    for (int j = 0; j < 8; ++j) { v[j] -= mu; q += v[j] * v[j]; }
    const float rstd = rsqrtf(wave_sum(q) * (1.0f / 512.0f) + EPS);
#pragma unroll
    for (int j = 0; j < 8; ++j) VN[(size_t)row * 512 + lane * 8 + j] = v[j] * rstd * ln_g[lane * 8 + j] + ln_b[lane * 8 + j];
}
__global__ __launch_bounds__(256) void nv_sgu(const float* __restrict__ VN, const bf16* __restrict__ U, const float* __restrict__ w_s, const float* __restrict__ b_s, bf16* __restrict__ YAB) {
    const int gid = blockIdx.x * 256 + threadIdx.x, c = gid & 511, tok = gid >> 9, tl = tok & 127, tb = tok - tl, g = c >> 6;
    float acc = b_s[g * 128 + tl];
    const float* wr = w_s + ((size_t)g * 128 + tl) * 128;
    for (int s = 0; s <= tl; ++s) acc += wr[s] * VN[(size_t)(tb + s) * 512 + c];
    YAB[(size_t)tok * 1024 + 512 + c] = f2bf(bf2f(U[(size_t)tok * 512 + c]) * acc);
}

__global__ __launch_bounds__(256) void nv_rowpass1(const float* __restrict__ x, const bf16* __restrict__ Y1, const float* __restrict__ mod, const float* __restrict__ g_post_mix,
                                                   const float* __restrict__ g_pre_ffn, const float* __restrict__ w_router, const float* __restrict__ b_router,
                                                   float* __restrict__ X1, bf16* __restrict__ XN2, int* __restrict__ tope, float* __restrict__ topg, unsigned* cnt, int* __restrict__ list) {
    const int row = blockIdx.x * 4 + (threadIdx.x >> 6), lane = threadIdx.x & 63, b = row / SEQ;
    const float* mb = mod + b * 6144;
    float xv[16], yv[16]; float ss = 0.f;
#pragma unroll
    for (int j = 0; j < 4; ++j) {
        const int c0 = (lane + 64 * j) * 4;
        const float4 xx = *(const float4*)(x + (size_t)row * D + c0); xv[4 * j] = xx.x; xv[4 * j + 1] = xx.y; xv[4 * j + 2] = xx.z; xv[4 * j + 3] = xx.w;
        const uint2 yy = *(const uint2*)(Y1 + (size_t)row * D + c0);
        yv[4 * j] = bf2f((bf16)(yy.x & 0xffff)); yv[4 * j + 1] = bf2f((bf16)(yy.x >> 16)); yv[4 * j + 2] = bf2f((bf16)(yy.y & 0xffff)); yv[4 * j + 3] = bf2f((bf16)(yy.y >> 16));
#pragma unroll
        for (int i = 0; i < 4; ++i) ss += yv[4 * j + i] * yv[4 * j + i];
    }
    const float rstd = rsqrtf(wave_sum(ss) * (1.0f / D) + EPS); float s2 = 0.f;
#pragma unroll
    for (int j = 0; j < 4; ++j) { const int c0 = (lane + 64 * j) * 4;
#pragma unroll
        for (int i = 0; i < 4; ++i) { const float x1 = xv[4 * j + i] + mb[GT1 + c0 + i] * (yv[4 * j + i] * rstd * g_post_mix[c0 + i]); xv[4 * j + i] = x1; s2 += x1 * x1; }
        *(float4*)(X1 + (size_t)row * D + c0) = make_float4(xv[4 * j], xv[4 * j + 1], xv[4 * j + 2], xv[4 * j + 3]); }
    const float rstd2 = rsqrtf(wave_sum(s2) * (1.0f / D) + EPS);
#pragma unroll
    for (int j = 0; j < 4; ++j) { const int c0 = (lane + 64 * j) * 4;
#pragma unroll
        for (int i = 0; i < 4; ++i) xv[4 * j + i] = xv[4 * j + i] * rstd2 * g_pre_ffn[c0 + i] * (1.0f + mb[SC2 + c0 + i]) + mb[SH2 + c0 + i];
        *(uint2*)(XN2 + (size_t)row * D + c0) = make_uint2((unsigned)f2bf(xv[4 * j]) | ((unsigned)f2bf(xv[4 * j + 1]) << 16), (unsigned)f2bf(xv[4 * j + 2]) | ((unsigned)f2bf(xv[4 * j + 3]) << 16)); }
    float mylogit = -1e30f;
    for (int e = 0; e < NEXP; ++e) {
        float p = 0.f;
#pragma unroll
        for (int j = 0; j < 4; ++j) { const int c0 = (lane + 64 * j) * 4;
#pragma unroll
            for (int i = 0; i < 4; ++i) p += xv[4 * j + i] * w_router[(size_t)(c0 + i) * NEXP + e]; }
        p = wave_sum(p) + b_router[e];
        if (lane == e) mylogit = p;
    }
    float tv[4]; int ti[4];
#pragma unroll
    for (int k = 0; k < 4; ++k) {
        float bv = mylogit; int bi = lane;
#pragma unroll
        for (int o = 1; o < 64; o <<= 1) { const float ov = __shfl_xor(bv, o); const int oi = __shfl_xor(bi, o); if (ov > bv || (ov == bv && oi < bi)) { bv = ov; bi = oi; } }
        tv[k] = bv; ti[k] = bi; if (lane == bi) mylogit = -3e38f;
    }
    if (lane == 0) {
        const float e0 = 1.0f, e1 = __expf(tv[1] - tv[0]), e2 = __expf(tv[2] - tv[0]), e3 = __expf(tv[3] - tv[0]); const float inv = 1.0f / (e0 + e1 + e2 + e3);
        const float gg[4] = {e0 * inv, e1 * inv, e2 * inv, e3 * inv};
#pragma unroll
        for (int k = 0; k < 4; ++k) { const int slot = row * 4 + k; tope[slot] = ti[k]; topg[slot] = gg[k]; const unsigned pos = atomicAdd(&cnt[ti[k]], 1u); list[(size_t)ti[k] * NTOK + pos] = slot; }
    }
}

__global__ __launch_bounds__(256) void nv_final(const bf16* __restrict__ Y2, const float* __restrict__ mod, const float* __restrict__ g_post_ffn, float* __restrict__ out) {
    const int row = blockIdx.x * 4 + (threadIdx.x >> 6), lane = threadIdx.x & 63, b = row / SEQ;
    const float* mb = mod + b * 6144;
    float yv[16]; float ss = 0.f;
#pragma unroll
    for (int j = 0; j < 4; ++j) { const int c0 = (lane + 64 * j) * 4; float a[4] = {0.f, 0.f, 0.f, 0.f};
#pragma unroll
        for (int k = 0; k < 4; ++k) { const uint2 yy = *(const uint2*)(Y2 + ((size_t)row * 4 + k) * D + c0);
            a[0] += bf2f((bf16)(yy.x & 0xffff)); a[1] += bf2f((bf16)(yy.x >> 16)); a[2] += bf2f((bf16)(yy.y & 0xffff)); a[3] += bf2f((bf16)(yy.y >> 16)); }
#pragma unroll
        for (int i = 0; i < 4; ++i) { yv[4 * j + i] = a[i]; ss += a[i] * a[i]; } }
    const float rstd = rsqrtf(wave_sum(ss) * (1.0f / D) + EPS);
#pragma unroll
    for (int j = 0; j < 4; ++j) { const int c0 = (lane + 64 * j) * 4; float4 xx = *(const float4*)(out + (size_t)row * D + c0);
        xx.x += mb[GT2 + c0] * (yv[4 * j] * rstd * g_post_ffn[c0]); xx.y += mb[GT2 + c0 + 1] * (yv[4 * j + 1] * rstd * g_post_ffn[c0 + 1]);
        xx.z += mb[GT2 + c0 + 2] * (yv[4 * j + 2] * rstd * g_post_ffn[c0 + 2]); xx.w += mb[GT2 + c0 + 3] * (yv[4 * j + 3] * rstd * g_post_ffn[c0 + 3]);
        *(float4*)(out + (size_t)row * D + c0) = xx; }
}

#define LAS __attribute__((address_space(3)))
#define GAS __attribute__((address_space(1)))
typedef short bf16x8 __attribute__((ext_vector_type(8)));
typedef short s16x4 __attribute__((ext_vector_type(4)));
typedef float f32x4 __attribute__((ext_vector_type(4)));
typedef float f32x2 __attribute__((ext_vector_type(2)));
typedef float f32x16 __attribute__((ext_vector_type(16)));
typedef unsigned u32x4 __attribute__((ext_vector_type(4)));
typedef unsigned u32x2 __attribute__((ext_vector_type(2)));
typedef __bf16 bf16x2_t __attribute__((ext_vector_type(2)));
constexpr int NWAVES = 8;
constexpr int TRASH_SLOT = NTOK * 4;

__device__ __forceinline__ unsigned cvtpk(float lo, float hi) { f32x2 v = {lo, hi}; bf16x2_t b = __builtin_convertvector(v, bf16x2_t); return __builtin_bit_cast(unsigned, b); }
__device__ __forceinline__ float wsum(float v) {
    v += __builtin_bit_cast(float, __builtin_amdgcn_update_dpp(0, __builtin_bit_cast(int, v), 0xB1, 0xF, 0xF, true));
    v += __builtin_bit_cast(float, __builtin_amdgcn_update_dpp(0, __builtin_bit_cast(int, v), 0x4E, 0xF, 0xF, true));
    v += __builtin_bit_cast(float, __builtin_amdgcn_update_dpp(0, __builtin_bit_cast(int, v), 0x124, 0xF, 0xF, true));
    v += __builtin_bit_cast(float, __builtin_amdgcn_update_dpp(0, __builtin_bit_cast(int, v), 0x128, 0xF, 0xF, true));
    const int iv = __builtin_bit_cast(int, v);
    const float s0 = __builtin_bit_cast(float, __builtin_amdgcn_readlane(iv, 0)), s1 = __builtin_bit_cast(float, __builtin_amdgcn_readlane(iv, 16));
    const float s2 = __builtin_bit_cast(float, __builtin_amdgcn_readlane(iv, 32)), s3 = __builtin_bit_cast(float, __builtin_amdgcn_readlane(iv, 48));
    return (s0 + s1) + (s2 + s3);
}
__device__ __forceinline__ float clamp8(float v) { return fminf(fmaxf(v, -448.0f), 448.0f); }
__device__ __forceinline__ unsigned pk_fp8x4(float a, float b, float c, float d) {
    int w = 0; w = __builtin_amdgcn_cvt_pk_fp8_f32(clamp8(a), clamp8(b), w, false); w = __builtin_amdgcn_cvt_pk_fp8_f32(clamp8(c), clamp8(d), w, true); return (unsigned)w; }
constexpr float F8_YSCALE = 16.0f;
constexpr size_t WS_X1B = 768 * MiB;
constexpr float F8_WSCALE = 64.0f, F8_ASCALE = 4.0f, F8_DESCALE = 1.0f / (64.0f * 4.0f);
__device__ __forceinline__ float bflo(unsigned w) { return __uint_as_float(w << 16); }
__device__ __forceinline__ float bfhi(unsigned w) { return __uint_as_float(w & 0xffff0000u); }
__device__ __forceinline__ float fast_sigmoid(float x) { return __builtin_amdgcn_rcpf(1.0f + __builtin_amdgcn_exp2f(-LOG2E * x)); }
__device__ __forceinline__ f32x2 sigmoid_pk(f32x2 v) { const f32x2 t = v * (-LOG2E); f32x2 e; e.x = __builtin_amdgcn_exp2f(t.x); e.y = __builtin_amdgcn_exp2f(t.y); const f32x2 d = e + 1.0f; f32x2 r; r.x = __builtin_amdgcn_rcpf(d.x); r.y = __builtin_amdgcn_rcpf(d.y); return r; }
__device__ __forceinline__ f32x2 gelu_pk(f32x2 v) {
    const f32x2 av = __builtin_elementwise_abs(v), d = av * 0.2316418882f + 1.0f;
    f32x2 t; t.x = __builtin_amdgcn_rcpf(d.x); t.y = __builtin_amdgcn_rcpf(d.y);
    f32x2 q = t * 0.5307027145f + (-0.7265760135f); q = q * t + 0.7107068705f; q = q * t + (-0.142248368f); q = q * t + 0.127414796f; q = q * t;
    const f32x2 s = (v * v) * (-0.72134752044f);
    f32x2 e; e.x = __builtin_amdgcn_exp2f(s.x); e.y = __builtin_amdgcn_exp2f(s.y);
    const f32x2 m = v * (q * e), r = v - m;
    f32x2 o; o.x = v.x < 0.f ? m.x : r.x; o.y = v.y < 0.f ? m.y : r.y; return o;
}

constexpr int RING_OFF = 0, RING_BYTES = 131072;
constexpr int GTAB_OFF = RING_BYTES, GTAB_UNITS = 20, GTAB_BYTES = GTAB_UNITS * 256 * 4;
constexpr int MISC_OFF = GTAB_OFF + GTAB_BYTES;
constexpr int LDS_BYTES = MISC_OFF + 512;
static_assert(LDS_BYTES <= 160 * 1024, "LDS map");

#define XB_TMO      128
#define XB_XCNT(j)  (256  + 64 * (j))
#define XB_XSUB(j)  (1280 + 64 * (j))
#define XB_XGEN(j)  (2304 + 64 * (j))
#define XB_TOP      3328
#define XB_TOPGEN   3392
#define XCD_BAR_WORDS 3456
#define XB_SPIN_CAP (1u << 18)
__device__ __forceinline__ unsigned xb_ld(unsigned* p)              { return __hip_atomic_load(p, __ATOMIC_RELAXED, __HIP_MEMORY_SCOPE_AGENT); }
__device__ __forceinline__ unsigned xb_add(unsigned* p, unsigned v) { return __hip_atomic_fetch_add(p, v, __ATOMIC_RELAXED, __HIP_MEMORY_SCOPE_AGENT); }
__device__ __forceinline__ unsigned xb_xcc_id() { return (unsigned)__builtin_amdgcn_s_getreg((3 << 11) | 20) & 0xFu; }
#define XB_SPIN(cond, bar) do { unsigned _sp = 0; while (cond) { __builtin_amdgcn_s_sleep(1); \
    if ((++_sp & 255u) == 0u) { if (xb_ld(&(bar)[XB_TMO])) break; if (_sp > XB_SPIN_CAP) { atomicAdd(&(bar)[XB_TMO], 1u); break; } } } } while (0)
struct XcdBarrier { unsigned* bar; unsigned x; volatile LAS unsigned* st; };
__device__ __forceinline__ XcdBarrier xcd_barrier_post(unsigned* bar, volatile LAS unsigned* st) {
    XcdBarrier b; b.bar = bar; b.x = xb_xcc_id(); b.st = st;
    if (threadIdx.x == 0) (void)xb_add(&bar[XB_XCNT(b.x)], 1u);
    return b;
}
__device__ __forceinline__ void xcd_barrier_complete(unsigned* bar, unsigned x, unsigned& nloc, unsigned& nx) {
    const unsigned G = gridDim.x * gridDim.y * gridDim.z;
    unsigned sum, cnt, mine, sp = 0u;
    for (;;) {
        sum = 0u; cnt = 0u; mine = 0u;
#pragma unroll
        for (unsigned j = 0; j < 16; ++j) { const unsigned c = xb_ld(&bar[XB_XCNT(j)]); sum += c; cnt += (c > 0u) ? 1u : 0u; mine = (j == x) ? c : mine; }
        if (sum == G) break;
        __builtin_amdgcn_s_sleep(1);
        if ((++sp & 255u) == 0u) { if (xb_ld(&bar[XB_TMO])) break; if (sp > XB_SPIN_CAP) { atomicAdd(&bar[XB_TMO], 1u); break; } }
    }
    nloc = mine > 0u ? mine : 1u; nx = cnt > 0u ? cnt : 1u;
}
__device__ __forceinline__ void xcd_barrier(const XcdBarrier& b) {
    asm volatile("s_waitcnt vmcnt(0)" ::: "memory");
    __syncthreads();
    if (threadIdx.x == 0) {
        unsigned* bar = b.bar;
        __builtin_amdgcn_s_waitcnt(0);
        unsigned nloc = b.st[0], nx = b.st[1];
        if (nloc == 0u) { xcd_barrier_complete(bar, b.x, nloc, nx); b.st[0] = nloc; b.st[1] = nx; }
        const unsigned old = xb_add(&bar[XB_XSUB(b.x)], 1u);
        const unsigned gen = old / nloc;
        if (old + 1u == (gen + 1u) * nloc) {
            __builtin_amdgcn_fence(__ATOMIC_RELEASE, "agent");
            asm volatile("s_waitcnt vmcnt(0)" ::: "memory");
            const unsigned og = xb_add(&bar[XB_TOP], 1u);
            const unsigned tg = og / nx;
            if (og + 1u == (tg + 1u) * nx) xb_add(&bar[XB_TOPGEN], 1u);
            else XB_SPIN(xb_ld(&bar[XB_TOPGEN]) == tg, bar);
            __builtin_amdgcn_fence(__ATOMIC_ACQUIRE, "agent");
            xb_add(&bar[XB_XGEN(b.x)], 1u);
            asm volatile("s_waitcnt vmcnt(0)" ::: "memory");
        } else {
            XB_SPIN(xb_ld(&bar[XB_XGEN(b.x)]) == gen, bar);
            __builtin_amdgcn_fence(__ATOMIC_ACQUIRE, "agent");
            asm volatile("s_waitcnt vmcnt(0)" ::: "memory");
        }
    }
    __syncthreads();
}
constexpr int CW_BAR = 4096;

namespace pg8 {
constexpr int BM = 256, BK = 64, HALF = 128, HTB = HALF * BK * 2, STAGE_BYTES = 8 * HTB, NXCD = 8, WGM = 8;
__host__ __device__ __forceinline__ int lds_byte(int r, int c) { return r * 128 + ((((c >> 3) ^ (r >> 1)) & 7) << 4); }
__host__ __device__ __forceinline__ void stage_rc(int b, int& R, int& C) { R = b >> 7; C = ((((b >> 4) ^ (R >> 1)) & 7) << 3); }
__host__ __device__ __forceinline__ int perm32(int rho) { const int n = rho >> 4, i = rho & 15; return 8 * (i >> 2) + 4 * n + (i & 3); }
struct Unit { int pm, pn, aux; };
typedef int v4i_t __attribute__((ext_vector_type(4)));
typedef int v8i_t __attribute__((ext_vector_type(8)));

__device__ __forceinline__ bool static_unit(int i, int G, int c, int nM, int nN, int& pm, int& pn) {
    const int nwg = nM * nN; const long L = (long)i * G + c; if (L >= nwg) return false;
    int wgid = (int)L; { const int q = nwg / NXCD, r = nwg % NXCD, xcd = wgid % NXCD, off = wgid / NXCD; wgid = (xcd < r ? xcd * (q + 1) : r * (q + 1) + (xcd - r) * q) + off; }
    const int nig = WGM * nN, gid = wgid / nig, fm = gid * WGM, gsz = (nM - fm) < WGM ? (nM - fm) : WGM;
    pm = fm + ((wgid % nig) % gsz); pn = (wgid % nig) / gsz; return true;
}

template <class Epi, class Sched, bool FP8>
__device__ __forceinline__ void gemm_phase(LAS unsigned char* lds, const Sched& S, const Epi& E, const int lda, const int ldb, const int nt, const int dbg_flags = 0) {
    const int tid = threadIdx.x, wid = __builtin_amdgcn_readfirstlane(tid >> 6), lane = tid & 63, wr = wid >> 2, wc = wid & 3, fr = lane & 15, fq = lane >> 4;
    int Rr[2], Cc[2]; unsigned voffB[2];
#pragma unroll
    for (int i = 0; i < 2; ++i) { stage_rc(tid * 16 + i * 8192, Rr[i], Cc[i]); const int Rb = (Rr[i] & ~31) + perm32(Rr[i] & 31); voffB[i] = (unsigned)(Rb * ldb + Cc[i] * 2); }
    const size_t kstep = (size_t)(BK * 2);
    const size_t hstepB = (size_t)HALF * ldb;
    const size_t hstepA = Sched::GATHER ? (size_t)0 : (size_t)HALF * lda;
    const unsigned ldsw = (unsigned)wid * 1024u;
    const int aoff = lds_byte(wr * 64 + fr, fq * 8), boff = lds_byte(wc * 32 + fr, fq * 8);
#define PG8_SA(b, h) (((b) * 2 + (h)) * HTB)
#define PG8_SB(b, h) ((4 + (b) * 2 + (h)) * HTB)
#define PG8_STAGE(bufoff, gbase, voff) do { _Pragma("unroll") for (int _i = 0; _i < 2; ++_i) \
        __builtin_amdgcn_global_load_lds((const unsigned*)((const char*)(gbase) + (voff)[_i]), (LAS unsigned*)(lds + (bufoff) + ldsw + _i * 8192), 16, 0, 0); } while (0)
#define PG8_LDA(dst, b, h) do { _Pragma("unroll") for (int m = 0; m < 4; ++m) _Pragma("unroll") for (int k = 0; k < 2; ++k) dst[m][k] = *(const LAS bf16x8*)(lds + PG8_SA(b, h) + (aoff ^ (k * 64)) + m * 2048); } while (0)
#define PG8_LDB(dst, b, h) do { _Pragma("unroll") for (int n = 0; n < 2; ++n) _Pragma("unroll") for (int k = 0; k < 2; ++k) dst[n][k] = *(const LAS bf16x8*)(lds + PG8_SB(b, h) + (boff ^ (k * 64)) + n * 2048); } while (0)
#define PG8_CAT(x) __builtin_shufflevector(__builtin_bit_cast(v4i_t, (x)[0]), __builtin_bit_cast(v4i_t, (x)[1]), 0, 1, 2, 3, 4, 5, 6, 7)
#define PG8_MMA(ai, bj, At, Bt) do { __builtin_amdgcn_s_setprio(1); if constexpr (FP8) { _Pragma("unroll") for (int m = 0; m < 4; ++m) _Pragma("unroll") for (int n = 0; n < 2; ++n) \
        acc[ai][bj][m][n] = __builtin_amdgcn_mfma_scale_f32_16x16x128_f8f6f4(PG8_CAT(Bt[n]), PG8_CAT(At[m]), acc[ai][bj][m][n], 0, 0, 0, 0x7F7F7F7F, 0, 0x7F7F7F7F); } \
    else { _Pragma("unroll") for (int m = 0; m < 4; ++m) _Pragma("unroll") for (int n = 0; n < 2; ++n) _Pragma("unroll") for (int k = 0; k < 2; ++k) \
        acc[ai][bj][m][n] = __builtin_amdgcn_mfma_f32_16x16x32_bf16(Bt[n][k], At[m][k], acc[ai][bj][m][n], 0, 0, 0); } __builtin_amdgcn_s_setprio(0); } while (0)
#define PG8_WAIT_V(n) asm volatile("s_waitcnt vmcnt(" #n ")" ::: "memory")
#define PG8_WAIT_L(n) asm volatile("s_waitcnt lgkmcnt(" #n ")" ::: "memory")
#define PG8_BAR __builtin_amdgcn_s_barrier()
#define PG8_SCHED __builtin_amdgcn_sched_barrier(0)
    Unit cur, nxt; int ui = 0;
    if (!S.next(0, cur)) return;
    f32x4 acc[2][2][4][2];
#pragma unroll
    for (int a = 0; a < 2; ++a)
#pragma unroll
        for (int b = 0; b < 2; ++b)
#pragma unroll
            for (int m = 0; m < 4; ++m)
#pragma unroll
                for (int n = 0; n < 2; ++n) acc[a][b][m][n] = (f32x4){0.f, 0.f, 0.f, 0.f};
    bf16x8 At[4][2], B0[2][2], B1[2][2];
    unsigned oA[2][2];
#pragma unroll
    for (int h = 0; h < 2; ++h)
#pragma unroll
        for (int i = 0; i < 2; ++i) oA[h][i] = Sched::GATHER ? (S.goff(0, h * HALF + Rr[i]) + (unsigned)Cc[i] * 2u) : (unsigned)(Rr[i] * lda + Cc[i] * 2);
    const char* cA = S.aptr(cur); const char* cB = S.bptr(cur);
    PG8_STAGE(PG8_SB(0, 0), cB, voffB); PG8_STAGE(PG8_SB(0, 1), cB + hstepB, voffB); PG8_STAGE(PG8_SA(0, 0), cA, oA[0]); PG8_STAGE(PG8_SA(0, 1), cA + hstepA, oA[1]);
    if (wr == 1) PG8_BAR;
    PG8_WAIT_V(2); PG8_BAR;
    PG8_STAGE(PG8_SB(1, 0), cB + kstep, voffB); PG8_STAGE(PG8_SA(1, 0), cA + kstep, oA[0]); PG8_STAGE(PG8_SB(1, 1), cB + hstepB + kstep, voffB);
    PG8_WAIT_V(6); PG8_BAR;
    for (;;) {
        const bool has_next = S.next(ui + 1, nxt);
        const char* nA = has_next ? S.aptr(nxt) : cA; const char* nB = has_next ? S.bptr(nxt) : cB;
#pragma clang loop unroll(disable)
        for (int t = 0; t < nt; t += 2) {
            const bool last = (t == nt - 2);
            const char* a1 = cA + (size_t)(t + 1) * kstep;
            const char* a2 = last ? nA : cA + (size_t)(t + 2) * kstep; const char* b2 = last ? nB : cB + (size_t)(t + 2) * kstep;
            const char* a3 = a2 + kstep; const char* b3 = b2 + kstep;
            PG8_LDB(B0, 0, 0); PG8_LDB(B1, 0, 1); PG8_SCHED; PG8_LDA(At, 0, 0); PG8_STAGE(PG8_SA(1, 1), a1 + hstepA, oA[1]);
            if constexpr (Sched::GATHER) { if (last && has_next) {
#pragma unroll
                for (int h = 0; h < 2; ++h)
#pragma unroll
                    for (int i = 0; i < 2; ++i) oA[h][i] = S.goff(ui + 1, h * HALF + Rr[i]) + (unsigned)Cc[i] * 2u; } }
            PG8_WAIT_V(8); PG8_WAIT_L(0); PG8_BAR; PG8_MMA(0, 0, At, B0); PG8_MMA(0, 1, At, B1); PG8_BAR; PG8_SCHED;
            PG8_LDA(At, 0, 1); PG8_STAGE(PG8_SB(0, 0), b2, voffB); PG8_STAGE(PG8_SB(0, 1), b2 + hstepB, voffB); PG8_STAGE(PG8_SA(0, 0), a2, oA[0]);
            PG8_WAIT_V(8); PG8_WAIT_L(0); PG8_BAR; PG8_MMA(1, 0, At, B0); PG8_MMA(1, 1, At, B1); PG8_BAR; PG8_SCHED;
            PG8_LDB(B0, 1, 0); PG8_LDB(B1, 1, 1); PG8_SCHED; PG8_LDA(At, 1, 0); PG8_STAGE(PG8_SA(0, 1), a2 + hstepA, oA[1]);
            PG8_WAIT_V(8); PG8_WAIT_L(0); PG8_BAR; PG8_MMA(0, 0, At, B0); PG8_MMA(0, 1, At, B1); PG8_BAR; PG8_SCHED;
            PG8_LDA(At, 1, 1); PG8_STAGE(PG8_SB(1, 0), b3, voffB); PG8_STAGE(PG8_SB(1, 1), b3 + hstepB, voffB); PG8_STAGE(PG8_SA(1, 0), a3, oA[0]);
            PG8_WAIT_V(8); PG8_WAIT_L(0); PG8_BAR; PG8_MMA(1, 0, At, B0); PG8_MMA(1, 1, At, B1); PG8_BAR; PG8_SCHED;
        }
        if (wr == 0) PG8_BAR;
        bool keep = false;
        {
            int tz = threadIdx.x; asm volatile("" : "+v"(tz)); const int ewid = tz >> 6, el = tz & 63, ewr = ewid >> 2, ewc = ewid & 3, efr = el & 15, efq = el >> 4;
            if constexpr (Sched::HAS_MID) { if (S.is_mid(cur)) { E.mid(acc, cur, ewr, ewc, efr, efq); keep = true; } }
            if (!keep && !(dbg_flags & 1)) E(acc, cur, ewr, ewc, efr, efq);
        }
        if (!has_next) break;
        if (!keep) {
#pragma unroll
            for (int a = 0; a < 2; ++a)
#pragma unroll
                for (int b = 0; b < 2; ++b)
#pragma unroll
                    for (int m = 0; m < 4; ++m)
#pragma unroll
                        for (int n = 0; n < 2; ++n) acc[a][b][m][n] = (f32x4){0.f, 0.f, 0.f, 0.f};
        }
        cur = nxt; cA = nA; cB = nB; ++ui;
        if (wr == 1) PG8_BAR;
    }
    PG8_WAIT_V(0);
    PG8_BAR;
#undef PG8_SA
#undef PG8_SB
#undef PG8_STAGE
#undef PG8_LDA
#undef PG8_LDB
#undef PG8_MMA
#undef PG8_CAT
#undef PG8_WAIT_V
#undef PG8_WAIT_L
#undef PG8_BAR
#undef PG8_SCHED
}
}
using pg8::Unit;

struct Args { const float* in[25]; float* out; unsigned char* ws; int ph_lo, ph_hi, rep_mask, pad; };
static_assert(sizeof(Args) == 27 * 8 + 16, "Args has no padding");
struct Frame {
    LAS unsigned char* lds; volatile LAS unsigned* MISC; unsigned* ctl;
    int tid, lane, wave, vcu, G;
};
#define LDS_WAIT() asm volatile("s_waitcnt lgkmcnt(0)" ::: "memory")
#define VM_WAIT() asm volatile("s_waitcnt vmcnt(0)" ::: "memory")

struct SchedStatic {
    static constexpr bool GATHER = false, HAS_MID = false;
    const char* A; const char* B; int nM, nN, G, c; size_t astep, bstep;
    __device__ __forceinline__ bool next(int i, Unit& u) const { u.aux = 0; return pg8::static_unit(i, G, c, nM, nN, u.pm, u.pn); }
    __device__ __forceinline__ const char* aptr(const Unit& u) const { return A + (size_t)u.pm * astep; }
    __device__ __forceinline__ const char* bptr(const Unit& u) const { return B + (size_t)u.pn * bstep; }
    __device__ __forceinline__ bool is_mid(const Unit&) const { return false; }
    __device__ __forceinline__ unsigned goff(int, int) const { return 0u; }
};
struct SchedSplit2 {
    static constexpr bool GATHER = false, HAS_MID = true;
    const char* A; const char* B; int nM, nN, G, c; size_t astep, bstep, khalf;
    __device__ __forceinline__ bool next(int i, Unit& u) const { u.aux = i & 1; return pg8::static_unit(i >> 1, G, c, nM, nN, u.pm, u.pn); }
    __device__ __forceinline__ const char* aptr(const Unit& u) const { return A + (size_t)u.pm * astep + (size_t)u.aux * khalf; }
    __device__ __forceinline__ const char* bptr(const Unit& u) const { return B + (size_t)u.pn * bstep + (size_t)u.aux * khalf; }
    __device__ __forceinline__ bool is_mid(const Unit& u) const { return u.aux == 0; }
    __device__ __forceinline__ unsigned goff(int, int) const { return 0u; }
};
__device__ __forceinline__ int moe_find_e(volatile LAS unsigned* MISC, int rb) { int e = 0;
#pragma unroll 1
    for (int i = 1; i < NEXP; ++i) e += ((int)MISC[i] <= rb) ? 1 : 0;
    return e; }
template <int NPN, bool GATH>
struct SchedMoe {
    static constexpr bool GATHER = GATH, HAS_MID = false;
    static constexpr int RPX = 32 / NPN;
    static constexpr int UT0 = 96, UTN = 24;
    const char* A; const char* B; volatile LAS unsigned* MISC; const LAS unsigned* gtab; int c, G, nrb; size_t bstep_e, bstep_n;
    __device__ __forceinline__ bool slow_next(int i, Unit& u) const {
        int rb, pn;
        if (G == 256) { const int x = c & 7, j = c >> 3; rb = (8 * i + x) * RPX + j / NPN; pn = j % NPN; }
        else { const long L = (long)i * G + c; rb = (int)(L / NPN); pn = (int)(L % NPN); }
        if (rb >= nrb) return false;
        u.pm = rb; u.pn = pn; u.aux = moe_find_e(MISC, rb); return true;
    }
    __device__ __forceinline__ void build(int tid) const {
        if (tid < UTN) { Unit u; const bool ok = slow_next(tid, u); MISC[UT0 + tid] = ok ? (0x80000000u | ((unsigned)u.aux << 16) | ((unsigned)u.pn << 12) | (unsigned)u.pm) : 0u; }
        __syncthreads();
    }
    __device__ __forceinline__ bool next(int i, Unit& u) const {
        if (i >= UTN) return false;
        const unsigned w = MISC[UT0 + i]; if (!(w >> 31)) return false;
        u.pm = (int)(w & 0xfffu); u.pn = (int)((w >> 12) & 0xfu); u.aux = (int)((w >> 16) & 0xffu); return true;
    }
    __device__ __forceinline__ const char* aptr(const Unit& u) const { return GATH ? A : A + (size_t)u.pm * (256 * 1024); }
    __device__ __forceinline__ const char* bptr(const Unit& u) const { return B + (size_t)u.aux * bstep_e + (size_t)u.pn * bstep_n; }
    __device__ __forceinline__ bool is_mid(const Unit&) const { return false; }
    __device__ __forceinline__ unsigned goff(int ui, int row) const { return gtab[ui * 256 + row]; }
};

#define EPI_ARGS f32x4 (&acc)[2][2][4][2], const Unit& u, int wr, int wc, int fr, int fq
struct EpiG1 {
    bf16 *Q, *K, *V, *U, *VG, *GT; const float* bgate;
    __device__ __forceinline__ void mid(EPI_ARGS) const {}
    __device__ __forceinline__ void operator()(EPI_ARGS) const {
        const int pn = u.pn; const int row0 = u.pm * 256 + wr * 64 + fr;
        if (pn < 6) {
            const int t = pn >> 1; bf16* base = Q + (size_t)t * ((WS_K - WS_Q) / 2); const float sc = (t == 0) ? QSCALE : 1.0f;    const int col0 = (pn & 1) * 256 + wc * 32 + 8 * fq;
#pragma unroll
            for (int ai = 0; ai < 2; ++ai)
#pragma unroll
                for (int m = 0; m < 4; ++m) { bf16* rowp = base + (size_t)(row0 + ai * 128 + m * 16) * 512 + col0;
#pragma unroll
                    for (int bj = 0; bj < 2; ++bj) { const f32x4 v0 = acc[ai][bj][m][0] * sc, v1 = acc[ai][bj][m][1] * sc;
                        u32x4 w; w.x = cvtpk(v0[0], v0[1]); w.y = cvtpk(v0[2], v0[3]); w.z = cvtpk(v1[0], v1[1]); w.w = cvtpk(v1[2], v1[3]); *(u32x4*)(rowp + bj * 128) = w; } }
        } else if (pn < 10) {
            bf16* base = Q + (size_t)(pn >> 1) * ((WS_K - WS_Q) / 2); const int col0 = (pn & 1) * 256 + wc * 32 + 8 * fq;
#pragma unroll
            for (int ai = 0; ai < 2; ++ai)
#pragma unroll
                for (int m = 0; m < 4; ++m) { bf16* rowp = base + (size_t)(row0 + ai * 128 + m * 16) * 512 + col0;
#pragma unroll
                    for (int bj = 0; bj < 2; ++bj) { const f32x4 v0 = acc[ai][bj][m][0], v1 = acc[ai][bj][m][1];
                        const f32x2 a = gelu_pk((f32x2){v0[0], v0[1]}), b = gelu_pk((f32x2){v0[2], v0[3]}), c = gelu_pk((f32x2){v1[0], v1[1]}), d = gelu_pk((f32x2){v1[2], v1[3]});
                        u32x4 w; w.x = cvtpk(a.x, a.y); w.y = cvtpk(b.x, b.y); w.z = cvtpk(c.x, c.y); w.w = cvtpk(d.x, d.y); *(u32x4*)(rowp + bj * 128) = w; } }
        } else {
            const int col0 = (pn - 10) * 256 + wc * 32 + 8 * fq;
            f32x4 bv[2][2];
#pragma unroll
            for (int bj = 0; bj < 2; ++bj)
#pragma unroll
                for (int n = 0; n < 2; ++n) bv[bj][n] = *(const f32x4*)(bgate + col0 + bj * 128 + 4 * n);
#pragma unroll
            for (int ai = 0; ai < 2; ++ai)
#pragma unroll
                for (int m = 0; m < 4; ++m) { bf16* rowp = GT + (size_t)(row0 + ai * 128 + m * 16) * 2048 + col0;
#pragma unroll
                    for (int bj = 0; bj < 2; ++bj) { const f32x4 v0 = acc[ai][bj][m][0] + bv[bj][0], v1 = acc[ai][bj][m][1] + bv[bj][1];
                        const f32x2 a = sigmoid_pk((f32x2){v0[0], v0[1]}), b = sigmoid_pk((f32x2){v0[2], v0[3]}), c = sigmoid_pk((f32x2){v1[0], v1[1]}), d = sigmoid_pk((f32x2){v1[2], v1[3]});
                        u32x4 w; w.x = cvtpk(a.x, a.y); w.y = cvtpk(b.x, b.y); w.z = cvtpk(c.x, c.y); w.w = cvtpk(d.x, d.y); *(u32x4*)(rowp + bj * 128) = w; } }
        }
    }
};
struct EpiG2 {
    const bf16* GT; bf16* MRG;
    __device__ __forceinline__ void mid(EPI_ARGS) const {
        const int row0 = u.pm * 256 + wr * 64 + fr, col0 = u.pn * 256 + wc * 32 + 8 * fq;
#pragma unroll
        for (int ai = 0; ai < 2; ++ai)
#pragma unroll
            for (int m = 0; m < 4; ++m) { const bf16* gp = GT + (size_t)(row0 + ai * 128 + m * 16) * 2048 + col0;
#pragma unroll
                for (int bj = 0; bj < 2; ++bj) { const u32x4 ga = *(const u32x4*)(gp + bj * 128), gb = *(const u32x4*)(gp + 1024 + bj * 128);
                    f32x4 r0, r1;
                    r0[0] = bflo(ga.x) * __builtin_amdgcn_rcpf(fmaxf(bflo(gb.x), 1e-30f)); r0[1] = bfhi(ga.x) * __builtin_amdgcn_rcpf(fmaxf(bfhi(gb.x), 1e-30f));
                    r0[2] = bflo(ga.y) * __builtin_amdgcn_rcpf(fmaxf(bflo(gb.y), 1e-30f)); r0[3] = bfhi(ga.y) * __builtin_amdgcn_rcpf(fmaxf(bfhi(gb.y), 1e-30f));
                    r1[0] = bflo(ga.z) * __builtin_amdgcn_rcpf(fmaxf(bflo(gb.z), 1e-30f)); r1[1] = bfhi(ga.z) * __builtin_amdgcn_rcpf(fmaxf(bfhi(gb.z), 1e-30f));
                    r1[2] = bflo(ga.w) * __builtin_amdgcn_rcpf(fmaxf(bflo(gb.w), 1e-30f)); r1[3] = bfhi(ga.w) * __builtin_amdgcn_rcpf(fmaxf(bfhi(gb.w), 1e-30f));
                    acc[ai][bj][m][0] *= r0; acc[ai][bj][m][1] *= r1; } }
    }
    __device__ __forceinline__ void operator()(EPI_ARGS) const {
        const int row0 = u.pm * 256 + wr * 64 + fr, col0 = u.pn * 256 + wc * 32 + 8 * fq;
#pragma unroll
        for (int ai = 0; ai < 2; ++ai)
#pragma unroll
            for (int m = 0; m < 4; ++m) { const size_t r = (size_t)(row0 + ai * 128 + m * 16); const bf16* gp = GT + r * 2048 + 1024 + col0; bf16* op = MRG + r * 1024 + col0;
#pragma unroll
                for (int bj = 0; bj < 2; ++bj) { const u32x4 gb = *(const u32x4*)(gp + bj * 128); const f32x4 v0 = acc[ai][bj][m][0], v1 = acc[ai][bj][m][1];
                    u32x4 w; w.x = cvtpk(v0[0] * bflo(gb.x), v0[1] * bfhi(gb.x)); w.y = cvtpk(v0[2] * bflo(gb.y), v0[3] * bfhi(gb.y));
                    w.z = cvtpk(v1[0] * bflo(gb.z), v1[1] * bfhi(gb.z)); w.w = cvtpk(v1[2] * bflo(gb.w), v1[3] * bfhi(gb.w)); *(u32x4*)(op + bj * 128) = w; } }
    }
};
struct EpiPlain {
    bf16* O;
    __device__ __forceinline__ void mid(EPI_ARGS) const {}
    __device__ __forceinline__ void operator()(EPI_ARGS) const {
        const int row0 = u.pm * 256 + wr * 64 + fr, col0 = u.pn * 256 + wc * 32 + 8 * fq;
#pragma unroll
        for (int ai = 0; ai < 2; ++ai)
#pragma unroll
            for (int m = 0; m < 4; ++m) { bf16* op = O + (size_t)(row0 + ai * 128 + m * 16) * 1024 + col0;
#pragma unroll
                for (int bj = 0; bj < 2; ++bj) { const f32x4 v0 = acc[ai][bj][m][0], v1 = acc[ai][bj][m][1];
                    u32x4 w; w.x = cvtpk(v0[0], v0[1]); w.y = cvtpk(v0[2], v0[3]); w.z = cvtpk(v1[0], v1[1]); w.w = cvtpk(v1[2], v1[3]); *(u32x4*)(op + bj * 128) = w; } }
    }
};
struct EpiAct {
    const float* bgu; unsigned char* ACT8;
    __device__ __forceinline__ void mid(EPI_ARGS) const {}
    __device__ __forceinline__ f32x2 act2(f32x2 g, f32x2 l) const {
        f32x2 xg, xl; xg.x = fminf(g.x, SWL); xg.y = fminf(g.y, SWL); xl.x = fminf(fmaxf(l.x, -SWL), SWL); xl.y = fminf(fmaxf(l.y, -SWL), SWL);
        const f32x2 t = xg * (-SWA * LOG2E); f32x2 e; e.x = __builtin_amdgcn_exp2f(t.x); e.y = __builtin_amdgcn_exp2f(t.y);
        const f32x2 d = e + 1.0f; f32x2 r; r.x = __builtin_amdgcn_rcpf(d.x); r.y = __builtin_amdgcn_rcpf(d.y);
        return (xg * r) * (xl * F8_ASCALE + F8_ASCALE);
    }
    __device__ __forceinline__ void operator()(EPI_ARGS) const {
        const int e = u.aux; const int row0 = u.pm * 256 + wr * 64 + fr, col0 = u.pn * 128 + wc * 32 + 8 * fq;
        const float* bp = bgu + (size_t)e * 2048 + col0;
        const f32x4 bg0 = *(const f32x4*)(bp), bg1 = *(const f32x4*)(bp + 4), bl0 = *(const f32x4*)(bp + 1024), bl1 = *(const f32x4*)(bp + 1028);
#pragma unroll
        for (int ai = 0; ai < 2; ++ai)
#pragma unroll
            for (int m = 0; m < 4; ++m) {
                const f32x4 g0 = acc[ai][0][m][0] * F8_DESCALE + bg0, g1 = acc[ai][0][m][1] * F8_DESCALE + bg1, l0 = acc[ai][1][m][0] * F8_DESCALE + bl0, l1 = acc[ai][1][m][1] * F8_DESCALE + bl1;
                const f32x2 o0 = act2((f32x2){g0[0], g0[1]}, (f32x2){l0[0], l0[1]}), o1 = act2((f32x2){g0[2], g0[3]}, (f32x2){l0[2], l0[3]});
                const f32x2 o2 = act2((f32x2){g1[0], g1[1]}, (f32x2){l1[0], l1[1]}), o3 = act2((f32x2){g1[2], g1[3]}, (f32x2){l1[2], l1[3]});
                u32x2 w; w.x = pk_fp8x4(o0.x, o0.y, o1.x, o1.y); w.y = pk_fp8x4(o2.x, o2.y, o3.x, o3.y);
                *(u32x2*)(ACT8 + (size_t)(row0 + ai * 128 + m * 16) * 1024 + col0) = w; }
    }
};
struct EpiDown {
    const float* bdn; unsigned char* Y2s;
    __device__ __forceinline__ void mid(EPI_ARGS) const {}
    __device__ __forceinline__ void operator()(EPI_ARGS) const {
        const int e = u.aux; const int row0 = u.pm * 256 + wr * 64 + fr, col0 = u.pn * 256 + wc * 32 + 8 * fq;
        f32x4 bv[2][2];
#pragma unroll
        for (int bj = 0; bj < 2; ++bj)
#pragma unroll
            for (int n = 0; n < 2; ++n) bv[bj][n] = *(const f32x4*)(bdn + (size_t)e * 1024 + col0 + bj * 128 + 4 * n) * F8_YSCALE;
#pragma unroll
        for (int ai = 0; ai < 2; ++ai)
#pragma unroll
            for (int m = 0; m < 4; ++m) { unsigned char* op = Y2s + (size_t)(row0 + ai * 128 + m * 16) * 1024 + col0;
#pragma unroll
                for (int bj = 0; bj < 2; ++bj) { const f32x4 v0 = acc[ai][bj][m][0] * (F8_DESCALE * F8_YSCALE) + bv[bj][0], v1 = acc[ai][bj][m][1] * (F8_DESCALE * F8_YSCALE) + bv[bj][1];
                    u32x2 w; w.x = pk_fp8x4(v0[0], v0[1], v0[2], v0[3]); w.y = pk_fp8x4(v1[0], v1[1], v1[2], v1[3]); *(u32x2*)(op + bj * 128) = w; } }
    }
};

struct WItem { const float* W; unsigned char* dst; int N, k0, n0, ldt, drow, dk0, fp8; };
__device__ __forceinline__ WItem witem_decode(const Args& a, int r) {
    unsigned char* ws = a.ws; WItem it;
    constexpr int I_IN = 8 * 80, I_GATE = 8 * 64, I_BR = 4 * 32, I_OUT = 8 * 32, I_GU = 8 * 64, I_DN = 8 * 32;
    it.fp8 = 0; it.dk0 = 0; it.ldt = 2048;
    if (r < I_IN) { it.W = a.in[6]; it.N = INW; it.k0 = 128 * (r / 80); it.n0 = 32 * (r % 80); it.dst = ws + WS_W1T; it.drow = it.n0; return it; } r -= I_IN;
    if (r < I_GATE) { it.W = a.in[14]; it.N = 2048; it.k0 = 128 * (r / 64); it.n0 = 32 * (r % 64); it.dst = ws + WS_W1T; it.drow = INW + it.n0; return it; } r -= I_GATE;
    if (r < I_BR) { it.W = a.in[12]; it.N = 1024; it.k0 = 128 * (r / 32); it.n0 = 32 * (r % 32); it.dst = ws + WS_WBRT; it.drow = it.n0; return it; } r -= I_BR;
    if (r < I_BR) { it.W = a.in[13]; it.N = 1024; it.k0 = 128 * (r / 32); it.n0 = 32 * (r % 32); it.dst = ws + WS_WBRT; it.drow = it.n0; it.dk0 = 512; return it; } r -= I_BR;
    if (r < I_OUT) { it.W = a.in[16]; it.N = 1024; it.k0 = 128 * (r / 32); it.n0 = 32 * (r % 32); it.dst = ws + WS_WOUTT; it.drow = it.n0; return it; } r -= I_OUT;
    it.fp8 = 1; it.ldt = 1024;
    if (r < NEXP * I_GU) { const int e = r / I_GU, q = r % I_GU; it.W = a.in[21] + (size_t)e * D * 2048; it.N = 2048; it.k0 = 128 * (q / 64); it.n0 = 32 * (q % 64); it.dst = ws + WS_WGUT + (size_t)e * 2048 * 1024;
        const int m0 = it.n0 & 1023; it.drow = 256 * (m0 >> 7) + (m0 & 127) + (it.n0 >= 1024 ? 128 : 0); return it; }
    r -= NEXP * I_GU;
    { const int e = r / I_DN, q = r % I_DN; it.W = a.in[23] + (size_t)e * D * D; it.N = 1024; it.k0 = 128 * (q / 32); it.n0 = 32 * (q % 32); it.dst = ws + WS_WDNT + (size_t)e * 1024 * 1024; it.drow = it.n0; }
    return it;
}
constexpr int W_NITEMS = 8 * 80 + 8 * 64 + 2 * 4 * 32 + 8 * 32 + NEXP * (8 * 64 + 8 * 32);
__device__ __forceinline__ void witem_load(const WItem& it, float (&v)[64], int lane) {
    const float* p = it.W + (size_t)(it.k0 + (lane >> 3)) * it.N + it.n0 + (lane & 7) * 4;
#pragma unroll
    for (int i = 0; i < 16; ++i) { const f32x4 t = __builtin_nontemporal_load((const f32x4*)(p + (size_t)(8 * i) * it.N)); v[4 * i] = t[0]; v[4 * i + 1] = t[1]; v[4 * i + 2] = t[2]; v[4 * i + 3] = t[3]; }
}
__device__ __forceinline__ void witem_store(const WItem& it, const float (&v)[64], LAS float* scr, int lane) {
#pragma unroll
    for (int i = 0; i < 16; ++i) { const int k = 8 * i + (lane >> 3); *(LAS f32x4*)(scr + k * 32 + (((lane & 7) * 4 + 4 * (i >> 1)) & 31)) = (f32x4){v[4 * i], v[4 * i + 1], v[4 * i + 2], v[4 * i + 3]}; }
    LDS_WAIT(); asm volatile("" ::: "memory");
    const int c = lane & 7;
#pragma unroll
    for (int j = 0; j < 4; ++j) { const int n = (lane >> 3) + 8 * j; const LAS float* s = scr + (16 * c) * 32 + ((n + 4 * c) & 31);
        float x[16];
#pragma unroll
        for (int q = 0; q < 16; ++q) x[q] = s[q * 32];
        unsigned char* d = it.dst + (size_t)(it.drow + n) * it.ldt;
        if (it.fp8) { u32x4 o;
            o.x = pk_fp8x4(x[0] * F8_WSCALE, x[1] * F8_WSCALE, x[2] * F8_WSCALE, x[3] * F8_WSCALE); o.y = pk_fp8x4(x[4] * F8_WSCALE, x[5] * F8_WSCALE, x[6] * F8_WSCALE, x[7] * F8_WSCALE);
            o.z = pk_fp8x4(x[8] * F8_WSCALE, x[9] * F8_WSCALE, x[10] * F8_WSCALE, x[11] * F8_WSCALE); o.w = pk_fp8x4(x[12] * F8_WSCALE, x[13] * F8_WSCALE, x[14] * F8_WSCALE, x[15] * F8_WSCALE);
            *(u32x4*)(d + it.dk0 + it.k0 + 16 * c) = o; }
        else { u32x4 o0, o1;
            o0.x = cvtpk(x[0], x[1]); o0.y = cvtpk(x[2], x[3]); o0.z = cvtpk(x[4], x[5]); o0.w = cvtpk(x[6], x[7]); o1.x = cvtpk(x[8], x[9]); o1.y = cvtpk(x[10], x[11]); o1.z = cvtpk(x[12], x[13]); o1.w = cvtpk(x[14], x[15]);
            *(u32x4*)(d + (size_t)(it.dk0 + it.k0 + 16 * c) * 2) = o0; *(u32x4*)(d + (size_t)(it.dk0 + it.k0 + 16 * c) * 2 + 16) = o1; } }
    LDS_WAIT(); asm volatile("" ::: "memory");
}
__device__ __forceinline__ void phaseA(const Frame& F, const Args& a) {
    unsigned char* ws = a.ws;
    if (F.vcu < 192) {
        const float* c = a.in[1]; const float* w_ada = a.in[2]; const float* b_ada = a.in[3]; float* mod = (float*)(ws + WS_MOD);
        LAS float* red = (LAS float*)(F.lds);
        const int col = F.vcu * 32 + (F.tid & 31), ks = F.tid >> 5;
        float a0 = 0.f, a1 = 0.f, a2 = 0.f, a3 = 0.f;
        for (int k = ks * 64; k < ks * 64 + 64; ++k) { const float w = w_ada[(size_t)k * 6144 + col];
            const float c0 = c[k], c1 = c[D + k], c2 = c[2 * D + k], c3 = c[3 * D + k];
            a0 += c0 * __builtin_amdgcn_rcpf(1.0f + __expf(-c0)) * w; a1 += c1 * __builtin_amdgcn_rcpf(1.0f + __expf(-c1)) * w;
            a2 += c2 * __builtin_amdgcn_rcpf(1.0f + __expf(-c2)) * w; a3 += c3 * __builtin_amdgcn_rcpf(1.0f + __expf(-c3)) * w; }
        red[(ks * 4 + 0) * 32 + (F.tid & 31)] = a0; red[(ks * 4 + 1) * 32 + (F.tid & 31)] = a1; red[(ks * 4 + 2) * 32 + (F.tid & 31)] = a2; red[(ks * 4 + 3) * 32 + (F.tid & 31)] = a3;
        __syncthreads();
        if (F.tid < 128) { const int b = F.tid >> 5, cc = F.tid & 31; float s = 0.f;
#pragma unroll
            for (int k = 0; k < 16; ++k) s += red[(k * 4 + b) * 32 + cc];
            mod[b * 6144 + F.vcu * 32 + cc] = s + b_ada[F.vcu * 32 + cc]; }
        __syncthreads();
    }
    if (F.vcu == 192 % F.G) {
        const float* w_router = a.in[19]; bf16* wrt = (bf16*)(ws + WS_WRT);
        for (int i = F.tid; i < D * NEXP; i += NWAVES * 64) { const int k = i >> 5, e = i & 31; const float w = w_router[i]; const unsigned hh = cvtpk(w, 0.f) & 0xffffu;
            wrt[(size_t)e * D + k] = (bf16)hh; wrt[(size_t)(NEXP + e) * D + k] = (bf16)(cvtpk(w - bflo(hh), 0.f) & 0xffffu); }
    }
    LAS float* scr = (LAS float*)(F.lds + F.wave * 17408);
    const int gw = F.vcu * NWAVES + F.wave, NGW = F.G * NWAVES;
    if (gw < W_NITEMS) {
        float va[64], vb[64];
        WItem ia = witem_decode(a, gw), ib = ia;
        witem_load(ia, va, F.lane);
        for (int it = gw; it < W_NITEMS; it += 2 * NGW) {
            const bool hb = (it + NGW < W_NITEMS);
            ib = witem_decode(a, hb ? it + NGW : it); witem_load(ib, vb, F.lane);
            witem_store(ia, va, scr, F.lane);
            if (!hb) break;
            const bool ha = (it + 2 * NGW < W_NITEMS);
            ia = witem_decode(a, ha ? it + 2 * NGW : it); witem_load(ia, va, F.lane);
            witem_store(ib, vb, scr, F.lane);
            if (!ha) break;
        }
    }
}
__device__ __forceinline__ void phaseB(const Frame& F, const Args& a) {
    const float* x = a.in[0]; const float* g = a.in[4]; const float* mod = (const float*)(a.ws + WS_MOD); bf16* xn = (bf16*)(a.ws + WS_XN);
    const int gw = F.vcu * NWAVES + F.wave, NGW = F.G * NWAVES;
    f32x4 cg[4], csh[4]; int cb = -1;
    for (int row0 = gw * 4; row0 < NTOK; row0 += NGW * 4) {
        f32x4 v[4][4];
#pragma unroll
        for (int rr = 0; rr < 4; ++rr)
#pragma unroll
            for (int j = 0; j < 4; ++j) v[rr][j] = __builtin_nontemporal_load((const f32x4*)(x + (size_t)(row0 + rr) * D) + F.lane + 64 * j);
        const int b = row0 / SEQ; const float* mb = mod + b * 6144;
        if (b != cb) { cb = b;
#pragma unroll
            for (int j = 0; j < 4; ++j) { const int c0 = (F.lane + 64 * j) * 4; cg[j] = *(const f32x4*)(g + c0) * (*(const f32x4*)(mb + SC1 + c0) + 1.0f); csh[j] = *(const f32x4*)(mb + SH1 + c0); } }
#pragma unroll
        for (int rr = 0; rr < 4; ++rr) {
            float ss = 0.f;
#pragma unroll
            for (int j = 0; j < 4; ++j) ss += (v[rr][j].x * v[rr][j].x + v[rr][j].y * v[rr][j].y) + (v[rr][j].z * v[rr][j].z + v[rr][j].w * v[rr][j].w);
            const float rstd = rsqrtf(wsum(ss) * (1.0f / D) + EPS);
            u32x2* o8 = (u32x2*)(xn + (size_t)(row0 + rr) * D) + F.lane;
#pragma unroll
            for (int j = 0; j < 4; ++j) {
                const f32x4 h = v[rr][j] * rstd * cg[j] + csh[j];
                u32x2 w; w.x = cvtpk(h[0], h[1]); w.y = cvtpk(h[2], h[3]); o8[64 * j] = w; }
        }
    }
}

constexpr int SGU_STRIDE = 1088;
__device__ __forceinline__ s16x4 vtr(const LAS unsigned char* p) { typedef short v4i16_t __attribute__((ext_vector_type(4))); return __builtin_bit_cast(s16x4, __builtin_amdgcn_ds_read_tr16_b64_v4i16((LAS v4i16_t*)p)); }
__device__ __forceinline__ void sgu_unit(const Frame& F, const Args& a, int b, int blk) {
    const bf16* VG = (const bf16*)(a.ws + WS_VG); const bf16* U = (const bf16*)(a.ws + WS_U); bf16* YAB = (bf16*)(a.ws + WS_YAB);
    const float* ln_g = a.in[8]; const float* ln_b = a.in[9]; const float* w_s = a.in[10]; const float* b_s = a.in[11];
    const int tok0 = b * SEQ + blk * SGB, lane = F.lane;
    {
        const f32x4 g0 = *(const f32x4*)(ln_g + lane * 8), g1 = *(const f32x4*)(ln_g + lane * 8 + 4), b0 = *(const f32x4*)(ln_b + lane * 8), b1 = *(const f32x4*)(ln_b + lane * 8 + 4);
#pragma unroll 1
        for (int r4 = 0; r4 < 16; r4 += 4) {
            u32x4 w[4];
#pragma unroll
            for (int rr = 0; rr < 4; ++rr) w[rr] = *(const u32x4*)(VG + (size_t)(tok0 + F.wave * 16 + r4 + rr) * 512 + lane * 8);
#pragma unroll
            for (int rr = 0; rr < 4; ++rr) { const int row = F.wave * 16 + r4 + rr;
                f32x4 v0 = {bflo(w[rr].x), bfhi(w[rr].x), bflo(w[rr].y), bfhi(w[rr].y)}, v1 = {bflo(w[rr].z), bfhi(w[rr].z), bflo(w[rr].w), bfhi(w[rr].w)};
                const float mu = wsum((v0[0] + v0[1]) + (v0[2] + v0[3]) + (v1[0] + v1[1]) + (v1[2] + v1[3])) * (1.0f / 512.0f);
                v0 -= mu; v1 -= mu;
                const float var = wsum((v0[0] * v0[0] + v0[1] * v0[1]) + (v0[2] * v0[2] + v0[3] * v0[3]) + (v1[0] * v1[0] + v1[1] * v1[1]) + (v1[2] * v1[2] + v1[3] * v1[3])) * (1.0f / 512.0f);
                const float rstd = rsqrtf(var + EPS);
                v0 = v0 * rstd * g0 + b0; v1 = v1 * rstd * g1 + b1;
                u32x4 o; o.x = cvtpk(v0[0], v0[1]); o.y = cvtpk(v0[2], v0[3]); o.z = cvtpk(v1[0], v1[1]); o.w = cvtpk(v1[2], v1[3]);
                *(LAS u32x4*)(F.lds + row * SGU_STRIDE + lane * 16) = o; }
        }
    }
    __syncthreads();
    {
        const int g = F.wave, r32 = lane & 31, hi = lane >> 5, i16 = lane & 15, g16 = (lane >> 4) & 1;
        const LAS unsigned char* vb = F.lds + (8 * hi + (i16 >> 2)) * SGU_STRIDE + (g * 64 + 16 * g16 + 4 * (i16 & 3)) * 2;
#pragma unroll
        for (int tb = 0; tb < 4; ++tb) {
            const int t = 32 * tb + r32; const float* wrow = w_s + ((size_t)g * 128 + t) * 128;
            f32x4 wr0[8], wr1[8];
#pragma unroll
            for (int ks = 0; ks < 2 * tb + 2; ++ks) { wr0[ks] = *(const f32x4*)(wrow + 16 * ks + 8 * hi); wr1[ks] = *(const f32x4*)(wrow + 16 * ks + 8 * hi + 4); }
            const float bs = b_s[g * 128 + t];
            const bf16* up = U + (size_t)(tok0 + t) * 512 + g * 64 + 4 * hi;
            u32x2 uu0[4], uu1[4];
#pragma unroll
            for (int gg = 0; gg < 4; ++gg) { uu0[gg] = *(const u32x2*)(up + 8 * gg); uu1[gg] = *(const u32x2*)(up + 32 + 8 * gg); }
            f32x16 a0, a1;
#pragma unroll
            for (int r = 0; r < 16; ++r) { a0[r] = 0.f; a1[r] = 0.f; }
#pragma unroll
            for (int ks = 0; ks < 2 * tb + 2; ++ks) {
                const int s0 = 16 * ks + 8 * hi;
                float wv[8] = {wr0[ks][0], wr0[ks][1], wr0[ks][2], wr0[ks][3], wr1[ks][0], wr1[ks][1], wr1[ks][2], wr1[ks][3]};
                if (ks >= 2 * tb) {
#pragma unroll
                    for (int j = 0; j < 8; ++j) wv[j] = (s0 + j <= t) ? wv[j] : 0.f; }
                u32x4 bw; bw.x = cvtpk(wv[0], wv[1]); bw.y = cvtpk(wv[2], wv[3]); bw.z = cvtpk(wv[4], wv[5]); bw.w = cvtpk(wv[6], wv[7]);
                const bf16x8 bfrag = __builtin_bit_cast(bf16x8, bw);
                const LAS unsigned char* p = vb + ks * 16 * SGU_STRIDE;
                const s16x4 l0 = vtr(p), h0 = vtr(p + 4 * SGU_STRIDE), l1 = vtr(p + 64), h1 = vtr(p + 4 * SGU_STRIDE + 64);
                const bf16x8 A0 = {l0[0], l0[1], l0[2], l0[3], h0[0], h0[1], h0[2], h0[3]}, A1 = {l1[0], l1[1], l1[2], l1[3], h1[0], h1[1], h1[2], h1[3]};
                a0 = __builtin_amdgcn_mfma_f32_32x32x16_bf16(A0, bfrag, a0, 0, 0, 0);
                a1 = __builtin_amdgcn_mfma_f32_32x32x16_bf16(A1, bfrag, a1, 0, 0, 0);
            }
            bf16* op = YAB + (size_t)(tok0 + t) * 1024 + 512 + g * 64 + 4 * hi;
#pragma unroll
            for (int gg = 0; gg < 4; ++gg) {
                u32x2 o0, o1;
                o0.x = cvtpk(bflo(uu0[gg].x) * (a0[4 * gg] + bs), bfhi(uu0[gg].x) * (a0[4 * gg + 1] + bs)); o0.y = cvtpk(bflo(uu0[gg].y) * (a0[4 * gg + 2] + bs), bfhi(uu0[gg].y) * (a0[4 * gg + 3] + bs));
                o1.x = cvtpk(bflo(uu1[gg].x) * (a1[4 * gg] + bs), bfhi(uu1[gg].x) * (a1[4 * gg + 1] + bs)); o1.y = cvtpk(bflo(uu1[gg].y) * (a1[4 * gg + 2] + bs), bfhi(uu1[gg].y) * (a1[4 * gg + 3] + bs));
                *(u32x2*)(op + 8 * gg) = o0; *(u32x2*)(op + 32 + 8 * gg) = o1; }
        }
    }
    __syncthreads();
}

constexpr int AT_BUF = 65536, AT_V = 32768, AT_BT = GTAB_OFF;
static_assert(8 * 1088 <= GTAB_BYTES, "bias tables fit above the ring");
__device__ __forceinline__ void attn_chunks(const Frame& F, const Args& a, int gc0, int gc1) {
    const bf16* __restrict__ Q = (const bf16*)(a.ws + WS_Q); const bf16* __restrict__ Kb = (const bf16*)(a.ws + WS_K); const bf16* __restrict__ Vb = (const bf16*)(a.ws + WS_V); bf16* YAB = (bf16*)(a.ws + WS_YAB);
    const int tid = F.tid, lane = F.lane, wave = F.wave, pr = wave >> 1, half = wave & 1;
    const int r32 = lane & 31, hi = lane >> 5, i16 = lane & 15, g16 = (lane >> 4) & 1;
    const int gcs[2] = {gc0, gc1};
    int j0s[2], nts[2], tok0s[2];
#pragma unroll
    for (int i = 0; i < 2; ++i) { const int c = gcs[i] % (SEQ / CHUNK); j0s[i] = (c < NLEFT) ? (NLEFT - c) : 0; nts[i] = 9 - j0s[i]; tok0s[i] = (gcs[i] / (SEQ / CHUNK)) * SEQ + c * CHUNK; }
    const int total = 2 * nts[0] + 2 * nts[1];
    const int lrow = tid >> 5, c16 = tid & 31, lhh = c16 >> 3, lch = c16 & 7;
    const int kwoff = lhh * 8192 + lrow * 128 + ((lch ^ ((lrow >> 1) & 7)) << 4);
    const int vwoff = AT_V + lhh * 8192 + lrow * 128 + ((lch ^ (((lrow >> 1) & 1) << 2)) << 4);
    int ko[4];
#pragma unroll
    for (int sI = 0; sI < 4; ++sI) ko[sI] = pr * 8192 + r32 * 128 + ((((2 * sI + hi) ^ ((r32 >> 1) & 7))) << 4);
    const int fb = (i16 >> 3) & 1;
    const int vr0 = AT_V + pr * 8192 + (4 * hi + (i16 >> 2)) * 128 + ((4 * (0 ^ fb) + 2 * g16 + ((i16 & 3) >> 1)) * 16) + (i16 & 1) * 8;
    const int vr1 = AT_V + pr * 8192 + (4 * hi + (i16 >> 2)) * 128 + ((4 * (1 ^ fb) + 2 * g16 + ((i16 & 3) >> 1)) * 16) + (i16 & 1) * 8;
#define AT_DECODE(t, ci, hp, j) do { ci = ((t) >= 2 * nts[0]) ? 1 : 0; const int tt_ = (t) - ci * 2 * nts[0]; hp = (tt_ >= nts[ci]) ? 1 : 0; j = j0s[ci] + tt_ - hp * nts[ci]; } while (0)
    u32x4 kn[4], vn[4];
    {
        int ci, hp, j; AT_DECODE(0, ci, hp, j);
        const size_t g = (size_t)(tok0s[ci] + (j - NLEFT) * CHUNK + lrow) * 512 + hp * 256 + c16 * 8;
#pragma unroll
        for (int i = 0; i < 4; ++i) { kn[i] = *(const u32x4*)(Kb + g + (size_t)i * 16 * 512); vn[i] = *(const u32x4*)(Vb + g + (size_t)i * 16 * 512); }
#pragma unroll
        for (int i = 0; i < 4; ++i) { *(LAS u32x4*)(F.lds + kwoff + i * 2048) = kn[i]; *(LAS u32x4*)(F.lds + vwoff + i * 2048) = vn[i]; }
    }
    __syncthreads();
    bf16x8 qf[4]; f32x16 o0, o1; float m = -1e30f, l = 0.f;
#pragma unroll
    for (int r = 0; r < 16; ++r) { o0[r] = 0.f; o1[r] = 0.f; }
#pragma unroll
    for (int sI = 0; sI < 4; ++sI) qf[sI] = (bf16x8){0, 0, 0, 0, 0, 0, 0, 0};
#pragma unroll 1
    for (int t = 0; t < total; ++t) {
        int ci, hp, j; AT_DECODE(t, ci, hp, j);
        const int tn = (t + 1 < total) ? t + 1 : t; int cin, hpn, jn; AT_DECODE(tn, cin, hpn, jn);
        const int h = 4 * hp + pr, qi = half * 32 + r32, qtok = tok0s[ci] + qi;
        if (j == j0s[ci]) {
#pragma unroll
            for (int sI = 0; sI < 4; ++sI) qf[sI] = *(const bf16x8*)(Q + (size_t)qtok * 512 + h * 64 + 16 * sI + 8 * hi);
#pragma unroll
            for (int r = 0; r < 16; ++r) { o0[r] = 0.f; o1[r] = 0.f; }
            m = -1e30f; l = 0.f;
        }
        asm volatile("" ::: "memory");
        {
            const size_t g = (size_t)(tok0s[cin] + (jn - NLEFT) * CHUNK + lrow) * 512 + hpn * 256 + c16 * 8;
#pragma unroll
            for (int i = 0; i < 4; ++i) { kn[i] = *(const u32x4*)(Kb + g + (size_t)i * 16 * 512); vn[i] = *(const u32x4*)(Vb + g + (size_t)i * 16 * 512); }
        }
        asm volatile("" ::: "memory");
        const LAS unsigned char* buf = F.lds + (t & 1) * AT_BUF;
        const bool first = (j == j0s[ci]);
        const float negm = first ? 0.f : -m;
        f32x16 p0, p1;
#pragma unroll
        for (int r = 0; r < 16; ++r) { p0[r] = negm; p1[r] = negm; }
#pragma unroll
        for (int sI = 0; sI < 4; ++sI) { const bf16x8 k0 = *(const LAS bf16x8*)(buf + ko[sI]), k1 = *(const LAS bf16x8*)(buf + ko[sI] + 4096);
            p0 = __builtin_amdgcn_mfma_f32_32x32x16_bf16(k0, qf[sI], p0, 0, 0, 0); p1 = __builtin_amdgcn_mfma_f32_32x32x16_bf16(k1, qf[sI], p1, 0, 0, 0); }
        if (j >= 6) {
            const LAS float* bt = (const LAS float*)(F.lds + AT_BT + h * 1088);
            const int base = 640 + qi - 64 * j - 4 * hi;
#pragma unroll
            for (int r = 0; r < 16; ++r) { const int kk = (r & 3) + 8 * (r >> 2); int i0 = base - kk, i1 = base - 32 - kk; i0 = i0 > 256 ? 256 : i0; i1 = i1 > 256 ? 256 : i1; p0[r] += bt[i0]; p1[r] += bt[i1]; }
        }
        float tm = fmaxf(p0[0], p1[0]);
#pragma unroll
        for (int r = 1; r < 16; ++r) tm = fmaxf(tm, fmaxf(p0[r], p1[r]));
        { const auto rr = __builtin_amdgcn_permlane32_swap(__float_as_uint(tm), __float_as_uint(tm), false, false); tm = fmaxf(__uint_as_float(rr[0]), __uint_as_float(rr[1])); }
        if (first) {
            m = tm;
#pragma unroll
            for (int r = 0; r < 16; ++r) { p0[r] -= tm; p1[r] -= tm; }
        } else if (__any(tm > 0.f)) {
            const float dlt = fmaxf(tm, 0.f), alpha = __builtin_amdgcn_exp2f(-dlt); m += dlt; l *= alpha;
#pragma unroll
            for (int r = 0; r < 16; ++r) { p0[r] -= dlt; p1[r] -= dlt; o0[r] *= alpha; o1[r] *= alpha; }
        }
        float ps = 0.f;
#pragma unroll
        for (int r = 0; r < 16; ++r) { p0[r] = __builtin_amdgcn_exp2f(p0[r]); p1[r] = __builtin_amdgcn_exp2f(p1[r]); ps += p0[r] + p1[r]; }
        l += ps;
        bf16x8 pb[2][2];
#pragma unroll
        for (int sI = 0; sI < 2; ++sI) {
            u32x4 w0; w0.x = cvtpk(p0[8 * sI], p0[8 * sI + 1]); w0.y = cvtpk(p0[8 * sI + 2], p0[8 * sI + 3]); w0.z = cvtpk(p0[8 * sI + 4], p0[8 * sI + 5]); w0.w = cvtpk(p0[8 * sI + 6], p0[8 * sI + 7]);
            u32x4 w1; w1.x = cvtpk(p1[8 * sI], p1[8 * sI + 1]); w1.y = cvtpk(p1[8 * sI + 2], p1[8 * sI + 3]); w1.z = cvtpk(p1[8 * sI + 4], p1[8 * sI + 5]); w1.w = cvtpk(p1[8 * sI + 6], p1[8 * sI + 7]);
            pb[0][sI] = __builtin_bit_cast(bf16x8, w0); pb[1][sI] = __builtin_bit_cast(bf16x8, w1); }
#pragma unroll
        for (int blk = 0; blk < 2; ++blk)
#pragma unroll
            for (int sI = 0; sI < 2; ++sI) {
                const int kof = (32 * blk + 16 * sI) * 128;
                const s16x4 l0 = vtr(buf + vr0 + kof), h0 = vtr(buf + vr0 + kof + 1024), l1 = vtr(buf + vr1 + kof), h1 = vtr(buf + vr1 + kof + 1024);
                const bf16x8 A0 = {l0[0], l0[1], l0[2], l0[3], h0[0], h0[1], h0[2], h0[3]}, A1 = {l1[0], l1[1], l1[2], l1[3], h1[0], h1[1], h1[2], h1[3]};
                o0 = __builtin_amdgcn_mfma_f32_32x32x16_bf16(A0, pb[blk][sI], o0, 0, 0, 0);
                o1 = __builtin_amdgcn_mfma_f32_32x32x16_bf16(A1, pb[blk][sI], o1, 0, 0, 0);
            }
        if (j == 8) {
            float lt = l; { const auto rr = __builtin_amdgcn_permlane32_swap(__float_as_uint(lt), __float_as_uint(lt), false, false); lt = __uint_as_float(rr[0]) + __uint_as_float(rr[1]); }
            const float inv = __builtin_amdgcn_rcpf(lt);
            bf16* op = YAB + (size_t)qtok * 1024 + h * 64 + 4 * hi;
#pragma unroll
            for (int gg = 0; gg < 4; ++gg) {
                u32x2 w0, w1;
                w0.x = cvtpk(o0[4 * gg] * inv, o0[4 * gg + 1] * inv); w0.y = cvtpk(o0[4 * gg + 2] * inv, o0[4 * gg + 3] * inv);
                w1.x = cvtpk(o1[4 * gg] * inv, o1[4 * gg + 1] * inv); w1.y = cvtpk(o1[4 * gg + 2] * inv, o1[4 * gg + 3] * inv);
                *(u32x2*)(op + 8 * gg) = w0; *(u32x2*)(op + 32 + 8 * gg) = w1; }
        }
        {
            LAS unsigned char* nb = F.lds + ((t + 1) & 1) * AT_BUF;
#pragma unroll
            for (int i = 0; i < 4; ++i) { *(LAS u32x4*)(nb + kwoff + i * 2048) = kn[i]; *(LAS u32x4*)(nb + vwoff + i * 2048) = vn[i]; }
        }
        __syncthreads();
    }
#undef AT_DECODE
}
__device__ __forceinline__ void phaseD(const Frame& F, const Args& a) {
    if (!(a.pad & 8)) for (int unit = F.vcu; unit < NB * (SEQ / SGB); unit += F.G) sgu_unit(F, a, unit / (SEQ / SGB), unit % (SEQ / SGB));
    if (a.pad & 16) return;
    for (int i = F.tid; i < NHEAD * NREL; i += NWAVES * 64) { const int h = i / NREL, k = i % NREL; ((LAS float*)(F.lds + AT_BT + h * 1088))[k] = (a.in[7][i] - a.in[7][h * NREL + 256]) * LOG2E; }
    __syncthreads();
    const int NCH = NB * (SEQ / CHUNK);
    for (int v = F.vcu; v < NCH / 2; v += F.G) attn_chunks(F, a, v, NCH - 1 - v);
}

constexpr int G_HT_STRIDE = 2064;
__device__ __forceinline__ void phaseG(const Frame& F, const Args& a) {
    const float* x = a.in[0]; const bf16* Y1 = (const bf16*)(a.ws + WS_Y1); const float* mod = (const float*)(a.ws + WS_MOD); const float* g_post_mix = a.in[5]; const float* g_pre_ffn = a.in[17];
    const float* b_router = a.in[20]; bf16* X1b = (bf16*)(a.ws + WS_X1B); unsigned char* XN8 = a.ws + WS_XN;
    const bf16* wrt = (const bf16*)(a.ws + WS_WRT);
    float* topg = (float*)(a.ws + WS_TOPG); int* list = (int*)(a.ws + WS_LIST); unsigned* cnt = F.ctl + CW_CNT;
    LAS unsigned char* HT = F.lds;
    LAS float* PL = (LAS float*)(F.lds + 33792);
    LAS float* LG = PL + 8 * 16 * 32;
    LAS float* TV = LG + 512;
    LAS unsigned* LC = (LAS unsigned*)(TV + 64);
    LAS unsigned* AS = LC + 64;
    const int tid = F.tid, lane = F.lane, wave = F.wave, kq = lane >> 4, i16 = lane & 15;
    if (tid < 64) LC[tid] = 0u;
    bf16x8 whi[2][4], wlo[2][4];
#pragma unroll
    for (int et = 0; et < 2; ++et)
#pragma unroll
        for (int ks = 0; ks < 4; ++ks) { const size_t o = (size_t)(et * 16 + i16) * D + 128 * wave + 32 * ks + 8 * kq; whi[et][ks] = *(const bf16x8*)(wrt + o); wlo[et][ks] = *(const bf16x8*)(wrt + (size_t)NEXP * D + o); }
    const int myrow = tid >> 5, mye = lane & 31;
    const float mybias = b_router[mye];
    __syncthreads();
    const int NT = NTOK / 16;
    f32x4 xv[2][4]; u32x2 yr[2][4];
    {   const int rbase = 16 * F.vcu + 2 * wave;
#pragma unroll
        for (int rr = 0; rr < 2; ++rr)
#pragma unroll
            for (int j = 0; j < 4; ++j) { const int c0 = (lane + 64 * j) * 4; xv[rr][j] = __builtin_nontemporal_load((const f32x4*)(x + (size_t)(rbase + rr) * D + c0)); yr[rr][j] = __builtin_nontemporal_load((const u32x2*)(Y1 + (size_t)(rbase + rr) * D + c0)); } }
    int tl = 0;
    f32x4 cgp[4], cgf[4], cgt[4], csc[4], csh[4]; int cb = -1;
#pragma unroll
    for (int j = 0; j < 4; ++j) { const int c0 = (lane + 64 * j) * 4; cgp[j] = *(const f32x4*)(g_post_mix + c0); cgf[j] = *(const f32x4*)(g_pre_ffn + c0); }
#pragma unroll 1
    for (int T = F.vcu; T < NT; T += F.G, ++tl) {
        const int b = (16 * T) / SEQ; const float* mb = mod + b * 6144; const int rbase = 16 * T + 2 * wave;
        if (b != cb) { cb = b;
#pragma unroll
            for (int j = 0; j < 4; ++j) { const int c0 = (lane + 64 * j) * 4; cgt[j] = *(const f32x4*)(mb + GT1 + c0); csc[j] = *(const f32x4*)(mb + SC2 + c0) + 1.0f; csh[j] = *(const f32x4*)(mb + SH2 + c0); } }
#pragma unroll
        for (int rr = 0; rr < 2; ++rr) {
            const int row = rbase + rr; f32x4 yv[4]; float ss = 0.f;
#pragma unroll
            for (int j = 0; j < 4; ++j) { yv[j] = (f32x4){bflo(yr[rr][j].x), bfhi(yr[rr][j].x), bflo(yr[rr][j].y), bfhi(yr[rr][j].y)}; ss += (yv[j][0] * yv[j][0] + yv[j][1] * yv[j][1]) + (yv[j][2] * yv[j][2] + yv[j][3] * yv[j][3]); }
            const float rstd = rsqrtf(wsum(ss) * (1.0f / D) + EPS); float s2 = 0.f;
#pragma unroll
            for (int j = 0; j < 4; ++j) { const int c0 = (lane + 64 * j) * 4;
                xv[rr][j] = xv[rr][j] + cgt[j] * (yv[j] * rstd * cgp[j]);
                { u32x2 w1; w1.x = cvtpk(xv[rr][j][0], xv[rr][j][1]); w1.y = cvtpk(xv[rr][j][2], xv[rr][j][3]); *(u32x2*)(X1b + (size_t)row * D + c0) = w1; }
                s2 += (xv[rr][j][0] * xv[rr][j][0] + xv[rr][j][1] * xv[rr][j][1]) + (xv[rr][j][2] * xv[rr][j][2] + xv[rr][j][3] * xv[rr][j][3]); }
            const float rstd2 = rsqrtf(wsum(s2) * (1.0f / D) + EPS);
#pragma unroll
            for (int j = 0; j < 4; ++j) { const int c0 = (lane + 64 * j) * 4;
                const f32x4 h = xv[rr][j] * rstd2 * cgf[j] * csc[j] + csh[j];
                u32x2 w; w.x = cvtpk(h[0], h[1]); w.y = cvtpk(h[2], h[3]); *(unsigned*)(XN8 + (size_t)row * D + c0) = pk_fp8x4(h[0] * F8_ASCALE, h[1] * F8_ASCALE, h[2] * F8_ASCALE, h[3] * F8_ASCALE);
                *(LAS u32x2*)(HT + (2 * wave + rr) * G_HT_STRIDE + c0 * 2) = w; }
        }
        {
            const int Tn = (T + F.G < NT) ? T + F.G : T; const int rb2 = 16 * Tn + 2 * wave;
#pragma unroll
            for (int rr = 0; rr < 2; ++rr)
#pragma unroll
                for (int j = 0; j < 4; ++j) { const int c0 = (lane + 64 * j) * 4; xv[rr][j] = __builtin_nontemporal_load((const f32x4*)(x + (size_t)(rb2 + rr) * D + c0)); yr[rr][j] = __builtin_nontemporal_load((const u32x2*)(Y1 + (size_t)(rb2 + rr) * D + c0)); }
        }
        LDS_WAIT(); __builtin_amdgcn_s_barrier(); asm volatile("" ::: "memory");
        {
            f32x4 acc0 = {0.f, 0.f, 0.f, 0.f}, acc1 = {0.f, 0.f, 0.f, 0.f};
#pragma unroll
            for (int ks = 0; ks < 4; ++ks) { const bf16x8 hb = *(const LAS bf16x8*)(HT + i16 * G_HT_STRIDE + (128 * wave + 32 * ks + 8 * kq) * 2);
                acc0 = __builtin_amdgcn_mfma_f32_16x16x32_bf16(whi[0][ks], hb, acc0, 0, 0, 0); acc0 = __builtin_amdgcn_mfma_f32_16x16x32_bf16(wlo[0][ks], hb, acc0, 0, 0, 0);
                acc1 = __builtin_amdgcn_mfma_f32_16x16x32_bf16(whi[1][ks], hb, acc1, 0, 0, 0); acc1 = __builtin_amdgcn_mfma_f32_16x16x32_bf16(wlo[1][ks], hb, acc1, 0, 0, 0); }
            *(LAS f32x4*)(PL + (wave * 16 + i16) * 32 + 4 * kq) = acc0; *(LAS f32x4*)(PL + (wave * 16 + i16) * 32 + 16 + 4 * kq) = acc1;
        }
        LDS_WAIT(); __builtin_amdgcn_s_barrier(); asm volatile("" ::: "memory");
        float lg = mybias;
#pragma unroll
        for (int w = 0; w < 8; ++w) lg += PL[(w * 16 + myrow) * 32 + mye];
        LG[myrow * 32 + mye] = lg;
        LDS_WAIT(); asm volatile("" ::: "memory");
        int rank = 0;
#pragma unroll
        for (int q = 0; q < 8; ++q) { const f32x4 o = *(const LAS f32x4*)(LG + myrow * 32 + 4 * q);
#pragma unroll
            for (int i = 0; i < 4; ++i) { const int e2 = 4 * q + i; rank += (o[i] > lg || (o[i] == lg && e2 < mye)) ? 1 : 0; } }
        if (rank < 4) TV[myrow * 4 + rank] = lg;
        LDS_WAIT(); asm volatile("" ::: "memory");
        const f32x4 tv = *(const LAS f32x4*)(TV + myrow * 4);
        if (rank < 4) {
            const float den = 1.0f + __expf(tv[1] - tv[0]) + __expf(tv[2] - tv[0]) + __expf(tv[3] - tv[0]);
            const int slot = (16 * T + myrow) * 4 + rank; topg[slot] = __expf(lg - tv[0]) / den;
            const unsigned lp = __hip_atomic_fetch_add(LC + mye, 1u, __ATOMIC_RELAXED, __HIP_MEMORY_SCOPE_WORKGROUP);
            if (tl < 16) AS[tl * 64 + myrow * 4 + rank] = (unsigned)mye | (lp << 8);
        }
    }
    __syncthreads();
    if (tid < NEXP) LC[32 + tid] = atomicAdd(&cnt[tid], LC[tid]);
    __syncthreads();
    for (int i = tid; i < tl * 64; i += NWAVES * 64) { const unsigned as = AS[i]; const int e = as & 255, lp = as >> 8; const int T = F.vcu + (i >> 6) * F.G;
        list[(size_t)e * NTOK + LC[32 + e] + lp] = (16 * T + ((i & 63) >> 2)) * 4 + (i & 3); }
}
__device__ __forceinline__ int moe_tables(const Frame& F) {
    __syncthreads();
    if (F.tid < NEXP) F.MISC[40 + F.tid] = __hip_atomic_load(F.ctl + CW_CNT + F.tid, __ATOMIC_RELAXED, __HIP_MEMORY_SCOPE_AGENT);
    __syncthreads();
    if (F.tid == 0) { unsigned s = 0; for (int e = 0; e < NEXP; ++e) { F.MISC[e] = s; s += (F.MISC[40 + e] + 255u) >> 8; } F.MISC[32] = s; }
    __syncthreads();
    return (int)F.MISC[32];
}
__device__ __forceinline__ void phaseJ(const Frame& F, const Args& a) {
    const unsigned char* Y2s = a.ws + WS_Y2; const bf16* X1b = (const bf16*)(a.ws + WS_X1B); const float* mod = (const float*)(a.ws + WS_MOD); const float* gpf = a.in[18]; float* out = a.out;
    const int* inv = (const int*)(a.ws + WS_TOPE); const float* topg = (const float*)(a.ws + WS_TOPG);
    const int lane = F.lane, gw = F.vcu * NWAVES + F.wave, NGW = F.G * NWAVES;
    f32x4 cgg[4]; int cb = -1;
    for (int row0 = gw * 4; row0 < NTOK; row0 += NGW * 4) {
        const int b = row0 / SEQ; const float* mb = mod + b * 6144;
        if (b != cb) { cb = b;
#pragma unroll
            for (int j = 0; j < 4; ++j) { const int c0 = (lane + 64 * j) * 4; cgg[j] = *(const f32x4*)(gpf + c0) * *(const f32x4*)(mb + GT2 + c0); } }
        int pp[4][4]; float gg[4][4];
#pragma unroll
        for (int rr = 0; rr < 4; ++rr)
#pragma unroll
            for (int k = 0; k < 4; ++k) { pp[rr][k] = __builtin_amdgcn_readfirstlane(inv[(row0 + rr) * 4 + k]); gg[rr][k] = topg[(row0 + rr) * 4 + k] * (1.0f / F8_YSCALE); }
        unsigned yy[4][4][4]; u32x2 xx[4][4];
#pragma unroll
        for (int rr = 0; rr < 4; ++rr)
#pragma unroll
            for (int j = 0; j < 4; ++j) { const int c0 = (lane + 64 * j) * 4;
#pragma unroll
                for (int k = 0; k < 4; ++k) yy[rr][j][k] = __builtin_nontemporal_load((const unsigned*)(Y2s + (size_t)pp[rr][k] * D + c0));
                xx[rr][j] = __builtin_nontemporal_load((const u32x2*)(X1b + (size_t)(row0 + rr) * D + c0)); }
#pragma unroll
        for (int rr = 0; rr < 4; ++rr) {
            f32x4 yv[4]; float ss = 0.f;
#pragma unroll
            for (int j = 0; j < 4; ++j) { f32x4 s = {0.f, 0.f, 0.f, 0.f};
#pragma unroll
                for (int k = 0; k < 4; ++k) { const f32x2 lo = __builtin_amdgcn_cvt_pk_f32_fp8((int)yy[rr][j][k], false), hi = __builtin_amdgcn_cvt_pk_f32_fp8((int)yy[rr][j][k], true);
                    s += (f32x4){lo.x, lo.y, hi.x, hi.y} * gg[rr][k]; }
                yv[j] = s; ss += (s[0] * s[0] + s[1] * s[1]) + (s[2] * s[2] + s[3] * s[3]); }
            const float rstd = rsqrtf(wsum(ss) * (1.0f / D) + EPS);
#pragma unroll
            for (int j = 0; j < 4; ++j) { const int c0 = (lane + 64 * j) * 4;
                const f32x4 x1 = {bflo(xx[rr][j].x), bfhi(xx[rr][j].x), bflo(xx[rr][j].y), bfhi(xx[rr][j].y)};
                *(f32x4*)(out + (size_t)(row0 + rr) * D + c0) = x1 + cgg[j] * (yv[j] * rstd); }
        }
    }
}

constexpr int N_PHASES = 10;
__global__ void __launch_bounds__(NWAVES * 64, 2) mega_fwd(Args args) {
    extern __shared__ __attribute__((aligned(16))) unsigned char lds_raw[];
    Frame F;
    F.lds = (LAS unsigned char*)lds_raw; F.MISC = (volatile LAS unsigned*)(F.lds + MISC_OFF);
    F.tid = threadIdx.x; F.lane = F.tid & 63; F.wave = __builtin_amdgcn_readfirstlane(F.tid >> 6);
    F.G = gridDim.x; { const int bx = blockIdx.x; F.vcu = (F.G % 8 == 0) ? (bx % 8) * (F.G / 8) + bx / 8 : bx; }
    F.ctl = (unsigned*)(args.ws + WS_CTL);
    for (int u = F.tid; u < 128; u += NWAVES * 64) F.MISC[u] = 0u;
    __syncthreads();
    const int lo = args.ph_lo, hi = args.ph_hi;
    XcdBarrier bar; bar.bar = F.ctl + CW_BAR; bar.x = 0; bar.st = F.MISC + 80;
    if (hi - lo > 1) bar = xcd_barrier_post(F.ctl + CW_BAR, F.MISC + 80);
#ifndef PH_COMPILE_MASK
#define PH_COMPILE_MASK 0x3ff
#endif
#define IN(k) (((PH_COMPILE_MASK >> (k)) & 1) && lo <= (k) && (k) < hi)
#define SEAM(k) do { if (IN(k) && IN((k) + 1)) { xcd_barrier(bar); if (args.pad & 64) xcd_barrier(bar); } } while (0)
    unsigned char* ws = args.ws;
    bf16 *XN = (bf16*)(ws + WS_XN), *Qb = (bf16*)(ws + WS_Q), *Kb = (bf16*)(ws + WS_K), *Vb = (bf16*)(ws + WS_V), *Ub = (bf16*)(ws + WS_U), *VG = (bf16*)(ws + WS_VG);
    bf16 *GT = (bf16*)(ws + WS_GT), *YAB = (bf16*)(ws + WS_YAB), *MRG = (bf16*)(ws + WS_MRG), *Y1 = (bf16*)(ws + WS_Y1), *ACT = (bf16*)(ws + WS_ACT), *Y2 = (bf16*)(ws + WS_Y2);

    if (IN(0)) { phaseA(F, args); } SEAM(0);
    if (IN(1)) { phaseB(F, args); } SEAM(1);
    if (IN(2)) {
        SchedStatic S{(const char*)XN, (const char*)(ws + WS_W1T), NTOK / 256, 4608 / 256, F.G, (int)blockIdx.x, (size_t)256 * 1024 * 2, (size_t)256 * 1024 * 2};
        EpiG1 E{Qb, Kb, Vb, Ub, VG, GT, args.in[15]};
        pg8::gemm_phase<EpiG1, SchedStatic, false>(F.lds + RING_OFF, S, E, 2048, 2048, 16, args.pad);
    } SEAM(2);
    if (IN(3)) { phaseD(F, args); } SEAM(3);
    if (IN(4)) {
        SchedSplit2 S{(const char*)YAB, (const char*)(ws + WS_WBRT), NTOK / 256, 4, F.G, (int)blockIdx.x, (size_t)256 * 1024 * 2, (size_t)256 * 1024 * 2, (size_t)512 * 2};
        EpiG2 E{GT, MRG};
        pg8::gemm_phase<EpiG2, SchedSplit2, false>(F.lds + RING_OFF, S, E, 2048, 2048, 8);
    } SEAM(4);
    if (IN(5)) {
        SchedStatic S{(const char*)MRG, (const char*)(ws + WS_WOUTT), NTOK / 256, 4, F.G, (int)blockIdx.x, (size_t)256 * 1024 * 2, (size_t)256 * 1024 * 2};
        EpiPlain E{Y1};
        pg8::gemm_phase<EpiPlain, SchedStatic, false>(F.lds + RING_OFF, S, E, 2048, 2048, 16);
    } SEAM(5);
    if (IN(6)) { phaseG(F, args); } SEAM(6);
    if (IN(7)) {
        const int nrb = moe_tables(F);
        const int* list = (const int*)(ws + WS_LIST);
        {
            int* inv = (int*)(ws + WS_TOPE);
            for (int g = (int)blockIdx.x * (NWAVES * 64) + F.tid; g < NTOK * TOPK; g += F.G * NWAVES * 64) {
                int e = 0, base = 0;
#pragma unroll 1
                for (int i = 0; i < NEXP; ++i) { const int c = (int)F.MISC[40 + i]; if (g >= base + c) { base += c; e = i + 1; } else break; }
                const int pos = g - base; if (e < NEXP) inv[list[(size_t)e * NTOK + pos]] = (int)F.MISC[e] * 256 + pos; }
        }
        typedef SchedMoe<8, true> SM;
        SM S{(const char*)XN, (const char*)(ws + WS_WGUT), F.MISC, (const LAS unsigned*)(F.lds + GTAB_OFF), (int)blockIdx.x, F.G, nrb, (size_t)2048 * 1024, (size_t)256 * 1024};
        S.build(F.tid);
        { Unit u; LAS unsigned* gt = (LAS unsigned*)(F.lds + GTAB_OFF);
          for (int k = 0; k < GTAB_UNITS && S.next(k, u); ++k) { const int e = u.aux, j256 = (u.pm - (int)F.MISC[e]) * 256, ecnt = (int)F.MISC[40 + e];
              for (int r = F.tid; r < 256; r += NWAVES * 64) { const int pos = j256 + r; int tok = 0; if (pos < ecnt) tok = list[(size_t)e * NTOK + pos] >> 2; gt[k * 256 + r] = (unsigned)tok * 1024u; } } }
        __syncthreads();
        EpiAct E{args.in[22], (unsigned char*)ACT};
        pg8::gemm_phase<EpiAct, SM, true>(F.lds + RING_OFF, S, E, 1024, 1024, 8, args.pad);
    } SEAM(7);
    if (IN(8)) {
        const int nrb = moe_tables(F);
        typedef SchedMoe<4, true> SM;
        SM S{(const char*)ACT, (const char*)(ws + WS_WDNT), F.MISC, (const LAS unsigned*)(F.lds + GTAB_OFF), (int)blockIdx.x, F.G, nrb, (size_t)1024 * 1024, (size_t)256 * 1024};
        S.build(F.tid);
        { Unit u; LAS unsigned* gt = (LAS unsigned*)(F.lds + GTAB_OFF);
          for (int k = 0; k < GTAB_UNITS && S.next(k, u); ++k) for (int r = F.tid; r < 256; r += NWAVES * 64) gt[k * 256 + r] = (unsigned)(u.pm * 256 + r) * 1024u; }
        __syncthreads();
        EpiDown E{args.in[24], (unsigned char*)Y2};
        pg8::gemm_phase<EpiDown, SM, true>(F.lds + RING_OFF, S, E, 1024, 1024, 8, args.pad);
    } SEAM(8);
    if (IN(9)) { phaseJ(F, args); }
#undef IN
#undef SEAM
}
#ifndef MEGA_MASK
#define MEGA_MASK 0x3ff
#endif
#ifndef REP_MASK
#define REP_MASK 0
#endif
#ifndef REP_FLAGS
#define REP_FLAGS 0
#endif
#ifndef MAIN_FLAGS
#define MAIN_FLAGS 0
#endif
#ifndef ONE_LAUNCH
#define ONE_LAUNCH 1
#endif
extern "C" void kernel_launch(void* const* d_in, const int* in_sizes, int n_in, void* d_out, int out_size, void* d_ws, size_t ws_size, hipStream_t stream) {
    if (n_in != 25 || in_sizes[0] != NTOK * D || out_size != NTOK * D || ws_size < WS_END) { fprintf(stderr, "kernel_launch: unexpected shapes (n_in %d in0 %d out %d ws %zu)\n", n_in, n_in > 0 ? in_sizes[0] : -1, out_size, ws_size); return; }
    static int grid = 0;
    if (grid == 0) {
        int dev = 0, cus = 0, per_cu = 0;
        if (hipGetDevice(&dev) != hipSuccess || hipDeviceGetAttribute(&cus, hipDeviceAttributeMultiprocessorCount, dev) != hipSuccess) { fprintf(stderr, "kernel_launch: device query failed\n"); grid = -1; return; }
        if (hipFuncSetAttribute((const void*)mega_fwd, hipFuncAttributeMaxDynamicSharedMemorySize, LDS_BYTES) != hipSuccess) { fprintf(stderr, "kernel_launch: hipFuncSetAttribute failed\n"); grid = -1; return; }
        if (hipOccupancyMaxActiveBlocksPerMultiprocessor(&per_cu, (const void*)mega_fwd, NWAVES * 64, LDS_BYTES) != hipSuccess || per_cu < 1) { fprintf(stderr, "kernel_launch: occupancy query says %d\n", per_cu); }
        (void)hipGetLastError();
        grid = cus;
    }
    if (grid < 0) return;
    const float* x = (const float*)d_in[0]; const float* c = (const float*)d_in[1]; const float* w_ada = (const float*)d_in[2]; const float* b_ada = (const float*)d_in[3];
    const float* g_pre_mix = (const float*)d_in[4]; const float* g_post_mix = (const float*)d_in[5]; const float* w_in = (const float*)d_in[6]; const float* rel_bias = (const float*)d_in[7];
    const float* sgu_ln_g = (const float*)d_in[8]; const float* sgu_ln_b = (const float*)d_in[9]; const float* w_spatial = (const float*)d_in[10]; const float* b_spatial = (const float*)d_in[11];
    const float* w_branch_a = (const float*)d_in[12]; const float* w_branch_b = (const float*)d_in[13]; const float* w_gate = (const float*)d_in[14]; const float* b_gate = (const float*)d_in[15];
    const float* w_out = (const float*)d_in[16]; const float* g_pre_ffn = (const float*)d_in[17]; const float* g_post_ffn = (const float*)d_in[18]; const float* w_router = (const float*)d_in[19];
    const float* b_router = (const float*)d_in[20]; const float* w_gate_up = (const float*)d_in[21]; const float* b_gate_up = (const float*)d_in[22]; const float* w_down = (const float*)d_in[23];
    const float* b_down = (const float*)d_in[24];
    unsigned char* ws = (unsigned char*)d_ws; float* out = (float*)d_out;
    unsigned* ctl = (unsigned*)(ws + WS_CTL); float* mod = (float*)(ws + WS_MOD);
    bf16 *XN = (bf16*)(ws + WS_XN), *Qb = (bf16*)(ws + WS_Q), *Kb = (bf16*)(ws + WS_K), *Vb = (bf16*)(ws + WS_V), *Ub = (bf16*)(ws + WS_U), *VG = (bf16*)(ws + WS_VG);
    bf16 *GT = (bf16*)(ws + WS_GT), *YAB = (bf16*)(ws + WS_YAB), *MRG = (bf16*)(ws + WS_MRG), *Y1 = (bf16*)(ws + WS_Y1), *ACT = (bf16*)(ws + WS_ACT), *Y2 = (bf16*)(ws + WS_Y2);
    float *VN = (float*)(ws + WS_VN), *TMP = (float*)(ws + WS_TMP);
    int* tope = (int*)(ws + WS_TOPE); float* topg = (float*)(ws + WS_TOPG); int* list = (int*)(ws + WS_LIST); unsigned* cnt = ctl + CW_CNT;
    (void)x; (void)c; (void)w_ada; (void)b_ada; (void)g_pre_mix; (void)rel_bias; (void)sgu_ln_g; (void)sgu_ln_b; (void)w_spatial; (void)b_spatial; (void)tope;

    if (hipMemsetAsync(ws + WS_CTL, 0, CTL_ZERO_BYTES, stream) != hipSuccess) { fprintf(stderr, "kernel_launch: memset failed\n"); return; }
    Args a{};
    for (int i = 0; i < 25; ++i) a.in[i] = (const float*)d_in[i];
    a.out = out; a.ws = ws;
#if ONE_LAUNCH
    a.ph_lo = 0; a.ph_hi = N_PHASES; a.pad = MAIN_FLAGS;
    hipLaunchKernelGGL(mega_fwd, dim3(grid), dim3(NWAVES * 64), LDS_BYTES, stream, a);
    if (hipPeekAtLastError() != hipSuccess) fprintf(stderr, "kernel_launch: launch failed\n");
    for (int ph = 0; ph < N_PHASES; ++ph) if ((REP_MASK >> ph) & 1) {
        a.ph_lo = ph; a.ph_hi = ph + 1; a.pad = REP_FLAGS; hipLaunchKernelGGL(mega_fwd, dim3(grid), dim3(NWAVES * 64), LDS_BYTES, stream, a); }
#else
    for (int ph = 0; ph < N_PHASES; ++ph) {
        if (((MEGA_MASK >> ph) & 1) || ph == 0) { a.ph_lo = ph; a.ph_hi = ph + 1; hipLaunchKernelGGL(mega_fwd, dim3(grid), dim3(NWAVES * 64), LDS_BYTES, stream, a); if (((MEGA_MASK >> ph) & 1)) continue; }
        switch (ph) {
        case 0: nv_mod<<<NMOD * D / 256, 256, 0, stream>>>(c, w_ada, b_ada, mod); break;
        case 1: nv_xn1<<<NTOK / 4, 256, 0, stream>>>(x, g_pre_mix, mod, XN); break;
        case 2: { G_In g{XN, w_in, Qb, Kb, Vb, Ub, VG}; nv_gemm<G_In, false><<<dim3(INW / 64, NTOK / 64, 1), 256, 0, stream>>>(g, INW, D); }
                { G_Gate g{XN, w_gate, b_gate, GT}; nv_gemm<G_Gate, false><<<dim3(2048 / 64, NTOK / 64, 1), 256, 0, stream>>>(g, 2048, D); } break;
        case 3: nv_attn<<<NTOK * NHEAD / 256, 256, 0, stream>>>(Qb, Kb, Vb, rel_bias, YAB);
                nv_sgu_ln<<<NTOK / 4, 256, 0, stream>>>(VG, sgu_ln_g, sgu_ln_b, VN);
                nv_sgu<<<NTOK * SW / 256, 256, 0, stream>>>(VN, Ub, w_spatial, b_spatial, YAB); break;
        case 4: { G_BrA g{YAB, w_branch_a, GT, TMP}; nv_gemm<G_BrA, false><<<dim3(D / 64, NTOK / 64, 1), 256, 0, stream>>>(g, D, AW); }
                { G_BrB g{YAB, w_branch_b, GT, TMP, MRG}; nv_gemm<G_BrB, false><<<dim3(D / 64, NTOK / 64, 1), 256, 0, stream>>>(g, D, SW); } break;
        case 5: { G_Out g{MRG, w_out, Y1}; nv_gemm<G_Out, false><<<dim3(D / 64, NTOK / 64, 1), 256, 0, stream>>>(g, D, D); } break;
        case 6: nv_rowpass1<<<NTOK / 4, 256, 0, stream>>>(x, Y1, mod, g_post_mix, g_pre_ffn, w_router, b_router, out, XN, tope, topg, cnt, list); break;
        case 7: { G_MoeGU g{XN, w_gate_up, b_gate_up, cnt, list, ACT}; nv_gemm<G_MoeGU, true><<<dim3(DE / 64, NTOK / 64, NEXP), 256, 0, stream>>>(g, 2048, D); } break;
        case 8: { G_MoeDn g{ACT, w_down, b_down, cnt, list, topg, Y2}; nv_gemm<G_MoeDn, false><<<dim3(D / 64, NTOK / 64, NEXP), 256, 0, stream>>>(g, D, DE); } break;
        case 9: nv_final<<<NTOK / 4, 256, 0, stream>>>(Y2, mod, g_post_ffn, out); break;
        }
    }
#endif
}
```

```cpp
#include <hip/hip_runtime.h>
#include <cstdio>
#include <cstdint>

constexpr int NB = 4, SEQ = 8192, D = 1024, NTOK = NB * SEQ;
constexpr int NHEAD = 8, CHUNK = 64, NLEFT = 8, NREL = 257;
constexpr int SGB = 128;
constexpr int INW = 2560, NEXP = 32, TOPK = 4;
constexpr float EPS = 1e-6f, SWL = 7.0f, SWA = 1.702f;
constexpr float LOG2E = 1.4426950408889634f;
constexpr float QSCALE = 0.125f * LOG2E;
constexpr int SH1 = 0, SC1 = 1024, GT1 = 2048, SH2 = 3072, SC2 = 4096, GT2 = 5120;
typedef unsigned short bf16;

constexpr size_t MiB = 1u << 20;
constexpr size_t WS_CTL = 0, CTL_ZERO_BYTES = 64 * 1024;
constexpr size_t WS_MOD = 1 * MiB;
constexpr size_t WS_W1T = 2 * MiB, WS_WBRT = 12 * MiB, WS_WOUTT = 14 * MiB, WS_WRT = 16 * MiB;
constexpr size_t WS_TOPE = 17 * MiB, WS_TOPG = 18 * MiB, WS_LIST = 19 * MiB;
constexpr size_t WS_WGUT = 32 * MiB, WS_WDNT = 160 * MiB;
constexpr size_t WS_XN = 224 * MiB;
constexpr size_t WS_Q = 288 * MiB, WS_K = 320 * MiB, WS_V = 352 * MiB, WS_U = 384 * MiB, WS_VG = 416 * MiB;
constexpr size_t WS_GT = 448 * MiB;
constexpr size_t WS_YAB = 576 * MiB, WS_MRG = 640 * MiB, WS_Y1 = 704 * MiB;
constexpr size_t WS_ACT = 288 * MiB;
constexpr size_t WS_Y2 = 576 * MiB;
constexpr size_t WS_END = 960 * MiB;
constexpr int CW_CNT = 1024;

#define LAS __attribute__((address_space(3)))
#define GAS __attribute__((address_space(1)))
typedef short bf16x8 __attribute__((ext_vector_type(8)));
typedef short s16x4 __attribute__((ext_vector_type(4)));
typedef float f32x4 __attribute__((ext_vector_type(4)));
typedef float f32x2 __attribute__((ext_vector_type(2)));
typedef float f32x16 __attribute__((ext_vector_type(16)));
typedef unsigned u32x4 __attribute__((ext_vector_type(4)));
typedef unsigned u32x2 __attribute__((ext_vector_type(2)));
typedef __bf16 bf16x2_t __attribute__((ext_vector_type(2)));
constexpr int NWAVES = 8;
constexpr int TRASH_SLOT = NTOK * 4;

__device__ __forceinline__ unsigned cvtpk(float lo, float hi) { f32x2 v = {lo, hi}; bf16x2_t b = __builtin_convertvector(v, bf16x2_t); return __builtin_bit_cast(unsigned, b); }
__device__ __forceinline__ float wsum(float v) {
    v += __builtin_bit_cast(float, __builtin_amdgcn_update_dpp(0, __builtin_bit_cast(int, v), 0xB1, 0xF, 0xF, true));
    v += __builtin_bit_cast(float, __builtin_amdgcn_update_dpp(0, __builtin_bit_cast(int, v), 0x4E, 0xF, 0xF, true));
    v += __builtin_bit_cast(float, __builtin_amdgcn_update_dpp(0, __builtin_bit_cast(int, v), 0x124, 0xF, 0xF, true));
    v += __builtin_bit_cast(float, __builtin_amdgcn_update_dpp(0, __builtin_bit_cast(int, v), 0x128, 0xF, 0xF, true));
    const int iv = __builtin_bit_cast(int, v);
    const float s0 = __builtin_bit_cast(float, __builtin_amdgcn_readlane(iv, 0)), s1 = __builtin_bit_cast(float, __builtin_amdgcn_readlane(iv, 16));
    const float s2 = __builtin_bit_cast(float, __builtin_amdgcn_readlane(iv, 32)), s3 = __builtin_bit_cast(float, __builtin_amdgcn_readlane(iv, 48));
    return (s0 + s1) + (s2 + s3);
}
__device__ __forceinline__ float clamp8(float v) { return fminf(fmaxf(v, -448.0f), 448.0f); }
__device__ __forceinline__ unsigned pk_fp8x4(float a, float b, float c, float d) {
    int w = 0; w = __builtin_amdgcn_cvt_pk_fp8_f32(clamp8(a), clamp8(b), w, false); w = __builtin_amdgcn_cvt_pk_fp8_f32(clamp8(c), clamp8(d), w, true); return (unsigned)w; }
constexpr float F8_YSCALE = 16.0f;
constexpr size_t WS_X1B = 768 * MiB;
constexpr float F8_WSCALE = 64.0f, F8_ASCALE = 4.0f, F8_DESCALE = 1.0f / (64.0f * 4.0f);
__device__ __forceinline__ float bflo(unsigned w) { return __uint_as_float(w << 16); }
__device__ __forceinline__ float bfhi(unsigned w) { return __uint_as_float(w & 0xffff0000u); }
__device__ __forceinline__ float fast_sigmoid(float x) { return __builtin_amdgcn_rcpf(1.0f + __builtin_amdgcn_exp2f(-LOG2E * x)); }
__device__ __forceinline__ f32x2 sigmoid_pk(f32x2 v) { const f32x2 t = v * (-LOG2E); f32x2 e; e.x = __builtin_amdgcn_exp2f(t.x); e.y = __builtin_amdgcn_exp2f(t.y); const f32x2 d = e + 1.0f; f32x2 r; r.x = __builtin_amdgcn_rcpf(d.x); r.y = __builtin_amdgcn_rcpf(d.y); return r; }
__device__ __forceinline__ f32x2 gelu_pk(f32x2 v) {
    const f32x2 av = __builtin_elementwise_abs(v), d = av * 0.2316418882f + 1.0f;
    f32x2 t; t.x = __builtin_amdgcn_rcpf(d.x); t.y = __builtin_amdgcn_rcpf(d.y);
    f32x2 q = t * 0.5307027145f + (-0.7265760135f); q = q * t + 0.7107068705f; q = q * t + (-0.142248368f); q = q * t + 0.127414796f; q = q * t;
    const f32x2 s = (v * v) * (-0.72134752044f);
    f32x2 e; e.x = __builtin_amdgcn_exp2f(s.x); e.y = __builtin_amdgcn_exp2f(s.y);
    const f32x2 m = v * (q * e), r = v - m;
    f32x2 o; o.x = v.x < 0.f ? m.x : r.x; o.y = v.y < 0.f ? m.y : r.y; return o;
}

constexpr int RING_OFF = 0, RING_BYTES = 131072;
constexpr int GTAB_OFF = RING_BYTES, GTAB_UNITS = 20, GTAB_BYTES = GTAB_UNITS * 256 * 4;
constexpr int MISC_OFF = GTAB_OFF + GTAB_BYTES;
constexpr int LDS_BYTES = MISC_OFF + 512;
static_assert(LDS_BYTES <= 160 * 1024, "LDS map");

#define XB_TMO      128
#define XB_XCNT(j)  (256  + 64 * (j))
#define XB_XSUB(j)  (1280 + 64 * (j))
#define XB_XGEN(j)  (2304 + 64 * (j))
#define XB_TOP      3328
#define XB_TOPGEN   3392
#define XCD_BAR_WORDS 3456
#define XB_SPIN_CAP (1u << 18)
__device__ __forceinline__ unsigned xb_ld(unsigned* p)              { return __hip_atomic_load(p, __ATOMIC_RELAXED, __HIP_MEMORY_SCOPE_AGENT); }
__device__ __forceinline__ unsigned xb_add(unsigned* p, unsigned v) { return __hip_atomic_fetch_add(p, v, __ATOMIC_RELAXED, __HIP_MEMORY_SCOPE_AGENT); }
__device__ __forceinline__ unsigned xb_xcc_id() { return (unsigned)__builtin_amdgcn_s_getreg((3 << 11) | 20) & 0xFu; }
#define XB_SPIN(cond, bar) do { unsigned _sp = 0; while (cond) { __builtin_amdgcn_s_sleep(1); \
    if ((++_sp & 255u) == 0u) { if (xb_ld(&(bar)[XB_TMO])) break; if (_sp > XB_SPIN_CAP) { atomicAdd(&(bar)[XB_TMO], 1u); break; } } } } while (0)
struct XcdBarrier { unsigned* bar; unsigned x; volatile LAS unsigned* st; };
__device__ __forceinline__ XcdBarrier xcd_barrier_post(unsigned* bar, volatile LAS unsigned* st) {
    XcdBarrier b; b.bar = bar; b.x = xb_xcc_id(); b.st = st;
    if (threadIdx.x == 0) (void)xb_add(&bar[XB_XCNT(b.x)], 1u);
    return b;
}
__device__ __forceinline__ void xcd_barrier_complete(unsigned* bar, unsigned x, unsigned& nloc, unsigned& nx) {
    const unsigned G = gridDim.x * gridDim.y * gridDim.z;
    unsigned sum, cnt, mine, sp = 0u;
    for (;;) {
        sum = 0u; cnt = 0u; mine = 0u;
#pragma unroll
        for (unsigned j = 0; j < 16; ++j) { const unsigned c = xb_ld(&bar[XB_XCNT(j)]); sum += c; cnt += (c > 0u) ? 1u : 0u; mine = (j == x) ? c : mine; }
        if (sum == G) break;
        __builtin_amdgcn_s_sleep(1);
        if ((++sp & 255u) == 0u) { if (xb_ld(&bar[XB_TMO])) break; if (sp > XB_SPIN_CAP) { atomicAdd(&bar[XB_TMO], 1u); break; } }
    }
    nloc = mine > 0u ? mine : 1u; nx = cnt > 0u ? cnt : 1u;
}
__device__ __forceinline__ void xcd_barrier(const XcdBarrier& b) {
    asm volatile("s_waitcnt vmcnt(0)" ::: "memory");
    __syncthreads();
    if (threadIdx.x == 0) {
        unsigned* bar = b.bar;
        __builtin_amdgcn_s_waitcnt(0);
        unsigned nloc = b.st[0], nx = b.st[1];
        if (nloc == 0u) { xcd_barrier_complete(bar, b.x, nloc, nx); b.st[0] = nloc; b.st[1] = nx; }
        const unsigned old = xb_add(&bar[XB_XSUB(b.x)], 1u);
        const unsigned gen = old / nloc;
        if (old + 1u == (gen + 1u) * nloc) {
            __builtin_amdgcn_fence(__ATOMIC_RELEASE, "agent");
            asm volatile("s_waitcnt vmcnt(0)" ::: "memory");
            const unsigned og = xb_add(&bar[XB_TOP], 1u);
            const unsigned tg = og / nx;
            if (og + 1u == (tg + 1u) * nx) xb_add(&bar[XB_TOPGEN], 1u);
            else XB_SPIN(xb_ld(&bar[XB_TOPGEN]) == tg, bar);
            __builtin_amdgcn_fence(__ATOMIC_ACQUIRE, "agent");
            xb_add(&bar[XB_XGEN(b.x)], 1u);
            asm volatile("s_waitcnt vmcnt(0)" ::: "memory");
        } else {
            XB_SPIN(xb_ld(&bar[XB_XGEN(b.x)]) == gen, bar);
            __builtin_amdgcn_fence(__ATOMIC_ACQUIRE, "agent");
            asm volatile("s_waitcnt vmcnt(0)" ::: "memory");
        }
    }
    __syncthreads();
}
constexpr int CW_BAR = 4096;

namespace pg8 {
constexpr int BM = 256, BK = 64, HALF = 128, HTB = HALF * BK * 2, STAGE_BYTES = 8 * HTB, NXCD = 8, WGM = 8;
__host__ __device__ __forceinline__ int lds_byte(int r, int c) { return r * 128 + ((((c >> 3) ^ (r >> 1)) & 7) << 4); }
__host__ __device__ __forceinline__ void stage_rc(int b, int& R, int& C) { R = b >> 7; C = ((((b >> 4) ^ (R >> 1)) & 7) << 3); }
__host__ __device__ __forceinline__ int perm32(int rho) { const int n = rho >> 4, i = rho & 15; return 8 * (i >> 2) + 4 * n + (i & 3); }
struct Unit { int pm, pn, aux; };
typedef int v4i_t __attribute__((ext_vector_type(4)));
typedef int v8i_t __attribute__((ext_vector_type(8)));

__device__ __forceinline__ bool static_unit(int i, int G, int c, int nM, int nN, int& pm, int& pn) {
    const int nwg = nM * nN; const long L = (long)i * G + c; if (L >= nwg) return false;
    int wgid = (int)L; { const int q = nwg / NXCD, r = nwg % NXCD, xcd = wgid % NXCD, off = wgid / NXCD; wgid = (xcd < r ? xcd * (q + 1) : r * (q + 1) + (xcd - r) * q) + off; }
    const int nig = WGM * nN, gid = wgid / nig, fm = gid * WGM, gsz = (nM - fm) < WGM ? (nM - fm) : WGM;
    pm = fm + ((wgid % nig) % gsz); pn = (wgid % nig) / gsz; return true;
}

template <class Epi, class Sched, bool FP8>
__device__ __forceinline__ void gemm_phase(LAS unsigned char* lds, const Sched& S, const Epi& E, const int lda, const int ldb, const int nt) {
    const int tid = threadIdx.x, wid = __builtin_amdgcn_readfirstlane(tid >> 6), lane = tid & 63, wr = wid >> 2, wc = wid & 3, fr = lane & 15, fq = lane >> 4;
    int Rr[2], Cc[2]; unsigned voffB[2];
#pragma unroll
    for (int i = 0; i < 2; ++i) { stage_rc(tid * 16 + i * 8192, Rr[i], Cc[i]); const int Rb = (Rr[i] & ~31) + perm32(Rr[i] & 31); voffB[i] = (unsigned)(Rb * ldb + Cc[i] * 2); }
    const size_t kstep = (size_t)(BK * 2);
    const size_t hstepB = (size_t)HALF * ldb;
    const size_t hstepA = Sched::GATHER ? (size_t)0 : (size_t)HALF * lda;
    const unsigned ldsw = (unsigned)wid * 1024u;
    const int aoff = lds_byte(wr * 64 + fr, fq * 8), boff = lds_byte(wc * 32 + fr, fq * 8);
#define PG8_SA(b, h) (((b) * 2 + (h)) * HTB)
#define PG8_SB(b, h) ((4 + (b) * 2 + (h)) * HTB)
#define PG8_STAGE(bufoff, gbase, voff) do { _Pragma("unroll") for (int _i = 0; _i < 2; ++_i) \
        __builtin_amdgcn_global_load_lds((const unsigned*)((const char*)(gbase) + (voff)[_i]), (LAS unsigned*)(lds + (bufoff) + ldsw + _i * 8192), 16, 0, 0); } while (0)
#define PG8_LDA(dst, b, h) do { _Pragma("unroll") for (int m = 0; m < 4; ++m) _Pragma("unroll") for (int k = 0; k < 2; ++k) dst[m][k] = *(const LAS bf16x8*)(lds + PG8_SA(b, h) + (aoff ^ (k * 64)) + m * 2048); } while (0)
#define PG8_LDB(dst, b, h) do { _Pragma("unroll") for (int n = 0; n < 2; ++n) _Pragma("unroll") for (int k = 0; k < 2; ++k) dst[n][k] = *(const LAS bf16x8*)(lds + PG8_SB(b, h) + (boff ^ (k * 64)) + n * 2048); } while (0)
#define PG8_CAT(x) __builtin_shufflevector(__builtin_bit_cast(v4i_t, (x)[0]), __builtin_bit_cast(v4i_t, (x)[1]), 0, 1, 2, 3, 4, 5, 6, 7)
#define PG8_MMA(ai, bj, At, Bt) do { __builtin_amdgcn_s_setprio(1); if constexpr (FP8) { _Pragma("unroll") for (int m = 0; m < 4; ++m) _Pragma("unroll") for (int n = 0; n < 2; ++n) \
        acc[ai][bj][m][n] = __builtin_amdgcn_mfma_scale_f32_16x16x128_f8f6f4(PG8_CAT(Bt[n]), PG8_CAT(At[m]), acc[ai][bj][m][n], 0, 0, 0, 0x7F7F7F7F, 0, 0x7F7F7F7F); } \
    else { _Pragma("unroll") for (int m = 0; m < 4; ++m) _Pragma("unroll") for (int n = 0; n < 2; ++n) _Pragma("unroll") for (int k = 0; k < 2; ++k) \
        acc[ai][bj][m][n] = __builtin_amdgcn_mfma_f32_16x16x32_bf16(Bt[n][k], At[m][k], acc[ai][bj][m][n], 0, 0, 0); } __builtin_amdgcn_s_setprio(0); } while (0)
#define PG8_WAIT_V(n) asm volatile("s_waitcnt vmcnt(" #n ")" ::: "memory")
#define PG8_WAIT_L(n) asm volatile("s_waitcnt lgkmcnt(" #n ")" ::: "memory")
#define PG8_BAR __builtin_amdgcn_s_barrier()
#define PG8_SCHED __builtin_amdgcn_sched_barrier(0)
    Unit cur, nxt; int ui = 0;
    if (!S.next(0, cur)) return;
    f32x4 acc[2][2][4][2];
#pragma unroll
    for (int a = 0; a < 2; ++a)
#pragma unroll
        for (int b = 0; b < 2; ++b)
#pragma unroll
            for (int m = 0; m < 4; ++m)
#pragma unroll
                for (int n = 0; n < 2; ++n) acc[a][b][m][n] = (f32x4){0.f, 0.f, 0.f, 0.f};
    bf16x8 At[4][2], B0[2][2], B1[2][2];
    unsigned oA[2][2];
#pragma unroll
    for (int h = 0; h < 2; ++h)
#pragma unroll
        for (int i = 0; i < 2; ++i) oA[h][i] = Sched::GATHER ? (S.goff(0, h * HALF + Rr[i]) + (unsigned)Cc[i] * 2u) : (unsigned)(Rr[i] * lda + Cc[i] * 2);
    const char* cA = S.aptr(cur); const char* cB = S.bptr(cur);
    PG8_STAGE(PG8_SB(0, 0), cB, voffB); PG8_STAGE(PG8_SB(0, 1), cB + hstepB, voffB); PG8_STAGE(PG8_SA(0, 0), cA, oA[0]); PG8_STAGE(PG8_SA(0, 1), cA + hstepA, oA[1]);
    if (wr == 1) PG8_BAR;
    PG8_WAIT_V(2); PG8_BAR;
    PG8_STAGE(PG8_SB(1, 0), cB + kstep, voffB); PG8_STAGE(PG8_SA(1, 0), cA + kstep, oA[0]); PG8_STAGE(PG8_SB(1, 1), cB + hstepB + kstep, voffB);
    PG8_WAIT_V(6); PG8_BAR;
    for (;;) {
        const bool has_next = S.next(ui + 1, nxt);
        const char* nA = has_next ? S.aptr(nxt) : cA; const char* nB = has_next ? S.bptr(nxt) : cB;
#pragma clang loop unroll(disable)
        for (int t = 0; t < nt; t += 2) {
            const bool last = (t == nt - 2);
            const char* a1 = cA + (size_t)(t + 1) * kstep;
            const char* a2 = last ? nA : cA + (size_t)(t + 2) * kstep; const char* b2 = last ? nB : cB + (size_t)(t + 2) * kstep;
            const char* a3 = a2 + kstep; const char* b3 = b2 + kstep;
            PG8_LDB(B0, 0, 0); PG8_LDB(B1, 0, 1); PG8_SCHED; PG8_LDA(At, 0, 0); PG8_STAGE(PG8_SA(1, 1), a1 + hstepA, oA[1]);
            if constexpr (Sched::GATHER) { if (last && has_next) {
#pragma unroll
                for (int h = 0; h < 2; ++h)
#pragma unroll
                    for (int i = 0; i < 2; ++i) oA[h][i] = S.goff(ui + 1, h * HALF + Rr[i]) + (unsigned)Cc[i] * 2u; } }
            PG8_WAIT_V(8); PG8_WAIT_L(0); PG8_BAR; PG8_MMA(0, 0, At, B0); PG8_MMA(0, 1, At, B1); PG8_BAR; PG8_SCHED;
            PG8_LDA(At, 0, 1); PG8_STAGE(PG8_SB(0, 0), b2, voffB); PG8_STAGE(PG8_SB(0, 1), b2 + hstepB, voffB); PG8_STAGE(PG8_SA(0, 0), a2, oA[0]);
            PG8_WAIT_V(8); PG8_WAIT_L(0); PG8_BAR; PG8_MMA(1, 0, At, B0); PG8_MMA(1, 1, At, B1); PG8_BAR; PG8_SCHED;
            PG8_LDB(B0, 1, 0); PG8_LDB(B1, 1, 1); PG8_SCHED; PG8_LDA(At, 1, 0); PG8_STAGE(PG8_SA(0, 1), a2 + hstepA, oA[1]);
            PG8_WAIT_V(8); PG8_WAIT_L(0); PG8_BAR; PG8_MMA(0, 0, At, B0); PG8_MMA(0, 1, At, B1); PG8_BAR; PG8_SCHED;
            PG8_LDA(At, 1, 1); PG8_STAGE(PG8_SB(1, 0), b3, voffB); PG8_STAGE(PG8_SB(1, 1), b3 + hstepB, voffB); PG8_STAGE(PG8_SA(1, 0), a3, oA[0]);
            PG8_WAIT_V(8); PG8_WAIT_L(0); PG8_BAR; PG8_MMA(1, 0, At, B0); PG8_MMA(1, 1, At, B1); PG8_BAR; PG8_SCHED;
        }
        if (wr == 0) PG8_BAR;
        bool keep = false;
        {
            int tz = threadIdx.x; asm volatile("" : "+v"(tz)); const int ewid = tz >> 6, el = tz & 63, ewr = ewid >> 2, ewc = ewid & 3, efr = el & 15, efq = el >> 4;
            if constexpr (Sched::HAS_MID) { if (S.is_mid(cur)) { E.mid(acc, cur, ewr, ewc, efr, efq); keep = true; } }
            if (!keep) E(acc, cur, ewr, ewc, efr, efq);
        }
        if (!has_next) break;
        if (!keep) {
#pragma unroll
            for (int a = 0; a < 2; ++a)
#pragma unroll
                for (int b = 0; b < 2; ++b)
#pragma unroll
                    for (int m = 0; m < 4; ++m)
#pragma unroll
                        for (int n = 0; n < 2; ++n) acc[a][b][m][n] = (f32x4){0.f, 0.f, 0.f, 0.f};
        }
        cur = nxt; cA = nA; cB = nB; ++ui;
        if (wr == 1) PG8_BAR;
    }
    PG8_WAIT_V(0);
    PG8_BAR;
#undef PG8_SA
#undef PG8_SB
#undef PG8_STAGE
#undef PG8_LDA
#undef PG8_LDB
#undef PG8_MMA
#undef PG8_CAT
#undef PG8_WAIT_V
#undef PG8_WAIT_L
#undef PG8_BAR
#undef PG8_SCHED
}
}
using pg8::Unit;

struct Args { const float* in[25]; float* out; unsigned char* ws; int ph_lo, ph_hi, pad0, pad1; };
static_assert(sizeof(Args) == 27 * 8 + 16, "Args has no padding");
struct Frame {
    LAS unsigned char* lds; volatile LAS unsigned* MISC; unsigned* ctl;
    int tid, lane, wave, vcu, G;
};
#define LDS_WAIT() asm volatile("s_waitcnt lgkmcnt(0)" ::: "memory")
#define VM_WAIT() asm volatile("s_waitcnt vmcnt(0)" ::: "memory")

struct SchedStatic {
    static constexpr bool GATHER = false, HAS_MID = false;
    const char* A; const char* B; int nM, nN, G, c; size_t astep, bstep;
    __device__ __forceinline__ bool next(int i, Unit& u) const { u.aux = 0; return pg8::static_unit(i, G, c, nM, nN, u.pm, u.pn); }
    __device__ __forceinline__ const char* aptr(const Unit& u) const { return A + (size_t)u.pm * astep; }
    __device__ __forceinline__ const char* bptr(const Unit& u) const { return B + (size_t)u.pn * bstep; }
    __device__ __forceinline__ bool is_mid(const Unit&) const { return false; }
    __device__ __forceinline__ unsigned goff(int, int) const { return 0u; }
};
struct SchedSplit2 {
    static constexpr bool GATHER = false, HAS_MID = true;
    const char* A; const char* B; int nM, nN, G, c; size_t astep, bstep, khalf;
    __device__ __forceinline__ bool next(int i, Unit& u) const { u.aux = i & 1; return pg8::static_unit(i >> 1, G, c, nM, nN, u.pm, u.pn); }
    __device__ __forceinline__ const char* aptr(const Unit& u) const { return A + (size_t)u.pm * astep + (size_t)u.aux * khalf; }
    __device__ __forceinline__ const char* bptr(const Unit& u) const { return B + (size_t)u.pn * bstep + (size_t)u.aux * khalf; }
    __device__ __forceinline__ bool is_mid(const Unit& u) const { return u.aux == 0; }
    __device__ __forceinline__ unsigned goff(int, int) const { return 0u; }
};
__device__ __forceinline__ int moe_find_e(volatile LAS unsigned* MISC, int rb) { int e = 0;
#pragma unroll 1
    for (int i = 1; i < NEXP; ++i) e += ((int)MISC[i] <= rb) ? 1 : 0;
    return e; }
template <int NPN, bool GATH>
struct SchedMoe {
    static constexpr bool GATHER = GATH, HAS_MID = false;
    static constexpr int RPX = 32 / NPN;
    static constexpr int UT0 = 96, UTN = 24;
    const char* A; const char* B; volatile LAS unsigned* MISC; const LAS unsigned* gtab; int c, G, nrb; size_t bstep_e, bstep_n;
    __device__ __forceinline__ bool slow_next(int i, Unit& u) const {
        int rb, pn;
        if (G == 256) { const int x = c & 7, j = c >> 3; rb = (8 * i + x) * RPX + j / NPN; pn = j % NPN; }
        else { const long L = (long)i * G + c; rb = (int)(L / NPN); pn = (int)(L % NPN); }
        if (rb >= nrb) return false;
        u.pm = rb; u.pn = pn; u.aux = moe_find_e(MISC, rb); return true;
    }
    __device__ __forceinline__ void build(int tid) const {
        if (tid < UTN) { Unit u; const bool ok = slow_next(tid, u); MISC[UT0 + tid] = ok ? (0x80000000u | ((unsigned)u.aux << 16) | ((unsigned)u.pn << 12) | (unsigned)u.pm) : 0u; }
        __syncthreads();
    }
    __device__ __forceinline__ bool next(int i, Unit& u) const {
        if (i >= UTN) return false;
        const unsigned w = MISC[UT0 + i]; if (!(w >> 31)) return false;
        u.pm = (int)(w & 0xfffu); u.pn = (int)((w >> 12) & 0xfu); u.aux = (int)((w >> 16) & 0xffu); return true;
    }
    __device__ __forceinline__ const char* aptr(const Unit& u) const { return GATH ? A : A + (size_t)u.pm * (256 * 1024); }
    __device__ __forceinline__ const char* bptr(const Unit& u) const { return B + (size_t)u.aux * bstep_e + (size_t)u.pn * bstep_n; }
    __device__ __forceinline__ bool is_mid(const Unit&) const { return false; }
    __device__ __forceinline__ unsigned goff(int ui, int row) const { return gtab[ui * 256 + row]; }
};

#define EPI_ARGS f32x4 (&acc)[2][2][4][2], const Unit& u, int wr, int wc, int fr, int fq
struct EpiG1 {
    bf16 *Q, *K, *V, *U, *VG, *GT; const float* bgate;
    __device__ __forceinline__ void mid(EPI_ARGS) const {}
    __device__ __forceinline__ void operator()(EPI_ARGS) const {
        const int pn = u.pn; const int row0 = u.pm * 256 + wr * 64 + fr;
        if (pn < 6) {
            const int t = pn >> 1; bf16* base = Q + (size_t)t * ((WS_K - WS_Q) / 2); const float sc = (t == 0) ? QSCALE : 1.0f;    const int col0 = (pn & 1) * 256 + wc * 32 + 8 * fq;
#pragma unroll
            for (int ai = 0; ai < 2; ++ai)
#pragma unroll
                for (int m = 0; m < 4; ++m) { bf16* rowp = base + (size_t)(row0 + ai * 128 + m * 16) * 512 + col0;
#pragma unroll
                    for (int bj = 0; bj < 2; ++bj) { const f32x4 v0 = acc[ai][bj][m][0] * sc, v1 = acc[ai][bj][m][1] * sc;
                        u32x4 w; w.x = cvtpk(v0[0], v0[1]); w.y = cvtpk(v0[2], v0[3]); w.z = cvtpk(v1[0], v1[1]); w.w = cvtpk(v1[2], v1[3]); *(u32x4*)(rowp + bj * 128) = w; } }
        } else if (pn < 10) {
            bf16* base = Q + (size_t)(pn >> 1) * ((WS_K - WS_Q) / 2); const int col0 = (pn & 1) * 256 + wc * 32 + 8 * fq;
#pragma unroll
            for (int ai = 0; ai < 2; ++ai)
#pragma unroll
                for (int m = 0; m < 4; ++m) { bf16* rowp = base + (size_t)(row0 + ai * 128 + m * 16) * 512 + col0;
#pragma unroll
                    for (int bj = 0; bj < 2; ++bj) { const f32x4 v0 = acc[ai][bj][m][0], v1 = acc[ai][bj][m][1];
                        const f32x2 a = gelu_pk((f32x2){v0[0], v0[1]}), b = gelu_pk((f32x2){v0[2], v0[3]}), c = gelu_pk((f32x2){v1[0], v1[1]}), d = gelu_pk((f32x2){v1[2], v1[3]});
                        u32x4 w; w.x = cvtpk(a.x, a.y); w.y = cvtpk(b.x, b.y); w.z = cvtpk(c.x, c.y); w.w = cvtpk(d.x, d.y); *(u32x4*)(rowp + bj * 128) = w; } }
        } else {
            const int col0 = (pn - 10) * 256 + wc * 32 + 8 * fq;
            f32x4 bv[2][2];
#pragma unroll
            for (int bj = 0; bj < 2; ++bj)
#pragma unroll
                for (int n = 0; n < 2; ++n) bv[bj][n] = *(const f32x4*)(bgate + col0 + bj * 128 + 4 * n);
#pragma unroll
            for (int ai = 0; ai < 2; ++ai)
#pragma unroll
                for (int m = 0; m < 4; ++m) { bf16* rowp = GT + (size_t)(row0 + ai * 128 + m * 16) * 2048 + col0;
#pragma unroll
                    for (int bj = 0; bj < 2; ++bj) { const f32x4 v0 = acc[ai][bj][m][0] + bv[bj][0], v1 = acc[ai][bj][m][1] + bv[bj][1];
                        const f32x2 a = sigmoid_pk((f32x2){v0[0], v0[1]}), b = sigmoid_pk((f32x2){v0[2], v0[3]}), c = sigmoid_pk((f32x2){v1[0], v1[1]}), d = sigmoid_pk((f32x2){v1[2], v1[3]});
                        u32x4 w; w.x = cvtpk(a.x, a.y); w.y = cvtpk(b.x, b.y); w.z = cvtpk(c.x, c.y); w.w = cvtpk(d.x, d.y); *(u32x4*)(rowp + bj * 128) = w; } }
        }
    }
};
struct EpiG2 {
    const bf16* GT; bf16* MRG;
    __device__ __forceinline__ void mid(EPI_ARGS) const {
        const int row0 = u.pm * 256 + wr * 64 + fr, col0 = u.pn * 256 + wc * 32 + 8 * fq;
#pragma unroll
        for (int ai = 0; ai < 2; ++ai)
#pragma unroll
            for (int m = 0; m < 4; ++m) { const bf16* gp = GT + (size_t)(row0 + ai * 128 + m * 16) * 2048 + col0;
#pragma unroll
                for (int bj = 0; bj < 2; ++bj) { const u32x4 ga = __builtin_nontemporal_load((const u32x4*)(gp + bj * 128)), gb = *(const u32x4*)(gp + 1024 + bj * 128);
                    f32x4 r0, r1;
                    r0[0] = bflo(ga.x) * __builtin_amdgcn_rcpf(fmaxf(bflo(gb.x), 1e-30f)); r0[1] = bfhi(ga.x) * __builtin_amdgcn_rcpf(fmaxf(bfhi(gb.x), 1e-30f));
                    r0[2] = bflo(ga.y) * __builtin_amdgcn_rcpf(fmaxf(bflo(gb.y), 1e-30f)); r0[3] = bfhi(ga.y) * __builtin_amdgcn_rcpf(fmaxf(bfhi(gb.y), 1e-30f));
                    r1[0] = bflo(ga.z) * __builtin_amdgcn_rcpf(fmaxf(bflo(gb.z), 1e-30f)); r1[1] = bfhi(ga.z) * __builtin_amdgcn_rcpf(fmaxf(bfhi(gb.z), 1e-30f));
                    r1[2] = bflo(ga.w) * __builtin_amdgcn_rcpf(fmaxf(bflo(gb.w), 1e-30f)); r1[3] = bfhi(ga.w) * __builtin_amdgcn_rcpf(fmaxf(bfhi(gb.w), 1e-30f));
                    acc[ai][bj][m][0] *= r0; acc[ai][bj][m][1] *= r1; } }
    }
    __device__ __forceinline__ void operator()(EPI_ARGS) const {
        const int row0 = u.pm * 256 + wr * 64 + fr, col0 = u.pn * 256 + wc * 32 + 8 * fq;
#pragma unroll
        for (int ai = 0; ai < 2; ++ai)
#pragma unroll
            for (int m = 0; m < 4; ++m) { const size_t r = (size_t)(row0 + ai * 128 + m * 16); const bf16* gp = GT + r * 2048 + 1024 + col0; bf16* op = MRG + r * 1024 + col0;
#pragma unroll
                for (int bj = 0; bj < 2; ++bj) { const u32x4 gb = __builtin_nontemporal_load((const u32x4*)(gp + bj * 128)); const f32x4 v0 = acc[ai][bj][m][0], v1 = acc[ai][bj][m][1];
                    u32x4 w; w.x = cvtpk(v0[0] * bflo(gb.x), v0[1] * bfhi(gb.x)); w.y = cvtpk(v0[2] * bflo(gb.y), v0[3] * bfhi(gb.y));
                    w.z = cvtpk(v1[0] * bflo(gb.z), v1[1] * bfhi(gb.z)); w.w = cvtpk(v1[2] * bflo(gb.w), v1[3] * bfhi(gb.w)); *(u32x4*)(op + bj * 128) = w; } }
    }
};
struct EpiPlain {
    bf16* O;
    __device__ __forceinline__ void mid(EPI_ARGS) const {}
    __device__ __forceinline__ void operator()(EPI_ARGS) const {
        const int row0 = u.pm * 256 + wr * 64 + fr, col0 = u.pn * 256 + wc * 32 + 8 * fq;
#pragma unroll
        for (int ai = 0; ai < 2; ++ai)
#pragma unroll
            for (int m = 0; m < 4; ++m) { bf16* op = O + (size_t)(row0 + ai * 128 + m * 16) * 1024 + col0;
#pragma unroll
                for (int bj = 0; bj < 2; ++bj) { const f32x4 v0 = acc[ai][bj][m][0], v1 = acc[ai][bj][m][1];
                    u32x4 w; w.x = cvtpk(v0[0], v0[1]); w.y = cvtpk(v0[2], v0[3]); w.z = cvtpk(v1[0], v1[1]); w.w = cvtpk(v1[2], v1[3]); *(u32x4*)(op + bj * 128) = w; } }
    }
};
struct EpiAct {
    const float* bgu; unsigned char* ACT8;
    __device__ __forceinline__ void mid(EPI_ARGS) const {}
    __device__ __forceinline__ f32x2 act2(f32x2 g, f32x2 l) const {
        f32x2 xg, xl; xg.x = fminf(g.x, SWL); xg.y = fminf(g.y, SWL); xl.x = fminf(fmaxf(l.x, -SWL), SWL); xl.y = fminf(fmaxf(l.y, -SWL), SWL);
        const f32x2 t = xg * (-SWA * LOG2E); f32x2 e; e.x = __builtin_amdgcn_exp2f(t.x); e.y = __builtin_amdgcn_exp2f(t.y);
        const f32x2 d = e + 1.0f; f32x2 r; r.x = __builtin_amdgcn_rcpf(d.x); r.y = __builtin_amdgcn_rcpf(d.y);
        return (xg * r) * (xl * F8_ASCALE + F8_ASCALE);
    }
    __device__ __forceinline__ void operator()(EPI_ARGS) const {
        const int e = u.aux; const int row0 = u.pm * 256 + wr * 64 + fr, col0 = u.pn * 128 + wc * 32 + 8 * fq;
        const float* bp = bgu + (size_t)e * 2048 + col0;
        const f32x4 bg0 = *(const f32x4*)(bp), bg1 = *(const f32x4*)(bp + 4), bl0 = *(const f32x4*)(bp + 1024), bl1 = *(const f32x4*)(bp + 1028);
#pragma unroll
        for (int ai = 0; ai < 2; ++ai)
#pragma unroll
            for (int m = 0; m < 4; ++m) {
                const f32x4 g0 = acc[ai][0][m][0] * F8_DESCALE + bg0, g1 = acc[ai][0][m][1] * F8_DESCALE + bg1, l0 = acc[ai][1][m][0] * F8_DESCALE + bl0, l1 = acc[ai][1][m][1] * F8_DESCALE + bl1;
                const f32x2 o0 = act2((f32x2){g0[0], g0[1]}, (f32x2){l0[0], l0[1]}), o1 = act2((f32x2){g0[2], g0[3]}, (f32x2){l0[2], l0[3]});
                const f32x2 o2 = act2((f32x2){g1[0], g1[1]}, (f32x2){l1[0], l1[1]}), o3 = act2((f32x2){g1[2], g1[3]}, (f32x2){l1[2], l1[3]});
                u32x2 w; w.x = pk_fp8x4(o0.x, o0.y, o1.x, o1.y); w.y = pk_fp8x4(o2.x, o2.y, o3.x, o3.y);
                *(u32x2*)(ACT8 + (size_t)(row0 + ai * 128 + m * 16) * 1024 + col0) = w; }
    }
};
struct EpiDown {
    const float* bdn; unsigned char* Y2s;
    __device__ __forceinline__ void mid(EPI_ARGS) const {}
    __device__ __forceinline__ void operator()(EPI_ARGS) const {
        const int e = u.aux; const int row0 = u.pm * 256 + wr * 64 + fr, col0 = u.pn * 256 + wc * 32 + 8 * fq;
        f32x4 bv[2][2];
#pragma unroll
        for (int bj = 0; bj < 2; ++bj)
#pragma unroll
            for (int n = 0; n < 2; ++n) bv[bj][n] = *(const f32x4*)(bdn + (size_t)e * 1024 + col0 + bj * 128 + 4 * n) * F8_YSCALE;
#pragma unroll
        for (int ai = 0; ai < 2; ++ai)
#pragma unroll
            for (int m = 0; m < 4; ++m) { unsigned char* op = Y2s + (size_t)(row0 + ai * 128 + m * 16) * 1024 + col0;
#pragma unroll
                for (int bj = 0; bj < 2; ++bj) { const f32x4 v0 = acc[ai][bj][m][0] * (F8_DESCALE * F8_YSCALE) + bv[bj][0], v1 = acc[ai][bj][m][1] * (F8_DESCALE * F8_YSCALE) + bv[bj][1];
                    u32x2 w; w.x = pk_fp8x4(v0[0], v0[1], v0[2], v0[3]); w.y = pk_fp8x4(v1[0], v1[1], v1[2], v1[3]); *(u32x2*)(op + bj * 128) = w; } }
    }
};

struct WItem { const float* W; unsigned char* dst; int N, k0, n0, ldt, drow, dk0, fp8; };
__device__ __forceinline__ WItem witem_decode(const Args& a, int r) {
    unsigned char* ws = a.ws; WItem it;
    constexpr int I_IN = 8 * 80, I_GATE = 8 * 64, I_BR = 4 * 32, I_OUT = 8 * 32, I_GU = 8 * 64, I_DN = 8 * 32;
    it.fp8 = 0; it.dk0 = 0; it.ldt = 2048;
    if (r < I_IN) { it.W = a.in[6]; it.N = INW; it.k0 = 128 * (r / 80); it.n0 = 32 * (r % 80); it.dst = ws + WS_W1T; it.drow = it.n0; return it; } r -= I_IN;
    if (r < I_GATE) { it.W = a.in[14]; it.N = 2048; it.k0 = 128 * (r / 64); it.n0 = 32 * (r % 64); it.dst = ws + WS_W1T; it.drow = INW + it.n0; return it; } r -= I_GATE;
    if (r < I_BR) { it.W = a.in[12]; it.N = 1024; it.k0 = 128 * (r / 32); it.n0 = 32 * (r % 32); it.dst = ws + WS_WBRT; it.drow = it.n0; return it; } r -= I_BR;
    if (r < I_BR) { it.W = a.in[13]; it.N = 1024; it.k0 = 128 * (r / 32); it.n0 = 32 * (r % 32); it.dst = ws + WS_WBRT; it.drow = it.n0; it.dk0 = 512; return it; } r -= I_BR;
    if (r < I_OUT) { it.W = a.in[16]; it.N = 1024; it.k0 = 128 * (r / 32); it.n0 = 32 * (r % 32); it.dst = ws + WS_WOUTT; it.drow = it.n0; return it; } r -= I_OUT;
    it.fp8 = 1; it.ldt = 1024;
    if (r < NEXP * I_GU) { const int e = r / I_GU, q = r % I_GU; it.W = a.in[21] + (size_t)e * D * 2048; it.N = 2048; it.k0 = 128 * (q / 64); it.n0 = 32 * (q % 64); it.dst = ws + WS_WGUT + (size_t)e * 2048 * 1024;
        const int m0 = it.n0 & 1023; it.drow = 256 * (m0 >> 7) + (m0 & 127) + (it.n0 >= 1024 ? 128 : 0); return it; }
    r -= NEXP * I_GU;
    { const int e = r / I_DN, q = r % I_DN; it.W = a.in[23] + (size_t)e * D * D; it.N = 1024; it.k0 = 128 * (q / 32); it.n0 = 32 * (q % 32); it.dst = ws + WS_WDNT + (size_t)e * 1024 * 1024; it.drow = it.n0; }
    return it;
}
constexpr int W_NITEMS = 8 * 80 + 8 * 64 + 2 * 4 * 32 + 8 * 32 + NEXP * (8 * 64 + 8 * 32);
__device__ __forceinline__ void witem_load(const WItem& it, float (&v)[64], int lane) {
    const float* p = it.W + (size_t)(it.k0 + (lane >> 3)) * it.N + it.n0 + (lane & 7) * 4;
#pragma unroll
    for (int i = 0; i < 16; ++i) { const f32x4 t = __builtin_nontemporal_load((const f32x4*)(p + (size_t)(8 * i) * it.N)); v[4 * i] = t[0]; v[4 * i + 1] = t[1]; v[4 * i + 2] = t[2]; v[4 * i + 3] = t[3]; }
}
__device__ __forceinline__ void witem_store(const WItem& it, const float (&v)[64], LAS float* scr, int lane) {
#pragma unroll
    for (int i = 0; i < 16; ++i) { const int k = 8 * i + (lane >> 3); *(LAS f32x4*)(scr + k * 32 + (((lane & 7) * 4 + 4 * (i >> 1)) & 31)) = (f32x4){v[4 * i], v[4 * i + 1], v[4 * i + 2], v[4 * i + 3]}; }
    LDS_WAIT(); asm volatile("" ::: "memory");
    const int c = lane & 7;
#pragma unroll
    for (int j = 0; j < 4; ++j) { const int n = (lane >> 3) + 8 * j; const LAS float* s = scr + (16 * c) * 32 + ((n + 4 * c) & 31);
        float x[16];
#pragma unroll
        for (int q = 0; q < 16; ++q) x[q] = s[q * 32];
        unsigned char* d = it.dst + (size_t)(it.drow + n) * it.ldt;
        if (it.fp8) { u32x4 o;
            o.x = pk_fp8x4(x[0] * F8_WSCALE, x[1] * F8_WSCALE, x[2] * F8_WSCALE, x[3] * F8_WSCALE); o.y = pk_fp8x4(x[4] * F8_WSCALE, x[5] * F8_WSCALE, x[6] * F8_WSCALE, x[7] * F8_WSCALE);
            o.z = pk_fp8x4(x[8] * F8_WSCALE, x[9] * F8_WSCALE, x[10] * F8_WSCALE, x[11] * F8_WSCALE); o.w = pk_fp8x4(x[12] * F8_WSCALE, x[13] * F8_WSCALE, x[14] * F8_WSCALE, x[15] * F8_WSCALE);
            *(u32x4*)(d + it.dk0 + it.k0 + 16 * c) = o; }
        else { u32x4 o0, o1;
            o0.x = cvtpk(x[0], x[1]); o0.y = cvtpk(x[2], x[3]); o0.z = cvtpk(x[4], x[5]); o0.w = cvtpk(x[6], x[7]); o1.x = cvtpk(x[8], x[9]); o1.y = cvtpk(x[10], x[11]); o1.z = cvtpk(x[12], x[13]); o1.w = cvtpk(x[14], x[15]);
            *(u32x4*)(d + (size_t)(it.dk0 + it.k0 + 16 * c) * 2) = o0; *(u32x4*)(d + (size_t)(it.dk0 + it.k0 + 16 * c) * 2 + 16) = o1; } }
    LDS_WAIT(); asm volatile("" ::: "memory");
}
__device__ __forceinline__ void phaseA(const Frame& F, const Args& a) {
    unsigned char* ws = a.ws;
    if (F.vcu < 192) {
        const float* c = a.in[1]; const float* w_ada = a.in[2]; const float* b_ada = a.in[3]; float* mod = (float*)(ws + WS_MOD);
        LAS float* red = (LAS float*)(F.lds);
        const int col = F.vcu * 32 + (F.tid & 31), ks = F.tid >> 5;
        float a0 = 0.f, a1 = 0.f, a2 = 0.f, a3 = 0.f;
        for (int k = ks * 64; k < ks * 64 + 64; ++k) { const float w = __builtin_nontemporal_load(w_ada + (size_t)k * 6144 + col);
            const float c0 = c[k], c1 = c[D + k], c2 = c[2 * D + k], c3 = c[3 * D + k];
            a0 += c0 * __builtin_amdgcn_rcpf(1.0f + __expf(-c0)) * w; a1 += c1 * __builtin_amdgcn_rcpf(1.0f + __expf(-c1)) * w;
            a2 += c2 * __builtin_amdgcn_rcpf(1.0f + __expf(-c2)) * w; a3 += c3 * __builtin_amdgcn_rcpf(1.0f + __expf(-c3)) * w; }
        red[(ks * 4 + 0) * 32 + (F.tid & 31)] = a0; red[(ks * 4 + 1) * 32 + (F.tid & 31)] = a1; red[(ks * 4 + 2) * 32 + (F.tid & 31)] = a2; red[(ks * 4 + 3) * 32 + (F.tid & 31)] = a3;
        __syncthreads();
        if (F.tid < 128) { const int b = F.tid >> 5, cc = F.tid & 31; float s = 0.f;
#pragma unroll
            for (int k = 0; k < 16; ++k) s += red[(k * 4 + b) * 32 + cc];
            mod[b * 6144 + F.vcu * 32 + cc] = s + b_ada[F.vcu * 32 + cc]; }
        __syncthreads();
    }
    if (F.vcu == 192 % F.G) {
        const float* w_router = a.in[19]; bf16* wrt = (bf16*)(ws + WS_WRT);
        for (int i = F.tid; i < D * NEXP; i += NWAVES * 64) { const int k = i >> 5, e = i & 31; const float w = w_router[i]; const unsigned hh = cvtpk(w, 0.f) & 0xffffu;
            wrt[(size_t)e * D + k] = (bf16)hh; wrt[(size_t)(NEXP + e) * D + k] = (bf16)(cvtpk(w - bflo(hh), 0.f) & 0xffffu); }
    }
    LAS float* scr = (LAS float*)(F.lds + F.wave * 17408);
    const int gw = F.vcu * NWAVES + F.wave, NGW = F.G * NWAVES;
    if (gw < W_NITEMS) {
        float va[64], vb[64];
        WItem ia = witem_decode(a, gw), ib = ia;
        witem_load(ia, va, F.lane);
        for (int it = gw; it < W_NITEMS; it += 2 * NGW) {
            const bool hb = (it + NGW < W_NITEMS);
            ib = witem_decode(a, hb ? it + NGW : it); witem_load(ib, vb, F.lane);
            witem_store(ia, va, scr, F.lane);
            if (!hb) break;
            const bool ha = (it + 2 * NGW < W_NITEMS);
            ia = witem_decode(a, ha ? it + 2 * NGW : it); witem_load(ia, va, F.lane);
            witem_store(ib, vb, scr, F.lane);
            if (!ha) break;
        }
    }
}
__device__ __forceinline__ void phaseB(const Frame& F, const Args& a) {
    const float* x = a.in[0]; const float* g = a.in[4]; const float* mod = (const float*)(a.ws + WS_MOD); bf16* xn = (bf16*)(a.ws + WS_XN);
    const int gw = F.vcu * NWAVES + F.wave, NGW = F.G * NWAVES;
    f32x4 cg[4], csh[4]; int cb = -1;
    for (int row0 = gw * 4; row0 < NTOK; row0 += NGW * 4) {
        f32x4 v[4][4];
#pragma unroll
        for (int rr = 0; rr < 4; ++rr)
#pragma unroll
            for (int j = 0; j < 4; ++j) v[rr][j] = __builtin_nontemporal_load((const f32x4*)(x + (size_t)(row0 + rr) * D) + F.lane + 64 * j);
        const int b = row0 / SEQ; const float* mb = mod + b * 6144;
        if (b != cb) { cb = b;
#pragma unroll
            for (int j = 0; j < 4; ++j) { const int c0 = (F.lane + 64 * j) * 4; cg[j] = *(const f32x4*)(g + c0) * (*(const f32x4*)(mb + SC1 + c0) + 1.0f); csh[j] = *(const f32x4*)(mb + SH1 + c0); } }
#pragma unroll
        for (int rr = 0; rr < 4; ++rr) {
            float ss = 0.f;
#pragma unroll
            for (int j = 0; j < 4; ++j) ss += (v[rr][j].x * v[rr][j].x + v[rr][j].y * v[rr][j].y) + (v[rr][j].z * v[rr][j].z + v[rr][j].w * v[rr][j].w);
            const float rstd = rsqrtf(wsum(ss) * (1.0f / D) + EPS);
            u32x2* o8 = (u32x2*)(xn + (size_t)(row0 + rr) * D) + F.lane;
#pragma unroll
            for (int j = 0; j < 4; ++j) {
                const f32x4 h = v[rr][j] * rstd * cg[j] + csh[j];
                u32x2 w; w.x = cvtpk(h[0], h[1]); w.y = cvtpk(h[2], h[3]); o8[64 * j] = w; }
        }
    }
}

constexpr int SGU_STRIDE = 1088;
__device__ __forceinline__ s16x4 vtr(const LAS unsigned char* p) { typedef short v4i16_t __attribute__((ext_vector_type(4))); return __builtin_bit_cast(s16x4, __builtin_amdgcn_ds_read_tr16_b64_v4i16((LAS v4i16_t*)p)); }
__device__ __forceinline__ void sgu_unit(const Frame& F, const Args& a, int b, int blk) {
    const bf16* VG = (const bf16*)(a.ws + WS_VG); const bf16* U = (const bf16*)(a.ws + WS_U); bf16* YAB = (bf16*)(a.ws + WS_YAB);
    const float* ln_g = a.in[8]; const float* ln_b = a.in[9]; const float* w_s = a.in[10]; const float* b_s = a.in[11];
    const int tok0 = b * SEQ + blk * SGB, lane = F.lane;
    {
        const f32x4 g0 = *(const f32x4*)(ln_g + lane * 8), g1 = *(const f32x4*)(ln_g + lane * 8 + 4), b0 = *(const f32x4*)(ln_b + lane * 8), b1 = *(const f32x4*)(ln_b + lane * 8 + 4);
#pragma unroll 1
        for (int r4 = 0; r4 < 16; r4 += 4) {
            u32x4 w[4];
#pragma unroll
            for (int rr = 0; rr < 4; ++rr) w[rr] = *(const u32x4*)(VG + (size_t)(tok0 + F.wave * 16 + r4 + rr) * 512 + lane * 8);
#pragma unroll
            for (int rr = 0; rr < 4; ++rr) { const int row = F.wave * 16 + r4 + rr;
                f32x4 v0 = {bflo(w[rr].x), bfhi(w[rr].x), bflo(w[rr].y), bfhi(w[rr].y)}, v1 = {bflo(w[rr].z), bfhi(w[rr].z), bflo(w[rr].w), bfhi(w[rr].w)};
                const float mu = wsum((v0[0] + v0[1]) + (v0[2] + v0[3]) + (v1[0] + v1[1]) + (v1[2] + v1[3])) * (1.0f / 512.0f);
                v0 -= mu; v1 -= mu;
                const float var = wsum((v0[0] * v0[0] + v0[1] * v0[1]) + (v0[2] * v0[2] + v0[3] * v0[3]) + (v1[0] * v1[0] + v1[1] * v1[1]) + (v1[2] * v1[2] + v1[3] * v1[3])) * (1.0f / 512.0f);
                const float rstd = rsqrtf(var + EPS);
                v0 = v0 * rstd * g0 + b0; v1 = v1 * rstd * g1 + b1;
                u32x4 o; o.x = cvtpk(v0[0], v0[1]); o.y = cvtpk(v0[2], v0[3]); o.z = cvtpk(v1[0], v1[1]); o.w = cvtpk(v1[2], v1[3]);
                *(LAS u32x4*)(F.lds + row * SGU_STRIDE + lane * 16) = o; }
        }
    }
    __syncthreads();
    {
        const int g = F.wave, r32 = lane & 31, hi = lane >> 5, i16 = lane & 15, g16 = (lane >> 4) & 1;
        const LAS unsigned char* vb = F.lds + (8 * hi + (i16 >> 2)) * SGU_STRIDE + (g * 64 + 16 * g16 + 4 * (i16 & 3)) * 2;
#pragma unroll
        for (int tb = 0; tb < 4; ++tb) {
            const int t = 32 * tb + r32; const float* wrow = w_s + ((size_t)g * 128 + t) * 128;
            f32x4 wr0[8], wr1[8];
#pragma unroll
            for (int ks = 0; ks < 2 * tb + 2; ++ks) { wr0[ks] = *(const f32x4*)(wrow + 16 * ks + 8 * hi); wr1[ks] = *(const f32x4*)(wrow + 16 * ks + 8 * hi + 4); }
            const float bs = b_s[g * 128 + t];
            const bf16* up = U + (size_t)(tok0 + t) * 512 + g * 64 + 4 * hi;
            u32x2 uu0[4], uu1[4];
#pragma unroll
            for (int gg = 0; gg < 4; ++gg) { uu0[gg] = *(const u32x2*)(up + 8 * gg); uu1[gg] = *(const u32x2*)(up + 32 + 8 * gg); }
            f32x16 a0, a1;
#pragma unroll
            for (int r = 0; r < 16; ++r) { a0[r] = 0.f; a1[r] = 0.f; }
#pragma unroll
            for (int ks = 0; ks < 2 * tb + 2; ++ks) {
                const int s0 = 16 * ks + 8 * hi;
                float wv[8] = {wr0[ks][0], wr0[ks][1], wr0[ks][2], wr0[ks][3], wr1[ks][0], wr1[ks][1], wr1[ks][2], wr1[ks][3]};
                if (ks >= 2 * tb) {
#pragma unroll
                    for (int j = 0; j < 8; ++j) wv[j] = (s0 + j <= t) ? wv[j] : 0.f; }
                u32x4 bw; bw.x = cvtpk(wv[0], wv[1]); bw.y = cvtpk(wv[2], wv[3]); bw.z = cvtpk(wv[4], wv[5]); bw.w = cvtpk(wv[6], wv[7]);
                const bf16x8 bfrag = __builtin_bit_cast(bf16x8, bw);
                const LAS unsigned char* p = vb + ks * 16 * SGU_STRIDE;
                const s16x4 l0 = vtr(p), h0 = vtr(p + 4 * SGU_STRIDE), l1 = vtr(p + 64), h1 = vtr(p + 4 * SGU_STRIDE + 64);
                const bf16x8 A0 = {l0[0], l0[1], l0[2], l0[3], h0[0], h0[1], h0[2], h0[3]}, A1 = {l1[0], l1[1], l1[2], l1[3], h1[0], h1[1], h1[2], h1[3]};
                a0 = __builtin_amdgcn_mfma_f32_32x32x16_bf16(A0, bfrag, a0, 0, 0, 0);
                a1 = __builtin_amdgcn_mfma_f32_32x32x16_bf16(A1, bfrag, a1, 0, 0, 0);
            }
            bf16* op = YAB + (size_t)(tok0 + t) * 1024 + 512 + g * 64 + 4 * hi;
#pragma unroll
            for (int gg = 0; gg < 4; ++gg) {
                u32x2 o0, o1;
                o0.x = cvtpk(bflo(uu0[gg].x) * (a0[4 * gg] + bs), bfhi(uu0[gg].x) * (a0[4 * gg + 1] + bs)); o0.y = cvtpk(bflo(uu0[gg].y) * (a0[4 * gg + 2] + bs), bfhi(uu0[gg].y) * (a0[4 * gg + 3] + bs));
                o1.x = cvtpk(bflo(uu1[gg].x) * (a1[4 * gg] + bs), bfhi(uu1[gg].x) * (a1[4 * gg + 1] + bs)); o1.y = cvtpk(bflo(uu1[gg].y) * (a1[4 * gg + 2] + bs), bfhi(uu1[gg].y) * (a1[4 * gg + 3] + bs));
                *(u32x2*)(op + 8 * gg) = o0; *(u32x2*)(op + 32 + 8 * gg) = o1; }
        }
    }
    __syncthreads();
}

constexpr int AT_BUF = 65536, AT_V = 32768, AT_BT = GTAB_OFF;
static_assert(8 * 1088 <= GTAB_BYTES, "bias tables fit above the ring");
__device__ __forceinline__ void attn_chunks(const Frame& F, const Args& a, int gc0, int gc1) {
    const bf16* __restrict__ Q = (const bf16*)(a.ws + WS_Q); const bf16* __restrict__ Kb = (const bf16*)(a.ws + WS_K); const bf16* __restrict__ Vb = (const bf16*)(a.ws + WS_V); bf16* YAB = (bf16*)(a.ws + WS_YAB);
    const int tid = F.tid, lane = F.lane, wave = F.wave, pr = wave >> 1, half = wave & 1;
    const int r32 = lane & 31, hi = lane >> 5, i16 = lane & 15, g16 = (lane >> 4) & 1;
    const int gcs[2] = {gc0, gc1};
    int j0s[2], nts[2], tok0s[2];
#pragma unroll
    for (int i = 0; i < 2; ++i) { const int c = gcs[i] % (SEQ / CHUNK); j0s[i] = (c < NLEFT) ? (NLEFT - c) : 0; nts[i] = 9 - j0s[i]; tok0s[i] = (gcs[i] / (SEQ / CHUNK)) * SEQ + c * CHUNK; }
    const int total = 2 * nts[0] + 2 * nts[1];
    const int lrow = tid >> 5, c16 = tid & 31, lhh = c16 >> 3, lch = c16 & 7;
    const int kwoff = lhh * 8192 + lrow * 128 + ((lch ^ ((lrow >> 1) & 7)) << 4);
    const int vwoff = AT_V + lhh * 8192 + lrow * 128 + ((lch ^ (((lrow >> 1) & 1) << 2)) << 4);
    int ko[4];
#pragma unroll
    for (int sI = 0; sI < 4; ++sI) ko[sI] = pr * 8192 + r32 * 128 + ((((2 * sI + hi) ^ ((r32 >> 1) & 7))) << 4);
    const int fb = (i16 >> 3) & 1;
    const int vr0 = AT_V + pr * 8192 + (4 * hi + (i16 >> 2)) * 128 + ((4 * (0 ^ fb) + 2 * g16 + ((i16 & 3) >> 1)) * 16) + (i16 & 1) * 8;
    const int vr1 = AT_V + pr * 8192 + (4 * hi + (i16 >> 2)) * 128 + ((4 * (1 ^ fb) + 2 * g16 + ((i16 & 3) >> 1)) * 16) + (i16 & 1) * 8;
#define AT_DECODE(t, ci, hp, j) do { ci = ((t) >= 2 * nts[0]) ? 1 : 0; const int tt_ = (t) - ci * 2 * nts[0]; hp = (tt_ >= nts[ci]) ? 1 : 0; j = j0s[ci] + tt_ - hp * nts[ci]; } while (0)
    u32x4 kn[4], vn[4];
    {
        int ci, hp, j; AT_DECODE(0, ci, hp, j);
        const size_t g = (size_t)(tok0s[ci] + (j - NLEFT) * CHUNK + lrow) * 512 + hp * 256 + c16 * 8;
#pragma unroll
        for (int i = 0; i < 4; ++i) { kn[i] = *(const u32x4*)(Kb + g + (size_t)i * 16 * 512); vn[i] = *(const u32x4*)(Vb + g + (size_t)i * 16 * 512); }
#pragma unroll
        for (int i = 0; i < 4; ++i) { *(LAS u32x4*)(F.lds + kwoff + i * 2048) = kn[i]; *(LAS u32x4*)(F.lds + vwoff + i * 2048) = vn[i]; }
    }
    __syncthreads();
    bf16x8 qf[4]; f32x16 o0, o1; float m = -1e30f, l = 0.f;
#pragma unroll
    for (int r = 0; r < 16; ++r) { o0[r] = 0.f; o1[r] = 0.f; }
#pragma unroll
    for (int sI = 0; sI < 4; ++sI) qf[sI] = (bf16x8){0, 0, 0, 0, 0, 0, 0, 0};
#pragma unroll 1
    for (int t = 0; t < total; ++t) {
        int ci, hp, j; AT_DECODE(t, ci, hp, j);
        const int tn = (t + 1 < total) ? t + 1 : t; int cin, hpn, jn; AT_DECODE(tn, cin, hpn, jn);
        const int h = 4 * hp + pr, qi = half * 32 + r32, qtok = tok0s[ci] + qi;
        if (j == j0s[ci]) {
#pragma unroll
            for (int sI = 0; sI < 4; ++sI) qf[sI] = *(const bf16x8*)(Q + (size_t)qtok * 512 + h * 64 + 16 * sI + 8 * hi);
#pragma unroll
            for (int r = 0; r < 16; ++r) { o0[r] = 0.f; o1[r] = 0.f; }
            m = -1e30f; l = 0.f;
        }
        asm volatile("" ::: "memory");
        {
            const size_t g = (size_t)(tok0s[cin] + (jn - NLEFT) * CHUNK + lrow) * 512 + hpn * 256 + c16 * 8;
#pragma unroll
            for (int i = 0; i < 4; ++i) { kn[i] = *(const u32x4*)(Kb + g + (size_t)i * 16 * 512); vn[i] = *(const u32x4*)(Vb + g + (size_t)i * 16 * 512); }
        }
        asm volatile("" ::: "memory");
        const LAS unsigned char* buf = F.lds + (t & 1) * AT_BUF;
        const bool first = (j == j0s[ci]);
        const float negm = first ? 0.f : -m;
        f32x16 p0, p1;
#pragma unroll
        for (int r = 0; r < 16; ++r) { p0[r] = negm; p1[r] = negm; }
#pragma unroll
        for (int sI = 0; sI < 4; ++sI) { const bf16x8 k0 = *(const LAS bf16x8*)(buf + ko[sI]), k1 = *(const LAS bf16x8*)(buf + ko[sI] + 4096);
            p0 = __builtin_amdgcn_mfma_f32_32x32x16_bf16(k0, qf[sI], p0, 0, 0, 0); p1 = __builtin_amdgcn_mfma_f32_32x32x16_bf16(k1, qf[sI], p1, 0, 0, 0); }
        if (j >= 6) {
            const LAS float* bt = (const LAS float*)(F.lds + AT_BT + h * 1088);
            const int base = 640 + qi - 64 * j - 4 * hi;
#pragma unroll
            for (int r = 0; r < 16; ++r) { const int kk = (r & 3) + 8 * (r >> 2); int i0 = base - kk, i1 = base - 32 - kk; i0 = i0 > 256 ? 256 : i0; i1 = i1 > 256 ? 256 : i1; p0[r] += bt[i0]; p1[r] += bt[i1]; }
        }
        float tm = fmaxf(p0[0], p1[0]);
#pragma unroll
        for (int r = 1; r < 16; ++r) tm = fmaxf(tm, fmaxf(p0[r], p1[r]));
        { const auto rr = __builtin_amdgcn_permlane32_swap(__float_as_uint(tm), __float_as_uint(tm), false, false); tm = fmaxf(__uint_as_float(rr[0]), __uint_as_float(rr[1])); }
        if (first) {
            m = tm;
#pragma unroll
            for (int r = 0; r < 16; ++r) { p0[r] -= tm; p1[r] -= tm; }
        } else if (__any(tm > 0.f)) {
            const float dlt = fmaxf(tm, 0.f), alpha = __builtin_amdgcn_exp2f(-dlt); m += dlt; l *= alpha;
#pragma unroll
            for (int r = 0; r < 16; ++r) { p0[r] -= dlt; p1[r] -= dlt; o0[r] *= alpha; o1[r] *= alpha; }
        }
        float ps = 0.f;
#pragma unroll
        for (int r = 0; r < 16; ++r) { p0[r] = __builtin_amdgcn_exp2f(p0[r]); p1[r] = __builtin_amdgcn_exp2f(p1[r]); ps += p0[r] + p1[r]; }
        l += ps;
        bf16x8 pb[2][2];
#pragma unroll
        for (int sI = 0; sI < 2; ++sI) {
            u32x4 w0; w0.x = cvtpk(p0[8 * sI], p0[8 * sI + 1]); w0.y = cvtpk(p0[8 * sI + 2], p0[8 * sI + 3]); w0.z = cvtpk(p0[8 * sI + 4], p0[8 * sI + 5]); w0.w = cvtpk(p0[8 * sI + 6], p0[8 * sI + 7]);
            u32x4 w1; w1.x = cvtpk(p1[8 * sI], p1[8 * sI + 1]); w1.y = cvtpk(p1[8 * sI + 2], p1[8 * sI + 3]); w1.z = cvtpk(p1[8 * sI + 4], p1[8 * sI + 5]); w1.w = cvtpk(p1[8 * sI + 6], p1[8 * sI + 7]);
            pb[0][sI] = __builtin_bit_cast(bf16x8, w0); pb[1][sI] = __builtin_bit_cast(bf16x8, w1); }
#pragma unroll
        for (int blk = 0; blk < 2; ++blk)
#pragma unroll
            for (int sI = 0; sI < 2; ++sI) {
                const int kof = (32 * blk + 16 * sI) * 128;
                const s16x4 l0 = vtr(buf + vr0 + kof), h0 = vtr(buf + vr0 + kof + 1024), l1 = vtr(buf + vr1 + kof), h1 = vtr(buf + vr1 + kof + 1024);
                const bf16x8 A0 = {l0[0], l0[1], l0[2], l0[3], h0[0], h0[1], h0[2], h0[3]}, A1 = {l1[0], l1[1], l1[2], l1[3], h1[0], h1[1], h1[2], h1[3]};
                o0 = __builtin_amdgcn_mfma_f32_32x32x16_bf16(A0, pb[blk][sI], o0, 0, 0, 0);
                o1 = __builtin_amdgcn_mfma_f32_32x32x16_bf16(A1, pb[blk][sI], o1, 0, 0, 0);
            }
        if (j == 8) {
            float lt = l; { const auto rr = __builtin_amdgcn_permlane32_swap(__float_as_uint(lt), __float_as_uint(lt), false, false); lt = __uint_as_float(rr[0]) + __uint_as_float(rr[1]); }
            const float inv = __builtin_amdgcn_rcpf(lt);
            bf16* op = YAB + (size_t)qtok * 1024 + h * 64 + 4 * hi;
#pragma unroll
            for (int gg = 0; gg < 4; ++gg) {
                u32x2 w0, w1;
                w0.x = cvtpk(o0[4 * gg] * inv, o0[4 * gg + 1] * inv); w0.y = cvtpk(o0[4 * gg + 2] * inv, o0[4 * gg + 3] * inv);
                w1.x = cvtpk(o1[4 * gg] * inv, o1[4 * gg + 1] * inv); w1.y = cvtpk(o1[4 * gg + 2] * inv, o1[4 * gg + 3] * inv);
                *(u32x2*)(op + 8 * gg) = w0; *(u32x2*)(op + 32 + 8 * gg) = w1; }
        }
        {
            LAS unsigned char* nb = F.lds + ((t + 1) & 1) * AT_BUF;
#pragma unroll
            for (int i = 0; i < 4; ++i) { *(LAS u32x4*)(nb + kwoff + i * 2048) = kn[i]; *(LAS u32x4*)(nb + vwoff + i * 2048) = vn[i]; }
        }
        __syncthreads();
    }
#undef AT_DECODE
}
__device__ __forceinline__ void phaseD(const Frame& F, const Args& a) {
    for (int unit = F.vcu; unit < NB * (SEQ / SGB); unit += F.G) sgu_unit(F, a, unit / (SEQ / SGB), unit % (SEQ / SGB));
    for (int i = F.tid; i < NHEAD * NREL; i += NWAVES * 64) { const int h = i / NREL, k = i % NREL; ((LAS float*)(F.lds + AT_BT + h * 1088))[k] = (a.in[7][i] - a.in[7][h * NREL + 256]) * LOG2E; }
    __syncthreads();
    const int NCH = NB * (SEQ / CHUNK);
    for (int v = F.vcu; v < NCH / 2; v += F.G) attn_chunks(F, a, v, NCH - 1 - v);
}

constexpr int G_HT_STRIDE = 2064;
__device__ __forceinline__ void phaseG(const Frame& F, const Args& a) {
    const float* x = a.in[0]; const bf16* Y1 = (const bf16*)(a.ws + WS_Y1); const float* mod = (const float*)(a.ws + WS_MOD); const float* g_post_mix = a.in[5]; const float* g_pre_ffn = a.in[17];
    const float* b_router = a.in[20]; bf16* X1b = (bf16*)(a.ws + WS_X1B); unsigned char* XN8 = a.ws + WS_XN;
    const bf16* wrt = (const bf16*)(a.ws + WS_WRT);
    float* topg = (float*)(a.ws + WS_TOPG); int* list = (int*)(a.ws + WS_LIST); unsigned* cnt = F.ctl + CW_CNT;
    LAS unsigned char* HT = F.lds;
    LAS float* PL = (LAS float*)(F.lds + 33792);
    LAS float* LG = PL + 8 * 16 * 32;
    LAS float* TV = LG + 512;
    LAS unsigned* LC = (LAS unsigned*)(TV + 64);
    LAS unsigned* AS = LC + 64;
    const int tid = F.tid, lane = F.lane, wave = F.wave, kq = lane >> 4, i16 = lane & 15;
    if (tid < 64) LC[tid] = 0u;
    bf16x8 whi[2][4], wlo[2][4];
#pragma unroll
    for (int et = 0; et < 2; ++et)
#pragma unroll
        for (int ks = 0; ks < 4; ++ks) { const size_t o = (size_t)(et * 16 + i16) * D + 128 * wave + 32 * ks + 8 * kq; whi[et][ks] = *(const bf16x8*)(wrt + o); wlo[et][ks] = *(const bf16x8*)(wrt + (size_t)NEXP * D + o); }
    const int myrow = tid >> 5, mye = lane & 31;
    const float mybias = b_router[mye];
    __syncthreads();
    const int NT = NTOK / 16;
    f32x4 xv[2][4]; u32x2 yr[2][4];
    {   const int rbase = 16 * F.vcu + 2 * wave;
#pragma unroll
        for (int rr = 0; rr < 2; ++rr)
#pragma unroll
            for (int j = 0; j < 4; ++j) { const int c0 = (lane + 64 * j) * 4; xv[rr][j] = __builtin_nontemporal_load((const f32x4*)(x + (size_t)(rbase + rr) * D + c0)); yr[rr][j] = __builtin_nontemporal_load((const u32x2*)(Y1 + (size_t)(rbase + rr) * D + c0)); } }
    int tl = 0;
    f32x4 cgp[4], cgf[4], cgt[4], csc[4], csh[4]; int cb = -1;
#pragma unroll
    for (int j = 0; j < 4; ++j) { const int c0 = (lane + 64 * j) * 4; cgp[j] = *(const f32x4*)(g_post_mix + c0); cgf[j] = *(const f32x4*)(g_pre_ffn + c0); }
#pragma unroll 1
    for (int T = F.vcu; T < NT; T += F.G, ++tl) {
        const int b = (16 * T) / SEQ; const float* mb = mod + b * 6144; const int rbase = 16 * T + 2 * wave;
        if (b != cb) { cb = b;
#pragma unroll
            for (int j = 0; j < 4; ++j) { const int c0 = (lane + 64 * j) * 4; cgt[j] = *(const f32x4*)(mb + GT1 + c0); csc[j] = *(const f32x4*)(mb + SC2 + c0) + 1.0f; csh[j] = *(const f32x4*)(mb + SH2 + c0); } }
#pragma unroll
        for (int rr = 0; rr < 2; ++rr) {
            const int row = rbase + rr; f32x4 yv[4]; float ss = 0.f;
#pragma unroll
            for (int j = 0; j < 4; ++j) { yv[j] = (f32x4){bflo(yr[rr][j].x), bfhi(yr[rr][j].x), bflo(yr[rr][j].y), bfhi(yr[rr][j].y)}; ss += (yv[j][0] * yv[j][0] + yv[j][1] * yv[j][1]) + (yv[j][2] * yv[j][2] + yv[j][3] * yv[j][3]); }
            const float rstd = rsqrtf(wsum(ss) * (1.0f / D) + EPS); float s2 = 0.f;
#pragma unroll
            for (int j = 0; j < 4; ++j) { const int c0 = (lane + 64 * j) * 4;
                xv[rr][j] = xv[rr][j] + cgt[j] * (yv[j] * rstd * cgp[j]);
                { u32x2 w1; w1.x = cvtpk(xv[rr][j][0], xv[rr][j][1]); w1.y = cvtpk(xv[rr][j][2], xv[rr][j][3]); __builtin_nontemporal_store(w1, (u32x2*)(X1b + (size_t)row * D + c0)); }
                s2 += (xv[rr][j][0] * xv[rr][j][0] + xv[rr][j][1] * xv[rr][j][1]) + (xv[rr][j][2] * xv[rr][j][2] + xv[rr][j][3] * xv[rr][j][3]); }
            const float rstd2 = rsqrtf(wsum(s2) * (1.0f / D) + EPS);
#pragma unroll
            for (int j = 0; j < 4; ++j) { const int c0 = (lane + 64 * j) * 4;
                const f32x4 h = xv[rr][j] * rstd2 * cgf[j] * csc[j] + csh[j];
                u32x2 w; w.x = cvtpk(h[0], h[1]); w.y = cvtpk(h[2], h[3]); *(unsigned*)(XN8 + (size_t)row * D + c0) = pk_fp8x4(h[0] * F8_ASCALE, h[1] * F8_ASCALE, h[2] * F8_ASCALE, h[3] * F8_ASCALE);
                *(LAS u32x2*)(HT + (2 * wave + rr) * G_HT_STRIDE + c0 * 2) = w; }
        }
        {
            const int Tn = (T + F.G < NT) ? T + F.G : T; const int rb2 = 16 * Tn + 2 * wave;
#pragma unroll
            for (int rr = 0; rr < 2; ++rr)
#pragma unroll
                for (int j = 0; j < 4; ++j) { const int c0 = (lane + 64 * j) * 4; xv[rr][j] = __builtin_nontemporal_load((const f32x4*)(x + (size_t)(rb2 + rr) * D + c0)); yr[rr][j] = __builtin_nontemporal_load((const u32x2*)(Y1 + (size_t)(rb2 + rr) * D + c0)); }
        }
        LDS_WAIT(); __builtin_amdgcn_s_barrier(); asm volatile("" ::: "memory");
        {
            f32x4 acc0 = {0.f, 0.f, 0.f, 0.f}, acc1 = {0.f, 0.f, 0.f, 0.f};
#pragma unroll
            for (int ks = 0; ks < 4; ++ks) { const bf16x8 hb = *(const LAS bf16x8*)(HT + i16 * G_HT_STRIDE + (128 * wave + 32 * ks + 8 * kq) * 2);
                acc0 = __builtin_amdgcn_mfma_f32_16x16x32_bf16(whi[0][ks], hb, acc0, 0, 0, 0); acc0 = __builtin_amdgcn_mfma_f32_16x16x32_bf16(wlo[0][ks], hb, acc0, 0, 0, 0);
                acc1 = __builtin_amdgcn_mfma_f32_16x16x32_bf16(whi[1][ks], hb, acc1, 0, 0, 0); acc1 = __builtin_amdgcn_mfma_f32_16x16x32_bf16(wlo[1][ks], hb, acc1, 0, 0, 0); }
            *(LAS f32x4*)(PL + (wave * 16 + i16) * 32 + 4 * kq) = acc0; *(LAS f32x4*)(PL + (wave * 16 + i16) * 32 + 16 + 4 * kq) = acc1;
        }
        LDS_WAIT(); __builtin_amdgcn_s_barrier(); asm volatile("" ::: "memory");
        float lg = mybias;
#pragma unroll
        for (int w = 0; w < 8; ++w) lg += PL[(w * 16 + myrow) * 32 + mye];
        LG[myrow * 32 + mye] = lg;
        LDS_WAIT(); asm volatile("" ::: "memory");
        int rank = 0;
#pragma unroll
        for (int q = 0; q < 8; ++q) { const f32x4 o = *(const LAS f32x4*)(LG + myrow * 32 + 4 * q);
#pragma unroll
            for (int i = 0; i < 4; ++i) { const int e2 = 4 * q + i; rank += (o[i] > lg || (o[i] == lg && e2 < mye)) ? 1 : 0; } }
        if (rank < 4) TV[myrow * 4 + rank] = lg;
        LDS_WAIT(); asm volatile("" ::: "memory");
        const f32x4 tv = *(const LAS f32x4*)(TV + myrow * 4);
        if (rank < 4) {
            const float den = 1.0f + __expf(tv[1] - tv[0]) + __expf(tv[2] - tv[0]) + __expf(tv[3] - tv[0]);
            const int slot = (16 * T + myrow) * 4 + rank; topg[slot] = __expf(lg - tv[0]) / den;
            const unsigned lp = __hip_atomic_fetch_add(LC + mye, 1u, __ATOMIC_RELAXED, __HIP_MEMORY_SCOPE_WORKGROUP);
            if (tl < 16) AS[tl * 64 + myrow * 4 + rank] = (unsigned)mye | (lp << 8);
        }
    }
    __syncthreads();
    if (tid < NEXP) LC[32 + tid] = atomicAdd(&cnt[tid], LC[tid]);
    __syncthreads();
    for (int i = tid; i < tl * 64; i += NWAVES * 64) { const unsigned as = AS[i]; const int e = as & 255, lp = as >> 8; const int T = F.vcu + (i >> 6) * F.G;
        list[(size_t)e * NTOK + LC[32 + e] + lp] = (16 * T + ((i & 63) >> 2)) * 4 + (i & 3); }
}
__device__ __forceinline__ int moe_tables(const Frame& F) {
    __syncthreads();
    if (F.tid < NEXP) F.MISC[40 + F.tid] = __hip_atomic_load(F.ctl + CW_CNT + F.tid, __ATOMIC_RELAXED, __HIP_MEMORY_SCOPE_AGENT);
    __syncthreads();
    if (F.tid == 0) { unsigned s = 0; for (int e = 0; e < NEXP; ++e) { F.MISC[e] = s; s += (F.MISC[40 + e] + 255u) >> 8; } F.MISC[32] = s; }
    __syncthreads();
    return (int)F.MISC[32];
}
__device__ __forceinline__ void phaseJ(const Frame& F, const Args& a) {
    const unsigned char* Y2s = a.ws + WS_Y2; const bf16* X1b = (const bf16*)(a.ws + WS_X1B); const float* mod = (const float*)(a.ws + WS_MOD); const float* gpf = a.in[18]; float* out = a.out;
    const int* inv = (const int*)(a.ws + WS_TOPE); const float* topg = (const float*)(a.ws + WS_TOPG);
    const int lane = F.lane, gw = F.vcu * NWAVES + F.wave, NGW = F.G * NWAVES;
    f32x4 cgg[4]; int cb = -1;
    for (int row0 = gw * 4; row0 < NTOK; row0 += NGW * 4) {
        const int b = row0 / SEQ; const float* mb = mod + b * 6144;
        if (b != cb) { cb = b;
#pragma unroll
            for (int j = 0; j < 4; ++j) { const int c0 = (lane + 64 * j) * 4; cgg[j] = *(const f32x4*)(gpf + c0) * *(const f32x4*)(mb + GT2 + c0); } }
        int pp[4][4]; float gg[4][4];
#pragma unroll
        for (int rr = 0; rr < 4; ++rr)
#pragma unroll
            for (int k = 0; k < 4; ++k) { pp[rr][k] = __builtin_amdgcn_readfirstlane(inv[(row0 + rr) * 4 + k]); gg[rr][k] = topg[(row0 + rr) * 4 + k] * (1.0f / F8_YSCALE); }
        unsigned yy[4][4][4]; u32x2 xx[4][4];
#pragma unroll
        for (int rr = 0; rr < 4; ++rr)
#pragma unroll
            for (int j = 0; j < 4; ++j) { const int c0 = (lane + 64 * j) * 4;
#pragma unroll
                for (int k = 0; k < 4; ++k) yy[rr][j][k] = __builtin_nontemporal_load((const unsigned*)(Y2s + (size_t)pp[rr][k] * D + c0));
                xx[rr][j] = __builtin_nontemporal_load((const u32x2*)(X1b + (size_t)(row0 + rr) * D + c0)); }
#pragma unroll
        for (int rr = 0; rr < 4; ++rr) {
            f32x4 yv[4]; float ss = 0.f;
#pragma unroll
            for (int j = 0; j < 4; ++j) { f32x4 s = {0.f, 0.f, 0.f, 0.f};
#pragma unroll
                for (int k = 0; k < 4; ++k) { const f32x2 lo = __builtin_amdgcn_cvt_pk_f32_fp8((int)yy[rr][j][k], false), hi = __builtin_amdgcn_cvt_pk_f32_fp8((int)yy[rr][j][k], true);
                    s += (f32x4){lo.x, lo.y, hi.x, hi.y} * gg[rr][k]; }
                yv[j] = s; ss += (s[0] * s[0] + s[1] * s[1]) + (s[2] * s[2] + s[3] * s[3]); }
            const float rstd = rsqrtf(wsum(ss) * (1.0f / D) + EPS);
#pragma unroll
            for (int j = 0; j < 4; ++j) { const int c0 = (lane + 64 * j) * 4;
                const f32x4 x1 = {bflo(xx[rr][j].x), bfhi(xx[rr][j].x), bflo(xx[rr][j].y), bfhi(xx[rr][j].y)};
                __builtin_nontemporal_store(x1 + cgg[j] * (yv[j] * rstd), (f32x4*)(out + (size_t)(row0 + rr) * D + c0)); }
        }
    }
}

constexpr int N_PHASES = 10;
__global__ void __launch_bounds__(NWAVES * 64, 2) mega_fwd(Args args) {
    extern __shared__ __attribute__((aligned(16))) unsigned char lds_raw[];
    Frame F;
    F.lds = (LAS unsigned char*)lds_raw; F.MISC = (volatile LAS unsigned*)(F.lds + MISC_OFF);
    F.tid = threadIdx.x; F.lane = F.tid & 63; F.wave = __builtin_amdgcn_readfirstlane(F.tid >> 6);
    F.G = gridDim.x; { const int bx = blockIdx.x; F.vcu = (F.G % 8 == 0) ? (bx % 8) * (F.G / 8) + bx / 8 : bx; }
    F.ctl = (unsigned*)(args.ws + WS_CTL);
    for (int u = F.tid; u < 128; u += NWAVES * 64) F.MISC[u] = 0u;
    __syncthreads();
    const int lo = args.ph_lo, hi = args.ph_hi;
    XcdBarrier bar; bar.bar = F.ctl + CW_BAR; bar.x = 0; bar.st = F.MISC + 80;
    if (hi - lo > 1) bar = xcd_barrier_post(F.ctl + CW_BAR, F.MISC + 80);
#define IN(k) (lo <= (k) && (k) < hi)
#define SEAM(k) do { if (IN(k) && IN((k) + 1)) xcd_barrier(bar); } while (0)
    unsigned char* ws = args.ws;
    bf16 *XN = (bf16*)(ws + WS_XN), *Qb = (bf16*)(ws + WS_Q), *Kb = (bf16*)(ws + WS_K), *Vb = (bf16*)(ws + WS_V), *Ub = (bf16*)(ws + WS_U), *VG = (bf16*)(ws + WS_VG);
    bf16 *GT = (bf16*)(ws + WS_GT), *YAB = (bf16*)(ws + WS_YAB), *MRG = (bf16*)(ws + WS_MRG), *Y1 = (bf16*)(ws + WS_Y1), *ACT = (bf16*)(ws + WS_ACT), *Y2 = (bf16*)(ws + WS_Y2);

    if (IN(0)) { phaseA(F, args); } SEAM(0);
    if (IN(1)) { phaseB(F, args); } SEAM(1);
    if (IN(2)) {
        SchedStatic S{(const char*)XN, (const char*)(ws + WS_W1T), NTOK / 256, 4608 / 256, F.G, (int)blockIdx.x, (size_t)256 * 1024 * 2, (size_t)256 * 1024 * 2};
        EpiG1 E{Qb, Kb, Vb, Ub, VG, GT, args.in[15]};
        pg8::gemm_phase<EpiG1, SchedStatic, false>(F.lds + RING_OFF, S, E, 2048, 2048, 16);
    } SEAM(2);
    if (IN(3)) { phaseD(F, args); } SEAM(3);
    if (IN(4)) {
        SchedSplit2 S{(const char*)YAB, (const char*)(ws + WS_WBRT), NTOK / 256, 4, F.G, (int)blockIdx.x, (size_t)256 * 1024 * 2, (size_t)256 * 1024 * 2, (size_t)512 * 2};
        EpiG2 E{GT, MRG};
        pg8::gemm_phase<EpiG2, SchedSplit2, false>(F.lds + RING_OFF, S, E, 2048, 2048, 8);
    } SEAM(4);
    if (IN(5)) {
        SchedStatic S{(const char*)MRG, (const char*)(ws + WS_WOUTT), NTOK / 256, 4, F.G, (int)blockIdx.x, (size_t)256 * 1024 * 2, (size_t)256 * 1024 * 2};
        EpiPlain E{Y1};
        pg8::gemm_phase<EpiPlain, SchedStatic, false>(F.lds + RING_OFF, S, E, 2048, 2048, 16);
    } SEAM(5);
    if (IN(6)) { phaseG(F, args); } SEAM(6);
    if (IN(7)) {
        const int nrb = moe_tables(F);
        const int* list = (const int*)(ws + WS_LIST);
        {
            int* inv = (int*)(ws + WS_TOPE);
            for (int g = (int)blockIdx.x * (NWAVES * 64) + F.tid; g < NTOK * TOPK; g += F.G * NWAVES * 64) {
                int e = 0, base = 0;
#pragma unroll 1
                for (int i = 0; i < NEXP; ++i) { const int c = (int)F.MISC[40 + i]; if (g >= base + c) { base += c; e = i + 1; } else break; }
                const int pos = g - base; if (e < NEXP) inv[list[(size_t)e * NTOK + pos]] = (int)F.MISC[e] * 256 + pos; }
        }
        typedef SchedMoe<8, true> SM;
        SM S{(const char*)XN, (const char*)(ws + WS_WGUT), F.MISC, (const LAS unsigned*)(F.lds + GTAB_OFF), (int)blockIdx.x, F.G, nrb, (size_t)2048 * 1024, (size_t)256 * 1024};
        S.build(F.tid);
        { Unit u; LAS unsigned* gt = (LAS unsigned*)(F.lds + GTAB_OFF);
          for (int k = 0; k < GTAB_UNITS && S.next(k, u); ++k) { const int e = u.aux, j256 = (u.pm - (int)F.MISC[e]) * 256, ecnt = (int)F.MISC[40 + e];
              for (int r = F.tid; r < 256; r += NWAVES * 64) { const int pos = j256 + r; int tok = 0; if (pos < ecnt) tok = list[(size_t)e * NTOK + pos] >> 2; gt[k * 256 + r] = (unsigned)tok * 1024u; } } }
        __syncthreads();
        EpiAct E{args.in[22], (unsigned char*)ACT};
        pg8::gemm_phase<EpiAct, SM, true>(F.lds + RING_OFF, S, E, 1024, 1024, 8);
    } SEAM(7);
    if (IN(8)) {
        const int nrb = moe_tables(F);
        typedef SchedMoe<4, true> SM;
        SM S{(const char*)ACT, (const char*)(ws + WS_WDNT), F.MISC, (const LAS unsigned*)(F.lds + GTAB_OFF), (int)blockIdx.x, F.G, nrb, (size_t)1024 * 1024, (size_t)256 * 1024};
        S.build(F.tid);
        { Unit u; LAS unsigned* gt = (LAS unsigned*)(F.lds + GTAB_OFF);
          for (int k = 0; k < GTAB_UNITS && S.next(k, u); ++k) for (int r = F.tid; r < 256; r += NWAVES * 64) gt[k * 256 + r] = (unsigned)(u.pm * 256 + r) * 1024u; }
        __syncthreads();
        EpiDown E{args.in[24], (unsigned char*)Y2};
        pg8::gemm_phase<EpiDown, SM, true>(F.lds + RING_OFF, S, E, 1024, 1024, 8);
    } SEAM(8);
    if (IN(9)) { phaseJ(F, args); }
#undef IN
#undef SEAM
}
extern "C" void kernel_launch(void* const* d_in, const int* in_sizes, int n_in, void* d_out, int out_size, void* d_ws, size_t ws_size, hipStream_t stream) {
    if (n_in != 25 || in_sizes[0] != NTOK * D || out_size != NTOK * D || ws_size < WS_END) { fprintf(stderr, "kernel_launch: unexpected shapes (n_in %d in0 %d out %d ws %zu)\n", n_in, n_in > 0 ? in_sizes[0] : -1, out_size, ws_size); return; }
    static int grid = 0;
    if (grid == 0) {
        int dev = 0, cus = 0, per_cu = 0;
        if (hipGetDevice(&dev) != hipSuccess || hipDeviceGetAttribute(&cus, hipDeviceAttributeMultiprocessorCount, dev) != hipSuccess) { fprintf(stderr, "kernel_launch: device query failed\n"); grid = -1; return; }
        if (hipFuncSetAttribute((const void*)mega_fwd, hipFuncAttributeMaxDynamicSharedMemorySize, LDS_BYTES) != hipSuccess) { fprintf(stderr, "kernel_launch: hipFuncSetAttribute failed\n"); grid = -1; return; }
        if (hipOccupancyMaxActiveBlocksPerMultiprocessor(&per_cu, (const void*)mega_fwd, NWAVES * 64, LDS_BYTES) != hipSuccess || per_cu < 1) { fprintf(stderr, "kernel_launch: occupancy query says %d\n", per_cu); }
        (void)hipGetLastError();
        grid = cus;
    }
    if (grid < 0) return;
    if (hipMemsetAsync((unsigned char*)d_ws + WS_CTL, 0, CTL_ZERO_BYTES, stream) != hipSuccess) { fprintf(stderr, "kernel_launch: memset failed\n"); return; }
    Args a{};
    for (int i = 0; i < 25; ++i) a.in[i] = (const float*)d_in[i];
    a.out = (float*)d_out; a.ws = (unsigned char*)d_ws; a.ph_lo = 0; a.ph_hi = N_PHASES;
    hipLaunchKernelGGL(mega_fwd, dim3(grid), dim3(NWAVES * 64), LDS_BYTES, stream, a);
    if (hipPeekAtLastError() != hipSuccess) fprintf(stderr, "kernel_launch: launch failed\n");
}
```

```cpp
#include <hip/hip_runtime.h>
#include <cstdio>
#include <cstdint>

constexpr int NB = 4, SEQ = 8192, D = 1024, NTOK = NB * SEQ;
constexpr int NHEAD = 8, CHUNK = 64, NLEFT = 8, NREL = 257;
constexpr int SGB = 128;
constexpr int INW = 2560, NEXP = 32, TOPK = 4;
constexpr float EPS = 1e-6f, SWL = 7.0f, SWA = 1.702f;
constexpr float LOG2E = 1.4426950408889634f;
constexpr float QSCALE = 0.125f * LOG2E;
constexpr int SH1 = 0, SC1 = 1024, GT1 = 2048, SH2 = 3072, SC2 = 4096, GT2 = 5120;
typedef unsigned short bf16;

constexpr size_t MiB = 1u << 20;
constexpr size_t WS_CTL = 0, CTL_ZERO_BYTES = 64 * 1024;
constexpr size_t WS_MOD = 1 * MiB;
constexpr size_t WS_W1T = 2 * MiB, WS_WBRT = 12 * MiB, WS_WOUTT = 14 * MiB, WS_WRT = 16 * MiB;
constexpr size_t WS_TOPE = 17 * MiB, WS_TOPG = 18 * MiB, WS_LIST = 19 * MiB;
constexpr size_t WS_WGUT = 32 * MiB, WS_WDNT = 160 * MiB;
constexpr size_t WS_XN = 224 * MiB;
constexpr size_t WS_Q = 288 * MiB, WS_K = 320 * MiB, WS_V = 352 * MiB, WS_U = 384 * MiB, WS_VG = 416 * MiB;
constexpr size_t WS_GT = 448 * MiB;
constexpr size_t WS_YAB = 576 * MiB, WS_MRG = 640 * MiB, WS_Y1 = 704 * MiB;
constexpr size_t WS_ACT = 288 * MiB;
constexpr size_t WS_Y2 = 576 * MiB;
constexpr size_t WS_END = 960 * MiB;
constexpr int CW_CNT = 1024;

#define LAS __attribute__((address_space(3)))
#define GAS __attribute__((address_space(1)))
typedef short bf16x8 __attribute__((ext_vector_type(8)));
typedef short s16x4 __attribute__((ext_vector_type(4)));
typedef float f32x4 __attribute__((ext_vector_type(4)));
typedef float f32x2 __attribute__((ext_vector_type(2)));
typedef float f32x16 __attribute__((ext_vector_type(16)));
typedef unsigned u32x4 __attribute__((ext_vector_type(4)));
typedef unsigned u32x2 __attribute__((ext_vector_type(2)));
typedef __bf16 bf16x2_t __attribute__((ext_vector_type(2)));
constexpr int NWAVES = 8;
constexpr int TRASH_SLOT = NTOK * 4;

__device__ __forceinline__ unsigned cvtpk(float lo, float hi) { f32x2 v = {lo, hi}; bf16x2_t b = __builtin_convertvector(v, bf16x2_t); return __builtin_bit_cast(unsigned, b); }
__device__ __forceinline__ float wsum(float v) {
    v += __builtin_bit_cast(float, __builtin_amdgcn_update_dpp(0, __builtin_bit_cast(int, v), 0xB1, 0xF, 0xF, true));
    v += __builtin_bit_cast(float, __builtin_amdgcn_update_dpp(0, __builtin_bit_cast(int, v), 0x4E, 0xF, 0xF, true));
    v += __builtin_bit_cast(float, __builtin_amdgcn_update_dpp(0, __builtin_bit_cast(int, v), 0x124, 0xF, 0xF, true));
    v += __builtin_bit_cast(float, __builtin_amdgcn_update_dpp(0, __builtin_bit_cast(int, v), 0x128, 0xF, 0xF, true));
    const int iv = __builtin_bit_cast(int, v);
    const float s0 = __builtin_bit_cast(float, __builtin_amdgcn_readlane(iv, 0)), s1 = __builtin_bit_cast(float, __builtin_amdgcn_readlane(iv, 16));
    const float s2 = __builtin_bit_cast(float, __builtin_amdgcn_readlane(iv, 32)), s3 = __builtin_bit_cast(float, __builtin_amdgcn_readlane(iv, 48));
    return (s0 + s1) + (s2 + s3);
}
__device__ __forceinline__ float clamp8(float v) { return fminf(fmaxf(v, -448.0f), 448.0f); }
__device__ __forceinline__ unsigned pk_fp8x4(float a, float b, float c, float d) {
    int w = 0; w = __builtin_amdgcn_cvt_pk_fp8_f32(clamp8(a), clamp8(b), w, false); w = __builtin_amdgcn_cvt_pk_fp8_f32(clamp8(c), clamp8(d), w, true); return (unsigned)w; }
constexpr float F8_YSCALE = 16.0f;
constexpr size_t WS_X1B = 768 * MiB;
constexpr float F8_WSCALE = 64.0f, F8_ASCALE = 4.0f, F8_DESCALE = 1.0f / (64.0f * 4.0f);
__device__ __forceinline__ float bflo(unsigned w) { return __uint_as_float(w << 16); }
__device__ __forceinline__ float bfhi(unsigned w) { return __uint_as_float(w & 0xffff0000u); }
__device__ __forceinline__ float fast_sigmoid(float x) { return __builtin_amdgcn_rcpf(1.0f + __builtin_amdgcn_exp2f(-LOG2E * x)); }
__device__ __forceinline__ f32x2 sigmoid_pk(f32x2 v) { const f32x2 t = v * (-LOG2E); f32x2 e; e.x = __builtin_amdgcn_exp2f(t.x); e.y = __builtin_amdgcn_exp2f(t.y); const f32x2 d = e + 1.0f; f32x2 r; r.x = __builtin_amdgcn_rcpf(d.x); r.y = __builtin_amdgcn_rcpf(d.y); return r; }
__device__ __forceinline__ f32x2 gelu_pk(f32x2 v) {
    const f32x2 av = __builtin_elementwise_abs(v), d = av * 0.2316418882f + 1.0f;
    f32x2 t; t.x = __builtin_amdgcn_rcpf(d.x); t.y = __builtin_amdgcn_rcpf(d.y);
    f32x2 q = t * 0.5307027145f + (-0.7265760135f); q = q * t + 0.7107068705f; q = q * t + (-0.142248368f); q = q * t + 0.127414796f; q = q * t;
    const f32x2 s = (v * v) * (-0.72134752044f);
    f32x2 e; e.x = __builtin_amdgcn_exp2f(s.x); e.y = __builtin_amdgcn_exp2f(s.y);
    const f32x2 m = v * (q * e), r = v - m;
    f32x2 o; o.x = v.x < 0.f ? m.x : r.x; o.y = v.y < 0.f ? m.y : r.y; return o;
}

constexpr int RING_OFF = 0, RING_BYTES = 131072;
constexpr int GTAB_OFF = RING_BYTES, GTAB_UNITS = 20, GTAB_BYTES = GTAB_UNITS * 256 * 4;
constexpr int MISC_OFF = GTAB_OFF + GTAB_BYTES;
constexpr int LDS_BYTES = MISC_OFF + 512;
static_assert(LDS_BYTES <= 160 * 1024, "LDS map");

#define XB_TMO      128
#define XB_XCNT(j)  (256  + 64 * (j))
#define XB_XSUB(j)  (1280 + 64 * (j))
#define XB_XGEN(j)  (2304 + 64 * (j))
#define XB_TOP      3328
#define XB_TOPGEN   3392
#define XCD_BAR_WORDS 3456
#define XB_SPIN_CAP (1u << 18)
__device__ __forceinline__ unsigned xb_ld(unsigned* p)              { return __hip_atomic_load(p, __ATOMIC_RELAXED, __HIP_MEMORY_SCOPE_AGENT); }
__device__ __forceinline__ unsigned xb_add(unsigned* p, unsigned v) { return __hip_atomic_fetch_add(p, v, __ATOMIC_RELAXED, __HIP_MEMORY_SCOPE_AGENT); }
__device__ __forceinline__ unsigned xb_xcc_id() { return (unsigned)__builtin_amdgcn_s_getreg((3 << 11) | 20) & 0xFu; }
#define XB_SPIN(cond, bar) do { unsigned _sp = 0; while (cond) { __builtin_amdgcn_s_sleep(1); \
    if ((++_sp & 255u) == 0u) { if (xb_ld(&(bar)[XB_TMO])) break; if (_sp > XB_SPIN_CAP) { atomicAdd(&(bar)[XB_TMO], 1u); break; } } } } while (0)
struct XcdBarrier { unsigned* bar; unsigned x; volatile LAS unsigned* st; };
__device__ __forceinline__ XcdBarrier xcd_barrier_post(unsigned* bar, volatile LAS unsigned* st) {
    XcdBarrier b; b.bar = bar; b.x = xb_xcc_id(); b.st = st;
    if (threadIdx.x == 0) (void)xb_add(&bar[XB_XCNT(b.x)], 1u);
    return b;
}
__device__ __forceinline__ void xcd_barrier_complete(unsigned* bar, unsigned x, unsigned& nloc, unsigned& nx) {
    const unsigned G = gridDim.x * gridDim.y * gridDim.z;
    unsigned sum, cnt, mine, sp = 0u;
    for (;;) {
        sum = 0u; cnt = 0u; mine = 0u;
#pragma unroll
        for (unsigned j = 0; j < 16; ++j) { const unsigned c = xb_ld(&bar[XB_XCNT(j)]); sum += c; cnt += (c > 0u) ? 1u : 0u; mine = (j == x) ? c : mine; }
        if (sum == G) break;
        __builtin_amdgcn_s_sleep(1);
        if ((++sp & 255u) == 0u) { if (xb_ld(&bar[XB_TMO])) break; if (sp > XB_SPIN_CAP) { atomicAdd(&bar[XB_TMO], 1u); break; } }
    }
    nloc = mine > 0u ? mine : 1u; nx = cnt > 0u ? cnt : 1u;
}
__device__ __forceinline__ void xcd_barrier(const XcdBarrier& b) {
    asm volatile("s_waitcnt vmcnt(0)" ::: "memory");
    __syncthreads();
    if (threadIdx.x == 0) {
        unsigned* bar = b.bar;
        __builtin_amdgcn_s_waitcnt(0);
        unsigned nloc = b.st[0], nx = b.st[1];
        if (nloc == 0u) { xcd_barrier_complete(bar, b.x, nloc, nx); b.st[0] = nloc; b.st[1] = nx; }
        const unsigned old = xb_add(&bar[XB_XSUB(b.x)], 1u);
        const unsigned gen = old / nloc;
        if (old + 1u == (gen + 1u) * nloc) {
            __builtin_amdgcn_fence(__ATOMIC_RELEASE, "agent");
            asm volatile("s_waitcnt vmcnt(0)" ::: "memory");
            const unsigned og = xb_add(&bar[XB_TOP], 1u);
            const unsigned tg = og / nx;
            if (og + 1u == (tg + 1u) * nx) xb_add(&bar[XB_TOPGEN], 1u);
            else XB_SPIN(xb_ld(&bar[XB_TOPGEN]) == tg, bar);
            __builtin_amdgcn_fence(__ATOMIC_ACQUIRE, "agent");
            xb_add(&bar[XB_XGEN(b.x)], 1u);
            asm volatile("s_waitcnt vmcnt(0)" ::: "memory");
        } else {
            XB_SPIN(xb_ld(&bar[XB_XGEN(b.x)]) == gen, bar);
            __builtin_amdgcn_fence(__ATOMIC_ACQUIRE, "agent");
            asm volatile("s_waitcnt vmcnt(0)" ::: "memory");
        }
    }
    __syncthreads();
}
constexpr int CW_BAR = 4096;

namespace pg8 {
constexpr int BM = 256, BK = 64, HALF = 128, HTB = HALF * BK * 2, STAGE_BYTES = 8 * HTB, NXCD = 8, WGM = 8;
__host__ __device__ __forceinline__ int lds_byte(int r, int c) { return r * 128 + ((((c >> 3) ^ (r >> 1)) & 7) << 4); }
__host__ __device__ __forceinline__ void stage_rc(int b, int& R, int& C) { R = b >> 7; C = ((((b >> 4) ^ (R >> 1)) & 7) << 3); }
__host__ __device__ __forceinline__ int perm32(int rho) { const int n = rho >> 4, i = rho & 15; return 8 * (i >> 2) + 4 * n + (i & 3); }
struct Unit { int pm, pn, aux; };
typedef int v4i_t __attribute__((ext_vector_type(4)));
typedef int v8i_t __attribute__((ext_vector_type(8)));

__device__ __forceinline__ bool static_unit(int i, int G, int c, int nM, int nN, int& pm, int& pn) {
    const int nwg = nM * nN; const long L = (long)i * G + c; if (L >= nwg) return false;
    int wgid = (int)L; { const int q = nwg / NXCD, r = nwg % NXCD, xcd = wgid % NXCD, off = wgid / NXCD; wgid = (xcd < r ? xcd * (q + 1) : r * (q + 1) + (xcd - r) * q) + off; }
    const int nig = WGM * nN, gid = wgid / nig, fm = gid * WGM, gsz = (nM - fm) < WGM ? (nM - fm) : WGM;
    pm = fm + ((wgid % nig) % gsz); pn = (wgid % nig) / gsz; return true;
}

template <class Epi, class Sched, bool FP8>
__device__ __forceinline__ void gemm_phase(LAS unsigned char* lds, const Sched& S, const Epi& E, const int lda, const int ldb, const int nt) {
    const int tid = threadIdx.x, wid = __builtin_amdgcn_readfirstlane(tid >> 6), lane = tid & 63, wr = wid >> 2, wc = wid & 3, fr = lane & 15, fq = lane >> 4;
    int Rr[2], Cc[2]; unsigned voffB[2];
#pragma unroll
    for (int i = 0; i < 2; ++i) { stage_rc(tid * 16 + i * 8192, Rr[i], Cc[i]); const int Rb = (Rr[i] & ~31) + perm32(Rr[i] & 31); voffB[i] = (unsigned)(Rb * ldb + Cc[i] * 2); }
    const size_t kstep = (size_t)(BK * 2);
    const size_t hstepB = (size_t)HALF * ldb;
    const size_t hstepA = Sched::GATHER ? (size_t)0 : (size_t)HALF * lda;
    const unsigned ldsw = (unsigned)wid * 1024u;
    const int aoff = lds_byte(wr * 64 + fr, fq * 8), boff = lds_byte(wc * 32 + fr, fq * 8);
#define PG8_SA(b, h) (((b) * 2 + (h)) * HTB)
#define PG8_SB(b, h) ((4 + (b) * 2 + (h)) * HTB)
#define PG8_STAGE(bufoff, gbase, voff) do { _Pragma("unroll") for (int _i = 0; _i < 2; ++_i) \
        __builtin_amdgcn_global_load_lds((const unsigned*)((const char*)(gbase) + (voff)[_i]), (LAS unsigned*)(lds + (bufoff) + ldsw + _i * 8192), 16, 0, 0); } while (0)
#define PG8_LDA(dst, b, h) do { _Pragma("unroll") for (int m = 0; m < 4; ++m) _Pragma("unroll") for (int k = 0; k < 2; ++k) dst[m][k] = *(const LAS bf16x8*)(lds + PG8_SA(b, h) + (aoff ^ (k * 64)) + m * 2048); } while (0)
#define PG8_LDB(dst, b, h) do { _Pragma("unroll") for (int n = 0; n < 2; ++n) _Pragma("unroll") for (int k = 0; k < 2; ++k) dst[n][k] = *(const LAS bf16x8*)(lds + PG8_SB(b, h) + (boff ^ (k * 64)) + n * 2048); } while (0)
#define PG8_CAT(x) __builtin_shufflevector(__builtin_bit_cast(v4i_t, (x)[0]), __builtin_bit_cast(v4i_t, (x)[1]), 0, 1, 2, 3, 4, 5, 6, 7)
#define PG8_MMA(ai, bj, At, Bt) do { __builtin_amdgcn_s_setprio(1); if constexpr (FP8) { _Pragma("unroll") for (int m = 0; m < 4; ++m) _Pragma("unroll") for (int n = 0; n < 2; ++n) \
        acc[ai][bj][m][n] = __builtin_amdgcn_mfma_scale_f32_16x16x128_f8f6f4(PG8_CAT(Bt[n]), PG8_CAT(At[m]), acc[ai][bj][m][n], 0, 0, 0, 0x7F7F7F7F, 0, 0x7F7F7F7F); } \
    else { _Pragma("unroll") for (int m = 0; m < 4; ++m) _Pragma("unroll") for (int n = 0; n < 2; ++n) _Pragma("unroll") for (int k = 0; k < 2; ++k) \
        acc[ai][bj][m][n] = __builtin_amdgcn_mfma_f32_16x16x32_bf16(Bt[n][k], At[m][k], acc[ai][bj][m][n], 0, 0, 0); } __builtin_amdgcn_s_setprio(0); } while (0)
#define PG8_WAIT_V(n) asm volatile("s_waitcnt vmcnt(" #n ")" ::: "memory")
#define PG8_WAIT_L(n) asm volatile("s_waitcnt lgkmcnt(" #n ")" ::: "memory")
#define PG8_BAR __builtin_amdgcn_s_barrier()
#define PG8_SCHED __builtin_amdgcn_sched_barrier(0)
    Unit cur, nxt; int ui = 0;
    if (!S.next(0, cur)) return;
    f32x4 acc[2][2][4][2];
#pragma unroll
    for (int a = 0; a < 2; ++a)
#pragma unroll
        for (int b = 0; b < 2; ++b)
#pragma unroll
            for (int m = 0; m < 4; ++m)
#pragma unroll
                for (int n = 0; n < 2; ++n) acc[a][b][m][n] = (f32x4){0.f, 0.f, 0.f, 0.f};
    bf16x8 At[4][2], B0[2][2], B1[2][2];
    unsigned oA[2][2];
#pragma unroll
    for (int h = 0; h < 2; ++h)
#pragma unroll
        for (int i = 0; i < 2; ++i) oA[h][i] = Sched::GATHER ? (S.goff(0, h * HALF + Rr[i]) + (unsigned)Cc[i] * 2u) : (unsigned)(Rr[i] * lda + Cc[i] * 2);
    const char* cA = S.aptr(cur); const char* cB = S.bptr(cur);
    PG8_STAGE(PG8_SB(0, 0), cB, voffB); PG8_STAGE(PG8_SB(0, 1), cB + hstepB, voffB); PG8_STAGE(PG8_SA(0, 0), cA, oA[0]); PG8_STAGE(PG8_SA(0, 1), cA + hstepA, oA[1]);
    if (wr == 1) PG8_BAR;
    PG8_WAIT_V(2); PG8_BAR;
    PG8_STAGE(PG8_SB(1, 0), cB + kstep, voffB); PG8_STAGE(PG8_SA(1, 0), cA + kstep, oA[0]); PG8_STAGE(PG8_SB(1, 1), cB + hstepB + kstep, voffB);
    PG8_WAIT_V(6); PG8_BAR;
    for (;;) {
        const bool has_next = S.next(ui + 1, nxt);
        const char* nA = has_next ? S.aptr(nxt) : cA; const char* nB = has_next ? S.bptr(nxt) : cB;
#pragma clang loop unroll(disable)
        for (int t = 0; t < nt; t += 2) {
            const bool last = (t == nt - 2);
            const char* a1 = cA + (size_t)(t + 1) * kstep;
            const char* a2 = last ? nA : cA + (size_t)(t + 2) * kstep; const char* b2 = last ? nB : cB + (size_t)(t + 2) * kstep;
            const char* a3 = a2 + kstep; const char* b3 = b2 + kstep;
            PG8_LDB(B0, 0, 0); PG8_LDB(B1, 0, 1); PG8_SCHED; PG8_LDA(At, 0, 0); PG8_STAGE(PG8_SA(1, 1), a1 + hstepA, oA[1]);
            if constexpr (Sched::GATHER) { if (last && has_next) {
#pragma unroll
                for (int h = 0; h < 2; ++h)
#pragma unroll
                    for (int i = 0; i < 2; ++i) oA[h][i] = S.goff(ui + 1, h * HALF + Rr[i]) + (unsigned)Cc[i] * 2u; } }
            PG8_WAIT_V(8); PG8_WAIT_L(0); PG8_BAR; PG8_MMA(0, 0, At, B0); PG8_MMA(0, 1, At, B1); PG8_BAR; PG8_SCHED;
            PG8_LDA(At, 0, 1); PG8_STAGE(PG8_SB(0, 0), b2, voffB); PG8_STAGE(PG8_SB(0, 1), b2 + hstepB, voffB); PG8_STAGE(PG8_SA(0, 0), a2, oA[0]);
            PG8_WAIT_V(8); PG8_WAIT_L(0); PG8_BAR; PG8_MMA(1, 0, At, B0); PG8_MMA(1, 1, At, B1); PG8_BAR; PG8_SCHED;
            PG8_LDB(B0, 1, 0); PG8_LDB(B1, 1, 1); PG8_SCHED; PG8_LDA(At, 1, 0); PG8_STAGE(PG8_SA(0, 1), a2 + hstepA, oA[1]);
            PG8_WAIT_V(8); PG8_WAIT_L(0); PG8_BAR; PG8_MMA(0, 0, At, B0); PG8_MMA(0, 1, At, B1); PG8_BAR; PG8_SCHED;
            PG8_LDA(At, 1, 1); PG8_STAGE(PG8_SB(1, 0), b3, voffB); PG8_STAGE(PG8_SB(1, 1), b3 + hstepB, voffB); PG8_STAGE(PG8_SA(1, 0), a3, oA[0]);
            PG8_WAIT_V(8); PG8_WAIT_L(0); PG8_BAR; PG8_MMA(1, 0, At, B0); PG8_MMA(1, 1, At, B1); PG8_BAR; PG8_SCHED;
        }
        if (wr == 0) PG8_BAR;
        bool keep = false;
        {
            int tz = threadIdx.x; asm volatile("" : "+v"(tz)); const int ewid = tz >> 6, el = tz & 63, ewr = ewid >> 2, ewc = ewid & 3, efr = el & 15, efq = el >> 4;
            if constexpr (Sched::HAS_MID) { if (S.is_mid(cur)) { E.mid(acc, cur, ewr, ewc, efr, efq); keep = true; } }
            if (!keep) E(acc, cur, ewr, ewc, efr, efq);
        }
        if (!has_next) break;
        if (!keep) {
#pragma unroll
            for (int a = 0; a < 2; ++a)
#pragma unroll
                for (int b = 0; b < 2; ++b)
#pragma unroll
                    for (int m = 0; m < 4; ++m)
#pragma unroll
                        for (int n = 0; n < 2; ++n) acc[a][b][m][n] = (f32x4){0.f, 0.f, 0.f, 0.f};
        }
        cur = nxt; cA = nA; cB = nB; ++ui;
        if (wr == 1) PG8_BAR;
    }
    PG8_WAIT_V(0);
    PG8_BAR;
#undef PG8_SA
#undef PG8_SB
#undef PG8_STAGE
#undef PG8_LDA
#undef PG8_LDB
#undef PG8_MMA
#undef PG8_CAT
#undef PG8_WAIT_V
#undef PG8_WAIT_L
#undef PG8_BAR
#undef PG8_SCHED
}
}
using pg8::Unit;

struct Args { const float* in[25]; float* out; unsigned char* ws; int ph_lo, ph_hi, pad0, pad1; };
static_assert(sizeof(Args) == 27 * 8 + 16, "Args has no padding");
struct Frame {
    LAS unsigned char* lds; volatile LAS unsigned* MISC; unsigned* ctl;
    int tid, lane, wave, vcu, G;
};
#define LDS_WAIT() asm volatile("s_waitcnt lgkmcnt(0)" ::: "memory")
#define VM_WAIT() asm volatile("s_waitcnt vmcnt(0)" ::: "memory")

struct SchedStatic {
    static constexpr bool GATHER = false, HAS_MID = false;
    const char* A; const char* B; int nM, nN, G, c; size_t astep, bstep;
    __device__ __forceinline__ bool next(int i, Unit& u) const { u.aux = 0; return pg8::static_unit(i, G, c, nM, nN, u.pm, u.pn); }
    __device__ __forceinline__ const char* aptr(const Unit& u) const { return A + (size_t)u.pm * astep; }
    __device__ __forceinline__ const char* bptr(const Unit& u) const { return B + (size_t)u.pn * bstep; }
    __device__ __forceinline__ bool is_mid(const Unit&) const { return false; }
    __device__ __forceinline__ unsigned goff(int, int) const { return 0u; }
};
struct SchedSplit2 {
    static constexpr bool GATHER = false, HAS_MID = true;
    const char* A; const char* B; int nM, nN, G, c; size_t astep, bstep, khalf;
    __device__ __forceinline__ bool next(int i, Unit& u) const { u.aux = i & 1; return pg8::static_unit(i >> 1, G, c, nM, nN, u.pm, u.pn); }
    __device__ __forceinline__ const char* aptr(const Unit& u) const { return A + (size_t)u.pm * astep + (size_t)u.aux * khalf; }
    __device__ __forceinline__ const char* bptr(const Unit& u) const { return B + (size_t)u.pn * bstep + (size_t)u.aux * khalf; }
    __device__ __forceinline__ bool is_mid(const Unit& u) const { return u.aux == 0; }
    __device__ __forceinline__ unsigned goff(int, int) const { return 0u; }
};
__device__ __forceinline__ int moe_find_e(volatile LAS unsigned* MISC, int rb) { int e = 0;
#pragma unroll 1
    for (int i = 1; i < NEXP; ++i) e += ((int)MISC[i] <= rb) ? 1 : 0;
    return e; }
template <int NPN, bool GATH>
struct SchedMoe {
    static constexpr bool GATHER = GATH, HAS_MID = false;
    static constexpr int RPX = 32 / NPN;
    static constexpr int UT0 = 96, UTN = 24;
    const char* A; const char* B; volatile LAS unsigned* MISC; const LAS unsigned* gtab; int c, G, nrb; size_t bstep_e, bstep_n;
    __device__ __forceinline__ bool slow_next(int i, Unit& u) const {
        int rb, pn;
        if (G == 256) { const int x = c & 7, j = c >> 3; rb = (8 * i + x) * RPX + j / NPN; pn = j % NPN; }
        else { const long L = (long)i * G + c; rb = (int)(L / NPN); pn = (int)(L % NPN); }
        if (rb >= nrb) return false;
        u.pm = rb; u.pn = pn; u.aux = moe_find_e(MISC, rb); return true;
    }
    __device__ __forceinline__ void build(int tid) const {
        if (tid < UTN) { Unit u; const bool ok = slow_next(tid, u); MISC[UT0 + tid] = ok ? (0x80000000u | ((unsigned)u.aux << 16) | ((unsigned)u.pn << 12) | (unsigned)u.pm) : 0u; }
        __syncthreads();
    }
    __device__ __forceinline__ bool next(int i, Unit& u) const {
        if (i >= UTN) return false;
        const unsigned w = MISC[UT0 + i]; if (!(w >> 31)) return false;
        u.pm = (int)(w & 0xfffu); u.pn = (int)((w >> 12) & 0xfu); u.aux = (int)((w >> 16) & 0xffu); return true;
    }
    __device__ __forceinline__ const char* aptr(const Unit& u) const { return GATH ? A : A + (size_t)u.pm * (256 * 1024); }
    __device__ __forceinline__ const char* bptr(const Unit& u) const { return B + (size_t)u.aux * bstep_e + (size_t)u.pn * bstep_n; }
    __device__ __forceinline__ bool is_mid(const Unit&) const { return false; }
    __device__ __forceinline__ unsigned goff(int ui, int row) const { return gtab[ui * 256 + row]; }
};

#define EPI_ARGS f32x4 (&acc)[2][2][4][2], const Unit& u, int wr, int wc, int fr, int fq
struct EpiG1 {
    bf16 *Q, *K, *V, *U, *VG, *GT; const float* bgate;
    __device__ __forceinline__ void mid(EPI_ARGS) const {}
    __device__ __forceinline__ void operator()(EPI_ARGS) const {
        const int pn = u.pn; const int row0 = u.pm * 256 + wr * 64 + fr;
        if (pn < 6) {
            const int t = pn >> 1; bf16* base = Q + (size_t)t * ((WS_K - WS_Q) / 2); const float sc = (t == 0) ? QSCALE : 1.0f;    const int col0 = (pn & 1) * 256 + wc * 32 + 8 * fq;
#pragma unroll
            for (int ai = 0; ai < 2; ++ai)
#pragma unroll
                for (int m = 0; m < 4; ++m) { bf16* rowp = base + (size_t)(row0 + ai * 128 + m * 16) * 512 + col0;
#pragma unroll
                    for (int bj = 0; bj < 2; ++bj) { const f32x4 v0 = acc[ai][bj][m][0] * sc, v1 = acc[ai][bj][m][1] * sc;
                        u32x4 w; w.x = cvtpk(v0[0], v0[1]); w.y = cvtpk(v0[2], v0[3]); w.z = cvtpk(v1[0], v1[1]); w.w = cvtpk(v1[2], v1[3]); *(u32x4*)(rowp + bj * 128) = w; } }
        } else if (pn < 10) {
            bf16* base = Q + (size_t)(pn >> 1) * ((WS_K - WS_Q) / 2); const int col0 = (pn & 1) * 256 + wc * 32 + 8 * fq;
#pragma unroll
            for (int ai = 0; ai < 2; ++ai)
#pragma unroll
                for (int m = 0; m < 4; ++m) { bf16* rowp = base + (size_t)(row0 + ai * 128 + m * 16) * 512 + col0;
#pragma unroll
                    for (int bj = 0; bj < 2; ++bj) { const f32x4 v0 = acc[ai][bj][m][0], v1 = acc[ai][bj][m][1];
                        const f32x2 a = gelu_pk((f32x2){v0[0], v0[1]}), b = gelu_pk((f32x2){v0[2], v0[3]}), c = gelu_pk((f32x2){v1[0], v1[1]}), d = gelu_pk((f32x2){v1[2], v1[3]});
                        u32x4 w; w.x = cvtpk(a.x, a.y); w.y = cvtpk(b.x, b.y); w.z = cvtpk(c.x, c.y); w.w = cvtpk(d.x, d.y); *(u32x4*)(rowp + bj * 128) = w; } }
        } else {
            const int col0 = (pn - 10) * 128 + wc * 32 + 8 * fq;
            const f32x4 ba0 = *(const f32x4*)(bgate + col0), ba1 = *(const f32x4*)(bgate + col0 + 4), bb0 = *(const f32x4*)(bgate + 1024 + col0), bb1 = *(const f32x4*)(bgate + 1024 + col0 + 4);
#pragma unroll
            for (int ai = 0; ai < 2; ++ai)
#pragma unroll
                for (int m = 0; m < 4; ++m) { bf16* rowp = GT + (size_t)(row0 + ai * 128 + m * 16) * 2048 + col0;
                    const f32x4 a0 = acc[ai][0][m][0] + ba0, a1 = acc[ai][0][m][1] + ba1, b0 = acc[ai][1][m][0] + bb0, b1 = acc[ai][1][m][1] + bb1;
                    f32x4 ea0, ea1, eb0, eb1;
#pragma unroll
                    for (int i = 0; i < 4; ++i) { ea0[i] = __builtin_amdgcn_exp2f(-LOG2E * a0[i]); ea1[i] = __builtin_amdgcn_exp2f(-LOG2E * a1[i]); eb0[i] = fminf(__builtin_amdgcn_exp2f(-LOG2E * b0[i]), 1e18f); eb1[i] = fminf(__builtin_amdgcn_exp2f(-LOG2E * b1[i]), 1e18f); }
                    f32x4 gb0, gb1, r0, r1;
#pragma unroll
                    for (int i = 0; i < 4; ++i) { gb0[i] = __builtin_amdgcn_rcpf(1.0f + eb0[i]); gb1[i] = __builtin_amdgcn_rcpf(1.0f + eb1[i]); r0[i] = (1.0f + eb0[i]) * __builtin_amdgcn_rcpf(1.0f + ea0[i]); r1[i] = (1.0f + eb1[i]) * __builtin_amdgcn_rcpf(1.0f + ea1[i]); }
                    u32x4 wr, wb; wr.x = cvtpk(r0[0], r0[1]); wr.y = cvtpk(r0[2], r0[3]); wr.z = cvtpk(r1[0], r1[1]); wr.w = cvtpk(r1[2], r1[3]);
                    wb.x = cvtpk(gb0[0], gb0[1]); wb.y = cvtpk(gb0[2], gb0[3]); wb.z = cvtpk(gb1[0], gb1[1]); wb.w = cvtpk(gb1[2], gb1[3]);
                    *(u32x4*)rowp = wr; *(u32x4*)(rowp + 1024) = wb; }
        }
    }
};
struct EpiG2 {
    const bf16* GT; bf16* MRG;
    __device__ __forceinline__ void mid(EPI_ARGS) const {
        const int row0 = u.pm * 256 + wr * 64 + fr, col0 = u.pn * 256 + wc * 32 + 8 * fq;
#pragma unroll
        for (int ai = 0; ai < 2; ++ai)
#pragma unroll
            for (int m = 0; m < 4; ++m) { const bf16* gp = GT + (size_t)(row0 + ai * 128 + m * 16) * 2048 + col0;
#pragma unroll
                for (int bj = 0; bj < 2; ++bj) { const u32x4 rr = __builtin_nontemporal_load((const u32x4*)(gp + bj * 128));
                    const f32x4 r0 = {bflo(rr.x), bfhi(rr.x), bflo(rr.y), bfhi(rr.y)}, r1 = {bflo(rr.z), bfhi(rr.z), bflo(rr.w), bfhi(rr.w)};
                    acc[ai][bj][m][0] *= r0; acc[ai][bj][m][1] *= r1; } }
    }
    __device__ __forceinline__ void operator()(EPI_ARGS) const {
        const int row0 = u.pm * 256 + wr * 64 + fr, col0 = u.pn * 256 + wc * 32 + 8 * fq;
#pragma unroll
        for (int ai = 0; ai < 2; ++ai)
#pragma unroll
            for (int m = 0; m < 4; ++m) { const size_t r = (size_t)(row0 + ai * 128 + m * 16); const bf16* gp = GT + r * 2048 + 1024 + col0; bf16* op = MRG + r * 1024 + col0;
#pragma unroll
                for (int bj = 0; bj < 2; ++bj) { const u32x4 gb = __builtin_nontemporal_load((const u32x4*)(gp + bj * 128)); const f32x4 v0 = acc[ai][bj][m][0], v1 = acc[ai][bj][m][1];
                    u32x4 w; w.x = cvtpk(v0[0] * bflo(gb.x), v0[1] * bfhi(gb.x)); w.y = cvtpk(v0[2] * bflo(gb.y), v0[3] * bfhi(gb.y));
                    w.z = cvtpk(v1[0] * bflo(gb.z), v1[1] * bfhi(gb.z)); w.w = cvtpk(v1[2] * bflo(gb.w), v1[3] * bfhi(gb.w)); *(u32x4*)(op + bj * 128) = w; } }
    }
};
struct EpiPlain {
    bf16* O;
    __device__ __forceinline__ void mid(EPI_ARGS) const {}
    __device__ __forceinline__ void operator()(EPI_ARGS) const {
        const int row0 = u.pm * 256 + wr * 64 + fr, col0 = u.pn * 256 + wc * 32 + 8 * fq;
#pragma unroll
        for (int ai = 0; ai < 2; ++ai)
#pragma unroll
            for (int m = 0; m < 4; ++m) { bf16* op = O + (size_t)(row0 + ai * 128 + m * 16) * 1024 + col0;
#pragma unroll
                for (int bj = 0; bj < 2; ++bj) { const f32x4 v0 = acc[ai][bj][m][0], v1 = acc[ai][bj][m][1];
                    u32x4 w; w.x = cvtpk(v0[0], v0[1]); w.y = cvtpk(v0[2], v0[3]); w.z = cvtpk(v1[0], v1[1]); w.w = cvtpk(v1[2], v1[3]); *(u32x4*)(op + bj * 128) = w; } }
    }
};
struct EpiAct {
    const float* bgu; unsigned char* ACT8;
    __device__ __forceinline__ void mid(EPI_ARGS) const {}
    __device__ __forceinline__ f32x2 act2(f32x2 g, f32x2 l) const {
        f32x2 xg, xl; xg.x = fminf(g.x, SWL); xg.y = fminf(g.y, SWL); xl.x = fminf(fmaxf(l.x, -SWL), SWL); xl.y = fminf(fmaxf(l.y, -SWL), SWL);
        const f32x2 t = xg * (-SWA * LOG2E); f32x2 e; e.x = __builtin_amdgcn_exp2f(t.x); e.y = __builtin_amdgcn_exp2f(t.y);
        const f32x2 d = e + 1.0f; f32x2 r; r.x = __builtin_amdgcn_rcpf(d.x); r.y = __builtin_amdgcn_rcpf(d.y);
        return (xg * r) * (xl * F8_ASCALE + F8_ASCALE);
    }
    __device__ __forceinline__ void operator()(EPI_ARGS) const {
        const int e = u.aux; const int row0 = u.pm * 256 + wr * 64 + fr, col0 = u.pn * 128 + wc * 32 + 8 * fq;
        const float* bp = bgu + (size_t)e * 2048 + col0;
        const f32x4 bg0 = *(const f32x4*)(bp), bg1 = *(const f32x4*)(bp + 4), bl0 = *(const f32x4*)(bp + 1024), bl1 = *(const f32x4*)(bp + 1028);
#pragma unroll
        for (int ai = 0; ai < 2; ++ai)
#pragma unroll
            for (int m = 0; m < 4; ++m) {
                const f32x4 g0 = acc[ai][0][m][0] * F8_DESCALE + bg0, g1 = acc[ai][0][m][1] * F8_DESCALE + bg1, l0 = acc[ai][1][m][0] * F8_DESCALE + bl0, l1 = acc[ai][1][m][1] * F8_DESCALE + bl1;
                const f32x2 o0 = act2((f32x2){g0[0], g0[1]}, (f32x2){l0[0], l0[1]}), o1 = act2((f32x2){g0[2], g0[3]}, (f32x2){l0[2], l0[3]});
                const f32x2 o2 = act2((f32x2){g1[0], g1[1]}, (f32x2){l1[0], l1[1]}), o3 = act2((f32x2){g1[2], g1[3]}, (f32x2){l1[2], l1[3]});
                u32x2 w; w.x = pk_fp8x4(o0.x, o0.y, o1.x, o1.y); w.y = pk_fp8x4(o2.x, o2.y, o3.x, o3.y);
                *(u32x2*)(ACT8 + (size_t)(row0 + ai * 128 + m * 16) * 1024 + col0) = w; }
    }
};
struct EpiDown {
    const float* bdn; unsigned char* Y2s;
    __device__ __forceinline__ void mid(EPI_ARGS) const {}
    __device__ __forceinline__ void operator()(EPI_ARGS) const {
        const int e = u.aux; const int row0 = u.pm * 256 + wr * 64 + fr, col0 = u.pn * 256 + wc * 32 + 8 * fq;
        f32x4 bv[2][2];
#pragma unroll
        for (int bj = 0; bj < 2; ++bj)
#pragma unroll
            for (int n = 0; n < 2; ++n) bv[bj][n] = *(const f32x4*)(bdn + (size_t)e * 1024 + col0 + bj * 128 + 4 * n) * F8_YSCALE;
#pragma unroll
        for (int ai = 0; ai < 2; ++ai)
#pragma unroll
            for (int m = 0; m < 4; ++m) { unsigned char* op = Y2s + (size_t)(row0 + ai * 128 + m * 16) * 1024 + col0;
#pragma unroll
                for (int bj = 0; bj < 2; ++bj) { const f32x4 v0 = acc[ai][bj][m][0] * (F8_DESCALE * F8_YSCALE) + bv[bj][0], v1 = acc[ai][bj][m][1] * (F8_DESCALE * F8_YSCALE) + bv[bj][1];
                    u32x2 w; w.x = pk_fp8x4(v0[0], v0[1], v0[2], v0[3]); w.y = pk_fp8x4(v1[0], v1[1], v1[2], v1[3]); *(u32x2*)(op + bj * 128) = w; } }
    }
};

struct WItem { const float* W; unsigned char* dst; int N, k0, n0, ldt, drow, dk0, fp8; };
__device__ __forceinline__ WItem witem_decode(const Args& a, int r) {
    unsigned char* ws = a.ws; WItem it;
    constexpr int I_IN = 8 * 80, I_GATE = 8 * 64, I_BR = 4 * 32, I_OUT = 8 * 32, I_GU = 8 * 64, I_DN = 8 * 32;
    it.fp8 = 0; it.dk0 = 0; it.ldt = 2048;
    if (r < I_IN) { it.W = a.in[6]; it.N = INW; it.k0 = 128 * (r / 80); it.n0 = 32 * (r % 80); it.dst = ws + WS_W1T; it.drow = it.n0; return it; } r -= I_IN;
    if (r < I_GATE) { it.W = a.in[14]; it.N = 2048; it.k0 = 128 * (r / 64); it.n0 = 32 * (r % 64); it.dst = ws + WS_W1T; const int m0 = it.n0 & 1023;
        it.drow = INW + 256 * (m0 >> 7) + (m0 & 127) + (it.n0 >= 1024 ? 128 : 0); return it; } r -= I_GATE;
    if (r < I_BR) { it.W = a.in[12]; it.N = 1024; it.k0 = 128 * (r / 32); it.n0 = 32 * (r % 32); it.dst = ws + WS_WBRT; it.drow = it.n0; return it; } r -= I_BR;
    if (r < I_BR) { it.W = a.in[13]; it.N = 1024; it.k0 = 128 * (r / 32); it.n0 = 32 * (r % 32); it.dst = ws + WS_WBRT; it.drow = it.n0; it.dk0 = 512; return it; } r -= I_BR;
    if (r < I_OUT) { it.W = a.in[16]; it.N = 1024; it.k0 = 128 * (r / 32); it.n0 = 32 * (r % 32); it.dst = ws + WS_WOUTT; it.drow = it.n0; return it; } r -= I_OUT;
    it.fp8 = 1; it.ldt = 1024;
    if (r < NEXP * I_GU) { const int e = r / I_GU, q = r % I_GU; it.W = a.in[21] + (size_t)e * D * 2048; it.N = 2048; it.k0 = 128 * (q / 64); it.n0 = 32 * (q % 64); it.dst = ws + WS_WGUT + (size_t)e * 2048 * 1024;
        const int m0 = it.n0 & 1023; it.drow = 256 * (m0 >> 7) + (m0 & 127) + (it.n0 >= 1024 ? 128 : 0); return it; }
    r -= NEXP * I_GU;
    { const int e = r / I_DN, q = r % I_DN; it.W = a.in[23] + (size_t)e * D * D; it.N = 1024; it.k0 = 128 * (q / 32); it.n0 = 32 * (q % 32); it.dst = ws + WS_WDNT + (size_t)e * 1024 * 1024; it.drow = it.n0; }
    return it;
}
constexpr int W_NITEMS = 8 * 80 + 8 * 64 + 2 * 4 * 32 + 8 * 32 + NEXP * (8 * 64 + 8 * 32);
__device__ __forceinline__ void witem_load(const WItem& it, float (&v)[64], int lane) {
    const float* p = it.W + (size_t)(it.k0 + (lane >> 3)) * it.N + it.n0 + (lane & 7) * 4;
#pragma unroll
    for (int i = 0; i < 16; ++i) { const f32x4 t = __builtin_nontemporal_load((const f32x4*)(p + (size_t)(8 * i) * it.N)); v[4 * i] = t[0]; v[4 * i + 1] = t[1]; v[4 * i + 2] = t[2]; v[4 * i + 3] = t[3]; }
}
__device__ __forceinline__ void witem_store(const WItem& it, const float (&v)[64], LAS float* scr, int lane) {
#pragma unroll
    for (int i = 0; i < 16; ++i) { const int k = 8 * i + (lane >> 3); *(LAS f32x4*)(scr + k * 32 + (((lane & 7) * 4 + 4 * (i >> 1)) & 31)) = (f32x4){v[4 * i], v[4 * i + 1], v[4 * i + 2], v[4 * i + 3]}; }
    LDS_WAIT(); asm volatile("" ::: "memory");
    const int c = lane & 7;
#pragma unroll
    for (int j = 0; j < 4; ++j) { const int n = (lane >> 3) + 8 * j; const LAS float* s = scr + (16 * c) * 32 + ((n + 4 * c) & 31);
        float x[16];
#pragma unroll
        for (int q = 0; q < 16; ++q) x[q] = s[q * 32];
        unsigned char* d = it.dst + (size_t)(it.drow + n) * it.ldt;
        if (it.fp8) { u32x4 o;
            o.x = pk_fp8x4(x[0] * F8_WSCALE, x[1] * F8_WSCALE, x[2] * F8_WSCALE, x[3] * F8_WSCALE); o.y = pk_fp8x4(x[4] * F8_WSCALE, x[5] * F8_WSCALE, x[6] * F8_WSCALE, x[7] * F8_WSCALE);
            o.z = pk_fp8x4(x[8] * F8_WSCALE, x[9] * F8_WSCALE, x[10] * F8_WSCALE, x[11] * F8_WSCALE); o.w = pk_fp8x4(x[12] * F8_WSCALE, x[13] * F8_WSCALE, x[14] * F8_WSCALE, x[15] * F8_WSCALE);
            *(u32x4*)(d + it.dk0 + it.k0 + 16 * c) = o; }
        else { u32x4 o0, o1;
            o0.x = cvtpk(x[0], x[1]); o0.y = cvtpk(x[2], x[3]); o0.z = cvtpk(x[4], x[5]); o0.w = cvtpk(x[6], x[7]); o1.x = cvtpk(x[8], x[9]); o1.y = cvtpk(x[10], x[11]); o1.z = cvtpk(x[12], x[13]); o1.w = cvtpk(x[14], x[15]);
            *(u32x4*)(d + (size_t)(it.dk0 + it.k0 + 16 * c) * 2) = o0; *(u32x4*)(d + (size_t)(it.dk0 + it.k0 + 16 * c) * 2 + 16) = o1; } }
    LDS_WAIT(); asm volatile("" ::: "memory");
}
__device__ __forceinline__ void phaseA(const Frame& F, const Args& a) {
    unsigned char* ws = a.ws;
    if (F.vcu < 192) {
        const float* c = a.in[1]; const float* w_ada = a.in[2]; const float* b_ada = a.in[3]; float* mod = (float*)(ws + WS_MOD);
        LAS float* red = (LAS float*)(F.lds);
        const int col = F.vcu * 32 + (F.tid & 31), ks = F.tid >> 5;
        float a0 = 0.f, a1 = 0.f, a2 = 0.f, a3 = 0.f;
        for (int k = ks * 64; k < ks * 64 + 64; ++k) { const float w = __builtin_nontemporal_load(w_ada + (size_t)k * 6144 + col);
            const float c0 = c[k], c1 = c[D + k], c2 = c[2 * D + k], c3 = c[3 * D + k];
            a0 += c0 * __builtin_amdgcn_rcpf(1.0f + __expf(-c0)) * w; a1 += c1 * __builtin_amdgcn_rcpf(1.0f + __expf(-c1)) * w;
            a2 += c2 * __builtin_amdgcn_rcpf(1.0f + __expf(-c2)) * w; a3 += c3 * __builtin_amdgcn_rcpf(1.0f + __expf(-c3)) * w; }
        red[(ks * 4 + 0) * 32 + (F.tid & 31)] = a0; red[(ks * 4 + 1) * 32 + (F.tid & 31)] = a1; red[(ks * 4 + 2) * 32 + (F.tid & 31)] = a2; red[(ks * 4 + 3) * 32 + (F.tid & 31)] = a3;
        __syncthreads();
        if (F.tid < 128) { const int b = F.tid >> 5, cc = F.tid & 31; float s = 0.f;
#pragma unroll
            for (int k = 0; k < 16; ++k) s += red[(k * 4 + b) * 32 + cc];
            mod[b * 6144 + F.vcu * 32 + cc] = s + b_ada[F.vcu * 32 + cc]; }
        __syncthreads();
    }
    if (F.vcu == 192 % F.G) {
        const float* w_router = a.in[19]; bf16* wrt = (bf16*)(ws + WS_WRT);
        for (int i = F.tid; i < D * NEXP; i += NWAVES * 64) { const int k = i >> 5, e = i & 31; const float w = w_router[i]; const unsigned hh = cvtpk(w, 0.f) & 0xffffu;
            wrt[(size_t)e * D + k] = (bf16)hh; wrt[(size_t)(NEXP + e) * D + k] = (bf16)(cvtpk(w - bflo(hh), 0.f) & 0xffffu); }
    }
    LAS float* scr = (LAS float*)(F.lds + F.wave * 17408);
    const int gw = F.vcu * NWAVES + F.wave, NGW = F.G * NWAVES;
    if (gw < W_NITEMS) {
        float va[64], vb[64];
        WItem ia = witem_decode(a, gw), ib = ia;
        witem_load(ia, va, F.lane);
        for (int it = gw; it < W_NITEMS; it += 2 * NGW) {
            const bool hb = (it + NGW < W_NITEMS);
            ib = witem_decode(a, hb ? it + NGW : it); witem_load(ib, vb, F.lane);
            witem_store(ia, va, scr, F.lane);
            if (!hb) break;
            const bool ha = (it + 2 * NGW < W_NITEMS);
            ia = witem_decode(a, ha ? it + 2 * NGW : it); witem_load(ia, va, F.lane);
            witem_store(ib, vb, scr, F.lane);
            if (!ha) break;
        }
    }
}
__device__ __forceinline__ void phaseB(const Frame& F, const Args& a) {
    const float* x = a.in[0]; const float* g = a.in[4]; const float* mod = (const float*)(a.ws + WS_MOD); bf16* xn = (bf16*)(a.ws + WS_XN);
    const int gw = F.vcu * NWAVES + F.wave, NGW = F.G * NWAVES;
    f32x4 cg[4], csh[4]; int cb = -1;
    for (int row0 = gw * 4; row0 < NTOK; row0 += NGW * 4) {
        f32x4 v[4][4];
#pragma unroll
        for (int rr = 0; rr < 4; ++rr)
#pragma unroll
            for (int j = 0; j < 4; ++j) v[rr][j] = __builtin_nontemporal_load((const f32x4*)(x + (size_t)(row0 + rr) * D) + F.lane + 64 * j);
        const int b = row0 / SEQ; const float* mb = mod + b * 6144;
        if (b != cb) { cb = b;
#pragma unroll
            for (int j = 0; j < 4; ++j) { const int c0 = (F.lane + 64 * j) * 4; cg[j] = *(const f32x4*)(g + c0) * (*(const f32x4*)(mb + SC1 + c0) + 1.0f); csh[j] = *(const f32x4*)(mb + SH1 + c0); } }
#pragma unroll
        for (int rr = 0; rr < 4; ++rr) {
            float ss = 0.f;
#pragma unroll
            for (int j = 0; j < 4; ++j) ss += (v[rr][j].x * v[rr][j].x + v[rr][j].y * v[rr][j].y) + (v[rr][j].z * v[rr][j].z + v[rr][j].w * v[rr][j].w);
            const float rstd = rsqrtf(wsum(ss) * (1.0f / D) + EPS);
            u32x2* o8 = (u32x2*)(xn + (size_t)(row0 + rr) * D) + F.lane;
#pragma unroll
            for (int j = 0; j < 4; ++j) {
                const f32x4 h = v[rr][j] * rstd * cg[j] + csh[j];
                u32x2 w; w.x = cvtpk(h[0], h[1]); w.y = cvtpk(h[2], h[3]); o8[64 * j] = w; }
        }
    }
}

constexpr int SGU_STRIDE = 1088;
__device__ __forceinline__ s16x4 vtr(const LAS unsigned char* p) { typedef short v4i16_t __attribute__((ext_vector_type(4))); return __builtin_bit_cast(s16x4, __builtin_amdgcn_ds_read_tr16_b64_v4i16((LAS v4i16_t*)p)); }
__device__ __forceinline__ void sgu_unit(const Frame& F, const Args& a, int b, int blk) {
    const bf16* VG = (const bf16*)(a.ws + WS_VG); const bf16* U = (const bf16*)(a.ws + WS_U); bf16* YAB = (bf16*)(a.ws + WS_YAB);
    const float* ln_g = a.in[8]; const float* ln_b = a.in[9]; const float* w_s = a.in[10]; const float* b_s = a.in[11];
    const int tok0 = b * SEQ + blk * SGB, lane = F.lane;
    {
        const f32x4 g0 = *(const f32x4*)(ln_g + lane * 8), g1 = *(const f32x4*)(ln_g + lane * 8 + 4), b0 = *(const f32x4*)(ln_b + lane * 8), b1 = *(const f32x4*)(ln_b + lane * 8 + 4);
#pragma unroll 1
        for (int r4 = 0; r4 < 16; r4 += 4) {
            u32x4 w[4];
#pragma unroll
            for (int rr = 0; rr < 4; ++rr) w[rr] = *(const u32x4*)(VG + (size_t)(tok0 + F.wave * 16 + r4 + rr) * 512 + lane * 8);
#pragma unroll
            for (int rr = 0; rr < 4; ++rr) { const int row = F.wave * 16 + r4 + rr;
                f32x4 v0 = {bflo(w[rr].x), bfhi(w[rr].x), bflo(w[rr].y), bfhi(w[rr].y)}, v1 = {bflo(w[rr].z), bfhi(w[rr].z), bflo(w[rr].w), bfhi(w[rr].w)};
                const float mu = wsum((v0[0] + v0[1]) + (v0[2] + v0[3]) + (v1[0] + v1[1]) + (v1[2] + v1[3])) * (1.0f / 512.0f);
                v0 -= mu; v1 -= mu;
                const float var = wsum((v0[0] * v0[0] + v0[1] * v0[1]) + (v0[2] * v0[2] + v0[3] * v0[3]) + (v1[0] * v1[0] + v1[1] * v1[1]) + (v1[2] * v1[2] + v1[3] * v1[3])) * (1.0f / 512.0f);
                const float rstd = rsqrtf(var + EPS);
                v0 = v0 * rstd * g0 + b0; v1 = v1 * rstd * g1 + b1;
                u32x4 o; o.x = cvtpk(v0[0], v0[1]); o.y = cvtpk(v0[2], v0[3]); o.z = cvtpk(v1[0], v1[1]); o.w = cvtpk(v1[2], v1[3]);
                *(LAS u32x4*)(F.lds + row * SGU_STRIDE + lane * 16) = o; }
        }
    }
    __syncthreads();
    {
        const int g = F.wave, r32 = lane & 31, hi = lane >> 5, i16 = lane & 15, g16 = (lane >> 4) & 1;
        const LAS unsigned char* vb = F.lds + (8 * hi + (i16 >> 2)) * SGU_STRIDE + (g * 64 + 16 * g16 + 4 * (i16 & 3)) * 2;
#pragma unroll
        for (int tb = 0; tb < 4; ++tb) {
            const int t = 32 * tb + r32; const float* wrow = w_s + ((size_t)g * 128 + t) * 128;
            f32x4 wr0[8], wr1[8];
#pragma unroll
            for (int ks = 0; ks < 2 * tb + 2; ++ks) { wr0[ks] = *(const f32x4*)(wrow + 16 * ks + 8 * hi); wr1[ks] = *(const f32x4*)(wrow + 16 * ks + 8 * hi + 4); }
            const float bs = b_s[g * 128 + t];
            const bf16* up = U + (size_t)(tok0 + t) * 512 + g * 64 + 4 * hi;
            u32x2 uu0[4], uu1[4];
#pragma unroll
            for (int gg = 0; gg < 4; ++gg) { uu0[gg] = *(const u32x2*)(up + 8 * gg); uu1[gg] = *(const u32x2*)(up + 32 + 8 * gg); }
            f32x16 a0, a1;
#pragma unroll
            for (int r = 0; r < 16; ++r) { a0[r] = 0.f; a1[r] = 0.f; }
#pragma unroll
            for (int ks = 0; ks < 2 * tb + 2; ++ks) {
                const int s0 = 16 * ks + 8 * hi;
                float wv[8] = {wr0[ks][0], wr0[ks][1], wr0[ks][2], wr0[ks][3], wr1[ks][0], wr1[ks][1], wr1[ks][2], wr1[ks][3]};
                if (ks >= 2 * tb) {
#pragma unroll
                    for (int j = 0; j < 8; ++j) wv[j] = (s0 + j <= t) ? wv[j] : 0.f; }
                u32x4 bw; bw.x = cvtpk(wv[0], wv[1]); bw.y = cvtpk(wv[2], wv[3]); bw.z = cvtpk(wv[4], wv[5]); bw.w = cvtpk(wv[6], wv[7]);
                const bf16x8 bfrag = __builtin_bit_cast(bf16x8, bw);
                const LAS unsigned char* p = vb + ks * 16 * SGU_STRIDE;
                const s16x4 l0 = vtr(p), h0 = vtr(p + 4 * SGU_STRIDE), l1 = vtr(p + 64), h1 = vtr(p + 4 * SGU_STRIDE + 64);
                const bf16x8 A0 = {l0[0], l0[1], l0[2], l0[3], h0[0], h0[1], h0[2], h0[3]}, A1 = {l1[0], l1[1], l1[2], l1[3], h1[0], h1[1], h1[2], h1[3]};
                a0 = __builtin_amdgcn_mfma_f32_32x32x16_bf16(A0, bfrag, a0, 0, 0, 0);
                a1 = __builtin_amdgcn_mfma_f32_32x32x16_bf16(A1, bfrag, a1, 0, 0, 0);
            }
            bf16* op = YAB + (size_t)(tok0 + t) * 1024 + 512 + g * 64 + 4 * hi;
#pragma unroll
            for (int gg = 0; gg < 4; ++gg) {
                u32x2 o0, o1;
                o0.x = cvtpk(bflo(uu0[gg].x) * (a0[4 * gg] + bs), bfhi(uu0[gg].x) * (a0[4 * gg + 1] + bs)); o0.y = cvtpk(bflo(uu0[gg].y) * (a0[4 * gg + 2] + bs), bfhi(uu0[gg].y) * (a0[4 * gg + 3] + bs));
                o1.x = cvtpk(bflo(uu1[gg].x) * (a1[4 * gg] + bs), bfhi(uu1[gg].x) * (a1[4 * gg + 1] + bs)); o1.y = cvtpk(bflo(uu1[gg].y) * (a1[4 * gg + 2] + bs), bfhi(uu1[gg].y) * (a1[4 * gg + 3] + bs));
                *(u32x2*)(op + 8 * gg) = o0; *(u32x2*)(op + 32 + 8 * gg) = o1; }
        }
    }
    __syncthreads();
}

constexpr int AT_BUF = 65536, AT_V = 32768, AT_BT = GTAB_OFF;
static_assert(8 * 1088 <= GTAB_BYTES, "bias tables fit above the ring");
__device__ __forceinline__ void attn_chunks(const Frame& F, const Args& a, int gc0, int gc1) {
    const bf16* __restrict__ Q = (const bf16*)(a.ws + WS_Q); const bf16* __restrict__ Kb = (const bf16*)(a.ws + WS_K); const bf16* __restrict__ Vb = (const bf16*)(a.ws + WS_V); bf16* YAB = (bf16*)(a.ws + WS_YAB);
    const int tid = F.tid, lane = F.lane, wave = F.wave, pr = wave >> 1, half = wave & 1;
    const int r32 = lane & 31, hi = lane >> 5, i16 = lane & 15, g16 = (lane >> 4) & 1;
    const int gcs[2] = {gc0, gc1};
    int j0s[2], nts[2], tok0s[2];
#pragma unroll
    for (int i = 0; i < 2; ++i) { const int c = gcs[i] % (SEQ / CHUNK); j0s[i] = (c < NLEFT) ? (NLEFT - c) : 0; nts[i] = 9 - j0s[i]; tok0s[i] = (gcs[i] / (SEQ / CHUNK)) * SEQ + c * CHUNK; }
    const int total = 2 * nts[0] + 2 * nts[1];
    const int lrow = tid >> 5, c16 = tid & 31, lhh = c16 >> 3, lch = c16 & 7;
    const int kwoff = lhh * 8192 + lrow * 128 + ((lch ^ ((lrow >> 1) & 7)) << 4);
    const int vwoff = AT_V + lhh * 8192 + lrow * 128 + ((lch ^ (((lrow >> 1) & 1) << 2)) << 4);
    int ko[4];
#pragma unroll
    for (int sI = 0; sI < 4; ++sI) ko[sI] = pr * 8192 + r32 * 128 + ((((2 * sI + hi) ^ ((r32 >> 1) & 7))) << 4);
    const int fb = (i16 >> 3) & 1;
    const int vr0 = AT_V + pr * 8192 + (4 * hi + (i16 >> 2)) * 128 + ((4 * (0 ^ fb) + 2 * g16 + ((i16 & 3) >> 1)) * 16) + (i16 & 1) * 8;
    const int vr1 = AT_V + pr * 8192 + (4 * hi + (i16 >> 2)) * 128 + ((4 * (1 ^ fb) + 2 * g16 + ((i16 & 3) >> 1)) * 16) + (i16 & 1) * 8;
#define AT_DECODE(t, ci, hp, j) do { ci = ((t) >= 2 * nts[0]) ? 1 : 0; const int tt_ = (t) - ci * 2 * nts[0]; hp = (tt_ >= nts[ci]) ? 1 : 0; j = j0s[ci] + tt_ - hp * nts[ci]; } while (0)
    u32x4 kn[4], vn[4];
    {
        int ci, hp, j; AT_DECODE(0, ci, hp, j);
        const size_t g = (size_t)(tok0s[ci] + (j - NLEFT) * CHUNK + lrow) * 512 + hp * 256 + c16 * 8;
#pragma unroll
        for (int i = 0; i < 4; ++i) { kn[i] = *(const u32x4*)(Kb + g + (size_t)i * 16 * 512); vn[i] = *(const u32x4*)(Vb + g + (size_t)i * 16 * 512); }
#pragma unroll
        for (int i = 0; i < 4; ++i) { *(LAS u32x4*)(F.lds + kwoff + i * 2048) = kn[i]; *(LAS u32x4*)(F.lds + vwoff + i * 2048) = vn[i]; }
    }
    __syncthreads();
    bf16x8 qf[4]; f32x16 o0, o1; float m = -1e30f, l = 0.f;
#pragma unroll
    for (int r = 0; r < 16; ++r) { o0[r] = 0.f; o1[r] = 0.f; }
#pragma unroll
    for (int sI = 0; sI < 4; ++sI) qf[sI] = (bf16x8){0, 0, 0, 0, 0, 0, 0, 0};
#pragma unroll 1
    for (int t = 0; t < total; ++t) {
        int ci, hp, j; AT_DECODE(t, ci, hp, j);
        const int tn = (t + 1 < total) ? t + 1 : t; int cin, hpn, jn; AT_DECODE(tn, cin, hpn, jn);
        const int h = 4 * hp + pr, qi = half * 32 + r32, qtok = tok0s[ci] + qi;
        if (j == j0s[ci]) {
#pragma unroll
            for (int sI = 0; sI < 4; ++sI) qf[sI] = *(const bf16x8*)(Q + (size_t)qtok * 512 + h * 64 + 16 * sI + 8 * hi);
#pragma unroll
            for (int r = 0; r < 16; ++r) { o0[r] = 0.f; o1[r] = 0.f; }
            m = -1e30f; l = 0.f;
        }
        asm volatile("" ::: "memory");
        {
            const size_t g = (size_t)(tok0s[cin] + (jn - NLEFT) * CHUNK + lrow) * 512 + hpn * 256 + c16 * 8;
#pragma unroll
            for (int i = 0; i < 4; ++i) { kn[i] = *(const u32x4*)(Kb + g + (size_t)i * 16 * 512); vn[i] = *(const u32x4*)(Vb + g + (size_t)i * 16 * 512); }
        }
        asm volatile("" ::: "memory");
        const LAS unsigned char* buf = F.lds + (t & 1) * AT_BUF;
        const bool first = (j == j0s[ci]);
        const float negm = first ? 0.f : -m;
        f32x16 p0, p1;
#pragma unroll
        for (int r = 0; r < 16; ++r) { p0[r] = negm; p1[r] = negm; }
#pragma unroll
        for (int sI = 0; sI < 4; ++sI) { const bf16x8 k0 = *(const LAS bf16x8*)(buf + ko[sI]), k1 = *(const LAS bf16x8*)(buf + ko[sI] + 4096);
            p0 = __builtin_amdgcn_mfma_f32_32x32x16_bf16(k0, qf[sI], p0, 0, 0, 0); p1 = __builtin_amdgcn_mfma_f32_32x32x16_bf16(k1, qf[sI], p1, 0, 0, 0); }
        if (j >= 6) {
            const LAS float* bt = (const LAS float*)(F.lds + AT_BT + h * 1088);
            const int base = 640 + qi - 64 * j - 4 * hi;
#pragma unroll
            for (int r = 0; r < 16; ++r) { const int kk = (r & 3) + 8 * (r >> 2); int i0 = base - kk, i1 = base - 32 - kk; i0 = i0 > 256 ? 256 : i0; i1 = i1 > 256 ? 256 : i1; p0[r] += bt[i0]; p1[r] += bt[i1]; }
        }
        float tm = fmaxf(p0[0], p1[0]);
#pragma unroll
        for (int r = 1; r < 16; ++r) tm = fmaxf(tm, fmaxf(p0[r], p1[r]));
        { const auto rr = __builtin_amdgcn_permlane32_swap(__float_as_uint(tm), __float_as_uint(tm), false, false); tm = fmaxf(__uint_as_float(rr[0]), __uint_as_float(rr[1])); }
        if (first) {
            m = tm;
#pragma unroll
            for (int r = 0; r < 16; ++r) { p0[r] -= tm; p1[r] -= tm; }
        } else if (__any(tm > 0.f)) {
            const float dlt = fmaxf(tm, 0.f), alpha = __builtin_amdgcn_exp2f(-dlt); m += dlt; l *= alpha;
#pragma unroll
            for (int r = 0; r < 16; ++r) { p0[r] -= dlt; p1[r] -= dlt; o0[r] *= alpha; o1[r] *= alpha; }
        }
        float ps = 0.f;
#pragma unroll
        for (int r = 0; r < 16; ++r) { p0[r] = __builtin_amdgcn_exp2f(p0[r]); p1[r] = __builtin_amdgcn_exp2f(p1[r]); ps += p0[r] + p1[r]; }
        l += ps;
        bf16x8 pb[2][2];
#pragma unroll
        for (int sI = 0; sI < 2; ++sI) {
            u32x4 w0; w0.x = cvtpk(p0[8 * sI], p0[8 * sI + 1]); w0.y = cvtpk(p0[8 * sI + 2], p0[8 * sI + 3]); w0.z = cvtpk(p0[8 * sI + 4], p0[8 * sI + 5]); w0.w = cvtpk(p0[8 * sI + 6], p0[8 * sI + 7]);
            u32x4 w1; w1.x = cvtpk(p1[8 * sI], p1[8 * sI + 1]); w1.y = cvtpk(p1[8 * sI + 2], p1[8 * sI + 3]); w1.z = cvtpk(p1[8 * sI + 4], p1[8 * sI + 5]); w1.w = cvtpk(p1[8 * sI + 6], p1[8 * sI + 7]);
            pb[0][sI] = __builtin_bit_cast(bf16x8, w0); pb[1][sI] = __builtin_bit_cast(bf16x8, w1); }
#pragma unroll
        for (int blk = 0; blk < 2; ++blk)
#pragma unroll
            for (int sI = 0; sI < 2; ++sI) {
                const int kof = (32 * blk + 16 * sI) * 128;
                const s16x4 l0 = vtr(buf + vr0 + kof), h0 = vtr(buf + vr0 + kof + 1024), l1 = vtr(buf + vr1 + kof), h1 = vtr(buf + vr1 + kof + 1024);
                const bf16x8 A0 = {l0[0], l0[1], l0[2], l0[3], h0[0], h0[1], h0[2], h0[3]}, A1 = {l1[0], l1[1], l1[2], l1[3], h1[0], h1[1], h1[2], h1[3]};
                o0 = __builtin_amdgcn_mfma_f32_32x32x16_bf16(A0, pb[blk][sI], o0, 0, 0, 0);
                o1 = __builtin_amdgcn_mfma_f32_32x32x16_bf16(A1, pb[blk][sI], o1, 0, 0, 0);
            }
        if (j == 8) {
            float lt = l; { const auto rr = __builtin_amdgcn_permlane32_swap(__float_as_uint(lt), __float_as_uint(lt), false, false); lt = __uint_as_float(rr[0]) + __uint_as_float(rr[1]); }
            const float inv = __builtin_amdgcn_rcpf(lt);
            bf16* op = YAB + (size_t)qtok * 1024 + h * 64 + 4 * hi;
#pragma unroll
            for (int gg = 0; gg < 4; ++gg) {
                u32x2 w0, w1;
                w0.x = cvtpk(o0[4 * gg] * inv, o0[4 * gg + 1] * inv); w0.y = cvtpk(o0[4 * gg + 2] * inv, o0[4 * gg + 3] * inv);
                w1.x = cvtpk(o1[4 * gg] * inv, o1[4 * gg + 1] * inv); w1.y = cvtpk(o1[4 * gg + 2] * inv, o1[4 * gg + 3] * inv);
                *(u32x2*)(op + 8 * gg) = w0; *(u32x2*)(op + 32 + 8 * gg) = w1; }
        }
        {
            LAS unsigned char* nb = F.lds + ((t + 1) & 1) * AT_BUF;
#pragma unroll
            for (int i = 0; i < 4; ++i) { *(LAS u32x4*)(nb + kwoff + i * 2048) = kn[i]; *(LAS u32x4*)(nb + vwoff + i * 2048) = vn[i]; }
        }
        __syncthreads();
    }
#undef AT_DECODE
}
__device__ __forceinline__ void phaseD(const Frame& F, const Args& a) {
    for (int unit = F.vcu; unit < NB * (SEQ / SGB); unit += F.G) sgu_unit(F, a, unit / (SEQ / SGB), unit % (SEQ / SGB));
    for (int i = F.tid; i < NHEAD * NREL; i += NWAVES * 64) { const int h = i / NREL, k = i % NREL; ((LAS float*)(F.lds + AT_BT + h * 1088))[k] = (a.in[7][i] - a.in[7][h * NREL + 256]) * LOG2E; }
    __syncthreads();
    const int NCH = NB * (SEQ / CHUNK);
    for (int v = F.vcu; v < NCH / 2; v += F.G) attn_chunks(F, a, v, NCH - 1 - v);
}

constexpr int G_HT_STRIDE = 2064;
__device__ __forceinline__ void phaseG(const Frame& F, const Args& a) {
    const float* x = a.in[0]; const bf16* Y1 = (const bf16*)(a.ws + WS_Y1); const float* mod = (const float*)(a.ws + WS_MOD); const float* g_post_mix = a.in[5]; const float* g_pre_ffn = a.in[17];
    const float* b_router = a.in[20]; bf16* X1b = (bf16*)(a.ws + WS_X1B); unsigned char* XN8 = a.ws + WS_XN;
    const bf16* wrt = (const bf16*)(a.ws + WS_WRT);
    float* topg = (float*)(a.ws + WS_TOPG); int* list = (int*)(a.ws + WS_LIST); unsigned* cnt = F.ctl + CW_CNT;
    LAS unsigned char* HT = F.lds;
    LAS float* PL = (LAS float*)(F.lds + 33792);
    LAS float* LG = PL + 8 * 16 * 32;
    LAS float* TV = LG + 512;
    LAS unsigned* LC = (LAS unsigned*)(TV + 64);
    LAS unsigned* AS = LC + 64;
    const int tid = F.tid, lane = F.lane, wave = F.wave, kq = lane >> 4, i16 = lane & 15;
    if (tid < 64) LC[tid] = 0u;
    bf16x8 whi[2][4], wlo[2][4];
#pragma unroll
    for (int et = 0; et < 2; ++et)
#pragma unroll
        for (int ks = 0; ks < 4; ++ks) { const size_t o = (size_t)(et * 16 + i16) * D + 128 * wave + 32 * ks + 8 * kq; whi[et][ks] = *(const bf16x8*)(wrt + o); wlo[et][ks] = *(const bf16x8*)(wrt + (size_t)NEXP * D + o); }
    const int myrow = tid >> 5, mye = lane & 31;
    const float mybias = b_router[mye];
    __syncthreads();
    const int NT = NTOK / 16;
    f32x4 xv[2][4]; u32x2 yr[2][4];
    {   const int rbase = 16 * F.vcu + 2 * wave;
#pragma unroll
        for (int rr = 0; rr < 2; ++rr)
#pragma unroll
            for (int j = 0; j < 4; ++j) { const int c0 = (lane + 64 * j) * 4; xv[rr][j] = __builtin_nontemporal_load((const f32x4*)(x + (size_t)(rbase + rr) * D + c0)); yr[rr][j] = __builtin_nontemporal_load((const u32x2*)(Y1 + (size_t)(rbase + rr) * D + c0)); } }
    int tl = 0;
    f32x4 cgp[4], cgf[4], cgt[4], csc[4], csh[4]; int cb = -1;
#pragma unroll
    for (int j = 0; j < 4; ++j) { const int c0 = (lane + 64 * j) * 4; cgp[j] = *(const f32x4*)(g_post_mix + c0); cgf[j] = *(const f32x4*)(g_pre_ffn + c0); }
#pragma unroll 1
    for (int T = F.vcu; T < NT; T += F.G, ++tl) {
        const int b = (16 * T) / SEQ; const float* mb = mod + b * 6144; const int rbase = 16 * T + 2 * wave;
        if (b != cb) { cb = b;
#pragma unroll
            for (int j = 0; j < 4; ++j) { const int c0 = (lane + 64 * j) * 4; cgt[j] = *(const f32x4*)(mb + GT1 + c0); csc[j] = *(const f32x4*)(mb + SC2 + c0) + 1.0f; csh[j] = *(const f32x4*)(mb + SH2 + c0); } }
#pragma unroll
        for (int rr = 0; rr < 2; ++rr) {
            const int row = rbase + rr; f32x4 yv[4]; float ss = 0.f;
#pragma unroll
            for (int j = 0; j < 4; ++j) { yv[j] = (f32x4){bflo(yr[rr][j].x), bfhi(yr[rr][j].x), bflo(yr[rr][j].y), bfhi(yr[rr][j].y)}; ss += (yv[j][0] * yv[j][0] + yv[j][1] * yv[j][1]) + (yv[j][2] * yv[j][2] + yv[j][3] * yv[j][3]); }
            const float rstd = rsqrtf(wsum(ss) * (1.0f / D) + EPS); float s2 = 0.f;
#pragma unroll
            for (int j = 0; j < 4; ++j) { const int c0 = (lane + 64 * j) * 4;
                xv[rr][j] = xv[rr][j] + cgt[j] * (yv[j] * rstd * cgp[j]);
                { u32x2 w1; w1.x = cvtpk(xv[rr][j][0], xv[rr][j][1]); w1.y = cvtpk(xv[rr][j][2], xv[rr][j][3]); __builtin_nontemporal_store(w1, (u32x2*)(X1b + (size_t)row * D + c0)); }
                s2 += (xv[rr][j][0] * xv[rr][j][0] + xv[rr][j][1] * xv[rr][j][1]) + (xv[rr][j][2] * xv[rr][j][2] + xv[rr][j][3] * xv[rr][j][3]); }
            const float rstd2 = rsqrtf(wsum(s2) * (1.0f / D) + EPS);
#pragma unroll
            for (int j = 0; j < 4; ++j) { const int c0 = (lane + 64 * j) * 4;
                const f32x4 h = xv[rr][j] * rstd2 * cgf[j] * csc[j] + csh[j];
                u32x2 w; w.x = cvtpk(h[0], h[1]); w.y = cvtpk(h[2], h[3]); *(unsigned*)(XN8 + (size_t)row * D + c0) = pk_fp8x4(h[0] * F8_ASCALE, h[1] * F8_ASCALE, h[2] * F8_ASCALE, h[3] * F8_ASCALE);
                *(LAS u32x2*)(HT + (2 * wave + rr) * G_HT_STRIDE + c0 * 2) = w; }
        }
        {
            const int Tn = (T + F.G < NT) ? T + F.G : T; const int rb2 = 16 * Tn + 2 * wave;
#pragma unroll
            for (int rr = 0; rr < 2; ++rr)
#pragma unroll
                for (int j = 0; j < 4; ++j) { const int c0 = (lane + 64 * j) * 4; xv[rr][j] = __builtin_nontemporal_load((const f32x4*)(x + (size_t)(rb2 + rr) * D + c0)); yr[rr][j] = __builtin_nontemporal_load((const u32x2*)(Y1 + (size_t)(rb2 + rr) * D + c0)); }
        }
        LDS_WAIT(); __builtin_amdgcn_s_barrier(); asm volatile("" ::: "memory");
        {
            f32x4 acc0 = {0.f, 0.f, 0.f, 0.f}, acc1 = {0.f, 0.f, 0.f, 0.f};
#pragma unroll
            for (int ks = 0; ks < 4; ++ks) { const bf16x8 hb = *(const LAS bf16x8*)(HT + i16 * G_HT_STRIDE + (128 * wave + 32 * ks + 8 * kq) * 2);
                acc0 = __builtin_amdgcn_mfma_f32_16x16x32_bf16(whi[0][ks], hb, acc0, 0, 0, 0); acc0 = __builtin_amdgcn_mfma_f32_16x16x32_bf16(wlo[0][ks], hb, acc0, 0, 0, 0);
                acc1 = __builtin_amdgcn_mfma_f32_16x16x32_bf16(whi[1][ks], hb, acc1, 0, 0, 0); acc1 = __builtin_amdgcn_mfma_f32_16x16x32_bf16(wlo[1][ks], hb, acc1, 0, 0, 0); }
            *(LAS f32x4*)(PL + (wave * 16 + i16) * 32 + 4 * kq) = acc0; *(LAS f32x4*)(PL + (wave * 16 + i16) * 32 + 16 + 4 * kq) = acc1;
        }
        LDS_WAIT(); __builtin_amdgcn_s_barrier(); asm volatile("" ::: "memory");
        float lg = mybias;
#pragma unroll
        for (int w = 0; w < 8; ++w) lg += PL[(w * 16 + myrow) * 32 + mye];
        LG[myrow * 32 + mye] = lg;
        LDS_WAIT(); asm volatile("" ::: "memory");
        int rank = 0;
#pragma unroll
        for (int q = 0; q < 8; ++q) { const f32x4 o = *(const LAS f32x4*)(LG + myrow * 32 + 4 * q);
#pragma unroll
            for (int i = 0; i < 4; ++i) { const int e2 = 4 * q + i; rank += (o[i] > lg || (o[i] == lg && e2 < mye)) ? 1 : 0; } }
        if (rank < 4) TV[myrow * 4 + rank] = lg;
        LDS_WAIT(); asm volatile("" ::: "memory");
        const f32x4 tv = *(const LAS f32x4*)(TV + myrow * 4);
        if (rank < 4) {
            const float den = 1.0f + __expf(tv[1] - tv[0]) + __expf(tv[2] - tv[0]) + __expf(tv[3] - tv[0]);
            const int slot = (16 * T + myrow) * 4 + rank; topg[slot] = __expf(lg - tv[0]) / den;
            const unsigned lp = __hip_atomic_fetch_add(LC + mye, 1u, __ATOMIC_RELAXED, __HIP_MEMORY_SCOPE_WORKGROUP);
            if (tl < 16) AS[tl * 64 + myrow * 4 + rank] = (unsigned)mye | (lp << 8);
        }
    }
    __syncthreads();
    if (tid < NEXP) LC[32 + tid] = atomicAdd(&cnt[tid], LC[tid]);
    __syncthreads();
    for (int i = tid; i < tl * 64; i += NWAVES * 64) { const unsigned as = AS[i]; const int e = as & 255, lp = as >> 8; const int T = F.vcu + (i >> 6) * F.G;
        list[(size_t)e * NTOK + LC[32 + e] + lp] = (16 * T + ((i & 63) >> 2)) * 4 + (i & 3); }
}
__device__ __forceinline__ int moe_tables(const Frame& F) {
    __syncthreads();
    if (F.tid < NEXP) F.MISC[40 + F.tid] = __hip_atomic_load(F.ctl + CW_CNT + F.tid, __ATOMIC_RELAXED, __HIP_MEMORY_SCOPE_AGENT);
    __syncthreads();
    if (F.tid == 0) { unsigned s = 0; for (int e = 0; e < NEXP; ++e) { F.MISC[e] = s; s += (F.MISC[40 + e] + 255u) >> 8; } F.MISC[32] = s; }
    __syncthreads();
    return (int)F.MISC[32];
}
__device__ __forceinline__ void phaseJ(const Frame& F, const Args& a) {
    const unsigned char* Y2s = a.ws + WS_Y2; const bf16* X1b = (const bf16*)(a.ws + WS_X1B); const float* mod = (const float*)(a.ws + WS_MOD); const float* gpf = a.in[18]; float* out = a.out;
    const int* inv = (const int*)(a.ws + WS_TOPE); const float* topg = (const float*)(a.ws + WS_TOPG);
    const int lane = F.lane, gw = F.vcu * NWAVES + F.wave, NGW = F.G * NWAVES;
    f32x4 cgg[4]; int cb = -1;
    for (int row0 = gw * 4; row0 < NTOK; row0 += NGW * 4) {
        const int b = row0 / SEQ; const float* mb = mod + b * 6144;
        if (b != cb) { cb = b;
#pragma unroll
            for (int j = 0; j < 4; ++j) { const int c0 = (lane + 64 * j) * 4; cgg[j] = *(const f32x4*)(gpf + c0) * *(const f32x4*)(mb + GT2 + c0); } }
        int pp[4][4]; float gg[4][4];
#pragma unroll
        for (int rr = 0; rr < 4; ++rr)
#pragma unroll
            for (int k = 0; k < 4; ++k) { pp[rr][k] = __builtin_amdgcn_readfirstlane(inv[(row0 + rr) * 4 + k]); gg[rr][k] = topg[(row0 + rr) * 4 + k] * (1.0f / F8_YSCALE); }
        unsigned yy[4][4][4]; u32x2 xx[4][4];
#pragma unroll
        for (int rr = 0; rr < 4; ++rr)
#pragma unroll
            for (int j = 0; j < 4; ++j) { const int c0 = (lane + 64 * j) * 4;
#pragma unroll
                for (int k = 0; k < 4; ++k) yy[rr][j][k] = __builtin_nontemporal_load((const unsigned*)(Y2s + (size_t)pp[rr][k] * D + c0));
                xx[rr][j] = __builtin_nontemporal_load((const u32x2*)(X1b + (size_t)(row0 + rr) * D + c0)); }
#pragma unroll
        for (int rr = 0; rr < 4; ++rr) {
            f32x4 yv[4]; float ss = 0.f;
#pragma unroll
            for (int j = 0; j < 4; ++j) { f32x4 s = {0.f, 0.f, 0.f, 0.f};
#pragma unroll
                for (int k = 0; k < 4; ++k) { const f32x2 lo = __builtin_amdgcn_cvt_pk_f32_fp8((int)yy[rr][j][k], false), hi = __builtin_amdgcn_cvt_pk_f32_fp8((int)yy[rr][j][k], true);
                    s += (f32x4){lo.x, lo.y, hi.x, hi.y} * gg[rr][k]; }
                yv[j] = s; ss += (s[0] * s[0] + s[1] * s[1]) + (s[2] * s[2] + s[3] * s[3]); }
            const float rstd = rsqrtf(wsum(ss) * (1.0f / D) + EPS);
#pragma unroll
            for (int j = 0; j < 4; ++j) { const int c0 = (lane + 64 * j) * 4;
                const f32x4 x1 = {bflo(xx[rr][j].x), bfhi(xx[rr][j].x), bflo(xx[rr][j].y), bfhi(xx[rr][j].y)};
                __builtin_nontemporal_store(x1 + cgg[j] * (yv[j] * rstd), (f32x4*)(out + (size_t)(row0 + rr) * D + c0)); }
        }
    }
}

constexpr int N_PHASES = 10;
__global__ void __launch_bounds__(NWAVES * 64, 2) mega_fwd(Args args) {
    extern __shared__ __attribute__((aligned(16))) unsigned char lds_raw[];
    Frame F;
    F.lds = (LAS unsigned char*)lds_raw; F.MISC = (volatile LAS unsigned*)(F.lds + MISC_OFF);
    F.tid = threadIdx.x; F.lane = F.tid & 63; F.wave = __builtin_amdgcn_readfirstlane(F.tid >> 6);
    F.G = gridDim.x; { const int bx = blockIdx.x; F.vcu = (F.G % 8 == 0) ? (bx % 8) * (F.G / 8) + bx / 8 : bx; }
    F.ctl = (unsigned*)(args.ws + WS_CTL);
    for (int u = F.tid; u < 128; u += NWAVES * 64) F.MISC[u] = 0u;
    __syncthreads();
    const int lo = args.ph_lo, hi = args.ph_hi;
    XcdBarrier bar; bar.bar = F.ctl + CW_BAR; bar.x = 0; bar.st = F.MISC + 80;
    if (hi - lo > 1) bar = xcd_barrier_post(F.ctl + CW_BAR, F.MISC + 80);
#define IN(k) (lo <= (k) && (k) < hi)
#define SEAM(k) do { if (IN(k) && IN((k) + 1)) xcd_barrier(bar); } while (0)
    unsigned char* ws = args.ws;
    bf16 *XN = (bf16*)(ws + WS_XN), *Qb = (bf16*)(ws + WS_Q), *Kb = (bf16*)(ws + WS_K), *Vb = (bf16*)(ws + WS_V), *Ub = (bf16*)(ws + WS_U), *VG = (bf16*)(ws + WS_VG);
    bf16 *GT = (bf16*)(ws + WS_GT), *YAB = (bf16*)(ws + WS_YAB), *MRG = (bf16*)(ws + WS_MRG), *Y1 = (bf16*)(ws + WS_Y1), *ACT = (bf16*)(ws + WS_ACT), *Y2 = (bf16*)(ws + WS_Y2);

    if (IN(0)) { phaseA(F, args); } SEAM(0);
    if (IN(1)) { phaseB(F, args); } SEAM(1);
    if (IN(2)) {
        SchedStatic S{(const char*)XN, (const char*)(ws + WS_W1T), NTOK / 256, 4608 / 256, F.G, (int)blockIdx.x, (size_t)256 * 1024 * 2, (size_t)256 * 1024 * 2};
        EpiG1 E{Qb, Kb, Vb, Ub, VG, GT, args.in[15]};
        pg8::gemm_phase<EpiG1, SchedStatic, false>(F.lds + RING_OFF, S, E, 2048, 2048, 16);
    } SEAM(2);
    if (IN(3)) { phaseD(F, args); } SEAM(3);
    if (IN(4)) {
        SchedSplit2 S{(const char*)YAB, (const char*)(ws + WS_WBRT), NTOK / 256, 4, F.G, (int)blockIdx.x, (size_t)256 * 1024 * 2, (size_t)256 * 1024 * 2, (size_t)512 * 2};
        EpiG2 E{GT, MRG};
        pg8::gemm_phase<EpiG2, SchedSplit2, false>(F.lds + RING_OFF, S, E, 2048, 2048, 8);
    } SEAM(4);
    if (IN(5)) {
        SchedStatic S{(const char*)MRG, (const char*)(ws + WS_WOUTT), NTOK / 256, 4, F.G, (int)blockIdx.x, (size_t)256 * 1024 * 2, (size_t)256 * 1024 * 2};
        EpiPlain E{Y1};
        pg8::gemm_phase<EpiPlain, SchedStatic, false>(F.lds + RING_OFF, S, E, 2048, 2048, 16);
    } SEAM(5);
    if (IN(6)) { phaseG(F, args); } SEAM(6);
    if (IN(7)) {
        const int nrb = moe_tables(F);
        const int* list = (const int*)(ws + WS_LIST);
        {
            int* inv = (int*)(ws + WS_TOPE);
            for (int g = (int)blockIdx.x * (NWAVES * 64) + F.tid; g < NTOK * TOPK; g += F.G * NWAVES * 64) {
                int e = 0, base = 0;
#pragma unroll 1
                for (int i = 0; i < NEXP; ++i) { const int c = (int)F.MISC[40 + i]; if (g >= base + c) { base += c; e = i + 1; } else break; }
                const int pos = g - base; if (e < NEXP) inv[list[(size_t)e * NTOK + pos]] = (int)F.MISC[e] * 256 + pos; }
        }
        typedef SchedMoe<8, true> SM;
        SM S{(const char*)XN, (const char*)(ws + WS_WGUT), F.MISC, (const LAS unsigned*)(F.lds + GTAB_OFF), (int)blockIdx.x, F.G, nrb, (size_t)2048 * 1024, (size_t)256 * 1024};
        S.build(F.tid);
        { Unit u; LAS unsigned* gt = (LAS unsigned*)(F.lds + GTAB_OFF);
          for (int k = 0; k < GTAB_UNITS && S.next(k, u); ++k) { const int e = u.aux, j256 = (u.pm - (int)F.MISC[e]) * 256, ecnt = (int)F.MISC[40 + e];
              for (int r = F.tid; r < 256; r += NWAVES * 64) { const int pos = j256 + r; int tok = 0; if (pos < ecnt) tok = list[(size_t)e * NTOK + pos] >> 2; gt[k * 256 + r] = (unsigned)tok * 1024u; } } }
        __syncthreads();
        EpiAct E{args.in[22], (unsigned char*)ACT};
        pg8::gemm_phase<EpiAct, SM, true>(F.lds + RING_OFF, S, E, 1024, 1024, 8);
    } SEAM(7);
    if (IN(8)) {
        const int nrb = moe_tables(F);
        typedef SchedMoe<4, true> SM;
        SM S{(const char*)ACT, (const char*)(ws + WS_WDNT), F.MISC, (const LAS unsigned*)(F.lds + GTAB_OFF), (int)blockIdx.x, F.G, nrb, (size_t)1024 * 1024, (size_t)256 * 1024};
        S.build(F.tid);
        { Unit u; LAS unsigned* gt = (LAS unsigned*)(F.lds + GTAB_OFF);
          for (int k = 0; k < GTAB_UNITS && S.next(k, u); ++k) for (int r = F.tid; r < 256; r += NWAVES * 64) gt[k * 256 + r] = (unsigned)(u.pm * 256 + r) * 1024u; }
        __syncthreads();
        EpiDown E{args.in[24], (unsigned char*)Y2};
        pg8::gemm_phase<EpiDown, SM, true>(F.lds + RING_OFF, S, E, 1024, 1024, 8);
    } SEAM(8);
    if (IN(9)) { phaseJ(F, args); }
#undef IN
#undef SEAM
}
extern "C" void kernel_launch(void* const* d_in, const int* in_sizes, int n_in, void* d_out, int out_size, void* d_ws, size_t ws_size, hipStream_t stream) {
    if (n_in != 25 || in_sizes[0] != NTOK * D || out_size != NTOK * D || ws_size < WS_END) { fprintf(stderr, "kernel_launch: unexpected shapes (n_in %d in0 %d out %d ws %zu)\n", n_in, n_in > 0 ? in_sizes[0] : -1, out_size, ws_size); return; }
    static int grid = 0;
    if (grid == 0) {
        int dev = 0, cus = 0, per_cu = 0;
        if (hipGetDevice(&dev) != hipSuccess || hipDeviceGetAttribute(&cus, hipDeviceAttributeMultiprocessorCount, dev) != hipSuccess) { fprintf(stderr, "kernel_launch: device query failed\n"); grid = -1; return; }
        if (hipFuncSetAttribute((const void*)mega_fwd, hipFuncAttributeMaxDynamicSharedMemorySize, LDS_BYTES) != hipSuccess) { fprintf(stderr, "kernel_launch: hipFuncSetAttribute failed\n"); grid = -1; return; }
        if (hipOccupancyMaxActiveBlocksPerMultiprocessor(&per_cu, (const void*)mega_fwd, NWAVES * 64, LDS_BYTES) != hipSuccess || per_cu < 1) { fprintf(stderr, "kernel_launch: occupancy query says %d\n", per_cu); }
        (void)hipGetLastError();
        grid = cus;
    }
    if (grid < 0) return;
    if (hipMemsetAsync((unsigned char*)d_ws + WS_CTL, 0, CTL_ZERO_BYTES, stream) != hipSuccess) { fprintf(stderr, "kernel_launch: memset failed\n"); return; }
    Args a{};
    for (int i = 0; i < 25; ++i) a.in[i] = (const float*)d_in[i];
    a.out = (float*)d_out; a.ws = (unsigned char*)d_ws; a.ph_lo = 0; a.ph_hi = N_PHASES;
    hipLaunchKernelGGL(mega_fwd, dim3(grid), dim3(NWAVES * 64), LDS_BYTES, stream, a);
    if (hipPeekAtLastError() != hipSuccess) fprintf(stderr, "kernel_launch: launch failed\n");
}
```

```cpp
#include <hip/hip_runtime.h>
#include <cstdio>
#include <cstdint>

constexpr int NB = 4, SEQ = 8192, D = 1024, NTOK = NB * SEQ;
constexpr int NHEAD = 8, CHUNK = 64, NLEFT = 8, NREL = 257;
constexpr int SGB = 128;
constexpr int INW = 2560, NEXP = 32, TOPK = 4;
constexpr float EPS = 1e-6f, SWL = 7.0f, SWA = 1.702f;
constexpr float LOG2E = 1.4426950408889634f;
constexpr float QSCALE = 0.125f * LOG2E;
constexpr int SH1 = 0, SC1 = 1024, GT1 = 2048, SH2 = 3072, SC2 = 4096, GT2 = 5120;
typedef unsigned short bf16;

constexpr size_t MiB = 1u << 20;
constexpr size_t WS_CTL = 0, CTL_ZERO_BYTES = 64 * 1024;
constexpr size_t WS_MOD = 1 * MiB;
constexpr size_t WS_W1T = 2 * MiB, WS_WBRT = 12 * MiB, WS_WOUTT = 14 * MiB, WS_WRT = 16 * MiB;
constexpr size_t WS_TOPE = 17 * MiB, WS_TOPG = 18 * MiB, WS_LIST = 19 * MiB;
constexpr size_t WS_WGUT = 32 * MiB, WS_WDNT = 160 * MiB;
constexpr size_t WS_XN = 224 * MiB;
constexpr size_t WS_Q = 288 * MiB, WS_K = 320 * MiB, WS_V = 352 * MiB, WS_U = 384 * MiB, WS_VG = 416 * MiB;
constexpr size_t WS_GT = 448 * MiB;
constexpr size_t WS_YAB = 576 * MiB, WS_MRG = 640 * MiB, WS_Y1 = 704 * MiB;
constexpr size_t WS_ACT = 288 * MiB;
constexpr size_t WS_Y2 = 576 * MiB;
constexpr size_t WS_END = 960 * MiB;
constexpr int CW_CNT = 1024;

#define LAS __attribute__((address_space(3)))
#define GAS __attribute__((address_space(1)))
typedef short bf16x8 __attribute__((ext_vector_type(8)));
typedef short s16x4 __attribute__((ext_vector_type(4)));
typedef float f32x4 __attribute__((ext_vector_type(4)));
typedef float f32x2 __attribute__((ext_vector_type(2)));
typedef float f32x16 __attribute__((ext_vector_type(16)));
typedef unsigned u32x4 __attribute__((ext_vector_type(4)));
typedef unsigned u32x2 __attribute__((ext_vector_type(2)));
typedef __bf16 bf16x2_t __attribute__((ext_vector_type(2)));
constexpr int NWAVES = 8;
constexpr int TRASH_SLOT = NTOK * 4;

__device__ __forceinline__ unsigned cvtpk(float lo, float hi) { f32x2 v = {lo, hi}; bf16x2_t b = __builtin_convertvector(v, bf16x2_t); return __builtin_bit_cast(unsigned, b); }
__device__ __forceinline__ float wsum(float v) {
    v += __builtin_bit_cast(float, __builtin_amdgcn_update_dpp(0, __builtin_bit_cast(int, v), 0xB1, 0xF, 0xF, true));
    v += __builtin_bit_cast(float, __builtin_amdgcn_update_dpp(0, __builtin_bit_cast(int, v), 0x4E, 0xF, 0xF, true));
    v += __builtin_bit_cast(float, __builtin_amdgcn_update_dpp(0, __builtin_bit_cast(int, v), 0x124, 0xF, 0xF, true));
    v += __builtin_bit_cast(float, __builtin_amdgcn_update_dpp(0, __builtin_bit_cast(int, v), 0x128, 0xF, 0xF, true));
    const int iv = __builtin_bit_cast(int, v);
    const float s0 = __builtin_bit_cast(float, __builtin_amdgcn_readlane(iv, 0)), s1 = __builtin_bit_cast(float, __builtin_amdgcn_readlane(iv, 16));
    const float s2 = __builtin_bit_cast(float, __builtin_amdgcn_readlane(iv, 32)), s3 = __builtin_bit_cast(float, __builtin_amdgcn_readlane(iv, 48));
    return (s0 + s1) + (s2 + s3);
}
__device__ __forceinline__ float clamp8(float v) { return fminf(fmaxf(v, -448.0f), 448.0f); }
__device__ __forceinline__ unsigned pk_fp8x4(float a, float b, float c, float d) {
    int w = 0; w = __builtin_amdgcn_cvt_pk_fp8_f32(clamp8(a), clamp8(b), w, false); w = __builtin_amdgcn_cvt_pk_fp8_f32(clamp8(c), clamp8(d), w, true); return (unsigned)w; }
__device__ __forceinline__ unsigned pk_fp8x4_nc(float a, float b, float c, float d) {
    int w = 0; w = __builtin_amdgcn_cvt_pk_fp8_f32(a, b, w, false); w = __builtin_amdgcn_cvt_pk_fp8_f32(c, d, w, true); return (unsigned)w; }
constexpr float F8_YSCALE = 16.0f;
constexpr size_t WS_X1B = 768 * MiB;
constexpr float F8_WSCALE = 64.0f, F8_ASCALE = 4.0f, F8_DESCALE = 1.0f / (64.0f * 4.0f);
__device__ __forceinline__ float bflo(unsigned w) { return __uint_as_float(w << 16); }
__device__ __forceinline__ float bfhi(unsigned w) { return __uint_as_float(w & 0xffff0000u); }
__device__ __forceinline__ float fast_sigmoid(float x) { return __builtin_amdgcn_rcpf(1.0f + __builtin_amdgcn_exp2f(-LOG2E * x)); }
__device__ __forceinline__ f32x2 sigmoid_pk(f32x2 v) { const f32x2 t = v * (-LOG2E); f32x2 e; e.x = __builtin_amdgcn_exp2f(t.x); e.y = __builtin_amdgcn_exp2f(t.y); const f32x2 d = e + 1.0f; f32x2 r; r.x = __builtin_amdgcn_rcpf(d.x); r.y = __builtin_amdgcn_rcpf(d.y); return r; }
__device__ __forceinline__ f32x2 gelu_pk(f32x2 v) {
    const f32x2 av = __builtin_elementwise_abs(v), d = av * 0.2316418882f + 1.0f;
    f32x2 t; t.x = __builtin_amdgcn_rcpf(d.x); t.y = __builtin_amdgcn_rcpf(d.y);
    f32x2 q = t * 0.5307027145f + (-0.7265760135f); q = q * t + 0.7107068705f; q = q * t + (-0.142248368f); q = q * t + 0.127414796f; q = q * t;
    const f32x2 s = (v * v) * (-0.72134752044f);
    f32x2 e; e.x = __builtin_amdgcn_exp2f(s.x); e.y = __builtin_amdgcn_exp2f(s.y);
    const f32x2 m = v * (q * e), r = v - m;
    f32x2 o; o.x = v.x < 0.f ? m.x : r.x; o.y = v.y < 0.f ? m.y : r.y; return o;
}

constexpr int RING_OFF = 0, RING_BYTES = 131072;
constexpr int GTAB_OFF = RING_BYTES, GTAB_UNITS = 20, GTAB_BYTES = GTAB_UNITS * 256 * 4;
constexpr int MISC_OFF = GTAB_OFF + GTAB_BYTES;
constexpr int LDS_BYTES = MISC_OFF + 512;
static_assert(LDS_BYTES <= 160 * 1024, "LDS map");

#define XB_TMO      128
#define XB_XCNT(j)  (256  + 64 * (j))
#define XB_XSUB(j)  (1280 + 64 * (j))
#define XB_XGEN(j)  (2304 + 64 * (j))
#define XB_TOP      3328
#define XB_TOPGEN   3392
#define XCD_BAR_WORDS 3456
#define XB_SPIN_CAP (1u << 18)
__device__ __forceinline__ unsigned xb_ld(unsigned* p)              { return __hip_atomic_load(p, __ATOMIC_RELAXED, __HIP_MEMORY_SCOPE_AGENT); }
__device__ __forceinline__ unsigned xb_add(unsigned* p, unsigned v) { return __hip_atomic_fetch_add(p, v, __ATOMIC_RELAXED, __HIP_MEMORY_SCOPE_AGENT); }
__device__ __forceinline__ unsigned xb_xcc_id() { return (unsigned)__builtin_amdgcn_s_getreg((3 << 11) | 20) & 0xFu; }
#define XB_SPIN(cond, bar) do { unsigned _sp = 0; while (cond) { __builtin_amdgcn_s_sleep(1); \
    if ((++_sp & 255u) == 0u) { if (xb_ld(&(bar)[XB_TMO])) break; if (_sp > XB_SPIN_CAP) { atomicAdd(&(bar)[XB_TMO], 1u); break; } } } } while (0)
struct XcdBarrier { unsigned* bar; unsigned x; volatile LAS unsigned* st; };
__device__ __forceinline__ XcdBarrier xcd_barrier_post(unsigned* bar, volatile LAS unsigned* st) {
    XcdBarrier b; b.bar = bar; b.x = xb_xcc_id(); b.st = st;
    if (threadIdx.x == 0) (void)xb_add(&bar[XB_XCNT(b.x)], 1u);
    return b;
}
__device__ __forceinline__ void xcd_barrier_complete(unsigned* bar, unsigned x, unsigned& nloc, unsigned& nx) {
    const unsigned G = gridDim.x * gridDim.y * gridDim.z;
    unsigned sum, cnt, mine, sp = 0u;
    for (;;) {
        sum = 0u; cnt = 0u; mine = 0u;
#pragma unroll
        for (unsigned j = 0; j < 16; ++j) { const unsigned c = xb_ld(&bar[XB_XCNT(j)]); sum += c; cnt += (c > 0u) ? 1u : 0u; mine = (j == x) ? c : mine; }
        if (sum == G) break;
        __builtin_amdgcn_s_sleep(1);
        if ((++sp & 255u) == 0u) { if (xb_ld(&bar[XB_TMO])) break; if (sp > XB_SPIN_CAP) { atomicAdd(&bar[XB_TMO], 1u); break; } }
    }
    nloc = mine > 0u ? mine : 1u; nx = cnt > 0u ? cnt : 1u;
}
__device__ __forceinline__ void xcd_barrier(const XcdBarrier& b) {
    asm volatile("s_waitcnt vmcnt(0)" ::: "memory");
    __syncthreads();
    if (threadIdx.x == 0) {
        unsigned* bar = b.bar;
        __builtin_amdgcn_s_waitcnt(0);
        unsigned nloc = b.st[0], nx = b.st[1];
        if (nloc == 0u) { xcd_barrier_complete(bar, b.x, nloc, nx); b.st[0] = nloc; b.st[1] = nx; }
        const unsigned old = xb_add(&bar[XB_XSUB(b.x)], 1u);
        const unsigned gen = old / nloc;
        if (old + 1u == (gen + 1u) * nloc) {
            __builtin_amdgcn_fence(__ATOMIC_RELEASE, "agent");
            asm volatile("s_waitcnt vmcnt(0)" ::: "memory");
            const unsigned og = xb_add(&bar[XB_TOP], 1u);
            const unsigned tg = og / nx;
            if (og + 1u == (tg + 1u) * nx) xb_add(&bar[XB_TOPGEN], 1u);
            else XB_SPIN(xb_ld(&bar[XB_TOPGEN]) == tg, bar);
            __builtin_amdgcn_fence(__ATOMIC_ACQUIRE, "agent");
            xb_add(&bar[XB_XGEN(b.x)], 1u);
            asm volatile("s_waitcnt vmcnt(0)" ::: "memory");
        } else {
            XB_SPIN(xb_ld(&bar[XB_XGEN(b.x)]) == gen, bar);
            __builtin_amdgcn_fence(__ATOMIC_ACQUIRE, "agent");
            asm volatile("s_waitcnt vmcnt(0)" ::: "memory");
        }
    }
    __syncthreads();
}
constexpr int CW_BAR = 4096;

namespace pg8 {
constexpr int BM = 256, BK = 64, HALF = 128, HTB = HALF * BK * 2, STAGE_BYTES = 8 * HTB, NXCD = 8, WGM = 8;
__host__ __device__ __forceinline__ int lds_byte(int r, int c) { return r * 128 + ((((c >> 3) ^ (r >> 1)) & 7) << 4); }
__host__ __device__ __forceinline__ void stage_rc(int b, int& R, int& C) { R = b >> 7; C = ((((b >> 4) ^ (R >> 1)) & 7) << 3); }
__host__ __device__ __forceinline__ int perm32(int rho) { const int n = rho >> 4, i = rho & 15; return 8 * (i >> 2) + 4 * n + (i & 3); }
struct Unit { int pm, pn, aux; };
typedef int v4i_t __attribute__((ext_vector_type(4)));
typedef int v8i_t __attribute__((ext_vector_type(8)));

__device__ __forceinline__ bool static_unit(int i, int G, int c, int nM, int nN, int& pm, int& pn) {
    const int nwg = nM * nN; const long L = (long)i * G + c; if (L >= nwg) return false;
    int wgid = (int)L; { const int q = nwg / NXCD, r = nwg % NXCD, xcd = wgid % NXCD, off = wgid / NXCD; wgid = (xcd < r ? xcd * (q + 1) : r * (q + 1) + (xcd - r) * q) + off; }
    const int nig = WGM * nN, gid = wgid / nig, fm = gid * WGM, gsz = (nM - fm) < WGM ? (nM - fm) : WGM;
    pm = fm + ((wgid % nig) % gsz); pn = (wgid % nig) / gsz; return true;
}

template <class Epi, class Sched, bool FP8>
__device__ __forceinline__ void gemm_phase(LAS unsigned char* lds, const Sched& S, const Epi& E, const int lda, const int ldb, const int nt) {
    const int tid = threadIdx.x, wid = __builtin_amdgcn_readfirstlane(tid >> 6), lane = tid & 63, wr = wid >> 2, wc = wid & 3, fr = lane & 15, fq = lane >> 4;
    int Rr[2], Cc[2]; unsigned voffB[2];
#pragma unroll
    for (int i = 0; i < 2; ++i) { stage_rc(tid * 16 + i * 8192, Rr[i], Cc[i]); const int Rb = (Rr[i] & ~31) + perm32(Rr[i] & 31); voffB[i] = (unsigned)(Rb * ldb + Cc[i] * 2); }
    const size_t kstep = (size_t)(BK * 2);
    const size_t hstepB = (size_t)HALF * ldb;
    const size_t hstepA = Sched::GATHER ? (size_t)0 : (size_t)HALF * lda;
    const unsigned ldsw = (unsigned)wid * 1024u;
    const int aoff = lds_byte(wr * 64 + fr, fq * 8), boff = lds_byte(wc * 32 + fr, fq * 8);
#define PG8_SA(b, h) (((b) * 2 + (h)) * HTB)
#define PG8_SB(b, h) ((4 + (b) * 2 + (h)) * HTB)
#define PG8_STAGE(bufoff, gbase, voff) do { _Pragma("unroll") for (int _i = 0; _i < 2; ++_i) \
        __builtin_amdgcn_global_load_lds((const unsigned*)((const char*)(gbase) + (voff)[_i]), (LAS unsigned*)(lds + (bufoff) + ldsw + _i * 8192), 16, 0, 0); } while (0)
#define PG8_LDA(dst, b, h) do { _Pragma("unroll") for (int m = 0; m < 4; ++m) _Pragma("unroll") for (int k = 0; k < 2; ++k) dst[m][k] = *(const LAS bf16x8*)(lds + PG8_SA(b, h) + (aoff ^ (k * 64)) + m * 2048); } while (0)
#define PG8_LDB(dst, b, h) do { _Pragma("unroll") for (int n = 0; n < 2; ++n) _Pragma("unroll") for (int k = 0; k < 2; ++k) dst[n][k] = *(const LAS bf16x8*)(lds + PG8_SB(b, h) + (boff ^ (k * 64)) + n * 2048); } while (0)
#define PG8_CAT(x) __builtin_shufflevector(__builtin_bit_cast(v4i_t, (x)[0]), __builtin_bit_cast(v4i_t, (x)[1]), 0, 1, 2, 3, 4, 5, 6, 7)
#define PG8_MMA(ai, bj, At, Bt) do { __builtin_amdgcn_s_setprio(1); if constexpr (FP8) { _Pragma("unroll") for (int m = 0; m < 4; ++m) _Pragma("unroll") for (int n = 0; n < 2; ++n) \
        acc[ai][bj][m][n] = __builtin_amdgcn_mfma_scale_f32_16x16x128_f8f6f4(PG8_CAT(Bt[n]), PG8_CAT(At[m]), acc[ai][bj][m][n], 0, 0, 0, 0x7F7F7F7F, 0, 0x7F7F7F7F); } \
    else { _Pragma("unroll") for (int m = 0; m < 4; ++m) _Pragma("unroll") for (int n = 0; n < 2; ++n) _Pragma("unroll") for (int k = 0; k < 2; ++k) \
        acc[ai][bj][m][n] = __builtin_amdgcn_mfma_f32_16x16x32_bf16(Bt[n][k], At[m][k], acc[ai][bj][m][n], 0, 0, 0); } __builtin_amdgcn_s_setprio(0); } while (0)
#define PG8_WAIT_V(n) asm volatile("s_waitcnt vmcnt(" #n ")" ::: "memory")
#define PG8_WAIT_L(n) asm volatile("s_waitcnt lgkmcnt(" #n ")" ::: "memory")
#define PG8_BAR __builtin_amdgcn_s_barrier()
#define PG8_SCHED __builtin_amdgcn_sched_barrier(0)
    Unit cur, nxt; int ui = 0;
    if (!S.next(0, cur)) return;
    f32x4 acc[2][2][4][2];
#pragma unroll
    for (int a = 0; a < 2; ++a)
#pragma unroll
        for (int b = 0; b < 2; ++b)
#pragma unroll
            for (int m = 0; m < 4; ++m)
#pragma unroll
                for (int n = 0; n < 2; ++n) acc[a][b][m][n] = (f32x4){0.f, 0.f, 0.f, 0.f};
    bf16x8 At[4][2], B0[2][2], B1[2][2];
    unsigned oA[2][2];
#pragma unroll
    for (int h = 0; h < 2; ++h)
#pragma unroll
        for (int i = 0; i < 2; ++i) oA[h][i] = Sched::GATHER ? (S.goff(0, h * HALF + Rr[i]) + (unsigned)Cc[i] * 2u) : (unsigned)(Rr[i] * lda + Cc[i] * 2);
    const char* cA = S.aptr(cur); const char* cB = S.bptr(cur);
    PG8_STAGE(PG8_SB(0, 0), cB, voffB); PG8_STAGE(PG8_SB(0, 1), cB + hstepB, voffB); PG8_STAGE(PG8_SA(0, 0), cA, oA[0]); PG8_STAGE(PG8_SA(0, 1), cA + hstepA, oA[1]);
    if (wr == 1) PG8_BAR;
    PG8_WAIT_V(2); PG8_BAR;
    PG8_STAGE(PG8_SB(1, 0), cB + kstep, voffB); PG8_STAGE(PG8_SA(1, 0), cA + kstep, oA[0]); PG8_STAGE(PG8_SB(1, 1), cB + hstepB + kstep, voffB);
    PG8_WAIT_V(6); PG8_BAR;
    for (;;) {
        const bool has_next = S.next(ui + 1, nxt);
        const char* nA = has_next ? S.aptr(nxt) : cA; const char* nB = has_next ? S.bptr(nxt) : cB;
#pragma clang loop unroll(disable)
        for (int t = 0; t < nt; t += 2) {
            const bool last = (t == nt - 2);
            const char* a1 = cA + (size_t)(t + 1) * kstep;
            const char* a2 = last ? nA : cA + (size_t)(t + 2) * kstep; const char* b2 = last ? nB : cB + (size_t)(t + 2) * kstep;
            const char* a3 = a2 + kstep; const char* b3 = b2 + kstep;
            PG8_LDB(B0, 0, 0); PG8_LDB(B1, 0, 1); PG8_SCHED; PG8_LDA(At, 0, 0); PG8_STAGE(PG8_SA(1, 1), a1 + hstepA, oA[1]);
            if constexpr (Sched::GATHER) { if (last && has_next) {
#pragma unroll
                for (int h = 0; h < 2; ++h)
#pragma unroll
                    for (int i = 0; i < 2; ++i) oA[h][i] = S.goff(ui + 1, h * HALF + Rr[i]) + (unsigned)Cc[i] * 2u; } }
            PG8_WAIT_V(8); PG8_WAIT_L(0); PG8_BAR; PG8_MMA(0, 0, At, B0); PG8_MMA(0, 1, At, B1); PG8_BAR; PG8_SCHED;
            PG8_LDA(At, 0, 1); PG8_STAGE(PG8_SB(0, 0), b2, voffB); PG8_STAGE(PG8_SB(0, 1), b2 + hstepB, voffB); PG8_STAGE(PG8_SA(0, 0), a2, oA[0]);
            PG8_WAIT_V(8); PG8_WAIT_L(0); PG8_BAR; PG8_MMA(1, 0, At, B0); PG8_MMA(1, 1, At, B1); PG8_BAR; PG8_SCHED;
            PG8_LDB(B0, 1, 0); PG8_LDB(B1, 1, 1); PG8_SCHED; PG8_LDA(At, 1, 0); PG8_STAGE(PG8_SA(0, 1), a2 + hstepA, oA[1]);
            PG8_WAIT_V(8); PG8_WAIT_L(0); PG8_BAR; PG8_MMA(0, 0, At, B0); PG8_MMA(0, 1, At, B1); PG8_BAR; PG8_SCHED;
            PG8_LDA(At, 1, 1); PG8_STAGE(PG8_SB(1, 0), b3, voffB); PG8_STAGE(PG8_SB(1, 1), b3 + hstepB, voffB); PG8_STAGE(PG8_SA(1, 0), a3, oA[0]);
            PG8_WAIT_V(8); PG8_WAIT_L(0); PG8_BAR; PG8_MMA(1, 0, At, B0); PG8_MMA(1, 1, At, B1); PG8_BAR; PG8_SCHED;
        }
        if (wr == 0) PG8_BAR;
        bool keep = false;
        {
            int tz = threadIdx.x; asm volatile("" : "+v"(tz)); const int ewid = tz >> 6, el = tz & 63, ewr = ewid >> 2, ewc = ewid & 3, efr = el & 15, efq = el >> 4;
            if constexpr (Sched::HAS_MID) { if (S.is_mid(cur)) { E.mid(acc, cur, ewr, ewc, efr, efq); keep = true; } }
            if (!keep) E(acc, cur, ewr, ewc, efr, efq);
        }
        if (!has_next) break;
        if (!keep) {
#pragma unroll
            for (int a = 0; a < 2; ++a)
#pragma unroll
                for (int b = 0; b < 2; ++b)
#pragma unroll
                    for (int m = 0; m < 4; ++m)
#pragma unroll
                        for (int n = 0; n < 2; ++n) acc[a][b][m][n] = (f32x4){0.f, 0.f, 0.f, 0.f};
        }
        cur = nxt; cA = nA; cB = nB; ++ui;
        if (wr == 1) PG8_BAR;
    }
    PG8_WAIT_V(0);
    PG8_BAR;
#undef PG8_SA
#undef PG8_SB
#undef PG8_STAGE
#undef PG8_LDA
#undef PG8_LDB
#undef PG8_MMA
#undef PG8_CAT
#undef PG8_WAIT_V
#undef PG8_WAIT_L
#undef PG8_BAR
#undef PG8_SCHED
}
}
using pg8::Unit;

struct Args { const float* in[25]; float* out; unsigned char* ws; int ph_lo, ph_hi, pad0, pad1; };
static_assert(sizeof(Args) == 27 * 8 + 16, "Args has no padding");
struct Frame {
    LAS unsigned char* lds; volatile LAS unsigned* MISC; unsigned* ctl;
    int tid, lane, wave, vcu, G;
};
#define LDS_WAIT() asm volatile("s_waitcnt lgkmcnt(0)" ::: "memory")
#define VM_WAIT() asm volatile("s_waitcnt vmcnt(0)" ::: "memory")

struct SchedStatic {
    static constexpr bool GATHER = false, HAS_MID = false;
    const char* A; const char* B; int nM, nN, G, c; size_t astep, bstep;
    __device__ __forceinline__ bool next(int i, Unit& u) const { u.aux = 0; return pg8::static_unit(i, G, c, nM, nN, u.pm, u.pn); }
    __device__ __forceinline__ const char* aptr(const Unit& u) const { return A + (size_t)u.pm * astep; }
    __device__ __forceinline__ const char* bptr(const Unit& u) const { return B + (size_t)u.pn * bstep; }
    __device__ __forceinline__ bool is_mid(const Unit&) const { return false; }
    __device__ __forceinline__ unsigned goff(int, int) const { return 0u; }
};
struct SchedSplit2 {
    static constexpr bool GATHER = false, HAS_MID = true;
    const char* A; const char* B; int nM, nN, G, c; size_t astep, bstep, khalf;
    __device__ __forceinline__ bool next(int i, Unit& u) const { u.aux = i & 1; return pg8::static_unit(i >> 1, G, c, nM, nN, u.pm, u.pn); }
    __device__ __forceinline__ const char* aptr(const Unit& u) const { return A + (size_t)u.pm * astep + (size_t)u.aux * khalf; }
    __device__ __forceinline__ const char* bptr(const Unit& u) const { return B + (size_t)u.pn * bstep + (size_t)u.aux * khalf; }
    __device__ __forceinline__ bool is_mid(const Unit& u) const { return u.aux == 0; }
    __device__ __forceinline__ unsigned goff(int, int) const { return 0u; }
};
__device__ __forceinline__ int moe_find_e(volatile LAS unsigned* MISC, int rb) { int e = 0;
#pragma unroll 1
    for (int i = 1; i < NEXP; ++i) e += ((int)MISC[i] <= rb) ? 1 : 0;
    return e; }
template <int NPN, bool GATH>
struct SchedMoe {
    static constexpr bool GATHER = GATH, HAS_MID = false;
    static constexpr int RPX = 32 / NPN;
    static constexpr int UT0 = 96, UTN = 24;
    const char* A; const char* B; volatile LAS unsigned* MISC; const LAS unsigned* gtab; int c, G, nrb; size_t bstep_e, bstep_n;
    __device__ __forceinline__ bool slow_next(int i, Unit& u) const {
        int rb, pn;
        if (G == 256) { const int x = c & 7, j = c >> 3; rb = (8 * i + x) * RPX + j / NPN; pn = j % NPN; }
        else { const long L = (long)i * G + c; rb = (int)(L / NPN); pn = (int)(L % NPN); }
        if (rb >= nrb) return false;
        u.pm = rb; u.pn = pn; u.aux = moe_find_e(MISC, rb); return true;
    }
    __device__ __forceinline__ void build(int tid) const {
        if (tid < UTN) { Unit u; const bool ok = slow_next(tid, u); MISC[UT0 + tid] = ok ? (0x80000000u | ((unsigned)u.aux << 16) | ((unsigned)u.pn << 12) | (unsigned)u.pm) : 0u; }
        __syncthreads();
    }
    __device__ __forceinline__ bool next(int i, Unit& u) const {
        if (i >= UTN) return false;
        const unsigned w = MISC[UT0 + i]; if (!(w >> 31)) return false;
        u.pm = (int)(w & 0xfffu); u.pn = (int)((w >> 12) & 0xfu); u.aux = (int)((w >> 16) & 0xffu); return true;
    }
    __device__ __forceinline__ const char* aptr(const Unit& u) const { return GATH ? A : A + (size_t)u.pm * (256 * 1024); }
    __device__ __forceinline__ const char* bptr(const Unit& u) const { return B + (size_t)u.aux * bstep_e + (size_t)u.pn * bstep_n; }
    __device__ __forceinline__ bool is_mid(const Unit&) const { return false; }
    __device__ __forceinline__ unsigned goff(int ui, int row) const { return gtab[ui * 256 + row]; }
};

#define EPI_ARGS f32x4 (&acc)[2][2][4][2], const Unit& u, int wr, int wc, int fr, int fq
struct EpiG1 {
    bf16 *Q, *K, *V, *U, *VG, *GT; const float* bgate;
    __device__ __forceinline__ void mid(EPI_ARGS) const {}
    __device__ __forceinline__ void operator()(EPI_ARGS) const {
        const int pn = u.pn; const int row0 = u.pm * 256 + wr * 64 + fr;
        if (pn < 6) {
            const int t = pn >> 1; bf16* base = Q + (size_t)t * ((WS_K - WS_Q) / 2); const float sc = (t == 0) ? QSCALE : 1.0f;    const int col0 = (pn & 1) * 256 + wc * 32 + 8 * fq;
#pragma unroll
            for (int ai = 0; ai < 2; ++ai)
#pragma unroll
                for (int m = 0; m < 4; ++m) { bf16* rowp = base + (size_t)(row0 + ai * 128 + m * 16) * 512 + col0;
#pragma unroll
                    for (int bj = 0; bj < 2; ++bj) { const f32x4 v0 = acc[ai][bj][m][0] * sc, v1 = acc[ai][bj][m][1] * sc;
                        u32x4 w; w.x = cvtpk(v0[0], v0[1]); w.y = cvtpk(v0[2], v0[3]); w.z = cvtpk(v1[0], v1[1]); w.w = cvtpk(v1[2], v1[3]); *(u32x4*)(rowp + bj * 128) = w; } }
        } else if (pn < 10) {
            bf16* base = Q + (size_t)(pn >> 1) * ((WS_K - WS_Q) / 2); const int col0 = (pn & 1) * 256 + wc * 32 + 8 * fq;
#pragma unroll
            for (int ai = 0; ai < 2; ++ai)
#pragma unroll
                for (int m = 0; m < 4; ++m) { bf16* rowp = base + (size_t)(row0 + ai * 128 + m * 16) * 512 + col0;
#pragma unroll
                    for (int bj = 0; bj < 2; ++bj) { const f32x4 v0 = acc[ai][bj][m][0], v1 = acc[ai][bj][m][1];
                        const f32x2 a = gelu_pk((f32x2){v0[0], v0[1]}), b = gelu_pk((f32x2){v0[2], v0[3]}), c = gelu_pk((f32x2){v1[0], v1[1]}), d = gelu_pk((f32x2){v1[2], v1[3]});
                        u32x4 w; w.x = cvtpk(a.x, a.y); w.y = cvtpk(b.x, b.y); w.z = cvtpk(c.x, c.y); w.w = cvtpk(d.x, d.y); *(u32x4*)(rowp + bj * 128) = w; } }
        } else {
            const int col0 = (pn - 10) * 128 + wc * 32 + 8 * fq;
            const f32x4 ba0 = *(const f32x4*)(bgate + col0), ba1 = *(const f32x4*)(bgate + col0 + 4), bb0 = *(const f32x4*)(bgate + 1024 + col0), bb1 = *(const f32x4*)(bgate + 1024 + col0 + 4);
#pragma unroll
            for (int ai = 0; ai < 2; ++ai)
#pragma unroll
                for (int m = 0; m < 4; ++m) { bf16* rowp = GT + (size_t)(row0 + ai * 128 + m * 16) * 2048 + col0;
                    const f32x4 a0 = acc[ai][0][m][0] + ba0, a1 = acc[ai][0][m][1] + ba1, b0 = acc[ai][1][m][0] + bb0, b1 = acc[ai][1][m][1] + bb1;
                    f32x4 ea0, ea1, eb0, eb1;
#pragma unroll
                    for (int i = 0; i < 4; ++i) { ea0[i] = __builtin_amdgcn_exp2f(-LOG2E * a0[i]); ea1[i] = __builtin_amdgcn_exp2f(-LOG2E * a1[i]); eb0[i] = fminf(__builtin_amdgcn_exp2f(-LOG2E * b0[i]), 1e18f); eb1[i] = fminf(__builtin_amdgcn_exp2f(-LOG2E * b1[i]), 1e18f); }
                    f32x4 gb0, gb1, r0, r1;
#pragma unroll
                    for (int i = 0; i < 4; ++i) { gb0[i] = __builtin_amdgcn_rcpf(1.0f + eb0[i]); gb1[i] = __builtin_amdgcn_rcpf(1.0f + eb1[i]); r0[i] = (1.0f + eb0[i]) * __builtin_amdgcn_rcpf(1.0f + ea0[i]); r1[i] = (1.0f + eb1[i]) * __builtin_amdgcn_rcpf(1.0f + ea1[i]); }
                    u32x4 wr, wb; wr.x = cvtpk(r0[0], r0[1]); wr.y = cvtpk(r0[2], r0[3]); wr.z = cvtpk(r1[0], r1[1]); wr.w = cvtpk(r1[2], r1[3]);
                    wb.x = cvtpk(gb0[0], gb0[1]); wb.y = cvtpk(gb0[2], gb0[3]); wb.z = cvtpk(gb1[0], gb1[1]); wb.w = cvtpk(gb1[2], gb1[3]);
                    __builtin_nontemporal_store(wr, (u32x4*)rowp); __builtin_nontemporal_store(wb, (u32x4*)(rowp + 1024)); }
        }
    }
};
struct EpiG2 {
    const bf16* GT; bf16* MRG;
    __device__ __forceinline__ void mid(EPI_ARGS) const {
        const int row0 = u.pm * 256 + wr * 64 + fr, col0 = u.pn * 256 + wc * 32 + 8 * fq;
#pragma unroll
        for (int ai = 0; ai < 2; ++ai)
#pragma unroll
            for (int m = 0; m < 4; ++m) { const bf16* gp = GT + (size_t)(row0 + ai * 128 + m * 16) * 2048 + col0;
#pragma unroll
                for (int bj = 0; bj < 2; ++bj) { const u32x4 rr = __builtin_nontemporal_load((const u32x4*)(gp + bj * 128));
                    const f32x4 r0 = {bflo(rr.x), bfhi(rr.x), bflo(rr.y), bfhi(rr.y)}, r1 = {bflo(rr.z), bfhi(rr.z), bflo(rr.w), bfhi(rr.w)};
                    acc[ai][bj][m][0] *= r0; acc[ai][bj][m][1] *= r1; } }
    }
    __device__ __forceinline__ void operator()(EPI_ARGS) const {
        const int row0 = u.pm * 256 + wr * 64 + fr, col0 = u.pn * 256 + wc * 32 + 8 * fq;
#pragma unroll
        for (int ai = 0; ai < 2; ++ai)
#pragma unroll
            for (int m = 0; m < 4; ++m) { const size_t r = (size_t)(row0 + ai * 128 + m * 16); const bf16* gp = GT + r * 2048 + 1024 + col0; bf16* op = MRG + r * 1024 + col0;
#pragma unroll
                for (int bj = 0; bj < 2; ++bj) { const u32x4 gb = __builtin_nontemporal_load((const u32x4*)(gp + bj * 128)); const f32x4 v0 = acc[ai][bj][m][0], v1 = acc[ai][bj][m][1];
                    u32x4 w; w.x = cvtpk(v0[0] * bflo(gb.x), v0[1] * bfhi(gb.x)); w.y = cvtpk(v0[2] * bflo(gb.y), v0[3] * bfhi(gb.y));
                    w.z = cvtpk(v1[0] * bflo(gb.z), v1[1] * bfhi(gb.z)); w.w = cvtpk(v1[2] * bflo(gb.w), v1[3] * bfhi(gb.w)); *(u32x4*)(op + bj * 128) = w; } }
    }
};
struct EpiPlain {
    bf16* O;
    __device__ __forceinline__ void mid(EPI_ARGS) const {}
    __device__ __forceinline__ void operator()(EPI_ARGS) const {
        const int row0 = u.pm * 256 + wr * 64 + fr, col0 = u.pn * 256 + wc * 32 + 8 * fq;
#pragma unroll
        for (int ai = 0; ai < 2; ++ai)
#pragma unroll
            for (int m = 0; m < 4; ++m) { bf16* op = O + (size_t)(row0 + ai * 128 + m * 16) * 1024 + col0;
#pragma unroll
                for (int bj = 0; bj < 2; ++bj) { const f32x4 v0 = acc[ai][bj][m][0], v1 = acc[ai][bj][m][1];
                    u32x4 w; w.x = cvtpk(v0[0], v0[1]); w.y = cvtpk(v0[2], v0[3]); w.z = cvtpk(v1[0], v1[1]); w.w = cvtpk(v1[2], v1[3]); *(u32x4*)(op + bj * 128) = w; } }
    }
};
struct EpiAct {
    const float* bgu; unsigned char* ACT8;
    __device__ __forceinline__ void mid(EPI_ARGS) const {}
    __device__ __forceinline__ f32x2 act2(f32x2 g, f32x2 l) const {
        f32x2 xg, xl; xg.x = fminf(g.x, SWL); xg.y = fminf(g.y, SWL); xl.x = fminf(fmaxf(l.x, -SWL), SWL); xl.y = fminf(fmaxf(l.y, -SWL), SWL);
        const f32x2 t = xg * (-SWA * LOG2E); f32x2 e; e.x = __builtin_amdgcn_exp2f(t.x); e.y = __builtin_amdgcn_exp2f(t.y);
        const f32x2 d = e + 1.0f; f32x2 r; r.x = __builtin_amdgcn_rcpf(d.x); r.y = __builtin_amdgcn_rcpf(d.y);
        return (xg * r) * (xl * F8_ASCALE + F8_ASCALE);
    }
    __device__ __forceinline__ void operator()(EPI_ARGS) const {
        const int e = u.aux; const int row0 = u.pm * 256 + wr * 64 + fr, col0 = u.pn * 128 + wc * 32 + 8 * fq;
        const float* bp = bgu + (size_t)e * 2048 + col0;
        const f32x4 bg0 = *(const f32x4*)(bp), bg1 = *(const f32x4*)(bp + 4), bl0 = *(const f32x4*)(bp + 1024), bl1 = *(const f32x4*)(bp + 1028);
#pragma unroll
        for (int ai = 0; ai < 2; ++ai)
#pragma unroll
            for (int m = 0; m < 4; ++m) {
                const f32x4 g0 = acc[ai][0][m][0] * F8_DESCALE + bg0, g1 = acc[ai][0][m][1] * F8_DESCALE + bg1, l0 = acc[ai][1][m][0] * F8_DESCALE + bl0, l1 = acc[ai][1][m][1] * F8_DESCALE + bl1;
                const f32x2 o0 = act2((f32x2){g0[0], g0[1]}, (f32x2){l0[0], l0[1]}), o1 = act2((f32x2){g0[2], g0[3]}, (f32x2){l0[2], l0[3]});
                const f32x2 o2 = act2((f32x2){g1[0], g1[1]}, (f32x2){l1[0], l1[1]}), o3 = act2((f32x2){g1[2], g1[3]}, (f32x2){l1[2], l1[3]});
                u32x2 w; w.x = pk_fp8x4_nc(o0.x, o0.y, o1.x, o1.y); w.y = pk_fp8x4_nc(o2.x, o2.y, o3.x, o3.y);
                *(u32x2*)(ACT8 + (size_t)(row0 + ai * 128 + m * 16) * 1024 + col0) = w; }
    }
};
struct EpiDown {
    const float* bdn; unsigned char* Y2s;
    __device__ __forceinline__ void mid(EPI_ARGS) const {}
    __device__ __forceinline__ void operator()(EPI_ARGS) const {
        const int e = u.aux; const int row0 = u.pm * 256 + wr * 64 + fr, col0 = u.pn * 256 + wc * 32 + 8 * fq;
        f32x4 bv[2][2];
#pragma unroll
        for (int bj = 0; bj < 2; ++bj)
#pragma unroll
            for (int n = 0; n < 2; ++n) bv[bj][n] = *(const f32x4*)(bdn + (size_t)e * 1024 + col0 + bj * 128 + 4 * n) * F8_YSCALE;
#pragma unroll
        for (int ai = 0; ai < 2; ++ai)
#pragma unroll
            for (int m = 0; m < 4; ++m) { unsigned char* op = Y2s + (size_t)(row0 + ai * 128 + m * 16) * 1024 + col0;
#pragma unroll
                for (int bj = 0; bj < 2; ++bj) { const f32x4 v0 = acc[ai][bj][m][0] * (F8_DESCALE * F8_YSCALE) + bv[bj][0], v1 = acc[ai][bj][m][1] * (F8_DESCALE * F8_YSCALE) + bv[bj][1];
                    u32x2 w; w.x = pk_fp8x4(v0[0], v0[1], v0[2], v0[3]); w.y = pk_fp8x4(v1[0], v1[1], v1[2], v1[3]); *(u32x2*)(op + bj * 128) = w; } }
    }
};

struct WItem { const float* W; unsigned char* dst; int N, k0, n0, ldt, drow, dk0, fp8; };
__device__ __forceinline__ WItem witem_decode(const Args& a, int r) {
    unsigned char* ws = a.ws; WItem it;
    constexpr int I_IN = 8 * 80, I_GATE = 8 * 64, I_BR = 4 * 32, I_OUT = 8 * 32, I_GU = 8 * 64, I_DN = 8 * 32;
    it.fp8 = 0; it.dk0 = 0; it.ldt = 2048;
    if (r < I_IN) { it.W = a.in[6]; it.N = INW; it.k0 = 128 * (r / 80); it.n0 = 32 * (r % 80); it.dst = ws + WS_W1T; it.drow = it.n0; return it; } r -= I_IN;
    if (r < I_GATE) { it.W = a.in[14]; it.N = 2048; it.k0 = 128 * (r / 64); it.n0 = 32 * (r % 64); it.dst = ws + WS_W1T; const int m0 = it.n0 & 1023;
        it.drow = INW + 256 * (m0 >> 7) + (m0 & 127) + (it.n0 >= 1024 ? 128 : 0); return it; } r -= I_GATE;
    if (r < I_BR) { it.W = a.in[12]; it.N = 1024; it.k0 = 128 * (r / 32); it.n0 = 32 * (r % 32); it.dst = ws + WS_WBRT; it.drow = it.n0; return it; } r -= I_BR;
    if (r < I_BR) { it.W = a.in[13]; it.N = 1024; it.k0 = 128 * (r / 32); it.n0 = 32 * (r % 32); it.dst = ws + WS_WBRT; it.drow = it.n0; it.dk0 = 512; return it; } r -= I_BR;
    if (r < I_OUT) { it.W = a.in[16]; it.N = 1024; it.k0 = 128 * (r / 32); it.n0 = 32 * (r % 32); it.dst = ws + WS_WOUTT; it.drow = it.n0; return it; } r -= I_OUT;
    it.fp8 = 1; it.ldt = 1024;
    if (r < NEXP * I_GU) { const int e = r / I_GU, q = r % I_GU; it.W = a.in[21] + (size_t)e * D * 2048; it.N = 2048; it.k0 = 128 * (q / 64); it.n0 = 32 * (q % 64); it.dst = ws + WS_WGUT + (size_t)e * 2048 * 1024;
        const int m0 = it.n0 & 1023; it.drow = 256 * (m0 >> 7) + (m0 & 127) + (it.n0 >= 1024 ? 128 : 0); return it; }
    r -= NEXP * I_GU;
    { const int e = r / I_DN, q = r % I_DN; it.W = a.in[23] + (size_t)e * D * D; it.N = 1024; it.k0 = 128 * (q / 32); it.n0 = 32 * (q % 32); it.dst = ws + WS_WDNT + (size_t)e * 1024 * 1024; it.drow = it.n0; }
    return it;
}
constexpr int W_NITEMS = 8 * 80 + 8 * 64 + 2 * 4 * 32 + 8 * 32 + NEXP * (8 * 64 + 8 * 32);
__device__ __forceinline__ void witem_load(const WItem& it, float (&v)[64], int lane) {
    const float* p = it.W + (size_t)(it.k0 + (lane >> 3)) * it.N + it.n0 + (lane & 7) * 4;
#pragma unroll
    for (int i = 0; i < 16; ++i) { const f32x4 t = __builtin_nontemporal_load((const f32x4*)(p + (size_t)(8 * i) * it.N)); v[4 * i] = t[0]; v[4 * i + 1] = t[1]; v[4 * i + 2] = t[2]; v[4 * i + 3] = t[3]; }
}
__device__ __forceinline__ void witem_store(const WItem& it, const float (&v)[64], LAS float* scr, int lane) {
#pragma unroll
    for (int i = 0; i < 16; ++i) { const int k = 8 * i + (lane >> 3); *(LAS f32x4*)(scr + k * 32 + (((lane & 7) * 4 + 4 * (i >> 1)) & 31)) = (f32x4){v[4 * i], v[4 * i + 1], v[4 * i + 2], v[4 * i + 3]}; }
    LDS_WAIT(); asm volatile("" ::: "memory");
    const int c = lane & 7;
#pragma unroll
    for (int j = 0; j < 4; ++j) { const int n = (lane >> 3) + 8 * j; const LAS float* s = scr + (16 * c) * 32 + ((n + 4 * c) & 31);
        float x[16];
#pragma unroll
        for (int q = 0; q < 16; ++q) x[q] = s[q * 32];
        unsigned char* d = it.dst + (size_t)(it.drow + n) * it.ldt;
        if (it.fp8) { u32x4 o;
            o.x = pk_fp8x4(x[0] * F8_WSCALE, x[1] * F8_WSCALE, x[2] * F8_WSCALE, x[3] * F8_WSCALE); o.y = pk_fp8x4(x[4] * F8_WSCALE, x[5] * F8_WSCALE, x[6] * F8_WSCALE, x[7] * F8_WSCALE);
            o.z = pk_fp8x4(x[8] * F8_WSCALE, x[9] * F8_WSCALE, x[10] * F8_WSCALE, x[11] * F8_WSCALE); o.w = pk_fp8x4(x[12] * F8_WSCALE, x[13] * F8_WSCALE, x[14] * F8_WSCALE, x[15] * F8_WSCALE);
            __builtin_nontemporal_store(o, (u32x4*)(d + it.dk0 + it.k0 + 16 * c)); }
        else { u32x4 o0, o1;
            o0.x = cvtpk(x[0], x[1]); o0.y = cvtpk(x[2], x[3]); o0.z = cvtpk(x[4], x[5]); o0.w = cvtpk(x[6], x[7]); o1.x = cvtpk(x[8], x[9]); o1.y = cvtpk(x[10], x[11]); o1.z = cvtpk(x[12], x[13]); o1.w = cvtpk(x[14], x[15]);
            *(u32x4*)(d + (size_t)(it.dk0 + it.k0 + 16 * c) * 2) = o0; *(u32x4*)(d + (size_t)(it.dk0 + it.k0 + 16 * c) * 2 + 16) = o1; } }
    LDS_WAIT(); asm volatile("" ::: "memory");
}
__device__ __forceinline__ void phaseA(const Frame& F, const Args& a) {
    unsigned char* ws = a.ws;
    if (F.vcu < 192) {
        const float* c = a.in[1]; const float* w_ada = a.in[2]; const float* b_ada = a.in[3]; float* mod = (float*)(ws + WS_MOD);
        LAS float* red = (LAS float*)(F.lds);
        const int col = F.vcu * 32 + (F.tid & 31), ks = F.tid >> 5;
        float a0 = 0.f, a1 = 0.f, a2 = 0.f, a3 = 0.f;
        for (int k = ks * 64; k < ks * 64 + 64; ++k) { const float w = __builtin_nontemporal_load(w_ada + (size_t)k * 6144 + col);
            const float c0 = c[k], c1 = c[D + k], c2 = c[2 * D + k], c3 = c[3 * D + k];
            a0 += c0 * __builtin_amdgcn_rcpf(1.0f + __expf(-c0)) * w; a1 += c1 * __builtin_amdgcn_rcpf(1.0f + __expf(-c1)) * w;
            a2 += c2 * __builtin_amdgcn_rcpf(1.0f + __expf(-c2)) * w; a3 += c3 * __builtin_amdgcn_rcpf(1.0f + __expf(-c3)) * w; }
        red[(ks * 4 + 0) * 32 + (F.tid & 31)] = a0; red[(ks * 4 + 1) * 32 + (F.tid & 31)] = a1; red[(ks * 4 + 2) * 32 + (F.tid & 31)] = a2; red[(ks * 4 + 3) * 32 + (F.tid & 31)] = a3;
        __syncthreads();
        if (F.tid < 128) { const int b = F.tid >> 5, cc = F.tid & 31; float s = 0.f;
#pragma unroll
            for (int k = 0; k < 16; ++k) s += red[(k * 4 + b) * 32 + cc];
            mod[b * 6144 + F.vcu * 32 + cc] = s + b_ada[F.vcu * 32 + cc]; }
        __syncthreads();
    }
    if (F.vcu == 192 % F.G) {
        const float* w_router = a.in[19]; bf16* wrt = (bf16*)(ws + WS_WRT);
        for (int i = F.tid; i < D * NEXP; i += NWAVES * 64) { const int k = i >> 5, e = i & 31; const float w = w_router[i]; const unsigned hh = cvtpk(w, 0.f) & 0xffffu;
            wrt[(size_t)e * D + k] = (bf16)hh; wrt[(size_t)(NEXP + e) * D + k] = (bf16)(cvtpk(w - bflo(hh), 0.f) & 0xffffu); }
    }
    LAS float* scr = (LAS float*)(F.lds + F.wave * 17408);
    const int gw = F.vcu * NWAVES + F.wave, NGW = F.G * NWAVES;
    if (gw < W_NITEMS) {
        float va[64], vb[64];
        WItem ia = witem_decode(a, gw), ib = ia;
        witem_load(ia, va, F.lane);
        for (int it = gw; it < W_NITEMS; it += 2 * NGW) {
            const bool hb = (it + NGW < W_NITEMS);
            ib = witem_decode(a, hb ? it + NGW : it); witem_load(ib, vb, F.lane);
            witem_store(ia, va, scr, F.lane);
            if (!hb) break;
            const bool ha = (it + 2 * NGW < W_NITEMS);
            ia = witem_decode(a, ha ? it + 2 * NGW : it); witem_load(ia, va, F.lane);
            witem_store(ib, vb, scr, F.lane);
            if (!ha) break;
        }
    }
}
__device__ __forceinline__ void phaseB(const Frame& F, const Args& a) {
    const float* x = a.in[0]; const float* g = a.in[4]; const float* mod = (const float*)(a.ws + WS_MOD); bf16* xn = (bf16*)(a.ws + WS_XN);
    const int gw = F.vcu * NWAVES + F.wave, NGW = F.G * NWAVES;
    f32x4 cg[4], csh[4]; int cb = -1;
    for (int row0 = gw * 4; row0 < NTOK; row0 += NGW * 4) {
        f32x4 v[4][4];
#pragma unroll
        for (int rr = 0; rr < 4; ++rr)
#pragma unroll
            for (int j = 0; j < 4; ++j) v[rr][j] = __builtin_nontemporal_load((const f32x4*)(x + (size_t)(row0 + rr) * D) + F.lane + 64 * j);
        const int b = row0 / SEQ; const float* mb = mod + b * 6144;
        if (b != cb) { cb = b;
#pragma unroll
            for (int j = 0; j < 4; ++j) { const int c0 = (F.lane + 64 * j) * 4; cg[j] = *(const f32x4*)(g + c0) * (*(const f32x4*)(mb + SC1 + c0) + 1.0f); csh[j] = *(const f32x4*)(mb + SH1 + c0); } }
#pragma unroll
        for (int rr = 0; rr < 4; ++rr) {
            float ss = 0.f;
#pragma unroll
            for (int j = 0; j < 4; ++j) ss += (v[rr][j].x * v[rr][j].x + v[rr][j].y * v[rr][j].y) + (v[rr][j].z * v[rr][j].z + v[rr][j].w * v[rr][j].w);
            const float rstd = rsqrtf(wsum(ss) * (1.0f / D) + EPS);
            u32x2* o8 = (u32x2*)(xn + (size_t)(row0 + rr) * D) + F.lane;
#pragma unroll
            for (int j = 0; j < 4; ++j) {
                const f32x4 h = v[rr][j] * rstd * cg[j] + csh[j];
                u32x2 w; w.x = cvtpk(h[0], h[1]); w.y = cvtpk(h[2], h[3]); o8[64 * j] = w; }
        }
    }
}

constexpr int SGU_STRIDE = 1088;
__device__ __forceinline__ s16x4 vtr(const LAS unsigned char* p) { typedef short v4i16_t __attribute__((ext_vector_type(4))); return __builtin_bit_cast(s16x4, __builtin_amdgcn_ds_read_tr16_b64_v4i16((LAS v4i16_t*)p)); }
__device__ __forceinline__ void sgu_unit(const Frame& F, const Args& a, int b, int blk) {
    const bf16* VG = (const bf16*)(a.ws + WS_VG); const bf16* U = (const bf16*)(a.ws + WS_U); bf16* YAB = (bf16*)(a.ws + WS_YAB);
    const float* ln_g = a.in[8]; const float* ln_b = a.in[9]; const float* w_s = a.in[10]; const float* b_s = a.in[11];
    const int tok0 = b * SEQ + blk * SGB, lane = F.lane;
    {
        const f32x4 g0 = *(const f32x4*)(ln_g + lane * 8), g1 = *(const f32x4*)(ln_g + lane * 8 + 4), b0 = *(const f32x4*)(ln_b + lane * 8), b1 = *(const f32x4*)(ln_b + lane * 8 + 4);
#pragma unroll 1
        for (int r4 = 0; r4 < 16; r4 += 4) {
            u32x4 w[4];
#pragma unroll
            for (int rr = 0; rr < 4; ++rr) w[rr] = __builtin_nontemporal_load((const u32x4*)(VG + (size_t)(tok0 + F.wave * 16 + r4 + rr) * 512 + lane * 8));
#pragma unroll
            for (int rr = 0; rr < 4; ++rr) { const int row = F.wave * 16 + r4 + rr;
                f32x4 v0 = {bflo(w[rr].x), bfhi(w[rr].x), bflo(w[rr].y), bfhi(w[rr].y)}, v1 = {bflo(w[rr].z), bfhi(w[rr].z), bflo(w[rr].w), bfhi(w[rr].w)};
                const float mu = wsum((v0[0] + v0[1]) + (v0[2] + v0[3]) + (v1[0] + v1[1]) + (v1[2] + v1[3])) * (1.0f / 512.0f);
                v0 -= mu; v1 -= mu;
                const float var = wsum((v0[0] * v0[0] + v0[1] * v0[1]) + (v0[2] * v0[2] + v0[3] * v0[3]) + (v1[0] * v1[0] + v1[1] * v1[1]) + (v1[2] * v1[2] + v1[3] * v1[3])) * (1.0f / 512.0f);
                const float rstd = rsqrtf(var + EPS);
                v0 = v0 * rstd * g0 + b0; v1 = v1 * rstd * g1 + b1;
                u32x4 o; o.x = cvtpk(v0[0], v0[1]); o.y = cvtpk(v0[2], v0[3]); o.z = cvtpk(v1[0], v1[1]); o.w = cvtpk(v1[2], v1[3]);
                *(LAS u32x4*)(F.lds + row * SGU_STRIDE + lane * 16) = o; }
        }
    }
    __syncthreads();
    {
        const int g = F.wave, r32 = lane & 31, hi = lane >> 5, i16 = lane & 15, g16 = (lane >> 4) & 1;
        const LAS unsigned char* vb = F.lds + (8 * hi + (i16 >> 2)) * SGU_STRIDE + (g * 64 + 16 * g16 + 4 * (i16 & 3)) * 2;
#pragma unroll
        for (int tb = 0; tb < 4; ++tb) {
            const int t = 32 * tb + r32; const float* wrow = w_s + ((size_t)g * 128 + t) * 128;
            f32x4 wr0[8], wr1[8];
#pragma unroll
            for (int ks = 0; ks < 2 * tb + 2; ++ks) { wr0[ks] = *(const f32x4*)(wrow + 16 * ks + 8 * hi); wr1[ks] = *(const f32x4*)(wrow + 16 * ks + 8 * hi + 4); }
            const float bs = b_s[g * 128 + t];
            const bf16* up = U + (size_t)(tok0 + t) * 512 + g * 64 + 4 * hi;
            u32x2 uu0[4], uu1[4];
#pragma unroll
            for (int gg = 0; gg < 4; ++gg) { uu0[gg] = *(const u32x2*)(up + 8 * gg); uu1[gg] = *(const u32x2*)(up + 32 + 8 * gg); }
            f32x16 a0, a1;
#pragma unroll
            for (int r = 0; r < 16; ++r) { a0[r] = 0.f; a1[r] = 0.f; }
#pragma unroll
            for (int ks = 0; ks < 2 * tb + 2; ++ks) {
                const int s0 = 16 * ks + 8 * hi;
                float wv[8] = {wr0[ks][0], wr0[ks][1], wr0[ks][2], wr0[ks][3], wr1[ks][0], wr1[ks][1], wr1[ks][2], wr1[ks][3]};
                if (ks >= 2 * tb) {
#pragma unroll
                    for (int j = 0; j < 8; ++j) wv[j] = (s0 + j <= t) ? wv[j] : 0.f; }
                u32x4 bw; bw.x = cvtpk(wv[0], wv[1]); bw.y = cvtpk(wv[2], wv[3]); bw.z = cvtpk(wv[4], wv[5]); bw.w = cvtpk(wv[6], wv[7]);
                const bf16x8 bfrag = __builtin_bit_cast(bf16x8, bw);
                const LAS unsigned char* p = vb + ks * 16 * SGU_STRIDE;
                const s16x4 l0 = vtr(p), h0 = vtr(p + 4 * SGU_STRIDE), l1 = vtr(p + 64), h1 = vtr(p + 4 * SGU_STRIDE + 64);
                const bf16x8 A0 = {l0[0], l0[1], l0[2], l0[3], h0[0], h0[1], h0[2], h0[3]}, A1 = {l1[0], l1[1], l1[2], l1[3], h1[0], h1[1], h1[2], h1[3]};
                a0 = __builtin_amdgcn_mfma_f32_32x32x16_bf16(A0, bfrag, a0, 0, 0, 0);
                a1 = __builtin_amdgcn_mfma_f32_32x32x16_bf16(A1, bfrag, a1, 0, 0, 0);
            }
            bf16* op = YAB + (size_t)(tok0 + t) * 1024 + 512 + g * 64 + 4 * hi;
#pragma unroll
            for (int gg = 0; gg < 4; ++gg) {
                u32x2 o0, o1;
                o0.x = cvtpk(bflo(uu0[gg].x) * (a0[4 * gg] + bs), bfhi(uu0[gg].x) * (a0[4 * gg + 1] + bs)); o0.y = cvtpk(bflo(uu0[gg].y) * (a0[4 * gg + 2] + bs), bfhi(uu0[gg].y) * (a0[4 * gg + 3] + bs));
                o1.x = cvtpk(bflo(uu1[gg].x) * (a1[4 * gg] + bs), bfhi(uu1[gg].x) * (a1[4 * gg + 1] + bs)); o1.y = cvtpk(bflo(uu1[gg].y) * (a1[4 * gg + 2] + bs), bfhi(uu1[gg].y) * (a1[4 * gg + 3] + bs));
                *(u32x2*)(op + 8 * gg) = o0; *(u32x2*)(op + 32 + 8 * gg) = o1; }
        }
    }
    __syncthreads();
}

constexpr int AT_BUF = 65536, AT_V = 32768, AT_BT = GTAB_OFF;
static_assert(8 * 1088 <= GTAB_BYTES, "bias tables fit above the ring");
__device__ __forceinline__ void attn_chunks(const Frame& F, const Args& a, int gc0, int gc1) {
    const bf16* __restrict__ Q = (const bf16*)(a.ws + WS_Q); const bf16* __restrict__ Kb = (const bf16*)(a.ws + WS_K); const bf16* __restrict__ Vb = (const bf16*)(a.ws + WS_V); bf16* YAB = (bf16*)(a.ws + WS_YAB);
    const int tid = F.tid, lane = F.lane, wave = F.wave, pr = wave >> 1, half = wave & 1;
    const int r32 = lane & 31, hi = lane >> 5, i16 = lane & 15, g16 = (lane >> 4) & 1;
    const int gcs[2] = {gc0, gc1};
    int j0s[2], nts[2], tok0s[2];
#pragma unroll
    for (int i = 0; i < 2; ++i) { const int c = gcs[i] % (SEQ / CHUNK); j0s[i] = (c < NLEFT) ? (NLEFT - c) : 0; nts[i] = 9 - j0s[i]; tok0s[i] = (gcs[i] / (SEQ / CHUNK)) * SEQ + c * CHUNK; }
    const int total = 2 * nts[0] + 2 * nts[1];
    const int lrow = tid >> 5, c16 = tid & 31, lhh = c16 >> 3, lch = c16 & 7;
    const int kwoff = lhh * 8192 + lrow * 128 + ((lch ^ ((lrow >> 1) & 7)) << 4);
    const int vwoff = AT_V + lhh * 8192 + lrow * 128 + ((lch ^ (((lrow >> 1) & 1) << 2)) << 4);
    int ko[4];
#pragma unroll
    for (int sI = 0; sI < 4; ++sI) ko[sI] = pr * 8192 + r32 * 128 + ((((2 * sI + hi) ^ ((r32 >> 1) & 7))) << 4);
    const int fb = (i16 >> 3) & 1;
    const int vr0 = AT_V + pr * 8192 + (4 * hi + (i16 >> 2)) * 128 + ((4 * (0 ^ fb) + 2 * g16 + ((i16 & 3) >> 1)) * 16) + (i16 & 1) * 8;
    const int vr1 = AT_V + pr * 8192 + (4 * hi + (i16 >> 2)) * 128 + ((4 * (1 ^ fb) + 2 * g16 + ((i16 & 3) >> 1)) * 16) + (i16 & 1) * 8;
#define AT_DECODE(t, ci, hp, j) do { ci = ((t) >= 2 * nts[0]) ? 1 : 0; const int tt_ = (t) - ci * 2 * nts[0]; hp = (tt_ >= nts[ci]) ? 1 : 0; j = j0s[ci] + tt_ - hp * nts[ci]; } while (0)
    u32x4 kn[4], vn[4];
    {
        int ci, hp, j; AT_DECODE(0, ci, hp, j);
        const size_t g = (size_t)(tok0s[ci] + (j - NLEFT) * CHUNK + lrow) * 512 + hp * 256 + c16 * 8;
#pragma unroll
        for (int i = 0; i < 4; ++i) { kn[i] = *(const u32x4*)(Kb + g + (size_t)i * 16 * 512); vn[i] = *(const u32x4*)(Vb + g + (size_t)i * 16 * 512); }
#pragma unroll
        for (int i = 0; i < 4; ++i) { *(LAS u32x4*)(F.lds + kwoff + i * 2048) = kn[i]; *(LAS u32x4*)(F.lds + vwoff + i * 2048) = vn[i]; }
    }
    __syncthreads();
    bf16x8 qf[4]; f32x16 o0, o1; float m = -1e30f, l = 0.f;
#pragma unroll
    for (int r = 0; r < 16; ++r) { o0[r] = 0.f; o1[r] = 0.f; }
#pragma unroll
    for (int sI = 0; sI < 4; ++sI) qf[sI] = (bf16x8){0, 0, 0, 0, 0, 0, 0, 0};
#pragma unroll 1
    for (int t = 0; t < total; ++t) {
        int ci, hp, j; AT_DECODE(t, ci, hp, j);
        const int tn = (t + 1 < total) ? t + 1 : t; int cin, hpn, jn; AT_DECODE(tn, cin, hpn, jn);
        const int h = 4 * hp + pr, qi = half * 32 + r32, qtok = tok0s[ci] + qi;
        if (j == j0s[ci]) {
#pragma unroll
            for (int sI = 0; sI < 4; ++sI) qf[sI] = __builtin_nontemporal_load((const bf16x8*)(Q + (size_t)qtok * 512 + h * 64 + 16 * sI + 8 * hi));
#pragma unroll
            for (int r = 0; r < 16; ++r) { o0[r] = 0.f; o1[r] = 0.f; }
            m = -1e30f; l = 0.f;
        }
        asm volatile("" ::: "memory");
        {
            const size_t g = (size_t)(tok0s[cin] + (jn - NLEFT) * CHUNK + lrow) * 512 + hpn * 256 + c16 * 8;
#pragma unroll
            for (int i = 0; i < 4; ++i) { kn[i] = *(const u32x4*)(Kb + g + (size_t)i * 16 * 512); vn[i] = *(const u32x4*)(Vb + g + (size_t)i * 16 * 512); }
        }
        asm volatile("" ::: "memory");
        const LAS unsigned char* buf = F.lds + (t & 1) * AT_BUF;
        const bool first = (j == j0s[ci]);
        const float negm = first ? 0.f : -m;
        f32x16 p0, p1;
#pragma unroll
        for (int r = 0; r < 16; ++r) { p0[r] = negm; p1[r] = negm; }
#pragma unroll
        for (int sI = 0; sI < 4; ++sI) { const bf16x8 k0 = *(const LAS bf16x8*)(buf + ko[sI]), k1 = *(const LAS bf16x8*)(buf + ko[sI] + 4096);
            p0 = __builtin_amdgcn_mfma_f32_32x32x16_bf16(k0, qf[sI], p0, 0, 0, 0); p1 = __builtin_amdgcn_mfma_f32_32x32x16_bf16(k1, qf[sI], p1, 0, 0, 0); }
        if (j >= 6) {
            const LAS float* bt = (const LAS float*)(F.lds + AT_BT + h * 1088);
            const int base = 640 + qi - 64 * j - 4 * hi;
#pragma unroll
            for (int r = 0; r < 16; ++r) { const int kk = (r & 3) + 8 * (r >> 2); int i0 = base - kk, i1 = base - 32 - kk; i0 = i0 > 256 ? 256 : i0; i1 = i1 > 256 ? 256 : i1; p0[r] += bt[i0]; p1[r] += bt[i1]; }
        }
        float tm = fmaxf(p0[0], p1[0]);
#pragma unroll
        for (int r = 1; r < 16; ++r) tm = fmaxf(tm, fmaxf(p0[r], p1[r]));
        { const auto rr = __builtin_amdgcn_permlane32_swap(__float_as_uint(tm), __float_as_uint(tm), false, false); tm = fmaxf(__uint_as_float(rr[0]), __uint_as_float(rr[1])); }
        if (first) {
            m = tm;
#pragma unroll
            for (int r = 0; r < 16; ++r) { p0[r] -= tm; p1[r] -= tm; }
        } else if (__any(tm > 0.f)) {
            const float dlt = fmaxf(tm, 0.f), alpha = __builtin_amdgcn_exp2f(-dlt); m += dlt; l *= alpha;
#pragma unroll
            for (int r = 0; r < 16; ++r) { p0[r] -= dlt; p1[r] -= dlt; o0[r] *= alpha; o1[r] *= alpha; }
        }
        float ps = 0.f;
#pragma unroll
        for (int r = 0; r < 16; ++r) { p0[r] = __builtin_amdgcn_exp2f(p0[r]); p1[r] = __builtin_amdgcn_exp2f(p1[r]); ps += p0[r] + p1[r]; }
        l += ps;
        bf16x8 pb[2][2];
#pragma unroll
        for (int sI = 0; sI < 2; ++sI) {
            u32x4 w0; w0.x = cvtpk(p0[8 * sI], p0[8 * sI + 1]); w0.y = cvtpk(p0[8 * sI + 2], p0[8 * sI + 3]); w0.z = cvtpk(p0[8 * sI + 4], p0[8 * sI + 5]); w0.w = cvtpk(p0[8 * sI + 6], p0[8 * sI + 7]);
            u32x4 w1; w1.x = cvtpk(p1[8 * sI], p1[8 * sI + 1]); w1.y = cvtpk(p1[8 * sI + 2], p1[8 * sI + 3]); w1.z = cvtpk(p1[8 * sI + 4], p1[8 * sI + 5]); w1.w = cvtpk(p1[8 * sI + 6], p1[8 * sI + 7]);
            pb[0][sI] = __builtin_bit_cast(bf16x8, w0); pb[1][sI] = __builtin_bit_cast(bf16x8, w1); }
#pragma unroll
        for (int blk = 0; blk < 2; ++blk)
#pragma unroll
            for (int sI = 0; sI < 2; ++sI) {
                const int kof = (32 * blk + 16 * sI) * 128;
                const s16x4 l0 = vtr(buf + vr0 + kof), h0 = vtr(buf + vr0 + kof + 1024), l1 = vtr(buf + vr1 + kof), h1 = vtr(buf + vr1 + kof + 1024);
                const bf16x8 A0 = {l0[0], l0[1], l0[2], l0[3], h0[0], h0[1], h0[2], h0[3]}, A1 = {l1[0], l1[1], l1[2], l1[3], h1[0], h1[1], h1[2], h1[3]};
                o0 = __builtin_amdgcn_mfma_f32_32x32x16_bf16(A0, pb[blk][sI], o0, 0, 0, 0);
                o1 = __builtin_amdgcn_mfma_f32_32x32x16_bf16(A1, pb[blk][sI], o1, 0, 0, 0);
            }
        if (j == 8) {
            float lt = l; { const auto rr = __builtin_amdgcn_permlane32_swap(__float_as_uint(lt), __float_as_uint(lt), false, false); lt = __uint_as_float(rr[0]) + __uint_as_float(rr[1]); }
            const float inv = __builtin_amdgcn_rcpf(lt);
            bf16* op = YAB + (size_t)qtok * 1024 + h * 64 + 4 * hi;
#pragma unroll
            for (int gg = 0; gg < 4; ++gg) {
                u32x2 w0, w1;
                w0.x = cvtpk(o0[4 * gg] * inv, o0[4 * gg + 1] * inv); w0.y = cvtpk(o0[4 * gg + 2] * inv, o0[4 * gg + 3] * inv);
                w1.x = cvtpk(o1[4 * gg] * inv, o1[4 * gg + 1] * inv); w1.y = cvtpk(o1[4 * gg + 2] * inv, o1[4 * gg + 3] * inv);
                *(u32x2*)(op + 8 * gg) = w0; *(u32x2*)(op + 32 + 8 * gg) = w1; }
        }
        {
            LAS unsigned char* nb = F.lds + ((t + 1) & 1) * AT_BUF;
#pragma unroll
            for (int i = 0; i < 4; ++i) { *(LAS u32x4*)(nb + kwoff + i * 2048) = kn[i]; *(LAS u32x4*)(nb + vwoff + i * 2048) = vn[i]; }
        }
        __syncthreads();
    }
#undef AT_DECODE
}
__device__ __forceinline__ void phaseD(const Frame& F, const Args& a) {
    for (int unit = F.vcu; unit < NB * (SEQ / SGB); unit += F.G) sgu_unit(F, a, unit / (SEQ / SGB), unit % (SEQ / SGB));
    for (int i = F.tid; i < NHEAD * NREL; i += NWAVES * 64) { const int h = i / NREL, k = i % NREL; ((LAS float*)(F.lds + AT_BT + h * 1088))[k] = (a.in[7][i] - a.in[7][h * NREL + 256]) * LOG2E; }
    __syncthreads();
    const int NCH = NB * (SEQ / CHUNK);
    for (int v = F.vcu; v < NCH / 2; v += F.G) attn_chunks(F, a, v, NCH - 1 - v);
}

constexpr int G_HT_STRIDE = 2064;
__device__ __forceinline__ void phaseG(const Frame& F, const Args& a) {
    const float* x = a.in[0]; const bf16* Y1 = (const bf16*)(a.ws + WS_Y1); const float* mod = (const float*)(a.ws + WS_MOD); const float* g_post_mix = a.in[5]; const float* g_pre_ffn = a.in[17];
    const float* b_router = a.in[20]; bf16* X1b = (bf16*)(a.ws + WS_X1B); unsigned char* XN8 = a.ws + WS_XN;
    const bf16* wrt = (const bf16*)(a.ws + WS_WRT);
    float* topg = (float*)(a.ws + WS_TOPG); int* list = (int*)(a.ws + WS_LIST); unsigned* cnt = F.ctl + CW_CNT;
    LAS unsigned char* HT = F.lds;
    LAS float* PL = (LAS float*)(F.lds + 33792);
    LAS float* LG = PL + 8 * 16 * 32;
    LAS float* TV = LG + 512;
    LAS unsigned* LC = (LAS unsigned*)(TV + 64);
    LAS unsigned* AS = LC + 64;
    const int tid = F.tid, lane = F.lane, wave = F.wave, kq = lane >> 4, i16 = lane & 15;
    if (tid < 64) LC[tid] = 0u;
    bf16x8 whi[2][4], wlo[2][4];
#pragma unroll
    for (int et = 0; et < 2; ++et)
#pragma unroll
        for (int ks = 0; ks < 4; ++ks) { const size_t o = (size_t)(et * 16 + i16) * D + 128 * wave + 32 * ks + 8 * kq; whi[et][ks] = *(const bf16x8*)(wrt + o); wlo[et][ks] = *(const bf16x8*)(wrt + (size_t)NEXP * D + o); }
    const int myrow = tid >> 5, mye = lane & 31;
    const float mybias = b_router[mye];
    __syncthreads();
    const int NT = NTOK / 16;
    f32x4 xv[2][4]; u32x2 yr[2][4];
    {   const int rbase = 16 * F.vcu + 2 * wave;
#pragma unroll
        for (int rr = 0; rr < 2; ++rr)
#pragma unroll
            for (int j = 0; j < 4; ++j) { const int c0 = (lane + 64 * j) * 4; xv[rr][j] = __builtin_nontemporal_load((const f32x4*)(x + (size_t)(rbase + rr) * D + c0)); yr[rr][j] = __builtin_nontemporal_load((const u32x2*)(Y1 + (size_t)(rbase + rr) * D + c0)); } }
    int tl = 0;
    f32x4 cgp[4], cgf[4], cgt[4], csc[4], csh[4]; int cb = -1;
#pragma unroll
    for (int j = 0; j < 4; ++j) { const int c0 = (lane + 64 * j) * 4; cgp[j] = *(const f32x4*)(g_post_mix + c0); cgf[j] = *(const f32x4*)(g_pre_ffn + c0); }
#pragma unroll 1
    for (int T = F.vcu; T < NT; T += F.G, ++tl) {
        const int b = (16 * T) / SEQ; const float* mb = mod + b * 6144; const int rbase = 16 * T + 2 * wave;
        if (b != cb) { cb = b;
#pragma unroll
            for (int j = 0; j < 4; ++j) { const int c0 = (lane + 64 * j) * 4; cgt[j] = *(const f32x4*)(mb + GT1 + c0); csc[j] = *(const f32x4*)(mb + SC2 + c0) + 1.0f; csh[j] = *(const f32x4*)(mb + SH2 + c0); } }
#pragma unroll
        for (int rr = 0; rr < 2; ++rr) {
            const int row = rbase + rr; f32x4 yv[4]; float ss = 0.f;
#pragma unroll
            for (int j = 0; j < 4; ++j) { yv[j] = (f32x4){bflo(yr[rr][j].x), bfhi(yr[rr][j].x), bflo(yr[rr][j].y), bfhi(yr[rr][j].y)}; ss += (yv[j][0] * yv[j][0] + yv[j][1] * yv[j][1]) + (yv[j][2] * yv[j][2] + yv[j][3] * yv[j][3]); }
            const float rstd = rsqrtf(wsum(ss) * (1.0f / D) + EPS); float s2 = 0.f;
#pragma unroll
            for (int j = 0; j < 4; ++j) { const int c0 = (lane + 64 * j) * 4;
                xv[rr][j] = xv[rr][j] + cgt[j] * (yv[j] * rstd * cgp[j]);
                { u32x2 w1; w1.x = cvtpk(xv[rr][j][0], xv[rr][j][1]); w1.y = cvtpk(xv[rr][j][2], xv[rr][j][3]); __builtin_nontemporal_store(w1, (u32x2*)(X1b + (size_t)row * D + c0)); }
                s2 += (xv[rr][j][0] * xv[rr][j][0] + xv[rr][j][1] * xv[rr][j][1]) + (xv[rr][j][2] * xv[rr][j][2] + xv[rr][j][3] * xv[rr][j][3]); }
            const float rstd2 = rsqrtf(wsum(s2) * (1.0f / D) + EPS);
#pragma unroll
            for (int j = 0; j < 4; ++j) { const int c0 = (lane + 64 * j) * 4;
                const f32x4 h = xv[rr][j] * rstd2 * cgf[j] * csc[j] + csh[j];
                u32x2 w; w.x = cvtpk(h[0], h[1]); w.y = cvtpk(h[2], h[3]); *(unsigned*)(XN8 + (size_t)row * D + c0) = pk_fp8x4(h[0] * F8_ASCALE, h[1] * F8_ASCALE, h[2] * F8_ASCALE, h[3] * F8_ASCALE);
                *(LAS u32x2*)(HT + (2 * wave + rr) * G_HT_STRIDE + c0 * 2) = w; }
        }
        {
            const int Tn = (T + F.G < NT) ? T + F.G : T; const int rb2 = 16 * Tn + 2 * wave;
#pragma unroll
            for (int rr = 0; rr < 2; ++rr)
#pragma unroll
                for (int j = 0; j < 4; ++j) { const int c0 = (lane + 64 * j) * 4; xv[rr][j] = __builtin_nontemporal_load((const f32x4*)(x + (size_t)(rb2 + rr) * D + c0)); yr[rr][j] = __builtin_nontemporal_load((const u32x2*)(Y1 + (size_t)(rb2 + rr) * D + c0)); }
        }
        LDS_WAIT(); __builtin_amdgcn_s_barrier(); asm volatile("" ::: "memory");
        {
            f32x4 acc0 = {0.f, 0.f, 0.f, 0.f}, acc1 = {0.f, 0.f, 0.f, 0.f};
#pragma unroll
            for (int ks = 0; ks < 4; ++ks) { const bf16x8 hb = *(const LAS bf16x8*)(HT + i16 * G_HT_STRIDE + (128 * wave + 32 * ks + 8 * kq) * 2);
                acc0 = __builtin_amdgcn_mfma_f32_16x16x32_bf16(whi[0][ks], hb, acc0, 0, 0, 0); acc0 = __builtin_amdgcn_mfma_f32_16x16x32_bf16(wlo[0][ks], hb, acc0, 0, 0, 0);
                acc1 = __builtin_amdgcn_mfma_f32_16x16x32_bf16(whi[1][ks], hb, acc1, 0, 0, 0); acc1 = __builtin_amdgcn_mfma_f32_16x16x32_bf16(wlo[1][ks], hb, acc1, 0, 0, 0); }
            *(LAS f32x4*)(PL + (wave * 16 + i16) * 32 + 4 * kq) = acc0; *(LAS f32x4*)(PL + (wave * 16 + i16) * 32 + 16 + 4 * kq) = acc1;
        }
        LDS_WAIT(); __builtin_amdgcn_s_barrier(); asm volatile("" ::: "memory");
        float lg = mybias;
#pragma unroll
        for (int w = 0; w < 8; ++w) lg += PL[(w * 16 + myrow) * 32 + mye];
        LG[myrow * 32 + mye] = lg;
        LDS_WAIT(); asm volatile("" ::: "memory");
        int rank = 0;
#pragma unroll
        for (int q = 0; q < 8; ++q) { const f32x4 o = *(const LAS f32x4*)(LG + myrow * 32 + 4 * q);
#pragma unroll
            for (int i = 0; i < 4; ++i) { const int e2 = 4 * q + i; rank += (o[i] > lg || (o[i] == lg && e2 < mye)) ? 1 : 0; } }
        if (rank < 4) TV[myrow * 4 + rank] = lg;
        LDS_WAIT(); asm volatile("" ::: "memory");
        const f32x4 tv = *(const LAS f32x4*)(TV + myrow * 4);
        if (rank < 4) {
            const float den = 1.0f + __expf(tv[1] - tv[0]) + __expf(tv[2] - tv[0]) + __expf(tv[3] - tv[0]);
            const int slot = (16 * T + myrow) * 4 + rank; topg[slot] = __expf(lg - tv[0]) / den;
            const unsigned lp = __hip_atomic_fetch_add(LC + mye, 1u, __ATOMIC_RELAXED, __HIP_MEMORY_SCOPE_WORKGROUP);
            if (tl < 16) AS[tl * 64 + myrow * 4 + rank] = (unsigned)mye | (lp << 8);
        }
    }
    __syncthreads();
    if (tid < NEXP) LC[32 + tid] = atomicAdd(&cnt[tid], LC[tid]);
    __syncthreads();
    for (int i = tid; i < tl * 64; i += NWAVES * 64) { const unsigned as = AS[i]; const int e = as & 255, lp = as >> 8; const int T = F.vcu + (i >> 6) * F.G;
        list[(size_t)e * NTOK + LC[32 + e] + lp] = (16 * T + ((i & 63) >> 2)) * 4 + (i & 3); }
}
__device__ __forceinline__ int moe_tables(const Frame& F) {
    __syncthreads();
    if (F.tid < NEXP) F.MISC[40 + F.tid] = __hip_atomic_load(F.ctl + CW_CNT + F.tid, __ATOMIC_RELAXED, __HIP_MEMORY_SCOPE_AGENT);
    __syncthreads();
    if (F.tid == 0) { unsigned s = 0; for (int e = 0; e < NEXP; ++e) { F.MISC[e] = s; s += (F.MISC[40 + e] + 255u) >> 8; } F.MISC[32] = s; }
    __syncthreads();
    return (int)F.MISC[32];
}
__device__ __forceinline__ void phaseJ(const Frame& F, const Args& a) {
    const unsigned char* Y2s = a.ws + WS_Y2; const bf16* X1b = (const bf16*)(a.ws + WS_X1B); const float* mod = (const float*)(a.ws + WS_MOD); const float* gpf = a.in[18]; float* out = a.out;
    const int* inv = (const int*)(a.ws + WS_TOPE); const float* topg = (const float*)(a.ws + WS_TOPG);
    const int lane = F.lane, gw = F.vcu * NWAVES + F.wave, NGW = F.G * NWAVES;
    f32x4 cgg[4]; int cb = -1;
    for (int row0 = gw * 4; row0 < NTOK; row0 += NGW * 4) {
        const int b = row0 / SEQ; const float* mb = mod + b * 6144;
        if (b != cb) { cb = b;
#pragma unroll
            for (int j = 0; j < 4; ++j) { const int c0 = (lane + 64 * j) * 4; cgg[j] = *(const f32x4*)(gpf + c0) * *(const f32x4*)(mb + GT2 + c0); } }
        int pp[4][4]; float gg[4][4];
#pragma unroll
        for (int rr = 0; rr < 4; ++rr)
#pragma unroll
            for (int k = 0; k < 4; ++k) { pp[rr][k] = __builtin_amdgcn_readfirstlane(inv[(row0 + rr) * 4 + k]); gg[rr][k] = topg[(row0 + rr) * 4 + k] * (1.0f / F8_YSCALE); }
        unsigned yy[4][4][4]; u32x2 xx[4][4];
#pragma unroll
        for (int rr = 0; rr < 4; ++rr)
#pragma unroll
            for (int j = 0; j < 4; ++j) { const int c0 = (lane + 64 * j) * 4;
#pragma unroll
                for (int k = 0; k < 4; ++k) yy[rr][j][k] = __builtin_nontemporal_load((const unsigned*)(Y2s + (size_t)pp[rr][k] * D + c0));
                xx[rr][j] = __builtin_nontemporal_load((const u32x2*)(X1b + (size_t)(row0 + rr) * D + c0)); }
#pragma unroll
        for (int rr = 0; rr < 4; ++rr) {
            f32x4 yv[4]; float ss = 0.f;
#pragma unroll
            for (int j = 0; j < 4; ++j) { f32x4 s = {0.f, 0.f, 0.f, 0.f};
#pragma unroll
                for (int k = 0; k < 4; ++k) { const f32x2 lo = __builtin_amdgcn_cvt_pk_f32_fp8((int)yy[rr][j][k], false), hi = __builtin_amdgcn_cvt_pk_f32_fp8((int)yy[rr][j][k], true);
                    s += (f32x4){lo.x, lo.y, hi.x, hi.y} * gg[rr][k]; }
                yv[j] = s; ss += (s[0] * s[0] + s[1] * s[1]) + (s[2] * s[2] + s[3] * s[3]); }
            const float rstd = rsqrtf(wsum(ss) * (1.0f / D) + EPS);
#pragma unroll
            for (int j = 0; j < 4; ++j) { const int c0 = (lane + 64 * j) * 4;
                const f32x4 x1 = {bflo(xx[rr][j].x), bfhi(xx[rr][j].x), bflo(xx[rr][j].y), bfhi(xx[rr][j].y)};
                __builtin_nontemporal_store(x1 + cgg[j] * (yv[j] * rstd), (f32x4*)(out + (size_t)(row0 + rr) * D + c0)); }
        }
    }
}

constexpr int N_PHASES = 10;
__global__ void __launch_bounds__(NWAVES * 64, 2) mega_fwd(Args args) {
    extern __shared__ __attribute__((aligned(16))) unsigned char lds_raw[];
    Frame F;
    F.lds = (LAS unsigned char*)lds_raw; F.MISC = (volatile LAS unsigned*)(F.lds + MISC_OFF);
    F.tid = threadIdx.x; F.lane = F.tid & 63; F.wave = __builtin_amdgcn_readfirstlane(F.tid >> 6);
    F.G = gridDim.x; { const int bx = blockIdx.x; F.vcu = (F.G % 8 == 0) ? (bx % 8) * (F.G / 8) + bx / 8 : bx; }
    F.ctl = (unsigned*)(args.ws + WS_CTL);
    for (int u = F.tid; u < 128; u += NWAVES * 64) F.MISC[u] = 0u;
    __syncthreads();
    const int lo = args.ph_lo, hi = args.ph_hi;
    XcdBarrier bar; bar.bar = F.ctl + CW_BAR; bar.x = 0; bar.st = F.MISC + 80;
    if (hi - lo > 1) bar = xcd_barrier_post(F.ctl + CW_BAR, F.MISC + 80);
#define IN(k) (lo <= (k) && (k) < hi)
#define SEAM(k) do { if (IN(k) && IN((k) + 1)) xcd_barrier(bar); } while (0)
    unsigned char* ws = args.ws;
    bf16 *XN = (bf16*)(ws + WS_XN), *Qb = (bf16*)(ws + WS_Q), *Kb = (bf16*)(ws + WS_K), *Vb = (bf16*)(ws + WS_V), *Ub = (bf16*)(ws + WS_U), *VG = (bf16*)(ws + WS_VG);
    bf16 *GT = (bf16*)(ws + WS_GT), *YAB = (bf16*)(ws + WS_YAB), *MRG = (bf16*)(ws + WS_MRG), *Y1 = (bf16*)(ws + WS_Y1), *ACT = (bf16*)(ws + WS_ACT), *Y2 = (bf16*)(ws + WS_Y2);

    if (IN(0)) { phaseA(F, args); } SEAM(0);
    if (IN(1)) { phaseB(F, args); } SEAM(1);
    if (IN(2)) {
        SchedStatic S{(const char*)XN, (const char*)(ws + WS_W1T), NTOK / 256, 4608 / 256, F.G, (int)blockIdx.x, (size_t)256 * 1024 * 2, (size_t)256 * 1024 * 2};
        EpiG1 E{Qb, Kb, Vb, Ub, VG, GT, args.in[15]};
        pg8::gemm_phase<EpiG1, SchedStatic, false>(F.lds + RING_OFF, S, E, 2048, 2048, 16);
    } SEAM(2);
    if (IN(3)) { phaseD(F, args); } SEAM(3);
    if (IN(4)) {
        SchedSplit2 S{(const char*)YAB, (const char*)(ws + WS_WBRT), NTOK / 256, 4, F.G, (int)blockIdx.x, (size_t)256 * 1024 * 2, (size_t)256 * 1024 * 2, (size_t)512 * 2};
        EpiG2 E{GT, MRG};
        pg8::gemm_phase<EpiG2, SchedSplit2, false>(F.lds + RING_OFF, S, E, 2048, 2048, 8);
    } SEAM(4);
    if (IN(5)) {
        SchedStatic S{(const char*)MRG, (const char*)(ws + WS_WOUTT), NTOK / 256, 4, F.G, (int)blockIdx.x, (size_t)256 * 1024 * 2, (size_t)256 * 1024 * 2};
        EpiPlain E{Y1};
        pg8::gemm_phase<EpiPlain, SchedStatic, false>(F.lds + RING_OFF, S, E, 2048, 2048, 16);
    } SEAM(5);
    if (IN(6)) { phaseG(F, args); } SEAM(6);
    if (IN(7)) {
        const int nrb = moe_tables(F);
        const int* list = (const int*)(ws + WS_LIST);
        {
            int* inv = (int*)(ws + WS_TOPE);
            for (int g = (int)blockIdx.x * (NWAVES * 64) + F.tid; g < NTOK * TOPK; g += F.G * NWAVES * 64) {
                int e = 0, base = 0;
#pragma unroll 1
                for (int i = 0; i < NEXP; ++i) { const int c = (int)F.MISC[40 + i]; if (g >= base + c) { base += c; e = i + 1; } else break; }
                const int pos = g - base; if (e < NEXP) inv[list[(size_t)e * NTOK + pos]] = (int)F.MISC[e] * 256 + pos; }
        }
        typedef SchedMoe<8, true> SM;
        SM S{(const char*)XN, (const char*)(ws + WS_WGUT), F.MISC, (const LAS unsigned*)(F.lds + GTAB_OFF), (int)blockIdx.x, F.G, nrb, (size_t)2048 * 1024, (size_t)256 * 1024};
        S.build(F.tid);
        { Unit u; LAS unsigned* gt = (LAS unsigned*)(F.lds + GTAB_OFF);
          for (int k = 0; k < GTAB_UNITS && S.next(k, u); ++k) { const int e = u.aux, j256 = (u.pm - (int)F.MISC[e]) * 256, ecnt = (int)F.MISC[40 + e];
              for (int r = F.tid; r < 256; r += NWAVES * 64) { const int pos = j256 + r; int tok = 0; if (pos < ecnt) tok = list[(size_t)e * NTOK + pos] >> 2; gt[k * 256 + r] = (unsigned)tok * 1024u; } } }
        __syncthreads();
        EpiAct E{args.in[22], (unsigned char*)ACT};
        pg8::gemm_phase<EpiAct, SM, true>(F.lds + RING_OFF, S, E, 1024, 1024, 8);
    } SEAM(7);
    if (IN(8)) {
        const int nrb = moe_tables(F);
        typedef SchedMoe<4, true> SM;
        SM S{(const char*)ACT, (const char*)(ws + WS_WDNT), F.MISC, (const LAS unsigned*)(F.lds + GTAB_OFF), (int)blockIdx.x, F.G, nrb, (size_t)1024 * 1024, (size_t)256 * 1024};
        S.build(F.tid);
        { Unit u; LAS unsigned* gt = (LAS unsigned*)(F.lds + GTAB_OFF);
          for (int k = 0; k < GTAB_UNITS && S.next(k, u); ++k) for (int r = F.tid; r < 256; r += NWAVES * 64) gt[k * 256 + r] = (unsigned)(u.pm * 256 + r) * 1024u; }
        __syncthreads();
        EpiDown E{args.in[24], (unsigned char*)Y2};
        pg8::gemm_phase<EpiDown, SM, true>(F.lds + RING_OFF, S, E, 1024, 1024, 8);
    } SEAM(8);
    if (IN(9)) { phaseJ(F, args); }
#undef IN
#undef SEAM
}
extern "C" void kernel_launch(void* const* d_in, const int* in_sizes, int n_in, void* d_out, int out_size, void* d_ws, size_t ws_size, hipStream_t stream) {
    if (n_in != 25 || in_sizes[0] != NTOK * D || out_size != NTOK * D || ws_size < WS_END) { fprintf(stderr, "kernel_launch: unexpected shapes (n_in %d in0 %d out %d ws %zu)\n", n_in, n_in > 0 ? in_sizes[0] : -1, out_size, ws_size); return; }
    static int grid = 0;
    if (grid == 0) {
        int dev = 0, cus = 0, per_cu = 0;
        if (hipGetDevice(&dev) != hipSuccess || hipDeviceGetAttribute(&cus, hipDeviceAttributeMultiprocessorCount, dev) != hipSuccess) { fprintf(stderr, "kernel_launch: device query failed\n"); grid = -1; return; }
        if (hipFuncSetAttribute((const void*)mega_fwd, hipFuncAttributeMaxDynamicSharedMemorySize, LDS_BYTES) != hipSuccess) { fprintf(stderr, "kernel_launch: hipFuncSetAttribute failed\n"); grid = -1; return; }
        if (hipOccupancyMaxActiveBlocksPerMultiprocessor(&per_cu, (const void*)mega_fwd, NWAVES * 64, LDS_BYTES) != hipSuccess || per_cu < 1) { fprintf(stderr, "kernel_launch: occupancy query says %d\n", per_cu); }
        (void)hipGetLastError();
        grid = cus;
    }
    if (grid < 0) return;
    if (hipMemsetAsync((unsigned char*)d_ws + WS_CTL, 0, CTL_ZERO_BYTES, stream) != hipSuccess) { fprintf(stderr, "kernel_launch: memset failed\n"); return; }
    Args a{};
    for (int i = 0; i < 25; ++i) a.in[i] = (const float*)d_in[i];
    a.out = (float*)d_out; a.ws = (unsigned char*)d_ws; a.ph_lo = 0; a.ph_hi = N_PHASES;
    hipLaunchKernelGGL(mega_fwd, dim3(grid), dim3(NWAVES * 64), LDS_BYTES, stream, a);
    if (hipPeekAtLastError() != hipSuccess) fprintf(stderr, "kernel_launch: launch failed\n");
}
```

```cpp
#include <hip/hip_runtime.h>
#include <cstdio>
#include <cstdint>

constexpr int NB = 4, SEQ = 8192, D = 1024, NTOK = NB * SEQ;
constexpr int NHEAD = 8, CHUNK = 64, NLEFT = 8, NREL = 257;
constexpr int SGB = 128;
constexpr int INW = 2560, NEXP = 32, TOPK = 4;
constexpr float EPS = 1e-6f, SWL = 7.0f, SWA = 1.702f;
constexpr float LOG2E = 1.4426950408889634f;
constexpr float QSCALE = 0.125f * LOG2E;
constexpr int SH1 = 0, SC1 = 1024, GT1 = 2048, SH2 = 3072, SC2 = 4096, GT2 = 5120;
typedef unsigned short bf16;

constexpr size_t MiB = 1u << 20;
constexpr size_t WS_CTL = 0, CTL_ZERO_BYTES = 64 * 1024;
constexpr size_t WS_MOD = 1 * MiB;
constexpr size_t WS_W1T = 2 * MiB, WS_WBRT = 12 * MiB, WS_WOUTT = 14 * MiB, WS_WRT = 16 * MiB;
constexpr size_t WS_TOPE = 17 * MiB, WS_TOPG = 18 * MiB, WS_LIST = 19 * MiB;
constexpr size_t WS_WGUT = 32 * MiB, WS_WDNT = 160 * MiB;
constexpr size_t WS_XN = 224 * MiB;
constexpr size_t WS_Q = 288 * MiB, WS_K = 320 * MiB, WS_V = 352 * MiB, WS_U = 384 * MiB, WS_VG = 416 * MiB;
constexpr size_t WS_GT = 448 * MiB;
constexpr size_t WS_YAB = 576 * MiB, WS_MRG = 640 * MiB, WS_Y1 = 704 * MiB;
constexpr size_t WS_ACT = 288 * MiB;
constexpr size_t WS_Y2 = 576 * MiB;
constexpr size_t WS_END = 960 * MiB;
constexpr int CW_CNT = 1024;

#define LAS __attribute__((address_space(3)))
#define GAS __attribute__((address_space(1)))
typedef short bf16x8 __attribute__((ext_vector_type(8)));
typedef short s16x4 __attribute__((ext_vector_type(4)));
typedef float f32x4 __attribute__((ext_vector_type(4)));
typedef float f32x2 __attribute__((ext_vector_type(2)));
typedef float f32x16 __attribute__((ext_vector_type(16)));
typedef unsigned u32x4 __attribute__((ext_vector_type(4)));
typedef unsigned u32x2 __attribute__((ext_vector_type(2)));
typedef __bf16 bf16x2_t __attribute__((ext_vector_type(2)));
constexpr int NWAVES = 8;
constexpr int TRASH_SLOT = NTOK * 4;

__device__ __forceinline__ unsigned cvtpk(float lo, float hi) { f32x2 v = {lo, hi}; bf16x2_t b = __builtin_convertvector(v, bf16x2_t); return __builtin_bit_cast(unsigned, b); }
__device__ __forceinline__ float wsum(float v) {
    v += __builtin_bit_cast(float, __builtin_amdgcn_update_dpp(0, __builtin_bit_cast(int, v), 0xB1, 0xF, 0xF, true));
    v += __builtin_bit_cast(float, __builtin_amdgcn_update_dpp(0, __builtin_bit_cast(int, v), 0x4E, 0xF, 0xF, true));
    v += __builtin_bit_cast(float, __builtin_amdgcn_update_dpp(0, __builtin_bit_cast(int, v), 0x124, 0xF, 0xF, true));
    v += __builtin_bit_cast(float, __builtin_amdgcn_update_dpp(0, __builtin_bit_cast(int, v), 0x128, 0xF, 0xF, true));
    const int iv = __builtin_bit_cast(int, v);
    const float s0 = __builtin_bit_cast(float, __builtin_amdgcn_readlane(iv, 0)), s1 = __builtin_bit_cast(float, __builtin_amdgcn_readlane(iv, 16));
    const float s2 = __builtin_bit_cast(float, __builtin_amdgcn_readlane(iv, 32)), s3 = __builtin_bit_cast(float, __builtin_amdgcn_readlane(iv, 48));
    return (s0 + s1) + (s2 + s3);
}
__device__ __forceinline__ float clamp8(float v) { return fminf(fmaxf(v, -448.0f), 448.0f); }
__device__ __forceinline__ unsigned pk_fp8x4(float a, float b, float c, float d) {
    int w = 0; w = __builtin_amdgcn_cvt_pk_fp8_f32(clamp8(a), clamp8(b), w, false); w = __builtin_amdgcn_cvt_pk_fp8_f32(clamp8(c), clamp8(d), w, true); return (unsigned)w; }
__device__ __forceinline__ unsigned pk_fp8x4_nc(float a, float b, float c, float d) {
    int w = 0; w = __builtin_amdgcn_cvt_pk_fp8_f32(a, b, w, false); w = __builtin_amdgcn_cvt_pk_fp8_f32(c, d, w, true); return (unsigned)w; }
constexpr float F8_YSCALE = 16.0f;
constexpr size_t WS_X1B = 768 * MiB;
constexpr float F8_WSCALE = 64.0f, F8_ASCALE = 4.0f, F8_DESCALE = 1.0f / (64.0f * 4.0f);
__device__ __forceinline__ float bflo(unsigned w) { return __uint_as_float(w << 16); }
__device__ __forceinline__ float bfhi(unsigned w) { return __uint_as_float(w & 0xffff0000u); }
__device__ __forceinline__ float fast_sigmoid(float x) { return __builtin_amdgcn_rcpf(1.0f + __builtin_amdgcn_exp2f(-LOG2E * x)); }
__device__ __forceinline__ f32x2 sigmoid_pk(f32x2 v) { const f32x2 t = v * (-LOG2E); f32x2 e; e.x = __builtin_amdgcn_exp2f(t.x); e.y = __builtin_amdgcn_exp2f(t.y); const f32x2 d = e + 1.0f; f32x2 r; r.x = __builtin_amdgcn_rcpf(d.x); r.y = __builtin_amdgcn_rcpf(d.y); return r; }
__device__ __forceinline__ f32x2 gelu_pk(f32x2 v) {
    const f32x2 av = __builtin_elementwise_abs(v), d = av * 0.2316418882f + 1.0f;
    f32x2 t; t.x = __builtin_amdgcn_rcpf(d.x); t.y = __builtin_amdgcn_rcpf(d.y);
    f32x2 q = t * 0.5307027145f + (-0.7265760135f); q = q * t + 0.7107068705f; q = q * t + (-0.142248368f); q = q * t + 0.127414796f; q = q * t;
    const f32x2 s = (v * v) * (-0.72134752044f);
    f32x2 e; e.x = __builtin_amdgcn_exp2f(s.x); e.y = __builtin_amdgcn_exp2f(s.y);
    const f32x2 m = v * (q * e), r = v - m;
    f32x2 o; o.x = v.x < 0.f ? m.x : r.x; o.y = v.y < 0.f ? m.y : r.y; return o;
}

constexpr int RING_OFF = 0, RING_BYTES = 131072;
constexpr int GTAB_OFF = RING_BYTES, GTAB_UNITS = 20, GTAB_BYTES = GTAB_UNITS * 256 * 4;
constexpr int MISC_OFF = GTAB_OFF + GTAB_BYTES;
constexpr int LDS_BYTES = MISC_OFF + 512;
static_assert(LDS_BYTES <= 160 * 1024, "LDS map");

#define XB_TMO      128
#define XB_XCNT(j)  (256  + 64 * (j))
#define XB_XSUB(j)  (1280 + 64 * (j))
#define XB_XGEN(j)  (2304 + 64 * (j))
#define XB_TOP      3328
#define XB_TOPGEN   3392
#define XCD_BAR_WORDS 3456
#define XB_SPIN_CAP (1u << 18)
__device__ __forceinline__ unsigned xb_ld(unsigned* p)              { return __hip_atomic_load(p, __ATOMIC_RELAXED, __HIP_MEMORY_SCOPE_AGENT); }
__device__ __forceinline__ unsigned xb_add(unsigned* p, unsigned v) { return __hip_atomic_fetch_add(p, v, __ATOMIC_RELAXED, __HIP_MEMORY_SCOPE_AGENT); }
__device__ __forceinline__ unsigned xb_xcc_id() { return (unsigned)__builtin_amdgcn_s_getreg((3 << 11) | 20) & 0xFu; }
#define XB_SPIN(cond, bar) do { unsigned _sp = 0; while (cond) { __builtin_amdgcn_s_sleep(1); \
    if ((++_sp & 255u) == 0u) { if (xb_ld(&(bar)[XB_TMO])) break; if (_sp > XB_SPIN_CAP) { atomicAdd(&(bar)[XB_TMO], 1u); break; } } } } while (0)
struct XcdBarrier { unsigned* bar; unsigned x; volatile LAS unsigned* st; };
__device__ __forceinline__ XcdBarrier xcd_barrier_post(unsigned* bar, volatile LAS unsigned* st) {
    XcdBarrier b; b.bar = bar; b.x = xb_xcc_id(); b.st = st;
    if (threadIdx.x == 0) (void)xb_add(&bar[XB_XCNT(b.x)], 1u);
    return b;
}
__device__ __forceinline__ void xcd_barrier_complete(unsigned* bar, unsigned x, unsigned& nloc, unsigned& nx) {
    const unsigned G = gridDim.x * gridDim.y * gridDim.z;
    unsigned sum, cnt, mine, sp = 0u;
    for (;;) {
        sum = 0u; cnt = 0u; mine = 0u;
#pragma unroll
        for (unsigned j = 0; j < 16; ++j) { const unsigned c = xb_ld(&bar[XB_XCNT(j)]); sum += c; cnt += (c > 0u) ? 1u : 0u; mine = (j == x) ? c : mine; }
        if (sum == G) break;
        __builtin_amdgcn_s_sleep(1);
        if ((++sp & 255u) == 0u) { if (xb_ld(&bar[XB_TMO])) break; if (sp > XB_SPIN_CAP) { atomicAdd(&bar[XB_TMO], 1u); break; } }
    }
    nloc = mine > 0u ? mine : 1u; nx = cnt > 0u ? cnt : 1u;
}
__device__ __forceinline__ void xcd_barrier(const XcdBarrier& b) {
    asm volatile("s_waitcnt vmcnt(0)" ::: "memory");
    __syncthreads();
    if (threadIdx.x == 0) {
        unsigned* bar = b.bar;
        __builtin_amdgcn_s_waitcnt(0);
        unsigned nloc = b.st[0], nx = b.st[1];
        if (nloc == 0u) { xcd_barrier_complete(bar, b.x, nloc, nx); b.st[0] = nloc; b.st[1] = nx; }
        const unsigned old = xb_add(&bar[XB_XSUB(b.x)], 1u);
        const unsigned gen = old / nloc;
        if (old + 1u == (gen + 1u) * nloc) {
            __builtin_amdgcn_fence(__ATOMIC_RELEASE, "agent");
            asm volatile("s_waitcnt vmcnt(0)" ::: "memory");
            const unsigned og = xb_add(&bar[XB_TOP], 1u);
            const unsigned tg = og / nx;
            if (og + 1u == (tg + 1u) * nx) xb_add(&bar[XB_TOPGEN], 1u);
            else XB_SPIN(xb_ld(&bar[XB_TOPGEN]) == tg, bar);
            __builtin_amdgcn_fence(__ATOMIC_ACQUIRE, "agent");
            xb_add(&bar[XB_XGEN(b.x)], 1u);
            asm volatile("s_waitcnt vmcnt(0)" ::: "memory");
        } else {
            XB_SPIN(xb_ld(&bar[XB_XGEN(b.x)]) == gen, bar);
            __builtin_amdgcn_fence(__ATOMIC_ACQUIRE, "agent");
            asm volatile("s_waitcnt vmcnt(0)" ::: "memory");
        }
    }
    __syncthreads();
}
constexpr int CW_BAR = 4096;

namespace pg8 {
constexpr int BM = 256, BK = 64, HALF = 128, HTB = HALF * BK * 2, STAGE_BYTES = 8 * HTB, NXCD = 8, WGM = 8;
__host__ __device__ __forceinline__ int lds_byte(int r, int c) { return r * 128 + ((((c >> 3) ^ (r >> 1)) & 7) << 4); }
__host__ __device__ __forceinline__ void stage_rc(int b, int& R, int& C) { R = b >> 7; C = ((((b >> 4) ^ (R >> 1)) & 7) << 3); }
__host__ __device__ __forceinline__ int perm32(int rho) { const int n = rho >> 4, i = rho & 15; return 8 * (i >> 2) + 4 * n + (i & 3); }
struct Unit { int pm, pn, aux; };
typedef int v4i_t __attribute__((ext_vector_type(4)));
typedef int v8i_t __attribute__((ext_vector_type(8)));

__device__ __forceinline__ bool static_unit(int i, int G, int c, int nM, int nN, int& pm, int& pn) {
    const int nwg = nM * nN; const long L = (long)i * G + c; if (L >= nwg) return false;
    int wgid = (int)L; { const int q = nwg / NXCD, r = nwg % NXCD, xcd = wgid % NXCD, off = wgid / NXCD; wgid = (xcd < r ? xcd * (q + 1) : r * (q + 1) + (xcd - r) * q) + off; }
    const int nig = WGM * nN, gid = wgid / nig, fm = gid * WGM, gsz = (nM - fm) < WGM ? (nM - fm) : WGM;
    pm = fm + ((wgid % nig) % gsz); pn = (wgid % nig) / gsz; return true;
}

template <class Epi, class Sched, bool FP8>
__device__ __forceinline__ void gemm_phase(LAS unsigned char* lds, const Sched& S, const Epi& E, const int lda, const int ldb, const int nt) {
    const int tid = threadIdx.x, wid = __builtin_amdgcn_readfirstlane(tid >> 6), lane = tid & 63, wr = wid >> 2, wc = wid & 3, fr = lane & 15, fq = lane >> 4;
    int Rr[2], Cc[2]; unsigned voffB[2];
#pragma unroll
    for (int i = 0; i < 2; ++i) { stage_rc(tid * 16 + i * 8192, Rr[i], Cc[i]); const int Rb = (Rr[i] & ~31) + perm32(Rr[i] & 31); voffB[i] = (unsigned)(Rb * ldb + Cc[i] * 2); }
    const size_t kstep = (size_t)(BK * 2);
    const size_t hstepB = (size_t)HALF * ldb;
    const size_t hstepA = Sched::GATHER ? (size_t)0 : (size_t)HALF * lda;
    const unsigned ldsw = (unsigned)wid * 1024u;
    const int aoff = lds_byte(wr * 64 + fr, fq * 8), boff = lds_byte(wc * 32 + fr, fq * 8);
#define PG8_SA(b, h) (((b) * 2 + (h)) * HTB)
#define PG8_SB(b, h) ((4 + (b) * 2 + (h)) * HTB)
#define PG8_STAGE(bufoff, gbase, voff) do { _Pragma("unroll") for (int _i = 0; _i < 2; ++_i) \
        __builtin_amdgcn_global_load_lds((const unsigned*)((const char*)(gbase) + (voff)[_i]), (LAS unsigned*)(lds + (bufoff) + ldsw + _i * 8192), 16, 0, 0); } while (0)
#define PG8_LDA(dst, b, h) do { _Pragma("unroll") for (int m = 0; m < 4; ++m) _Pragma("unroll") for (int k = 0; k < 2; ++k) dst[m][k] = *(const LAS bf16x8*)(lds + PG8_SA(b, h) + (aoff ^ (k * 64)) + m * 2048); } while (0)
#define PG8_LDB(dst, b, h) do { _Pragma("unroll") for (int n = 0; n < 2; ++n) _Pragma("unroll") for (int k = 0; k < 2; ++k) dst[n][k] = *(const LAS bf16x8*)(lds + PG8_SB(b, h) + (boff ^ (k * 64)) + n * 2048); } while (0)
#define PG8_CAT(x) __builtin_shufflevector(__builtin_bit_cast(v4i_t, (x)[0]), __builtin_bit_cast(v4i_t, (x)[1]), 0, 1, 2, 3, 4, 5, 6, 7)
#define PG8_MMA(ai, bj, At, Bt) do { __builtin_amdgcn_s_setprio(1); if constexpr (FP8) { _Pragma("unroll") for (int m = 0; m < 4; ++m) _Pragma("unroll") for (int n = 0; n < 2; ++n) \
        acc[ai][bj][m][n] = __builtin_amdgcn_mfma_scale_f32_16x16x128_f8f6f4(PG8_CAT(Bt[n]), PG8_CAT(At[m]), acc[ai][bj][m][n], 0, 0, 0, 0x7F7F7F7F, 0, 0x7F7F7F7F); } \
    else { _Pragma("unroll") for (int m = 0; m < 4; ++m) _Pragma("unroll") for (int n = 0; n < 2; ++n) _Pragma("unroll") for (int k = 0; k < 2; ++k) \
        acc[ai][bj][m][n] = __builtin_amdgcn_mfma_f32_16x16x32_bf16(Bt[n][k], At[m][k], acc[ai][bj][m][n], 0, 0, 0); } __builtin_amdgcn_s_setprio(0); } while (0)
#define PG8_WAIT_V(n) asm volatile("s_waitcnt vmcnt(" #n ")" ::: "memory")
#define PG8_WAIT_L(n) asm volatile("s_waitcnt lgkmcnt(" #n ")" ::: "memory")
#define PG8_BAR __builtin_amdgcn_s_barrier()
#define PG8_SCHED __builtin_amdgcn_sched_barrier(0)
    Unit cur, nxt; int ui = 0;
    if (!S.next(0, cur)) return;
    f32x4 acc[2][2][4][2];
#pragma unroll
    for (int a = 0; a < 2; ++a)
#pragma unroll
        for (int b = 0; b < 2; ++b)
#pragma unroll
            for (int m = 0; m < 4; ++m)
#pragma unroll
                for (int n = 0; n < 2; ++n) acc[a][b][m][n] = (f32x4){0.f, 0.f, 0.f, 0.f};
    bf16x8 At[4][2], B0[2][2], B1[2][2];
    unsigned oA[2][2];
#pragma unroll
    for (int h = 0; h < 2; ++h)
#pragma unroll
        for (int i = 0; i < 2; ++i) oA[h][i] = Sched::GATHER ? (S.goff(0, h * HALF + Rr[i]) + (unsigned)Cc[i] * 2u) : (unsigned)(Rr[i] * lda + Cc[i] * 2);
    const char* cA = S.aptr(cur); const char* cB = S.bptr(cur);
    PG8_STAGE(PG8_SB(0, 0), cB, voffB); PG8_STAGE(PG8_SB(0, 1), cB + hstepB, voffB); PG8_STAGE(PG8_SA(0, 0), cA, oA[0]); PG8_STAGE(PG8_SA(0, 1), cA + hstepA, oA[1]);
    if (wr == 1) PG8_BAR;
    PG8_WAIT_V(2); PG8_BAR;
    PG8_STAGE(PG8_SB(1, 0), cB + kstep, voffB); PG8_STAGE(PG8_SA(1, 0), cA + kstep, oA[0]); PG8_STAGE(PG8_SB(1, 1), cB + hstepB + kstep, voffB);
    PG8_WAIT_V(6); PG8_BAR;
    for (;;) {
        const bool has_next = S.next(ui + 1, nxt);
        const char* nA = has_next ? S.aptr(nxt) : cA; const char* nB = has_next ? S.bptr(nxt) : cB;
#pragma clang loop unroll(disable)
        for (int t = 0; t < nt; t += 2) {
            const bool last = (t == nt - 2);
            const char* a1 = cA + (size_t)(t + 1) * kstep;
            const char* a2 = last ? nA : cA + (size_t)(t + 2) * kstep; const char* b2 = last ? nB : cB + (size_t)(t + 2) * kstep;
            const char* a3 = a2 + kstep; const char* b3 = b2 + kstep;
            PG8_LDB(B0, 0, 0); PG8_LDB(B1, 0, 1); PG8_SCHED; PG8_LDA(At, 0, 0); PG8_STAGE(PG8_SA(1, 1), a1 + hstepA, oA[1]);
            if constexpr (Sched::GATHER) { if (last && has_next) {
#pragma unroll
                for (int h = 0; h < 2; ++h)
#pragma unroll
                    for (int i = 0; i < 2; ++i) oA[h][i] = S.goff(ui + 1, h * HALF + Rr[i]) + (unsigned)Cc[i] * 2u; } }
            PG8_WAIT_V(8); PG8_WAIT_L(0); PG8_BAR; PG8_MMA(0, 0, At, B0); PG8_MMA(0, 1, At, B1); PG8_BAR; PG8_SCHED;
            PG8_LDA(At, 0, 1); PG8_STAGE(PG8_SB(0, 0), b2, voffB); PG8_STAGE(PG8_SB(0, 1), b2 + hstepB, voffB); PG8_STAGE(PG8_SA(0, 0), a2, oA[0]);
            PG8_WAIT_V(8); PG8_WAIT_L(0); PG8_BAR; PG8_MMA(1, 0, At, B0); PG8_MMA(1, 1, At, B1); PG8_BAR; PG8_SCHED;
            PG8_LDB(B0, 1, 0); PG8_LDB(B1, 1, 1); PG8_SCHED; PG8_LDA(At, 1, 0); PG8_STAGE(PG8_SA(0, 1), a2 + hstepA, oA[1]);
            PG8_WAIT_V(8); PG8_WAIT_L(0); PG8_BAR; PG8_MMA(0, 0, At, B0); PG8_MMA(0, 1, At, B1); PG8_BAR; PG8_SCHED;
            PG8_LDA(At, 1, 1); PG8_STAGE(PG8_SB(1, 0), b3, voffB); PG8_STAGE(PG8_SB(1, 1), b3 + hstepB, voffB); PG8_STAGE(PG8_SA(1, 0), a3, oA[0]);
            PG8_WAIT_V(8); PG8_WAIT_L(0); PG8_BAR; PG8_MMA(1, 0, At, B0); PG8_MMA(1, 1, At, B1); PG8_BAR; PG8_SCHED;
        }
        if (wr == 0) PG8_BAR;
        bool keep = false;
        {
            int tz = threadIdx.x; asm volatile("" : "+v"(tz)); const int ewid = tz >> 6, el = tz & 63, ewr = ewid >> 2, ewc = ewid & 3, efr = el & 15, efq = el >> 4;
            if constexpr (Sched::HAS_MID) { if (S.is_mid(cur)) { E.mid(acc, cur, ewr, ewc, efr, efq); keep = true; } }
            if (!keep) E(acc, cur, ewr, ewc, efr, efq);
        }
        if (!has_next) break;
        if (!keep) {
#pragma unroll
            for (int a = 0; a < 2; ++a)
#pragma unroll
                for (int b = 0; b < 2; ++b)
#pragma unroll
                    for (int m = 0; m < 4; ++m)
#pragma unroll
                        for (int n = 0; n < 2; ++n) acc[a][b][m][n] = (f32x4){0.f, 0.f, 0.f, 0.f};
        }
        cur = nxt; cA = nA; cB = nB; ++ui;
        if (wr == 1) PG8_BAR;
    }
    PG8_WAIT_V(0);
    PG8_BAR;
#undef PG8_SA
#undef PG8_SB
#undef PG8_STAGE
#undef PG8_LDA
#undef PG8_LDB
#undef PG8_MMA
#undef PG8_CAT
#undef PG8_WAIT_V
#undef PG8_WAIT_L
#undef PG8_BAR
#undef PG8_SCHED
}
}
using pg8::Unit;

struct Args { const float* in[25]; float* out; unsigned char* ws; int ph_lo, ph_hi, pad0, pad1; };
static_assert(sizeof(Args) == 27 * 8 + 16, "Args has no padding");
struct Frame {
    LAS unsigned char* lds; volatile LAS unsigned* MISC; unsigned* ctl;
    int tid, lane, wave, vcu, G;
};
#define LDS_WAIT() asm volatile("s_waitcnt lgkmcnt(0)" ::: "memory")
#define VM_WAIT() asm volatile("s_waitcnt vmcnt(0)" ::: "memory")

struct SchedStatic {
    static constexpr bool GATHER = false, HAS_MID = false;
    const char* A; const char* B; int nM, nN, G, c; size_t astep, bstep;
    __device__ __forceinline__ bool next(int i, Unit& u) const { u.aux = 0; return pg8::static_unit(i, G, c, nM, nN, u.pm, u.pn); }
    __device__ __forceinline__ const char* aptr(const Unit& u) const { return A + (size_t)u.pm * astep; }
    __device__ __forceinline__ const char* bptr(const Unit& u) const { return B + (size_t)u.pn * bstep; }
    __device__ __forceinline__ bool is_mid(const Unit&) const { return false; }
    __device__ __forceinline__ unsigned goff(int, int) const { return 0u; }
};
struct SchedSplit2 {
    static constexpr bool GATHER = false, HAS_MID = true;
    const char* A; const char* B; int nM, nN, G, c; size_t astep, bstep, khalf;
    __device__ __forceinline__ bool next(int i, Unit& u) const { u.aux = i & 1; return pg8::static_unit(i >> 1, G, c, nM, nN, u.pm, u.pn); }
    __device__ __forceinline__ const char* aptr(const Unit& u) const { return A + (size_t)u.pm * astep + (size_t)u.aux * khalf; }
    __device__ __forceinline__ const char* bptr(const Unit& u) const { return B + (size_t)u.pn * bstep + (size_t)u.aux * khalf; }
    __device__ __forceinline__ bool is_mid(const Unit& u) const { return u.aux == 0; }
    __device__ __forceinline__ unsigned goff(int, int) const { return 0u; }
};
__device__ __forceinline__ int moe_find_e(volatile LAS unsigned* MISC, int rb) { int e = 0;
#pragma unroll 1
    for (int i = 1; i < NEXP; ++i) e += ((int)MISC[i] <= rb) ? 1 : 0;
    return e; }
template <int NPN, bool GATH>
struct SchedMoe {
    static constexpr bool GATHER = GATH, HAS_MID = false;
    static constexpr int RPX = 32 / NPN;
    static constexpr int UT0 = 96, UTN = 24;
    const char* A; const char* B; volatile LAS unsigned* MISC; const LAS unsigned* gtab; int c, G, nrb; size_t bstep_e, bstep_n;
    __device__ __forceinline__ bool slow_next(int i, Unit& u) const {
        int rb, pn;
        if (G == 256) { const int x = c & 7, j = c >> 3; rb = (8 * i + x) * RPX + j / NPN; pn = j % NPN; }
        else { const long L = (long)i * G + c; rb = (int)(L / NPN); pn = (int)(L % NPN); }
        if (rb >= nrb) return false;
        u.pm = rb; u.pn = pn; u.aux = moe_find_e(MISC, rb); return true;
    }
    __device__ __forceinline__ void build(int tid) const {
        if (tid < UTN) { Unit u; const bool ok = slow_next(tid, u); MISC[UT0 + tid] = ok ? (0x80000000u | ((unsigned)u.aux << 16) | ((unsigned)u.pn << 12) | (unsigned)u.pm) : 0u; }
        __syncthreads();
    }
    __device__ __forceinline__ bool next(int i, Unit& u) const {
        if (i >= UTN) return false;
        const unsigned w = MISC[UT0 + i]; if (!(w >> 31)) return false;
        u.pm = (int)(w & 0xfffu); u.pn = (int)((w >> 12) & 0xfu); u.aux = (int)((w >> 16) & 0xffu); return true;
    }
    __device__ __forceinline__ const char* aptr(const Unit& u) const { return GATH ? A : A + (size_t)u.pm * (256 * 1024); }
    __device__ __forceinline__ const char* bptr(const Unit& u) const { return B + (size_t)u.aux * bstep_e + (size_t)u.pn * bstep_n; }
    __device__ __forceinline__ bool is_mid(const Unit&) const { return false; }
    __device__ __forceinline__ unsigned goff(int ui, int row) const { return gtab[ui * 256 + row]; }
};

#define EPI_ARGS f32x4 (&acc)[2][2][4][2], const Unit& u, int wr, int wc, int fr, int fq
struct EpiG1 {
    bf16 *Q, *K, *V, *U, *VG, *GT; const float* bgate;
    __device__ __forceinline__ void mid(EPI_ARGS) const {}
    __device__ __forceinline__ void operator()(EPI_ARGS) const {
        const int pn = u.pn; const int row0 = u.pm * 256 + wr * 64 + fr;
        if (pn < 6) {
            const int t = pn >> 1; bf16* base = Q + (size_t)t * ((WS_K - WS_Q) / 2); const float sc = (t == 0) ? QSCALE : 1.0f;    const int col0 = (pn & 1) * 256 + wc * 32 + 8 * fq;
#pragma unroll
            for (int ai = 0; ai < 2; ++ai)
#pragma unroll
                for (int m = 0; m < 4; ++m) { bf16* rowp = base + (size_t)(row0 + ai * 128 + m * 16) * 512 + col0;
#pragma unroll
                    for (int bj = 0; bj < 2; ++bj) { const f32x4 v0 = acc[ai][bj][m][0] * sc, v1 = acc[ai][bj][m][1] * sc;
                        u32x4 w; w.x = cvtpk(v0[0], v0[1]); w.y = cvtpk(v0[2], v0[3]); w.z = cvtpk(v1[0], v1[1]); w.w = cvtpk(v1[2], v1[3]); *(u32x4*)(rowp + bj * 128) = w; } }
        } else if (pn < 10) {
            bf16* base = Q + (size_t)(pn >> 1) * ((WS_K - WS_Q) / 2); const int col0 = (pn & 1) * 256 + wc * 32 + 8 * fq;
#pragma unroll
            for (int ai = 0; ai < 2; ++ai)
#pragma unroll
                for (int m = 0; m < 4; ++m) { bf16* rowp = base + (size_t)(row0 + ai * 128 + m * 16) * 512 + col0;
#pragma unroll
                    for (int bj = 0; bj < 2; ++bj) { const f32x4 v0 = acc[ai][bj][m][0], v1 = acc[ai][bj][m][1];
                        const f32x2 a = gelu_pk((f32x2){v0[0], v0[1]}), b = gelu_pk((f32x2){v0[2], v0[3]}), c = gelu_pk((f32x2){v1[0], v1[1]}), d = gelu_pk((f32x2){v1[2], v1[3]});
                        u32x4 w; w.x = cvtpk(a.x, a.y); w.y = cvtpk(b.x, b.y); w.z = cvtpk(c.x, c.y); w.w = cvtpk(d.x, d.y); *(u32x4*)(rowp + bj * 128) = w; } }
        } else {
            const int col0 = (pn - 10) * 128 + wc * 32 + 8 * fq;
            const f32x4 ba0 = *(const f32x4*)(bgate + col0), ba1 = *(const f32x4*)(bgate + col0 + 4), bb0 = *(const f32x4*)(bgate + 1024 + col0), bb1 = *(const f32x4*)(bgate + 1024 + col0 + 4);
#pragma unroll
            for (int ai = 0; ai < 2; ++ai)
#pragma unroll
                for (int m = 0; m < 4; ++m) { bf16* rowp = GT + (size_t)(row0 + ai * 128 + m * 16) * 2048 + col0;
                    const f32x4 a0 = acc[ai][0][m][0] + ba0, a1 = acc[ai][0][m][1] + ba1, b0 = acc[ai][1][m][0] + bb0, b1 = acc[ai][1][m][1] + bb1;
                    f32x4 ea0, ea1, eb0, eb1;
#pragma unroll
                    for (int i = 0; i < 4; ++i) { ea0[i] = __builtin_amdgcn_exp2f(-LOG2E * a0[i]); ea1[i] = __builtin_amdgcn_exp2f(-LOG2E * a1[i]); eb0[i] = fminf(__builtin_amdgcn_exp2f(-LOG2E * b0[i]), 1e18f); eb1[i] = fminf(__builtin_amdgcn_exp2f(-LOG2E * b1[i]), 1e18f); }
                    f32x4 gb0, gb1, r0, r1;
#pragma unroll
                    for (int i = 0; i < 4; ++i) { gb0[i] = __builtin_amdgcn_rcpf(1.0f + eb0[i]); gb1[i] = __builtin_amdgcn_rcpf(1.0f + eb1[i]); r0[i] = (1.0f + eb0[i]) * __builtin_amdgcn_rcpf(1.0f + ea0[i]); r1[i] = (1.0f + eb1[i]) * __builtin_amdgcn_rcpf(1.0f + ea1[i]); }
                    u32x4 wr, wb; wr.x = cvtpk(r0[0], r0[1]); wr.y = cvtpk(r0[2], r0[3]); wr.z = cvtpk(r1[0], r1[1]); wr.w = cvtpk(r1[2], r1[3]);
                    wb.x = cvtpk(gb0[0], gb0[1]); wb.y = cvtpk(gb0[2], gb0[3]); wb.z = cvtpk(gb1[0], gb1[1]); wb.w = cvtpk(gb1[2], gb1[3]);
                    __builtin_nontemporal_store(wr, (u32x4*)rowp); __builtin_nontemporal_store(wb, (u32x4*)(rowp + 1024)); }
        }
    }
};
struct EpiG2 {
    const bf16* GT; bf16* MRG;
    __device__ __forceinline__ void mid(EPI_ARGS) const {
        const int row0 = u.pm * 256 + wr * 64 + fr, col0 = u.pn * 256 + wc * 32 + 8 * fq;
#pragma unroll
        for (int ai = 0; ai < 2; ++ai)
#pragma unroll
            for (int m = 0; m < 4; ++m) { const bf16* gp = GT + (size_t)(row0 + ai * 128 + m * 16) * 2048 + col0;
#pragma unroll
                for (int bj = 0; bj < 2; ++bj) { const u32x4 rr = __builtin_nontemporal_load((const u32x4*)(gp + bj * 128));
                    const f32x4 r0 = {bflo(rr.x), bfhi(rr.x), bflo(rr.y), bfhi(rr.y)}, r1 = {bflo(rr.z), bfhi(rr.z), bflo(rr.w), bfhi(rr.w)};
                    acc[ai][bj][m][0] *= r0; acc[ai][bj][m][1] *= r1; } }
    }
    __device__ __forceinline__ void operator()(EPI_ARGS) const {
        const int row0 = u.pm * 256 + wr * 64 + fr, col0 = u.pn * 256 + wc * 32 + 8 * fq;
#pragma unroll
        for (int ai = 0; ai < 2; ++ai)
#pragma unroll
            for (int m = 0; m < 4; ++m) { const size_t r = (size_t)(row0 + ai * 128 + m * 16); const bf16* gp = GT + r * 2048 + 1024 + col0; bf16* op = MRG + r * 1024 + col0;
#pragma unroll
                for (int bj = 0; bj < 2; ++bj) { const u32x4 gb = __builtin_nontemporal_load((const u32x4*)(gp + bj * 128)); const f32x4 v0 = acc[ai][bj][m][0], v1 = acc[ai][bj][m][1];
                    u32x4 w; w.x = cvtpk(v0[0] * bflo(gb.x), v0[1] * bfhi(gb.x)); w.y = cvtpk(v0[2] * bflo(gb.y), v0[3] * bfhi(gb.y));
                    w.z = cvtpk(v1[0] * bflo(gb.z), v1[1] * bfhi(gb.z)); w.w = cvtpk(v1[2] * bflo(gb.w), v1[3] * bfhi(gb.w)); *(u32x4*)(op + bj * 128) = w; } }
    }
};
struct EpiPlain {
    bf16* O;
    __device__ __forceinline__ void mid(EPI_ARGS) const {}
    __device__ __forceinline__ void operator()(EPI_ARGS) const {
        const int row0 = u.pm * 256 + wr * 64 + fr, col0 = u.pn * 256 + wc * 32 + 8 * fq;
#pragma unroll
        for (int ai = 0; ai < 2; ++ai)
#pragma unroll
            for (int m = 0; m < 4; ++m) { bf16* op = O + (size_t)(row0 + ai * 128 + m * 16) * 1024 + col0;
#pragma unroll
                for (int bj = 0; bj < 2; ++bj) { const f32x4 v0 = acc[ai][bj][m][0], v1 = acc[ai][bj][m][1];
                    u32x4 w; w.x = cvtpk(v0[0], v0[1]); w.y = cvtpk(v0[2], v0[3]); w.z = cvtpk(v1[0], v1[1]); w.w = cvtpk(v1[2], v1[3]); *(u32x4*)(op + bj * 128) = w; } }
    }
};
struct EpiAct {
    const float* bgu; unsigned char* ACT8;
    __device__ __forceinline__ void mid(EPI_ARGS) const {}
    __device__ __forceinline__ f32x2 act2(f32x2 g, f32x2 l) const {
        f32x2 xg, xl; xg.x = fminf(g.x, SWL); xg.y = fminf(g.y, SWL); xl.x = fminf(fmaxf(l.x, -SWL), SWL); xl.y = fminf(fmaxf(l.y, -SWL), SWL);
        const f32x2 t = xg * (-SWA * LOG2E); f32x2 e; e.x = __builtin_amdgcn_exp2f(t.x); e.y = __builtin_amdgcn_exp2f(t.y);
        const f32x2 d = e + 1.0f; f32x2 r; r.x = __builtin_amdgcn_rcpf(d.x); r.y = __builtin_amdgcn_rcpf(d.y);
        return (xg * r) * (xl * F8_ASCALE + F8_ASCALE);
    }
    __device__ __forceinline__ void operator()(EPI_ARGS) const {
        const int e = u.aux; const int row0 = u.pm * 256 + wr * 64 + fr, col0 = u.pn * 128 + wc * 32 + 8 * fq;
        const float* bp = bgu + (size_t)e * 2048 + col0;
        const f32x4 bg0 = *(const f32x4*)(bp), bg1 = *(const f32x4*)(bp + 4), bl0 = *(const f32x4*)(bp + 1024), bl1 = *(const f32x4*)(bp + 1028);
#pragma unroll
        for (int ai = 0; ai < 2; ++ai)
#pragma unroll
            for (int m = 0; m < 4; ++m) {
                const f32x4 g0 = acc[ai][0][m][0] * F8_DESCALE + bg0, g1 = acc[ai][0][m][1] * F8_DESCALE + bg1, l0 = acc[ai][1][m][0] * F8_DESCALE + bl0, l1 = acc[ai][1][m][1] * F8_DESCALE + bl1;
                const f32x2 o0 = act2((f32x2){g0[0], g0[1]}, (f32x2){l0[0], l0[1]}), o1 = act2((f32x2){g0[2], g0[3]}, (f32x2){l0[2], l0[3]});
                const f32x2 o2 = act2((f32x2){g1[0], g1[1]}, (f32x2){l1[0], l1[1]}), o3 = act2((f32x2){g1[2], g1[3]}, (f32x2){l1[2], l1[3]});
                u32x2 w; w.x = pk_fp8x4_nc(o0.x, o0.y, o1.x, o1.y); w.y = pk_fp8x4_nc(o2.x, o2.y, o3.x, o3.y);
                *(u32x2*)(ACT8 + (size_t)(row0 + ai * 128 + m * 16) * 1024 + col0) = w; }
    }
};
struct EpiDown {
    const float* bdn; unsigned char* Y2s;
    __device__ __forceinline__ void mid(EPI_ARGS) const {}
    __device__ __forceinline__ void operator()(EPI_ARGS) const {
        const int e = u.aux; const int row0 = u.pm * 256 + wr * 64 + fr, col0 = u.pn * 256 + wc * 32 + 8 * fq;
        f32x4 bv[2][2];
#pragma unroll
        for (int bj = 0; bj < 2; ++bj)
#pragma unroll
            for (int n = 0; n < 2; ++n) bv[bj][n] = *(const f32x4*)(bdn + (size_t)e * 1024 + col0 + bj * 128 + 4 * n) * F8_YSCALE;
#pragma unroll
        for (int ai = 0; ai < 2; ++ai)
#pragma unroll
            for (int m = 0; m < 4; ++m) { unsigned char* op = Y2s + (size_t)(row0 + ai * 128 + m * 16) * 1024 + col0;
#pragma unroll
                for (int bj = 0; bj < 2; ++bj) { const f32x4 v0 = acc[ai][bj][m][0] * (F8_DESCALE * F8_YSCALE) + bv[bj][0], v1 = acc[ai][bj][m][1] * (F8_DESCALE * F8_YSCALE) + bv[bj][1];
                    u32x2 w; w.x = pk_fp8x4(v0[0], v0[1], v0[2], v0[3]); w.y = pk_fp8x4(v1[0], v1[1], v1[2], v1[3]); *(u32x2*)(op + bj * 128) = w; } }
    }
};

struct WItem { const float* W; unsigned char* dst; int N, k0, n0, ldt, drow, dk0, fp8; };
__device__ __forceinline__ WItem witem_decode(const Args& a, int r) {
    unsigned char* ws = a.ws; WItem it;
    constexpr int I_IN = 8 * 80, I_GATE = 8 * 64, I_BR = 4 * 32, I_OUT = 8 * 32, I_GU = 8 * 64, I_DN = 8 * 32;
    it.fp8 = 0; it.dk0 = 0; it.ldt = 2048;
    if (r < I_IN) { it.W = a.in[6]; it.N = INW; it.k0 = 128 * (r / 80); it.n0 = 32 * (r % 80); it.dst = ws + WS_W1T; it.drow = it.n0; return it; } r -= I_IN;
    if (r < I_GATE) { it.W = a.in[14]; it.N = 2048; it.k0 = 128 * (r / 64); it.n0 = 32 * (r % 64); it.dst = ws + WS_W1T; const int m0 = it.n0 & 1023;
        it.drow = INW + 256 * (m0 >> 7) + (m0 & 127) + (it.n0 >= 1024 ? 128 : 0); return it; } r -= I_GATE;
    if (r < I_BR) { it.W = a.in[12]; it.N = 1024; it.k0 = 128 * (r / 32); it.n0 = 32 * (r % 32); it.dst = ws + WS_WBRT; it.drow = it.n0; return it; } r -= I_BR;
    if (r < I_BR) { it.W = a.in[13]; it.N = 1024; it.k0 = 128 * (r / 32); it.n0 = 32 * (r % 32); it.dst = ws + WS_WBRT; it.drow = it.n0; it.dk0 = 512; return it; } r -= I_BR;
    if (r < I_OUT) { it.W = a.in[16]; it.N = 1024; it.k0 = 128 * (r / 32); it.n0 = 32 * (r % 32); it.dst = ws + WS_WOUTT; it.drow = it.n0; return it; } r -= I_OUT;
    it.fp8 = 1; it.ldt = 1024;
    if (r < NEXP * I_GU) { const int e = r / I_GU, q = r % I_GU; it.W = a.in[21] + (size_t)e * D * 2048; it.N = 2048; it.k0 = 128 * (q / 64); it.n0 = 32 * (q % 64); it.dst = ws + WS_WGUT + (size_t)e * 2048 * 1024;
        const int m0 = it.n0 & 1023; it.drow = 256 * (m0 >> 7) + (m0 & 127) + (it.n0 >= 1024 ? 128 : 0); return it; }
    r -= NEXP * I_GU;
    { const int e = r / I_DN, q = r % I_DN; it.W = a.in[23] + (size_t)e * D * D; it.N = 1024; it.k0 = 128 * (q / 32); it.n0 = 32 * (q % 32); it.dst = ws + WS_WDNT + (size_t)e * 1024 * 1024; it.drow = it.n0; }
    return it;
}
constexpr int W_NITEMS = 8 * 80 + 8 * 64 + 2 * 4 * 32 + 8 * 32 + NEXP * (8 * 64 + 8 * 32);
__device__ __forceinline__ void witem_load(const WItem& it, float (&v)[64], int lane) {
    const float* p = it.W + (size_t)(it.k0 + (lane >> 3)) * it.N + it.n0 + (lane & 7) * 4;
#pragma unroll
    for (int i = 0; i < 16; ++i) { const f32x4 t = __builtin_nontemporal_load((const f32x4*)(p + (size_t)(8 * i) * it.N)); v[4 * i] = t[0]; v[4 * i + 1] = t[1]; v[4 * i + 2] = t[2]; v[4 * i + 3] = t[3]; }
}
__device__ __forceinline__ void witem_store(const WItem& it, const float (&v)[64], LAS float* scr, int lane) {
#pragma unroll
    for (int i = 0; i < 16; ++i) { const int k = 8 * i + (lane >> 3); *(LAS f32x4*)(scr + k * 32 + (((lane & 7) * 4 + 4 * (i >> 1)) & 31)) = (f32x4){v[4 * i], v[4 * i + 1], v[4 * i + 2], v[4 * i + 3]}; }
    LDS_WAIT(); asm volatile("" ::: "memory");
    const int c = lane & 7;
#pragma unroll
    for (int j = 0; j < 4; ++j) { const int n = (lane >> 3) + 8 * j; const LAS float* s = scr + (16 * c) * 32 + ((n + 4 * c) & 31);
        float x[16];
#pragma unroll
        for (int q = 0; q < 16; ++q) x[q] = s[q * 32];
        unsigned char* d = it.dst + (size_t)(it.drow + n) * it.ldt;
        if (it.fp8) { u32x4 o;
            o.x = pk_fp8x4(x[0] * F8_WSCALE, x[1] * F8_WSCALE, x[2] * F8_WSCALE, x[3] * F8_WSCALE); o.y = pk_fp8x4(x[4] * F8_WSCALE, x[5] * F8_WSCALE, x[6] * F8_WSCALE, x[7] * F8_WSCALE);
            o.z = pk_fp8x4(x[8] * F8_WSCALE, x[9] * F8_WSCALE, x[10] * F8_WSCALE, x[11] * F8_WSCALE); o.w = pk_fp8x4(x[12] * F8_WSCALE, x[13] * F8_WSCALE, x[14] * F8_WSCALE, x[15] * F8_WSCALE);
            __builtin_nontemporal_store(o, (u32x4*)(d + it.dk0 + it.k0 + 16 * c)); }
        else { u32x4 o0, o1;
            o0.x = cvtpk(x[0], x[1]); o0.y = cvtpk(x[2], x[3]); o0.z = cvtpk(x[4], x[5]); o0.w = cvtpk(x[6], x[7]); o1.x = cvtpk(x[8], x[9]); o1.y = cvtpk(x[10], x[11]); o1.z = cvtpk(x[12], x[13]); o1.w = cvtpk(x[14], x[15]);
            *(u32x4*)(d + (size_t)(it.dk0 + it.k0 + 16 * c) * 2) = o0; *(u32x4*)(d + (size_t)(it.dk0 + it.k0 + 16 * c) * 2 + 16) = o1; } }
    LDS_WAIT(); asm volatile("" ::: "memory");
}
__device__ __forceinline__ void phaseA(const Frame& F, const Args& a) {
    unsigned char* ws = a.ws;
    if (F.vcu < 192) {
        const float* c = a.in[1]; const float* w_ada = a.in[2]; const float* b_ada = a.in[3]; float* mod = (float*)(ws + WS_MOD);
        LAS float* red = (LAS float*)(F.lds);
        const int col = F.vcu * 32 + (F.tid & 31), ks = F.tid >> 5;
        float a0 = 0.f, a1 = 0.f, a2 = 0.f, a3 = 0.f;
        for (int k = ks * 64; k < ks * 64 + 64; ++k) { const float w = __builtin_nontemporal_load(w_ada + (size_t)k * 6144 + col);
            const float c0 = c[k], c1 = c[D + k], c2 = c[2 * D + k], c3 = c[3 * D + k];
            a0 += c0 * __builtin_amdgcn_rcpf(1.0f + __expf(-c0)) * w; a1 += c1 * __builtin_amdgcn_rcpf(1.0f + __expf(-c1)) * w;
            a2 += c2 * __builtin_amdgcn_rcpf(1.0f + __expf(-c2)) * w; a3 += c3 * __builtin_amdgcn_rcpf(1.0f + __expf(-c3)) * w; }
        red[(ks * 4 + 0) * 32 + (F.tid & 31)] = a0; red[(ks * 4 + 1) * 32 + (F.tid & 31)] = a1; red[(ks * 4 + 2) * 32 + (F.tid & 31)] = a2; red[(ks * 4 + 3) * 32 + (F.tid & 31)] = a3;
        __syncthreads();
        if (F.tid < 128) { const int b = F.tid >> 5, cc = F.tid & 31; float s = 0.f;
#pragma unroll
            for (int k = 0; k < 16; ++k) s += red[(k * 4 + b) * 32 + cc];
            mod[b * 6144 + F.vcu * 32 + cc] = s + b_ada[F.vcu * 32 + cc]; }
        __syncthreads();
    }
    if (F.vcu == 192 % F.G) {
        const float* w_router = a.in[19]; bf16* wrt = (bf16*)(ws + WS_WRT);
        for (int i = F.tid; i < D * NEXP; i += NWAVES * 64) { const int k = i >> 5, e = i & 31; const float w = w_router[i]; const unsigned hh = cvtpk(w, 0.f) & 0xffffu;
            wrt[(size_t)e * D + k] = (bf16)hh; wrt[(size_t)(NEXP + e) * D + k] = (bf16)(cvtpk(w - bflo(hh), 0.f) & 0xffffu); }
    }
    LAS float* scr = (LAS float*)(F.lds + F.wave * 17408);
    const int gw = F.vcu * NWAVES + F.wave, NGW = F.G * NWAVES;
    if (gw < W_NITEMS) {
        float va[64], vb[64];
        WItem ia = witem_decode(a, gw), ib = ia;
        witem_load(ia, va, F.lane);
        for (int it = gw; it < W_NITEMS; it += 2 * NGW) {
            const bool hb = (it + NGW < W_NITEMS);
            ib = witem_decode(a, hb ? it + NGW : it); witem_load(ib, vb, F.lane);
            witem_store(ia, va, scr, F.lane);
            if (!hb) break;
            const bool ha = (it + 2 * NGW < W_NITEMS);
            ia = witem_decode(a, ha ? it + 2 * NGW : it); witem_load(ia, va, F.lane);
            witem_store(ib, vb, scr, F.lane);
            if (!ha) break;
        }
    }
}
__device__ __forceinline__ void phaseB(const Frame& F, const Args& a) {
    const float* x = a.in[0]; const float* g = a.in[4]; const float* mod = (const float*)(a.ws + WS_MOD); bf16* xn = (bf16*)(a.ws + WS_XN);
    const int gw = F.vcu * NWAVES + F.wave, NGW = F.G * NWAVES;
    f32x4 cg[4], csh[4]; int cb = -1;
    for (int row0 = gw * 4; row0 < NTOK; row0 += NGW * 4) {
        f32x4 v[4][4];
#pragma unroll
        for (int rr = 0; rr < 4; ++rr)
#pragma unroll
            for (int j = 0; j < 4; ++j) v[rr][j] = __builtin_nontemporal_load((const f32x4*)(x + (size_t)(row0 + rr) * D) + F.lane + 64 * j);
        const int b = row0 / SEQ; const float* mb = mod + b * 6144;
        if (b != cb) { cb = b;
#pragma unroll
            for (int j = 0; j < 4; ++j) { const int c0 = (F.lane + 64 * j) * 4; cg[j] = *(const f32x4*)(g + c0) * (*(const f32x4*)(mb + SC1 + c0) + 1.0f); csh[j] = *(const f32x4*)(mb + SH1 + c0); } }
#pragma unroll
        for (int rr = 0; rr < 4; ++rr) {
            float ss = 0.f;
#pragma unroll
            for (int j = 0; j < 4; ++j) ss += (v[rr][j].x * v[rr][j].x + v[rr][j].y * v[rr][j].y) + (v[rr][j].z * v[rr][j].z + v[rr][j].w * v[rr][j].w);
            const float rstd = rsqrtf(wsum(ss) * (1.0f / D) + EPS);
            u32x2* o8 = (u32x2*)(xn + (size_t)(row0 + rr) * D) + F.lane;
#pragma unroll
            for (int j = 0; j < 4; ++j) {
                const f32x4 h = v[rr][j] * rstd * cg[j] + csh[j];
                u32x2 w; w.x = cvtpk(h[0], h[1]); w.y = cvtpk(h[2], h[3]); o8[64 * j] = w; }
        }
    }
}

constexpr int SGU_STRIDE = 1088;
__device__ __forceinline__ s16x4 vtr(const LAS unsigned char* p) { typedef short v4i16_t __attribute__((ext_vector_type(4))); return __builtin_bit_cast(s16x4, __builtin_amdgcn_ds_read_tr16_b64_v4i16((LAS v4i16_t*)p)); }
__device__ __forceinline__ void sgu_unit(const Frame& F, const Args& a, int b, int blk) {
    const bf16* VG = (const bf16*)(a.ws + WS_VG); const bf16* U = (const bf16*)(a.ws + WS_U); bf16* YAB = (bf16*)(a.ws + WS_YAB);
    const float* ln_g = a.in[8]; const float* ln_b = a.in[9]; const float* w_s = a.in[10]; const float* b_s = a.in[11];
    const int tok0 = b * SEQ + blk * SGB, lane = F.lane;
    {
        const f32x4 g0 = *(const f32x4*)(ln_g + lane * 8), g1 = *(const f32x4*)(ln_g + lane * 8 + 4), b0 = *(const f32x4*)(ln_b + lane * 8), b1 = *(const f32x4*)(ln_b + lane * 8 + 4);
#pragma unroll 1
        for (int r4 = 0; r4 < 16; r4 += 4) {
            u32x4 w[4];
#pragma unroll
            for (int rr = 0; rr < 4; ++rr) w[rr] = __builtin_nontemporal_load((const u32x4*)(VG + (size_t)(tok0 + F.wave * 16 + r4 + rr) * 512 + lane * 8));
#pragma unroll
            for (int rr = 0; rr < 4; ++rr) { const int row = F.wave * 16 + r4 + rr;
                f32x4 v0 = {bflo(w[rr].x), bfhi(w[rr].x), bflo(w[rr].y), bfhi(w[rr].y)}, v1 = {bflo(w[rr].z), bfhi(w[rr].z), bflo(w[rr].w), bfhi(w[rr].w)};
                const float mu = wsum((v0[0] + v0[1]) + (v0[2] + v0[3]) + (v1[0] + v1[1]) + (v1[2] + v1[3])) * (1.0f / 512.0f);
                v0 -= mu; v1 -= mu;
                const float var = wsum((v0[0] * v0[0] + v0[1] * v0[1]) + (v0[2] * v0[2] + v0[3] * v0[3]) + (v1[0] * v1[0] + v1[1] * v1[1]) + (v1[2] * v1[2] + v1[3] * v1[3])) * (1.0f / 512.0f);
                const float rstd = rsqrtf(var + EPS);
                v0 = v0 * rstd * g0 + b0; v1 = v1 * rstd * g1 + b1;
                u32x4 o; o.x = cvtpk(v0[0], v0[1]); o.y = cvtpk(v0[2], v0[3]); o.z = cvtpk(v1[0], v1[1]); o.w = cvtpk(v1[2], v1[3]);
                *(LAS u32x4*)(F.lds + row * SGU_STRIDE + lane * 16) = o; }
        }
    }
    __syncthreads();
    {
        const int g = F.wave, r32 = lane & 31, hi = lane >> 5, i16 = lane & 15, g16 = (lane >> 4) & 1;
        const LAS unsigned char* vb = F.lds + (8 * hi + (i16 >> 2)) * SGU_STRIDE + (g * 64 + 16 * g16 + 4 * (i16 & 3)) * 2;
#pragma unroll
        for (int tb = 0; tb < 4; ++tb) {
            const int t = 32 * tb + r32; const float* wrow = w_s + ((size_t)g * 128 + t) * 128;
            f32x4 wr0[8], wr1[8];
#pragma unroll
            for (int ks = 0; ks < 2 * tb + 2; ++ks) { wr0[ks] = *(const f32x4*)(wrow + 16 * ks + 8 * hi); wr1[ks] = *(const f32x4*)(wrow + 16 * ks + 8 * hi + 4); }
            const float bs = b_s[g * 128 + t];
            const bf16* up = U + (size_t)(tok0 + t) * 512 + g * 64 + 4 * hi;
            u32x2 uu0[4], uu1[4];
#pragma unroll
            for (int gg = 0; gg < 4; ++gg) { uu0[gg] = *(const u32x2*)(up + 8 * gg); uu1[gg] = *(const u32x2*)(up + 32 + 8 * gg); }
            f32x16 a0, a1;
#pragma unroll
            for (int r = 0; r < 16; ++r) { a0[r] = 0.f; a1[r] = 0.f; }
#pragma unroll
            for (int ks = 0; ks < 2 * tb + 2; ++ks) {
                const int s0 = 16 * ks + 8 * hi;
                float wv[8] = {wr0[ks][0], wr0[ks][1], wr0[ks][2], wr0[ks][3], wr1[ks][0], wr1[ks][1], wr1[ks][2], wr1[ks][3]};
                if (ks >= 2 * tb) {
#pragma unroll
                    for (int j = 0; j < 8; ++j) wv[j] = (s0 + j <= t) ? wv[j] : 0.f; }
                u32x4 bw; bw.x = cvtpk(wv[0], wv[1]); bw.y = cvtpk(wv[2], wv[3]); bw.z = cvtpk(wv[4], wv[5]); bw.w = cvtpk(wv[6], wv[7]);
                const bf16x8 bfrag = __builtin_bit_cast(bf16x8, bw);
                const LAS unsigned char* p = vb + ks * 16 * SGU_STRIDE;
                const s16x4 l0 = vtr(p), h0 = vtr(p + 4 * SGU_STRIDE), l1 = vtr(p + 64), h1 = vtr(p + 4 * SGU_STRIDE + 64);
                const bf16x8 A0 = {l0[0], l0[1], l0[2], l0[3], h0[0], h0[1], h0[2], h0[3]}, A1 = {l1[0], l1[1], l1[2], l1[3], h1[0], h1[1], h1[2], h1[3]};
                a0 = __builtin_amdgcn_mfma_f32_32x32x16_bf16(A0, bfrag, a0, 0, 0, 0);
                a1 = __builtin_amdgcn_mfma_f32_32x32x16_bf16(A1, bfrag, a1, 0, 0, 0);
            }
            bf16* op = YAB + (size_t)(tok0 + t) * 1024 + 512 + g * 64 + 4 * hi;
#pragma unroll
            for (int gg = 0; gg < 4; ++gg) {
                u32x2 o0, o1;
                o0.x = cvtpk(bflo(uu0[gg].x) * (a0[4 * gg] + bs), bfhi(uu0[gg].x) * (a0[4 * gg + 1] + bs)); o0.y = cvtpk(bflo(uu0[gg].y) * (a0[4 * gg + 2] + bs), bfhi(uu0[gg].y) * (a0[4 * gg + 3] + bs));
                o1.x = cvtpk(bflo(uu1[gg].x) * (a1[4 * gg] + bs), bfhi(uu1[gg].x) * (a1[4 * gg + 1] + bs)); o1.y = cvtpk(bflo(uu1[gg].y) * (a1[4 * gg + 2] + bs), bfhi(uu1[gg].y) * (a1[4 * gg + 3] + bs));
                *(u32x2*)(op + 8 * gg) = o0; *(u32x2*)(op + 32 + 8 * gg) = o1; }
        }
    }
    __syncthreads();
}

constexpr int AT_BUF = 65536, AT_V = 32768, AT_BT = GTAB_OFF;
static_assert(8 * 1088 <= GTAB_BYTES, "bias tables fit above the ring");
__device__ __forceinline__ void attn_chunks(const Frame& F, const Args& a, int gc0, int gc1) {
    const bf16* __restrict__ Q = (const bf16*)(a.ws + WS_Q); const bf16* __restrict__ Kb = (const bf16*)(a.ws + WS_K); const bf16* __restrict__ Vb = (const bf16*)(a.ws + WS_V); bf16* YAB = (bf16*)(a.ws + WS_YAB);
    const int tid = F.tid, lane = F.lane, wave = F.wave, pr = wave >> 1, half = wave & 1;
    const int r32 = lane & 31, hi = lane >> 5, i16 = lane & 15, g16 = (lane >> 4) & 1;
    const int gcs[2] = {gc0, gc1};
    int j0s[2], nts[2], tok0s[2];
#pragma unroll
    for (int i = 0; i < 2; ++i) { const int c = gcs[i] % (SEQ / CHUNK); j0s[i] = (c < NLEFT) ? (NLEFT - c) : 0; nts[i] = 9 - j0s[i]; tok0s[i] = (gcs[i] / (SEQ / CHUNK)) * SEQ + c * CHUNK; }
    const int total = 2 * nts[0] + 2 * nts[1];
    unsigned dsrcK[4], dsrcV[4];
#pragma unroll
    for (int i = 0; i < 4; ++i) { const int piece = 4 * wave + i, hh = piece >> 3, kb = piece & 7, key = 8 * kb + (lane >> 3), slot = lane & 7;
        dsrcK[i] = (unsigned)(key * 512 + hh * 64 + ((slot ^ ((key >> 1) & 7)) << 3)); dsrcV[i] = (unsigned)(key * 512 + hh * 64 + ((slot ^ (((key >> 1) & 1) << 2)) << 3)); }
#define AT_DMA(bufp, tbase) do { _Pragma("unroll") for (int i_ = 0; i_ < 4; ++i_) { const int piece_ = 4 * wave + i_; \
        __builtin_amdgcn_global_load_lds((const unsigned*)(Kb + (tbase) + dsrcK[i_]), (LAS unsigned*)((bufp) + (piece_ >> 3) * 8192 + (piece_ & 7) * 1024), 16, 0, 0); \
        __builtin_amdgcn_global_load_lds((const unsigned*)(Vb + (tbase) + dsrcV[i_]), (LAS unsigned*)((bufp) + AT_V + (piece_ >> 3) * 8192 + (piece_ & 7) * 1024), 16, 0, 0); } } while (0)
    int ko[4];
#pragma unroll
    for (int sI = 0; sI < 4; ++sI) ko[sI] = pr * 8192 + r32 * 128 + ((((2 * sI + hi) ^ ((r32 >> 1) & 7))) << 4);
    const int fb = (i16 >> 3) & 1;
    const int vr0 = AT_V + pr * 8192 + (4 * hi + (i16 >> 2)) * 128 + ((4 * (0 ^ fb) + 2 * g16 + ((i16 & 3) >> 1)) * 16) + (i16 & 1) * 8;
    const int vr1 = AT_V + pr * 8192 + (4 * hi + (i16 >> 2)) * 128 + ((4 * (1 ^ fb) + 2 * g16 + ((i16 & 3) >> 1)) * 16) + (i16 & 1) * 8;
#define AT_DECODE(t, ci, hp, j) do { ci = ((t) >= 2 * nts[0]) ? 1 : 0; const int tt_ = (t) - ci * 2 * nts[0]; hp = (tt_ >= nts[ci]) ? 1 : 0; j = j0s[ci] + tt_ - hp * nts[ci]; } while (0)
    {
        int ci, hp, j; AT_DECODE(0, ci, hp, j);
        const size_t tb0 = (size_t)(tok0s[ci] + (j - NLEFT) * CHUNK) * 512 + hp * 256;
        AT_DMA(F.lds, tb0);
    }
    __syncthreads();
    bf16x8 qf[4]; f32x16 o0, o1; float m = -1e30f, l = 0.f;
#pragma unroll
    for (int r = 0; r < 16; ++r) { o0[r] = 0.f; o1[r] = 0.f; }
#pragma unroll
    for (int sI = 0; sI < 4; ++sI) qf[sI] = (bf16x8){0, 0, 0, 0, 0, 0, 0, 0};
#pragma unroll 1
    for (int t = 0; t < total; ++t) {
        int ci, hp, j; AT_DECODE(t, ci, hp, j);
        const int tn = (t + 1 < total) ? t + 1 : t; int cin, hpn, jn; AT_DECODE(tn, cin, hpn, jn);
        const int h = 4 * hp + pr, qi = half * 32 + r32, qtok = tok0s[ci] + qi;
        if (j == j0s[ci]) {
#pragma unroll
            for (int sI = 0; sI < 4; ++sI) qf[sI] = __builtin_nontemporal_load((const bf16x8*)(Q + (size_t)qtok * 512 + h * 64 + 16 * sI + 8 * hi));
#pragma unroll
            for (int r = 0; r < 16; ++r) { o0[r] = 0.f; o1[r] = 0.f; }
            m = -1e30f; l = 0.f;
        }
        asm volatile("" ::: "memory");
        {
            const size_t tbn = (size_t)(tok0s[cin] + (jn - NLEFT) * CHUNK) * 512 + hpn * 256;
            AT_DMA(F.lds + ((t + 1) & 1) * AT_BUF, tbn);
        }
        asm volatile("" ::: "memory");
        const LAS unsigned char* buf = F.lds + (t & 1) * AT_BUF;
        const bool first = (j == j0s[ci]);
        const float negm = first ? 0.f : -m;
        f32x16 p0, p1;
#pragma unroll
        for (int r = 0; r < 16; ++r) { p0[r] = negm; p1[r] = negm; }
#pragma unroll
        for (int sI = 0; sI < 4; ++sI) { const bf16x8 k0 = *(const LAS bf16x8*)(buf + ko[sI]), k1 = *(const LAS bf16x8*)(buf + ko[sI] + 4096);
            p0 = __builtin_amdgcn_mfma_f32_32x32x16_bf16(k0, qf[sI], p0, 0, 0, 0); p1 = __builtin_amdgcn_mfma_f32_32x32x16_bf16(k1, qf[sI], p1, 0, 0, 0); }
        if (j >= 6) {
            const LAS float* bt = (const LAS float*)(F.lds + AT_BT + h * 1088);
            const int base = 640 + qi - 64 * j - 4 * hi;
#pragma unroll
            for (int r = 0; r < 16; ++r) { const int kk = (r & 3) + 8 * (r >> 2); int i0 = base - kk, i1 = base - 32 - kk; i0 = i0 > 256 ? 256 : i0; i1 = i1 > 256 ? 256 : i1; p0[r] += bt[i0]; p1[r] += bt[i1]; }
        }
        float tm = fmaxf(p0[0], p1[0]);
#pragma unroll
        for (int r = 1; r < 16; ++r) tm = fmaxf(tm, fmaxf(p0[r], p1[r]));
        { const auto rr = __builtin_amdgcn_permlane32_swap(__float_as_uint(tm), __float_as_uint(tm), false, false); tm = fmaxf(__uint_as_float(rr[0]), __uint_as_float(rr[1])); }
        if (first) {
            m = tm;
#pragma unroll
            for (int r = 0; r < 16; ++r) { p0[r] -= tm; p1[r] -= tm; }
        } else if (__any(tm > 0.f)) {
            const float dlt = fmaxf(tm, 0.f), alpha = __builtin_amdgcn_exp2f(-dlt); m += dlt; l *= alpha;
#pragma unroll
            for (int r = 0; r < 16; ++r) { p0[r] -= dlt; p1[r] -= dlt; o0[r] *= alpha; o1[r] *= alpha; }
        }
        float ps = 0.f;
#pragma unroll
        for (int r = 0; r < 16; ++r) { p0[r] = __builtin_amdgcn_exp2f(p0[r]); p1[r] = __builtin_amdgcn_exp2f(p1[r]); ps += p0[r] + p1[r]; }
        l += ps;
        bf16x8 pb[2][2];
#pragma unroll
        for (int sI = 0; sI < 2; ++sI) {
            u32x4 w0; w0.x = cvtpk(p0[8 * sI], p0[8 * sI + 1]); w0.y = cvtpk(p0[8 * sI + 2], p0[8 * sI + 3]); w0.z = cvtpk(p0[8 * sI + 4], p0[8 * sI + 5]); w0.w = cvtpk(p0[8 * sI + 6], p0[8 * sI + 7]);
            u32x4 w1; w1.x = cvtpk(p1[8 * sI], p1[8 * sI + 1]); w1.y = cvtpk(p1[8 * sI + 2], p1[8 * sI + 3]); w1.z = cvtpk(p1[8 * sI + 4], p1[8 * sI + 5]); w1.w = cvtpk(p1[8 * sI + 6], p1[8 * sI + 7]);
            pb[0][sI] = __builtin_bit_cast(bf16x8, w0); pb[1][sI] = __builtin_bit_cast(bf16x8, w1); }
#pragma unroll
        for (int blk = 0; blk < 2; ++blk)
#pragma unroll
            for (int sI = 0; sI < 2; ++sI) {
                const int kof = (32 * blk + 16 * sI) * 128;
                const s16x4 l0 = vtr(buf + vr0 + kof), h0 = vtr(buf + vr0 + kof + 1024), l1 = vtr(buf + vr1 + kof), h1 = vtr(buf + vr1 + kof + 1024);
                const bf16x8 A0 = {l0[0], l0[1], l0[2], l0[3], h0[0], h0[1], h0[2], h0[3]}, A1 = {l1[0], l1[1], l1[2], l1[3], h1[0], h1[1], h1[2], h1[3]};
                o0 = __builtin_amdgcn_mfma_f32_32x32x16_bf16(A0, pb[blk][sI], o0, 0, 0, 0);
                o1 = __builtin_amdgcn_mfma_f32_32x32x16_bf16(A1, pb[blk][sI], o1, 0, 0, 0);
            }
        if (j == 8) {
            float lt = l; { const auto rr = __builtin_amdgcn_permlane32_swap(__float_as_uint(lt), __float_as_uint(lt), false, false); lt = __uint_as_float(rr[0]) + __uint_as_float(rr[1]); }
            const float inv = __builtin_amdgcn_rcpf(lt);
            bf16* op = YAB + (size_t)qtok * 1024 + h * 64 + 4 * hi;
#pragma unroll
            for (int gg = 0; gg < 4; ++gg) {
                u32x2 w0, w1;
                w0.x = cvtpk(o0[4 * gg] * inv, o0[4 * gg + 1] * inv); w0.y = cvtpk(o0[4 * gg + 2] * inv, o0[4 * gg + 3] * inv);
                w1.x = cvtpk(o1[4 * gg] * inv, o1[4 * gg + 1] * inv); w1.y = cvtpk(o1[4 * gg + 2] * inv, o1[4 * gg + 3] * inv);
                *(u32x2*)(op + 8 * gg) = w0; *(u32x2*)(op + 32 + 8 * gg) = w1; }
        }
        __syncthreads();
    }
#undef AT_DMA
#undef AT_DECODE
}
__device__ __forceinline__ void phaseD(const Frame& F, const Args& a) {
    for (int unit = F.vcu; unit < NB * (SEQ / SGB); unit += F.G) sgu_unit(F, a, unit / (SEQ / SGB), unit % (SEQ / SGB));
    for (int i = F.tid; i < NHEAD * NREL; i += NWAVES * 64) { const int h = i / NREL, k = i % NREL; ((LAS float*)(F.lds + AT_BT + h * 1088))[k] = (a.in[7][i] - a.in[7][h * NREL + 256]) * LOG2E; }
    __syncthreads();
    const int NCH = NB * (SEQ / CHUNK);
    for (int v = F.vcu; v < NCH / 2; v += F.G) attn_chunks(F, a, v, NCH - 1 - v);
}

constexpr int G_HT_STRIDE = 2064;
__device__ __forceinline__ void phaseG(const Frame& F, const Args& a) {
    const float* x = a.in[0]; const bf16* Y1 = (const bf16*)(a.ws + WS_Y1); const float* mod = (const float*)(a.ws + WS_MOD); const float* g_post_mix = a.in[5]; const float* g_pre_ffn = a.in[17];
    const float* b_router = a.in[20]; bf16* X1b = (bf16*)(a.ws + WS_X1B); unsigned char* XN8 = a.ws + WS_XN;
    const bf16* wrt = (const bf16*)(a.ws + WS_WRT);
    float* topg = (float*)(a.ws + WS_TOPG); int* list = (int*)(a.ws + WS_LIST); unsigned* cnt = F.ctl + CW_CNT;
    LAS unsigned char* HT = F.lds;
    LAS float* PL = (LAS float*)(F.lds + 33792);
    LAS float* LG = PL + 8 * 16 * 32;
    LAS float* TV = LG + 512;
    LAS unsigned* LC = (LAS unsigned*)(TV + 64);
    LAS unsigned* AS = LC + 64;
    const int tid = F.tid, lane = F.lane, wave = F.wave, kq = lane >> 4, i16 = lane & 15;
    if (tid < 64) LC[tid] = 0u;
    bf16x8 whi[2][4], wlo[2][4];
#pragma unroll
    for (int et = 0; et < 2; ++et)
#pragma unroll
        for (int ks = 0; ks < 4; ++ks) { const size_t o = (size_t)(et * 16 + i16) * D + 128 * wave + 32 * ks + 8 * kq; whi[et][ks] = *(const bf16x8*)(wrt + o); wlo[et][ks] = *(const bf16x8*)(wrt + (size_t)NEXP * D + o); }
    const int myrow = tid >> 5, mye = lane & 31;
    const float mybias = b_router[mye];
    __syncthreads();
    const int NT = NTOK / 16;
    f32x4 xv[2][4]; u32x2 yr[2][4];
    {   const int rbase = 16 * F.vcu + 2 * wave;
#pragma unroll
        for (int rr = 0; rr < 2; ++rr)
#pragma unroll
            for (int j = 0; j < 4; ++j) { const int c0 = (lane + 64 * j) * 4; xv[rr][j] = __builtin_nontemporal_load((const f32x4*)(x + (size_t)(rbase + rr) * D + c0)); yr[rr][j] = __builtin_nontemporal_load((const u32x2*)(Y1 + (size_t)(rbase + rr) * D + c0)); } }
    int tl = 0;
    f32x4 cgp[4], cgf[4], cgt[4], csc[4], csh[4]; int cb = -1;
#pragma unroll
    for (int j = 0; j < 4; ++j) { const int c0 = (lane + 64 * j) * 4; cgp[j] = *(const f32x4*)(g_post_mix + c0); cgf[j] = *(const f32x4*)(g_pre_ffn + c0); }
#pragma unroll 1
    for (int T = F.vcu; T < NT; T += F.G, ++tl) {
        const int b = (16 * T) / SEQ; const float* mb = mod + b * 6144; const int rbase = 16 * T + 2 * wave;
        if (b != cb) { cb = b;
#pragma unroll
            for (int j = 0; j < 4; ++j) { const int c0 = (lane + 64 * j) * 4; cgt[j] = *(const f32x4*)(mb + GT1 + c0); csc[j] = *(const f32x4*)(mb + SC2 + c0) + 1.0f; csh[j] = *(const f32x4*)(mb + SH2 + c0); } }
#pragma unroll
        for (int rr = 0; rr < 2; ++rr) {
            const int row = rbase + rr; f32x4 yv[4]; float ss = 0.f;
#pragma unroll
            for (int j = 0; j < 4; ++j) { yv[j] = (f32x4){bflo(yr[rr][j].x), bfhi(yr[rr][j].x), bflo(yr[rr][j].y), bfhi(yr[rr][j].y)}; ss += (yv[j][0] * yv[j][0] + yv[j][1] * yv[j][1]) + (yv[j][2] * yv[j][2] + yv[j][3] * yv[j][3]); }
            const float rstd = rsqrtf(wsum(ss) * (1.0f / D) + EPS); float s2 = 0.f;
#pragma unroll
            for (int j = 0; j < 4; ++j) { const int c0 = (lane + 64 * j) * 4;
                xv[rr][j] = xv[rr][j] + cgt[j] * (yv[j] * rstd * cgp[j]);
                { u32x2 w1; w1.x = cvtpk(xv[rr][j][0], xv[rr][j][1]); w1.y = cvtpk(xv[rr][j][2], xv[rr][j][3]); __builtin_nontemporal_store(w1, (u32x2*)(X1b + (size_t)row * D + c0)); }
                s2 += (xv[rr][j][0] * xv[rr][j][0] + xv[rr][j][1] * xv[rr][j][1]) + (xv[rr][j][2] * xv[rr][j][2] + xv[rr][j][3] * xv[rr][j][3]); }
            const float rstd2 = rsqrtf(wsum(s2) * (1.0f / D) + EPS);
#pragma unroll
            for (int j = 0; j < 4; ++j) { const int c0 = (lane + 64 * j) * 4;
                const f32x4 h = xv[rr][j] * rstd2 * cgf[j] * csc[j] + csh[j];
                u32x2 w; w.x = cvtpk(h[0], h[1]); w.y = cvtpk(h[2], h[3]); *(unsigned*)(XN8 + (size_t)row * D + c0) = pk_fp8x4(h[0] * F8_ASCALE, h[1] * F8_ASCALE, h[2] * F8_ASCALE, h[3] * F8_ASCALE);
                *(LAS u32x2*)(HT + (2 * wave + rr) * G_HT_STRIDE + c0 * 2) = w; }
        }
        {
            const int Tn = (T + F.G < NT) ? T + F.G : T; const int rb2 = 16 * Tn + 2 * wave;
#pragma unroll
            for (int rr = 0; rr < 2; ++rr)
#pragma unroll
                for (int j = 0; j < 4; ++j) { const int c0 = (lane + 64 * j) * 4; xv[rr][j] = __builtin_nontemporal_load((const f32x4*)(x + (size_t)(rb2 + rr) * D + c0)); yr[rr][j] = __builtin_nontemporal_load((const u32x2*)(Y1 + (size_t)(rb2 + rr) * D + c0)); }
        }
        LDS_WAIT(); __builtin_amdgcn_s_barrier(); asm volatile("" ::: "memory");
        {
            f32x4 acc0 = {0.f, 0.f, 0.f, 0.f}, acc1 = {0.f, 0.f, 0.f, 0.f};
#pragma unroll
            for (int ks = 0; ks < 4; ++ks) { const bf16x8 hb = *(const LAS bf16x8*)(HT + i16 * G_HT_STRIDE + (128 * wave + 32 * ks + 8 * kq) * 2);
                acc0 = __builtin_amdgcn_mfma_f32_16x16x32_bf16(whi[0][ks], hb, acc0, 0, 0, 0); acc0 = __builtin_amdgcn_mfma_f32_16x16x32_bf16(wlo[0][ks], hb, acc0, 0, 0, 0);
                acc1 = __builtin_amdgcn_mfma_f32_16x16x32_bf16(whi[1][ks], hb, acc1, 0, 0, 0); acc1 = __builtin_amdgcn_mfma_f32_16x16x32_bf16(wlo[1][ks], hb, acc1, 0, 0, 0); }
            *(LAS f32x4*)(PL + (wave * 16 + i16) * 32 + 4 * kq) = acc0; *(LAS f32x4*)(PL + (wave * 16 + i16) * 32 + 16 + 4 * kq) = acc1;
        }
        LDS_WAIT(); __builtin_amdgcn_s_barrier(); asm volatile("" ::: "memory");
        float lg = mybias;
#pragma unroll
        for (int w = 0; w < 8; ++w) lg += PL[(w * 16 + myrow) * 32 + mye];
        LG[myrow * 32 + mye] = lg;
        LDS_WAIT(); asm volatile("" ::: "memory");
        int rank = 0;
#pragma unroll
        for (int q = 0; q < 8; ++q) { const f32x4 o = *(const LAS f32x4*)(LG + myrow * 32 + 4 * q);
#pragma unroll
            for (int i = 0; i < 4; ++i) { const int e2 = 4 * q + i; rank += (o[i] > lg || (o[i] == lg && e2 < mye)) ? 1 : 0; } }
        if (rank < 4) TV[myrow * 4 + rank] = lg;
        LDS_WAIT(); asm volatile("" ::: "memory");
        const f32x4 tv = *(const LAS f32x4*)(TV + myrow * 4);
        if (rank < 4) {
            const float den = 1.0f + __expf(tv[1] - tv[0]) + __expf(tv[2] - tv[0]) + __expf(tv[3] - tv[0]);
            const int slot = (16 * T + myrow) * 4 + rank; topg[slot] = __expf(lg - tv[0]) / den;
            const unsigned lp = __hip_atomic_fetch_add(LC + mye, 1u, __ATOMIC_RELAXED, __HIP_MEMORY_SCOPE_WORKGROUP);
            if (tl < 16) AS[tl * 64 + myrow * 4 + rank] = (unsigned)mye | (lp << 8);
        }
    }
    __syncthreads();
    if (tid < NEXP) LC[32 + tid] = atomicAdd(&cnt[tid], LC[tid]);
    __syncthreads();
    for (int i = tid; i < tl * 64; i += NWAVES * 64) { const unsigned as = AS[i]; const int e = as & 255, lp = as >> 8; const int T = F.vcu + (i >> 6) * F.G;
        list[(size_t)e * NTOK + LC[32 + e] + lp] = (16 * T + ((i & 63) >> 2)) * 4 + (i & 3); }
}
__device__ __forceinline__ int moe_tables(const Frame& F) {
    __syncthreads();
    if (F.tid < NEXP) F.MISC[40 + F.tid] = __hip_atomic_load(F.ctl + CW_CNT + F.tid, __ATOMIC_RELAXED, __HIP_MEMORY_SCOPE_AGENT);
    __syncthreads();
    if (F.tid == 0) { unsigned s = 0; for (int e = 0; e < NEXP; ++e) { F.MISC[e] = s; s += (F.MISC[40 + e] + 255u) >> 8; } F.MISC[32] = s; }
    __syncthreads();
    return (int)F.MISC[32];
}
__device__ __forceinline__ void phaseJ(const Frame& F, const Args& a) {
    const unsigned char* Y2s = a.ws + WS_Y2; const bf16* X1b = (const bf16*)(a.ws + WS_X1B); const float* mod = (const float*)(a.ws + WS_MOD); const float* gpf = a.in[18]; float* out = a.out;
    const int* inv = (const int*)(a.ws + WS_TOPE); const float* topg = (const float*)(a.ws + WS_TOPG);
    const int lane = F.lane, gw = F.vcu * NWAVES + F.wave, NGW = F.G * NWAVES;
    f32x4 cgg[4]; int cb = -1;
    for (int row0 = gw * 4; row0 < NTOK; row0 += NGW * 4) {
        const int b = row0 / SEQ; const float* mb = mod + b * 6144;
        if (b != cb) { cb = b;
#pragma unroll
            for (int j = 0; j < 4; ++j) { const int c0 = (lane + 64 * j) * 4; cgg[j] = *(const f32x4*)(gpf + c0) * *(const f32x4*)(mb + GT2 + c0); } }
        int pp[4][4]; float gg[4][4];
#pragma unroll
        for (int rr = 0; rr < 4; ++rr)
#pragma unroll
            for (int k = 0; k < 4; ++k) { pp[rr][k] = __builtin_amdgcn_readfirstlane(inv[(row0 + rr) * 4 + k]); gg[rr][k] = topg[(row0 + rr) * 4 + k] * (1.0f / F8_YSCALE); }
        unsigned yy[4][4][4]; u32x2 xx[4][4];
#pragma unroll
        for (int rr = 0; rr < 4; ++rr)
#pragma unroll
            for (int j = 0; j < 4; ++j) { const int c0 = (lane + 64 * j) * 4;
#pragma unroll
                for (int k = 0; k < 4; ++k) yy[rr][j][k] = __builtin_nontemporal_load((const unsigned*)(Y2s + (size_t)pp[rr][k] * D + c0));
                xx[rr][j] = __builtin_nontemporal_load((const u32x2*)(X1b + (size_t)(row0 + rr) * D + c0)); }
#pragma unroll
        for (int rr = 0; rr < 4; ++rr) {
            f32x4 yv[4]; float ss = 0.f;
#pragma unroll
            for (int j = 0; j < 4; ++j) { f32x4 s = {0.f, 0.f, 0.f, 0.f};
#pragma unroll
                for (int k = 0; k < 4; ++k) { const f32x2 lo = __builtin_amdgcn_cvt_pk_f32_fp8((int)yy[rr][j][k], false), hi = __builtin_amdgcn_cvt_pk_f32_fp8((int)yy[rr][j][k], true);
                    s += (f32x4){lo.x, lo.y, hi.x, hi.y} * gg[rr][k]; }
                yv[j] = s; ss += (s[0] * s[0] + s[1] * s[1]) + (s[2] * s[2] + s[3] * s[3]); }
            const float rstd = rsqrtf(wsum(ss) * (1.0f / D) + EPS);
#pragma unroll
            for (int j = 0; j < 4; ++j) { const int c0 = (lane + 64 * j) * 4;
                const f32x4 x1 = {bflo(xx[rr][j].x), bfhi(xx[rr][j].x), bflo(xx[rr][j].y), bfhi(xx[rr][j].y)};
                __builtin_nontemporal_store(x1 + cgg[j] * (yv[j] * rstd), (f32x4*)(out + (size_t)(row0 + rr) * D + c0)); }
        }
    }
}

constexpr int N_PHASES = 10;
__global__ void __launch_bounds__(NWAVES * 64, 2) mega_fwd(Args args) {
    extern __shared__ __attribute__((aligned(16))) unsigned char lds_raw[];
    Frame F;
    F.lds = (LAS unsigned char*)lds_raw; F.MISC = (volatile LAS unsigned*)(F.lds + MISC_OFF);
    F.tid = threadIdx.x; F.lane = F.tid & 63; F.wave = __builtin_amdgcn_readfirstlane(F.tid >> 6);
    F.G = gridDim.x; { const int bx = blockIdx.x; F.vcu = (F.G % 8 == 0) ? (bx % 8) * (F.G / 8) + bx / 8 : bx; }
    F.ctl = (unsigned*)(args.ws + WS_CTL);
    for (int u = F.tid; u < 128; u += NWAVES * 64) F.MISC[u] = 0u;
    __syncthreads();
    const int lo = args.ph_lo, hi = args.ph_hi;
    XcdBarrier bar; bar.bar = F.ctl + CW_BAR; bar.x = 0; bar.st = F.MISC + 80;
    if (hi - lo > 1) bar = xcd_barrier_post(F.ctl + CW_BAR, F.MISC + 80);
#define IN(k) (lo <= (k) && (k) < hi)
#define SEAM(k) do { if (IN(k) && IN((k) + 1)) xcd_barrier(bar); } while (0)
    unsigned char* ws = args.ws;
    bf16 *XN = (bf16*)(ws + WS_XN), *Qb = (bf16*)(ws + WS_Q), *Kb = (bf16*)(ws + WS_K), *Vb = (bf16*)(ws + WS_V), *Ub = (bf16*)(ws + WS_U), *VG = (bf16*)(ws + WS_VG);
    bf16 *GT = (bf16*)(ws + WS_GT), *YAB = (bf16*)(ws + WS_YAB), *MRG = (bf16*)(ws + WS_MRG), *Y1 = (bf16*)(ws + WS_Y1), *ACT = (bf16*)(ws + WS_ACT), *Y2 = (bf16*)(ws + WS_Y2);

    if (IN(0)) { phaseA(F, args); } SEAM(0);
    if (IN(1)) { phaseB(F, args); } SEAM(1);
    if (IN(2)) {
        SchedStatic S{(const char*)XN, (const char*)(ws + WS_W1T), NTOK / 256, 4608 / 256, F.G, (int)blockIdx.x, (size_t)256 * 1024 * 2, (size_t)256 * 1024 * 2};
        EpiG1 E{Qb, Kb, Vb, Ub, VG, GT, args.in[15]};
        pg8::gemm_phase<EpiG1, SchedStatic, false>(F.lds + RING_OFF, S, E, 2048, 2048, 16);
    } SEAM(2);
    if (IN(3)) { phaseD(F, args); } SEAM(3);
    if (IN(4)) {
        SchedSplit2 S{(const char*)YAB, (const char*)(ws + WS_WBRT), NTOK / 256, 4, F.G, (int)blockIdx.x, (size_t)256 * 1024 * 2, (size_t)256 * 1024 * 2, (size_t)512 * 2};
        EpiG2 E{GT, MRG};
        pg8::gemm_phase<EpiG2, SchedSplit2, false>(F.lds + RING_OFF, S, E, 2048, 2048, 8);
    } SEAM(4);
    if (IN(5)) {
        SchedStatic S{(const char*)MRG, (const char*)(ws + WS_WOUTT), NTOK / 256, 4, F.G, (int)blockIdx.x, (size_t)256 * 1024 * 2, (size_t)256 * 1024 * 2};
        EpiPlain E{Y1};
        pg8::gemm_phase<EpiPlain, SchedStatic, false>(F.lds + RING_OFF, S, E, 2048, 2048, 16);
    } SEAM(5);
    if (IN(6)) { phaseG(F, args); } SEAM(6);
    if (IN(7)) {
        const int nrb = moe_tables(F);
        const int* list = (const int*)(ws + WS_LIST);
        {
            int* inv = (int*)(ws + WS_TOPE);
            for (int g = (int)blockIdx.x * (NWAVES * 64) + F.tid; g < NTOK * TOPK; g += F.G * NWAVES * 64) {
                int e = 0, base = 0;
#pragma unroll 1
                for (int i = 0; i < NEXP; ++i) { const int c = (int)F.MISC[40 + i]; if (g >= base + c) { base += c; e = i + 1; } else break; }
                const int pos = g - base; if (e < NEXP) inv[list[(size_t)e * NTOK + pos]] = (int)F.MISC[e] * 256 + pos; }
        }
        typedef SchedMoe<8, true> SM;
        SM S{(const char*)XN, (const char*)(ws + WS_WGUT), F.MISC, (const LAS unsigned*)(F.lds + GTAB_OFF), (int)blockIdx.x, F.G, nrb, (size_t)2048 * 1024, (size_t)256 * 1024};
        S.build(F.tid);
        { Unit u; LAS unsigned* gt = (LAS unsigned*)(F.lds + GTAB_OFF);
          for (int k = 0; k < GTAB_UNITS && S.next(k, u); ++k) { const int e = u.aux, j256 = (u.pm - (int)F.MISC[e]) * 256, ecnt = (int)F.MISC[40 + e];
              for (int r = F.tid; r < 256; r += NWAVES * 64) { const int pos = j256 + r; int tok = 0; if (pos < ecnt) tok = list[(size_t)e * NTOK + pos] >> 2; gt[k * 256 + r] = (unsigned)tok * 1024u; } } }
        __syncthreads();
        EpiAct E{args.in[22], (unsigned char*)ACT};
        pg8::gemm_phase<EpiAct, SM, true>(F.lds + RING_OFF, S, E, 1024, 1024, 8);
    } SEAM(7);
    if (IN(8)) {
        const int nrb = moe_tables(F);
        typedef SchedMoe<4, true> SM;
        SM S{(const char*)ACT, (const char*)(ws + WS_WDNT), F.MISC, (const LAS unsigned*)(F.lds + GTAB_OFF), (int)blockIdx.x, F.G, nrb, (size_t)1024 * 1024, (size_t)256 * 1024};
        S.build(F.tid);
        { Unit u; LAS unsigned* gt = (LAS unsigned*)(F.lds + GTAB_OFF);
          for (int k = 0; k < GTAB_UNITS && S.next(k, u); ++k) for (int r = F.tid; r < 256; r += NWAVES * 64) gt[k * 256 + r] = (unsigned)(u.pm * 256 + r) * 1024u; }
        __syncthreads();
        EpiDown E{args.in[24], (unsigned char*)Y2};
        pg8::gemm_phase<EpiDown, SM, true>(F.lds + RING_OFF, S, E, 1024, 1024, 8);
    } SEAM(8);
    if (IN(9)) { phaseJ(F, args); }
#undef IN
#undef SEAM
}
extern "C" void kernel_launch(void* const* d_in, const int* in_sizes, int n_in, void* d_out, int out_size, void* d_ws, size_t ws_size, hipStream_t stream) {
    if (n_in != 25 || in_sizes[0] != NTOK * D || out_size != NTOK * D || ws_size < WS_END) { fprintf(stderr, "kernel_launch: unexpected shapes (n_in %d in0 %d out %d ws %zu)\n", n_in, n_in > 0 ? in_sizes[0] : -1, out_size, ws_size); return; }
    static int grid = 0;
    if (grid == 0) {
        int dev = 0, cus = 0, per_cu = 0;
        if (hipGetDevice(&dev) != hipSuccess || hipDeviceGetAttribute(&cus, hipDeviceAttributeMultiprocessorCount, dev) != hipSuccess) { fprintf(stderr, "kernel_launch: device query failed\n"); grid = -1; return; }
        if (hipFuncSetAttribute((const void*)mega_fwd, hipFuncAttributeMaxDynamicSharedMemorySize, LDS_BYTES) != hipSuccess) { fprintf(stderr, "kernel_launch: hipFuncSetAttribute failed\n"); grid = -1; return; }
        if (hipOccupancyMaxActiveBlocksPerMultiprocessor(&per_cu, (const void*)mega_fwd, NWAVES * 64, LDS_BYTES) != hipSuccess || per_cu < 1) { fprintf(stderr, "kernel_launch: occupancy query says %d\n", per_cu); }
        (void)hipGetLastError();
        grid = cus;
    }
    if (grid < 0) return;
    if (hipMemsetAsync((unsigned char*)d_ws + WS_CTL, 0, CTL_ZERO_BYTES, stream) != hipSuccess) { fprintf(stderr, "kernel_launch: memset failed\n"); return; }
    Args a{};
    for (int i = 0; i < 25; ++i) a.in[i] = (const float*)d_in[i];
    a.out = (float*)d_out; a.ws = (unsigned char*)d_ws; a.ph_lo = 0; a.ph_hi = N_PHASES;
    hipLaunchKernelGGL(mega_fwd, dim3(grid), dim3(NWAVES * 64), LDS_BYTES, stream, a);
    if (hipPeekAtLastError() != hipSuccess) fprintf(stderr, "kernel_launch: launch failed\n");
}
```

```cpp
#include <hip/hip_runtime.h>
#include <cstdio>
#include <cstdint>

constexpr int NB = 4, SEQ = 8192, D = 1024, NTOK = NB * SEQ;
constexpr int NHEAD = 8, CHUNK = 64, NLEFT = 8, NREL = 257;
constexpr int SGB = 128;
constexpr int INW = 2560, NEXP = 32, TOPK = 4;
constexpr float EPS = 1e-6f, SWL = 7.0f, SWA = 1.702f;
constexpr float LOG2E = 1.4426950408889634f;
constexpr float QSCALE = 0.125f * LOG2E;
constexpr int SH1 = 0, SC1 = 1024, GT1 = 2048, SH2 = 3072, SC2 = 4096, GT2 = 5120;
typedef unsigned short bf16;

constexpr size_t MiB = 1u << 20;
constexpr size_t WS_CTL = 0, CTL_ZERO_BYTES = 64 * 1024;
constexpr size_t WS_MOD = 1 * MiB;
constexpr size_t WS_W1T = 2 * MiB, WS_WBRT = 12 * MiB, WS_WOUTT = 14 * MiB, WS_WRT = 16 * MiB;
constexpr size_t WS_TOPE = 17 * MiB, WS_TOPG = 18 * MiB, WS_LIST = 19 * MiB;
constexpr size_t WS_WGUT = 32 * MiB, WS_WDNT = 160 * MiB;
constexpr size_t WS_XN = 224 * MiB;
constexpr size_t WS_Q = 288 * MiB, WS_K = 320 * MiB, WS_V = 352 * MiB, WS_U = 384 * MiB, WS_VG = 416 * MiB;
constexpr size_t WS_GT = 448 * MiB;
constexpr size_t WS_YAB = 576 * MiB, WS_MRG = 640 * MiB, WS_Y1 = 704 * MiB;
constexpr size_t WS_ACT = 288 * MiB;
constexpr size_t WS_Y2 = 576 * MiB;
constexpr size_t WS_END = 960 * MiB;
constexpr int CW_CNT = 1024;

#define LAS __attribute__((address_space(3)))
#define GAS __attribute__((address_space(1)))
typedef short bf16x8 __attribute__((ext_vector_type(8)));
typedef short s16x4 __attribute__((ext_vector_type(4)));
typedef float f32x4 __attribute__((ext_vector_type(4)));
typedef float f32x2 __attribute__((ext_vector_type(2)));
typedef float f32x16 __attribute__((ext_vector_type(16)));
typedef unsigned u32x4 __attribute__((ext_vector_type(4)));
typedef unsigned u32x2 __attribute__((ext_vector_type(2)));
typedef __bf16 bf16x2_t __attribute__((ext_vector_type(2)));
constexpr int NWAVES = 8;
constexpr int TRASH_SLOT = NTOK * 4;

__device__ __forceinline__ unsigned cvtpk(float lo, float hi) { f32x2 v = {lo, hi}; bf16x2_t b = __builtin_convertvector(v, bf16x2_t); return __builtin_bit_cast(unsigned, b); }
__device__ __forceinline__ float wsum(float v) {
    v += __builtin_bit_cast(float, __builtin_amdgcn_update_dpp(0, __builtin_bit_cast(int, v), 0xB1, 0xF, 0xF, true));
    v += __builtin_bit_cast(float, __builtin_amdgcn_update_dpp(0, __builtin_bit_cast(int, v), 0x4E, 0xF, 0xF, true));
    v += __builtin_bit_cast(float, __builtin_amdgcn_update_dpp(0, __builtin_bit_cast(int, v), 0x124, 0xF, 0xF, true));
    v += __builtin_bit_cast(float, __builtin_amdgcn_update_dpp(0, __builtin_bit_cast(int, v), 0x128, 0xF, 0xF, true));
    const int iv = __builtin_bit_cast(int, v);
    const float s0 = __builtin_bit_cast(float, __builtin_amdgcn_readlane(iv, 0)), s1 = __builtin_bit_cast(float, __builtin_amdgcn_readlane(iv, 16));
    const float s2 = __builtin_bit_cast(float, __builtin_amdgcn_readlane(iv, 32)), s3 = __builtin_bit_cast(float, __builtin_amdgcn_readlane(iv, 48));
    return (s0 + s1) + (s2 + s3);
}
__device__ __forceinline__ float clamp8(float v) { return fminf(fmaxf(v, -448.0f), 448.0f); }
__device__ __forceinline__ unsigned pk_fp8x4(float a, float b, float c, float d) {
    int w = 0; w = __builtin_amdgcn_cvt_pk_fp8_f32(clamp8(a), clamp8(b), w, false); w = __builtin_amdgcn_cvt_pk_fp8_f32(clamp8(c), clamp8(d), w, true); return (unsigned)w; }
__device__ __forceinline__ unsigned pk_fp8x4_nc(float a, float b, float c, float d) {
    int w = 0; w = __builtin_amdgcn_cvt_pk_fp8_f32(a, b, w, false); w = __builtin_amdgcn_cvt_pk_fp8_f32(c, d, w, true); return (unsigned)w; }
constexpr float F8_YSCALE = 16.0f;
constexpr size_t WS_X1B = 768 * MiB;
constexpr float F8_WSCALE = 64.0f, F8_ASCALE = 4.0f, F8_DESCALE = 1.0f / (64.0f * 4.0f);
__device__ __forceinline__ float bflo(unsigned w) { return __uint_as_float(w << 16); }
__device__ __forceinline__ float bfhi(unsigned w) { return __uint_as_float(w & 0xffff0000u); }
__device__ __forceinline__ float fast_sigmoid(float x) { return __builtin_amdgcn_rcpf(1.0f + __builtin_amdgcn_exp2f(-LOG2E * x)); }
__device__ __forceinline__ f32x2 sigmoid_pk(f32x2 v) { const f32x2 t = v * (-LOG2E); f32x2 e; e.x = __builtin_amdgcn_exp2f(t.x); e.y = __builtin_amdgcn_exp2f(t.y); const f32x2 d = e + 1.0f; f32x2 r; r.x = __builtin_amdgcn_rcpf(d.x); r.y = __builtin_amdgcn_rcpf(d.y); return r; }
__device__ __forceinline__ f32x2 gelu_pk(f32x2 v) {
    const f32x2 av = __builtin_elementwise_abs(v), d = av * 0.2316418882f + 1.0f;
    f32x2 t; t.x = __builtin_amdgcn_rcpf(d.x); t.y = __builtin_amdgcn_rcpf(d.y);
    f32x2 q = t * 0.5307027145f + (-0.7265760135f); q = q * t + 0.7107068705f; q = q * t + (-0.142248368f); q = q * t + 0.127414796f; q = q * t;
    const f32x2 s = (v * v) * (-0.72134752044f);
    f32x2 e; e.x = __builtin_amdgcn_exp2f(s.x); e.y = __builtin_amdgcn_exp2f(s.y);
    const f32x2 m = v * (q * e), r = v - m;
    f32x2 o; o.x = v.x < 0.f ? m.x : r.x; o.y = v.y < 0.f ? m.y : r.y; return o;
}

constexpr int RING_OFF = 0, RING_BYTES = 131072;
constexpr int GTAB_OFF = RING_BYTES, GTAB_UNITS = 20, GTAB_BYTES = GTAB_UNITS * 256 * 4;
constexpr int MISC_OFF = GTAB_OFF + GTAB_BYTES;
constexpr int LDS_BYTES = MISC_OFF + 512;
static_assert(LDS_BYTES <= 160 * 1024, "LDS map");

#define XB_TMO      128
#define XB_XCNT(j)  (256  + 64 * (j))
#define XB_XSUB(j)  (1280 + 64 * (j))
#define XB_XGEN(j)  (2304 + 64 * (j))
#define XB_TOP      3328
#define XB_TOPGEN   3392
#define XCD_BAR_WORDS 3456
#define XB_SPIN_CAP (1u << 18)
__device__ __forceinline__ unsigned xb_ld(unsigned* p)              { return __hip_atomic_load(p, __ATOMIC_RELAXED, __HIP_MEMORY_SCOPE_AGENT); }
__device__ __forceinline__ unsigned xb_add(unsigned* p, unsigned v) { return __hip_atomic_fetch_add(p, v, __ATOMIC_RELAXED, __HIP_MEMORY_SCOPE_AGENT); }
__device__ __forceinline__ unsigned xb_xcc_id() { return (unsigned)__builtin_amdgcn_s_getreg((3 << 11) | 20) & 0xFu; }
#define XB_SPIN(cond, bar) do { unsigned _sp = 0; while (cond) { __builtin_amdgcn_s_sleep(1); \
    if ((++_sp & 255u) == 0u) { if (xb_ld(&(bar)[XB_TMO])) break; if (_sp > XB_SPIN_CAP) { atomicAdd(&(bar)[XB_TMO], 1u); break; } } } } while (0)
struct XcdBarrier { unsigned* bar; unsigned x; volatile LAS unsigned* st; };
__device__ __forceinline__ XcdBarrier xcd_barrier_post(unsigned* bar, volatile LAS unsigned* st) {
    XcdBarrier b; b.bar = bar; b.x = xb_xcc_id(); b.st = st;
    if (threadIdx.x == 0) (void)xb_add(&bar[XB_XCNT(b.x)], 1u);
    return b;
}
__device__ __forceinline__ void xcd_barrier_complete(unsigned* bar, unsigned x, unsigned& nloc, unsigned& nx) {
    const unsigned G = gridDim.x * gridDim.y * gridDim.z;
    unsigned sum, cnt, mine, sp = 0u;
    for (;;) {
        sum = 0u; cnt = 0u; mine = 0u;
#pragma unroll
        for (unsigned j = 0; j < 16; ++j) { const unsigned c = xb_ld(&bar[XB_XCNT(j)]); sum += c; cnt += (c > 0u) ? 1u : 0u; mine = (j == x) ? c : mine; }
        if (sum == G) break;
        __builtin_amdgcn_s_sleep(1);
        if ((++sp & 255u) == 0u) { if (xb_ld(&bar[XB_TMO])) break; if (sp > XB_SPIN_CAP) { atomicAdd(&bar[XB_TMO], 1u); break; } }
    }
    nloc = mine > 0u ? mine : 1u; nx = cnt > 0u ? cnt : 1u;
}
__device__ __forceinline__ void xcd_barrier(const XcdBarrier& b) {
    asm volatile("s_waitcnt vmcnt(0)" ::: "memory");
    __syncthreads();
    if (threadIdx.x == 0) {
        unsigned* bar = b.bar;
        __builtin_amdgcn_s_waitcnt(0);
        unsigned nloc = b.st[0], nx = b.st[1];
        if (nloc == 0u) { xcd_barrier_complete(bar, b.x, nloc, nx); b.st[0] = nloc; b.st[1] = nx; }
        const unsigned old = xb_add(&bar[XB_XSUB(b.x)], 1u);
        const unsigned gen = old / nloc;
        if (old + 1u == (gen + 1u) * nloc) {
            __builtin_amdgcn_fence(__ATOMIC_RELEASE, "agent");
            asm volatile("s_waitcnt vmcnt(0)" ::: "memory");
            const unsigned og = xb_add(&bar[XB_TOP], 1u);
            const unsigned tg = og / nx;
            if (og + 1u == (tg + 1u) * nx) xb_add(&bar[XB_TOPGEN], 1u);
            else XB_SPIN(xb_ld(&bar[XB_TOPGEN]) == tg, bar);
            __builtin_amdgcn_fence(__ATOMIC_ACQUIRE, "agent");
            xb_add(&bar[XB_XGEN(b.x)], 1u);
            asm volatile("s_waitcnt vmcnt(0)" ::: "memory");
        } else {
            XB_SPIN(xb_ld(&bar[XB_XGEN(b.x)]) == gen, bar);
            __builtin_amdgcn_fence(__ATOMIC_ACQUIRE, "agent");
            asm volatile("s_waitcnt vmcnt(0)" ::: "memory");
        }
    }
    __syncthreads();
}
constexpr int CW_BAR = 4096;

namespace pg8 {
constexpr int BM = 256, BK = 64, HALF = 128, HTB = HALF * BK * 2, STAGE_BYTES = 8 * HTB, NXCD = 8, WGM = 8;
__host__ __device__ __forceinline__ int lds_byte(int r, int c) { return r * 128 + ((((c >> 3) ^ (r >> 1)) & 7) << 4); }
__host__ __device__ __forceinline__ void stage_rc(int b, int& R, int& C) { R = b >> 7; C = ((((b >> 4) ^ (R >> 1)) & 7) << 3); }
__host__ __device__ __forceinline__ int perm32(int rho) { const int n = rho >> 4, i = rho & 15; return 8 * (i >> 2) + 4 * n + (i & 3); }
struct Unit { int pm, pn, aux; };
typedef int v4i_t __attribute__((ext_vector_type(4)));
typedef int v8i_t __attribute__((ext_vector_type(8)));

__device__ __forceinline__ bool static_unit(int i, int G, int c, int nM, int nN, int& pm, int& pn) {
    const int nwg = nM * nN; const long L = (long)i * G + c; if (L >= nwg) return false;
    int wgid = (int)L; { const int q = nwg / NXCD, r = nwg % NXCD, xcd = wgid % NXCD, off = wgid / NXCD; wgid = (xcd < r ? xcd * (q + 1) : r * (q + 1) + (xcd - r) * q) + off; }
    const int nig = WGM * nN, gid = wgid / nig, fm = gid * WGM, gsz = (nM - fm) < WGM ? (nM - fm) : WGM;
    pm = fm + ((wgid % nig) % gsz); pn = (wgid % nig) / gsz; return true;
}

template <class Epi, class Sched, bool FP8>
__device__ __forceinline__ void gemm_phase(LAS unsigned char* lds, const Sched& S, const Epi& E, const int lda, const int ldb, const int nt) {
    const int tid = threadIdx.x, wid = __builtin_amdgcn_readfirstlane(tid >> 6), lane = tid & 63, wr = wid >> 2, wc = wid & 3, fr = lane & 15, fq = lane >> 4;
    int Rr[2], Cc[2]; unsigned voffB[2];
#pragma unroll
    for (int i = 0; i < 2; ++i) { stage_rc(tid * 16 + i * 8192, Rr[i], Cc[i]); const int Rb = (Rr[i] & ~31) + perm32(Rr[i] & 31); voffB[i] = (unsigned)(Rb * ldb + Cc[i] * 2); }
    const size_t kstep = (size_t)(BK * 2);
    const size_t hstepB = (size_t)HALF * ldb;
    const size_t hstepA = Sched::GATHER ? (size_t)0 : (size_t)HALF * lda;
    const unsigned ldsw = (unsigned)wid * 1024u;
    const int aoff = lds_byte(wr * 64 + fr, fq * 8), boff = lds_byte(wc * 32 + fr, fq * 8);
#define PG8_SA(b, h) (((b) * 2 + (h)) * HTB)
#define PG8_SB(b, h) ((4 + (b) * 2 + (h)) * HTB)
#define PG8_STAGE(bufoff, gbase, voff) do { _Pragma("unroll") for (int _i = 0; _i < 2; ++_i) \
        __builtin_amdgcn_global_load_lds((const unsigned*)((const char*)(gbase) + (voff)[_i]), (LAS unsigned*)(lds + (bufoff) + ldsw + _i * 8192), 16, 0, 0); } while (0)
#define PG8_LDA(dst, b, h) do { _Pragma("unroll") for (int m = 0; m < 4; ++m) _Pragma("unroll") for (int k = 0; k < 2; ++k) dst[m][k] = *(const LAS bf16x8*)(lds + PG8_SA(b, h) + (aoff ^ (k * 64)) + m * 2048); } while (0)
#define PG8_LDB(dst, b, h) do { _Pragma("unroll") for (int n = 0; n < 2; ++n) _Pragma("unroll") for (int k = 0; k < 2; ++k) dst[n][k] = *(const LAS bf16x8*)(lds + PG8_SB(b, h) + (boff ^ (k * 64)) + n * 2048); } while (0)
#define PG8_CAT(x) __builtin_shufflevector(__builtin_bit_cast(v4i_t, (x)[0]), __builtin_bit_cast(v4i_t, (x)[1]), 0, 1, 2, 3, 4, 5, 6, 7)
#define PG8_MMA(ai, bj, At, Bt) do { __builtin_amdgcn_s_setprio(1); if constexpr (FP8) { _Pragma("unroll") for (int m = 0; m < 4; ++m) _Pragma("unroll") for (int n = 0; n < 2; ++n) \
        acc[ai][bj][m][n] = __builtin_amdgcn_mfma_scale_f32_16x16x128_f8f6f4(PG8_CAT(Bt[n]), PG8_CAT(At[m]), acc[ai][bj][m][n], 0, 0, 0, 0, 0, 0); }   \
    else { _Pragma("unroll") for (int m = 0; m < 4; ++m) _Pragma("unroll") for (int n = 0; n < 2; ++n) _Pragma("unroll") for (int k = 0; k < 2; ++k) \
        acc[ai][bj][m][n] = __builtin_amdgcn_mfma_f32_16x16x32_bf16(Bt[n][k], At[m][k], acc[ai][bj][m][n], 0, 0, 0); } __builtin_amdgcn_s_setprio(0); } while (0)
#define PG8_WAIT_V(n) asm volatile("s_waitcnt vmcnt(" #n ")" ::: "memory")
#define PG8_WAIT_L(n) asm volatile("s_waitcnt lgkmcnt(" #n ")" ::: "memory")
#define PG8_BAR __builtin_amdgcn_s_barrier()
#define PG8_SCHED __builtin_amdgcn_sched_barrier(0)
    Unit cur, nxt; int ui = 0;
    if (!S.next(0, cur)) return;
    f32x4 acc[2][2][4][2];
#pragma unroll
    for (int a = 0; a < 2; ++a)
#pragma unroll
        for (int b = 0; b < 2; ++b)
#pragma unroll
            for (int m = 0; m < 4; ++m)
#pragma unroll
                for (int n = 0; n < 2; ++n) acc[a][b][m][n] = (f32x4){0.f, 0.f, 0.f, 0.f};
    bf16x8 At[4][2], B0[2][2], B1[2][2];
    unsigned oA[2][2];
#pragma unroll
    for (int h = 0; h < 2; ++h)
#pragma unroll
        for (int i = 0; i < 2; ++i) oA[h][i] = Sched::GATHER ? (S.goff(0, h * HALF + Rr[i]) + (unsigned)Cc[i] * 2u) : (unsigned)(Rr[i] * lda + Cc[i] * 2);
    const char* cA = S.aptr(cur); const char* cB = S.bptr(cur);
    PG8_STAGE(PG8_SB(0, 0), cB, voffB); PG8_STAGE(PG8_SB(0, 1), cB + hstepB, voffB); PG8_STAGE(PG8_SA(0, 0), cA, oA[0]); PG8_STAGE(PG8_SA(0, 1), cA + hstepA, oA[1]);
    if (wr == 1) PG8_BAR;
    PG8_WAIT_V(2); PG8_BAR;
    PG8_STAGE(PG8_SB(1, 0), cB + kstep, voffB); PG8_STAGE(PG8_SA(1, 0), cA + kstep, oA[0]); PG8_STAGE(PG8_SB(1, 1), cB + hstepB + kstep, voffB);
    PG8_WAIT_V(6); PG8_BAR;
    for (;;) {
        const bool has_next = S.next(ui + 1, nxt);
        const char* nA = has_next ? S.aptr(nxt) : cA; const char* nB = has_next ? S.bptr(nxt) : cB;
#pragma clang loop unroll(disable)
        for (int t = 0; t < nt; t += 2) {
            const bool last = (t == nt - 2);
            const char* a1 = cA + (size_t)(t + 1) * kstep;
            const char* a2 = last ? nA : cA + (size_t)(t + 2) * kstep; const char* b2 = last ? nB : cB + (size_t)(t + 2) * kstep;
            const char* a3 = a2 + kstep; const char* b3 = b2 + kstep;
            PG8_LDB(B0, 0, 0); PG8_LDB(B1, 0, 1); PG8_SCHED; PG8_LDA(At, 0, 0); PG8_STAGE(PG8_SA(1, 1), a1 + hstepA, oA[1]);
            if constexpr (Sched::GATHER) { if (last && has_next) {
#pragma unroll
                for (int h = 0; h < 2; ++h)
#pragma unroll
                    for (int i = 0; i < 2; ++i) oA[h][i] = S.goff(ui + 1, h * HALF + Rr[i]) + (unsigned)Cc[i] * 2u; } }
            PG8_WAIT_V(8); PG8_WAIT_L(0); PG8_BAR; PG8_MMA(0, 0, At, B0); PG8_MMA(0, 1, At, B1); PG8_BAR; PG8_SCHED;
            PG8_LDA(At, 0, 1); PG8_STAGE(PG8_SB(0, 0), b2, voffB); PG8_STAGE(PG8_SB(0, 1), b2 + hstepB, voffB); PG8_STAGE(PG8_SA(0, 0), a2, oA[0]);
            PG8_WAIT_V(8); PG8_WAIT_L(0); PG8_BAR; PG8_MMA(1, 0, At, B0); PG8_MMA(1, 1, At, B1); PG8_BAR; PG8_SCHED;
            PG8_LDB(B0, 1, 0); PG8_LDB(B1, 1, 1); PG8_SCHED; PG8_LDA(At, 1, 0); PG8_STAGE(PG8_SA(0, 1), a2 + hstepA, oA[1]);
            PG8_WAIT_V(8); PG8_WAIT_L(0); PG8_BAR; PG8_MMA(0, 0, At, B0); PG8_MMA(0, 1, At, B1); PG8_BAR; PG8_SCHED;
            PG8_LDA(At, 1, 1); PG8_STAGE(PG8_SB(1, 0), b3, voffB); PG8_STAGE(PG8_SB(1, 1), b3 + hstepB, voffB); PG8_STAGE(PG8_SA(1, 0), a3, oA[0]);
            PG8_WAIT_V(8); PG8_WAIT_L(0); PG8_BAR; PG8_MMA(1, 0, At, B0); PG8_MMA(1, 1, At, B1); PG8_BAR; PG8_SCHED;
        }
        if (wr == 0) PG8_BAR;
        bool keep = false;
        {
            int tz = threadIdx.x; asm volatile("" : "+v"(tz)); const int ewid = tz >> 6, el = tz & 63, ewr = ewid >> 2, ewc = ewid & 3, efr = el & 15, efq = el >> 4;
            if constexpr (Sched::HAS_MID) { if (S.is_mid(cur)) { E.mid(acc, cur, ewr, ewc, efr, efq); keep = true; } }
            if (!keep) E(acc, cur, ewr, ewc, efr, efq);
        }
        if (!has_next) break;
        if (!keep) {
#pragma unroll
            for (int a = 0; a < 2; ++a)
#pragma unroll
                for (int b = 0; b < 2; ++b)
#pragma unroll
                    for (int m = 0; m < 4; ++m)
#pragma unroll
                        for (int n = 0; n < 2; ++n) acc[a][b][m][n] = (f32x4){0.f, 0.f, 0.f, 0.f};
        }
        cur = nxt; cA = nA; cB = nB; ++ui;
        if (wr == 1) PG8_BAR;
    }
    PG8_WAIT_V(0);
    PG8_BAR;
#undef PG8_SA
#undef PG8_SB
#undef PG8_STAGE
#undef PG8_LDA
#undef PG8_LDB
#undef PG8_MMA
#undef PG8_CAT
#undef PG8_WAIT_V
#undef PG8_WAIT_L
#undef PG8_BAR
#undef PG8_SCHED
}
}
using pg8::Unit;

struct Args { const float* in[25]; float* out; unsigned char* ws; int ph_lo, ph_hi, pad0, pad1; };
static_assert(sizeof(Args) == 27 * 8 + 16, "Args has no padding");
struct Frame {
    LAS unsigned char* lds; volatile LAS unsigned* MISC; unsigned* ctl;
    int tid, lane, wave, vcu, G;
};
#define LDS_WAIT() asm volatile("s_waitcnt lgkmcnt(0)" ::: "memory")
#define VM_WAIT() asm volatile("s_waitcnt vmcnt(0)" ::: "memory")

struct SchedStatic {
    static constexpr bool GATHER = false, HAS_MID = false;
    const char* A; const char* B; int nM, nN, G, c; size_t astep, bstep;
    __device__ __forceinline__ bool next(int i, Unit& u) const { u.aux = 0; return pg8::static_unit(i, G, c, nM, nN, u.pm, u.pn); }
    __device__ __forceinline__ const char* aptr(const Unit& u) const { return A + (size_t)u.pm * astep; }
    __device__ __forceinline__ const char* bptr(const Unit& u) const { return B + (size_t)u.pn * bstep; }
    __device__ __forceinline__ bool is_mid(const Unit&) const { return false; }
    __device__ __forceinline__ unsigned goff(int, int) const { return 0u; }
};
struct SchedSplit2 {
    static constexpr bool GATHER = false, HAS_MID = true;
    const char* A; const char* B; int nM, nN, G, c; size_t astep, bstep, khalf;
    __device__ __forceinline__ bool next(int i, Unit& u) const { u.aux = i & 1; return pg8::static_unit(i >> 1, G, c, nM, nN, u.pm, u.pn); }
    __device__ __forceinline__ const char* aptr(const Unit& u) const { return A + (size_t)u.pm * astep + (size_t)u.aux * khalf; }
    __device__ __forceinline__ const char* bptr(const Unit& u) const { return B + (size_t)u.pn * bstep + (size_t)u.aux * khalf; }
    __device__ __forceinline__ bool is_mid(const Unit& u) const { return u.aux == 0; }
    __device__ __forceinline__ unsigned goff(int, int) const { return 0u; }
};
__device__ __forceinline__ int moe_find_e(volatile LAS unsigned* MISC, int rb) { int e = 0;
#pragma unroll 1
    for (int i = 1; i < NEXP; ++i) e += ((int)MISC[i] <= rb) ? 1 : 0;
    return e; }
template <int NPN, bool GATH>
struct SchedMoe {
    static constexpr bool GATHER = GATH, HAS_MID = false;
    static constexpr int RPX = 32 / NPN;
    static constexpr int UT0 = 96, UTN = 24;
    const char* A; const char* B; volatile LAS unsigned* MISC; const LAS unsigned* gtab; int c, G, nrb; size_t bstep_e, bstep_n;
    __device__ __forceinline__ bool slow_next(int i, Unit& u) const {
        int rb, pn;
        if (G == 256) { const int x = c & 7, j = c >> 3; rb = (8 * i + x) * RPX + j / NPN; pn = j % NPN; }
        else { const long L = (long)i * G + c; rb = (int)(L / NPN); pn = (int)(L % NPN); }
        if (rb >= nrb) return false;
        u.pm = rb; u.pn = pn; u.aux = moe_find_e(MISC, rb); return true;
    }
    __device__ __forceinline__ void build(int tid) const {
        if (tid < UTN) { Unit u; const bool ok = slow_next(tid, u); MISC[UT0 + tid] = ok ? (0x80000000u | ((unsigned)u.aux << 16) | ((unsigned)u.pn << 12) | (unsigned)u.pm) : 0u; }
        __syncthreads();
    }
    __device__ __forceinline__ bool next(int i, Unit& u) const {
        if (i >= UTN) return false;
        const unsigned w = MISC[UT0 + i]; if (!(w >> 31)) return false;
        u.pm = (int)(w & 0xfffu); u.pn = (int)((w >> 12) & 0xfu); u.aux = (int)((w >> 16) & 0xffu); return true;
    }
    __device__ __forceinline__ const char* aptr(const Unit& u) const { return GATH ? A : A + (size_t)u.pm * (256 * 1024); }
    __device__ __forceinline__ const char* bptr(const Unit& u) const { return B + (size_t)u.aux * bstep_e + (size_t)u.pn * bstep_n; }
    __device__ __forceinline__ bool is_mid(const Unit&) const { return false; }
    __device__ __forceinline__ unsigned goff(int ui, int row) const { return gtab[ui * 256 + row]; }
};

#define EPI_ARGS f32x4 (&acc)[2][2][4][2], const Unit& u, int wr, int wc, int fr, int fq
struct EpiG1 {
    bf16 *Q, *K, *V, *U, *VG, *GT; const float* bgate;
    __device__ __forceinline__ void mid(EPI_ARGS) const {}
    __device__ __forceinline__ void operator()(EPI_ARGS) const {
        const int pn = u.pn; const int row0 = u.pm * 256 + wr * 64 + fr;
        if (pn < 6) {
            const int t = pn >> 1; bf16* base = Q + (size_t)t * ((WS_K - WS_Q) / 2); const float sc = (t == 0) ? QSCALE : 1.0f;    const int col0 = (pn & 1) * 256 + wc * 32 + 8 * fq;
#pragma unroll
            for (int ai = 0; ai < 2; ++ai)
#pragma unroll
                for (int m = 0; m < 4; ++m) { bf16* rowp = base + (size_t)(row0 + ai * 128 + m * 16) * 512 + col0;
#pragma unroll
                    for (int bj = 0; bj < 2; ++bj) { const f32x4 v0 = acc[ai][bj][m][0] * sc, v1 = acc[ai][bj][m][1] * sc;
                        u32x4 w; w.x = cvtpk(v0[0], v0[1]); w.y = cvtpk(v0[2], v0[3]); w.z = cvtpk(v1[0], v1[1]); w.w = cvtpk(v1[2], v1[3]); *(u32x4*)(rowp + bj * 128) = w; } }
        } else if (pn < 10) {
            bf16* base = Q + (size_t)(pn >> 1) * ((WS_K - WS_Q) / 2); const int col0 = (pn & 1) * 256 + wc * 32 + 8 * fq;
#pragma unroll
            for (int ai = 0; ai < 2; ++ai)
#pragma unroll
                for (int m = 0; m < 4; ++m) { bf16* rowp = base + (size_t)(row0 + ai * 128 + m * 16) * 512 + col0;
#pragma unroll
                    for (int bj = 0; bj < 2; ++bj) { const f32x4 v0 = acc[ai][bj][m][0], v1 = acc[ai][bj][m][1];
                        const f32x2 a = gelu_pk((f32x2){v0[0], v0[1]}), b = gelu_pk((f32x2){v0[2], v0[3]}), c = gelu_pk((f32x2){v1[0], v1[1]}), d = gelu_pk((f32x2){v1[2], v1[3]});
                        u32x4 w; w.x = cvtpk(a.x, a.y); w.y = cvtpk(b.x, b.y); w.z = cvtpk(c.x, c.y); w.w = cvtpk(d.x, d.y); *(u32x4*)(rowp + bj * 128) = w; } }
        } else {
            const int col0 = (pn - 10) * 128 + wc * 32 + 8 * fq;
            const f32x4 ba0 = *(const f32x4*)(bgate + col0), ba1 = *(const f32x4*)(bgate + col0 + 4), bb0 = *(const f32x4*)(bgate + 1024 + col0), bb1 = *(const f32x4*)(bgate + 1024 + col0 + 4);
#pragma unroll
            for (int ai = 0; ai < 2; ++ai)
#pragma unroll
                for (int m = 0; m < 4; ++m) { bf16* rowp = GT + (size_t)(row0 + ai * 128 + m * 16) * 2048 + col0;
                    const f32x4 a0 = acc[ai][0][m][0] + ba0, a1 = acc[ai][0][m][1] + ba1, b0 = acc[ai][1][m][0] + bb0, b1 = acc[ai][1][m][1] + bb1;
                    f32x4 ea0, ea1, eb0, eb1;
#pragma unroll
                    for (int i = 0; i < 4; ++i) { ea0[i] = __builtin_amdgcn_exp2f(-LOG2E * a0[i]); ea1[i] = __builtin_amdgcn_exp2f(-LOG2E * a1[i]); eb0[i] = fminf(__builtin_amdgcn_exp2f(-LOG2E * b0[i]), 1e18f); eb1[i] = fminf(__builtin_amdgcn_exp2f(-LOG2E * b1[i]), 1e18f); }
                    f32x4 gb0, gb1, r0, r1;
#pragma unroll
                    for (int i = 0; i < 4; ++i) { gb0[i] = __builtin_amdgcn_rcpf(1.0f + eb0[i]); gb1[i] = __builtin_amdgcn_rcpf(1.0f + eb1[i]); r0[i] = (1.0f + eb0[i]) * __builtin_amdgcn_rcpf(1.0f + ea0[i]); r1[i] = (1.0f + eb1[i]) * __builtin_amdgcn_rcpf(1.0f + ea1[i]); }
                    u32x4 wr, wb; wr.x = cvtpk(r0[0], r0[1]); wr.y = cvtpk(r0[2], r0[3]); wr.z = cvtpk(r1[0], r1[1]); wr.w = cvtpk(r1[2], r1[3]);
                    wb.x = cvtpk(gb0[0], gb0[1]); wb.y = cvtpk(gb0[2], gb0[3]); wb.z = cvtpk(gb1[0], gb1[1]); wb.w = cvtpk(gb1[2], gb1[3]);
                    __builtin_nontemporal_store(wr, (u32x4*)rowp); __builtin_nontemporal_store(wb, (u32x4*)(rowp + 1024)); }
        }
    }
};
struct EpiG2 {
    const bf16* GT; bf16* MRG;
    __device__ __forceinline__ void mid(EPI_ARGS) const {
        const int row0 = u.pm * 256 + wr * 64 + fr, col0 = u.pn * 256 + wc * 32 + 8 * fq;
#pragma unroll
        for (int ai = 0; ai < 2; ++ai)
#pragma unroll
            for (int m = 0; m < 4; ++m) { const bf16* gp = GT + (size_t)(row0 + ai * 128 + m * 16) * 2048 + col0;
#pragma unroll
                for (int bj = 0; bj < 2; ++bj) { const u32x4 rr = __builtin_nontemporal_load((const u32x4*)(gp + bj * 128));
                    const f32x4 r0 = {bflo(rr.x), bfhi(rr.x), bflo(rr.y), bfhi(rr.y)}, r1 = {bflo(rr.z), bfhi(rr.z), bflo(rr.w), bfhi(rr.w)};
                    acc[ai][bj][m][0] *= r0; acc[ai][bj][m][1] *= r1; } }
    }
    __device__ __forceinline__ void operator()(EPI_ARGS) const {
        const int row0 = u.pm * 256 + wr * 64 + fr, col0 = u.pn * 256 + wc * 32 + 8 * fq;
#pragma unroll
        for (int ai = 0; ai < 2; ++ai)
#pragma unroll
            for (int m = 0; m < 4; ++m) { const size_t r = (size_t)(row0 + ai * 128 + m * 16); const bf16* gp = GT + r * 2048 + 1024 + col0; bf16* op = MRG + r * 1024 + col0;
#pragma unroll
                for (int bj = 0; bj < 2; ++bj) { const u32x4 gb = __builtin_nontemporal_load((const u32x4*)(gp + bj * 128)); const f32x4 v0 = acc[ai][bj][m][0], v1 = acc[ai][bj][m][1];
                    u32x4 w; w.x = cvtpk(v0[0] * bflo(gb.x), v0[1] * bfhi(gb.x)); w.y = cvtpk(v0[2] * bflo(gb.y), v0[3] * bfhi(gb.y));
                    w.z = cvtpk(v1[0] * bflo(gb.z), v1[1] * bfhi(gb.z)); w.w = cvtpk(v1[2] * bflo(gb.w), v1[3] * bfhi(gb.w)); *(u32x4*)(op + bj * 128) = w; } }
    }
};
struct EpiPlain {
    bf16* O;
    __device__ __forceinline__ void mid(EPI_ARGS) const {}
    __device__ __forceinline__ void operator()(EPI_ARGS) const {
        const int row0 = u.pm * 256 + wr * 64 + fr, col0 = u.pn * 256 + wc * 32 + 8 * fq;
#pragma unroll
        for (int ai = 0; ai < 2; ++ai)
#pragma unroll
            for (int m = 0; m < 4; ++m) { bf16* op = O + (size_t)(row0 + ai * 128 + m * 16) * 1024 + col0;
#pragma unroll
                for (int bj = 0; bj < 2; ++bj) { const f32x4 v0 = acc[ai][bj][m][0], v1 = acc[ai][bj][m][1];
                    u32x4 w; w.x = cvtpk(v0[0], v0[1]); w.y = cvtpk(v0[2], v0[3]); w.z = cvtpk(v1[0], v1[1]); w.w = cvtpk(v1[2], v1[3]); *(u32x4*)(op + bj * 128) = w; } }
    }
};
struct EpiAct {
    const float* bgu; unsigned char* ACT8;
    __device__ __forceinline__ void mid(EPI_ARGS) const {}
    __device__ __forceinline__ f32x2 act2(f32x2 g, f32x2 l) const {
        f32x2 xg, xl; xg.x = fminf(g.x, SWL); xg.y = fminf(g.y, SWL); xl.x = fminf(fmaxf(l.x, -SWL), SWL); xl.y = fminf(fmaxf(l.y, -SWL), SWL);
        const f32x2 t = xg * (-SWA * LOG2E); f32x2 e; e.x = __builtin_amdgcn_exp2f(t.x); e.y = __builtin_amdgcn_exp2f(t.y);
        const f32x2 d = e + 1.0f; f32x2 r; r.x = __builtin_amdgcn_rcpf(d.x); r.y = __builtin_amdgcn_rcpf(d.y);
        return (xg * r) * (xl * F8_ASCALE + F8_ASCALE);
    }
    __device__ __forceinline__ void operator()(EPI_ARGS) const {
        const int e = u.aux; const int row0 = u.pm * 256 + wr * 64 + fr, col0 = u.pn * 128 + wc * 32 + 8 * fq;
        const float* bp = bgu + (size_t)e * 2048 + col0;
        const f32x4 bg0 = *(const f32x4*)(bp), bg1 = *(const f32x4*)(bp + 4), bl0 = *(const f32x4*)(bp + 1024), bl1 = *(const f32x4*)(bp + 1028);
#pragma unroll
        for (int ai = 0; ai < 2; ++ai)
#pragma unroll
            for (int m = 0; m < 4; ++m) {
                const f32x4 g0 = acc[ai][0][m][0] * F8_DESCALE + bg0, g1 = acc[ai][0][m][1] * F8_DESCALE + bg1, l0 = acc[ai][1][m][0] * F8_DESCALE + bl0, l1 = acc[ai][1][m][1] * F8_DESCALE + bl1;
                const f32x2 o0 = act2((f32x2){g0[0], g0[1]}, (f32x2){l0[0], l0[1]}), o1 = act2((f32x2){g0[2], g0[3]}, (f32x2){l0[2], l0[3]});
                const f32x2 o2 = act2((f32x2){g1[0], g1[1]}, (f32x2){l1[0], l1[1]}), o3 = act2((f32x2){g1[2], g1[3]}, (f32x2){l1[2], l1[3]});
                u32x2 w; w.x = pk_fp8x4_nc(o0.x, o0.y, o1.x, o1.y); w.y = pk_fp8x4_nc(o2.x, o2.y, o3.x, o3.y);
                *(u32x2*)(ACT8 + (size_t)(row0 + ai * 128 + m * 16) * 1024 + col0) = w; }
    }
};
struct EpiDown {
    const float* bdn; unsigned char* Y2s;
    __device__ __forceinline__ void mid(EPI_ARGS) const {}
    __device__ __forceinline__ void operator()(EPI_ARGS) const {
        const int e = u.aux; const int row0 = u.pm * 256 + wr * 64 + fr, col0 = u.pn * 256 + wc * 32 + 8 * fq;
        f32x4 bv[2][2];
#pragma unroll
        for (int bj = 0; bj < 2; ++bj)
#pragma unroll
            for (int n = 0; n < 2; ++n) bv[bj][n] = *(const f32x4*)(bdn + (size_t)e * 1024 + col0 + bj * 128 + 4 * n) * F8_YSCALE;
#pragma unroll
        for (int ai = 0; ai < 2; ++ai)
#pragma unroll
            for (int m = 0; m < 4; ++m) { unsigned char* op = Y2s + (size_t)(row0 + ai * 128 + m * 16) * 1024 + col0;
#pragma unroll
                for (int bj = 0; bj < 2; ++bj) { const f32x4 v0 = acc[ai][bj][m][0] * (F8_DESCALE * F8_YSCALE) + bv[bj][0], v1 = acc[ai][bj][m][1] * (F8_DESCALE * F8_YSCALE) + bv[bj][1];
                    u32x2 w; w.x = pk_fp8x4(v0[0], v0[1], v0[2], v0[3]); w.y = pk_fp8x4(v1[0], v1[1], v1[2], v1[3]); *(u32x2*)(op + bj * 128) = w; } }
    }
};

struct WItem { const float* W; unsigned char* dst; int N, k0, n0, ldt, drow, dk0, fp8; };
__device__ __forceinline__ WItem witem_decode(const Args& a, int r) {
    unsigned char* ws = a.ws; WItem it;
    constexpr int I_IN = 8 * 80, I_GATE = 8 * 64, I_BR = 4 * 32, I_OUT = 8 * 32, I_GU = 8 * 64, I_DN = 8 * 32;
    it.fp8 = 0; it.dk0 = 0; it.ldt = 2048;
    if (r < I_IN) { it.W = a.in[6]; it.N = INW; it.k0 = 128 * (r / 80); it.n0 = 32 * (r % 80); it.dst = ws + WS_W1T; it.drow = it.n0; return it; } r -= I_IN;
    if (r < I_GATE) { it.W = a.in[14]; it.N = 2048; it.k0 = 128 * (r / 64); it.n0 = 32 * (r % 64); it.dst = ws + WS_W1T; const int m0 = it.n0 & 1023;
        it.drow = INW + 256 * (m0 >> 7) + (m0 & 127) + (it.n0 >= 1024 ? 128 : 0); return it; } r -= I_GATE;
    if (r < I_BR) { it.W = a.in[12]; it.N = 1024; it.k0 = 128 * (r / 32); it.n0 = 32 * (r % 32); it.dst = ws + WS_WBRT; it.drow = it.n0; return it; } r -= I_BR;
    if (r < I_BR) { it.W = a.in[13]; it.N = 1024; it.k0 = 128 * (r / 32); it.n0 = 32 * (r % 32); it.dst = ws + WS_WBRT; it.drow = it.n0; it.dk0 = 512; return it; } r -= I_BR;
    if (r < I_OUT) { it.W = a.in[16]; it.N = 1024; it.k0 = 128 * (r / 32); it.n0 = 32 * (r % 32); it.dst = ws + WS_WOUTT; it.drow = it.n0; return it; } r -= I_OUT;
    it.fp8 = 1; it.ldt = 1024;
    if (r < NEXP * I_GU) { const int e = r / I_GU, q = r % I_GU; it.W = a.in[21] + (size_t)e * D * 2048; it.N = 2048; it.k0 = 128 * (q / 64); it.n0 = 32 * (q % 64); it.dst = ws + WS_WGUT + (size_t)e * 2048 * 1024;
        const int m0 = it.n0 & 1023; it.drow = 256 * (m0 >> 7) + (m0 & 127) + (it.n0 >= 1024 ? 128 : 0); return it; }
    r -= NEXP * I_GU;
    { const int e = r / I_DN, q = r % I_DN; it.W = a.in[23] + (size_t)e * D * D; it.N = 1024; it.k0 = 128 * (q / 32); it.n0 = 32 * (q % 32); it.dst = ws + WS_WDNT + (size_t)e * 1024 * 1024; it.drow = it.n0; }
    return it;
}
constexpr int W_NITEMS = 8 * 80 + 8 * 64 + 2 * 4 * 32 + 8 * 32 + NEXP * (8 * 64 + 8 * 32);
__device__ __forceinline__ void witem_load(const WItem& it, float (&v)[64], int lane) {
    const float* p = it.W + (size_t)(it.k0 + (lane >> 3)) * it.N + it.n0 + (lane & 7) * 4;
#pragma unroll
    for (int i = 0; i < 16; ++i) { const f32x4 t = __builtin_nontemporal_load((const f32x4*)(p + (size_t)(8 * i) * it.N)); v[4 * i] = t[0]; v[4 * i + 1] = t[1]; v[4 * i + 2] = t[2]; v[4 * i + 3] = t[3]; }
}
__device__ __forceinline__ void witem_store(const WItem& it, const float (&v)[64], LAS float* scr, int lane) {
#pragma unroll
    for (int i = 0; i < 16; ++i) { const int k = 8 * i + (lane >> 3); *(LAS f32x4*)(scr + k * 32 + (((lane & 7) * 4 + 4 * (i >> 1)) & 31)) = (f32x4){v[4 * i], v[4 * i + 1], v[4 * i + 2], v[4 * i + 3]}; }
    LDS_WAIT(); asm volatile("" ::: "memory");
    const int c = lane & 7;
#pragma unroll
    for (int j = 0; j < 4; ++j) { const int n = (lane >> 3) + 8 * j; const LAS float* s = scr + (16 * c) * 32 + ((n + 4 * c) & 31);
        float x[16];
#pragma unroll
        for (int q = 0; q < 16; ++q) x[q] = s[q * 32];
        unsigned char* d = it.dst + (size_t)(it.drow + n) * it.ldt;
        if (it.fp8) { u32x4 o;
            o.x = pk_fp8x4(x[0] * F8_WSCALE, x[1] * F8_WSCALE, x[2] * F8_WSCALE, x[3] * F8_WSCALE); o.y = pk_fp8x4(x[4] * F8_WSCALE, x[5] * F8_WSCALE, x[6] * F8_WSCALE, x[7] * F8_WSCALE);
            o.z = pk_fp8x4(x[8] * F8_WSCALE, x[9] * F8_WSCALE, x[10] * F8_WSCALE, x[11] * F8_WSCALE); o.w = pk_fp8x4(x[12] * F8_WSCALE, x[13] * F8_WSCALE, x[14] * F8_WSCALE, x[15] * F8_WSCALE);
            __builtin_nontemporal_store(o, (u32x4*)(d + it.dk0 + it.k0 + 16 * c)); }
        else { u32x4 o0, o1;
            o0.x = cvtpk(x[0], x[1]); o0.y = cvtpk(x[2], x[3]); o0.z = cvtpk(x[4], x[5]); o0.w = cvtpk(x[6], x[7]); o1.x = cvtpk(x[8], x[9]); o1.y = cvtpk(x[10], x[11]); o1.z = cvtpk(x[12], x[13]); o1.w = cvtpk(x[14], x[15]);
            *(u32x4*)(d + (size_t)(it.dk0 + it.k0 + 16 * c) * 2) = o0; *(u32x4*)(d + (size_t)(it.dk0 + it.k0 + 16 * c) * 2 + 16) = o1; } }
    LDS_WAIT(); asm volatile("" ::: "memory");
}
__device__ __forceinline__ void phaseA(const Frame& F, const Args& a) {
    unsigned char* ws = a.ws;
    if (F.vcu < 192) {
        const float* c = a.in[1]; const float* w_ada = a.in[2]; const float* b_ada = a.in[3]; float* mod = (float*)(ws + WS_MOD);
        LAS float* red = (LAS float*)(F.lds);
        const int col = F.vcu * 32 + (F.tid & 31), ks = F.tid >> 5;
        float a0 = 0.f, a1 = 0.f, a2 = 0.f, a3 = 0.f;
        for (int k = ks * 64; k < ks * 64 + 64; ++k) { const float w = __builtin_nontemporal_load(w_ada + (size_t)k * 6144 + col);
            const float c0 = c[k], c1 = c[D + k], c2 = c[2 * D + k], c3 = c[3 * D + k];
            a0 += c0 * __builtin_amdgcn_rcpf(1.0f + __expf(-c0)) * w; a1 += c1 * __builtin_amdgcn_rcpf(1.0f + __expf(-c1)) * w;
            a2 += c2 * __builtin_amdgcn_rcpf(1.0f + __expf(-c2)) * w; a3 += c3 * __builtin_amdgcn_rcpf(1.0f + __expf(-c3)) * w; }
        red[(ks * 4 + 0) * 32 + (F.tid & 31)] = a0; red[(ks * 4 + 1) * 32 + (F.tid & 31)] = a1; red[(ks * 4 + 2) * 32 + (F.tid & 31)] = a2; red[(ks * 4 + 3) * 32 + (F.tid & 31)] = a3;
        __syncthreads();
        if (F.tid < 128) { const int b = F.tid >> 5, cc = F.tid & 31; float s = 0.f;
#pragma unroll
            for (int k = 0; k < 16; ++k) s += red[(k * 4 + b) * 32 + cc];
            mod[b * 6144 + F.vcu * 32 + cc] = s + b_ada[F.vcu * 32 + cc]; }
        __syncthreads();
    }
    if (F.vcu == 192 % F.G) {
        const float* w_router = a.in[19]; bf16* wrt = (bf16*)(ws + WS_WRT);
        for (int i = F.tid; i < D * NEXP; i += NWAVES * 64) { const int k = i >> 5, e = i & 31; const float w = w_router[i]; const unsigned hh = cvtpk(w, 0.f) & 0xffffu;
            wrt[(size_t)e * D + k] = (bf16)hh; wrt[(size_t)(NEXP + e) * D + k] = (bf16)(cvtpk(w - bflo(hh), 0.f) & 0xffffu); }
    }
    LAS float* scr = (LAS float*)(F.lds + F.wave * 17408);
    const int gw = F.vcu * NWAVES + F.wave, NGW = F.G * NWAVES;
    if (gw < W_NITEMS) {
        float va[64], vb[64];
        WItem ia = witem_decode(a, gw), ib = ia;
        witem_load(ia, va, F.lane);
        for (int it = gw; it < W_NITEMS; it += 2 * NGW) {
            const bool hb = (it + NGW < W_NITEMS);
            ib = witem_decode(a, hb ? it + NGW : it); witem_load(ib, vb, F.lane);
            witem_store(ia, va, scr, F.lane);
            if (!hb) break;
            const bool ha = (it + 2 * NGW < W_NITEMS);
            ia = witem_decode(a, ha ? it + 2 * NGW : it); witem_load(ia, va, F.lane);
            witem_store(ib, vb, scr, F.lane);
            if (!ha) break;
        }
    }
}
__device__ __forceinline__ void phaseB(const Frame& F, const Args& a) {
    const float* x = a.in[0]; const float* g = a.in[4]; const float* mod = (const float*)(a.ws + WS_MOD); bf16* xn = (bf16*)(a.ws + WS_XN);
    const int gw = F.vcu * NWAVES + F.wave, NGW = F.G * NWAVES;
    f32x4 cg[4], csh[4]; int cb = -1;
    for (int row0 = gw * 4; row0 < NTOK; row0 += NGW * 4) {
        f32x4 v[4][4];
#pragma unroll
        for (int rr = 0; rr < 4; ++rr)
#pragma unroll
            for (int j = 0; j < 4; ++j) v[rr][j] = __builtin_nontemporal_load((const f32x4*)(x + (size_t)(row0 + rr) * D) + F.lane + 64 * j);
        const int b = row0 / SEQ; const float* mb = mod + b * 6144;
        if (b != cb) { cb = b;
#pragma unroll
            for (int j = 0; j < 4; ++j) { const int c0 = (F.lane + 64 * j) * 4; cg[j] = *(const f32x4*)(g + c0) * (*(const f32x4*)(mb + SC1 + c0) + 1.0f); csh[j] = *(const f32x4*)(mb + SH1 + c0); } }
#pragma unroll
        for (int rr = 0; rr < 4; ++rr) {
            float ss = 0.f;
#pragma unroll
            for (int j = 0; j < 4; ++j) ss += (v[rr][j].x * v[rr][j].x + v[rr][j].y * v[rr][j].y) + (v[rr][j].z * v[rr][j].z + v[rr][j].w * v[rr][j].w);
            const float rstd = rsqrtf(wsum(ss) * (1.0f / D) + EPS);
            u32x2* o8 = (u32x2*)(xn + (size_t)(row0 + rr) * D) + F.lane;
#pragma unroll
            for (int j = 0; j < 4; ++j) {
                const f32x4 h = v[rr][j] * rstd * cg[j] + csh[j];
                u32x2 w; w.x = cvtpk(h[0], h[1]); w.y = cvtpk(h[2], h[3]); o8[64 * j] = w; }
        }
    }
}

constexpr int SGU_STRIDE = 1088;
__device__ __forceinline__ s16x4 vtr(const LAS unsigned char* p) { typedef short v4i16_t __attribute__((ext_vector_type(4))); return __builtin_bit_cast(s16x4, __builtin_amdgcn_ds_read_tr16_b64_v4i16((LAS v4i16_t*)p)); }
__device__ __forceinline__ void sgu_unit(const Frame& F, const Args& a, int b, int blk) {
    const bf16* VG = (const bf16*)(a.ws + WS_VG); const bf16* U = (const bf16*)(a.ws + WS_U); bf16* YAB = (bf16*)(a.ws + WS_YAB);
    const float* ln_g = a.in[8]; const float* ln_b = a.in[9]; const float* w_s = a.in[10]; const float* b_s = a.in[11];
    const int tok0 = b * SEQ + blk * SGB, lane = F.lane;
    {
        const f32x4 g0 = *(const f32x4*)(ln_g + lane * 8), g1 = *(const f32x4*)(ln_g + lane * 8 + 4), b0 = *(const f32x4*)(ln_b + lane * 8), b1 = *(const f32x4*)(ln_b + lane * 8 + 4);
#pragma unroll 1
        for (int r4 = 0; r4 < 16; r4 += 4) {
            u32x4 w[4];
#pragma unroll
            for (int rr = 0; rr < 4; ++rr) w[rr] = __builtin_nontemporal_load((const u32x4*)(VG + (size_t)(tok0 + F.wave * 16 + r4 + rr) * 512 + lane * 8));
#pragma unroll
            for (int rr = 0; rr < 4; ++rr) { const int row = F.wave * 16 + r4 + rr;
                f32x4 v0 = {bflo(w[rr].x), bfhi(w[rr].x), bflo(w[rr].y), bfhi(w[rr].y)}, v1 = {bflo(w[rr].z), bfhi(w[rr].z), bflo(w[rr].w), bfhi(w[rr].w)};
                const float mu = wsum((v0[0] + v0[1]) + (v0[2] + v0[3]) + (v1[0] + v1[1]) + (v1[2] + v1[3])) * (1.0f / 512.0f);
                v0 -= mu; v1 -= mu;
                const float var = wsum((v0[0] * v0[0] + v0[1] * v0[1]) + (v0[2] * v0[2] + v0[3] * v0[3]) + (v1[0] * v1[0] + v1[1] * v1[1]) + (v1[2] * v1[2] + v1[3] * v1[3])) * (1.0f / 512.0f);
                const float rstd = rsqrtf(var + EPS);
                v0 = v0 * rstd * g0 + b0; v1 = v1 * rstd * g1 + b1;
                u32x4 o; o.x = cvtpk(v0[0], v0[1]); o.y = cvtpk(v0[2], v0[3]); o.z = cvtpk(v1[0], v1[1]); o.w = cvtpk(v1[2], v1[3]);
                *(LAS u32x4*)(F.lds + row * SGU_STRIDE + lane * 16) = o; }
        }
    }
    __syncthreads();
    {
        const int g = F.wave, r32 = lane & 31, hi = lane >> 5, i16 = lane & 15, g16 = (lane >> 4) & 1;
        const LAS unsigned char* vb = F.lds + (8 * hi + (i16 >> 2)) * SGU_STRIDE + (g * 64 + 16 * g16 + 4 * (i16 & 3)) * 2;
#pragma unroll
        for (int tb = 0; tb < 4; ++tb) {
            const int t = 32 * tb + r32; const float* wrow = w_s + ((size_t)g * 128 + t) * 128;
            f32x4 wr0[8], wr1[8];
#pragma unroll
            for (int ks = 0; ks < 2 * tb + 2; ++ks) { wr0[ks] = *(const f32x4*)(wrow + 16 * ks + 8 * hi); wr1[ks] = *(const f32x4*)(wrow + 16 * ks + 8 * hi + 4); }
            const float bs = b_s[g * 128 + t];
            const bf16* up = U + (size_t)(tok0 + t) * 512 + g * 64 + 4 * hi;
            u32x2 uu0[4], uu1[4];
#pragma unroll
            for (int gg = 0; gg < 4; ++gg) { uu0[gg] = *(const u32x2*)(up + 8 * gg); uu1[gg] = *(const u32x2*)(up + 32 + 8 * gg); }
            f32x16 a0, a1;
#pragma unroll
            for (int r = 0; r < 16; ++r) { a0[r] = 0.f; a1[r] = 0.f; }
#pragma unroll
            for (int ks = 0; ks < 2 * tb + 2; ++ks) {
                const int s0 = 16 * ks + 8 * hi;
                float wv[8] = {wr0[ks][0], wr0[ks][1], wr0[ks][2], wr0[ks][3], wr1[ks][0], wr1[ks][1], wr1[ks][2], wr1[ks][3]};
                if (ks >= 2 * tb) {
#pragma unroll
                    for (int j = 0; j < 8; ++j) wv[j] = (s0 + j <= t) ? wv[j] : 0.f; }
                u32x4 bw; bw.x = cvtpk(wv[0], wv[1]); bw.y = cvtpk(wv[2], wv[3]); bw.z = cvtpk(wv[4], wv[5]); bw.w = cvtpk(wv[6], wv[7]);
                const bf16x8 bfrag = __builtin_bit_cast(bf16x8, bw);
                const LAS unsigned char* p = vb + ks * 16 * SGU_STRIDE;
                const s16x4 l0 = vtr(p), h0 = vtr(p + 4 * SGU_STRIDE), l1 = vtr(p + 64), h1 = vtr(p + 4 * SGU_STRIDE + 64);
                const bf16x8 A0 = {l0[0], l0[1], l0[2], l0[3], h0[0], h0[1], h0[2], h0[3]}, A1 = {l1[0], l1[1], l1[2], l1[3], h1[0], h1[1], h1[2], h1[3]};
                a0 = __builtin_amdgcn_mfma_f32_32x32x16_bf16(A0, bfrag, a0, 0, 0, 0);
                a1 = __builtin_amdgcn_mfma_f32_32x32x16_bf16(A1, bfrag, a1, 0, 0, 0);
            }
            bf16* op = YAB + (size_t)(tok0 + t) * 1024 + 512 + g * 64 + 4 * hi;
#pragma unroll
            for (int gg = 0; gg < 4; ++gg) {
                u32x2 o0, o1;
                o0.x = cvtpk(bflo(uu0[gg].x) * (a0[4 * gg] + bs), bfhi(uu0[gg].x) * (a0[4 * gg + 1] + bs)); o0.y = cvtpk(bflo(uu0[gg].y) * (a0[4 * gg + 2] + bs), bfhi(uu0[gg].y) * (a0[4 * gg + 3] + bs));
                o1.x = cvtpk(bflo(uu1[gg].x) * (a1[4 * gg] + bs), bfhi(uu1[gg].x) * (a1[4 * gg + 1] + bs)); o1.y = cvtpk(bflo(uu1[gg].y) * (a1[4 * gg + 2] + bs), bfhi(uu1[gg].y) * (a1[4 * gg + 3] + bs));
                *(u32x2*)(op + 8 * gg) = o0; *(u32x2*)(op + 32 + 8 * gg) = o1; }
        }
    }
    __syncthreads();
}

constexpr int AT_BUF = 65536, AT_V = 32768, AT_BT = GTAB_OFF;
static_assert(8 * 1088 <= GTAB_BYTES, "bias tables fit above the ring");
__device__ __forceinline__ void attn_chunks(const Frame& F, const Args& a, int gc0, int gc1) {
    const bf16* __restrict__ Q = (const bf16*)(a.ws + WS_Q); const bf16* __restrict__ Kb = (const bf16*)(a.ws + WS_K); const bf16* __restrict__ Vb = (const bf16*)(a.ws + WS_V); bf16* YAB = (bf16*)(a.ws + WS_YAB);
    const int tid = F.tid, lane = F.lane, wave = F.wave, pr = wave >> 1, half = wave & 1;
    const int r32 = lane & 31, hi = lane >> 5, i16 = lane & 15, g16 = (lane >> 4) & 1;
    const int gcs[2] = {gc0, gc1};
    int j0s[2], nts[2], tok0s[2];
#pragma unroll
    for (int i = 0; i < 2; ++i) { const int c = gcs[i] % (SEQ / CHUNK); j0s[i] = (c < NLEFT) ? (NLEFT - c) : 0; nts[i] = 9 - j0s[i]; tok0s[i] = (gcs[i] / (SEQ / CHUNK)) * SEQ + c * CHUNK; }
    const int total = 2 * nts[0] + 2 * nts[1];
    unsigned dsrcK[4], dsrcV[4];
#pragma unroll
    for (int i = 0; i < 4; ++i) { const int piece = 4 * wave + i, hh = piece >> 3, kb = piece & 7, key = 8 * kb + (lane >> 3), slot = lane & 7;
        dsrcK[i] = (unsigned)(key * 512 + hh * 64 + ((slot ^ ((key >> 1) & 7)) << 3)); dsrcV[i] = (unsigned)(key * 512 + hh * 64 + ((slot ^ (((key >> 1) & 1) << 2)) << 3)); }
#define AT_DMA(bufp, tbase) do { _Pragma("unroll") for (int i_ = 0; i_ < 4; ++i_) { const int piece_ = 4 * wave + i_; \
        __builtin_amdgcn_global_load_lds((const unsigned*)(Kb + (tbase) + dsrcK[i_]), (LAS unsigned*)((bufp) + (piece_ >> 3) * 8192 + (piece_ & 7) * 1024), 16, 0, 0); \
        __builtin_amdgcn_global_load_lds((const unsigned*)(Vb + (tbase) + dsrcV[i_]), (LAS unsigned*)((bufp) + AT_V + (piece_ >> 3) * 8192 + (piece_ & 7) * 1024), 16, 0, 0); } } while (0)
    int ko[4];
#pragma unroll
    for (int sI = 0; sI < 4; ++sI) ko[sI] = pr * 8192 + r32 * 128 + ((((2 * sI + hi) ^ ((r32 >> 1) & 7))) << 4);
    const int fb = (i16 >> 3) & 1;
    const int vr0 = AT_V + pr * 8192 + (4 * hi + (i16 >> 2)) * 128 + ((4 * (0 ^ fb) + 2 * g16 + ((i16 & 3) >> 1)) * 16) + (i16 & 1) * 8;
    const int vr1 = AT_V + pr * 8192 + (4 * hi + (i16 >> 2)) * 128 + ((4 * (1 ^ fb) + 2 * g16 + ((i16 & 3) >> 1)) * 16) + (i16 & 1) * 8;
#define AT_DECODE(t, ci, hp, j) do { ci = ((t) >= 2 * nts[0]) ? 1 : 0; const int tt_ = (t) - ci * 2 * nts[0]; hp = (tt_ >= nts[ci]) ? 1 : 0; j = j0s[ci] + tt_ - hp * nts[ci]; } while (0)
    {
        int ci, hp, j; AT_DECODE(0, ci, hp, j);
        const size_t tb0 = (size_t)(tok0s[ci] + (j - NLEFT) * CHUNK) * 512 + hp * 256;
        AT_DMA(F.lds, tb0);
    }
    __syncthreads();
    bf16x8 qf[4]; f32x16 o0, o1; float m = -1e30f, l = 0.f;
#pragma unroll
    for (int r = 0; r < 16; ++r) { o0[r] = 0.f; o1[r] = 0.f; }
#pragma unroll
    for (int sI = 0; sI < 4; ++sI) qf[sI] = (bf16x8){0, 0, 0, 0, 0, 0, 0, 0};
#pragma unroll 1
    for (int t = 0; t < total; ++t) {
        int ci, hp, j; AT_DECODE(t, ci, hp, j);
        const int tn = (t + 1 < total) ? t + 1 : t; int cin, hpn, jn; AT_DECODE(tn, cin, hpn, jn);
        const int h = 4 * hp + pr, qi = half * 32 + r32, qtok = tok0s[ci] + qi;
        if (j == j0s[ci]) {
#pragma unroll
            for (int sI = 0; sI < 4; ++sI) qf[sI] = __builtin_nontemporal_load((const bf16x8*)(Q + (size_t)qtok * 512 + h * 64 + 16 * sI + 8 * hi));
#pragma unroll
            for (int r = 0; r < 16; ++r) { o0[r] = 0.f; o1[r] = 0.f; }
            m = -1e30f; l = 0.f;
        }
        asm volatile("" ::: "memory");
        {
            const size_t tbn = (size_t)(tok0s[cin] + (jn - NLEFT) * CHUNK) * 512 + hpn * 256;
            AT_DMA(F.lds + ((t + 1) & 1) * AT_BUF, tbn);
        }
        asm volatile("" ::: "memory");
        const LAS unsigned char* buf = F.lds + (t & 1) * AT_BUF;
        const bool first = (j == j0s[ci]);
        const float negm = first ? 0.f : -m;
        f32x16 p0, p1;
#pragma unroll
        for (int r = 0; r < 16; ++r) { p0[r] = negm; p1[r] = negm; }
#pragma unroll
        for (int sI = 0; sI < 4; ++sI) { const bf16x8 k0 = *(const LAS bf16x8*)(buf + ko[sI]), k1 = *(const LAS bf16x8*)(buf + ko[sI] + 4096);
            p0 = __builtin_amdgcn_mfma_f32_32x32x16_bf16(k0, qf[sI], p0, 0, 0, 0); p1 = __builtin_amdgcn_mfma_f32_32x32x16_bf16(k1, qf[sI], p1, 0, 0, 0); }
        if (j >= 6) {
            const LAS float* bt = (const LAS float*)(F.lds + AT_BT + h * 1088);
            const int base = 640 + qi - 64 * j - 4 * hi;
#pragma unroll
            for (int r = 0; r < 16; ++r) { const int kk = (r & 3) + 8 * (r >> 2); int i0 = base - kk, i1 = base - 32 - kk; i0 = i0 > 256 ? 256 : i0; i1 = i1 > 256 ? 256 : i1; p0[r] += bt[i0]; p1[r] += bt[i1]; }
        }
        float tm = fmaxf(p0[0], p1[0]);
#pragma unroll
        for (int r = 1; r < 16; ++r) tm = fmaxf(tm, fmaxf(p0[r], p1[r]));
        { const auto rr = __builtin_amdgcn_permlane32_swap(__float_as_uint(tm), __float_as_uint(tm), false, false); tm = fmaxf(__uint_as_float(rr[0]), __uint_as_float(rr[1])); }
        if (first) {
            m = tm;
#pragma unroll
            for (int r = 0; r < 16; ++r) { p0[r] -= tm; p1[r] -= tm; }
        } else if (__any(tm > 0.f)) {
            const float dlt = fmaxf(tm, 0.f), alpha = __builtin_amdgcn_exp2f(-dlt); m += dlt; l *= alpha;
#pragma unroll
            for (int r = 0; r < 16; ++r) { p0[r] -= dlt; p1[r] -= dlt; o0[r] *= alpha; o1[r] *= alpha; }
        }
        float ps = 0.f;
#pragma unroll
        for (int r = 0; r < 16; ++r) { p0[r] = __builtin_amdgcn_exp2f(p0[r]); p1[r] = __builtin_amdgcn_exp2f(p1[r]); ps += p0[r] + p1[r]; }
        l += ps;
        bf16x8 pb[2][2];
#pragma unroll
        for (int sI = 0; sI < 2; ++sI) {
            u32x4 w0; w0.x = cvtpk(p0[8 * sI], p0[8 * sI + 1]); w0.y = cvtpk(p0[8 * sI + 2], p0[8 * sI + 3]); w0.z = cvtpk(p0[8 * sI + 4], p0[8 * sI + 5]); w0.w = cvtpk(p0[8 * sI + 6], p0[8 * sI + 7]);
            u32x4 w1; w1.x = cvtpk(p1[8 * sI], p1[8 * sI + 1]); w1.y = cvtpk(p1[8 * sI + 2], p1[8 * sI + 3]); w1.z = cvtpk(p1[8 * sI + 4], p1[8 * sI + 5]); w1.w = cvtpk(p1[8 * sI + 6], p1[8 * sI + 7]);
            pb[0][sI] = __builtin_bit_cast(bf16x8, w0); pb[1][sI] = __builtin_bit_cast(bf16x8, w1); }
#pragma unroll
        for (int blk = 0; blk < 2; ++blk)
#pragma unroll
            for (int sI = 0; sI < 2; ++sI) {
                const int kof = (32 * blk + 16 * sI) * 128;
                const s16x4 l0 = vtr(buf + vr0 + kof), h0 = vtr(buf + vr0 + kof + 1024), l1 = vtr(buf + vr1 + kof), h1 = vtr(buf + vr1 + kof + 1024);
                const bf16x8 A0 = {l0[0], l0[1], l0[2], l0[3], h0[0], h0[1], h0[2], h0[3]}, A1 = {l1[0], l1[1], l1[2], l1[3], h1[0], h1[1], h1[2], h1[3]};
                o0 = __builtin_amdgcn_mfma_f32_32x32x16_bf16(A0, pb[blk][sI], o0, 0, 0, 0);
                o1 = __builtin_amdgcn_mfma_f32_32x32x16_bf16(A1, pb[blk][sI], o1, 0, 0, 0);
            }
        if (j == 8) {
            float lt = l; { const auto rr = __builtin_amdgcn_permlane32_swap(__float_as_uint(lt), __float_as_uint(lt), false, false); lt = __uint_as_float(rr[0]) + __uint_as_float(rr[1]); }
            const float inv = __builtin_amdgcn_rcpf(lt);
            bf16* op = YAB + (size_t)qtok * 1024 + h * 64 + 4 * hi;
#pragma unroll
            for (int gg = 0; gg < 4; ++gg) {
                u32x2 w0, w1;
                w0.x = cvtpk(o0[4 * gg] * inv, o0[4 * gg + 1] * inv); w0.y = cvtpk(o0[4 * gg + 2] * inv, o0[4 * gg + 3] * inv);
                w1.x = cvtpk(o1[4 * gg] * inv, o1[4 * gg + 1] * inv); w1.y = cvtpk(o1[4 * gg + 2] * inv, o1[4 * gg + 3] * inv);
                *(u32x2*)(op + 8 * gg) = w0; *(u32x2*)(op + 32 + 8 * gg) = w1; }
        }
        __syncthreads();
    }
#undef AT_DMA
#undef AT_DECODE
}
__device__ __forceinline__ void phaseD(const Frame& F, const Args& a) {
    for (int unit = F.vcu; unit < NB * (SEQ / SGB); unit += F.G) sgu_unit(F, a, unit / (SEQ / SGB), unit % (SEQ / SGB));
    for (int i = F.tid; i < NHEAD * NREL; i += NWAVES * 64) { const int h = i / NREL, k = i % NREL; ((LAS float*)(F.lds + AT_BT + h * 1088))[k] = (a.in[7][i] - a.in[7][h * NREL + 256]) * LOG2E; }
    __syncthreads();
    const int NCH = NB * (SEQ / CHUNK);
    for (int v = F.vcu; v < NCH / 2; v += F.G) attn_chunks(F, a, v, NCH - 1 - v);
}

constexpr int G_HT_STRIDE = 2064;
__device__ __forceinline__ void phaseG(const Frame& F, const Args& a) {
    const float* x = a.in[0]; const bf16* Y1 = (const bf16*)(a.ws + WS_Y1); const float* mod = (const float*)(a.ws + WS_MOD); const float* g_post_mix = a.in[5]; const float* g_pre_ffn = a.in[17];
    const float* b_router = a.in[20]; bf16* X1b = (bf16*)(a.ws + WS_X1B); unsigned char* XN8 = a.ws + WS_XN;
    const bf16* wrt = (const bf16*)(a.ws + WS_WRT);
    float* topg = (float*)(a.ws + WS_TOPG); int* list = (int*)(a.ws + WS_LIST); unsigned* cnt = F.ctl + CW_CNT;
    LAS unsigned char* HT = F.lds;
    LAS float* PL = (LAS float*)(F.lds + 33792);
    LAS float* LG = PL + 8 * 16 * 32;
    LAS float* TV = LG + 512;
    LAS unsigned* LC = (LAS unsigned*)(TV + 64);
    LAS unsigned* AS = LC + 64;
    const int tid = F.tid, lane = F.lane, wave = F.wave, kq = lane >> 4, i16 = lane & 15;
    if (tid < 64) LC[tid] = 0u;
    bf16x8 whi[2][4], wlo[2][4];
#pragma unroll
    for (int et = 0; et < 2; ++et)
#pragma unroll
        for (int ks = 0; ks < 4; ++ks) { const size_t o = (size_t)(et * 16 + i16) * D + 128 * wave + 32 * ks + 8 * kq; whi[et][ks] = *(const bf16x8*)(wrt + o); wlo[et][ks] = *(const bf16x8*)(wrt + (size_t)NEXP * D + o); }
    const int myrow = tid >> 5, mye = lane & 31;
    const float mybias = b_router[mye];
    __syncthreads();
    const int NT = NTOK / 16;
    f32x4 xv[2][4]; u32x2 yr[2][4];
    {   const int rbase = 16 * F.vcu + 2 * wave;
#pragma unroll
        for (int rr = 0; rr < 2; ++rr)
#pragma unroll
            for (int j = 0; j < 4; ++j) { const int c0 = (lane + 64 * j) * 4; xv[rr][j] = __builtin_nontemporal_load((const f32x4*)(x + (size_t)(rbase + rr) * D + c0)); yr[rr][j] = __builtin_nontemporal_load((const u32x2*)(Y1 + (size_t)(rbase + rr) * D + c0)); } }
    int tl = 0;
    f32x4 cgp[4], cgf[4], cgt[4], csc[4], csh[4]; int cb = -1;
#pragma unroll
    for (int j = 0; j < 4; ++j) { const int c0 = (lane + 64 * j) * 4; cgp[j] = *(const f32x4*)(g_post_mix + c0); cgf[j] = *(const f32x4*)(g_pre_ffn + c0); }
#pragma unroll 1
    for (int T = F.vcu; T < NT; T += F.G, ++tl) {
        const int b = (16 * T) / SEQ; const float* mb = mod + b * 6144; const int rbase = 16 * T + 2 * wave;
        if (b != cb) { cb = b;
#pragma unroll
            for (int j = 0; j < 4; ++j) { const int c0 = (lane + 64 * j) * 4; cgt[j] = *(const f32x4*)(mb + GT1 + c0); csc[j] = *(const f32x4*)(mb + SC2 + c0) + 1.0f; csh[j] = *(const f32x4*)(mb + SH2 + c0); } }
#pragma unroll
        for (int rr = 0; rr < 2; ++rr) {
            const int row = rbase + rr; f32x4 yv[4]; float ss = 0.f;
#pragma unroll
            for (int j = 0; j < 4; ++j) { yv[j] = (f32x4){bflo(yr[rr][j].x), bfhi(yr[rr][j].x), bflo(yr[rr][j].y), bfhi(yr[rr][j].y)}; ss += (yv[j][0] * yv[j][0] + yv[j][1] * yv[j][1]) + (yv[j][2] * yv[j][2] + yv[j][3] * yv[j][3]); }
            const float rstd = rsqrtf(wsum(ss) * (1.0f / D) + EPS); float s2 = 0.f;
#pragma unroll
            for (int j = 0; j < 4; ++j) { const int c0 = (lane + 64 * j) * 4;
                xv[rr][j] = xv[rr][j] + cgt[j] * (yv[j] * rstd * cgp[j]);
                { u32x2 w1; w1.x = cvtpk(xv[rr][j][0], xv[rr][j][1]); w1.y = cvtpk(xv[rr][j][2], xv[rr][j][3]); __builtin_nontemporal_store(w1, (u32x2*)(X1b + (size_t)row * D + c0)); }
                s2 += (xv[rr][j][0] * xv[rr][j][0] + xv[rr][j][1] * xv[rr][j][1]) + (xv[rr][j][2] * xv[rr][j][2] + xv[rr][j][3] * xv[rr][j][3]); }
            const float rstd2 = rsqrtf(wsum(s2) * (1.0f / D) + EPS);
#pragma unroll
            for (int j = 0; j < 4; ++j) { const int c0 = (lane + 64 * j) * 4;
                const f32x4 h = xv[rr][j] * rstd2 * cgf[j] * csc[j] + csh[j];
                u32x2 w; w.x = cvtpk(h[0], h[1]); w.y = cvtpk(h[2], h[3]); *(unsigned*)(XN8 + (size_t)row * D + c0) = pk_fp8x4(h[0] * F8_ASCALE, h[1] * F8_ASCALE, h[2] * F8_ASCALE, h[3] * F8_ASCALE);
                *(LAS u32x2*)(HT + (2 * wave + rr) * G_HT_STRIDE + c0 * 2) = w; }
        }
        {
            const int Tn = (T + F.G < NT) ? T + F.G : T; const int rb2 = 16 * Tn + 2 * wave;
#pragma unroll
            for (int rr = 0; rr < 2; ++rr)
#pragma unroll
                for (int j = 0; j < 4; ++j) { const int c0 = (lane + 64 * j) * 4; xv[rr][j] = __builtin_nontemporal_load((const f32x4*)(x + (size_t)(rb2 + rr) * D + c0)); yr[rr][j] = __builtin_nontemporal_load((const u32x2*)(Y1 + (size_t)(rb2 + rr) * D + c0)); }
        }
        LDS_WAIT(); __builtin_amdgcn_s_barrier(); asm volatile("" ::: "memory");
        {
            f32x4 acc0 = {0.f, 0.f, 0.f, 0.f}, acc1 = {0.f, 0.f, 0.f, 0.f};
#pragma unroll
            for (int ks = 0; ks < 4; ++ks) { const bf16x8 hb = *(const LAS bf16x8*)(HT + i16 * G_HT_STRIDE + (128 * wave + 32 * ks + 8 * kq) * 2);
                acc0 = __builtin_amdgcn_mfma_f32_16x16x32_bf16(whi[0][ks], hb, acc0, 0, 0, 0); acc0 = __builtin_amdgcn_mfma_f32_16x16x32_bf16(wlo[0][ks], hb, acc0, 0, 0, 0);
                acc1 = __builtin_amdgcn_mfma_f32_16x16x32_bf16(whi[1][ks], hb, acc1, 0, 0, 0); acc1 = __builtin_amdgcn_mfma_f32_16x16x32_bf16(wlo[1][ks], hb, acc1, 0, 0, 0); }
            *(LAS f32x4*)(PL + (wave * 16 + i16) * 32 + 4 * kq) = acc0; *(LAS f32x4*)(PL + (wave * 16 + i16) * 32 + 16 + 4 * kq) = acc1;
        }
        LDS_WAIT(); __builtin_amdgcn_s_barrier(); asm volatile("" ::: "memory");
        float lg = mybias;
#pragma unroll
        for (int w = 0; w < 8; ++w) lg += PL[(w * 16 + myrow) * 32 + mye];
        LG[myrow * 32 + mye] = lg;
        LDS_WAIT(); asm volatile("" ::: "memory");
        int rank = 0;
#pragma unroll
        for (int q = 0; q < 8; ++q) { const f32x4 o = *(const LAS f32x4*)(LG + myrow * 32 + 4 * q);
#pragma unroll
            for (int i = 0; i < 4; ++i) { const int e2 = 4 * q + i; rank += (o[i] > lg || (o[i] == lg && e2 < mye)) ? 1 : 0; } }
        if (rank < 4) TV[myrow * 4 + rank] = lg;
        LDS_WAIT(); asm volatile("" ::: "memory");
        const f32x4 tv = *(const LAS f32x4*)(TV + myrow * 4);
        if (rank < 4) {
            const float den = 1.0f + __expf(tv[1] - tv[0]) + __expf(tv[2] - tv[0]) + __expf(tv[3] - tv[0]);
            const int slot = (16 * T + myrow) * 4 + rank; topg[slot] = __expf(lg - tv[0]) / den;
            const unsigned lp = __hip_atomic_fetch_add(LC + mye, 1u, __ATOMIC_RELAXED, __HIP_MEMORY_SCOPE_WORKGROUP);
            if (tl < 16) AS[tl * 64 + myrow * 4 + rank] = (unsigned)mye | (lp << 8);
        }
    }
    __syncthreads();
    if (tid < NEXP) LC[32 + tid] = atomicAdd(&cnt[tid], LC[tid]);
    __syncthreads();
    for (int i = tid; i < tl * 64; i += NWAVES * 64) { const unsigned as = AS[i]; const int e = as & 255, lp = as >> 8; const int T = F.vcu + (i >> 6) * F.G;
        list[(size_t)e * NTOK + LC[32 + e] + lp] = (16 * T + ((i & 63) >> 2)) * 4 + (i & 3); }
}
__device__ __forceinline__ int moe_tables(const Frame& F) {
    __syncthreads();
    if (F.tid < NEXP) F.MISC[40 + F.tid] = __hip_atomic_load(F.ctl + CW_CNT + F.tid, __ATOMIC_RELAXED, __HIP_MEMORY_SCOPE_AGENT);
    __syncthreads();
    if (F.tid == 0) { unsigned s = 0; for (int e = 0; e < NEXP; ++e) { F.MISC[e] = s; s += (F.MISC[40 + e] + 255u) >> 8; } F.MISC[32] = s; }
    __syncthreads();
    return (int)F.MISC[32];
}
__device__ __forceinline__ void phaseJ(const Frame& F, const Args& a) {
    const unsigned char* Y2s = a.ws + WS_Y2; const bf16* X1b = (const bf16*)(a.ws + WS_X1B); const float* mod = (const float*)(a.ws + WS_MOD); const float* gpf = a.in[18]; float* out = a.out;
    const int* inv = (const int*)(a.ws + WS_TOPE); const float* topg = (const float*)(a.ws + WS_TOPG);
    const int lane = F.lane, gw = F.vcu * NWAVES + F.wave, NGW = F.G * NWAVES;
    f32x4 cgg[4]; int cb = -1;
    for (int row0 = gw * 4; row0 < NTOK; row0 += NGW * 4) {
        const int b = row0 / SEQ; const float* mb = mod + b * 6144;
        if (b != cb) { cb = b;
#pragma unroll
            for (int j = 0; j < 4; ++j) { const int c0 = (lane + 64 * j) * 4; cgg[j] = *(const f32x4*)(gpf + c0) * *(const f32x4*)(mb + GT2 + c0); } }
        int pp[4][4]; float gg[4][4];
#pragma unroll
        for (int rr = 0; rr < 4; ++rr)
#pragma unroll
            for (int k = 0; k < 4; ++k) { pp[rr][k] = __builtin_amdgcn_readfirstlane(inv[(row0 + rr) * 4 + k]); gg[rr][k] = topg[(row0 + rr) * 4 + k] * (1.0f / F8_YSCALE); }
        unsigned yy[4][4][4]; u32x2 xx[4][4];
#pragma unroll
        for (int rr = 0; rr < 4; ++rr)
#pragma unroll
            for (int j = 0; j < 4; ++j) { const int c0 = (lane + 64 * j) * 4;
#pragma unroll
                for (int k = 0; k < 4; ++k) yy[rr][j][k] = __builtin_nontemporal_load((const unsigned*)(Y2s + (size_t)pp[rr][k] * D + c0));
                xx[rr][j] = __builtin_nontemporal_load((const u32x2*)(X1b + (size_t)(row0 + rr) * D + c0)); }
#pragma unroll
        for (int rr = 0; rr < 4; ++rr) {
            f32x4 yv[4]; float ss = 0.f;
#pragma unroll
            for (int j = 0; j < 4; ++j) { f32x4 s = {0.f, 0.f, 0.f, 0.f};
#pragma unroll
                for (int k = 0; k < 4; ++k) { const f32x2 lo = __builtin_amdgcn_cvt_pk_f32_fp8((int)yy[rr][j][k], false), hi = __builtin_amdgcn_cvt_pk_f32_fp8((int)yy[rr][j][k], true);
                    s += (f32x4){lo.x, lo.y, hi.x, hi.y} * gg[rr][k]; }
                yv[j] = s; ss += (s[0] * s[0] + s[1] * s[1]) + (s[2] * s[2] + s[3] * s[3]); }
            const float rstd = rsqrtf(wsum(ss) * (1.0f / D) + EPS);
#pragma unroll
            for (int j = 0; j < 4; ++j) { const int c0 = (lane + 64 * j) * 4;
                const f32x4 x1 = {bflo(xx[rr][j].x), bfhi(xx[rr][j].x), bflo(xx[rr][j].y), bfhi(xx[rr][j].y)};
                __builtin_nontemporal_store(x1 + cgg[j] * (yv[j] * rstd), (f32x4*)(out + (size_t)(row0 + rr) * D + c0)); }
        }
    }
}

constexpr int N_PHASES = 10;
__global__ void __launch_bounds__(NWAVES * 64, 2) mega_fwd(Args args) {
    extern __shared__ __attribute__((aligned(16))) unsigned char lds_raw[];
    Frame F;
    F.lds = (LAS unsigned char*)lds_raw; F.MISC = (volatile LAS unsigned*)(F.lds + MISC_OFF);
    F.tid = threadIdx.x; F.lane = F.tid & 63; F.wave = __builtin_amdgcn_readfirstlane(F.tid >> 6);
    F.G = gridDim.x; { const int bx = blockIdx.x; F.vcu = (F.G % 8 == 0) ? (bx % 8) * (F.G / 8) + bx / 8 : bx; }
    F.ctl = (unsigned*)(args.ws + WS_CTL);
    for (int u = F.tid; u < 128; u += NWAVES * 64) F.MISC[u] = 0u;
    __syncthreads();
    const int lo = args.ph_lo, hi = args.ph_hi;
    XcdBarrier bar; bar.bar = F.ctl + CW_BAR; bar.x = 0; bar.st = F.MISC + 80;
    if (hi - lo > 1) bar = xcd_barrier_post(F.ctl + CW_BAR, F.MISC + 80);
#define IN(k) (lo <= (k) && (k) < hi)
#define SEAM(k) do { if (IN(k) && IN((k) + 1)) xcd_barrier(bar); } while (0)
    unsigned char* ws = args.ws;
    bf16 *XN = (bf16*)(ws + WS_XN), *Qb = (bf16*)(ws + WS_Q), *Kb = (bf16*)(ws + WS_K), *Vb = (bf16*)(ws + WS_V), *Ub = (bf16*)(ws + WS_U), *VG = (bf16*)(ws + WS_VG);
    bf16 *GT = (bf16*)(ws + WS_GT), *YAB = (bf16*)(ws + WS_YAB), *MRG = (bf16*)(ws + WS_MRG), *Y1 = (bf16*)(ws + WS_Y1), *ACT = (bf16*)(ws + WS_ACT), *Y2 = (bf16*)(ws + WS_Y2);

    if (IN(0)) { phaseA(F, args); } SEAM(0);
    if (IN(1)) { phaseB(F, args); } SEAM(1);
    if (IN(2)) {
        SchedStatic S{(const char*)XN, (const char*)(ws + WS_W1T), NTOK / 256, 4608 / 256, F.G, (int)blockIdx.x, (size_t)256 * 1024 * 2, (size_t)256 * 1024 * 2};
        EpiG1 E{Qb, Kb, Vb, Ub, VG, GT, args.in[15]};
        pg8::gemm_phase<EpiG1, SchedStatic, false>(F.lds + RING_OFF, S, E, 2048, 2048, 16);
    } SEAM(2);
    if (IN(3)) { phaseD(F, args); } SEAM(3);
    if (IN(4)) {
        SchedSplit2 S{(const char*)YAB, (const char*)(ws + WS_WBRT), NTOK / 256, 4, F.G, (int)blockIdx.x, (size_t)256 * 1024 * 2, (size_t)256 * 1024 * 2, (size_t)512 * 2};
        EpiG2 E{GT, MRG};
        pg8::gemm_phase<EpiG2, SchedSplit2, false>(F.lds + RING_OFF, S, E, 2048, 2048, 8);
    } SEAM(4);
    if (IN(5)) {
        SchedStatic S{(const char*)MRG, (const char*)(ws + WS_WOUTT), NTOK / 256, 4, F.G, (int)blockIdx.x, (size_t)256 * 1024 * 2, (size_t)256 * 1024 * 2};
        EpiPlain E{Y1};
        pg8::gemm_phase<EpiPlain, SchedStatic, false>(F.lds + RING_OFF, S, E, 2048, 2048, 16);
    } SEAM(5);
    if (IN(6)) { phaseG(F, args); } SEAM(6);
    if (IN(7)) {
        const int nrb = moe_tables(F);
        const int* list = (const int*)(ws + WS_LIST);
        {
            int* inv = (int*)(ws + WS_TOPE);
            for (int g = (int)blockIdx.x * (NWAVES * 64) + F.tid; g < NTOK * TOPK; g += F.G * NWAVES * 64) {
                int e = 0, base = 0;
#pragma unroll 1
                for (int i = 0; i < NEXP; ++i) { const int c = (int)F.MISC[40 + i]; if (g >= base + c) { base += c; e = i + 1; } else break; }
                const int pos = g - base; if (e < NEXP) inv[list[(size_t)e * NTOK + pos]] = (int)F.MISC[e] * 256 + pos; }
        }
        typedef SchedMoe<8, true> SM;
        SM S{(const char*)XN, (const char*)(ws + WS_WGUT), F.MISC, (const LAS unsigned*)(F.lds + GTAB_OFF), (int)blockIdx.x, F.G, nrb, (size_t)2048 * 1024, (size_t)256 * 1024};
        S.build(F.tid);
        { Unit u; LAS unsigned* gt = (LAS unsigned*)(F.lds + GTAB_OFF);
          for (int k = 0; k < GTAB_UNITS && S.next(k, u); ++k) { const int e = u.aux, j256 = (u.pm - (int)F.MISC[e]) * 256, ecnt = (int)F.MISC[40 + e];
              for (int r = F.tid; r < 256; r += NWAVES * 64) { const int pos = j256 + r; int tok = 0; if (pos < ecnt) tok = list[(size_t)e * NTOK + pos] >> 2; gt[k * 256 + r] = (unsigned)tok * 1024u; } } }
        __syncthreads();
        EpiAct E{args.in[22], (unsigned char*)ACT};
        pg8::gemm_phase<EpiAct, SM, true>(F.lds + RING_OFF, S, E, 1024, 1024, 8);
    } SEAM(7);
    if (IN(8)) {
        const int nrb = moe_tables(F);
        typedef SchedMoe<4, true> SM;
        SM S{(const char*)ACT, (const char*)(ws + WS_WDNT), F.MISC, (const LAS unsigned*)(F.lds + GTAB_OFF), (int)blockIdx.x, F.G, nrb, (size_t)1024 * 1024, (size_t)256 * 1024};
        S.build(F.tid);
        { Unit u; LAS unsigned* gt = (LAS unsigned*)(F.lds + GTAB_OFF);
          for (int k = 0; k < GTAB_UNITS && S.next(k, u); ++k) for (int r = F.tid; r < 256; r += NWAVES * 64) gt[k * 256 + r] = (unsigned)(u.pm * 256 + r) * 1024u; }
        __syncthreads();
        EpiDown E{args.in[24], (unsigned char*)Y2};
        pg8::gemm_phase<EpiDown, SM, true>(F.lds + RING_OFF, S, E, 1024, 1024, 8);
    } SEAM(8);
    if (IN(9)) { phaseJ(F, args); }
#undef IN
#undef SEAM
}
extern "C" void kernel_launch(void* const* d_in, const int* in_sizes, int n_in, void* d_out, int out_size, void* d_ws, size_t ws_size, hipStream_t stream) {
    if (n_in != 25 || in_sizes[0] != NTOK * D || out_size != NTOK * D || ws_size < WS_END) { fprintf(stderr, "kernel_launch: unexpected shapes (n_in %d in0 %d out %d ws %zu)\n", n_in, n_in > 0 ? in_sizes[0] : -1, out_size, ws_size); return; }
    static int grid = 0;
    if (grid == 0) {
        int dev = 0, cus = 0, per_cu = 0;
        if (hipGetDevice(&dev) != hipSuccess || hipDeviceGetAttribute(&cus, hipDeviceAttributeMultiprocessorCount, dev) != hipSuccess) { fprintf(stderr, "kernel_launch: device query failed\n"); grid = -1; return; }
        if (hipFuncSetAttribute((const void*)mega_fwd, hipFuncAttributeMaxDynamicSharedMemorySize, LDS_BYTES) != hipSuccess) { fprintf(stderr, "kernel_launch: hipFuncSetAttribute failed\n"); grid = -1; return; }
        if (hipOccupancyMaxActiveBlocksPerMultiprocessor(&per_cu, (const void*)mega_fwd, NWAVES * 64, LDS_BYTES) != hipSuccess || per_cu < 1) { fprintf(stderr, "kernel_launch: occupancy query says %d\n", per_cu); }
        (void)hipGetLastError();
        grid = cus;
    }
    if (grid < 0) return;
    if (hipMemsetAsync((unsigned char*)d_ws + WS_CTL, 0, CTL_ZERO_BYTES, stream) != hipSuccess) { fprintf(stderr, "kernel_launch: memset failed\n"); return; }
    Args a{};
    for (int i = 0; i < 25; ++i) a.in[i] = (const float*)d_in[i];
    a.out = (float*)d_out; a.ws = (unsigned char*)d_ws; a.ph_lo = 0; a.ph_hi = N_PHASES;
    hipLaunchKernelGGL(mega_fwd, dim3(grid), dim3(NWAVES * 64), LDS_BYTES, stream, a);
    if (hipPeekAtLastError() != hipSuccess) fprintf(stderr, "kernel_launch: launch failed\n");
}
```

```cpp
#include <hip/hip_runtime.h>
#include <cstdio>
#include <cstdint>

constexpr int NB = 4, SEQ = 8192, D = 1024, NTOK = NB * SEQ;
constexpr int NHEAD = 8, CHUNK = 64, NLEFT = 8, NREL = 257;
constexpr int SGB = 128;
constexpr int INW = 2560, NEXP = 32, TOPK = 4;
constexpr float EPS = 1e-6f, SWL = 7.0f, SWA = 1.702f;
constexpr float LOG2E = 1.4426950408889634f;
constexpr float QSCALE = 0.125f * LOG2E;
constexpr int SH1 = 0, SC1 = 1024, GT1 = 2048, SH2 = 3072, SC2 = 4096, GT2 = 5120;
typedef unsigned short bf16;

constexpr size_t MiB = 1u << 20;
constexpr size_t WS_CTL = 0, CTL_ZERO_BYTES = 64 * 1024;
constexpr size_t WS_MOD = 1 * MiB;
constexpr size_t WS_W1T = 2 * MiB, WS_WBRT = 12 * MiB, WS_WOUTT = 14 * MiB, WS_WRT = 16 * MiB;
constexpr size_t WS_TOPE = 17 * MiB, WS_TOPG = 18 * MiB, WS_LIST = 19 * MiB;
constexpr size_t WS_WGUT = 32 * MiB, WS_WDNT = 160 * MiB;
constexpr size_t WS_XN = 224 * MiB;
constexpr size_t WS_Q = 288 * MiB, WS_K = 320 * MiB, WS_V = 352 * MiB, WS_U = 384 * MiB, WS_VG = 416 * MiB;
constexpr size_t WS_GT = 448 * MiB;
constexpr size_t WS_YAB = 576 * MiB, WS_MRG = 640 * MiB, WS_Y1 = 704 * MiB;
constexpr size_t WS_ACT = 288 * MiB;
constexpr size_t WS_Y2 = 576 * MiB;
constexpr size_t WS_END = 960 * MiB;
constexpr int CW_CNT = 1024;

#define LAS __attribute__((address_space(3)))
#define GAS __attribute__((address_space(1)))
typedef short bf16x8 __attribute__((ext_vector_type(8)));
typedef short s16x4 __attribute__((ext_vector_type(4)));
typedef float f32x4 __attribute__((ext_vector_type(4)));
typedef float f32x2 __attribute__((ext_vector_type(2)));
typedef float f32x16 __attribute__((ext_vector_type(16)));
typedef unsigned u32x4 __attribute__((ext_vector_type(4)));
typedef unsigned u32x2 __attribute__((ext_vector_type(2)));
typedef __bf16 bf16x2_t __attribute__((ext_vector_type(2)));
constexpr int NWAVES = 8;
constexpr int TRASH_SLOT = NTOK * 4;

__device__ __forceinline__ unsigned cvtpk(float lo, float hi) { f32x2 v = {lo, hi}; bf16x2_t b = __builtin_convertvector(v, bf16x2_t); return __builtin_bit_cast(unsigned, b); }
__device__ __forceinline__ float wsum(float v) {
    v += __builtin_bit_cast(float, __builtin_amdgcn_update_dpp(0, __builtin_bit_cast(int, v), 0xB1, 0xF, 0xF, true));
    v += __builtin_bit_cast(float, __builtin_amdgcn_update_dpp(0, __builtin_bit_cast(int, v), 0x4E, 0xF, 0xF, true));
    v += __builtin_bit_cast(float, __builtin_amdgcn_update_dpp(0, __builtin_bit_cast(int, v), 0x124, 0xF, 0xF, true));
    v += __builtin_bit_cast(float, __builtin_amdgcn_update_dpp(0, __builtin_bit_cast(int, v), 0x128, 0xF, 0xF, true));
    const int iv = __builtin_bit_cast(int, v);
    const float s0 = __builtin_bit_cast(float, __builtin_amdgcn_readlane(iv, 0)), s1 = __builtin_bit_cast(float, __builtin_amdgcn_readlane(iv, 16));
    const float s2 = __builtin_bit_cast(float, __builtin_amdgcn_readlane(iv, 32)), s3 = __builtin_bit_cast(float, __builtin_amdgcn_readlane(iv, 48));
    return (s0 + s1) + (s2 + s3);
}
__device__ __forceinline__ float clamp8(float v) { return fminf(fmaxf(v, -448.0f), 448.0f); }
__device__ __forceinline__ unsigned pk_fp8x4(float a, float b, float c, float d) {
    int w = 0; w = __builtin_amdgcn_cvt_pk_fp8_f32(clamp8(a), clamp8(b), w, false); w = __builtin_amdgcn_cvt_pk_fp8_f32(clamp8(c), clamp8(d), w, true); return (unsigned)w; }
__device__ __forceinline__ unsigned pk_fp8x4_nc(float a, float b, float c, float d) {
    int w = 0; w = __builtin_amdgcn_cvt_pk_fp8_f32(a, b, w, false); w = __builtin_amdgcn_cvt_pk_fp8_f32(c, d, w, true); return (unsigned)w; }
constexpr float F8_YSCALE = 16.0f;
constexpr size_t WS_X1B = 768 * MiB;
constexpr float F8_WSCALE = 64.0f, F8_ASCALE = 4.0f, F8_DESCALE = 1.0f / (64.0f * 4.0f);
__device__ __forceinline__ float bflo(unsigned w) { return __uint_as_float(w << 16); }
__device__ __forceinline__ float bfhi(unsigned w) { return __uint_as_float(w & 0xffff0000u); }
__device__ __forceinline__ float fast_sigmoid(float x) { return __builtin_amdgcn_rcpf(1.0f + __builtin_amdgcn_exp2f(-LOG2E * x)); }
__device__ __forceinline__ f32x2 sigmoid_pk(f32x2 v) { const f32x2 t = v * (-LOG2E); f32x2 e; e.x = __builtin_amdgcn_exp2f(t.x); e.y = __builtin_amdgcn_exp2f(t.y); const f32x2 d = e + 1.0f; f32x2 r; r.x = __builtin_amdgcn_rcpf(d.x); r.y = __builtin_amdgcn_rcpf(d.y); return r; }
__device__ __forceinline__ f32x2 gelu_pk(f32x2 v) {
    const f32x2 av = __builtin_elementwise_abs(v), d = av * 0.2316418882f + 1.0f;
    f32x2 t; t.x = __builtin_amdgcn_rcpf(d.x); t.y = __builtin_amdgcn_rcpf(d.y);
    f32x2 q = t * 0.5307027145f + (-0.7265760135f); q = q * t + 0.7107068705f; q = q * t + (-0.142248368f); q = q * t + 0.127414796f; q = q * t;
    const f32x2 s = (v * v) * (-0.72134752044f);
    f32x2 e; e.x = __builtin_amdgcn_exp2f(s.x); e.y = __builtin_amdgcn_exp2f(s.y);
    const f32x2 m = v * (q * e), r = v - m;
    f32x2 o; o.x = v.x < 0.f ? m.x : r.x; o.y = v.y < 0.f ? m.y : r.y; return o;
}

constexpr int RING_OFF = 0, RING_BYTES = 131072;
constexpr int GTAB_OFF = RING_BYTES, GTAB_UNITS = 20, GTAB_BYTES = GTAB_UNITS * 256 * 4;
constexpr int MISC_OFF = GTAB_OFF + GTAB_BYTES;
constexpr int LDS_BYTES = MISC_OFF + 512;
static_assert(LDS_BYTES <= 160 * 1024, "LDS map");

#define XB_TMO      128
#define XB_XCNT(j)  (256  + 64 * (j))
#define XB_XSUB(j)  (1280 + 64 * (j))
#define XB_XGEN(j)  (2304 + 64 * (j))
#define XB_TOP      3328
#define XB_TOPGEN   3392
#define XCD_BAR_WORDS 3456
#define XB_SPIN_CAP (1u << 18)
__device__ __forceinline__ unsigned xb_ld(unsigned* p)              { return __hip_atomic_load(p, __ATOMIC_RELAXED, __HIP_MEMORY_SCOPE_AGENT); }
__device__ __forceinline__ unsigned xb_add(unsigned* p, unsigned v) { return __hip_atomic_fetch_add(p, v, __ATOMIC_RELAXED, __HIP_MEMORY_SCOPE_AGENT); }
__device__ __forceinline__ unsigned xb_xcc_id() { return (unsigned)__builtin_amdgcn_s_getreg((3 << 11) | 20) & 0xFu; }
#define XB_SPIN(cond, bar) do { unsigned _sp = 0; while (cond) { __builtin_amdgcn_s_sleep(1); \
    if ((++_sp & 255u) == 0u) { if (xb_ld(&(bar)[XB_TMO])) break; if (_sp > XB_SPIN_CAP) { atomicAdd(&(bar)[XB_TMO], 1u); break; } } } } while (0)
struct XcdBarrier { unsigned* bar; unsigned x; volatile LAS unsigned* st; };
__device__ __forceinline__ XcdBarrier xcd_barrier_post(unsigned* bar, volatile LAS unsigned* st) {
    XcdBarrier b; b.bar = bar; b.x = xb_xcc_id(); b.st = st;
    if (threadIdx.x == 0) (void)xb_add(&bar[XB_XCNT(b.x)], 1u);
    return b;
}
__device__ __forceinline__ void xcd_barrier_complete(unsigned* bar, unsigned x, unsigned& nloc, unsigned& nx) {
    const unsigned G = gridDim.x * gridDim.y * gridDim.z;
    unsigned sum, cnt, mine, sp = 0u;
    for (;;) {
        sum = 0u; cnt = 0u; mine = 0u;
#pragma unroll
        for (unsigned j = 0; j < 16; ++j) { const unsigned c = xb_ld(&bar[XB_XCNT(j)]); sum += c; cnt += (c > 0u) ? 1u : 0u; mine = (j == x) ? c : mine; }
        if (sum == G) break;
        __builtin_amdgcn_s_sleep(1);
        if ((++sp & 255u) == 0u) { if (xb_ld(&bar[XB_TMO])) break; if (sp > XB_SPIN_CAP) { atomicAdd(&bar[XB_TMO], 1u); break; } }
    }
    nloc = mine > 0u ? mine : 1u; nx = cnt > 0u ? cnt : 1u;
}
__device__ __forceinline__ void xcd_barrier(const XcdBarrier& b) {
    asm volatile("s_waitcnt vmcnt(0)" ::: "memory");
    __syncthreads();
    if (threadIdx.x == 0) {
        unsigned* bar = b.bar;
        __builtin_amdgcn_s_waitcnt(0);
        unsigned nloc = b.st[0], nx = b.st[1];
        if (nloc == 0u) { xcd_barrier_complete(bar, b.x, nloc, nx); b.st[0] = nloc; b.st[1] = nx; }
        const unsigned old = xb_add(&bar[XB_XSUB(b.x)], 1u);
        const unsigned gen = old / nloc;
        if (old + 1u == (gen + 1u) * nloc) {
            __builtin_amdgcn_fence(__ATOMIC_RELEASE, "agent");
            asm volatile("s_waitcnt vmcnt(0)" ::: "memory");
            const unsigned og = xb_add(&bar[XB_TOP], 1u);
            const unsigned tg = og / nx;
            if (og + 1u == (tg + 1u) * nx) xb_add(&bar[XB_TOPGEN], 1u);
            else XB_SPIN(xb_ld(&bar[XB_TOPGEN]) == tg, bar);
            __builtin_amdgcn_fence(__ATOMIC_ACQUIRE, "agent");
            xb_add(&bar[XB_XGEN(b.x)], 1u);
            asm volatile("s_waitcnt vmcnt(0)" ::: "memory");
        } else {
            XB_SPIN(xb_ld(&bar[XB_XGEN(b.x)]) == gen, bar);
            __builtin_amdgcn_fence(__ATOMIC_ACQUIRE, "agent");
            asm volatile("s_waitcnt vmcnt(0)" ::: "memory");
        }
    }
    __syncthreads();
}
constexpr int CW_BAR = 4096;

namespace pg8 {
constexpr int BM = 256, BK = 64, HALF = 128, HTB = HALF * BK * 2, STAGE_BYTES = 8 * HTB, NXCD = 8, WGM = 8;
__host__ __device__ __forceinline__ int lds_byte(int r, int c) { return r * 128 + ((((c >> 3) ^ (r >> 1)) & 7) << 4); }
__host__ __device__ __forceinline__ void stage_rc(int b, int& R, int& C) { R = b >> 7; C = ((((b >> 4) ^ (R >> 1)) & 7) << 3); }
__host__ __device__ __forceinline__ int perm32(int rho) { const int n = rho >> 4, i = rho & 15; return 8 * (i >> 2) + 4 * n + (i & 3); }
struct Unit { int pm, pn, aux; };
typedef int v4i_t __attribute__((ext_vector_type(4)));
typedef int v8i_t __attribute__((ext_vector_type(8)));

__device__ __forceinline__ bool static_unit(int i, int G, int c, int nM, int nN, int& pm, int& pn) {
    const int nwg = nM * nN; const long L = (long)i * G + c; if (L >= nwg) return false;
    int wgid = (int)L; { const int q = nwg / NXCD, r = nwg % NXCD, xcd = wgid % NXCD, off = wgid / NXCD; wgid = (xcd < r ? xcd * (q + 1) : r * (q + 1) + (xcd - r) * q) + off; }
    const int nig = WGM * nN, gid = wgid / nig, fm = gid * WGM, gsz = (nM - fm) < WGM ? (nM - fm) : WGM;
    pm = fm + ((wgid % nig) % gsz); pn = (wgid % nig) / gsz; return true;
}

template <class Epi, class Sched, bool FP8>
__device__ __forceinline__ void gemm_phase(LAS unsigned char* lds, const Sched& S, const Epi& E, const int lda, const int ldb, const int nt) {
    const int tid = threadIdx.x, wid = __builtin_amdgcn_readfirstlane(tid >> 6), lane = tid & 63, wr = wid >> 2, wc = wid & 3, fr = lane & 15, fq = lane >> 4;
    int Rr[2], Cc[2]; unsigned voffB[2];
#pragma unroll
    for (int i = 0; i < 2; ++i) { stage_rc(tid * 16 + i * 8192, Rr[i], Cc[i]); const int Rb = (Rr[i] & ~31) + perm32(Rr[i] & 31); voffB[i] = (unsigned)(Rb * ldb + Cc[i] * 2); }
    const size_t kstep = (size_t)(BK * 2);
    const size_t hstepB = (size_t)HALF * ldb;
    const size_t hstepA = Sched::GATHER ? (size_t)0 : (size_t)HALF * lda;
    const unsigned ldsw = (unsigned)wid * 1024u;
    const int aoff = lds_byte(wr * 64 + fr, fq * 8), boff = lds_byte(wc * 32 + fr, fq * 8);
#define PG8_SA(b, h) (((b) * 2 + (h)) * HTB)
#define PG8_SB(b, h) ((4 + (b) * 2 + (h)) * HTB)
#define PG8_STAGE(bufoff, gbase, voff) do { _Pragma("unroll") for (int _i = 0; _i < 2; ++_i) \
        __builtin_amdgcn_global_load_lds((const unsigned*)((const char*)(gbase) + (voff)[_i]), (LAS unsigned*)(lds + (bufoff) + ldsw + _i * 8192), 16, 0, 0); } while (0)
#define PG8_LDA(dst, b, h) do { _Pragma("unroll") for (int m = 0; m < 4; ++m) _Pragma("unroll") for (int k = 0; k < 2; ++k) dst[m][k] = *(const LAS bf16x8*)(lds + PG8_SA(b, h) + (aoff ^ (k * 64)) + m * 2048); } while (0)
#define PG8_LDB(dst, b, h) do { _Pragma("unroll") for (int n = 0; n < 2; ++n) _Pragma("unroll") for (int k = 0; k < 2; ++k) dst[n][k] = *(const LAS bf16x8*)(lds + PG8_SB(b, h) + (boff ^ (k * 64)) + n * 2048); } while (0)
#define PG8_CAT(x) __builtin_shufflevector(__builtin_bit_cast(v4i_t, (x)[0]), __builtin_bit_cast(v4i_t, (x)[1]), 0, 1, 2, 3, 4, 5, 6, 7)
#define PG8_MMA(ai, bj, At, Bt) do { __builtin_amdgcn_s_setprio(1); if constexpr (FP8) { _Pragma("unroll") for (int m = 0; m < 4; ++m) _Pragma("unroll") for (int n = 0; n < 2; ++n) \
        acc[ai][bj][m][n] = __builtin_amdgcn_mfma_scale_f32_16x16x128_f8f6f4(PG8_CAT(Bt[n]), PG8_CAT(At[m]), acc[ai][bj][m][n], 0, 0, 0, 0, 0, 0); }   \
    else { _Pragma("unroll") for (int m = 0; m < 4; ++m) _Pragma("unroll") for (int n = 0; n < 2; ++n) _Pragma("unroll") for (int k = 0; k < 2; ++k) \
        acc[ai][bj][m][n] = __builtin_amdgcn_mfma_f32_16x16x32_bf16(Bt[n][k], At[m][k], acc[ai][bj][m][n], 0, 0, 0); } __builtin_amdgcn_s_setprio(0); } while (0)
#define PG8_WAIT_V(n) asm volatile("s_waitcnt vmcnt(" #n ")" ::: "memory")
#define PG8_WAIT_L(n) asm volatile("s_waitcnt lgkmcnt(" #n ")" ::: "memory")
#define PG8_BAR __builtin_amdgcn_s_barrier()
#define PG8_SCHED __builtin_amdgcn_sched_barrier(0)
    Unit cur, nxt; int ui = 0;
    if (!S.next(0, cur)) return;
    f32x4 acc[2][2][4][2];
#pragma unroll
    for (int a = 0; a < 2; ++a)
#pragma unroll
        for (int b = 0; b < 2; ++b)
#pragma unroll
            for (int m = 0; m < 4; ++m)
#pragma unroll
                for (int n = 0; n < 2; ++n) acc[a][b][m][n] = (f32x4){0.f, 0.f, 0.f, 0.f};
    bf16x8 At[4][2], B0[2][2], B1[2][2];
    unsigned oA[2][2];
#pragma unroll
    for (int h = 0; h < 2; ++h)
#pragma unroll
        for (int i = 0; i < 2; ++i) oA[h][i] = Sched::GATHER ? (S.goff(0, h * HALF + Rr[i]) + (unsigned)Cc[i] * 2u) : (unsigned)(Rr[i] * lda + Cc[i] * 2);
    const char* cA = S.aptr(cur); const char* cB = S.bptr(cur);
    PG8_STAGE(PG8_SB(0, 0), cB, voffB); PG8_STAGE(PG8_SB(0, 1), cB + hstepB, voffB); PG8_STAGE(PG8_SA(0, 0), cA, oA[0]); PG8_STAGE(PG8_SA(0, 1), cA + hstepA, oA[1]);
    if (wr == 1) PG8_BAR;
    PG8_WAIT_V(2); PG8_BAR;
    PG8_STAGE(PG8_SB(1, 0), cB + kstep, voffB); PG8_STAGE(PG8_SA(1, 0), cA + kstep, oA[0]); PG8_STAGE(PG8_SB(1, 1), cB + hstepB + kstep, voffB);
    PG8_WAIT_V(6); PG8_BAR;
    for (;;) {
        const bool has_next = S.next(ui + 1, nxt);
        const char* nA = has_next ? S.aptr(nxt) : cA; const char* nB = has_next ? S.bptr(nxt) : cB;
#pragma clang loop unroll(disable)
        for (int t = 0; t < nt; t += 2) {
            const bool last = (t == nt - 2);
            const char* a1 = cA + (size_t)(t + 1) * kstep;
            const char* a2 = last ? nA : cA + (size_t)(t + 2) * kstep; const char* b2 = last ? nB : cB + (size_t)(t + 2) * kstep;
            const char* a3 = a2 + kstep; const char* b3 = b2 + kstep;
            PG8_LDB(B0, 0, 0); PG8_LDB(B1, 0, 1); PG8_SCHED; PG8_LDA(At, 0, 0); PG8_STAGE(PG8_SA(1, 1), a1 + hstepA, oA[1]);
            if constexpr (Sched::GATHER) { if (last && has_next) {
#pragma unroll
                for (int h = 0; h < 2; ++h)
#pragma unroll
                    for (int i = 0; i < 2; ++i) oA[h][i] = S.goff(ui + 1, h * HALF + Rr[i]) + (unsigned)Cc[i] * 2u; } }
            PG8_WAIT_V(8); PG8_WAIT_L(0); PG8_BAR; PG8_MMA(0, 0, At, B0); PG8_MMA(0, 1, At, B1); PG8_BAR; PG8_SCHED;
            PG8_LDA(At, 0, 1); PG8_STAGE(PG8_SB(0, 0), b2, voffB); PG8_STAGE(PG8_SB(0, 1), b2 + hstepB, voffB); PG8_STAGE(PG8_SA(0, 0), a2, oA[0]);
            PG8_WAIT_V(8); PG8_WAIT_L(0); PG8_BAR; PG8_MMA(1, 0, At, B0); PG8_MMA(1, 1, At, B1); PG8_BAR; PG8_SCHED;
            PG8_LDB(B0, 1, 0); PG8_LDB(B1, 1, 1); PG8_SCHED; PG8_LDA(At, 1, 0); PG8_STAGE(PG8_SA(0, 1), a2 + hstepA, oA[1]);
            PG8_WAIT_V(8); PG8_WAIT_L(0); PG8_BAR; PG8_MMA(0, 0, At, B0); PG8_MMA(0, 1, At, B1); PG8_BAR; PG8_SCHED;
            PG8_LDA(At, 1, 1); PG8_STAGE(PG8_SB(1, 0), b3, voffB); PG8_STAGE(PG8_SB(1, 1), b3 + hstepB, voffB); PG8_STAGE(PG8_SA(1, 0), a3, oA[0]);
            PG8_WAIT_V(8); PG8_WAIT_L(0); PG8_BAR; PG8_MMA(1, 0, At, B0); PG8_MMA(1, 1, At, B1); PG8_BAR; PG8_SCHED;
        }
        if (wr == 0) PG8_BAR;
        bool keep = false;
        {
            int tz = threadIdx.x; asm volatile("" : "+v"(tz)); const int ewid = tz >> 6, el = tz & 63, ewr = ewid >> 2, ewc = ewid & 3, efr = el & 15, efq = el >> 4;
            if constexpr (Sched::HAS_MID) { if (S.is_mid(cur)) { E.mid(acc, cur, ewr, ewc, efr, efq); keep = true; } }
            if (!keep) E(acc, cur, ewr, ewc, efr, efq);
        }
        if (!has_next) break;
        if (!keep) {
#pragma unroll
            for (int a = 0; a < 2; ++a)
#pragma unroll
                for (int b = 0; b < 2; ++b)
#pragma unroll
                    for (int m = 0; m < 4; ++m)
#pragma unroll
                        for (int n = 0; n < 2; ++n) acc[a][b][m][n] = (f32x4){0.f, 0.f, 0.f, 0.f};
        }
        cur = nxt; cA = nA; cB = nB; ++ui;
        if (wr == 1) PG8_BAR;
    }
    PG8_WAIT_V(0);
    PG8_BAR;
#undef PG8_SA
#undef PG8_SB
#undef PG8_STAGE
#undef PG8_LDA
#undef PG8_LDB
#undef PG8_MMA
#undef PG8_CAT
#undef PG8_WAIT_V
#undef PG8_WAIT_L
#undef PG8_BAR
#undef PG8_SCHED
}
}
using pg8::Unit;

struct Args { const float* in[25]; float* out; unsigned char* ws; int ph_lo, ph_hi, pad0, pad1; };
static_assert(sizeof(Args) == 27 * 8 + 16, "Args has no padding");
struct Frame {
    LAS unsigned char* lds; volatile LAS unsigned* MISC; unsigned* ctl;
    int tid, lane, wave, vcu, G;
};
#define LDS_WAIT() asm volatile("s_waitcnt lgkmcnt(0)" ::: "memory")
#define VM_WAIT() asm volatile("s_waitcnt vmcnt(0)" ::: "memory")

struct SchedStatic {
    static constexpr bool GATHER = false, HAS_MID = false;
    const char* A; const char* B; int nM, nN, G, c; size_t astep, bstep;
    __device__ __forceinline__ bool next(int i, Unit& u) const { u.aux = 0; return pg8::static_unit(i, G, c, nM, nN, u.pm, u.pn); }
    __device__ __forceinline__ const char* aptr(const Unit& u) const { return A + (size_t)u.pm * astep; }
    __device__ __forceinline__ const char* bptr(const Unit& u) const { return B + (size_t)u.pn * bstep; }
    __device__ __forceinline__ bool is_mid(const Unit&) const { return false; }
    __device__ __forceinline__ unsigned goff(int, int) const { return 0u; }
};
struct SchedSplit2 {
    static constexpr bool GATHER = false, HAS_MID = true;
    const char* A; const char* B; int nM, nN, G, c; size_t astep, bstep, khalf;
    __device__ __forceinline__ bool next(int i, Unit& u) const { u.aux = i & 1; return pg8::static_unit(i >> 1, G, c, nM, nN, u.pm, u.pn); }
    __device__ __forceinline__ const char* aptr(const Unit& u) const { return A + (size_t)u.pm * astep + (size_t)u.aux * khalf; }
    __device__ __forceinline__ const char* bptr(const Unit& u) const { return B + (size_t)u.pn * bstep + (size_t)u.aux * khalf; }
    __device__ __forceinline__ bool is_mid(const Unit& u) const { return u.aux == 0; }
    __device__ __forceinline__ unsigned goff(int, int) const { return 0u; }
};
__device__ __forceinline__ int moe_find_e(volatile LAS unsigned* MISC, int rb) { int e = 0;
#pragma unroll 1
    for (int i = 1; i < NEXP; ++i) e += ((int)MISC[i] <= rb) ? 1 : 0;
    return e; }
template <int NPN, bool GATH>
struct SchedMoe {
    static constexpr bool GATHER = GATH, HAS_MID = false;
    static constexpr int RPX = 32 / NPN;
    static constexpr int UT0 = 96, UTN = 24;
    const char* A; const char* B; volatile LAS unsigned* MISC; const LAS unsigned* gtab; int c, G, nrb; size_t bstep_e, bstep_n;
    __device__ __forceinline__ bool slow_next(int i, Unit& u) const {
        int rb, pn;
        if (G == 256) { const int x = c & 7, j = c >> 3; rb = (8 * i + x) * RPX + j / NPN; pn = j % NPN; }
        else { const long L = (long)i * G + c; rb = (int)(L / NPN); pn = (int)(L % NPN); }
        if (rb >= nrb) return false;
        u.pm = rb; u.pn = pn; u.aux = moe_find_e(MISC, rb); return true;
    }
    __device__ __forceinline__ void build(int tid) const {
        if (tid < UTN) { Unit u; const bool ok = slow_next(tid, u); MISC[UT0 + tid] = ok ? (0x80000000u | ((unsigned)u.aux << 16) | ((unsigned)u.pn << 12) | (unsigned)u.pm) : 0u; }
        __syncthreads();
    }
    __device__ __forceinline__ bool next(int i, Unit& u) const {
        if (i >= UTN) return false;
        const unsigned w = MISC[UT0 + i]; if (!(w >> 31)) return false;
        u.pm = (int)(w & 0xfffu); u.pn = (int)((w >> 12) & 0xfu); u.aux = (int)((w >> 16) & 0xffu); return true;
    }
    __device__ __forceinline__ const char* aptr(const Unit& u) const { return GATH ? A : A + (size_t)u.pm * (256 * 1024); }
    __device__ __forceinline__ const char* bptr(const Unit& u) const { return B + (size_t)u.aux * bstep_e + (size_t)u.pn * bstep_n; }
    __device__ __forceinline__ bool is_mid(const Unit&) const { return false; }
    __device__ __forceinline__ unsigned goff(int ui, int row) const { return gtab[ui * 256 + row]; }
};

#define EPI_ARGS f32x4 (&acc)[2][2][4][2], const Unit& u, int wr, int wc, int fr, int fq
__device__ __forceinline__ u32x4 pair16(u32x2 x, u32x2 y) {
    const auto rx = __builtin_amdgcn_permlane16_swap(x.x, y.x, false, false); const auto ry = __builtin_amdgcn_permlane16_swap(x.y, y.y, false, false);
    return (u32x4){rx[0], ry[0], rx[1], ry[1]};
}
struct EpiG1 {
    bf16 *Q, *K, *V, *U, *VG, *GT; const float* bgate;
    __device__ __forceinline__ void mid(EPI_ARGS) const {}
    __device__ __forceinline__ void operator()(EPI_ARGS) const {
        const int pn = u.pn; const int row0 = u.pm * 256 + wr * 64 + fr;
        if (pn < 6) {
            const int t = pn >> 1; bf16* base = Q + (size_t)t * ((WS_K - WS_Q) / 2); const float sc = (t == 0) ? QSCALE : 1.0f;    const int col0 = (pn & 1) * 256 + wc * 32 + 8 * fq;
#pragma unroll
            for (int ai = 0; ai < 2; ++ai)
#pragma unroll
                for (int m = 0; m < 4; ++m) { bf16* rowp = base + (size_t)(row0 + ai * 128 + m * 16) * 512 + col0;
#pragma unroll
                    for (int bj = 0; bj < 2; ++bj) { const f32x4 v0 = acc[ai][bj][m][0] * sc, v1 = acc[ai][bj][m][1] * sc;
                        u32x4 w; w.x = cvtpk(v0[0], v0[1]); w.y = cvtpk(v0[2], v0[3]); w.z = cvtpk(v1[0], v1[1]); w.w = cvtpk(v1[2], v1[3]); *(u32x4*)(rowp + bj * 128) = w; } }
        } else if (pn < 10) {
            bf16* base = Q + (size_t)(pn >> 1) * ((WS_K - WS_Q) / 2); const int col0 = (pn & 1) * 256 + wc * 32 + 8 * fq;
#pragma unroll
            for (int ai = 0; ai < 2; ++ai)
#pragma unroll
                for (int m = 0; m < 4; ++m) { bf16* rowp = base + (size_t)(row0 + ai * 128 + m * 16) * 512 + col0;
#pragma unroll
                    for (int bj = 0; bj < 2; ++bj) { const f32x4 v0 = acc[ai][bj][m][0], v1 = acc[ai][bj][m][1];
                        const f32x2 a = gelu_pk((f32x2){v0[0], v0[1]}), b = gelu_pk((f32x2){v0[2], v0[3]}), c = gelu_pk((f32x2){v1[0], v1[1]}), d = gelu_pk((f32x2){v1[2], v1[3]});
                        u32x4 w; w.x = cvtpk(a.x, a.y); w.y = cvtpk(b.x, b.y); w.z = cvtpk(c.x, c.y); w.w = cvtpk(d.x, d.y); *(u32x4*)(rowp + bj * 128) = w; } }
        } else {
            const int col0 = (pn - 10) * 128 + wc * 32 + 8 * fq;
            const f32x4 ba0 = *(const f32x4*)(bgate + col0), ba1 = *(const f32x4*)(bgate + col0 + 4), bb0 = *(const f32x4*)(bgate + 1024 + col0), bb1 = *(const f32x4*)(bgate + 1024 + col0 + 4);
#pragma unroll
            for (int ai = 0; ai < 2; ++ai)
#pragma unroll
                for (int m = 0; m < 4; ++m) { bf16* rowp = GT + (size_t)(row0 + ai * 128 + m * 16) * 2048 + col0;
                    const f32x4 a0 = acc[ai][0][m][0] + ba0, a1 = acc[ai][0][m][1] + ba1, b0 = acc[ai][1][m][0] + bb0, b1 = acc[ai][1][m][1] + bb1;
                    f32x4 ea0, ea1, eb0, eb1;
#pragma unroll
                    for (int i = 0; i < 4; ++i) { ea0[i] = __builtin_amdgcn_exp2f(-LOG2E * a0[i]); ea1[i] = __builtin_amdgcn_exp2f(-LOG2E * a1[i]); eb0[i] = fminf(__builtin_amdgcn_exp2f(-LOG2E * b0[i]), 1e18f); eb1[i] = fminf(__builtin_amdgcn_exp2f(-LOG2E * b1[i]), 1e18f); }
                    f32x4 gb0, gb1, r0, r1;
#pragma unroll
                    for (int i = 0; i < 4; ++i) { gb0[i] = __builtin_amdgcn_rcpf(1.0f + eb0[i]); gb1[i] = __builtin_amdgcn_rcpf(1.0f + eb1[i]); r0[i] = (1.0f + eb0[i]) * __builtin_amdgcn_rcpf(1.0f + ea0[i]); r1[i] = (1.0f + eb1[i]) * __builtin_amdgcn_rcpf(1.0f + ea1[i]); }
                    u32x4 wr, wb; wr.x = cvtpk(r0[0], r0[1]); wr.y = cvtpk(r0[2], r0[3]); wr.z = cvtpk(r1[0], r1[1]); wr.w = cvtpk(r1[2], r1[3]);
                    wb.x = cvtpk(gb0[0], gb0[1]); wb.y = cvtpk(gb0[2], gb0[3]); wb.z = cvtpk(gb1[0], gb1[1]); wb.w = cvtpk(gb1[2], gb1[3]);
                    __builtin_nontemporal_store(wr, (u32x4*)rowp); __builtin_nontemporal_store(wb, (u32x4*)(rowp + 1024)); }
        }
    }
};
struct EpiG2 {
    const bf16* GT; bf16* MRG;
    __device__ __forceinline__ void mid(EPI_ARGS) const {
        const int row0 = u.pm * 256 + wr * 64 + fr, col0 = u.pn * 256 + wc * 32 + 8 * fq;
#pragma unroll
        for (int ai = 0; ai < 2; ++ai)
#pragma unroll
            for (int m = 0; m < 4; ++m) { const bf16* gp = GT + (size_t)(row0 + ai * 128 + m * 16) * 2048 + col0;
#pragma unroll
                for (int bj = 0; bj < 2; ++bj) { const u32x4 rr = __builtin_nontemporal_load((const u32x4*)(gp + bj * 128));
                    const f32x4 r0 = {bflo(rr.x), bfhi(rr.x), bflo(rr.y), bfhi(rr.y)}, r1 = {bflo(rr.z), bfhi(rr.z), bflo(rr.w), bfhi(rr.w)};
                    acc[ai][bj][m][0] *= r0; acc[ai][bj][m][1] *= r1; } }
    }
    __device__ __forceinline__ void operator()(EPI_ARGS) const {
        const int row0 = u.pm * 256 + wr * 64 + fr, col0 = u.pn * 256 + wc * 32 + 8 * fq;
#pragma unroll
        for (int ai = 0; ai < 2; ++ai)
#pragma unroll
            for (int m = 0; m < 4; ++m) { const size_t r = (size_t)(row0 + ai * 128 + m * 16); const bf16* gp = GT + r * 2048 + 1024 + col0; bf16* op = MRG + r * 1024 + col0;
#pragma unroll
                for (int bj = 0; bj < 2; ++bj) { const u32x4 gb = __builtin_nontemporal_load((const u32x4*)(gp + bj * 128)); const f32x4 v0 = acc[ai][bj][m][0], v1 = acc[ai][bj][m][1];
                    u32x4 w; w.x = cvtpk(v0[0] * bflo(gb.x), v0[1] * bfhi(gb.x)); w.y = cvtpk(v0[2] * bflo(gb.y), v0[3] * bfhi(gb.y));
                    w.z = cvtpk(v1[0] * bflo(gb.z), v1[1] * bfhi(gb.z)); w.w = cvtpk(v1[2] * bflo(gb.w), v1[3] * bfhi(gb.w)); *(u32x4*)(op + bj * 128) = w; } }
    }
};
struct EpiPlain {
    bf16* O;
    __device__ __forceinline__ void mid(EPI_ARGS) const {}
    __device__ __forceinline__ void operator()(EPI_ARGS) const {
        const int row0 = u.pm * 256 + wr * 64 + fr, col0 = u.pn * 256 + wc * 32 + 8 * fq;
#pragma unroll
        for (int ai = 0; ai < 2; ++ai)
#pragma unroll
            for (int m = 0; m < 4; ++m) { bf16* op = O + (size_t)(row0 + ai * 128 + m * 16) * 1024 + col0;
#pragma unroll
                for (int bj = 0; bj < 2; ++bj) { const f32x4 v0 = acc[ai][bj][m][0], v1 = acc[ai][bj][m][1];
                    u32x4 w; w.x = cvtpk(v0[0], v0[1]); w.y = cvtpk(v0[2], v0[3]); w.z = cvtpk(v1[0], v1[1]); w.w = cvtpk(v1[2], v1[3]); *(u32x4*)(op + bj * 128) = w; } }
    }
};
struct EpiAct {
    const float* bgu; unsigned char* ACT8;
    __device__ __forceinline__ void mid(EPI_ARGS) const {}
    __device__ __forceinline__ f32x2 act2(f32x2 g, f32x2 l) const {
        f32x2 xg, xl; xg.x = fminf(g.x, SWL); xg.y = fminf(g.y, SWL); xl.x = fminf(fmaxf(l.x, -SWL), SWL); xl.y = fminf(fmaxf(l.y, -SWL), SWL);
        const f32x2 t = xg * (-SWA * LOG2E); f32x2 e; e.x = __builtin_amdgcn_exp2f(t.x); e.y = __builtin_amdgcn_exp2f(t.y);
        const f32x2 d = e + 1.0f; f32x2 r; r.x = __builtin_amdgcn_rcpf(d.x); r.y = __builtin_amdgcn_rcpf(d.y);
        return (xg * r) * (xl * F8_ASCALE + F8_ASCALE);
    }
    __device__ __forceinline__ void operator()(EPI_ARGS) const {
        const int e = u.aux; const int row0 = u.pm * 256 + wr * 64 + fr, col0 = u.pn * 128 + wc * 32 + 8 * fq;
        const float* bp = bgu + (size_t)e * 2048 + col0;
        const f32x4 bg0 = *(const f32x4*)(bp), bg1 = *(const f32x4*)(bp + 4), bl0 = *(const f32x4*)(bp + 1024), bl1 = *(const f32x4*)(bp + 1028);
#pragma unroll
        for (int ai = 0; ai < 2; ++ai)
#pragma unroll
            for (int mp = 0; mp < 2; ++mp) {
                u32x2 w[2];
#pragma unroll
                for (int mm = 0; mm < 2; ++mm) { const int m = 2 * mp + mm;
                    const f32x4 g0 = acc[ai][0][m][0] * F8_DESCALE + bg0, g1 = acc[ai][0][m][1] * F8_DESCALE + bg1, l0 = acc[ai][1][m][0] * F8_DESCALE + bl0, l1 = acc[ai][1][m][1] * F8_DESCALE + bl1;
                    const f32x2 o0 = act2((f32x2){g0[0], g0[1]}, (f32x2){l0[0], l0[1]}), o1 = act2((f32x2){g0[2], g0[3]}, (f32x2){l0[2], l0[3]});
                    const f32x2 o2 = act2((f32x2){g1[0], g1[1]}, (f32x2){l1[0], l1[1]}), o3 = act2((f32x2){g1[2], g1[3]}, (f32x2){l1[2], l1[3]});
                    w[mm].x = pk_fp8x4_nc(o0.x, o0.y, o1.x, o1.y); w[mm].y = pk_fp8x4_nc(o2.x, o2.y, o3.x, o3.y); }
                *(u32x4*)(ACT8 + (size_t)(row0 + ai * 128 + (2 * mp + (fq & 1)) * 16) * 1024 + (col0 - 8 * (fq & 1))) = pair16(w[0], w[1]); }
    }
};
struct EpiDown {
    const float* bdn; unsigned char* Y2s;
    __device__ __forceinline__ void mid(EPI_ARGS) const {}
    __device__ __forceinline__ void operator()(EPI_ARGS) const {
        const int e = u.aux; const int row0 = u.pm * 256 + wr * 64 + fr, col0 = u.pn * 256 + wc * 32 + 8 * fq;
        f32x4 bv[2][2];
#pragma unroll
        for (int bj = 0; bj < 2; ++bj)
#pragma unroll
            for (int n = 0; n < 2; ++n) bv[bj][n] = *(const f32x4*)(bdn + (size_t)e * 1024 + col0 + bj * 128 + 4 * n) * F8_YSCALE;
#pragma unroll
        for (int ai = 0; ai < 2; ++ai)
#pragma unroll
            for (int mp = 0; mp < 2; ++mp) { unsigned char* op = Y2s + (size_t)(row0 + ai * 128 + (2 * mp + (fq & 1)) * 16) * 1024 + (col0 - 8 * (fq & 1));
#pragma unroll
                for (int bj = 0; bj < 2; ++bj) { u32x2 w[2];
#pragma unroll
                    for (int mm = 0; mm < 2; ++mm) { const int m = 2 * mp + mm;
                        const f32x4 v0 = acc[ai][bj][m][0] * (F8_DESCALE * F8_YSCALE) + bv[bj][0], v1 = acc[ai][bj][m][1] * (F8_DESCALE * F8_YSCALE) + bv[bj][1];
                        w[mm].x = pk_fp8x4(v0[0], v0[1], v0[2], v0[3]); w[mm].y = pk_fp8x4(v1[0], v1[1], v1[2], v1[3]); }
                    *(u32x4*)(op + bj * 128) = pair16(w[0], w[1]); } }
    }
};

struct WItem { const float* W; unsigned char* dst; int N, k0, n0, ldt, drow, dk0, fp8; };
__device__ __forceinline__ WItem witem_decode(const Args& a, int r) {
    unsigned char* ws = a.ws; WItem it;
    constexpr int I_IN = 8 * 80, I_GATE = 8 * 64, I_BR = 4 * 32, I_OUT = 8 * 32, I_GU = 8 * 64, I_DN = 8 * 32;
    it.fp8 = 0; it.dk0 = 0; it.ldt = 2048;
    if (r < I_IN) { it.W = a.in[6]; it.N = INW; it.k0 = 128 * (r / 80); it.n0 = 32 * (r % 80); it.dst = ws + WS_W1T; it.drow = it.n0; return it; } r -= I_IN;
    if (r < I_GATE) { it.W = a.in[14]; it.N = 2048; it.k0 = 128 * (r / 64); it.n0 = 32 * (r % 64); it.dst = ws + WS_W1T; const int m0 = it.n0 & 1023;
        it.drow = INW + 256 * (m0 >> 7) + (m0 & 127) + (it.n0 >= 1024 ? 128 : 0); return it; } r -= I_GATE;
    if (r < I_BR) { it.W = a.in[12]; it.N = 1024; it.k0 = 128 * (r / 32); it.n0 = 32 * (r % 32); it.dst = ws + WS_WBRT; it.drow = it.n0; return it; } r -= I_BR;
    if (r < I_BR) { it.W = a.in[13]; it.N = 1024; it.k0 = 128 * (r / 32); it.n0 = 32 * (r % 32); it.dst = ws + WS_WBRT; it.drow = it.n0; it.dk0 = 512; return it; } r -= I_BR;
    if (r < I_OUT) { it.W = a.in[16]; it.N = 1024; it.k0 = 128 * (r / 32); it.n0 = 32 * (r % 32); it.dst = ws + WS_WOUTT; it.drow = it.n0; return it; } r -= I_OUT;
    it.fp8 = 1; it.ldt = 1024;
    if (r < NEXP * I_GU) { const int e = r / I_GU, q = r % I_GU; it.W = a.in[21] + (size_t)e * D * 2048; it.N = 2048; it.k0 = 128 * (q / 64); it.n0 = 32 * (q % 64); it.dst = ws + WS_WGUT + (size_t)e * 2048 * 1024;
        const int m0 = it.n0 & 1023; it.drow = 256 * (m0 >> 7) + (m0 & 127) + (it.n0 >= 1024 ? 128 : 0); return it; }
    r -= NEXP * I_GU;
    { const int e = r / I_DN, q = r % I_DN; it.W = a.in[23] + (size_t)e * D * D; it.N = 1024; it.k0 = 128 * (q / 32); it.n0 = 32 * (q % 32); it.dst = ws + WS_WDNT + (size_t)e * 1024 * 1024; it.drow = it.n0; }
    return it;
}
constexpr int W_NITEMS = 8 * 80 + 8 * 64 + 2 * 4 * 32 + 8 * 32 + NEXP * (8 * 64 + 8 * 32);
__device__ __forceinline__ void witem_load(const WItem& it, float (&v)[64], int lane) {
    const float* p = it.W + (size_t)(it.k0 + (lane >> 3)) * it.N + it.n0 + (lane & 7) * 4;
#pragma unroll
    for (int i = 0; i < 16; ++i) { const f32x4 t = __builtin_nontemporal_load((const f32x4*)(p + (size_t)(8 * i) * it.N)); v[4 * i] = t[0]; v[4 * i + 1] = t[1]; v[4 * i + 2] = t[2]; v[4 * i + 3] = t[3]; }
}
__device__ __forceinline__ void witem_store(const WItem& it, const float (&v)[64], LAS float* scr, int lane) {
#pragma unroll
    for (int i = 0; i < 16; ++i) { const int k = 8 * i + (lane >> 3); *(LAS f32x4*)(scr + k * 32 + (((lane & 7) * 4 + 4 * (i >> 1)) & 31)) = (f32x4){v[4 * i], v[4 * i + 1], v[4 * i + 2], v[4 * i + 3]}; }
    LDS_WAIT(); asm volatile("" ::: "memory");
    const int c = lane & 7;
#pragma unroll
    for (int j = 0; j < 4; ++j) { const int n = (lane >> 3) + 8 * j; const LAS float* s = scr + (16 * c) * 32 + ((n + 4 * c) & 31);
        float x[16];
#pragma unroll
        for (int q = 0; q < 16; ++q) x[q] = s[q * 32];
        unsigned char* d = it.dst + (size_t)(it.drow + n) * it.ldt;
        if (it.fp8) { u32x4 o;
            o.x = pk_fp8x4(x[0] * F8_WSCALE, x[1] * F8_WSCALE, x[2] * F8_WSCALE, x[3] * F8_WSCALE); o.y = pk_fp8x4(x[4] * F8_WSCALE, x[5] * F8_WSCALE, x[6] * F8_WSCALE, x[7] * F8_WSCALE);
            o.z = pk_fp8x4(x[8] * F8_WSCALE, x[9] * F8_WSCALE, x[10] * F8_WSCALE, x[11] * F8_WSCALE); o.w = pk_fp8x4(x[12] * F8_WSCALE, x[13] * F8_WSCALE, x[14] * F8_WSCALE, x[15] * F8_WSCALE);
            __builtin_nontemporal_store(o, (u32x4*)(d + it.dk0 + it.k0 + 16 * c)); }
        else { u32x4 o0, o1;
            o0.x = cvtpk(x[0], x[1]); o0.y = cvtpk(x[2], x[3]); o0.z = cvtpk(x[4], x[5]); o0.w = cvtpk(x[6], x[7]); o1.x = cvtpk(x[8], x[9]); o1.y = cvtpk(x[10], x[11]); o1.z = cvtpk(x[12], x[13]); o1.w = cvtpk(x[14], x[15]);
            *(u32x4*)(d + (size_t)(it.dk0 + it.k0 + 16 * c) * 2) = o0; *(u32x4*)(d + (size_t)(it.dk0 + it.k0 + 16 * c) * 2 + 16) = o1; } }
    LDS_WAIT(); asm volatile("" ::: "memory");
}
__device__ __forceinline__ void phaseA(const Frame& F, const Args& a) {
    unsigned char* ws = a.ws;
    if (F.vcu < 192) {
        const float* c = a.in[1]; const float* w_ada = a.in[2]; const float* b_ada = a.in[3]; float* mod = (float*)(ws + WS_MOD);
        LAS float* red = (LAS float*)(F.lds);
        const int col = F.vcu * 32 + (F.tid & 31), ks = F.tid >> 5;
        float a0 = 0.f, a1 = 0.f, a2 = 0.f, a3 = 0.f;
        for (int k = ks * 64; k < ks * 64 + 64; ++k) { const float w = __builtin_nontemporal_load(w_ada + (size_t)k * 6144 + col);
            const float c0 = c[k], c1 = c[D + k], c2 = c[2 * D + k], c3 = c[3 * D + k];
            a0 += c0 * __builtin_amdgcn_rcpf(1.0f + __expf(-c0)) * w; a1 += c1 * __builtin_amdgcn_rcpf(1.0f + __expf(-c1)) * w;
            a2 += c2 * __builtin_amdgcn_rcpf(1.0f + __expf(-c2)) * w; a3 += c3 * __builtin_amdgcn_rcpf(1.0f + __expf(-c3)) * w; }
        red[(ks * 4 + 0) * 32 + (F.tid & 31)] = a0; red[(ks * 4 + 1) * 32 + (F.tid & 31)] = a1; red[(ks * 4 + 2) * 32 + (F.tid & 31)] = a2; red[(ks * 4 + 3) * 32 + (F.tid & 31)] = a3;
        __syncthreads();
        if (F.tid < 128) { const int b = F.tid >> 5, cc = F.tid & 31; float s = 0.f;
#pragma unroll
            for (int k = 0; k < 16; ++k) s += red[(k * 4 + b) * 32 + cc];
            mod[b * 6144 + F.vcu * 32 + cc] = s + b_ada[F.vcu * 32 + cc]; }
        __syncthreads();
    }
    if (F.vcu == 192 % F.G) {
        const float* w_router = a.in[19]; bf16* wrt = (bf16*)(ws + WS_WRT);
        for (int i = F.tid; i < D * NEXP; i += NWAVES * 64) { const int k = i >> 5, e = i & 31; const float w = w_router[i]; const unsigned hh = cvtpk(w, 0.f) & 0xffffu;
            wrt[(size_t)e * D + k] = (bf16)hh; wrt[(size_t)(NEXP + e) * D + k] = (bf16)(cvtpk(w - bflo(hh), 0.f) & 0xffffu); }
    }
    LAS float* scr = (LAS float*)(F.lds + F.wave * 17408);
    const int gw = F.vcu * NWAVES + F.wave, NGW = F.G * NWAVES;
    if (gw < W_NITEMS) {
        float va[64], vb[64];
        WItem ia = witem_decode(a, gw), ib = ia;
        witem_load(ia, va, F.lane);
        for (int it = gw; it < W_NITEMS; it += 2 * NGW) {
            const bool hb = (it + NGW < W_NITEMS);
            ib = witem_decode(a, hb ? it + NGW : it); witem_load(ib, vb, F.lane);
            witem_store(ia, va, scr, F.lane);
            if (!hb) break;
            const bool ha = (it + 2 * NGW < W_NITEMS);
            ia = witem_decode(a, ha ? it + 2 * NGW : it); witem_load(ia, va, F.lane);
            witem_store(ib, vb, scr, F.lane);
            if (!ha) break;
        }
    }
}
__device__ __forceinline__ void phaseB(const Frame& F, const Args& a) {
    const float* x = a.in[0]; const float* g = a.in[4]; const float* mod = (const float*)(a.ws + WS_MOD); bf16* xn = (bf16*)(a.ws + WS_XN);
    const int gw = F.vcu * NWAVES + F.wave, NGW = F.G * NWAVES;
    f32x4 cg[4], csh[4]; int cb = -1;
    for (int row0 = gw * 4; row0 < NTOK; row0 += NGW * 4) {
        f32x4 v[4][4];
#pragma unroll
        for (int rr = 0; rr < 4; ++rr)
#pragma unroll
            for (int j = 0; j < 4; ++j) v[rr][j] = __builtin_nontemporal_load((const f32x4*)(x + (size_t)(row0 + rr) * D) + F.lane + 64 * j);
        const int b = row0 / SEQ; const float* mb = mod + b * 6144;
        if (b != cb) { cb = b;
#pragma unroll
            for (int j = 0; j < 4; ++j) { const int c0 = (F.lane + 64 * j) * 4; cg[j] = *(const f32x4*)(g + c0) * (*(const f32x4*)(mb + SC1 + c0) + 1.0f); csh[j] = *(const f32x4*)(mb + SH1 + c0); } }
#pragma unroll
        for (int rr = 0; rr < 4; ++rr) {
            float ss = 0.f;
#pragma unroll
            for (int j = 0; j < 4; ++j) ss += (v[rr][j].x * v[rr][j].x + v[rr][j].y * v[rr][j].y) + (v[rr][j].z * v[rr][j].z + v[rr][j].w * v[rr][j].w);
            const float rstd = rsqrtf(wsum(ss) * (1.0f / D) + EPS);
            u32x2* o8 = (u32x2*)(xn + (size_t)(row0 + rr) * D) + F.lane;
#pragma unroll
            for (int j = 0; j < 4; ++j) {
                const f32x4 h = v[rr][j] * rstd * cg[j] + csh[j];
                u32x2 w; w.x = cvtpk(h[0], h[1]); w.y = cvtpk(h[2], h[3]); o8[64 * j] = w; }
        }
    }
}

__device__ __forceinline__ void store_row32(bf16* blk, u32x2 w0, u32x2 w1, u32x2 w2, u32x2 w3, int hi) {
    { const auto rx = __builtin_amdgcn_permlane32_swap(w0.x, w1.x, false, false); const auto ry = __builtin_amdgcn_permlane32_swap(w0.y, w1.y, false, false);
      u32x4 o = {rx[0], ry[0], rx[1], ry[1]}; *(u32x4*)(blk + (hi ? 8 : 0)) = o; }
    { const auto rx = __builtin_amdgcn_permlane32_swap(w2.x, w3.x, false, false); const auto ry = __builtin_amdgcn_permlane32_swap(w2.y, w3.y, false, false);
      u32x4 o = {rx[0], ry[0], rx[1], ry[1]}; *(u32x4*)(blk + 16 + (hi ? 8 : 0)) = o; }
}
constexpr int SGU_STRIDE = 1088;
__device__ __forceinline__ s16x4 vtr(const LAS unsigned char* p) { typedef short v4i16_t __attribute__((ext_vector_type(4))); return __builtin_bit_cast(s16x4, __builtin_amdgcn_ds_read_tr16_b64_v4i16((LAS v4i16_t*)p)); }
__device__ __forceinline__ void sgu_unit(const Frame& F, const Args& a, int b, int blk) {
    const bf16* VG = (const bf16*)(a.ws + WS_VG); const bf16* U = (const bf16*)(a.ws + WS_U); bf16* YAB = (bf16*)(a.ws + WS_YAB);
    const float* ln_g = a.in[8]; const float* ln_b = a.in[9]; const float* w_s = a.in[10]; const float* b_s = a.in[11];
    const int tok0 = b * SEQ + blk * SGB, lane = F.lane;
    {
        const f32x4 g0 = *(const f32x4*)(ln_g + lane * 8), g1 = *(const f32x4*)(ln_g + lane * 8 + 4), b0 = *(const f32x4*)(ln_b + lane * 8), b1 = *(const f32x4*)(ln_b + lane * 8 + 4);
#pragma unroll 1
        for (int r4 = 0; r4 < 16; r4 += 4) {
            u32x4 w[4];
#pragma unroll
            for (int rr = 0; rr < 4; ++rr) w[rr] = __builtin_nontemporal_load((const u32x4*)(VG + (size_t)(tok0 + F.wave * 16 + r4 + rr) * 512 + lane * 8));
#pragma unroll
            for (int rr = 0; rr < 4; ++rr) { const int row = F.wave * 16 + r4 + rr;
                f32x4 v0 = {bflo(w[rr].x), bfhi(w[rr].x), bflo(w[rr].y), bfhi(w[rr].y)}, v1 = {bflo(w[rr].z), bfhi(w[rr].z), bflo(w[rr].w), bfhi(w[rr].w)};
                const float mu = wsum((v0[0] + v0[1]) + (v0[2] + v0[3]) + (v1[0] + v1[1]) + (v1[2] + v1[3])) * (1.0f / 512.0f);
                v0 -= mu; v1 -= mu;
                const float var = wsum((v0[0] * v0[0] + v0[1] * v0[1]) + (v0[2] * v0[2] + v0[3] * v0[3]) + (v1[0] * v1[0] + v1[1] * v1[1]) + (v1[2] * v1[2] + v1[3] * v1[3])) * (1.0f / 512.0f);
                const float rstd = rsqrtf(var + EPS);
                v0 = v0 * rstd * g0 + b0; v1 = v1 * rstd * g1 + b1;
                u32x4 o; o.x = cvtpk(v0[0], v0[1]); o.y = cvtpk(v0[2], v0[3]); o.z = cvtpk(v1[0], v1[1]); o.w = cvtpk(v1[2], v1[3]);
                *(LAS u32x4*)(F.lds + row * SGU_STRIDE + lane * 16) = o; }
        }
    }
    __syncthreads();
    {
        const int g = F.wave, r32 = lane & 31, hi = lane >> 5, i16 = lane & 15, g16 = (lane >> 4) & 1;
        const LAS unsigned char* vb = F.lds + (8 * hi + (i16 >> 2)) * SGU_STRIDE + (g * 64 + 16 * g16 + 4 * (i16 & 3)) * 2;
#pragma unroll
        for (int tb = 0; tb < 4; ++tb) {
            const int t = 32 * tb + r32; const float* wrow = w_s + ((size_t)g * 128 + t) * 128;
            f32x4 wr0[8], wr1[8];
#pragma unroll
            for (int ks = 0; ks < 2 * tb + 2; ++ks) { wr0[ks] = *(const f32x4*)(wrow + 16 * ks + 8 * hi); wr1[ks] = *(const f32x4*)(wrow + 16 * ks + 8 * hi + 4); }
            const float bs = b_s[g * 128 + t];
            const bf16* up = U + (size_t)(tok0 + t) * 512 + g * 64 + 4 * hi;
            u32x2 uu0[4], uu1[4];
#pragma unroll
            for (int gg = 0; gg < 4; ++gg) { uu0[gg] = *(const u32x2*)(up + 8 * gg); uu1[gg] = *(const u32x2*)(up + 32 + 8 * gg); }
            f32x16 a0, a1;
#pragma unroll
            for (int r = 0; r < 16; ++r) { a0[r] = 0.f; a1[r] = 0.f; }
#pragma unroll
            for (int ks = 0; ks < 2 * tb + 2; ++ks) {
                const int s0 = 16 * ks + 8 * hi;
                float wv[8] = {wr0[ks][0], wr0[ks][1], wr0[ks][2], wr0[ks][3], wr1[ks][0], wr1[ks][1], wr1[ks][2], wr1[ks][3]};
                if (ks >= 2 * tb) {
#pragma unroll
                    for (int j = 0; j < 8; ++j) wv[j] = (s0 + j <= t) ? wv[j] : 0.f; }
                u32x4 bw; bw.x = cvtpk(wv[0], wv[1]); bw.y = cvtpk(wv[2], wv[3]); bw.z = cvtpk(wv[4], wv[5]); bw.w = cvtpk(wv[6], wv[7]);
                const bf16x8 bfrag = __builtin_bit_cast(bf16x8, bw);
                const LAS unsigned char* p = vb + ks * 16 * SGU_STRIDE;
                const s16x4 l0 = vtr(p), h0 = vtr(p + 4 * SGU_STRIDE), l1 = vtr(p + 64), h1 = vtr(p + 4 * SGU_STRIDE + 64);
                const bf16x8 A0 = {l0[0], l0[1], l0[2], l0[3], h0[0], h0[1], h0[2], h0[3]}, A1 = {l1[0], l1[1], l1[2], l1[3], h1[0], h1[1], h1[2], h1[3]};
                a0 = __builtin_amdgcn_mfma_f32_32x32x16_bf16(A0, bfrag, a0, 0, 0, 0);
                a1 = __builtin_amdgcn_mfma_f32_32x32x16_bf16(A1, bfrag, a1, 0, 0, 0);
            }
            bf16* op = YAB + (size_t)(tok0 + t) * 1024 + 512 + g * 64;
            u32x2 q0[4], q1[4];
#pragma unroll
            for (int gg = 0; gg < 4; ++gg) {
                q0[gg].x = cvtpk(bflo(uu0[gg].x) * (a0[4 * gg] + bs), bfhi(uu0[gg].x) * (a0[4 * gg + 1] + bs)); q0[gg].y = cvtpk(bflo(uu0[gg].y) * (a0[4 * gg + 2] + bs), bfhi(uu0[gg].y) * (a0[4 * gg + 3] + bs));
                q1[gg].x = cvtpk(bflo(uu1[gg].x) * (a1[4 * gg] + bs), bfhi(uu1[gg].x) * (a1[4 * gg + 1] + bs)); q1[gg].y = cvtpk(bflo(uu1[gg].y) * (a1[4 * gg + 2] + bs), bfhi(uu1[gg].y) * (a1[4 * gg + 3] + bs)); }
            store_row32(op, q0[0], q0[1], q0[2], q0[3], hi); store_row32(op + 32, q1[0], q1[1], q1[2], q1[3], hi);
        }
    }
    __syncthreads();
}

constexpr int AT_BUF = 65536, AT_V = 32768, AT_BT = GTAB_OFF;
static_assert(8 * 1088 <= GTAB_BYTES, "bias tables fit above the ring");
__device__ __forceinline__ void attn_chunks(const Frame& F, const Args& a, int gc0, int gc1) {
    const bf16* __restrict__ Q = (const bf16*)(a.ws + WS_Q); const bf16* __restrict__ Kb = (const bf16*)(a.ws + WS_K); const bf16* __restrict__ Vb = (const bf16*)(a.ws + WS_V); bf16* YAB = (bf16*)(a.ws + WS_YAB);
    const int tid = F.tid, lane = F.lane, wave = F.wave, pr = wave >> 1, half = wave & 1;
    const int r32 = lane & 31, hi = lane >> 5, i16 = lane & 15, g16 = (lane >> 4) & 1;
    const int gcs[2] = {gc0, gc1};
    int j0s[2], nts[2], tok0s[2];
#pragma unroll
    for (int i = 0; i < 2; ++i) { const int c = gcs[i] % (SEQ / CHUNK); j0s[i] = (c < NLEFT) ? (NLEFT - c) : 0; nts[i] = 9 - j0s[i]; tok0s[i] = (gcs[i] / (SEQ / CHUNK)) * SEQ + c * CHUNK; }
    const int total = 2 * nts[0] + 2 * nts[1];
    unsigned dsrcK[4], dsrcV[4];
#pragma unroll
    for (int i = 0; i < 4; ++i) { const int piece = 4 * wave + i, hh = piece >> 3, kb = piece & 7, key = 8 * kb + (lane >> 3), slot = lane & 7;
        dsrcK[i] = (unsigned)(key * 512 + hh * 64 + ((slot ^ ((key >> 1) & 7)) << 3)); dsrcV[i] = (unsigned)(key * 512 + hh * 64 + ((slot ^ (((key >> 1) & 1) << 2)) << 3)); }
#define AT_DMA(bufp, tbase) do { _Pragma("unroll") for (int i_ = 0; i_ < 4; ++i_) { const int piece_ = 4 * wave + i_; \
        __builtin_amdgcn_global_load_lds((const unsigned*)(Kb + (tbase) + dsrcK[i_]), (LAS unsigned*)((bufp) + (piece_ >> 3) * 8192 + (piece_ & 7) * 1024), 16, 0, 0); \
        __builtin_amdgcn_global_load_lds((const unsigned*)(Vb + (tbase) + dsrcV[i_]), (LAS unsigned*)((bufp) + AT_V + (piece_ >> 3) * 8192 + (piece_ & 7) * 1024), 16, 0, 0); } } while (0)
    int ko[4];
#pragma unroll
    for (int sI = 0; sI < 4; ++sI) ko[sI] = pr * 8192 + r32 * 128 + ((((2 * sI + hi) ^ ((r32 >> 1) & 7))) << 4);
    const int fb = (i16 >> 3) & 1;
    const int vr0 = AT_V + pr * 8192 + (4 * hi + (i16 >> 2)) * 128 + ((4 * (0 ^ fb) + 2 * g16 + ((i16 & 3) >> 1)) * 16) + (i16 & 1) * 8;
    const int vr1 = AT_V + pr * 8192 + (4 * hi + (i16 >> 2)) * 128 + ((4 * (1 ^ fb) + 2 * g16 + ((i16 & 3) >> 1)) * 16) + (i16 & 1) * 8;
#define AT_DECODE(t, ci, hp, j) do { ci = ((t) >= 2 * nts[0]) ? 1 : 0; const int tt_ = (t) - ci * 2 * nts[0]; hp = (tt_ >= nts[ci]) ? 1 : 0; j = j0s[ci] + tt_ - hp * nts[ci]; } while (0)
    {
        int ci, hp, j; AT_DECODE(0, ci, hp, j);
        const size_t tb0 = (size_t)(tok0s[ci] + (j - NLEFT) * CHUNK) * 512 + hp * 256;
        AT_DMA(F.lds, tb0);
    }
    __syncthreads();
    bf16x8 qf[4]; f32x16 o0, o1; float m = -1e30f, l = 0.f;
#pragma unroll
    for (int r = 0; r < 16; ++r) { o0[r] = 0.f; o1[r] = 0.f; }
#pragma unroll
    for (int sI = 0; sI < 4; ++sI) qf[sI] = (bf16x8){0, 0, 0, 0, 0, 0, 0, 0};
#pragma unroll 1
    for (int t = 0; t < total; ++t) {
        int ci, hp, j; AT_DECODE(t, ci, hp, j);
        const int tn = (t + 1 < total) ? t + 1 : t; int cin, hpn, jn; AT_DECODE(tn, cin, hpn, jn);
        const int h = 4 * hp + pr, qi = half * 32 + r32, qtok = tok0s[ci] + qi;
        if (j == j0s[ci]) {
#pragma unroll
            for (int sI = 0; sI < 4; ++sI) qf[sI] = __builtin_nontemporal_load((const bf16x8*)(Q + (size_t)qtok * 512 + h * 64 + 16 * sI + 8 * hi));
#pragma unroll
            for (int r = 0; r < 16; ++r) { o0[r] = 0.f; o1[r] = 0.f; }
            m = -1e30f; l = 0.f;
        }
        asm volatile("" ::: "memory");
        {
            const size_t tbn = (size_t)(tok0s[cin] + (jn - NLEFT) * CHUNK) * 512 + hpn * 256;
            AT_DMA(F.lds + ((t + 1) & 1) * AT_BUF, tbn);
        }
        asm volatile("" ::: "memory");
        const LAS unsigned char* buf = F.lds + (t & 1) * AT_BUF;
        const bool first = (j == j0s[ci]);
        const float negm = first ? 0.f : -m;
        f32x16 p0, p1;
#pragma unroll
        for (int r = 0; r < 16; ++r) { p0[r] = negm; p1[r] = negm; }
#pragma unroll
        for (int sI = 0; sI < 4; ++sI) { const bf16x8 k0 = *(const LAS bf16x8*)(buf + ko[sI]), k1 = *(const LAS bf16x8*)(buf + ko[sI] + 4096);
            p0 = __builtin_amdgcn_mfma_f32_32x32x16_bf16(k0, qf[sI], p0, 0, 0, 0); p1 = __builtin_amdgcn_mfma_f32_32x32x16_bf16(k1, qf[sI], p1, 0, 0, 0); }
        if (j >= 6) {
            const LAS float* bt = (const LAS float*)(F.lds + AT_BT + h * 1088);
            const int base = 640 + qi - 64 * j - 4 * hi;
#pragma unroll
            for (int r = 0; r < 16; ++r) { const int kk = (r & 3) + 8 * (r >> 2); int i0 = base - kk, i1 = base - 32 - kk; i0 = i0 > 256 ? 256 : i0; i1 = i1 > 256 ? 256 : i1; p0[r] += bt[i0]; p1[r] += bt[i1]; }
        }
        float tm = fmaxf(p0[0], p1[0]);
#pragma unroll
        for (int r = 1; r < 16; ++r) tm = fmaxf(tm, fmaxf(p0[r], p1[r]));
        { const auto rr = __builtin_amdgcn_permlane32_swap(__float_as_uint(tm), __float_as_uint(tm), false, false); tm = fmaxf(__uint_as_float(rr[0]), __uint_as_float(rr[1])); }
        if (first) {
            m = tm;
#pragma unroll
            for (int r = 0; r < 16; ++r) { p0[r] -= tm; p1[r] -= tm; }
        } else if (__any(tm > 0.f)) {
            const float dlt = fmaxf(tm, 0.f), alpha = __builtin_amdgcn_exp2f(-dlt); m += dlt; l *= alpha;
#pragma unroll
            for (int r = 0; r < 16; ++r) { p0[r] -= dlt; p1[r] -= dlt; o0[r] *= alpha; o1[r] *= alpha; }
        }
        float ps = 0.f;
#pragma unroll
        for (int r = 0; r < 16; ++r) { p0[r] = __builtin_amdgcn_exp2f(p0[r]); p1[r] = __builtin_amdgcn_exp2f(p1[r]); ps += p0[r] + p1[r]; }
        l += ps;
        bf16x8 pb[2][2];
#pragma unroll
        for (int sI = 0; sI < 2; ++sI) {
            u32x4 w0; w0.x = cvtpk(p0[8 * sI], p0[8 * sI + 1]); w0.y = cvtpk(p0[8 * sI + 2], p0[8 * sI + 3]); w0.z = cvtpk(p0[8 * sI + 4], p0[8 * sI + 5]); w0.w = cvtpk(p0[8 * sI + 6], p0[8 * sI + 7]);
            u32x4 w1; w1.x = cvtpk(p1[8 * sI], p1[8 * sI + 1]); w1.y = cvtpk(p1[8 * sI + 2], p1[8 * sI + 3]); w1.z = cvtpk(p1[8 * sI + 4], p1[8 * sI + 5]); w1.w = cvtpk(p1[8 * sI + 6], p1[8 * sI + 7]);
            pb[0][sI] = __builtin_bit_cast(bf16x8, w0); pb[1][sI] = __builtin_bit_cast(bf16x8, w1); }
#pragma unroll
        for (int blk = 0; blk < 2; ++blk)
#pragma unroll
            for (int sI = 0; sI < 2; ++sI) {
                const int kof = (32 * blk + 16 * sI) * 128;
                const s16x4 l0 = vtr(buf + vr0 + kof), h0 = vtr(buf + vr0 + kof + 1024), l1 = vtr(buf + vr1 + kof), h1 = vtr(buf + vr1 + kof + 1024);
                const bf16x8 A0 = {l0[0], l0[1], l0[2], l0[3], h0[0], h0[1], h0[2], h0[3]}, A1 = {l1[0], l1[1], l1[2], l1[3], h1[0], h1[1], h1[2], h1[3]};
                o0 = __builtin_amdgcn_mfma_f32_32x32x16_bf16(A0, pb[blk][sI], o0, 0, 0, 0);
                o1 = __builtin_amdgcn_mfma_f32_32x32x16_bf16(A1, pb[blk][sI], o1, 0, 0, 0);
            }
        if (j == 8) {
            float lt = l; { const auto rr = __builtin_amdgcn_permlane32_swap(__float_as_uint(lt), __float_as_uint(lt), false, false); lt = __uint_as_float(rr[0]) + __uint_as_float(rr[1]); }
            const float inv = __builtin_amdgcn_rcpf(lt);
            bf16* op = YAB + (size_t)qtok * 1024 + h * 64;
            u32x2 q0[4], q1[4];
#pragma unroll
            for (int gg = 0; gg < 4; ++gg) {
                q0[gg].x = cvtpk(o0[4 * gg] * inv, o0[4 * gg + 1] * inv); q0[gg].y = cvtpk(o0[4 * gg + 2] * inv, o0[4 * gg + 3] * inv);
                q1[gg].x = cvtpk(o1[4 * gg] * inv, o1[4 * gg + 1] * inv); q1[gg].y = cvtpk(o1[4 * gg + 2] * inv, o1[4 * gg + 3] * inv); }
            store_row32(op, q0[0], q0[1], q0[2], q0[3], hi); store_row32(op + 32, q1[0], q1[1], q1[2], q1[3], hi);
        }
        __syncthreads();
    }
#undef AT_DMA
#undef AT_DECODE
}
__device__ __forceinline__ void phaseD(const Frame& F, const Args& a) {
    for (int unit = F.vcu; unit < NB * (SEQ / SGB); unit += F.G) sgu_unit(F, a, unit / (SEQ / SGB), unit % (SEQ / SGB));
    for (int i = F.tid; i < NHEAD * NREL; i += NWAVES * 64) { const int h = i / NREL, k = i % NREL; ((LAS float*)(F.lds + AT_BT + h * 1088))[k] = (a.in[7][i] - a.in[7][h * NREL + 256]) * LOG2E; }
    __syncthreads();
    const int NCH = NB * (SEQ / CHUNK);
    for (int v = F.vcu; v < NCH / 2; v += F.G) attn_chunks(F, a, v, NCH - 1 - v);
}

constexpr int G_HT_STRIDE = 2064;
__device__ __forceinline__ void phaseG(const Frame& F, const Args& a) {
    const float* x = a.in[0]; const bf16* Y1 = (const bf16*)(a.ws + WS_Y1); const float* mod = (const float*)(a.ws + WS_MOD); const float* g_post_mix = a.in[5]; const float* g_pre_ffn = a.in[17];
    const float* b_router = a.in[20]; bf16* X1b = (bf16*)(a.ws + WS_X1B); unsigned char* XN8 = a.ws + WS_XN;
    const bf16* wrt = (const bf16*)(a.ws + WS_WRT);
    float* topg = (float*)(a.ws + WS_TOPG); int* list = (int*)(a.ws + WS_LIST); unsigned* cnt = F.ctl + CW_CNT;
    LAS unsigned char* HT = F.lds;
    LAS float* PL = (LAS float*)(F.lds + 33792);
    LAS float* LG = PL + 8 * 16 * 32;
    LAS float* TV = LG + 512;
    LAS unsigned* LC = (LAS unsigned*)(TV + 64);
    LAS unsigned* AS = LC + 64;
    const int tid = F.tid, lane = F.lane, wave = F.wave, kq = lane >> 4, i16 = lane & 15;
    if (tid < 64) LC[tid] = 0u;
    bf16x8 whi[2][4], wlo[2][4];
#pragma unroll
    for (int et = 0; et < 2; ++et)
#pragma unroll
        for (int ks = 0; ks < 4; ++ks) { const size_t o = (size_t)(et * 16 + i16) * D + 128 * wave + 32 * ks + 8 * kq; whi[et][ks] = *(const bf16x8*)(wrt + o); wlo[et][ks] = *(const bf16x8*)(wrt + (size_t)NEXP * D + o); }
    const int myrow = tid >> 5, mye = lane & 31;
    const float mybias = b_router[mye];
    __syncthreads();
    const int NT = NTOK / 16;
    f32x4 xv[2][4]; u32x2 yr[2][4];
    {   const int rbase = 16 * F.vcu + 2 * wave;
#pragma unroll
        for (int rr = 0; rr < 2; ++rr)
#pragma unroll
            for (int j = 0; j < 4; ++j) { const int c0 = (lane + 64 * j) * 4; xv[rr][j] = __builtin_nontemporal_load((const f32x4*)(x + (size_t)(rbase + rr) * D + c0)); yr[rr][j] = __builtin_nontemporal_load((const u32x2*)(Y1 + (size_t)(rbase + rr) * D + c0)); } }
    int tl = 0;
    f32x4 cgp[4], cgf[4], cgt[4], csc[4], csh[4]; int cb = -1;
#pragma unroll
    for (int j = 0; j < 4; ++j) { const int c0 = (lane + 64 * j) * 4; cgp[j] = *(const f32x4*)(g_post_mix + c0); cgf[j] = *(const f32x4*)(g_pre_ffn + c0); }
#pragma unroll 1
    for (int T = F.vcu; T < NT; T += F.G, ++tl) {
        const int b = (16 * T) / SEQ; const float* mb = mod + b * 6144; const int rbase = 16 * T + 2 * wave;
        if (b != cb) { cb = b;
#pragma unroll
            for (int j = 0; j < 4; ++j) { const int c0 = (lane + 64 * j) * 4; cgt[j] = *(const f32x4*)(mb + GT1 + c0); csc[j] = *(const f32x4*)(mb + SC2 + c0) + 1.0f; csh[j] = *(const f32x4*)(mb + SH2 + c0); } }
#pragma unroll
        for (int rr = 0; rr < 2; ++rr) {
            const int row = rbase + rr; f32x4 yv[4]; float ss = 0.f;
#pragma unroll
            for (int j = 0; j < 4; ++j) { yv[j] = (f32x4){bflo(yr[rr][j].x), bfhi(yr[rr][j].x), bflo(yr[rr][j].y), bfhi(yr[rr][j].y)}; ss += (yv[j][0] * yv[j][0] + yv[j][1] * yv[j][1]) + (yv[j][2] * yv[j][2] + yv[j][3] * yv[j][3]); }
            const float rstd = rsqrtf(wsum(ss) * (1.0f / D) + EPS); float s2 = 0.f;
#pragma unroll
            for (int j = 0; j < 4; ++j) { const int c0 = (lane + 64 * j) * 4;
                xv[rr][j] = xv[rr][j] + cgt[j] * (yv[j] * rstd * cgp[j]);
                { u32x2 w1; w1.x = cvtpk(xv[rr][j][0], xv[rr][j][1]); w1.y = cvtpk(xv[rr][j][2], xv[rr][j][3]); __builtin_nontemporal_store(w1, (u32x2*)(X1b + (size_t)row * D + c0)); }
                s2 += (xv[rr][j][0] * xv[rr][j][0] + xv[rr][j][1] * xv[rr][j][1]) + (xv[rr][j][2] * xv[rr][j][2] + xv[rr][j][3] * xv[rr][j][3]); }
            const float rstd2 = rsqrtf(wsum(s2) * (1.0f / D) + EPS);
#pragma unroll
            for (int j = 0; j < 4; ++j) { const int c0 = (lane + 64 * j) * 4;
                const f32x4 h = xv[rr][j] * rstd2 * cgf[j] * csc[j] + csh[j];
                u32x2 w; w.x = cvtpk(h[0], h[1]); w.y = cvtpk(h[2], h[3]); *(unsigned*)(XN8 + (size_t)row * D + c0) = pk_fp8x4(h[0] * F8_ASCALE, h[1] * F8_ASCALE, h[2] * F8_ASCALE, h[3] * F8_ASCALE);
                *(LAS u32x2*)(HT + (2 * wave + rr) * G_HT_STRIDE + c0 * 2) = w; }
        }
        {
            const int Tn = (T + F.G < NT) ? T + F.G : T; const int rb2 = 16 * Tn + 2 * wave;
#pragma unroll
            for (int rr = 0; rr < 2; ++rr)
#pragma unroll
                for (int j = 0; j < 4; ++j) { const int c0 = (lane + 64 * j) * 4; xv[rr][j] = __builtin_nontemporal_load((const f32x4*)(x + (size_t)(rb2 + rr) * D + c0)); yr[rr][j] = __builtin_nontemporal_load((const u32x2*)(Y1 + (size_t)(rb2 + rr) * D + c0)); }
        }
        LDS_WAIT(); __builtin_amdgcn_s_barrier(); asm volatile("" ::: "memory");
        {
            f32x4 acc0 = {0.f, 0.f, 0.f, 0.f}, acc1 = {0.f, 0.f, 0.f, 0.f};
#pragma unroll
            for (int ks = 0; ks < 4; ++ks) { const bf16x8 hb = *(const LAS bf16x8*)(HT + i16 * G_HT_STRIDE + (128 * wave + 32 * ks + 8 * kq) * 2);
                acc0 = __builtin_amdgcn_mfma_f32_16x16x32_bf16(whi[0][ks], hb, acc0, 0, 0, 0); acc0 = __builtin_amdgcn_mfma_f32_16x16x32_bf16(wlo[0][ks], hb, acc0, 0, 0, 0);
                acc1 = __builtin_amdgcn_mfma_f32_16x16x32_bf16(whi[1][ks], hb, acc1, 0, 0, 0); acc1 = __builtin_amdgcn_mfma_f32_16x16x32_bf16(wlo[1][ks], hb, acc1, 0, 0, 0); }
            *(LAS f32x4*)(PL + (wave * 16 + i16) * 32 + 4 * kq) = acc0; *(LAS f32x4*)(PL + (wave * 16 + i16) * 32 + 16 + 4 * kq) = acc1;
        }
        LDS_WAIT(); __builtin_amdgcn_s_barrier(); asm volatile("" ::: "memory");
        float lg = mybias;
#pragma unroll
        for (int w = 0; w < 8; ++w) lg += PL[(w * 16 + myrow) * 32 + mye];
        LG[myrow * 32 + mye] = lg;
        LDS_WAIT(); asm volatile("" ::: "memory");
        int rank = 0;
#pragma unroll
        for (int q = 0; q < 8; ++q) { const f32x4 o = *(const LAS f32x4*)(LG + myrow * 32 + 4 * q);
#pragma unroll
            for (int i = 0; i < 4; ++i) { const int e2 = 4 * q + i; rank += (o[i] > lg || (o[i] == lg && e2 < mye)) ? 1 : 0; } }
        if (rank < 4) TV[myrow * 4 + rank] = lg;
        LDS_WAIT(); asm volatile("" ::: "memory");
        const f32x4 tv = *(const LAS f32x4*)(TV + myrow * 4);
        if (rank < 4) {
            const float den = 1.0f + __expf(tv[1] - tv[0]) + __expf(tv[2] - tv[0]) + __expf(tv[3] - tv[0]);
            const int slot = (16 * T + myrow) * 4 + rank; topg[slot] = __expf(lg - tv[0]) / den;
            const unsigned lp = __hip_atomic_fetch_add(LC + mye, 1u, __ATOMIC_RELAXED, __HIP_MEMORY_SCOPE_WORKGROUP);
            if (tl < 16) AS[tl * 64 + myrow * 4 + rank] = (unsigned)mye | (lp << 8);
        }
    }
    __syncthreads();
    if (tid < NEXP) LC[32 + tid] = atomicAdd(&cnt[tid], LC[tid]);
    __syncthreads();
    for (int i = tid; i < tl * 64; i += NWAVES * 64) { const unsigned as = AS[i]; const int e = as & 255, lp = as >> 8; const int T = F.vcu + (i >> 6) * F.G;
        list[(size_t)e * NTOK + LC[32 + e] + lp] = (16 * T + ((i & 63) >> 2)) * 4 + (i & 3); }
}
__device__ __forceinline__ int moe_tables(const Frame& F) {
    __syncthreads();
    if (F.tid < NEXP) F.MISC[40 + F.tid] = __hip_atomic_load(F.ctl + CW_CNT + F.tid, __ATOMIC_RELAXED, __HIP_MEMORY_SCOPE_AGENT);
    __syncthreads();
    if (F.tid == 0) { unsigned s = 0; for (int e = 0; e < NEXP; ++e) { F.MISC[e] = s; s += (F.MISC[40 + e] + 255u) >> 8; } F.MISC[32] = s; }
    __syncthreads();
    return (int)F.MISC[32];
}
__device__ __forceinline__ void phaseJ(const Frame& F, const Args& a) {
    const unsigned char* Y2s = a.ws + WS_Y2; const bf16* X1b = (const bf16*)(a.ws + WS_X1B); const float* mod = (const float*)(a.ws + WS_MOD); const float* gpf = a.in[18]; float* out = a.out;
    const int* inv = (const int*)(a.ws + WS_TOPE); const float* topg = (const float*)(a.ws + WS_TOPG);
    const int lane = F.lane, gw = F.vcu * NWAVES + F.wave, NGW = F.G * NWAVES;
    f32x4 cgg[4]; int cb = -1;
    for (int row0 = gw * 4; row0 < NTOK; row0 += NGW * 4) {
        const int b = row0 / SEQ; const float* mb = mod + b * 6144;
        if (b != cb) { cb = b;
#pragma unroll
            for (int j = 0; j < 4; ++j) { const int c0 = (lane + 64 * j) * 4; cgg[j] = *(const f32x4*)(gpf + c0) * *(const f32x4*)(mb + GT2 + c0); } }
        int pp[4][4]; float gg[4][4];
#pragma unroll
        for (int rr = 0; rr < 4; ++rr)
#pragma unroll
            for (int k = 0; k < 4; ++k) { pp[rr][k] = __builtin_amdgcn_readfirstlane(inv[(row0 + rr) * 4 + k]); gg[rr][k] = topg[(row0 + rr) * 4 + k] * (1.0f / F8_YSCALE); }
        unsigned yy[4][4][4]; u32x2 xx[4][4];
#pragma unroll
        for (int rr = 0; rr < 4; ++rr)
#pragma unroll
            for (int j = 0; j < 4; ++j) { const int c0 = (lane + 64 * j) * 4;
#pragma unroll
                for (int k = 0; k < 4; ++k) yy[rr][j][k] = __builtin_nontemporal_load((const unsigned*)(Y2s + (size_t)pp[rr][k] * D + c0));
                xx[rr][j] = __builtin_nontemporal_load((const u32x2*)(X1b + (size_t)(row0 + rr) * D + c0)); }
#pragma unroll
        for (int rr = 0; rr < 4; ++rr) {
            f32x4 yv[4]; float ss = 0.f;
#pragma unroll
            for (int j = 0; j < 4; ++j) { f32x4 s = {0.f, 0.f, 0.f, 0.f};
#pragma unroll
                for (int k = 0; k < 4; ++k) { const f32x2 lo = __builtin_amdgcn_cvt_pk_f32_fp8((int)yy[rr][j][k], false), hi = __builtin_amdgcn_cvt_pk_f32_fp8((int)yy[rr][j][k], true);
                    s += (f32x4){lo.x, lo.y, hi.x, hi.y} * gg[rr][k]; }
                yv[j] = s; ss += (s[0] * s[0] + s[1] * s[1]) + (s[2] * s[2] + s[3] * s[3]); }
            const float rstd = rsqrtf(wsum(ss) * (1.0f / D) + EPS);
#pragma unroll
            for (int j = 0; j < 4; ++j) { const int c0 = (lane + 64 * j) * 4;
                const f32x4 x1 = {bflo(xx[rr][j].x), bfhi(xx[rr][j].x), bflo(xx[rr][j].y), bfhi(xx[rr][j].y)};
                __builtin_nontemporal_store(x1 + cgg[j] * (yv[j] * rstd), (f32x4*)(out + (size_t)(row0 + rr) * D + c0)); }
        }
    }
}

constexpr int N_PHASES = 10;
__global__ void __launch_bounds__(NWAVES * 64, 2) mega_fwd(Args args) {
    extern __shared__ __attribute__((aligned(16))) unsigned char lds_raw[];
    Frame F;
    F.lds = (LAS unsigned char*)lds_raw; F.MISC = (volatile LAS unsigned*)(F.lds + MISC_OFF);
    F.tid = threadIdx.x; F.lane = F.tid & 63; F.wave = __builtin_amdgcn_readfirstlane(F.tid >> 6);
    F.G = gridDim.x; { const int bx = blockIdx.x; F.vcu = (F.G % 8 == 0) ? (bx % 8) * (F.G / 8) + bx / 8 : bx; }
    F.ctl = (unsigned*)(args.ws + WS_CTL);
    for (int u = F.tid; u < 128; u += NWAVES * 64) F.MISC[u] = 0u;
    __syncthreads();
    const int lo = args.ph_lo, hi = args.ph_hi;
    XcdBarrier bar; bar.bar = F.ctl + CW_BAR; bar.x = 0; bar.st = F.MISC + 80;
    if (hi - lo > 1) bar = xcd_barrier_post(F.ctl + CW_BAR, F.MISC + 80);
#define IN(k) (lo <= (k) && (k) < hi)
#define SEAM(k) do { if (IN(k) && IN((k) + 1)) xcd_barrier(bar); } while (0)
    unsigned char* ws = args.ws;
    bf16 *XN = (bf16*)(ws + WS_XN), *Qb = (bf16*)(ws + WS_Q), *Kb = (bf16*)(ws + WS_K), *Vb = (bf16*)(ws + WS_V), *Ub = (bf16*)(ws + WS_U), *VG = (bf16*)(ws + WS_VG);
    bf16 *GT = (bf16*)(ws + WS_GT), *YAB = (bf16*)(ws + WS_YAB), *MRG = (bf16*)(ws + WS_MRG), *Y1 = (bf16*)(ws + WS_Y1), *ACT = (bf16*)(ws + WS_ACT), *Y2 = (bf16*)(ws + WS_Y2);

    if (IN(0)) { phaseA(F, args); } SEAM(0);
    if (IN(1)) { phaseB(F, args); } SEAM(1);
    if (IN(2)) {
        SchedStatic S{(const char*)XN, (const char*)(ws + WS_W1T), NTOK / 256, 4608 / 256, F.G, (int)blockIdx.x, (size_t)256 * 1024 * 2, (size_t)256 * 1024 * 2};
        EpiG1 E{Qb, Kb, Vb, Ub, VG, GT, args.in[15]};
        pg8::gemm_phase<EpiG1, SchedStatic, false>(F.lds + RING_OFF, S, E, 2048, 2048, 16);
    } SEAM(2);
    if (IN(3)) { phaseD(F, args); } SEAM(3);
    if (IN(4)) {
        SchedSplit2 S{(const char*)YAB, (const char*)(ws + WS_WBRT), NTOK / 256, 4, F.G, (int)blockIdx.x, (size_t)256 * 1024 * 2, (size_t)256 * 1024 * 2, (size_t)512 * 2};
        EpiG2 E{GT, MRG};
        pg8::gemm_phase<EpiG2, SchedSplit2, false>(F.lds + RING_OFF, S, E, 2048, 2048, 8);
    } SEAM(4);
    if (IN(5)) {
        SchedStatic S{(const char*)MRG, (const char*)(ws + WS_WOUTT), NTOK / 256, 4, F.G, (int)blockIdx.x, (size_t)256 * 1024 * 2, (size_t)256 * 1024 * 2};
        EpiPlain E{Y1};
        pg8::gemm_phase<EpiPlain, SchedStatic, false>(F.lds + RING_OFF, S, E, 2048, 2048, 16);
    } SEAM(5);
    if (IN(6)) { phaseG(F, args); } SEAM(6);
    if (IN(7)) {
        const int nrb = moe_tables(F);
        const int* list = (const int*)(ws + WS_LIST);
        {
            int* inv = (int*)(ws + WS_TOPE);
            for (int g = (int)blockIdx.x * (NWAVES * 64) + F.tid; g < NTOK * TOPK; g += F.G * NWAVES * 64) {
                int e = 0, base = 0;
#pragma unroll 1
                for (int i = 0; i < NEXP; ++i) { const int c = (int)F.MISC[40 + i]; if (g >= base + c) { base += c; e = i + 1; } else break; }
                const int pos = g - base; if (e < NEXP) inv[list[(size_t)e * NTOK + pos]] = (int)F.MISC[e] * 256 + pos; }
        }
        typedef SchedMoe<8, true> SM;
        SM S{(const char*)XN, (const char*)(ws + WS_WGUT), F.MISC, (const LAS unsigned*)(F.lds + GTAB_OFF), (int)blockIdx.x, F.G, nrb, (size_t)2048 * 1024, (size_t)256 * 1024};
        S.build(F.tid);
        { Unit u; LAS unsigned* gt = (LAS unsigned*)(F.lds + GTAB_OFF);
          for (int k = 0; k < GTAB_UNITS && S.next(k, u); ++k) { const int e = u.aux, j256 = (u.pm - (int)F.MISC[e]) * 256, ecnt = (int)F.MISC[40 + e];
              for (int r = F.tid; r < 256; r += NWAVES * 64) { const int pos = j256 + r; int tok = 0; if (pos < ecnt) tok = list[(size_t)e * NTOK + pos] >> 2; gt[k * 256 + r] = (unsigned)tok * 1024u; } } }
        __syncthreads();
        EpiAct E{args.in[22], (unsigned char*)ACT};
        pg8::gemm_phase<EpiAct, SM, true>(F.lds + RING_OFF, S, E, 1024, 1024, 8);
    } SEAM(7);
    if (IN(8)) {
        const int nrb = moe_tables(F);
        typedef SchedMoe<4, true> SM;
        SM S{(const char*)ACT, (const char*)(ws + WS_WDNT), F.MISC, (const LAS unsigned*)(F.lds + GTAB_OFF), (int)blockIdx.x, F.G, nrb, (size_t)1024 * 1024, (size_t)256 * 1024};
        S.build(F.tid);
        { Unit u; LAS unsigned* gt = (LAS unsigned*)(F.lds + GTAB_OFF);
          for (int k = 0; k < GTAB_UNITS && S.next(k, u); ++k) for (int r = F.tid; r < 256; r += NWAVES * 64) gt[k * 256 + r] = (unsigned)(u.pm * 256 + r) * 1024u; }
        __syncthreads();
        EpiDown E{args.in[24], (unsigned char*)Y2};
        pg8::gemm_phase<EpiDown, SM, true>(F.lds + RING_OFF, S, E, 1024, 1024, 8);
    } SEAM(8);
    if (IN(9)) { phaseJ(F, args); }
#undef IN
#undef SEAM
}
extern "C" void kernel_launch(void* const* d_in, const int* in_sizes, int n_in, void* d_out, int out_size, void* d_ws, size_t ws_size, hipStream_t stream) {
    if (n_in != 25 || in_sizes[0] != NTOK * D || out_size != NTOK * D || ws_size < WS_END) { fprintf(stderr, "kernel_launch: unexpected shapes (n_in %d in0 %d out %d ws %zu)\n", n_in, n_in > 0 ? in_sizes[0] : -1, out_size, ws_size); return; }
    static int grid = 0;
    if (grid == 0) {
        int dev = 0, cus = 0, per_cu = 0;
        if (hipGetDevice(&dev) != hipSuccess || hipDeviceGetAttribute(&cus, hipDeviceAttributeMultiprocessorCount, dev) != hipSuccess) { fprintf(stderr, "kernel_launch: device query failed\n"); grid = -1; return; }
        if (hipFuncSetAttribute((const void*)mega_fwd, hipFuncAttributeMaxDynamicSharedMemorySize, LDS_BYTES) != hipSuccess) { fprintf(stderr, "kernel_launch: hipFuncSetAttribute failed\n"); grid = -1; return; }
        if (hipOccupancyMaxActiveBlocksPerMultiprocessor(&per_cu, (const void*)mega_fwd, NWAVES * 64, LDS_BYTES) != hipSuccess || per_cu < 1) { fprintf(stderr, "kernel_launch: occupancy query says %d\n", per_cu); }
        (void)hipGetLastError();
        grid = cus;
    }
    if (grid < 0) return;
    if (hipMemsetAsync((unsigned char*)d_ws + WS_CTL, 0, CTL_ZERO_BYTES, stream) != hipSuccess) { fprintf(stderr, "kernel_launch: memset failed\n"); return; }
    Args a{};
    for (int i = 0; i < 25; ++i) a.in[i] = (const float*)d_in[i];
    a.out = (float*)d_out; a.ws = (unsigned char*)d_ws; a.ph_lo = 0; a.ph_hi = N_PHASES;
    hipLaunchKernelGGL(mega_fwd, dim3(grid), dim3(NWAVES * 64), LDS_BYTES, stream, a);
    if (hipPeekAtLastError() != hipSuccess) fprintf(stderr, "kernel_launch: launch failed\n");
}
```

```cpp
#include <hip/hip_runtime.h>
#include <cstdio>
#include <cstdint>

constexpr int NB = 4, SEQ = 8192, D = 1024, NTOK = NB * SEQ;
constexpr int NHEAD = 8, CHUNK = 64, NLEFT = 8, NREL = 257;
constexpr int SGB = 128;
constexpr int INW = 2560, NEXP = 32, TOPK = 4;
constexpr float EPS = 1e-6f, SWL = 7.0f, SWA = 1.702f;
constexpr float LOG2E = 1.4426950408889634f;
constexpr float QSCALE = 0.125f * LOG2E;
constexpr int SH1 = 0, SC1 = 1024, GT1 = 2048, SH2 = 3072, SC2 = 4096, GT2 = 5120;
typedef unsigned short bf16;

constexpr size_t MiB = 1u << 20;
constexpr size_t WS_CTL = 0, CTL_ZERO_BYTES = 64 * 1024;
constexpr size_t WS_MOD = 1 * MiB;
constexpr size_t WS_W1T = 2 * MiB, WS_WBRT = 12 * MiB, WS_WOUTT = 14 * MiB, WS_WRT = 16 * MiB;
constexpr size_t WS_TOPE = 17 * MiB, WS_TOPG = 18 * MiB, WS_LIST = 19 * MiB;
constexpr size_t WS_WGUT = 32 * MiB, WS_WDNT = 160 * MiB;
constexpr size_t WS_XN = 224 * MiB;
constexpr size_t WS_Q = 288 * MiB, WS_K = 320 * MiB, WS_V = 352 * MiB, WS_U = 384 * MiB, WS_VG = 416 * MiB;
constexpr size_t WS_GT = 448 * MiB;
constexpr size_t WS_YAB = 576 * MiB, WS_MRG = 640 * MiB, WS_Y1 = 704 * MiB;
constexpr size_t WS_ACT = 288 * MiB;
constexpr size_t WS_Y2 = 576 * MiB;
constexpr size_t WS_END = 960 * MiB;
constexpr int CW_CNT = 1024;

#define LAS __attribute__((address_space(3)))
#define GAS __attribute__((address_space(1)))
typedef short bf16x8 __attribute__((ext_vector_type(8)));
typedef short s16x4 __attribute__((ext_vector_type(4)));
typedef float f32x4 __attribute__((ext_vector_type(4)));
typedef float f32x2 __attribute__((ext_vector_type(2)));
typedef float f32x16 __attribute__((ext_vector_type(16)));
typedef unsigned u32x4 __attribute__((ext_vector_type(4)));
typedef unsigned u32x2 __attribute__((ext_vector_type(2)));
typedef __bf16 bf16x2_t __attribute__((ext_vector_type(2)));
constexpr int NWAVES = 8;
constexpr int TRASH_SLOT = NTOK * 4;

__device__ __forceinline__ unsigned cvtpk(float lo, float hi) { f32x2 v = {lo, hi}; bf16x2_t b = __builtin_convertvector(v, bf16x2_t); return __builtin_bit_cast(unsigned, b); }
__device__ __forceinline__ float wsum(float v) {
    v += __builtin_bit_cast(float, __builtin_amdgcn_update_dpp(0, __builtin_bit_cast(int, v), 0xB1, 0xF, 0xF, true));
    v += __builtin_bit_cast(float, __builtin_amdgcn_update_dpp(0, __builtin_bit_cast(int, v), 0x4E, 0xF, 0xF, true));
    v += __builtin_bit_cast(float, __builtin_amdgcn_update_dpp(0, __builtin_bit_cast(int, v), 0x124, 0xF, 0xF, true));
    v += __builtin_bit_cast(float, __builtin_amdgcn_update_dpp(0, __builtin_bit_cast(int, v), 0x128, 0xF, 0xF, true));
    const int iv = __builtin_bit_cast(int, v);
    const float s0 = __builtin_bit_cast(float, __builtin_amdgcn_readlane(iv, 0)), s1 = __builtin_bit_cast(float, __builtin_amdgcn_readlane(iv, 16));
    const float s2 = __builtin_bit_cast(float, __builtin_amdgcn_readlane(iv, 32)), s3 = __builtin_bit_cast(float, __builtin_amdgcn_readlane(iv, 48));
    return (s0 + s1) + (s2 + s3);
}
__device__ __forceinline__ float clamp8(float v) { return fminf(fmaxf(v, -448.0f), 448.0f); }
__device__ __forceinline__ unsigned pk_fp8x4(float a, float b, float c, float d) {
    int w = 0; w = __builtin_amdgcn_cvt_pk_fp8_f32(clamp8(a), clamp8(b), w, false); w = __builtin_amdgcn_cvt_pk_fp8_f32(clamp8(c), clamp8(d), w, true); return (unsigned)w; }
__device__ __forceinline__ unsigned pk_fp8x4_nc(float a, float b, float c, float d) {
    int w = 0; w = __builtin_amdgcn_cvt_pk_fp8_f32(a, b, w, false); w = __builtin_amdgcn_cvt_pk_fp8_f32(c, d, w, true); return (unsigned)w; }
constexpr float F8_YSCALE = 16.0f;
constexpr size_t WS_X1B = 768 * MiB;
constexpr float F8_WSCALE = 64.0f, F8_ASCALE = 4.0f, F8_DESCALE = 1.0f / (64.0f * 4.0f);
__device__ __forceinline__ float bflo(unsigned w) { return __uint_as_float(w << 16); }
__device__ __forceinline__ float bfhi(unsigned w) { return __uint_as_float(w & 0xffff0000u); }
__device__ __forceinline__ float fast_sigmoid(float x) { return __builtin_amdgcn_rcpf(1.0f + __builtin_amdgcn_exp2f(-LOG2E * x)); }
__device__ __forceinline__ f32x2 sigmoid_pk(f32x2 v) { const f32x2 t = v * (-LOG2E); f32x2 e; e.x = __builtin_amdgcn_exp2f(t.x); e.y = __builtin_amdgcn_exp2f(t.y); const f32x2 d = e + 1.0f; f32x2 r; r.x = __builtin_amdgcn_rcpf(d.x); r.y = __builtin_amdgcn_rcpf(d.y); return r; }
__device__ __forceinline__ f32x2 gelu_pk(f32x2 v) {
    const f32x2 av = __builtin_elementwise_abs(v), d = av * 0.2316418882f + 1.0f;
    f32x2 t; t.x = __builtin_amdgcn_rcpf(d.x); t.y = __builtin_amdgcn_rcpf(d.y);
    f32x2 q = t * 0.5307027145f + (-0.7265760135f); q = q * t + 0.7107068705f; q = q * t + (-0.142248368f); q = q * t + 0.127414796f; q = q * t;
    const f32x2 s = (v * v) * (-0.72134752044f);
    f32x2 e; e.x = __builtin_amdgcn_exp2f(s.x); e.y = __builtin_amdgcn_exp2f(s.y);
    const f32x2 m = v * (q * e), r = v - m;
    f32x2 o; o.x = v.x < 0.f ? m.x : r.x; o.y = v.y < 0.f ? m.y : r.y; return o;
}

constexpr int RING_OFF = 0, RING_BYTES = 131072;
constexpr int GTAB_OFF = RING_BYTES, GTAB_UNITS = 20, GTAB_BYTES = GTAB_UNITS * 256 * 4;
constexpr int MISC_OFF = GTAB_OFF + GTAB_BYTES;
constexpr int LDS_BYTES = MISC_OFF + 512;
static_assert(LDS_BYTES <= 160 * 1024, "LDS map");

#define XB_TMO      128
#define XB_XCNT(j)  (256  + 64 * (j))
#define XB_XSUB(j)  (1280 + 64 * (j))
#define XB_XGEN(j)  (2304 + 64 * (j))
#define XB_TOP      3328
#define XB_TOPGEN   3392
#define XCD_BAR_WORDS 3456
#define XB_SPIN_CAP (1u << 18)
__device__ __forceinline__ unsigned xb_ld(unsigned* p)              { return __hip_atomic_load(p, __ATOMIC_RELAXED, __HIP_MEMORY_SCOPE_AGENT); }
__device__ __forceinline__ unsigned xb_add(unsigned* p, unsigned v) { return __hip_atomic_fetch_add(p, v, __ATOMIC_RELAXED, __HIP_MEMORY_SCOPE_AGENT); }
__device__ __forceinline__ unsigned xb_xcc_id() { return (unsigned)__builtin_amdgcn_s_getreg((3 << 11) | 20) & 0xFu; }
#define XB_SPIN(cond, bar) do { unsigned _sp = 0; while (cond) { __builtin_amdgcn_s_sleep(1); \
    if ((++_sp & 255u) == 0u) { if (xb_ld(&(bar)[XB_TMO])) break; if (_sp > XB_SPIN_CAP) { atomicAdd(&(bar)[XB_TMO], 1u); break; } } } } while (0)
struct XcdBarrier { unsigned* bar; unsigned x; volatile LAS unsigned* st; };
__device__ __forceinline__ XcdBarrier xcd_barrier_post(unsigned* bar, volatile LAS unsigned* st) {
    XcdBarrier b; b.bar = bar; b.x = xb_xcc_id(); b.st = st;
    if (threadIdx.x == 0) (void)xb_add(&bar[XB_XCNT(b.x)], 1u);
    return b;
}
__device__ __forceinline__ void xcd_barrier_complete(unsigned* bar, unsigned x, unsigned& nloc, unsigned& nx) {
    const unsigned G = gridDim.x * gridDim.y * gridDim.z;
    unsigned sum, cnt, mine, sp = 0u;
    for (;;) {
        sum = 0u; cnt = 0u; mine = 0u;
#pragma unroll
        for (unsigned j = 0; j < 16; ++j) { const unsigned c = xb_ld(&bar[XB_XCNT(j)]); sum += c; cnt += (c > 0u) ? 1u : 0u; mine = (j == x) ? c : mine; }
        if (sum == G) break;
        __builtin_amdgcn_s_sleep(1);
        if ((++sp & 255u) == 0u) { if (xb_ld(&bar[XB_TMO])) break; if (sp > XB_SPIN_CAP) { atomicAdd(&bar[XB_TMO], 1u); break; } }
    }
    nloc = mine > 0u ? mine : 1u; nx = cnt > 0u ? cnt : 1u;
}
__device__ __forceinline__ void xcd_barrier(const XcdBarrier& b) {
    asm volatile("s_waitcnt vmcnt(0)" ::: "memory");
    __syncthreads();
    if (threadIdx.x == 0) {
        unsigned* bar = b.bar;
        __builtin_amdgcn_s_waitcnt(0);
        unsigned nloc = b.st[0], nx = b.st[1];
        if (nloc == 0u) { xcd_barrier_complete(bar, b.x, nloc, nx); b.st[0] = nloc; b.st[1] = nx; }
        const unsigned old = xb_add(&bar[XB_XSUB(b.x)], 1u);
        const unsigned gen = old / nloc;
        if (old + 1u == (gen + 1u) * nloc) {
            __builtin_amdgcn_fence(__ATOMIC_RELEASE, "agent");
            asm volatile("s_waitcnt vmcnt(0)" ::: "memory");
            const unsigned og = xb_add(&bar[XB_TOP], 1u);
            const unsigned tg = og / nx;
            if (og + 1u == (tg + 1u) * nx) xb_add(&bar[XB_TOPGEN], 1u);
            else XB_SPIN(xb_ld(&bar[XB_TOPGEN]) == tg, bar);
            __builtin_amdgcn_fence(__ATOMIC_ACQUIRE, "agent");
            xb_add(&bar[XB_XGEN(b.x)], 1u);
            asm volatile("s_waitcnt vmcnt(0)" ::: "memory");
        } else {
            XB_SPIN(xb_ld(&bar[XB_XGEN(b.x)]) == gen, bar);
            __builtin_amdgcn_fence(__ATOMIC_ACQUIRE, "agent");
            asm volatile("s_waitcnt vmcnt(0)" ::: "memory");
        }
    }
    __syncthreads();
}
constexpr int CW_BAR = 4096;

namespace pg8 {
constexpr int BM = 256, BK = 64, HALF = 128, HTB = HALF * BK * 2, STAGE_BYTES = 8 * HTB, NXCD = 8, WGM = 8;
__host__ __device__ __forceinline__ int lds_byte(int r, int c) { return r * 128 + ((((c >> 3) ^ (r >> 1)) & 7) << 4); }
__host__ __device__ __forceinline__ void stage_rc(int b, int& R, int& C) { R = b >> 7; C = ((((b >> 4) ^ (R >> 1)) & 7) << 3); }
__host__ __device__ __forceinline__ int perm32(int rho) { const int n = rho >> 4, i = rho & 15; return 8 * (i >> 2) + 4 * n + (i & 3); }
struct Unit { int pm, pn, aux; };
typedef int v4i_t __attribute__((ext_vector_type(4)));
typedef int v8i_t __attribute__((ext_vector_type(8)));

__device__ __forceinline__ bool static_unit(int i, int G, int c, int nM, int nN, int& pm, int& pn) {
    const int nwg = nM * nN; const long L = (long)i * G + c; if (L >= nwg) return false;
    int wgid = (int)L; { const int q = nwg / NXCD, r = nwg % NXCD, xcd = wgid % NXCD, off = wgid / NXCD; wgid = (xcd < r ? xcd * (q + 1) : r * (q + 1) + (xcd - r) * q) + off; }
    const int nig = WGM * nN, gid = wgid / nig, fm = gid * WGM, gsz = (nM - fm) < WGM ? (nM - fm) : WGM;
    pm = fm + ((wgid % nig) % gsz); pn = (wgid % nig) / gsz; return true;
}

template <class Epi, class Sched, bool FP8>
__device__ __forceinline__ void gemm_phase(LAS unsigned char* lds, const Sched& S, const Epi& E, const int lda, const int ldb, const int nt) {
    const int tid = threadIdx.x, wid = __builtin_amdgcn_readfirstlane(tid >> 6), lane = tid & 63, wr = wid >> 2, wc = wid & 3, fr = lane & 15, fq = lane >> 4;
    int Rr[2], Cc[2]; unsigned voffB[2];
#pragma unroll
    for (int i = 0; i < 2; ++i) { stage_rc(tid * 16 + i * 8192, Rr[i], Cc[i]); const int Rb = (Rr[i] & ~31) + perm32(Rr[i] & 31); voffB[i] = (unsigned)(Rb * ldb + Cc[i] * 2); }
    const size_t kstep = (size_t)(BK * 2);
    const size_t hstepB = (size_t)HALF * ldb;
    const size_t hstepA = Sched::GATHER ? (size_t)0 : (size_t)HALF * lda;
    const unsigned ldsw = (unsigned)wid * 1024u;
    const int aoff = lds_byte(wr * 64 + fr, fq * 8), boff = lds_byte(wc * 32 + fr, fq * 8);
#define PG8_SA(b, h) (((b) * 2 + (h)) * HTB)
#define PG8_SB(b, h) ((4 + (b) * 2 + (h)) * HTB)
#define PG8_STAGE(bufoff, gbase, voff) do { _Pragma("unroll") for (int _i = 0; _i < 2; ++_i) \
        __builtin_amdgcn_global_load_lds((const unsigned*)((const char*)(gbase) + (voff)[_i]), (LAS unsigned*)(lds + (bufoff) + ldsw + _i * 8192), 16, 0, 0); } while (0)
#define PG8_LDA(dst, b, h) do { _Pragma("unroll") for (int m = 0; m < 4; ++m) _Pragma("unroll") for (int k = 0; k < 2; ++k) dst[m][k] = *(const LAS bf16x8*)(lds + PG8_SA(b, h) + (aoff ^ (k * 64)) + m * 2048); } while (0)
#define PG8_LDB(dst, b, h) do { _Pragma("unroll") for (int n = 0; n < 2; ++n) _Pragma("unroll") for (int k = 0; k < 2; ++k) dst[n][k] = *(const LAS bf16x8*)(lds + PG8_SB(b, h) + (boff ^ (k * 64)) + n * 2048); } while (0)
#define PG8_CAT(x) __builtin_shufflevector(__builtin_bit_cast(v4i_t, (x)[0]), __builtin_bit_cast(v4i_t, (x)[1]), 0, 1, 2, 3, 4, 5, 6, 7)
#define PG8_MMA(ai, bj, At, Bt) do { __builtin_amdgcn_s_setprio(1); if constexpr (FP8) { _Pragma("unroll") for (int m = 0; m < 4; ++m) _Pragma("unroll") for (int n = 0; n < 2; ++n) \
        acc[ai][bj][m][n] = __builtin_amdgcn_mfma_scale_f32_16x16x128_f8f6f4(PG8_CAT(Bt[n]), PG8_CAT(At[m]), acc[ai][bj][m][n], 0, 0, 0, 0, 0, 0); }   \
    else { _Pragma("unroll") for (int m = 0; m < 4; ++m) _Pragma("unroll") for (int n = 0; n < 2; ++n) _Pragma("unroll") for (int k = 0; k < 2; ++k) \
        acc[ai][bj][m][n] = __builtin_amdgcn_mfma_f32_16x16x32_bf16(Bt[n][k], At[m][k], acc[ai][bj][m][n], 0, 0, 0); } __builtin_amdgcn_s_setprio(0); } while (0)
#define PG8_WAIT_V(n) asm volatile("s_waitcnt vmcnt(" #n ")" ::: "memory")
#define PG8_WAIT_L(n) asm volatile("s_waitcnt lgkmcnt(" #n ")" ::: "memory")
#define PG8_BAR __builtin_amdgcn_s_barrier()
#define PG8_SCHED __builtin_amdgcn_sched_barrier(0)
    Unit cur, nxt; int ui = 0;
    if (!S.next(0, cur)) return;
    f32x4 acc[2][2][4][2];
#pragma unroll
    for (int a = 0; a < 2; ++a)
#pragma unroll
        for (int b = 0; b < 2; ++b)
#pragma unroll
            for (int m = 0; m < 4; ++m)
#pragma unroll
                for (int n = 0; n < 2; ++n) acc[a][b][m][n] = (f32x4){0.f, 0.f, 0.f, 0.f};
    bf16x8 At[4][2], B0[2][2], B1[2][2];
    unsigned oA[2][2];
#pragma unroll
    for (int h = 0; h < 2; ++h)
#pragma unroll
        for (int i = 0; i < 2; ++i) oA[h][i] = Sched::GATHER ? (S.goff(0, h * HALF + Rr[i]) + (unsigned)Cc[i] * 2u) : (unsigned)(Rr[i] * lda + Cc[i] * 2);
    const char* cA = S.aptr(cur); const char* cB = S.bptr(cur);
    PG8_STAGE(PG8_SB(0, 0), cB, voffB); PG8_STAGE(PG8_SB(0, 1), cB + hstepB, voffB); PG8_STAGE(PG8_SA(0, 0), cA, oA[0]); PG8_STAGE(PG8_SA(0, 1), cA + hstepA, oA[1]);
    if (wr == 1) PG8_BAR;
    PG8_WAIT_V(2); PG8_BAR;
    PG8_STAGE(PG8_SB(1, 0), cB + kstep, voffB); PG8_STAGE(PG8_SA(1, 0), cA + kstep, oA[0]); PG8_STAGE(PG8_SB(1, 1), cB + hstepB + kstep, voffB);
    PG8_WAIT_V(6); PG8_BAR;
    for (;;) {
        const bool has_next = S.next(ui + 1, nxt);
        const char* nA = has_next ? S.aptr(nxt) : cA; const char* nB = has_next ? S.bptr(nxt) : cB;
#pragma clang loop unroll(disable)
        for (int t = 0; t < nt; t += 2) {
            const bool last = (t == nt - 2);
            const char* a1 = cA + (size_t)(t + 1) * kstep;
            const char* a2 = last ? nA : cA + (size_t)(t + 2) * kstep; const char* b2 = last ? nB : cB + (size_t)(t + 2) * kstep;
            const char* a3 = a2 + kstep; const char* b3 = b2 + kstep;
            PG8_LDB(B0, 0, 0); PG8_LDB(B1, 0, 1); PG8_SCHED; PG8_LDA(At, 0, 0); PG8_STAGE(PG8_SA(1, 1), a1 + hstepA, oA[1]);
            if constexpr (Sched::GATHER) { if (last && has_next) {
#pragma unroll
                for (int h = 0; h < 2; ++h)
#pragma unroll
                    for (int i = 0; i < 2; ++i) oA[h][i] = S.goff(ui + 1, h * HALF + Rr[i]) + (unsigned)Cc[i] * 2u; } }
            PG8_WAIT_V(8); PG8_WAIT_L(0); PG8_BAR; PG8_MMA(0, 0, At, B0); PG8_MMA(0, 1, At, B1); PG8_BAR; PG8_SCHED;
            PG8_LDA(At, 0, 1); PG8_STAGE(PG8_SB(0, 0), b2, voffB); PG8_STAGE(PG8_SB(0, 1), b2 + hstepB, voffB); PG8_STAGE(PG8_SA(0, 0), a2, oA[0]);
            PG8_WAIT_V(8); PG8_WAIT_L(0); PG8_BAR; PG8_MMA(1, 0, At, B0); PG8_MMA(1, 1, At, B1); PG8_BAR; PG8_SCHED;
            PG8_LDB(B0, 1, 0); PG8_LDB(B1, 1, 1); PG8_SCHED; PG8_LDA(At, 1, 0); PG8_STAGE(PG8_SA(0, 1), a2 + hstepA, oA[1]);
            PG8_WAIT_V(8); PG8_WAIT_L(0); PG8_BAR; PG8_MMA(0, 0, At, B0); PG8_MMA(0, 1, At, B1); PG8_BAR; PG8_SCHED;
            PG8_LDA(At, 1, 1); PG8_STAGE(PG8_SB(1, 0), b3, voffB); PG8_STAGE(PG8_SB(1, 1), b3 + hstepB, voffB); PG8_STAGE(PG8_SA(1, 0), a3, oA[0]);
            PG8_WAIT_V(8); PG8_WAIT_L(0); PG8_BAR; PG8_MMA(1, 0, At, B0); PG8_MMA(1, 1, At, B1); PG8_BAR; PG8_SCHED;
        }
        if (wr == 0) PG8_BAR;
        bool keep = false;
        {
            int tz = threadIdx.x; asm volatile("" : "+v"(tz)); const int ewid = tz >> 6, el = tz & 63, ewr = ewid >> 2, ewc = ewid & 3, efr = el & 15, efq = el >> 4;
            if constexpr (Sched::HAS_MID) { if (S.is_mid(cur)) { E.mid(acc, cur, ewr, ewc, efr, efq); keep = true; } }
            if (!keep) E(acc, cur, ewr, ewc, efr, efq);
        }
        if (!has_next) break;
        if (!keep) {
#pragma unroll
            for (int a = 0; a < 2; ++a)
#pragma unroll
                for (int b = 0; b < 2; ++b)
#pragma unroll
                    for (int m = 0; m < 4; ++m)
#pragma unroll
                        for (int n = 0; n < 2; ++n) acc[a][b][m][n] = (f32x4){0.f, 0.f, 0.f, 0.f};
        }
        cur = nxt; cA = nA; cB = nB; ++ui;
        if (wr == 1) PG8_BAR;
    }
    PG8_WAIT_V(0);
    PG8_BAR;
#undef PG8_SA
#undef PG8_SB
#undef PG8_STAGE
#undef PG8_LDA
#undef PG8_LDB
#undef PG8_MMA
#undef PG8_CAT
#undef PG8_WAIT_V
#undef PG8_WAIT_L
#undef PG8_BAR
#undef PG8_SCHED
}
}
using pg8::Unit;

struct Args { const float* in[25]; float* out; unsigned char* ws; int ph_lo, ph_hi, pad0, pad1; };
static_assert(sizeof(Args) == 27 * 8 + 16, "Args has no padding");
struct Frame {
    LAS unsigned char* lds; volatile LAS unsigned* MISC; unsigned* ctl;
    int tid, lane, wave, vcu, G;
};
#define LDS_WAIT() asm volatile("s_waitcnt lgkmcnt(0)" ::: "memory")
#define VM_WAIT() asm volatile("s_waitcnt vmcnt(0)" ::: "memory")

struct SchedStatic {
    static constexpr bool GATHER = false, HAS_MID = false;
    const char* A; const char* B; int nM, nN, G, c; size_t astep, bstep;
    __device__ __forceinline__ bool next(int i, Unit& u) const { u.aux = 0; return pg8::static_unit(i, G, c, nM, nN, u.pm, u.pn); }
    __device__ __forceinline__ const char* aptr(const Unit& u) const { return A + (size_t)u.pm * astep; }
    __device__ __forceinline__ const char* bptr(const Unit& u) const { return B + (size_t)u.pn * bstep; }
    __device__ __forceinline__ bool is_mid(const Unit&) const { return false; }
    __device__ __forceinline__ unsigned goff(int, int) const { return 0u; }
};
struct SchedSplit2 {
    static constexpr bool GATHER = false, HAS_MID = true;
    const char* A; const char* B; int nM, nN, G, c; size_t astep, bstep, khalf;
    __device__ __forceinline__ bool next(int i, Unit& u) const { u.aux = i & 1; return pg8::static_unit(i >> 1, G, c, nM, nN, u.pm, u.pn); }
    __device__ __forceinline__ const char* aptr(const Unit& u) const { return A + (size_t)u.pm * astep + (size_t)u.aux * khalf; }
    __device__ __forceinline__ const char* bptr(const Unit& u) const { return B + (size_t)u.pn * bstep + (size_t)u.aux * khalf; }
    __device__ __forceinline__ bool is_mid(const Unit& u) const { return u.aux == 0; }
    __device__ __forceinline__ unsigned goff(int, int) const { return 0u; }
};
__device__ __forceinline__ int moe_find_e(volatile LAS unsigned* MISC, int rb) { int e = 0;
#pragma unroll 1
    for (int i = 1; i < NEXP; ++i) e += ((int)MISC[i] <= rb) ? 1 : 0;
    return e; }
template <int NPN, bool GATH>
struct SchedMoe {
    static constexpr bool GATHER = GATH, HAS_MID = false;
    static constexpr int RPX = 32 / NPN;
    static constexpr int UT0 = 96, UTN = 24;
    const char* A; const char* B; volatile LAS unsigned* MISC; const LAS unsigned* gtab; int c, G, nrb; size_t bstep_e, bstep_n;
    __device__ __forceinline__ bool slow_next(int i, Unit& u) const {
        int rb, pn;
        if (G == 256) { const int x = c & 7, j = c >> 3; rb = (8 * i + x) * RPX + j / NPN; pn = j % NPN; }
        else { const long L = (long)i * G + c; rb = (int)(L / NPN); pn = (int)(L % NPN); }
        if (rb >= nrb) return false;
        u.pm = rb; u.pn = pn; u.aux = moe_find_e(MISC, rb); return true;
    }
    __device__ __forceinline__ void build(int tid) const {
        if (tid < UTN) { Unit u; const bool ok = slow_next(tid, u); MISC[UT0 + tid] = ok ? (0x80000000u | ((unsigned)u.aux << 16) | ((unsigned)u.pn << 12) | (unsigned)u.pm) : 0u; }
        __syncthreads();
    }
    __device__ __forceinline__ bool next(int i, Unit& u) const {
        if (i >= UTN) return false;
        const unsigned w = MISC[UT0 + i]; if (!(w >> 31)) return false;
        u.pm = (int)(w & 0xfffu); u.pn = (int)((w >> 12) & 0xfu); u.aux = (int)((w >> 16) & 0xffu); return true;
    }
    __device__ __forceinline__ const char* aptr(const Unit& u) const { return GATH ? A : A + (size_t)u.pm * (256 * 1024); }
    __device__ __forceinline__ const char* bptr(const Unit& u) const { return B + (size_t)u.aux * bstep_e + (size_t)u.pn * bstep_n; }
    __device__ __forceinline__ bool is_mid(const Unit&) const { return false; }
    __device__ __forceinline__ unsigned goff(int ui, int row) const { return gtab[ui * 256 + row]; }
};

#define EPI_ARGS f32x4 (&acc)[2][2][4][2], const Unit& u, int wr, int wc, int fr, int fq
__device__ __forceinline__ u32x4 pair16(u32x2 x, u32x2 y) {
    const auto rx = __builtin_amdgcn_permlane16_swap(x.x, y.x, false, false); const auto ry = __builtin_amdgcn_permlane16_swap(x.y, y.y, false, false);
    return (u32x4){rx[0], ry[0], rx[1], ry[1]};
}
struct EpiG1 {
    bf16 *Q, *K, *V, *U, *VG, *GT; const float* bgate;
    __device__ __forceinline__ void mid(EPI_ARGS) const {}
    __device__ __forceinline__ void operator()(EPI_ARGS) const {
        const int pn = u.pn; const int row0 = u.pm * 256 + wr * 64 + fr;
        if (pn < 6) {
            const int t = pn >> 1; bf16* base = Q + (size_t)t * ((WS_K - WS_Q) / 2); const float sc = (t == 0) ? QSCALE : 1.0f;    const int col0 = (pn & 1) * 256 + wc * 32 + 8 * fq;
#pragma unroll
            for (int ai = 0; ai < 2; ++ai)
#pragma unroll
                for (int m = 0; m < 4; ++m) { bf16* rowp = base + (size_t)(row0 + ai * 128 + m * 16) * 512 + col0;
#pragma unroll
                    for (int bj = 0; bj < 2; ++bj) { const f32x4 v0 = acc[ai][bj][m][0] * sc, v1 = acc[ai][bj][m][1] * sc;
                        u32x4 w; w.x = cvtpk(v0[0], v0[1]); w.y = cvtpk(v0[2], v0[3]); w.z = cvtpk(v1[0], v1[1]); w.w = cvtpk(v1[2], v1[3]); *(u32x4*)(rowp + bj * 128) = w; } }
        } else if (pn < 10) {
            bf16* base = Q + (size_t)(pn >> 1) * ((WS_K - WS_Q) / 2); const int col0 = (pn & 1) * 256 + wc * 32 + 8 * fq;
#pragma unroll
            for (int ai = 0; ai < 2; ++ai)
#pragma unroll
                for (int m = 0; m < 4; ++m) { bf16* rowp = base + (size_t)(row0 + ai * 128 + m * 16) * 512 + col0;
#pragma unroll
                    for (int bj = 0; bj < 2; ++bj) { const f32x4 v0 = acc[ai][bj][m][0], v1 = acc[ai][bj][m][1];
                        const f32x2 a = gelu_pk((f32x2){v0[0], v0[1]}), b = gelu_pk((f32x2){v0[2], v0[3]}), c = gelu_pk((f32x2){v1[0], v1[1]}), d = gelu_pk((f32x2){v1[2], v1[3]});
                        u32x4 w; w.x = cvtpk(a.x, a.y); w.y = cvtpk(b.x, b.y); w.z = cvtpk(c.x, c.y); w.w = cvtpk(d.x, d.y); *(u32x4*)(rowp + bj * 128) = w; } }
        } else {
            const int col0 = (pn - 10) * 128 + wc * 32 + 8 * fq;
            const f32x4 ba0 = *(const f32x4*)(bgate + col0), ba1 = *(const f32x4*)(bgate + col0 + 4), bb0 = *(const f32x4*)(bgate + 1024 + col0), bb1 = *(const f32x4*)(bgate + 1024 + col0 + 4);
#pragma unroll
            for (int ai = 0; ai < 2; ++ai)
#pragma unroll
                for (int m = 0; m < 4; ++m) { bf16* rowp = GT + (size_t)(row0 + ai * 128 + m * 16) * 2048 + col0;
                    const f32x4 a0 = acc[ai][0][m][0] + ba0, a1 = acc[ai][0][m][1] + ba1, b0 = acc[ai][1][m][0] + bb0, b1 = acc[ai][1][m][1] + bb1;
                    f32x4 ea0, ea1, eb0, eb1;
#pragma unroll
                    for (int i = 0; i < 4; ++i) { ea0[i] = __builtin_amdgcn_exp2f(-LOG2E * a0[i]); ea1[i] = __builtin_amdgcn_exp2f(-LOG2E * a1[i]); eb0[i] = fminf(__builtin_amdgcn_exp2f(-LOG2E * b0[i]), 1e18f); eb1[i] = fminf(__builtin_amdgcn_exp2f(-LOG2E * b1[i]), 1e18f); }
                    f32x4 gb0, gb1, r0, r1;
#pragma unroll
                    for (int i = 0; i < 4; ++i) { gb0[i] = __builtin_amdgcn_rcpf(1.0f + eb0[i]); gb1[i] = __builtin_amdgcn_rcpf(1.0f + eb1[i]); r0[i] = (1.0f + eb0[i]) * __builtin_amdgcn_rcpf(1.0f + ea0[i]); r1[i] = (1.0f + eb1[i]) * __builtin_amdgcn_rcpf(1.0f + ea1[i]); }
                    u32x4 wr, wb; wr.x = cvtpk(r0[0], r0[1]); wr.y = cvtpk(r0[2], r0[3]); wr.z = cvtpk(r1[0], r1[1]); wr.w = cvtpk(r1[2], r1[3]);
                    wb.x = cvtpk(gb0[0], gb0[1]); wb.y = cvtpk(gb0[2], gb0[3]); wb.z = cvtpk(gb1[0], gb1[1]); wb.w = cvtpk(gb1[2], gb1[3]);
                    __builtin_nontemporal_store(wr, (u32x4*)rowp); __builtin_nontemporal_store(wb, (u32x4*)(rowp + 1024)); }
        }
    }
};
struct EpiG2 {
    const bf16* GT; bf16* MRG;
    __device__ __forceinline__ void mid(EPI_ARGS) const {
        const int row0 = u.pm * 256 + wr * 64 + fr, col0 = u.pn * 256 + wc * 32 + 8 * fq;
#pragma unroll
        for (int ai = 0; ai < 2; ++ai)
#pragma unroll
            for (int m = 0; m < 4; ++m) { const bf16* gp = GT + (size_t)(row0 + ai * 128 + m * 16) * 2048 + col0;
#pragma unroll
                for (int bj = 0; bj < 2; ++bj) { const u32x4 rr = __builtin_nontemporal_load((const u32x4*)(gp + bj * 128));
                    const f32x4 r0 = {bflo(rr.x), bfhi(rr.x), bflo(rr.y), bfhi(rr.y)}, r1 = {bflo(rr.z), bfhi(rr.z), bflo(rr.w), bfhi(rr.w)};
                    acc[ai][bj][m][0] *= r0; acc[ai][bj][m][1] *= r1; } }
    }
    __device__ __forceinline__ void operator()(EPI_ARGS) const {
        const int row0 = u.pm * 256 + wr * 64 + fr, col0 = u.pn * 256 + wc * 32 + 8 * fq;
#pragma unroll
        for (int ai = 0; ai < 2; ++ai)
#pragma unroll
            for (int m = 0; m < 4; ++m) { const size_t r = (size_t)(row0 + ai * 128 + m * 16); const bf16* gp = GT + r * 2048 + 1024 + col0; bf16* op = MRG + r * 1024 + col0;
#pragma unroll
                for (int bj = 0; bj < 2; ++bj) { const u32x4 gb = __builtin_nontemporal_load((const u32x4*)(gp + bj * 128)); const f32x4 v0 = acc[ai][bj][m][0], v1 = acc[ai][bj][m][1];
                    u32x4 w; w.x = cvtpk(v0[0] * bflo(gb.x), v0[1] * bfhi(gb.x)); w.y = cvtpk(v0[2] * bflo(gb.y), v0[3] * bfhi(gb.y));
                    w.z = cvtpk(v1[0] * bflo(gb.z), v1[1] * bfhi(gb.z)); w.w = cvtpk(v1[2] * bflo(gb.w), v1[3] * bfhi(gb.w)); *(u32x4*)(op + bj * 128) = w; } }
    }
};
struct EpiPlain {
    bf16* O;
    __device__ __forceinline__ void mid(EPI_ARGS) const {}
    __device__ __forceinline__ void operator()(EPI_ARGS) const {
        const int row0 = u.pm * 256 + wr * 64 + fr, col0 = u.pn * 256 + wc * 32 + 8 * fq;
#pragma unroll
        for (int ai = 0; ai < 2; ++ai)
#pragma unroll
            for (int m = 0; m < 4; ++m) { bf16* op = O + (size_t)(row0 + ai * 128 + m * 16) * 1024 + col0;
#pragma unroll
                for (int bj = 0; bj < 2; ++bj) { const f32x4 v0 = acc[ai][bj][m][0], v1 = acc[ai][bj][m][1];
                    u32x4 w; w.x = cvtpk(v0[0], v0[1]); w.y = cvtpk(v0[2], v0[3]); w.z = cvtpk(v1[0], v1[1]); w.w = cvtpk(v1[2], v1[3]); *(u32x4*)(op + bj * 128) = w; } }
    }
};
struct EpiAct {
    const float* bgu; unsigned char* ACT8;
    __device__ __forceinline__ void mid(EPI_ARGS) const {}
    __device__ __forceinline__ f32x2 act2(f32x2 g, f32x2 l) const {
        f32x2 xg, xl; xg.x = fminf(g.x, SWL); xg.y = fminf(g.y, SWL); xl.x = fminf(fmaxf(l.x, -SWL), SWL); xl.y = fminf(fmaxf(l.y, -SWL), SWL);
        const f32x2 t = xg * (-SWA * LOG2E); f32x2 e; e.x = __builtin_amdgcn_exp2f(t.x); e.y = __builtin_amdgcn_exp2f(t.y);
        const f32x2 d = e + 1.0f; f32x2 r; r.x = __builtin_amdgcn_rcpf(d.x); r.y = __builtin_amdgcn_rcpf(d.y);
        return (xg * r) * (xl * F8_ASCALE + F8_ASCALE);
    }
    __device__ __forceinline__ void operator()(EPI_ARGS) const {
        const int e = u.aux; const int row0 = u.pm * 256 + wr * 64 + fr, col0 = u.pn * 128 + wc * 32 + 8 * fq;
        const float* bp = bgu + (size_t)e * 2048 + col0;
        const f32x4 bg0 = *(const f32x4*)(bp), bg1 = *(const f32x4*)(bp + 4), bl0 = *(const f32x4*)(bp + 1024), bl1 = *(const f32x4*)(bp + 1028);
#pragma unroll
        for (int ai = 0; ai < 2; ++ai)
#pragma unroll
            for (int mp = 0; mp < 2; ++mp) {
                u32x2 w[2];
#pragma unroll
                for (int mm = 0; mm < 2; ++mm) { const int m = 2 * mp + mm;
                    const f32x4 g0 = acc[ai][0][m][0] * F8_DESCALE + bg0, g1 = acc[ai][0][m][1] * F8_DESCALE + bg1, l0 = acc[ai][1][m][0] * F8_DESCALE + bl0, l1 = acc[ai][1][m][1] * F8_DESCALE + bl1;
                    const f32x2 o0 = act2((f32x2){g0[0], g0[1]}, (f32x2){l0[0], l0[1]}), o1 = act2((f32x2){g0[2], g0[3]}, (f32x2){l0[2], l0[3]});
                    const f32x2 o2 = act2((f32x2){g1[0], g1[1]}, (f32x2){l1[0], l1[1]}), o3 = act2((f32x2){g1[2], g1[3]}, (f32x2){l1[2], l1[3]});
                    w[mm].x = pk_fp8x4_nc(o0.x, o0.y, o1.x, o1.y); w[mm].y = pk_fp8x4_nc(o2.x, o2.y, o3.x, o3.y); }
                *(u32x4*)(ACT8 + (size_t)(row0 + ai * 128 + (2 * mp + (fq & 1)) * 16) * 1024 + (col0 - 8 * (fq & 1))) = pair16(w[0], w[1]); }
    }
};
struct EpiDown {
    const float* bdn; unsigned char* Y2s;
    __device__ __forceinline__ void mid(EPI_ARGS) const {}
    __device__ __forceinline__ void operator()(EPI_ARGS) const {
        const int e = u.aux; const int row0 = u.pm * 256 + wr * 64 + fr, col0 = u.pn * 256 + wc * 32 + 8 * fq;
        f32x4 bv[2][2];
#pragma unroll
        for (int bj = 0; bj < 2; ++bj)
#pragma unroll
            for (int n = 0; n < 2; ++n) bv[bj][n] = *(const f32x4*)(bdn + (size_t)e * 1024 + col0 + bj * 128 + 4 * n) * F8_YSCALE;
#pragma unroll
        for (int ai = 0; ai < 2; ++ai)
#pragma unroll
            for (int mp = 0; mp < 2; ++mp) { unsigned char* op = Y2s + (size_t)(row0 + ai * 128 + (2 * mp + (fq & 1)) * 16) * 1024 + (col0 - 8 * (fq & 1));
#pragma unroll
                for (int bj = 0; bj < 2; ++bj) { u32x2 w[2];
#pragma unroll
                    for (int mm = 0; mm < 2; ++mm) { const int m = 2 * mp + mm;
                        const f32x4 v0 = acc[ai][bj][m][0] * (F8_DESCALE * F8_YSCALE) + bv[bj][0], v1 = acc[ai][bj][m][1] * (F8_DESCALE * F8_YSCALE) + bv[bj][1];
                        w[mm].x = pk_fp8x4(v0[0], v0[1], v0[2], v0[3]); w[mm].y = pk_fp8x4(v1[0], v1[1], v1[2], v1[3]); }
                    *(u32x4*)(op + bj * 128) = pair16(w[0], w[1]); } }
    }
};

struct WItem { const float* W; unsigned char* dst; int N, k0, n0, ldt, drow, dk0, fp8; };
__device__ __forceinline__ WItem witem_decode(const Args& a, int r) {
    unsigned char* ws = a.ws; WItem it;
    constexpr int I_IN = 8 * 80, I_GATE = 8 * 64, I_BR = 4 * 32, I_OUT = 8 * 32, I_GU = 8 * 64, I_DN = 8 * 32;
    it.fp8 = 0; it.dk0 = 0; it.ldt = 2048;
    if (r < I_IN) { it.W = a.in[6]; it.N = INW; it.k0 = 128 * (r / 80); it.n0 = 32 * (r % 80); it.dst = ws + WS_W1T; it.drow = it.n0; return it; } r -= I_IN;
    if (r < I_GATE) { it.W = a.in[14]; it.N = 2048; it.k0 = 128 * (r / 64); it.n0 = 32 * (r % 64); it.dst = ws + WS_W1T; const int m0 = it.n0 & 1023;
        it.drow = INW + 256 * (m0 >> 7) + (m0 & 127) + (it.n0 >= 1024 ? 128 : 0); return it; } r -= I_GATE;
    if (r < I_BR) { it.W = a.in[12]; it.N = 1024; it.k0 = 128 * (r / 32); it.n0 = 32 * (r % 32); it.dst = ws + WS_WBRT; it.drow = it.n0; return it; } r -= I_BR;
    if (r < I_BR) { it.W = a.in[13]; it.N = 1024; it.k0 = 128 * (r / 32); it.n0 = 32 * (r % 32); it.dst = ws + WS_WBRT; it.drow = it.n0; it.dk0 = 512; return it; } r -= I_BR;
    if (r < I_OUT) { it.W = a.in[16]; it.N = 1024; it.k0 = 128 * (r / 32); it.n0 = 32 * (r % 32); it.dst = ws + WS_WOUTT; it.drow = it.n0; return it; } r -= I_OUT;
    it.fp8 = 1; it.ldt = 1024;
    if (r < NEXP * I_GU) { const int e = r / I_GU, q = r % I_GU; it.W = a.in[21] + (size_t)e * D * 2048; it.N = 2048; it.k0 = 128 * (q / 64); it.n0 = 32 * (q % 64); it.dst = ws + WS_WGUT + (size_t)e * 2048 * 1024;
        const int m0 = it.n0 & 1023; it.drow = 256 * (m0 >> 7) + (m0 & 127) + (it.n0 >= 1024 ? 128 : 0); return it; }
    r -= NEXP * I_GU;
    { const int e = r / I_DN, q = r % I_DN; it.W = a.in[23] + (size_t)e * D * D; it.N = 1024; it.k0 = 128 * (q / 32); it.n0 = 32 * (q % 32); it.dst = ws + WS_WDNT + (size_t)e * 1024 * 1024; it.drow = it.n0; }
    return it;
}
constexpr int W_NITEMS = 8 * 80 + 8 * 64 + 2 * 4 * 32 + 8 * 32 + NEXP * (8 * 64 + 8 * 32);
__device__ __forceinline__ void witem_load(const WItem& it, float (&v)[64], int lane) {
    const float* p = it.W + (size_t)(it.k0 + (lane >> 3)) * it.N + it.n0 + (lane & 7) * 4;
#pragma unroll
    for (int i = 0; i < 16; ++i) { const f32x4 t = __builtin_nontemporal_load((const f32x4*)(p + (size_t)(8 * i) * it.N)); v[4 * i] = t[0]; v[4 * i + 1] = t[1]; v[4 * i + 2] = t[2]; v[4 * i + 3] = t[3]; }
}
__device__ __forceinline__ void witem_store(const WItem& it, const float (&v)[64], LAS float* scr, int lane) {
#pragma unroll
    for (int i = 0; i < 16; ++i) { const int k = 8 * i + (lane >> 3); *(LAS f32x4*)(scr + k * 32 + (((lane & 7) * 4 + 4 * (i >> 1)) & 31)) = (f32x4){v[4 * i], v[4 * i + 1], v[4 * i + 2], v[4 * i + 3]}; }
    LDS_WAIT(); asm volatile("" ::: "memory");
    const int c = lane & 7;
#pragma unroll
    for (int j = 0; j < 4; ++j) { const int n = (lane >> 3) + 8 * j; const LAS float* s = scr + (16 * c) * 32 + ((n + 4 * c) & 31);
        float x[16];
#pragma unroll
        for (int q = 0; q < 16; ++q) x[q] = s[q * 32];
        unsigned char* d = it.dst + (size_t)(it.drow + n) * it.ldt;
        if (it.fp8) { u32x4 o;
            o.x = pk_fp8x4(x[0] * F8_WSCALE, x[1] * F8_WSCALE, x[2] * F8_WSCALE, x[3] * F8_WSCALE); o.y = pk_fp8x4(x[4] * F8_WSCALE, x[5] * F8_WSCALE, x[6] * F8_WSCALE, x[7] * F8_WSCALE);
            o.z = pk_fp8x4(x[8] * F8_WSCALE, x[9] * F8_WSCALE, x[10] * F8_WSCALE, x[11] * F8_WSCALE); o.w = pk_fp8x4(x[12] * F8_WSCALE, x[13] * F8_WSCALE, x[14] * F8_WSCALE, x[15] * F8_WSCALE);
            __builtin_nontemporal_store(o, (u32x4*)(d + it.dk0 + it.k0 + 16 * c)); }
        else { u32x4 o0, o1;
            o0.x = cvtpk(x[0], x[1]); o0.y = cvtpk(x[2], x[3]); o0.z = cvtpk(x[4], x[5]); o0.w = cvtpk(x[6], x[7]); o1.x = cvtpk(x[8], x[9]); o1.y = cvtpk(x[10], x[11]); o1.z = cvtpk(x[12], x[13]); o1.w = cvtpk(x[14], x[15]);
            *(u32x4*)(d + (size_t)(it.dk0 + it.k0 + 16 * c) * 2) = o0; *(u32x4*)(d + (size_t)(it.dk0 + it.k0 + 16 * c) * 2 + 16) = o1; } }
    LDS_WAIT(); asm volatile("" ::: "memory");
}
__device__ __forceinline__ void phaseA(const Frame& F, const Args& a) {
    unsigned char* ws = a.ws;
    if (F.vcu < 192) {
        const float* c = a.in[1]; const float* w_ada = a.in[2]; const float* b_ada = a.in[3]; float* mod = (float*)(ws + WS_MOD);
        LAS float* red = (LAS float*)(F.lds);
        const int col = F.vcu * 32 + (F.tid & 31), ks = F.tid >> 5;
        float a0 = 0.f, a1 = 0.f, a2 = 0.f, a3 = 0.f;
        for (int k = ks * 64; k < ks * 64 + 64; ++k) { const float w = __builtin_nontemporal_load(w_ada + (size_t)k * 6144 + col);
            const float c0 = c[k], c1 = c[D + k], c2 = c[2 * D + k], c3 = c[3 * D + k];
            a0 += c0 * __builtin_amdgcn_rcpf(1.0f + __expf(-c0)) * w; a1 += c1 * __builtin_amdgcn_rcpf(1.0f + __expf(-c1)) * w;
            a2 += c2 * __builtin_amdgcn_rcpf(1.0f + __expf(-c2)) * w; a3 += c3 * __builtin_amdgcn_rcpf(1.0f + __expf(-c3)) * w; }
        red[(ks * 4 + 0) * 32 + (F.tid & 31)] = a0; red[(ks * 4 + 1) * 32 + (F.tid & 31)] = a1; red[(ks * 4 + 2) * 32 + (F.tid & 31)] = a2; red[(ks * 4 + 3) * 32 + (F.tid & 31)] = a3;
        __syncthreads();
        if (F.tid < 128) { const int b = F.tid >> 5, cc = F.tid & 31; float s = 0.f;
#pragma unroll
            for (int k = 0; k < 16; ++k) s += red[(k * 4 + b) * 32 + cc];
            mod[b * 6144 + F.vcu * 32 + cc] = s + b_ada[F.vcu * 32 + cc]; }
        __syncthreads();
    }
    if (F.vcu == 192 % F.G) {
        const float* w_router = a.in[19]; bf16* wrt = (bf16*)(ws + WS_WRT);
        for (int i = F.tid; i < D * NEXP; i += NWAVES * 64) { const int k = i >> 5, e = i & 31; const float w = w_router[i]; const unsigned hh = cvtpk(w, 0.f) & 0xffffu;
            wrt[(size_t)e * D + k] = (bf16)hh; wrt[(size_t)(NEXP + e) * D + k] = (bf16)(cvtpk(w - bflo(hh), 0.f) & 0xffffu); }
    }
    LAS float* scr = (LAS float*)(F.lds + F.wave * 17408);
    const int gw = F.vcu * NWAVES + F.wave, NGW = F.G * NWAVES;
    if (gw < W_NITEMS) {
        float va[64], vb[64];
        WItem ia = witem_decode(a, gw), ib = ia;
        witem_load(ia, va, F.lane);
        for (int it = gw; it < W_NITEMS; it += 2 * NGW) {
            const bool hb = (it + NGW < W_NITEMS);
            ib = witem_decode(a, hb ? it + NGW : it); witem_load(ib, vb, F.lane);
            witem_store(ia, va, scr, F.lane);
            if (!hb) break;
            const bool ha = (it + 2 * NGW < W_NITEMS);
            ia = witem_decode(a, ha ? it + 2 * NGW : it); witem_load(ia, va, F.lane);
            witem_store(ib, vb, scr, F.lane);
            if (!ha) break;
        }
    }
}
__device__ __forceinline__ void phaseB(const Frame& F, const Args& a) {
    const float* x = a.in[0]; const float* g = a.in[4]; const float* mod = (const float*)(a.ws + WS_MOD); bf16* xn = (bf16*)(a.ws + WS_XN);
    const int gw = F.vcu * NWAVES + F.wave, NGW = F.G * NWAVES;
    f32x4 cg[4], csh[4]; int cb = -1;
    for (int row0 = gw * 4; row0 < NTOK; row0 += NGW * 4) {
        f32x4 v[4][4];
#pragma unroll
        for (int rr = 0; rr < 4; ++rr)
#pragma unroll
            for (int j = 0; j < 4; ++j) v[rr][j] = __builtin_nontemporal_load((const f32x4*)(x + (size_t)(row0 + rr) * D) + F.lane + 64 * j);
        const int b = row0 / SEQ; const float* mb = mod + b * 6144;
        if (b != cb) { cb = b;
#pragma unroll
            for (int j = 0; j < 4; ++j) { const int c0 = (F.lane + 64 * j) * 4; cg[j] = *(const f32x4*)(g + c0) * (*(const f32x4*)(mb + SC1 + c0) + 1.0f); csh[j] = *(const f32x4*)(mb + SH1 + c0); } }
#pragma unroll
        for (int rr = 0; rr < 4; ++rr) {
            float ss = 0.f;
#pragma unroll
            for (int j = 0; j < 4; ++j) ss += (v[rr][j].x * v[rr][j].x + v[rr][j].y * v[rr][j].y) + (v[rr][j].z * v[rr][j].z + v[rr][j].w * v[rr][j].w);
            const float rstd = rsqrtf(wsum(ss) * (1.0f / D) + EPS);
            u32x2* o8 = (u32x2*)(xn + (size_t)(row0 + rr) * D) + F.lane;
#pragma unroll
            for (int j = 0; j < 4; ++j) {
                const f32x4 h = v[rr][j] * rstd * cg[j] + csh[j];
                u32x2 w; w.x = cvtpk(h[0], h[1]); w.y = cvtpk(h[2], h[3]); o8[64 * j] = w; }
        }
    }
}

__device__ __forceinline__ void store_row32(bf16* blk, u32x2 w0, u32x2 w1, u32x2 w2, u32x2 w3, int hi) {
    { const auto rx = __builtin_amdgcn_permlane32_swap(w0.x, w1.x, false, false); const auto ry = __builtin_amdgcn_permlane32_swap(w0.y, w1.y, false, false);
      u32x4 o = {rx[0], ry[0], rx[1], ry[1]}; *(u32x4*)(blk + (hi ? 8 : 0)) = o; }
    { const auto rx = __builtin_amdgcn_permlane32_swap(w2.x, w3.x, false, false); const auto ry = __builtin_amdgcn_permlane32_swap(w2.y, w3.y, false, false);
      u32x4 o = {rx[0], ry[0], rx[1], ry[1]}; *(u32x4*)(blk + 16 + (hi ? 8 : 0)) = o; }
}
constexpr int SGU_STRIDE = 1088;
__device__ __forceinline__ s16x4 vtr(const LAS unsigned char* p) { typedef short v4i16_t __attribute__((ext_vector_type(4))); return __builtin_bit_cast(s16x4, __builtin_amdgcn_ds_read_tr16_b64_v4i16((LAS v4i16_t*)p)); }
__device__ __forceinline__ void sgu_unit(const Frame& F, const Args& a, int b, int blk) {
    const bf16* VG = (const bf16*)(a.ws + WS_VG); const bf16* U = (const bf16*)(a.ws + WS_U); bf16* YAB = (bf16*)(a.ws + WS_YAB);
    const float* ln_g = a.in[8]; const float* ln_b = a.in[9]; const float* w_s = a.in[10]; const float* b_s = a.in[11];
    const int tok0 = b * SEQ + blk * SGB, lane = F.lane;
    {
        const f32x4 g0 = *(const f32x4*)(ln_g + lane * 8), g1 = *(const f32x4*)(ln_g + lane * 8 + 4), b0 = *(const f32x4*)(ln_b + lane * 8), b1 = *(const f32x4*)(ln_b + lane * 8 + 4);
#pragma unroll 1
        for (int r4 = 0; r4 < 16; r4 += 4) {
            u32x4 w[4];
#pragma unroll
            for (int rr = 0; rr < 4; ++rr) w[rr] = __builtin_nontemporal_load((const u32x4*)(VG + (size_t)(tok0 + F.wave * 16 + r4 + rr) * 512 + lane * 8));
#pragma unroll
            for (int rr = 0; rr < 4; ++rr) { const int row = F.wave * 16 + r4 + rr;
                f32x4 v0 = {bflo(w[rr].x), bfhi(w[rr].x), bflo(w[rr].y), bfhi(w[rr].y)}, v1 = {bflo(w[rr].z), bfhi(w[rr].z), bflo(w[rr].w), bfhi(w[rr].w)};
                const float mu = wsum((v0[0] + v0[1]) + (v0[2] + v0[3]) + (v1[0] + v1[1]) + (v1[2] + v1[3])) * (1.0f / 512.0f);
                v0 -= mu; v1 -= mu;
                const float var = wsum((v0[0] * v0[0] + v0[1] * v0[1]) + (v0[2] * v0[2] + v0[3] * v0[3]) + (v1[0] * v1[0] + v1[1] * v1[1]) + (v1[2] * v1[2] + v1[3] * v1[3])) * (1.0f / 512.0f);
                const float rstd = rsqrtf(var + EPS);
                v0 = v0 * rstd * g0 + b0; v1 = v1 * rstd * g1 + b1;
                u32x4 o; o.x = cvtpk(v0[0], v0[1]); o.y = cvtpk(v0[2], v0[3]); o.z = cvtpk(v1[0], v1[1]); o.w = cvtpk(v1[2], v1[3]);
                *(LAS u32x4*)(F.lds + row * SGU_STRIDE + lane * 16) = o; }
        }
    }
    __syncthreads();
    {
        const int g = F.wave, r32 = lane & 31, hi = lane >> 5, i16 = lane & 15, g16 = (lane >> 4) & 1;
        const LAS unsigned char* vb = F.lds + (8 * hi + (i16 >> 2)) * SGU_STRIDE + (g * 64 + 16 * g16 + 4 * (i16 & 3)) * 2;
#pragma unroll
        for (int tb = 0; tb < 4; ++tb) {
            const int t = 32 * tb + r32; const float* wrow = w_s + ((size_t)g * 128 + t) * 128;
            f32x4 wr0[8], wr1[8];
#pragma unroll
            for (int ks = 0; ks < 2 * tb + 2; ++ks) { wr0[ks] = *(const f32x4*)(wrow + 16 * ks + 8 * hi); wr1[ks] = *(const f32x4*)(wrow + 16 * ks + 8 * hi + 4); }
            const float bs = b_s[g * 128 + t];
            const bf16* up = U + (size_t)(tok0 + t) * 512 + g * 64 + 4 * hi;
            u32x2 uu0[4], uu1[4];
#pragma unroll
            for (int gg = 0; gg < 4; ++gg) { uu0[gg] = *(const u32x2*)(up + 8 * gg); uu1[gg] = *(const u32x2*)(up + 32 + 8 * gg); }
            f32x16 a0, a1;
#pragma unroll
            for (int r = 0; r < 16; ++r) { a0[r] = 0.f; a1[r] = 0.f; }
#pragma unroll
            for (int ks = 0; ks < 2 * tb + 2; ++ks) {
                const int s0 = 16 * ks + 8 * hi;
                float wv[8] = {wr0[ks][0], wr0[ks][1], wr0[ks][2], wr0[ks][3], wr1[ks][0], wr1[ks][1], wr1[ks][2], wr1[ks][3]};
                if (ks >= 2 * tb) {
#pragma unroll
                    for (int j = 0; j < 8; ++j) wv[j] = (s0 + j <= t) ? wv[j] : 0.f; }
                u32x4 bw; bw.x = cvtpk(wv[0], wv[1]); bw.y = cvtpk(wv[2], wv[3]); bw.z = cvtpk(wv[4], wv[5]); bw.w = cvtpk(wv[6], wv[7]);
                const bf16x8 bfrag = __builtin_bit_cast(bf16x8, bw);
                const LAS unsigned char* p = vb + ks * 16 * SGU_STRIDE;
                const s16x4 l0 = vtr(p), h0 = vtr(p + 4 * SGU_STRIDE), l1 = vtr(p + 64), h1 = vtr(p + 4 * SGU_STRIDE + 64);
                const bf16x8 A0 = {l0[0], l0[1], l0[2], l0[3], h0[0], h0[1], h0[2], h0[3]}, A1 = {l1[0], l1[1], l1[2], l1[3], h1[0], h1[1], h1[2], h1[3]};
                a0 = __builtin_amdgcn_mfma_f32_32x32x16_bf16(A0, bfrag, a0, 0, 0, 0);
                a1 = __builtin_amdgcn_mfma_f32_32x32x16_bf16(A1, bfrag, a1, 0, 0, 0);
            }
            bf16* op = YAB + (size_t)(tok0 + t) * 1024 + 512 + g * 64;
            u32x2 q0[4], q1[4];
#pragma unroll
            for (int gg = 0; gg < 4; ++gg) {
                q0[gg].x = cvtpk(bflo(uu0[gg].x) * (a0[4 * gg] + bs), bfhi(uu0[gg].x) * (a0[4 * gg + 1] + bs)); q0[gg].y = cvtpk(bflo(uu0[gg].y) * (a0[4 * gg + 2] + bs), bfhi(uu0[gg].y) * (a0[4 * gg + 3] + bs));
                q1[gg].x = cvtpk(bflo(uu1[gg].x) * (a1[4 * gg] + bs), bfhi(uu1[gg].x) * (a1[4 * gg + 1] + bs)); q1[gg].y = cvtpk(bflo(uu1[gg].y) * (a1[4 * gg + 2] + bs), bfhi(uu1[gg].y) * (a1[4 * gg + 3] + bs)); }
            store_row32(op, q0[0], q0[1], q0[2], q0[3], hi); store_row32(op + 32, q1[0], q1[1], q1[2], q1[3], hi);
        }
    }
    __syncthreads();
}

constexpr int AT_WAVE = 16384, AT_BUF = 8192, AT_V = 4096, AT_BT = GTAB_OFF;
static_assert(8 * 1088 <= GTAB_BYTES, "bias tables fit above the ring");
__device__ __forceinline__ void attn_chunks(const Frame& F, const Args& a, int gc0, int gc1) {
    const bf16* __restrict__ Q = (const bf16*)(a.ws + WS_Q); const bf16* __restrict__ Kb = (const bf16*)(a.ws + WS_K); const bf16* __restrict__ Vb = (const bf16*)(a.ws + WS_V); bf16* YAB = (bf16*)(a.ws + WS_YAB);
    int tid = F.tid; asm volatile("" : "+v"(tid));
    const int lane = tid & 63, wave = F.wave, h = wave;
    const int r32 = lane & 31, hi = lane >> 5, i16 = lane & 15, g16 = (lane >> 4) & 1;
    const int gcs[2] = {gc0, gc1};
    int j0s[2], nts[2], tok0s[2];
#pragma unroll
    for (int i = 0; i < 2; ++i) { const int c = gcs[i] % (SEQ / CHUNK); j0s[i] = (c < NLEFT) ? (NLEFT - c) : 0; nts[i] = 2 * (9 - j0s[i]); tok0s[i] = (gcs[i] / (SEQ / CHUNK)) * SEQ + c * CHUNK; }
    const int total = nts[0] + nts[1];
    LAS unsigned char* wb = F.lds + wave * AT_WAVE;
    const LAS float* bt = (const LAS float*)(F.lds + AT_BT + h * 1088);
    unsigned dsrcK[4], dsrcV[4];
#pragma unroll
    for (int i = 0; i < 4; ++i) { const int key = 8 * i + (lane >> 3), slot = lane & 7;
        dsrcK[i] = (unsigned)(key * 512 + h * 64 + ((slot ^ ((key >> 1) & 7)) << 3)); dsrcV[i] = (unsigned)(key * 512 + h * 64 + ((slot ^ (((key >> 1) & 1) << 2)) << 3)); }
#define AT_DMA(bufp, tbase) do { _Pragma("unroll") for (int i_ = 0; i_ < 4; ++i_) { \
        __builtin_amdgcn_global_load_lds((const unsigned*)(Kb + (tbase) + dsrcK[i_]), (LAS unsigned*)((bufp) + i_ * 1024), 16, 0, 0); \
        __builtin_amdgcn_global_load_lds((const unsigned*)(Vb + (tbase) + dsrcV[i_]), (LAS unsigned*)((bufp) + AT_V + i_ * 1024), 16, 0, 0); } } while (0)
#define AT_DECODE(t, ci, j, sub) do { ci = ((t) >= nts[0]) ? 1 : 0; const int u_ = (t) - ci * nts[0]; j = j0s[ci] + (u_ >> 1); sub = u_ & 1; } while (0)
    int ko[4];
#pragma unroll
    for (int sI = 0; sI < 4; ++sI) ko[sI] = r32 * 128 + ((((2 * sI + hi) ^ ((r32 >> 1) & 7))) << 4);
    const int fb = (i16 >> 3) & 1;
    const int vr0 = AT_V + (4 * hi + (i16 >> 2)) * 128 + ((4 * (0 ^ fb) + 2 * g16 + ((i16 & 3) >> 1)) * 16) + (i16 & 1) * 8;
    const int vr1 = AT_V + (4 * hi + (i16 >> 2)) * 128 + ((4 * (1 ^ fb) + 2 * g16 + ((i16 & 3) >> 1)) * 16) + (i16 & 1) * 8;
    {
        int ci, j, sub; AT_DECODE(0, ci, j, sub);
        AT_DMA(wb, (size_t)(tok0s[ci] + (j - NLEFT) * CHUNK + 32 * sub) * 512);
    }
    bf16x8 qf[2][4]; f32x16 oA[2], oB[2]; float m[2] = {-1e30f, -1e30f}, l[2] = {0.f, 0.f};
#pragma unroll
    for (int hf = 0; hf < 2; ++hf) {
#pragma unroll
        for (int r = 0; r < 16; ++r) { oA[hf][r] = 0.f; oB[hf][r] = 0.f; }
#pragma unroll
        for (int sI = 0; sI < 4; ++sI) qf[hf][sI] = (bf16x8){0, 0, 0, 0, 0, 0, 0, 0}; }
#pragma unroll 1
    for (int t = 0; t < total; ++t) {
        int ci, j, sub; AT_DECODE(t, ci, j, sub);
        const int tn = (t + 1 < total) ? t + 1 : t; int cin, jn, subn; AT_DECODE(tn, cin, jn, subn);
        const bool first = (j == j0s[ci]) && (sub == 0);
        if (first) {
#pragma unroll
            for (int hf = 0; hf < 2; ++hf) {
#pragma unroll
                for (int sI = 0; sI < 4; ++sI) qf[hf][sI] = __builtin_nontemporal_load((const bf16x8*)(Q + (size_t)(tok0s[ci] + 32 * hf + r32) * 512 + h * 64 + 16 * sI + 8 * hi));
#pragma unroll
                for (int r = 0; r < 16; ++r) { oA[hf][r] = 0.f; oB[hf][r] = 0.f; }
                m[hf] = -1e30f; l[hf] = 0.f; }
        }
        asm volatile("" ::: "memory");
        AT_DMA(wb + ((t + 1) & 1) * AT_BUF, (size_t)(tok0s[cin] + (jn - NLEFT) * CHUNK + 32 * subn) * 512);
        asm volatile("s_waitcnt vmcnt(8)" ::: "memory");
        const LAS unsigned char* buf = wb + (t & 1) * AT_BUF;
        bf16x8 kf[4];
#pragma unroll
        for (int sI = 0; sI < 4; ++sI) kf[sI] = *(const LAS bf16x8*)(buf + ko[sI]);
        f32x16 p[2];
#pragma unroll
        for (int hf = 0; hf < 2; ++hf) { const float negm = first ? 0.f : -m[hf];
#pragma unroll
            for (int r = 0; r < 16; ++r) p[hf][r] = negm; }
#pragma unroll
        for (int sI = 0; sI < 4; ++sI) { p[0] = __builtin_amdgcn_mfma_f32_32x32x16_bf16(kf[sI], qf[0][sI], p[0], 0, 0, 0); p[1] = __builtin_amdgcn_mfma_f32_32x32x16_bf16(kf[sI], qf[1][sI], p[1], 0, 0, 0); }
        bf16x8 pb[2][2];
#pragma unroll
        for (int hf = 0; hf < 2; ++hf) {
            if (j >= 6) {
                const int base = 640 + (32 * hf + r32) - 64 * j - 32 * sub - 4 * hi;
#pragma unroll
                for (int r = 0; r < 16; ++r) { int i0 = base - ((r & 3) + 8 * (r >> 2)); i0 = i0 > 256 ? 256 : i0; p[hf][r] += bt[i0]; }
            }
            float tm = p[hf][0];
#pragma unroll
            for (int r = 1; r < 16; ++r) tm = fmaxf(tm, p[hf][r]);
            { const auto rr = __builtin_amdgcn_permlane32_swap(__float_as_uint(tm), __float_as_uint(tm), false, false); tm = fmaxf(__uint_as_float(rr[0]), __uint_as_float(rr[1])); }
            if (first) { m[hf] = tm;
#pragma unroll
                for (int r = 0; r < 16; ++r) p[hf][r] -= tm;
            } else if (__any(tm > 0.f)) {
                const float dlt = fmaxf(tm, 0.f), alpha = __builtin_amdgcn_exp2f(-dlt); m[hf] += dlt; l[hf] *= alpha;
#pragma unroll
                for (int r = 0; r < 16; ++r) { p[hf][r] -= dlt; oA[hf][r] *= alpha; oB[hf][r] *= alpha; }
            }
            float ps = 0.f;
#pragma unroll
            for (int r = 0; r < 16; ++r) { p[hf][r] = __builtin_amdgcn_exp2f(p[hf][r]); ps += p[hf][r]; }
            l[hf] += ps;
#pragma unroll
            for (int sI = 0; sI < 2; ++sI) { u32x4 w; w.x = cvtpk(p[hf][8 * sI], p[hf][8 * sI + 1]); w.y = cvtpk(p[hf][8 * sI + 2], p[hf][8 * sI + 3]); w.z = cvtpk(p[hf][8 * sI + 4], p[hf][8 * sI + 5]); w.w = cvtpk(p[hf][8 * sI + 6], p[hf][8 * sI + 7]);
                pb[hf][sI] = __builtin_bit_cast(bf16x8, w); }
        }
#pragma unroll
        for (int sI = 0; sI < 2; ++sI) {
            const int kof = 16 * sI * 128;
            const s16x4 l0 = vtr(buf + vr0 + kof), h0 = vtr(buf + vr0 + kof + 1024), l1 = vtr(buf + vr1 + kof), h1 = vtr(buf + vr1 + kof + 1024);
            const bf16x8 A0 = {l0[0], l0[1], l0[2], l0[3], h0[0], h0[1], h0[2], h0[3]}, A1 = {l1[0], l1[1], l1[2], l1[3], h1[0], h1[1], h1[2], h1[3]};
#pragma unroll
            for (int hf = 0; hf < 2; ++hf) { oA[hf] = __builtin_amdgcn_mfma_f32_32x32x16_bf16(A0, pb[hf][sI], oA[hf], 0, 0, 0); oB[hf] = __builtin_amdgcn_mfma_f32_32x32x16_bf16(A1, pb[hf][sI], oB[hf], 0, 0, 0); }
        }
        if (j == 8 && sub == 1) {
#pragma unroll
            for (int hf = 0; hf < 2; ++hf) {
                float lt = l[hf]; { const auto rr = __builtin_amdgcn_permlane32_swap(__float_as_uint(lt), __float_as_uint(lt), false, false); lt = __uint_as_float(rr[0]) + __uint_as_float(rr[1]); }
                const float inv = __builtin_amdgcn_rcpf(lt);
                bf16* op = YAB + (size_t)(tok0s[ci] + 32 * hf + r32) * 1024 + h * 64;
                u32x2 q0[4], q1[4];
#pragma unroll
                for (int gg = 0; gg < 4; ++gg) {
                    q0[gg].x = cvtpk(oA[hf][4 * gg] * inv, oA[hf][4 * gg + 1] * inv); q0[gg].y = cvtpk(oA[hf][4 * gg + 2] * inv, oA[hf][4 * gg + 3] * inv);
                    q1[gg].x = cvtpk(oB[hf][4 * gg] * inv, oB[hf][4 * gg + 1] * inv); q1[gg].y = cvtpk(oB[hf][4 * gg + 2] * inv, oB[hf][4 * gg + 3] * inv); }
                store_row32(op, q0[0], q0[1], q0[2], q0[3], hi); store_row32(op + 32, q1[0], q1[1], q1[2], q1[3], hi);
            }
        }
    }
    asm volatile("s_waitcnt vmcnt(0)" ::: "memory");
#undef AT_DECODE
#undef AT_DMA
}
__device__ __forceinline__ void phaseD(const Frame& F, const Args& a) {
    for (int unit = F.vcu; unit < NB * (SEQ / SGB); unit += F.G) sgu_unit(F, a, unit / (SEQ / SGB), unit % (SEQ / SGB));
    for (int i = F.tid; i < NHEAD * NREL; i += NWAVES * 64) { const int h = i / NREL, k = i % NREL; ((LAS float*)(F.lds + AT_BT + h * 1088))[k] = (a.in[7][i] - a.in[7][h * NREL + 256]) * LOG2E; }
    __syncthreads();
    const int NCH = NB * (SEQ / CHUNK);
    for (int v = F.vcu; v < NCH / 2; v += F.G) attn_chunks(F, a, v, NCH - 1 - v);
    __syncthreads();
}

constexpr int G_HT_STRIDE = 2064;
__device__ __forceinline__ void phaseG(const Frame& F, const Args& a) {
    const float* x = a.in[0]; const bf16* Y1 = (const bf16*)(a.ws + WS_Y1); const float* mod = (const float*)(a.ws + WS_MOD); const float* g_post_mix = a.in[5]; const float* g_pre_ffn = a.in[17];
    const float* b_router = a.in[20]; bf16* X1b = (bf16*)(a.ws + WS_X1B); unsigned char* XN8 = a.ws + WS_XN;
    const bf16* wrt = (const bf16*)(a.ws + WS_WRT);
    float* topg = (float*)(a.ws + WS_TOPG); int* list = (int*)(a.ws + WS_LIST); unsigned* cnt = F.ctl + CW_CNT;
    LAS unsigned char* HT = F.lds;
    LAS float* PL = (LAS float*)(F.lds + 33792);
    LAS float* LG = PL + 8 * 16 * 32;
    LAS float* TV = LG + 512;
    LAS unsigned* LC = (LAS unsigned*)(TV + 64);
    LAS unsigned* AS = LC + 64;
    const int tid = F.tid, lane = F.lane, wave = F.wave, kq = lane >> 4, i16 = lane & 15;
    if (tid < 64) LC[tid] = 0u;
    bf16x8 whi[2][4], wlo[2][4];
#pragma unroll
    for (int et = 0; et < 2; ++et)
#pragma unroll
        for (int ks = 0; ks < 4; ++ks) { const size_t o = (size_t)(et * 16 + i16) * D + 128 * wave + 32 * ks + 8 * kq; whi[et][ks] = *(const bf16x8*)(wrt + o); wlo[et][ks] = *(const bf16x8*)(wrt + (size_t)NEXP * D + o); }
    const int myrow = tid >> 5, mye = lane & 31;
    const float mybias = b_router[mye];
    __syncthreads();
    const int NT = NTOK / 16;
    f32x4 xv[2][4]; u32x2 yr[2][4];
    {   const int rbase = 16 * F.vcu + 2 * wave;
#pragma unroll
        for (int rr = 0; rr < 2; ++rr)
#pragma unroll
            for (int j = 0; j < 4; ++j) { const int c0 = (lane + 64 * j) * 4; xv[rr][j] = __builtin_nontemporal_load((const f32x4*)(x + (size_t)(rbase + rr) * D + c0)); yr[rr][j] = __builtin_nontemporal_load((const u32x2*)(Y1 + (size_t)(rbase + rr) * D + c0)); } }
    int tl = 0;
    f32x4 cgp[4], cgf[4], cgt[4], csc[4], csh[4]; int cb = -1;
#pragma unroll
    for (int j = 0; j < 4; ++j) { const int c0 = (lane + 64 * j) * 4; cgp[j] = *(const f32x4*)(g_post_mix + c0); cgf[j] = *(const f32x4*)(g_pre_ffn + c0); }
#pragma unroll 1
    for (int T = F.vcu; T < NT; T += F.G, ++tl) {
        const int b = (16 * T) / SEQ; const float* mb = mod + b * 6144; const int rbase = 16 * T + 2 * wave;
        if (b != cb) { cb = b;
#pragma unroll
            for (int j = 0; j < 4; ++j) { const int c0 = (lane + 64 * j) * 4; cgt[j] = *(const f32x4*)(mb + GT1 + c0); csc[j] = *(const f32x4*)(mb + SC2 + c0) + 1.0f; csh[j] = *(const f32x4*)(mb + SH2 + c0); } }
#pragma unroll
        for (int rr = 0; rr < 2; ++rr) {
            const int row = rbase + rr; f32x4 yv[4]; float ss = 0.f;
#pragma unroll
            for (int j = 0; j < 4; ++j) { yv[j] = (f32x4){bflo(yr[rr][j].x), bfhi(yr[rr][j].x), bflo(yr[rr][j].y), bfhi(yr[rr][j].y)}; ss += (yv[j][0] * yv[j][0] + yv[j][1] * yv[j][1]) + (yv[j][2] * yv[j][2] + yv[j][3] * yv[j][3]); }
            const float rstd = rsqrtf(wsum(ss) * (1.0f / D) + EPS); float s2 = 0.f;
#pragma unroll
            for (int j = 0; j < 4; ++j) { const int c0 = (lane + 64 * j) * 4;
                xv[rr][j] = xv[rr][j] + cgt[j] * (yv[j] * rstd * cgp[j]);
                { u32x2 w1; w1.x = cvtpk(xv[rr][j][0], xv[rr][j][1]); w1.y = cvtpk(xv[rr][j][2], xv[rr][j][3]); __builtin_nontemporal_store(w1, (u32x2*)(X1b + (size_t)row * D + c0)); }
                s2 += (xv[rr][j][0] * xv[rr][j][0] + xv[rr][j][1] * xv[rr][j][1]) + (xv[rr][j][2] * xv[rr][j][2] + xv[rr][j][3] * xv[rr][j][3]); }
            const float rstd2 = rsqrtf(wsum(s2) * (1.0f / D) + EPS);
#pragma unroll
            for (int j = 0; j < 4; ++j) { const int c0 = (lane + 64 * j) * 4;
                const f32x4 h = xv[rr][j] * rstd2 * cgf[j] * csc[j] + csh[j];
                u32x2 w; w.x = cvtpk(h[0], h[1]); w.y = cvtpk(h[2], h[3]); *(unsigned*)(XN8 + (size_t)row * D + c0) = pk_fp8x4(h[0] * F8_ASCALE, h[1] * F8_ASCALE, h[2] * F8_ASCALE, h[3] * F8_ASCALE);
                *(LAS u32x2*)(HT + (2 * wave + rr) * G_HT_STRIDE + c0 * 2) = w; }
        }
        {
            const int Tn = (T + F.G < NT) ? T + F.G : T; const int rb2 = 16 * Tn + 2 * wave;
#pragma unroll
            for (int rr = 0; rr < 2; ++rr)
#pragma unroll
                for (int j = 0; j < 4; ++j) { const int c0 = (lane + 64 * j) * 4; xv[rr][j] = __builtin_nontemporal_load((const f32x4*)(x + (size_t)(rb2 + rr) * D + c0)); yr[rr][j] = __builtin_nontemporal_load((const u32x2*)(Y1 + (size_t)(rb2 + rr) * D + c0)); }
        }
        LDS_WAIT(); __builtin_amdgcn_s_barrier(); asm volatile("" ::: "memory");
        {
            f32x4 acc0 = {0.f, 0.f, 0.f, 0.f}, acc1 = {0.f, 0.f, 0.f, 0.f};
#pragma unroll
            for (int ks = 0; ks < 4; ++ks) { const bf16x8 hb = *(const LAS bf16x8*)(HT + i16 * G_HT_STRIDE + (128 * wave + 32 * ks + 8 * kq) * 2);
                acc0 = __builtin_amdgcn_mfma_f32_16x16x32_bf16(whi[0][ks], hb, acc0, 0, 0, 0); acc0 = __builtin_amdgcn_mfma_f32_16x16x32_bf16(wlo[0][ks], hb, acc0, 0, 0, 0);
                acc1 = __builtin_amdgcn_mfma_f32_16x16x32_bf16(whi[1][ks], hb, acc1, 0, 0, 0); acc1 = __builtin_amdgcn_mfma_f32_16x16x32_bf16(wlo[1][ks], hb, acc1, 0, 0, 0); }
            *(LAS f32x4*)(PL + (wave * 16 + i16) * 32 + 4 * kq) = acc0; *(LAS f32x4*)(PL + (wave * 16 + i16) * 32 + 16 + 4 * kq) = acc1;
        }
        LDS_WAIT(); __builtin_amdgcn_s_barrier(); asm volatile("" ::: "memory");
        float lg = mybias;
#pragma unroll
        for (int w = 0; w < 8; ++w) lg += PL[(w * 16 + myrow) * 32 + mye];
        LG[myrow * 32 + mye] = lg;
        LDS_WAIT(); asm volatile("" ::: "memory");
        int rank = 0;
#pragma unroll
        for (int q = 0; q < 8; ++q) { const f32x4 o = *(const LAS f32x4*)(LG + myrow * 32 + 4 * q);
#pragma unroll
            for (int i = 0; i < 4; ++i) { const int e2 = 4 * q + i; rank += (o[i] > lg || (o[i] == lg && e2 < mye)) ? 1 : 0; } }
        if (rank < 4) TV[myrow * 4 + rank] = lg;
        LDS_WAIT(); asm volatile("" ::: "memory");
        const f32x4 tv = *(const LAS f32x4*)(TV + myrow * 4);
        if (rank < 4) {
            const float den = 1.0f + __expf(tv[1] - tv[0]) + __expf(tv[2] - tv[0]) + __expf(tv[3] - tv[0]);
            const int slot = (16 * T + myrow) * 4 + rank; topg[slot] = __expf(lg - tv[0]) / den;
            const unsigned lp = __hip_atomic_fetch_add(LC + mye, 1u, __ATOMIC_RELAXED, __HIP_MEMORY_SCOPE_WORKGROUP);
            if (tl < 16) AS[tl * 64 + myrow * 4 + rank] = (unsigned)mye | (lp << 8);
        }
    }
    __syncthreads();
    if (tid < NEXP) LC[32 + tid] = atomicAdd(&cnt[tid], LC[tid]);
    __syncthreads();
    for (int i = tid; i < tl * 64; i += NWAVES * 64) { const unsigned as = AS[i]; const int e = as & 255, lp = as >> 8; const int T = F.vcu + (i >> 6) * F.G;
        list[(size_t)e * NTOK + LC[32 + e] + lp] = (16 * T + ((i & 63) >> 2)) * 4 + (i & 3); }
}
__device__ __forceinline__ int moe_tables(const Frame& F) {
    __syncthreads();
    if (F.tid < NEXP) F.MISC[40 + F.tid] = __hip_atomic_load(F.ctl + CW_CNT + F.tid, __ATOMIC_RELAXED, __HIP_MEMORY_SCOPE_AGENT);
    __syncthreads();
    if (F.tid == 0) { unsigned s = 0; for (int e = 0; e < NEXP; ++e) { F.MISC[e] = s; s += (F.MISC[40 + e] + 255u) >> 8; } F.MISC[32] = s; }
    __syncthreads();
    return (int)F.MISC[32];
}
__device__ __forceinline__ void phaseJ(const Frame& F, const Args& a) {
    const unsigned char* Y2s = a.ws + WS_Y2; const bf16* X1b = (const bf16*)(a.ws + WS_X1B); const float* mod = (const float*)(a.ws + WS_MOD); const float* gpf = a.in[18]; float* out = a.out;
    const int* inv = (const int*)(a.ws + WS_TOPE); const float* topg = (const float*)(a.ws + WS_TOPG);
    const int lane = F.lane, gw = F.vcu * NWAVES + F.wave, NGW = F.G * NWAVES;
    f32x4 cgg[4]; int cb = -1;
    for (int row0 = gw * 4; row0 < NTOK; row0 += NGW * 4) {
        const int b = row0 / SEQ; const float* mb = mod + b * 6144;
        if (b != cb) { cb = b;
#pragma unroll
            for (int j = 0; j < 4; ++j) { const int c0 = (lane + 64 * j) * 4; cgg[j] = *(const f32x4*)(gpf + c0) * *(const f32x4*)(mb + GT2 + c0); } }
        int pp[4][4]; float gg[4][4];
#pragma unroll
        for (int rr = 0; rr < 4; ++rr)
#pragma unroll
            for (int k = 0; k < 4; ++k) { pp[rr][k] = __builtin_amdgcn_readfirstlane(inv[(row0 + rr) * 4 + k]); gg[rr][k] = topg[(row0 + rr) * 4 + k] * (1.0f / F8_YSCALE); }
        unsigned yy[4][4][4]; u32x2 xx[4][4];
#pragma unroll
        for (int rr = 0; rr < 4; ++rr)
#pragma unroll
            for (int j = 0; j < 4; ++j) { const int c0 = (lane + 64 * j) * 4;
#pragma unroll
                for (int k = 0; k < 4; ++k) yy[rr][j][k] = __builtin_nontemporal_load((const unsigned*)(Y2s + (size_t)pp[rr][k] * D + c0));
                xx[rr][j] = __builtin_nontemporal_load((const u32x2*)(X1b + (size_t)(row0 + rr) * D + c0)); }
#pragma unroll
        for (int rr = 0; rr < 4; ++rr) {
            f32x4 yv[4]; float ss = 0.f;
#pragma unroll
            for (int j = 0; j < 4; ++j) { f32x4 s = {0.f, 0.f, 0.f, 0.f};
#pragma unroll
                for (int k = 0; k < 4; ++k) { const f32x2 lo = __builtin_amdgcn_cvt_pk_f32_fp8((int)yy[rr][j][k], false), hi = __builtin_amdgcn_cvt_pk_f32_fp8((int)yy[rr][j][k], true);
                    s += (f32x4){lo.x, lo.y, hi.x, hi.y} * gg[rr][k]; }
                yv[j] = s; ss += (s[0] * s[0] + s[1] * s[1]) + (s[2] * s[2] + s[3] * s[3]); }
            const float rstd = rsqrtf(wsum(ss) * (1.0f / D) + EPS);
#pragma unroll
            for (int j = 0; j < 4; ++j) { const int c0 = (lane + 64 * j) * 4;
                const f32x4 x1 = {bflo(xx[rr][j].x), bfhi(xx[rr][j].x), bflo(xx[rr][j].y), bfhi(xx[rr][j].y)};
                __builtin_nontemporal_store(x1 + cgg[j] * (yv[j] * rstd), (f32x4*)(out + (size_t)(row0 + rr) * D + c0)); }
        }
    }
}

constexpr int N_PHASES = 10;
__global__ void __launch_bounds__(NWAVES * 64, 2) mega_fwd(Args args) {
    extern __shared__ __attribute__((aligned(16))) unsigned char lds_raw[];
    Frame F;
    F.lds = (LAS unsigned char*)lds_raw; F.MISC = (volatile LAS unsigned*)(F.lds + MISC_OFF);
    F.tid = threadIdx.x; F.lane = F.tid & 63; F.wave = __builtin_amdgcn_readfirstlane(F.tid >> 6);
    F.G = gridDim.x; { const int bx = blockIdx.x; F.vcu = (F.G % 8 == 0) ? (bx % 8) * (F.G / 8) + bx / 8 : bx; }
    F.ctl = (unsigned*)(args.ws + WS_CTL);
    for (int u = F.tid; u < 128; u += NWAVES * 64) F.MISC[u] = 0u;
    __syncthreads();
    const int lo = args.ph_lo, hi = args.ph_hi;
    XcdBarrier bar; bar.bar = F.ctl + CW_BAR; bar.x = 0; bar.st = F.MISC + 80;
    if (hi - lo > 1) bar = xcd_barrier_post(F.ctl + CW_BAR, F.MISC + 80);
#define IN(k) (lo <= (k) && (k) < hi)
#define SEAM(k) do { if (IN(k) && IN((k) + 1)) xcd_barrier(bar); } while (0)
    unsigned char* ws = args.ws;
    bf16 *XN = (bf16*)(ws + WS_XN), *Qb = (bf16*)(ws + WS_Q), *Kb = (bf16*)(ws + WS_K), *Vb = (bf16*)(ws + WS_V), *Ub = (bf16*)(ws + WS_U), *VG = (bf16*)(ws + WS_VG);
    bf16 *GT = (bf16*)(ws + WS_GT), *YAB = (bf16*)(ws + WS_YAB), *MRG = (bf16*)(ws + WS_MRG), *Y1 = (bf16*)(ws + WS_Y1), *ACT = (bf16*)(ws + WS_ACT), *Y2 = (bf16*)(ws + WS_Y2);

    if (IN(0)) { phaseA(F, args); } SEAM(0);
    if (IN(1)) { phaseB(F, args); } SEAM(1);
    if (IN(2)) {
        SchedStatic S{(const char*)XN, (const char*)(ws + WS_W1T), NTOK / 256, 4608 / 256, F.G, (int)blockIdx.x, (size_t)256 * 1024 * 2, (size_t)256 * 1024 * 2};
        EpiG1 E{Qb, Kb, Vb, Ub, VG, GT, args.in[15]};
        pg8::gemm_phase<EpiG1, SchedStatic, false>(F.lds + RING_OFF, S, E, 2048, 2048, 16);
    } SEAM(2);
    if (IN(3)) { phaseD(F, args); } SEAM(3);
    if (IN(4)) {
        SchedSplit2 S{(const char*)YAB, (const char*)(ws + WS_WBRT), NTOK / 256, 4, F.G, (int)blockIdx.x, (size_t)256 * 1024 * 2, (size_t)256 * 1024 * 2, (size_t)512 * 2};
        EpiG2 E{GT, MRG};
        pg8::gemm_phase<EpiG2, SchedSplit2, false>(F.lds + RING_OFF, S, E, 2048, 2048, 8);
    } SEAM(4);
    if (IN(5)) {
        SchedStatic S{(const char*)MRG, (const char*)(ws + WS_WOUTT), NTOK / 256, 4, F.G, (int)blockIdx.x, (size_t)256 * 1024 * 2, (size_t)256 * 1024 * 2};
        EpiPlain E{Y1};
        pg8::gemm_phase<EpiPlain, SchedStatic, false>(F.lds + RING_OFF, S, E, 2048, 2048, 16);
    } SEAM(5);
    if (IN(6)) { phaseG(F, args); } SEAM(6);
    if (IN(7)) {
        const int nrb = moe_tables(F);
        const int* list = (const int*)(ws + WS_LIST);
        {
            int* inv = (int*)(ws + WS_TOPE);
            for (int g = (int)blockIdx.x * (NWAVES * 64) + F.tid; g < NTOK * TOPK; g += F.G * NWAVES * 64) {
                int e = 0, base = 0;
#pragma unroll 1
                for (int i = 0; i < NEXP; ++i) { const int c = (int)F.MISC[40 + i]; if (g >= base + c) { base += c; e = i + 1; } else break; }
                const int pos = g - base; if (e < NEXP) inv[list[(size_t)e * NTOK + pos]] = (int)F.MISC[e] * 256 + pos; }
        }
        typedef SchedMoe<8, true> SM;
        SM S{(const char*)XN, (const char*)(ws + WS_WGUT), F.MISC, (const LAS unsigned*)(F.lds + GTAB_OFF), (int)blockIdx.x, F.G, nrb, (size_t)2048 * 1024, (size_t)256 * 1024};
        S.build(F.tid);
        { Unit u; LAS unsigned* gt = (LAS unsigned*)(F.lds + GTAB_OFF);
          for (int k = 0; k < GTAB_UNITS && S.next(k, u); ++k) { const int e = u.aux, j256 = (u.pm - (int)F.MISC[e]) * 256, ecnt = (int)F.MISC[40 + e];
              for (int r = F.tid; r < 256; r += NWAVES * 64) { const int pos = j256 + r; int tok = 0; if (pos < ecnt) tok = list[(size_t)e * NTOK + pos] >> 2; gt[k * 256 + r] = (unsigned)tok * 1024u; } } }
        __syncthreads();
        EpiAct E{args.in[22], (unsigned char*)ACT};
        pg8::gemm_phase<EpiAct, SM, true>(F.lds + RING_OFF, S, E, 1024, 1024, 8);
    } SEAM(7);
    if (IN(8)) {
        const int nrb = moe_tables(F);
        typedef SchedMoe<4, true> SM;
        SM S{(const char*)ACT, (const char*)(ws + WS_WDNT), F.MISC, (const LAS unsigned*)(F.lds + GTAB_OFF), (int)blockIdx.x, F.G, nrb, (size_t)1024 * 1024, (size_t)256 * 1024};
        S.build(F.tid);
        { Unit u; LAS unsigned* gt = (LAS unsigned*)(F.lds + GTAB_OFF);
          for (int k = 0; k < GTAB_UNITS && S.next(k, u); ++k) for (int r = F.tid; r < 256; r += NWAVES * 64) gt[k * 256 + r] = (unsigned)(u.pm * 256 + r) * 1024u; }
        __syncthreads();
        EpiDown E{args.in[24], (unsigned char*)Y2};
        pg8::gemm_phase<EpiDown, SM, true>(F.lds + RING_OFF, S, E, 1024, 1024, 8);
    } SEAM(8);
    if (IN(9)) { phaseJ(F, args); }
#undef IN
#undef SEAM
}
extern "C" void kernel_launch(void* const* d_in, const int* in_sizes, int n_in, void* d_out, int out_size, void* d_ws, size_t ws_size, hipStream_t stream) {
    if (n_in != 25 || in_sizes[0] != NTOK * D || out_size != NTOK * D || ws_size < WS_END) { fprintf(stderr, "kernel_launch: unexpected shapes (n_in %d in0 %d out %d ws %zu)\n", n_in, n_in > 0 ? in_sizes[0] : -1, out_size, ws_size); return; }
    static int grid = 0;
    if (grid == 0) {
        int dev = 0, cus = 0, per_cu = 0;
        if (hipGetDevice(&dev) != hipSuccess || hipDeviceGetAttribute(&cus, hipDeviceAttributeMultiprocessorCount, dev) != hipSuccess) { fprintf(stderr, "kernel_launch: device query failed\n"); grid = -1; return; }
        if (hipFuncSetAttribute((const void*)mega_fwd, hipFuncAttributeMaxDynamicSharedMemorySize, LDS_BYTES) != hipSuccess) { fprintf(stderr, "kernel_launch: hipFuncSetAttribute failed\n"); grid = -1; return; }
        if (hipOccupancyMaxActiveBlocksPerMultiprocessor(&per_cu, (const void*)mega_fwd, NWAVES * 64, LDS_BYTES) != hipSuccess || per_cu < 1) { fprintf(stderr, "kernel_launch: occupancy query says %d\n", per_cu); }
        (void)hipGetLastError();
        grid = cus;
    }
    if (grid < 0) return;
    if (hipMemsetAsync((unsigned char*)d_ws + WS_CTL, 0, CTL_ZERO_BYTES, stream) != hipSuccess) { fprintf(stderr, "kernel_launch: memset failed\n"); return; }
    Args a{};
    for (int i = 0; i < 25; ++i) a.in[i] = (const float*)d_in[i];
    a.out = (float*)d_out; a.ws = (unsigned char*)d_ws; a.ph_lo = 0; a.ph_hi = N_PHASES;
    hipLaunchKernelGGL(mega_fwd, dim3(grid), dim3(NWAVES * 64), LDS_BYTES, stream, a);
    if (hipPeekAtLastError() != hipSuccess) fprintf(stderr, "kernel_launch: launch failed\n");
}
```

```cpp
#include <hip/hip_runtime.h>
#include <cstdio>
#include <cstdint>

constexpr int NB = 4, SEQ = 8192, D = 1024, NTOK = NB * SEQ;
constexpr int NHEAD = 8, CHUNK = 64, NLEFT = 8, NREL = 257;
constexpr int SGB = 128;
constexpr int INW = 2560, NEXP = 32, TOPK = 4;
constexpr float EPS = 1e-6f, SWL = 7.0f, SWA = 1.702f;
constexpr float LOG2E = 1.4426950408889634f;
constexpr float QSCALE = 0.125f * LOG2E;
constexpr int SH1 = 0, SC1 = 1024, GT1 = 2048, SH2 = 3072, SC2 = 4096, GT2 = 5120;
typedef unsigned short bf16;

constexpr size_t MiB = 1u << 20;
constexpr size_t WS_CTL = 0, CTL_ZERO_BYTES = 64 * 1024;
constexpr size_t WS_MOD = 1 * MiB;
constexpr size_t WS_W1T = 2 * MiB, WS_WBRT = 12 * MiB, WS_WOUTT = 14 * MiB, WS_WRT = 16 * MiB;
constexpr size_t WS_TOPE = 17 * MiB, WS_TOPG = 18 * MiB, WS_LIST = 19 * MiB;
constexpr size_t WS_WGUT = 32 * MiB, WS_WDNT = 160 * MiB;
constexpr size_t WS_XN = 224 * MiB;
constexpr size_t WS_Q = 288 * MiB, WS_K = 320 * MiB, WS_V = 352 * MiB, WS_U = 384 * MiB, WS_VG = 416 * MiB;
constexpr size_t WS_GT = 448 * MiB;
constexpr size_t WS_YAB = 576 * MiB, WS_MRG = 640 * MiB, WS_Y1 = 704 * MiB;
constexpr size_t WS_ACT = 288 * MiB;
constexpr size_t WS_Y2 = 576 * MiB;
constexpr size_t WS_WG8 = 24 * MiB;
constexpr size_t WS_XN8A = 832 * MiB;
constexpr size_t WS_END = 960 * MiB;
constexpr int CW_CNT = 1024;

#define LAS __attribute__((address_space(3)))
#define GAS __attribute__((address_space(1)))
typedef short bf16x8 __attribute__((ext_vector_type(8)));
typedef short s16x4 __attribute__((ext_vector_type(4)));
typedef float f32x4 __attribute__((ext_vector_type(4)));
typedef float f32x2 __attribute__((ext_vector_type(2)));
typedef float f32x16 __attribute__((ext_vector_type(16)));
typedef unsigned u32x4 __attribute__((ext_vector_type(4)));
typedef unsigned u32x2 __attribute__((ext_vector_type(2)));
typedef __bf16 bf16x2_t __attribute__((ext_vector_type(2)));
constexpr int NWAVES = 8;
constexpr int TRASH_SLOT = NTOK * 4;

__device__ __forceinline__ unsigned cvtpk(float lo, float hi) { f32x2 v = {lo, hi}; bf16x2_t b = __builtin_convertvector(v, bf16x2_t); return __builtin_bit_cast(unsigned, b); }
__device__ __forceinline__ float wsum(float v) {
    v += __builtin_bit_cast(float, __builtin_amdgcn_update_dpp(0, __builtin_bit_cast(int, v), 0xB1, 0xF, 0xF, true));
    v += __builtin_bit_cast(float, __builtin_amdgcn_update_dpp(0, __builtin_bit_cast(int, v), 0x4E, 0xF, 0xF, true));
    v += __builtin_bit_cast(float, __builtin_amdgcn_update_dpp(0, __builtin_bit_cast(int, v), 0x124, 0xF, 0xF, true));
    v += __builtin_bit_cast(float, __builtin_amdgcn_update_dpp(0, __builtin_bit_cast(int, v), 0x128, 0xF, 0xF, true));
    const int iv = __builtin_bit_cast(int, v);
    const float s0 = __builtin_bit_cast(float, __builtin_amdgcn_readlane(iv, 0)), s1 = __builtin_bit_cast(float, __builtin_amdgcn_readlane(iv, 16));
    const float s2 = __builtin_bit_cast(float, __builtin_amdgcn_readlane(iv, 32)), s3 = __builtin_bit_cast(float, __builtin_amdgcn_readlane(iv, 48));
    return (s0 + s1) + (s2 + s3);
}
__device__ __forceinline__ float clamp8(float v) { return fminf(fmaxf(v, -448.0f), 448.0f); }
__device__ __forceinline__ unsigned pk_fp8x4(float a, float b, float c, float d) {
    int w = 0; w = __builtin_amdgcn_cvt_pk_fp8_f32(clamp8(a), clamp8(b), w, false); w = __builtin_amdgcn_cvt_pk_fp8_f32(clamp8(c), clamp8(d), w, true); return (unsigned)w; }
__device__ __forceinline__ unsigned pk_fp8x4_nc(float a, float b, float c, float d) {
    int w = 0; w = __builtin_amdgcn_cvt_pk_fp8_f32(a, b, w, false); w = __builtin_amdgcn_cvt_pk_fp8_f32(c, d, w, true); return (unsigned)w; }
constexpr float F8_YSCALE = 16.0f;
constexpr size_t WS_X1B = 768 * MiB;
constexpr float F8_WSCALE = 64.0f, F8_ASCALE = 4.0f, F8_DESCALE = 1.0f / (64.0f * 4.0f);
__device__ __forceinline__ float bflo(unsigned w) { return __uint_as_float(w << 16); }
__device__ __forceinline__ float bfhi(unsigned w) { return __uint_as_float(w & 0xffff0000u); }
__device__ __forceinline__ float fast_sigmoid(float x) { return __builtin_amdgcn_rcpf(1.0f + __builtin_amdgcn_exp2f(-LOG2E * x)); }
__device__ __forceinline__ f32x2 sigmoid_pk(f32x2 v) { const f32x2 t = v * (-LOG2E); f32x2 e; e.x = __builtin_amdgcn_exp2f(t.x); e.y = __builtin_amdgcn_exp2f(t.y); const f32x2 d = e + 1.0f; f32x2 r; r.x = __builtin_amdgcn_rcpf(d.x); r.y = __builtin_amdgcn_rcpf(d.y); return r; }
__device__ __forceinline__ f32x2 gelu_pk(f32x2 v) {
    const f32x2 av = __builtin_elementwise_abs(v), d = av * 0.2316418882f + 1.0f;
    f32x2 t; t.x = __builtin_amdgcn_rcpf(d.x); t.y = __builtin_amdgcn_rcpf(d.y);
    f32x2 q = t * 0.5307027145f + (-0.7265760135f); q = q * t + 0.7107068705f; q = q * t + (-0.142248368f); q = q * t + 0.127414796f; q = q * t;
    const f32x2 s = (v * v) * (-0.72134752044f);
    f32x2 e; e.x = __builtin_amdgcn_exp2f(s.x); e.y = __builtin_amdgcn_exp2f(s.y);
    const f32x2 m = v * (q * e), r = v - m;
    f32x2 o; o.x = v.x < 0.f ? m.x : r.x; o.y = v.y < 0.f ? m.y : r.y; return o;
}

constexpr int RING_OFF = 0, RING_BYTES = 131072;
constexpr int GTAB_OFF = RING_BYTES, GTAB_UNITS = 20, GTAB_BYTES = GTAB_UNITS * 256 * 4;
constexpr int MISC_OFF = GTAB_OFF + GTAB_BYTES;
constexpr int LDS_BYTES = MISC_OFF + 512;
static_assert(LDS_BYTES <= 160 * 1024, "LDS map");

#define XB_TMO      128
#define XB_XCNT(j)  (256  + 64 * (j))
#define XB_XSUB(j)  (1280 + 64 * (j))
#define XB_XGEN(j)  (2304 + 64 * (j))
#define XB_TOP      3328
#define XB_TOPGEN   3392
#define XCD_BAR_WORDS 3456
#define XB_SPIN_CAP (1u << 18)
__device__ __forceinline__ unsigned xb_ld(unsigned* p)              { return __hip_atomic_load(p, __ATOMIC_RELAXED, __HIP_MEMORY_SCOPE_AGENT); }
__device__ __forceinline__ unsigned xb_add(unsigned* p, unsigned v) { return __hip_atomic_fetch_add(p, v, __ATOMIC_RELAXED, __HIP_MEMORY_SCOPE_AGENT); }
__device__ __forceinline__ unsigned xb_xcc_id() { return (unsigned)__builtin_amdgcn_s_getreg((3 << 11) | 20) & 0xFu; }
#define XB_SPIN(cond, bar) do { unsigned _sp = 0; while (cond) { __builtin_amdgcn_s_sleep(1); \
    if ((++_sp & 255u) == 0u) { if (xb_ld(&(bar)[XB_TMO])) break; if (_sp > XB_SPIN_CAP) { atomicAdd(&(bar)[XB_TMO], 1u); break; } } } } while (0)
struct XcdBarrier { unsigned* bar; unsigned x; volatile LAS unsigned* st; };
__device__ __forceinline__ XcdBarrier xcd_barrier_post(unsigned* bar, volatile LAS unsigned* st) {
    XcdBarrier b; b.bar = bar; b.x = xb_xcc_id(); b.st = st;
    if (threadIdx.x == 0) (void)xb_add(&bar[XB_XCNT(b.x)], 1u);
    return b;
}
__device__ __forceinline__ void xcd_barrier_complete(unsigned* bar, unsigned x, unsigned& nloc, unsigned& nx) {
    const unsigned G = gridDim.x * gridDim.y * gridDim.z;
    unsigned sum, cnt, mine, sp = 0u;
    for (;;) {
        sum = 0u; cnt = 0u; mine = 0u;
#pragma unroll
        for (unsigned j = 0; j < 16; ++j) { const unsigned c = xb_ld(&bar[XB_XCNT(j)]); sum += c; cnt += (c > 0u) ? 1u : 0u; mine = (j == x) ? c : mine; }
        if (sum == G) break;
        __builtin_amdgcn_s_sleep(1);
        if ((++sp & 255u) == 0u) { if (xb_ld(&bar[XB_TMO])) break; if (sp > XB_SPIN_CAP) { atomicAdd(&bar[XB_TMO], 1u); break; } }
    }
    nloc = mine > 0u ? mine : 1u; nx = cnt > 0u ? cnt : 1u;
}
__device__ __forceinline__ void xcd_barrier(const XcdBarrier& b) {
    asm volatile("s_waitcnt vmcnt(0)" ::: "memory");
    __syncthreads();
    if (threadIdx.x == 0) {
        unsigned* bar = b.bar;
        __builtin_amdgcn_s_waitcnt(0);
        unsigned nloc = b.st[0], nx = b.st[1];
        if (nloc == 0u) { xcd_barrier_complete(bar, b.x, nloc, nx); b.st[0] = nloc; b.st[1] = nx; }
        const unsigned old = xb_add(&bar[XB_XSUB(b.x)], 1u);
        const unsigned gen = old / nloc;
        if (old + 1u == (gen + 1u) * nloc) {
            __builtin_amdgcn_fence(__ATOMIC_RELEASE, "agent");
            asm volatile("s_waitcnt vmcnt(0)" ::: "memory");
            const unsigned og = xb_add(&bar[XB_TOP], 1u);
            const unsigned tg = og / nx;
            if (og + 1u == (tg + 1u) * nx) xb_add(&bar[XB_TOPGEN], 1u);
            else XB_SPIN(xb_ld(&bar[XB_TOPGEN]) == tg, bar);
            __builtin_amdgcn_fence(__ATOMIC_ACQUIRE, "agent");
            xb_add(&bar[XB_XGEN(b.x)], 1u);
            asm volatile("s_waitcnt vmcnt(0)" ::: "memory");
        } else {
            XB_SPIN(xb_ld(&bar[XB_XGEN(b.x)]) == gen, bar);
            __builtin_amdgcn_fence(__ATOMIC_ACQUIRE, "agent");
            asm volatile("s_waitcnt vmcnt(0)" ::: "memory");
        }
    }
    __syncthreads();
}
constexpr int CW_BAR = 4096;

namespace pg8 {
constexpr int BM = 256, BK = 64, HALF = 128, HTB = HALF * BK * 2, STAGE_BYTES = 8 * HTB, NXCD = 8, WGM = 8;
__host__ __device__ __forceinline__ int lds_byte(int r, int c) { return r * 128 + ((((c >> 3) ^ (r >> 1)) & 7) << 4); }
__host__ __device__ __forceinline__ void stage_rc(int b, int& R, int& C) { R = b >> 7; C = ((((b >> 4) ^ (R >> 1)) & 7) << 3); }
__host__ __device__ __forceinline__ int perm32(int rho) { const int n = rho >> 4, i = rho & 15; return 8 * (i >> 2) + 4 * n + (i & 3); }
struct Unit { int pm, pn, aux; };
typedef int v4i_t __attribute__((ext_vector_type(4)));
typedef int v8i_t __attribute__((ext_vector_type(8)));

__device__ __forceinline__ bool static_unit(int i, int G, int c, int nM, int nN, int& pm, int& pn) {
    const int nwg = nM * nN; const long L = (long)i * G + c; if (L >= nwg) return false;
    int wgid = (int)L; { const int q = nwg / NXCD, r = nwg % NXCD, xcd = wgid % NXCD, off = wgid / NXCD; wgid = (xcd < r ? xcd * (q + 1) : r * (q + 1) + (xcd - r) * q) + off; }
    const int nig = WGM * nN, gid = wgid / nig, fm = gid * WGM, gsz = (nM - fm) < WGM ? (nM - fm) : WGM;
    pm = fm + ((wgid % nig) % gsz); pn = (wgid % nig) / gsz; return true;
}

template <class Epi, class Sched, bool FP8>
__device__ __forceinline__ void gemm_phase(LAS unsigned char* lds, const Sched& S, const Epi& E, const int lda, const int ldb, const int nt) {
    const int tid = threadIdx.x, wid = __builtin_amdgcn_readfirstlane(tid >> 6), lane = tid & 63, wr = wid >> 2, wc = wid & 3, fr = lane & 15, fq = lane >> 4;
    int Rr[2], Cc[2]; unsigned voffB[2];
#pragma unroll
    for (int i = 0; i < 2; ++i) { stage_rc(tid * 16 + i * 8192, Rr[i], Cc[i]); const int Rb = (Rr[i] & ~31) + perm32(Rr[i] & 31); voffB[i] = (unsigned)(Rb * ldb + Cc[i] * 2); }
    const size_t kstep = (size_t)(BK * 2);
    const size_t hstepB = (size_t)HALF * ldb;
    const size_t hstepA = Sched::GATHER ? (size_t)0 : (size_t)HALF * lda;
    const unsigned ldsw = (unsigned)wid * 1024u;
    const int aoff = lds_byte(wr * 64 + fr, fq * 8), boff = lds_byte(wc * 32 + fr, fq * 8);
#define PG8_SA(b, h) (((b) * 2 + (h)) * HTB)
#define PG8_SB(b, h) ((4 + (b) * 2 + (h)) * HTB)
#define PG8_STAGE(bufoff, gbase, voff) do { _Pragma("unroll") for (int _i = 0; _i < 2; ++_i) \
        __builtin_amdgcn_global_load_lds((const unsigned*)((const char*)(gbase) + (voff)[_i]), (LAS unsigned*)(lds + (bufoff) + ldsw + _i * 8192), 16, 0, 0); } while (0)
#define PG8_LDA(dst, b, h) do { _Pragma("unroll") for (int m = 0; m < 4; ++m) _Pragma("unroll") for (int k = 0; k < 2; ++k) dst[m][k] = *(const LAS bf16x8*)(lds + PG8_SA(b, h) + (aoff ^ (k * 64)) + m * 2048); } while (0)
#define PG8_LDB(dst, b, h) do { _Pragma("unroll") for (int n = 0; n < 2; ++n) _Pragma("unroll") for (int k = 0; k < 2; ++k) dst[n][k] = *(const LAS bf16x8*)(lds + PG8_SB(b, h) + (boff ^ (k * 64)) + n * 2048); } while (0)
#define PG8_CAT(x) __builtin_shufflevector(__builtin_bit_cast(v4i_t, (x)[0]), __builtin_bit_cast(v4i_t, (x)[1]), 0, 1, 2, 3, 4, 5, 6, 7)
#define PG8_MMA(ai, bj, At, Bt) do { __builtin_amdgcn_s_setprio(1); if constexpr (FP8) { _Pragma("unroll") for (int m = 0; m < 4; ++m) _Pragma("unroll") for (int n = 0; n < 2; ++n) \
        acc[ai][bj][m][n] = __builtin_amdgcn_mfma_scale_f32_16x16x128_f8f6f4(PG8_CAT(Bt[n]), PG8_CAT(At[m]), acc[ai][bj][m][n], 0, 0, 0, 0, 0, 0); }   \
    else { _Pragma("unroll") for (int m = 0; m < 4; ++m) _Pragma("unroll") for (int n = 0; n < 2; ++n) _Pragma("unroll") for (int k = 0; k < 2; ++k) \
        acc[ai][bj][m][n] = __builtin_amdgcn_mfma_f32_16x16x32_bf16(Bt[n][k], At[m][k], acc[ai][bj][m][n], 0, 0, 0); } __builtin_amdgcn_s_setprio(0); } while (0)
#define PG8_WAIT_V(n) asm volatile("s_waitcnt vmcnt(" #n ")" ::: "memory")
#define PG8_WAIT_L(n) asm volatile("s_waitcnt lgkmcnt(" #n ")" ::: "memory")
#define PG8_BAR __builtin_amdgcn_s_barrier()
#define PG8_SCHED __builtin_amdgcn_sched_barrier(0)
    Unit cur, nxt; int ui = 0;
    if (!S.next(0, cur)) return;
    f32x4 acc[2][2][4][2];
#pragma unroll
    for (int a = 0; a < 2; ++a)
#pragma unroll
        for (int b = 0; b < 2; ++b)
#pragma unroll
            for (int m = 0; m < 4; ++m)
#pragma unroll
                for (int n = 0; n < 2; ++n) acc[a][b][m][n] = (f32x4){0.f, 0.f, 0.f, 0.f};
    bf16x8 At[4][2], B0[2][2], B1[2][2];
    unsigned oA[2][2];
#pragma unroll
    for (int h = 0; h < 2; ++h)
#pragma unroll
        for (int i = 0; i < 2; ++i) oA[h][i] = Sched::GATHER ? (S.goff(0, h * HALF + Rr[i]) + (unsigned)Cc[i] * 2u) : (unsigned)(Rr[i] * lda + Cc[i] * 2);
    const char* cA = S.aptr(cur); const char* cB = S.bptr(cur);
    PG8_STAGE(PG8_SB(0, 0), cB, voffB); PG8_STAGE(PG8_SB(0, 1), cB + hstepB, voffB); PG8_STAGE(PG8_SA(0, 0), cA, oA[0]); PG8_STAGE(PG8_SA(0, 1), cA + hstepA, oA[1]);
    if (wr == 1) PG8_BAR;
    PG8_WAIT_V(2); PG8_BAR;
    PG8_STAGE(PG8_SB(1, 0), cB + kstep, voffB); PG8_STAGE(PG8_SA(1, 0), cA + kstep, oA[0]); PG8_STAGE(PG8_SB(1, 1), cB + hstepB + kstep, voffB);
    PG8_WAIT_V(6); PG8_BAR;
    for (;;) {
        const bool has_next = S.next(ui + 1, nxt);
        const char* nA = has_next ? S.aptr(nxt) : cA; const char* nB = has_next ? S.bptr(nxt) : cB;
#pragma clang loop unroll(disable)
        for (int t = 0; t < nt; t += 2) {
            const bool last = (t == nt - 2);
            const char* a1 = cA + (size_t)(t + 1) * kstep;
            const char* a2 = last ? nA : cA + (size_t)(t + 2) * kstep; const char* b2 = last ? nB : cB + (size_t)(t + 2) * kstep;
            const char* a3 = a2 + kstep; const char* b3 = b2 + kstep;
            PG8_LDB(B0, 0, 0); PG8_LDB(B1, 0, 1); PG8_SCHED; PG8_LDA(At, 0, 0); PG8_STAGE(PG8_SA(1, 1), a1 + hstepA, oA[1]);
            if constexpr (Sched::GATHER) { if (last && has_next) {
#pragma unroll
                for (int h = 0; h < 2; ++h)
#pragma unroll
                    for (int i = 0; i < 2; ++i) oA[h][i] = S.goff(ui + 1, h * HALF + Rr[i]) + (unsigned)Cc[i] * 2u; } }
            PG8_WAIT_V(8); PG8_WAIT_L(0); PG8_BAR; PG8_MMA(0, 0, At, B0); PG8_MMA(0, 1, At, B1); PG8_BAR; PG8_SCHED;
            PG8_LDA(At, 0, 1); PG8_STAGE(PG8_SB(0, 0), b2, voffB); PG8_STAGE(PG8_SB(0, 1), b2 + hstepB, voffB); PG8_STAGE(PG8_SA(0, 0), a2, oA[0]);
            PG8_WAIT_V(8); PG8_WAIT_L(0); PG8_BAR; PG8_MMA(1, 0, At, B0); PG8_MMA(1, 1, At, B1); PG8_BAR; PG8_SCHED;
            PG8_LDB(B0, 1, 0); PG8_LDB(B1, 1, 1); PG8_SCHED; PG8_LDA(At, 1, 0); PG8_STAGE(PG8_SA(0, 1), a2 + hstepA, oA[1]);
            PG8_WAIT_V(8); PG8_WAIT_L(0); PG8_BAR; PG8_MMA(0, 0, At, B0); PG8_MMA(0, 1, At, B1); PG8_BAR; PG8_SCHED;
            PG8_LDA(At, 1, 1); PG8_STAGE(PG8_SB(1, 0), b3, voffB); PG8_STAGE(PG8_SB(1, 1), b3 + hstepB, voffB); PG8_STAGE(PG8_SA(1, 0), a3, oA[0]);
            PG8_WAIT_V(8); PG8_WAIT_L(0); PG8_BAR; PG8_MMA(1, 0, At, B0); PG8_MMA(1, 1, At, B1); PG8_BAR; PG8_SCHED;
        }
        if (wr == 0) PG8_BAR;
        bool keep = false;
        {
            int tz = threadIdx.x; asm volatile("" : "+v"(tz)); const int ewid = tz >> 6, el = tz & 63, ewr = ewid >> 2, ewc = ewid & 3, efr = el & 15, efq = el >> 4;
            if constexpr (Sched::HAS_MID) { if (S.is_mid(cur)) { E.mid(acc, cur, ewr, ewc, efr, efq); keep = true; } }
            if (!keep) E(acc, cur, ewr, ewc, efr, efq);
        }
        if (!has_next) break;
        if (!keep) {
#pragma unroll
            for (int a = 0; a < 2; ++a)
#pragma unroll
                for (int b = 0; b < 2; ++b)
#pragma unroll
                    for (int m = 0; m < 4; ++m)
#pragma unroll
                        for (int n = 0; n < 2; ++n) acc[a][b][m][n] = (f32x4){0.f, 0.f, 0.f, 0.f};
        }
        cur = nxt; cA = nA; cB = nB; ++ui;
        if (wr == 1) PG8_BAR;
    }
    PG8_WAIT_V(0);
    PG8_BAR;
#undef PG8_SA
#undef PG8_SB
#undef PG8_STAGE
#undef PG8_LDA
#undef PG8_LDB
#undef PG8_MMA
#undef PG8_CAT
#undef PG8_WAIT_V
#undef PG8_WAIT_L
#undef PG8_BAR
#undef PG8_SCHED
}
}
using pg8::Unit;

struct Args { const float* in[25]; float* out; unsigned char* ws; int ph_lo, ph_hi, pad0, pad1; };
static_assert(sizeof(Args) == 27 * 8 + 16, "Args has no padding");
struct Frame {
    LAS unsigned char* lds; volatile LAS unsigned* MISC; unsigned* ctl;
    int tid, lane, wave, vcu, G;
};
#define LDS_WAIT() asm volatile("s_waitcnt lgkmcnt(0)" ::: "memory")
#define VM_WAIT() asm volatile("s_waitcnt vmcnt(0)" ::: "memory")

struct SchedStatic {
    static constexpr bool GATHER = false, HAS_MID = false;
    const char* A; const char* B; int nM, nN, G, c; size_t astep, bstep;
    __device__ __forceinline__ bool next(int i, Unit& u) const { u.aux = 0; return pg8::static_unit(i, G, c, nM, nN, u.pm, u.pn); }
    __device__ __forceinline__ const char* aptr(const Unit& u) const { return A + (size_t)u.pm * astep; }
    __device__ __forceinline__ const char* bptr(const Unit& u) const { return B + (size_t)u.pn * bstep; }
    __device__ __forceinline__ bool is_mid(const Unit&) const { return false; }
    __device__ __forceinline__ unsigned goff(int, int) const { return 0u; }
};
struct SchedStaticG {
    static constexpr bool GATHER = true, HAS_MID = false;
    const char* A; const char* B; int nM, nN, G, c; size_t bstep; unsigned lda;
    __device__ __forceinline__ bool next(int i, Unit& u) const { u.aux = 0; return pg8::static_unit(i, G, c, nM, nN, u.pm, u.pn); }
    __device__ __forceinline__ const char* aptr(const Unit&) const { return A; }
    __device__ __forceinline__ const char* bptr(const Unit& u) const { return B + (size_t)u.pn * bstep; }
    __device__ __forceinline__ bool is_mid(const Unit&) const { return false; }
    __device__ __forceinline__ unsigned goff(int ui, int row) const { int pm = 0, pn = 0; pg8::static_unit(ui, G, c, nM, nN, pm, pn); return (unsigned)(pm * 256 + row) * lda; }
};
struct SchedSplit2 {
    static constexpr bool GATHER = false, HAS_MID = true;
    const char* A; const char* B; int nM, nN, G, c; size_t astep, bstep, khalf;
    __device__ __forceinline__ bool next(int i, Unit& u) const { u.aux = i & 1; return pg8::static_unit(i >> 1, G, c, nM, nN, u.pm, u.pn); }
    __device__ __forceinline__ const char* aptr(const Unit& u) const { return A + (size_t)u.pm * astep + (size_t)u.aux * khalf; }
    __device__ __forceinline__ const char* bptr(const Unit& u) const { return B + (size_t)u.pn * bstep + (size_t)u.aux * khalf; }
    __device__ __forceinline__ bool is_mid(const Unit& u) const { return u.aux == 0; }
    __device__ __forceinline__ unsigned goff(int, int) const { return 0u; }
};
__device__ __forceinline__ int moe_find_e(volatile LAS unsigned* MISC, int rb) { int e = 0;
#pragma unroll 1
    for (int i = 1; i < NEXP; ++i) e += ((int)MISC[i] <= rb) ? 1 : 0;
    return e; }
template <int NPN, bool GATH>
struct SchedMoe {
    static constexpr bool GATHER = GATH, HAS_MID = false;
    static constexpr int RPX = 32 / NPN;
    static constexpr int UT0 = 96, UTN = 24;
    const char* A; const char* B; volatile LAS unsigned* MISC; const LAS unsigned* gtab; int c, G, nrb; size_t bstep_e, bstep_n;
    __device__ __forceinline__ bool slow_next(int i, Unit& u) const {
        int rb, pn;
        if (G == 256) { const int x = c & 7, j = c >> 3; rb = (8 * i + x) * RPX + j / NPN; pn = j % NPN; }
        else { const long L = (long)i * G + c; rb = (int)(L / NPN); pn = (int)(L % NPN); }
        if (rb >= nrb) return false;
        u.pm = rb; u.pn = pn; u.aux = moe_find_e(MISC, rb); return true;
    }
    __device__ __forceinline__ void build(int tid) const {
        if (tid < UTN) { Unit u; const bool ok = slow_next(tid, u); MISC[UT0 + tid] = ok ? (0x80000000u | ((unsigned)u.aux << 16) | ((unsigned)u.pn << 12) | (unsigned)u.pm) : 0u; }
        __syncthreads();
    }
    __device__ __forceinline__ bool next(int i, Unit& u) const {
        if (i >= UTN) return false;
        const unsigned w = MISC[UT0 + i]; if (!(w >> 31)) return false;
        u.pm = (int)(w & 0xfffu); u.pn = (int)((w >> 12) & 0xfu); u.aux = (int)((w >> 16) & 0xffu); return true;
    }
    __device__ __forceinline__ const char* aptr(const Unit& u) const { return GATH ? A : A + (size_t)u.pm * (256 * 1024); }
    __device__ __forceinline__ const char* bptr(const Unit& u) const { return B + (size_t)u.aux * bstep_e + (size_t)u.pn * bstep_n; }
    __device__ __forceinline__ bool is_mid(const Unit&) const { return false; }
    __device__ __forceinline__ unsigned goff(int ui, int row) const { return gtab[ui * 256 + row]; }
};

#define EPI_ARGS f32x4 (&acc)[2][2][4][2], const Unit& u, int wr, int wc, int fr, int fq
__device__ __forceinline__ u32x4 pair16(u32x2 x, u32x2 y) {
    const auto rx = __builtin_amdgcn_permlane16_swap(x.x, y.x, false, false); const auto ry = __builtin_amdgcn_permlane16_swap(x.y, y.y, false, false);
    return (u32x4){rx[0], ry[0], rx[1], ry[1]};
}
struct EpiG1 {
    bf16 *Q, *K, *V, *U, *VG;
    __device__ __forceinline__ void mid(EPI_ARGS) const {}
    __device__ __forceinline__ void operator()(EPI_ARGS) const {
        const int pn = u.pn; const int row0 = u.pm * 256 + wr * 64 + fr;
        if (pn < 6) {
            const int t = pn >> 1; bf16* base = Q + (size_t)t * ((WS_K - WS_Q) / 2); const float sc = (t == 0) ? QSCALE : 1.0f;    const int col0 = (pn & 1) * 256 + wc * 32 + 8 * fq;
#pragma unroll
            for (int ai = 0; ai < 2; ++ai)
#pragma unroll
                for (int m = 0; m < 4; ++m) { bf16* rowp = base + (size_t)(row0 + ai * 128 + m * 16) * 512 + col0;
#pragma unroll
                    for (int bj = 0; bj < 2; ++bj) { const f32x4 v0 = acc[ai][bj][m][0] * sc, v1 = acc[ai][bj][m][1] * sc;
                        u32x4 w; w.x = cvtpk(v0[0], v0[1]); w.y = cvtpk(v0[2], v0[3]); w.z = cvtpk(v1[0], v1[1]); w.w = cvtpk(v1[2], v1[3]); *(u32x4*)(rowp + bj * 128) = w; } }
        } else {
            bf16* base = Q + (size_t)(pn >> 1) * ((WS_K - WS_Q) / 2); const int col0 = (pn & 1) * 256 + wc * 32 + 8 * fq;
#pragma unroll
            for (int ai = 0; ai < 2; ++ai)
#pragma unroll
                for (int m = 0; m < 4; ++m) { bf16* rowp = base + (size_t)(row0 + ai * 128 + m * 16) * 512 + col0;
#pragma unroll
                    for (int bj = 0; bj < 2; ++bj) { const f32x4 v0 = acc[ai][bj][m][0], v1 = acc[ai][bj][m][1];
                        const f32x2 a = gelu_pk((f32x2){v0[0], v0[1]}), b = gelu_pk((f32x2){v0[2], v0[3]}), c = gelu_pk((f32x2){v1[0], v1[1]}), d = gelu_pk((f32x2){v1[2], v1[3]});
                        u32x4 w; w.x = cvtpk(a.x, a.y); w.y = cvtpk(b.x, b.y); w.z = cvtpk(c.x, c.y); w.w = cvtpk(d.x, d.y); *(u32x4*)(rowp + bj * 128) = w; } }
        }
    }
};
struct EpiGate {
    bf16* GT; const float* bgate;
    __device__ __forceinline__ void mid(EPI_ARGS) const {}
    __device__ __forceinline__ void operator()(EPI_ARGS) const {
        const int row0 = u.pm * 256 + wr * 64 + fr;
        {
            const int col0 = u.pn * 128 + wc * 32 + 8 * fq;
            const f32x4 ba0 = *(const f32x4*)(bgate + col0), ba1 = *(const f32x4*)(bgate + col0 + 4), bb0 = *(const f32x4*)(bgate + 1024 + col0), bb1 = *(const f32x4*)(bgate + 1024 + col0 + 4);
#pragma unroll
            for (int ai = 0; ai < 2; ++ai)
#pragma unroll
                for (int m = 0; m < 4; ++m) { bf16* rowp = GT + (size_t)(row0 + ai * 128 + m * 16) * 2048 + col0;
                    const f32x4 a0 = acc[ai][0][m][0] * F8_DESCALE + ba0, a1 = acc[ai][0][m][1] * F8_DESCALE + ba1, b0 = acc[ai][1][m][0] * F8_DESCALE + bb0, b1 = acc[ai][1][m][1] * F8_DESCALE + bb1;
                    f32x4 ea0, ea1, eb0, eb1;
#pragma unroll
                    for (int i = 0; i < 4; ++i) { ea0[i] = __builtin_amdgcn_exp2f(-LOG2E * a0[i]); ea1[i] = __builtin_amdgcn_exp2f(-LOG2E * a1[i]); eb0[i] = fminf(__builtin_amdgcn_exp2f(-LOG2E * b0[i]), 1e18f); eb1[i] = fminf(__builtin_amdgcn_exp2f(-LOG2E * b1[i]), 1e18f); }
                    f32x4 gb0, gb1, r0, r1;
#pragma unroll
                    for (int i = 0; i < 4; ++i) { gb0[i] = __builtin_amdgcn_rcpf(1.0f + eb0[i]); gb1[i] = __builtin_amdgcn_rcpf(1.0f + eb1[i]); r0[i] = (1.0f + eb0[i]) * __builtin_amdgcn_rcpf(1.0f + ea0[i]); r1[i] = (1.0f + eb1[i]) * __builtin_amdgcn_rcpf(1.0f + ea1[i]); }
                    u32x4 wr, wb; wr.x = cvtpk(r0[0], r0[1]); wr.y = cvtpk(r0[2], r0[3]); wr.z = cvtpk(r1[0], r1[1]); wr.w = cvtpk(r1[2], r1[3]);
                    wb.x = cvtpk(gb0[0], gb0[1]); wb.y = cvtpk(gb0[2], gb0[3]); wb.z = cvtpk(gb1[0], gb1[1]); wb.w = cvtpk(gb1[2], gb1[3]);
                    __builtin_nontemporal_store(wr, (u32x4*)rowp); __builtin_nontemporal_store(wb, (u32x4*)(rowp + 1024)); }
        }
    }
};
struct EpiG2 {
    const bf16* GT; bf16* MRG;
    __device__ __forceinline__ void mid(EPI_ARGS) const {
        const int row0 = u.pm * 256 + wr * 64 + fr, col0 = u.pn * 256 + wc * 32 + 8 * fq;
#pragma unroll
        for (int ai = 0; ai < 2; ++ai)
#pragma unroll
            for (int m = 0; m < 4; ++m) { const bf16* gp = GT + (size_t)(row0 + ai * 128 + m * 16) * 2048 + col0;
#pragma unroll
                for (int bj = 0; bj < 2; ++bj) { const u32x4 rr = __builtin_nontemporal_load((const u32x4*)(gp + bj * 128));
                    const f32x4 r0 = {bflo(rr.x), bfhi(rr.x), bflo(rr.y), bfhi(rr.y)}, r1 = {bflo(rr.z), bfhi(rr.z), bflo(rr.w), bfhi(rr.w)};
                    acc[ai][bj][m][0] *= r0; acc[ai][bj][m][1] *= r1; } }
    }
    __device__ __forceinline__ void operator()(EPI_ARGS) const {
        const int row0 = u.pm * 256 + wr * 64 + fr, col0 = u.pn * 256 + wc * 32 + 8 * fq;
#pragma unroll
        for (int ai = 0; ai < 2; ++ai)
#pragma unroll
            for (int m = 0; m < 4; ++m) { const size_t r = (size_t)(row0 + ai * 128 + m * 16); const bf16* gp = GT + r * 2048 + 1024 + col0; bf16* op = MRG + r * 1024 + col0;
#pragma unroll
                for (int bj = 0; bj < 2; ++bj) { const u32x4 gb = __builtin_nontemporal_load((const u32x4*)(gp + bj * 128)); const f32x4 v0 = acc[ai][bj][m][0], v1 = acc[ai][bj][m][1];
                    u32x4 w; w.x = cvtpk(v0[0] * bflo(gb.x), v0[1] * bfhi(gb.x)); w.y = cvtpk(v0[2] * bflo(gb.y), v0[3] * bfhi(gb.y));
                    w.z = cvtpk(v1[0] * bflo(gb.z), v1[1] * bfhi(gb.z)); w.w = cvtpk(v1[2] * bflo(gb.w), v1[3] * bfhi(gb.w)); *(u32x4*)(op + bj * 128) = w; } }
    }
};
struct EpiPlain {
    bf16* O;
    __device__ __forceinline__ void mid(EPI_ARGS) const {}
    __device__ __forceinline__ void operator()(EPI_ARGS) const {
        const int row0 = u.pm * 256 + wr * 64 + fr, col0 = u.pn * 256 + wc * 32 + 8 * fq;
#pragma unroll
        for (int ai = 0; ai < 2; ++ai)
#pragma unroll
            for (int m = 0; m < 4; ++m) { bf16* op = O + (size_t)(row0 + ai * 128 + m * 16) * 1024 + col0;
#pragma unroll
                for (int bj = 0; bj < 2; ++bj) { const f32x4 v0 = acc[ai][bj][m][0], v1 = acc[ai][bj][m][1];
                    u32x4 w; w.x = cvtpk(v0[0], v0[1]); w.y = cvtpk(v0[2], v0[3]); w.z = cvtpk(v1[0], v1[1]); w.w = cvtpk(v1[2], v1[3]); *(u32x4*)(op + bj * 128) = w; } }
    }
};
struct EpiAct {
    const float* bgu; unsigned char* ACT8;
    __device__ __forceinline__ void mid(EPI_ARGS) const {}
    __device__ __forceinline__ f32x2 act2(f32x2 g, f32x2 l) const {
        f32x2 xg, xl; xg.x = fminf(g.x, SWL); xg.y = fminf(g.y, SWL); xl.x = fminf(fmaxf(l.x, -SWL), SWL); xl.y = fminf(fmaxf(l.y, -SWL), SWL);
        const f32x2 t = xg * (-SWA * LOG2E); f32x2 e; e.x = __builtin_amdgcn_exp2f(t.x); e.y = __builtin_amdgcn_exp2f(t.y);
        const f32x2 d = e + 1.0f; f32x2 r; r.x = __builtin_amdgcn_rcpf(d.x); r.y = __builtin_amdgcn_rcpf(d.y);
        return (xg * r) * (xl * F8_ASCALE + F8_ASCALE);
    }
    __device__ __forceinline__ void operator()(EPI_ARGS) const {
        const int e = u.aux; const int row0 = u.pm * 256 + wr * 64 + fr, col0 = u.pn * 128 + wc * 32 + 8 * fq;
        const float* bp = bgu + (size_t)e * 2048 + col0;
        const f32x4 bg0 = *(const f32x4*)(bp), bg1 = *(const f32x4*)(bp + 4), bl0 = *(const f32x4*)(bp + 1024), bl1 = *(const f32x4*)(bp + 1028);
#pragma unroll
        for (int ai = 0; ai < 2; ++ai)
#pragma unroll
            for (int mp = 0; mp < 2; ++mp) {
                u32x2 w[2];
#pragma unroll
                for (int mm = 0; mm < 2; ++mm) { const int m = 2 * mp + mm;
                    const f32x4 g0 = acc[ai][0][m][0] * F8_DESCALE + bg0, g1 = acc[ai][0][m][1] * F8_DESCALE + bg1, l0 = acc[ai][1][m][0] * F8_DESCALE + bl0, l1 = acc[ai][1][m][1] * F8_DESCALE + bl1;
                    const f32x2 o0 = act2((f32x2){g0[0], g0[1]}, (f32x2){l0[0], l0[1]}), o1 = act2((f32x2){g0[2], g0[3]}, (f32x2){l0[2], l0[3]});
                    const f32x2 o2 = act2((f32x2){g1[0], g1[1]}, (f32x2){l1[0], l1[1]}), o3 = act2((f32x2){g1[2], g1[3]}, (f32x2){l1[2], l1[3]});
                    w[mm].x = pk_fp8x4_nc(o0.x, o0.y, o1.x, o1.y); w[mm].y = pk_fp8x4_nc(o2.x, o2.y, o3.x, o3.y); }
                *(u32x4*)(ACT8 + (size_t)(row0 + ai * 128 + (2 * mp + (fq & 1)) * 16) * 1024 + (col0 - 8 * (fq & 1))) = pair16(w[0], w[1]); }
    }
};
struct EpiDown {
    const float* bdn; unsigned char* Y2s;
    __device__ __forceinline__ void mid(EPI_ARGS) const {}
    __device__ __forceinline__ void operator()(EPI_ARGS) const {
        const int e = u.aux; const int row0 = u.pm * 256 + wr * 64 + fr, col0 = u.pn * 256 + wc * 32 + 8 * fq;
        f32x4 bv[2][2];
#pragma unroll
        for (int bj = 0; bj < 2; ++bj)
#pragma unroll
            for (int n = 0; n < 2; ++n) bv[bj][n] = *(const f32x4*)(bdn + (size_t)e * 1024 + col0 + bj * 128 + 4 * n) * F8_YSCALE;
#pragma unroll
        for (int ai = 0; ai < 2; ++ai)
#pragma unroll
            for (int mp = 0; mp < 2; ++mp) { unsigned char* op = Y2s + (size_t)(row0 + ai * 128 + (2 * mp + (fq & 1)) * 16) * 1024 + (col0 - 8 * (fq & 1));
#pragma unroll
                for (int bj = 0; bj < 2; ++bj) { u32x2 w[2];
#pragma unroll
                    for (int mm = 0; mm < 2; ++mm) { const int m = 2 * mp + mm;
                        const f32x4 v0 = acc[ai][bj][m][0] * (F8_DESCALE * F8_YSCALE) + bv[bj][0], v1 = acc[ai][bj][m][1] * (F8_DESCALE * F8_YSCALE) + bv[bj][1];
                        w[mm].x = pk_fp8x4(v0[0], v0[1], v0[2], v0[3]); w[mm].y = pk_fp8x4(v1[0], v1[1], v1[2], v1[3]); }
                    *(u32x4*)(op + bj * 128) = pair16(w[0], w[1]); } }
    }
};

struct WItem { const float* W; unsigned char* dst; int N, k0, n0, ldt, drow, dk0, fp8; };
__device__ __forceinline__ WItem witem_decode(const Args& a, int r) {
    unsigned char* ws = a.ws; WItem it;
    constexpr int I_IN = 8 * 80, I_GATE = 8 * 64, I_BR = 4 * 32, I_OUT = 8 * 32, I_GU = 8 * 64, I_DN = 8 * 32;
    it.fp8 = 0; it.dk0 = 0; it.ldt = 2048;
    if (r < I_IN) { it.W = a.in[6]; it.N = INW; it.k0 = 128 * (r / 80); it.n0 = 32 * (r % 80); it.dst = ws + WS_W1T; it.drow = it.n0; return it; } r -= I_IN;
    if (r < I_GATE) { it.W = a.in[14]; it.N = 2048; it.k0 = 128 * (r / 64); it.n0 = 32 * (r % 64); it.dst = ws + WS_WG8; const int m0 = it.n0 & 1023; it.fp8 = 1; it.ldt = 1024;
        it.drow = 256 * (m0 >> 7) + (m0 & 127) + (it.n0 >= 1024 ? 128 : 0); return it; } r -= I_GATE;
    if (r < I_BR) { it.W = a.in[12]; it.N = 1024; it.k0 = 128 * (r / 32); it.n0 = 32 * (r % 32); it.dst = ws + WS_WBRT; it.drow = it.n0; return it; } r -= I_BR;
    if (r < I_BR) { it.W = a.in[13]; it.N = 1024; it.k0 = 128 * (r / 32); it.n0 = 32 * (r % 32); it.dst = ws + WS_WBRT; it.drow = it.n0; it.dk0 = 512; return it; } r -= I_BR;
    if (r < I_OUT) { it.W = a.in[16]; it.N = 1024; it.k0 = 128 * (r / 32); it.n0 = 32 * (r % 32); it.dst = ws + WS_WOUTT; it.drow = it.n0; return it; } r -= I_OUT;
    it.fp8 = 1; it.ldt = 1024;
    if (r < NEXP * I_GU) { const int e = r / I_GU, q = r % I_GU; it.W = a.in[21] + (size_t)e * D * 2048; it.N = 2048; it.k0 = 128 * (q / 64); it.n0 = 32 * (q % 64); it.dst = ws + WS_WGUT + (size_t)e * 2048 * 1024;
        const int m0 = it.n0 & 1023; it.drow = 256 * (m0 >> 7) + (m0 & 127) + (it.n0 >= 1024 ? 128 : 0); return it; }
    r -= NEXP * I_GU;
    { const int e = r / I_DN, q = r % I_DN; it.W = a.in[23] + (size_t)e * D * D; it.N = 1024; it.k0 = 128 * (q / 32); it.n0 = 32 * (q % 32); it.dst = ws + WS_WDNT + (size_t)e * 1024 * 1024; it.drow = it.n0; }
    return it;
}
constexpr int W_NITEMS = 8 * 80 + 8 * 64 + 2 * 4 * 32 + 8 * 32 + NEXP * (8 * 64 + 8 * 32);
__device__ __forceinline__ void witem_load(const WItem& it, float (&v)[64], int lane) {
    const float* p = it.W + (size_t)(it.k0 + (lane >> 3)) * it.N + it.n0 + (lane & 7) * 4;
#pragma unroll
    for (int i = 0; i < 16; ++i) { const f32x4 t = __builtin_nontemporal_load((const f32x4*)(p + (size_t)(8 * i) * it.N)); v[4 * i] = t[0]; v[4 * i + 1] = t[1]; v[4 * i + 2] = t[2]; v[4 * i + 3] = t[3]; }
}
__device__ __forceinline__ void witem_store(const WItem& it, const float (&v)[64], LAS float* scr, int lane) {
#pragma unroll
    for (int i = 0; i < 16; ++i) { const int k = 8 * i + (lane >> 3); *(LAS f32x4*)(scr + k * 32 + (((lane & 7) * 4 + 4 * (i >> 1)) & 31)) = (f32x4){v[4 * i], v[4 * i + 1], v[4 * i + 2], v[4 * i + 3]}; }
    LDS_WAIT(); asm volatile("" ::: "memory");
    const int c = lane & 7;
#pragma unroll
    for (int j = 0; j < 4; ++j) { const int n = (lane >> 3) + 8 * j; const LAS float* s = scr + (16 * c) * 32 + ((n + 4 * c) & 31);
        float x[16];
#pragma unroll
        for (int q = 0; q < 16; ++q) x[q] = s[q * 32];
        unsigned char* d = it.dst + (size_t)(it.drow + n) * it.ldt;
        if (it.fp8) { u32x4 o;
            o.x = pk_fp8x4(x[0] * F8_WSCALE, x[1] * F8_WSCALE, x[2] * F8_WSCALE, x[3] * F8_WSCALE); o.y = pk_fp8x4(x[4] * F8_WSCALE, x[5] * F8_WSCALE, x[6] * F8_WSCALE, x[7] * F8_WSCALE);
            o.z = pk_fp8x4(x[8] * F8_WSCALE, x[9] * F8_WSCALE, x[10] * F8_WSCALE, x[11] * F8_WSCALE); o.w = pk_fp8x4(x[12] * F8_WSCALE, x[13] * F8_WSCALE, x[14] * F8_WSCALE, x[15] * F8_WSCALE);
            __builtin_nontemporal_store(o, (u32x4*)(d + it.dk0 + it.k0 + 16 * c)); }
        else { u32x4 o0, o1;
            o0.x = cvtpk(x[0], x[1]); o0.y = cvtpk(x[2], x[3]); o0.z = cvtpk(x[4], x[5]); o0.w = cvtpk(x[6], x[7]); o1.x = cvtpk(x[8], x[9]); o1.y = cvtpk(x[10], x[11]); o1.z = cvtpk(x[12], x[13]); o1.w = cvtpk(x[14], x[15]);
            *(u32x4*)(d + (size_t)(it.dk0 + it.k0 + 16 * c) * 2) = o0; *(u32x4*)(d + (size_t)(it.dk0 + it.k0 + 16 * c) * 2 + 16) = o1; } }
    LDS_WAIT(); asm volatile("" ::: "memory");
}
__device__ __forceinline__ void phaseA(const Frame& F, const Args& a) {
    unsigned char* ws = a.ws;
    if (F.vcu < 192) {
        const float* c = a.in[1]; const float* w_ada = a.in[2]; const float* b_ada = a.in[3]; float* mod = (float*)(ws + WS_MOD);
        LAS float* red = (LAS float*)(F.lds);
        const int col = F.vcu * 32 + (F.tid & 31), ks = F.tid >> 5;
        float a0 = 0.f, a1 = 0.f, a2 = 0.f, a3 = 0.f;
        for (int k = ks * 64; k < ks * 64 + 64; ++k) { const float w = __builtin_nontemporal_load(w_ada + (size_t)k * 6144 + col);
            const float c0 = c[k], c1 = c[D + k], c2 = c[2 * D + k], c3 = c[3 * D + k];
            a0 += c0 * __builtin_amdgcn_rcpf(1.0f + __expf(-c0)) * w; a1 += c1 * __builtin_amdgcn_rcpf(1.0f + __expf(-c1)) * w;
            a2 += c2 * __builtin_amdgcn_rcpf(1.0f + __expf(-c2)) * w; a3 += c3 * __builtin_amdgcn_rcpf(1.0f + __expf(-c3)) * w; }
        red[(ks * 4 + 0) * 32 + (F.tid & 31)] = a0; red[(ks * 4 + 1) * 32 + (F.tid & 31)] = a1; red[(ks * 4 + 2) * 32 + (F.tid & 31)] = a2; red[(ks * 4 + 3) * 32 + (F.tid & 31)] = a3;
        __syncthreads();
        if (F.tid < 128) { const int b = F.tid >> 5, cc = F.tid & 31; float s = 0.f;
#pragma unroll
            for (int k = 0; k < 16; ++k) s += red[(k * 4 + b) * 32 + cc];
            mod[b * 6144 + F.vcu * 32 + cc] = s + b_ada[F.vcu * 32 + cc]; }
        __syncthreads();
    }
    if (F.vcu == 192 % F.G) {
        const float* w_router = a.in[19]; bf16* wrt = (bf16*)(ws + WS_WRT);
        for (int i = F.tid; i < D * NEXP; i += NWAVES * 64) { const int k = i >> 5, e = i & 31; const float w = w_router[i]; const unsigned hh = cvtpk(w, 0.f) & 0xffffu;
            wrt[(size_t)e * D + k] = (bf16)hh; wrt[(size_t)(NEXP + e) * D + k] = (bf16)(cvtpk(w - bflo(hh), 0.f) & 0xffffu); }
    }
    LAS float* scr = (LAS float*)(F.lds + F.wave * 17408);
    const int gw = F.vcu * NWAVES + F.wave, NGW = F.G * NWAVES;
    if (gw < W_NITEMS) {
        float va[64], vb[64];
        WItem ia = witem_decode(a, gw), ib = ia;
        witem_load(ia, va, F.lane);
        for (int it = gw; it < W_NITEMS; it += 2 * NGW) {
            const bool hb = (it + NGW < W_NITEMS);
            ib = witem_decode(a, hb ? it + NGW : it); witem_load(ib, vb, F.lane);
            witem_store(ia, va, scr, F.lane);
            if (!hb) break;
            const bool ha = (it + 2 * NGW < W_NITEMS);
            ia = witem_decode(a, ha ? it + 2 * NGW : it); witem_load(ia, va, F.lane);
            witem_store(ib, vb, scr, F.lane);
            if (!ha) break;
        }
    }
}
__device__ __forceinline__ void phaseB(const Frame& F, const Args& a) {
    const float* x = a.in[0]; const float* g = a.in[4]; const float* mod = (const float*)(a.ws + WS_MOD); bf16* xn = (bf16*)(a.ws + WS_XN); unsigned* xn8 = (unsigned*)(a.ws + WS_XN8A);
    const int gw = F.vcu * NWAVES + F.wave, NGW = F.G * NWAVES;
    f32x4 cg[4], csh[4]; int cb = -1;
    for (int row0 = gw * 4; row0 < NTOK; row0 += NGW * 4) {
        f32x4 v[4][4];
#pragma unroll
        for (int rr = 0; rr < 4; ++rr)
#pragma unroll
            for (int j = 0; j < 4; ++j) v[rr][j] = __builtin_nontemporal_load((const f32x4*)(x + (size_t)(row0 + rr) * D) + F.lane + 64 * j);
        const int b = row0 / SEQ; const float* mb = mod + b * 6144;
        if (b != cb) { cb = b;
#pragma unroll
            for (int j = 0; j < 4; ++j) { const int c0 = (F.lane + 64 * j) * 4; cg[j] = *(const f32x4*)(g + c0) * (*(const f32x4*)(mb + SC1 + c0) + 1.0f); csh[j] = *(const f32x4*)(mb + SH1 + c0); } }
#pragma unroll
        for (int rr = 0; rr < 4; ++rr) {
            float ss = 0.f;
#pragma unroll
            for (int j = 0; j < 4; ++j) ss += (v[rr][j].x * v[rr][j].x + v[rr][j].y * v[rr][j].y) + (v[rr][j].z * v[rr][j].z + v[rr][j].w * v[rr][j].w);
            const float rstd = rsqrtf(wsum(ss) * (1.0f / D) + EPS);
            u32x2* o8 = (u32x2*)(xn + (size_t)(row0 + rr) * D) + F.lane; unsigned* o4 = xn8 + (size_t)(row0 + rr) * (D / 4) + F.lane;
#pragma unroll
            for (int j = 0; j < 4; ++j) {
                const f32x4 h = v[rr][j] * rstd * cg[j] + csh[j];
                u32x2 w; w.x = cvtpk(h[0], h[1]); w.y = cvtpk(h[2], h[3]); o8[64 * j] = w;
                o4[64 * j] = pk_fp8x4(h[0] * F8_ASCALE, h[1] * F8_ASCALE, h[2] * F8_ASCALE, h[3] * F8_ASCALE); }
        }
    }
}

__device__ __forceinline__ void store_row32(bf16* blk, u32x2 w0, u32x2 w1, u32x2 w2, u32x2 w3, int hi) {
    { const auto rx = __builtin_amdgcn_permlane32_swap(w0.x, w1.x, false, false); const auto ry = __builtin_amdgcn_permlane32_swap(w0.y, w1.y, false, false);
      u32x4 o = {rx[0], ry[0], rx[1], ry[1]}; *(u32x4*)(blk + (hi ? 8 : 0)) = o; }
    { const auto rx = __builtin_amdgcn_permlane32_swap(w2.x, w3.x, false, false); const auto ry = __builtin_amdgcn_permlane32_swap(w2.y, w3.y, false, false);
      u32x4 o = {rx[0], ry[0], rx[1], ry[1]}; *(u32x4*)(blk + 16 + (hi ? 8 : 0)) = o; }
}
constexpr int SGU_STRIDE = 1088;
__device__ __forceinline__ s16x4 vtr(const LAS unsigned char* p) { typedef short v4i16_t __attribute__((ext_vector_type(4))); return __builtin_bit_cast(s16x4, __builtin_amdgcn_ds_read_tr16_b64_v4i16((LAS v4i16_t*)p)); }
__device__ __forceinline__ void sgu_unit(const Frame& F, const Args& a, int b, int blk) {
    const bf16* VG = (const bf16*)(a.ws + WS_VG); const bf16* U = (const bf16*)(a.ws + WS_U); bf16* YAB = (bf16*)(a.ws + WS_YAB);
    const float* ln_g = a.in[8]; const float* ln_b = a.in[9]; const float* w_s = a.in[10]; const float* b_s = a.in[11];
    const int tok0 = b * SEQ + blk * SGB, lane = F.lane;
    {
        const f32x4 g0 = *(const f32x4*)(ln_g + lane * 8), g1 = *(const f32x4*)(ln_g + lane * 8 + 4), b0 = *(const f32x4*)(ln_b + lane * 8), b1 = *(const f32x4*)(ln_b + lane * 8 + 4);
#pragma unroll 1
        for (int r4 = 0; r4 < 16; r4 += 4) {
            u32x4 w[4];
#pragma unroll
            for (int rr = 0; rr < 4; ++rr) w[rr] = __builtin_nontemporal_load((const u32x4*)(VG + (size_t)(tok0 + F.wave * 16 + r4 + rr) * 512 + lane * 8));
#pragma unroll
            for (int rr = 0; rr < 4; ++rr) { const int row = F.wave * 16 + r4 + rr;
                f32x4 v0 = {bflo(w[rr].x), bfhi(w[rr].x), bflo(w[rr].y), bfhi(w[rr].y)}, v1 = {bflo(w[rr].z), bfhi(w[rr].z), bflo(w[rr].w), bfhi(w[rr].w)};
                const float mu = wsum((v0[0] + v0[1]) + (v0[2] + v0[3]) + (v1[0] + v1[1]) + (v1[2] + v1[3])) * (1.0f / 512.0f);
                v0 -= mu; v1 -= mu;
                const float var = wsum((v0[0] * v0[0] + v0[1] * v0[1]) + (v0[2] * v0[2] + v0[3] * v0[3]) + (v1[0] * v1[0] + v1[1] * v1[1]) + (v1[2] * v1[2] + v1[3] * v1[3])) * (1.0f / 512.0f);
                const float rstd = rsqrtf(var + EPS);
                v0 = v0 * rstd * g0 + b0; v1 = v1 * rstd * g1 + b1;
                u32x4 o; o.x = cvtpk(v0[0], v0[1]); o.y = cvtpk(v0[2], v0[3]); o.z = cvtpk(v1[0], v1[1]); o.w = cvtpk(v1[2], v1[3]);
                *(LAS u32x4*)(F.lds + row * SGU_STRIDE + lane * 16) = o; }
        }
    }
    __syncthreads();
    {
        const int g = F.wave, r32 = lane & 31, hi = lane >> 5, i16 = lane & 15, g16 = (lane >> 4) & 1;
        const LAS unsigned char* vb = F.lds + (8 * hi + (i16 >> 2)) * SGU_STRIDE + (g * 64 + 16 * g16 + 4 * (i16 & 3)) * 2;
#pragma unroll
        for (int tb = 0; tb < 4; ++tb) {
            const int t = 32 * tb + r32; const float* wrow = w_s + ((size_t)g * 128 + t) * 128;
            f32x4 wr0[8], wr1[8];
#pragma unroll
            for (int ks = 0; ks < 2 * tb + 2; ++ks) { wr0[ks] = *(const f32x4*)(wrow + 16 * ks + 8 * hi); wr1[ks] = *(const f32x4*)(wrow + 16 * ks + 8 * hi + 4); }
            const float bs = b_s[g * 128 + t];
            const bf16* up = U + (size_t)(tok0 + t) * 512 + g * 64 + 4 * hi;
            u32x2 uu0[4], uu1[4];
#pragma unroll
            for (int gg = 0; gg < 4; ++gg) { uu0[gg] = *(const u32x2*)(up + 8 * gg); uu1[gg] = *(const u32x2*)(up + 32 + 8 * gg); }
            f32x16 a0, a1;
#pragma unroll
            for (int r = 0; r < 16; ++r) { a0[r] = 0.f; a1[r] = 0.f; }
#pragma unroll
            for (int ks = 0; ks < 2 * tb + 2; ++ks) {
                const int s0 = 16 * ks + 8 * hi;
                float wv[8] = {wr0[ks][0], wr0[ks][1], wr0[ks][2], wr0[ks][3], wr1[ks][0], wr1[ks][1], wr1[ks][2], wr1[ks][3]};
                if (ks >= 2 * tb) {
#pragma unroll
                    for (int j = 0; j < 8; ++j) wv[j] = (s0 + j <= t) ? wv[j] : 0.f; }
                u32x4 bw; bw.x = cvtpk(wv[0], wv[1]); bw.y = cvtpk(wv[2], wv[3]); bw.z = cvtpk(wv[4], wv[5]); bw.w = cvtpk(wv[6], wv[7]);
                const bf16x8 bfrag = __builtin_bit_cast(bf16x8, bw);
                const LAS unsigned char* p = vb + ks * 16 * SGU_STRIDE;
                const s16x4 l0 = vtr(p), h0 = vtr(p + 4 * SGU_STRIDE), l1 = vtr(p + 64), h1 = vtr(p + 4 * SGU_STRIDE + 64);
                const bf16x8 A0 = {l0[0], l0[1], l0[2], l0[3], h0[0], h0[1], h0[2], h0[3]}, A1 = {l1[0], l1[1], l1[2], l1[3], h1[0], h1[1], h1[2], h1[3]};
                a0 = __builtin_amdgcn_mfma_f32_32x32x16_bf16(A0, bfrag, a0, 0, 0, 0);
                a1 = __builtin_amdgcn_mfma_f32_32x32x16_bf16(A1, bfrag, a1, 0, 0, 0);
            }
            bf16* op = YAB + (size_t)(tok0 + t) * 1024 + 512 + g * 64;
            u32x2 q0[4], q1[4];
#pragma unroll
            for (int gg = 0; gg < 4; ++gg) {
                q0[gg].x = cvtpk(bflo(uu0[gg].x) * (a0[4 * gg] + bs), bfhi(uu0[gg].x) * (a0[4 * gg + 1] + bs)); q0[gg].y = cvtpk(bflo(uu0[gg].y) * (a0[4 * gg + 2] + bs), bfhi(uu0[gg].y) * (a0[4 * gg + 3] + bs));
                q1[gg].x = cvtpk(bflo(uu1[gg].x) * (a1[4 * gg] + bs), bfhi(uu1[gg].x) * (a1[4 * gg + 1] + bs)); q1[gg].y = cvtpk(bflo(uu1[gg].y) * (a1[4 * gg + 2] + bs), bfhi(uu1[gg].y) * (a1[4 * gg + 3] + bs)); }
            store_row32(op, q0[0], q0[1], q0[2], q0[3], hi); store_row32(op + 32, q1[0], q1[1], q1[2], q1[3], hi);
        }
    }
    __syncthreads();
}

constexpr int AT_BUF = 65536, AT_V = 32768, AT_BT = GTAB_OFF;
static_assert(8 * 1088 <= GTAB_BYTES, "bias tables fit above the ring");
__device__ __forceinline__ void attn_chunks(const Frame& F, const Args& a, int gc0, int gc1) {
    const bf16* __restrict__ Q = (const bf16*)(a.ws + WS_Q); const bf16* __restrict__ Kb = (const bf16*)(a.ws + WS_K); const bf16* __restrict__ Vb = (const bf16*)(a.ws + WS_V); bf16* YAB = (bf16*)(a.ws + WS_YAB);
    const int tid = F.tid, lane = F.lane, wave = F.wave, pr = wave >> 1, half = wave & 1;
    const int r32 = lane & 31, hi = lane >> 5, i16 = lane & 15, g16 = (lane >> 4) & 1;
    const int gcs[2] = {gc0, gc1};
    int j0s[2], nts[2], tok0s[2];
#pragma unroll
    for (int i = 0; i < 2; ++i) { const int c = gcs[i] % (SEQ / CHUNK); j0s[i] = (c < NLEFT) ? (NLEFT - c) : 0; nts[i] = 9 - j0s[i]; tok0s[i] = (gcs[i] / (SEQ / CHUNK)) * SEQ + c * CHUNK; }
    const int total = 2 * nts[0] + 2 * nts[1];
    unsigned dsrcK[4], dsrcV[4];
#pragma unroll
    for (int i = 0; i < 4; ++i) { const int piece = 4 * wave + i, hh = piece >> 3, kb = piece & 7, key = 8 * kb + (lane >> 3), slot = lane & 7;
        dsrcK[i] = (unsigned)(key * 512 + hh * 64 + ((slot ^ ((key >> 1) & 7)) << 3)); dsrcV[i] = (unsigned)(key * 512 + hh * 64 + ((slot ^ (((key >> 1) & 1) << 2)) << 3)); }
#define AT_DMA(bufp, tbase) do { _Pragma("unroll") for (int i_ = 0; i_ < 4; ++i_) { const int piece_ = 4 * wave + i_; \
        __builtin_amdgcn_global_load_lds((const unsigned*)(Kb + (tbase) + dsrcK[i_]), (LAS unsigned*)((bufp) + (piece_ >> 3) * 8192 + (piece_ & 7) * 1024), 16, 0, 0); \
        __builtin_amdgcn_global_load_lds((const unsigned*)(Vb + (tbase) + dsrcV[i_]), (LAS unsigned*)((bufp) + AT_V + (piece_ >> 3) * 8192 + (piece_ & 7) * 1024), 16, 0, 0); } } while (0)
    int ko[4];
#pragma unroll
    for (int sI = 0; sI < 4; ++sI) ko[sI] = pr * 8192 + r32 * 128 + ((((2 * sI + hi) ^ ((r32 >> 1) & 7))) << 4);
    const int fb = (i16 >> 3) & 1;
    const int vr0 = AT_V + pr * 8192 + (4 * hi + (i16 >> 2)) * 128 + ((4 * (0 ^ fb) + 2 * g16 + ((i16 & 3) >> 1)) * 16) + (i16 & 1) * 8;
    const int vr1 = AT_V + pr * 8192 + (4 * hi + (i16 >> 2)) * 128 + ((4 * (1 ^ fb) + 2 * g16 + ((i16 & 3) >> 1)) * 16) + (i16 & 1) * 8;
#define AT_DECODE(t, ci, hp, j) do { ci = ((t) >= 2 * nts[0]) ? 1 : 0; const int tt_ = (t) - ci * 2 * nts[0]; hp = (tt_ >= nts[ci]) ? 1 : 0; j = j0s[ci] + tt_ - hp * nts[ci]; } while (0)
    {
        int ci, hp, j; AT_DECODE(0, ci, hp, j);
        const size_t tb0 = (size_t)(tok0s[ci] + (j - NLEFT) * CHUNK) * 512 + hp * 256;
        AT_DMA(F.lds, tb0);
    }
    __syncthreads();
    bf16x8 qf[4]; f32x16 o0, o1; float m = -1e30f, l = 0.f;
#pragma unroll
    for (int r = 0; r < 16; ++r) { o0[r] = 0.f; o1[r] = 0.f; }
#pragma unroll
    for (int sI = 0; sI < 4; ++sI) qf[sI] = (bf16x8){0, 0, 0, 0, 0, 0, 0, 0};
#pragma unroll 1
    for (int t = 0; t < total; ++t) {
        int ci, hp, j; AT_DECODE(t, ci, hp, j);
        const int tn = (t + 1 < total) ? t + 1 : t; int cin, hpn, jn; AT_DECODE(tn, cin, hpn, jn);
        const int h = 4 * hp + pr, qi = half * 32 + r32, qtok = tok0s[ci] + qi;
        if (j == j0s[ci]) {
#pragma unroll
            for (int sI = 0; sI < 4; ++sI) qf[sI] = __builtin_nontemporal_load((const bf16x8*)(Q + (size_t)qtok * 512 + h * 64 + 16 * sI + 8 * hi));
#pragma unroll
            for (int r = 0; r < 16; ++r) { o0[r] = 0.f; o1[r] = 0.f; }
            m = -1e30f; l = 0.f;
        }
        asm volatile("" ::: "memory");
        {
            const size_t tbn = (size_t)(tok0s[cin] + (jn - NLEFT) * CHUNK) * 512 + hpn * 256;
            AT_DMA(F.lds + ((t + 1) & 1) * AT_BUF, tbn);
        }
        asm volatile("" ::: "memory");
        const LAS unsigned char* buf = F.lds + (t & 1) * AT_BUF;
        const bool first = (j == j0s[ci]);
        const float negm = first ? 0.f : -m;
        f32x16 p0, p1;
#pragma unroll
        for (int r = 0; r < 16; ++r) { p0[r] = negm; p1[r] = negm; }
#pragma unroll
        for (int sI = 0; sI < 4; ++sI) { const bf16x8 k0 = *(const LAS bf16x8*)(buf + ko[sI]), k1 = *(const LAS bf16x8*)(buf + ko[sI] + 4096);
            p0 = __builtin_amdgcn_mfma_f32_32x32x16_bf16(k0, qf[sI], p0, 0, 0, 0); p1 = __builtin_amdgcn_mfma_f32_32x32x16_bf16(k1, qf[sI], p1, 0, 0, 0); }
        if (j >= 6) {
            const LAS float* bt = (const LAS float*)(F.lds + AT_BT + h * 1088);
            const int base = 640 + qi - 64 * j - 4 * hi;
#pragma unroll
            for (int r = 0; r < 16; ++r) { const int kk = (r & 3) + 8 * (r >> 2); int i0 = base - kk, i1 = base - 32 - kk; i0 = i0 > 256 ? 256 : i0; i1 = i1 > 256 ? 256 : i1; p0[r] += bt[i0]; p1[r] += bt[i1]; }
        }
        float tm = fmaxf(p0[0], p1[0]);
#pragma unroll
        for (int r = 1; r < 16; ++r) tm = fmaxf(tm, fmaxf(p0[r], p1[r]));
        { const auto rr = __builtin_amdgcn_permlane32_swap(__float_as_uint(tm), __float_as_uint(tm), false, false); tm = fmaxf(__uint_as_float(rr[0]), __uint_as_float(rr[1])); }
        if (first) {
            m = tm;
#pragma unroll
            for (int r = 0; r < 16; ++r) { p0[r] -= tm; p1[r] -= tm; }
        } else if (__any(tm > 0.f)) {
            const float dlt = fmaxf(tm, 0.f), alpha = __builtin_amdgcn_exp2f(-dlt); m += dlt; l *= alpha;
#pragma unroll
            for (int r = 0; r < 16; ++r) { p0[r] -= dlt; p1[r] -= dlt; o0[r] *= alpha; o1[r] *= alpha; }
        }
        float ps = 0.f;
#pragma unroll
        for (int r = 0; r < 16; ++r) { p0[r] = __builtin_amdgcn_exp2f(p0[r]); p1[r] = __builtin_amdgcn_exp2f(p1[r]); ps += p0[r] + p1[r]; }
        l += ps;
        bf16x8 pb[2][2];
#pragma unroll
        for (int sI = 0; sI < 2; ++sI) {
            u32x4 w0; w0.x = cvtpk(p0[8 * sI], p0[8 * sI + 1]); w0.y = cvtpk(p0[8 * sI + 2], p0[8 * sI + 3]); w0.z = cvtpk(p0[8 * sI + 4], p0[8 * sI + 5]); w0.w = cvtpk(p0[8 * sI + 6], p0[8 * sI + 7]);
            u32x4 w1; w1.x = cvtpk(p1[8 * sI], p1[8 * sI + 1]); w1.y = cvtpk(p1[8 * sI + 2], p1[8 * sI + 3]); w1.z = cvtpk(p1[8 * sI + 4], p1[8 * sI + 5]); w1.w = cvtpk(p1[8 * sI + 6], p1[8 * sI + 7]);
            pb[0][sI] = __builtin_bit_cast(bf16x8, w0); pb[1][sI] = __builtin_bit_cast(bf16x8, w1); }
#pragma unroll
        for (int blk = 0; blk < 2; ++blk)
#pragma unroll
            for (int sI = 0; sI < 2; ++sI) {
                const int kof = (32 * blk + 16 * sI) * 128;
                const s16x4 l0 = vtr(buf + vr0 + kof), h0 = vtr(buf + vr0 + kof + 1024), l1 = vtr(buf + vr1 + kof), h1 = vtr(buf + vr1 + kof + 1024);
                const bf16x8 A0 = {l0[0], l0[1], l0[2], l0[3], h0[0], h0[1], h0[2], h0[3]}, A1 = {l1[0], l1[1], l1[2], l1[3], h1[0], h1[1], h1[2], h1[3]};
                o0 = __builtin_amdgcn_mfma_f32_32x32x16_bf16(A0, pb[blk][sI], o0, 0, 0, 0);
                o1 = __builtin_amdgcn_mfma_f32_32x32x16_bf16(A1, pb[blk][sI], o1, 0, 0, 0);
            }
        if (j == 8) {
            float lt = l; { const auto rr = __builtin_amdgcn_permlane32_swap(__float_as_uint(lt), __float_as_uint(lt), false, false); lt = __uint_as_float(rr[0]) + __uint_as_float(rr[1]); }
            const float inv = __builtin_amdgcn_rcpf(lt);
            bf16* op = YAB + (size_t)qtok * 1024 + h * 64;
            u32x2 q0[4], q1[4];
#pragma unroll
            for (int gg = 0; gg < 4; ++gg) {
                q0[gg].x = cvtpk(o0[4 * gg] * inv, o0[4 * gg + 1] * inv); q0[gg].y = cvtpk(o0[4 * gg + 2] * inv, o0[4 * gg + 3] * inv);
                q1[gg].x = cvtpk(o1[4 * gg] * inv, o1[4 * gg + 1] * inv); q1[gg].y = cvtpk(o1[4 * gg + 2] * inv, o1[4 * gg + 3] * inv); }
            store_row32(op, q0[0], q0[1], q0[2], q0[3], hi); store_row32(op + 32, q1[0], q1[1], q1[2], q1[3], hi);
        }
        __syncthreads();
    }
#undef AT_DMA
#undef AT_DECODE
}
__device__ __forceinline__ void phaseD(const Frame& F, const Args& a) {
    for (int unit = F.vcu; unit < NB * (SEQ / SGB); unit += F.G) sgu_unit(F, a, unit / (SEQ / SGB), unit % (SEQ / SGB));
    for (int i = F.tid; i < NHEAD * NREL; i += NWAVES * 64) { const int h = i / NREL, k = i % NREL; ((LAS float*)(F.lds + AT_BT + h * 1088))[k] = (a.in[7][i] - a.in[7][h * NREL + 256]) * LOG2E; }
    __syncthreads();
    const int NCH = NB * (SEQ / CHUNK);
    for (int v = F.vcu; v < NCH / 2; v += F.G) attn_chunks(F, a, v, NCH - 1 - v);
}

constexpr int G_HT_STRIDE = 2064;
__device__ __forceinline__ void phaseG(const Frame& F, const Args& a) {
    const float* x = a.in[0]; const bf16* Y1 = (const bf16*)(a.ws + WS_Y1); const float* mod = (const float*)(a.ws + WS_MOD); const float* g_post_mix = a.in[5]; const float* g_pre_ffn = a.in[17];
    const float* b_router = a.in[20]; bf16* X1b = (bf16*)(a.ws + WS_X1B); unsigned char* XN8 = a.ws + WS_XN;
    const bf16* wrt = (const bf16*)(a.ws + WS_WRT);
    float* topg = (float*)(a.ws + WS_TOPG); int* list = (int*)(a.ws + WS_LIST); unsigned* cnt = F.ctl + CW_CNT;
    LAS unsigned char* HT = F.lds;
    LAS float* PL = (LAS float*)(F.lds + 33792);
    LAS float* LG = PL + 8 * 16 * 32;
    LAS float* TV = LG + 512;
    LAS unsigned* LC = (LAS unsigned*)(TV + 64);
    LAS unsigned* AS = LC + 64;
    const int tid = F.tid, lane = F.lane, wave = F.wave, kq = lane >> 4, i16 = lane & 15;
    if (tid < 64) LC[tid] = 0u;
    bf16x8 whi[2][4], wlo[2][4];
#pragma unroll
    for (int et = 0; et < 2; ++et)
#pragma unroll
        for (int ks = 0; ks < 4; ++ks) { const size_t o = (size_t)(et * 16 + i16) * D + 128 * wave + 32 * ks + 8 * kq; whi[et][ks] = *(const bf16x8*)(wrt + o); wlo[et][ks] = *(const bf16x8*)(wrt + (size_t)NEXP * D + o); }
    const int myrow = tid >> 5, mye = lane & 31;
    const float mybias = b_router[mye];
    __syncthreads();
    const int NT = NTOK / 16;
    f32x4 xv[2][4]; u32x2 yr[2][4];
    {   const int rbase = 16 * F.vcu + 2 * wave;
#pragma unroll
        for (int rr = 0; rr < 2; ++rr)
#pragma unroll
            for (int j = 0; j < 4; ++j) { const int c0 = (lane + 64 * j) * 4; xv[rr][j] = __builtin_nontemporal_load((const f32x4*)(x + (size_t)(rbase + rr) * D + c0)); yr[rr][j] = __builtin_nontemporal_load((const u32x2*)(Y1 + (size_t)(rbase + rr) * D + c0)); } }
    int tl = 0;
    f32x4 cgp[4], cgf[4], cgt[4], csc[4], csh[4]; int cb = -1;
#pragma unroll
    for (int j = 0; j < 4; ++j) { const int c0 = (lane + 64 * j) * 4; cgp[j] = *(const f32x4*)(g_post_mix + c0); cgf[j] = *(const f32x4*)(g_pre_ffn + c0); }
#pragma unroll 1
    for (int T = F.vcu; T < NT; T += F.G, ++tl) {
        const int b = (16 * T) / SEQ; const float* mb = mod + b * 6144; const int rbase = 16 * T + 2 * wave;
        if (b != cb) { cb = b;
#pragma unroll
            for (int j = 0; j < 4; ++j) { const int c0 = (lane + 64 * j) * 4; cgt[j] = *(const f32x4*)(mb + GT1 + c0); csc[j] = *(const f32x4*)(mb + SC2 + c0) + 1.0f; csh[j] = *(const f32x4*)(mb + SH2 + c0); } }
#pragma unroll
        for (int rr = 0; rr < 2; ++rr) {
            const int row = rbase + rr; f32x4 yv[4]; float ss = 0.f;
#pragma unroll
            for (int j = 0; j < 4; ++j) { yv[j] = (f32x4){bflo(yr[rr][j].x), bfhi(yr[rr][j].x), bflo(yr[rr][j].y), bfhi(yr[rr][j].y)}; ss += (yv[j][0] * yv[j][0] + yv[j][1] * yv[j][1]) + (yv[j][2] * yv[j][2] + yv[j][3] * yv[j][3]); }
            const float rstd = rsqrtf(wsum(ss) * (1.0f / D) + EPS); float s2 = 0.f;
#pragma unroll
            for (int j = 0; j < 4; ++j) { const int c0 = (lane + 64 * j) * 4;
                xv[rr][j] = xv[rr][j] + cgt[j] * (yv[j] * rstd * cgp[j]);
                { u32x2 w1; w1.x = cvtpk(xv[rr][j][0], xv[rr][j][1]); w1.y = cvtpk(xv[rr][j][2], xv[rr][j][3]); __builtin_nontemporal_store(w1, (u32x2*)(X1b + (size_t)row * D + c0)); }
                s2 += (xv[rr][j][0] * xv[rr][j][0] + xv[rr][j][1] * xv[rr][j][1]) + (xv[rr][j][2] * xv[rr][j][2] + xv[rr][j][3] * xv[rr][j][3]); }
            const float rstd2 = rsqrtf(wsum(s2) * (1.0f / D) + EPS);
#pragma unroll
            for (int j = 0; j < 4; ++j) { const int c0 = (lane + 64 * j) * 4;
                const f32x4 h = xv[rr][j] * rstd2 * cgf[j] * csc[j] + csh[j];
                u32x2 w; w.x = cvtpk(h[0], h[1]); w.y = cvtpk(h[2], h[3]); *(unsigned*)(XN8 + (size_t)row * D + c0) = pk_fp8x4(h[0] * F8_ASCALE, h[1] * F8_ASCALE, h[2] * F8_ASCALE, h[3] * F8_ASCALE);
                *(LAS u32x2*)(HT + (2 * wave + rr) * G_HT_STRIDE + c0 * 2) = w; }
        }
        {
            const int Tn = (T + F.G < NT) ? T + F.G : T; const int rb2 = 16 * Tn + 2 * wave;
#pragma unroll
            for (int rr = 0; rr < 2; ++rr)
#pragma unroll
                for (int j = 0; j < 4; ++j) { const int c0 = (lane + 64 * j) * 4; xv[rr][j] = __builtin_nontemporal_load((const f32x4*)(x + (size_t)(rb2 + rr) * D + c0)); yr[rr][j] = __builtin_nontemporal_load((const u32x2*)(Y1 + (size_t)(rb2 + rr) * D + c0)); }
        }
        LDS_WAIT(); __builtin_amdgcn_s_barrier(); asm volatile("" ::: "memory");
        {
            f32x4 acc0 = {0.f, 0.f, 0.f, 0.f}, acc1 = {0.f, 0.f, 0.f, 0.f};
#pragma unroll
            for (int ks = 0; ks < 4; ++ks) { const bf16x8 hb = *(const LAS bf16x8*)(HT + i16 * G_HT_STRIDE + (128 * wave + 32 * ks + 8 * kq) * 2);
                acc0 = __builtin_amdgcn_mfma_f32_16x16x32_bf16(whi[0][ks], hb, acc0, 0, 0, 0); acc0 = __builtin_amdgcn_mfma_f32_16x16x32_bf16(wlo[0][ks], hb, acc0, 0, 0, 0);
                acc1 = __builtin_amdgcn_mfma_f32_16x16x32_bf16(whi[1][ks], hb, acc1, 0, 0, 0); acc1 = __builtin_amdgcn_mfma_f32_16x16x32_bf16(wlo[1][ks], hb, acc1, 0, 0, 0); }
            *(LAS f32x4*)(PL + (wave * 16 + i16) * 32 + 4 * kq) = acc0; *(LAS f32x4*)(PL + (wave * 16 + i16) * 32 + 16 + 4 * kq) = acc1;
        }
        LDS_WAIT(); __builtin_amdgcn_s_barrier(); asm volatile("" ::: "memory");
        float lg = mybias;
#pragma unroll
        for (int w = 0; w < 8; ++w) lg += PL[(w * 16 + myrow) * 32 + mye];
        LG[myrow * 32 + mye] = lg;
        LDS_WAIT(); asm volatile("" ::: "memory");
        int rank = 0;
#pragma unroll
        for (int q = 0; q < 8; ++q) { const f32x4 o = *(const LAS f32x4*)(LG + myrow * 32 + 4 * q);
#pragma unroll
            for (int i = 0; i < 4; ++i) { const int e2 = 4 * q + i; rank += (o[i] > lg || (o[i] == lg && e2 < mye)) ? 1 : 0; } }
        if (rank < 4) TV[myrow * 4 + rank] = lg;
        LDS_WAIT(); asm volatile("" ::: "memory");
        const f32x4 tv = *(const LAS f32x4*)(TV + myrow * 4);
        if (rank < 4) {
            const float den = 1.0f + __expf(tv[1] - tv[0]) + __expf(tv[2] - tv[0]) + __expf(tv[3] - tv[0]);
            const int slot = (16 * T + myrow) * 4 + rank; topg[slot] = __expf(lg - tv[0]) / den;
            const unsigned lp = __hip_atomic_fetch_add(LC + mye, 1u, __ATOMIC_RELAXED, __HIP_MEMORY_SCOPE_WORKGROUP);
            if (tl < 16) AS[tl * 64 + myrow * 4 + rank] = (unsigned)mye | (lp << 8);
        }
    }
    __syncthreads();
    if (tid < NEXP) LC[32 + tid] = atomicAdd(&cnt[tid], LC[tid]);
    __syncthreads();
    for (int i = tid; i < tl * 64; i += NWAVES * 64) { const unsigned as = AS[i]; const int e = as & 255, lp = as >> 8; const int T = F.vcu + (i >> 6) * F.G;
        list[(size_t)e * NTOK + LC[32 + e] + lp] = (16 * T + ((i & 63) >> 2)) * 4 + (i & 3); }
}
__device__ __forceinline__ int moe_tables(const Frame& F) {
    __syncthreads();
    if (F.tid < NEXP) F.MISC[40 + F.tid] = __hip_atomic_load(F.ctl + CW_CNT + F.tid, __ATOMIC_RELAXED, __HIP_MEMORY_SCOPE_AGENT);
    __syncthreads();
    if (F.tid == 0) { unsigned s = 0; for (int e = 0; e < NEXP; ++e) { F.MISC[e] = s; s += (F.MISC[40 + e] + 255u) >> 8; } F.MISC[32] = s; }
    __syncthreads();
    return (int)F.MISC[32];
}
__device__ __forceinline__ void phaseJ(const Frame& F, const Args& a) {
    const unsigned char* Y2s = a.ws + WS_Y2; const bf16* X1b = (const bf16*)(a.ws + WS_X1B); const float* mod = (const float*)(a.ws + WS_MOD); const float* gpf = a.in[18]; float* out = a.out;
    const int* inv = (const int*)(a.ws + WS_TOPE); const float* topg = (const float*)(a.ws + WS_TOPG);
    const int lane = F.lane, gw = F.vcu * NWAVES + F.wave, NGW = F.G * NWAVES;
    f32x4 cgg[4]; int cb = -1;
    for (int row0 = gw * 4; row0 < NTOK; row0 += NGW * 4) {
        const int b = row0 / SEQ; const float* mb = mod + b * 6144;
        if (b != cb) { cb = b;
#pragma unroll
            for (int j = 0; j < 4; ++j) { const int c0 = (lane + 64 * j) * 4; cgg[j] = *(const f32x4*)(gpf + c0) * *(const f32x4*)(mb + GT2 + c0); } }
        int pp[4][4]; float gg[4][4];
#pragma unroll
        for (int rr = 0; rr < 4; ++rr)
#pragma unroll
            for (int k = 0; k < 4; ++k) { pp[rr][k] = __builtin_amdgcn_readfirstlane(inv[(row0 + rr) * 4 + k]); gg[rr][k] = topg[(row0 + rr) * 4 + k] * (1.0f / F8_YSCALE); }
        unsigned yy[4][4][4]; u32x2 xx[4][4];
#pragma unroll
        for (int rr = 0; rr < 4; ++rr)
#pragma unroll
            for (int j = 0; j < 4; ++j) { const int c0 = (lane + 64 * j) * 4;
#pragma unroll
                for (int k = 0; k < 4; ++k) yy[rr][j][k] = __builtin_nontemporal_load((const unsigned*)(Y2s + (size_t)pp[rr][k] * D + c0));
                xx[rr][j] = __builtin_nontemporal_load((const u32x2*)(X1b + (size_t)(row0 + rr) * D + c0)); }
#pragma unroll
        for (int rr = 0; rr < 4; ++rr) {
            f32x4 yv[4]; float ss = 0.f;
#pragma unroll
            for (int j = 0; j < 4; ++j) { f32x4 s = {0.f, 0.f, 0.f, 0.f};
#pragma unroll
                for (int k = 0; k < 4; ++k) { const f32x2 lo = __builtin_amdgcn_cvt_pk_f32_fp8((int)yy[rr][j][k], false), hi = __builtin_amdgcn_cvt_pk_f32_fp8((int)yy[rr][j][k], true);
                    s += (f32x4){lo.x, lo.y, hi.x, hi.y} * gg[rr][k]; }
                yv[j] = s; ss += (s[0] * s[0] + s[1] * s[1]) + (s[2] * s[2] + s[3] * s[3]); }
            const float rstd = rsqrtf(wsum(ss) * (1.0f / D) + EPS);
#pragma unroll
            for (int j = 0; j < 4; ++j) { const int c0 = (lane + 64 * j) * 4;
                const f32x4 x1 = {bflo(xx[rr][j].x), bfhi(xx[rr][j].x), bflo(xx[rr][j].y), bfhi(xx[rr][j].y)};
                __builtin_nontemporal_store(x1 + cgg[j] * (yv[j] * rstd), (f32x4*)(out + (size_t)(row0 + rr) * D + c0)); }
        }
    }
}

constexpr int N_PHASES = 10;
__global__ void __launch_bounds__(NWAVES * 64, 2) mega_fwd(Args args) {
    extern __shared__ __attribute__((aligned(16))) unsigned char lds_raw[];
    Frame F;
    F.lds = (LAS unsigned char*)lds_raw; F.MISC = (volatile LAS unsigned*)(F.lds + MISC_OFF);
    F.tid = threadIdx.x; F.lane = F.tid & 63; F.wave = __builtin_amdgcn_readfirstlane(F.tid >> 6);
    F.G = gridDim.x; { const int bx = blockIdx.x; F.vcu = (F.G % 8 == 0) ? (bx % 8) * (F.G / 8) + bx / 8 : bx; }
    F.ctl = (unsigned*)(args.ws + WS_CTL);
    for (int u = F.tid; u < 128; u += NWAVES * 64) F.MISC[u] = 0u;
    __syncthreads();
    const int lo = args.ph_lo, hi = args.ph_hi;
    XcdBarrier bar; bar.bar = F.ctl + CW_BAR; bar.x = 0; bar.st = F.MISC + 80;
    if (hi - lo > 1) bar = xcd_barrier_post(F.ctl + CW_BAR, F.MISC + 80);
#define IN(k) (lo <= (k) && (k) < hi)
#define SEAM(k) do { if (IN(k) && IN((k) + 1)) xcd_barrier(bar); } while (0)
    unsigned char* ws = args.ws;
    bf16 *XN = (bf16*)(ws + WS_XN), *Qb = (bf16*)(ws + WS_Q), *Kb = (bf16*)(ws + WS_K), *Vb = (bf16*)(ws + WS_V), *Ub = (bf16*)(ws + WS_U), *VG = (bf16*)(ws + WS_VG);
    bf16 *GT = (bf16*)(ws + WS_GT), *YAB = (bf16*)(ws + WS_YAB), *MRG = (bf16*)(ws + WS_MRG), *Y1 = (bf16*)(ws + WS_Y1), *ACT = (bf16*)(ws + WS_ACT), *Y2 = (bf16*)(ws + WS_Y2);

    if (IN(0)) { phaseA(F, args); } SEAM(0);
    if (IN(1)) { phaseB(F, args); } SEAM(1);
    if (IN(2)) {
        { SchedStatic S{(const char*)XN, (const char*)(ws + WS_W1T), NTOK / 256, INW / 256, F.G, (int)blockIdx.x, (size_t)256 * 1024 * 2, (size_t)256 * 1024 * 2};
          EpiG1 E{Qb, Kb, Vb, Ub, VG};
          pg8::gemm_phase<EpiG1, SchedStatic, false>(F.lds + RING_OFF, S, E, 2048, 2048, 16); }
        {
          SchedStaticG S{(const char*)(ws + WS_XN8A), (const char*)(ws + WS_WG8), NTOK / 256, 2048 / 256, F.G, (int)blockIdx.x, (size_t)256 * 1024, 1024u};
          EpiGate E{GT, args.in[15]};
          pg8::gemm_phase<EpiGate, SchedStaticG, true>(F.lds + RING_OFF, S, E, 1024, 1024, 8); }
    } SEAM(2);
    if (IN(3)) { phaseD(F, args); } SEAM(3);
    if (IN(4)) {
        SchedSplit2 S{(const char*)YAB, (const char*)(ws + WS_WBRT), NTOK / 256, 4, F.G, (int)blockIdx.x, (size_t)256 * 1024 * 2, (size_t)256 * 1024 * 2, (size_t)512 * 2};
        EpiG2 E{GT, MRG};
        pg8::gemm_phase<EpiG2, SchedSplit2, false>(F.lds + RING_OFF, S, E, 2048, 2048, 8);
    } SEAM(4);
    if (IN(5)) {
        SchedStatic S{(const char*)MRG, (const char*)(ws + WS_WOUTT), NTOK / 256, 4, F.G, (int)blockIdx.x, (size_t)256 * 1024 * 2, (size_t)256 * 1024 * 2};
        EpiPlain E{Y1};
        pg8::gemm_phase<EpiPlain, SchedStatic, false>(F.lds + RING_OFF, S, E, 2048, 2048, 16);
    } SEAM(5);
    if (IN(6)) { phaseG(F, args); } SEAM(6);
    if (IN(7)) {
        const int nrb = moe_tables(F);
        const int* list = (const int*)(ws + WS_LIST);
        {
            int* inv = (int*)(ws + WS_TOPE);
            for (int g = (int)blockIdx.x * (NWAVES * 64) + F.tid; g < NTOK * TOPK; g += F.G * NWAVES * 64) {
                int e = 0, base = 0;
#pragma unroll 1
                for (int i = 0; i < NEXP; ++i) { const int c = (int)F.MISC[40 + i]; if (g >= base + c) { base += c; e = i + 1; } else break; }
                const int pos = g - base; if (e < NEXP) inv[list[(size_t)e * NTOK + pos]] = (int)F.MISC[e] * 256 + pos; }
        }
        typedef SchedMoe<8, true> SM;
        SM S{(const char*)XN, (const char*)(ws + WS_WGUT), F.MISC, (const LAS unsigned*)(F.lds + GTAB_OFF), (int)blockIdx.x, F.G, nrb, (size_t)2048 * 1024, (size_t)256 * 1024};
        S.build(F.tid);
        { Unit u; LAS unsigned* gt = (LAS unsigned*)(F.lds + GTAB_OFF);
          for (int k = 0; k < GTAB_UNITS && S.next(k, u); ++k) { const int e = u.aux, j256 = (u.pm - (int)F.MISC[e]) * 256, ecnt = (int)F.MISC[40 + e];
              for (int r = F.tid; r < 256; r += NWAVES * 64) { const int pos = j256 + r; int tok = 0; if (pos < ecnt) tok = list[(size_t)e * NTOK + pos] >> 2; gt[k * 256 + r] = (unsigned)tok * 1024u; } } }
        __syncthreads();
        EpiAct E{args.in[22], (unsigned char*)ACT};
        pg8::gemm_phase<EpiAct, SM, true>(F.lds + RING_OFF, S, E, 1024, 1024, 8);
    } SEAM(7);
    if (IN(8)) {
        const int nrb = moe_tables(F);
        typedef SchedMoe<4, true> SM;
        SM S{(const char*)ACT, (const char*)(ws + WS_WDNT), F.MISC, (const LAS unsigned*)(F.lds + GTAB_OFF), (int)blockIdx.x, F.G, nrb, (size_t)1024 * 1024, (size_t)256 * 1024};
        S.build(F.tid);
        { Unit u; LAS unsigned* gt = (LAS unsigned*)(F.lds + GTAB_OFF);
          for (int k = 0; k < GTAB_UNITS && S.next(k, u); ++k) for (int r = F.tid; r < 256; r += NWAVES * 64) gt[k * 256 + r] = (unsigned)(u.pm * 256 + r) * 1024u; }
        __syncthreads();
        EpiDown E{args.in[24], (unsigned char*)Y2};
        pg8::gemm_phase<EpiDown, SM, true>(F.lds + RING_OFF, S, E, 1024, 1024, 8);
    } SEAM(8);
    if (IN(9)) { phaseJ(F, args); }
#undef IN
#undef SEAM
}
extern "C" void kernel_launch(void* const* d_in, const int* in_sizes, int n_in, void* d_out, int out_size, void* d_ws, size_t ws_size, hipStream_t stream) {
    if (n_in != 25 || in_sizes[0] != NTOK * D || out_size != NTOK * D || ws_size < WS_END) { fprintf(stderr, "kernel_launch: unexpected shapes (n_in %d in0 %d out %d ws %zu)\n", n_in, n_in > 0 ? in_sizes[0] : -1, out_size, ws_size); return; }
    static int grid = 0;
    if (grid == 0) {
        int dev = 0, cus = 0, per_cu = 0;
        if (hipGetDevice(&dev) != hipSuccess || hipDeviceGetAttribute(&cus, hipDeviceAttributeMultiprocessorCount, dev) != hipSuccess) { fprintf(stderr, "kernel_launch: device query failed\n"); grid = -1; return; }
        if (hipFuncSetAttribute((const void*)mega_fwd, hipFuncAttributeMaxDynamicSharedMemorySize, LDS_BYTES) != hipSuccess) { fprintf(stderr, "kernel_launch: hipFuncSetAttribute failed\n"); grid = -1; return; }
        if (hipOccupancyMaxActiveBlocksPerMultiprocessor(&per_cu, (const void*)mega_fwd, NWAVES * 64, LDS_BYTES) != hipSuccess || per_cu < 1) { fprintf(stderr, "kernel_launch: occupancy query says %d\n", per_cu); }
        (void)hipGetLastError();
        grid = cus;
    }
    if (grid < 0) return;
    if (hipMemsetAsync((unsigned char*)d_ws + WS_CTL, 0, CTL_ZERO_BYTES, stream) != hipSuccess) { fprintf(stderr, "kernel_launch: memset failed\n"); return; }
    Args a{};
    for (int i = 0; i < 25; ++i) a.in[i] = (const float*)d_in[i];
    a.out = (float*)d_out; a.ws = (unsigned char*)d_ws; a.ph_lo = 0; a.ph_hi = N_PHASES;
    hipLaunchKernelGGL(mega_fwd, dim3(grid), dim3(NWAVES * 64), LDS_BYTES, stream, a);
    if (hipPeekAtLastError() != hipSuccess) fprintf(stderr, "kernel_launch: launch failed\n");
}
```

```cpp
#include <hip/hip_runtime.h>
#include <cstdio>
#include <cstdint>

constexpr int NB = 4, SEQ = 8192, D = 1024, NTOK = NB * SEQ;
constexpr int NHEAD = 8, CHUNK = 64, NLEFT = 8, NREL = 257;
constexpr int SGB = 128;
constexpr int INW = 2560, NEXP = 32, TOPK = 4;
constexpr float EPS = 1e-6f, SWL = 7.0f, SWA = 1.702f;
constexpr float LOG2E = 1.4426950408889634f;
constexpr float QSCALE = 0.125f * LOG2E;
constexpr int SH1 = 0, SC1 = 1024, GT1 = 2048, SH2 = 3072, SC2 = 4096, GT2 = 5120;
typedef unsigned short bf16;

constexpr size_t MiB = 1u << 20;
constexpr size_t WS_CTL = 0, CTL_ZERO_BYTES = 64 * 1024;
constexpr size_t WS_MOD = 1 * MiB;
constexpr size_t WS_W1T = 2 * MiB, WS_WBRT = 12 * MiB, WS_WOUTT = 14 * MiB, WS_WRT = 16 * MiB;
constexpr size_t WS_TOPE = 17 * MiB, WS_TOPG = 18 * MiB, WS_LIST = 19 * MiB;
constexpr size_t WS_WGUT = 32 * MiB, WS_WDNT = 160 * MiB;
constexpr size_t WS_XN = 224 * MiB;
constexpr size_t WS_Q = 288 * MiB, WS_K = 320 * MiB, WS_V = 352 * MiB, WS_U = 384 * MiB, WS_VG = 416 * MiB;
constexpr size_t WS_GT = 448 * MiB;
constexpr size_t WS_YAB = 576 * MiB, WS_MRG = 640 * MiB, WS_Y1 = 704 * MiB;
constexpr size_t WS_ACT = 288 * MiB;
constexpr size_t WS_Y2 = 576 * MiB;
constexpr size_t WS_WG8 = 24 * MiB;
constexpr size_t WS_XN8A = 832 * MiB;
constexpr size_t WS_END = 960 * MiB;
constexpr int CW_CNT = 1024;

#define LAS __attribute__((address_space(3)))
#define GAS __attribute__((address_space(1)))
typedef short bf16x8 __attribute__((ext_vector_type(8)));
typedef short s16x4 __attribute__((ext_vector_type(4)));
typedef float f32x4 __attribute__((ext_vector_type(4)));
typedef float f32x2 __attribute__((ext_vector_type(2)));
typedef float f32x16 __attribute__((ext_vector_type(16)));
typedef unsigned u32x4 __attribute__((ext_vector_type(4)));
typedef unsigned u32x2 __attribute__((ext_vector_type(2)));
typedef __bf16 bf16x2_t __attribute__((ext_vector_type(2)));
constexpr int NWAVES = 8;
constexpr int TRASH_SLOT = NTOK * 4;

__device__ __forceinline__ unsigned cvtpk(float lo, float hi) { f32x2 v = {lo, hi}; bf16x2_t b = __builtin_convertvector(v, bf16x2_t); return __builtin_bit_cast(unsigned, b); }
__device__ __forceinline__ float wsum(float v) {
    v += __builtin_bit_cast(float, __builtin_amdgcn_update_dpp(0, __builtin_bit_cast(int, v), 0xB1, 0xF, 0xF, true));
    v += __builtin_bit_cast(float, __builtin_amdgcn_update_dpp(0, __builtin_bit_cast(int, v), 0x4E, 0xF, 0xF, true));
    v += __builtin_bit_cast(float, __builtin_amdgcn_update_dpp(0, __builtin_bit_cast(int, v), 0x124, 0xF, 0xF, true));
    v += __builtin_bit_cast(float, __builtin_amdgcn_update_dpp(0, __builtin_bit_cast(int, v), 0x128, 0xF, 0xF, true));
    const int iv = __builtin_bit_cast(int, v);
    const float s0 = __builtin_bit_cast(float, __builtin_amdgcn_readlane(iv, 0)), s1 = __builtin_bit_cast(float, __builtin_amdgcn_readlane(iv, 16));
    const float s2 = __builtin_bit_cast(float, __builtin_amdgcn_readlane(iv, 32)), s3 = __builtin_bit_cast(float, __builtin_amdgcn_readlane(iv, 48));
    return (s0 + s1) + (s2 + s3);
}
__device__ __forceinline__ float clamp8(float v) { return fminf(fmaxf(v, -448.0f), 448.0f); }
__device__ __forceinline__ unsigned pk_fp8x4(float a, float b, float c, float d) {
    int w = 0; w = __builtin_amdgcn_cvt_pk_fp8_f32(clamp8(a), clamp8(b), w, false); w = __builtin_amdgcn_cvt_pk_fp8_f32(clamp8(c), clamp8(d), w, true); return (unsigned)w; }
__device__ __forceinline__ unsigned pk_fp8x4_nc(float a, float b, float c, float d) {
    int w = 0; w = __builtin_amdgcn_cvt_pk_fp8_f32(a, b, w, false); w = __builtin_amdgcn_cvt_pk_fp8_f32(c, d, w, true); return (unsigned)w; }
constexpr float F8_YSCALE = 16.0f;
constexpr size_t WS_X1B = 768 * MiB;
constexpr float F8_WSCALE = 64.0f, F8_ASCALE = 4.0f, F8_DESCALE = 1.0f / (64.0f * 4.0f);
__device__ __forceinline__ float bflo(unsigned w) { return __uint_as_float(w << 16); }
__device__ __forceinline__ float bfhi(unsigned w) { return __uint_as_float(w & 0xffff0000u); }
__device__ __forceinline__ float fast_sigmoid(float x) { return __builtin_amdgcn_rcpf(1.0f + __builtin_amdgcn_exp2f(-LOG2E * x)); }
__device__ __forceinline__ f32x2 sigmoid_pk(f32x2 v) { const f32x2 t = v * (-LOG2E); f32x2 e; e.x = __builtin_amdgcn_exp2f(t.x); e.y = __builtin_amdgcn_exp2f(t.y); const f32x2 d = e + 1.0f; f32x2 r; r.x = __builtin_amdgcn_rcpf(d.x); r.y = __builtin_amdgcn_rcpf(d.y); return r; }
__device__ __forceinline__ f32x2 gelu_pk(f32x2 v) {
    const f32x2 av = __builtin_elementwise_abs(v), d = av * 0.2316418882f + 1.0f;
    f32x2 t; t.x = __builtin_amdgcn_rcpf(d.x); t.y = __builtin_amdgcn_rcpf(d.y);
    f32x2 q = t * 0.5307027145f + (-0.7265760135f); q = q * t + 0.7107068705f; q = q * t + (-0.142248368f); q = q * t + 0.127414796f; q = q * t;
    const f32x2 s = (v * v) * (-0.72134752044f);
    f32x2 e; e.x = __builtin_amdgcn_exp2f(s.x); e.y = __builtin_amdgcn_exp2f(s.y);
    const f32x2 m = v * (q * e), r = v - m;
    f32x2 o; o.x = v.x < 0.f ? m.x : r.x; o.y = v.y < 0.f ? m.y : r.y; return o;
}

constexpr int RING_OFF = 0, RING_BYTES = 131072;
constexpr int GTAB_OFF = RING_BYTES, GTAB_UNITS = 20, GTAB_BYTES = GTAB_UNITS * 256 * 4;
constexpr int MISC_OFF = GTAB_OFF + GTAB_BYTES;
constexpr int LDS_BYTES = MISC_OFF + 512;
static_assert(LDS_BYTES <= 160 * 1024, "LDS map");

#define XB_TMO      128
#define XB_XCNT(j)  (256  + 64 * (j))
#define XB_XSUB(j)  (1280 + 64 * (j))
#define XB_XGEN(j)  (2304 + 64 * (j))
#define XB_TOP      3328
#define XB_TOPGEN   3392
#define XCD_BAR_WORDS 3456
#define XB_SPIN_CAP (1u << 18)
__device__ __forceinline__ unsigned xb_ld(unsigned* p)              { return __hip_atomic_load(p, __ATOMIC_RELAXED, __HIP_MEMORY_SCOPE_AGENT); }
__device__ __forceinline__ unsigned xb_add(unsigned* p, unsigned v) { return __hip_atomic_fetch_add(p, v, __ATOMIC_RELAXED, __HIP_MEMORY_SCOPE_AGENT); }
__device__ __forceinline__ unsigned xb_xcc_id() { return (unsigned)__builtin_amdgcn_s_getreg((3 << 11) | 20) & 0xFu; }
#define XB_SPIN(cond, bar) do { unsigned _sp = 0; while (cond) { __builtin_amdgcn_s_sleep(1); \
    if ((++_sp & 255u) == 0u) { if (xb_ld(&(bar)[XB_TMO])) break; if (_sp > XB_SPIN_CAP) { atomicAdd(&(bar)[XB_TMO], 1u); break; } } } } while (0)
struct XcdBarrier { unsigned* bar; unsigned x; volatile LAS unsigned* st; };
__device__ __forceinline__ XcdBarrier xcd_barrier_post(unsigned* bar, volatile LAS unsigned* st) {
    XcdBarrier b; b.bar = bar; b.x = xb_xcc_id(); b.st = st;
    if (threadIdx.x == 0) (void)xb_add(&bar[XB_XCNT(b.x)], 1u);
    return b;
}
__device__ __forceinline__ void xcd_barrier_complete(unsigned* bar, unsigned x, unsigned& nloc, unsigned& nx) {
    const unsigned G = gridDim.x * gridDim.y * gridDim.z;
    unsigned sum, cnt, mine, sp = 0u;
    for (;;) {
        sum = 0u; cnt = 0u; mine = 0u;
#pragma unroll
        for (unsigned j = 0; j < 16; ++j) { const unsigned c = xb_ld(&bar[XB_XCNT(j)]); sum += c; cnt += (c > 0u) ? 1u : 0u; mine = (j == x) ? c : mine; }
        if (sum == G) break;
        __builtin_amdgcn_s_sleep(1);
        if ((++sp & 255u) == 0u) { if (xb_ld(&bar[XB_TMO])) break; if (sp > XB_SPIN_CAP) { atomicAdd(&bar[XB_TMO], 1u); break; } }
    }
    nloc = mine > 0u ? mine : 1u; nx = cnt > 0u ? cnt : 1u;
}
__device__ __forceinline__ void xcd_barrier(const XcdBarrier& b) {
    asm volatile("s_waitcnt vmcnt(0)" ::: "memory");
    __syncthreads();
    if (threadIdx.x == 0) {
        unsigned* bar = b.bar;
        __builtin_amdgcn_s_waitcnt(0);
        unsigned nloc = b.st[0], nx = b.st[1];
        if (nloc == 0u) { xcd_barrier_complete(bar, b.x, nloc, nx); b.st[0] = nloc; b.st[1] = nx; }
        const unsigned old = xb_add(&bar[XB_XSUB(b.x)], 1u);
        const unsigned gen = old / nloc;
        if (old + 1u == (gen + 1u) * nloc) {
            __builtin_amdgcn_fence(__ATOMIC_RELEASE, "agent");
            asm volatile("s_waitcnt vmcnt(0)" ::: "memory");
            const unsigned og = xb_add(&bar[XB_TOP], 1u);
            const unsigned tg = og / nx;
            if (og + 1u == (tg + 1u) * nx) xb_add(&bar[XB_TOPGEN], 1u);
            else XB_SPIN(xb_ld(&bar[XB_TOPGEN]) == tg, bar);
            __builtin_amdgcn_fence(__ATOMIC_ACQUIRE, "agent");
            xb_add(&bar[XB_XGEN(b.x)], 1u);
            asm volatile("s_waitcnt vmcnt(0)" ::: "memory");
        } else {
            XB_SPIN(xb_ld(&bar[XB_XGEN(b.x)]) == gen, bar);
            __builtin_amdgcn_fence(__ATOMIC_ACQUIRE, "agent");
            asm volatile("s_waitcnt vmcnt(0)" ::: "memory");
        }
    }
    __syncthreads();
}
constexpr int CW_BAR = 4096;

namespace pg8 {
constexpr int BM = 256, BK = 64, HALF = 128, HTB = HALF * BK * 2, STAGE_BYTES = 8 * HTB, NXCD = 8, WGM = 8;
__host__ __device__ __forceinline__ int lds_byte(int r, int c) { return r * 128 + ((((c >> 3) ^ (r >> 1)) & 7) << 4); }
__host__ __device__ __forceinline__ void stage_rc(int b, int& R, int& C) { R = b >> 7; C = ((((b >> 4) ^ (R >> 1)) & 7) << 3); }
__host__ __device__ __forceinline__ int perm32(int rho) { const int n = rho >> 4, i = rho & 15; return 8 * (i >> 2) + 4 * n + (i & 3); }
struct Unit { int pm, pn, aux; };
typedef int v4i_t __attribute__((ext_vector_type(4)));
typedef int v8i_t __attribute__((ext_vector_type(8)));

__device__ __forceinline__ bool static_unit(int i, int G, int c, int nM, int nN, int& pm, int& pn) {
    const int nwg = nM * nN; const long L = (long)i * G + c; if (L >= nwg) return false;
    int wgid = (int)L; { const int q = nwg / NXCD, r = nwg % NXCD, xcd = wgid % NXCD, off = wgid / NXCD; wgid = (xcd < r ? xcd * (q + 1) : r * (q + 1) + (xcd - r) * q) + off; }
    const int nig = WGM * nN, gid = wgid / nig, fm = gid * WGM, gsz = (nM - fm) < WGM ? (nM - fm) : WGM;
    pm = fm + ((wgid % nig) % gsz); pn = (wgid % nig) / gsz; return true;
}

template <class Epi, class Sched, bool FP8>
__device__ __forceinline__ void gemm_phase(LAS unsigned char* lds, const Sched& S, const Epi& E, const int lda, const int ldb, const int nt) {
    const int tid = threadIdx.x, wid = __builtin_amdgcn_readfirstlane(tid >> 6), lane = tid & 63, wr = wid >> 2, wc = wid & 3, fr = lane & 15, fq = lane >> 4;
    int Rr[2], Cc[2]; unsigned voffB[2];
#pragma unroll
    for (int i = 0; i < 2; ++i) { stage_rc(tid * 16 + i * 8192, Rr[i], Cc[i]); const int Rb = (Rr[i] & ~31) + perm32(Rr[i] & 31); voffB[i] = (unsigned)(Rb * ldb + Cc[i] * 2); }
    const size_t kstep = (size_t)(BK * 2);
    const size_t hstepB = (size_t)HALF * ldb;
    const size_t hstepA = Sched::GATHER ? (size_t)0 : (size_t)HALF * lda;
    const unsigned ldsw = (unsigned)wid * 1024u;
    const int aoff = lds_byte(wr * 64 + fr, fq * 8), boff = lds_byte(wc * 32 + fr, fq * 8);
#define PG8_SA(b, h) (((b) * 2 + (h)) * HTB)
#define PG8_SB(b, h) ((4 + (b) * 2 + (h)) * HTB)
#define PG8_STAGE(bufoff, gbase, voff) do { _Pragma("unroll") for (int _i = 0; _i < 2; ++_i) \
        __builtin_amdgcn_global_load_lds((const unsigned*)((const char*)(gbase) + (voff)[_i]), (LAS unsigned*)(lds + (bufoff) + ldsw + _i * 8192), 16, 0, 0); } while (0)
#define PG8_LDA(dst, b, h) do { _Pragma("unroll") for (int m = 0; m < 4; ++m) _Pragma("unroll") for (int k = 0; k < 2; ++k) dst[m][k] = *(const LAS bf16x8*)(lds + PG8_SA(b, h) + (aoff ^ (k * 64)) + m * 2048); } while (0)
#define PG8_LDB(dst, b, h) do { _Pragma("unroll") for (int n = 0; n < 2; ++n) _Pragma("unroll") for (int k = 0; k < 2; ++k) dst[n][k] = *(const LAS bf16x8*)(lds + PG8_SB(b, h) + (boff ^ (k * 64)) + n * 2048); } while (0)
#define PG8_CAT(x) __builtin_shufflevector(__builtin_bit_cast(v4i_t, (x)[0]), __builtin_bit_cast(v4i_t, (x)[1]), 0, 1, 2, 3, 4, 5, 6, 7)
#define PG8_MMA(ai, bj, At, Bt) do { __builtin_amdgcn_s_setprio(1); if constexpr (FP8) { _Pragma("unroll") for (int m = 0; m < 4; ++m) _Pragma("unroll") for (int n = 0; n < 2; ++n) \
        acc[ai][bj][m][n] = __builtin_amdgcn_mfma_scale_f32_16x16x128_f8f6f4(PG8_CAT(Bt[n]), PG8_CAT(At[m]), acc[ai][bj][m][n], 0, 0, 0, 0, 0, 0); }   \
    else { _Pragma("unroll") for (int m = 0; m < 4; ++m) _Pragma("unroll") for (int n = 0; n < 2; ++n) _Pragma("unroll") for (int k = 0; k < 2; ++k) \
        acc[ai][bj][m][n] = __builtin_amdgcn_mfma_f32_16x16x32_bf16(Bt[n][k], At[m][k], acc[ai][bj][m][n], 0, 0, 0); } __builtin_amdgcn_s_setprio(0); } while (0)
#define PG8_WAIT_V(n) asm volatile("s_waitcnt vmcnt(" #n ")" ::: "memory")
#define PG8_WAIT_L(n) asm volatile("s_waitcnt lgkmcnt(" #n ")" ::: "memory")
#define PG8_BAR __builtin_amdgcn_s_barrier()
#define PG8_SCHED __builtin_amdgcn_sched_barrier(0)
    Unit cur, nxt; int ui = 0;
    if (!S.next(0, cur)) return;
    f32x4 acc[2][2][4][2];
#pragma unroll
    for (int a = 0; a < 2; ++a)
#pragma unroll
        for (int b = 0; b < 2; ++b)
#pragma unroll
            for (int m = 0; m < 4; ++m)
#pragma unroll
                for (int n = 0; n < 2; ++n) acc[a][b][m][n] = (f32x4){0.f, 0.f, 0.f, 0.f};
    bf16x8 At[4][2], B0[2][2], B1[2][2];
    unsigned oA[2][2];
#pragma unroll
    for (int h = 0; h < 2; ++h)
#pragma unroll
        for (int i = 0; i < 2; ++i) oA[h][i] = Sched::GATHER ? (S.goff(0, h * HALF + Rr[i]) + (unsigned)Cc[i] * 2u) : (unsigned)(Rr[i] * lda + Cc[i] * 2);
    const char* cA = S.aptr(cur); const char* cB = S.bptr(cur);
    PG8_STAGE(PG8_SB(0, 0), cB, voffB); PG8_STAGE(PG8_SB(0, 1), cB + hstepB, voffB); PG8_STAGE(PG8_SA(0, 0), cA, oA[0]); PG8_STAGE(PG8_SA(0, 1), cA + hstepA, oA[1]);
    if (wr == 1) PG8_BAR;
    PG8_WAIT_V(2); PG8_BAR;
    PG8_STAGE(PG8_SB(1, 0), cB + kstep, voffB); PG8_STAGE(PG8_SA(1, 0), cA + kstep, oA[0]); PG8_STAGE(PG8_SB(1, 1), cB + hstepB + kstep, voffB);
    PG8_WAIT_V(6); PG8_BAR;
    for (;;) {
        const bool has_next = S.next(ui + 1, nxt);
        const char* nA = has_next ? S.aptr(nxt) : cA; const char* nB = has_next ? S.bptr(nxt) : cB;
#pragma clang loop unroll(disable)
        for (int t = 0; t < nt; t += 2) {
            const bool last = (t == nt - 2);
            const char* a1 = cA + (size_t)(t + 1) * kstep;
            const char* a2 = last ? nA : cA + (size_t)(t + 2) * kstep; const char* b2 = last ? nB : cB + (size_t)(t + 2) * kstep;
            const char* a3 = a2 + kstep; const char* b3 = b2 + kstep;
            PG8_LDB(B0, 0, 0); PG8_LDB(B1, 0, 1); PG8_SCHED; PG8_LDA(At, 0, 0); PG8_STAGE(PG8_SA(1, 1), a1 + hstepA, oA[1]);
            if constexpr (Sched::GATHER) { if (last && has_next) {
#pragma unroll
                for (int h = 0; h < 2; ++h)
#pragma unroll
                    for (int i = 0; i < 2; ++i) oA[h][i] = S.goff(ui + 1, h * HALF + Rr[i]) + (unsigned)Cc[i] * 2u; } }
            PG8_WAIT_V(8); PG8_WAIT_L(0); PG8_BAR; PG8_MMA(0, 0, At, B0); PG8_MMA(0, 1, At, B1); PG8_BAR; PG8_SCHED;
            PG8_LDA(At, 0, 1); PG8_STAGE(PG8_SB(0, 0), b2, voffB); PG8_STAGE(PG8_SB(0, 1), b2 + hstepB, voffB); PG8_STAGE(PG8_SA(0, 0), a2, oA[0]);
            PG8_WAIT_V(8); PG8_WAIT_L(0); PG8_BAR; PG8_MMA(1, 0, At, B0); PG8_MMA(1, 1, At, B1); PG8_BAR; PG8_SCHED;
            PG8_LDB(B0, 1, 0); PG8_LDB(B1, 1, 1); PG8_SCHED; PG8_LDA(At, 1, 0); PG8_STAGE(PG8_SA(0, 1), a2 + hstepA, oA[1]);
            PG8_WAIT_V(8); PG8_WAIT_L(0); PG8_BAR; PG8_MMA(0, 0, At, B0); PG8_MMA(0, 1, At, B1); PG8_BAR; PG8_SCHED;
            PG8_LDA(At, 1, 1); PG8_STAGE(PG8_SB(1, 0), b3, voffB); PG8_STAGE(PG8_SB(1, 1), b3 + hstepB, voffB); PG8_STAGE(PG8_SA(1, 0), a3, oA[0]);
            PG8_WAIT_V(8); PG8_WAIT_L(0); PG8_BAR; PG8_MMA(1, 0, At, B0); PG8_MMA(1, 1, At, B1); PG8_BAR; PG8_SCHED;
        }
        if (wr == 0) PG8_BAR;
        bool keep = false;
        {
            int tz = threadIdx.x; asm volatile("" : "+v"(tz)); const int ewid = tz >> 6, el = tz & 63, ewr = ewid >> 2, ewc = ewid & 3, efr = el & 15, efq = el >> 4;
            if constexpr (Sched::HAS_MID) { if (S.is_mid(cur)) { E.mid(acc, cur, ewr, ewc, efr, efq); keep = true; } }
            if (!keep) E(acc, cur, ewr, ewc, efr, efq);
        }
        if (!has_next) break;
        if (!keep) {
#pragma unroll
            for (int a = 0; a < 2; ++a)
#pragma unroll
                for (int b = 0; b < 2; ++b)
#pragma unroll
                    for (int m = 0; m < 4; ++m)
#pragma unroll
                        for (int n = 0; n < 2; ++n) acc[a][b][m][n] = (f32x4){0.f, 0.f, 0.f, 0.f};
        }
        cur = nxt; cA = nA; cB = nB; ++ui;
        if (wr == 1) PG8_BAR;
    }
    PG8_WAIT_V(0);
    PG8_BAR;
#undef PG8_SA
#undef PG8_SB
#undef PG8_STAGE
#undef PG8_LDA
#undef PG8_LDB
#undef PG8_MMA
#undef PG8_CAT
#undef PG8_WAIT_V
#undef PG8_WAIT_L
#undef PG8_BAR
#undef PG8_SCHED
}
}
using pg8::Unit;

struct Args { const float* in[25]; float* out; unsigned char* ws; int ph_lo, ph_hi, pad0, pad1; };
static_assert(sizeof(Args) == 27 * 8 + 16, "Args has no padding");
struct Frame {
    LAS unsigned char* lds; volatile LAS unsigned* MISC; unsigned* ctl;
    int tid, lane, wave, vcu, G;
};
#define LDS_WAIT() asm volatile("s_waitcnt lgkmcnt(0)" ::: "memory")
#define VM_WAIT() asm volatile("s_waitcnt vmcnt(0)" ::: "memory")

struct SchedStatic {
    static constexpr bool GATHER = false, HAS_MID = false;
    const char* A; const char* B; int nM, nN, G, c; size_t astep, bstep;
    __device__ __forceinline__ bool next(int i, Unit& u) const { u.aux = 0; return pg8::static_unit(i, G, c, nM, nN, u.pm, u.pn); }
    __device__ __forceinline__ const char* aptr(const Unit& u) const { return A + (size_t)u.pm * astep; }
    __device__ __forceinline__ const char* bptr(const Unit& u) const { return B + (size_t)u.pn * bstep; }
    __device__ __forceinline__ bool is_mid(const Unit&) const { return false; }
    __device__ __forceinline__ unsigned goff(int, int) const { return 0u; }
};
struct SchedStaticG {
    static constexpr bool GATHER = true, HAS_MID = false;
    const char* A; const char* B; int nM, nN, G, c; size_t bstep; unsigned lda;
    __device__ __forceinline__ bool next(int i, Unit& u) const { u.aux = 0; return pg8::static_unit(i, G, c, nM, nN, u.pm, u.pn); }
    __device__ __forceinline__ const char* aptr(const Unit&) const { return A; }
    __device__ __forceinline__ const char* bptr(const Unit& u) const { return B + (size_t)u.pn * bstep; }
    __device__ __forceinline__ bool is_mid(const Unit&) const { return false; }
    __device__ __forceinline__ unsigned goff(int ui, int row) const { int pm = 0, pn = 0; pg8::static_unit(ui, G, c, nM, nN, pm, pn); return (unsigned)(pm * 256 + row) * lda; }
};
struct SchedSplit2 {
    static constexpr bool GATHER = false, HAS_MID = true;
    const char* A; const char* B; int nM, nN, G, c; size_t astep, bstep, khalf;
    __device__ __forceinline__ bool next(int i, Unit& u) const { u.aux = i & 1; return pg8::static_unit(i >> 1, G, c, nM, nN, u.pm, u.pn); }
    __device__ __forceinline__ const char* aptr(const Unit& u) const { return A + (size_t)u.pm * astep + (size_t)u.aux * khalf; }
    __device__ __forceinline__ const char* bptr(const Unit& u) const { return B + (size_t)u.pn * bstep + (size_t)u.aux * khalf; }
    __device__ __forceinline__ bool is_mid(const Unit& u) const { return u.aux == 0; }
    __device__ __forceinline__ unsigned goff(int, int) const { return 0u; }
};
__device__ __forceinline__ int moe_find_e(volatile LAS unsigned* MISC, int rb) { int e = 0;
#pragma unroll 1
    for (int i = 1; i < NEXP; ++i) e += ((int)MISC[i] <= rb) ? 1 : 0;
    return e; }
template <int NPN, bool GATH>
struct SchedMoe {
    static constexpr bool GATHER = GATH, HAS_MID = false;
    static constexpr int RPX = 32 / NPN;
    static constexpr int UT0 = 96, UTN = 24;
    const char* A; const char* B; volatile LAS unsigned* MISC; const LAS unsigned* gtab; int c, G, nrb; size_t bstep_e, bstep_n;
    __device__ __forceinline__ bool slow_next(int i, Unit& u) const {
        int rb, pn;
        if (G == 256) { const int x = c & 7, j = c >> 3; rb = (8 * i + x) * RPX + j / NPN; pn = j % NPN; }
        else { const long L = (long)i * G + c; rb = (int)(L / NPN); pn = (int)(L % NPN); }
        if (rb >= nrb) return false;
        u.pm = rb; u.pn = pn; u.aux = moe_find_e(MISC, rb); return true;
    }
    __device__ __forceinline__ void build(int tid) const {
        if (tid < UTN) { Unit u; const bool ok = slow_next(tid, u); MISC[UT0 + tid] = ok ? (0x80000000u | ((unsigned)u.aux << 16) | ((unsigned)u.pn << 12) | (unsigned)u.pm) : 0u; }
        __syncthreads();
    }
    __device__ __forceinline__ bool next(int i, Unit& u) const {
        if (i >= UTN) return false;
        const unsigned w = MISC[UT0 + i]; if (!(w >> 31)) return false;
        u.pm = (int)(w & 0xfffu); u.pn = (int)((w >> 12) & 0xfu); u.aux = (int)((w >> 16) & 0xffu); return true;
    }
    __device__ __forceinline__ const char* aptr(const Unit& u) const { return GATH ? A : A + (size_t)u.pm * (256 * 1024); }
    __device__ __forceinline__ const char* bptr(const Unit& u) const { return B + (size_t)u.aux * bstep_e + (size_t)u.pn * bstep_n; }
    __device__ __forceinline__ bool is_mid(const Unit&) const { return false; }
    __device__ __forceinline__ unsigned goff(int ui, int row) const { return gtab[ui * 256 + row]; }
};

#define EPI_ARGS f32x4 (&acc)[2][2][4][2], const Unit& u, int wr, int wc, int fr, int fq
__device__ __forceinline__ u32x4 pair16(u32x2 x, u32x2 y) {
    const auto rx = __builtin_amdgcn_permlane16_swap(x.x, y.x, false, false); const auto ry = __builtin_amdgcn_permlane16_swap(x.y, y.y, false, false);
    return (u32x4){rx[0], ry[0], rx[1], ry[1]};
}
struct EpiG1 {
    bf16 *Q, *K, *V, *U, *VG;
    __device__ __forceinline__ void mid(EPI_ARGS) const {}
    __device__ __forceinline__ void operator()(EPI_ARGS) const {
        const int pn = u.pn; const int row0 = u.pm * 256 + wr * 64 + fr;
        if (pn < 6) {
            const int t = pn >> 1; bf16* base = Q + (size_t)t * ((WS_K - WS_Q) / 2); const float sc = (t == 0) ? QSCALE : 1.0f;    const int col0 = (pn & 1) * 256 + wc * 32 + 8 * fq;
#pragma unroll
            for (int ai = 0; ai < 2; ++ai)
#pragma unroll
                for (int m = 0; m < 4; ++m) { bf16* rowp = base + (size_t)(row0 + ai * 128 + m * 16) * 512 + col0;
#pragma unroll
                    for (int bj = 0; bj < 2; ++bj) { const f32x4 v0 = acc[ai][bj][m][0] * sc, v1 = acc[ai][bj][m][1] * sc;
                        u32x4 w; w.x = cvtpk(v0[0], v0[1]); w.y = cvtpk(v0[2], v0[3]); w.z = cvtpk(v1[0], v1[1]); w.w = cvtpk(v1[2], v1[3]); *(u32x4*)(rowp + bj * 128) = w; } }
        } else {
            bf16* base = Q + (size_t)(pn >> 1) * ((WS_K - WS_Q) / 2); const int col0 = (pn & 1) * 256 + wc * 32 + 8 * fq;
#pragma unroll
            for (int ai = 0; ai < 2; ++ai)
#pragma unroll
                for (int m = 0; m < 4; ++m) { bf16* rowp = base + (size_t)(row0 + ai * 128 + m * 16) * 512 + col0;
#pragma unroll
                    for (int bj = 0; bj < 2; ++bj) { const f32x4 v0 = acc[ai][bj][m][0], v1 = acc[ai][bj][m][1];
                        const f32x2 a = gelu_pk((f32x2){v0[0], v0[1]}), b = gelu_pk((f32x2){v0[2], v0[3]}), c = gelu_pk((f32x2){v1[0], v1[1]}), d = gelu_pk((f32x2){v1[2], v1[3]});
                        u32x4 w; w.x = cvtpk(a.x, a.y); w.y = cvtpk(b.x, b.y); w.z = cvtpk(c.x, c.y); w.w = cvtpk(d.x, d.y); *(u32x4*)(rowp + bj * 128) = w; } }
        }
    }
};
struct EpiGate {
    bf16* GT; const float* bgate;
    __device__ __forceinline__ void mid(EPI_ARGS) const {}
    __device__ __forceinline__ void operator()(EPI_ARGS) const {
        const int row0 = u.pm * 256 + wr * 64 + fr;
        {
            const int col0 = u.pn * 128 + wc * 32 + 8 * fq;
            const f32x4 ba0 = *(const f32x4*)(bgate + col0), ba1 = *(const f32x4*)(bgate + col0 + 4), bb0 = *(const f32x4*)(bgate + 1024 + col0), bb1 = *(const f32x4*)(bgate + 1024 + col0 + 4);
#pragma unroll
            for (int ai = 0; ai < 2; ++ai)
#pragma unroll
                for (int m = 0; m < 4; ++m) { bf16* rowp = GT + (size_t)(row0 + ai * 128 + m * 16) * 2048 + col0;
                    const f32x4 a0 = acc[ai][0][m][0] * F8_DESCALE + ba0, a1 = acc[ai][0][m][1] * F8_DESCALE + ba1, b0 = acc[ai][1][m][0] * F8_DESCALE + bb0, b1 = acc[ai][1][m][1] * F8_DESCALE + bb1;
                    f32x4 ea0, ea1, eb0, eb1;
#pragma unroll
                    for (int i = 0; i < 4; ++i) { ea0[i] = __builtin_amdgcn_exp2f(-LOG2E * a0[i]); ea1[i] = __builtin_amdgcn_exp2f(-LOG2E * a1[i]); eb0[i] = fminf(__builtin_amdgcn_exp2f(-LOG2E * b0[i]), 1e18f); eb1[i] = fminf(__builtin_amdgcn_exp2f(-LOG2E * b1[i]), 1e18f); }
                    f32x4 gb0, gb1, r0, r1;
#pragma unroll
                    for (int i = 0; i < 4; ++i) { gb0[i] = __builtin_amdgcn_rcpf(1.0f + eb0[i]); gb1[i] = __builtin_amdgcn_rcpf(1.0f + eb1[i]); r0[i] = (1.0f + eb0[i]) * __builtin_amdgcn_rcpf(1.0f + ea0[i]); r1[i] = (1.0f + eb1[i]) * __builtin_amdgcn_rcpf(1.0f + ea1[i]); }
                    u32x4 wr, wb; wr.x = cvtpk(r0[0], r0[1]); wr.y = cvtpk(r0[2], r0[3]); wr.z = cvtpk(r1[0], r1[1]); wr.w = cvtpk(r1[2], r1[3]);
                    wb.x = cvtpk(gb0[0], gb0[1]); wb.y = cvtpk(gb0[2], gb0[3]); wb.z = cvtpk(gb1[0], gb1[1]); wb.w = cvtpk(gb1[2], gb1[3]);
                    __builtin_nontemporal_store(wr, (u32x4*)rowp); __builtin_nontemporal_store(wb, (u32x4*)(rowp + 1024)); }
        }
    }
};
struct EpiG2 {
    const bf16* GT; bf16* MRG;
    __device__ __forceinline__ void mid(EPI_ARGS) const {
        const int row0 = u.pm * 256 + wr * 64 + fr, col0 = u.pn * 256 + wc * 32 + 8 * fq;
#pragma unroll
        for (int ai = 0; ai < 2; ++ai)
#pragma unroll
            for (int m = 0; m < 4; ++m) { const bf16* gp = GT + (size_t)(row0 + ai * 128 + m * 16) * 2048 + col0;
#pragma unroll
                for (int bj = 0; bj < 2; ++bj) { const u32x4 rr = __builtin_nontemporal_load((const u32x4*)(gp + bj * 128));
                    const f32x4 r0 = {bflo(rr.x), bfhi(rr.x), bflo(rr.y), bfhi(rr.y)}, r1 = {bflo(rr.z), bfhi(rr.z), bflo(rr.w), bfhi(rr.w)};
                    acc[ai][bj][m][0] *= r0; acc[ai][bj][m][1] *= r1; } }
    }
    __device__ __forceinline__ void operator()(EPI_ARGS) const {
        const int row0 = u.pm * 256 + wr * 64 + fr, col0 = u.pn * 256 + wc * 32 + 8 * fq;
#pragma unroll
        for (int ai = 0; ai < 2; ++ai)
#pragma unroll
            for (int m = 0; m < 4; ++m) { const size_t r = (size_t)(row0 + ai * 128 + m * 16); const bf16* gp = GT + r * 2048 + 1024 + col0; bf16* op = MRG + r * 1024 + col0;
#pragma unroll
                for (int bj = 0; bj < 2; ++bj) { const u32x4 gb = __builtin_nontemporal_load((const u32x4*)(gp + bj * 128)); const f32x4 v0 = acc[ai][bj][m][0], v1 = acc[ai][bj][m][1];
                    u32x4 w; w.x = cvtpk(v0[0] * bflo(gb.x), v0[1] * bfhi(gb.x)); w.y = cvtpk(v0[2] * bflo(gb.y), v0[3] * bfhi(gb.y));
                    w.z = cvtpk(v1[0] * bflo(gb.z), v1[1] * bfhi(gb.z)); w.w = cvtpk(v1[2] * bflo(gb.w), v1[3] * bfhi(gb.w)); *(u32x4*)(op + bj * 128) = w; } }
    }
};
struct EpiPlain {
    bf16* O;
    __device__ __forceinline__ void mid(EPI_ARGS) const {}
    __device__ __forceinline__ void operator()(EPI_ARGS) const {
        const int row0 = u.pm * 256 + wr * 64 + fr, col0 = u.pn * 256 + wc * 32 + 8 * fq;
#pragma unroll
        for (int ai = 0; ai < 2; ++ai)
#pragma unroll
            for (int m = 0; m < 4; ++m) { bf16* op = O + (size_t)(row0 + ai * 128 + m * 16) * 1024 + col0;
#pragma unroll
                for (int bj = 0; bj < 2; ++bj) { const f32x4 v0 = acc[ai][bj][m][0], v1 = acc[ai][bj][m][1];
                    u32x4 w; w.x = cvtpk(v0[0], v0[1]); w.y = cvtpk(v0[2], v0[3]); w.z = cvtpk(v1[0], v1[1]); w.w = cvtpk(v1[2], v1[3]); *(u32x4*)(op + bj * 128) = w; } }
    }
};
struct EpiAct {
    const float* bgu; unsigned char* ACT8;
    __device__ __forceinline__ void mid(EPI_ARGS) const {}
    __device__ __forceinline__ f32x2 act2(f32x2 g, f32x2 l) const {
        f32x2 xg, xl; xg.x = fminf(g.x, SWL); xg.y = fminf(g.y, SWL); xl.x = fminf(fmaxf(l.x, -SWL), SWL); xl.y = fminf(fmaxf(l.y, -SWL), SWL);
        const f32x2 t = xg * (-SWA * LOG2E); f32x2 e; e.x = __builtin_amdgcn_exp2f(t.x); e.y = __builtin_amdgcn_exp2f(t.y);
        const f32x2 d = e + 1.0f; f32x2 r; r.x = __builtin_amdgcn_rcpf(d.x); r.y = __builtin_amdgcn_rcpf(d.y);
        return (xg * r) * (xl * F8_ASCALE + F8_ASCALE);
    }
    __device__ __forceinline__ void operator()(EPI_ARGS) const {
        const int e = u.aux; const int row0 = u.pm * 256 + wr * 64 + fr, col0 = u.pn * 128 + wc * 32 + 8 * fq;
        const float* bp = bgu + (size_t)e * 2048 + col0;
        const f32x4 bg0 = *(const f32x4*)(bp), bg1 = *(const f32x4*)(bp + 4), bl0 = *(const f32x4*)(bp + 1024), bl1 = *(const f32x4*)(bp + 1028);
#pragma unroll
        for (int ai = 0; ai < 2; ++ai)
#pragma unroll
            for (int mp = 0; mp < 2; ++mp) {
                u32x2 w[2];
#pragma unroll
                for (int mm = 0; mm < 2; ++mm) { const int m = 2 * mp + mm;
                    const f32x4 g0 = acc[ai][0][m][0] * F8_DESCALE + bg0, g1 = acc[ai][0][m][1] * F8_DESCALE + bg1, l0 = acc[ai][1][m][0] * F8_DESCALE + bl0, l1 = acc[ai][1][m][1] * F8_DESCALE + bl1;
                    const f32x2 o0 = act2((f32x2){g0[0], g0[1]}, (f32x2){l0[0], l0[1]}), o1 = act2((f32x2){g0[2], g0[3]}, (f32x2){l0[2], l0[3]});
                    const f32x2 o2 = act2((f32x2){g1[0], g1[1]}, (f32x2){l1[0], l1[1]}), o3 = act2((f32x2){g1[2], g1[3]}, (f32x2){l1[2], l1[3]});
                    w[mm].x = pk_fp8x4_nc(o0.x, o0.y, o1.x, o1.y); w[mm].y = pk_fp8x4_nc(o2.x, o2.y, o3.x, o3.y); }
                *(u32x4*)(ACT8 + (size_t)(row0 + ai * 128 + (2 * mp + (fq & 1)) * 16) * 1024 + (col0 - 8 * (fq & 1))) = pair16(w[0], w[1]); }
    }
};
struct EpiDown {
    const float* bdn; unsigned char* Y2s;
    __device__ __forceinline__ void mid(EPI_ARGS) const {}
    __device__ __forceinline__ void operator()(EPI_ARGS) const {
        const int e = u.aux; const int row0 = u.pm * 256 + wr * 64 + fr, col0 = u.pn * 256 + wc * 32 + 8 * fq;
        f32x4 bv[2][2];
#pragma unroll
        for (int bj = 0; bj < 2; ++bj)
#pragma unroll
            for (int n = 0; n < 2; ++n) bv[bj][n] = *(const f32x4*)(bdn + (size_t)e * 1024 + col0 + bj * 128 + 4 * n) * F8_YSCALE;
#pragma unroll
        for (int ai = 0; ai < 2; ++ai)
#pragma unroll
            for (int mp = 0; mp < 2; ++mp) { unsigned char* op = Y2s + (size_t)(row0 + ai * 128 + (2 * mp + (fq & 1)) * 16) * 1024 + (col0 - 8 * (fq & 1));
#pragma unroll
                for (int bj = 0; bj < 2; ++bj) { u32x2 w[2];
#pragma unroll
                    for (int mm = 0; mm < 2; ++mm) { const int m = 2 * mp + mm;
                        const f32x4 v0 = acc[ai][bj][m][0] * (F8_DESCALE * F8_YSCALE) + bv[bj][0], v1 = acc[ai][bj][m][1] * (F8_DESCALE * F8_YSCALE) + bv[bj][1];
                        w[mm].x = pk_fp8x4(v0[0], v0[1], v0[2], v0[3]); w[mm].y = pk_fp8x4(v1[0], v1[1], v1[2], v1[3]); }
                    *(u32x4*)(op + bj * 128) = pair16(w[0], w[1]); } }
    }
};

struct WItem { const float* W; unsigned char* dst; int N, k0, n0, ldt, drow, dk0, fp8; };
__device__ __forceinline__ WItem witem_decode(const Args& a, int r) {
    unsigned char* ws = a.ws; WItem it;
    constexpr int I_IN = 8 * 80, I_GATE = 8 * 64, I_BR = 4 * 32, I_OUT = 8 * 32, I_GU = 8 * 64, I_DN = 8 * 32;
    it.fp8 = 0; it.dk0 = 0; it.ldt = 2048;
    if (r < I_IN) { it.W = a.in[6]; it.N = INW; it.k0 = 128 * (r / 80); it.n0 = 32 * (r % 80); it.dst = ws + WS_W1T; it.drow = it.n0; return it; } r -= I_IN;
    if (r < I_GATE) { it.W = a.in[14]; it.N = 2048; it.k0 = 128 * (r / 64); it.n0 = 32 * (r % 64); it.dst = ws + WS_WG8; const int m0 = it.n0 & 1023; it.fp8 = 1; it.ldt = 1024;
        it.drow = 256 * (m0 >> 7) + (m0 & 127) + (it.n0 >= 1024 ? 128 : 0); return it; } r -= I_GATE;
    if (r < I_BR) { it.W = a.in[12]; it.N = 1024; it.k0 = 128 * (r / 32); it.n0 = 32 * (r % 32); it.dst = ws + WS_WBRT; it.drow = it.n0; return it; } r -= I_BR;
    if (r < I_BR) { it.W = a.in[13]; it.N = 1024; it.k0 = 128 * (r / 32); it.n0 = 32 * (r % 32); it.dst = ws + WS_WBRT; it.drow = it.n0; it.dk0 = 512; return it; } r -= I_BR;
    if (r < I_OUT) { it.W = a.in[16]; it.N = 1024; it.k0 = 128 * (r / 32); it.n0 = 32 * (r % 32); it.dst = ws + WS_WOUTT; it.drow = it.n0; return it; } r -= I_OUT;
    it.fp8 = 1; it.ldt = 1024;
    if (r < NEXP * I_GU) { const int e = r / I_GU, q = r % I_GU; it.W = a.in[21] + (size_t)e * D * 2048; it.N = 2048; it.k0 = 128 * (q / 64); it.n0 = 32 * (q % 64); it.dst = ws + WS_WGUT + (size_t)e * 2048 * 1024;
        const int m0 = it.n0 & 1023; it.drow = 256 * (m0 >> 7) + (m0 & 127) + (it.n0 >= 1024 ? 128 : 0); return it; }
    r -= NEXP * I_GU;
    { const int e = r / I_DN, q = r % I_DN; it.W = a.in[23] + (size_t)e * D * D; it.N = 1024; it.k0 = 128 * (q / 32); it.n0 = 32 * (q % 32); it.dst = ws + WS_WDNT + (size_t)e * 1024 * 1024; it.drow = it.n0; }
    return it;
}
constexpr int W_NITEMS = 8 * 80 + 8 * 64 + 2 * 4 * 32 + 8 * 32 + NEXP * (8 * 64 + 8 * 32);
__device__ __forceinline__ void witem_load(const WItem& it, float (&v)[64], int lane) {
    const float* p = it.W + (size_t)(it.k0 + (lane >> 3)) * it.N + it.n0 + (lane & 7) * 4;
#pragma unroll
    for (int i = 0; i < 16; ++i) { const f32x4 t = __builtin_nontemporal_load((const f32x4*)(p + (size_t)(8 * i) * it.N)); v[4 * i] = t[0]; v[4 * i + 1] = t[1]; v[4 * i + 2] = t[2]; v[4 * i + 3] = t[3]; }
}
__device__ __forceinline__ void witem_store(const WItem& it, const float (&v)[64], LAS float* scr, int lane) {
#pragma unroll
    for (int i = 0; i < 16; ++i) { const int k = 8 * i + (lane >> 3); *(LAS f32x4*)(scr + k * 32 + (((lane & 7) * 4 + 4 * (i >> 1)) & 31)) = (f32x4){v[4 * i], v[4 * i + 1], v[4 * i + 2], v[4 * i + 3]}; }
    LDS_WAIT(); asm volatile("" ::: "memory");
    const int c = lane & 7;
#pragma unroll
    for (int j = 0; j < 4; ++j) { const int n = (lane >> 3) + 8 * j; const LAS float* s = scr + (16 * c) * 32 + ((n + 4 * c) & 31);
        float x[16];
#pragma unroll
        for (int q = 0; q < 16; ++q) x[q] = s[q * 32];
        unsigned char* d = it.dst + (size_t)(it.drow + n) * it.ldt;
        if (it.fp8) { u32x4 o;
            o.x = pk_fp8x4(x[0] * F8_WSCALE, x[1] * F8_WSCALE, x[2] * F8_WSCALE, x[3] * F8_WSCALE); o.y = pk_fp8x4(x[4] * F8_WSCALE, x[5] * F8_WSCALE, x[6] * F8_WSCALE, x[7] * F8_WSCALE);
            o.z = pk_fp8x4(x[8] * F8_WSCALE, x[9] * F8_WSCALE, x[10] * F8_WSCALE, x[11] * F8_WSCALE); o.w = pk_fp8x4(x[12] * F8_WSCALE, x[13] * F8_WSCALE, x[14] * F8_WSCALE, x[15] * F8_WSCALE);
            __builtin_nontemporal_store(o, (u32x4*)(d + it.dk0 + it.k0 + 16 * c)); }
        else { u32x4 o0, o1;
            o0.x = cvtpk(x[0], x[1]); o0.y = cvtpk(x[2], x[3]); o0.z = cvtpk(x[4], x[5]); o0.w = cvtpk(x[6], x[7]); o1.x = cvtpk(x[8], x[9]); o1.y = cvtpk(x[10], x[11]); o1.z = cvtpk(x[12], x[13]); o1.w = cvtpk(x[14], x[15]);
            *(u32x4*)(d + (size_t)(it.dk0 + it.k0 + 16 * c) * 2) = o0; *(u32x4*)(d + (size_t)(it.dk0 + it.k0 + 16 * c) * 2 + 16) = o1; } }
    LDS_WAIT(); asm volatile("" ::: "memory");
}
__device__ __forceinline__ void phaseA(const Frame& F, const Args& a) {
    unsigned char* ws = a.ws;
    if (F.vcu < 192) {
        const float* c = a.in[1]; const float* w_ada = a.in[2]; const float* b_ada = a.in[3]; float* mod = (float*)(ws + WS_MOD);
        LAS float* red = (LAS float*)(F.lds);
        const int col = F.vcu * 32 + (F.tid & 31), ks = F.tid >> 5;
        float a0 = 0.f, a1 = 0.f, a2 = 0.f, a3 = 0.f;
        for (int k = ks * 64; k < ks * 64 + 64; ++k) { const float w = __builtin_nontemporal_load(w_ada + (size_t)k * 6144 + col);
            const float c0 = c[k], c1 = c[D + k], c2 = c[2 * D + k], c3 = c[3 * D + k];
            a0 += c0 * __builtin_amdgcn_rcpf(1.0f + __expf(-c0)) * w; a1 += c1 * __builtin_amdgcn_rcpf(1.0f + __expf(-c1)) * w;
            a2 += c2 * __builtin_amdgcn_rcpf(1.0f + __expf(-c2)) * w; a3 += c3 * __builtin_amdgcn_rcpf(1.0f + __expf(-c3)) * w; }
        red[(ks * 4 + 0) * 32 + (F.tid & 31)] = a0; red[(ks * 4 + 1) * 32 + (F.tid & 31)] = a1; red[(ks * 4 + 2) * 32 + (F.tid & 31)] = a2; red[(ks * 4 + 3) * 32 + (F.tid & 31)] = a3;
        __syncthreads();
        if (F.tid < 128) { const int b = F.tid >> 5, cc = F.tid & 31; float s = 0.f;
#pragma unroll
            for (int k = 0; k < 16; ++k) s += red[(k * 4 + b) * 32 + cc];
            mod[b * 6144 + F.vcu * 32 + cc] = s + b_ada[F.vcu * 32 + cc]; }
        __syncthreads();
    }
    if (F.vcu == 192 % F.G) {
        const float* w_router = a.in[19]; bf16* wrt = (bf16*)(ws + WS_WRT);
        for (int i = F.tid; i < D * NEXP; i += NWAVES * 64) { const int k = i >> 5, e = i & 31; const float w = w_router[i]; const unsigned hh = cvtpk(w, 0.f) & 0xffffu;
            wrt[(size_t)e * D + k] = (bf16)hh; wrt[(size_t)(NEXP + e) * D + k] = (bf16)(cvtpk(w - bflo(hh), 0.f) & 0xffffu); }
    }
    LAS float* scr = (LAS float*)(F.lds + F.wave * 17408);
    const int gw = F.vcu * NWAVES + F.wave, NGW = F.G * NWAVES;
    if (gw < W_NITEMS) {
        float va[64], vb[64];
        WItem ia = witem_decode(a, gw), ib = ia;
        witem_load(ia, va, F.lane);
        for (int it = gw; it < W_NITEMS; it += 2 * NGW) {
            const bool hb = (it + NGW < W_NITEMS);
            ib = witem_decode(a, hb ? it + NGW : it); witem_load(ib, vb, F.lane);
            witem_store(ia, va, scr, F.lane);
            if (!hb) break;
            const bool ha = (it + 2 * NGW < W_NITEMS);
            ia = witem_decode(a, ha ? it + 2 * NGW : it); witem_load(ia, va, F.lane);
            witem_store(ib, vb, scr, F.lane);
            if (!ha) break;
        }
    }
}
__device__ __forceinline__ void phaseB(const Frame& F, const Args& a) {
    const float* x = a.in[0]; const float* g = a.in[4]; const float* mod = (const float*)(a.ws + WS_MOD); bf16* xn = (bf16*)(a.ws + WS_XN); unsigned* xn8 = (unsigned*)(a.ws + WS_XN8A);
    const int gw = F.vcu * NWAVES + F.wave, NGW = F.G * NWAVES;
    f32x4 cg[4], csh[4]; int cb = -1;
    for (int row0 = gw * 4; row0 < NTOK; row0 += NGW * 4) {
        f32x4 v[4][4];
#pragma unroll
        for (int rr = 0; rr < 4; ++rr)
#pragma unroll
            for (int j = 0; j < 4; ++j) v[rr][j] = __builtin_nontemporal_load((const f32x4*)(x + (size_t)(row0 + rr) * D) + F.lane + 64 * j);
        const int b = row0 / SEQ; const float* mb = mod + b * 6144;
        if (b != cb) { cb = b;
#pragma unroll
            for (int j = 0; j < 4; ++j) { const int c0 = (F.lane + 64 * j) * 4; cg[j] = *(const f32x4*)(g + c0) * (*(const f32x4*)(mb + SC1 + c0) + 1.0f); csh[j] = *(const f32x4*)(mb + SH1 + c0); } }
#pragma unroll
        for (int rr = 0; rr < 4; ++rr) {
            float ss = 0.f;
#pragma unroll
            for (int j = 0; j < 4; ++j) ss += (v[rr][j].x * v[rr][j].x + v[rr][j].y * v[rr][j].y) + (v[rr][j].z * v[rr][j].z + v[rr][j].w * v[rr][j].w);
            const float rstd = rsqrtf(wsum(ss) * (1.0f / D) + EPS);
            u32x2* o8 = (u32x2*)(xn + (size_t)(row0 + rr) * D) + F.lane; unsigned* o4 = xn8 + (size_t)(row0 + rr) * (D / 4) + F.lane;
#pragma unroll
            for (int j = 0; j < 4; ++j) {
                const f32x4 h = v[rr][j] * rstd * cg[j] + csh[j];
                u32x2 w; w.x = cvtpk(h[0], h[1]); w.y = cvtpk(h[2], h[3]); o8[64 * j] = w;
                o4[64 * j] = pk_fp8x4(h[0] * F8_ASCALE, h[1] * F8_ASCALE, h[2] * F8_ASCALE, h[3] * F8_ASCALE); }
        }
    }
}

__device__ __forceinline__ void store_row32(bf16* blk, u32x2 w0, u32x2 w1, u32x2 w2, u32x2 w3, int hi) {
    { const auto rx = __builtin_amdgcn_permlane32_swap(w0.x, w1.x, false, false); const auto ry = __builtin_amdgcn_permlane32_swap(w0.y, w1.y, false, false);
      u32x4 o = {rx[0], ry[0], rx[1], ry[1]}; *(u32x4*)(blk + (hi ? 8 : 0)) = o; }
    { const auto rx = __builtin_amdgcn_permlane32_swap(w2.x, w3.x, false, false); const auto ry = __builtin_amdgcn_permlane32_swap(w2.y, w3.y, false, false);
      u32x4 o = {rx[0], ry[0], rx[1], ry[1]}; *(u32x4*)(blk + 16 + (hi ? 8 : 0)) = o; }
}
constexpr int SGU_STRIDE = 1088;
__device__ __forceinline__ s16x4 vtr(const LAS unsigned char* p) { typedef short v4i16_t __attribute__((ext_vector_type(4))); return __builtin_bit_cast(s16x4, __builtin_amdgcn_ds_read_tr16_b64_v4i16((LAS v4i16_t*)p)); }
__device__ __forceinline__ void sgu_unit(const Frame& F, const Args& a, int b, int blk) {
    const bf16* VG = (const bf16*)(a.ws + WS_VG); const bf16* U = (const bf16*)(a.ws + WS_U); bf16* YAB = (bf16*)(a.ws + WS_YAB);
    const float* ln_g = a.in[8]; const float* ln_b = a.in[9]; const float* w_s = a.in[10]; const float* b_s = a.in[11];
    const int tok0 = b * SEQ + blk * SGB, lane = F.lane;
    {
        const f32x4 g0 = *(const f32x4*)(ln_g + lane * 8), g1 = *(const f32x4*)(ln_g + lane * 8 + 4), b0 = *(const f32x4*)(ln_b + lane * 8), b1 = *(const f32x4*)(ln_b + lane * 8 + 4);
#pragma unroll 1
        for (int r4 = 0; r4 < 16; r4 += 4) {
            u32x4 w[4];
#pragma unroll
            for (int rr = 0; rr < 4; ++rr) w[rr] = __builtin_nontemporal_load((const u32x4*)(VG + (size_t)(tok0 + F.wave * 16 + r4 + rr) * 512 + lane * 8));
#pragma unroll
            for (int rr = 0; rr < 4; ++rr) { const int row = F.wave * 16 + r4 + rr;
                f32x4 v0 = {bflo(w[rr].x), bfhi(w[rr].x), bflo(w[rr].y), bfhi(w[rr].y)}, v1 = {bflo(w[rr].z), bfhi(w[rr].z), bflo(w[rr].w), bfhi(w[rr].w)};
                const float mu = wsum((v0[0] + v0[1]) + (v0[2] + v0[3]) + (v1[0] + v1[1]) + (v1[2] + v1[3])) * (1.0f / 512.0f);
                v0 -= mu; v1 -= mu;
                const float var = wsum((v0[0] * v0[0] + v0[1] * v0[1]) + (v0[2] * v0[2] + v0[3] * v0[3]) + (v1[0] * v1[0] + v1[1] * v1[1]) + (v1[2] * v1[2] + v1[3] * v1[3])) * (1.0f / 512.0f);
                const float rstd = rsqrtf(var + EPS);
                v0 = v0 * rstd * g0 + b0; v1 = v1 * rstd * g1 + b1;
                u32x4 o; o.x = cvtpk(v0[0], v0[1]); o.y = cvtpk(v0[2], v0[3]); o.z = cvtpk(v1[0], v1[1]); o.w = cvtpk(v1[2], v1[3]);
                *(LAS u32x4*)(F.lds + row * SGU_STRIDE + lane * 16) = o; }
        }
    }
    __syncthreads();
    {
        const int g = F.wave, r32 = lane & 31, hi = lane >> 5, i16 = lane & 15, g16 = (lane >> 4) & 1;
        const LAS unsigned char* vb = F.lds + (8 * hi + (i16 >> 2)) * SGU_STRIDE + (g * 64 + 16 * g16 + 4 * (i16 & 3)) * 2;
#pragma unroll
        for (int tb = 0; tb < 4; ++tb) {
            const int t = 32 * tb + r32; const float* wrow = w_s + ((size_t)g * 128 + t) * 128;
            f32x4 wr0[8], wr1[8];
#pragma unroll
            for (int ks = 0; ks < 2 * tb + 2; ++ks) { wr0[ks] = *(const f32x4*)(wrow + 16 * ks + 8 * hi); wr1[ks] = *(const f32x4*)(wrow + 16 * ks + 8 * hi + 4); }
            const float bs = b_s[g * 128 + t];
            const bf16* up = U + (size_t)(tok0 + t) * 512 + g * 64 + 4 * hi;
            u32x2 uu0[4], uu1[4];
#pragma unroll
            for (int gg = 0; gg < 4; ++gg) { uu0[gg] = *(const u32x2*)(up + 8 * gg); uu1[gg] = *(const u32x2*)(up + 32 + 8 * gg); }
            f32x16 a0, a1;
#pragma unroll
            for (int r = 0; r < 16; ++r) { a0[r] = 0.f; a1[r] = 0.f; }
#pragma unroll
            for (int ks = 0; ks < 2 * tb + 2; ++ks) {
                const int s0 = 16 * ks + 8 * hi;
                float wv[8] = {wr0[ks][0], wr0[ks][1], wr0[ks][2], wr0[ks][3], wr1[ks][0], wr1[ks][1], wr1[ks][2], wr1[ks][3]};
                if (ks >= 2 * tb) {
#pragma unroll
                    for (int j = 0; j < 8; ++j) wv[j] = (s0 + j <= t) ? wv[j] : 0.f; }
                u32x4 bw; bw.x = cvtpk(wv[0], wv[1]); bw.y = cvtpk(wv[2], wv[3]); bw.z = cvtpk(wv[4], wv[5]); bw.w = cvtpk(wv[6], wv[7]);
                const bf16x8 bfrag = __builtin_bit_cast(bf16x8, bw);
                const LAS unsigned char* p = vb + ks * 16 * SGU_STRIDE;
                const s16x4 l0 = vtr(p), h0 = vtr(p + 4 * SGU_STRIDE), l1 = vtr(p + 64), h1 = vtr(p + 4 * SGU_STRIDE + 64);
                const bf16x8 A0 = {l0[0], l0[1], l0[2], l0[3], h0[0], h0[1], h0[2], h0[3]}, A1 = {l1[0], l1[1], l1[2], l1[3], h1[0], h1[1], h1[2], h1[3]};
                a0 = __builtin_amdgcn_mfma_f32_32x32x16_bf16(A0, bfrag, a0, 0, 0, 0);
                a1 = __builtin_amdgcn_mfma_f32_32x32x16_bf16(A1, bfrag, a1, 0, 0, 0);
            }
            bf16* op = YAB + (size_t)(tok0 + t) * 1024 + 512 + g * 64;
            u32x2 q0[4], q1[4];
#pragma unroll
            for (int gg = 0; gg < 4; ++gg) {
                q0[gg].x = cvtpk(bflo(uu0[gg].x) * (a0[4 * gg] + bs), bfhi(uu0[gg].x) * (a0[4 * gg + 1] + bs)); q0[gg].y = cvtpk(bflo(uu0[gg].y) * (a0[4 * gg + 2] + bs), bfhi(uu0[gg].y) * (a0[4 * gg + 3] + bs));
                q1[gg].x = cvtpk(bflo(uu1[gg].x) * (a1[4 * gg] + bs), bfhi(uu1[gg].x) * (a1[4 * gg + 1] + bs)); q1[gg].y = cvtpk(bflo(uu1[gg].y) * (a1[4 * gg + 2] + bs), bfhi(uu1[gg].y) * (a1[4 * gg + 3] + bs)); }
            store_row32(op, q0[0], q0[1], q0[2], q0[3], hi); store_row32(op + 32, q1[0], q1[1], q1[2], q1[3], hi);
        }
    }
    __syncthreads();
}

constexpr int AT_BUF = 65536, AT_V = 32768, AT_BT = GTAB_OFF;
static_assert(8 * 1088 <= GTAB_BYTES, "bias tables fit above the ring");
__device__ __forceinline__ void attn_chunks(const Frame& F, const Args& a, int gc0, int gc1) {
    const bf16* __restrict__ Q = (const bf16*)(a.ws + WS_Q); const bf16* __restrict__ Kb = (const bf16*)(a.ws + WS_K); const bf16* __restrict__ Vb = (const bf16*)(a.ws + WS_V); bf16* YAB = (bf16*)(a.ws + WS_YAB);
    const int tid = F.tid, lane = F.lane, wave = F.wave, pr = wave >> 1, half = wave & 1;
    const int r32 = lane & 31, hi = lane >> 5, i16 = lane & 15, g16 = (lane >> 4) & 1;
    const int gcs[2] = {gc0, gc1};
    int j0s[2], nts[2], tok0s[2];
#pragma unroll
    for (int i = 0; i < 2; ++i) { const int c = gcs[i] % (SEQ / CHUNK); j0s[i] = (c < NLEFT) ? (NLEFT - c) : 0; nts[i] = 9 - j0s[i]; tok0s[i] = (gcs[i] / (SEQ / CHUNK)) * SEQ + c * CHUNK; }
    const int total = 2 * nts[0] + 2 * nts[1];
    unsigned dsrcK[4], dsrcV[4];
#pragma unroll
    for (int i = 0; i < 4; ++i) { const int piece = 4 * wave + i, hh = piece >> 3, kb = piece & 7, key = 8 * kb + (lane >> 3), slot = lane & 7;
        dsrcK[i] = (unsigned)(key * 512 + hh * 64 + ((slot ^ ((key >> 1) & 7)) << 3)); dsrcV[i] = (unsigned)(key * 512 + hh * 64 + ((slot ^ (((key >> 1) & 1) << 2)) << 3)); }
#define AT_DMA(bufp, tbase) do { _Pragma("unroll") for (int i_ = 0; i_ < 4; ++i_) { const int piece_ = 4 * wave + i_; \
        __builtin_amdgcn_global_load_lds((const unsigned*)(Kb + (tbase) + dsrcK[i_]), (LAS unsigned*)((bufp) + (piece_ >> 3) * 8192 + (piece_ & 7) * 1024), 16, 0, 0); \
        __builtin_amdgcn_global_load_lds((const unsigned*)(Vb + (tbase) + dsrcV[i_]), (LAS unsigned*)((bufp) + AT_V + (piece_ >> 3) * 8192 + (piece_ & 7) * 1024), 16, 0, 0); } } while (0)
    int ko[4];
#pragma unroll
    for (int sI = 0; sI < 4; ++sI) ko[sI] = pr * 8192 + r32 * 128 + ((((2 * sI + hi) ^ ((r32 >> 1) & 7))) << 4);
    const int fb = (i16 >> 3) & 1;
    const int vr0 = AT_V + pr * 8192 + (4 * hi + (i16 >> 2)) * 128 + ((4 * (0 ^ fb) + 2 * g16 + ((i16 & 3) >> 1)) * 16) + (i16 & 1) * 8;
    const int vr1 = AT_V + pr * 8192 + (4 * hi + (i16 >> 2)) * 128 + ((4 * (1 ^ fb) + 2 * g16 + ((i16 & 3) >> 1)) * 16) + (i16 & 1) * 8;
#define AT_DECODE(t, ci, hp, j) do { ci = ((t) >= 2 * nts[0]) ? 1 : 0; const int tt_ = (t) - ci * 2 * nts[0]; hp = (tt_ >= nts[ci]) ? 1 : 0; j = j0s[ci] + tt_ - hp * nts[ci]; } while (0)
    {
        int ci, hp, j; AT_DECODE(0, ci, hp, j);
        const size_t tb0 = (size_t)(tok0s[ci] + (j - NLEFT) * CHUNK) * 512 + hp * 256;
        AT_DMA(F.lds, tb0);
    }
    bf16x8 qn[4];
    {   int ci, hp, j; AT_DECODE(0, ci, hp, j);
#pragma unroll
        for (int sI = 0; sI < 4; ++sI) qn[sI] = __builtin_nontemporal_load((const bf16x8*)(Q + (size_t)(tok0s[ci] + half * 32 + r32) * 512 + (4 * hp + pr) * 64 + 16 * sI + 8 * hi));
    }
    __syncthreads();
    bf16x8 qf[4]; f32x16 o0, o1; float m = -1e30f, l = 0.f;
#pragma unroll
    for (int r = 0; r < 16; ++r) { o0[r] = 0.f; o1[r] = 0.f; }
#pragma unroll
    for (int sI = 0; sI < 4; ++sI) qf[sI] = (bf16x8){0, 0, 0, 0, 0, 0, 0, 0};
#pragma unroll 1
    for (int t = 0; t < total; ++t) {
        int ci, hp, j; AT_DECODE(t, ci, hp, j);
        const int tn = (t + 1 < total) ? t + 1 : t; int cin, hpn, jn; AT_DECODE(tn, cin, hpn, jn);
        const int h = 4 * hp + pr, qi = half * 32 + r32, qtok = tok0s[ci] + qi;
        if (j == j0s[ci]) {
#pragma unroll
            for (int sI = 0; sI < 4; ++sI) qf[sI] = qn[sI];
#pragma unroll
            for (int r = 0; r < 16; ++r) { o0[r] = 0.f; o1[r] = 0.f; }
            m = -1e30f; l = 0.f;
        }
        asm volatile("" ::: "memory");
        {
            const size_t tbn = (size_t)(tok0s[cin] + (jn - NLEFT) * CHUNK) * 512 + hpn * 256;
            AT_DMA(F.lds + ((t + 1) & 1) * AT_BUF, tbn);
        }
        if (tn != t && jn == j0s[cin]) {
#pragma unroll
            for (int sI = 0; sI < 4; ++sI) qn[sI] = __builtin_nontemporal_load((const bf16x8*)(Q + (size_t)(tok0s[cin] + qi) * 512 + (4 * hpn + pr) * 64 + 16 * sI + 8 * hi));
        }
        asm volatile("" ::: "memory");
        const LAS unsigned char* buf = F.lds + (t & 1) * AT_BUF;
        const bool first = (j == j0s[ci]);
        const float negm = first ? 0.f : -m;
        f32x16 p0, p1;
#pragma unroll
        for (int r = 0; r < 16; ++r) { p0[r] = negm; p1[r] = negm; }
#pragma unroll
        for (int sI = 0; sI < 4; ++sI) { const bf16x8 k0 = *(const LAS bf16x8*)(buf + ko[sI]), k1 = *(const LAS bf16x8*)(buf + ko[sI] + 4096);
            p0 = __builtin_amdgcn_mfma_f32_32x32x16_bf16(k0, qf[sI], p0, 0, 0, 0); p1 = __builtin_amdgcn_mfma_f32_32x32x16_bf16(k1, qf[sI], p1, 0, 0, 0); }
        if (j >= 6) {
            const LAS float* bt = (const LAS float*)(F.lds + AT_BT + h * 1088);
            const int base = 640 + qi - 64 * j - 4 * hi;
#pragma unroll
            for (int r = 0; r < 16; ++r) { const int kk = (r & 3) + 8 * (r >> 2); int i0 = base - kk, i1 = base - 32 - kk; i0 = i0 > 256 ? 256 : i0; i1 = i1 > 256 ? 256 : i1; p0[r] += bt[i0]; p1[r] += bt[i1]; }
        }
        float tm = fmaxf(p0[0], p1[0]);
#pragma unroll
        for (int r = 1; r < 16; ++r) tm = fmaxf(tm, fmaxf(p0[r], p1[r]));
        { const auto rr = __builtin_amdgcn_permlane32_swap(__float_as_uint(tm), __float_as_uint(tm), false, false); tm = fmaxf(__uint_as_float(rr[0]), __uint_as_float(rr[1])); }
        if (first) {
            m = tm;
#pragma unroll
            for (int r = 0; r < 16; ++r) { p0[r] -= tm; p1[r] -= tm; }
        } else if (__any(tm > 0.f)) {
            const float dlt = fmaxf(tm, 0.f), alpha = __builtin_amdgcn_exp2f(-dlt); m += dlt; l *= alpha;
#pragma unroll
            for (int r = 0; r < 16; ++r) { p0[r] -= dlt; p1[r] -= dlt; o0[r] *= alpha; o1[r] *= alpha; }
        }
        float ps = 0.f;
#pragma unroll
        for (int r = 0; r < 16; ++r) { p0[r] = __builtin_amdgcn_exp2f(p0[r]); p1[r] = __builtin_amdgcn_exp2f(p1[r]); ps += p0[r] + p1[r]; }
        l += ps;
        bf16x8 pb[2][2];
#pragma unroll
        for (int sI = 0; sI < 2; ++sI) {
            u32x4 w0; w0.x = cvtpk(p0[8 * sI], p0[8 * sI + 1]); w0.y = cvtpk(p0[8 * sI + 2], p0[8 * sI + 3]); w0.z = cvtpk(p0[8 * sI + 4], p0[8 * sI + 5]); w0.w = cvtpk(p0[8 * sI + 6], p0[8 * sI + 7]);
            u32x4 w1; w1.x = cvtpk(p1[8 * sI], p1[8 * sI + 1]); w1.y = cvtpk(p1[8 * sI + 2], p1[8 * sI + 3]); w1.z = cvtpk(p1[8 * sI + 4], p1[8 * sI + 5]); w1.w = cvtpk(p1[8 * sI + 6], p1[8 * sI + 7]);
            pb[0][sI] = __builtin_bit_cast(bf16x8, w0); pb[1][sI] = __builtin_bit_cast(bf16x8, w1); }
#pragma unroll
        for (int blk = 0; blk < 2; ++blk)
#pragma unroll
            for (int sI = 0; sI < 2; ++sI) {
                const int kof = (32 * blk + 16 * sI) * 128;
                const s16x4 l0 = vtr(buf + vr0 + kof), h0 = vtr(buf + vr0 + kof + 1024), l1 = vtr(buf + vr1 + kof), h1 = vtr(buf + vr1 + kof + 1024);
                const bf16x8 A0 = {l0[0], l0[1], l0[2], l0[3], h0[0], h0[1], h0[2], h0[3]}, A1 = {l1[0], l1[1], l1[2], l1[3], h1[0], h1[1], h1[2], h1[3]};
                o0 = __builtin_amdgcn_mfma_f32_32x32x16_bf16(A0, pb[blk][sI], o0, 0, 0, 0);
                o1 = __builtin_amdgcn_mfma_f32_32x32x16_bf16(A1, pb[blk][sI], o1, 0, 0, 0);
            }
        if (j == 8) {
            float lt = l; { const auto rr = __builtin_amdgcn_permlane32_swap(__float_as_uint(lt), __float_as_uint(lt), false, false); lt = __uint_as_float(rr[0]) + __uint_as_float(rr[1]); }
            const float inv = __builtin_amdgcn_rcpf(lt);
            bf16* op = YAB + (size_t)qtok * 1024 + h * 64;
            u32x2 q0[4], q1[4];
#pragma unroll
            for (int gg = 0; gg < 4; ++gg) {
                q0[gg].x = cvtpk(o0[4 * gg] * inv, o0[4 * gg + 1] * inv); q0[gg].y = cvtpk(o0[4 * gg + 2] * inv, o0[4 * gg + 3] * inv);
                q1[gg].x = cvtpk(o1[4 * gg] * inv, o1[4 * gg + 1] * inv); q1[gg].y = cvtpk(o1[4 * gg + 2] * inv, o1[4 * gg + 3] * inv); }
            store_row32(op, q0[0], q0[1], q0[2], q0[3], hi); store_row32(op + 32, q1[0], q1[1], q1[2], q1[3], hi);
        }
        __syncthreads();
    }
#undef AT_DMA
#undef AT_DECODE
}
__device__ __forceinline__ void phaseD(const Frame& F, const Args& a) {
    for (int unit = F.vcu; unit < NB * (SEQ / SGB); unit += F.G) sgu_unit(F, a, unit / (SEQ / SGB), unit % (SEQ / SGB));
    for (int i = F.tid; i < NHEAD * NREL; i += NWAVES * 64) { const int h = i / NREL, k = i % NREL; ((LAS float*)(F.lds + AT_BT + h * 1088))[k] = (a.in[7][i] - a.in[7][h * NREL + 256]) * LOG2E; }
    __syncthreads();
    const int NCH = NB * (SEQ / CHUNK);
    for (int v = F.vcu; v < NCH / 2; v += F.G) attn_chunks(F, a, v, NCH - 1 - v);
}

constexpr int G_HT_STRIDE = 2064;
__device__ __forceinline__ void phaseG(const Frame& F, const Args& a) {
    const float* x = a.in[0]; const bf16* Y1 = (const bf16*)(a.ws + WS_Y1); const float* mod = (const float*)(a.ws + WS_MOD); const float* g_post_mix = a.in[5]; const float* g_pre_ffn = a.in[17];
    const float* b_router = a.in[20]; bf16* X1b = (bf16*)(a.ws + WS_X1B); unsigned char* XN8 = a.ws + WS_XN;
    const bf16* wrt = (const bf16*)(a.ws + WS_WRT);
    float* topg = (float*)(a.ws + WS_TOPG); int* list = (int*)(a.ws + WS_LIST); unsigned* cnt = F.ctl + CW_CNT;
    LAS unsigned char* HT = F.lds;
    LAS float* PL = (LAS float*)(F.lds + 33792);
    LAS float* LG = PL + 8 * 16 * 32;
    LAS float* TV = LG + 512;
    LAS unsigned* LC = (LAS unsigned*)(TV + 64);
    LAS unsigned* AS = LC + 64;
    const int tid = F.tid, lane = F.lane, wave = F.wave, kq = lane >> 4, i16 = lane & 15;
    if (tid < 64) LC[tid] = 0u;
    bf16x8 whi[2][4], wlo[2][4];
#pragma unroll
    for (int et = 0; et < 2; ++et)
#pragma unroll
        for (int ks = 0; ks < 4; ++ks) { const size_t o = (size_t)(et * 16 + i16) * D + 128 * wave + 32 * ks + 8 * kq; whi[et][ks] = *(const bf16x8*)(wrt + o); wlo[et][ks] = *(const bf16x8*)(wrt + (size_t)NEXP * D + o); }
    const int myrow = tid >> 5, mye = lane & 31;
    const float mybias = b_router[mye];
    __syncthreads();
    const int NT = NTOK / 16;
    f32x4 xv[2][4]; u32x2 yr[2][4];
    {   const int rbase = 16 * F.vcu + 2 * wave;
#pragma unroll
        for (int rr = 0; rr < 2; ++rr)
#pragma unroll
            for (int j = 0; j < 4; ++j) { const int c0 = (lane + 64 * j) * 4; xv[rr][j] = __builtin_nontemporal_load((const f32x4*)(x + (size_t)(rbase + rr) * D + c0)); yr[rr][j] = __builtin_nontemporal_load((const u32x2*)(Y1 + (size_t)(rbase + rr) * D + c0)); } }
    int tl = 0;
    f32x4 cgp[4], cgf[4], cgt[4], csc[4], csh[4]; int cb = -1;
#pragma unroll
    for (int j = 0; j < 4; ++j) { const int c0 = (lane + 64 * j) * 4; cgp[j] = *(const f32x4*)(g_post_mix + c0); cgf[j] = *(const f32x4*)(g_pre_ffn + c0); }
#pragma unroll 1
    for (int T = F.vcu; T < NT; T += F.G, ++tl) {
        const int b = (16 * T) / SEQ; const float* mb = mod + b * 6144; const int rbase = 16 * T + 2 * wave;
        if (b != cb) { cb = b;
#pragma unroll
            for (int j = 0; j < 4; ++j) { const int c0 = (lane + 64 * j) * 4; cgt[j] = *(const f32x4*)(mb + GT1 + c0); csc[j] = *(const f32x4*)(mb + SC2 + c0) + 1.0f; csh[j] = *(const f32x4*)(mb + SH2 + c0); } }
#pragma unroll
        for (int rr = 0; rr < 2; ++rr) {
            const int row = rbase + rr; f32x4 yv[4]; float ss = 0.f;
#pragma unroll
            for (int j = 0; j < 4; ++j) { yv[j] = (f32x4){bflo(yr[rr][j].x), bfhi(yr[rr][j].x), bflo(yr[rr][j].y), bfhi(yr[rr][j].y)}; ss += (yv[j][0] * yv[j][0] + yv[j][1] * yv[j][1]) + (yv[j][2] * yv[j][2] + yv[j][3] * yv[j][3]); }
            const float rstd = rsqrtf(wsum(ss) * (1.0f / D) + EPS); float s2 = 0.f;
#pragma unroll
            for (int j = 0; j < 4; ++j) { const int c0 = (lane + 64 * j) * 4;
                xv[rr][j] = xv[rr][j] + cgt[j] * (yv[j] * rstd * cgp[j]);
                { u32x2 w1; w1.x = cvtpk(xv[rr][j][0], xv[rr][j][1]); w1.y = cvtpk(xv[rr][j][2], xv[rr][j][3]); __builtin_nontemporal_store(w1, (u32x2*)(X1b + (size_t)row * D + c0)); }
                s2 += (xv[rr][j][0] * xv[rr][j][0] + xv[rr][j][1] * xv[rr][j][1]) + (xv[rr][j][2] * xv[rr][j][2] + xv[rr][j][3] * xv[rr][j][3]); }
            const float rstd2 = rsqrtf(wsum(s2) * (1.0f / D) + EPS);
#pragma unroll
            for (int j = 0; j < 4; ++j) { const int c0 = (lane + 64 * j) * 4;
                const f32x4 h = xv[rr][j] * rstd2 * cgf[j] * csc[j] + csh[j];
                u32x2 w; w.x = cvtpk(h[0], h[1]); w.y = cvtpk(h[2], h[3]); *(unsigned*)(XN8 + (size_t)row * D + c0) = pk_fp8x4(h[0] * F8_ASCALE, h[1] * F8_ASCALE, h[2] * F8_ASCALE, h[3] * F8_ASCALE);
                *(LAS u32x2*)(HT + (2 * wave + rr) * G_HT_STRIDE + c0 * 2) = w; }
        }
        {
            const int Tn = (T + F.G < NT) ? T + F.G : T; const int rb2 = 16 * Tn + 2 * wave;
#pragma unroll
            for (int rr = 0; rr < 2; ++rr)
#pragma unroll
                for (int j = 0; j < 4; ++j) { const int c0 = (lane + 64 * j) * 4; xv[rr][j] = __builtin_nontemporal_load((const f32x4*)(x + (size_t)(rb2 + rr) * D + c0)); yr[rr][j] = __builtin_nontemporal_load((const u32x2*)(Y1 + (size_t)(rb2 + rr) * D + c0)); }
        }
        LDS_WAIT(); __builtin_amdgcn_s_barrier(); asm volatile("" ::: "memory");
        {
            f32x4 acc0 = {0.f, 0.f, 0.f, 0.f}, acc1 = {0.f, 0.f, 0.f, 0.f};
#pragma unroll
            for (int ks = 0; ks < 4; ++ks) { const bf16x8 hb = *(const LAS bf16x8*)(HT + i16 * G_HT_STRIDE + (128 * wave + 32 * ks + 8 * kq) * 2);
                acc0 = __builtin_amdgcn_mfma_f32_16x16x32_bf16(whi[0][ks], hb, acc0, 0, 0, 0); acc0 = __builtin_amdgcn_mfma_f32_16x16x32_bf16(wlo[0][ks], hb, acc0, 0, 0, 0);
                acc1 = __builtin_amdgcn_mfma_f32_16x16x32_bf16(whi[1][ks], hb, acc1, 0, 0, 0); acc1 = __builtin_amdgcn_mfma_f32_16x16x32_bf16(wlo[1][ks], hb, acc1, 0, 0, 0); }
            *(LAS f32x4*)(PL + (wave * 16 + i16) * 32 + 4 * kq) = acc0; *(LAS f32x4*)(PL + (wave * 16 + i16) * 32 + 16 + 4 * kq) = acc1;
        }
        LDS_WAIT(); __builtin_amdgcn_s_barrier(); asm volatile("" ::: "memory");
        float lg = mybias;
#pragma unroll
        for (int w = 0; w < 8; ++w) lg += PL[(w * 16 + myrow) * 32 + mye];
        LG[myrow * 32 + mye] = lg;
        LDS_WAIT(); asm volatile("" ::: "memory");
        int rank = 0;
#pragma unroll
        for (int q = 0; q < 8; ++q) { const f32x4 o = *(const LAS f32x4*)(LG + myrow * 32 + 4 * q);
#pragma unroll
            for (int i = 0; i < 4; ++i) { const int e2 = 4 * q + i; rank += (o[i] > lg || (o[i] == lg && e2 < mye)) ? 1 : 0; } }
        if (rank < 4) TV[myrow * 4 + rank] = lg;
        LDS_WAIT(); asm volatile("" ::: "memory");
        const f32x4 tv = *(const LAS f32x4*)(TV + myrow * 4);
        if (rank < 4) {
            const float den = 1.0f + __expf(tv[1] - tv[0]) + __expf(tv[2] - tv[0]) + __expf(tv[3] - tv[0]);
            const int slot = (16 * T + myrow) * 4 + rank; topg[slot] = __expf(lg - tv[0]) / den;
            const unsigned lp = __hip_atomic_fetch_add(LC + mye, 1u, __ATOMIC_RELAXED, __HIP_MEMORY_SCOPE_WORKGROUP);
            if (tl < 16) AS[tl * 64 + myrow * 4 + rank] = (unsigned)mye | (lp << 8);
        }
    }
    __syncthreads();
    if (tid < NEXP) LC[32 + tid] = atomicAdd(&cnt[tid], LC[tid]);
    __syncthreads();
    for (int i = tid; i < tl * 64; i += NWAVES * 64) { const unsigned as = AS[i]; const int e = as & 255, lp = as >> 8; const int T = F.vcu + (i >> 6) * F.G;
        list[(size_t)e * NTOK + LC[32 + e] + lp] = (16 * T + ((i & 63) >> 2)) * 4 + (i & 3); }
}
__device__ __forceinline__ int moe_tables(const Frame& F) {
    __syncthreads();
    if (F.tid < NEXP) F.MISC[40 + F.tid] = __hip_atomic_load(F.ctl + CW_CNT + F.tid, __ATOMIC_RELAXED, __HIP_MEMORY_SCOPE_AGENT);
    __syncthreads();
    if (F.tid == 0) { unsigned s = 0; for (int e = 0; e < NEXP; ++e) { F.MISC[e] = s; s += (F.MISC[40 + e] + 255u) >> 8; } F.MISC[32] = s; }
    __syncthreads();
    return (int)F.MISC[32];
}
__device__ __forceinline__ void phaseJ(const Frame& F, const Args& a) {
    const unsigned char* Y2s = a.ws + WS_Y2; const bf16* X1b = (const bf16*)(a.ws + WS_X1B); const float* mod = (const float*)(a.ws + WS_MOD); const float* gpf = a.in[18]; float* out = a.out;
    const int* inv = (const int*)(a.ws + WS_TOPE); const float* topg = (const float*)(a.ws + WS_TOPG);
    const int lane = F.lane, gw = F.vcu * NWAVES + F.wave, NGW = F.G * NWAVES;
    f32x4 cgg[4]; int cb = -1;
    for (int row0 = gw * 4; row0 < NTOK; row0 += NGW * 4) {
        const int b = row0 / SEQ; const float* mb = mod + b * 6144;
        if (b != cb) { cb = b;
#pragma unroll
            for (int j = 0; j < 4; ++j) { const int c0 = (lane + 64 * j) * 4; cgg[j] = *(const f32x4*)(gpf + c0) * *(const f32x4*)(mb + GT2 + c0); } }
        int pp[4][4]; float gg[4][4];
#pragma unroll
        for (int rr = 0; rr < 4; ++rr)
#pragma unroll
            for (int k = 0; k < 4; ++k) { pp[rr][k] = __builtin_amdgcn_readfirstlane(inv[(row0 + rr) * 4 + k]); gg[rr][k] = topg[(row0 + rr) * 4 + k] * (1.0f / F8_YSCALE); }
        unsigned yy[4][4][4]; u32x2 xx[4][4];
#pragma unroll
        for (int rr = 0; rr < 4; ++rr)
#pragma unroll
            for (int j = 0; j < 4; ++j) { const int c0 = (lane + 64 * j) * 4;
#pragma unroll
                for (int k = 0; k < 4; ++k) yy[rr][j][k] = __builtin_nontemporal_load((const unsigned*)(Y2s + (size_t)pp[rr][k] * D + c0));
                xx[rr][j] = __builtin_nontemporal_load((const u32x2*)(X1b + (size_t)(row0 + rr) * D + c0)); }
#pragma unroll
        for (int rr = 0; rr < 4; ++rr) {
            f32x4 yv[4]; float ss = 0.f;
#pragma unroll
            for (int j = 0; j < 4; ++j) { f32x4 s = {0.f, 0.f, 0.f, 0.f};
#pragma unroll
                for (int k = 0; k < 4; ++k) { const f32x2 lo = __builtin_amdgcn_cvt_pk_f32_fp8((int)yy[rr][j][k], false), hi = __builtin_amdgcn_cvt_pk_f32_fp8((int)yy[rr][j][k], true);
                    s += (f32x4){lo.x, lo.y, hi.x, hi.y} * gg[rr][k]; }
                yv[j] = s; ss += (s[0] * s[0] + s[1] * s[1]) + (s[2] * s[2] + s[3] * s[3]); }
            const float rstd = rsqrtf(wsum(ss) * (1.0f / D) + EPS);
#pragma unroll
            for (int j = 0; j < 4; ++j) { const int c0 = (lane + 64 * j) * 4;
                const f32x4 x1 = {bflo(xx[rr][j].x), bfhi(xx[rr][j].x), bflo(xx[rr][j].y), bfhi(xx[rr][j].y)};
                __builtin_nontemporal_store(x1 + cgg[j] * (yv[j] * rstd), (f32x4*)(out + (size_t)(row0 + rr) * D + c0)); }
        }
    }
}

constexpr int N_PHASES = 10;
__global__ void __launch_bounds__(NWAVES * 64, 2) mega_fwd(Args args) {
    extern __shared__ __attribute__((aligned(16))) unsigned char lds_raw[];
    Frame F;
    F.lds = (LAS unsigned char*)lds_raw; F.MISC = (volatile LAS unsigned*)(F.lds + MISC_OFF);
    F.tid = threadIdx.x; F.lane = F.tid & 63; F.wave = __builtin_amdgcn_readfirstlane(F.tid >> 6);
    F.G = gridDim.x; { const int bx = blockIdx.x; F.vcu = (F.G % 8 == 0) ? (bx % 8) * (F.G / 8) + bx / 8 : bx; }
    F.ctl = (unsigned*)(args.ws + WS_CTL);
    for (int u = F.tid; u < 128; u += NWAVES * 64) F.MISC[u] = 0u;
    __syncthreads();
    const int lo = args.ph_lo, hi = args.ph_hi;
    XcdBarrier bar; bar.bar = F.ctl + CW_BAR; bar.x = 0; bar.st = F.MISC + 80;
    if (hi - lo > 1) bar = xcd_barrier_post(F.ctl + CW_BAR, F.MISC + 80);
#define IN(k) (lo <= (k) && (k) < hi)
#define SEAM(k) do { if (IN(k) && IN((k) + 1)) xcd_barrier(bar); } while (0)
    unsigned char* ws = args.ws;
    bf16 *XN = (bf16*)(ws + WS_XN), *Qb = (bf16*)(ws + WS_Q), *Kb = (bf16*)(ws + WS_K), *Vb = (bf16*)(ws + WS_V), *Ub = (bf16*)(ws + WS_U), *VG = (bf16*)(ws + WS_VG);
    bf16 *GT = (bf16*)(ws + WS_GT), *YAB = (bf16*)(ws + WS_YAB), *MRG = (bf16*)(ws + WS_MRG), *Y1 = (bf16*)(ws + WS_Y1), *ACT = (bf16*)(ws + WS_ACT), *Y2 = (bf16*)(ws + WS_Y2);

    if (IN(0)) { phaseA(F, args); } SEAM(0);
    if (IN(1)) { phaseB(F, args); } SEAM(1);
    if (IN(2)) {
        { SchedStatic S{(const char*)XN, (const char*)(ws + WS_W1T), NTOK / 256, INW / 256, F.G, (int)blockIdx.x, (size_t)256 * 1024 * 2, (size_t)256 * 1024 * 2};
          EpiG1 E{Qb, Kb, Vb, Ub, VG};
          pg8::gemm_phase<EpiG1, SchedStatic, false>(F.lds + RING_OFF, S, E, 2048, 2048, 16); }
        {
          SchedStaticG S{(const char*)(ws + WS_XN8A), (const char*)(ws + WS_WG8), NTOK / 256, 2048 / 256, F.G, (int)blockIdx.x, (size_t)256 * 1024, 1024u};
          EpiGate E{GT, args.in[15]};
          pg8::gemm_phase<EpiGate, SchedStaticG, true>(F.lds + RING_OFF, S, E, 1024, 1024, 8); }
    } SEAM(2);
    if (IN(3)) { phaseD(F, args); } SEAM(3);
    if (IN(4)) {
        SchedSplit2 S{(const char*)YAB, (const char*)(ws + WS_WBRT), NTOK / 256, 4, F.G, (int)blockIdx.x, (size_t)256 * 1024 * 2, (size_t)256 * 1024 * 2, (size_t)512 * 2};
        EpiG2 E{GT, MRG};
        pg8::gemm_phase<EpiG2, SchedSplit2, false>(F.lds + RING_OFF, S, E, 2048, 2048, 8);
    } SEAM(4);
    if (IN(5)) {
        SchedStatic S{(const char*)MRG, (const char*)(ws + WS_WOUTT), NTOK / 256, 4, F.G, (int)blockIdx.x, (size_t)256 * 1024 * 2, (size_t)256 * 1024 * 2};
        EpiPlain E{Y1};
        pg8::gemm_phase<EpiPlain, SchedStatic, false>(F.lds + RING_OFF, S, E, 2048, 2048, 16);
    } SEAM(5);
    if (IN(6)) { phaseG(F, args); } SEAM(6);
    if (IN(7)) {
        const int nrb = moe_tables(F);
        const int* list = (const int*)(ws + WS_LIST);
        {
            int* inv = (int*)(ws + WS_TOPE);
            for (int g = (int)blockIdx.x * (NWAVES * 64) + F.tid; g < NTOK * TOPK; g += F.G * NWAVES * 64) {
                int e = 0, base = 0;
#pragma unroll 1
                for (int i = 0; i < NEXP; ++i) { const int c = (int)F.MISC[40 + i]; if (g >= base + c) { base += c; e = i + 1; } else break; }
                const int pos = g - base; if (e < NEXP) inv[list[(size_t)e * NTOK + pos]] = (int)F.MISC[e] * 256 + pos; }
        }
        typedef SchedMoe<8, true> SM;
        SM S{(const char*)XN, (const char*)(ws + WS_WGUT), F.MISC, (const LAS unsigned*)(F.lds + GTAB_OFF), (int)blockIdx.x, F.G, nrb, (size_t)2048 * 1024, (size_t)256 * 1024};
        S.build(F.tid);
        { Unit u; LAS unsigned* gt = (LAS unsigned*)(F.lds + GTAB_OFF);
          for (int k = 0; k < GTAB_UNITS && S.next(k, u); ++k) { const int e = u.aux, j256 = (u.pm - (int)F.MISC[e]) * 256, ecnt = (int)F.MISC[40 + e];
              for (int r = F.tid; r < 256; r += NWAVES * 64) { const int pos = j256 + r; int tok = 0; if (pos < ecnt) tok = list[(size_t)e * NTOK + pos] >> 2; gt[k * 256 + r] = (unsigned)tok * 1024u; } } }
        __syncthreads();
        EpiAct E{args.in[22], (unsigned char*)ACT};
        pg8::gemm_phase<EpiAct, SM, true>(F.lds + RING_OFF, S, E, 1024, 1024, 8);
    } SEAM(7);
    if (IN(8)) {
        const int nrb = moe_tables(F);
        typedef SchedMoe<4, true> SM;
        SM S{(const char*)ACT, (const char*)(ws + WS_WDNT), F.MISC, (const LAS unsigned*)(F.lds + GTAB_OFF), (int)blockIdx.x, F.G, nrb, (size_t)1024 * 1024, (size_t)256 * 1024};
        S.build(F.tid);
        { Unit u; LAS unsigned* gt = (LAS unsigned*)(F.lds + GTAB_OFF);
          for (int k = 0; k < GTAB_UNITS && S.next(k, u); ++k) for (int r = F.tid; r < 256; r += NWAVES * 64) gt[k * 256 + r] = (unsigned)(u.pm * 256 + r) * 1024u; }
        __syncthreads();
        EpiDown E{args.in[24], (unsigned char*)Y2};
        pg8::gemm_phase<EpiDown, SM, true>(F.lds + RING_OFF, S, E, 1024, 1024, 8);
    } SEAM(8);
    if (IN(9)) { phaseJ(F, args); }
#undef IN
#undef SEAM
}
extern "C" void kernel_launch(void* const* d_in, const int* in_sizes, int n_in, void* d_out, int out_size, void* d_ws, size_t ws_size, hipStream_t stream) {
    if (n_in != 25 || in_sizes[0] != NTOK * D || out_size != NTOK * D || ws_size < WS_END) { fprintf(stderr, "kernel_launch: unexpected shapes (n_in %d in0 %d out %d ws %zu)\n", n_in, n_in > 0 ? in_sizes[0] : -1, out_size, ws_size); return; }
    static int grid = 0;
    if (grid == 0) {
        int dev = 0, cus = 0, per_cu = 0;
        if (hipGetDevice(&dev) != hipSuccess || hipDeviceGetAttribute(&cus, hipDeviceAttributeMultiprocessorCount, dev) != hipSuccess) { fprintf(stderr, "kernel_launch: device query failed\n"); grid = -1; return; }
        if (hipFuncSetAttribute((const void*)mega_fwd, hipFuncAttributeMaxDynamicSharedMemorySize, LDS_BYTES) != hipSuccess) { fprintf(stderr, "kernel_launch: hipFuncSetAttribute failed\n"); grid = -1; return; }
        if (hipOccupancyMaxActiveBlocksPerMultiprocessor(&per_cu, (const void*)mega_fwd, NWAVES * 64, LDS_BYTES) != hipSuccess || per_cu < 1) { fprintf(stderr, "kernel_launch: occupancy query says %d\n", per_cu); }
        (void)hipGetLastError();
        grid = cus;
    }
    if (grid < 0) return;
    if (hipMemsetAsync((unsigned char*)d_ws + WS_CTL, 0, CTL_ZERO_BYTES, stream) != hipSuccess) { fprintf(stderr, "kernel_launch: memset failed\n"); return; }
    Args a{};
    for (int i = 0; i < 25; ++i) a.in[i] = (const float*)d_in[i];
    a.out = (float*)d_out; a.ws = (unsigned char*)d_ws; a.ph_lo = 0; a.ph_hi = N_PHASES;
    hipLaunchKernelGGL(mega_fwd, dim3(grid), dim3(NWAVES * 64), LDS_BYTES, stream, a);
    if (hipPeekAtLastError() != hipSuccess) fprintf(stderr, "kernel_launch: launch failed\n");
}
```

```cpp
#include <hip/hip_runtime.h>
#include <cstdio>
#include <cstdint>

constexpr int NB = 4, SEQ = 8192, D = 1024, NTOK = NB * SEQ;
constexpr int NHEAD = 8, CHUNK = 64, NLEFT = 8, NREL = 257;
constexpr int SGB = 128;
constexpr int INW = 2560, NEXP = 32, TOPK = 4;
constexpr float EPS = 1e-6f, SWL = 7.0f, SWA = 1.702f;
constexpr float LOG2E = 1.4426950408889634f;
constexpr float QSCALE = 0.125f * LOG2E;
constexpr int SH1 = 0, SC1 = 1024, GT1 = 2048, SH2 = 3072, SC2 = 4096, GT2 = 5120;
typedef unsigned short bf16;

constexpr size_t MiB = 1u << 20;
constexpr size_t WS_CTL = 0, CTL_ZERO_BYTES = 64 * 1024;
constexpr size_t WS_MOD = 1 * MiB;
constexpr size_t WS_W1T = 2 * MiB, WS_WBRT = 12 * MiB, WS_WOUTT = 14 * MiB, WS_WRT = 16 * MiB;
constexpr size_t WS_TOPE = 17 * MiB, WS_TOPG = 18 * MiB, WS_LIST = 19 * MiB;
constexpr size_t WS_WGUT = 32 * MiB, WS_WDNT = 160 * MiB;
constexpr size_t WS_XN = 224 * MiB;
constexpr size_t WS_Q = 288 * MiB, WS_K = 320 * MiB, WS_V = 352 * MiB, WS_U = 384 * MiB, WS_VG = 416 * MiB;
constexpr size_t WS_GT = 448 * MiB;
constexpr size_t WS_YAB = 576 * MiB, WS_MRG = 640 * MiB, WS_Y1 = 704 * MiB;
constexpr size_t WS_ACT = 288 * MiB;
constexpr size_t WS_Y2 = 576 * MiB;
constexpr size_t WS_WG8 = 24 * MiB;
constexpr size_t WS_XN8A = 832 * MiB;
constexpr size_t WS_END = 960 * MiB;
constexpr int CW_CNT = 1024;

#define LAS __attribute__((address_space(3)))
#define GAS __attribute__((address_space(1)))
typedef short bf16x8 __attribute__((ext_vector_type(8)));
typedef short s16x4 __attribute__((ext_vector_type(4)));
typedef float f32x4 __attribute__((ext_vector_type(4)));
typedef float f32x2 __attribute__((ext_vector_type(2)));
typedef float f32x16 __attribute__((ext_vector_type(16)));
typedef unsigned u32x4 __attribute__((ext_vector_type(4)));
typedef unsigned u32x2 __attribute__((ext_vector_type(2)));
typedef __bf16 bf16x2_t __attribute__((ext_vector_type(2)));
constexpr int NWAVES = 8;
constexpr int TRASH_SLOT = NTOK * 4;

__device__ __forceinline__ unsigned cvtpk(float lo, float hi) { f32x2 v = {lo, hi}; bf16x2_t b = __builtin_convertvector(v, bf16x2_t); return __builtin_bit_cast(unsigned, b); }
__device__ __forceinline__ float wsum(float v) {
    v += __builtin_bit_cast(float, __builtin_amdgcn_update_dpp(0, __builtin_bit_cast(int, v), 0xB1, 0xF, 0xF, true));
    v += __builtin_bit_cast(float, __builtin_amdgcn_update_dpp(0, __builtin_bit_cast(int, v), 0x4E, 0xF, 0xF, true));
    v += __builtin_bit_cast(float, __builtin_amdgcn_update_dpp(0, __builtin_bit_cast(int, v), 0x124, 0xF, 0xF, true));
    v += __builtin_bit_cast(float, __builtin_amdgcn_update_dpp(0, __builtin_bit_cast(int, v), 0x128, 0xF, 0xF, true));
    const int iv = __builtin_bit_cast(int, v);
    const float s0 = __builtin_bit_cast(float, __builtin_amdgcn_readlane(iv, 0)), s1 = __builtin_bit_cast(float, __builtin_amdgcn_readlane(iv, 16));
    const float s2 = __builtin_bit_cast(float, __builtin_amdgcn_readlane(iv, 32)), s3 = __builtin_bit_cast(float, __builtin_amdgcn_readlane(iv, 48));
    return (s0 + s1) + (s2 + s3);
}
__device__ __forceinline__ float clamp8(float v) { return fminf(fmaxf(v, -448.0f), 448.0f); }
__device__ __forceinline__ unsigned pk_fp8x4(float a, float b, float c, float d) {
    int w = 0; w = __builtin_amdgcn_cvt_pk_fp8_f32(clamp8(a), clamp8(b), w, false); w = __builtin_amdgcn_cvt_pk_fp8_f32(clamp8(c), clamp8(d), w, true); return (unsigned)w; }
__device__ __forceinline__ unsigned pk_fp8x4_nc(float a, float b, float c, float d) {
    int w = 0; w = __builtin_amdgcn_cvt_pk_fp8_f32(a, b, w, false); w = __builtin_amdgcn_cvt_pk_fp8_f32(c, d, w, true); return (unsigned)w; }
constexpr float F8_YSCALE = 16.0f;
constexpr size_t WS_X1B = 768 * MiB;
constexpr float F8_WSCALE = 64.0f, F8_ASCALE = 4.0f, F8_DESCALE = 1.0f / (64.0f * 4.0f);
__device__ __forceinline__ float bflo(unsigned w) { return __uint_as_float(w << 16); }
__device__ __forceinline__ float bfhi(unsigned w) { return __uint_as_float(w & 0xffff0000u); }
__device__ __forceinline__ float fast_sigmoid(float x) { return __builtin_amdgcn_rcpf(1.0f + __builtin_amdgcn_exp2f(-LOG2E * x)); }
__device__ __forceinline__ f32x2 sigmoid_pk(f32x2 v) { const f32x2 t = v * (-LOG2E); f32x2 e; e.x = __builtin_amdgcn_exp2f(t.x); e.y = __builtin_amdgcn_exp2f(t.y); const f32x2 d = e + 1.0f; f32x2 r; r.x = __builtin_amdgcn_rcpf(d.x); r.y = __builtin_amdgcn_rcpf(d.y); return r; }
__device__ __forceinline__ f32x2 gelu_pk(f32x2 v) {
    const f32x2 av = __builtin_elementwise_abs(v), d = av * 0.2316418882f + 1.0f;
    f32x2 t; t.x = __builtin_amdgcn_rcpf(d.x); t.y = __builtin_amdgcn_rcpf(d.y);
    f32x2 q = t * 0.5307027145f + (-0.7265760135f); q = q * t + 0.7107068705f; q = q * t + (-0.142248368f); q = q * t + 0.127414796f; q = q * t;
    const f32x2 s = (v * v) * (-0.72134752044f);
    f32x2 e; e.x = __builtin_amdgcn_exp2f(s.x); e.y = __builtin_amdgcn_exp2f(s.y);
    const f32x2 m = v * (q * e), r = v - m;
    f32x2 o; o.x = v.x < 0.f ? m.x : r.x; o.y = v.y < 0.f ? m.y : r.y; return o;
}

constexpr int RING_OFF = 0, RING_BYTES = 131072;
constexpr int GTAB_OFF = RING_BYTES, GTAB_UNITS = 20, GTAB_BYTES = GTAB_UNITS * 256 * 4;
constexpr int MISC_OFF = GTAB_OFF + GTAB_BYTES;
constexpr int LDS_BYTES = MISC_OFF + 512;
static_assert(LDS_BYTES <= 160 * 1024, "LDS map");

#define XB_TMO      128
#define XB_XCNT(j)  (256  + 64 * (j))
#define XB_XSUB(j)  (1280 + 64 * (j))
#define XB_XGEN(j)  (2304 + 64 * (j))
#define XB_TOP      3328
#define XB_TOPGEN   3392
#define XCD_BAR_WORDS 3456
#define XB_SPIN_CAP (1u << 18)
__device__ __forceinline__ unsigned xb_ld(unsigned* p)              { return __hip_atomic_load(p, __ATOMIC_RELAXED, __HIP_MEMORY_SCOPE_AGENT); }
__device__ __forceinline__ unsigned xb_add(unsigned* p, unsigned v) { return __hip_atomic_fetch_add(p, v, __ATOMIC_RELAXED, __HIP_MEMORY_SCOPE_AGENT); }
__device__ __forceinline__ unsigned xb_xcc_id() { return (unsigned)__builtin_amdgcn_s_getreg((3 << 11) | 20) & 0xFu; }
#define XB_SPIN(cond, bar) do { unsigned _sp = 0; while (cond) { __builtin_amdgcn_s_sleep(1); \
    if ((++_sp & 255u) == 0u) { if (xb_ld(&(bar)[XB_TMO])) break; if (_sp > XB_SPIN_CAP) { atomicAdd(&(bar)[XB_TMO], 1u); break; } } } } while (0)
struct XcdBarrier { unsigned* bar; unsigned x; volatile LAS unsigned* st; };
__device__ __forceinline__ XcdBarrier xcd_barrier_post(unsigned* bar, volatile LAS unsigned* st) {
    XcdBarrier b; b.bar = bar; b.x = xb_xcc_id(); b.st = st;
    if (threadIdx.x == 0) (void)xb_add(&bar[XB_XCNT(b.x)], 1u);
    return b;
}
__device__ __forceinline__ void xcd_barrier_complete(unsigned* bar, unsigned x, unsigned& nloc, unsigned& nx) {
    const unsigned G = gridDim.x * gridDim.y * gridDim.z;
    unsigned sum, cnt, mine, sp = 0u;
    for (;;) {
        sum = 0u; cnt = 0u; mine = 0u;
#pragma unroll
        for (unsigned j = 0; j < 16; ++j) { const unsigned c = xb_ld(&bar[XB_XCNT(j)]); sum += c; cnt += (c > 0u) ? 1u : 0u; mine = (j == x) ? c : mine; }
        if (sum == G) break;
        __builtin_amdgcn_s_sleep(1);
        if ((++sp & 255u) == 0u) { if (xb_ld(&bar[XB_TMO])) break; if (sp > XB_SPIN_CAP) { atomicAdd(&bar[XB_TMO], 1u); break; } }
    }
    nloc = mine > 0u ? mine : 1u; nx = cnt > 0u ? cnt : 1u;
}
__device__ __forceinline__ void xcd_barrier(const XcdBarrier& b) {
    asm volatile("s_waitcnt vmcnt(0)" ::: "memory");
    __syncthreads();
    if (threadIdx.x == 0) {
        unsigned* bar = b.bar;
        __builtin_amdgcn_s_waitcnt(0);
        unsigned nloc = b.st[0], nx = b.st[1];
        if (nloc == 0u) { xcd_barrier_complete(bar, b.x, nloc, nx); b.st[0] = nloc; b.st[1] = nx; }
        const unsigned old = xb_add(&bar[XB_XSUB(b.x)], 1u);
        const unsigned gen = old / nloc;
        if (old + 1u == (gen + 1u) * nloc) {
            __builtin_amdgcn_fence(__ATOMIC_RELEASE, "agent");
            asm volatile("s_waitcnt vmcnt(0)" ::: "memory");
            const unsigned og = xb_add(&bar[XB_TOP], 1u);
            const unsigned tg = og / nx;
            if (og + 1u == (tg + 1u) * nx) xb_add(&bar[XB_TOPGEN], 1u);
            else XB_SPIN(xb_ld(&bar[XB_TOPGEN]) == tg, bar);
            __builtin_amdgcn_fence(__ATOMIC_ACQUIRE, "agent");
            xb_add(&bar[XB_XGEN(b.x)], 1u);
            asm volatile("s_waitcnt vmcnt(0)" ::: "memory");
        } else {
            XB_SPIN(xb_ld(&bar[XB_XGEN(b.x)]) == gen, bar);
            __builtin_amdgcn_fence(__ATOMIC_ACQUIRE, "agent");
            asm volatile("s_waitcnt vmcnt(0)" ::: "memory");
        }
    }
    __syncthreads();
}
constexpr int CW_BAR = 4096;

namespace pg8 {
constexpr int BM = 256, BK = 64, HALF = 128, HTB = HALF * BK * 2, STAGE_BYTES = 8 * HTB, NXCD = 8, WGM = 8;
__host__ __device__ __forceinline__ int lds_byte(int r, int c) { return r * 128 + ((((c >> 3) ^ (r >> 1)) & 7) << 4); }
__host__ __device__ __forceinline__ void stage_rc(int b, int& R, int& C) { R = b >> 7; C = ((((b >> 4) ^ (R >> 1)) & 7) << 3); }
__host__ __device__ __forceinline__ int perm32(int rho) { const int n = rho >> 4, i = rho & 15; return 8 * (i >> 2) + 4 * n + (i & 3); }
struct Unit { int pm, pn, aux; };
typedef int v4i_t __attribute__((ext_vector_type(4)));
typedef int v8i_t __attribute__((ext_vector_type(8)));

__device__ __forceinline__ bool static_unit(int i, int G, int c, int nM, int nN, int& pm, int& pn) {
    const int nwg = nM * nN; const long L = (long)i * G + c; if (L >= nwg) return false;
    int wgid = (int)L; { const int q = nwg / NXCD, r = nwg % NXCD, xcd = wgid % NXCD, off = wgid / NXCD; wgid = (xcd < r ? xcd * (q + 1) : r * (q + 1) + (xcd - r) * q) + off; }
    const int nig = WGM * nN, gid = wgid / nig, fm = gid * WGM, gsz = (nM - fm) < WGM ? (nM - fm) : WGM;
    pm = fm + ((wgid % nig) % gsz); pn = (wgid % nig) / gsz; return true;
}

template <class Epi, class Sched, bool FP8>
__device__ __forceinline__ void gemm_phase(LAS unsigned char* lds, const Sched& S, const Epi& E, const int lda, const int ldb, const int nt) {
    const int tid = threadIdx.x, wid = __builtin_amdgcn_readfirstlane(tid >> 6), lane = tid & 63, wr = wid >> 2, wc = wid & 3, fr = lane & 15, fq = lane >> 4;
    int Rr[2], Cc[2]; unsigned voffB[2];
#pragma unroll
    for (int i = 0; i < 2; ++i) { stage_rc(tid * 16 + i * 8192, Rr[i], Cc[i]); const int Rb = (Rr[i] & ~31) + perm32(Rr[i] & 31); voffB[i] = (unsigned)(Rb * ldb + Cc[i] * 2); }
    const size_t kstep = (size_t)(BK * 2);
    const size_t hstepB = (size_t)HALF * ldb;
    const size_t hstepA = Sched::GATHER ? (size_t)0 : (size_t)HALF * lda;
    const unsigned ldsw = (unsigned)wid * 1024u;
    const int aoff = lds_byte(wr * 64 + fr, fq * 8), boff = lds_byte(wc * 32 + fr, fq * 8);
#define PG8_SA(b, h) (((b) * 2 + (h)) * HTB)
#define PG8_SB(b, h) ((4 + (b) * 2 + (h)) * HTB)
#define PG8_STAGE(bufoff, gbase, voff) do { _Pragma("unroll") for (int _i = 0; _i < 2; ++_i) \
        __builtin_amdgcn_global_load_lds((const unsigned*)((const char*)(gbase) + (voff)[_i]), (LAS unsigned*)(lds + (bufoff) + ldsw + _i * 8192), 16, 0, 0); } while (0)
#define PG8_LDA(dst, b, h) do { _Pragma("unroll") for (int m = 0; m < 4; ++m) _Pragma("unroll") for (int k = 0; k < 2; ++k) dst[m][k] = *(const LAS bf16x8*)(lds + PG8_SA(b, h) + (aoff ^ (k * 64)) + m * 2048); } while (0)
#define PG8_LDB(dst, b, h) do { _Pragma("unroll") for (int n = 0; n < 2; ++n) _Pragma("unroll") for (int k = 0; k < 2; ++k) dst[n][k] = *(const LAS bf16x8*)(lds + PG8_SB(b, h) + (boff ^ (k * 64)) + n * 2048); } while (0)
#define PG8_CAT(x) __builtin_shufflevector(__builtin_bit_cast(v4i_t, (x)[0]), __builtin_bit_cast(v4i_t, (x)[1]), 0, 1, 2, 3, 4, 5, 6, 7)
#define PG8_MMA(ai, bj, At, Bt) do { __builtin_amdgcn_s_setprio(1); if constexpr (FP8) { _Pragma("unroll") for (int m = 0; m < 4; ++m) _Pragma("unroll") for (int n = 0; n < 2; ++n) \
        acc[ai][bj][m][n] = __builtin_amdgcn_mfma_scale_f32_16x16x128_f8f6f4(PG8_CAT(Bt[n]), PG8_CAT(At[m]), acc[ai][bj][m][n], 0, 0, 0, 0, 0, 0); }   \
    else { _Pragma("unroll") for (int m = 0; m < 4; ++m) _Pragma("unroll") for (int n = 0; n < 2; ++n) _Pragma("unroll") for (int k = 0; k < 2; ++k) \
        acc[ai][bj][m][n] = __builtin_amdgcn_mfma_f32_16x16x32_bf16(Bt[n][k], At[m][k], acc[ai][bj][m][n], 0, 0, 0); } __builtin_amdgcn_s_setprio(0); } while (0)
#define PG8_WAIT_V(n) asm volatile("s_waitcnt vmcnt(" #n ")" ::: "memory")
#define PG8_WAIT_L(n) asm volatile("s_waitcnt lgkmcnt(" #n ")" ::: "memory")
#define PG8_BAR __builtin_amdgcn_s_barrier()
#define PG8_SCHED __builtin_amdgcn_sched_barrier(0)
    Unit cur, nxt; int ui = 0;
    if (!S.next(0, cur)) return;
    f32x4 acc[2][2][4][2];
#pragma unroll
    for (int a = 0; a < 2; ++a)
#pragma unroll
        for (int b = 0; b < 2; ++b)
#pragma unroll
            for (int m = 0; m < 4; ++m)
#pragma unroll
                for (int n = 0; n < 2; ++n) acc[a][b][m][n] = (f32x4){0.f, 0.f, 0.f, 0.f};
    bf16x8 At[4][2], B0[2][2], B1[2][2];
    unsigned oA[2][2];
#pragma unroll
    for (int h = 0; h < 2; ++h)
#pragma unroll
        for (int i = 0; i < 2; ++i) oA[h][i] = Sched::GATHER ? (S.goff(0, h * HALF + Rr[i]) + (unsigned)Cc[i] * 2u) : (unsigned)(Rr[i] * lda + Cc[i] * 2);
    const char* cA = S.aptr(cur); const char* cB = S.bptr(cur);
    PG8_STAGE(PG8_SB(0, 0), cB, voffB); PG8_STAGE(PG8_SB(0, 1), cB + hstepB, voffB); PG8_STAGE(PG8_SA(0, 0), cA, oA[0]); PG8_STAGE(PG8_SA(0, 1), cA + hstepA, oA[1]);
    if (wr == 1) PG8_BAR;
    PG8_WAIT_V(2); PG8_BAR;
    PG8_STAGE(PG8_SB(1, 0), cB + kstep, voffB); PG8_STAGE(PG8_SA(1, 0), cA + kstep, oA[0]); PG8_STAGE(PG8_SB(1, 1), cB + hstepB + kstep, voffB);
    PG8_WAIT_V(6); PG8_BAR;
    for (;;) {
        const bool has_next = S.next(ui + 1, nxt);
        const char* nA = has_next ? S.aptr(nxt) : cA; const char* nB = has_next ? S.bptr(nxt) : cB;
#pragma clang loop unroll(disable)
        for (int t = 0; t < nt; t += 2) {
            const bool last = (t == nt - 2);
            const char* a1 = cA + (size_t)(t + 1) * kstep;
            const char* a2 = last ? nA : cA + (size_t)(t + 2) * kstep; const char* b2 = last ? nB : cB + (size_t)(t + 2) * kstep;
            const char* a3 = a2 + kstep; const char* b3 = b2 + kstep;
            PG8_LDB(B0, 0, 0); PG8_LDB(B1, 0, 1); PG8_SCHED; PG8_LDA(At, 0, 0); PG8_STAGE(PG8_SA(1, 1), a1 + hstepA, oA[1]);
            if constexpr (Sched::GATHER) { if (last && has_next) {
#pragma unroll
                for (int h = 0; h < 2; ++h)
#pragma unroll
                    for (int i = 0; i < 2; ++i) oA[h][i] = S.goff(ui + 1, h * HALF + Rr[i]) + (unsigned)Cc[i] * 2u; } }
            PG8_WAIT_V(8); PG8_WAIT_L(0); PG8_BAR; PG8_MMA(0, 0, At, B0); PG8_MMA(0, 1, At, B1); PG8_BAR; PG8_SCHED;
            PG8_LDA(At, 0, 1); PG8_STAGE(PG8_SB(0, 0), b2, voffB); PG8_STAGE(PG8_SB(0, 1), b2 + hstepB, voffB); PG8_STAGE(PG8_SA(0, 0), a2, oA[0]);
            PG8_WAIT_V(8); PG8_WAIT_L(0); PG8_BAR; PG8_MMA(1, 0, At, B0); PG8_MMA(1, 1, At, B1); PG8_BAR; PG8_SCHED;
            PG8_LDB(B0, 1, 0); PG8_LDB(B1, 1, 1); PG8_SCHED; PG8_LDA(At, 1, 0); PG8_STAGE(PG8_SA(0, 1), a2 + hstepA, oA[1]);
            PG8_WAIT_V(8); PG8_WAIT_L(0); PG8_BAR; PG8_MMA(0, 0, At, B0); PG8_MMA(0, 1, At, B1); PG8_BAR; PG8_SCHED;
            PG8_LDA(At, 1, 1); PG8_STAGE(PG8_SB(1, 0), b3, voffB); PG8_STAGE(PG8_SB(1, 1), b3 + hstepB, voffB); PG8_STAGE(PG8_SA(1, 0), a3, oA[0]);
            PG8_WAIT_V(8); PG8_WAIT_L(0); PG8_BAR; PG8_MMA(1, 0, At, B0); PG8_MMA(1, 1, At, B1); PG8_BAR; PG8_SCHED;
        }
        if (wr == 0) PG8_BAR;
        bool keep = false;
        {
            int tz = threadIdx.x; asm volatile("" : "+v"(tz)); const int ewid = tz >> 6, el = tz & 63, ewr = ewid >> 2, ewc = ewid & 3, efr = el & 15, efq = el >> 4;
            if constexpr (Sched::HAS_MID) { if (S.is_mid(cur)) { E.mid(acc, cur, ewr, ewc, efr, efq); keep = true; } }
            if (!keep) E(acc, cur, ewr, ewc, efr, efq);
        }
        if (!has_next) break;
        if (!keep) {
#pragma unroll
            for (int a = 0; a < 2; ++a)
#pragma unroll
                for (int b = 0; b < 2; ++b)
#pragma unroll
                    for (int m = 0; m < 4; ++m)
#pragma unroll
                        for (int n = 0; n < 2; ++n) acc[a][b][m][n] = (f32x4){0.f, 0.f, 0.f, 0.f};
        }
        cur = nxt; cA = nA; cB = nB; ++ui;
        if (wr == 1) PG8_BAR;
    }
    PG8_WAIT_V(0);
    PG8_BAR;
#undef PG8_SA
#undef PG8_SB
#undef PG8_STAGE
#undef PG8_LDA
#undef PG8_LDB
#undef PG8_MMA
#undef PG8_CAT
#undef PG8_WAIT_V
#undef PG8_WAIT_L
#undef PG8_BAR
#undef PG8_SCHED
}
}
using pg8::Unit;

struct Args { const float* in[25]; float* out; unsigned char* ws; int ph_lo, ph_hi, pad0, pad1; };
static_assert(sizeof(Args) == 27 * 8 + 16, "Args has no padding");
struct Frame {
    LAS unsigned char* lds; volatile LAS unsigned* MISC; unsigned* ctl;
    int tid, lane, wave, vcu, G;
};
#define LDS_WAIT() asm volatile("s_waitcnt lgkmcnt(0)" ::: "memory")
#define VM_WAIT() asm volatile("s_waitcnt vmcnt(0)" ::: "memory")

struct SchedStatic {
    static constexpr bool GATHER = false, HAS_MID = false;
    const char* A; const char* B; int nM, nN, G, c; size_t astep, bstep;
    __device__ __forceinline__ bool next(int i, Unit& u) const { u.aux = 0; return pg8::static_unit(i, G, c, nM, nN, u.pm, u.pn); }
    __device__ __forceinline__ const char* aptr(const Unit& u) const { return A + (size_t)u.pm * astep; }
    __device__ __forceinline__ const char* bptr(const Unit& u) const { return B + (size_t)u.pn * bstep; }
    __device__ __forceinline__ bool is_mid(const Unit&) const { return false; }
    __device__ __forceinline__ unsigned goff(int, int) const { return 0u; }
};
struct SchedStaticG {
    static constexpr bool GATHER = true, HAS_MID = false;
    const char* A; const char* B; int nM, nN, G, c; size_t bstep; unsigned lda;
    __device__ __forceinline__ bool next(int i, Unit& u) const { u.aux = 0; return pg8::static_unit(i, G, c, nM, nN, u.pm, u.pn); }
    __device__ __forceinline__ const char* aptr(const Unit&) const { return A; }
    __device__ __forceinline__ const char* bptr(const Unit& u) const { return B + (size_t)u.pn * bstep; }
    __device__ __forceinline__ bool is_mid(const Unit&) const { return false; }
    __device__ __forceinline__ unsigned goff(int ui, int row) const { int pm = 0, pn = 0; pg8::static_unit(ui, G, c, nM, nN, pm, pn); return (unsigned)(pm * 256 + row) * lda; }
};
struct SchedSplit2 {
    static constexpr bool GATHER = false, HAS_MID = true;
    const char* A; const char* B; int nM, nN, G, c; size_t astep, bstep, khalf;
    __device__ __forceinline__ bool next(int i, Unit& u) const { u.aux = i & 1; return pg8::static_unit(i >> 1, G, c, nM, nN, u.pm, u.pn); }
    __device__ __forceinline__ const char* aptr(const Unit& u) const { return A + (size_t)u.pm * astep + (size_t)u.aux * khalf; }
    __device__ __forceinline__ const char* bptr(const Unit& u) const { return B + (size_t)u.pn * bstep + (size_t)u.aux * khalf; }
    __device__ __forceinline__ bool is_mid(const Unit& u) const { return u.aux == 0; }
    __device__ __forceinline__ unsigned goff(int, int) const { return 0u; }
};
__device__ __forceinline__ int moe_find_e(volatile LAS unsigned* MISC, int rb) { int e = 0;
#pragma unroll 1
    for (int i = 1; i < NEXP; ++i) e += ((int)MISC[i] <= rb) ? 1 : 0;
    return e; }
template <int NPN, bool GATH>
struct SchedMoe {
    static constexpr bool GATHER = GATH, HAS_MID = false;
    static constexpr int RPX = 32 / NPN;
    static constexpr int UT0 = 96, UTN = 24;
    const char* A; const char* B; volatile LAS unsigned* MISC; const LAS unsigned* gtab; int c, G, nrb; size_t bstep_e, bstep_n;
    __device__ __forceinline__ bool slow_next(int i, Unit& u) const {
        int rb, pn;
        if (G == 256) { const int x = c & 7, j = c >> 3; rb = (8 * i + x) * RPX + j / NPN; pn = j % NPN; }
        else { const long L = (long)i * G + c; rb = (int)(L / NPN); pn = (int)(L % NPN); }
        if (rb >= nrb) return false;
        u.pm = rb; u.pn = pn; u.aux = moe_find_e(MISC, rb); return true;
    }
    __device__ __forceinline__ void build(int tid) const {
        if (tid < UTN) { Unit u; const bool ok = slow_next(tid, u); MISC[UT0 + tid] = ok ? (0x80000000u | ((unsigned)u.aux << 16) | ((unsigned)u.pn << 12) | (unsigned)u.pm) : 0u; }
        __syncthreads();
    }
    __device__ __forceinline__ bool next(int i, Unit& u) const {
        if (i >= UTN) return false;
        const unsigned w = MISC[UT0 + i]; if (!(w >> 31)) return false;
        u.pm = (int)(w & 0xfffu); u.pn = (int)((w >> 12) & 0xfu); u.aux = (int)((w >> 16) & 0xffu); return true;
    }
    __device__ __forceinline__ const char* aptr(const Unit& u) const { return GATH ? A : A + (size_t)u.pm * (256 * 1024); }
    __device__ __forceinline__ const char* bptr(const Unit& u) const { return B + (size_t)u.aux * bstep_e + (size_t)u.pn * bstep_n; }
    __device__ __forceinline__ bool is_mid(const Unit&) const { return false; }
    __device__ __forceinline__ unsigned goff(int ui, int row) const { return gtab[ui * 256 + row]; }
};

#define EPI_ARGS f32x4 (&acc)[2][2][4][2], const Unit& u, int wr, int wc, int fr, int fq
__device__ __forceinline__ u32x4 pair16(u32x2 x, u32x2 y) {
    const auto rx = __builtin_amdgcn_permlane16_swap(x.x, y.x, false, false); const auto ry = __builtin_amdgcn_permlane16_swap(x.y, y.y, false, false);
    return (u32x4){rx[0], ry[0], rx[1], ry[1]};
}
struct EpiG1 {
    bf16 *Q, *K, *V, *U, *VG;
    __device__ __forceinline__ void mid(EPI_ARGS) const {}
    __device__ __forceinline__ void operator()(EPI_ARGS) const {
        const int pn = u.pn; const int row0 = u.pm * 256 + wr * 64 + fr;
        if (pn < 6) {
            const int t = pn >> 1; bf16* base = Q + (size_t)t * ((WS_K - WS_Q) / 2); const float sc = (t == 0) ? QSCALE : 1.0f;    const int col0 = (pn & 1) * 256 + wc * 32 + 8 * fq;
#pragma unroll
            for (int ai = 0; ai < 2; ++ai)
#pragma unroll
                for (int m = 0; m < 4; ++m) { bf16* rowp = base + (size_t)(row0 + ai * 128 + m * 16) * 512 + col0;
#pragma unroll
                    for (int bj = 0; bj < 2; ++bj) { const f32x4 v0 = acc[ai][bj][m][0] * sc, v1 = acc[ai][bj][m][1] * sc;
                        u32x4 w; w.x = cvtpk(v0[0], v0[1]); w.y = cvtpk(v0[2], v0[3]); w.z = cvtpk(v1[0], v1[1]); w.w = cvtpk(v1[2], v1[3]); *(u32x4*)(rowp + bj * 128) = w; } }
        } else {
            bf16* base = Q + (size_t)(pn >> 1) * ((WS_K - WS_Q) / 2); const int col0 = (pn & 1) * 256 + wc * 32 + 8 * fq;
#pragma unroll
            for (int ai = 0; ai < 2; ++ai)
#pragma unroll
                for (int m = 0; m < 4; ++m) { bf16* rowp = base + (size_t)(row0 + ai * 128 + m * 16) * 512 + col0;
#pragma unroll
                    for (int bj = 0; bj < 2; ++bj) { const f32x4 v0 = acc[ai][bj][m][0], v1 = acc[ai][bj][m][1];
                        const f32x2 a = gelu_pk((f32x2){v0[0], v0[1]}), b = gelu_pk((f32x2){v0[2], v0[3]}), c = gelu_pk((f32x2){v1[0], v1[1]}), d = gelu_pk((f32x2){v1[2], v1[3]});
                        u32x4 w; w.x = cvtpk(a.x, a.y); w.y = cvtpk(b.x, b.y); w.z = cvtpk(c.x, c.y); w.w = cvtpk(d.x, d.y); *(u32x4*)(rowp + bj * 128) = w; } }
        }
    }
};
struct EpiGate {
    bf16* GT; const float* bgate;
    __device__ __forceinline__ void mid(EPI_ARGS) const {}
    __device__ __forceinline__ void operator()(EPI_ARGS) const {
        const int row0 = u.pm * 256 + wr * 64 + fr;
        {
            const int col0 = u.pn * 128 + wc * 32 + 8 * fq;
            const f32x4 ba0 = *(const f32x4*)(bgate + col0), ba1 = *(const f32x4*)(bgate + col0 + 4), bb0 = *(const f32x4*)(bgate + 1024 + col0), bb1 = *(const f32x4*)(bgate + 1024 + col0 + 4);
#pragma unroll
            for (int ai = 0; ai < 2; ++ai)
#pragma unroll
                for (int m = 0; m < 4; ++m) { bf16* rowp = GT + (size_t)(row0 + ai * 128 + m * 16) * 2048 + col0;
                    const f32x4 a0 = acc[ai][0][m][0] * F8_DESCALE + ba0, a1 = acc[ai][0][m][1] * F8_DESCALE + ba1, b0 = acc[ai][1][m][0] * F8_DESCALE + bb0, b1 = acc[ai][1][m][1] * F8_DESCALE + bb1;
                    f32x4 ea0, ea1, eb0, eb1;
#pragma unroll
                    for (int i = 0; i < 4; ++i) { ea0[i] = __builtin_amdgcn_exp2f(-LOG2E * a0[i]); ea1[i] = __builtin_amdgcn_exp2f(-LOG2E * a1[i]); eb0[i] = fminf(__builtin_amdgcn_exp2f(-LOG2E * b0[i]), 1e18f); eb1[i] = fminf(__builtin_amdgcn_exp2f(-LOG2E * b1[i]), 1e18f); }
                    f32x4 gb0, gb1, r0, r1;
#pragma unroll
                    for (int i = 0; i < 4; ++i) { gb0[i] = __builtin_amdgcn_rcpf(1.0f + eb0[i]); gb1[i] = __builtin_amdgcn_rcpf(1.0f + eb1[i]); r0[i] = (1.0f + eb0[i]) * __builtin_amdgcn_rcpf(1.0f + ea0[i]); r1[i] = (1.0f + eb1[i]) * __builtin_amdgcn_rcpf(1.0f + ea1[i]); }
                    u32x4 wr, wb; wr.x = cvtpk(r0[0], r0[1]); wr.y = cvtpk(r0[2], r0[3]); wr.z = cvtpk(r1[0], r1[1]); wr.w = cvtpk(r1[2], r1[3]);
                    wb.x = cvtpk(gb0[0], gb0[1]); wb.y = cvtpk(gb0[2], gb0[3]); wb.z = cvtpk(gb1[0], gb1[1]); wb.w = cvtpk(gb1[2], gb1[3]);
                    __builtin_nontemporal_store(wr, (u32x4*)rowp); __builtin_nontemporal_store(wb, (u32x4*)(rowp + 1024)); }
        }
    }
};
struct EpiG2 {
    const bf16* GT; bf16* MRG;
    __device__ __forceinline__ void mid(EPI_ARGS) const {
        const int row0 = u.pm * 256 + wr * 64 + fr, col0 = u.pn * 256 + wc * 32 + 8 * fq;
#pragma unroll
        for (int ai = 0; ai < 2; ++ai)
#pragma unroll
            for (int m = 0; m < 4; ++m) { const bf16* gp = GT + (size_t)(row0 + ai * 128 + m * 16) * 2048 + col0;
#pragma unroll
                for (int bj = 0; bj < 2; ++bj) { const u32x4 rr = __builtin_nontemporal_load((const u32x4*)(gp + bj * 128));
                    const f32x4 r0 = {bflo(rr.x), bfhi(rr.x), bflo(rr.y), bfhi(rr.y)}, r1 = {bflo(rr.z), bfhi(rr.z), bflo(rr.w), bfhi(rr.w)};
                    acc[ai][bj][m][0] *= r0; acc[ai][bj][m][1] *= r1; } }
    }
    __device__ __forceinline__ void operator()(EPI_ARGS) const {
        const int row0 = u.pm * 256 + wr * 64 + fr, col0 = u.pn * 256 + wc * 32 + 8 * fq;
#pragma unroll
        for (int ai = 0; ai < 2; ++ai)
#pragma unroll
            for (int m = 0; m < 4; ++m) { const size_t r = (size_t)(row0 + ai * 128 + m * 16); const bf16* gp = GT + r * 2048 + 1024 + col0; bf16* op = MRG + r * 1024 + col0;
#pragma unroll
                for (int bj = 0; bj < 2; ++bj) { const u32x4 gb = __builtin_nontemporal_load((const u32x4*)(gp + bj * 128)); const f32x4 v0 = acc[ai][bj][m][0], v1 = acc[ai][bj][m][1];
                    u32x4 w; w.x = cvtpk(v0[0] * bflo(gb.x), v0[1] * bfhi(gb.x)); w.y = cvtpk(v0[2] * bflo(gb.y), v0[3] * bfhi(gb.y));
                    w.z = cvtpk(v1[0] * bflo(gb.z), v1[1] * bfhi(gb.z)); w.w = cvtpk(v1[2] * bflo(gb.w), v1[3] * bfhi(gb.w)); *(u32x4*)(op + bj * 128) = w; } }
    }
};
struct EpiPlain {
    bf16* O;
    __device__ __forceinline__ void mid(EPI_ARGS) const {}
    __device__ __forceinline__ void operator()(EPI_ARGS) const {
        const int row0 = u.pm * 256 + wr * 64 + fr, col0 = u.pn * 256 + wc * 32 + 8 * fq;
#pragma unroll
        for (int ai = 0; ai < 2; ++ai)
#pragma unroll
            for (int m = 0; m < 4; ++m) { bf16* op = O + (size_t)(row0 + ai * 128 + m * 16) * 1024 + col0;
#pragma unroll
                for (int bj = 0; bj < 2; ++bj) { const f32x4 v0 = acc[ai][bj][m][0], v1 = acc[ai][bj][m][1];
                    u32x4 w; w.x = cvtpk(v0[0], v0[1]); w.y = cvtpk(v0[2], v0[3]); w.z = cvtpk(v1[0], v1[1]); w.w = cvtpk(v1[2], v1[3]); *(u32x4*)(op + bj * 128) = w; } }
    }
};
struct EpiAct {
    const float* bgu; unsigned char* ACT8;
    __device__ __forceinline__ void mid(EPI_ARGS) const {}
    __device__ __forceinline__ f32x2 act2(f32x2 g, f32x2 l) const {
        f32x2 xg, xl; xg.x = fminf(g.x, SWL); xg.y = fminf(g.y, SWL); xl.x = fminf(fmaxf(l.x, -SWL), SWL); xl.y = fminf(fmaxf(l.y, -SWL), SWL);
        const f32x2 t = xg * (-SWA * LOG2E); f32x2 e; e.x = __builtin_amdgcn_exp2f(t.x); e.y = __builtin_amdgcn_exp2f(t.y);
        const f32x2 d = e + 1.0f; f32x2 r; r.x = __builtin_amdgcn_rcpf(d.x); r.y = __builtin_amdgcn_rcpf(d.y);
        return (xg * r) * (xl * F8_ASCALE + F8_ASCALE);
    }
    __device__ __forceinline__ void operator()(EPI_ARGS) const {
        const int e = u.aux; const int row0 = u.pm * 256 + wr * 64 + fr, col0 = u.pn * 128 + wc * 32 + 8 * fq;
        const float* bp = bgu + (size_t)e * 2048 + col0;
        const f32x4 bg0 = *(const f32x4*)(bp), bg1 = *(const f32x4*)(bp + 4), bl0 = *(const f32x4*)(bp + 1024), bl1 = *(const f32x4*)(bp + 1028);
#pragma unroll
        for (int ai = 0; ai < 2; ++ai)
#pragma unroll
            for (int mp = 0; mp < 2; ++mp) {
                u32x2 w[2];
#pragma unroll
                for (int mm = 0; mm < 2; ++mm) { const int m = 2 * mp + mm;
                    const f32x4 g0 = acc[ai][0][m][0] * F8_DESCALE + bg0, g1 = acc[ai][0][m][1] * F8_DESCALE + bg1, l0 = acc[ai][1][m][0] * F8_DESCALE + bl0, l1 = acc[ai][1][m][1] * F8_DESCALE + bl1;
                    const f32x2 o0 = act2((f32x2){g0[0], g0[1]}, (f32x2){l0[0], l0[1]}), o1 = act2((f32x2){g0[2], g0[3]}, (f32x2){l0[2], l0[3]});
                    const f32x2 o2 = act2((f32x2){g1[0], g1[1]}, (f32x2){l1[0], l1[1]}), o3 = act2((f32x2){g1[2], g1[3]}, (f32x2){l1[2], l1[3]});
                    w[mm].x = pk_fp8x4_nc(o0.x, o0.y, o1.x, o1.y); w[mm].y = pk_fp8x4_nc(o2.x, o2.y, o3.x, o3.y); }
                *(u32x4*)(ACT8 + (size_t)(row0 + ai * 128 + (2 * mp + (fq & 1)) * 16) * 1024 + (col0 - 8 * (fq & 1))) = pair16(w[0], w[1]); }
    }
};
struct EpiDown {
    const float* bdn; unsigned char* Y2s;
    __device__ __forceinline__ void mid(EPI_ARGS) const {}
    __device__ __forceinline__ void operator()(EPI_ARGS) const {
        const int e = u.aux; const int row0 = u.pm * 256 + wr * 64 + fr, col0 = u.pn * 256 + wc * 32 + 8 * fq;
        f32x4 bv[2][2];
#pragma unroll
        for (int bj = 0; bj < 2; ++bj)
#pragma unroll
            for (int n = 0; n < 2; ++n) bv[bj][n] = *(const f32x4*)(bdn + (size_t)e * 1024 + col0 + bj * 128 + 4 * n) * F8_YSCALE;
#pragma unroll
        for (int ai = 0; ai < 2; ++ai)
#pragma unroll
            for (int mp = 0; mp < 2; ++mp) { unsigned char* op = Y2s + (size_t)(row0 + ai * 128 + (2 * mp + (fq & 1)) * 16) * 1024 + (col0 - 8 * (fq & 1));
#pragma unroll
                for (int bj = 0; bj < 2; ++bj) { u32x2 w[2];
#pragma unroll
                    for (int mm = 0; mm < 2; ++mm) { const int m = 2 * mp + mm;
                        const f32x4 v0 = acc[ai][bj][m][0] * (F8_DESCALE * F8_YSCALE) + bv[bj][0], v1 = acc[ai][bj][m][1] * (F8_DESCALE * F8_YSCALE) + bv[bj][1];
                        w[mm].x = pk_fp8x4(v0[0], v0[1], v0[2], v0[3]); w[mm].y = pk_fp8x4(v1[0], v1[1], v1[2], v1[3]); }
                    *(u32x4*)(op + bj * 128) = pair16(w[0], w[1]); } }
    }
};

struct WItem { const float* W; unsigned char* dst; int N, k0, n0, ldt, drow, dk0, fp8; };
__device__ __forceinline__ WItem witem_decode(const Args& a, int r) {
    unsigned char* ws = a.ws; WItem it;
    constexpr int I_IN = 8 * 80, I_GATE = 8 * 64, I_BR = 4 * 32, I_OUT = 8 * 32, I_GU = 8 * 64, I_DN = 8 * 32;
    it.fp8 = 0; it.dk0 = 0; it.ldt = 2048;
    if (r < I_IN) { it.W = a.in[6]; it.N = INW; it.k0 = 128 * (r / 80); it.n0 = 32 * (r % 80); it.dst = ws + WS_W1T; it.drow = it.n0; return it; } r -= I_IN;
    if (r < I_GATE) { it.W = a.in[14]; it.N = 2048; it.k0 = 128 * (r / 64); it.n0 = 32 * (r % 64); it.dst = ws + WS_WG8; const int m0 = it.n0 & 1023; it.fp8 = 1; it.ldt = 1024;
        it.drow = 256 * (m0 >> 7) + (m0 & 127) + (it.n0 >= 1024 ? 128 : 0); return it; } r -= I_GATE;
    if (r < I_BR) { it.W = a.in[12]; it.N = 1024; it.k0 = 128 * (r / 32); it.n0 = 32 * (r % 32); it.dst = ws + WS_WBRT; it.drow = it.n0; return it; } r -= I_BR;
    if (r < I_BR) { it.W = a.in[13]; it.N = 1024; it.k0 = 128 * (r / 32); it.n0 = 32 * (r % 32); it.dst = ws + WS_WBRT; it.drow = it.n0; it.dk0 = 512; return it; } r -= I_BR;
    if (r < I_OUT) { it.W = a.in[16]; it.N = 1024; it.k0 = 128 * (r / 32); it.n0 = 32 * (r % 32); it.dst = ws + WS_WOUTT; it.drow = it.n0; return it; } r -= I_OUT;
    it.fp8 = 1; it.ldt = 1024;
    if (r < NEXP * I_GU) { const int e = r / I_GU, q = r % I_GU; it.W = a.in[21] + (size_t)e * D * 2048; it.N = 2048; it.k0 = 128 * (q / 64); it.n0 = 32 * (q % 64); it.dst = ws + WS_WGUT + (size_t)e * 2048 * 1024;
        const int m0 = it.n0 & 1023; it.drow = 256 * (m0 >> 7) + (m0 & 127) + (it.n0 >= 1024 ? 128 : 0); return it; }
    r -= NEXP * I_GU;
    { const int e = r / I_DN, q = r % I_DN; it.W = a.in[23] + (size_t)e * D * D; it.N = 1024; it.k0 = 128 * (q / 32); it.n0 = 32 * (q % 32); it.dst = ws + WS_WDNT + (size_t)e * 1024 * 1024; it.drow = it.n0; }
    return it;
}
constexpr int W_NITEMS = 8 * 80 + 8 * 64 + 2 * 4 * 32 + 8 * 32 + NEXP * (8 * 64 + 8 * 32);
__device__ __forceinline__ void witem_load(const WItem& it, float (&v)[64], int lane) {
    const float* p = it.W + (size_t)(it.k0 + (lane >> 3)) * it.N + it.n0 + (lane & 7) * 4;
#pragma unroll
    for (int i = 0; i < 16; ++i) { const f32x4 t = __builtin_nontemporal_load((const f32x4*)(p + (size_t)(8 * i) * it.N)); v[4 * i] = t[0]; v[4 * i + 1] = t[1]; v[4 * i + 2] = t[2]; v[4 * i + 3] = t[3]; }
}
__device__ __forceinline__ void witem_store(const WItem& it, const float (&v)[64], LAS float* scr, int lane) {
#pragma unroll
    for (int i = 0; i < 16; ++i) { const int k = 8 * i + (lane >> 3); *(LAS f32x4*)(scr + k * 32 + (((lane & 7) * 4 + 4 * (i >> 1)) & 31)) = (f32x4){v[4 * i], v[4 * i + 1], v[4 * i + 2], v[4 * i + 3]}; }
    LDS_WAIT(); asm volatile("" ::: "memory");
    const int c = lane & 7;
#pragma unroll
    for (int j = 0; j < 4; ++j) { const int n = (lane >> 3) + 8 * j; const LAS float* s = scr + (16 * c) * 32 + ((n + 4 * c) & 31);
        float x[16];
#pragma unroll
        for (int q = 0; q < 16; ++q) x[q] = s[q * 32];
        unsigned char* d = it.dst + (size_t)(it.drow + n) * it.ldt;
        if (it.fp8) { u32x4 o;
            o.x = pk_fp8x4(x[0] * F8_WSCALE, x[1] * F8_WSCALE, x[2] * F8_WSCALE, x[3] * F8_WSCALE); o.y = pk_fp8x4(x[4] * F8_WSCALE, x[5] * F8_WSCALE, x[6] * F8_WSCALE, x[7] * F8_WSCALE);
            o.z = pk_fp8x4(x[8] * F8_WSCALE, x[9] * F8_WSCALE, x[10] * F8_WSCALE, x[11] * F8_WSCALE); o.w = pk_fp8x4(x[12] * F8_WSCALE, x[13] * F8_WSCALE, x[14] * F8_WSCALE, x[15] * F8_WSCALE);
            __builtin_nontemporal_store(o, (u32x4*)(d + it.dk0 + it.k0 + 16 * c)); }
        else { u32x4 o0, o1;
            o0.x = cvtpk(x[0], x[1]); o0.y = cvtpk(x[2], x[3]); o0.z = cvtpk(x[4], x[5]); o0.w = cvtpk(x[6], x[7]); o1.x = cvtpk(x[8], x[9]); o1.y = cvtpk(x[10], x[11]); o1.z = cvtpk(x[12], x[13]); o1.w = cvtpk(x[14], x[15]);
            *(u32x4*)(d + (size_t)(it.dk0 + it.k0 + 16 * c) * 2) = o0; *(u32x4*)(d + (size_t)(it.dk0 + it.k0 + 16 * c) * 2 + 16) = o1; } }
    LDS_WAIT(); asm volatile("" ::: "memory");
}
__device__ __forceinline__ void phaseA(const Frame& F, const Args& a) {
    unsigned char* ws = a.ws;
    if (F.vcu < 192) {
        const float* c = a.in[1]; const float* w_ada = a.in[2]; const float* b_ada = a.in[3]; float* mod = (float*)(ws + WS_MOD);
        LAS float* red = (LAS float*)(F.lds);
        const int col = F.vcu * 32 + (F.tid & 31), ks = F.tid >> 5;
        float a0 = 0.f, a1 = 0.f, a2 = 0.f, a3 = 0.f;
        for (int k = ks * 64; k < ks * 64 + 64; ++k) { const float w = __builtin_nontemporal_load(w_ada + (size_t)k * 6144 + col);
            const float c0 = c[k], c1 = c[D + k], c2 = c[2 * D + k], c3 = c[3 * D + k];
            a0 += c0 * __builtin_amdgcn_rcpf(1.0f + __expf(-c0)) * w; a1 += c1 * __builtin_amdgcn_rcpf(1.0f + __expf(-c1)) * w;
            a2 += c2 * __builtin_amdgcn_rcpf(1.0f + __expf(-c2)) * w; a3 += c3 * __builtin_amdgcn_rcpf(1.0f + __expf(-c3)) * w; }
        red[(ks * 4 + 0) * 32 + (F.tid & 31)] = a0; red[(ks * 4 + 1) * 32 + (F.tid & 31)] = a1; red[(ks * 4 + 2) * 32 + (F.tid & 31)] = a2; red[(ks * 4 + 3) * 32 + (F.tid & 31)] = a3;
        __syncthreads();
        if (F.tid < 128) { const int b = F.tid >> 5, cc = F.tid & 31; float s = 0.f;
#pragma unroll
            for (int k = 0; k < 16; ++k) s += red[(k * 4 + b) * 32 + cc];
            mod[b * 6144 + F.vcu * 32 + cc] = s + b_ada[F.vcu * 32 + cc]; }
        __syncthreads();
    }
    if (F.vcu == 192 % F.G) {
        const float* w_router = a.in[19]; bf16* wrt = (bf16*)(ws + WS_WRT);
        for (int i = F.tid; i < D * NEXP; i += NWAVES * 64) { const int k = i >> 5, e = i & 31; const float w = w_router[i]; const unsigned hh = cvtpk(w, 0.f) & 0xffffu;
            wrt[(size_t)e * D + k] = (bf16)hh; wrt[(size_t)(NEXP + e) * D + k] = (bf16)(cvtpk(w - bflo(hh), 0.f) & 0xffffu); }
    }
    LAS float* scr = (LAS float*)(F.lds + F.wave * 17408);
    const int gw = F.vcu * NWAVES + F.wave, NGW = F.G * NWAVES;
    if (gw < W_NITEMS) {
        float va[64], vb[64];
        WItem ia = witem_decode(a, gw), ib = ia;
        witem_load(ia, va, F.lane);
        for (int it = gw; it < W_NITEMS; it += 2 * NGW) {
            const bool hb = (it + NGW < W_NITEMS);
            ib = witem_decode(a, hb ? it + NGW : it); witem_load(ib, vb, F.lane);
            witem_store(ia, va, scr, F.lane);
            if (!hb) break;
            const bool ha = (it + 2 * NGW < W_NITEMS);
            ia = witem_decode(a, ha ? it + 2 * NGW : it); witem_load(ia, va, F.lane);
            witem_store(ib, vb, scr, F.lane);
            if (!ha) break;
        }
    }
}
__device__ __forceinline__ void phaseB(const Frame& F, const Args& a) {
    const float* x = a.in[0]; const float* g = a.in[4]; const float* mod = (const float*)(a.ws + WS_MOD); bf16* xn = (bf16*)(a.ws + WS_XN); unsigned* xn8 = (unsigned*)(a.ws + WS_XN8A);
    const int gw = F.vcu * NWAVES + F.wave, NGW = F.G * NWAVES;
    f32x4 cg[4], csh[4]; int cb = -1;
    for (int row0 = gw * 4; row0 < NTOK; row0 += NGW * 4) {
        f32x4 v[4][4];
#pragma unroll
        for (int rr = 0; rr < 4; ++rr)
#pragma unroll
            for (int j = 0; j < 4; ++j) v[rr][j] = __builtin_nontemporal_load((const f32x4*)(x + (size_t)(row0 + rr) * D) + F.lane + 64 * j);
        const int b = row0 / SEQ; const float* mb = mod + b * 6144;
        if (b != cb) { cb = b;
#pragma unroll
            for (int j = 0; j < 4; ++j) { const int c0 = (F.lane + 64 * j) * 4; cg[j] = *(const f32x4*)(g + c0) * (*(const f32x4*)(mb + SC1 + c0) + 1.0f); csh[j] = *(const f32x4*)(mb + SH1 + c0); } }
#pragma unroll
        for (int rr = 0; rr < 4; ++rr) {
            float ss = 0.f;
#pragma unroll
            for (int j = 0; j < 4; ++j) ss += (v[rr][j].x * v[rr][j].x + v[rr][j].y * v[rr][j].y) + (v[rr][j].z * v[rr][j].z + v[rr][j].w * v[rr][j].w);
            const float rstd = rsqrtf(wsum(ss) * (1.0f / D) + EPS);
            u32x2* o8 = (u32x2*)(xn + (size_t)(row0 + rr) * D) + F.lane; unsigned* o4 = xn8 + (size_t)(row0 + rr) * (D / 4) + F.lane;
#pragma unroll
            for (int j = 0; j < 4; ++j) {
                const f32x4 h = v[rr][j] * rstd * cg[j] + csh[j];
                u32x2 w; w.x = cvtpk(h[0], h[1]); w.y = cvtpk(h[2], h[3]); o8[64 * j] = w;
                o4[64 * j] = pk_fp8x4(h[0] * F8_ASCALE, h[1] * F8_ASCALE, h[2] * F8_ASCALE, h[3] * F8_ASCALE); }
        }
    }
}

__device__ __forceinline__ void store_row32(bf16* blk, u32x2 w0, u32x2 w1, u32x2 w2, u32x2 w3, int hi) {
    { const auto rx = __builtin_amdgcn_permlane32_swap(w0.x, w1.x, false, false); const auto ry = __builtin_amdgcn_permlane32_swap(w0.y, w1.y, false, false);
      u32x4 o = {rx[0], ry[0], rx[1], ry[1]}; *(u32x4*)(blk + (hi ? 8 : 0)) = o; }
    { const auto rx = __builtin_amdgcn_permlane32_swap(w2.x, w3.x, false, false); const auto ry = __builtin_amdgcn_permlane32_swap(w2.y, w3.y, false, false);
      u32x4 o = {rx[0], ry[0], rx[1], ry[1]}; *(u32x4*)(blk + 16 + (hi ? 8 : 0)) = o; }
}
constexpr int SGU_STRIDE = 1088;
__device__ __forceinline__ s16x4 vtr(const LAS unsigned char* p) { typedef short v4i16_t __attribute__((ext_vector_type(4))); return __builtin_bit_cast(s16x4, __builtin_amdgcn_ds_read_tr16_b64_v4i16((LAS v4i16_t*)p)); }
__device__ __forceinline__ void sgu_unit(const Frame& F, const Args& a, int b, int blk) {
    const bf16* VG = (const bf16*)(a.ws + WS_VG); const bf16* U = (const bf16*)(a.ws + WS_U); bf16* YAB = (bf16*)(a.ws + WS_YAB);
    const float* ln_g = a.in[8]; const float* ln_b = a.in[9]; const float* w_s = a.in[10]; const float* b_s = a.in[11];
    const int tok0 = b * SEQ + blk * SGB, lane = F.lane;
    {
        const f32x4 g0 = *(const f32x4*)(ln_g + lane * 8), g1 = *(const f32x4*)(ln_g + lane * 8 + 4), b0 = *(const f32x4*)(ln_b + lane * 8), b1 = *(const f32x4*)(ln_b + lane * 8 + 4);
#pragma unroll 1
        for (int r4 = 0; r4 < 16; r4 += 4) {
            u32x4 w[4];
#pragma unroll
            for (int rr = 0; rr < 4; ++rr) w[rr] = __builtin_nontemporal_load((const u32x4*)(VG + (size_t)(tok0 + F.wave * 16 + r4 + rr) * 512 + lane * 8));
#pragma unroll
            for (int rr = 0; rr < 4; ++rr) { const int row = F.wave * 16 + r4 + rr;
                f32x4 v0 = {bflo(w[rr].x), bfhi(w[rr].x), bflo(w[rr].y), bfhi(w[rr].y)}, v1 = {bflo(w[rr].z), bfhi(w[rr].z), bflo(w[rr].w), bfhi(w[rr].w)};
                const float mu = wsum((v0[0] + v0[1]) + (v0[2] + v0[3]) + (v1[0] + v1[1]) + (v1[2] + v1[3])) * (1.0f / 512.0f);
                v0 -= mu; v1 -= mu;
                const float var = wsum((v0[0] * v0[0] + v0[1] * v0[1]) + (v0[2] * v0[2] + v0[3] * v0[3]) + (v1[0] * v1[0] + v1[1] * v1[1]) + (v1[2] * v1[2] + v1[3] * v1[3])) * (1.0f / 512.0f);
                const float rstd = rsqrtf(var + EPS);
                v0 = v0 * rstd * g0 + b0; v1 = v1 * rstd * g1 + b1;
                u32x4 o; o.x = cvtpk(v0[0], v0[1]); o.y = cvtpk(v0[2], v0[3]); o.z = cvtpk(v1[0], v1[1]); o.w = cvtpk(v1[2], v1[3]);
                *(LAS u32x4*)(F.lds + row * SGU_STRIDE + lane * 16) = o; }
        }
    }
    __syncthreads();
    {
        const int g = F.wave, r32 = lane & 31, hi = lane >> 5, i16 = lane & 15, g16 = (lane >> 4) & 1;
        const LAS unsigned char* vb = F.lds + (8 * hi + (i16 >> 2)) * SGU_STRIDE + (g * 64 + 16 * g16 + 4 * (i16 & 3)) * 2;
#pragma unroll
        for (int tb = 0; tb < 4; ++tb) {
            const int t = 32 * tb + r32; const float* wrow = w_s + ((size_t)g * 128 + t) * 128;
            f32x4 wr0[8], wr1[8];
#pragma unroll
            for (int ks = 0; ks < 2 * tb + 2; ++ks) { wr0[ks] = *(const f32x4*)(wrow + 16 * ks + 8 * hi); wr1[ks] = *(const f32x4*)(wrow + 16 * ks + 8 * hi + 4); }
            const float bs = b_s[g * 128 + t];
            const bf16* up = U + (size_t)(tok0 + t) * 512 + g * 64 + 4 * hi;
            u32x2 uu0[4], uu1[4];
#pragma unroll
            for (int gg = 0; gg < 4; ++gg) { uu0[gg] = *(const u32x2*)(up + 8 * gg); uu1[gg] = *(const u32x2*)(up + 32 + 8 * gg); }
            f32x16 a0, a1;
#pragma unroll
            for (int r = 0; r < 16; ++r) { a0[r] = 0.f; a1[r] = 0.f; }
#pragma unroll
            for (int ks = 0; ks < 2 * tb + 2; ++ks) {
                const int s0 = 16 * ks + 8 * hi;
                float wv[8] = {wr0[ks][0], wr0[ks][1], wr0[ks][2], wr0[ks][3], wr1[ks][0], wr1[ks][1], wr1[ks][2], wr1[ks][3]};
                if (ks >= 2 * tb) {
#pragma unroll
                    for (int j = 0; j < 8; ++j) wv[j] = (s0 + j <= t) ? wv[j] : 0.f; }
                u32x4 bw; bw.x = cvtpk(wv[0], wv[1]); bw.y = cvtpk(wv[2], wv[3]); bw.z = cvtpk(wv[4], wv[5]); bw.w = cvtpk(wv[6], wv[7]);
                const bf16x8 bfrag = __builtin_bit_cast(bf16x8, bw);
                const LAS unsigned char* p = vb + ks * 16 * SGU_STRIDE;
                const s16x4 l0 = vtr(p), h0 = vtr(p + 4 * SGU_STRIDE), l1 = vtr(p + 64), h1 = vtr(p + 4 * SGU_STRIDE + 64);
                const bf16x8 A0 = {l0[0], l0[1], l0[2], l0[3], h0[0], h0[1], h0[2], h0[3]}, A1 = {l1[0], l1[1], l1[2], l1[3], h1[0], h1[1], h1[2], h1[3]};
                a0 = __builtin_amdgcn_mfma_f32_32x32x16_bf16(A0, bfrag, a0, 0, 0, 0);
                a1 = __builtin_amdgcn_mfma_f32_32x32x16_bf16(A1, bfrag, a1, 0, 0, 0);
            }
            bf16* op = YAB + (size_t)(tok0 + t) * 1024 + 512 + g * 64;
            u32x2 q0[4], q1[4];
#pragma unroll
            for (int gg = 0; gg < 4; ++gg) {
                q0[gg].x = cvtpk(bflo(uu0[gg].x) * (a0[4 * gg] + bs), bfhi(uu0[gg].x) * (a0[4 * gg + 1] + bs)); q0[gg].y = cvtpk(bflo(uu0[gg].y) * (a0[4 * gg + 2] + bs), bfhi(uu0[gg].y) * (a0[4 * gg + 3] + bs));
                q1[gg].x = cvtpk(bflo(uu1[gg].x) * (a1[4 * gg] + bs), bfhi(uu1[gg].x) * (a1[4 * gg + 1] + bs)); q1[gg].y = cvtpk(bflo(uu1[gg].y) * (a1[4 * gg + 2] + bs), bfhi(uu1[gg].y) * (a1[4 * gg + 3] + bs)); }
            store_row32(op, q0[0], q0[1], q0[2], q0[3], hi); store_row32(op + 32, q1[0], q1[1], q1[2], q1[3], hi);
        }
    }
    __syncthreads();
}

constexpr int AT_BUF = 65536, AT_V = 32768, AT_BT = GTAB_OFF;
static_assert(8 * 1088 <= GTAB_BYTES, "bias tables fit above the ring");
__device__ __forceinline__ void attn_pair(const Frame& F, const Args& a, int pairi) {
    const bf16* __restrict__ Q = (const bf16*)(a.ws + WS_Q); const bf16* __restrict__ Kb = (const bf16*)(a.ws + WS_K); const bf16* __restrict__ Vb = (const bf16*)(a.ws + WS_V); bf16* YAB = (bf16*)(a.ws + WS_YAB);
    int tz = threadIdx.x; asm volatile("" : "+v"(tz));
    const int lane = tz & 63, wave = __builtin_amdgcn_readfirstlane(tz >> 6), pr = wave >> 1, half = wave & 1;
    const int r32 = lane & 31, hi = lane >> 5, i16 = lane & 15, g16 = (lane >> 4) & 1;
    const int c0 = 2 * (pairi % (SEQ / CHUNK / 2)), tokb = (pairi / (SEQ / CHUNK / 2)) * SEQ;
    const int kc0 = (c0 > NLEFT) ? (c0 - NLEFT) : 0, nsteps = c0 + 2 - kc0, total = 2 * nsteps;
    const int qi = half * 32 + r32;
    unsigned dsrcK[4], dsrcV[4];
#pragma unroll
    for (int i = 0; i < 4; ++i) { const int piece = 4 * wave + i, hh = piece >> 3, kb = piece & 7, key = 8 * kb + (lane >> 3), slot = lane & 7;
        dsrcK[i] = (unsigned)(key * 512 + hh * 64 + ((slot ^ ((key >> 1) & 7)) << 3)); dsrcV[i] = (unsigned)(key * 512 + hh * 64 + ((slot ^ (((key >> 1) & 1) << 2)) << 3)); }
#define AT_DMA(bufp, tbase) do { _Pragma("unroll") for (int i_ = 0; i_ < 4; ++i_) { const int piece_ = 4 * wave + i_; \
        __builtin_amdgcn_global_load_lds((const unsigned*)(Kb + (tbase) + dsrcK[i_]), (LAS unsigned*)((bufp) + (piece_ >> 3) * 8192 + (piece_ & 7) * 1024), 16, 0, 0); \
        __builtin_amdgcn_global_load_lds((const unsigned*)(Vb + (tbase) + dsrcV[i_]), (LAS unsigned*)((bufp) + AT_V + (piece_ >> 3) * 8192 + (piece_ & 7) * 1024), 16, 0, 0); } } while (0)
    int ko[4];
#pragma unroll
    for (int sI = 0; sI < 4; ++sI) ko[sI] = pr * 8192 + r32 * 128 + ((((2 * sI + hi) ^ ((r32 >> 1) & 7))) << 4);
    const int fb = (i16 >> 3) & 1;
    const int vr0 = AT_V + pr * 8192 + (4 * hi + (i16 >> 2)) * 128 + ((4 * (0 ^ fb) + 2 * g16 + ((i16 & 3) >> 1)) * 16) + (i16 & 1) * 8;
    const int vr1 = AT_V + pr * 8192 + (4 * hi + (i16 >> 2)) * 128 + ((4 * (1 ^ fb) + 2 * g16 + ((i16 & 3) >> 1)) * 16) + (i16 & 1) * 8;
    AT_DMA(F.lds, (size_t)(tokb + kc0 * CHUNK) * 512);
    bf16x8 qf[2][4]; f32x16 o0[2], o1[2]; float m[2], l[2];
#pragma unroll
    for (int i = 0; i < 2; ++i) {
#pragma unroll
        for (int sI = 0; sI < 4; ++sI) qf[i][sI] = __builtin_nontemporal_load((const bf16x8*)(Q + (size_t)(tokb + (c0 + i) * CHUNK + qi) * 512 + pr * 64 + 16 * sI + 8 * hi));
#pragma unroll
        for (int r = 0; r < 16; ++r) { o0[i][r] = 0.f; o1[i][r] = 0.f; }
        m[i] = -1e30f; l[i] = 0.f; }
    __syncthreads();
#pragma unroll 1
    for (int t = 0; t < total; ++t) {
        const int hp = (t >= nsteps) ? 1 : 0, s = t - hp * nsteps, kc = kc0 + s;
        {
            const int tn = (t + 1 < total) ? t + 1 : t, hpn = (tn >= nsteps) ? 1 : 0, kcn = kc0 + tn - hpn * nsteps;
            AT_DMA(F.lds + ((t + 1) & 1) * AT_BUF, (size_t)(tokb + kcn * CHUNK) * 512 + hpn * 256);
        }
        asm volatile("" ::: "memory");
        const LAS unsigned char* buf = F.lds + (t & 1) * AT_BUF;
        const int h = 4 * hp + pr;
#pragma unroll
        for (int i = 0; i < 2; ++i) {
            const int cq = c0 + i, j = kc - cq + NLEFT;
            if (j >= 0 && j <= NLEFT) {
                const bool first = (j == 0) || (kc == 0);
                const float negm = first ? 0.f : -m[i];
                f32x16 p0, p1;
#pragma unroll
                for (int r = 0; r < 16; ++r) { p0[r] = negm; p1[r] = negm; }
#pragma unroll
                for (int sI = 0; sI < 4; ++sI) { const bf16x8 k0 = *(const LAS bf16x8*)(buf + ko[sI]), k1 = *(const LAS bf16x8*)(buf + ko[sI] + 4096);
                    p0 = __builtin_amdgcn_mfma_f32_32x32x16_bf16(k0, qf[i][sI], p0, 0, 0, 0); p1 = __builtin_amdgcn_mfma_f32_32x32x16_bf16(k1, qf[i][sI], p1, 0, 0, 0); }
                if (j >= 6) {
                    const LAS float* bt = (const LAS float*)(F.lds + AT_BT + h * 1088);
                    const int base = 640 + qi - 64 * j - 4 * hi;
#pragma unroll
                    for (int r = 0; r < 16; ++r) { const int kk = (r & 3) + 8 * (r >> 2); int i0 = base - kk, i1 = base - 32 - kk; i0 = i0 > 256 ? 256 : i0; i1 = i1 > 256 ? 256 : i1; p0[r] += bt[i0]; p1[r] += bt[i1]; }
                }
                float tm = fmaxf(p0[0], p1[0]);
#pragma unroll
                for (int r = 1; r < 16; ++r) tm = fmaxf(tm, fmaxf(p0[r], p1[r]));
                { const auto rr = __builtin_amdgcn_permlane32_swap(__float_as_uint(tm), __float_as_uint(tm), false, false); tm = fmaxf(__uint_as_float(rr[0]), __uint_as_float(rr[1])); }
                if (first) {
                    m[i] = tm; l[i] = 0.f;
#pragma unroll
                    for (int r = 0; r < 16; ++r) { p0[r] -= tm; p1[r] -= tm; o0[i][r] = 0.f; o1[i][r] = 0.f; }
                } else if (__any(tm > 0.f)) {
                    const float dlt = fmaxf(tm, 0.f), alpha = __builtin_amdgcn_exp2f(-dlt); m[i] += dlt; l[i] *= alpha;
#pragma unroll
                    for (int r = 0; r < 16; ++r) { p0[r] -= dlt; p1[r] -= dlt; o0[i][r] *= alpha; o1[i][r] *= alpha; }
                }
                float ps = 0.f;
#pragma unroll
                for (int r = 0; r < 16; ++r) { p0[r] = __builtin_amdgcn_exp2f(p0[r]); p1[r] = __builtin_amdgcn_exp2f(p1[r]); ps += p0[r] + p1[r]; }
                l[i] += ps;
                bf16x8 pb[2][2];
#pragma unroll
                for (int sI = 0; sI < 2; ++sI) {
                    u32x4 w0; w0.x = cvtpk(p0[8 * sI], p0[8 * sI + 1]); w0.y = cvtpk(p0[8 * sI + 2], p0[8 * sI + 3]); w0.z = cvtpk(p0[8 * sI + 4], p0[8 * sI + 5]); w0.w = cvtpk(p0[8 * sI + 6], p0[8 * sI + 7]);
                    u32x4 w1; w1.x = cvtpk(p1[8 * sI], p1[8 * sI + 1]); w1.y = cvtpk(p1[8 * sI + 2], p1[8 * sI + 3]); w1.z = cvtpk(p1[8 * sI + 4], p1[8 * sI + 5]); w1.w = cvtpk(p1[8 * sI + 6], p1[8 * sI + 7]);
                    pb[0][sI] = __builtin_bit_cast(bf16x8, w0); pb[1][sI] = __builtin_bit_cast(bf16x8, w1); }
#pragma unroll
                for (int blk = 0; blk < 2; ++blk)
#pragma unroll
                    for (int sI = 0; sI < 2; ++sI) {
                        const int kof = (32 * blk + 16 * sI) * 128;
                        const s16x4 l0 = vtr(buf + vr0 + kof), h0 = vtr(buf + vr0 + kof + 1024), l1 = vtr(buf + vr1 + kof), h1 = vtr(buf + vr1 + kof + 1024);
                        const bf16x8 A0 = {l0[0], l0[1], l0[2], l0[3], h0[0], h0[1], h0[2], h0[3]}, A1 = {l1[0], l1[1], l1[2], l1[3], h1[0], h1[1], h1[2], h1[3]};
                        o0[i] = __builtin_amdgcn_mfma_f32_32x32x16_bf16(A0, pb[blk][sI], o0[i], 0, 0, 0);
                        o1[i] = __builtin_amdgcn_mfma_f32_32x32x16_bf16(A1, pb[blk][sI], o1[i], 0, 0, 0);
                    }
                if (j == NLEFT) {
                    float lt = l[i]; { const auto rr = __builtin_amdgcn_permlane32_swap(__float_as_uint(lt), __float_as_uint(lt), false, false); lt = __uint_as_float(rr[0]) + __uint_as_float(rr[1]); }
                    const float inv = __builtin_amdgcn_rcpf(lt);
                    bf16* op = YAB + (size_t)(tokb + cq * CHUNK + qi) * 1024 + h * 64;
                    u32x2 q0[4], q1[4];
#pragma unroll
                    for (int gg = 0; gg < 4; ++gg) {
                        q0[gg].x = cvtpk(o0[i][4 * gg] * inv, o0[i][4 * gg + 1] * inv); q0[gg].y = cvtpk(o0[i][4 * gg + 2] * inv, o0[i][4 * gg + 3] * inv);
                        q1[gg].x = cvtpk(o1[i][4 * gg] * inv, o1[i][4 * gg + 1] * inv); q1[gg].y = cvtpk(o1[i][4 * gg + 2] * inv, o1[i][4 * gg + 3] * inv); }
                    store_row32(op, q0[0], q0[1], q0[2], q0[3], hi); store_row32(op + 32, q1[0], q1[1], q1[2], q1[3], hi);
                }
            }
        }
        if (t == nsteps - 1) {
#pragma unroll
            for (int i = 0; i < 2; ++i)
#pragma unroll
                for (int sI = 0; sI < 4; ++sI) qf[i][sI] = __builtin_nontemporal_load((const bf16x8*)(Q + (size_t)(tokb + (c0 + i) * CHUNK + qi) * 512 + (4 + pr) * 64 + 16 * sI + 8 * hi));
        }
        __syncthreads();
    }
#undef AT_DMA
}
__device__ __forceinline__ void phaseD(const Frame& F, const Args& a) {
    for (int unit = F.vcu; unit < NB * (SEQ / SGB); unit += F.G) sgu_unit(F, a, unit / (SEQ / SGB), unit % (SEQ / SGB));
    for (int i = F.tid; i < NHEAD * NREL; i += NWAVES * 64) { const int h = i / NREL, k = i % NREL; ((LAS float*)(F.lds + AT_BT + h * 1088))[k] = (a.in[7][i] - a.in[7][h * NREL + 256]) * LOG2E; }
    __syncthreads();
    const int NCH = NB * (SEQ / CHUNK);
    for (int v = F.vcu; v < NCH / 2; v += F.G) attn_pair(F, a, v);
}

constexpr int G_HT_STRIDE = 2064;
__device__ __forceinline__ void phaseG(const Frame& F, const Args& a) {
    const float* x = a.in[0]; const bf16* Y1 = (const bf16*)(a.ws + WS_Y1); const float* mod = (const float*)(a.ws + WS_MOD); const float* g_post_mix = a.in[5]; const float* g_pre_ffn = a.in[17];
    const float* b_router = a.in[20]; bf16* X1b = (bf16*)(a.ws + WS_X1B); unsigned char* XN8 = a.ws + WS_XN;
    const bf16* wrt = (const bf16*)(a.ws + WS_WRT);
    float* topg = (float*)(a.ws + WS_TOPG); int* list = (int*)(a.ws + WS_LIST); unsigned* cnt = F.ctl + CW_CNT;
    LAS unsigned char* HT = F.lds;
    LAS float* PL = (LAS float*)(F.lds + 33792);
    LAS float* LG = PL + 8 * 16 * 32;
    LAS float* TV = LG + 512;
    LAS unsigned* LC = (LAS unsigned*)(TV + 64);
    LAS unsigned* AS = LC + 64;
    const int tid = F.tid, lane = F.lane, wave = F.wave, kq = lane >> 4, i16 = lane & 15;
    if (tid < 64) LC[tid] = 0u;
    bf16x8 whi[2][4], wlo[2][4];
#pragma unroll
    for (int et = 0; et < 2; ++et)
#pragma unroll
        for (int ks = 0; ks < 4; ++ks) { const size_t o = (size_t)(et * 16 + i16) * D + 128 * wave + 32 * ks + 8 * kq; whi[et][ks] = *(const bf16x8*)(wrt + o); wlo[et][ks] = *(const bf16x8*)(wrt + (size_t)NEXP * D + o); }
    const int myrow = tid >> 5, mye = lane & 31;
    const float mybias = b_router[mye];
    __syncthreads();
    const int NT = NTOK / 16;
    f32x4 xv[2][4]; u32x2 yr[2][4];
    {   const int rbase = 16 * F.vcu + 2 * wave;
#pragma unroll
        for (int rr = 0; rr < 2; ++rr)
#pragma unroll
            for (int j = 0; j < 4; ++j) { const int c0 = (lane + 64 * j) * 4; xv[rr][j] = __builtin_nontemporal_load((const f32x4*)(x + (size_t)(rbase + rr) * D + c0)); yr[rr][j] = __builtin_nontemporal_load((const u32x2*)(Y1 + (size_t)(rbase + rr) * D + c0)); } }
    int tl = 0;
    f32x4 cgp[4], cgf[4], cgt[4], csc[4], csh[4]; int cb = -1;
#pragma unroll
    for (int j = 0; j < 4; ++j) { const int c0 = (lane + 64 * j) * 4; cgp[j] = *(const f32x4*)(g_post_mix + c0); cgf[j] = *(const f32x4*)(g_pre_ffn + c0); }
#pragma unroll 1
    for (int T = F.vcu; T < NT; T += F.G, ++tl) {
        const int b = (16 * T) / SEQ; const float* mb = mod + b * 6144; const int rbase = 16 * T + 2 * wave;
        if (b != cb) { cb = b;
#pragma unroll
            for (int j = 0; j < 4; ++j) { const int c0 = (lane + 64 * j) * 4; cgt[j] = *(const f32x4*)(mb + GT1 + c0); csc[j] = *(const f32x4*)(mb + SC2 + c0) + 1.0f; csh[j] = *(const f32x4*)(mb + SH2 + c0); } }
#pragma unroll
        for (int rr = 0; rr < 2; ++rr) {
            const int row = rbase + rr; f32x4 yv[4]; float ss = 0.f;
#pragma unroll
            for (int j = 0; j < 4; ++j) { yv[j] = (f32x4){bflo(yr[rr][j].x), bfhi(yr[rr][j].x), bflo(yr[rr][j].y), bfhi(yr[rr][j].y)}; ss += (yv[j][0] * yv[j][0] + yv[j][1] * yv[j][1]) + (yv[j][2] * yv[j][2] + yv[j][3] * yv[j][3]); }
            const float rstd = rsqrtf(wsum(ss) * (1.0f / D) + EPS); float s2 = 0.f;
#pragma unroll
            for (int j = 0; j < 4; ++j) { const int c0 = (lane + 64 * j) * 4;
                xv[rr][j] = xv[rr][j] + cgt[j] * (yv[j] * rstd * cgp[j]);
                { u32x2 w1; w1.x = cvtpk(xv[rr][j][0], xv[rr][j][1]); w1.y = cvtpk(xv[rr][j][2], xv[rr][j][3]); __builtin_nontemporal_store(w1, (u32x2*)(X1b + (size_t)row * D + c0)); }
                s2 += (xv[rr][j][0] * xv[rr][j][0] + xv[rr][j][1] * xv[rr][j][1]) + (xv[rr][j][2] * xv[rr][j][2] + xv[rr][j][3] * xv[rr][j][3]); }
            const float rstd2 = rsqrtf(wsum(s2) * (1.0f / D) + EPS);
#pragma unroll
            for (int j = 0; j < 4; ++j) { const int c0 = (lane + 64 * j) * 4;
                const f32x4 h = xv[rr][j] * rstd2 * cgf[j] * csc[j] + csh[j];
                u32x2 w; w.x = cvtpk(h[0], h[1]); w.y = cvtpk(h[2], h[3]); *(unsigned*)(XN8 + (size_t)row * D + c0) = pk_fp8x4(h[0] * F8_ASCALE, h[1] * F8_ASCALE, h[2] * F8_ASCALE, h[3] * F8_ASCALE);
                *(LAS u32x2*)(HT + (2 * wave + rr) * G_HT_STRIDE + c0 * 2) = w; }
        }
        {
            const int Tn = (T + F.G < NT) ? T + F.G : T; const int rb2 = 16 * Tn + 2 * wave;
#pragma unroll
            for (int rr = 0; rr < 2; ++rr)
#pragma unroll
                for (int j = 0; j < 4; ++j) { const int c0 = (lane + 64 * j) * 4; xv[rr][j] = __builtin_nontemporal_load((const f32x4*)(x + (size_t)(rb2 + rr) * D + c0)); yr[rr][j] = __builtin_nontemporal_load((const u32x2*)(Y1 + (size_t)(rb2 + rr) * D + c0)); }
        }
        LDS_WAIT(); __builtin_amdgcn_s_barrier(); asm volatile("" ::: "memory");
        {
            f32x4 acc0 = {0.f, 0.f, 0.f, 0.f}, acc1 = {0.f, 0.f, 0.f, 0.f};
#pragma unroll
            for (int ks = 0; ks < 4; ++ks) { const bf16x8 hb = *(const LAS bf16x8*)(HT + i16 * G_HT_STRIDE + (128 * wave + 32 * ks + 8 * kq) * 2);
                acc0 = __builtin_amdgcn_mfma_f32_16x16x32_bf16(whi[0][ks], hb, acc0, 0, 0, 0); acc0 = __builtin_amdgcn_mfma_f32_16x16x32_bf16(wlo[0][ks], hb, acc0, 0, 0, 0);
                acc1 = __builtin_amdgcn_mfma_f32_16x16x32_bf16(whi[1][ks], hb, acc1, 0, 0, 0); acc1 = __builtin_amdgcn_mfma_f32_16x16x32_bf16(wlo[1][ks], hb, acc1, 0, 0, 0); }
            *(LAS f32x4*)(PL + (wave * 16 + i16) * 32 + 4 * kq) = acc0; *(LAS f32x4*)(PL + (wave * 16 + i16) * 32 + 16 + 4 * kq) = acc1;
        }
        LDS_WAIT(); __builtin_amdgcn_s_barrier(); asm volatile("" ::: "memory");
        float lg = mybias;
#pragma unroll
        for (int w = 0; w < 8; ++w) lg += PL[(w * 16 + myrow) * 32 + mye];
        LG[myrow * 32 + mye] = lg;
        LDS_WAIT(); asm volatile("" ::: "memory");
        int rank = 0;
#pragma unroll
        for (int q = 0; q < 8; ++q) { const f32x4 o = *(const LAS f32x4*)(LG + myrow * 32 + 4 * q);
#pragma unroll
            for (int i = 0; i < 4; ++i) { const int e2 = 4 * q + i; rank += (o[i] > lg || (o[i] == lg && e2 < mye)) ? 1 : 0; } }
        if (rank < 4) TV[myrow * 4 + rank] = lg;
        LDS_WAIT(); asm volatile("" ::: "memory");
        const f32x4 tv = *(const LAS f32x4*)(TV + myrow * 4);
        if (rank < 4) {
            const float den = 1.0f + __expf(tv[1] - tv[0]) + __expf(tv[2] - tv[0]) + __expf(tv[3] - tv[0]);
            const int slot = (16 * T + myrow) * 4 + rank; topg[slot] = __expf(lg - tv[0]) / den;
            const unsigned lp = __hip_atomic_fetch_add(LC + mye, 1u, __ATOMIC_RELAXED, __HIP_MEMORY_SCOPE_WORKGROUP);
            if (tl < 16) AS[tl * 64 + myrow * 4 + rank] = (unsigned)mye | (lp << 8);
        }
    }
    __syncthreads();
    if (tid < NEXP) LC[32 + tid] = atomicAdd(&cnt[tid], LC[tid]);
    __syncthreads();
    for (int i = tid; i < tl * 64; i += NWAVES * 64) { const unsigned as = AS[i]; const int e = as & 255, lp = as >> 8; const int T = F.vcu + (i >> 6) * F.G;
        list[(size_t)e * NTOK + LC[32 + e] + lp] = (16 * T + ((i & 63) >> 2)) * 4 + (i & 3); }
}
__device__ __forceinline__ int moe_tables(const Frame& F) {
    __syncthreads();
    if (F.tid < NEXP) F.MISC[40 + F.tid] = __hip_atomic_load(F.ctl + CW_CNT + F.tid, __ATOMIC_RELAXED, __HIP_MEMORY_SCOPE_AGENT);
    __syncthreads();
    if (F.tid == 0) { unsigned s = 0; for (int e = 0; e < NEXP; ++e) { F.MISC[e] = s; s += (F.MISC[40 + e] + 255u) >> 8; } F.MISC[32] = s; }
    __syncthreads();
    return (int)F.MISC[32];
}
__device__ __forceinline__ void phaseJ(const Frame& F, const Args& a) {
    const unsigned char* Y2s = a.ws + WS_Y2; const bf16* X1b = (const bf16*)(a.ws + WS_X1B); const float* mod = (const float*)(a.ws + WS_MOD); const float* gpf = a.in[18]; float* out = a.out;
    const int* inv = (const int*)(a.ws + WS_TOPE); const float* topg = (const float*)(a.ws + WS_TOPG);
    const int lane = F.lane, gw = F.vcu * NWAVES + F.wave, NGW = F.G * NWAVES;
    f32x4 cgg[4]; int cb = -1;
    for (int row0 = gw * 4; row0 < NTOK; row0 += NGW * 4) {
        const int b = row0 / SEQ; const float* mb = mod + b * 6144;
        if (b != cb) { cb = b;
#pragma unroll
            for (int j = 0; j < 4; ++j) { const int c0 = (lane + 64 * j) * 4; cgg[j] = *(const f32x4*)(gpf + c0) * *(const f32x4*)(mb + GT2 + c0); } }
        int pp[4][4]; float gg[4][4];
#pragma unroll
        for (int rr = 0; rr < 4; ++rr)
#pragma unroll
            for (int k = 0; k < 4; ++k) { pp[rr][k] = __builtin_amdgcn_readfirstlane(inv[(row0 + rr) * 4 + k]); gg[rr][k] = topg[(row0 + rr) * 4 + k] * (1.0f / F8_YSCALE); }
        unsigned yy[4][4][4]; u32x2 xx[4][4];
#pragma unroll
        for (int rr = 0; rr < 4; ++rr)
#pragma unroll
            for (int j = 0; j < 4; ++j) { const int c0 = (lane + 64 * j) * 4;
#pragma unroll
                for (int k = 0; k < 4; ++k) yy[rr][j][k] = __builtin_nontemporal_load((const unsigned*)(Y2s + (size_t)pp[rr][k] * D + c0));
                xx[rr][j] = __builtin_nontemporal_load((const u32x2*)(X1b + (size_t)(row0 + rr) * D + c0)); }
#pragma unroll
        for (int rr = 0; rr < 4; ++rr) {
            f32x4 yv[4]; float ss = 0.f;
#pragma unroll
            for (int j = 0; j < 4; ++j) { f32x4 s = {0.f, 0.f, 0.f, 0.f};
#pragma unroll
                for (int k = 0; k < 4; ++k) { const f32x2 lo = __builtin_amdgcn_cvt_pk_f32_fp8((int)yy[rr][j][k], false), hi = __builtin_amdgcn_cvt_pk_f32_fp8((int)yy[rr][j][k], true);
                    s += (f32x4){lo.x, lo.y, hi.x, hi.y} * gg[rr][k]; }
                yv[j] = s; ss += (s[0] * s[0] + s[1] * s[1]) + (s[2] * s[2] + s[3] * s[3]); }
            const float rstd = rsqrtf(wsum(ss) * (1.0f / D) + EPS);
#pragma unroll
            for (int j = 0; j < 4; ++j) { const int c0 = (lane + 64 * j) * 4;
                const f32x4 x1 = {bflo(xx[rr][j].x), bfhi(xx[rr][j].x), bflo(xx[rr][j].y), bfhi(xx[rr][j].y)};
                __builtin_nontemporal_store(x1 + cgg[j] * (yv[j] * rstd), (f32x4*)(out + (size_t)(row0 + rr) * D + c0)); }
        }
    }
}

constexpr int N_PHASES = 10;
__global__ void __launch_bounds__(NWAVES * 64, 2) mega_fwd(Args args) {
    extern __shared__ __attribute__((aligned(16))) unsigned char lds_raw[];
    Frame F;
    F.lds = (LAS unsigned char*)lds_raw; F.MISC = (volatile LAS unsigned*)(F.lds + MISC_OFF);
    F.tid = threadIdx.x; F.lane = F.tid & 63; F.wave = __builtin_amdgcn_readfirstlane(F.tid >> 6);
    F.G = gridDim.x; { const int bx = blockIdx.x; F.vcu = (F.G % 8 == 0) ? (bx % 8) * (F.G / 8) + bx / 8 : bx; }
    F.ctl = (unsigned*)(args.ws + WS_CTL);
    for (int u = F.tid; u < 128; u += NWAVES * 64) F.MISC[u] = 0u;
    __syncthreads();
    const int lo = args.ph_lo, hi = args.ph_hi;
    XcdBarrier bar; bar.bar = F.ctl + CW_BAR; bar.x = 0; bar.st = F.MISC + 80;
    if (hi - lo > 1) bar = xcd_barrier_post(F.ctl + CW_BAR, F.MISC + 80);
#define IN(k) (lo <= (k) && (k) < hi)
#define SEAM(k) do { if (IN(k) && IN((k) + 1)) xcd_barrier(bar); } while (0)
    unsigned char* ws = args.ws;
    bf16 *XN = (bf16*)(ws + WS_XN), *Qb = (bf16*)(ws + WS_Q), *Kb = (bf16*)(ws + WS_K), *Vb = (bf16*)(ws + WS_V), *Ub = (bf16*)(ws + WS_U), *VG = (bf16*)(ws + WS_VG);
    bf16 *GT = (bf16*)(ws + WS_GT), *YAB = (bf16*)(ws + WS_YAB), *MRG = (bf16*)(ws + WS_MRG), *Y1 = (bf16*)(ws + WS_Y1), *ACT = (bf16*)(ws + WS_ACT), *Y2 = (bf16*)(ws + WS_Y2);

    if (IN(0)) { phaseA(F, args); } SEAM(0);
    if (IN(1)) { phaseB(F, args); } SEAM(1);
    if (IN(2)) {
        { SchedStatic S{(const char*)XN, (const char*)(ws + WS_W1T), NTOK / 256, INW / 256, F.G, (int)blockIdx.x, (size_t)256 * 1024 * 2, (size_t)256 * 1024 * 2};
          EpiG1 E{Qb, Kb, Vb, Ub, VG};
          pg8::gemm_phase<EpiG1, SchedStatic, false>(F.lds + RING_OFF, S, E, 2048, 2048, 16); }
        {
          SchedStaticG S{(const char*)(ws + WS_XN8A), (const char*)(ws + WS_WG8), NTOK / 256, 2048 / 256, F.G, (int)blockIdx.x, (size_t)256 * 1024, 1024u};
          EpiGate E{GT, args.in[15]};
          pg8::gemm_phase<EpiGate, SchedStaticG, true>(F.lds + RING_OFF, S, E, 1024, 1024, 8); }
    } SEAM(2);
    if (IN(3)) { phaseD(F, args); } SEAM(3);
    if (IN(4)) {
        SchedSplit2 S{(const char*)YAB, (const char*)(ws + WS_WBRT), NTOK / 256, 4, F.G, (int)blockIdx.x, (size_t)256 * 1024 * 2, (size_t)256 * 1024 * 2, (size_t)512 * 2};
        EpiG2 E{GT, MRG};
        pg8::gemm_phase<EpiG2, SchedSplit2, false>(F.lds + RING_OFF, S, E, 2048, 2048, 8);
    } SEAM(4);
    if (IN(5)) {
        SchedStatic S{(const char*)MRG, (const char*)(ws + WS_WOUTT), NTOK / 256, 4, F.G, (int)blockIdx.x, (size_t)256 * 1024 * 2, (size_t)256 * 1024 * 2};
        EpiPlain E{Y1};
        pg8::gemm_phase<EpiPlain, SchedStatic, false>(F.lds + RING_OFF, S, E, 2048, 2048, 16);
    } SEAM(5);
    if (IN(6)) { phaseG(F, args); } SEAM(6);
    if (IN(7)) {
        const int nrb = moe_tables(F);
        const int* list = (const int*)(ws + WS_LIST);
        {
            int* inv = (int*)(ws + WS_TOPE);
            for (int g = (int)blockIdx.x * (NWAVES * 64) + F.tid; g < NTOK * TOPK; g += F.G * NWAVES * 64) {
                int e = 0, base = 0;
#pragma unroll 1
                for (int i = 0; i < NEXP; ++i) { const int c = (int)F.MISC[40 + i]; if (g >= base + c) { base += c; e = i + 1; } else break; }
                const int pos = g - base; if (e < NEXP) inv[list[(size_t)e * NTOK + pos]] = (int)F.MISC[e] * 256 + pos; }
        }
        typedef SchedMoe<8, true> SM;
        SM S{(const char*)XN, (const char*)(ws + WS_WGUT), F.MISC, (const LAS unsigned*)(F.lds + GTAB_OFF), (int)blockIdx.x, F.G, nrb, (size_t)2048 * 1024, (size_t)256 * 1024};
        S.build(F.tid);
        { Unit u; LAS unsigned* gt = (LAS unsigned*)(F.lds + GTAB_OFF);
          for (int k = 0; k < GTAB_UNITS && S.next(k, u); ++k) { const int e = u.aux, j256 = (u.pm - (int)F.MISC[e]) * 256, ecnt = (int)F.MISC[40 + e];
              for (int r = F.tid; r < 256; r += NWAVES * 64) { const int pos = j256 + r; int tok = 0; if (pos < ecnt) tok = list[(size_t)e * NTOK + pos] >> 2; gt[k * 256 + r] = (unsigned)tok * 1024u; } } }
        __syncthreads();
        EpiAct E{args.in[22], (unsigned char*)ACT};
        pg8::gemm_phase<EpiAct, SM, true>(F.lds + RING_OFF, S, E, 1024, 1024, 8);
    } SEAM(7);
    if (IN(8)) {
        const int nrb = moe_tables(F);
        typedef SchedMoe<4, true> SM;
        SM S{(const char*)ACT, (const char*)(ws + WS_WDNT), F.MISC, (const LAS unsigned*)(F.lds + GTAB_OFF), (int)blockIdx.x, F.G, nrb, (size_t)1024 * 1024, (size_t)256 * 1024};
        S.build(F.tid);
        { Unit u; LAS unsigned* gt = (LAS unsigned*)(F.lds + GTAB_OFF);
          for (int k = 0; k < GTAB_UNITS && S.next(k, u); ++k) for (int r = F.tid; r < 256; r += NWAVES * 64) gt[k * 256 + r] = (unsigned)(u.pm * 256 + r) * 1024u; }
        __syncthreads();
        EpiDown E{args.in[24], (unsigned char*)Y2};
        pg8::gemm_phase<EpiDown, SM, true>(F.lds + RING_OFF, S, E, 1024, 1024, 8);
    } SEAM(8);
    if (IN(9)) { phaseJ(F, args); }
#undef IN
#undef SEAM
}
extern "C" void kernel_launch(void* const* d_in, const int* in_sizes, int n_in, void* d_out, int out_size, void* d_ws, size_t ws_size, hipStream_t stream) {
    if (n_in != 25 || in_sizes[0] != NTOK * D || out_size != NTOK * D || ws_size < WS_END) { fprintf(stderr, "kernel_launch: unexpected shapes (n_in %d in0 %d out %d ws %zu)\n", n_in, n_in > 0 ? in_sizes[0] : -1, out_size, ws_size); return; }
    static int grid = 0;
    if (grid == 0) {
        int dev = 0, cus = 0, per_cu = 0;
        if (hipGetDevice(&dev) != hipSuccess || hipDeviceGetAttribute(&cus, hipDeviceAttributeMultiprocessorCount, dev) != hipSuccess) { fprintf(stderr, "kernel_launch: device query failed\n"); grid = -1; return; }
        if (hipFuncSetAttribute((const void*)mega_fwd, hipFuncAttributeMaxDynamicSharedMemorySize, LDS_BYTES) != hipSuccess) { fprintf(stderr, "kernel_launch: hipFuncSetAttribute failed\n"); grid = -1; return; }
        if (hipOccupancyMaxActiveBlocksPerMultiprocessor(&per_cu, (const void*)mega_fwd, NWAVES * 64, LDS_BYTES) != hipSuccess || per_cu < 1) { fprintf(stderr, "kernel_launch: occupancy query says %d\n", per_cu); }
        (void)hipGetLastError();
        grid = cus;
    }
    if (grid < 0) return;
    if (hipMemsetAsync((unsigned char*)d_ws + WS_CTL, 0, CTL_ZERO_BYTES, stream) != hipSuccess) { fprintf(stderr, "kernel_launch: memset failed\n"); return; }
    Args a{};
    for (int i = 0; i < 25; ++i) a.in[i] = (const float*)d_in[i];
    a.out = (float*)d_out; a.ws = (unsigned char*)d_ws; a.ph_lo = 0; a.ph_hi = N_PHASES;
    hipLaunchKernelGGL(mega_fwd, dim3(grid), dim3(NWAVES * 64), LDS_BYTES, stream, a);
    if (hipPeekAtLastError() != hipSuccess) fprintf(stderr, "kernel_launch: launch failed\n");
}
```
